# Optimizing an MI355X kernel written in HIP

```python
import jax
import jax.numpy as jnp
from jax import lax
import numpy as np

D_MODEL = 1024
BATCH = 16
SEQ = 4096
DEPTH = 4

GRID_W = 64
CTX_LEN = 256
HEAD_DIM = 64
BLOCK = 128
ROPE_THETA = 10000.0
NEG_INF = -1e30
EPS = 1e-6

NA_HEADS = 4
NA_ROWS = 8
NA_COLS = 16
GQA_HEADS = 4
GQA_KV_HEADS = 2
WIN_HEADS = 4
WIN_KV_HEADS = 2
WINDOW = 128
MLA_HEADS = 4
MLA_Q_RANK = 256
MLA_KV_RANK = 128
MLA_NOPE = 64
MLA_ROPE = 32
MLA_V = 64

D_MIX = NA_HEADS * HEAD_DIM + GQA_HEADS * HEAD_DIM + WIN_HEADS * HEAD_DIM + MLA_HEADS * MLA_V
PROJ_SPLITS = ((NA_HEADS * HEAD_DIM,) * 3
               + (GQA_HEADS * HEAD_DIM, GQA_KV_HEADS * HEAD_DIM, GQA_KV_HEADS * HEAD_DIM)
               + (WIN_HEADS * HEAD_DIM, WIN_KV_HEADS * HEAD_DIM, WIN_KV_HEADS * HEAD_DIM)
               + (MLA_Q_RANK, MLA_KV_RANK, MLA_ROPE))
D_PROJ = sum(PROJ_SPLITS)
PROJ_OFFSETS = tuple(int(o) for o in np.cumsum(PROJ_SPLITS)[:-1])

N_GROUPS = 4
EXPERTS_PER_GROUP = 4
N_EXPERTS = N_GROUPS * EXPERTS_PER_GROUP
TOP_K = 2
D_EXPERT = 512

ALPHA = (2.0 * DEPTH) ** 0.25
BETA = (8.0 * DEPTH) ** -0.25

kernel_name = 'hybrid_dit_parallel_heads_hmoe'


def _layer_norm(x, g=None, b=None):
    xf = x.astype(jnp.float32)
    mu = jnp.mean(xf, -1, keepdims=True)
    var = jnp.mean(jnp.square(xf - mu), -1, keepdims=True)
    y = (xf - mu) * lax.rsqrt(var + EPS)
    if g is not None:
        y = y * g.astype(jnp.float32) + b.astype(jnp.float32)
    return y.astype(x.dtype)


def _rms_norm(x, g):
    xf = x.astype(jnp.float32)
    y = xf * lax.rsqrt(jnp.mean(xf * xf, -1, keepdims=True) + EPS) * g.astype(jnp.float32)
    return y.astype(x.dtype)


def _heads(z, n):
    return z.reshape(z.shape[0], z.shape[1], n, -1)


def _rope_1d(x, pos):
    d = x.shape[-1]
    freq = ROPE_THETA ** (-jnp.arange(0, d, 2, dtype=jnp.float32) / d)
    ang = pos.astype(jnp.float32)[:, None] * freq[None, :]
    cos = jnp.cos(ang)[:, None, :]
    sin = jnp.sin(ang)[:, None, :]
    x1 = x[..., : d // 2].astype(jnp.float32)
    x2 = x[..., d // 2:].astype(jnp.float32)
    return jnp.concatenate([x1 * cos - x2 * sin, x1 * sin + x2 * cos], -1).astype(x.dtype)


def _rope_2d(x, row, col):
    h = x.shape[-1] // 2
    return jnp.concatenate([_rope_1d(x[..., :h], row), _rope_1d(x[..., h:], col)], -1)


def _gqa_dense(q, k, v, sink=None):
    b, tq, hq, dk = q.shape
    hkv, dv = k.shape[2], v.shape[-1]
    g = hq // hkv
    scale = dk ** -0.5
    qb = q.reshape(b, tq // BLOCK, BLOCK, hkv, g, dk).transpose(1, 0, 2, 3, 4, 5)

    def one(qi):
        s = jnp.einsum('bqkgd,bskd->bkgqs', qi, k).astype(jnp.float32) * scale
        if sink is not None:
            s_sink = jnp.broadcast_to(sink.astype(jnp.float32).reshape(1, hkv, g, 1, 1), s.shape[:-1] + (1,))
            p = jax.nn.softmax(jnp.concatenate([s, s_sink], -1), -1)[..., :-1]
        else:
            p = jax.nn.softmax(s, -1)
        return jnp.einsum('bkgqs,bskd->bqkgd', p.astype(v.dtype), v)

    o = lax.map(one, qb)
    return o.transpose(1, 0, 2, 3, 4, 5).reshape(b, tq, hq * dv)


def _window_attn(q, k, v, kc, vc, sink):
    b, t, hq, dk = q.shape
    hkv, dv = k.shape[2], v.shape[-1]
    g = hq // hkv
    n_blk = t // BLOCK
    span = BLOCK + 2 * WINDOW
    scale = dk ** -0.5
    pad = ((0, 0), (WINDOW, WINDOW), (0, 0), (0, 0))
    kp = jnp.pad(k, pad)
    vp = jnp.pad(v, pad)
    k_rel = jnp.arange(span) - WINDOW
    band = jnp.abs(jnp.arange(BLOCK)[:, None] - k_rel[None, :]) <= WINDOW
    sink_l = sink.astype(jnp.float32).reshape(1, hkv, g, 1, 1)
    qb = q.reshape(b, n_blk, BLOCK, hkv, g, dk).transpose(1, 0, 2, 3, 4, 5)

    def one(args):
        n, qi = args
        start = n * BLOCK
        kw = lax.dynamic_slice_in_dim(kp, start, span, axis=1)
        vw = lax.dynamic_slice_in_dim(vp, start, span, axis=1)
        k_abs = start + k_rel
        mask = band & ((k_abs >= 0) & (k_abs < t))[None, :]
        s_loc = jnp.einsum('bqkgd,bskd->bkgqs', qi, kw).astype(jnp.float32) * scale
        s_loc = jnp.where(mask, s_loc, NEG_INF)
        s_ctx = jnp.einsum('bqkgd,blkd->bkgql', qi, kc).astype(jnp.float32) * scale
        s_sink = jnp.broadcast_to(sink_l, s_ctx.shape[:-1] + (1,))
        p = jax.nn.softmax(jnp.concatenate([s_loc, s_ctx, s_sink], -1), -1).astype(v.dtype)
        return (jnp.einsum('bkgqs,bskd->bqkgd', p[..., :span], vw)
                + jnp.einsum('bkgql,blkd->bqkgd', p[..., span:-1], vc))

    o = lax.map(one, (jnp.arange(n_blk), qb))
    return o.transpose(1, 0, 2, 3, 4, 5).reshape(b, t, hq * dv)


def _neighbourhood_attn(q, k, v, kc, vc, bias):
    b, t, h, d = q.shape
    rows = t // GRID_W
    kr = min(NA_ROWS, rows)
    nk = kr * NA_COLS
    scale = d ** -0.5
    cols = jnp.arange(GRID_W)
    c0 = jnp.clip(cols - NA_COLS // 2, 0, GRID_W - NA_COLS)
    key_col = c0[:, None, None] + jnp.arange(NA_COLS)[None, None, :]
    col_off = key_col - cols[:, None, None] + (NA_COLS - 1)
    dr = jnp.arange(kr)
    qb = q.reshape(b, rows, GRID_W, h, d).transpose(1, 0, 2, 3, 4)

    def one(args):
        r, qi = args
        r0 = jnp.clip(r - kr // 2, 0, rows - kr)
        key_row = r0 + dr
        idx = (key_row[None, :, None] * GRID_W + key_col).reshape(GRID_W, nk)
        rb = bias[:, (key_row - r + NA_ROWS - 1)[None, :, None], col_off].reshape(h, GRID_W, nk)
        kg = jnp.take(k, idx, axis=1)
        vg = jnp.take(v, idx, axis=1)
        s_loc = jnp.einsum('bqhd,bqkhd->bhqk', qi, kg).astype(jnp.float32) * scale + rb.astype(jnp.float32)[None]
        s_ctx = jnp.einsum('bqhd,blhd->bhql', qi, kc).astype(jnp.float32) * scale
        p = jax.nn.softmax(jnp.concatenate([s_loc, s_ctx], -1), -1).astype(v.dtype)
        return (jnp.einsum('bhqk,bqkhd->bqhd', p[..., :nk], vg)
                + jnp.einsum('bhql,blhd->bqhd', p[..., nk:], vc))

    o = lax.map(one, (jnp.arange(rows), qb))
    return o.transpose(1, 0, 2, 3, 4).reshape(b, t, h * d)


def _mla_q(cq, gain, w_qb):
    return _heads(_rms_norm(cq, gain) @ w_qb, MLA_HEADS)


def _mla_kv(ckv, gain, w_kvb):
    kv = _heads(_rms_norm(ckv, gain) @ w_kvb, MLA_HEADS)
    return kv[..., :MLA_NOPE], kv[..., MLA_NOPE:]


def _mla_key(k_nope, k_rope):
    return jnp.concatenate([k_nope, jnp.broadcast_to(k_rope, k_nope.shape[:3] + (MLA_ROPE,))], -1)


def _token_mix(h, hc, row, col, w_in, na_bias, gqa_q_gain, gqa_k_gain, win_sink,
               mla_q_gain, mla_w_qb, mla_kv_gain, mla_w_kvb, w_out, with_ctx):
    aq, ak, av, bq, bk, bv, cq, ck, cv, dq, dkv, dkr = jnp.split(h @ w_in, PROJ_OFFSETS, axis=-1)
    aqc, akc, avc, bqc, bkc, bvc, cqc, ckc, cvc, dqc, dkvc, dkrc = jnp.split(hc @ w_in, PROJ_OFFSETS, axis=-1)

    ka_c, va_c = _heads(akc, NA_HEADS), _heads(avc, NA_HEADS)
    out_a = _neighbourhood_attn(_heads(aq, NA_HEADS), _heads(ak, NA_HEADS), _heads(av, NA_HEADS),
                                ka_c, va_c, na_bias)

    qb = _rope_2d(_rms_norm(_heads(bq, GQA_HEADS), gqa_q_gain), row, col)
    kb = _rope_2d(_rms_norm(_heads(bk, GQA_KV_HEADS), gqa_k_gain), row, col)
    kb_c = _rms_norm(_heads(bkc, GQA_KV_HEADS), gqa_k_gain)
    vb_c = _heads(bvc, GQA_KV_HEADS)
    out_b = _gqa_dense(qb, jnp.concatenate([kb, kb_c], 1),
                       jnp.concatenate([_heads(bv, GQA_KV_HEADS), vb_c], 1))

    kc_c, vc_c = _heads(ckc, WIN_KV_HEADS), _heads(cvc, WIN_KV_HEADS)
    out_c = _window_attn(_rope_2d(_heads(cq, WIN_HEADS), row, col),
                         _rope_2d(_heads(ck, WIN_KV_HEADS), row, col),
                         _heads(cv, WIN_KV_HEADS), kc_c, vc_c, win_sink)

    qd = _mla_q(dq, mla_q_gain, mla_w_qb)
    qd = jnp.concatenate([qd[..., :MLA_NOPE], _rope_2d(qd[..., MLA_NOPE:], row, col)], -1)
    kn, vd = _mla_kv(dkv, mla_kv_gain, mla_w_kvb)
    kd = _mla_key(kn, _rope_2d(dkr[:, :, None, :], row, col))
    kn_c, vd_c = _mla_kv(dkvc, mla_kv_gain, mla_w_kvb)
    kd_c = _mla_key(kn_c, dkrc[:, :, None, :])
    out_d = _gqa_dense(qd, jnp.concatenate([kd, kd_c], 1), jnp.concatenate([vd, vd_c], 1))

    mix = jnp.concatenate([out_a, out_b, out_c, out_d], -1) @ w_out
    if not with_ctx:
        return mix, None
    mix_c = jnp.concatenate([
        _gqa_dense(_heads(aqc, NA_HEADS), ka_c, va_c),
        _gqa_dense(_rms_norm(_heads(bqc, GQA_HEADS), gqa_q_gain), kb_c, vb_c),
        _gqa_dense(_heads(cqc, WIN_HEADS), kc_c, vc_c, win_sink),
        _gqa_dense(_mla_q(dqc, mla_q_gain, mla_w_qb), kd_c, vd_c),
    ], -1) @ w_out
    return mix, mix_c


def _hier_moe(h, wg, bg, we, be, w_gate, w_up, w_down):
    shp = h.shape
    hf = h.reshape(-1, shp[-1])
    lg = (hf @ wg).astype(jnp.float32) + bg.astype(jnp.float32)
    grp = jnp.argmax(lg, -1)
    p_grp = jnp.max(jax.nn.softmax(lg, -1), -1, keepdims=True)
    le = ((hf @ we).astype(jnp.float32) + be.astype(jnp.float32)).reshape(-1, N_GROUPS, EXPERTS_PER_GROUP)
    le_sel = jnp.take_along_axis(le, grp[:, None, None], axis=1)[:, 0]
    top_v, top_i = lax.top_k(le_sel, TOP_K)
    w_top = jax.nn.softmax(top_v, -1) * p_grp
    eid = grp[:, None] * EXPERTS_PER_GROUP + top_i
    gate = jnp.einsum('nke,nk->ne', jax.nn.one_hot(eid, N_EXPERTS, dtype=jnp.float32), w_top)
    y = jnp.zeros(hf.shape, jnp.float32)
    for e in range(N_EXPERTS):
        a = jax.nn.silu(hf @ w_gate[e]) * (hf @ w_up[e])
        y = y + gate[:, e:e + 1] * (a @ w_down[e]).astype(jnp.float32)
    return y.astype(h.dtype).reshape(shp)


def setup_inputs(seed: int = 0) -> dict:
    key = jax.random.key(seed)
    ks = iter(jax.random.split(key, 32))

    def nrm(shape, s):
        return jax.random.normal(next(ks), shape, jnp.float32) * s

    L, D = DEPTH, D_MODEL
    return {
        'x': nrm((BATCH, SEQ, D), 1.0),
        'c': nrm((BATCH, D), 1.0),
        'ctx': nrm((BATCH, CTX_LEN, D), 1.0),
        'c_ctx': nrm((D,), 1.0),
        'w_ada': nrm((L, D, 6 * D), 0.5 * D ** -0.5),
        'b_ada': nrm((L, 6 * D), 0.02),
        'w_in': nrm((L, D, D_PROJ), D ** -0.5),
        'na_bias': nrm((L, NA_HEADS, 2 * NA_ROWS - 1, 2 * NA_COLS - 1), 0.1),
        'gqa_q_gain': 1.0 + nrm((L, HEAD_DIM), 0.02),
        'gqa_k_gain': 1.0 + nrm((L, HEAD_DIM), 0.02),
        'win_sink': nrm((L, WIN_HEADS), 0.5),
        'mla_q_gain': 1.0 + nrm((L, MLA_Q_RANK), 0.02),
        'mla_w_qb': nrm((L, MLA_Q_RANK, MLA_HEADS * (MLA_NOPE + MLA_ROPE)), MLA_Q_RANK ** -0.5),
        'mla_kv_gain': 1.0 + nrm((L, MLA_KV_RANK), 0.02),
        'mla_w_kvb': nrm((L, MLA_KV_RANK, MLA_HEADS * (MLA_NOPE + MLA_V)), MLA_KV_RANK ** -0.5),
        'w_out': nrm((L, D_MIX, D), BETA * D_MIX ** -0.5),
        'ln1_g': 1.0 + nrm((L, D), 0.02),
        'ln1_b': nrm((L, D), 0.02),
        'router_group_w': nrm((L, D, N_GROUPS), D ** -0.5),
        'router_group_b': nrm((L, N_GROUPS), 0.01),
        'router_expert_w': nrm((L, D, N_EXPERTS), D ** -0.5),
        'router_expert_b': nrm((L, N_EXPERTS), 0.01),
        'moe_w_gate': nrm((L, N_EXPERTS, D, D_EXPERT), D ** -0.5),
        'moe_w_up': nrm((L, N_EXPERTS, D, D_EXPERT), D ** -0.5),
        'moe_w_down': nrm((L, N_EXPERTS, D_EXPERT, D), BETA * D_EXPERT ** -0.5),
        'ln2_g': 1.0 + nrm((L, D), 0.02),
        'ln2_b': nrm((L, D), 0.02),
    }


def reference(x, c, ctx, c_ctx, w_ada, b_ada, w_in, na_bias, gqa_q_gain, gqa_k_gain, win_sink,
              mla_q_gain, mla_w_qb, mla_kv_gain, mla_w_kvb, w_out, ln1_g, ln1_b,
              router_group_w, router_group_b, router_expert_w, router_expert_b,
              moe_w_gate, moe_w_up, moe_w_down, ln2_g, ln2_b):
    t = x.shape[1]
    pos = jnp.arange(t)
    row = pos // GRID_W
    col = pos % GRID_W
    xc = ctx
    for l in range(DEPTH):
        with_ctx = l < DEPTH - 1
        mod = jax.nn.silu(c) @ w_ada[l] + b_ada[l]
        sh1, sc1, g1, sh2, sc2, g2 = jnp.split(mod[:, None, :], 6, axis=-1)
        sh1c, sc1c, g1c, sh2c, sc2c, g2c = jnp.split(jax.nn.silu(c_ctx) @ w_ada[l] + b_ada[l], 6, axis=-1)

        h = _layer_norm(x) * (1 + sc1) + sh1
        hc = _layer_norm(xc) * (1 + sc1c) + sh1c
        mix, mix_c = _token_mix(h, hc, row, col, w_in[l], na_bias[l], gqa_q_gain[l], gqa_k_gain[l],
                                win_sink[l], mla_q_gain[l], mla_w_qb[l], mla_kv_gain[l], mla_w_kvb[l],
                                w_out[l], with_ctx)
        x = _layer_norm(ALPHA * x + g1 * mix, ln1_g[l], ln1_b[l])
        moe_p = (router_group_w[l], router_group_b[l], router_expert_w[l], router_expert_b[l],
                 moe_w_gate[l], moe_w_up[l], moe_w_down[l])
        x = _layer_norm(ALPHA * x + g2 * _hier_moe(_layer_norm(x) * (1 + sc2) + sh2, *moe_p),
                        ln2_g[l], ln2_b[l])
        if with_ctx:
            xc = _layer_norm(ALPHA * xc + g1c * mix_c, ln1_g[l], ln1_b[l])
            xc = _layer_norm(ALPHA * xc + g2c * _hier_moe(_layer_norm(xc) * (1 + sc2c) + sh2c, *moe_p),
                             ln2_g[l], ln2_b[l])
    return x
```

```cpp
#include <hip/hip_runtime.h>
#include <cstdio>
#include <cstdint>
namespace pg8 {
#define PG8_LAS __attribute__((address_space(3)))
typedef unsigned short bf16_t;
typedef short bf16x8 __attribute__((ext_vector_type(8)));
typedef float f32x4 __attribute__((ext_vector_type(4)));
typedef unsigned u32x4 __attribute__((ext_vector_type(4)));
constexpr int BM = 256, BK = 64, HALF = 128, HTB = HALF * BK * 2  , STAGE_BYTES = 8 * HTB, NXCD = 8, WGM = 8;

__host__ __device__ __forceinline__ int lds_byte(int r, int c) { const int st = (r >> 4) * 2 + (c >> 5), rr = r & 15, cc = c & 31, ob = rr * 64 + cc * 2; return st * 1024 + (ob ^ (((ob >> 9) & 1) << 5)); }
__host__ __device__ __forceinline__ void stage_rc(int b, int& R, int& C) { const int st = b / 1024, sb = b % 1024, swz = sb ^ (((sb >> 9) & 1) << 5); R = (st >> 1) * 16 + swz / 64; C = (st & 1) * 32 + (swz % 64) / 2; }
__host__ __device__ __forceinline__ int perm32(int rho) { const int n = rho >> 4, i = rho & 15; return 8 * (i >> 2) + 4 * n + (i & 3); }

struct Unit { int pm, pn; };
struct Gemm { const bf16_t* A; const bf16_t* Bt; int M, N, K, lda; };

struct StaticOrder {
    int nM, nN, nwg, G, c;
    __host__ __device__ void init(int M, int N, int G_, int c_) { nM = M / BM; nN = N / BM; nwg = nM * nN; G = G_; c = c_; }
    __host__ __device__ bool next(int i, Unit& u) const {
        const long L = (long)i * G + c; if (L >= nwg) return false;
        int wgid = (int)L; { const int q = nwg / NXCD, r = nwg % NXCD, xcd = wgid % NXCD, off = wgid / NXCD; wgid = (xcd < r ? xcd * (q + 1) : r * (q + 1) + (xcd - r) * q) + off; }
        const int nig = WGM * nN, gid = wgid / nig, fm = gid * WGM, gsz = (nM - fm) < WGM ? (nM - fm) : WGM;
        u.pm = fm + ((wgid % nig) % gsz); u.pn = (wgid % nig) / gsz; return true;
    }
    __device__ __forceinline__ void a_ready(const Unit&) const {}
    __device__ __forceinline__ void done(const Unit&) const {}
};

__device__ __forceinline__ unsigned cvt_pk_bf16(float lo, float hi) { unsigned r; asm volatile("v_cvt_pk_bf16_f32 %0, %1, %2" : "=v"(r) : "v"(lo), "v"(hi)); return r; }
typedef float f32x2 __attribute__((ext_vector_type(2)));
__device__ __forceinline__ f32x2 gelu_pk(f32x2 v) {
    const f32x2 av = __builtin_elementwise_abs(v), d = av * 0.2316418882f + 1.0f;
    f32x2 t; t.x = __builtin_amdgcn_rcpf(d.x); t.y = __builtin_amdgcn_rcpf(d.y);
    f32x2 q = t * 0.5307027145f + (-0.7265760135f); q = q * t + 0.7107068705f; q = q * t + (-0.142248368f); q = q * t + 0.127414796f; q = q * t;
    const f32x2 s = (v * v) * (-0.72134752044f);
    f32x2 e; e.x = __builtin_amdgcn_exp2f(s.x); e.y = __builtin_amdgcn_exp2f(s.y);
    const f32x2 m = v * (q * e), r = v - m;
    f32x2 o; o.x = v.x < 0.f ? m.x : r.x; o.y = v.y < 0.f ? m.y : r.y; return o;
}

template <int ACT  > struct EpiBf16 {
    static constexpr bool PERM = true, AFTER_DRAIN = false; static_assert(ACT == 0 || ACT == 1, "EpiBf16: ACT is 0 (none) or 1 (gelu_pk)");
    bf16_t* O; int ldc; const float* bias; int split_cols; size_t split_stride; float scale0;
    __device__ __forceinline__ void operator()(const f32x4 (&acc)[2][2][4][2], const Unit& u, int wr, int wc, int fr, int fq) const {
        const int row0 = u.pm * BM + wr * 64 + fr; int colt = u.pn * BM; bf16_t* base = O;
        float sc = 1.f; if (split_cols) { const int t = colt / split_cols; base += (size_t)t * split_stride; colt -= t * split_cols; if (t == 0) sc = scale0; }
        const int col0 = colt + wc * 32 + 8 * fq, bcol0 = u.pn * BM + wc * 32 + 8 * fq;
        f32x4 bv[2][2];
#pragma unroll
        for (int bj = 0; bj < 2; ++bj)
#pragma unroll
            for (int n = 0; n < 2; ++n) bv[bj][n] = bias ? *(const f32x4*)(bias + bcol0 + bj * HALF + 4 * n) : (f32x4){0.f, 0.f, 0.f, 0.f};
#pragma unroll
        for (int ai = 0; ai < 2; ++ai)
#pragma unroll
            for (int m = 0; m < 4; ++m) { bf16_t* rowp = base + (size_t)(row0 + ai * HALF + m * 16) * ldc + col0;
#pragma unroll
                for (int bj = 0; bj < 2; ++bj) { f32x4 v0 = acc[ai][bj][m][0] + bv[bj][0], v1 = acc[ai][bj][m][1] + bv[bj][1];
                    if (ACT == 1) { f32x2 a = gelu_pk((f32x2){v0[0], v0[1]}), b = gelu_pk((f32x2){v0[2], v0[3]}), c = gelu_pk((f32x2){v1[0], v1[1]}), d = gelu_pk((f32x2){v1[2], v1[3]});
                        v0 = (f32x4){a.x, a.y, b.x, b.y}; v1 = (f32x4){c.x, c.y, d.x, d.y}; }
                    v0 = v0 * sc; v1 = v1 * sc; u32x4 w; w.x = cvt_pk_bf16(v0[0], v0[1]); w.y = cvt_pk_bf16(v0[2], v0[3]); w.z = cvt_pk_bf16(v1[0], v1[1]); w.w = cvt_pk_bf16(v1[2], v1[3]);
                    *(u32x4*)(rowp + bj * HALF) = w; } }
    }
};
struct EpiF32 {
    static constexpr bool PERM = false, AFTER_DRAIN = false;
    float* C; int ldc; const float* bias;
    __device__ __forceinline__ void operator()(const f32x4 (&acc)[2][2][4][2], const Unit& u, int wr, int wc, int fr, int fq) const {
        const int row0 = u.pm * BM + wr * 64 + fr, col0 = u.pn * BM + wc * 32 + 4 * fq;
        f32x4 bv[2][2];
#pragma unroll
        for (int bj = 0; bj < 2; ++bj)
#pragma unroll
            for (int n = 0; n < 2; ++n) bv[bj][n] = bias ? *(const f32x4*)(bias + col0 + bj * HALF + n * 16) : (f32x4){0.f, 0.f, 0.f, 0.f};
#pragma unroll
        for (int ai = 0; ai < 2; ++ai)
#pragma unroll
            for (int m = 0; m < 4; ++m) { float* rowp = C + (size_t)(row0 + ai * HALF + m * 16) * ldc + col0;
#pragma unroll
                for (int bj = 0; bj < 2; ++bj)
#pragma unroll
                    for (int n = 0; n < 2; ++n) *(f32x4*)(rowp + bj * HALF + n * 16) = acc[ai][bj][m][n] + bv[bj][n]; }
    }
};
template <class Epi, class Sched, bool ALIGN_EPI = false, bool SP2 = false>
__device__ __forceinline__ void gemm_phase(PG8_LAS unsigned char* lds, const Gemm g, const Sched& S, const Epi& E) {
    int tid = threadIdx.x; asm volatile("" : "+v"(tid)); const int wid = __builtin_amdgcn_readfirstlane(tid >> 6), lane = tid & 63, wr = wid >> 2, wc = wid & 3, fr = lane & 15, fq = lane >> 4;
    const int K = g.K, nt = K / BK;
    unsigned voffA[2], voffB[2];
#pragma unroll
    for (int i = 0; i < 2; ++i) { int R, C; stage_rc(tid * 16 + i * 8192, R, C); const int Rb = Epi::PERM ? ((R & ~31) + perm32(R & 31)) : R;
        voffA[i] = (unsigned)(R * g.lda + C) * 2u; voffB[i] = (unsigned)(Rb * K + C) * 2u; }
    const size_t kstep = (size_t)(BK * 2);
    const size_t hstepA = (size_t)HALF * g.lda * 2, hstepB = (size_t)HALF * K * 2;
    const size_t tstepA = 2 * hstepA, tstepB = 2 * hstepB;
    const unsigned ldsw = (unsigned)wid * 1024u;
    const int aoff = lds_byte(wr * 64 + fr, fq * 8), boff = lds_byte(wc * 32 + fr, fq * 8);
#define PG8_SA(b, h) (((b) * 2 + (h)) * HTB)
#define PG8_SB(b, h) ((4 + (b) * 2 + (h)) * HTB)
#define PG8_STAGE(bufoff, gbase, voff) do { _Pragma("unroll") for (int _i = 0; _i < 2; ++_i) \
        __builtin_amdgcn_global_load_lds((const unsigned*)((const char*)(gbase) + (voff)[_i]), (PG8_LAS unsigned*)(lds + (bufoff) + ldsw + _i * 8192), 16, 0, 0); } while (0)
#define PG8_LDA(dst, b, h) do { _Pragma("unroll") for (int m = 0; m < 4; ++m) _Pragma("unroll") for (int k = 0; k < 2; ++k) dst[m][k] = *(const PG8_LAS bf16x8*)(lds + PG8_SA(b, h) + aoff + m * 2048 + k * 1024); } while (0)
#define PG8_LDB(dst, b, h) do { _Pragma("unroll") for (int n = 0; n < 2; ++n) _Pragma("unroll") for (int k = 0; k < 2; ++k) dst[n][k] = *(const PG8_LAS bf16x8*)(lds + PG8_SB(b, h) + boff + n * 2048 + k * 1024); } while (0)
#define PG8_MMA(ai, bj, At, Bt) do { __builtin_amdgcn_s_setprio(1); _Pragma("unroll") for (int m = 0; m < 4; ++m) _Pragma("unroll") for (int n = 0; n < 2; ++n) _Pragma("unroll") for (int k = 0; k < 2; ++k) \
        acc[ai][bj][m][n] = __builtin_amdgcn_mfma_f32_16x16x32_bf16(Bt[n][k], At[m][k], acc[ai][bj][m][n], 0, 0, 0); __builtin_amdgcn_s_setprio(0); } while (0)
#define PG8_WAIT_V(n) asm volatile("s_waitcnt vmcnt(" #n ")" ::: "memory")
#define PG8_WAIT_L(n) asm volatile("s_waitcnt lgkmcnt(" #n ")" ::: "memory")
#define PG8_BAR __builtin_amdgcn_s_barrier()
#define PG8_SCHED __builtin_amdgcn_sched_barrier(0)
    Unit cur, nxt; int ui = 0;
    if (!S.next(0, cur)) return;
    f32x4 acc[2][2][4][2];
#pragma unroll
    for (int a = 0; a < 2; ++a)
#pragma unroll
        for (int b = 0; b < 2; ++b)
#pragma unroll
            for (int m = 0; m < 4; ++m)
#pragma unroll
                for (int n = 0; n < 2; ++n) acc[a][b][m][n] = (f32x4){0.f, 0.f, 0.f, 0.f};
    bf16x8 At[4][2], B0[2][2], B1[2][2];
    const char* cA = (const char*)g.A + (size_t)cur.pm * tstepA; const char* cB = (const char*)g.Bt + (size_t)cur.pn * tstepB;
    S.a_ready(cur);
    if constexpr (SP2) {
        PG8_STAGE(PG8_SB(0, 0), cB, voffB); PG8_STAGE(PG8_SB(0, 1), cB + hstepB, voffB); PG8_STAGE(PG8_SA(0, 0), cA, voffA); PG8_STAGE(PG8_SA(0, 1), cA + hstepA, voffA);
        if (wr == 1) PG8_BAR;
        PG8_WAIT_V(2); PG8_BAR;
        PG8_STAGE(PG8_SB(1, 0), cB + kstep, voffB); PG8_STAGE(PG8_SA(1, 0), cA + kstep, voffA); PG8_STAGE(PG8_SB(1, 1), cB + hstepB + kstep, voffB);
        PG8_WAIT_V(6); PG8_BAR;
    } else {
        PG8_STAGE(PG8_SB(0, 0), cB, voffB); PG8_STAGE(PG8_SA(0, 0), cA, voffA); PG8_STAGE(PG8_SB(0, 1), cB + hstepB, voffB); PG8_STAGE(PG8_SA(0, 1), cA + hstepA, voffA);
        if (wr == 1) PG8_BAR;
        PG8_WAIT_V(4); PG8_BAR;
        PG8_STAGE(PG8_SB(1, 0), cB + kstep, voffB); PG8_STAGE(PG8_SA(1, 0), cA + kstep, voffA); PG8_STAGE(PG8_SB(1, 1), cB + hstepB + kstep, voffB);
        PG8_WAIT_V(6); PG8_BAR;
    }
    for (;;) {
        const bool has_next = S.next(ui + 1, nxt);
        const char* nA = has_next ? (const char*)g.A + (size_t)nxt.pm * tstepA : cA; const char* nB = has_next ? (const char*)g.Bt + (size_t)nxt.pn * tstepB : cB;
#pragma unroll 1
        for (int t = 0; t < nt; t += 2) {
            const bool last = (t == nt - 2);
            const char* a1 = cA + (size_t)(t + 1) * kstep;
            const char* a2 = last ? nA : cA + (size_t)(t + 2) * kstep; const char* b2 = last ? nB : cB + (size_t)(t + 2) * kstep;
            const char* a3 = a2 + kstep; const char* b3 = b2 + kstep;
            if (last && has_next) S.a_ready(nxt);
            if constexpr (SP2) {
            PG8_LDB(B0, 0, 0); PG8_LDB(B1, 0, 1); PG8_SCHED; PG8_LDA(At, 0, 0); PG8_STAGE(PG8_SA(1, 1), a1 + hstepA, voffA);
            PG8_WAIT_V(8); PG8_WAIT_L(0); PG8_BAR; PG8_MMA(0, 0, At, B0); PG8_MMA(0, 1, At, B1); PG8_BAR; PG8_SCHED;
            PG8_LDA(At, 0, 1); PG8_STAGE(PG8_SB(0, 0), b2, voffB); PG8_STAGE(PG8_SB(0, 1), b2 + hstepB, voffB); PG8_STAGE(PG8_SA(0, 0), a2, voffA);
            PG8_WAIT_V(8); PG8_WAIT_L(0); PG8_BAR; PG8_MMA(1, 0, At, B0); PG8_MMA(1, 1, At, B1); PG8_BAR; PG8_SCHED;
            PG8_LDB(B0, 1, 0); PG8_LDB(B1, 1, 1); PG8_SCHED; PG8_LDA(At, 1, 0); PG8_STAGE(PG8_SA(0, 1), a2 + hstepA, voffA);
            PG8_WAIT_V(8); PG8_WAIT_L(0); PG8_BAR; PG8_MMA(0, 0, At, B0); PG8_MMA(0, 1, At, B1); PG8_BAR; PG8_SCHED;
            PG8_LDA(At, 1, 1); PG8_STAGE(PG8_SB(1, 0), b3, voffB); PG8_STAGE(PG8_SB(1, 1), b3 + hstepB, voffB); PG8_STAGE(PG8_SA(1, 0), a3, voffA);
            PG8_WAIT_V(8); PG8_WAIT_L(0); PG8_BAR; PG8_MMA(1, 0, At, B0); PG8_MMA(1, 1, At, B1); PG8_BAR; PG8_SCHED;
            } else {
            PG8_LDB(B0, 0, 0); PG8_SCHED; PG8_LDA(At, 0, 0); PG8_STAGE(PG8_SA(1, 1), a1 + hstepA, voffA);
            PG8_WAIT_L(8); PG8_BAR; PG8_WAIT_L(0); PG8_MMA(0, 0, At, B0); PG8_BAR; PG8_SCHED;
            PG8_LDB(B1, 0, 1); PG8_STAGE(PG8_SB(0, 0), b2, voffB);
            PG8_BAR; PG8_WAIT_L(0); PG8_MMA(0, 1, At, B1); PG8_BAR;
            PG8_LDA(At, 0, 1); PG8_STAGE(PG8_SA(0, 0), a2, voffA);
            PG8_BAR; PG8_WAIT_L(0); PG8_MMA(1, 0, At, B0); PG8_BAR; PG8_SCHED;
            PG8_STAGE(PG8_SB(0, 1), b2 + hstepB, voffB);
            PG8_WAIT_V(6); PG8_BAR; PG8_MMA(1, 1, At, B1); PG8_BAR;
            PG8_LDB(B0, 1, 0); PG8_SCHED; PG8_LDA(At, 1, 0); PG8_STAGE(PG8_SA(0, 1), a2 + hstepA, voffA);
            PG8_WAIT_L(8); PG8_BAR; PG8_WAIT_L(0); PG8_MMA(0, 0, At, B0); PG8_BAR; PG8_SCHED;
            PG8_LDB(B1, 1, 1); PG8_STAGE(PG8_SB(1, 0), b3, voffB);
            PG8_BAR; PG8_WAIT_L(0); PG8_MMA(0, 1, At, B1); PG8_BAR;
            PG8_LDA(At, 1, 1); PG8_STAGE(PG8_SA(1, 0), a3, voffA);
            PG8_BAR; PG8_WAIT_L(0); PG8_MMA(1, 0, At, B0); PG8_BAR; PG8_SCHED;
            PG8_STAGE(PG8_SB(1, 1), b3 + hstepB, voffB);
            PG8_WAIT_V(6); PG8_BAR; PG8_MMA(1, 1, At, B1); PG8_BAR;
            }
        }
        if constexpr (ALIGN_EPI) { if (wr == 0) PG8_BAR; }
        if constexpr (!Epi::AFTER_DRAIN) { E(acc, cur, wr, wc, fr, fq); S.done(cur); }
        if (!has_next) break;
#pragma unroll
        for (int a = 0; a < 2; ++a)
#pragma unroll
            for (int b = 0; b < 2; ++b)
#pragma unroll
                for (int m = 0; m < 4; ++m)
#pragma unroll
                    for (int n = 0; n < 2; ++n) acc[a][b][m][n] = (f32x4){0.f, 0.f, 0.f, 0.f};
        cur = nxt; cA = nA; cB = nB; ++ui;
        if constexpr (ALIGN_EPI) { if (wr == 1) PG8_BAR; }
    }
    PG8_WAIT_V(0);
    if constexpr (!ALIGN_EPI) { if (wr == 0) PG8_BAR; }
    PG8_BAR;
    if constexpr (Epi::AFTER_DRAIN) { E.fused(acc, cur, wr, wc, fr, fq, lds, wid, lane); S.done(cur); }
#undef PG8_SA
#undef PG8_SB
#undef PG8_STAGE
#undef PG8_LDA
#undef PG8_LDB
#undef PG8_MMA
#undef PG8_WAIT_V
#undef PG8_WAIT_L
#undef PG8_BAR
#undef PG8_SCHED
}
}

constexpr int NB = 16, SEQ = 4096, CTX = 256, TT = SEQ + CTX, M = NB * TT, D = 1024, NL = 4;
constexpr int NPJ = 2304, DPROJ = 2208;
constexpr int MS = 143360;
constexpr float EPS = 1e-6f, ALPHA = 1.6817928305074290f, LOG2E = 1.4426950408889634f;
constexpr int NWAVES = 8, NTHR = 512;
#ifndef MK_MULTI
#define MK_MULTI 1
#endif
constexpr int NPHASE = 2 + 10 * NL;

constexpr size_t WS_CTL = 0, CTL_BYTES = 65536;
constexpr size_t WS_MODS = WS_CTL + CTL_BYTES;
constexpr size_t WS_T64 = WS_MODS + (size_t)NL * 17 * 6144 * 4;
constexpr size_t WS_T32 = WS_T64 + 8192;
constexpr size_t WS_RS = WS_T32 + 4096;
constexpr size_t WS_RT = WS_RS + (size_t)M * 8;
constexpr size_t WS_HIST = WS_RT + (size_t)M * 32;
constexpr size_t WS_XC = WS_HIST + 65536;
constexpr size_t WS_WIN = WS_XC + (size_t)NB * CTX * D * 4;
constexpr size_t WS_WD = WS_WIN + (size_t)NL * NPJ * D * 2;
constexpr size_t WS_WOUT = WS_WD + (size_t)NL * 1024 * 384 * 2;
constexpr size_t WS_WGU = WS_WOUT + (size_t)NL * D * D * 2;
constexpr size_t WS_WDN = WS_WGU + (size_t)NL * 16 * 1024 * 1024 * 2;
constexpr size_t WS_HA = WS_WDN + (size_t)NL * 16 * 1024 * 512 * 2;
constexpr size_t WS_PB = WS_HA + (size_t)M * D * 2;
constexpr size_t WS_QD = WS_PB + (size_t)M * NPJ * 2;
constexpr size_t WS_KD = WS_QD + (size_t)M * 384 * 2;
constexpr size_t WS_VD = WS_KD + (size_t)M * 384 * 2;
constexpr size_t WS_ACT = WS_VD + (size_t)M * 256 * 2;
constexpr size_t WS_END = WS_ACT + (size_t)MS * 512 * 2;
static_assert(WS_END <= (size_t)1073741824, "d_ws map must fit 1 GiB");
static_assert((size_t)M * NPJ * 2 >= (size_t)MS * D * 2 && (size_t)M * NPJ * 2 >= (size_t)M * D * 4, "region PB overlays");
constexpr int CW_BAR = 0;
constexpr int CW_QUEUE = 4096;

constexpr int RING_BYTES = 131072, MISC_OFF = RING_BYTES, LDS_BYTES = 147456;
constexpr int MI_BAR = 0, MI_Q = 4, MI_TOT = 16, MI_BASE = 32, MI_PST = 48, MI_LH = 80;

#define GAS __attribute__((address_space(1)))
#define LAS __attribute__((address_space(3)))
typedef unsigned short bf16;
typedef unsigned v4u __attribute__((ext_vector_type(4)));
typedef unsigned v2u __attribute__((ext_vector_type(2)));
typedef float f32x4 __attribute__((ext_vector_type(4)));
typedef float f32x2 __attribute__((ext_vector_type(2)));
typedef short bf16x8 __attribute__((ext_vector_type(8)));
typedef float f32x16 __attribute__((ext_vector_type(16)));
typedef short v4i16 __attribute__((ext_vector_type(4)));

__device__ __forceinline__ unsigned f2bf(float f) { unsigned u = __builtin_bit_cast(unsigned, f); return (u + 0x7fffu + ((u >> 16) & 1u)) >> 16; }
__device__ __forceinline__ unsigned pk2(float lo, float hi) { return f2bf(lo) | (f2bf(hi) << 16); }
__device__ __forceinline__ float bflo(unsigned w) { return __builtin_bit_cast(float, w << 16); }
__device__ __forceinline__ float bfhi(unsigned w) { return __builtin_bit_cast(float, w & 0xffff0000u); }
__device__ __forceinline__ void unpack8(v4u w, float (&f)[8]) { f[0] = bflo(w.x); f[1] = bfhi(w.x); f[2] = bflo(w.y); f[3] = bfhi(w.y); f[4] = bflo(w.z); f[5] = bfhi(w.z); f[6] = bflo(w.w); f[7] = bfhi(w.w); }
__device__ __forceinline__ v4u pack8(const float (&f)[8]) { v4u w; w.x = pk2(f[0], f[1]); w.y = pk2(f[2], f[3]); w.z = pk2(f[4], f[5]); w.w = pk2(f[6], f[7]); return w; }
__device__ __forceinline__ float wave_sum(float v) {
#pragma unroll
    for (int o = 1; o < 64; o <<= 1) v += __shfl_xor(v, o);
    return v;
}

#define XB_TMO      128
#define XB_XCNT(j)  (256  + 64 * (j))
#define XB_XSUB(j)  (1280 + 64 * (j))
#define XB_XGEN(j)  (2304 + 64 * (j))
#define XB_TOP      3328
#define XB_TOPGEN   3392
#define XCD_BAR_WORDS 3456
#define XB_SPIN_CAP (1u << 22)
__device__ __forceinline__ unsigned xb_ld(unsigned* p)              { return __hip_atomic_load(p, __ATOMIC_RELAXED, __HIP_MEMORY_SCOPE_AGENT); }
__device__ __forceinline__ unsigned xb_add(unsigned* p, unsigned v) { return __hip_atomic_fetch_add(p, v, __ATOMIC_RELAXED, __HIP_MEMORY_SCOPE_AGENT); }
__device__ __forceinline__ unsigned xb_xcc_id() { return (unsigned)__builtin_amdgcn_s_getreg((3 << 11) | 20) & 0xFu; }
#define XB_SPIN(cond, bar) do { unsigned _sp = 0; while (cond) { __builtin_amdgcn_s_sleep(1); \
    if ((++_sp & 255u) == 0u) { if (xb_ld(&(bar)[XB_TMO])) break; if (_sp > XB_SPIN_CAP) { atomicAdd(&(bar)[XB_TMO], 1u); break; } } } } while (0)
struct XcdBarrier { unsigned* bar; unsigned x; volatile LAS unsigned* st; };
__device__ __forceinline__ XcdBarrier xcd_barrier_post(unsigned* bar, volatile LAS unsigned* st) {
    XcdBarrier b; b.bar = bar; b.x = xb_xcc_id(); b.st = st;
    if (threadIdx.x == 0) (void)xb_add(&bar[XB_XCNT(b.x)], 1u);
    return b;
}
__device__ __forceinline__ void xcd_barrier_complete(unsigned* bar, unsigned x, unsigned& nloc, unsigned& nx) {
    const unsigned G = gridDim.x * gridDim.y * gridDim.z;
    unsigned sum, cnt, mine, sp = 0u;
    for (;;) {
        sum = 0u; cnt = 0u; mine = 0u;
#pragma unroll
        for (unsigned j = 0; j < 16; ++j) { const unsigned c = xb_ld(&bar[XB_XCNT(j)]); sum += c; cnt += (c > 0u) ? 1u : 0u; mine = (j == x) ? c : mine; }
        if (sum == G) break;
        __builtin_amdgcn_s_sleep(1);
        if ((++sp & 255u) == 0u) { if (xb_ld(&bar[XB_TMO])) break; if (sp > XB_SPIN_CAP) { atomicAdd(&bar[XB_TMO], 1u); break; } }
    }
    nloc = mine > 0u ? mine : 1u; nx = cnt > 0u ? cnt : 1u;
}
__device__ __forceinline__ void xcd_barrier(const XcdBarrier& b) {
    asm volatile("s_waitcnt vmcnt(0)" ::: "memory");
    __syncthreads();
    if (threadIdx.x == 0) {
        unsigned* bar = b.bar;
        __builtin_amdgcn_s_waitcnt(0);
        unsigned nloc = b.st[0], nx = b.st[1];
        if (nloc == 0u) { xcd_barrier_complete(bar, b.x, nloc, nx); b.st[0] = nloc; b.st[1] = nx; }
        const unsigned old = xb_add(&bar[XB_XSUB(b.x)], 1u);
        const unsigned gen = old / nloc;
        if (old + 1u == (gen + 1u) * nloc) {
            __builtin_amdgcn_fence(__ATOMIC_RELEASE, "agent");
            asm volatile("s_waitcnt vmcnt(0)" ::: "memory");
            const unsigned og = xb_add(&bar[XB_TOP], 1u);
            const unsigned tg = og / nx;
            if (og + 1u == (tg + 1u) * nx) xb_add(&bar[XB_TOPGEN], 1u);
            else XB_SPIN(xb_ld(&bar[XB_TOPGEN]) == tg, bar);
            __builtin_amdgcn_fence(__ATOMIC_ACQUIRE, "agent");
            xb_add(&bar[XB_XGEN(b.x)], 1u);
            asm volatile("s_waitcnt vmcnt(0)" ::: "memory");
        } else {
            XB_SPIN(xb_ld(&bar[XB_XGEN(b.x)]) == gen, bar);
            __builtin_amdgcn_fence(__ATOMIC_ACQUIRE, "agent");
            asm volatile("s_waitcnt vmcnt(0)" ::: "memory");
        }
    }
    __syncthreads();
}

struct Args { const float* in[27]; float* out; unsigned char* ws; int ph_lo, ph_hi; };
enum { I_X = 0, I_C, I_CTX, I_CCTX, I_WADA, I_BADA, I_WIN, I_NABIAS, I_GQG, I_GKG, I_SINK, I_MQG, I_WQB, I_MKVG, I_WKVB, I_WOUT, I_LN1G, I_LN1B, I_RGW, I_RGB, I_REW, I_REB, I_WG, I_WU, I_WDN, I_LN2G, I_LN2B };

struct Frame {
    LAS unsigned char* lds; volatile LAS unsigned* MISC;
    int tid, lane, wave, G, gw, ngw, bid;
    GAS unsigned char* ws;
};
__device__ __forceinline__ int opaque_tid() { int t = threadIdx.x; asm volatile("" : "+v"(t)); return t; }
__device__ __forceinline__ int opaque_s(int x) { asm volatile("" : "+s"(x)); return x; }
constexpr int PTAB_OFF = MISC_OFF + 2048, I_OUT = 27;
__device__ __forceinline__ GAS unsigned char* ptab_get(const Frame& F, int i) {
    const LAS unsigned* t = (const LAS unsigned*)(F.lds + PTAB_OFF) + 2 * i;
    const unsigned lo = __builtin_amdgcn_readfirstlane(t[0]), hi = __builtin_amdgcn_readfirstlane(t[1]);
    return (GAS unsigned char*)(((unsigned long long)hi << 32) | lo);
}
#define INP(i) ((const float*)ptab_get(F, (i)))
__device__ __forceinline__ Frame make_frame(GAS unsigned char* ws) {
    extern __shared__ __attribute__((aligned(16))) unsigned char lds_raw[];
    Frame F;
    F.lds = (LAS unsigned char*)lds_raw; F.MISC = (volatile LAS unsigned*)(F.lds + MISC_OFF);
    F.tid = opaque_tid(); F.lane = F.tid & 63; F.wave = __builtin_amdgcn_readfirstlane(F.tid >> 6);
    F.G = opaque_s((int)gridDim.x); F.bid = opaque_s((int)blockIdx.x); F.gw = F.bid * NWAVES + F.wave; F.ngw = F.G * NWAVES;
    { unsigned long long w = (unsigned long long)ws; asm volatile("" : "+s"(w)); F.ws = (GAS unsigned char*)w; }
    return F;
}
__device__ __forceinline__ const float* xin_row(const Frame& F, int r) {
    const int b = r / TT, t = r - b * TT;
    return t < SEQ ? INP(I_X) + ((size_t)b * SEQ + t) * D : INP(I_CTX) + ((size_t)b * CTX + (t - SEQ)) * D;
}
__device__ __forceinline__ float* xs_row(const Frame& F, int r) {
    const int b = r / TT, t = r - b * TT;
    return t < SEQ ? (float*)ptab_get(F, I_OUT) + ((size_t)b * SEQ + t) * D : (float*)(F.ws + WS_XC) + ((size_t)b * CTX + (t - SEQ)) * D;
}
__device__ __forceinline__ void ld16(const float* p, int lane, float (&v)[16]) {
    const f32x4* q = (const f32x4*)p;
    const f32x4 a = q[2 * lane], b = q[2 * lane + 1], c = q[128 + 2 * lane], d = q[129 + 2 * lane];
    v[0] = a.x; v[1] = a.y; v[2] = a.z; v[3] = a.w; v[4] = b.x; v[5] = b.y; v[6] = b.z; v[7] = b.w;
    v[8] = c.x; v[9] = c.y; v[10] = c.z; v[11] = c.w; v[12] = d.x; v[13] = d.y; v[14] = d.z; v[15] = d.w;
}
__device__ __forceinline__ void st16(float* p, int lane, const float (&v)[16]) {
    f32x4* q = (f32x4*)p;
    q[2 * lane] = (f32x4){v[0], v[1], v[2], v[3]}; q[2 * lane + 1] = (f32x4){v[4], v[5], v[6], v[7]};
    q[128 + 2 * lane] = (f32x4){v[8], v[9], v[10], v[11]}; q[129 + 2 * lane] = (f32x4){v[12], v[13], v[14], v[15]};
}
__device__ __forceinline__ void ld16bf(const bf16* p, int lane, float (&v)[16]) {
    const v4u* q = (const v4u*)p; const v4u a = q[lane], b = q[64 + lane];
    float f[8]; unpack8(a, f);
#pragma unroll
    for (int i = 0; i < 8; ++i) v[i] = f[i];
    unpack8(b, f);
#pragma unroll
    for (int i = 0; i < 8; ++i) v[8 + i] = f[i];
}
__device__ __forceinline__ void st16bf(bf16* p, int lane, const float (&v)[16]) {
    v4u* q = (v4u*)p; v4u a, b;
    a.x = pk2(v[0], v[1]); a.y = pk2(v[2], v[3]); a.z = pk2(v[4], v[5]); a.w = pk2(v[6], v[7]);
    b.x = pk2(v[8], v[9]); b.y = pk2(v[10], v[11]); b.z = pk2(v[12], v[13]); b.w = pk2(v[14], v[15]);
    q[lane] = a; q[64 + lane] = b;
}
__device__ __forceinline__ void ln16(float (&v)[16]) {
    float s = 0.f;
#pragma unroll
    for (int i = 0; i < 16; ++i) s += v[i];
    const float mean = wave_sum(s) * (1.0f / D); float q = 0.f;
#pragma unroll
    for (int i = 0; i < 16; ++i) { v[i] -= mean; q += v[i] * v[i]; }
    const float rstd = 1.0f / sqrtf(wave_sum(q) * (1.0f / D) + EPS);
#pragma unroll
    for (int i = 0; i < 16; ++i) v[i] *= rstd;
}

template <int TYPE>
__device__ __forceinline__ float conv_src(const float* p0, const float* p1, const float* g0, const float* g1, int l, int k, int n) {
    if (TYPE == 0) return n < DPROJ ? p0[((size_t)l * D + k) * DPROJ + n] : 0.f;
    if (TYPE == 1) { if (n < 384) return k < 256 ? g0[l * 256 + k] * p0[((size_t)l * 256 + k) * 384 + n] : 0.f;
                     if (n < 896) return k >= 256 ? g1[l * 128 + (k - 256)] * p1[((size_t)l * 128 + (k - 256)) * 512 + (n - 384)] : 0.f;
                     return 0.f; }
    if (TYPE == 2) return p0[((size_t)l * D + k) * D + n];
    if (TYPE == 3) { const int e = n >> 10, nn = n & 1023, q = nn >> 3, j = nn & 7;
                     return j < 4 ? p0[(((size_t)l * 16 + e) * D + k) * 512 + 4 * q + j] : p1[(((size_t)l * 16 + e) * D + k) * 512 + 4 * q + (j - 4)]; }
    { const int e = n >> 10, nn = n & 1023; return p0[(((size_t)l * 16 + e) * 512 + k) * D + nn]; }
}
template <int TYPE>
__device__ __forceinline__ void conv_item(const Frame& F, int l, int item, LAS float* scr) {
    constexpr int Nd = TYPE == 0 ? NPJ : TYPE == 1 ? 1024 : TYPE == 2 ? 1024 : 16384, Kd = TYPE == 1 ? 384 : TYPE == 4 ? 512 : 1024;
    bf16* dst = (bf16*)(F.ws + (TYPE == 0 ? WS_WIN : TYPE == 1 ? WS_WD : TYPE == 2 ? WS_WOUT : TYPE == 3 ? WS_WGU : WS_WDN)) + (size_t)l * Nd * Kd;
    const float* p0 = INP(TYPE == 0 ? I_WIN : TYPE == 1 ? I_WQB : TYPE == 2 ? I_WOUT : TYPE == 3 ? I_WG : I_WDN);
    const float* p1 = INP(TYPE == 1 ? I_WKVB : I_WU); const float* g0 = INP(I_MQG); const float* g1 = INP(I_MKVG);
    constexpr int nblk = Nd / 32; const int kb = item / nblk, nb = item - kb * nblk, k0 = 64 * kb, n0 = 32 * nb, lane = F.lane;
#pragma unroll 4
    for (int i = 0; i < 32; ++i) { const int kk = 2 * i + (lane >> 5); scr[kk * 33 + (lane & 31)] = conv_src<TYPE>(p0, p1, g0, g1, l, k0 + kk, n0 + (lane & 31)); }
    asm volatile("s_waitcnt lgkmcnt(0)" ::: "memory");
    const int c = lane & 7;
#pragma unroll
    for (int j = 0; j < 4; ++j) { const int n = (lane >> 3) + 8 * j; const LAS float* s = scr + (8 * c) * 33 + n;
        v4u o; o.x = pk2(s[0 * 33], s[1 * 33]); o.y = pk2(s[2 * 33], s[3 * 33]); o.z = pk2(s[4 * 33], s[5 * 33]); o.w = pk2(s[6 * 33], s[7 * 33]);
        *(v4u*)(dst + (size_t)(n0 + n) * Kd + k0 + 8 * c) = o; }
    asm volatile("s_waitcnt lgkmcnt(0)" ::: "memory");
}
__device__ __forceinline__ void phase_prologue(const Frame& F) {
    {
        LAS float* sv = (LAS float*)F.lds;
        LAS float* red = (LAS float*)(F.lds + 17 * 1024 * 4);
        float* mods = (float*)(F.ws + WS_MODS);
        for (int u = F.bid; u < NL * 48; u += F.G) {
            const int l = u / 48, cc = u - l * 48;
            for (int i = F.tid; i < 17 * 1024; i += NTHR) { const int mr = i >> 10, k = i & 1023; const float c = mr < 16 ? INP(I_C)[mr * 1024 + k] : INP(I_CCTX)[k]; sv[i] = c / (1.0f + expf(-c)); }
            __syncthreads();
            const int col = F.tid & 127, kg = F.tid >> 7;
            float acc[17];
#pragma unroll
            for (int mr = 0; mr < 17; ++mr) acc[mr] = 0.f;
            const float* w = INP(I_WADA) + ((size_t)l * 1024 + kg * 256) * 6144 + cc * 128 + col;
            for (int k4 = 0; k4 < 256; k4 += 4) {
                const float w0 = w[(size_t)(k4 + 0) * 6144], w1 = w[(size_t)(k4 + 1) * 6144], w2 = w[(size_t)(k4 + 2) * 6144], w3 = w[(size_t)(k4 + 3) * 6144];
#pragma unroll
                for (int mr = 0; mr < 17; ++mr) { const f32x4 s = *(const LAS f32x4*)(sv + mr * 1024 + kg * 256 + k4); acc[mr] += (s.x * w0 + s.y * w1) + (s.z * w2 + s.w * w3); }
            }
#pragma unroll
            for (int mr = 0; mr < 17; ++mr) red[(kg * 17 + mr) * 128 + col] = acc[mr];
            __syncthreads();
            for (int i = F.tid; i < 17 * 128; i += NTHR) { const int mr = i >> 7, c = i & 127;
                const float s = (red[(0 * 17 + mr) * 128 + c] + red[(1 * 17 + mr) * 128 + c]) + (red[(2 * 17 + mr) * 128 + c] + red[(3 * 17 + mr) * 128 + c]);
                mods[((size_t)l * 17 + mr) * 6144 + cc * 128 + c] = s + INP(I_BADA)[l * 6144 + cc * 128 + c]; }
            __syncthreads();
        }
    }
    {
        float* t64 = (float*)(F.ws + WS_T64); float* t32 = (float*)(F.ws + WS_T32);
        for (int i = F.bid * NTHR + F.tid; i < 64 * 16 + 64 * 8; i += F.G * NTHR) {
            if (i < 1024) { const int p = i >> 4, k = i & 15; const float fr = powf(10000.0f, -(float)k / 16.0f), ang = (float)p * fr; t64[2 * i] = cosf(ang); t64[2 * i + 1] = sinf(ang); }
            else { const int j = i - 1024, p = j >> 3, k = j & 7; const float fr = powf(10000.0f, -(float)k / 8.0f), ang = (float)p * fr; t32[2 * j] = cosf(ang); t32[2 * j + 1] = sinf(ang); }
        }
    }
    {
        __syncthreads();
        LAS float* scr = (LAS float*)(F.lds + F.wave * 8448);
        constexpr int I0 = 1152, I1 = 192, I2 = 512, I3 = 8192, I4 = 4096, IL = I0 + I1 + I2 + I3 + I4;
        for (int it = F.gw; it < NL * IL; it += F.ngw) {
            const int l = it / IL; int r = it - l * IL;
            if (r < I0) { conv_item<0>(F, l, r, scr); continue; } r -= I0;
            if (r < I1) { conv_item<1>(F, l, r, scr); continue; } r -= I1;
            if (r < I2) { conv_item<2>(F, l, r, scr); continue; } r -= I2;
            if (r < I3) { conv_item<3>(F, l, r, scr); continue; } r -= I3;
            conv_item<4>(F, l, r, scr);
        }
    }
}

__device__ __forceinline__ void phase_ln(const Frame& F, int l) {
    const float* mods = (const float*)(F.ws + WS_MODS); bf16* HA = (bf16*)(F.ws + WS_HA);
    const bf16* Y = (const bf16*)(F.ws + WS_PB); const unsigned* RT = (const unsigned*)(F.ws + WS_RT);
    for (int r = F.gw; r < M; r += F.ngw) {
        const int b = r / TT, t = r - b * TT; const bool lat = t < SEQ; const int mr = lat ? b : 16;
        if (l == NL && !lat) continue;
        float v[16];
        if (l == 0) ld16(xin_row(F, r), F.lane, v);
        else {
            float* xr = xs_row(F, r); ld16(xr, F.lane, v);
            const unsigned* rt = RT + (size_t)r * 8;
            const float w0 = __builtin_bit_cast(float, rt[4]), w1 = __builtin_bit_cast(float, rt[5]); const unsigned p0 = rt[6], p1 = rt[7];
            float y0[16], y1[16], g2[16], gg[16], bb[16];
            ld16bf(Y + (size_t)p0 * D, F.lane, y0); ld16bf(Y + (size_t)p1 * D, F.lane, y1);
            ld16(mods + ((size_t)(l - 1) * 17 + mr) * 6144 + 5120, F.lane, g2);
#pragma unroll
            for (int i = 0; i < 16; ++i) v[i] = ALPHA * v[i] + g2[i] * (w0 * y0[i] + w1 * y1[i]);
            ln16(v);
            ld16(INP(I_LN2G) + (l - 1) * D, F.lane, gg); ld16(INP(I_LN2B) + (l - 1) * D, F.lane, bb);
#pragma unroll
            for (int i = 0; i < 16; ++i) v[i] = v[i] * gg[i] + bb[i];
            st16(xr, F.lane, v);
        }
        if (l < NL) {
            float sh[16], sc[16];
            ld16(mods + ((size_t)l * 17 + mr) * 6144, F.lane, sh); ld16(mods + ((size_t)l * 17 + mr) * 6144 + 1024, F.lane, sc);
            ln16(v);
#pragma unroll
            for (int i = 0; i < 16; ++i) v[i] = v[i] * (1.0f + sc[i]) + sh[i];
            st16bf(HA + (size_t)r * D, F.lane, v);
        }
    }
}

__device__ __forceinline__ void rope8(float (&f)[8], const float (&p)[8], const float* cs, bool first) {
    const f32x4* c4 = (const f32x4*)cs;
#pragma unroll
    for (int q = 0; q < 4; ++q) { const f32x4 t = c4[q];
        f[2 * q] = first ? f[2 * q] * t.x - p[2 * q] * t.y : p[2 * q] * t.y + f[2 * q] * t.x;
        f[2 * q + 1] = first ? f[2 * q + 1] * t.z - p[2 * q + 1] * t.w : p[2 * q + 1] * t.w + f[2 * q + 1] * t.z; }
}
__device__ __forceinline__ void phase_post(const Frame& F, int l) {
    bf16* P = (bf16*)(F.ws + WS_PB); bf16* KD = (bf16*)(F.ws + WS_KD);
    const float* t64 = (const float*)(F.ws + WS_T64); const float* t32 = (const float*)(F.ws + WS_T32);
    const int lane = F.lane;
    for (int r = F.gw; r < M; r += F.ngw) {
        const int b = r / TT, t = r - b * TT; const bool lat = t < SEQ; const int gr = (t >> 6) & 63, gc = t & 63;
        bf16* prow = P + (size_t)r * NPJ;
        const int j = lane & 7;
        const float* cs64 = t64 + ((size_t)((j < 4 ? gr : gc) * 16 + (j & 1) * 8)) * 2;
        {
            v4u* pp = (v4u*)(prow + 768) + lane; float f[8]; unpack8(*pp, f);
            float ss = 0.f;
#pragma unroll
            for (int i = 0; i < 8; ++i) ss += f[i] * f[i];
            ss += __shfl_xor(ss, 1); ss += __shfl_xor(ss, 2); ss += __shfl_xor(ss, 4);
            const float rr = 1.0f / sqrtf(ss * (1.0f / 64.0f) + EPS);
            const float* gn = (lane < 32 ? INP(I_GQG) : INP(I_GKG)) + l * 64 + j * 8;
#pragma unroll
            for (int i = 0; i < 8; ++i) f[i] = f[i] * rr * gn[i];
            float p[8];
#pragma unroll
            for (int i = 0; i < 8; ++i) p[i] = __shfl_xor(f[i], 2);
            if (lat) rope8(f, p, cs64, (j & 2) == 0);
            if (lane < 48) *pp = pack8(f);
        }
        if (lat) {
            v4u* pp = (v4u*)(prow + 1280) + lane; float f[8]; unpack8(*pp, f);
            float p[8];
#pragma unroll
            for (int i = 0; i < 8; ++i) p[i] = __shfl_xor(f[i], 2);
            rope8(f, p, cs64, (j & 2) == 0);
            if (lane < 48) *pp = pack8(f);
        }
        {
            const v4u w = *((const v4u*)(prow + 1792) + lane); float f[8]; unpack8(w, f);
            float ss = 0.f;
#pragma unroll
            for (int i = 0; i < 8; ++i) ss += f[i] * f[i];
            ss += __shfl_xor(ss, 1); ss += __shfl_xor(ss, 2); ss += __shfl_xor(ss, 4); ss += __shfl_xor(ss, 8);
            const float s32 = ss + __shfl_xor(ss, 16);
            const float rn = lane < 32 ? 1.0f / sqrtf(s32 * (1.0f / 256.0f) + EPS) : 1.0f / sqrtf(ss * (1.0f / 128.0f) + EPS);
            if (lane < 48) { float fn[8];
#pragma unroll
                for (int i = 0; i < 8; ++i) fn[i] = f[i] * rn;
                *((v4u*)(prow + 1792) + lane) = pack8(fn); }
            float p[8];
#pragma unroll
            for (int i = 0; i < 8; ++i) p[i] = __shfl_xor(f[i], 1);
            const int jj = lane & 3;
            if (lat) rope8(f, p, t32 + ((size_t)((jj < 2 ? gr : gc) * 8)) * 2, (jj & 1) == 0);
            if (lane >= 48 && lane < 52) { const v4u o = pack8(f);
#pragma unroll
                for (int h = 0; h < 4; ++h) *(v4u*)(KD + (size_t)r * 384 + h * 96 + 64 + 8 * jj) = o; }
        }
    }
}

__device__ __forceinline__ void phase_route(const Frame& F, int l) {
    const float* mods = (const float*)(F.ws + WS_MODS); bf16* HA = (bf16*)(F.ws + WS_HA);
    const float* MIX = (const float*)(F.ws + WS_PB); unsigned* RT = (unsigned*)(F.ws + WS_RT); int* HIST = (int*)(F.ws + WS_HIST);
    LAS float* WR = (LAS float*)F.lds;
    for (int i = F.tid; i < 20 * 1024; i += NTHR) { const int jx = i >> 10, k = i & 1023;
        WR[i] = jx < 4 ? INP(I_RGW)[((size_t)l * D + k) * 4 + jx] : INP(I_REW)[((size_t)l * D + k) * 16 + (jx - 4)]; }
    if (F.tid < 16) F.MISC[MI_LH + F.tid] = 0u;
    __syncthreads();
    float bias[20];
#pragma unroll
    for (int jx = 0; jx < 20; ++jx) bias[jx] = jx < 4 ? INP(I_RGB)[l * 4 + jx] : INP(I_REB)[l * 16 + (jx - 4)];
    for (int r = F.gw; r < M; r += F.ngw) {
        const int b = r / TT, t = r - b * TT; const bool lat = t < SEQ; const int mr = lat ? b : 16;
        const float* md = mods + ((size_t)l * 17 + mr) * 6144;
        float v[16], mx[16], g1[16], gg[16], bb[16];
        ld16(l == 0 ? xin_row(F, r) : xs_row(F, r), F.lane, v);
        ld16(MIX + (size_t)r * D, F.lane, mx); ld16(md + 2048, F.lane, g1);
#pragma unroll
        for (int i = 0; i < 16; ++i) v[i] = ALPHA * v[i] + g1[i] * mx[i];
        ln16(v);
        ld16(INP(I_LN1G) + l * D, F.lane, gg); ld16(INP(I_LN1B) + l * D, F.lane, bb);
#pragma unroll
        for (int i = 0; i < 16; ++i) v[i] = v[i] * gg[i] + bb[i];
        st16(xs_row(F, r), F.lane, v);
        ld16(md + 3072, F.lane, gg); ld16(md + 4096, F.lane, bb);
        ln16(v);
#pragma unroll
        for (int i = 0; i < 16; ++i) v[i] = v[i] * (1.0f + bb[i]) + gg[i];
        st16bf(HA + (size_t)r * D, F.lane, v);
        float lgt[20];
#pragma unroll
        for (int jx = 0; jx < 20; ++jx) {
            const LAS f32x4* wq = (const LAS f32x4*)(WR + jx * 1024);
            const f32x4 w0 = wq[2 * F.lane], w1 = wq[2 * F.lane + 1], w2 = wq[128 + 2 * F.lane], w3 = wq[129 + 2 * F.lane];
            float s = (v[0] * w0.x + v[1] * w0.y) + (v[2] * w0.z + v[3] * w0.w) + (v[4] * w1.x + v[5] * w1.y) + (v[6] * w1.z + v[7] * w1.w)
                    + (v[8] * w2.x + v[9] * w2.y) + (v[10] * w2.z + v[11] * w2.w) + (v[12] * w3.x + v[13] * w3.y) + (v[14] * w3.z + v[15] * w3.w);
            lgt[jx] = wave_sum(s) + bias[jx];
        }
        int grp = 0; float mg = lgt[0];
#pragma unroll
        for (int g = 1; g < 4; ++g) if (lgt[g] > mg) { mg = lgt[g]; grp = g; }
        float sg = 0.f;
#pragma unroll
        for (int g = 0; g < 4; ++g) sg += expf(lgt[g] - mg);
        const float pg = 1.0f / sg;
        float sel[4];
#pragma unroll
        for (int i = 0; i < 4; ++i) sel[i] = grp == 0 ? lgt[4 + i] : grp == 1 ? lgt[8 + i] : grp == 2 ? lgt[12 + i] : lgt[16 + i];
        int i1 = 0; float v1 = sel[0];
#pragma unroll
        for (int i = 1; i < 4; ++i) if (sel[i] > v1) { v1 = sel[i]; i1 = i; }
        int i2 = -1; float v2 = -3.0e38f;
#pragma unroll
        for (int i = 0; i < 4; ++i) if (i != i1 && (i2 < 0 || sel[i] > v2)) { v2 = sel[i]; i2 = i; }
        const float ee = expf(v2 - v1), w1 = pg / (1.0f + ee), w2 = pg * ee / (1.0f + ee);
        const int e1 = grp * 4 + i1, e2 = grp * 4 + i2;
        if (F.lane == 0) {
            const unsigned k1 = __hip_atomic_fetch_add((LAS unsigned*)&F.MISC[MI_LH + e1], 1u, __ATOMIC_RELAXED, __HIP_MEMORY_SCOPE_WORKGROUP);
            const unsigned k2 = __hip_atomic_fetch_add((LAS unsigned*)&F.MISC[MI_LH + e2], 1u, __ATOMIC_RELAXED, __HIP_MEMORY_SCOPE_WORKGROUP);
            v4u ra; ra.x = (unsigned)e1; ra.y = (unsigned)e2; ra.z = k1; ra.w = k2;
            v4u rb; rb.x = __builtin_bit_cast(unsigned, w1); rb.y = __builtin_bit_cast(unsigned, w2); rb.z = 0u; rb.w = 0u;
            *(v4u*)(RT + (size_t)r * 8) = ra; *(v4u*)(RT + (size_t)r * 8 + 4) = rb;
        }
    }
    __syncthreads();
    if (F.tid < 16) HIST[F.bid * 16 + F.tid] = (int)F.MISC[MI_LH + F.tid];
}
__device__ __forceinline__ void moe_tables(const Frame& F) {
    const int* HIST = (const int*)(F.ws + WS_HIST); LAS int* hl = (LAS int*)F.lds;
    __syncthreads();
    for (int i = F.tid; i < F.G * 16; i += NTHR) hl[i] = HIST[i];
    __syncthreads();
    if (F.tid < 16) { int tot = 0, mine = 0; for (int g = 0; g < F.G; ++g) { const int c = hl[g * 16 + F.tid]; tot += c; mine += (g < F.bid) ? c : 0; }
        F.MISC[MI_TOT + F.tid] = (unsigned)tot; F.MISC[MI_BASE + F.tid] = (unsigned)mine; }
    __syncthreads();
    if (F.tid == 0) { unsigned p = 0; for (int e = 0; e < 16; ++e) { F.MISC[MI_PST + e] = p; F.MISC[MI_BASE + e] += p * 256u; p += (F.MISC[MI_TOT + e] + 255u) >> 8; } F.MISC[MI_PST + 16] = p; }
    __syncthreads();
}
__device__ __forceinline__ void phase_permute(const Frame& F) {
    const bf16* HA = (const bf16*)(F.ws + WS_HA); bf16* HS = (bf16*)(F.ws + WS_PB); unsigned* RT = (unsigned*)(F.ws + WS_RT);
    moe_tables(F);
    for (int r = F.gw; r < M; r += F.ngw) {
        const v4u ra = *(const v4u*)(RT + (size_t)r * 8);
        const unsigned p0 = F.MISC[MI_BASE + (ra.x & 15u)] + ra.z, p1 = F.MISC[MI_BASE + (ra.y & 15u)] + ra.w;
        const v4u* src = (const v4u*)(HA + (size_t)r * D); const v4u x0 = src[F.lane], x1 = src[64 + F.lane];
        v4u* d0 = (v4u*)(HS + (size_t)p0 * D); v4u* d1 = (v4u*)(HS + (size_t)p1 * D);
        d0[F.lane] = x0; d0[64 + F.lane] = x1; d1[F.lane] = x0; d1[64 + F.lane] = x1;
        if (F.lane == 0) { RT[(size_t)r * 8 + 6] = p0; RT[(size_t)r * 8 + 7] = p1; }
    }
}

struct EpiMla {
    static constexpr bool PERM = true, AFTER_DRAIN = false;
    bf16* QD; bf16* KD; bf16* VD;
    __device__ __forceinline__ void operator()(const pg8::f32x4 (&acc)[2][2][4][2], const pg8::Unit& u, int wr, int wc, int fr, int fq) const {
#pragma unroll
        for (int bj = 0; bj < 2; ++bj) {
            const int g0 = u.pn * 256 + bj * 128 + wc * 32, col0 = g0 + 8 * fq;
            if (g0 >= 896) continue;
            const int c = col0 - 384, hd = c >> 7, jx = c & 127;
            bf16* dst = g0 < 384 ? QD + col0 : jx < 64 ? KD + hd * 96 + jx : VD + hd * 64 + (jx - 64);
            const int stride = (g0 < 384 || jx < 64) ? 384 : 256;
            dst += (size_t)(u.pm * 256 + wr * 64 + fr) * stride;
#pragma unroll
            for (int ai = 0; ai < 2; ++ai)
#pragma unroll
                for (int m = 0; m < 4; ++m) {
                    v4u o; o.x = pk2(acc[ai][bj][m][0][0], acc[ai][bj][m][0][1]); o.y = pk2(acc[ai][bj][m][0][2], acc[ai][bj][m][0][3]);
                    o.z = pk2(acc[ai][bj][m][1][0], acc[ai][bj][m][1][1]); o.w = pk2(acc[ai][bj][m][1][2], acc[ai][bj][m][1][3]);
                    *(v4u*)(dst + (size_t)(ai * 128 + m * 16) * stride) = o;
                }
        }
    }
};
struct EpiGU {
    static constexpr bool PERM = true, AFTER_DRAIN = false;
    bf16* ACT;
    __device__ __forceinline__ void operator()(const pg8::f32x4 (&acc)[2][2][4][2], const pg8::Unit& u, int wr, int wc, int fr, int fq) const {
#pragma unroll
        for (int ai = 0; ai < 2; ++ai)
#pragma unroll
            for (int m = 0; m < 4; ++m) {
                const int row = u.pm * 256 + ai * 128 + wr * 64 + m * 16 + fr;
#pragma unroll
                for (int bj = 0; bj < 2; ++bj) {
                    const int c = (u.pn & 3) * 256 + bj * 128 + wc * 32 + 8 * fq;
                    float o[4];
#pragma unroll
                    for (int i = 0; i < 4; ++i) { const float g = acc[ai][bj][m][0][i], up = acc[ai][bj][m][1][i]; o[i] = g / (1.0f + __expf(-g)) * up; }
                    v2u w; w.x = pk2(o[0], o[1]); w.y = pk2(o[2], o[3]);
                    *(v2u*)(ACT + (size_t)row * 512 + (c >> 1)) = w;
                }
            }
    }
};
struct MoeOrder {
    volatile LAS unsigned* pst; int G, c;
    __device__ __forceinline__ bool next(int i, pg8::Unit& u) const {
        const int L = i * G + c; const int np = (int)pst[16];
        if (L >= np * 4) return false;
        const int panel = L >> 2; int e = 0;
#pragma unroll
        for (int k = 1; k < 16; ++k) e += (panel >= (int)pst[k]) ? 1 : 0;
        u.pm = __builtin_amdgcn_readfirstlane(panel); u.pn = __builtin_amdgcn_readfirstlane(e * 4 + (L & 3)); return true;
    }
    __device__ __forceinline__ void a_ready(const pg8::Unit&) const {}
    __device__ __forceinline__ void done(const pg8::Unit&) const {}
};

#ifndef DBG_VAR
#define DBG_VAR 1
#endif
namespace att {
constexpr int VRS = 192, KBUF = 64 * 208, VBUF = 64 * VRS, BUF = KBUF + VBUF, BIAS_OFF = 2 * BUF;
constexpr float NEG = -30000.0f;
__device__ __forceinline__ int crow(int r, int hi) { return (r & 3) + 8 * (r >> 2) + 4 * hi; }
__device__ __forceinline__ float xhalf_max(float v) { const unsigned a = __builtin_bit_cast(unsigned, v);
    auto rr = __builtin_amdgcn_permlane32_swap(a, a, false, false); const unsigned r0 = rr[0], r1 = rr[1]; return fmaxf(__uint_as_float(r0), __uint_as_float(r1)); }
__device__ __forceinline__ float xhalf_sum(float v) { const unsigned a = __builtin_bit_cast(unsigned, v);
    auto rr = __builtin_amdgcn_permlane32_swap(a, a, false, false); const unsigned r0 = rr[0], r1 = rr[1]; return __uint_as_float(r0) + __uint_as_float(r1); }
typedef __bf16 bf16x2_t __attribute__((ext_vector_type(2)));
__device__ __forceinline__ unsigned cvtpk(float lo, float hi) { f32x2 v = {lo, hi}; bf16x2_t b = __builtin_convertvector(v, bf16x2_t); return __builtin_bit_cast(unsigned, b); }

template <int DK>
__device__ __forceinline__ void unit(LAS unsigned char* lds, const bf16* Qp, int qpitch, const bf16* Kp, int kpitch, const bf16* Vp, int vpitch, bf16* Op,
                                     int var, int qt, int lo, int n1, int nt, float qscale, float sinkl2, bool has_sink, const LAS float* bias, const float* t32, unsigned* dbg) {
    constexpr int KRS = DK * 2 + 16, NS = DK / 16, CPK = DK / 8;
    int tid = threadIdx.x; asm volatile("" : "+v"(tid)); const int lane = tid & 63, r32 = lane & 31, hi = lane >> 5, wid = __builtin_amdgcn_readfirstlane(tid >> 6);
    const int qrow = 256 * qt + 32 * wid + r32;
    bf16x8 qr[NS];
#pragma unroll
    for (int s = 0; s < NS; ++s) { const v4u raw = *(const v4u*)(Qp + (size_t)qrow * qpitch + 16 * s + 8 * hi); float f[8]; unpack8(raw, f);
#pragma unroll
        for (int i = 0; i < 8; ++i) f[i] *= qscale;
        if (DK == 96 && s >= 4) {
            float p[8];
#pragma unroll
            for (int i = 0; i < 8; ++i) p[i] = __shfl_xor(f[i], 32);
            if (qt < 16) rope8(f, p, t32 + ((size_t)((s == 4 ? (qrow >> 6) : (qrow & 63)) * 8)) * 2, hi == 0);
        }
        qr[s] = __builtin_bit_cast(bf16x8, pack8(f)); }
    const int kkey0 = tid / CPK, kch0 = tid - kkey0 * CPK, kkey1 = (tid + 512) / CPK, kch1 = (tid + 512) - kkey1 * CPK;
    const int vkey = tid >> 3, vch = tid & 7;
    v4u kreg0, kreg1 = {0u, 0u, 0u, 0u}, vreg;
#define ATT_TROW(j) ((((j) < n1) ? (lo + (j)) : (64 + (j) - n1)) * 64)
#define ATT_LOAD(j) do { const int tr_ = ATT_TROW(j); kreg0 = *(const v4u*)(Kp + (size_t)(tr_ + kkey0) * kpitch + kch0 * 8); \
        if (DK == 96 && tid < 256) kreg1 = *(const v4u*)(Kp + (size_t)(tr_ + kkey1) * kpitch + kch1 * 8); \
        vreg = *(const v4u*)(Vp + (size_t)(tr_ + vkey) * vpitch + vch * 8); } while (0)
#define ATT_STORE(bf) do { LAS unsigned char* b_ = lds + (bf) * BUF; *(LAS v4u*)(b_ + kkey0 * KRS + kch0 * 16) = kreg0; \
        if (DK == 96 && tid < 256) *(LAS v4u*)(b_ + kkey1 * KRS + kch1 * 16) = kreg1; \
        *(LAS v4u*)(b_ + KBUF + vkey * VRS + vch * 16) = vreg; } while (0)
    float m = NEG, l = 0.f; f32x16 o0 = {}, o1 = {};
    const int grw = 4 * qt + (wid >> 1), r0w = min(max(grw - 4, 0), 56), gc = (wid & 1) * 32 + r32, c0 = min(max(gc - 8, 0), 48), i0w = 256 * qt + 32 * wid;
    ATT_LOAD(0); ATT_STORE(0);
    __syncthreads();
    for (int j = 0; j < nt; ++j) {
        if (j + 1 < nt) ATT_LOAD(j + 1);
        const int kt = ATT_TROW(j) >> 6;
        bool actv = true;
        if (kt < 64) { if (var == 0) actv = (kt >= r0w) && (kt <= r0w + 7); else if (var == 2) actv = !((64 * kt - (i0w + 31) > 128) || (i0w - (64 * kt + 63) > 128)); }
        if (actv) {
            const LAS unsigned char* Kb = lds + (j & 1) * BUF; const LAS unsigned char* Vb = Kb + KBUF;
            f32x16 s0 = {}, s1 = {};
#pragma unroll
            for (int s = 0; s < NS; ++s) {
                const bf16x8 ka = *(const LAS bf16x8*)(Kb + r32 * KRS + (16 * s + 8 * hi) * 2);
                const bf16x8 kb = *(const LAS bf16x8*)(Kb + (32 + r32) * KRS + (16 * s + 8 * hi) * 2);
                s0 = __builtin_amdgcn_mfma_f32_32x32x16_bf16(ka, qr[s], s0, 0, 0, 0);
                s1 = __builtin_amdgcn_mfma_f32_32x32x16_bf16(kb, qr[s], s1, 0, 0, 0);
            }
            if (kt < 64 && var == 0) {
                const int rowoff = (kt - grw + 7) * 31 - gc + 15;
#pragma unroll
                for (int r = 0; r < 16; ++r) { const int j0 = crow(r, hi), j1 = j0 + 32;
                    const bool v0 = (unsigned)(j0 - c0) < 16u, v1 = (unsigned)(j1 - c0) < 16u;
                    const float b0 = bias[v0 ? rowoff + j0 : 0], b1 = bias[v1 ? rowoff + j1 : 0];
                    s0[r] = v0 ? s0[r] + b0 : NEG; s1[r] = v1 ? s1[r] + b1 : NEG; }
            } else if (kt < 64 && var == 2) {
                const int dbase = 64 * kt - qrow + 128;
#pragma unroll
                for (int r = 0; r < 16; ++r) { const int j0 = crow(r, hi);
                    s0[r] = (unsigned)(dbase + j0) <= 256u ? s0[r] : NEG; s1[r] = (unsigned)(dbase + j0 + 32) <= 256u ? s1[r] : NEG; }
            }
            float mx = fmaxf(s0[0], s1[0]);
#pragma unroll
            for (int r = 1; r < 16; ++r) mx = fmaxf(mx, fmaxf(s0[r], s1[r]));
            mx = xhalf_max(mx);
            const float mnew = fmaxf(m, mx), alpha = __builtin_amdgcn_exp2f(m - mnew);
            m = mnew;
            float ps = 0.f;
#pragma unroll
            for (int r = 0; r < 16; ++r) { s0[r] = __builtin_amdgcn_exp2f(s0[r] - mnew); s1[r] = __builtin_amdgcn_exp2f(s1[r] - mnew); ps += s0[r] + s1[r]; }
            l = l * alpha + ps;
            if (__any(alpha != 1.0f)) {
#pragma unroll
                for (int r = 0; r < 16; ++r) { o0[r] *= alpha; o1[r] *= alpha; }
            }
            bf16x8 pb[4];
#pragma unroll
            for (int s = 0; s < 2; ++s) {
                v4u w; w.x = cvtpk(s0[8 * s], s0[8 * s + 1]); w.y = cvtpk(s0[8 * s + 2], s0[8 * s + 3]); w.z = cvtpk(s0[8 * s + 4], s0[8 * s + 5]); w.w = cvtpk(s0[8 * s + 6], s0[8 * s + 7]);
                pb[s] = __builtin_bit_cast(bf16x8, w);
                v4u x; x.x = cvtpk(s1[8 * s], s1[8 * s + 1]); x.y = cvtpk(s1[8 * s + 2], s1[8 * s + 3]); x.z = cvtpk(s1[8 * s + 4], s1[8 * s + 5]); x.w = cvtpk(s1[8 * s + 6], s1[8 * s + 7]);
                pb[2 + s] = __builtin_bit_cast(bf16x8, x);
            }
            const LAS unsigned char* vbase = Vb + (4 * hi + ((lane & 15) >> 2)) * VRS + ((lane >> 4) & 1) * 32 + (lane & 3) * 8;
#pragma unroll
            for (int s = 0; s < 4; ++s) {
                const v4i16 a0 = __builtin_amdgcn_ds_read_tr16_b64_v4i16((LAS v4i16*)(vbase + (16 * s) * VRS));
                const v4i16 a1 = __builtin_amdgcn_ds_read_tr16_b64_v4i16((LAS v4i16*)(vbase + (16 * s + 8) * VRS));
                const v4i16 c0_ = __builtin_amdgcn_ds_read_tr16_b64_v4i16((LAS v4i16*)(vbase + (16 * s) * VRS + 64));
                const v4i16 c1_ = __builtin_amdgcn_ds_read_tr16_b64_v4i16((LAS v4i16*)(vbase + (16 * s + 8) * VRS + 64));
                const bf16x8 va = {a0[0], a0[1], a0[2], a0[3], a1[0], a1[1], a1[2], a1[3]};
                const bf16x8 vc = {c0_[0], c0_[1], c0_[2], c0_[3], c1_[0], c1_[1], c1_[2], c1_[3]};
                o0 = __builtin_amdgcn_mfma_f32_32x32x16_bf16(va, pb[s], o0, 0, 0, 0);
                o1 = __builtin_amdgcn_mfma_f32_32x32x16_bf16(vc, pb[s], o1, 0, 0, 0);
            }
        }
        if (j + 1 < nt) ATT_STORE((j + 1) & 1);
        __syncthreads();
    }
    l = xhalf_sum(l);
    const float sterm = has_sink ? __builtin_amdgcn_exp2f(sinkl2 - m) : 0.f;
    if (dbg && hi == 0) { dbg[(size_t)qrow * 2] = __builtin_bit_cast(unsigned, m); dbg[(size_t)qrow * 2 + 1] = __builtin_bit_cast(unsigned, l); }
    if (has_sink) l += sterm;
    const float inv = 1.0f / l;
    bf16* orow = Op + (size_t)qrow * D;
#pragma unroll
    for (int g = 0; g < 4; ++g) {
        v2u w0; w0.x = pk2(o0[4 * g] * inv, o0[4 * g + 1] * inv); w0.y = pk2(o0[4 * g + 2] * inv, o0[4 * g + 3] * inv);
        v2u w1; w1.x = pk2(o1[4 * g] * inv, o1[4 * g + 1] * inv); w1.y = pk2(o1[4 * g + 2] * inv, o1[4 * g + 3] * inv);
        *(v2u*)(orow + 8 * g + 4 * hi) = w0; *(v2u*)(orow + 32 + 8 * g + 4 * hi) = w1;
    }
#undef ATT_TROW
#undef ATT_LOAD
#undef ATT_STORE
}
}

__device__ __forceinline__ void phase_attn(const Frame& F, int l) {
    const bf16* P = (const bf16*)(F.ws + WS_PB); const bf16* QD = (const bf16*)(F.ws + WS_QD); const bf16* KD = (const bf16*)(F.ws + WS_KD);
    const bf16* VD = (const bf16*)(F.ws + WS_VD); bf16* O = (bf16*)(F.ws + WS_HA);
    unsigned* ctr = (unsigned*)(F.ws + WS_CTL) + CW_QUEUE + 64 * l;
    LAS float* bias = (LAS float*)(F.lds + att::BIAS_OFF);
    for (int i = F.tid; i < 4 * 465; i += NTHR) bias[i] = INP(I_NABIAS)[l * 4 * 465 + i] * LOG2E;
    __syncthreads();
    const int nunits = 4096 + (l < NL - 1 ? 256 : 0);
    for (;;) {
        if (F.tid == 0) F.MISC[MI_Q] = __hip_atomic_fetch_add(ctr, 1u, __ATOMIC_RELAXED, __HIP_MEMORY_SCOPE_AGENT);
        __syncthreads();
        const int idx = (int)F.MISC[MI_Q];
        __syncthreads();
        if (idx >= nunits) break;
        int var, b, h, qt;
        if (idx < 4096) { const int grp = idx >> 10, rem = idx & 1023; var = grp == 0 ? 3 : grp == 1 ? 1 : grp == 2 ? 0 : 2; b = rem >> 6; h = (rem >> 4) & 3; qt = rem & 15; }
        else { const int rem = idx - 4096; b = rem >> 4; var = (rem >> 2) & 3; h = rem & 3; qt = 16; }
        int lo = 0, n1 = 64;
        if (qt == 16) { lo = 0; n1 = 0; }
        else if (var == 0) { lo = min(max(4 * qt - 4, 0), 56); n1 = min(max(4 * qt - 1, 0), 56) + 7 - lo + 1; }
        else if (var == 2) { lo = max(4 * qt - 2, 0); n1 = min(4 * qt + 5, 63) - lo + 1; }
        const int nt = n1 + 4;
        const size_t rb = (size_t)b * TT;
        bf16* Op = O + rb * D + var * 256 + h * 64;
        if (var == 3) {
            att::unit<96>(F.lds, QD + rb * 384 + h * 96, 384, KD + rb * 384 + h * 96, 384, VD + rb * 256 + h * 64, 256, Op, 3, qt, lo, n1, nt, 0.10206207261596575f * LOG2E, 0.f, false, bias, (const float*)(F.ws + WS_T32), nullptr);
        } else {
            const int qc = var == 0 ? h * 64 : var == 1 ? 768 + h * 64 : 1280 + h * 64;
            const int kc = var == 0 ? 256 + h * 64 : var == 1 ? 1024 + (h >> 1) * 64 : 1536 + (h >> 1) * 64;
            const int vc = var == 0 ? 512 + h * 64 : var == 1 ? 1152 + (h >> 1) * 64 : 1664 + (h >> 1) * 64;
            att::unit<64>(F.lds, P + rb * NPJ + qc, NPJ, P + rb * NPJ + kc, NPJ, P + rb * NPJ + vc, NPJ, Op, var, qt, lo, n1, nt, 0.125f * LOG2E,
                          var == 2 ? INP(I_SINK)[l * 4 + h] * LOG2E : 0.f, var == 2, bias + h * 465, nullptr, (var == DBG_VAR && h == 0) ? (unsigned*)(F.ws + WS_RS) + rb * 2 : nullptr);
        }
    }
}

#define PHASE_FN static __device__ __forceinline__ void
PHASE_FN ph_prologue(GAS unsigned char* ws) { const Frame F = make_frame(ws); phase_prologue(F); }
PHASE_FN ph_ln(GAS unsigned char* ws, int l) { const Frame F = make_frame(ws); phase_ln(F, l); }
PHASE_FN ph_gemm_in(GAS unsigned char* ws, int l) {
    const Frame F = make_frame(ws);
    pg8::Gemm g{(const bf16*)(F.ws + WS_HA), (const bf16*)(F.ws + WS_WIN) + (size_t)l * NPJ * D, M, NPJ, D, D}; pg8::StaticOrder S; S.init(M, NPJ, F.G, F.bid);
    pg8::EpiBf16<0> E{(bf16*)(F.ws + WS_PB), NPJ, nullptr, 0, 0, 1.f};
    pg8::gemm_phase<pg8::EpiBf16<0>, pg8::StaticOrder, true, true>(F.lds, g, S, E);
}
PHASE_FN ph_post(GAS unsigned char* ws, int l) { const Frame F = make_frame(ws); phase_post(F, l); }
PHASE_FN ph_gemm_mla(GAS unsigned char* ws, int l) {
    const Frame F = make_frame(ws);
    pg8::Gemm g{(const bf16*)(F.ws + WS_PB) + 1792, (const bf16*)(F.ws + WS_WD) + (size_t)l * 1024 * 384, M, 1024, 384, NPJ}; pg8::StaticOrder S; S.init(M, 1024, F.G, F.bid);
    EpiMla E{(bf16*)(F.ws + WS_QD), (bf16*)(F.ws + WS_KD), (bf16*)(F.ws + WS_VD)};
    pg8::gemm_phase<EpiMla, pg8::StaticOrder, true, true>(F.lds, g, S, E);
}
PHASE_FN ph_attn(GAS unsigned char* ws, int l) { const Frame F = make_frame(ws); phase_attn(F, l); }
PHASE_FN ph_gemm_out(GAS unsigned char* ws, int l) {
    const Frame F = make_frame(ws);
    pg8::Gemm g{(const bf16*)(F.ws + WS_HA), (const bf16*)(F.ws + WS_WOUT) + (size_t)l * D * D, M, D, D, D}; pg8::StaticOrder S; S.init(M, D, F.G, F.bid);
    pg8::EpiF32 E{(float*)(F.ws + WS_PB), D, nullptr};
    pg8::gemm_phase<pg8::EpiF32, pg8::StaticOrder, true, true>(F.lds, g, S, E);
}
PHASE_FN ph_route(GAS unsigned char* ws, int l) { const Frame F = make_frame(ws); phase_route(F, l); }
PHASE_FN ph_permute(GAS unsigned char* ws) { const Frame F = make_frame(ws); phase_permute(F); }
PHASE_FN ph_gemm_gu(GAS unsigned char* ws, int l) {
    const Frame F = make_frame(ws);
    moe_tables(F);
    pg8::Gemm g{(const bf16*)(F.ws + WS_PB), (const bf16*)(F.ws + WS_WGU) + (size_t)l * 16384 * 1024, MS, 16384, D, D}; MoeOrder S{F.MISC + MI_PST, F.G, F.bid};
    EpiGU E{(bf16*)(F.ws + WS_ACT)};
    pg8::gemm_phase<EpiGU, MoeOrder, true, true>(F.lds, g, S, E);
}
PHASE_FN ph_gemm_dn(GAS unsigned char* ws, int l) {
    const Frame F = make_frame(ws);
    moe_tables(F);
    pg8::Gemm g{(const bf16*)(F.ws + WS_ACT), (const bf16*)(F.ws + WS_WDN) + (size_t)l * 16384 * 512, MS, 16384, 512, 512}; MoeOrder S{F.MISC + MI_PST, F.G, F.bid};
    pg8::EpiBf16<0> E{(bf16*)(F.ws + WS_PB), D, nullptr, 1024, 0, 1.f};
    pg8::gemm_phase<pg8::EpiBf16<0>, MoeOrder, true, true>(F.lds, g, S, E);
}


#ifndef DBG_MODE
#define DBG_MODE 0
#endif
__device__ __forceinline__ float oracle_attn(const Frame& F, int l, int r, int var, int h, int mode = 0) {
    const bf16* P = (const bf16*)(F.ws + WS_PB); const bf16* QD = (const bf16*)(F.ws + WS_QD); const bf16* KD = (const bf16*)(F.ws + WS_KD); const bf16* VD = (const bf16*)(F.ws + WS_VD);
    const bf16* O = (const bf16*)(F.ws + WS_HA); const float* t32 = (const float*)(F.ws + WS_T32);
    const int b = r / TT, t = r - b * TT; const bool lat = t < SEQ; const size_t rb = (size_t)b * TT;
    const int dk = var == 3 ? 96 : 64;
    const bf16* qp; const bf16* kp; const bf16* vp; int kpitch, vpitch;
    if (var == 3) { qp = QD + (size_t)r * 384 + h * 96; kp = KD + rb * 384 + h * 96; kpitch = 384; vp = VD + rb * 256 + h * 64; vpitch = 256; }
    else { const int qc = var == 0 ? h * 64 : var == 1 ? 768 + h * 64 : 1280 + h * 64, kc = var == 0 ? 256 + h * 64 : var == 1 ? 1024 + (h >> 1) * 64 : 1536 + (h >> 1) * 64,
           vc = var == 0 ? 512 + h * 64 : var == 1 ? 1152 + (h >> 1) * 64 : 1664 + (h >> 1) * 64;
           qp = P + (size_t)r * NPJ + qc; kp = P + rb * NPJ + kc; kpitch = NPJ; vp = P + rb * NPJ + vc; vpitch = NPJ; }
    LAS float* qs = (LAS float*)(F.lds + 65536) + F.wave * 128;
    for (int d = F.lane; d < dk; d += 64) qs[d] = __builtin_bit_cast(float, (unsigned)qp[d] << 16);
    asm volatile("s_waitcnt lgkmcnt(0)" ::: "memory");
    if (var == 3 && lat && F.lane < 32) {
        const int c = F.lane >> 3, e = F.lane & 7, gr = t >> 6, gc = t & 63; const float own = qs[64 + F.lane], par = qs[64 + (F.lane ^ 8)];
        const float cs = t32[((c < 2 ? gr : gc) * 8 + e) * 2], sn = t32[((c < 2 ? gr : gc) * 8 + e) * 2 + 1];
        const float nv = (c & 1) == 0 ? own * cs - par * sn : par * sn + own * cs;
        asm volatile("s_waitcnt lgkmcnt(0)" ::: "memory"); qs[64 + F.lane] = nv; }
    asm volatile("s_waitcnt lgkmcnt(0)" ::: "memory");
    const float scale = var == 3 ? 0.10206207261596575f : 0.125f;
    const int gr = t >> 6, gc = t & 63, r0 = min(max(gr - 4, 0), 56), c0 = min(max(gc - 8, 0), 48);
    float m = -3.0e38f, lsum = 0.f, acc[64];
#pragma unroll
    for (int d = 0; d < 64; ++d) acc[d] = 0.f;
    for (int j = F.lane; j < TT; j += 64) {
        bool ok = true; float bias = 0.f;
        if (!lat) ok = j >= SEQ;
        else if (j < SEQ) {
            if (var == 0) { const int kr = j >> 6, kc2 = j & 63; ok = kr >= r0 && kr <= r0 + 7 && kc2 >= c0 && kc2 <= c0 + 15;
                if (ok) bias = INP(I_NABIAS)[((l * 4 + h) * 15 + (kr - gr + 7)) * 31 + (kc2 - gc + 15)]; }
            else if (var == 2) ok = (j - t <= 128) && (t - j <= 128);
        }
        if (!ok) continue;
        float sc = 0.f; const bf16* kr_ = kp + (size_t)j * kpitch;
        for (int d = 0; d < dk; ++d) sc += qs[d] * __builtin_bit_cast(float, (unsigned)kr_[d] << 16);
        sc = sc * scale + bias;
        const float mn = fmaxf(m, sc), a = expf(m - mn), p = expf(sc - mn); m = mn; lsum = lsum * a + p;
        const bf16* vr = vp + (size_t)j * vpitch;
#pragma unroll
        for (int d = 0; d < 64; ++d) acc[d] = acc[d] * a + p * __builtin_bit_cast(float, (unsigned)vr[d] << 16);
    }
    float mg = m;
#pragma unroll
    for (int o = 1; o < 64; o <<= 1) mg = fmaxf(mg, __shfl_xor(mg, o));
    if (mode >= 1) {
        const unsigned* rec = (const unsigned*)(F.ws + WS_RS) + (size_t)r * 2; const float mk = __builtin_bit_cast(float, rec[0]), lk = __builtin_bit_cast(float, rec[1]);
        const float lref = wave_sum(lsum * expf(m - mg));
        const float lker = lk * exp2f(mk - mg * LOG2E);
        if (mode == 2) return fabsf(mk / LOG2E - mg);
        return fabsf(lker / lref - 1.0f);
    }
    const float f = expf(m - mg); lsum *= f; lsum = wave_sum(lsum);
    if (var == 2) lsum += expf(INP(I_SINK)[l * 4 + h] - mg);
    float err = 0.f, mag = 1.0e-6f;
    const bf16* orow = O + (size_t)r * D + var * 256 + h * 64;
#pragma unroll
    for (int d = 0; d < 64; ++d) { const float ref = wave_sum(acc[d] * f) / lsum; const float got = __builtin_bit_cast(float, (unsigned)orow[d] << 16);
        const float df = fabsf(got - ref); err = (df == df) ? fmaxf(err, df) : 1.0e30f; mag = fmaxf(mag, fabsf(ref)); }
    return err / mag;
}
__device__ __forceinline__ void phase_dump(const Frame& F, int code) {
    float* out = (float*)ptab_get(F, I_OUT);
    for (int r = F.gw; r < M; r += F.ngw) {
        const int b = r / TT, t = r - b * TT; if (t >= SEQ) continue;
        float v[16];
        if (code == 1) ld16bf((const bf16*)(F.ws + WS_HA) + (size_t)r * D, F.lane, v);
        else if (code == 2) ld16bf((const bf16*)(F.ws + WS_PB) + (size_t)r * NPJ, F.lane, v);
        else if (code == 3) ld16bf((const bf16*)(F.ws + WS_PB) + (size_t)r * NPJ + 1024, F.lane, v);
        else if (code == 4) ld16bf((const bf16*)(F.ws + WS_PB) + (size_t)r * NPJ + 1280, F.lane, v);
        else if (code == 5) ld16((const float*)(F.ws + WS_PB) + (size_t)r * D, F.lane, v);
        else if (code == 8) {
            const v4u w0 = *((const v4u*)((const bf16*)(F.ws + WS_HA) + (size_t)r * D) + F.lane), w1 = *((const v4u*)((const bf16*)(F.ws + WS_HA) + (size_t)r * D) + 64 + F.lane);
            float f[8]; int bad0 = 0, bad1 = 0; unpack8(w0, f);
#pragma unroll
            for (int i = 0; i < 8; ++i) { const unsigned u = __builtin_bit_cast(unsigned, f[i]); bad0 |= ((u & 0x7f800000u) == 0x7f800000u) ? 1 : 0; }
            unpack8(w1, f);
#pragma unroll
            for (int i = 0; i < 8; ++i) { const unsigned u = __builtin_bit_cast(unsigned, f[i]); bad1 |= ((u & 0x7f800000u) == 0x7f800000u) ? 1 : 0; }
            const unsigned long long m0 = __ballot(bad0), m1 = __ballot(bad1);
            const bool vA = (m0 & 0xffffffffull) != 0, vB = (m0 >> 32) != 0, vC = (m1 & 0xffffffffull) != 0, vD = (m1 >> 32) != 0;
            const float val = (float)(t + 1) * ((vA ? 1.0f : 0.f) + (vB ? 1.0e2f : 0.f) + (vC ? 1.0e4f : 0.f) + (vD ? 1.0e6f : 0.f));
#pragma unroll
            for (int i = 0; i < 16; ++i) v[i] = val;
        }
        else if (code == 9) { const unsigned cd = ((const unsigned*)(F.ws + WS_RS))[(size_t)r * 2]; float val = 0.f; if (cd) { val = 1.f; for (unsigned k = 0; k < cd; ++k) val *= 10.f; }
#pragma unroll
            for (int i = 0; i < 16; ++i) v[i] = val; }
        else if (code == 10) {
            const v4u w1 = *((const v4u*)((const bf16*)(F.ws + WS_HA) + (size_t)r * D) + 64 + F.lane);
            float f[8]; int bad1 = 0; unpack8(w1, f);
#pragma unroll
            for (int i = 0; i < 8; ++i) { const unsigned u = __builtin_bit_cast(unsigned, f[i]); bad1 |= ((u & 0x7f800000u) == 0x7f800000u) ? 1 : 0; }
            const bool vC = (__ballot(bad1) & 0xffffffffull) != 0;
            const bf16* pc = (const bf16*)(F.ws + WS_PB) + ((size_t)b * TT + SEQ + (t & 255)) * NPJ; int badp = 0;
            for (int c = F.lane; c < 288; c += 64) { const v4u w = *((const v4u*)pc + c); unpack8(w, f);
#pragma unroll
                for (int i = 0; i < 8; ++i) { const unsigned u = __builtin_bit_cast(unsigned, f[i]); badp |= ((u & 0x7f800000u) == 0x7f800000u) ? 1 : 0; } }
            float val = 0.f; if (vC) { val = 1.f; for (int k = 0; k <= (t & 15); ++k) val *= 10.f; }
            if (__any(badp)) val = 1.0e30f;
#pragma unroll
            for (int i = 0; i < 16; ++i) v[i] = val;
        }
        else if (code == 11) {
            const bf16* pr = (const bf16*)(F.ws + WS_PB) + (size_t)r * NPJ; int grp = -1;
            for (int c = F.lane; c < 288; c += 64) { const v4u w = *((const v4u*)pr + c); float f[8]; unpack8(w, f);
#pragma unroll
                for (int i = 0; i < 8; ++i) if (!(fabsf(f[i]) < 1.0e4f)) grp = (c * 8) >> 8; }
#pragma unroll
            for (int o = 1; o < 64; o <<= 1) { const int g2 = __shfl_xor(grp, o); grp = g2 > grp ? g2 : grp; }
            float val = 0.f; if (grp >= 0) { val = 100.f; for (int k = 0; k < grp; ++k) val *= 10.f; }
#pragma unroll
            for (int i = 0; i < 16; ++i) v[i] = val;
        }
        else if (code >= 20 && code < 24) {
            float val = 0.f;
            if ((t & 15) == 5) { for (int h = 0; h < 4; ++h) { const float e = oracle_attn(F, 0, r, code - 20, h); const float cls = e > 1.0e20f ? 3.f : e > 0.5f ? 2.f : e > 0.03f ? 1.f : 0.f; if (cls > 0.f) { float w = cls; for (int k = 0; k <= h; ++k) w *= 10.f; val = fmaxf(val, w); } } }
#pragma unroll
            for (int i = 0; i < 16; ++i) v[i] = val;
        }
        else if (code >= 30 && code < 46) {
            float val = 0.f;
            if ((t & 15) == 5) { const float e = oracle_attn(F, 0, r, (code - 30) >> 2, (code - 30) & 3, DBG_MODE); val = e > 10.f ? 1.0e4f : 1000.f * e; }
#pragma unroll
            for (int i = 0; i < 16; ++i) v[i] = val;
        }
        else if (code == 7) {
            auto bad16 = [&](const bf16* p, int nchunks) { int bad = 0; for (int c = F.lane; c < nchunks; c += 64) { const v4u w = *((const v4u*)p + c); float f[8]; unpack8(w, f);
#pragma unroll
                for (int i = 0; i < 8; ++i) { const unsigned u = __builtin_bit_cast(unsigned, f[i]); bad |= ((u & 0x7f800000u) == 0x7f800000u) ? 1 : 0; } } return __any(bad); };
            const int bP = bad16((const bf16*)(F.ws + WS_PB) + (size_t)r * NPJ, 288), bQ = bad16((const bf16*)(F.ws + WS_QD) + (size_t)r * 384, 48),
                      bK = bad16((const bf16*)(F.ws + WS_KD) + (size_t)r * 384, 48), bV = bad16((const bf16*)(F.ws + WS_VD) + (size_t)r * 256, 32), bO = bad16((const bf16*)(F.ws + WS_HA) + (size_t)r * D, 128);
            const float val = bP ? 1.0e6f : bQ ? 1.0e5f : bK ? 1.0e4f : bV ? 1.0e3f : bO ? 1.0e2f : 0.f;
#pragma unroll
            for (int i = 0; i < 16; ++i) v[i] = val;
        }
#pragma unroll
        for (int i = 0; i < 16; ++i) { const unsigned u = __builtin_bit_cast(unsigned, v[i]); if ((u & 0x7f800000u) == 0x7f800000u) v[i] = 777.0f; }
        st16(out + ((size_t)b * SEQ + t) * D, F.lane, v);
    }
}
static __device__ __forceinline__ void ph_dump(GAS unsigned char* ws, int code) { const Frame F = make_frame(ws); phase_dump(F, code); }
__global__ void __launch_bounds__(NTHR, 2) mk_fwd(Args args) {
    extern __shared__ __attribute__((aligned(16))) unsigned char lds_raw[];
    LAS unsigned char* lds = (LAS unsigned char*)lds_raw; volatile LAS unsigned* MISC = (volatile LAS unsigned*)(lds + MISC_OFF);
    const int tid = threadIdx.x;
    GAS unsigned char* ws = (GAS unsigned char*)args.ws;
    for (int u = tid; u < (LDS_BYTES - MISC_OFF) / 4; u += NTHR) MISC[u] = 0u;
    __syncthreads();
    if (tid < 28) { const unsigned long long p = tid < 27 ? (unsigned long long)args.in[tid] : (unsigned long long)args.out;
        LAS unsigned* t = (LAS unsigned*)(lds + PTAB_OFF) + 2 * tid; t[0] = (unsigned)p; t[1] = (unsigned)(p >> 32); }
    __syncthreads();
#if MK_MULTI
#define GRID_BAR() do { } while (0)
#else
    XcdBarrier bar = xcd_barrier_post((unsigned*)(ws + WS_CTL) + CW_BAR, MISC + MI_BAR);
#define GRID_BAR() xcd_barrier(bar)
#endif
    const int lo = args.ph_lo, hi = args.ph_hi;
#define IN(k) (lo <= (k) && (k) < hi)
#define SEAM(k) do { if (IN(k) && IN((k) + 1)) GRID_BAR(); } while (0)

    if (lo >= 100) { ph_dump(ws, lo - 100); return; }
    if (IN(0)) { ph_prologue(ws); } SEAM(0);
    for (int l = 0; l < NL; ++l) {
        const int pb = 1 + 10 * l;
        if (IN(pb + 0)) { ph_ln(ws, l); } SEAM(pb + 0);
        if (IN(pb + 1)) { ph_gemm_in(ws, l); } SEAM(pb + 1);
        if (IN(pb + 2)) { ph_post(ws, l); } SEAM(pb + 2);
        if (IN(pb + 3)) { ph_gemm_mla(ws, l); } SEAM(pb + 3);
        if (IN(pb + 4)) { ph_attn(ws, l); } SEAM(pb + 4);
        if (IN(pb + 5)) { ph_gemm_out(ws, l); } SEAM(pb + 5);
        if (IN(pb + 6)) { ph_route(ws, l); } SEAM(pb + 6);
        if (IN(pb + 7)) { ph_permute(ws); } SEAM(pb + 7);
        if (IN(pb + 8)) { ph_gemm_gu(ws, l); } SEAM(pb + 8);
        if (IN(pb + 9)) { ph_gemm_dn(ws, l); } SEAM(pb + 9);
    }
    if (IN(NPHASE - 1)) { ph_ln(ws, NL); }
#undef IN
#undef SEAM
#undef GRID_BAR
}

extern "C" void kernel_launch(void* const* d_in, const int* in_sizes, int n_in, void* d_out, int out_size, void* d_ws, size_t ws_size, hipStream_t stream) {
    static int grid = 0;
    if (grid == 0) {
        if (n_in != 27 || out_size != NB * SEQ * D || ws_size < WS_END) { fprintf(stderr, "kernel_launch: unexpected problem (n_in %d, out %d, ws %zu < %zu)\n", n_in, out_size, ws_size, (size_t)WS_END); grid = -1; return; }
        int dev = 0, cus = 0, per_cu = 0;
        if (hipGetDevice(&dev) != hipSuccess || hipDeviceGetAttribute(&cus, hipDeviceAttributeMultiprocessorCount, dev) != hipSuccess) { grid = -1; return; }
        if (hipFuncSetAttribute((const void*)mk_fwd, hipFuncAttributeMaxDynamicSharedMemorySize, LDS_BYTES) != hipSuccess) { fprintf(stderr, "kernel_launch: hipFuncSetAttribute failed\n"); grid = -1; return; }
        if (hipOccupancyMaxActiveBlocksPerMultiprocessor(&per_cu, (const void*)mk_fwd, NTHR, LDS_BYTES) != hipSuccess || per_cu < 1) fprintf(stderr, "kernel_launch: occupancy query reports %d\n", per_cu);
        (void)hipGetLastError();
        grid = cus > 1024 ? 1024 : cus;
    }
    if (grid < 0) return;
    (void)hipMemsetAsync((char*)d_ws + WS_CTL, 0, CTL_BYTES, stream);
    Args a{};
    for (int i = 0; i < 27; ++i) a.in[i] = (const float*)d_in[i];
    a.out = (float*)d_out; a.ws = (unsigned char*)d_ws;
#if MK_MULTI
#ifndef DBG_NRUN
#define DBG_NRUN NPHASE
#endif
    for (int p = 0; p < DBG_NRUN; ++p) { a.ph_lo = p; a.ph_hi = p + 1; hipLaunchKernelGGL(mk_fwd, dim3(grid), dim3(NTHR), LDS_BYTES, stream, a); }
#ifdef DBG_DUMP
    a.ph_lo = 100 + DBG_DUMP; a.ph_hi = 101 + DBG_DUMP; hipLaunchKernelGGL(mk_fwd, dim3(grid), dim3(NTHR), LDS_BYTES, stream, a);
#endif
#else
    a.ph_lo = 0; a.ph_hi = NPHASE;
    hipLaunchKernelGGL(mk_fwd, dim3(grid), dim3(NTHR), LDS_BYTES, stream, a);
#endif
}
```

```cpp
#include <hip/hip_runtime.h>
#include <cstdio>
#include <cstdint>
namespace pg8 {
#define PG8_LAS __attribute__((address_space(3)))
typedef unsigned short bf16_t;
typedef short bf16x8 __attribute__((ext_vector_type(8)));
typedef float f32x4 __attribute__((ext_vector_type(4)));
typedef unsigned u32x4 __attribute__((ext_vector_type(4)));
constexpr int BM = 256, BK = 64, HALF = 128, HTB = HALF * BK * 2  , STAGE_BYTES = 8 * HTB, NXCD = 8, WGM = 8;

__host__ __device__ __forceinline__ int lds_byte(int r, int c) { const int st = (r >> 4) * 2 + (c >> 5), rr = r & 15, cc = c & 31, ob = rr * 64 + cc * 2; return st * 1024 + (ob ^ (((ob >> 9) & 1) << 5)); }
__host__ __device__ __forceinline__ void stage_rc(int b, int& R, int& C) { const int st = b / 1024, sb = b % 1024, swz = sb ^ (((sb >> 9) & 1) << 5); R = (st >> 1) * 16 + swz / 64; C = (st & 1) * 32 + (swz % 64) / 2; }
__host__ __device__ __forceinline__ int perm32(int rho) { const int n = rho >> 4, i = rho & 15; return 8 * (i >> 2) + 4 * n + (i & 3); }

struct Unit { int pm, pn; };
struct Gemm { const bf16_t* A; const bf16_t* Bt; int M, N, K, lda; };

struct StaticOrder {
    int nM, nN, nwg, G, c;
    __host__ __device__ void init(int M, int N, int G_, int c_) { nM = M / BM; nN = N / BM; nwg = nM * nN; G = G_; c = c_; }
    __host__ __device__ bool next(int i, Unit& u) const {
        const long L = (long)i * G + c; if (L >= nwg) return false;
        int wgid = (int)L; { const int q = nwg / NXCD, r = nwg % NXCD, xcd = wgid % NXCD, off = wgid / NXCD; wgid = (xcd < r ? xcd * (q + 1) : r * (q + 1) + (xcd - r) * q) + off; }
        const int nig = WGM * nN, gid = wgid / nig, fm = gid * WGM, gsz = (nM - fm) < WGM ? (nM - fm) : WGM;
        u.pm = fm + ((wgid % nig) % gsz); u.pn = (wgid % nig) / gsz; return true;
    }
    __device__ __forceinline__ void a_ready(const Unit&) const {}
    __device__ __forceinline__ void done(const Unit&) const {}
};

__device__ __forceinline__ unsigned cvt_pk_bf16(float lo, float hi) { unsigned r; asm volatile("v_cvt_pk_bf16_f32 %0, %1, %2" : "=v"(r) : "v"(lo), "v"(hi)); return r; }
typedef float f32x2 __attribute__((ext_vector_type(2)));
__device__ __forceinline__ f32x2 gelu_pk(f32x2 v) {
    const f32x2 av = __builtin_elementwise_abs(v), d = av * 0.2316418882f + 1.0f;
    f32x2 t; t.x = __builtin_amdgcn_rcpf(d.x); t.y = __builtin_amdgcn_rcpf(d.y);
    f32x2 q = t * 0.5307027145f + (-0.7265760135f); q = q * t + 0.7107068705f; q = q * t + (-0.142248368f); q = q * t + 0.127414796f; q = q * t;
    const f32x2 s = (v * v) * (-0.72134752044f);
    f32x2 e; e.x = __builtin_amdgcn_exp2f(s.x); e.y = __builtin_amdgcn_exp2f(s.y);
    const f32x2 m = v * (q * e), r = v - m;
    f32x2 o; o.x = v.x < 0.f ? m.x : r.x; o.y = v.y < 0.f ? m.y : r.y; return o;
}

template <int ACT  > struct EpiBf16 {
    static constexpr bool PERM = true, AFTER_DRAIN = false; static_assert(ACT == 0 || ACT == 1, "EpiBf16: ACT is 0 (none) or 1 (gelu_pk)");
    bf16_t* O; int ldc; const float* bias; int split_cols; size_t split_stride; float scale0;
    __device__ __forceinline__ void operator()(const f32x4 (&acc)[2][2][4][2], const Unit& u, int wr, int wc, int fr, int fq) const {
        const int row0 = u.pm * BM + wr * 64 + fr; int colt = u.pn * BM; bf16_t* base = O;
        float sc = 1.f; if (split_cols) { const int t = colt / split_cols; base += (size_t)t * split_stride; colt -= t * split_cols; if (t == 0) sc = scale0; }
        const int col0 = colt + wc * 32 + 8 * fq, bcol0 = u.pn * BM + wc * 32 + 8 * fq;
        f32x4 bv[2][2];
#pragma unroll
        for (int bj = 0; bj < 2; ++bj)
#pragma unroll
            for (int n = 0; n < 2; ++n) bv[bj][n] = bias ? *(const f32x4*)(bias + bcol0 + bj * HALF + 4 * n) : (f32x4){0.f, 0.f, 0.f, 0.f};
#pragma unroll
        for (int ai = 0; ai < 2; ++ai)
#pragma unroll
            for (int m = 0; m < 4; ++m) { bf16_t* rowp = base + (size_t)(row0 + ai * HALF + m * 16) * ldc + col0;
#pragma unroll
                for (int bj = 0; bj < 2; ++bj) { f32x4 v0 = acc[ai][bj][m][0] + bv[bj][0], v1 = acc[ai][bj][m][1] + bv[bj][1];
                    if (ACT == 1) { f32x2 a = gelu_pk((f32x2){v0[0], v0[1]}), b = gelu_pk((f32x2){v0[2], v0[3]}), c = gelu_pk((f32x2){v1[0], v1[1]}), d = gelu_pk((f32x2){v1[2], v1[3]});
                        v0 = (f32x4){a.x, a.y, b.x, b.y}; v1 = (f32x4){c.x, c.y, d.x, d.y}; }
                    v0 = v0 * sc; v1 = v1 * sc; u32x4 w; w.x = cvt_pk_bf16(v0[0], v0[1]); w.y = cvt_pk_bf16(v0[2], v0[3]); w.z = cvt_pk_bf16(v1[0], v1[1]); w.w = cvt_pk_bf16(v1[2], v1[3]);
                    *(u32x4*)(rowp + bj * HALF) = w; } }
    }
};
struct EpiF32 {
    static constexpr bool PERM = false, AFTER_DRAIN = false;
    float* C; int ldc; const float* bias;
    __device__ __forceinline__ void operator()(const f32x4 (&acc)[2][2][4][2], const Unit& u, int wr, int wc, int fr, int fq) const {
        const int row0 = u.pm * BM + wr * 64 + fr, col0 = u.pn * BM + wc * 32 + 4 * fq;
        f32x4 bv[2][2];
#pragma unroll
        for (int bj = 0; bj < 2; ++bj)
#pragma unroll
            for (int n = 0; n < 2; ++n) bv[bj][n] = bias ? *(const f32x4*)(bias + col0 + bj * HALF + n * 16) : (f32x4){0.f, 0.f, 0.f, 0.f};
#pragma unroll
        for (int ai = 0; ai < 2; ++ai)
#pragma unroll
            for (int m = 0; m < 4; ++m) { float* rowp = C + (size_t)(row0 + ai * HALF + m * 16) * ldc + col0;
#pragma unroll
                for (int bj = 0; bj < 2; ++bj)
#pragma unroll
                    for (int n = 0; n < 2; ++n) *(f32x4*)(rowp + bj * HALF + n * 16) = acc[ai][bj][m][n] + bv[bj][n]; }
    }
};
template <class Epi, class Sched, bool ALIGN_EPI = false, bool SP2 = false>
__device__ __forceinline__ void gemm_phase(PG8_LAS unsigned char* lds, const Gemm g, const Sched& S, const Epi& E) {
    int tid = threadIdx.x; asm volatile("" : "+v"(tid)); const int wid = __builtin_amdgcn_readfirstlane(tid >> 6), lane = tid & 63, wr = wid >> 2, wc = wid & 3, fr = lane & 15, fq = lane >> 4;
    const int K = g.K, nt = K / BK;
    unsigned voffA[2], voffB[2];
#pragma unroll
    for (int i = 0; i < 2; ++i) { int R, C; stage_rc(tid * 16 + i * 8192, R, C); const int Rb = Epi::PERM ? ((R & ~31) + perm32(R & 31)) : R;
        voffA[i] = (unsigned)(R * g.lda + C) * 2u; voffB[i] = (unsigned)(Rb * K + C) * 2u; }
    const size_t kstep = (size_t)(BK * 2);
    const size_t hstepA = (size_t)HALF * g.lda * 2, hstepB = (size_t)HALF * K * 2;
    const size_t tstepA = 2 * hstepA, tstepB = 2 * hstepB;
    const unsigned ldsw = (unsigned)wid * 1024u;
    const int aoff = lds_byte(wr * 64 + fr, fq * 8), boff = lds_byte(wc * 32 + fr, fq * 8);
#define PG8_SA(b, h) (((b) * 2 + (h)) * HTB)
#define PG8_SB(b, h) ((4 + (b) * 2 + (h)) * HTB)
#define PG8_STAGE(bufoff, gbase, voff) do { _Pragma("unroll") for (int _i = 0; _i < 2; ++_i) \
        __builtin_amdgcn_global_load_lds((const unsigned*)((const char*)(gbase) + (voff)[_i]), (PG8_LAS unsigned*)(lds + (bufoff) + ldsw + _i * 8192), 16, 0, 0); } while (0)
#define PG8_LDA(dst, b, h) do { _Pragma("unroll") for (int m = 0; m < 4; ++m) _Pragma("unroll") for (int k = 0; k < 2; ++k) dst[m][k] = *(const PG8_LAS bf16x8*)(lds + PG8_SA(b, h) + aoff + m * 2048 + k * 1024); } while (0)
#define PG8_LDB(dst, b, h) do { _Pragma("unroll") for (int n = 0; n < 2; ++n) _Pragma("unroll") for (int k = 0; k < 2; ++k) dst[n][k] = *(const PG8_LAS bf16x8*)(lds + PG8_SB(b, h) + boff + n * 2048 + k * 1024); } while (0)
#define PG8_MMA(ai, bj, At, Bt) do { __builtin_amdgcn_s_setprio(1); _Pragma("unroll") for (int m = 0; m < 4; ++m) _Pragma("unroll") for (int n = 0; n < 2; ++n) _Pragma("unroll") for (int k = 0; k < 2; ++k) \
        acc[ai][bj][m][n] = __builtin_amdgcn_mfma_f32_16x16x32_bf16(Bt[n][k], At[m][k], acc[ai][bj][m][n], 0, 0, 0); __builtin_amdgcn_s_setprio(0); } while (0)
#define PG8_WAIT_V(n) asm volatile("s_waitcnt vmcnt(" #n ")" ::: "memory")
#define PG8_WAIT_L(n) asm volatile("s_waitcnt lgkmcnt(" #n ")" ::: "memory")
#define PG8_BAR __builtin_amdgcn_s_barrier()
#define PG8_SCHED __builtin_amdgcn_sched_barrier(0)
    Unit cur, nxt; int ui = 0;
    if (!S.next(0, cur)) return;
    f32x4 acc[2][2][4][2];
#pragma unroll
    for (int a = 0; a < 2; ++a)
#pragma unroll
        for (int b = 0; b < 2; ++b)
#pragma unroll
            for (int m = 0; m < 4; ++m)
#pragma unroll
                for (int n = 0; n < 2; ++n) acc[a][b][m][n] = (f32x4){0.f, 0.f, 0.f, 0.f};
    bf16x8 At[4][2], B0[2][2], B1[2][2];
    const char* cA = (const char*)g.A + (size_t)cur.pm * tstepA; const char* cB = (const char*)g.Bt + (size_t)cur.pn * tstepB;
    S.a_ready(cur);
    if constexpr (SP2) {
        PG8_STAGE(PG8_SB(0, 0), cB, voffB); PG8_STAGE(PG8_SB(0, 1), cB + hstepB, voffB); PG8_STAGE(PG8_SA(0, 0), cA, voffA); PG8_STAGE(PG8_SA(0, 1), cA + hstepA, voffA);
        if (wr == 1) PG8_BAR;
        PG8_WAIT_V(2); PG8_BAR;
        PG8_STAGE(PG8_SB(1, 0), cB + kstep, voffB); PG8_STAGE(PG8_SA(1, 0), cA + kstep, voffA); PG8_STAGE(PG8_SB(1, 1), cB + hstepB + kstep, voffB);
        PG8_WAIT_V(6); PG8_BAR;
    } else {
        PG8_STAGE(PG8_SB(0, 0), cB, voffB); PG8_STAGE(PG8_SA(0, 0), cA, voffA); PG8_STAGE(PG8_SB(0, 1), cB + hstepB, voffB); PG8_STAGE(PG8_SA(0, 1), cA + hstepA, voffA);
        if (wr == 1) PG8_BAR;
        PG8_WAIT_V(4); PG8_BAR;
        PG8_STAGE(PG8_SB(1, 0), cB + kstep, voffB); PG8_STAGE(PG8_SA(1, 0), cA + kstep, voffA); PG8_STAGE(PG8_SB(1, 1), cB + hstepB + kstep, voffB);
        PG8_WAIT_V(6); PG8_BAR;
    }
    for (;;) {
        const bool has_next = S.next(ui + 1, nxt);
        const char* nA = has_next ? (const char*)g.A + (size_t)nxt.pm * tstepA : cA; const char* nB = has_next ? (const char*)g.Bt + (size_t)nxt.pn * tstepB : cB;
#pragma unroll 1
        for (int t = 0; t < nt; t += 2) {
            const bool last = (t == nt - 2);
            const char* a1 = cA + (size_t)(t + 1) * kstep;
            const char* a2 = last ? nA : cA + (size_t)(t + 2) * kstep; const char* b2 = last ? nB : cB + (size_t)(t + 2) * kstep;
            const char* a3 = a2 + kstep; const char* b3 = b2 + kstep;
            if (last && has_next) S.a_ready(nxt);
            if constexpr (SP2) {
            PG8_LDB(B0, 0, 0); PG8_LDB(B1, 0, 1); PG8_SCHED; PG8_LDA(At, 0, 0); PG8_STAGE(PG8_SA(1, 1), a1 + hstepA, voffA);
            PG8_WAIT_V(8); PG8_WAIT_L(0); PG8_BAR; PG8_MMA(0, 0, At, B0); PG8_MMA(0, 1, At, B1); PG8_BAR; PG8_SCHED;
            PG8_LDA(At, 0, 1); PG8_STAGE(PG8_SB(0, 0), b2, voffB); PG8_STAGE(PG8_SB(0, 1), b2 + hstepB, voffB); PG8_STAGE(PG8_SA(0, 0), a2, voffA);
            PG8_WAIT_V(8); PG8_WAIT_L(0); PG8_BAR; PG8_MMA(1, 0, At, B0); PG8_MMA(1, 1, At, B1); PG8_BAR; PG8_SCHED;
            PG8_LDB(B0, 1, 0); PG8_LDB(B1, 1, 1); PG8_SCHED; PG8_LDA(At, 1, 0); PG8_STAGE(PG8_SA(0, 1), a2 + hstepA, voffA);
            PG8_WAIT_V(8); PG8_WAIT_L(0); PG8_BAR; PG8_MMA(0, 0, At, B0); PG8_MMA(0, 1, At, B1); PG8_BAR; PG8_SCHED;
            PG8_LDA(At, 1, 1); PG8_STAGE(PG8_SB(1, 0), b3, voffB); PG8_STAGE(PG8_SB(1, 1), b3 + hstepB, voffB); PG8_STAGE(PG8_SA(1, 0), a3, voffA);
            PG8_WAIT_V(8); PG8_WAIT_L(0); PG8_BAR; PG8_MMA(1, 0, At, B0); PG8_MMA(1, 1, At, B1); PG8_BAR; PG8_SCHED;
            } else {
            PG8_LDB(B0, 0, 0); PG8_SCHED; PG8_LDA(At, 0, 0); PG8_STAGE(PG8_SA(1, 1), a1 + hstepA, voffA);
            PG8_WAIT_L(8); PG8_BAR; PG8_WAIT_L(0); PG8_MMA(0, 0, At, B0); PG8_BAR; PG8_SCHED;
            PG8_LDB(B1, 0, 1); PG8_STAGE(PG8_SB(0, 0), b2, voffB);
            PG8_BAR; PG8_WAIT_L(0); PG8_MMA(0, 1, At, B1); PG8_BAR;
            PG8_LDA(At, 0, 1); PG8_STAGE(PG8_SA(0, 0), a2, voffA);
            PG8_BAR; PG8_WAIT_L(0); PG8_MMA(1, 0, At, B0); PG8_BAR; PG8_SCHED;
            PG8_STAGE(PG8_SB(0, 1), b2 + hstepB, voffB);
            PG8_WAIT_V(6); PG8_BAR; PG8_MMA(1, 1, At, B1); PG8_BAR;
            PG8_LDB(B0, 1, 0); PG8_SCHED; PG8_LDA(At, 1, 0); PG8_STAGE(PG8_SA(0, 1), a2 + hstepA, voffA);
            PG8_WAIT_L(8); PG8_BAR; PG8_WAIT_L(0); PG8_MMA(0, 0, At, B0); PG8_BAR; PG8_SCHED;
            PG8_LDB(B1, 1, 1); PG8_STAGE(PG8_SB(1, 0), b3, voffB);
            PG8_BAR; PG8_WAIT_L(0); PG8_MMA(0, 1, At, B1); PG8_BAR;
            PG8_LDA(At, 1, 1); PG8_STAGE(PG8_SA(1, 0), a3, voffA);
            PG8_BAR; PG8_WAIT_L(0); PG8_MMA(1, 0, At, B0); PG8_BAR; PG8_SCHED;
            PG8_STAGE(PG8_SB(1, 1), b3 + hstepB, voffB);
            PG8_WAIT_V(6); PG8_BAR; PG8_MMA(1, 1, At, B1); PG8_BAR;
            }
        }
        if constexpr (ALIGN_EPI) { if (wr == 0) PG8_BAR; }
        if constexpr (!Epi::AFTER_DRAIN) { E(acc, cur, wr, wc, fr, fq); S.done(cur); }
        if (!has_next) break;
#pragma unroll
        for (int a = 0; a < 2; ++a)
#pragma unroll
            for (int b = 0; b < 2; ++b)
#pragma unroll
                for (int m = 0; m < 4; ++m)
#pragma unroll
                    for (int n = 0; n < 2; ++n) acc[a][b][m][n] = (f32x4){0.f, 0.f, 0.f, 0.f};
        cur = nxt; cA = nA; cB = nB; ++ui;
        if constexpr (ALIGN_EPI) { if (wr == 1) PG8_BAR; }
    }
    PG8_WAIT_V(0);
    if constexpr (!ALIGN_EPI) { if (wr == 0) PG8_BAR; }
    PG8_BAR;
    if constexpr (Epi::AFTER_DRAIN) { E.fused(acc, cur, wr, wc, fr, fq, lds, wid, lane); S.done(cur); }
#undef PG8_SA
#undef PG8_SB
#undef PG8_STAGE
#undef PG8_LDA
#undef PG8_LDB
#undef PG8_MMA
#undef PG8_WAIT_V
#undef PG8_WAIT_L
#undef PG8_BAR
#undef PG8_SCHED
}
}

constexpr int NB = 16, SEQ = 4096, CTX = 256, TT = SEQ + CTX, M = NB * TT, D = 1024, NL = 4;
constexpr int NPJ = 2304, DPROJ = 2208;
constexpr int MS = 143360;
constexpr float EPS = 1e-6f, ALPHA = 1.6817928305074290f, LOG2E = 1.4426950408889634f;
constexpr int NWAVES = 8, NTHR = 512;
#ifndef MK_DEBUG
#define MK_DEBUG 0
#endif
#ifndef MK_MULTI
#define MK_MULTI 0
#endif
constexpr int NPHASE = 2 + 10 * NL;

constexpr size_t WS_CTL = 0, CTL_BYTES = 65536;
constexpr size_t WS_MODS = WS_CTL + CTL_BYTES;
constexpr size_t WS_T64 = WS_MODS + (size_t)NL * 17 * 6144 * 4;
constexpr size_t WS_T32 = WS_T64 + 8192;
constexpr size_t WS_RS = WS_T32 + 4096;
constexpr size_t WS_RT = WS_RS + (size_t)M * 8;
constexpr size_t WS_HIST = WS_RT + (size_t)M * 32;
constexpr size_t WS_XC = WS_HIST + 65536;
constexpr size_t WS_WIN = WS_XC + (size_t)NB * CTX * D * 4;
constexpr size_t WS_WD = WS_WIN + (size_t)NL * NPJ * D * 2;
constexpr size_t WS_WOUT = WS_WD + (size_t)NL * 1024 * 384 * 2;
constexpr size_t WS_WGU = WS_WOUT + (size_t)NL * D * D * 2;
constexpr size_t WS_WDN = WS_WGU + (size_t)NL * 16 * 1024 * 1024 * 2;
constexpr size_t WS_HA = WS_WDN + (size_t)NL * 16 * 1024 * 512 * 2;
constexpr size_t WS_PB = WS_HA + (size_t)M * D * 2;
constexpr size_t WS_QD = WS_PB + (size_t)M * NPJ * 2;
constexpr size_t WS_KD = WS_QD + (size_t)M * 384 * 2;
constexpr size_t WS_VD = WS_KD + (size_t)M * 384 * 2;
constexpr size_t WS_ACT = WS_VD + (size_t)M * 256 * 2;
constexpr size_t WS_END = WS_ACT + (size_t)MS * 512 * 2;
static_assert(WS_END <= (size_t)1073741824, "d_ws map must fit 1 GiB");
static_assert((size_t)M * NPJ * 2 >= (size_t)MS * D * 2 && (size_t)M * NPJ * 2 >= (size_t)M * D * 4, "region PB overlays");
constexpr int CW_BAR = 0;
constexpr int CW_QUEUE = 4096;

constexpr int RING_BYTES = 131072, MISC_OFF = RING_BYTES, LDS_BYTES = 147456;
constexpr int MI_BAR = 0, MI_Q = 4, MI_TOT = 16, MI_BASE = 32, MI_PST = 48, MI_LH = 80;

#define GAS __attribute__((address_space(1)))
#define LAS __attribute__((address_space(3)))
typedef unsigned short bf16;
typedef unsigned v4u __attribute__((ext_vector_type(4)));
typedef unsigned v2u __attribute__((ext_vector_type(2)));
typedef float f32x4 __attribute__((ext_vector_type(4)));
typedef float f32x2 __attribute__((ext_vector_type(2)));
typedef short bf16x8 __attribute__((ext_vector_type(8)));
typedef float f32x16 __attribute__((ext_vector_type(16)));
typedef short v4i16 __attribute__((ext_vector_type(4)));

__device__ __forceinline__ unsigned f2bf(float f) { unsigned u = __builtin_bit_cast(unsigned, f); return (u + 0x7fffu + ((u >> 16) & 1u)) >> 16; }
__device__ __forceinline__ unsigned pk2(float lo, float hi) { return f2bf(lo) | (f2bf(hi) << 16); }
__device__ __forceinline__ float bflo(unsigned w) { return __builtin_bit_cast(float, w << 16); }
__device__ __forceinline__ float bfhi(unsigned w) { return __builtin_bit_cast(float, w & 0xffff0000u); }
__device__ __forceinline__ void unpack8(v4u w, float (&f)[8]) { f[0] = bflo(w.x); f[1] = bfhi(w.x); f[2] = bflo(w.y); f[3] = bfhi(w.y); f[4] = bflo(w.z); f[5] = bfhi(w.z); f[6] = bflo(w.w); f[7] = bfhi(w.w); }
__device__ __forceinline__ v4u pack8(const float (&f)[8]) { v4u w; w.x = pk2(f[0], f[1]); w.y = pk2(f[2], f[3]); w.z = pk2(f[4], f[5]); w.w = pk2(f[6], f[7]); return w; }
__device__ __forceinline__ float wave_sum(float v) {
#pragma unroll
    for (int o = 1; o < 64; o <<= 1) v += __shfl_xor(v, o);
    return v;
}

#define XB_TMO      128
#define XB_XCNT(j)  (256  + 64 * (j))
#define XB_XSUB(j)  (1280 + 64 * (j))
#define XB_XGEN(j)  (2304 + 64 * (j))
#define XB_TOP      3328
#define XB_TOPGEN   3392
#define XCD_BAR_WORDS 3456
#define XB_SPIN_CAP (1u << 22)
__device__ __forceinline__ unsigned xb_ld(unsigned* p)              { return __hip_atomic_load(p, __ATOMIC_RELAXED, __HIP_MEMORY_SCOPE_AGENT); }
__device__ __forceinline__ unsigned xb_add(unsigned* p, unsigned v) { return __hip_atomic_fetch_add(p, v, __ATOMIC_RELAXED, __HIP_MEMORY_SCOPE_AGENT); }
__device__ __forceinline__ unsigned xb_xcc_id() { return (unsigned)__builtin_amdgcn_s_getreg((3 << 11) | 20) & 0xFu; }
#define XB_SPIN(cond, bar) do { unsigned _sp = 0; while (cond) { __builtin_amdgcn_s_sleep(1); \
    if ((++_sp & 255u) == 0u) { if (xb_ld(&(bar)[XB_TMO])) break; if (_sp > XB_SPIN_CAP) { atomicAdd(&(bar)[XB_TMO], 1u); break; } } } } while (0)
struct XcdBarrier { unsigned* bar; unsigned x; volatile LAS unsigned* st; };
__device__ __forceinline__ XcdBarrier xcd_barrier_post(unsigned* bar, volatile LAS unsigned* st) {
    XcdBarrier b; b.bar = bar; b.x = xb_xcc_id(); b.st = st;
    if (threadIdx.x == 0) (void)xb_add(&bar[XB_XCNT(b.x)], 1u);
    return b;
}
__device__ __forceinline__ void xcd_barrier_complete(unsigned* bar, unsigned x, unsigned& nloc, unsigned& nx) {
    const unsigned G = gridDim.x * gridDim.y * gridDim.z;
    unsigned sum, cnt, mine, sp = 0u;
    for (;;) {
        sum = 0u; cnt = 0u; mine = 0u;
#pragma unroll
        for (unsigned j = 0; j < 16; ++j) { const unsigned c = xb_ld(&bar[XB_XCNT(j)]); sum += c; cnt += (c > 0u) ? 1u : 0u; mine = (j == x) ? c : mine; }
        if (sum == G) break;
        __builtin_amdgcn_s_sleep(1);
        if ((++sp & 255u) == 0u) { if (xb_ld(&bar[XB_TMO])) break; if (sp > XB_SPIN_CAP) { atomicAdd(&bar[XB_TMO], 1u); break; } }
    }
    nloc = mine > 0u ? mine : 1u; nx = cnt > 0u ? cnt : 1u;
}
__device__ __forceinline__ void xcd_barrier(const XcdBarrier& b) {
    asm volatile("s_waitcnt vmcnt(0)" ::: "memory");
    __syncthreads();
    if (threadIdx.x == 0) {
        unsigned* bar = b.bar;
        __builtin_amdgcn_s_waitcnt(0);
        unsigned nloc = b.st[0], nx = b.st[1];
        if (nloc == 0u) { xcd_barrier_complete(bar, b.x, nloc, nx); b.st[0] = nloc; b.st[1] = nx; }
        const unsigned old = xb_add(&bar[XB_XSUB(b.x)], 1u);
        const unsigned gen = old / nloc;
        if (old + 1u == (gen + 1u) * nloc) {
            __builtin_amdgcn_fence(__ATOMIC_RELEASE, "agent");
            asm volatile("s_waitcnt vmcnt(0)" ::: "memory");
            const unsigned og = xb_add(&bar[XB_TOP], 1u);
            const unsigned tg = og / nx;
            if (og + 1u == (tg + 1u) * nx) xb_add(&bar[XB_TOPGEN], 1u);
            else XB_SPIN(xb_ld(&bar[XB_TOPGEN]) == tg, bar);
            __builtin_amdgcn_fence(__ATOMIC_ACQUIRE, "agent");
            xb_add(&bar[XB_XGEN(b.x)], 1u);
            asm volatile("s_waitcnt vmcnt(0)" ::: "memory");
        } else {
            XB_SPIN(xb_ld(&bar[XB_XGEN(b.x)]) == gen, bar);
            __builtin_amdgcn_fence(__ATOMIC_ACQUIRE, "agent");
            asm volatile("s_waitcnt vmcnt(0)" ::: "memory");
        }
    }
    __syncthreads();
}

struct Args { const float* in[27]; float* out; unsigned char* ws; int ph_lo, ph_hi; };
enum { I_X = 0, I_C, I_CTX, I_CCTX, I_WADA, I_BADA, I_WIN, I_NABIAS, I_GQG, I_GKG, I_SINK, I_MQG, I_WQB, I_MKVG, I_WKVB, I_WOUT, I_LN1G, I_LN1B, I_RGW, I_RGB, I_REW, I_REB, I_WG, I_WU, I_WDN, I_LN2G, I_LN2B };

struct Frame {
    LAS unsigned char* lds; volatile LAS unsigned* MISC;
    int tid, lane, wave, G, gw, ngw, bid;
    GAS unsigned char* ws;
};
__device__ __forceinline__ int opaque_tid() { int t = threadIdx.x; asm volatile("" : "+v"(t)); return t; }
__device__ __forceinline__ int opaque_s(int x) { asm volatile("" : "+s"(x)); return x; }
constexpr int PTAB_OFF = MISC_OFF + 2048, I_OUT = 27;
__device__ __forceinline__ GAS unsigned char* ptab_get(const Frame& F, int i) {
    const LAS unsigned* t = (const LAS unsigned*)(F.lds + PTAB_OFF) + 2 * i;
    const unsigned lo = __builtin_amdgcn_readfirstlane(t[0]), hi = __builtin_amdgcn_readfirstlane(t[1]);
    return (GAS unsigned char*)(((unsigned long long)hi << 32) | lo);
}
#define INP(i) ((const float*)ptab_get(F, (i)))
__device__ __forceinline__ Frame make_frame(GAS unsigned char* ws) {
    extern __shared__ __attribute__((aligned(16))) unsigned char lds_raw[];
    Frame F;
    F.lds = (LAS unsigned char*)lds_raw; F.MISC = (volatile LAS unsigned*)(F.lds + MISC_OFF);
    F.tid = opaque_tid(); F.lane = F.tid & 63; F.wave = __builtin_amdgcn_readfirstlane(F.tid >> 6);
    F.G = opaque_s((int)gridDim.x); F.bid = opaque_s((int)blockIdx.x); F.gw = F.bid * NWAVES + F.wave; F.ngw = F.G * NWAVES;
    { unsigned long long w = (unsigned long long)ws; asm volatile("" : "+s"(w)); F.ws = (GAS unsigned char*)w; }
    return F;
}
__device__ __forceinline__ const float* xin_row(const Frame& F, int r) {
    const int b = r / TT, t = r - b * TT;
    return t < SEQ ? INP(I_X) + ((size_t)b * SEQ + t) * D : INP(I_CTX) + ((size_t)b * CTX + (t - SEQ)) * D;
}
__device__ __forceinline__ float* xs_row(const Frame& F, int r) {
    const int b = r / TT, t = r - b * TT;
    return t < SEQ ? (float*)ptab_get(F, I_OUT) + ((size_t)b * SEQ + t) * D : (float*)(F.ws + WS_XC) + ((size_t)b * CTX + (t - SEQ)) * D;
}
__device__ __forceinline__ void ld16(const float* p, int lane, float (&v)[16]) {
    const f32x4* q = (const f32x4*)p;
    const f32x4 a = q[2 * lane], b = q[2 * lane + 1], c = q[128 + 2 * lane], d = q[129 + 2 * lane];
    v[0] = a.x; v[1] = a.y; v[2] = a.z; v[3] = a.w; v[4] = b.x; v[5] = b.y; v[6] = b.z; v[7] = b.w;
    v[8] = c.x; v[9] = c.y; v[10] = c.z; v[11] = c.w; v[12] = d.x; v[13] = d.y; v[14] = d.z; v[15] = d.w;
}
__device__ __forceinline__ void st16(float* p, int lane, const float (&v)[16]) {
    f32x4* q = (f32x4*)p;
    q[2 * lane] = (f32x4){v[0], v[1], v[2], v[3]}; q[2 * lane + 1] = (f32x4){v[4], v[5], v[6], v[7]};
    q[128 + 2 * lane] = (f32x4){v[8], v[9], v[10], v[11]}; q[129 + 2 * lane] = (f32x4){v[12], v[13], v[14], v[15]};
}
__device__ __forceinline__ void ld16bf(const bf16* p, int lane, float (&v)[16]) {
    const v4u* q = (const v4u*)p; const v4u a = q[lane], b = q[64 + lane];
    float f[8]; unpack8(a, f);
#pragma unroll
    for (int i = 0; i < 8; ++i) v[i] = f[i];
    unpack8(b, f);
#pragma unroll
    for (int i = 0; i < 8; ++i) v[8 + i] = f[i];
}
__device__ __forceinline__ void st16bf(bf16* p, int lane, const float (&v)[16]) {
    v4u* q = (v4u*)p; v4u a, b;
    a.x = pk2(v[0], v[1]); a.y = pk2(v[2], v[3]); a.z = pk2(v[4], v[5]); a.w = pk2(v[6], v[7]);
    b.x = pk2(v[8], v[9]); b.y = pk2(v[10], v[11]); b.z = pk2(v[12], v[13]); b.w = pk2(v[14], v[15]);
    q[lane] = a; q[64 + lane] = b;
}
__device__ __forceinline__ void ln16(float (&v)[16]) {
    float s = 0.f;
#pragma unroll
    for (int i = 0; i < 16; ++i) s += v[i];
    const float mean = wave_sum(s) * (1.0f / D); float q = 0.f;
#pragma unroll
    for (int i = 0; i < 16; ++i) { v[i] -= mean; q += v[i] * v[i]; }
    const float rstd = 1.0f / sqrtf(wave_sum(q) * (1.0f / D) + EPS);
#pragma unroll
    for (int i = 0; i < 16; ++i) v[i] *= rstd;
}

template <int TYPE>
__device__ __forceinline__ float conv_src(const float* p0, const float* p1, const float* g0, const float* g1, int l, int k, int n) {
    if (TYPE == 0) return n < DPROJ ? p0[((size_t)l * D + k) * DPROJ + n] : 0.f;
    if (TYPE == 1) { if (n < 384) return k < 256 ? g0[l * 256 + k] * p0[((size_t)l * 256 + k) * 384 + n] : 0.f;
                     if (n < 896) return k >= 256 ? g1[l * 128 + (k - 256)] * p1[((size_t)l * 128 + (k - 256)) * 512 + (n - 384)] : 0.f;
                     return 0.f; }
    if (TYPE == 2) return p0[((size_t)l * D + k) * D + n];
    if (TYPE == 3) { const int e = n >> 10, nn = n & 1023, q = nn >> 3, j = nn & 7;
                     return j < 4 ? p0[(((size_t)l * 16 + e) * D + k) * 512 + 4 * q + j] : p1[(((size_t)l * 16 + e) * D + k) * 512 + 4 * q + (j - 4)]; }
    { const int e = n >> 10, nn = n & 1023; return p0[(((size_t)l * 16 + e) * 512 + k) * D + nn]; }
}
template <int TYPE>
__device__ __forceinline__ void conv_item(const Frame& F, int l, int item, LAS float* scr) {
    constexpr int Nd = TYPE == 0 ? NPJ : TYPE == 1 ? 1024 : TYPE == 2 ? 1024 : 16384, Kd = TYPE == 1 ? 384 : TYPE == 4 ? 512 : 1024;
    bf16* dst = (bf16*)(F.ws + (TYPE == 0 ? WS_WIN : TYPE == 1 ? WS_WD : TYPE == 2 ? WS_WOUT : TYPE == 3 ? WS_WGU : WS_WDN)) + (size_t)l * Nd * Kd;
    const float* p0 = INP(TYPE == 0 ? I_WIN : TYPE == 1 ? I_WQB : TYPE == 2 ? I_WOUT : TYPE == 3 ? I_WG : I_WDN);
    const float* p1 = INP(TYPE == 1 ? I_WKVB : I_WU); const float* g0 = INP(I_MQG); const float* g1 = INP(I_MKVG);
    constexpr int nblk = Nd / 32; const int kb = item / nblk, nb = item - kb * nblk, k0 = 64 * kb, n0 = 32 * nb, lane = F.lane;
#pragma unroll 4
    for (int i = 0; i < 32; ++i) { const int kk = 2 * i + (lane >> 5); scr[kk * 33 + (lane & 31)] = conv_src<TYPE>(p0, p1, g0, g1, l, k0 + kk, n0 + (lane & 31)); }
    asm volatile("s_waitcnt lgkmcnt(0)" ::: "memory");
    const int c = lane & 7;
#pragma unroll
    for (int j = 0; j < 4; ++j) { const int n = (lane >> 3) + 8 * j; const LAS float* s = scr + (8 * c) * 33 + n;
        v4u o; o.x = pk2(s[0 * 33], s[1 * 33]); o.y = pk2(s[2 * 33], s[3 * 33]); o.z = pk2(s[4 * 33], s[5 * 33]); o.w = pk2(s[6 * 33], s[7 * 33]);
        *(v4u*)(dst + (size_t)(n0 + n) * Kd + k0 + 8 * c) = o; }
    asm volatile("s_waitcnt lgkmcnt(0)" ::: "memory");
}
__device__ __forceinline__ void phase_prologue(const Frame& F) {
    {
        LAS float* sv = (LAS float*)F.lds;
        LAS float* red = (LAS float*)(F.lds + 17 * 1024 * 4);
        float* mods = (float*)(F.ws + WS_MODS);
        for (int u = F.bid; u < NL * 48; u += F.G) {
            const int l = u / 48, cc = u - l * 48;
            for (int i = F.tid; i < 17 * 1024; i += NTHR) { const int mr = i >> 10, k = i & 1023; const float c = mr < 16 ? INP(I_C)[mr * 1024 + k] : INP(I_CCTX)[k]; sv[i] = c / (1.0f + expf(-c)); }
            __syncthreads();
            const int col = F.tid & 127, kg = F.tid >> 7;
            float acc[17];
#pragma unroll
            for (int mr = 0; mr < 17; ++mr) acc[mr] = 0.f;
            const float* w = INP(I_WADA) + ((size_t)l * 1024 + kg * 256) * 6144 + cc * 128 + col;
            for (int k4 = 0; k4 < 256; k4 += 4) {
                const float w0 = w[(size_t)(k4 + 0) * 6144], w1 = w[(size_t)(k4 + 1) * 6144], w2 = w[(size_t)(k4 + 2) * 6144], w3 = w[(size_t)(k4 + 3) * 6144];
#pragma unroll
                for (int mr = 0; mr < 17; ++mr) { const f32x4 s = *(const LAS f32x4*)(sv + mr * 1024 + kg * 256 + k4); acc[mr] += (s.x * w0 + s.y * w1) + (s.z * w2 + s.w * w3); }
            }
#pragma unroll
            for (int mr = 0; mr < 17; ++mr) red[(kg * 17 + mr) * 128 + col] = acc[mr];
            __syncthreads();
            for (int i = F.tid; i < 17 * 128; i += NTHR) { const int mr = i >> 7, c = i & 127;
                const float s = (red[(0 * 17 + mr) * 128 + c] + red[(1 * 17 + mr) * 128 + c]) + (red[(2 * 17 + mr) * 128 + c] + red[(3 * 17 + mr) * 128 + c]);
                mods[((size_t)l * 17 + mr) * 6144 + cc * 128 + c] = s + INP(I_BADA)[l * 6144 + cc * 128 + c]; }
            __syncthreads();
        }
    }
    {
        float* t64 = (float*)(F.ws + WS_T64); float* t32 = (float*)(F.ws + WS_T32);
        for (int i = F.bid * NTHR + F.tid; i < 64 * 16 + 64 * 8; i += F.G * NTHR) {
            if (i < 1024) { const int p = i >> 4, k = i & 15; const float fr = powf(10000.0f, -(float)k / 16.0f), ang = (float)p * fr; t64[2 * i] = cosf(ang); t64[2 * i + 1] = sinf(ang); }
            else { const int j = i - 1024, p = j >> 3, k = j & 7; const float fr = powf(10000.0f, -(float)k / 8.0f), ang = (float)p * fr; t32[2 * j] = cosf(ang); t32[2 * j + 1] = sinf(ang); }
        }
    }
    {
        __syncthreads();
        LAS float* scr = (LAS float*)(F.lds + F.wave * 8448);
        constexpr int I0 = 1152, I1 = 192, I2 = 512, I3 = 8192, I4 = 4096, IL = I0 + I1 + I2 + I3 + I4;
        for (int it = F.gw; it < NL * IL; it += F.ngw) {
            const int l = it / IL; int r = it - l * IL;
            if (r < I0) { conv_item<0>(F, l, r, scr); continue; } r -= I0;
            if (r < I1) { conv_item<1>(F, l, r, scr); continue; } r -= I1;
            if (r < I2) { conv_item<2>(F, l, r, scr); continue; } r -= I2;
            if (r < I3) { conv_item<3>(F, l, r, scr); continue; } r -= I3;
            conv_item<4>(F, l, r, scr);
        }
    }
}

__device__ __forceinline__ void phase_ln(const Frame& F, int l) {
    const float* mods = (const float*)(F.ws + WS_MODS); bf16* HA = (bf16*)(F.ws + WS_HA);
    const bf16* Y = (const bf16*)(F.ws + WS_PB); const unsigned* RT = (const unsigned*)(F.ws + WS_RT);
    for (int r = F.gw; r < M; r += F.ngw) {
        const int b = r / TT, t = r - b * TT; const bool lat = t < SEQ; const int mr = lat ? b : 16;
        if (l == NL && !lat) continue;
        float v[16];
        if (l == 0) ld16(xin_row(F, r), F.lane, v);
        else {
            float* xr = xs_row(F, r); ld16(xr, F.lane, v);
            const unsigned* rt = RT + (size_t)r * 8;
            const float w0 = __builtin_bit_cast(float, rt[4]), w1 = __builtin_bit_cast(float, rt[5]); const unsigned p0 = rt[6], p1 = rt[7];
            float y0[16], y1[16], g2[16], gg[16], bb[16];
            ld16bf(Y + (size_t)p0 * D, F.lane, y0); ld16bf(Y + (size_t)p1 * D, F.lane, y1);
            ld16(mods + ((size_t)(l - 1) * 17 + mr) * 6144 + 5120, F.lane, g2);
#pragma unroll
            for (int i = 0; i < 16; ++i) v[i] = ALPHA * v[i] + g2[i] * (w0 * y0[i] + w1 * y1[i]);
            ln16(v);
            ld16(INP(I_LN2G) + (l - 1) * D, F.lane, gg); ld16(INP(I_LN2B) + (l - 1) * D, F.lane, bb);
#pragma unroll
            for (int i = 0; i < 16; ++i) v[i] = v[i] * gg[i] + bb[i];
            st16(xr, F.lane, v);
        }
        if (l < NL) {
            float sh[16], sc[16];
            ld16(mods + ((size_t)l * 17 + mr) * 6144, F.lane, sh); ld16(mods + ((size_t)l * 17 + mr) * 6144 + 1024, F.lane, sc);
            ln16(v);
#pragma unroll
            for (int i = 0; i < 16; ++i) v[i] = v[i] * (1.0f + sc[i]) + sh[i];
            st16bf(HA + (size_t)r * D, F.lane, v);
        }
    }
}

__device__ __forceinline__ void rope8(float (&f)[8], const float (&p)[8], const float* cs, bool first) {
    const f32x4* c4 = (const f32x4*)cs;
#pragma unroll
    for (int q = 0; q < 4; ++q) { const f32x4 t = c4[q];
        f[2 * q] = first ? f[2 * q] * t.x - p[2 * q] * t.y : p[2 * q] * t.y + f[2 * q] * t.x;
        f[2 * q + 1] = first ? f[2 * q + 1] * t.z - p[2 * q + 1] * t.w : p[2 * q + 1] * t.w + f[2 * q + 1] * t.z; }
}
__device__ __forceinline__ void phase_post(const Frame& F, int l) {
    bf16* P = (bf16*)(F.ws + WS_PB); bf16* KD = (bf16*)(F.ws + WS_KD);
    const float* t64 = (const float*)(F.ws + WS_T64); const float* t32 = (const float*)(F.ws + WS_T32);
    const int lane = F.lane;
    for (int r = F.gw; r < M; r += F.ngw) {
        const int b = r / TT, t = r - b * TT; const bool lat = t < SEQ; const int gr = (t >> 6) & 63, gc = t & 63;
        bf16* prow = P + (size_t)r * NPJ;
        const int j = lane & 7;
        const float* cs64 = t64 + ((size_t)((j < 4 ? gr : gc) * 16 + (j & 1) * 8)) * 2;
        {
            v4u* pp = (v4u*)(prow + 768) + lane; float f[8]; unpack8(*pp, f);
            float ss = 0.f;
#pragma unroll
            for (int i = 0; i < 8; ++i) ss += f[i] * f[i];
            ss += __shfl_xor(ss, 1); ss += __shfl_xor(ss, 2); ss += __shfl_xor(ss, 4);
            const float rr = 1.0f / sqrtf(ss * (1.0f / 64.0f) + EPS);
            const float* gn = (lane < 32 ? INP(I_GQG) : INP(I_GKG)) + l * 64 + j * 8;
#pragma unroll
            for (int i = 0; i < 8; ++i) f[i] = f[i] * rr * gn[i];
            float p[8];
#pragma unroll
            for (int i = 0; i < 8; ++i) p[i] = __shfl_xor(f[i], 2);
            if (lat) rope8(f, p, cs64, (j & 2) == 0);
            if (lane < 48) *pp = pack8(f);
        }
        if (lat) {
            v4u* pp = (v4u*)(prow + 1280) + lane; float f[8]; unpack8(*pp, f);
            float p[8];
#pragma unroll
            for (int i = 0; i < 8; ++i) p[i] = __shfl_xor(f[i], 2);
            rope8(f, p, cs64, (j & 2) == 0);
            if (lane < 48) *pp = pack8(f);
        }
        {
            const v4u w = *((const v4u*)(prow + 1792) + lane); float f[8]; unpack8(w, f);
            float ss = 0.f;
#pragma unroll
            for (int i = 0; i < 8; ++i) ss += f[i] * f[i];
            ss += __shfl_xor(ss, 1); ss += __shfl_xor(ss, 2); ss += __shfl_xor(ss, 4); ss += __shfl_xor(ss, 8);
            const float s32 = ss + __shfl_xor(ss, 16);
            const float rn = lane < 32 ? 1.0f / sqrtf(s32 * (1.0f / 256.0f) + EPS) : 1.0f / sqrtf(ss * (1.0f / 128.0f) + EPS);
            if (lane < 48) { float fn[8];
#pragma unroll
                for (int i = 0; i < 8; ++i) fn[i] = f[i] * rn;
                *((v4u*)(prow + 1792) + lane) = pack8(fn); }
            float p[8];
#pragma unroll
            for (int i = 0; i < 8; ++i) p[i] = __shfl_xor(f[i], 1);
            const int jj = lane & 3;
            if (lat) rope8(f, p, t32 + ((size_t)((jj < 2 ? gr : gc) * 8)) * 2, (jj & 1) == 0);
            if (lane >= 48 && lane < 52) { const v4u o = pack8(f);
#pragma unroll
                for (int h = 0; h < 4; ++h) *(v4u*)(KD + (size_t)r * 384 + h * 96 + 64 + 8 * jj) = o; }
        }
    }
}

__device__ __forceinline__ void phase_route(const Frame& F, int l) {
    const float* mods = (const float*)(F.ws + WS_MODS); bf16* HA = (bf16*)(F.ws + WS_HA);
    const float* MIX = (const float*)(F.ws + WS_PB); unsigned* RT = (unsigned*)(F.ws + WS_RT); int* HIST = (int*)(F.ws + WS_HIST);
    LAS float* WR = (LAS float*)F.lds;
    for (int i = F.tid; i < 20 * 1024; i += NTHR) { const int jx = i >> 10, k = i & 1023;
        WR[i] = jx < 4 ? INP(I_RGW)[((size_t)l * D + k) * 4 + jx] : INP(I_REW)[((size_t)l * D + k) * 16 + (jx - 4)]; }
    if (F.tid < 16) F.MISC[MI_LH + F.tid] = 0u;
    __syncthreads();
    float bias[20];
#pragma unroll
    for (int jx = 0; jx < 20; ++jx) bias[jx] = jx < 4 ? INP(I_RGB)[l * 4 + jx] : INP(I_REB)[l * 16 + (jx - 4)];
    for (int r = F.gw; r < M; r += F.ngw) {
        const int b = r / TT, t = r - b * TT; const bool lat = t < SEQ; const int mr = lat ? b : 16;
        const float* md = mods + ((size_t)l * 17 + mr) * 6144;
        float v[16], mx[16], g1[16], gg[16], bb[16];
        ld16(l == 0 ? xin_row(F, r) : xs_row(F, r), F.lane, v);
        ld16(MIX + (size_t)r * D, F.lane, mx); ld16(md + 2048, F.lane, g1);
#pragma unroll
        for (int i = 0; i < 16; ++i) v[i] = ALPHA * v[i] + g1[i] * mx[i];
        ln16(v);
        ld16(INP(I_LN1G) + l * D, F.lane, gg); ld16(INP(I_LN1B) + l * D, F.lane, bb);
#pragma unroll
        for (int i = 0; i < 16; ++i) v[i] = v[i] * gg[i] + bb[i];
        st16(xs_row(F, r), F.lane, v);
        ld16(md + 3072, F.lane, gg); ld16(md + 4096, F.lane, bb);
        ln16(v);
#pragma unroll
        for (int i = 0; i < 16; ++i) v[i] = v[i] * (1.0f + bb[i]) + gg[i];
        st16bf(HA + (size_t)r * D, F.lane, v);
        float lgt[20];
#pragma unroll
        for (int jx = 0; jx < 20; ++jx) {
            const LAS f32x4* wq = (const LAS f32x4*)(WR + jx * 1024);
            const f32x4 w0 = wq[2 * F.lane], w1 = wq[2 * F.lane + 1], w2 = wq[128 + 2 * F.lane], w3 = wq[129 + 2 * F.lane];
            float s = (v[0] * w0.x + v[1] * w0.y) + (v[2] * w0.z + v[3] * w0.w) + (v[4] * w1.x + v[5] * w1.y) + (v[6] * w1.z + v[7] * w1.w)
                    + (v[8] * w2.x + v[9] * w2.y) + (v[10] * w2.z + v[11] * w2.w) + (v[12] * w3.x + v[13] * w3.y) + (v[14] * w3.z + v[15] * w3.w);
            lgt[jx] = wave_sum(s) + bias[jx];
        }
        int grp = 0; float mg = lgt[0];
#pragma unroll
        for (int g = 1; g < 4; ++g) if (lgt[g] > mg) { mg = lgt[g]; grp = g; }
        float sg = 0.f;
#pragma unroll
        for (int g = 0; g < 4; ++g) sg += expf(lgt[g] - mg);
        const float pg = 1.0f / sg;
        float sel[4];
#pragma unroll
        for (int i = 0; i < 4; ++i) sel[i] = grp == 0 ? lgt[4 + i] : grp == 1 ? lgt[8 + i] : grp == 2 ? lgt[12 + i] : lgt[16 + i];
        int i1 = 0; float v1 = sel[0];
#pragma unroll
        for (int i = 1; i < 4; ++i) if (sel[i] > v1) { v1 = sel[i]; i1 = i; }
        int i2 = -1; float v2 = -3.0e38f;
#pragma unroll
        for (int i = 0; i < 4; ++i) if (i != i1 && (i2 < 0 || sel[i] > v2)) { v2 = sel[i]; i2 = i; }
        const float ee = expf(v2 - v1), w1 = pg / (1.0f + ee), w2 = pg * ee / (1.0f + ee);
        const int e1 = grp * 4 + i1, e2 = grp * 4 + i2;
        if (F.lane == 0) {
            const unsigned k1 = __hip_atomic_fetch_add((LAS unsigned*)&F.MISC[MI_LH + e1], 1u, __ATOMIC_RELAXED, __HIP_MEMORY_SCOPE_WORKGROUP);
            const unsigned k2 = __hip_atomic_fetch_add((LAS unsigned*)&F.MISC[MI_LH + e2], 1u, __ATOMIC_RELAXED, __HIP_MEMORY_SCOPE_WORKGROUP);
            v4u ra; ra.x = (unsigned)e1; ra.y = (unsigned)e2; ra.z = k1; ra.w = k2;
            v4u rb; rb.x = __builtin_bit_cast(unsigned, w1); rb.y = __builtin_bit_cast(unsigned, w2); rb.z = 0u; rb.w = 0u;
            *(v4u*)(RT + (size_t)r * 8) = ra; *(v4u*)(RT + (size_t)r * 8 + 4) = rb;
        }
    }
    __syncthreads();
    if (F.tid < 16) HIST[F.bid * 16 + F.tid] = (int)F.MISC[MI_LH + F.tid];
}
__device__ __forceinline__ void moe_tables(const Frame& F) {
    const int* HIST = (const int*)(F.ws + WS_HIST); LAS int* hl = (LAS int*)F.lds;
    __syncthreads();
    for (int i = F.tid; i < F.G * 16; i += NTHR) hl[i] = HIST[i];
    __syncthreads();
    if (F.tid < 16) { int tot = 0, mine = 0; for (int g = 0; g < F.G; ++g) { const int c = hl[g * 16 + F.tid]; tot += c; mine += (g < F.bid) ? c : 0; }
        F.MISC[MI_TOT + F.tid] = (unsigned)tot; F.MISC[MI_BASE + F.tid] = (unsigned)mine; }
    __syncthreads();
    if (F.tid == 0) { unsigned p = 0; for (int e = 0; e < 16; ++e) { F.MISC[MI_PST + e] = p; F.MISC[MI_BASE + e] += p * 256u; p += (F.MISC[MI_TOT + e] + 255u) >> 8; } F.MISC[MI_PST + 16] = p; }
    __syncthreads();
}
__device__ __forceinline__ void phase_permute(const Frame& F) {
    const bf16* HA = (const bf16*)(F.ws + WS_HA); bf16* HS = (bf16*)(F.ws + WS_PB); unsigned* RT = (unsigned*)(F.ws + WS_RT);
    moe_tables(F);
    for (int r = F.gw; r < M; r += F.ngw) {
        const v4u ra = *(const v4u*)(RT + (size_t)r * 8);
        const unsigned p0 = F.MISC[MI_BASE + (ra.x & 15u)] + ra.z, p1 = F.MISC[MI_BASE + (ra.y & 15u)] + ra.w;
        const v4u* src = (const v4u*)(HA + (size_t)r * D); const v4u x0 = src[F.lane], x1 = src[64 + F.lane];
        v4u* d0 = (v4u*)(HS + (size_t)p0 * D); v4u* d1 = (v4u*)(HS + (size_t)p1 * D);
        d0[F.lane] = x0; d0[64 + F.lane] = x1; d1[F.lane] = x0; d1[64 + F.lane] = x1;
        if (F.lane == 0) { RT[(size_t)r * 8 + 6] = p0; RT[(size_t)r * 8 + 7] = p1; }
    }
}

struct EpiMla {
    static constexpr bool PERM = true, AFTER_DRAIN = false;
    bf16* QD; bf16* KD; bf16* VD;
    __device__ __forceinline__ void operator()(const pg8::f32x4 (&acc)[2][2][4][2], const pg8::Unit& u, int wr, int wc, int fr, int fq) const {
#pragma unroll
        for (int bj = 0; bj < 2; ++bj) {
            const int g0 = u.pn * 256 + bj * 128 + wc * 32, col0 = g0 + 8 * fq;
            if (g0 >= 896) continue;
            const int c = col0 - 384, hd = c >> 7, jx = c & 127;
            bf16* dst = g0 < 384 ? QD + col0 : jx < 64 ? KD + hd * 96 + jx : VD + hd * 64 + (jx - 64);
            const int stride = (g0 < 384 || jx < 64) ? 384 : 256;
            dst += (size_t)(u.pm * 256 + wr * 64 + fr) * stride;
#pragma unroll
            for (int ai = 0; ai < 2; ++ai)
#pragma unroll
                for (int m = 0; m < 4; ++m) {
                    v4u o; o.x = pk2(acc[ai][bj][m][0][0], acc[ai][bj][m][0][1]); o.y = pk2(acc[ai][bj][m][0][2], acc[ai][bj][m][0][3]);
                    o.z = pk2(acc[ai][bj][m][1][0], acc[ai][bj][m][1][1]); o.w = pk2(acc[ai][bj][m][1][2], acc[ai][bj][m][1][3]);
                    *(v4u*)(dst + (size_t)(ai * 128 + m * 16) * stride) = o;
                }
        }
    }
};
struct EpiGU {
    static constexpr bool PERM = true, AFTER_DRAIN = false;
    bf16* ACT;
    __device__ __forceinline__ void operator()(const pg8::f32x4 (&acc)[2][2][4][2], const pg8::Unit& u, int wr, int wc, int fr, int fq) const {
#pragma unroll
        for (int ai = 0; ai < 2; ++ai)
#pragma unroll
            for (int m = 0; m < 4; ++m) {
                const int row = u.pm * 256 + ai * 128 + wr * 64 + m * 16 + fr;
#pragma unroll
                for (int bj = 0; bj < 2; ++bj) {
                    const int c = (u.pn & 3) * 256 + bj * 128 + wc * 32 + 8 * fq;
                    float o[4];
#pragma unroll
                    for (int i = 0; i < 4; ++i) { const float g = acc[ai][bj][m][0][i], up = acc[ai][bj][m][1][i]; o[i] = g / (1.0f + __expf(-g)) * up; }
                    v2u w; w.x = pk2(o[0], o[1]); w.y = pk2(o[2], o[3]);
                    *(v2u*)(ACT + (size_t)row * 512 + (c >> 1)) = w;
                }
            }
    }
};
struct MoeOrder {
    volatile LAS unsigned* pst; int G, c;
    __device__ __forceinline__ bool next(int i, pg8::Unit& u) const {
        const int L = i * G + c; const int np = (int)pst[16];
        if (L >= np * 4) return false;
        const int panel = L >> 2; int e = 0;
#pragma unroll
        for (int k = 1; k < 16; ++k) e += (panel >= (int)pst[k]) ? 1 : 0;
        u.pm = __builtin_amdgcn_readfirstlane(panel); u.pn = __builtin_amdgcn_readfirstlane(e * 4 + (L & 3)); return true;
    }
    __device__ __forceinline__ void a_ready(const pg8::Unit&) const {}
    __device__ __forceinline__ void done(const pg8::Unit&) const {}
};

#ifndef DBG_VAR
#define DBG_VAR 1
#endif
namespace att {
constexpr int VRS = 192, KBUF = 64 * 208, VBUF = 64 * VRS, BUF = KBUF + VBUF, BIAS_OFF = 2 * BUF;
constexpr float NEG = -30000.0f;
__device__ __forceinline__ int crow(int r, int hi) { return (r & 3) + 8 * (r >> 2) + 4 * hi; }
__device__ __forceinline__ float xhalf_max(float v) { const unsigned a = __builtin_bit_cast(unsigned, v);
    auto rr = __builtin_amdgcn_permlane32_swap(a, a, false, false); const unsigned r0 = rr[0], r1 = rr[1]; return fmaxf(__uint_as_float(r0), __uint_as_float(r1)); }
__device__ __forceinline__ float xhalf_sum(float v) { const unsigned a = __builtin_bit_cast(unsigned, v);
    auto rr = __builtin_amdgcn_permlane32_swap(a, a, false, false); const unsigned r0 = rr[0], r1 = rr[1]; return __uint_as_float(r0) + __uint_as_float(r1); }
typedef __bf16 bf16x2_t __attribute__((ext_vector_type(2)));
__device__ __forceinline__ unsigned cvtpk(float lo, float hi) { f32x2 v = {lo, hi}; bf16x2_t b = __builtin_convertvector(v, bf16x2_t); return __builtin_bit_cast(unsigned, b); }

template <int DK>
__device__ __forceinline__ void unit(LAS unsigned char* lds, const bf16* Qp, int qpitch, const bf16* Kp, int kpitch, const bf16* Vp, int vpitch, bf16* Op,
                                     int var, int qt, int lo, int n1, int nt, float qscale, float sinkl2, bool has_sink, const LAS float* bias, const float* t32, unsigned* dbg) {
    constexpr int KRS = DK * 2 + 16, NS = DK / 16, CPK = DK / 8;
    int tid = threadIdx.x; asm volatile("" : "+v"(tid)); const int lane = tid & 63, r32 = lane & 31, hi = lane >> 5, wid = __builtin_amdgcn_readfirstlane(tid >> 6);
    const int qrow = 256 * qt + 32 * wid + r32;
    bf16x8 qr[NS];
#pragma unroll
    for (int s = 0; s < NS; ++s) { const v4u raw = *(const v4u*)(Qp + (size_t)qrow * qpitch + 16 * s + 8 * hi); float f[8]; unpack8(raw, f);
#pragma unroll
        for (int i = 0; i < 8; ++i) f[i] *= qscale;
        if (DK == 96 && s >= 4) {
            float p[8];
#pragma unroll
            for (int i = 0; i < 8; ++i) p[i] = __shfl_xor(f[i], 32);
            if (qt < 16) rope8(f, p, t32 + ((size_t)((s == 4 ? (qrow >> 6) : (qrow & 63)) * 8)) * 2, hi == 0);
        }
        qr[s] = __builtin_bit_cast(bf16x8, pack8(f)); }
    const int kkey0 = tid / CPK, kch0 = tid - kkey0 * CPK, kkey1 = (tid + 512) / CPK, kch1 = (tid + 512) - kkey1 * CPK;
    const int vkey = tid >> 3, vch = tid & 7;
    v4u kreg0, kreg1 = {0u, 0u, 0u, 0u}, vreg;
#define ATT_TROW(j) ((((j) < n1) ? (lo + (j)) : (64 + (j) - n1)) * 64)
#define ATT_LOAD(j) do { const int tr_ = ATT_TROW(j); kreg0 = *(const v4u*)(Kp + (size_t)(tr_ + kkey0) * kpitch + kch0 * 8); \
        if (DK == 96 && tid < 256) kreg1 = *(const v4u*)(Kp + (size_t)(tr_ + kkey1) * kpitch + kch1 * 8); \
        vreg = *(const v4u*)(Vp + (size_t)(tr_ + vkey) * vpitch + vch * 8); } while (0)
#define ATT_STORE(bf) do { LAS unsigned char* b_ = lds + (bf) * BUF; *(LAS v4u*)(b_ + kkey0 * KRS + kch0 * 16) = kreg0; \
        if (DK == 96 && tid < 256) *(LAS v4u*)(b_ + kkey1 * KRS + kch1 * 16) = kreg1; \
        *(LAS v4u*)(b_ + KBUF + vkey * VRS + vch * 16) = vreg; } while (0)
    float m = NEG, l = 0.f; f32x16 o0 = {}, o1 = {};
    const int grw = 4 * qt + (wid >> 1), r0w = min(max(grw - 4, 0), 56), gc = (wid & 1) * 32 + r32, c0 = min(max(gc - 8, 0), 48), i0w = 256 * qt + 32 * wid;
    ATT_LOAD(0); ATT_STORE(0);
    __syncthreads();
    for (int j = 0; j < nt; ++j) {
        if (j + 1 < nt) ATT_LOAD(j + 1);
        const int kt = ATT_TROW(j) >> 6;
        bool actv = true;
        if (kt < 64) { if (var == 0) actv = (kt >= r0w) && (kt <= r0w + 7); else if (var == 2) actv = !((64 * kt - (i0w + 31) > 128) || (i0w - (64 * kt + 63) > 128)); }
        if (actv) {
            const LAS unsigned char* Kb = lds + (j & 1) * BUF; const LAS unsigned char* Vb = Kb + KBUF;
            f32x16 s0 = {}, s1 = {};
#pragma unroll
            for (int s = 0; s < NS; ++s) {
                const bf16x8 ka = *(const LAS bf16x8*)(Kb + r32 * KRS + (16 * s + 8 * hi) * 2);
                const bf16x8 kb = *(const LAS bf16x8*)(Kb + (32 + r32) * KRS + (16 * s + 8 * hi) * 2);
                s0 = __builtin_amdgcn_mfma_f32_32x32x16_bf16(ka, qr[s], s0, 0, 0, 0);
                s1 = __builtin_amdgcn_mfma_f32_32x32x16_bf16(kb, qr[s], s1, 0, 0, 0);
            }
            if (kt < 64 && var == 0) {
                const int rowoff = (kt - grw + 7) * 31 - gc + 15;
#pragma unroll
                for (int r = 0; r < 16; ++r) { const int j0 = crow(r, hi), j1 = j0 + 32;
                    const bool v0 = (unsigned)(j0 - c0) < 16u, v1 = (unsigned)(j1 - c0) < 16u;
                    const float b0 = bias[v0 ? rowoff + j0 : 0], b1 = bias[v1 ? rowoff + j1 : 0];
                    s0[r] = v0 ? s0[r] + b0 : NEG; s1[r] = v1 ? s1[r] + b1 : NEG; }
            } else if (kt < 64 && var == 2) {
                const int dbase = 64 * kt - qrow + 128;
#pragma unroll
                for (int r = 0; r < 16; ++r) { const int j0 = crow(r, hi);
                    s0[r] = (unsigned)(dbase + j0) <= 256u ? s0[r] : NEG; s1[r] = (unsigned)(dbase + j0 + 32) <= 256u ? s1[r] : NEG; }
            }
            float mx = fmaxf(s0[0], s1[0]);
#pragma unroll
            for (int r = 1; r < 16; ++r) mx = fmaxf(mx, fmaxf(s0[r], s1[r]));
            mx = xhalf_max(mx);
            const float mnew = fmaxf(m, mx), alpha = __builtin_amdgcn_exp2f(m - mnew);
            m = mnew;
            float ps = 0.f;
#pragma unroll
            for (int r = 0; r < 16; ++r) { s0[r] = __builtin_amdgcn_exp2f(s0[r] - mnew); s1[r] = __builtin_amdgcn_exp2f(s1[r] - mnew); ps += s0[r] + s1[r]; }
            l = l * alpha + ps;
            if (__any(alpha != 1.0f)) {
#pragma unroll
                for (int r = 0; r < 16; ++r) { o0[r] *= alpha; o1[r] *= alpha; }
            }
            bf16x8 pb[4];
#pragma unroll
            for (int s = 0; s < 2; ++s) {
                v4u w; w.x = cvtpk(s0[8 * s], s0[8 * s + 1]); w.y = cvtpk(s0[8 * s + 2], s0[8 * s + 3]); w.z = cvtpk(s0[8 * s + 4], s0[8 * s + 5]); w.w = cvtpk(s0[8 * s + 6], s0[8 * s + 7]);
                pb[s] = __builtin_bit_cast(bf16x8, w);
                v4u x; x.x = cvtpk(s1[8 * s], s1[8 * s + 1]); x.y = cvtpk(s1[8 * s + 2], s1[8 * s + 3]); x.z = cvtpk(s1[8 * s + 4], s1[8 * s + 5]); x.w = cvtpk(s1[8 * s + 6], s1[8 * s + 7]);
                pb[2 + s] = __builtin_bit_cast(bf16x8, x);
            }
            const LAS unsigned char* vbase = Vb + (4 * hi + ((lane & 15) >> 2)) * VRS + ((lane >> 4) & 1) * 32 + (lane & 3) * 8;
#pragma unroll
            for (int s = 0; s < 4; ++s) {
                const v4i16 a0 = __builtin_amdgcn_ds_read_tr16_b64_v4i16((LAS v4i16*)(vbase + (16 * s) * VRS));
                const v4i16 a1 = __builtin_amdgcn_ds_read_tr16_b64_v4i16((LAS v4i16*)(vbase + (16 * s + 8) * VRS));
                const v4i16 c0_ = __builtin_amdgcn_ds_read_tr16_b64_v4i16((LAS v4i16*)(vbase + (16 * s) * VRS + 64));
                const v4i16 c1_ = __builtin_amdgcn_ds_read_tr16_b64_v4i16((LAS v4i16*)(vbase + (16 * s + 8) * VRS + 64));
                const bf16x8 va = {a0[0], a0[1], a0[2], a0[3], a1[0], a1[1], a1[2], a1[3]};
                const bf16x8 vc = {c0_[0], c0_[1], c0_[2], c0_[3], c1_[0], c1_[1], c1_[2], c1_[3]};
                o0 = __builtin_amdgcn_mfma_f32_32x32x16_bf16(va, pb[s], o0, 0, 0, 0);
                o1 = __builtin_amdgcn_mfma_f32_32x32x16_bf16(vc, pb[s], o1, 0, 0, 0);
            }
        }
        if (j + 1 < nt) ATT_STORE((j + 1) & 1);
        __syncthreads();
    }
    l = xhalf_sum(l);
    const float sterm = has_sink ? __builtin_amdgcn_exp2f(sinkl2 - m) : 0.f;
#if MK_DEBUG
    if (dbg && hi == 0) { dbg[(size_t)qrow * 2] = __builtin_bit_cast(unsigned, m); dbg[(size_t)qrow * 2 + 1] = __builtin_bit_cast(unsigned, l); }
#endif
    if (has_sink) l += sterm;
    const float inv = 1.0f / l;
    bf16* orow = Op + (size_t)qrow * D;
#pragma unroll
    for (int g = 0; g < 4; ++g) {
        v2u w0; w0.x = pk2(o0[4 * g] * inv, o0[4 * g + 1] * inv); w0.y = pk2(o0[4 * g + 2] * inv, o0[4 * g + 3] * inv);
        v2u w1; w1.x = pk2(o1[4 * g] * inv, o1[4 * g + 1] * inv); w1.y = pk2(o1[4 * g + 2] * inv, o1[4 * g + 3] * inv);
        *(v2u*)(orow + 8 * g + 4 * hi) = w0; *(v2u*)(orow + 32 + 8 * g + 4 * hi) = w1;
    }
#undef ATT_TROW
#undef ATT_LOAD
#undef ATT_STORE
}
}

__device__ __forceinline__ void phase_attn(const Frame& F, int l) {
    const bf16* P = (const bf16*)(F.ws + WS_PB); const bf16* QD = (const bf16*)(F.ws + WS_QD); const bf16* KD = (const bf16*)(F.ws + WS_KD);
    const bf16* VD = (const bf16*)(F.ws + WS_VD); bf16* O = (bf16*)(F.ws + WS_HA);
    unsigned* ctr = (unsigned*)(F.ws + WS_CTL) + CW_QUEUE + 64 * l;
    LAS float* bias = (LAS float*)(F.lds + att::BIAS_OFF);
    for (int i = F.tid; i < 4 * 465; i += NTHR) bias[i] = INP(I_NABIAS)[l * 4 * 465 + i] * LOG2E;
    __syncthreads();
    const int nunits = 4096 + (l < NL - 1 ? 256 : 0);
    for (;;) {
        if (F.tid == 0) F.MISC[MI_Q] = __hip_atomic_fetch_add(ctr, 1u, __ATOMIC_RELAXED, __HIP_MEMORY_SCOPE_AGENT);
        __syncthreads();
        const int idx = (int)F.MISC[MI_Q];
        __syncthreads();
        if (idx >= nunits) break;
        int var, b, h, qt;
        if (idx < 4096) { const int grp = idx >> 10, rem = idx & 1023; var = grp == 0 ? 3 : grp == 1 ? 1 : grp == 2 ? 0 : 2; b = rem >> 6; h = (rem >> 4) & 3; qt = rem & 15; }
        else { const int rem = idx - 4096; b = rem >> 4; var = (rem >> 2) & 3; h = rem & 3; qt = 16; }
        int lo = 0, n1 = 64;
        if (qt == 16) { lo = 0; n1 = 0; }
        else if (var == 0) { lo = min(max(4 * qt - 4, 0), 56); n1 = min(max(4 * qt - 1, 0), 56) + 7 - lo + 1; }
        else if (var == 2) { lo = max(4 * qt - 2, 0); n1 = min(4 * qt + 5, 63) - lo + 1; }
        const int nt = n1 + 4;
        const size_t rb = (size_t)b * TT;
        bf16* Op = O + rb * D + var * 256 + h * 64;
        if (var == 3) {
            att::unit<96>(F.lds, QD + rb * 384 + h * 96, 384, KD + rb * 384 + h * 96, 384, VD + rb * 256 + h * 64, 256, Op, 3, qt, lo, n1, nt, 0.10206207261596575f * LOG2E, 0.f, false, bias, (const float*)(F.ws + WS_T32), nullptr);
        } else {
            const int qc = var == 0 ? h * 64 : var == 1 ? 768 + h * 64 : 1280 + h * 64;
            const int kc = var == 0 ? 256 + h * 64 : var == 1 ? 1024 + (h >> 1) * 64 : 1536 + (h >> 1) * 64;
            const int vc = var == 0 ? 512 + h * 64 : var == 1 ? 1152 + (h >> 1) * 64 : 1664 + (h >> 1) * 64;
            att::unit<64>(F.lds, P + rb * NPJ + qc, NPJ, P + rb * NPJ + kc, NPJ, P + rb * NPJ + vc, NPJ, Op, var, qt, lo, n1, nt, 0.125f * LOG2E,
                          var == 2 ? INP(I_SINK)[l * 4 + h] * LOG2E : 0.f, var == 2, bias + h * 465, nullptr, (MK_DEBUG && var == DBG_VAR && h == 0) ? (unsigned*)(F.ws + WS_RS) + rb * 2 : nullptr);
        }
    }
}

#define PHASE_FN static __device__ __forceinline__ void
PHASE_FN ph_prologue(GAS unsigned char* ws) { const Frame F = make_frame(ws); phase_prologue(F); }
PHASE_FN ph_ln(GAS unsigned char* ws, int l) { const Frame F = make_frame(ws); phase_ln(F, l); }
PHASE_FN ph_gemm_in(GAS unsigned char* ws, int l) {
    const Frame F = make_frame(ws);
    pg8::Gemm g{(const bf16*)(F.ws + WS_HA), (const bf16*)(F.ws + WS_WIN) + (size_t)l * NPJ * D, M, NPJ, D, D}; pg8::StaticOrder S; S.init(M, NPJ, F.G, F.bid);
    pg8::EpiBf16<0> E{(bf16*)(F.ws + WS_PB), NPJ, nullptr, 0, 0, 1.f};
    pg8::gemm_phase<pg8::EpiBf16<0>, pg8::StaticOrder, true, true>(F.lds, g, S, E);
}
PHASE_FN ph_post(GAS unsigned char* ws, int l) { const Frame F = make_frame(ws); phase_post(F, l); }
PHASE_FN ph_gemm_mla(GAS unsigned char* ws, int l) {
    const Frame F = make_frame(ws);
    pg8::Gemm g{(const bf16*)(F.ws + WS_PB) + 1792, (const bf16*)(F.ws + WS_WD) + (size_t)l * 1024 * 384, M, 1024, 384, NPJ}; pg8::StaticOrder S; S.init(M, 1024, F.G, F.bid);
    EpiMla E{(bf16*)(F.ws + WS_QD), (bf16*)(F.ws + WS_KD), (bf16*)(F.ws + WS_VD)};
    pg8::gemm_phase<EpiMla, pg8::StaticOrder, true, true>(F.lds, g, S, E);
}
PHASE_FN ph_attn(GAS unsigned char* ws, int l) { const Frame F = make_frame(ws); phase_attn(F, l); }
PHASE_FN ph_gemm_out(GAS unsigned char* ws, int l) {
    const Frame F = make_frame(ws);
    pg8::Gemm g{(const bf16*)(F.ws + WS_HA), (const bf16*)(F.ws + WS_WOUT) + (size_t)l * D * D, M, D, D, D}; pg8::StaticOrder S; S.init(M, D, F.G, F.bid);
    pg8::EpiF32 E{(float*)(F.ws + WS_PB), D, nullptr};
    pg8::gemm_phase<pg8::EpiF32, pg8::StaticOrder, true, true>(F.lds, g, S, E);
}
PHASE_FN ph_route(GAS unsigned char* ws, int l) { const Frame F = make_frame(ws); phase_route(F, l); }
PHASE_FN ph_permute(GAS unsigned char* ws) { const Frame F = make_frame(ws); phase_permute(F); }
PHASE_FN ph_gemm_gu(GAS unsigned char* ws, int l) {
    const Frame F = make_frame(ws);
    moe_tables(F);
    pg8::Gemm g{(const bf16*)(F.ws + WS_PB), (const bf16*)(F.ws + WS_WGU) + (size_t)l * 16384 * 1024, MS, 16384, D, D}; MoeOrder S{F.MISC + MI_PST, F.G, F.bid};
    EpiGU E{(bf16*)(F.ws + WS_ACT)};
    pg8::gemm_phase<EpiGU, MoeOrder, true, true>(F.lds, g, S, E);
}
PHASE_FN ph_gemm_dn(GAS unsigned char* ws, int l) {
    const Frame F = make_frame(ws);
    moe_tables(F);
    pg8::Gemm g{(const bf16*)(F.ws + WS_ACT), (const bf16*)(F.ws + WS_WDN) + (size_t)l * 16384 * 512, MS, 16384, 512, 512}; MoeOrder S{F.MISC + MI_PST, F.G, F.bid};
    pg8::EpiBf16<0> E{(bf16*)(F.ws + WS_PB), D, nullptr, 1024, 0, 1.f};
    pg8::gemm_phase<pg8::EpiBf16<0>, MoeOrder, true, true>(F.lds, g, S, E);
}


#if MK_DEBUG
#ifndef DBG_MODE
#define DBG_MODE 0
#endif
__device__ __forceinline__ float oracle_attn(const Frame& F, int l, int r, int var, int h, int mode = 0) {
    const bf16* P = (const bf16*)(F.ws + WS_PB); const bf16* QD = (const bf16*)(F.ws + WS_QD); const bf16* KD = (const bf16*)(F.ws + WS_KD); const bf16* VD = (const bf16*)(F.ws + WS_VD);
    const bf16* O = (const bf16*)(F.ws + WS_HA); const float* t32 = (const float*)(F.ws + WS_T32);
    const int b = r / TT, t = r - b * TT; const bool lat = t < SEQ; const size_t rb = (size_t)b * TT;
    const int dk = var == 3 ? 96 : 64;
    const bf16* qp; const bf16* kp; const bf16* vp; int kpitch, vpitch;
    if (var == 3) { qp = QD + (size_t)r * 384 + h * 96; kp = KD + rb * 384 + h * 96; kpitch = 384; vp = VD + rb * 256 + h * 64; vpitch = 256; }
    else { const int qc = var == 0 ? h * 64 : var == 1 ? 768 + h * 64 : 1280 + h * 64, kc = var == 0 ? 256 + h * 64 : var == 1 ? 1024 + (h >> 1) * 64 : 1536 + (h >> 1) * 64,
           vc = var == 0 ? 512 + h * 64 : var == 1 ? 1152 + (h >> 1) * 64 : 1664 + (h >> 1) * 64;
           qp = P + (size_t)r * NPJ + qc; kp = P + rb * NPJ + kc; kpitch = NPJ; vp = P + rb * NPJ + vc; vpitch = NPJ; }
    LAS float* qs = (LAS float*)(F.lds + 65536) + F.wave * 128;
    for (int d = F.lane; d < dk; d += 64) qs[d] = __builtin_bit_cast(float, (unsigned)qp[d] << 16);
    asm volatile("s_waitcnt lgkmcnt(0)" ::: "memory");
    if (var == 3 && lat && F.lane < 32) {
        const int c = F.lane >> 3, e = F.lane & 7, gr = t >> 6, gc = t & 63; const float own = qs[64 + F.lane], par = qs[64 + (F.lane ^ 8)];
        const float cs = t32[((c < 2 ? gr : gc) * 8 + e) * 2], sn = t32[((c < 2 ? gr : gc) * 8 + e) * 2 + 1];
        const float nv = (c & 1) == 0 ? own * cs - par * sn : par * sn + own * cs;
        asm volatile("s_waitcnt lgkmcnt(0)" ::: "memory"); qs[64 + F.lane] = nv; }
    asm volatile("s_waitcnt lgkmcnt(0)" ::: "memory");
    const float scale = var == 3 ? 0.10206207261596575f : 0.125f;
    const int gr = t >> 6, gc = t & 63, r0 = min(max(gr - 4, 0), 56), c0 = min(max(gc - 8, 0), 48);
    float m = -3.0e38f, lsum = 0.f, acc[64];
#pragma unroll
    for (int d = 0; d < 64; ++d) acc[d] = 0.f;
    for (int j = F.lane; j < TT; j += 64) {
        bool ok = true; float bias = 0.f;
        if (!lat) ok = j >= SEQ;
        else if (j < SEQ) {
            if (var == 0) { const int kr = j >> 6, kc2 = j & 63; ok = kr >= r0 && kr <= r0 + 7 && kc2 >= c0 && kc2 <= c0 + 15;
                if (ok) bias = INP(I_NABIAS)[((l * 4 + h) * 15 + (kr - gr + 7)) * 31 + (kc2 - gc + 15)]; }
            else if (var == 2) ok = (j - t <= 128) && (t - j <= 128);
        }
        if (!ok) continue;
        float sc = 0.f; const bf16* kr_ = kp + (size_t)j * kpitch;
        for (int d = 0; d < dk; ++d) sc += qs[d] * __builtin_bit_cast(float, (unsigned)kr_[d] << 16);
        sc = sc * scale + bias;
        const float mn = fmaxf(m, sc), a = expf(m - mn), p = expf(sc - mn); m = mn; lsum = lsum * a + p;
        const bf16* vr = vp + (size_t)j * vpitch;
#pragma unroll
        for (int d = 0; d < 64; ++d) acc[d] = acc[d] * a + p * __builtin_bit_cast(float, (unsigned)vr[d] << 16);
    }
    float mg = m;
#pragma unroll
    for (int o = 1; o < 64; o <<= 1) mg = fmaxf(mg, __shfl_xor(mg, o));
    if (mode >= 1) {
        const unsigned* rec = (const unsigned*)(F.ws + WS_RS) + (size_t)r * 2; const float mk = __builtin_bit_cast(float, rec[0]), lk = __builtin_bit_cast(float, rec[1]);
        const float lref = wave_sum(lsum * expf(m - mg));
        const float lker = lk * exp2f(mk - mg * LOG2E);
        if (mode == 2) return fabsf(mk / LOG2E - mg);
        return fabsf(lker / lref - 1.0f);
    }
    const float f = expf(m - mg); lsum *= f; lsum = wave_sum(lsum);
    if (var == 2) lsum += expf(INP(I_SINK)[l * 4 + h] - mg);
    float err = 0.f, mag = 1.0e-6f;
    const bf16* orow = O + (size_t)r * D + var * 256 + h * 64;
#pragma unroll
    for (int d = 0; d < 64; ++d) { const float ref = wave_sum(acc[d] * f) / lsum; const float got = __builtin_bit_cast(float, (unsigned)orow[d] << 16);
        const float df = fabsf(got - ref); err = (df == df) ? fmaxf(err, df) : 1.0e30f; mag = fmaxf(mag, fabsf(ref)); }
    return err / mag;
}
__device__ __forceinline__ void phase_dump(const Frame& F, int code) {
    float* out = (float*)ptab_get(F, I_OUT);
    for (int r = F.gw; r < M; r += F.ngw) {
        const int b = r / TT, t = r - b * TT; if (t >= SEQ) continue;
        float v[16];
        if (code == 1) ld16bf((const bf16*)(F.ws + WS_HA) + (size_t)r * D, F.lane, v);
        else if (code == 2) ld16bf((const bf16*)(F.ws + WS_PB) + (size_t)r * NPJ, F.lane, v);
        else if (code == 3) ld16bf((const bf16*)(F.ws + WS_PB) + (size_t)r * NPJ + 1024, F.lane, v);
        else if (code == 4) ld16bf((const bf16*)(F.ws + WS_PB) + (size_t)r * NPJ + 1280, F.lane, v);
        else if (code == 5) ld16((const float*)(F.ws + WS_PB) + (size_t)r * D, F.lane, v);
        else if (code == 8) {
            const v4u w0 = *((const v4u*)((const bf16*)(F.ws + WS_HA) + (size_t)r * D) + F.lane), w1 = *((const v4u*)((const bf16*)(F.ws + WS_HA) + (size_t)r * D) + 64 + F.lane);
            float f[8]; int bad0 = 0, bad1 = 0; unpack8(w0, f);
#pragma unroll
            for (int i = 0; i < 8; ++i) { const unsigned u = __builtin_bit_cast(unsigned, f[i]); bad0 |= ((u & 0x7f800000u) == 0x7f800000u) ? 1 : 0; }
            unpack8(w1, f);
#pragma unroll
            for (int i = 0; i < 8; ++i) { const unsigned u = __builtin_bit_cast(unsigned, f[i]); bad1 |= ((u & 0x7f800000u) == 0x7f800000u) ? 1 : 0; }
            const unsigned long long m0 = __ballot(bad0), m1 = __ballot(bad1);
            const bool vA = (m0 & 0xffffffffull) != 0, vB = (m0 >> 32) != 0, vC = (m1 & 0xffffffffull) != 0, vD = (m1 >> 32) != 0;
            const float val = (float)(t + 1) * ((vA ? 1.0f : 0.f) + (vB ? 1.0e2f : 0.f) + (vC ? 1.0e4f : 0.f) + (vD ? 1.0e6f : 0.f));
#pragma unroll
            for (int i = 0; i < 16; ++i) v[i] = val;
        }
        else if (code == 9) { const unsigned cd = ((const unsigned*)(F.ws + WS_RS))[(size_t)r * 2]; float val = 0.f; if (cd) { val = 1.f; for (unsigned k = 0; k < cd; ++k) val *= 10.f; }
#pragma unroll
            for (int i = 0; i < 16; ++i) v[i] = val; }
        else if (code == 10) {
            const v4u w1 = *((const v4u*)((const bf16*)(F.ws + WS_HA) + (size_t)r * D) + 64 + F.lane);
            float f[8]; int bad1 = 0; unpack8(w1, f);
#pragma unroll
            for (int i = 0; i < 8; ++i) { const unsigned u = __builtin_bit_cast(unsigned, f[i]); bad1 |= ((u & 0x7f800000u) == 0x7f800000u) ? 1 : 0; }
            const bool vC = (__ballot(bad1) & 0xffffffffull) != 0;
            const bf16* pc = (const bf16*)(F.ws + WS_PB) + ((size_t)b * TT + SEQ + (t & 255)) * NPJ; int badp = 0;
            for (int c = F.lane; c < 288; c += 64) { const v4u w = *((const v4u*)pc + c); unpack8(w, f);
#pragma unroll
                for (int i = 0; i < 8; ++i) { const unsigned u = __builtin_bit_cast(unsigned, f[i]); badp |= ((u & 0x7f800000u) == 0x7f800000u) ? 1 : 0; } }
            float val = 0.f; if (vC) { val = 1.f; for (int k = 0; k <= (t & 15); ++k) val *= 10.f; }
            if (__any(badp)) val = 1.0e30f;
#pragma unroll
            for (int i = 0; i < 16; ++i) v[i] = val;
        }
        else if (code == 11) {
            const bf16* pr = (const bf16*)(F.ws + WS_PB) + (size_t)r * NPJ; int grp = -1;
            for (int c = F.lane; c < 288; c += 64) { const v4u w = *((const v4u*)pr + c); float f[8]; unpack8(w, f);
#pragma unroll
                for (int i = 0; i < 8; ++i) if (!(fabsf(f[i]) < 1.0e4f)) grp = (c * 8) >> 8; }
#pragma unroll
            for (int o = 1; o < 64; o <<= 1) { const int g2 = __shfl_xor(grp, o); grp = g2 > grp ? g2 : grp; }
            float val = 0.f; if (grp >= 0) { val = 100.f; for (int k = 0; k < grp; ++k) val *= 10.f; }
#pragma unroll
            for (int i = 0; i < 16; ++i) v[i] = val;
        }
        else if (code >= 20 && code < 24) {
            float val = 0.f;
            if ((t & 15) == 5) { for (int h = 0; h < 4; ++h) { const float e = oracle_attn(F, 0, r, code - 20, h); const float cls = e > 1.0e20f ? 3.f : e > 0.5f ? 2.f : e > 0.03f ? 1.f : 0.f; if (cls > 0.f) { float w = cls; for (int k = 0; k <= h; ++k) w *= 10.f; val = fmaxf(val, w); } } }
#pragma unroll
            for (int i = 0; i < 16; ++i) v[i] = val;
        }
        else if (code >= 30 && code < 46) {
            float val = 0.f;
            if ((t & 15) == 5) { const float e = oracle_attn(F, 0, r, (code - 30) >> 2, (code - 30) & 3, DBG_MODE); val = e > 10.f ? 1.0e4f : 1000.f * e; }
#pragma unroll
            for (int i = 0; i < 16; ++i) v[i] = val;
        }
        else if (code == 7) {
            auto bad16 = [&](const bf16* p, int nchunks) { int bad = 0; for (int c = F.lane; c < nchunks; c += 64) { const v4u w = *((const v4u*)p + c); float f[8]; unpack8(w, f);
#pragma unroll
                for (int i = 0; i < 8; ++i) { const unsigned u = __builtin_bit_cast(unsigned, f[i]); bad |= ((u & 0x7f800000u) == 0x7f800000u) ? 1 : 0; } } return __any(bad); };
            const int bP = bad16((const bf16*)(F.ws + WS_PB) + (size_t)r * NPJ, 288), bQ = bad16((const bf16*)(F.ws + WS_QD) + (size_t)r * 384, 48),
                      bK = bad16((const bf16*)(F.ws + WS_KD) + (size_t)r * 384, 48), bV = bad16((const bf16*)(F.ws + WS_VD) + (size_t)r * 256, 32), bO = bad16((const bf16*)(F.ws + WS_HA) + (size_t)r * D, 128);
            const float val = bP ? 1.0e6f : bQ ? 1.0e5f : bK ? 1.0e4f : bV ? 1.0e3f : bO ? 1.0e2f : 0.f;
#pragma unroll
            for (int i = 0; i < 16; ++i) v[i] = val;
        }
#pragma unroll
        for (int i = 0; i < 16; ++i) { const unsigned u = __builtin_bit_cast(unsigned, v[i]); if ((u & 0x7f800000u) == 0x7f800000u) v[i] = 777.0f; }
        st16(out + ((size_t)b * SEQ + t) * D, F.lane, v);
    }
}
static __device__ __forceinline__ void ph_dump(GAS unsigned char* ws, int code) { const Frame F = make_frame(ws); phase_dump(F, code); }
#endif
__global__ void __launch_bounds__(NTHR, 2) mk_fwd(Args args) {
    extern __shared__ __attribute__((aligned(16))) unsigned char lds_raw[];
    LAS unsigned char* lds = (LAS unsigned char*)lds_raw; volatile LAS unsigned* MISC = (volatile LAS unsigned*)(lds + MISC_OFF);
    const int tid = threadIdx.x;
    GAS unsigned char* ws = (GAS unsigned char*)args.ws;
    for (int u = tid; u < (LDS_BYTES - MISC_OFF) / 4; u += NTHR) MISC[u] = 0u;
    __syncthreads();
    if (tid < 28) { const unsigned long long p = tid < 27 ? (unsigned long long)args.in[tid] : (unsigned long long)args.out;
        LAS unsigned* t = (LAS unsigned*)(lds + PTAB_OFF) + 2 * tid; t[0] = (unsigned)p; t[1] = (unsigned)(p >> 32); }
    __syncthreads();
#if MK_MULTI
#define GRID_BAR() do { } while (0)
#else
    XcdBarrier bar = xcd_barrier_post((unsigned*)(ws + WS_CTL) + CW_BAR, MISC + MI_BAR);
#define GRID_BAR() xcd_barrier(bar)
#endif
    const int lo = args.ph_lo, hi = args.ph_hi;
#define IN(k) (lo <= (k) && (k) < hi)
#define SEAM(k) do { if (IN(k) && IN((k) + 1)) GRID_BAR(); } while (0)

#if MK_DEBUG
    if (lo >= 100) { ph_dump(ws, lo - 100); return; }
#endif
    if (IN(0)) { ph_prologue(ws); } SEAM(0);
    for (int l = 0; l < NL; ++l) {
        const int pb = 1 + 10 * l;
        if (IN(pb + 0)) { ph_ln(ws, l); } SEAM(pb + 0);
        if (IN(pb + 1)) { ph_gemm_in(ws, l); } SEAM(pb + 1);
        if (IN(pb + 2)) { ph_post(ws, l); } SEAM(pb + 2);
        if (IN(pb + 3)) { ph_gemm_mla(ws, l); } SEAM(pb + 3);
        if (IN(pb + 4)) { ph_attn(ws, l); } SEAM(pb + 4);
        if (IN(pb + 5)) { ph_gemm_out(ws, l); } SEAM(pb + 5);
        if (IN(pb + 6)) { ph_route(ws, l); } SEAM(pb + 6);
        if (IN(pb + 7)) { ph_permute(ws); } SEAM(pb + 7);
        if (IN(pb + 8)) { ph_gemm_gu(ws, l); } SEAM(pb + 8);
        if (IN(pb + 9)) { ph_gemm_dn(ws, l); } SEAM(pb + 9);
    }
    if (IN(NPHASE - 1)) { ph_ln(ws, NL); }
#undef IN
#undef SEAM
#undef GRID_BAR
}

extern "C" void kernel_launch(void* const* d_in, const int* in_sizes, int n_in, void* d_out, int out_size, void* d_ws, size_t ws_size, hipStream_t stream) {
    static int grid = 0;
    if (grid == 0) {
        if (n_in != 27 || out_size != NB * SEQ * D || ws_size < WS_END) { fprintf(stderr, "kernel_launch: unexpected problem (n_in %d, out %d, ws %zu < %zu)\n", n_in, out_size, ws_size, (size_t)WS_END); grid = -1; return; }
        int dev = 0, cus = 0, per_cu = 0;
        if (hipGetDevice(&dev) != hipSuccess || hipDeviceGetAttribute(&cus, hipDeviceAttributeMultiprocessorCount, dev) != hipSuccess) { grid = -1; return; }
        if (hipFuncSetAttribute((const void*)mk_fwd, hipFuncAttributeMaxDynamicSharedMemorySize, LDS_BYTES) != hipSuccess) { fprintf(stderr, "kernel_launch: hipFuncSetAttribute failed\n"); grid = -1; return; }
        if (hipOccupancyMaxActiveBlocksPerMultiprocessor(&per_cu, (const void*)mk_fwd, NTHR, LDS_BYTES) != hipSuccess || per_cu < 1) fprintf(stderr, "kernel_launch: occupancy query reports %d\n", per_cu);
        (void)hipGetLastError();
        grid = cus > 1024 ? 1024 : cus;
    }
    if (grid < 0) return;
    (void)hipMemsetAsync((char*)d_ws + WS_CTL, 0, CTL_BYTES, stream);
    Args a{};
    for (int i = 0; i < 27; ++i) a.in[i] = (const float*)d_in[i];
    a.out = (float*)d_out; a.ws = (unsigned char*)d_ws;
#if MK_MULTI
#ifndef DBG_NRUN
#define DBG_NRUN NPHASE
#endif
    for (int p = 0; p < DBG_NRUN; ++p) { a.ph_lo = p; a.ph_hi = p + 1; hipLaunchKernelGGL(mk_fwd, dim3(grid), dim3(NTHR), LDS_BYTES, stream, a); }
#ifdef DBG_DUMP
    a.ph_lo = 100 + DBG_DUMP; a.ph_hi = 101 + DBG_DUMP; hipLaunchKernelGGL(mk_fwd, dim3(grid), dim3(NTHR), LDS_BYTES, stream, a);
#endif
#else
    a.ph_lo = 0; a.ph_hi = NPHASE;
    hipLaunchKernelGGL(mk_fwd, dim3(grid), dim3(NTHR), LDS_BYTES, stream, a);
#endif
}
```

```cpp
#include <hip/hip_runtime.h>
#include <cstdio>
#include <cstdint>
namespace pg8 {
#define PG8_LAS __attribute__((address_space(3)))
typedef unsigned short bf16_t;
typedef short bf16x8 __attribute__((ext_vector_type(8)));
typedef float f32x4 __attribute__((ext_vector_type(4)));
typedef unsigned u32x4 __attribute__((ext_vector_type(4)));
constexpr int BM = 256, BK = 64, HALF = 128, HTB = HALF * BK * 2  , STAGE_BYTES = 8 * HTB, NXCD = 8, WGM = 8;

__host__ __device__ __forceinline__ int lds_byte(int r, int c) { const int st = (r >> 4) * 2 + (c >> 5), rr = r & 15, cc = c & 31, ob = rr * 64 + cc * 2; return st * 1024 + (ob ^ (((ob >> 9) & 1) << 5)); }
__host__ __device__ __forceinline__ void stage_rc(int b, int& R, int& C) { const int st = b / 1024, sb = b % 1024, swz = sb ^ (((sb >> 9) & 1) << 5); R = (st >> 1) * 16 + swz / 64; C = (st & 1) * 32 + (swz % 64) / 2; }
__host__ __device__ __forceinline__ int perm32(int rho) { const int n = rho >> 4, i = rho & 15; return 8 * (i >> 2) + 4 * n + (i & 3); }

struct Unit { int pm, pn; };
struct Gemm { const bf16_t* A; const bf16_t* Bt; int M, N, K, lda; };

struct StaticOrder {
    int nM, nN, nwg, G, c;
    __host__ __device__ void init(int M, int N, int G_, int c_) { nM = M / BM; nN = N / BM; nwg = nM * nN; G = G_; c = c_; }
    __host__ __device__ bool next(int i, Unit& u) const {
        const long L = (long)i * G + c; if (L >= nwg) return false;
        int wgid = (int)L; { const int q = nwg / NXCD, r = nwg % NXCD, xcd = wgid % NXCD, off = wgid / NXCD; wgid = (xcd < r ? xcd * (q + 1) : r * (q + 1) + (xcd - r) * q) + off; }
        const int nig = WGM * nN, gid = wgid / nig, fm = gid * WGM, gsz = (nM - fm) < WGM ? (nM - fm) : WGM;
        u.pm = fm + ((wgid % nig) % gsz); u.pn = (wgid % nig) / gsz; return true;
    }
    __device__ __forceinline__ void a_ready(const Unit&) const {}
    __device__ __forceinline__ void done(const Unit&) const {}
};

__device__ __forceinline__ unsigned cvt_pk_bf16(float lo, float hi) { unsigned r; asm volatile("v_cvt_pk_bf16_f32 %0, %1, %2" : "=v"(r) : "v"(lo), "v"(hi)); return r; }
typedef float f32x2 __attribute__((ext_vector_type(2)));
__device__ __forceinline__ f32x2 gelu_pk(f32x2 v) {
    const f32x2 av = __builtin_elementwise_abs(v), d = av * 0.2316418882f + 1.0f;
    f32x2 t; t.x = __builtin_amdgcn_rcpf(d.x); t.y = __builtin_amdgcn_rcpf(d.y);
    f32x2 q = t * 0.5307027145f + (-0.7265760135f); q = q * t + 0.7107068705f; q = q * t + (-0.142248368f); q = q * t + 0.127414796f; q = q * t;
    const f32x2 s = (v * v) * (-0.72134752044f);
    f32x2 e; e.x = __builtin_amdgcn_exp2f(s.x); e.y = __builtin_amdgcn_exp2f(s.y);
    const f32x2 m = v * (q * e), r = v - m;
    f32x2 o; o.x = v.x < 0.f ? m.x : r.x; o.y = v.y < 0.f ? m.y : r.y; return o;
}

template <int ACT  > struct EpiBf16 {
    static constexpr bool PERM = true, AFTER_DRAIN = false; static_assert(ACT == 0 || ACT == 1, "EpiBf16: ACT is 0 (none) or 1 (gelu_pk)");
    bf16_t* O; int ldc; const float* bias; int split_cols; size_t split_stride; float scale0;
    __device__ __forceinline__ void operator()(const f32x4 (&acc)[2][2][4][2], const Unit& u, int wr, int wc, int fr, int fq) const {
        const int row0 = u.pm * BM + wr * 64 + fr; int colt = u.pn * BM; bf16_t* base = O;
        float sc = 1.f; if (split_cols) { const int t = colt / split_cols; base += (size_t)t * split_stride; colt -= t * split_cols; if (t == 0) sc = scale0; }
        const int col0 = colt + wc * 32 + 8 * fq, bcol0 = u.pn * BM + wc * 32 + 8 * fq;
        f32x4 bv[2][2];
#pragma unroll
        for (int bj = 0; bj < 2; ++bj)
#pragma unroll
            for (int n = 0; n < 2; ++n) bv[bj][n] = bias ? *(const f32x4*)(bias + bcol0 + bj * HALF + 4 * n) : (f32x4){0.f, 0.f, 0.f, 0.f};
#pragma unroll
        for (int ai = 0; ai < 2; ++ai)
#pragma unroll
            for (int m = 0; m < 4; ++m) { bf16_t* rowp = base + (size_t)(row0 + ai * HALF + m * 16) * ldc + col0;
#pragma unroll
                for (int bj = 0; bj < 2; ++bj) { f32x4 v0 = acc[ai][bj][m][0] + bv[bj][0], v1 = acc[ai][bj][m][1] + bv[bj][1];
                    if (ACT == 1) { f32x2 a = gelu_pk((f32x2){v0[0], v0[1]}), b = gelu_pk((f32x2){v0[2], v0[3]}), c = gelu_pk((f32x2){v1[0], v1[1]}), d = gelu_pk((f32x2){v1[2], v1[3]});
                        v0 = (f32x4){a.x, a.y, b.x, b.y}; v1 = (f32x4){c.x, c.y, d.x, d.y}; }
                    v0 = v0 * sc; v1 = v1 * sc; u32x4 w; w.x = cvt_pk_bf16(v0[0], v0[1]); w.y = cvt_pk_bf16(v0[2], v0[3]); w.z = cvt_pk_bf16(v1[0], v1[1]); w.w = cvt_pk_bf16(v1[2], v1[3]);
                    *(u32x4*)(rowp + bj * HALF) = w; } }
    }
};
struct EpiF32 {
    static constexpr bool PERM = false, AFTER_DRAIN = false;
    float* C; int ldc; const float* bias;
    __device__ __forceinline__ void operator()(const f32x4 (&acc)[2][2][4][2], const Unit& u, int wr, int wc, int fr, int fq) const {
        const int row0 = u.pm * BM + wr * 64 + fr, col0 = u.pn * BM + wc * 32 + 4 * fq;
        f32x4 bv[2][2];
#pragma unroll
        for (int bj = 0; bj < 2; ++bj)
#pragma unroll
            for (int n = 0; n < 2; ++n) bv[bj][n] = bias ? *(const f32x4*)(bias + col0 + bj * HALF + n * 16) : (f32x4){0.f, 0.f, 0.f, 0.f};
#pragma unroll
        for (int ai = 0; ai < 2; ++ai)
#pragma unroll
            for (int m = 0; m < 4; ++m) { float* rowp = C + (size_t)(row0 + ai * HALF + m * 16) * ldc + col0;
#pragma unroll
                for (int bj = 0; bj < 2; ++bj)
#pragma unroll
                    for (int n = 0; n < 2; ++n) *(f32x4*)(rowp + bj * HALF + n * 16) = acc[ai][bj][m][n] + bv[bj][n]; }
    }
};
template <class Epi, class Sched, bool ALIGN_EPI = false, bool SP2 = false>
__device__ __forceinline__ void gemm_phase(PG8_LAS unsigned char* lds, const Gemm g, const Sched& S, const Epi& E) {
    int tid = threadIdx.x; asm volatile("" : "+v"(tid)); const int wid = __builtin_amdgcn_readfirstlane(tid >> 6), lane = tid & 63, wr = wid >> 2, wc = wid & 3, fr = lane & 15, fq = lane >> 4;
    const int K = g.K, nt = K / BK;
    unsigned voffA[2], voffB[2];
#pragma unroll
    for (int i = 0; i < 2; ++i) { int R, C; stage_rc(tid * 16 + i * 8192, R, C); const int Rb = Epi::PERM ? ((R & ~31) + perm32(R & 31)) : R;
        voffA[i] = (unsigned)(R * g.lda + C) * 2u; voffB[i] = (unsigned)(Rb * K + C) * 2u; }
    const size_t kstep = (size_t)(BK * 2);
    const size_t hstepA = (size_t)HALF * g.lda * 2, hstepB = (size_t)HALF * K * 2;
    const size_t tstepA = 2 * hstepA, tstepB = 2 * hstepB;
    const unsigned ldsw = (unsigned)wid * 1024u;
    const int aoff = lds_byte(wr * 64 + fr, fq * 8), boff = lds_byte(wc * 32 + fr, fq * 8);
#define PG8_SA(b, h) (((b) * 2 + (h)) * HTB)
#define PG8_SB(b, h) ((4 + (b) * 2 + (h)) * HTB)
#define PG8_STAGE(bufoff, gbase, voff) do { _Pragma("unroll") for (int _i = 0; _i < 2; ++_i) \
        __builtin_amdgcn_global_load_lds((const unsigned*)((const char*)(gbase) + (voff)[_i]), (PG8_LAS unsigned*)(lds + (bufoff) + ldsw + _i * 8192), 16, 0, 0); } while (0)
#define PG8_LDA(dst, b, h) do { _Pragma("unroll") for (int m = 0; m < 4; ++m) _Pragma("unroll") for (int k = 0; k < 2; ++k) dst[m][k] = *(const PG8_LAS bf16x8*)(lds + PG8_SA(b, h) + aoff + m * 2048 + k * 1024); } while (0)
#define PG8_LDB(dst, b, h) do { _Pragma("unroll") for (int n = 0; n < 2; ++n) _Pragma("unroll") for (int k = 0; k < 2; ++k) dst[n][k] = *(const PG8_LAS bf16x8*)(lds + PG8_SB(b, h) + boff + n * 2048 + k * 1024); } while (0)
#define PG8_MMA(ai, bj, At, Bt) do { __builtin_amdgcn_s_setprio(1); _Pragma("unroll") for (int m = 0; m < 4; ++m) _Pragma("unroll") for (int n = 0; n < 2; ++n) _Pragma("unroll") for (int k = 0; k < 2; ++k) \
        acc[ai][bj][m][n] = __builtin_amdgcn_mfma_f32_16x16x32_bf16(Bt[n][k], At[m][k], acc[ai][bj][m][n], 0, 0, 0); __builtin_amdgcn_s_setprio(0); } while (0)
#define PG8_WAIT_V(n) asm volatile("s_waitcnt vmcnt(" #n ")" ::: "memory")
#define PG8_WAIT_L(n) asm volatile("s_waitcnt lgkmcnt(" #n ")" ::: "memory")
#define PG8_BAR __builtin_amdgcn_s_barrier()
#define PG8_SCHED __builtin_amdgcn_sched_barrier(0)
    Unit cur, nxt; int ui = 0;
    if (!S.next(0, cur)) return;
    f32x4 acc[2][2][4][2];
#pragma unroll
    for (int a = 0; a < 2; ++a)
#pragma unroll
        for (int b = 0; b < 2; ++b)
#pragma unroll
            for (int m = 0; m < 4; ++m)
#pragma unroll
                for (int n = 0; n < 2; ++n) acc[a][b][m][n] = (f32x4){0.f, 0.f, 0.f, 0.f};
    bf16x8 At[4][2], B0[2][2], B1[2][2];
    const char* cA = (const char*)g.A + (size_t)cur.pm * tstepA; const char* cB = (const char*)g.Bt + (size_t)cur.pn * tstepB;
    S.a_ready(cur);
    if constexpr (SP2) {
        PG8_STAGE(PG8_SB(0, 0), cB, voffB); PG8_STAGE(PG8_SB(0, 1), cB + hstepB, voffB); PG8_STAGE(PG8_SA(0, 0), cA, voffA); PG8_STAGE(PG8_SA(0, 1), cA + hstepA, voffA);
        if (wr == 1) PG8_BAR;
        PG8_WAIT_V(2); PG8_BAR;
        PG8_STAGE(PG8_SB(1, 0), cB + kstep, voffB); PG8_STAGE(PG8_SA(1, 0), cA + kstep, voffA); PG8_STAGE(PG8_SB(1, 1), cB + hstepB + kstep, voffB);
        PG8_WAIT_V(6); PG8_BAR;
    } else {
        PG8_STAGE(PG8_SB(0, 0), cB, voffB); PG8_STAGE(PG8_SA(0, 0), cA, voffA); PG8_STAGE(PG8_SB(0, 1), cB + hstepB, voffB); PG8_STAGE(PG8_SA(0, 1), cA + hstepA, voffA);
        if (wr == 1) PG8_BAR;
        PG8_WAIT_V(4); PG8_BAR;
        PG8_STAGE(PG8_SB(1, 0), cB + kstep, voffB); PG8_STAGE(PG8_SA(1, 0), cA + kstep, voffA); PG8_STAGE(PG8_SB(1, 1), cB + hstepB + kstep, voffB);
        PG8_WAIT_V(6); PG8_BAR;
    }
    for (;;) {
        const bool has_next = S.next(ui + 1, nxt);
        const char* nA = has_next ? (const char*)g.A + (size_t)nxt.pm * tstepA : cA; const char* nB = has_next ? (const char*)g.Bt + (size_t)nxt.pn * tstepB : cB;
#pragma unroll 1
        for (int t = 0; t < nt; t += 2) {
            const bool last = (t == nt - 2);
            const char* a1 = cA + (size_t)(t + 1) * kstep;
            const char* a2 = last ? nA : cA + (size_t)(t + 2) * kstep; const char* b2 = last ? nB : cB + (size_t)(t + 2) * kstep;
            const char* a3 = a2 + kstep; const char* b3 = b2 + kstep;
            if (last && has_next) S.a_ready(nxt);
            if constexpr (SP2) {
            PG8_LDB(B0, 0, 0); PG8_LDB(B1, 0, 1); PG8_SCHED; PG8_LDA(At, 0, 0); PG8_STAGE(PG8_SA(1, 1), a1 + hstepA, voffA);
            PG8_WAIT_V(8); PG8_WAIT_L(0); PG8_BAR; PG8_MMA(0, 0, At, B0); PG8_MMA(0, 1, At, B1); PG8_BAR; PG8_SCHED;
            PG8_LDA(At, 0, 1); PG8_STAGE(PG8_SB(0, 0), b2, voffB); PG8_STAGE(PG8_SB(0, 1), b2 + hstepB, voffB); PG8_STAGE(PG8_SA(0, 0), a2, voffA);
            PG8_WAIT_V(8); PG8_WAIT_L(0); PG8_BAR; PG8_MMA(1, 0, At, B0); PG8_MMA(1, 1, At, B1); PG8_BAR; PG8_SCHED;
            PG8_LDB(B0, 1, 0); PG8_LDB(B1, 1, 1); PG8_SCHED; PG8_LDA(At, 1, 0); PG8_STAGE(PG8_SA(0, 1), a2 + hstepA, voffA);
            PG8_WAIT_V(8); PG8_WAIT_L(0); PG8_BAR; PG8_MMA(0, 0, At, B0); PG8_MMA(0, 1, At, B1); PG8_BAR; PG8_SCHED;
            PG8_LDA(At, 1, 1); PG8_STAGE(PG8_SB(1, 0), b3, voffB); PG8_STAGE(PG8_SB(1, 1), b3 + hstepB, voffB); PG8_STAGE(PG8_SA(1, 0), a3, voffA);
            PG8_WAIT_V(8); PG8_WAIT_L(0); PG8_BAR; PG8_MMA(1, 0, At, B0); PG8_MMA(1, 1, At, B1); PG8_BAR; PG8_SCHED;
            } else {
            PG8_LDB(B0, 0, 0); PG8_SCHED; PG8_LDA(At, 0, 0); PG8_STAGE(PG8_SA(1, 1), a1 + hstepA, voffA);
            PG8_WAIT_L(8); PG8_BAR; PG8_WAIT_L(0); PG8_MMA(0, 0, At, B0); PG8_BAR; PG8_SCHED;
            PG8_LDB(B1, 0, 1); PG8_STAGE(PG8_SB(0, 0), b2, voffB);
            PG8_BAR; PG8_WAIT_L(0); PG8_MMA(0, 1, At, B1); PG8_BAR;
            PG8_LDA(At, 0, 1); PG8_STAGE(PG8_SA(0, 0), a2, voffA);
            PG8_BAR; PG8_WAIT_L(0); PG8_MMA(1, 0, At, B0); PG8_BAR; PG8_SCHED;
            PG8_STAGE(PG8_SB(0, 1), b2 + hstepB, voffB);
            PG8_WAIT_V(6); PG8_BAR; PG8_MMA(1, 1, At, B1); PG8_BAR;
            PG8_LDB(B0, 1, 0); PG8_SCHED; PG8_LDA(At, 1, 0); PG8_STAGE(PG8_SA(0, 1), a2 + hstepA, voffA);
            PG8_WAIT_L(8); PG8_BAR; PG8_WAIT_L(0); PG8_MMA(0, 0, At, B0); PG8_BAR; PG8_SCHED;
            PG8_LDB(B1, 1, 1); PG8_STAGE(PG8_SB(1, 0), b3, voffB);
            PG8_BAR; PG8_WAIT_L(0); PG8_MMA(0, 1, At, B1); PG8_BAR;
            PG8_LDA(At, 1, 1); PG8_STAGE(PG8_SA(1, 0), a3, voffA);
            PG8_BAR; PG8_WAIT_L(0); PG8_MMA(1, 0, At, B0); PG8_BAR; PG8_SCHED;
            PG8_STAGE(PG8_SB(1, 1), b3 + hstepB, voffB);
            PG8_WAIT_V(6); PG8_BAR; PG8_MMA(1, 1, At, B1); PG8_BAR;
            }
        }
        if constexpr (ALIGN_EPI) { if (wr == 0) PG8_BAR; }
        if constexpr (!Epi::AFTER_DRAIN) { E(acc, cur, wr, wc, fr, fq); S.done(cur); }
        if (!has_next) break;
#pragma unroll
        for (int a = 0; a < 2; ++a)
#pragma unroll
            for (int b = 0; b < 2; ++b)
#pragma unroll
                for (int m = 0; m < 4; ++m)
#pragma unroll
                    for (int n = 0; n < 2; ++n) acc[a][b][m][n] = (f32x4){0.f, 0.f, 0.f, 0.f};
        cur = nxt; cA = nA; cB = nB; ++ui;
        if constexpr (ALIGN_EPI) { if (wr == 1) PG8_BAR; }
    }
    PG8_WAIT_V(0);
    if constexpr (!ALIGN_EPI) { if (wr == 0) PG8_BAR; }
    PG8_BAR;
    if constexpr (Epi::AFTER_DRAIN) { E.fused(acc, cur, wr, wc, fr, fq, lds, wid, lane); S.done(cur); }
#undef PG8_SA
#undef PG8_SB
#undef PG8_STAGE
#undef PG8_LDA
#undef PG8_LDB
#undef PG8_MMA
#undef PG8_WAIT_V
#undef PG8_WAIT_L
#undef PG8_BAR
#undef PG8_SCHED
}
}

constexpr int NB = 16, SEQ = 4096, CTX = 256, TT = SEQ + CTX, M = NB * TT, D = 1024, NL = 4;
constexpr int NPJ = 2304, DPROJ = 2208;
constexpr int MS = 143360;
constexpr float EPS = 1e-6f, ALPHA = 1.6817928305074290f, LOG2E = 1.4426950408889634f;
constexpr int NWAVES = 8, NTHR = 512;
#ifndef MK_DEBUG
#define MK_DEBUG 0
#endif
#ifndef MK_DUP
#define MK_DUP 0
#endif
#ifndef MK_MULTI
#define MK_MULTI 0
#endif
constexpr int NPHASE = 2 + 10 * NL;

constexpr size_t WS_CTL = 0, CTL_BYTES = 65536;
constexpr size_t WS_MODS = WS_CTL + CTL_BYTES;
constexpr size_t WS_T64 = WS_MODS + (size_t)NL * 17 * 6144 * 4;
constexpr size_t WS_T32 = WS_T64 + 8192;
constexpr size_t WS_RS = WS_T32 + 4096;
constexpr size_t WS_RT = WS_RS + (size_t)M * 8;
constexpr size_t WS_HIST = WS_RT + (size_t)M * 32;
constexpr size_t WS_XC = WS_HIST + 65536;
constexpr size_t WS_WIN = WS_XC + (size_t)NB * CTX * D * 4;
constexpr size_t WS_WD = WS_WIN + (size_t)NL * NPJ * D * 2;
constexpr size_t WS_WOUT = WS_WD + (size_t)NL * 1024 * 384 * 2;
constexpr size_t WS_WGU = WS_WOUT + (size_t)NL * D * D * 2;
constexpr size_t WS_WDN = WS_WGU + (size_t)NL * 16 * 1024 * 1024 * 2;
constexpr size_t WS_HA = WS_WDN + (size_t)NL * 16 * 1024 * 512 * 2;
constexpr size_t WS_PB = WS_HA + (size_t)M * D * 2;
constexpr size_t WS_QD = WS_PB + (size_t)M * NPJ * 2;
constexpr size_t WS_KD = WS_QD + (size_t)M * 384 * 2;
constexpr size_t WS_VD = WS_KD + (size_t)M * 384 * 2;
constexpr size_t WS_ACT = WS_VD + (size_t)M * 256 * 2;
constexpr size_t WS_END = WS_ACT + (size_t)MS * 512 * 2;
static_assert(WS_END <= (size_t)1073741824, "d_ws map must fit 1 GiB");
static_assert((size_t)M * NPJ * 2 >= (size_t)MS * D * 2 && (size_t)M * NPJ * 2 >= (size_t)M * D * 4, "region PB overlays");
constexpr int CW_BAR = 0;
constexpr int CW_QUEUE = 4096;

constexpr int RING_BYTES = 131072, MISC_OFF = RING_BYTES, LDS_BYTES = 147456;
constexpr int MI_BAR = 0, MI_Q = 4, MI_TOT = 16, MI_BASE = 32, MI_PST = 48, MI_LH = 80;

#define GAS __attribute__((address_space(1)))
#define LAS __attribute__((address_space(3)))
typedef unsigned short bf16;
typedef unsigned v4u __attribute__((ext_vector_type(4)));
typedef unsigned v2u __attribute__((ext_vector_type(2)));
typedef float f32x4 __attribute__((ext_vector_type(4)));
typedef float f32x2 __attribute__((ext_vector_type(2)));
typedef short bf16x8 __attribute__((ext_vector_type(8)));
typedef float f32x16 __attribute__((ext_vector_type(16)));
typedef short v4i16 __attribute__((ext_vector_type(4)));

__device__ __forceinline__ unsigned f2bf(float f) { unsigned u = __builtin_bit_cast(unsigned, f); return (u + 0x7fffu + ((u >> 16) & 1u)) >> 16; }
__device__ __forceinline__ unsigned pk2(float lo, float hi) { return f2bf(lo) | (f2bf(hi) << 16); }
__device__ __forceinline__ float bflo(unsigned w) { return __builtin_bit_cast(float, w << 16); }
__device__ __forceinline__ float bfhi(unsigned w) { return __builtin_bit_cast(float, w & 0xffff0000u); }
__device__ __forceinline__ void unpack8(v4u w, float (&f)[8]) { f[0] = bflo(w.x); f[1] = bfhi(w.x); f[2] = bflo(w.y); f[3] = bfhi(w.y); f[4] = bflo(w.z); f[5] = bfhi(w.z); f[6] = bflo(w.w); f[7] = bfhi(w.w); }
__device__ __forceinline__ v4u pack8(const float (&f)[8]) { v4u w; w.x = pk2(f[0], f[1]); w.y = pk2(f[2], f[3]); w.z = pk2(f[4], f[5]); w.w = pk2(f[6], f[7]); return w; }
__device__ __forceinline__ float wave_sum(float v) {
#pragma unroll
    for (int o = 1; o < 64; o <<= 1) v += __shfl_xor(v, o);
    return v;
}

#define XB_TMO      128
#define XB_XCNT(j)  (256  + 64 * (j))
#define XB_XSUB(j)  (1280 + 64 * (j))
#define XB_XGEN(j)  (2304 + 64 * (j))
#define XB_TOP      3328
#define XB_TOPGEN   3392
#define XCD_BAR_WORDS 3456
#define XB_SPIN_CAP (1u << 22)
__device__ __forceinline__ unsigned xb_ld(unsigned* p)              { return __hip_atomic_load(p, __ATOMIC_RELAXED, __HIP_MEMORY_SCOPE_AGENT); }
__device__ __forceinline__ unsigned xb_add(unsigned* p, unsigned v) { return __hip_atomic_fetch_add(p, v, __ATOMIC_RELAXED, __HIP_MEMORY_SCOPE_AGENT); }
__device__ __forceinline__ unsigned xb_xcc_id() { return (unsigned)__builtin_amdgcn_s_getreg((3 << 11) | 20) & 0xFu; }
#define XB_SPIN(cond, bar) do { unsigned _sp = 0; while (cond) { __builtin_amdgcn_s_sleep(1); \
    if ((++_sp & 255u) == 0u) { if (xb_ld(&(bar)[XB_TMO])) break; if (_sp > XB_SPIN_CAP) { atomicAdd(&(bar)[XB_TMO], 1u); break; } } } } while (0)
struct XcdBarrier { unsigned* bar; unsigned x; volatile LAS unsigned* st; };
__device__ __forceinline__ XcdBarrier xcd_barrier_post(unsigned* bar, volatile LAS unsigned* st) {
    XcdBarrier b; b.bar = bar; b.x = xb_xcc_id(); b.st = st;
    if (threadIdx.x == 0) (void)xb_add(&bar[XB_XCNT(b.x)], 1u);
    return b;
}
__device__ __forceinline__ void xcd_barrier_complete(unsigned* bar, unsigned x, unsigned& nloc, unsigned& nx) {
    const unsigned G = gridDim.x * gridDim.y * gridDim.z;
    unsigned sum, cnt, mine, sp = 0u;
    for (;;) {
        sum = 0u; cnt = 0u; mine = 0u;
#pragma unroll
        for (unsigned j = 0; j < 16; ++j) { const unsigned c = xb_ld(&bar[XB_XCNT(j)]); sum += c; cnt += (c > 0u) ? 1u : 0u; mine = (j == x) ? c : mine; }
        if (sum == G) break;
        __builtin_amdgcn_s_sleep(1);
        if ((++sp & 255u) == 0u) { if (xb_ld(&bar[XB_TMO])) break; if (sp > XB_SPIN_CAP) { atomicAdd(&bar[XB_TMO], 1u); break; } }
    }
    nloc = mine > 0u ? mine : 1u; nx = cnt > 0u ? cnt : 1u;
}
__device__ __forceinline__ void xcd_barrier(const XcdBarrier& b) {
    asm volatile("s_waitcnt vmcnt(0)" ::: "memory");
    __syncthreads();
    if (threadIdx.x == 0) {
        unsigned* bar = b.bar;
        __builtin_amdgcn_s_waitcnt(0);
        unsigned nloc = b.st[0], nx = b.st[1];
        if (nloc == 0u) { xcd_barrier_complete(bar, b.x, nloc, nx); b.st[0] = nloc; b.st[1] = nx; }
        const unsigned old = xb_add(&bar[XB_XSUB(b.x)], 1u);
        const unsigned gen = old / nloc;
        if (old + 1u == (gen + 1u) * nloc) {
            __builtin_amdgcn_fence(__ATOMIC_RELEASE, "agent");
            asm volatile("s_waitcnt vmcnt(0)" ::: "memory");
            const unsigned og = xb_add(&bar[XB_TOP], 1u);
            const unsigned tg = og / nx;
            if (og + 1u == (tg + 1u) * nx) xb_add(&bar[XB_TOPGEN], 1u);
            else XB_SPIN(xb_ld(&bar[XB_TOPGEN]) == tg, bar);
            __builtin_amdgcn_fence(__ATOMIC_ACQUIRE, "agent");
            xb_add(&bar[XB_XGEN(b.x)], 1u);
            asm volatile("s_waitcnt vmcnt(0)" ::: "memory");
        } else {
            XB_SPIN(xb_ld(&bar[XB_XGEN(b.x)]) == gen, bar);
            __builtin_amdgcn_fence(__ATOMIC_ACQUIRE, "agent");
            asm volatile("s_waitcnt vmcnt(0)" ::: "memory");
        }
    }
    __syncthreads();
}

struct Args { const float* in[27]; float* out; unsigned char* ws; int ph_lo, ph_hi; };
enum { I_X = 0, I_C, I_CTX, I_CCTX, I_WADA, I_BADA, I_WIN, I_NABIAS, I_GQG, I_GKG, I_SINK, I_MQG, I_WQB, I_MKVG, I_WKVB, I_WOUT, I_LN1G, I_LN1B, I_RGW, I_RGB, I_REW, I_REB, I_WG, I_WU, I_WDN, I_LN2G, I_LN2B };

struct Frame {
    LAS unsigned char* lds; volatile LAS unsigned* MISC;
    int tid, lane, wave, G, gw, ngw, bid;
    GAS unsigned char* ws;
};
__device__ __forceinline__ int opaque_tid() { int t = threadIdx.x; asm volatile("" : "+v"(t)); return t; }
__device__ __forceinline__ int opaque_s(int x) { asm volatile("" : "+s"(x)); return x; }
constexpr int PTAB_OFF = MISC_OFF + 2048, I_OUT = 27;
__device__ __forceinline__ GAS unsigned char* ptab_get(const Frame& F, int i) {
    const LAS unsigned* t = (const LAS unsigned*)(F.lds + PTAB_OFF) + 2 * i;
    const unsigned lo = __builtin_amdgcn_readfirstlane(t[0]), hi = __builtin_amdgcn_readfirstlane(t[1]);
    return (GAS unsigned char*)(((unsigned long long)hi << 32) | lo);
}
#define INP(i) ((const float*)ptab_get(F, (i)))
__device__ __forceinline__ Frame make_frame(GAS unsigned char* ws) {
    extern __shared__ __attribute__((aligned(16))) unsigned char lds_raw[];
    Frame F;
    F.lds = (LAS unsigned char*)lds_raw; F.MISC = (volatile LAS unsigned*)(F.lds + MISC_OFF);
    F.tid = opaque_tid(); F.lane = F.tid & 63; F.wave = __builtin_amdgcn_readfirstlane(F.tid >> 6);
    F.G = opaque_s((int)gridDim.x); F.bid = opaque_s((int)blockIdx.x); F.gw = F.bid * NWAVES + F.wave; F.ngw = F.G * NWAVES;
    { unsigned long long w = (unsigned long long)ws; asm volatile("" : "+s"(w)); F.ws = (GAS unsigned char*)w; }
    return F;
}
__device__ __forceinline__ const float* xin_row(const Frame& F, int r) {
    const int b = r / TT, t = r - b * TT;
    return t < SEQ ? INP(I_X) + ((size_t)b * SEQ + t) * D : INP(I_CTX) + ((size_t)b * CTX + (t - SEQ)) * D;
}
__device__ __forceinline__ float* xs_row(const Frame& F, int r) {
    const int b = r / TT, t = r - b * TT;
    return t < SEQ ? (float*)ptab_get(F, I_OUT) + ((size_t)b * SEQ + t) * D : (float*)(F.ws + WS_XC) + ((size_t)b * CTX + (t - SEQ)) * D;
}
__device__ __forceinline__ void ld16(const float* p, int lane, float (&v)[16]) {
    const f32x4* q = (const f32x4*)p;
    const f32x4 a = q[2 * lane], b = q[2 * lane + 1], c = q[128 + 2 * lane], d = q[129 + 2 * lane];
    v[0] = a.x; v[1] = a.y; v[2] = a.z; v[3] = a.w; v[4] = b.x; v[5] = b.y; v[6] = b.z; v[7] = b.w;
    v[8] = c.x; v[9] = c.y; v[10] = c.z; v[11] = c.w; v[12] = d.x; v[13] = d.y; v[14] = d.z; v[15] = d.w;
}
__device__ __forceinline__ void st16(float* p, int lane, const float (&v)[16]) {
    f32x4* q = (f32x4*)p;
    q[2 * lane] = (f32x4){v[0], v[1], v[2], v[3]}; q[2 * lane + 1] = (f32x4){v[4], v[5], v[6], v[7]};
    q[128 + 2 * lane] = (f32x4){v[8], v[9], v[10], v[11]}; q[129 + 2 * lane] = (f32x4){v[12], v[13], v[14], v[15]};
}
__device__ __forceinline__ void ld16bf(const bf16* p, int lane, float (&v)[16]) {
    const v4u* q = (const v4u*)p; const v4u a = q[lane], b = q[64 + lane];
    float f[8]; unpack8(a, f);
#pragma unroll
    for (int i = 0; i < 8; ++i) v[i] = f[i];
    unpack8(b, f);
#pragma unroll
    for (int i = 0; i < 8; ++i) v[8 + i] = f[i];
}
__device__ __forceinline__ void st16bf(bf16* p, int lane, const float (&v)[16]) {
    v4u* q = (v4u*)p; v4u a, b;
    a.x = pk2(v[0], v[1]); a.y = pk2(v[2], v[3]); a.z = pk2(v[4], v[5]); a.w = pk2(v[6], v[7]);
    b.x = pk2(v[8], v[9]); b.y = pk2(v[10], v[11]); b.z = pk2(v[12], v[13]); b.w = pk2(v[14], v[15]);
    q[lane] = a; q[64 + lane] = b;
}
__device__ __forceinline__ void ln16(float (&v)[16]) {
    float s = 0.f;
#pragma unroll
    for (int i = 0; i < 16; ++i) s += v[i];
    const float mean = wave_sum(s) * (1.0f / D); float q = 0.f;
#pragma unroll
    for (int i = 0; i < 16; ++i) { v[i] -= mean; q += v[i] * v[i]; }
    const float rstd = 1.0f / sqrtf(wave_sum(q) * (1.0f / D) + EPS);
#pragma unroll
    for (int i = 0; i < 16; ++i) v[i] *= rstd;
}

template <int TYPE>
__device__ __forceinline__ float conv_src(const float* p0, const float* p1, const float* g0, const float* g1, int l, int k, int n) {
    if (TYPE == 0) return n < DPROJ ? p0[((size_t)l * D + k) * DPROJ + n] : 0.f;
    if (TYPE == 1) { if (n < 384) return k < 256 ? g0[l * 256 + k] * p0[((size_t)l * 256 + k) * 384 + n] : 0.f;
                     if (n < 896) return k >= 256 ? g1[l * 128 + (k - 256)] * p1[((size_t)l * 128 + (k - 256)) * 512 + (n - 384)] : 0.f;
                     return 0.f; }
    if (TYPE == 2) return p0[((size_t)l * D + k) * D + n];
    if (TYPE == 3) { const int e = n >> 10, nn = n & 1023, q = nn >> 3, j = nn & 7;
                     return j < 4 ? p0[(((size_t)l * 16 + e) * D + k) * 512 + 4 * q + j] : p1[(((size_t)l * 16 + e) * D + k) * 512 + 4 * q + (j - 4)]; }
    { const int e = n >> 10, nn = n & 1023; return p0[(((size_t)l * 16 + e) * 512 + k) * D + nn]; }
}
template <int TYPE>
__device__ __forceinline__ void conv_item(const Frame& F, int l, int item, LAS float* scr) {
    constexpr int Nd = TYPE == 0 ? NPJ : TYPE == 1 ? 1024 : TYPE == 2 ? 1024 : 16384, Kd = TYPE == 1 ? 384 : TYPE == 4 ? 512 : 1024;
    bf16* dst = (bf16*)(F.ws + (TYPE == 0 ? WS_WIN : TYPE == 1 ? WS_WD : TYPE == 2 ? WS_WOUT : TYPE == 3 ? WS_WGU : WS_WDN)) + (size_t)l * Nd * Kd;
    const float* p0 = INP(TYPE == 0 ? I_WIN : TYPE == 1 ? I_WQB : TYPE == 2 ? I_WOUT : TYPE == 3 ? I_WG : I_WDN);
    const float* p1 = INP(TYPE == 1 ? I_WKVB : I_WU); const float* g0 = INP(I_MQG); const float* g1 = INP(I_MKVG);
    constexpr int nblk = Nd / 32; const int kb = item / nblk, nb = item - kb * nblk, k0 = 64 * kb, n0 = 32 * nb, lane = F.lane;
#pragma unroll 4
    for (int i = 0; i < 32; ++i) { const int kk = 2 * i + (lane >> 5); scr[kk * 33 + (lane & 31)] = conv_src<TYPE>(p0, p1, g0, g1, l, k0 + kk, n0 + (lane & 31)); }
    asm volatile("s_waitcnt lgkmcnt(0)" ::: "memory");
    const int c = lane & 7;
#pragma unroll
    for (int j = 0; j < 4; ++j) { const int n = (lane >> 3) + 8 * j; const LAS float* s = scr + (8 * c) * 33 + n;
        v4u o; o.x = pk2(s[0 * 33], s[1 * 33]); o.y = pk2(s[2 * 33], s[3 * 33]); o.z = pk2(s[4 * 33], s[5 * 33]); o.w = pk2(s[6 * 33], s[7 * 33]);
        *(v4u*)(dst + (size_t)(n0 + n) * Kd + k0 + 8 * c) = o; }
    asm volatile("s_waitcnt lgkmcnt(0)" ::: "memory");
}
__device__ __forceinline__ void phase_prologue(const Frame& F) {
    {
        LAS float* sv = (LAS float*)F.lds;
        LAS float* red = (LAS float*)(F.lds + 17 * 1024 * 4);
        float* mods = (float*)(F.ws + WS_MODS);
        for (int u = F.bid; u < NL * 48; u += F.G) {
            const int l = u / 48, cc = u - l * 48;
            for (int i = F.tid; i < 17 * 1024; i += NTHR) { const int mr = i >> 10, k = i & 1023; const float c = mr < 16 ? INP(I_C)[mr * 1024 + k] : INP(I_CCTX)[k]; sv[i] = c / (1.0f + expf(-c)); }
            __syncthreads();
            const int col = F.tid & 127, kg = F.tid >> 7;
            float acc[17];
#pragma unroll
            for (int mr = 0; mr < 17; ++mr) acc[mr] = 0.f;
            const float* w = INP(I_WADA) + ((size_t)l * 1024 + kg * 256) * 6144 + cc * 128 + col;
            for (int k4 = 0; k4 < 256; k4 += 4) {
                const float w0 = w[(size_t)(k4 + 0) * 6144], w1 = w[(size_t)(k4 + 1) * 6144], w2 = w[(size_t)(k4 + 2) * 6144], w3 = w[(size_t)(k4 + 3) * 6144];
#pragma unroll
                for (int mr = 0; mr < 17; ++mr) { const f32x4 s = *(const LAS f32x4*)(sv + mr * 1024 + kg * 256 + k4); acc[mr] += (s.x * w0 + s.y * w1) + (s.z * w2 + s.w * w3); }
            }
#pragma unroll
            for (int mr = 0; mr < 17; ++mr) red[(kg * 17 + mr) * 128 + col] = acc[mr];
            __syncthreads();
            for (int i = F.tid; i < 17 * 128; i += NTHR) { const int mr = i >> 7, c = i & 127;
                const float s = (red[(0 * 17 + mr) * 128 + c] + red[(1 * 17 + mr) * 128 + c]) + (red[(2 * 17 + mr) * 128 + c] + red[(3 * 17 + mr) * 128 + c]);
                mods[((size_t)l * 17 + mr) * 6144 + cc * 128 + c] = s + INP(I_BADA)[l * 6144 + cc * 128 + c]; }
            __syncthreads();
        }
    }
    {
        float* t64 = (float*)(F.ws + WS_T64); float* t32 = (float*)(F.ws + WS_T32);
        for (int i = F.bid * NTHR + F.tid; i < 64 * 16 + 64 * 8; i += F.G * NTHR) {
            if (i < 1024) { const int p = i >> 4, k = i & 15; const float fr = powf(10000.0f, -(float)k / 16.0f), ang = (float)p * fr; t64[2 * i] = cosf(ang); t64[2 * i + 1] = sinf(ang); }
            else { const int j = i - 1024, p = j >> 3, k = j & 7; const float fr = powf(10000.0f, -(float)k / 8.0f), ang = (float)p * fr; t32[2 * j] = cosf(ang); t32[2 * j + 1] = sinf(ang); }
        }
    }
    {
        __syncthreads();
        LAS float* scr = (LAS float*)(F.lds + F.wave * 8448);
        constexpr int I0 = 1152, I1 = 192, I2 = 512, I3 = 8192, I4 = 4096, IL = I0 + I1 + I2 + I3 + I4;
        for (int it = F.gw; it < NL * IL; it += F.ngw) {
            const int l = it / IL; int r = it - l * IL;
            if (r < I0) { conv_item<0>(F, l, r, scr); continue; } r -= I0;
            if (r < I1) { conv_item<1>(F, l, r, scr); continue; } r -= I1;
            if (r < I2) { conv_item<2>(F, l, r, scr); continue; } r -= I2;
            if (r < I3) { conv_item<3>(F, l, r, scr); continue; } r -= I3;
            conv_item<4>(F, l, r, scr);
        }
    }
}

__device__ __forceinline__ void phase_ln(const Frame& F, int l) {
    constexpr int NR = 4;
    const float* mods = (const float*)(F.ws + WS_MODS); bf16* HA = (bf16*)(F.ws + WS_HA);
    const bf16* Y = (const bf16*)(F.ws + WS_PB); const unsigned* RT = (const unsigned*)(F.ws + WS_RT);
    const int lane = F.lane;
    for (int r0 = F.gw; r0 < M; r0 += NR * F.ngw) {
        float v[NR][16]; v4u rt[NR]; v4u ya[NR][2], yb[NR][2]; bool act[NR]; int mrr[NR];
#pragma unroll
        for (int u = 0; u < NR; ++u) {
            const int r = r0 + u * F.ngw; const int rc = r < M ? r : r0; const int b = rc / TT, t = rc - b * TT; const bool lat = t < SEQ;
            act[u] = (r < M) && !(l == NL && !lat); mrr[u] = lat ? b : 16;
            ld16(l == 0 ? xin_row(F, rc) : xs_row(F, rc), lane, v[u]);
            rt[u] = l == 0 ? (v4u){0u, 0u, 0u, 0u} : *(const v4u*)(RT + (size_t)rc * 8 + 4);
        }
        if (l > 0) {
#pragma unroll
            for (int u = 0; u < NR; ++u) { const v4u* y0 = (const v4u*)(Y + (size_t)rt[u].z * D); const v4u* y1 = (const v4u*)(Y + (size_t)rt[u].w * D);
                ya[u][0] = y0[lane]; ya[u][1] = y0[64 + lane]; yb[u][0] = y1[lane]; yb[u][1] = y1[64 + lane]; }
#pragma unroll
            for (int u = 0; u < NR; ++u) {
                float g2[16], gg[16], bb[16], f0[8], f1[8];
                ld16(mods + ((size_t)(l - 1) * 17 + mrr[u]) * 6144 + 5120, lane, g2);
                const float w0 = __uint_as_float(rt[u].x), w1 = __uint_as_float(rt[u].y);
                unpack8(ya[u][0], f0); unpack8(yb[u][0], f1);
#pragma unroll
                for (int i = 0; i < 8; ++i) v[u][i] = ALPHA * v[u][i] + g2[i] * (w0 * f0[i] + w1 * f1[i]);
                unpack8(ya[u][1], f0); unpack8(yb[u][1], f1);
#pragma unroll
                for (int i = 0; i < 8; ++i) v[u][8 + i] = ALPHA * v[u][8 + i] + g2[8 + i] * (w0 * f0[i] + w1 * f1[i]);
                ln16(v[u]);
                ld16(INP(I_LN2G) + (l - 1) * D, lane, gg); ld16(INP(I_LN2B) + (l - 1) * D, lane, bb);
#pragma unroll
                for (int i = 0; i < 16; ++i) v[u][i] = v[u][i] * gg[i] + bb[i];
                if (act[u]) st16(xs_row(F, r0 + u * F.ngw), lane, v[u]);
            }
        }
        if (l < NL) {
#pragma unroll
            for (int u = 0; u < NR; ++u) {
                float sh[16], sc[16];
                ld16(mods + ((size_t)l * 17 + mrr[u]) * 6144, lane, sh); ld16(mods + ((size_t)l * 17 + mrr[u]) * 6144 + 1024, lane, sc);
                ln16(v[u]);
#pragma unroll
                for (int i = 0; i < 16; ++i) v[u][i] = v[u][i] * (1.0f + sc[i]) + sh[i];
                if (act[u]) st16bf(HA + (size_t)(r0 + u * F.ngw) * D, lane, v[u]);
            }
        }
    }
}

__device__ __forceinline__ void rope8(float (&f)[8], const float (&p)[8], const float* cs, bool first) {
    const f32x4* c4 = (const f32x4*)cs;
#pragma unroll
    for (int q = 0; q < 4; ++q) { const f32x4 t = c4[q];
        f[2 * q] = first ? f[2 * q] * t.x - p[2 * q] * t.y : p[2 * q] * t.y + f[2 * q] * t.x;
        f[2 * q + 1] = first ? f[2 * q + 1] * t.z - p[2 * q + 1] * t.w : p[2 * q + 1] * t.w + f[2 * q + 1] * t.z; }
}
__device__ __forceinline__ void phase_post(const Frame& F, int l) {
    bf16* P = (bf16*)(F.ws + WS_PB); bf16* KD = (bf16*)(F.ws + WS_KD);
    const float* t64 = (const float*)(F.ws + WS_T64); const float* t32 = (const float*)(F.ws + WS_T32);
    const int lane = F.lane;
    for (int r = F.gw; r < M; r += F.ngw) {
        const int b = r / TT, t = r - b * TT; const bool lat = t < SEQ; const int gr = (t >> 6) & 63, gc = t & 63;
        bf16* prow = P + (size_t)r * NPJ;
        const int j = lane & 7;
        const float* cs64 = t64 + ((size_t)((j < 4 ? gr : gc) * 16 + (j & 1) * 8)) * 2;
        {
            v4u* pp = (v4u*)(prow + 768) + lane; float f[8]; unpack8(*pp, f);
            float ss = 0.f;
#pragma unroll
            for (int i = 0; i < 8; ++i) ss += f[i] * f[i];
            ss += __shfl_xor(ss, 1); ss += __shfl_xor(ss, 2); ss += __shfl_xor(ss, 4);
            const float rr = 1.0f / sqrtf(ss * (1.0f / 64.0f) + EPS);
            const float* gn = (lane < 32 ? INP(I_GQG) : INP(I_GKG)) + l * 64 + j * 8;
#pragma unroll
            for (int i = 0; i < 8; ++i) f[i] = f[i] * rr * gn[i];
            float p[8];
#pragma unroll
            for (int i = 0; i < 8; ++i) p[i] = __shfl_xor(f[i], 2);
            if (lat) rope8(f, p, cs64, (j & 2) == 0);
            if (lane < 48) *pp = pack8(f);
        }
        if (lat) {
            v4u* pp = (v4u*)(prow + 1280) + lane; float f[8]; unpack8(*pp, f);
            float p[8];
#pragma unroll
            for (int i = 0; i < 8; ++i) p[i] = __shfl_xor(f[i], 2);
            rope8(f, p, cs64, (j & 2) == 0);
            if (lane < 48) *pp = pack8(f);
        }
        {
            const v4u w = *((const v4u*)(prow + 1792) + lane); float f[8]; unpack8(w, f);
            float ss = 0.f;
#pragma unroll
            for (int i = 0; i < 8; ++i) ss += f[i] * f[i];
            ss += __shfl_xor(ss, 1); ss += __shfl_xor(ss, 2); ss += __shfl_xor(ss, 4); ss += __shfl_xor(ss, 8);
            const float s32 = ss + __shfl_xor(ss, 16);
            const float rn = lane < 32 ? 1.0f / sqrtf(s32 * (1.0f / 256.0f) + EPS) : 1.0f / sqrtf(ss * (1.0f / 128.0f) + EPS);
            if (lane < 48) { float fn[8];
#pragma unroll
                for (int i = 0; i < 8; ++i) fn[i] = f[i] * rn;
                *((v4u*)(prow + 1792) + lane) = pack8(fn); }
            float p[8];
#pragma unroll
            for (int i = 0; i < 8; ++i) p[i] = __shfl_xor(f[i], 1);
            const int jj = lane & 3;
            if (lat) rope8(f, p, t32 + ((size_t)((jj < 2 ? gr : gc) * 8)) * 2, (jj & 1) == 0);
            if (lane >= 48 && lane < 52) { const v4u o = pack8(f);
#pragma unroll
                for (int h = 0; h < 4; ++h) *(v4u*)(KD + (size_t)r * 384 + h * 96 + 64 + 8 * jj) = o; }
        }
    }
}

__device__ __forceinline__ void phase_route(const Frame& F, int l) {
    const float* mods = (const float*)(F.ws + WS_MODS); bf16* HA = (bf16*)(F.ws + WS_HA);
    const bf16* MIX = (const bf16*)(F.ws + WS_PB); unsigned* RT = (unsigned*)(F.ws + WS_RT); int* HIST = (int*)(F.ws + WS_HIST);
    LAS float* WR = (LAS float*)F.lds;
    for (int i = F.tid; i < 20 * 1024; i += NTHR) { const int jx = i >> 10, k = i & 1023;
        WR[i] = jx < 4 ? INP(I_RGW)[((size_t)l * D + k) * 4 + jx] : INP(I_REW)[((size_t)l * D + k) * 16 + (jx - 4)]; }
    if (F.tid < 16) F.MISC[MI_LH + F.tid] = 0u;
    __syncthreads();
    float bias[20];
#pragma unroll
    for (int jx = 0; jx < 20; ++jx) bias[jx] = jx < 4 ? INP(I_RGB)[l * 4 + jx] : INP(I_REB)[l * 16 + (jx - 4)];
    for (int r = F.gw; r < M; r += F.ngw) {
        const int b = r / TT, t = r - b * TT; const bool lat = t < SEQ; const int mr = lat ? b : 16;
        const float* md = mods + ((size_t)l * 17 + mr) * 6144;
        float v[16], mx[16], g1[16], gg[16], bb[16];
        ld16(l == 0 ? xin_row(F, r) : xs_row(F, r), F.lane, v);
        ld16bf(MIX + (size_t)r * D, F.lane, mx); ld16(md + 2048, F.lane, g1);
#pragma unroll
        for (int i = 0; i < 16; ++i) v[i] = ALPHA * v[i] + g1[i] * mx[i];
        ln16(v);
        ld16(INP(I_LN1G) + l * D, F.lane, gg); ld16(INP(I_LN1B) + l * D, F.lane, bb);
#pragma unroll
        for (int i = 0; i < 16; ++i) v[i] = v[i] * gg[i] + bb[i];
        st16(xs_row(F, r), F.lane, v);
        ld16(md + 3072, F.lane, gg); ld16(md + 4096, F.lane, bb);
        ln16(v);
#pragma unroll
        for (int i = 0; i < 16; ++i) v[i] = v[i] * (1.0f + bb[i]) + gg[i];
        st16bf(HA + (size_t)r * D, F.lane, v);
        float lgt[20];
#pragma unroll
        for (int jx = 0; jx < 20; ++jx) {
            const LAS f32x4* wq = (const LAS f32x4*)(WR + jx * 1024);
            const f32x4 w0 = wq[2 * F.lane], w1 = wq[2 * F.lane + 1], w2 = wq[128 + 2 * F.lane], w3 = wq[129 + 2 * F.lane];
            float s = (v[0] * w0.x + v[1] * w0.y) + (v[2] * w0.z + v[3] * w0.w) + (v[4] * w1.x + v[5] * w1.y) + (v[6] * w1.z + v[7] * w1.w)
                    + (v[8] * w2.x + v[9] * w2.y) + (v[10] * w2.z + v[11] * w2.w) + (v[12] * w3.x + v[13] * w3.y) + (v[14] * w3.z + v[15] * w3.w);
            lgt[jx] = wave_sum(s) + bias[jx];
        }
        int grp = 0; float mg = lgt[0];
#pragma unroll
        for (int g = 1; g < 4; ++g) if (lgt[g] > mg) { mg = lgt[g]; grp = g; }
        float sg = 0.f;
#pragma unroll
        for (int g = 0; g < 4; ++g) sg += expf(lgt[g] - mg);
        const float pg = 1.0f / sg;
        float sel[4];
#pragma unroll
        for (int i = 0; i < 4; ++i) sel[i] = grp == 0 ? lgt[4 + i] : grp == 1 ? lgt[8 + i] : grp == 2 ? lgt[12 + i] : lgt[16 + i];
        int i1 = 0; float v1 = sel[0];
#pragma unroll
        for (int i = 1; i < 4; ++i) if (sel[i] > v1) { v1 = sel[i]; i1 = i; }
        int i2 = -1; float v2 = -3.0e38f;
#pragma unroll
        for (int i = 0; i < 4; ++i) if (i != i1 && (i2 < 0 || sel[i] > v2)) { v2 = sel[i]; i2 = i; }
        const float ee = expf(v2 - v1), w1 = pg / (1.0f + ee), w2 = pg * ee / (1.0f + ee);
        const int e1 = grp * 4 + i1, e2 = grp * 4 + i2;
        if (F.lane == 0) {
            const unsigned k1 = __hip_atomic_fetch_add((LAS unsigned*)&F.MISC[MI_LH + e1], 1u, __ATOMIC_RELAXED, __HIP_MEMORY_SCOPE_WORKGROUP);
            const unsigned k2 = __hip_atomic_fetch_add((LAS unsigned*)&F.MISC[MI_LH + e2], 1u, __ATOMIC_RELAXED, __HIP_MEMORY_SCOPE_WORKGROUP);
            v4u ra; ra.x = (unsigned)e1; ra.y = (unsigned)e2; ra.z = k1; ra.w = k2;
            v4u rb; rb.x = __builtin_bit_cast(unsigned, w1); rb.y = __builtin_bit_cast(unsigned, w2); rb.z = 0u; rb.w = 0u;
            *(v4u*)(RT + (size_t)r * 8) = ra; *(v4u*)(RT + (size_t)r * 8 + 4) = rb;
        }
    }
    __syncthreads();
    if (F.tid < 16) HIST[F.bid * 16 + F.tid] = (int)F.MISC[MI_LH + F.tid];
}
__device__ __forceinline__ void moe_tables(const Frame& F) {
    const int* HIST = (const int*)(F.ws + WS_HIST); LAS int* hl = (LAS int*)F.lds;
    __syncthreads();
    for (int i = F.tid; i < F.G * 16; i += NTHR) hl[i] = HIST[i];
    __syncthreads();
    if (F.tid < 16) { int tot = 0, mine = 0; for (int g = 0; g < F.G; ++g) { const int c = hl[g * 16 + F.tid]; tot += c; mine += (g < F.bid) ? c : 0; }
        F.MISC[MI_TOT + F.tid] = (unsigned)tot; F.MISC[MI_BASE + F.tid] = (unsigned)mine; }
    __syncthreads();
    if (F.tid == 0) { unsigned p = 0; for (int e = 0; e < 16; ++e) { F.MISC[MI_PST + e] = p; F.MISC[MI_BASE + e] += p * 256u; p += (F.MISC[MI_TOT + e] + 255u) >> 8; } F.MISC[MI_PST + 16] = p; }
    __syncthreads();
}
__device__ __forceinline__ void phase_permute(const Frame& F) {
    const bf16* HA = (const bf16*)(F.ws + WS_HA); bf16* HS = (bf16*)(F.ws + WS_PB); unsigned* RT = (unsigned*)(F.ws + WS_RT);
    moe_tables(F);
    constexpr int NR = 4;
    for (int r0 = F.gw; r0 < M; r0 += NR * F.ngw) {
        v4u ra[NR], x0[NR], x1[NR];
#pragma unroll
        for (int u = 0; u < NR; ++u) { const int r = r0 + u * F.ngw, rc = r < M ? r : r0; ra[u] = *(const v4u*)(RT + (size_t)rc * 8);
            const v4u* src = (const v4u*)(HA + (size_t)rc * D); x0[u] = src[F.lane]; x1[u] = src[64 + F.lane]; }
#pragma unroll
        for (int u = 0; u < NR; ++u) { const int r = r0 + u * F.ngw; if (r >= M) continue;
            const unsigned p0 = F.MISC[MI_BASE + (ra[u].x & 15u)] + ra[u].z, p1 = F.MISC[MI_BASE + (ra[u].y & 15u)] + ra[u].w;
            v4u* d0 = (v4u*)(HS + (size_t)p0 * D); v4u* d1 = (v4u*)(HS + (size_t)p1 * D);
            d0[F.lane] = x0[u]; d0[64 + F.lane] = x1[u]; d1[F.lane] = x0[u]; d1[64 + F.lane] = x1[u];
            if (F.lane == 0) { RT[(size_t)r * 8 + 6] = p0; RT[(size_t)r * 8 + 7] = p1; } }
    }
}

struct EpiMla {
    static constexpr bool PERM = true, AFTER_DRAIN = false;
    bf16* QD; bf16* KD; bf16* VD;
    __device__ __forceinline__ void operator()(const pg8::f32x4 (&acc)[2][2][4][2], const pg8::Unit& u, int wr, int wc, int fr, int fq) const {
#pragma unroll
        for (int bj = 0; bj < 2; ++bj) {
            const int g0 = u.pn * 256 + bj * 128 + wc * 32, col0 = g0 + 8 * fq;
            if (g0 >= 896) continue;
            const int c = col0 - 384, hd = c >> 7, jx = c & 127;
            bf16* dst = g0 < 384 ? QD + col0 : jx < 64 ? KD + hd * 96 + jx : VD + hd * 64 + (jx - 64);
            const int stride = (g0 < 384 || jx < 64) ? 384 : 256;
            dst += (size_t)(u.pm * 256 + wr * 64 + fr) * stride;
#pragma unroll
            for (int ai = 0; ai < 2; ++ai)
#pragma unroll
                for (int m = 0; m < 4; ++m) {
                    v4u o; o.x = pk2(acc[ai][bj][m][0][0], acc[ai][bj][m][0][1]); o.y = pk2(acc[ai][bj][m][0][2], acc[ai][bj][m][0][3]);
                    o.z = pk2(acc[ai][bj][m][1][0], acc[ai][bj][m][1][1]); o.w = pk2(acc[ai][bj][m][1][2], acc[ai][bj][m][1][3]);
                    *(v4u*)(dst + (size_t)(ai * 128 + m * 16) * stride) = o;
                }
        }
    }
};
struct EpiGU {
    static constexpr bool PERM = true, AFTER_DRAIN = false;
    bf16* ACT;
    __device__ __forceinline__ void operator()(const pg8::f32x4 (&acc)[2][2][4][2], const pg8::Unit& u, int wr, int wc, int fr, int fq) const {
#pragma unroll
        for (int ai = 0; ai < 2; ++ai)
#pragma unroll
            for (int m = 0; m < 4; ++m) {
                const int row = u.pm * 256 + ai * 128 + wr * 64 + m * 16 + fr;
#pragma unroll
                for (int bj = 0; bj < 2; ++bj) {
                    const int c = (u.pn & 3) * 256 + bj * 128 + wc * 32 + 8 * fq;
                    float o[4];
#pragma unroll
                    for (int i = 0; i < 4; ++i) { const float g = acc[ai][bj][m][0][i], up = acc[ai][bj][m][1][i]; o[i] = g / (1.0f + __expf(-g)) * up; }
                    v2u w; w.x = pk2(o[0], o[1]); w.y = pk2(o[2], o[3]);
                    *(v2u*)(ACT + (size_t)row * 512 + (c >> 1)) = w;
                }
            }
    }
};
struct MoeOrder {
    volatile LAS unsigned* pst; int G, c;
    __device__ __forceinline__ bool next(int i, pg8::Unit& u) const {
        const int L = i * G + c; const int np = (int)pst[16];
        if (L >= np * 4) return false;
        const int panel = L >> 2; int e = 0;
#pragma unroll
        for (int k = 1; k < 16; ++k) e += (panel >= (int)pst[k]) ? 1 : 0;
        u.pm = __builtin_amdgcn_readfirstlane(panel); u.pn = __builtin_amdgcn_readfirstlane(e * 4 + (L & 3)); return true;
    }
    __device__ __forceinline__ void a_ready(const pg8::Unit&) const {}
    __device__ __forceinline__ void done(const pg8::Unit&) const {}
};

#ifndef DBG_VAR
#define DBG_VAR 1
#endif
namespace att {
constexpr int VRS = 192, KBUF = 64 * 208, VBUF = 64 * VRS, BUF = KBUF + VBUF, BIAS_OFF = 2 * BUF;
constexpr float NEG = -30000.0f;
__device__ __forceinline__ int crow(int r, int hi) { return (r & 3) + 8 * (r >> 2) + 4 * hi; }
__device__ __forceinline__ float xhalf_max(float v) { const unsigned a = __builtin_bit_cast(unsigned, v);
    auto rr = __builtin_amdgcn_permlane32_swap(a, a, false, false); const unsigned r0 = rr[0], r1 = rr[1]; return fmaxf(__uint_as_float(r0), __uint_as_float(r1)); }
__device__ __forceinline__ float xhalf_sum(float v) { const unsigned a = __builtin_bit_cast(unsigned, v);
    auto rr = __builtin_amdgcn_permlane32_swap(a, a, false, false); const unsigned r0 = rr[0], r1 = rr[1]; return __uint_as_float(r0) + __uint_as_float(r1); }
__device__ __forceinline__ float max3f(float a, float b, float c) { float r; asm("v_max3_f32 %0, %1, %2, %3" : "=v"(r) : "v"(a), "v"(b), "v"(c)); return r; }
typedef __bf16 bf16x2_t __attribute__((ext_vector_type(2)));
__device__ __forceinline__ unsigned cvtpk(float lo, float hi) { f32x2 v = {lo, hi}; bf16x2_t b = __builtin_convertvector(v, bf16x2_t); return __builtin_bit_cast(unsigned, b); }

template <int DK>
__device__ __forceinline__ void unit(LAS unsigned char* lds, const bf16* Qp, int qpitch, const bf16* Kp, int kpitch, const bf16* Vp, int vpitch, bf16* Op,
                                     int var, int qt, int lo, int n1, int nt, float qscale, float sinkl2, bool has_sink, const LAS float* bias, const float* t32, unsigned* dbg) {
    constexpr int KRS = DK * 2 + 16, NS = DK / 16, CPK = DK / 8;
    int tid = threadIdx.x; asm volatile("" : "+v"(tid)); const int lane = tid & 63, r32 = lane & 31, hi = lane >> 5, wid = __builtin_amdgcn_readfirstlane(tid >> 6);
    const int qrow = 256 * qt + 32 * wid + r32;
    bf16x8 qr[NS];
#pragma unroll
    for (int s = 0; s < NS; ++s) { const v4u raw = *(const v4u*)(Qp + (size_t)qrow * qpitch + 16 * s + 8 * hi); float f[8]; unpack8(raw, f);
#pragma unroll
        for (int i = 0; i < 8; ++i) f[i] *= qscale;
        if (DK == 96 && s >= 4) {
            float p[8];
#pragma unroll
            for (int i = 0; i < 8; ++i) p[i] = __shfl_xor(f[i], 32);
            if (qt < 16) rope8(f, p, t32 + ((size_t)((s == 4 ? (qrow >> 6) : (qrow & 63)) * 8)) * 2, hi == 0);
        }
        qr[s] = __builtin_bit_cast(bf16x8, pack8(f)); }
    const int kkey0 = tid / CPK, kch0 = tid - kkey0 * CPK, kkey1 = (tid + 512) / CPK, kch1 = (tid + 512) - kkey1 * CPK;
    const int vkey = tid >> 3, vch = tid & 7;
    v4u kreg0, kreg1 = {0u, 0u, 0u, 0u}, vreg;
#define ATT_TROW(j) ((((j) < n1) ? (lo + (j)) : (64 + (j) - n1)) * 64)
#define ATT_LOAD(j) do { const int tr_ = ATT_TROW(j); kreg0 = *(const v4u*)(Kp + (size_t)(tr_ + kkey0) * kpitch + kch0 * 8); \
        if (DK == 96 && tid < 256) kreg1 = *(const v4u*)(Kp + (size_t)(tr_ + kkey1) * kpitch + kch1 * 8); \
        vreg = *(const v4u*)(Vp + (size_t)(tr_ + vkey) * vpitch + vch * 8); } while (0)
#define ATT_STORE(bf) do { LAS unsigned char* b_ = lds + (bf) * BUF; *(LAS v4u*)(b_ + kkey0 * KRS + kch0 * 16) = kreg0; \
        if (DK == 96 && tid < 256) *(LAS v4u*)(b_ + kkey1 * KRS + kch1 * 16) = kreg1; \
        *(LAS v4u*)(b_ + KBUF + vkey * VRS + vch * 16) = vreg; } while (0)
    constexpr float THR = 6.0f;
    float m = 0.f; f32x2 lacc = {0.f, 0.f}; f32x16 o0 = {}, o1 = {}; f32x16 negm = {}; bool first = true;
    const int grw = 4 * qt + (wid >> 1), r0w = min(max(grw - 4, 0), 56), gc = (wid & 1) * 32 + r32, c0 = min(max(gc - 8, 0), 48), i0w = 256 * qt + 32 * wid;
    ATT_LOAD(0); ATT_STORE(0);
    __syncthreads();
    for (int j = 0; j < nt; ++j) {
        if (j + 1 < nt) ATT_LOAD(j + 1);
        const int kt = ATT_TROW(j) >> 6;
        bool actv = true;
        if (kt < 64) { if (var == 0) actv = (kt >= r0w) && (kt <= r0w + 7); else if (var == 2) actv = !((64 * kt - (i0w + 31) > 128) || (i0w - (64 * kt + 63) > 128)); }
        if (actv) {
            const LAS unsigned char* Kb = lds + (j & 1) * BUF; const LAS unsigned char* Vb = Kb + KBUF;
            f32x16 s0 = negm, s1 = negm;
#pragma unroll
            for (int s = 0; s < NS; ++s) {
                const bf16x8 ka = *(const LAS bf16x8*)(Kb + r32 * KRS + (16 * s + 8 * hi) * 2);
                const bf16x8 kb = *(const LAS bf16x8*)(Kb + (32 + r32) * KRS + (16 * s + 8 * hi) * 2);
                s0 = __builtin_amdgcn_mfma_f32_32x32x16_bf16(ka, qr[s], s0, 0, 0, 0);
                s1 = __builtin_amdgcn_mfma_f32_32x32x16_bf16(kb, qr[s], s1, 0, 0, 0);
            }
            asm volatile("s_nop 15\n\ts_nop 7" : "+v"(s0), "+v"(s1));
            if (kt < 64 && var == 0) {
                const int rowoff = (kt - grw + 7) * 31 - gc + 15;
#pragma unroll
                for (int r = 0; r < 16; ++r) { const int j0 = crow(r, hi), j1 = j0 + 32;
                    const bool v0 = (unsigned)(j0 - c0) < 16u, v1 = (unsigned)(j1 - c0) < 16u;
                    const float b0 = bias[v0 ? rowoff + j0 : 0], b1 = bias[v1 ? rowoff + j1 : 0];
                    s0[r] = v0 ? s0[r] + b0 : NEG; s1[r] = v1 ? s1[r] + b1 : NEG; }
            } else if (kt < 64 && var == 2) {
                const int dbase = 64 * kt - qrow + 128;
#pragma unroll
                for (int r = 0; r < 16; ++r) { const int j0 = crow(r, hi);
                    s0[r] = (unsigned)(dbase + j0) <= 256u ? s0[r] : NEG; s1[r] = (unsigned)(dbase + j0 + 32) <= 256u ? s1[r] : NEG; }
            }
            float mxa = max3f(s0[0], s0[1], s1[0]), mxb = max3f(s0[2], s0[3], s1[1]); mxa = max3f(mxa, s1[2], s1[3]);
#pragma unroll
            for (int r = 4; r < 16; r += 4) { mxa = max3f(mxa, s0[r], s0[r + 1]); mxb = max3f(mxb, s0[r + 2], s0[r + 3]); mxa = max3f(mxa, s1[r], s1[r + 1]); mxb = max3f(mxb, s1[r + 2], s1[r + 3]); }
            const float mx = xhalf_max(fmaxf(mxa, mxb));
            if (first || __any(mx > THR)) {
                const float d = first ? fmaxf(mx, -64.0f) : fmaxf(mx, 0.f), alpha = __builtin_amdgcn_exp2f(-d);
                m += d; first = false;
#pragma unroll
                for (int r = 0; r < 16; ++r) { s0[r] -= d; s1[r] -= d; o0[r] *= alpha; o1[r] *= alpha; negm[r] = -m; }
                lacc *= alpha;
            }
#pragma unroll
            for (int r = 0; r < 16; ++r) { s0[r] = __builtin_amdgcn_exp2f(s0[r]); s1[r] = __builtin_amdgcn_exp2f(s1[r]); lacc += (f32x2){s0[r], s1[r]}; }
            bf16x8 pb[4];
#pragma unroll
            for (int s = 0; s < 2; ++s) {
                v4u w; w.x = cvtpk(s0[8 * s], s0[8 * s + 1]); w.y = cvtpk(s0[8 * s + 2], s0[8 * s + 3]); w.z = cvtpk(s0[8 * s + 4], s0[8 * s + 5]); w.w = cvtpk(s0[8 * s + 6], s0[8 * s + 7]);
                pb[s] = __builtin_bit_cast(bf16x8, w);
                v4u x; x.x = cvtpk(s1[8 * s], s1[8 * s + 1]); x.y = cvtpk(s1[8 * s + 2], s1[8 * s + 3]); x.z = cvtpk(s1[8 * s + 4], s1[8 * s + 5]); x.w = cvtpk(s1[8 * s + 6], s1[8 * s + 7]);
                pb[2 + s] = __builtin_bit_cast(bf16x8, x);
            }
            const LAS unsigned char* vbase = Vb + (4 * hi + ((lane & 15) >> 2)) * VRS + ((lane >> 4) & 1) * 32 + (lane & 3) * 8;
#pragma unroll
            for (int s = 0; s < 4; ++s) {
                const v4i16 a0 = __builtin_amdgcn_ds_read_tr16_b64_v4i16((LAS v4i16*)(vbase + (16 * s) * VRS));
                const v4i16 a1 = __builtin_amdgcn_ds_read_tr16_b64_v4i16((LAS v4i16*)(vbase + (16 * s + 8) * VRS));
                const v4i16 c0_ = __builtin_amdgcn_ds_read_tr16_b64_v4i16((LAS v4i16*)(vbase + (16 * s) * VRS + 64));
                const v4i16 c1_ = __builtin_amdgcn_ds_read_tr16_b64_v4i16((LAS v4i16*)(vbase + (16 * s + 8) * VRS + 64));
                const bf16x8 va = {a0[0], a0[1], a0[2], a0[3], a1[0], a1[1], a1[2], a1[3]};
                const bf16x8 vc = {c0_[0], c0_[1], c0_[2], c0_[3], c1_[0], c1_[1], c1_[2], c1_[3]};
                o0 = __builtin_amdgcn_mfma_f32_32x32x16_bf16(va, pb[s], o0, 0, 0, 0);
                o1 = __builtin_amdgcn_mfma_f32_32x32x16_bf16(vc, pb[s], o1, 0, 0, 0);
            }
        }
        if (j + 1 < nt) ATT_STORE((j + 1) & 1);
        __syncthreads();
    }
    float l = xhalf_sum(lacc.x + lacc.y);
    const float sterm = has_sink ? __builtin_amdgcn_exp2f(sinkl2 - m) : 0.f;
#if MK_DEBUG
    if (dbg && hi == 0) { dbg[(size_t)qrow * 2] = __builtin_bit_cast(unsigned, m); dbg[(size_t)qrow * 2 + 1] = __builtin_bit_cast(unsigned, l); }
#endif
    if (has_sink) l += sterm;
    const float inv = 1.0f / l;
    bf16* orow = Op + (size_t)qrow * D;
#pragma unroll
    for (int g = 0; g < 4; ++g) {
        v2u w0; w0.x = pk2(o0[4 * g] * inv, o0[4 * g + 1] * inv); w0.y = pk2(o0[4 * g + 2] * inv, o0[4 * g + 3] * inv);
        v2u w1; w1.x = pk2(o1[4 * g] * inv, o1[4 * g + 1] * inv); w1.y = pk2(o1[4 * g + 2] * inv, o1[4 * g + 3] * inv);
        *(v2u*)(orow + 8 * g + 4 * hi) = w0; *(v2u*)(orow + 32 + 8 * g + 4 * hi) = w1;
    }
#undef ATT_TROW
#undef ATT_LOAD
#undef ATT_STORE
}
}

__device__ __forceinline__ void phase_attn(const Frame& F, int lq) {
    const int l = lq & 3;
    const bf16* P = (const bf16*)(F.ws + WS_PB); const bf16* QD = (const bf16*)(F.ws + WS_QD); const bf16* KD = (const bf16*)(F.ws + WS_KD);
    const bf16* VD = (const bf16*)(F.ws + WS_VD); bf16* O = (bf16*)(F.ws + WS_HA);
    unsigned* ctr = (unsigned*)(F.ws + WS_CTL) + CW_QUEUE + 64 * lq;
    LAS float* bias = (LAS float*)(F.lds + att::BIAS_OFF);
    for (int i = F.tid; i < 4 * 465; i += NTHR) bias[i] = INP(I_NABIAS)[l * 4 * 465 + i] * LOG2E;
    __syncthreads();
    const int nunits = 4096 + (l < NL - 1 ? 256 : 0);
    for (;;) {
        if (F.tid == 0) F.MISC[MI_Q] = __hip_atomic_fetch_add(ctr, 1u, __ATOMIC_RELAXED, __HIP_MEMORY_SCOPE_AGENT);
        __syncthreads();
        const int idx = (int)F.MISC[MI_Q];
        __syncthreads();
        if (idx >= nunits) break;
        int var, b, h, qt;
        if (idx < 4096) { const int grp = idx >> 10, rem = idx & 1023; var = grp == 0 ? 3 : grp == 1 ? 1 : grp == 2 ? 0 : 2; b = rem >> 6; h = (rem >> 4) & 3; qt = rem & 15; }
        else { const int rem = idx - 4096; b = rem >> 4; var = (rem >> 2) & 3; h = rem & 3; qt = 16; }
        int lo = 0, n1 = 64;
        if (qt == 16) { lo = 0; n1 = 0; }
        else if (var == 0) { lo = min(max(4 * qt - 4, 0), 56); n1 = min(max(4 * qt - 1, 0), 56) + 7 - lo + 1; }
        else if (var == 2) { lo = max(4 * qt - 2, 0); n1 = min(4 * qt + 5, 63) - lo + 1; }
        const int nt = n1 + 4;
        const size_t rb = (size_t)b * TT;
        bf16* Op = O + rb * D + var * 256 + h * 64;
        if (var == 3) {
            att::unit<96>(F.lds, QD + rb * 384 + h * 96, 384, KD + rb * 384 + h * 96, 384, VD + rb * 256 + h * 64, 256, Op, 3, qt, lo, n1, nt, 0.10206207261596575f * LOG2E, 0.f, false, bias, (const float*)(F.ws + WS_T32), nullptr);
        } else {
            const int qc = var == 0 ? h * 64 : var == 1 ? 768 + h * 64 : 1280 + h * 64;
            const int kc = var == 0 ? 256 + h * 64 : var == 1 ? 1024 + (h >> 1) * 64 : 1536 + (h >> 1) * 64;
            const int vc = var == 0 ? 512 + h * 64 : var == 1 ? 1152 + (h >> 1) * 64 : 1664 + (h >> 1) * 64;
            att::unit<64>(F.lds, P + rb * NPJ + qc, NPJ, P + rb * NPJ + kc, NPJ, P + rb * NPJ + vc, NPJ, Op, var, qt, lo, n1, nt, 0.125f * LOG2E,
                          var == 2 ? INP(I_SINK)[l * 4 + h] * LOG2E : 0.f, var == 2, bias + h * 465, nullptr, (MK_DEBUG && var == DBG_VAR && h == 0) ? (unsigned*)(F.ws + WS_RS) + rb * 2 : nullptr);
        }
    }
}

#define PHASE_FN static __device__ __forceinline__ void
PHASE_FN ph_prologue(GAS unsigned char* ws) { const Frame F = make_frame(ws); phase_prologue(F); }
PHASE_FN ph_ln(GAS unsigned char* ws, int l) { const Frame F = make_frame(ws); phase_ln(F, l); }
PHASE_FN ph_gemm_in(GAS unsigned char* ws, int l) {
    const Frame F = make_frame(ws);
    pg8::Gemm g{(const bf16*)(F.ws + WS_HA), (const bf16*)(F.ws + WS_WIN) + (size_t)l * NPJ * D, M, NPJ, D, D}; pg8::StaticOrder S; S.init(M, NPJ, F.G, F.bid);
    pg8::EpiBf16<0> E{(bf16*)(F.ws + WS_PB), NPJ, nullptr, 0, 0, 1.f};
    pg8::gemm_phase<pg8::EpiBf16<0>, pg8::StaticOrder, true, true>(F.lds, g, S, E);
}
PHASE_FN ph_post(GAS unsigned char* ws, int l) { const Frame F = make_frame(ws); phase_post(F, l); }
PHASE_FN ph_gemm_mla(GAS unsigned char* ws, int l) {
    const Frame F = make_frame(ws);
    pg8::Gemm g{(const bf16*)(F.ws + WS_PB) + 1792, (const bf16*)(F.ws + WS_WD) + (size_t)l * 1024 * 384, M, 1024, 384, NPJ}; pg8::StaticOrder S; S.init(M, 1024, F.G, F.bid);
    EpiMla E{(bf16*)(F.ws + WS_QD), (bf16*)(F.ws + WS_KD), (bf16*)(F.ws + WS_VD)};
    pg8::gemm_phase<EpiMla, pg8::StaticOrder, true, true>(F.lds, g, S, E);
}
PHASE_FN ph_attn(GAS unsigned char* ws, int l) { const Frame F = make_frame(ws); phase_attn(F, l); }
PHASE_FN ph_gemm_out(GAS unsigned char* ws, int l) {
    const Frame F = make_frame(ws);
    pg8::Gemm g{(const bf16*)(F.ws + WS_HA), (const bf16*)(F.ws + WS_WOUT) + (size_t)l * D * D, M, D, D, D}; pg8::StaticOrder S; S.init(M, D, F.G, F.bid);
    pg8::EpiBf16<0> E{(bf16*)(F.ws + WS_PB), D, nullptr, 0, 0, 1.f};
    pg8::gemm_phase<pg8::EpiBf16<0>, pg8::StaticOrder, true, true>(F.lds, g, S, E);
}
PHASE_FN ph_route(GAS unsigned char* ws, int l) { const Frame F = make_frame(ws); phase_route(F, l); }
PHASE_FN ph_permute(GAS unsigned char* ws) { const Frame F = make_frame(ws); phase_permute(F); }
PHASE_FN ph_gemm_gu(GAS unsigned char* ws, int l) {
    const Frame F = make_frame(ws);
    moe_tables(F);
    pg8::Gemm g{(const bf16*)(F.ws + WS_PB), (const bf16*)(F.ws + WS_WGU) + (size_t)l * 16384 * 1024, MS, 16384, D, D}; MoeOrder S{F.MISC + MI_PST, F.G, F.bid};
    EpiGU E{(bf16*)(F.ws + WS_ACT)};
    pg8::gemm_phase<EpiGU, MoeOrder, true, true>(F.lds, g, S, E);
}
PHASE_FN ph_gemm_dn(GAS unsigned char* ws, int l) {
    const Frame F = make_frame(ws);
    moe_tables(F);
    pg8::Gemm g{(const bf16*)(F.ws + WS_ACT), (const bf16*)(F.ws + WS_WDN) + (size_t)l * 16384 * 512, MS, 16384, 512, 512}; MoeOrder S{F.MISC + MI_PST, F.G, F.bid};
    pg8::EpiBf16<0> E{(bf16*)(F.ws + WS_PB), D, nullptr, 1024, 0, 1.f};
    pg8::gemm_phase<pg8::EpiBf16<0>, MoeOrder, true, true>(F.lds, g, S, E);
}


#if MK_DEBUG
#ifndef DBG_MODE
#define DBG_MODE 0
#endif
__device__ __forceinline__ float oracle_attn(const Frame& F, int l, int r, int var, int h, int mode = 0) {
    const bf16* P = (const bf16*)(F.ws + WS_PB); const bf16* QD = (const bf16*)(F.ws + WS_QD); const bf16* KD = (const bf16*)(F.ws + WS_KD); const bf16* VD = (const bf16*)(F.ws + WS_VD);
    const bf16* O = (const bf16*)(F.ws + WS_HA); const float* t32 = (const float*)(F.ws + WS_T32);
    const int b = r / TT, t = r - b * TT; const bool lat = t < SEQ; const size_t rb = (size_t)b * TT;
    const int dk = var == 3 ? 96 : 64;
    const bf16* qp; const bf16* kp; const bf16* vp; int kpitch, vpitch;
    if (var == 3) { qp = QD + (size_t)r * 384 + h * 96; kp = KD + rb * 384 + h * 96; kpitch = 384; vp = VD + rb * 256 + h * 64; vpitch = 256; }
    else { const int qc = var == 0 ? h * 64 : var == 1 ? 768 + h * 64 : 1280 + h * 64, kc = var == 0 ? 256 + h * 64 : var == 1 ? 1024 + (h >> 1) * 64 : 1536 + (h >> 1) * 64,
           vc = var == 0 ? 512 + h * 64 : var == 1 ? 1152 + (h >> 1) * 64 : 1664 + (h >> 1) * 64;
           qp = P + (size_t)r * NPJ + qc; kp = P + rb * NPJ + kc; kpitch = NPJ; vp = P + rb * NPJ + vc; vpitch = NPJ; }
    LAS float* qs = (LAS float*)(F.lds + 65536) + F.wave * 128;
    for (int d = F.lane; d < dk; d += 64) qs[d] = __builtin_bit_cast(float, (unsigned)qp[d] << 16);
    asm volatile("s_waitcnt lgkmcnt(0)" ::: "memory");
    if (var == 3 && lat && F.lane < 32) {
        const int c = F.lane >> 3, e = F.lane & 7, gr = t >> 6, gc = t & 63; const float own = qs[64 + F.lane], par = qs[64 + (F.lane ^ 8)];
        const float cs = t32[((c < 2 ? gr : gc) * 8 + e) * 2], sn = t32[((c < 2 ? gr : gc) * 8 + e) * 2 + 1];
        const float nv = (c & 1) == 0 ? own * cs - par * sn : par * sn + own * cs;
        asm volatile("s_waitcnt lgkmcnt(0)" ::: "memory"); qs[64 + F.lane] = nv; }
    asm volatile("s_waitcnt lgkmcnt(0)" ::: "memory");
    const float scale = var == 3 ? 0.10206207261596575f : 0.125f;
    const int gr = t >> 6, gc = t & 63, r0 = min(max(gr - 4, 0), 56), c0 = min(max(gc - 8, 0), 48);
    float m = -3.0e38f, lsum = 0.f, acc[64];
#pragma unroll
    for (int d = 0; d < 64; ++d) acc[d] = 0.f;
    for (int j = F.lane; j < TT; j += 64) {
        bool ok = true; float bias = 0.f;
        if (!lat) ok = j >= SEQ;
        else if (j < SEQ) {
            if (var == 0) { const int kr = j >> 6, kc2 = j & 63; ok = kr >= r0 && kr <= r0 + 7 && kc2 >= c0 && kc2 <= c0 + 15;
                if (ok) bias = INP(I_NABIAS)[((l * 4 + h) * 15 + (kr - gr + 7)) * 31 + (kc2 - gc + 15)]; }
            else if (var == 2) ok = (j - t <= 128) && (t - j <= 128);
        }
        if (!ok) continue;
        float sc = 0.f; const bf16* kr_ = kp + (size_t)j * kpitch;
        for (int d = 0; d < dk; ++d) sc += qs[d] * __builtin_bit_cast(float, (unsigned)kr_[d] << 16);
        sc = sc * scale + bias;
        const float mn = fmaxf(m, sc), a = expf(m - mn), p = expf(sc - mn); m = mn; lsum = lsum * a + p;
        const bf16* vr = vp + (size_t)j * vpitch;
#pragma unroll
        for (int d = 0; d < 64; ++d) acc[d] = acc[d] * a + p * __builtin_bit_cast(float, (unsigned)vr[d] << 16);
    }
    float mg = m;
#pragma unroll
    for (int o = 1; o < 64; o <<= 1) mg = fmaxf(mg, __shfl_xor(mg, o));
    if (mode >= 1) {
        const unsigned* rec = (const unsigned*)(F.ws + WS_RS) + (size_t)r * 2; const float mk = __builtin_bit_cast(float, rec[0]), lk = __builtin_bit_cast(float, rec[1]);
        const float lref = wave_sum(lsum * expf(m - mg));
        const float lker = lk * exp2f(mk - mg * LOG2E);
        if (mode == 2) return fabsf(mk / LOG2E - mg);
        return fabsf(lker / lref - 1.0f);
    }
    const float f = expf(m - mg); lsum *= f; lsum = wave_sum(lsum);
    if (var == 2) lsum += expf(INP(I_SINK)[l * 4 + h] - mg);
    float err = 0.f, mag = 1.0e-6f;
    const bf16* orow = O + (size_t)r * D + var * 256 + h * 64;
#pragma unroll
    for (int d = 0; d < 64; ++d) { const float ref = wave_sum(acc[d] * f) / lsum; const float got = __builtin_bit_cast(float, (unsigned)orow[d] << 16);
        const float df = fabsf(got - ref); err = (df == df) ? fmaxf(err, df) : 1.0e30f; mag = fmaxf(mag, fabsf(ref)); }
    return err / mag;
}
__device__ __forceinline__ void phase_dump(const Frame& F, int code) {
    float* out = (float*)ptab_get(F, I_OUT);
    for (int r = F.gw; r < M; r += F.ngw) {
        const int b = r / TT, t = r - b * TT; if (t >= SEQ) continue;
        float v[16];
        if (code == 1) ld16bf((const bf16*)(F.ws + WS_HA) + (size_t)r * D, F.lane, v);
        else if (code == 2) ld16bf((const bf16*)(F.ws + WS_PB) + (size_t)r * NPJ, F.lane, v);
        else if (code == 3) ld16bf((const bf16*)(F.ws + WS_PB) + (size_t)r * NPJ + 1024, F.lane, v);
        else if (code == 4) ld16bf((const bf16*)(F.ws + WS_PB) + (size_t)r * NPJ + 1280, F.lane, v);
        else if (code == 5) ld16((const float*)(F.ws + WS_PB) + (size_t)r * D, F.lane, v);
        else if (code == 8) {
            const v4u w0 = *((const v4u*)((const bf16*)(F.ws + WS_HA) + (size_t)r * D) + F.lane), w1 = *((const v4u*)((const bf16*)(F.ws + WS_HA) + (size_t)r * D) + 64 + F.lane);
            float f[8]; int bad0 = 0, bad1 = 0; unpack8(w0, f);
#pragma unroll
            for (int i = 0; i < 8; ++i) { const unsigned u = __builtin_bit_cast(unsigned, f[i]); bad0 |= ((u & 0x7f800000u) == 0x7f800000u) ? 1 : 0; }
            unpack8(w1, f);
#pragma unroll
            for (int i = 0; i < 8; ++i) { const unsigned u = __builtin_bit_cast(unsigned, f[i]); bad1 |= ((u & 0x7f800000u) == 0x7f800000u) ? 1 : 0; }
            const unsigned long long m0 = __ballot(bad0), m1 = __ballot(bad1);
            const bool vA = (m0 & 0xffffffffull) != 0, vB = (m0 >> 32) != 0, vC = (m1 & 0xffffffffull) != 0, vD = (m1 >> 32) != 0;
            const float val = (float)(t + 1) * ((vA ? 1.0f : 0.f) + (vB ? 1.0e2f : 0.f) + (vC ? 1.0e4f : 0.f) + (vD ? 1.0e6f : 0.f));
#pragma unroll
            for (int i = 0; i < 16; ++i) v[i] = val;
        }
        else if (code == 9) { const unsigned cd = ((const unsigned*)(F.ws + WS_RS))[(size_t)r * 2]; float val = 0.f; if (cd) { val = 1.f; for (unsigned k = 0; k < cd; ++k) val *= 10.f; }
#pragma unroll
            for (int i = 0; i < 16; ++i) v[i] = val; }
        else if (code == 10) {
            const v4u w1 = *((const v4u*)((const bf16*)(F.ws + WS_HA) + (size_t)r * D) + 64 + F.lane);
            float f[8]; int bad1 = 0; unpack8(w1, f);
#pragma unroll
            for (int i = 0; i < 8; ++i) { const unsigned u = __builtin_bit_cast(unsigned, f[i]); bad1 |= ((u & 0x7f800000u) == 0x7f800000u) ? 1 : 0; }
            const bool vC = (__ballot(bad1) & 0xffffffffull) != 0;
            const bf16* pc = (const bf16*)(F.ws + WS_PB) + ((size_t)b * TT + SEQ + (t & 255)) * NPJ; int badp = 0;
            for (int c = F.lane; c < 288; c += 64) { const v4u w = *((const v4u*)pc + c); unpack8(w, f);
#pragma unroll
                for (int i = 0; i < 8; ++i) { const unsigned u = __builtin_bit_cast(unsigned, f[i]); badp |= ((u & 0x7f800000u) == 0x7f800000u) ? 1 : 0; } }
            float val = 0.f; if (vC) { val = 1.f; for (int k = 0; k <= (t & 15); ++k) val *= 10.f; }
            if (__any(badp)) val = 1.0e30f;
#pragma unroll
            for (int i = 0; i < 16; ++i) v[i] = val;
        }
        else if (code == 11) {
            const bf16* pr = (const bf16*)(F.ws + WS_PB) + (size_t)r * NPJ; int grp = -1;
            for (int c = F.lane; c < 288; c += 64) { const v4u w = *((const v4u*)pr + c); float f[8]; unpack8(w, f);
#pragma unroll
                for (int i = 0; i < 8; ++i) if (!(fabsf(f[i]) < 1.0e4f)) grp = (c * 8) >> 8; }
#pragma unroll
            for (int o = 1; o < 64; o <<= 1) { const int g2 = __shfl_xor(grp, o); grp = g2 > grp ? g2 : grp; }
            float val = 0.f; if (grp >= 0) { val = 100.f; for (int k = 0; k < grp; ++k) val *= 10.f; }
#pragma unroll
            for (int i = 0; i < 16; ++i) v[i] = val;
        }
        else if (code >= 20 && code < 24) {
            float val = 0.f;
            if ((t & 15) == 5) { for (int h = 0; h < 4; ++h) { const float e = oracle_attn(F, 0, r, code - 20, h); const float cls = e > 1.0e20f ? 3.f : e > 0.5f ? 2.f : e > 0.03f ? 1.f : 0.f; if (cls > 0.f) { float w = cls; for (int k = 0; k <= h; ++k) w *= 10.f; val = fmaxf(val, w); } } }
#pragma unroll
            for (int i = 0; i < 16; ++i) v[i] = val;
        }
        else if (code >= 30 && code < 46) {
            float val = 0.f;
            if ((t & 15) == 5) { const float e = oracle_attn(F, 0, r, (code - 30) >> 2, (code - 30) & 3, DBG_MODE); val = e > 10.f ? 1.0e4f : 1000.f * e; }
#pragma unroll
            for (int i = 0; i < 16; ++i) v[i] = val;
        }
        else if (code == 7) {
            auto bad16 = [&](const bf16* p, int nchunks) { int bad = 0; for (int c = F.lane; c < nchunks; c += 64) { const v4u w = *((const v4u*)p + c); float f[8]; unpack8(w, f);
#pragma unroll
                for (int i = 0; i < 8; ++i) { const unsigned u = __builtin_bit_cast(unsigned, f[i]); bad |= ((u & 0x7f800000u) == 0x7f800000u) ? 1 : 0; } } return __any(bad); };
            const int bP = bad16((const bf16*)(F.ws + WS_PB) + (size_t)r * NPJ, 288), bQ = bad16((const bf16*)(F.ws + WS_QD) + (size_t)r * 384, 48),
                      bK = bad16((const bf16*)(F.ws + WS_KD) + (size_t)r * 384, 48), bV = bad16((const bf16*)(F.ws + WS_VD) + (size_t)r * 256, 32), bO = bad16((const bf16*)(F.ws + WS_HA) + (size_t)r * D, 128);
            const float val = bP ? 1.0e6f : bQ ? 1.0e5f : bK ? 1.0e4f : bV ? 1.0e3f : bO ? 1.0e2f : 0.f;
#pragma unroll
            for (int i = 0; i < 16; ++i) v[i] = val;
        }
#pragma unroll
        for (int i = 0; i < 16; ++i) { const unsigned u = __builtin_bit_cast(unsigned, v[i]); if ((u & 0x7f800000u) == 0x7f800000u) v[i] = 777.0f; }
        st16(out + ((size_t)b * SEQ + t) * D, F.lane, v);
    }
}
static __device__ __forceinline__ void ph_dump(GAS unsigned char* ws, int code) { const Frame F = make_frame(ws); phase_dump(F, code); }
#endif
__global__ void __launch_bounds__(NTHR, 2) mk_fwd(Args args) {
    extern __shared__ __attribute__((aligned(16))) unsigned char lds_raw[];
    LAS unsigned char* lds = (LAS unsigned char*)lds_raw; volatile LAS unsigned* MISC = (volatile LAS unsigned*)(lds + MISC_OFF);
    const int tid = threadIdx.x;
    GAS unsigned char* ws = (GAS unsigned char*)args.ws;
    for (int u = tid; u < (LDS_BYTES - MISC_OFF) / 4; u += NTHR) MISC[u] = 0u;
    __syncthreads();
    if (tid < 28) { const unsigned long long p = tid < 27 ? (unsigned long long)args.in[tid] : (unsigned long long)args.out;
        LAS unsigned* t = (LAS unsigned*)(lds + PTAB_OFF) + 2 * tid; t[0] = (unsigned)p; t[1] = (unsigned)(p >> 32); }
    __syncthreads();
#if MK_MULTI
#define GRID_BAR() do { } while (0)
#else
    XcdBarrier bar = xcd_barrier_post((unsigned*)(ws + WS_CTL) + CW_BAR, MISC + MI_BAR);
#define GRID_BAR() xcd_barrier(bar)
#endif
    const int lo = args.ph_lo, hi = args.ph_hi;
#define IN(k) (lo <= (k) && (k) < hi)
#define SEAM(k) do { if (IN(k) && IN((k) + 1)) GRID_BAR(); } while (0)

#if MK_DEBUG
    if (lo >= 100) { ph_dump(ws, lo - 100); return; }
#endif
    if (IN(0)) { ph_prologue(ws); } SEAM(0);
    for (int l = 0; l < NL; ++l) {
        const int pb = 1 + 10 * l;
        if (IN(pb + 0)) { ph_ln(ws, l); } SEAM(pb + 0);
        if (IN(pb + 1)) { ph_gemm_in(ws, l); if (MK_DUP & 2) { GRID_BAR(); ph_gemm_in(ws, l); } } SEAM(pb + 1);
        if (IN(pb + 2)) { ph_post(ws, l); } SEAM(pb + 2);
        if (IN(pb + 3)) { ph_gemm_mla(ws, l); if (MK_DUP & 8) { GRID_BAR(); ph_gemm_mla(ws, l); } } SEAM(pb + 3);
        if (IN(pb + 4)) { ph_attn(ws, l); if (MK_DUP & 16) { GRID_BAR(); ph_attn(ws, l + 4); } } SEAM(pb + 4);
        if (IN(pb + 5)) { ph_gemm_out(ws, l); if (MK_DUP & 32) { GRID_BAR(); ph_gemm_out(ws, l); } } SEAM(pb + 5);
        if (IN(pb + 6)) { ph_route(ws, l); } SEAM(pb + 6);
        if (IN(pb + 7)) { ph_permute(ws); if (MK_DUP & 128) { GRID_BAR(); ph_permute(ws); } } SEAM(pb + 7);
        if (IN(pb + 8)) { ph_gemm_gu(ws, l); if (MK_DUP & 256) { GRID_BAR(); ph_gemm_gu(ws, l); } } SEAM(pb + 8);
        if (IN(pb + 9)) { ph_gemm_dn(ws, l); if (MK_DUP & 512) { GRID_BAR(); ph_gemm_dn(ws, l); } } SEAM(pb + 9);
    }
    if (IN(NPHASE - 1)) { ph_ln(ws, NL); }
#undef IN
#undef SEAM
#undef GRID_BAR
}

extern "C" void kernel_launch(void* const* d_in, const int* in_sizes, int n_in, void* d_out, int out_size, void* d_ws, size_t ws_size, hipStream_t stream) {
    static int grid = 0;
    if (grid == 0) {
        if (n_in != 27 || out_size != NB * SEQ * D || ws_size < WS_END) { fprintf(stderr, "kernel_launch: unexpected problem (n_in %d, out %d, ws %zu < %zu)\n", n_in, out_size, ws_size, (size_t)WS_END); grid = -1; return; }
        int dev = 0, cus = 0, per_cu = 0;
        if (hipGetDevice(&dev) != hipSuccess || hipDeviceGetAttribute(&cus, hipDeviceAttributeMultiprocessorCount, dev) != hipSuccess) { grid = -1; return; }
        if (hipFuncSetAttribute((const void*)mk_fwd, hipFuncAttributeMaxDynamicSharedMemorySize, LDS_BYTES) != hipSuccess) { fprintf(stderr, "kernel_launch: hipFuncSetAttribute failed\n"); grid = -1; return; }
        if (hipOccupancyMaxActiveBlocksPerMultiprocessor(&per_cu, (const void*)mk_fwd, NTHR, LDS_BYTES) != hipSuccess || per_cu < 1) fprintf(stderr, "kernel_launch: occupancy query reports %d\n", per_cu);
        (void)hipGetLastError();
        grid = cus > 1024 ? 1024 : cus;
    }
    if (grid < 0) return;
    (void)hipMemsetAsync((char*)d_ws + WS_CTL, 0, CTL_BYTES, stream);
    Args a{};
    for (int i = 0; i < 27; ++i) a.in[i] = (const float*)d_in[i];
    a.out = (float*)d_out; a.ws = (unsigned char*)d_ws;
#if MK_MULTI
#ifndef DBG_NRUN
#define DBG_NRUN NPHASE
#endif
    for (int p = 0; p < DBG_NRUN; ++p) { a.ph_lo = p; a.ph_hi = p + 1; hipLaunchKernelGGL(mk_fwd, dim3(grid), dim3(NTHR), LDS_BYTES, stream, a); }
#ifdef DBG_DUMP
    a.ph_lo = 100 + DBG_DUMP; a.ph_hi = 101 + DBG_DUMP; hipLaunchKernelGGL(mk_fwd, dim3(grid), dim3(NTHR), LDS_BYTES, stream, a);
#endif
#else
    a.ph_lo = 0; a.ph_hi = NPHASE;
    hipLaunchKernelGGL(mk_fwd, dim3(grid), dim3(NTHR), LDS_BYTES, stream, a);
#endif
}
```

```cpp
#include <hip/hip_runtime.h>
#include <cstdio>
#include <cstdint>
namespace pg8 {
#define PG8_LAS __attribute__((address_space(3)))
typedef unsigned short bf16_t;
typedef short bf16x8 __attribute__((ext_vector_type(8)));
typedef float f32x4 __attribute__((ext_vector_type(4)));
typedef unsigned u32x4 __attribute__((ext_vector_type(4)));
constexpr int BM = 256, BK = 64, HALF = 128, HTB = HALF * BK * 2  , STAGE_BYTES = 8 * HTB, NXCD = 8, WGM = 8;

__host__ __device__ __forceinline__ int lds_byte(int r, int c) { const int st = (r >> 4) * 2 + (c >> 5), rr = r & 15, cc = c & 31, ob = rr * 64 + cc * 2; return st * 1024 + (ob ^ (((ob >> 9) & 1) << 5)); }
__host__ __device__ __forceinline__ void stage_rc(int b, int& R, int& C) { const int st = b / 1024, sb = b % 1024, swz = sb ^ (((sb >> 9) & 1) << 5); R = (st >> 1) * 16 + swz / 64; C = (st & 1) * 32 + (swz % 64) / 2; }
__host__ __device__ __forceinline__ int perm32(int rho) { const int n = rho >> 4, i = rho & 15; return 8 * (i >> 2) + 4 * n + (i & 3); }

struct Unit { int pm, pn; };
struct Gemm { const bf16_t* A; const bf16_t* Bt; int M, N, K, lda; const int* src; };

struct StaticOrder {
    int nM, nN, nwg, G, c;
    __host__ __device__ void init(int M, int N, int G_, int c_) { nM = M / BM; nN = N / BM; nwg = nM * nN; G = G_; c = c_; }
    __host__ __device__ bool next(int i, Unit& u) const {
        const long L = (long)i * G + c; if (L >= nwg) return false;
        int wgid = (int)L; { const int q = nwg / NXCD, r = nwg % NXCD, xcd = wgid % NXCD, off = wgid / NXCD; wgid = (xcd < r ? xcd * (q + 1) : r * (q + 1) + (xcd - r) * q) + off; }
        const int nig = WGM * nN, gid = wgid / nig, fm = gid * WGM, gsz = (nM - fm) < WGM ? (nM - fm) : WGM;
        u.pm = fm + ((wgid % nig) % gsz); u.pn = (wgid % nig) / gsz; return true;
    }
    __device__ __forceinline__ void a_ready(const Unit&) const {}
    __device__ __forceinline__ void done(const Unit&) const {}
};

__device__ __forceinline__ unsigned cvt_pk_bf16(float lo, float hi) { unsigned r; asm volatile("v_cvt_pk_bf16_f32 %0, %1, %2" : "=v"(r) : "v"(lo), "v"(hi)); return r; }
typedef float f32x2 __attribute__((ext_vector_type(2)));
__device__ __forceinline__ f32x2 gelu_pk(f32x2 v) {
    const f32x2 av = __builtin_elementwise_abs(v), d = av * 0.2316418882f + 1.0f;
    f32x2 t; t.x = __builtin_amdgcn_rcpf(d.x); t.y = __builtin_amdgcn_rcpf(d.y);
    f32x2 q = t * 0.5307027145f + (-0.7265760135f); q = q * t + 0.7107068705f; q = q * t + (-0.142248368f); q = q * t + 0.127414796f; q = q * t;
    const f32x2 s = (v * v) * (-0.72134752044f);
    f32x2 e; e.x = __builtin_amdgcn_exp2f(s.x); e.y = __builtin_amdgcn_exp2f(s.y);
    const f32x2 m = v * (q * e), r = v - m;
    f32x2 o; o.x = v.x < 0.f ? m.x : r.x; o.y = v.y < 0.f ? m.y : r.y; return o;
}

template <int ACT  > struct EpiBf16 {
    static constexpr bool PERM = true, AFTER_DRAIN = false; static_assert(ACT == 0 || ACT == 1, "EpiBf16: ACT is 0 (none) or 1 (gelu_pk)");
    bf16_t* O; int ldc; const float* bias; int split_cols; size_t split_stride; float scale0;
    __device__ __forceinline__ void operator()(const f32x4 (&acc)[2][2][4][2], const Unit& u, int wr, int wc, int fr, int fq) const {
        const int row0 = u.pm * BM + wr * 64 + fr; int colt = u.pn * BM; bf16_t* base = O;
        float sc = 1.f; if (split_cols) { const int t = colt / split_cols; base += (size_t)t * split_stride; colt -= t * split_cols; if (t == 0) sc = scale0; }
        const int col0 = colt + wc * 32 + 8 * fq, bcol0 = u.pn * BM + wc * 32 + 8 * fq;
        f32x4 bv[2][2];
#pragma unroll
        for (int bj = 0; bj < 2; ++bj)
#pragma unroll
            for (int n = 0; n < 2; ++n) bv[bj][n] = bias ? *(const f32x4*)(bias + bcol0 + bj * HALF + 4 * n) : (f32x4){0.f, 0.f, 0.f, 0.f};
#pragma unroll
        for (int ai = 0; ai < 2; ++ai)
#pragma unroll
            for (int m = 0; m < 4; ++m) { bf16_t* rowp = base + (size_t)(row0 + ai * HALF + m * 16) * ldc + col0;
#pragma unroll
                for (int bj = 0; bj < 2; ++bj) { f32x4 v0 = acc[ai][bj][m][0] + bv[bj][0], v1 = acc[ai][bj][m][1] + bv[bj][1];
                    if (ACT == 1) { f32x2 a = gelu_pk((f32x2){v0[0], v0[1]}), b = gelu_pk((f32x2){v0[2], v0[3]}), c = gelu_pk((f32x2){v1[0], v1[1]}), d = gelu_pk((f32x2){v1[2], v1[3]});
                        v0 = (f32x4){a.x, a.y, b.x, b.y}; v1 = (f32x4){c.x, c.y, d.x, d.y}; }
                    v0 = v0 * sc; v1 = v1 * sc; u32x4 w; w.x = cvt_pk_bf16(v0[0], v0[1]); w.y = cvt_pk_bf16(v0[2], v0[3]); w.z = cvt_pk_bf16(v1[0], v1[1]); w.w = cvt_pk_bf16(v1[2], v1[3]);
                    *(u32x4*)(rowp + bj * HALF) = w; } }
    }
};
template <int ACT  > struct EpiBf16NT {
    static constexpr bool PERM = true, AFTER_DRAIN = false; static_assert(ACT == 0 || ACT == 1, "EpiBf16: ACT is 0 (none) or 1 (gelu_pk)");
    bf16_t* O; int ldc; const float* bias; int split_cols; size_t split_stride; float scale0;
    __device__ __forceinline__ void operator()(const f32x4 (&acc)[2][2][4][2], const Unit& u, int wr, int wc, int fr, int fq) const {
        const int row0 = u.pm * BM + wr * 64 + fr; int colt = u.pn * BM; bf16_t* base = O;
        float sc = 1.f; if (split_cols) { const int t = colt / split_cols; base += (size_t)t * split_stride; colt -= t * split_cols; if (t == 0) sc = scale0; }
        const int col0 = colt + wc * 32 + 8 * fq, bcol0 = u.pn * BM + wc * 32 + 8 * fq;
        f32x4 bv[2][2];
#pragma unroll
        for (int bj = 0; bj < 2; ++bj)
#pragma unroll
            for (int n = 0; n < 2; ++n) bv[bj][n] = bias ? *(const f32x4*)(bias + bcol0 + bj * HALF + 4 * n) : (f32x4){0.f, 0.f, 0.f, 0.f};
#pragma unroll
        for (int ai = 0; ai < 2; ++ai)
#pragma unroll
            for (int m = 0; m < 4; ++m) { bf16_t* rowp = base + (size_t)(row0 + ai * HALF + m * 16) * ldc + col0;
#pragma unroll
                for (int bj = 0; bj < 2; ++bj) { f32x4 v0 = acc[ai][bj][m][0] + bv[bj][0], v1 = acc[ai][bj][m][1] + bv[bj][1];
                    if (ACT == 1) { f32x2 a = gelu_pk((f32x2){v0[0], v0[1]}), b = gelu_pk((f32x2){v0[2], v0[3]}), c = gelu_pk((f32x2){v1[0], v1[1]}), d = gelu_pk((f32x2){v1[2], v1[3]});
                        v0 = (f32x4){a.x, a.y, b.x, b.y}; v1 = (f32x4){c.x, c.y, d.x, d.y}; }
                    v0 = v0 * sc; v1 = v1 * sc; u32x4 w; w.x = cvt_pk_bf16(v0[0], v0[1]); w.y = cvt_pk_bf16(v0[2], v0[3]); w.z = cvt_pk_bf16(v1[0], v1[1]); w.w = cvt_pk_bf16(v1[2], v1[3]);
                    __builtin_nontemporal_store(w, (u32x4*)(rowp + bj * HALF)); } }
    }
};
struct EpiF32 {
    static constexpr bool PERM = false, AFTER_DRAIN = false;
    float* C; int ldc; const float* bias;
    __device__ __forceinline__ void operator()(const f32x4 (&acc)[2][2][4][2], const Unit& u, int wr, int wc, int fr, int fq) const {
        const int row0 = u.pm * BM + wr * 64 + fr, col0 = u.pn * BM + wc * 32 + 4 * fq;
        f32x4 bv[2][2];
#pragma unroll
        for (int bj = 0; bj < 2; ++bj)
#pragma unroll
            for (int n = 0; n < 2; ++n) bv[bj][n] = bias ? *(const f32x4*)(bias + col0 + bj * HALF + n * 16) : (f32x4){0.f, 0.f, 0.f, 0.f};
#pragma unroll
        for (int ai = 0; ai < 2; ++ai)
#pragma unroll
            for (int m = 0; m < 4; ++m) { float* rowp = C + (size_t)(row0 + ai * HALF + m * 16) * ldc + col0;
#pragma unroll
                for (int bj = 0; bj < 2; ++bj)
#pragma unroll
                    for (int n = 0; n < 2; ++n) *(f32x4*)(rowp + bj * HALF + n * 16) = acc[ai][bj][m][n] + bv[bj][n]; }
    }
};
template <class Epi, class Sched, bool ALIGN_EPI = false, bool SP2 = false, bool GATHER = false>
__device__ __forceinline__ void gemm_phase(PG8_LAS unsigned char* lds, const Gemm g, const Sched& S, const Epi& E) {
    int tid = threadIdx.x; asm volatile("" : "+v"(tid)); const int wid = __builtin_amdgcn_readfirstlane(tid >> 6), lane = tid & 63, wr = wid >> 2, wc = wid & 3, fr = lane & 15, fq = lane >> 4;
    const int K = g.K, nt = K / BK;
    unsigned voffA[2], voffB[2]; int RA[2]; unsigned CA2[2];
#pragma unroll
    for (int i = 0; i < 2; ++i) { int R, C; stage_rc(tid * 16 + i * 8192, R, C); const int Rb = Epi::PERM ? ((R & ~31) + perm32(R & 31)) : R;
        voffA[i] = (unsigned)(R * g.lda + C) * 2u; voffB[i] = (unsigned)(Rb * K + C) * 2u; RA[i] = R; CA2[i] = (unsigned)C * 2u; }
    unsigned gcur[2][2] = {{0u, 0u}, {0u, 0u}}, gnxt[2][2] = {{0u, 0u}, {0u, 0u}};
#define PG8_GOFF(dst, u_) do { _Pragma("unroll") for (int h_ = 0; h_ < 2; ++h_) _Pragma("unroll") for (int i_ = 0; i_ < 2; ++i_) \
        dst[h_][i_] = (unsigned)g.src[(u_).pm * BM + h_ * HALF + RA[i_]] * (unsigned)(g.lda * 2) + CA2[i_]; } while (0)
#define PG8_STAGE_A(bufoff, gbase, h, nx) do { if constexpr (GATHER) { unsigned vs_[2] = {(nx) ? gnxt[h][0] : gcur[h][0], (nx) ? gnxt[h][1] : gcur[h][1]}; PG8_STAGE(bufoff, gbase, vs_); } \
        else { PG8_STAGE(bufoff, (gbase) + ((h) ? hstepA : 0), voffA); } } while (0)
    const size_t kstep = (size_t)(BK * 2);
    const size_t hstepA = (size_t)HALF * g.lda * 2, hstepB = (size_t)HALF * K * 2;
    const size_t tstepA = 2 * hstepA, tstepB = 2 * hstepB;
    const unsigned ldsw = (unsigned)wid * 1024u;
    const int aoff = lds_byte(wr * 64 + fr, fq * 8), boff = lds_byte(wc * 32 + fr, fq * 8);
#define PG8_SA(b, h) (((b) * 2 + (h)) * HTB)
#define PG8_SB(b, h) ((4 + (b) * 2 + (h)) * HTB)
#define PG8_STAGE(bufoff, gbase, voff) do { _Pragma("unroll") for (int _i = 0; _i < 2; ++_i) \
        __builtin_amdgcn_global_load_lds((const unsigned*)((const char*)(gbase) + (voff)[_i]), (PG8_LAS unsigned*)(lds + (bufoff) + ldsw + _i * 8192), 16, 0, 0); } while (0)
#define PG8_LDA(dst, b, h) do { _Pragma("unroll") for (int m = 0; m < 4; ++m) _Pragma("unroll") for (int k = 0; k < 2; ++k) dst[m][k] = *(const PG8_LAS bf16x8*)(lds + PG8_SA(b, h) + aoff + m * 2048 + k * 1024); } while (0)
#define PG8_LDB(dst, b, h) do { _Pragma("unroll") for (int n = 0; n < 2; ++n) _Pragma("unroll") for (int k = 0; k < 2; ++k) dst[n][k] = *(const PG8_LAS bf16x8*)(lds + PG8_SB(b, h) + boff + n * 2048 + k * 1024); } while (0)
#define PG8_MMA(ai, bj, At, Bt) do { __builtin_amdgcn_s_setprio(1); _Pragma("unroll") for (int m = 0; m < 4; ++m) _Pragma("unroll") for (int n = 0; n < 2; ++n) _Pragma("unroll") for (int k = 0; k < 2; ++k) \
        acc[ai][bj][m][n] = __builtin_amdgcn_mfma_f32_16x16x32_bf16(Bt[n][k], At[m][k], acc[ai][bj][m][n], 0, 0, 0); __builtin_amdgcn_s_setprio(0); } while (0)
#define PG8_WAIT_V(n) asm volatile("s_waitcnt vmcnt(" #n ")" ::: "memory")
#define PG8_WAIT_L(n) asm volatile("s_waitcnt lgkmcnt(" #n ")" ::: "memory")
#define PG8_BAR __builtin_amdgcn_s_barrier()
#define PG8_SCHED __builtin_amdgcn_sched_barrier(0)
    Unit cur, nxt; int ui = 0;
    if (!S.next(0, cur)) return;
    f32x4 acc[2][2][4][2];
#pragma unroll
    for (int a = 0; a < 2; ++a)
#pragma unroll
        for (int b = 0; b < 2; ++b)
#pragma unroll
            for (int m = 0; m < 4; ++m)
#pragma unroll
                for (int n = 0; n < 2; ++n) acc[a][b][m][n] = (f32x4){0.f, 0.f, 0.f, 0.f};
    bf16x8 At[4][2], B0[2][2], B1[2][2];
    const char* cA = (const char*)g.A + (GATHER ? (size_t)0 : (size_t)cur.pm * tstepA); const char* cB = (const char*)g.Bt + (size_t)cur.pn * tstepB;
    if constexpr (GATHER) PG8_GOFF(gcur, cur);
    S.a_ready(cur);
    if constexpr (SP2) {
        PG8_STAGE(PG8_SB(0, 0), cB, voffB); PG8_STAGE(PG8_SB(0, 1), cB + hstepB, voffB); PG8_STAGE_A(PG8_SA(0, 0), cA, 0, false); PG8_STAGE_A(PG8_SA(0, 1), cA, 1, false);
        if (wr == 1) PG8_BAR;
        PG8_WAIT_V(2); PG8_BAR;
        PG8_STAGE(PG8_SB(1, 0), cB + kstep, voffB); PG8_STAGE_A(PG8_SA(1, 0), cA + kstep, 0, false); PG8_STAGE(PG8_SB(1, 1), cB + hstepB + kstep, voffB);
        PG8_WAIT_V(6); PG8_BAR;
    } else {
        PG8_STAGE(PG8_SB(0, 0), cB, voffB); PG8_STAGE_A(PG8_SA(0, 0), cA, 0, false); PG8_STAGE(PG8_SB(0, 1), cB + hstepB, voffB); PG8_STAGE_A(PG8_SA(0, 1), cA, 1, false);
        if (wr == 1) PG8_BAR;
        PG8_WAIT_V(4); PG8_BAR;
        PG8_STAGE(PG8_SB(1, 0), cB + kstep, voffB); PG8_STAGE_A(PG8_SA(1, 0), cA + kstep, 0, false); PG8_STAGE(PG8_SB(1, 1), cB + hstepB + kstep, voffB);
        PG8_WAIT_V(6); PG8_BAR;
    }
    for (;;) {
        const bool has_next = S.next(ui + 1, nxt);
        const char* nA = (has_next && !GATHER) ? (const char*)g.A + (size_t)nxt.pm * tstepA : cA; const char* nB = has_next ? (const char*)g.Bt + (size_t)nxt.pn * tstepB : cB;
        if constexpr (GATHER) { if (has_next) PG8_GOFF(gnxt, nxt); else { _Pragma("unroll") for (int h_ = 0; h_ < 2; ++h_) { gnxt[h_][0] = gcur[h_][0]; gnxt[h_][1] = gcur[h_][1]; } } }
#pragma unroll 1
        for (int t = 0; t < nt; t += 2) {
            const bool last = (t == nt - 2);
            const char* a1 = cA + (size_t)(t + 1) * kstep;
            const char* a2 = last ? nA : cA + (size_t)(t + 2) * kstep; const char* b2 = last ? nB : cB + (size_t)(t + 2) * kstep;
            const char* a3 = a2 + kstep; const char* b3 = b2 + kstep;
            if (last && has_next) S.a_ready(nxt);
            if constexpr (SP2) {
            PG8_LDB(B0, 0, 0); PG8_LDB(B1, 0, 1); PG8_SCHED; PG8_LDA(At, 0, 0); PG8_STAGE_A(PG8_SA(1, 1), a1, 1, false);
            PG8_WAIT_V(8); PG8_WAIT_L(0); PG8_BAR; PG8_MMA(0, 0, At, B0); PG8_MMA(0, 1, At, B1); PG8_BAR; PG8_SCHED;
            PG8_LDA(At, 0, 1); PG8_STAGE(PG8_SB(0, 0), b2, voffB); PG8_STAGE(PG8_SB(0, 1), b2 + hstepB, voffB); PG8_STAGE_A(PG8_SA(0, 0), a2, 0, last);
            PG8_WAIT_V(8); PG8_WAIT_L(0); PG8_BAR; PG8_MMA(1, 0, At, B0); PG8_MMA(1, 1, At, B1); PG8_BAR; PG8_SCHED;
            PG8_LDB(B0, 1, 0); PG8_LDB(B1, 1, 1); PG8_SCHED; PG8_LDA(At, 1, 0); PG8_STAGE_A(PG8_SA(0, 1), a2, 1, last);
            PG8_WAIT_V(8); PG8_WAIT_L(0); PG8_BAR; PG8_MMA(0, 0, At, B0); PG8_MMA(0, 1, At, B1); PG8_BAR; PG8_SCHED;
            PG8_LDA(At, 1, 1); PG8_STAGE(PG8_SB(1, 0), b3, voffB); PG8_STAGE(PG8_SB(1, 1), b3 + hstepB, voffB); PG8_STAGE_A(PG8_SA(1, 0), a3, 0, last);
            PG8_WAIT_V(8); PG8_WAIT_L(0); PG8_BAR; PG8_MMA(1, 0, At, B0); PG8_MMA(1, 1, At, B1); PG8_BAR; PG8_SCHED;
            } else {
            PG8_LDB(B0, 0, 0); PG8_SCHED; PG8_LDA(At, 0, 0); PG8_STAGE_A(PG8_SA(1, 1), a1, 1, false);
            PG8_WAIT_L(8); PG8_BAR; PG8_WAIT_L(0); PG8_MMA(0, 0, At, B0); PG8_BAR; PG8_SCHED;
            PG8_LDB(B1, 0, 1); PG8_STAGE(PG8_SB(0, 0), b2, voffB);
            PG8_BAR; PG8_WAIT_L(0); PG8_MMA(0, 1, At, B1); PG8_BAR;
            PG8_LDA(At, 0, 1); PG8_STAGE_A(PG8_SA(0, 0), a2, 0, last);
            PG8_BAR; PG8_WAIT_L(0); PG8_MMA(1, 0, At, B0); PG8_BAR; PG8_SCHED;
            PG8_STAGE(PG8_SB(0, 1), b2 + hstepB, voffB);
            PG8_WAIT_V(6); PG8_BAR; PG8_MMA(1, 1, At, B1); PG8_BAR;
            PG8_LDB(B0, 1, 0); PG8_SCHED; PG8_LDA(At, 1, 0); PG8_STAGE_A(PG8_SA(0, 1), a2, 1, last);
            PG8_WAIT_L(8); PG8_BAR; PG8_WAIT_L(0); PG8_MMA(0, 0, At, B0); PG8_BAR; PG8_SCHED;
            PG8_LDB(B1, 1, 1); PG8_STAGE(PG8_SB(1, 0), b3, voffB);
            PG8_BAR; PG8_WAIT_L(0); PG8_MMA(0, 1, At, B1); PG8_BAR;
            PG8_LDA(At, 1, 1); PG8_STAGE_A(PG8_SA(1, 0), a3, 0, last);
            PG8_BAR; PG8_WAIT_L(0); PG8_MMA(1, 0, At, B0); PG8_BAR; PG8_SCHED;
            PG8_STAGE(PG8_SB(1, 1), b3 + hstepB, voffB);
            PG8_WAIT_V(6); PG8_BAR; PG8_MMA(1, 1, At, B1); PG8_BAR;
            }
        }
        if constexpr (ALIGN_EPI) { if (wr == 0) PG8_BAR; }
        if constexpr (!Epi::AFTER_DRAIN) { E(acc, cur, wr, wc, fr, fq); S.done(cur); }
        if (!has_next) break;
#pragma unroll
        for (int a = 0; a < 2; ++a)
#pragma unroll
            for (int b = 0; b < 2; ++b)
#pragma unroll
                for (int m = 0; m < 4; ++m)
#pragma unroll
                    for (int n = 0; n < 2; ++n) acc[a][b][m][n] = (f32x4){0.f, 0.f, 0.f, 0.f};
        cur = nxt; cA = nA; cB = nB; ++ui;
        if constexpr (GATHER) { _Pragma("unroll") for (int h_ = 0; h_ < 2; ++h_) { gcur[h_][0] = gnxt[h_][0]; gcur[h_][1] = gnxt[h_][1]; } }
        if constexpr (ALIGN_EPI) { if (wr == 1) PG8_BAR; }
    }
    PG8_WAIT_V(0);
    if constexpr (!ALIGN_EPI) { if (wr == 0) PG8_BAR; }
    PG8_BAR;
    if constexpr (Epi::AFTER_DRAIN) { E.fused(acc, cur, wr, wc, fr, fq, lds, wid, lane); S.done(cur); }
#undef PG8_SA
#undef PG8_GOFF
#undef PG8_STAGE_A
#undef PG8_SB
#undef PG8_STAGE
#undef PG8_LDA
#undef PG8_LDB
#undef PG8_MMA
#undef PG8_WAIT_V
#undef PG8_WAIT_L
#undef PG8_BAR
#undef PG8_SCHED
}
}

constexpr int NB = 16, SEQ = 4096, CTX = 256, TT = SEQ + CTX, M = NB * TT, D = 1024, NL = 4;
constexpr int NPJ = 2304, DPROJ = 2208;
constexpr int MS = 143360;
constexpr float EPS = 1e-6f, ALPHA = 1.6817928305074290f, LOG2E = 1.4426950408889634f;
constexpr int NWAVES = 8, NTHR = 512;
#ifndef MK_DEBUG
#define MK_DEBUG 0
#endif
#ifndef MK_TIME
#define MK_TIME 0
#endif
#ifndef MK_TMUL
#define MK_TMUL 1
#endif
#ifndef MK_VM
#define MK_VM 0
#endif
#ifndef MK_DUP
#define MK_DUP 0
#endif
#ifndef MK_MULTI
#define MK_MULTI 0
#endif
constexpr int NPHASE = 2 + 10 * NL;

constexpr size_t WS_CTL = 0, CTL_BYTES = 65536;
constexpr size_t WS_MODS = WS_CTL + CTL_BYTES;
constexpr size_t WS_T64 = WS_MODS + (size_t)NL * 17 * 6144 * 4;
constexpr size_t WS_T32 = WS_T64 + 8192;
constexpr size_t WS_RS = WS_T32 + 4096;
constexpr size_t WS_RT = WS_RS + (size_t)M * 8;
constexpr size_t WS_HIST = WS_RT + (size_t)M * 32;
constexpr size_t WS_XC = WS_HIST + 65536;
constexpr size_t WS_WIN = WS_XC + (size_t)NB * CTX * D * 4;
constexpr size_t WS_WD = WS_WIN + (size_t)NL * NPJ * D * 2;
constexpr size_t WS_WOUT = WS_WD + (size_t)NL * 1024 * 384 * 2;
constexpr size_t WS_WGU = WS_WOUT + (size_t)NL * D * D * 2;
constexpr size_t WS_WDN = WS_WGU + (size_t)NL * 16 * 1024 * 1024 * 2;
constexpr size_t WS_HA = WS_WDN + (size_t)NL * 16 * 1024 * 512 * 2;
constexpr size_t WS_PB = WS_HA + (size_t)M * D * 2;
constexpr size_t WS_QD = WS_PB + (size_t)M * NPJ * 2;
constexpr size_t WS_KD = WS_QD + (size_t)M * 384 * 2;
constexpr size_t WS_VD = WS_KD + (size_t)M * 384 * 2;
constexpr size_t WS_ACT = WS_VD + (size_t)M * 256 * 2;
constexpr size_t WS_END = WS_ACT + (size_t)MS * 512 * 2;
static_assert(WS_END <= (size_t)1073741824, "d_ws map must fit 1 GiB");
static_assert((size_t)M * NPJ * 2 >= (size_t)MS * D * 2 && (size_t)M * NPJ * 2 >= (size_t)M * D * 4, "region PB overlays");
constexpr int CW_BAR = 0;
constexpr int CW_QUEUE = 4096;

constexpr int RING_BYTES = 131072, MISC_OFF = RING_BYTES, LDS_BYTES = 147456;
constexpr int MI_BAR = 0, MI_Q = 4, MI_TOT = 16, MI_BASE = 32, MI_PST = 48, MI_LH = 80;

#define GAS __attribute__((address_space(1)))
#define LAS __attribute__((address_space(3)))
typedef unsigned short bf16;
typedef unsigned v4u __attribute__((ext_vector_type(4)));
typedef unsigned v2u __attribute__((ext_vector_type(2)));
typedef float f32x4 __attribute__((ext_vector_type(4)));
typedef float f32x2 __attribute__((ext_vector_type(2)));
typedef short bf16x8 __attribute__((ext_vector_type(8)));
typedef float f32x16 __attribute__((ext_vector_type(16)));
typedef short v4i16 __attribute__((ext_vector_type(4)));

__device__ __forceinline__ unsigned f2bf(float f) { unsigned u = __builtin_bit_cast(unsigned, f); return (u + 0x7fffu + ((u >> 16) & 1u)) >> 16; }
__device__ __forceinline__ unsigned pk2(float lo, float hi) { return f2bf(lo) | (f2bf(hi) << 16); }
__device__ __forceinline__ float bflo(unsigned w) { return __builtin_bit_cast(float, w << 16); }
__device__ __forceinline__ float bfhi(unsigned w) { return __builtin_bit_cast(float, w & 0xffff0000u); }
__device__ __forceinline__ void unpack8(v4u w, float (&f)[8]) { f[0] = bflo(w.x); f[1] = bfhi(w.x); f[2] = bflo(w.y); f[3] = bfhi(w.y); f[4] = bflo(w.z); f[5] = bfhi(w.z); f[6] = bflo(w.w); f[7] = bfhi(w.w); }
__device__ __forceinline__ v4u pack8(const float (&f)[8]) { v4u w; w.x = pk2(f[0], f[1]); w.y = pk2(f[2], f[3]); w.z = pk2(f[4], f[5]); w.w = pk2(f[6], f[7]); return w; }
__device__ __forceinline__ float wave_sum(float v) {
    int x = __builtin_bit_cast(int, v);
#define WS_DPP(ctrl, rmask) v += __builtin_bit_cast(float, __builtin_amdgcn_update_dpp(0, x, ctrl, rmask, 0xf, true)); x = __builtin_bit_cast(int, v)
    WS_DPP(0xB1, 0xf);
    WS_DPP(0x4E, 0xf);
    WS_DPP(0x141, 0xf);
    WS_DPP(0x140, 0xf);
    WS_DPP(0x142, 0xa);
    WS_DPP(0x143, 0xc);
#undef WS_DPP
    return __builtin_bit_cast(float, __builtin_amdgcn_readlane(__builtin_bit_cast(int, v), 63));
}

#define XB_TMO      128
#define XB_XCNT(j)  (256  + 64 * (j))
#define XB_XSUB(j)  (1280 + 64 * (j))
#define XB_XGEN(j)  (2304 + 64 * (j))
#define XB_TOP      3328
#define XB_TOPGEN   3392
#define XCD_BAR_WORDS 3456
#define XB_SPIN_CAP (1u << 22)
__device__ __forceinline__ unsigned xb_ld(unsigned* p)              { return __hip_atomic_load(p, __ATOMIC_RELAXED, __HIP_MEMORY_SCOPE_AGENT); }
__device__ __forceinline__ unsigned xb_add(unsigned* p, unsigned v) { return __hip_atomic_fetch_add(p, v, __ATOMIC_RELAXED, __HIP_MEMORY_SCOPE_AGENT); }
__device__ __forceinline__ unsigned xb_xcc_id() { return (unsigned)__builtin_amdgcn_s_getreg((3 << 11) | 20) & 0xFu; }
#define XB_SPIN(cond, bar) do { unsigned _sp = 0; while (cond) { __builtin_amdgcn_s_sleep(1); \
    if ((++_sp & 255u) == 0u) { if (xb_ld(&(bar)[XB_TMO])) break; if (_sp > XB_SPIN_CAP) { atomicAdd(&(bar)[XB_TMO], 1u); break; } } } } while (0)
struct XcdBarrier { unsigned* bar; unsigned x; volatile LAS unsigned* st; };
__device__ __forceinline__ XcdBarrier xcd_barrier_post(unsigned* bar, volatile LAS unsigned* st) {
    XcdBarrier b; b.bar = bar; b.x = xb_xcc_id(); b.st = st;
    if (threadIdx.x == 0) (void)xb_add(&bar[XB_XCNT(b.x)], 1u);
    return b;
}
__device__ __forceinline__ void xcd_barrier_complete(unsigned* bar, unsigned x, unsigned& nloc, unsigned& nx) {
    const unsigned G = gridDim.x * gridDim.y * gridDim.z;
    unsigned sum, cnt, mine, sp = 0u;
    for (;;) {
        sum = 0u; cnt = 0u; mine = 0u;
#pragma unroll
        for (unsigned j = 0; j < 16; ++j) { const unsigned c = xb_ld(&bar[XB_XCNT(j)]); sum += c; cnt += (c > 0u) ? 1u : 0u; mine = (j == x) ? c : mine; }
        if (sum == G) break;
        __builtin_amdgcn_s_sleep(1);
        if ((++sp & 255u) == 0u) { if (xb_ld(&bar[XB_TMO])) break; if (sp > XB_SPIN_CAP) { atomicAdd(&bar[XB_TMO], 1u); break; } }
    }
    nloc = mine > 0u ? mine : 1u; nx = cnt > 0u ? cnt : 1u;
}
__device__ __forceinline__ void xcd_barrier(const XcdBarrier& b) {
    asm volatile("s_waitcnt vmcnt(0)" ::: "memory");
    __syncthreads();
    if (threadIdx.x == 0) {
        unsigned* bar = b.bar;
        __builtin_amdgcn_s_waitcnt(0);
        unsigned nloc = b.st[0], nx = b.st[1];
        if (nloc == 0u) { xcd_barrier_complete(bar, b.x, nloc, nx); b.st[0] = nloc; b.st[1] = nx; }
        const unsigned old = xb_add(&bar[XB_XSUB(b.x)], 1u);
        const unsigned gen = old / nloc;
        if (old + 1u == (gen + 1u) * nloc) {
            __builtin_amdgcn_fence(__ATOMIC_RELEASE, "agent");
            asm volatile("s_waitcnt vmcnt(0)" ::: "memory");
            const unsigned og = xb_add(&bar[XB_TOP], 1u);
            const unsigned tg = og / nx;
            if (og + 1u == (tg + 1u) * nx) xb_add(&bar[XB_TOPGEN], 1u);
            else XB_SPIN(xb_ld(&bar[XB_TOPGEN]) == tg, bar);
            __builtin_amdgcn_fence(__ATOMIC_ACQUIRE, "agent");
            xb_add(&bar[XB_XGEN(b.x)], 1u);
            asm volatile("s_waitcnt vmcnt(0)" ::: "memory");
        } else {
            XB_SPIN(xb_ld(&bar[XB_XGEN(b.x)]) == gen, bar);
            __builtin_amdgcn_fence(__ATOMIC_ACQUIRE, "agent");
            asm volatile("s_waitcnt vmcnt(0)" ::: "memory");
        }
    }
    __syncthreads();
}

struct Args { const float* in[27]; float* out; unsigned char* ws; int ph_lo, ph_hi; };
enum { I_X = 0, I_C, I_CTX, I_CCTX, I_WADA, I_BADA, I_WIN, I_NABIAS, I_GQG, I_GKG, I_SINK, I_MQG, I_WQB, I_MKVG, I_WKVB, I_WOUT, I_LN1G, I_LN1B, I_RGW, I_RGB, I_REW, I_REB, I_WG, I_WU, I_WDN, I_LN2G, I_LN2B };

struct Frame {
    LAS unsigned char* lds; volatile LAS unsigned* MISC;
    int tid, lane, wave, G, gw, ngw, bid;
    GAS unsigned char* ws;
};
__device__ __forceinline__ int opaque_tid() { int t = threadIdx.x; asm volatile("" : "+v"(t)); return t; }
__device__ __forceinline__ int opaque_s(int x) { asm volatile("" : "+s"(x)); return x; }
constexpr int PTAB_OFF = MISC_OFF + 2048, I_OUT = 27;
__device__ __forceinline__ GAS unsigned char* ptab_get(const Frame& F, int i) {
    const LAS unsigned* t = (const LAS unsigned*)(F.lds + PTAB_OFF) + 2 * i;
    const unsigned lo = __builtin_amdgcn_readfirstlane(t[0]), hi = __builtin_amdgcn_readfirstlane(t[1]);
    return (GAS unsigned char*)(((unsigned long long)hi << 32) | lo);
}
#define INP(i) ((const float*)ptab_get(F, (i)))
__device__ __forceinline__ Frame make_frame(GAS unsigned char* ws) {
    extern __shared__ __attribute__((aligned(16))) unsigned char lds_raw[];
    Frame F;
    F.lds = (LAS unsigned char*)lds_raw; F.MISC = (volatile LAS unsigned*)(F.lds + MISC_OFF);
    F.tid = opaque_tid(); F.lane = F.tid & 63; F.wave = __builtin_amdgcn_readfirstlane(F.tid >> 6);
    F.G = opaque_s((int)gridDim.x); F.bid = opaque_s((int)blockIdx.x); F.gw = F.bid * NWAVES + F.wave; F.ngw = F.G * NWAVES;
    { unsigned long long w = (unsigned long long)ws; asm volatile("" : "+s"(w)); F.ws = (GAS unsigned char*)w; }
    return F;
}
struct RowPtrs { const float* x; const float* ctx; float* out; float* xc; };
__device__ __forceinline__ RowPtrs row_ptrs(const Frame& F) { RowPtrs p; p.x = INP(I_X); p.ctx = INP(I_CTX); p.out = (float*)ptab_get(F, I_OUT); p.xc = (float*)(F.ws + WS_XC); return p; }
__device__ __forceinline__ const float* xin_row(const RowPtrs& P, int r) {
    const int b = r / TT, t = r - b * TT;
    return t < SEQ ? P.x + ((size_t)b * SEQ + t) * D : P.ctx + ((size_t)b * CTX + (t - SEQ)) * D;
}
__device__ __forceinline__ float* xs_row(const RowPtrs& P, int r) {
    const int b = r / TT, t = r - b * TT;
    return t < SEQ ? P.out + ((size_t)b * SEQ + t) * D : P.xc + ((size_t)b * CTX + (t - SEQ)) * D;
}
__device__ __forceinline__ void ld16(const float* p, int lane, float (&v)[16]) {
    const f32x4* q = (const f32x4*)p + lane;
    const f32x4 a = q[0], b = q[64], c = q[128], d = q[192];
    v[0] = a.x; v[1] = a.y; v[2] = a.z; v[3] = a.w; v[4] = b.x; v[5] = b.y; v[6] = b.z; v[7] = b.w;
    v[8] = c.x; v[9] = c.y; v[10] = c.z; v[11] = c.w; v[12] = d.x; v[13] = d.y; v[14] = d.z; v[15] = d.w;
}
__device__ __forceinline__ void st16(float* p, int lane, const float (&v)[16]) {
    f32x4* q = (f32x4*)p + lane;
    q[0] = (f32x4){v[0], v[1], v[2], v[3]}; q[64] = (f32x4){v[4], v[5], v[6], v[7]};
    q[128] = (f32x4){v[8], v[9], v[10], v[11]}; q[192] = (f32x4){v[12], v[13], v[14], v[15]};
}
__device__ __forceinline__ void ld16nt(const float* p, int lane, float (&v)[16]) {
    const f32x4* q = (const f32x4*)p + lane;
    const f32x4 a = __builtin_nontemporal_load(q), b = __builtin_nontemporal_load(q + 64), c = __builtin_nontemporal_load(q + 128), d = __builtin_nontemporal_load(q + 192);
    v[0] = a.x; v[1] = a.y; v[2] = a.z; v[3] = a.w; v[4] = b.x; v[5] = b.y; v[6] = b.z; v[7] = b.w;
    v[8] = c.x; v[9] = c.y; v[10] = c.z; v[11] = c.w; v[12] = d.x; v[13] = d.y; v[14] = d.z; v[15] = d.w;
}
__device__ __forceinline__ void st16nt(float* p, int lane, const float (&v)[16]) {
    f32x4* q = (f32x4*)p + lane;
    __builtin_nontemporal_store((f32x4){v[0], v[1], v[2], v[3]}, q); __builtin_nontemporal_store((f32x4){v[4], v[5], v[6], v[7]}, q + 64);
    __builtin_nontemporal_store((f32x4){v[8], v[9], v[10], v[11]}, q + 128); __builtin_nontemporal_store((f32x4){v[12], v[13], v[14], v[15]}, q + 192);
}
__device__ __forceinline__ void unpack16(const v2u (&w)[4], float (&v)[16]) {
#pragma unroll
    for (int g = 0; g < 4; ++g) { v[4 * g] = bflo(w[g].x); v[4 * g + 1] = bfhi(w[g].x); v[4 * g + 2] = bflo(w[g].y); v[4 * g + 3] = bfhi(w[g].y); }
}
__device__ __forceinline__ void ld16bf_raw(const bf16* p, int lane, v2u (&w)[4]) {
    const v2u* q = (const v2u*)p + lane; w[0] = q[0]; w[1] = q[64]; w[2] = q[128]; w[3] = q[192];
}
__device__ __forceinline__ void ld16bf_raw_nt(const bf16* p, int lane, v2u (&w)[4]) {
    const v2u* q = (const v2u*)p + lane; w[0] = __builtin_nontemporal_load(q); w[1] = __builtin_nontemporal_load(q + 64); w[2] = __builtin_nontemporal_load(q + 128); w[3] = __builtin_nontemporal_load(q + 192);
}
__device__ __forceinline__ void ld16bf(const bf16* p, int lane, float (&v)[16]) { v2u w[4]; ld16bf_raw(p, lane, w); unpack16(w, v); }
__device__ __forceinline__ void ld16bf_nt(const bf16* p, int lane, float (&v)[16]) { v2u w[4]; ld16bf_raw_nt(p, lane, w); unpack16(w, v); }
__device__ __forceinline__ void st16bf(bf16* p, int lane, const float (&v)[16]) {
    v2u* q = (v2u*)p + lane;
#pragma unroll
    for (int g = 0; g < 4; ++g) { v2u w; w.x = pk2(v[4 * g], v[4 * g + 1]); w.y = pk2(v[4 * g + 2], v[4 * g + 3]); q[64 * g] = w; }
}
__device__ __forceinline__ void ln16(float (&v)[16]) {
    float s = 0.f;
#pragma unroll
    for (int i = 0; i < 16; ++i) s += v[i];
    const float mean = wave_sum(s) * (1.0f / D); float q = 0.f;
#pragma unroll
    for (int i = 0; i < 16; ++i) { v[i] -= mean; q += v[i] * v[i]; }
    const float rstd = 1.0f / sqrtf(wave_sum(q) * (1.0f / D) + EPS);
#pragma unroll
    for (int i = 0; i < 16; ++i) v[i] *= rstd;
}

__device__ __forceinline__ int rows_per_wave(int ngw) {
    int rpw = (M + ngw - 1) / ngw;
    if (!((SEQ % rpw) % 4 == 0 && (TT % rpw) == 0 && (rpw % 2) == 0)) rpw = (rpw + 3) & ~3;
    return rpw;
}
template <int TYPE>
__device__ __forceinline__ float conv_src(const float* p0, const float* p1, const float* g0, const float* g1, int l, int k, int n) {
    if (TYPE == 0) return n < DPROJ ? p0[((size_t)l * D + k) * DPROJ + n] : 0.f;
    if (TYPE == 1) { if (n < 384) return k < 256 ? g0[l * 256 + k] * p0[((size_t)l * 256 + k) * 384 + n] : 0.f;
                     if (n < 896) return k >= 256 ? g1[l * 128 + (k - 256)] * p1[((size_t)l * 128 + (k - 256)) * 512 + (n - 384)] : 0.f;
                     return 0.f; }
    if (TYPE == 2) return p0[((size_t)l * D + k) * D + n];
    if (TYPE == 3) { const int e = n >> 10, nn = n & 1023, q = nn >> 3, j = nn & 7;
                     return j < 4 ? p0[(((size_t)l * 16 + e) * D + k) * 512 + 4 * q + j] : p1[(((size_t)l * 16 + e) * D + k) * 512 + 4 * q + (j - 4)]; }
    { const int e = n >> 10, nn = n & 1023; return p0[(((size_t)l * 16 + e) * 512 + k) * D + nn]; }
}
template <int TYPE>
__device__ __forceinline__ void conv_item(const Frame& F, int l, int item, LAS float* scr) {
    constexpr int Nd = TYPE == 0 ? NPJ : TYPE == 1 ? 1024 : TYPE == 2 ? 1024 : 16384, Kd = TYPE == 1 ? 384 : TYPE == 4 ? 512 : 1024;
    bf16* dst = (bf16*)(F.ws + (TYPE == 0 ? WS_WIN : TYPE == 1 ? WS_WD : TYPE == 2 ? WS_WOUT : TYPE == 3 ? WS_WGU : WS_WDN)) + (size_t)l * Nd * Kd;
    const float* p0 = INP(TYPE == 0 ? I_WIN : TYPE == 1 ? I_WQB : TYPE == 2 ? I_WOUT : TYPE == 3 ? I_WG : I_WDN);
    const float* p1 = INP(TYPE == 1 ? I_WKVB : I_WU); const float* g0 = INP(I_MQG); const float* g1 = INP(I_MKVG);
    constexpr int nblk = Nd / 32; const int kb = item / nblk, nb = item - kb * nblk, k0 = 64 * kb, n0 = 32 * nb, lane = F.lane;
#pragma unroll
    for (int i = 0; i < 32; ++i) { const int kk = 2 * i + (lane >> 5); scr[kk * 33 + (lane & 31)] = conv_src<TYPE>(p0, p1, g0, g1, l, k0 + kk, n0 + (lane & 31)); }
    asm volatile("s_waitcnt lgkmcnt(0)" ::: "memory");
    const int c = lane & 7;
#pragma unroll
    for (int j = 0; j < 4; ++j) { const int n = (lane >> 3) + 8 * j; const LAS float* s = scr + (8 * c) * 33 + n;
        v4u o; o.x = pk2(s[0 * 33], s[1 * 33]); o.y = pk2(s[2 * 33], s[3 * 33]); o.z = pk2(s[4 * 33], s[5 * 33]); o.w = pk2(s[6 * 33], s[7 * 33]);
        *(v4u*)(dst + (size_t)(n0 + n) * Kd + k0 + 8 * c) = o; }
    asm volatile("s_waitcnt lgkmcnt(0)" ::: "memory");
}
__device__ __forceinline__ void phase_prologue(const Frame& F) {
    {
        LAS float* sv = (LAS float*)F.lds;
        LAS float* red = (LAS float*)(F.lds + 17 * 1024 * 4);
        float* mods = (float*)(F.ws + WS_MODS);
        for (int u = F.bid; u < NL * 48; u += F.G) {
            const int l = u / 48, cc = u - l * 48;
            const float* pc = INP(I_C); const float* pcc = INP(I_CCTX);
            for (int i = F.tid; i < 17 * 1024; i += NTHR) { const int mr = i >> 10, k = i & 1023; const float c = mr < 16 ? pc[mr * 1024 + k] : pcc[k]; sv[i] = c / (1.0f + expf(-c)); }
            __syncthreads();
            const int col = F.tid & 127, kg = F.tid >> 7;
            float acc[17];
#pragma unroll
            for (int mr = 0; mr < 17; ++mr) acc[mr] = 0.f;
            const float* w = INP(I_WADA) + ((size_t)l * 1024 + kg * 256) * 6144 + cc * 128 + col;
            for (int k4 = 0; k4 < 256; k4 += 4) {
                const float w0 = w[(size_t)(k4 + 0) * 6144], w1 = w[(size_t)(k4 + 1) * 6144], w2 = w[(size_t)(k4 + 2) * 6144], w3 = w[(size_t)(k4 + 3) * 6144];
#pragma unroll
                for (int mr = 0; mr < 17; ++mr) { const f32x4 s = *(const LAS f32x4*)(sv + mr * 1024 + kg * 256 + k4); acc[mr] += (s.x * w0 + s.y * w1) + (s.z * w2 + s.w * w3); }
            }
#pragma unroll
            for (int mr = 0; mr < 17; ++mr) red[(kg * 17 + mr) * 128 + col] = acc[mr];
            __syncthreads();
            const float* bada = INP(I_BADA);
            for (int i = F.tid; i < 17 * 128; i += NTHR) { const int mr = i >> 7, c = i & 127;
                const float s = (red[(0 * 17 + mr) * 128 + c] + red[(1 * 17 + mr) * 128 + c]) + (red[(2 * 17 + mr) * 128 + c] + red[(3 * 17 + mr) * 128 + c]);
                mods[((size_t)l * 17 + mr) * 6144 + cc * 128 + c] = s + bada[l * 6144 + cc * 128 + c]; }
            __syncthreads();
        }
    }
    {
        float* t64 = (float*)(F.ws + WS_T64); float* t32 = (float*)(F.ws + WS_T32);
        for (int i = F.bid * NTHR + F.tid; i < 64 * 16 + 64 * 8; i += F.G * NTHR) {
            if (i < 1024) { const int p = i >> 4, k = i & 15; const float fr = powf(10000.0f, -(float)k / 16.0f), ang = (float)p * fr; t64[2 * i] = cosf(ang); t64[2 * i + 1] = sinf(ang); }
            else { const int j = i - 1024, p = j >> 3, k = j & 7; const float fr = powf(10000.0f, -(float)k / 8.0f), ang = (float)p * fr; t32[2 * j] = cosf(ang); t32[2 * j + 1] = sinf(ang); }
        }
    }
    {
        __syncthreads();
        LAS float* scr = (LAS float*)(F.lds + F.wave * 8448);
        constexpr int I0 = 1152, I1 = 192, I2 = 512, I3 = 8192, I4 = 4096, IL = I0 + I1 + I2 + I3 + I4;
        for (int it = F.gw; it < NL * IL; it += F.ngw) {
            const int l = it / IL; int r = it - l * IL;
            if (r < I0) { conv_item<0>(F, l, r, scr); continue; } r -= I0;
            if (r < I1) { conv_item<1>(F, l, r, scr); continue; } r -= I1;
            if (r < I2) { conv_item<2>(F, l, r, scr); continue; } r -= I2;
            if (r < I3) { conv_item<3>(F, l, r, scr); continue; } r -= I3;
            conv_item<4>(F, l, r, scr);
        }
    }
}

__device__ __forceinline__ void phase_ln(const Frame& F, int l) {
    constexpr int NR = 4;
    const float* mods = (const float*)(F.ws + WS_MODS); bf16* HA = (bf16*)(F.ws + WS_HA);
    const bf16* Y = (const bf16*)(F.ws + WS_PB); const unsigned* RT = (const unsigned*)(F.ws + WS_RT);
    const int lane = F.lane; const RowPtrs RP = row_ptrs(F);
    const float* ln2g = INP(I_LN2G) + (l > 0 ? l - 1 : 0) * D; const float* ln2b = INP(I_LN2B) + (l > 0 ? l - 1 : 0) * D;
    const int rpw = rows_per_wave(F.ngw), rbeg = F.gw * rpw, rend = min(M, rbeg + rpw);
    float g2[16]; int cur_mr = -1;
    for (int r0 = rbeg; r0 < rend; r0 += NR) {
        float v[NR][16]; v4u rt[NR]; v2u ya[NR][4], yb[NR][4]; bool act[NR];
        const int b0 = r0 / TT, t0 = r0 - b0 * TT; const bool lat = t0 < SEQ; const int mr = lat ? b0 : 16;
        if (l == NL && !lat) continue;
#pragma unroll
        for (int u = 0; u < NR; ++u) {
            const int r = r0 + u; act[u] = r < rend; const int rc = act[u] ? r : r0;
            ld16nt(l == 0 ? xin_row(RP, rc) : xs_row(RP, rc), lane, v[u]);
            rt[u] = *(const v4u*)(RT + (size_t)rc * 8 + 4);
        }
        if (mr != cur_mr) { if (l > 0) ld16(mods + ((size_t)(l - 1) * 17 + mr) * 6144 + 5120, lane, g2); cur_mr = mr; }
        if (l > 0) {
#pragma unroll
            for (int u = 0; u < NR; ++u) { ld16bf_raw_nt(Y + (size_t)rt[u].z * D, lane, ya[u]); ld16bf_raw_nt(Y + (size_t)rt[u].w * D, lane, yb[u]); }
#pragma unroll
            for (int u = 0; u < NR; ++u) {
                float f0[16], f1[16], gg[16], bb[16];
                const float w0 = __uint_as_float(rt[u].x), w1 = __uint_as_float(rt[u].y);
                unpack16(ya[u], f0); unpack16(yb[u], f1);
#pragma unroll
                for (int i = 0; i < 16; ++i) v[u][i] = ALPHA * v[u][i] + g2[i] * (w0 * f0[i] + w1 * f1[i]);
                ld16(ln2g, lane, gg); ld16(ln2b, lane, bb);
                ln16(v[u]);
#pragma unroll
                for (int i = 0; i < 16; ++i) v[u][i] = v[u][i] * gg[i] + bb[i];
                if (act[u]) st16nt(xs_row(RP, r0 + u), lane, v[u]);
            }
        }
        if (l < NL) {
            float sh[16], sc[16]; ld16(mods + ((size_t)l * 17 + mr) * 6144, lane, sh); ld16(mods + ((size_t)l * 17 + mr) * 6144 + 1024, lane, sc);
#pragma unroll
            for (int u = 0; u < NR; ++u) {
                ln16(v[u]);
#pragma unroll
                for (int i = 0; i < 16; ++i) v[u][i] = v[u][i] * (1.0f + sc[i]) + sh[i];
                if (act[u]) st16bf(HA + (size_t)(r0 + u) * D, lane, v[u]);
            }
        }
    }
}

__device__ __forceinline__ void rope8(float (&f)[8], const float (&p)[8], const float* cs, bool first) {
    const f32x4* c4 = (const f32x4*)cs;
#pragma unroll
    for (int q = 0; q < 4; ++q) { const f32x4 t = c4[q];
        f[2 * q] = first ? f[2 * q] * t.x - p[2 * q] * t.y : p[2 * q] * t.y + f[2 * q] * t.x;
        f[2 * q + 1] = first ? f[2 * q + 1] * t.z - p[2 * q + 1] * t.w : p[2 * q + 1] * t.w + f[2 * q + 1] * t.z; }
}
__device__ __forceinline__ void phase_post(const Frame& F, int l) {
    constexpr int NR = 4;
    bf16* P = (bf16*)(F.ws + WS_PB); bf16* KD = (bf16*)(F.ws + WS_KD);
    const float* t64 = (const float*)(F.ws + WS_T64); const float* t32 = (const float*)(F.ws + WS_T32);
    const int lane = F.lane; const float* gains = (lane < 32 ? INP(I_GQG) : INP(I_GKG)) + l * 64;
    const int j = lane & 7, jj = lane & 3;
    float gn[8];
#pragma unroll
    for (int i = 0; i < 8; ++i) gn[i] = gains[j * 8 + i];
    for (int r0 = F.gw; r0 < M; r0 += NR * F.ngw) {
        v4u w0[NR], w1[NR], w2[NR]; int rr[NR]; bool act[NR];
#pragma unroll
        for (int u = 0; u < NR; ++u) { const int r = r0 + u * F.ngw; act[u] = r < M; rr[u] = act[u] ? r : r0; const bf16* prow = P + (size_t)rr[u] * NPJ;
            w0[u] = *((const v4u*)(prow + 768) + lane); w1[u] = *((const v4u*)(prow + 1280) + lane); w2[u] = *((const v4u*)(prow + 1792) + lane); }
#pragma unroll
        for (int u = 0; u < NR; ++u) {
            const int r = rr[u]; const int b = r / TT, t = r - b * TT; const bool lat = t < SEQ; const int gr = (t >> 6) & 63, gc = t & 63;
            bf16* prow = P + (size_t)r * NPJ;
            const float* cs64 = t64 + ((size_t)((j < 4 ? gr : gc) * 16 + (j & 1) * 8)) * 2;
            {
                float f[8]; unpack8(w0[u], f);
                float ss = 0.f;
#pragma unroll
                for (int i = 0; i < 8; ++i) ss += f[i] * f[i];
                ss += __shfl_xor(ss, 1); ss += __shfl_xor(ss, 2); ss += __shfl_xor(ss, 4);
                const float rs = 1.0f / sqrtf(ss * (1.0f / 64.0f) + EPS);
#pragma unroll
                for (int i = 0; i < 8; ++i) f[i] = f[i] * rs * gn[i];
                float p[8];
#pragma unroll
                for (int i = 0; i < 8; ++i) p[i] = __shfl_xor(f[i], 2);
                if (lat) rope8(f, p, cs64, (j & 2) == 0);
                if (lane < 48 && act[u]) *((v4u*)(prow + 768) + lane) = pack8(f);
            }
            {
                float f[8]; unpack8(w1[u], f);
                float p[8];
#pragma unroll
                for (int i = 0; i < 8; ++i) p[i] = __shfl_xor(f[i], 2);
                rope8(f, p, cs64, (j & 2) == 0);
                if (lat && lane < 48 && act[u]) *((v4u*)(prow + 1280) + lane) = pack8(f);
            }
            {
                float f[8]; unpack8(w2[u], f);
                float ss = 0.f;
#pragma unroll
                for (int i = 0; i < 8; ++i) ss += f[i] * f[i];
                ss += __shfl_xor(ss, 1); ss += __shfl_xor(ss, 2); ss += __shfl_xor(ss, 4); ss += __shfl_xor(ss, 8);
                const float s32 = ss + __shfl_xor(ss, 16);
                const float rn = lane < 32 ? 1.0f / sqrtf(s32 * (1.0f / 256.0f) + EPS) : 1.0f / sqrtf(ss * (1.0f / 128.0f) + EPS);
                if (lane < 48 && act[u]) { float fn[8];
#pragma unroll
                    for (int i = 0; i < 8; ++i) fn[i] = f[i] * rn;
                    *((v4u*)(prow + 1792) + lane) = pack8(fn); }
                float p[8];
#pragma unroll
                for (int i = 0; i < 8; ++i) p[i] = __shfl_xor(f[i], 1);
                if (lat) rope8(f, p, t32 + ((size_t)((jj < 2 ? gr : gc) * 8)) * 2, (jj & 1) == 0);
                if (lane >= 48 && lane < 52 && act[u]) { const v4u o = pack8(f);
#pragma unroll
                    for (int h = 0; h < 4; ++h) *(v4u*)(KD + (size_t)r * 384 + h * 96 + 64 + 8 * jj) = o; }
            }
        }
    }
}

__device__ __forceinline__ void phase_route(const Frame& F, int l) {
    const float* mods = (const float*)(F.ws + WS_MODS); bf16* HA = (bf16*)(F.ws + WS_HA);
    const bf16* MIX = (const bf16*)(F.ws + WS_PB); unsigned* RT = (unsigned*)(F.ws + WS_RT); int* HIST = (int*)(F.ws + WS_HIST);
    LAS float* WR = (LAS float*)F.lds;
    { const float* rgw = INP(I_RGW); const float* rew = INP(I_REW);
      for (int i = F.tid; i < 20 * 1024; i += NTHR) { const int jx = i >> 10, k = i & 1023;
        WR[i] = jx < 4 ? rgw[((size_t)l * D + k) * 4 + jx] : rew[((size_t)l * D + k) * 16 + (jx - 4)]; } }
    if (F.tid < 16) F.MISC[MI_LH + F.tid] = 0u;
    __syncthreads();
    LAS float* bias = (LAS float*)(F.lds + 20 * 1024 * 4);
    if (F.tid < 20) bias[F.tid] = F.tid < 4 ? INP(I_RGB)[l * 4 + F.tid] : INP(I_REB)[l * 16 + (F.tid - 4)];
    __syncthreads();
    const RowPtrs RP = row_ptrs(F); const float* ln1g = INP(I_LN1G) + l * D; const float* ln1b = INP(I_LN1B) + l * D;
    constexpr int NR = 2;
    const int rpw = rows_per_wave(F.ngw), rbeg = F.gw * rpw, rend = min(M, rbeg + rpw);
    float g1[16], sh[16], sc[16]; int cur_mr = -1;
    for (int r0 = rbeg; r0 < rend; r0 += NR) {
        if (l == NL - 1 && (r0 % TT) >= SEQ) continue;
        float v[NR][16], mx[NR][16], gg[16], bb[16]; int rr[NR]; bool act[NR];
#pragma unroll
        for (int u = 0; u < NR; ++u) { const int r = r0 + u; act[u] = r < rend; rr[u] = act[u] ? r : r0;
            ld16nt(l == 0 ? xin_row(RP, rr[u]) : xs_row(RP, rr[u]), F.lane, v[u]); ld16bf_nt(MIX + (size_t)rr[u] * D, F.lane, mx[u]); }
        ld16(ln1g, F.lane, gg); ld16(ln1b, F.lane, bb);
        { const int b = r0 / TT, t = r0 - b * TT, mr = t < SEQ ? b : 16;
          if (mr != cur_mr) { const float* md = mods + ((size_t)l * 17 + mr) * 6144; ld16(md + 2048, F.lane, g1); ld16(md + 3072, F.lane, sh); ld16(md + 4096, F.lane, sc); cur_mr = mr; } }
#pragma unroll
        for (int u = 0; u < NR; ++u) {
#pragma unroll
            for (int i = 0; i < 16; ++i) v[u][i] = ALPHA * v[u][i] + g1[i] * mx[u][i]; }
#pragma unroll
        for (int u = 0; u < NR; ++u) ln16(v[u]);
#pragma unroll
        for (int u = 0; u < NR; ++u) {
#pragma unroll
            for (int i = 0; i < 16; ++i) v[u][i] = v[u][i] * gg[i] + bb[i];
            if (act[u]) st16nt(xs_row(RP, rr[u]), F.lane, v[u]); }
#pragma unroll
        for (int u = 0; u < NR; ++u) ln16(v[u]);
#pragma unroll
        for (int u = 0; u < NR; ++u) {
#pragma unroll
            for (int i = 0; i < 16; ++i) v[u][i] = v[u][i] * (1.0f + sc[i]) + sh[i];
            if (act[u]) st16bf(HA + (size_t)rr[u] * D, F.lane, v[u]); }
        float lgt[NR][20];
#pragma unroll
        for (int jx = 0; jx < 20; ++jx) {
            const LAS f32x4* wq = (const LAS f32x4*)(WR + jx * 1024);
            const f32x4 w0 = wq[F.lane], w1 = wq[64 + F.lane], w2 = wq[128 + F.lane], w3 = wq[192 + F.lane];
#pragma unroll
            for (int u = 0; u < NR; ++u) {
                const float sm = (v[u][0] * w0.x + v[u][1] * w0.y) + (v[u][2] * w0.z + v[u][3] * w0.w) + (v[u][4] * w1.x + v[u][5] * w1.y) + (v[u][6] * w1.z + v[u][7] * w1.w)
                               + (v[u][8] * w2.x + v[u][9] * w2.y) + (v[u][10] * w2.z + v[u][11] * w2.w) + (v[u][12] * w3.x + v[u][13] * w3.y) + (v[u][14] * w3.z + v[u][15] * w3.w);
                lgt[u][jx] = sm; }
        }
#pragma unroll
        for (int o = 1; o < 64; o <<= 1)
#pragma unroll
            for (int u = 0; u < NR; ++u)
#pragma unroll
                for (int jx = 0; jx < 20; ++jx) lgt[u][jx] += __shfl_xor(lgt[u][jx], o);
#pragma unroll
        for (int u = 0; u < NR; ++u) {
#pragma unroll
            for (int jx = 0; jx < 20; ++jx) lgt[u][jx] += bias[jx];
            int grp = 0; float mg = lgt[u][0];
#pragma unroll
            for (int g = 1; g < 4; ++g) if (lgt[u][g] > mg) { mg = lgt[u][g]; grp = g; }
            float sg = 0.f;
#pragma unroll
            for (int g = 0; g < 4; ++g) sg += expf(lgt[u][g] - mg);
            const float pg = 1.0f / sg;
            float sel[4];
#pragma unroll
            for (int i = 0; i < 4; ++i) sel[i] = grp == 0 ? lgt[u][4 + i] : grp == 1 ? lgt[u][8 + i] : grp == 2 ? lgt[u][12 + i] : lgt[u][16 + i];
            int i1 = 0; float v1 = sel[0];
#pragma unroll
            for (int i = 1; i < 4; ++i) if (sel[i] > v1) { v1 = sel[i]; i1 = i; }
            int i2 = -1; float v2 = -3.0e38f;
#pragma unroll
            for (int i = 0; i < 4; ++i) if (i != i1 && (i2 < 0 || sel[i] > v2)) { v2 = sel[i]; i2 = i; }
            const float ee = expf(v2 - v1), w1 = pg / (1.0f + ee), w2 = pg * ee / (1.0f + ee);
            const int e1 = grp * 4 + i1, e2 = grp * 4 + i2;
            if (F.lane == 0 && act[u]) {
                const unsigned k1 = __hip_atomic_fetch_add((LAS unsigned*)&F.MISC[MI_LH + e1], 1u, __ATOMIC_RELAXED, __HIP_MEMORY_SCOPE_WORKGROUP);
                const unsigned k2 = __hip_atomic_fetch_add((LAS unsigned*)&F.MISC[MI_LH + e2], 1u, __ATOMIC_RELAXED, __HIP_MEMORY_SCOPE_WORKGROUP);
                v4u ra; ra.x = (unsigned)e1; ra.y = (unsigned)e2; ra.z = k1; ra.w = k2;
                v4u rb; rb.x = __builtin_bit_cast(unsigned, w1); rb.y = __builtin_bit_cast(unsigned, w2); rb.z = 0u; rb.w = 0u;
                *(v4u*)(RT + (size_t)rr[u] * 8) = ra; *(v4u*)(RT + (size_t)rr[u] * 8 + 4) = rb;
            }
        }
    }
    __syncthreads();
    if (F.tid < 16) HIST[F.bid * 16 + F.tid] = (int)F.MISC[MI_LH + F.tid];
}
__device__ __forceinline__ void moe_tables(const Frame& F) {
    const int* HIST = (const int*)(F.ws + WS_HIST); LAS int* hl = (LAS int*)F.lds;
    __syncthreads();
    for (int i = F.tid; i < F.G * 16; i += NTHR) hl[i] = HIST[i];
    __syncthreads();
    if (F.tid < 16) { int tot = 0, mine = 0; for (int g = 0; g < F.G; ++g) { const int c = hl[g * 16 + F.tid]; tot += c; mine += (g < F.bid) ? c : 0; }
        F.MISC[MI_TOT + F.tid] = (unsigned)tot; F.MISC[MI_BASE + F.tid] = (unsigned)mine; }
    __syncthreads();
    if (F.tid == 0) { unsigned p = 0; for (int e = 0; e < 16; ++e) { F.MISC[MI_PST + e] = p; F.MISC[MI_BASE + e] += p * 256u; p += (F.MISC[MI_TOT + e] + 255u) >> 8; } F.MISC[MI_PST + 16] = p; }
    __syncthreads();
}
__device__ __forceinline__ void phase_permute(const Frame& F, int l) {
    unsigned* RT = (unsigned*)(F.ws + WS_RT); int* SRC = (int*)(F.ws + WS_QD);
    moe_tables(F);
    const int rpw = rows_per_wave(F.ngw), rbeg = F.gw * rpw, rend = min(M, rbeg + rpw);
    for (int r = rbeg + F.lane; r < rend; r += 64) {
        if (l == NL - 1 && (r % TT) >= SEQ) continue;
        const v4u ra = *(const v4u*)(RT + (size_t)r * 8);
        const unsigned p0 = F.MISC[MI_BASE + (ra.x & 15u)] + ra.z, p1 = F.MISC[MI_BASE + (ra.y & 15u)] + ra.w;
        RT[(size_t)r * 8 + 6] = p0; RT[(size_t)r * 8 + 7] = p1; SRC[p0] = r; SRC[p1] = r;
    }
    if (F.bid == 0) {
        for (int e = 0; e < 16; ++e) { const int beg = (int)F.MISC[MI_PST + e] * 256 + (int)F.MISC[MI_TOT + e], end = (int)F.MISC[MI_PST + e + 1] * 256;
            for (int p = beg + F.tid; p < end; p += NTHR) SRC[p] = 0; }
    }
}

struct EpiMla {
    static constexpr bool PERM = true, AFTER_DRAIN = false;
    bf16* QD; bf16* KD; bf16* VD;
    __device__ __forceinline__ void operator()(const pg8::f32x4 (&acc)[2][2][4][2], const pg8::Unit& u, int wr, int wc, int fr, int fq) const {
#pragma unroll
        for (int bj = 0; bj < 2; ++bj) {
            const int g0 = u.pn * 256 + bj * 128 + wc * 32, col0 = g0 + 8 * fq;
            if (g0 >= 896) continue;
            const int c = col0 - 384, hd = c >> 7, jx = c & 127;
            bf16* dst = g0 < 384 ? QD + col0 : jx < 64 ? KD + hd * 96 + jx : VD + hd * 64 + (jx - 64);
            const int stride = (g0 < 384 || jx < 64) ? 384 : 256;
            dst += (size_t)(u.pm * 256 + wr * 64 + fr) * stride;
#pragma unroll
            for (int ai = 0; ai < 2; ++ai)
#pragma unroll
                for (int m = 0; m < 4; ++m) {
                    v4u o; o.x = pk2(acc[ai][bj][m][0][0], acc[ai][bj][m][0][1]); o.y = pk2(acc[ai][bj][m][0][2], acc[ai][bj][m][0][3]);
                    o.z = pk2(acc[ai][bj][m][1][0], acc[ai][bj][m][1][1]); o.w = pk2(acc[ai][bj][m][1][2], acc[ai][bj][m][1][3]);
                    *(v4u*)(dst + (size_t)(ai * 128 + m * 16) * stride) = o;
                }
        }
    }
};
struct EpiGU {
    static constexpr bool PERM = true, AFTER_DRAIN = false;
    bf16* ACT;
    __device__ __forceinline__ void operator()(const pg8::f32x4 (&acc)[2][2][4][2], const pg8::Unit& u, int wr, int wc, int fr, int fq) const {
#pragma unroll
        for (int ai = 0; ai < 2; ++ai)
#pragma unroll
            for (int m = 0; m < 4; ++m) {
                const int row = u.pm * 256 + ai * 128 + wr * 64 + m * 16 + fr;
#pragma unroll
                for (int bj = 0; bj < 2; ++bj) {
                    const int c = (u.pn & 3) * 256 + bj * 128 + wc * 32 + 8 * fq;
                    float o[4];
#pragma unroll
                    for (int i = 0; i < 4; ++i) { const float g = acc[ai][bj][m][0][i], up = acc[ai][bj][m][1][i]; o[i] = g / (1.0f + __expf(-g)) * up; }
                    v2u w; w.x = pk2(o[0], o[1]); w.y = pk2(o[2], o[3]);
                    *(v2u*)(ACT + (size_t)row * 512 + (c >> 1)) = w;
                }
            }
    }
};
struct MoeOrder {
    volatile LAS unsigned* pst; int G, c;
    __device__ __forceinline__ bool next(int i, pg8::Unit& u) const {
        const int np = (int)pst[16]; int panel, pn;
        if ((G & 7) == 0) { const int x = c & 7, uu = i * (G >> 3) + (c >> 3); panel = (uu >> 2) * 8 + x; pn = uu & 3; }
        else { const int L = i * G + c; panel = L >> 2; pn = L & 3; }
        if (panel >= np) return false;
        int e = 0;
#pragma unroll
        for (int k = 1; k < 16; ++k) e += (panel >= (int)pst[k]) ? 1 : 0;
        u.pm = __builtin_amdgcn_readfirstlane(panel); u.pn = __builtin_amdgcn_readfirstlane(e * 4 + pn); return true;
    }
    __device__ __forceinline__ void a_ready(const pg8::Unit&) const {}
    __device__ __forceinline__ void done(const pg8::Unit&) const {}
};

struct LatOrder {
    int G, c;
    __device__ __forceinline__ bool next(int i, pg8::Unit& u) const {
        int pl, pn;
        if ((G & 7) == 0) { const int x = c & 7, uu = i * (G >> 3) + (c >> 3); pl = (uu >> 2) * 8 + x; pn = uu & 3; } else { const int L = i * G + c; pl = L >> 2; pn = L & 3; }
        if (pl >= NB * 16) return false;
        u.pm = pl + (pl >> 4); u.pn = pn; return true;
    }
    __device__ __forceinline__ void a_ready(const pg8::Unit&) const {}
    __device__ __forceinline__ void done(const pg8::Unit&) const {}
};

#ifndef DBG_VAR
#define DBG_VAR 1
#endif
namespace att {
constexpr int VRS = 192, KBUF = 64 * 208, VBUF = 64 * VRS, BUF = KBUF + VBUF, BIAS_OFF = 4 * BUF;
constexpr float NEG = -30000.0f;
__device__ __forceinline__ int crow(int r, int hi) { return (r & 3) + 8 * (r >> 2) + 4 * hi; }
__device__ __forceinline__ float xhalf_max(float v) { const unsigned a = __builtin_bit_cast(unsigned, v);
    auto rr = __builtin_amdgcn_permlane32_swap(a, a, false, false); const unsigned r0 = rr[0], r1 = rr[1]; return fmaxf(__uint_as_float(r0), __uint_as_float(r1)); }
__device__ __forceinline__ float xhalf_sum(float v) { const unsigned a = __builtin_bit_cast(unsigned, v);
    auto rr = __builtin_amdgcn_permlane32_swap(a, a, false, false); const unsigned r0 = rr[0], r1 = rr[1]; return __uint_as_float(r0) + __uint_as_float(r1); }
__device__ __forceinline__ float max3f(float a, float b, float c) { float r; asm("v_max3_f32 %0, %1, %2, %3" : "=v"(r) : "v"(a), "v"(b), "v"(c)); return r; }
typedef __bf16 bf16x2_t __attribute__((ext_vector_type(2)));
__device__ __forceinline__ unsigned cvtpk(float lo, float hi) { f32x2 v = {lo, hi}; bf16x2_t b = __builtin_convertvector(v, bf16x2_t); return __builtin_bit_cast(unsigned, b); }

template <int DK, int VM = 0>
__device__ __forceinline__ void unit(LAS unsigned char* lds, const bf16* Qp, int qpitch, const bf16* Kp, int kpitch, const bf16* Vp, int vpitch, bf16* Op,
                                     int var, int qt, int lo, int n1, int nt, float qscale, float sinkl2, bool has_sink, const LAS float* bias, const float* t32, unsigned* dbg) {
    constexpr int KRS = DK * 2 + 16, NS = DK / 16, CPK = DK / 8;
    int tid = threadIdx.x; asm volatile("" : "+v"(tid)); const int lane = tid & 63, r32 = lane & 31, hi = lane >> 5, wid = __builtin_amdgcn_readfirstlane(tid >> 6);
    const int qrow = 256 * qt + 32 * wid + r32;
    bf16x8 qr[NS];
#pragma unroll
    for (int s = 0; s < NS; ++s) { const v4u raw = *(const v4u*)(Qp + (size_t)qrow * qpitch + 16 * s + 8 * hi); float f[8]; unpack8(raw, f);
#pragma unroll
        for (int i = 0; i < 8; ++i) f[i] *= qscale;
        if (DK == 96 && s >= 4) {
            float p[8];
#pragma unroll
            for (int i = 0; i < 8; ++i) p[i] = __shfl_xor(f[i], 32);
            if (qt < 16) rope8(f, p, t32 + ((size_t)((s == 4 ? (qrow >> 6) : (qrow & 63)) * 8)) * 2, hi == 0);
        }
        qr[s] = __builtin_bit_cast(bf16x8, pack8(f)); }
    const int kkey0 = tid / CPK, kch0 = tid - kkey0 * CPK, kkey1 = (tid + 512) / CPK, kch1 = (tid + 512) - kkey1 * CPK;
    const int vkey = tid >> 3, vch = tid & 7;
    v4u kreg0, kreg1 = {0u, 0u, 0u, 0u}, vreg;
#define ATT_TROW(j) ((((j) < n1) ? (lo + (j)) : (64 + (j) - n1)) * 64)
#define ATT_LOAD(j) do { const int tr_ = ATT_TROW(j); kreg0 = *(const v4u*)(Kp + (size_t)(tr_ + kkey0) * kpitch + kch0 * 8); \
        if (DK == 96 && tid < 256) kreg1 = *(const v4u*)(Kp + (size_t)(tr_ + kkey1) * kpitch + kch1 * 8); \
        vreg = *(const v4u*)(Vp + (size_t)(tr_ + vkey) * vpitch + vch * 8); } while (0)
#define ATT_STORE(bf) do { LAS unsigned char* b_ = lds + (bf) * BUF; *(LAS v4u*)(b_ + kkey0 * KRS + kch0 * 16) = kreg0; \
        if (DK == 96 && tid < 256) *(LAS v4u*)(b_ + kkey1 * KRS + kch1 * 16) = kreg1; \
        *(LAS v4u*)(b_ + KBUF + vkey * VRS + vch * 16) = vreg; } while (0)
    constexpr float THR = 6.0f;
    float m = 0.f; f32x2 lacc = {0.f, 0.f}; f32x16 o0 = {}, o1 = {}; f32x16 negm = {}; bool first = true;
    const int grw = 4 * qt + (wid >> 1), r0w = min(max(grw - 4, 0), 56), gc = (wid & 1) * 32 + r32, c0 = min(max(gc - 8, 0), 48), i0w = 256 * qt + 32 * wid;
    ATT_LOAD(0); ATT_STORE(0);
    __syncthreads();
    for (int j = 0; j < nt; ++j) {
        if (!(VM & 8) && j + 1 < nt) ATT_LOAD(j + 1);
        const int kt = ATT_TROW(j) >> 6;
        bool actv = true;
        if (kt < 64) { if (var == 0) actv = (kt >= r0w) && (kt <= r0w + 7); else if (var == 2) actv = !((64 * kt - (i0w + 31) > 128) || (i0w - (64 * kt + 63) > 128)); }
        if (actv) {
            const LAS unsigned char* Kb = lds + (j & 1) * BUF; const LAS unsigned char* Vb = Kb + KBUF;
            f32x16 s0 = negm, s1 = negm;
            bf16x8 ka[NS], kb[NS];
#pragma unroll
            for (int s = 0; s < NS; ++s) { ka[s] = *(const LAS bf16x8*)(Kb + r32 * KRS + (16 * s + 8 * hi) * 2); kb[s] = *(const LAS bf16x8*)(Kb + (32 + r32) * KRS + (16 * s + 8 * hi) * 2); }
            __builtin_amdgcn_sched_barrier(0);
            if (VM & 2) {
#pragma unroll
                for (int s = 0; s < NS; ++s) asm volatile("" :: "v"(ka[s]), "v"(kb[s]), "v"(qr[s]));
            } else {
#pragma unroll
            for (int s = 0; s < NS; ++s) { s0 = __builtin_amdgcn_mfma_f32_32x32x16_bf16(ka[s], qr[s], s0, 0, 0, 0); s1 = __builtin_amdgcn_mfma_f32_32x32x16_bf16(kb[s], qr[s], s1, 0, 0, 0); }
            }
            asm volatile("s_nop 15\n\ts_nop 7" : "+v"(s0), "+v"(s1));
            if (kt < 64 && var == 0) {
                const int rowoff = (kt - grw + 7) * 31 - gc + 15;
#pragma unroll
                for (int r = 0; r < 16; ++r) { const int j0 = crow(r, hi), j1 = j0 + 32;
                    const bool v0 = (unsigned)(j0 - c0) < 16u, v1 = (unsigned)(j1 - c0) < 16u;
                    const float b0 = bias[v0 ? rowoff + j0 : 0], b1 = bias[v1 ? rowoff + j1 : 0];
                    s0[r] = v0 ? s0[r] + b0 : NEG; s1[r] = v1 ? s1[r] + b1 : NEG; }
            } else if (kt < 64 && var == 2) {
                const int dbase = 64 * kt - qrow + 128;
#pragma unroll
                for (int r = 0; r < 16; ++r) { const int j0 = crow(r, hi);
                    s0[r] = (unsigned)(dbase + j0) <= 256u ? s0[r] : NEG; s1[r] = (unsigned)(dbase + j0 + 32) <= 256u ? s1[r] : NEG; }
            }
            if (!(VM & 4)) {
            float mxa = max3f(s0[0], s0[1], s1[0]), mxb = max3f(s0[2], s0[3], s1[1]); mxa = max3f(mxa, s1[2], s1[3]);
#pragma unroll
            for (int r = 4; r < 16; r += 4) { mxa = max3f(mxa, s0[r], s0[r + 1]); mxb = max3f(mxb, s0[r + 2], s0[r + 3]); mxa = max3f(mxa, s1[r], s1[r + 1]); mxb = max3f(mxb, s1[r + 2], s1[r + 3]); }
            const float mx = xhalf_max(fmaxf(mxa, mxb));
            if (first || __any(mx > THR)) {
                const float d = first ? fmaxf(mx, -64.0f) : fmaxf(mx, 0.f), alpha = __builtin_amdgcn_exp2f(-d);
                m += d; first = false;
#pragma unroll
                for (int r = 0; r < 16; ++r) { s0[r] -= d; s1[r] -= d; o0[r] *= alpha; o1[r] *= alpha; negm[r] = -m; }
                lacc *= alpha;
            }
#pragma unroll
            for (int r = 0; r < 16; ++r) { s0[r] = __builtin_amdgcn_exp2f(s0[r]); s1[r] = __builtin_amdgcn_exp2f(s1[r]); lacc += (f32x2){s0[r], s1[r]}; }
            }
            bf16x8 pb[4];
#pragma unroll
            for (int s = 0; s < 2; ++s) {
                v4u w; w.x = cvtpk(s0[8 * s], s0[8 * s + 1]); w.y = cvtpk(s0[8 * s + 2], s0[8 * s + 3]); w.z = cvtpk(s0[8 * s + 4], s0[8 * s + 5]); w.w = cvtpk(s0[8 * s + 6], s0[8 * s + 7]);
                pb[s] = __builtin_bit_cast(bf16x8, w);
                v4u x; x.x = cvtpk(s1[8 * s], s1[8 * s + 1]); x.y = cvtpk(s1[8 * s + 2], s1[8 * s + 3]); x.z = cvtpk(s1[8 * s + 4], s1[8 * s + 5]); x.w = cvtpk(s1[8 * s + 6], s1[8 * s + 7]);
                pb[2 + s] = __builtin_bit_cast(bf16x8, x);
            }
            if (VM & 1) { asm volatile("" :: "v"(pb[0]), "v"(pb[1]), "v"(pb[2]), "v"(pb[3])); } else {
            const LAS unsigned char* vbase = Vb + (4 * hi + ((lane & 15) >> 2)) * VRS + ((lane >> 4) & 1) * 32 + (lane & 3) * 8;
#pragma unroll
            for (int s = 0; s < 4; ++s) {
                const v4i16 a0 = __builtin_amdgcn_ds_read_tr16_b64_v4i16((LAS v4i16*)(vbase + (16 * s) * VRS));
                const v4i16 a1 = __builtin_amdgcn_ds_read_tr16_b64_v4i16((LAS v4i16*)(vbase + (16 * s + 8) * VRS));
                const v4i16 c0_ = __builtin_amdgcn_ds_read_tr16_b64_v4i16((LAS v4i16*)(vbase + (16 * s) * VRS + 64));
                const v4i16 c1_ = __builtin_amdgcn_ds_read_tr16_b64_v4i16((LAS v4i16*)(vbase + (16 * s + 8) * VRS + 64));
                const bf16x8 va = {a0[0], a0[1], a0[2], a0[3], a1[0], a1[1], a1[2], a1[3]};
                const bf16x8 vc = {c0_[0], c0_[1], c0_[2], c0_[3], c1_[0], c1_[1], c1_[2], c1_[3]};
                o0 = __builtin_amdgcn_mfma_f32_32x32x16_bf16(va, pb[s], o0, 0, 0, 0);
                o1 = __builtin_amdgcn_mfma_f32_32x32x16_bf16(vc, pb[s], o1, 0, 0, 0);
            }
            }
        }
        if (!(VM & 8) && j + 1 < nt) ATT_STORE((j + 1) & 1);
        if (!(VM & 16)) __syncthreads();
    }
    float l = xhalf_sum(lacc.x + lacc.y);
    const float sterm = has_sink ? __builtin_amdgcn_exp2f(sinkl2 - m) : 0.f;
#if MK_DEBUG
    if (dbg && hi == 0) { dbg[(size_t)qrow * 2] = __builtin_bit_cast(unsigned, m); dbg[(size_t)qrow * 2 + 1] = __builtin_bit_cast(unsigned, l); }
#endif
    if (has_sink) l += sterm;
    const float inv = 1.0f / l;
    bf16* orow = Op + (size_t)qrow * D;
#pragma unroll
    for (int g = 0; g < 4; ++g) {
        v2u w0; w0.x = pk2(o0[4 * g] * inv, o0[4 * g + 1] * inv); w0.y = pk2(o0[4 * g + 2] * inv, o0[4 * g + 3] * inv);
        v2u w1; w1.x = pk2(o1[4 * g] * inv, o1[4 * g + 1] * inv); w1.y = pk2(o1[4 * g + 2] * inv, o1[4 * g + 3] * inv);
        *(v2u*)(orow + 8 * g + 4 * hi) = w0; *(v2u*)(orow + 32 + 8 * g + 4 * hi) = w1;
    }
#undef ATT_TROW
#undef ATT_LOAD
#undef ATT_STORE
}

template <int DK, int MODE, int VM = 0>
__device__ __forceinline__ void unit2(LAS unsigned char* lds, const bf16* Qp, int qpitch, const bf16* Kp, int kpitch, const bf16* Vp, int vpitch, bf16* Op,
                                      int var, int qt, int lo, int n1, int nt, float qscale, float sink0, float sink1, bool has_sink, const LAS float* bias, const float* t32) {
    constexpr int KRS = DK * 2 + 16, NS = DK / 16, CPK = DK / 8;
    int tid = threadIdx.x; asm volatile("" : "+v"(tid)); const int lane = tid & 63, r32 = lane & 31, hi = lane >> 5, wid = __builtin_amdgcn_readfirstlane(tid >> 6);
    const int rowbase = MODE == 0 ? 512 * qt + 64 * wid : 256 * qt + 32 * wid;
    bf16x8 qr[2][NS];
#pragma unroll
    for (int u = 0; u < 2; ++u) {
        const int qrow = rowbase + (MODE == 0 ? 32 * u : 0) + r32;
        const bf16* qp = Qp + (MODE == 1 ? 64 * u : 0) + (size_t)qrow * qpitch;
#pragma unroll
        for (int s = 0; s < NS; ++s) { const v4u raw = *(const v4u*)(qp + 16 * s + 8 * hi); float f[8]; unpack8(raw, f);
#pragma unroll
            for (int i = 0; i < 8; ++i) f[i] *= qscale;
            if (DK == 96 && s >= 4) { float p[8];
#pragma unroll
                for (int i = 0; i < 8; ++i) p[i] = __shfl_xor(f[i], 32);
                rope8(f, p, t32 + ((size_t)((s == 4 ? (qrow >> 6) : (qrow & 63)) * 8)) * 2, hi == 0); }
            qr[u][s] = __builtin_bit_cast(bf16x8, pack8(f)); }
    }
    const int kkey0 = tid / CPK, kch0 = tid - kkey0 * CPK, kkey1 = (tid + 512) / CPK, kch1 = (tid + 512) - kkey1 * CPK;
    const int vkey = tid >> 3, vch = tid & 7;
    v4u kreg0, kreg1 = {0u, 0u, 0u, 0u}, vreg;
#define ATT_TROW(j) ((((j) < n1) ? (lo + (j)) : (64 + (j) - n1)) * 64)
#define ATT_LOAD(j) do { const int tr_ = ATT_TROW(j); kreg0 = *(const v4u*)(Kp + (size_t)(tr_ + kkey0) * kpitch + kch0 * 8); \
        if (DK == 96 && tid < 256) kreg1 = *(const v4u*)(Kp + (size_t)(tr_ + kkey1) * kpitch + kch1 * 8); \
        vreg = *(const v4u*)(Vp + (size_t)(tr_ + vkey) * vpitch + vch * 8); } while (0)
#define ATT_STORE(bf) do { LAS unsigned char* b_ = lds + (bf) * BUF; *(LAS v4u*)(b_ + kkey0 * KRS + kch0 * 16) = kreg0; \
        if (DK == 96 && tid < 256) *(LAS v4u*)(b_ + kkey1 * KRS + kch1 * 16) = kreg1; \
        *(LAS v4u*)(b_ + KBUF + vkey * VRS + vch * 16) = vreg; } while (0)
    constexpr float THR = 6.0f;
    float m = 0.f; f32x2 lacc[2] = {{0.f, 0.f}, {0.f, 0.f}}; f32x16 o0[2] = {{}, {}}, o1[2] = {{}, {}}; bool first = true;
    const int grw = 8 * qt + wid, r0w = min(max(grw - 4, 0), 56), i0w = rowbase;
    ATT_LOAD(0); ATT_STORE(0);
    __syncthreads();
    for (int j = 0; j < nt; ++j) {
        if (!(VM & 8) && j + 1 < nt) ATT_LOAD(j + 1);
        const int kt = ATT_TROW(j) >> 6;
        bool actv = true;
        if (kt < 64) { if (var == 0) actv = (kt >= r0w) && (kt <= r0w + 7); else if (var == 2) actv = !((64 * kt - (i0w + 31) > 128) || (i0w - (64 * kt + 63) > 128)); }
        if (actv) {
            const LAS unsigned char* Kb = lds + (j & 1) * BUF; const LAS unsigned char* Vb = Kb + KBUF;
            f32x16 s0[2] = {{}, {}}, s1[2] = {{}, {}};
#pragma unroll
            for (int s = 0; s < NS; ++s) {
                const bf16x8 ka = *(const LAS bf16x8*)(Kb + r32 * KRS + (16 * s + 8 * hi) * 2);
                const bf16x8 kb = *(const LAS bf16x8*)(Kb + (32 + r32) * KRS + (16 * s + 8 * hi) * 2);
                if (VM & 2) { asm volatile("" :: "v"(ka), "v"(kb), "v"(qr[0][s]), "v"(qr[1][s])); } else {
#pragma unroll
                for (int u = 0; u < 2; ++u) { s0[u] = __builtin_amdgcn_mfma_f32_32x32x16_bf16(ka, qr[u][s], s0[u], 0, 0, 0); s1[u] = __builtin_amdgcn_mfma_f32_32x32x16_bf16(kb, qr[u][s], s1[u], 0, 0, 0); }
                }
            }
            asm volatile("s_nop 15\n\ts_nop 7" : "+v"(s0[0]), "+v"(s1[0]), "+v"(s0[1]), "+v"(s1[1]));
            if (kt < 64 && var == 0) {
#pragma unroll
                for (int u = 0; u < 2; ++u) { const int gc = 32 * u + r32, c0 = min(max(gc - 8, 0), 48), rowoff = (kt - grw + 7) * 31 - gc + 15;
#pragma unroll
                    for (int r = 0; r < 16; ++r) { const int j0 = crow(r, hi), j1 = j0 + 32;
                        const bool v0 = (unsigned)(j0 - c0) < 16u, v1 = (unsigned)(j1 - c0) < 16u;
                        const float b0 = bias[v0 ? rowoff + j0 : 0], b1 = bias[v1 ? rowoff + j1 : 0];
                        s0[u][r] = v0 ? s0[u][r] + b0 : NEG; s1[u][r] = v1 ? s1[u][r] + b1 : NEG; } }
            } else if (kt < 64 && var == 2) {
                const int dbase = 64 * kt - (rowbase + r32) + 128;
#pragma unroll
                for (int r = 0; r < 16; ++r) { const int j0 = crow(r, hi); const bool v0 = (unsigned)(dbase + j0) <= 256u, v1 = (unsigned)(dbase + j0 + 32) <= 256u;
                    s0[0][r] = v0 ? s0[0][r] : NEG; s1[0][r] = v1 ? s1[0][r] : NEG; s0[1][r] = v0 ? s0[1][r] : NEG; s1[1][r] = v1 ? s1[1][r] : NEG; }
            }
            if (!(VM & 4)) {
            float mxa = max3f(s0[0][0], s0[0][1], s1[0][0]), mxb = max3f(s0[1][0], s0[1][1], s1[1][0]);
#pragma unroll
            for (int r = 0; r < 16; r += 2) { if (r) { mxa = max3f(mxa, s0[0][r], s0[0][r + 1]); mxb = max3f(mxb, s0[1][r], s0[1][r + 1]); }
                if (r) { mxa = max3f(mxa, s1[0][r], s1[0][r + 1]); mxb = max3f(mxb, s1[1][r], s1[1][r + 1]); } else { mxa = fmaxf(mxa, s1[0][1]); mxb = fmaxf(mxb, s1[1][1]); } }
            const float mx = xhalf_max(fmaxf(mxa, mxb)) - m;
            if (first || __any(mx > THR)) {
                const float d = first ? fmaxf(mx, -64.0f) : fmaxf(mx, 0.f), alpha = __builtin_amdgcn_exp2f(-d);
                m += d; first = false;
#pragma unroll
                for (int u = 0; u < 2; ++u) {
#pragma unroll
                    for (int r = 0; r < 16; ++r) { o0[u][r] *= alpha; o1[u][r] *= alpha; }
                    lacc[u] *= alpha; }
            }
            }
            bf16x8 pb[2][4];
#pragma unroll
            for (int u = 0; u < 2; ++u) {
                if (!(VM & 4))
#pragma unroll
                for (int r = 0; r < 16; ++r) { s0[u][r] = __builtin_amdgcn_exp2f(s0[u][r] - m); s1[u][r] = __builtin_amdgcn_exp2f(s1[u][r] - m); lacc[u] += (f32x2){s0[u][r], s1[u][r]}; }
#pragma unroll
                for (int s = 0; s < 2; ++s) {
                    v4u w; w.x = cvtpk(s0[u][8 * s], s0[u][8 * s + 1]); w.y = cvtpk(s0[u][8 * s + 2], s0[u][8 * s + 3]); w.z = cvtpk(s0[u][8 * s + 4], s0[u][8 * s + 5]); w.w = cvtpk(s0[u][8 * s + 6], s0[u][8 * s + 7]);
                    pb[u][s] = __builtin_bit_cast(bf16x8, w);
                    v4u x; x.x = cvtpk(s1[u][8 * s], s1[u][8 * s + 1]); x.y = cvtpk(s1[u][8 * s + 2], s1[u][8 * s + 3]); x.z = cvtpk(s1[u][8 * s + 4], s1[u][8 * s + 5]); x.w = cvtpk(s1[u][8 * s + 6], s1[u][8 * s + 7]);
                    pb[u][2 + s] = __builtin_bit_cast(bf16x8, x);
                }
            }
            if (VM & 1) { asm volatile("" :: "v"(pb[0][0]), "v"(pb[0][1]), "v"(pb[0][2]), "v"(pb[0][3]), "v"(pb[1][0]), "v"(pb[1][1]), "v"(pb[1][2]), "v"(pb[1][3])); } else {
            const LAS unsigned char* vbase = Vb + (4 * hi + ((lane & 15) >> 2)) * VRS + ((lane >> 4) & 1) * 32 + (lane & 3) * 8;
#pragma unroll
            for (int s = 0; s < 4; ++s) {
                const v4i16 a0 = __builtin_amdgcn_ds_read_tr16_b64_v4i16((LAS v4i16*)(vbase + (16 * s) * VRS));
                const v4i16 a1 = __builtin_amdgcn_ds_read_tr16_b64_v4i16((LAS v4i16*)(vbase + (16 * s + 8) * VRS));
                const v4i16 c0_ = __builtin_amdgcn_ds_read_tr16_b64_v4i16((LAS v4i16*)(vbase + (16 * s) * VRS + 64));
                const v4i16 c1_ = __builtin_amdgcn_ds_read_tr16_b64_v4i16((LAS v4i16*)(vbase + (16 * s + 8) * VRS + 64));
                const bf16x8 va = {a0[0], a0[1], a0[2], a0[3], a1[0], a1[1], a1[2], a1[3]};
                const bf16x8 vc = {c0_[0], c0_[1], c0_[2], c0_[3], c1_[0], c1_[1], c1_[2], c1_[3]};
#pragma unroll
                for (int u = 0; u < 2; ++u) { o0[u] = __builtin_amdgcn_mfma_f32_32x32x16_bf16(va, pb[u][s], o0[u], 0, 0, 0); o1[u] = __builtin_amdgcn_mfma_f32_32x32x16_bf16(vc, pb[u][s], o1[u], 0, 0, 0); }
            }
            }
        }
        if (!(VM & 8) && j + 1 < nt) ATT_STORE((j + 1) & 1);
        if (!(VM & 16)) __syncthreads();
    }
#pragma unroll
    for (int u = 0; u < 2; ++u) {
        float l = xhalf_sum(lacc[u].x + lacc[u].y);
        if (has_sink) l += __builtin_amdgcn_exp2f((u == 0 ? sink0 : sink1) - m);
        const float inv = 1.0f / l;
        const int qrow = rowbase + (MODE == 0 ? 32 * u : 0) + r32;
        bf16* orow = Op + (MODE == 1 ? 64 * u : 0) + (size_t)qrow * D;
#pragma unroll
        for (int g = 0; g < 4; ++g) {
            v2u w0; w0.x = pk2(o0[u][4 * g] * inv, o0[u][4 * g + 1] * inv); w0.y = pk2(o0[u][4 * g + 2] * inv, o0[u][4 * g + 3] * inv);
            v2u w1; w1.x = pk2(o1[u][4 * g] * inv, o1[u][4 * g + 1] * inv); w1.y = pk2(o1[u][4 * g + 2] * inv, o1[u][4 * g + 3] * inv);
            *(v2u*)(orow + 8 * g + 4 * hi) = w0; *(v2u*)(orow + 32 + 8 * g + 4 * hi) = w1;
        }
    }
#undef ATT_TROW
#undef ATT_LOAD
#undef ATT_STORE
}

template <int VM = 0>
__device__ __forceinline__ void unit_k2(LAS unsigned char* lds, const bf16* Qp, const bf16* Kp, const bf16* Vp, bf16* Op, int qt, int nt2, float qscale, const float* t32) {
    constexpr int DK = 96, KRS = DK * 2 + 16, NS = 6, KB2 = 128 * KRS, BUF2 = KB2 + 128 * VRS;
    int tid = threadIdx.x; asm volatile("" : "+v"(tid)); const int lane = tid & 63, r32 = lane & 31, hi = lane >> 5, wid = __builtin_amdgcn_readfirstlane(tid >> 6);
    const int qrow = 256 * qt + 32 * wid + r32;
    bf16x8 qr[NS];
#pragma unroll
    for (int s = 0; s < NS; ++s) { const v4u raw = *(const v4u*)(Qp + (size_t)qrow * 384 + 16 * s + 8 * hi); float f[8]; unpack8(raw, f);
#pragma unroll
        for (int i = 0; i < 8; ++i) f[i] *= qscale;
        if (s >= 4) { float p[8];
#pragma unroll
            for (int i = 0; i < 8; ++i) p[i] = __shfl_xor(f[i], 32);
            if (qt < 16) rope8(f, p, t32 + ((size_t)((s == 4 ? (qrow >> 6) : (qrow & 63)) * 8)) * 2, hi == 0); }
        qr[s] = __builtin_bit_cast(bf16x8, pack8(f)); }
    int kk[3], kc[3];
#pragma unroll
    for (int i = 0; i < 3; ++i) { const int c = tid + 512 * i; kk[i] = c / 12; kc[i] = c - kk[i] * 12; }
    const int vk0 = tid >> 3, vc0 = tid & 7;
    v4u kreg[3], vreg[2];
#define K2_LOAD(j) do { const size_t tr_ = (size_t)(j) * 128; _Pragma("unroll") for (int i_ = 0; i_ < 3; ++i_) kreg[i_] = *(const v4u*)(Kp + (tr_ + kk[i_]) * 384 + kc[i_] * 8); \
        vreg[0] = *(const v4u*)(Vp + (tr_ + vk0) * 256 + vc0 * 8); vreg[1] = *(const v4u*)(Vp + (tr_ + 64 + vk0) * 256 + vc0 * 8); } while (0)
#define K2_STORE(bf) do { LAS unsigned char* b_ = lds + (bf) * BUF2; _Pragma("unroll") for (int i_ = 0; i_ < 3; ++i_) *(LAS v4u*)(b_ + kk[i_] * KRS + kc[i_] * 16) = kreg[i_]; \
        *(LAS v4u*)(b_ + KB2 + vk0 * VRS + vc0 * 16) = vreg[0]; *(LAS v4u*)(b_ + KB2 + (64 + vk0) * VRS + vc0 * 16) = vreg[1]; } while (0)
    constexpr float THR = 6.0f;
    float m = 0.f; f32x2 lacc = {0.f, 0.f}; f32x16 o0 = {}, o1 = {}; bool first = true;
    K2_LOAD(0); K2_STORE(0);
    __syncthreads();
    for (int j = 0; j < nt2; ++j) {
        if (!(VM & 8) && j + 1 < nt2) K2_LOAD(j + 1);
        const LAS unsigned char* Kb = lds + (j & 1) * BUF2; const LAS unsigned char* Vb = Kb + KB2;
        f32x16 s0[2] = {{}, {}}, s1[2] = {{}, {}};
#pragma unroll
        for (int h = 0; h < 2; ++h) {
            bf16x8 ka[NS], kb[NS];
#pragma unroll
            for (int s = 0; s < NS; ++s) { ka[s] = *(const LAS bf16x8*)(Kb + (64 * h + r32) * KRS + (16 * s + 8 * hi) * 2); kb[s] = *(const LAS bf16x8*)(Kb + (64 * h + 32 + r32) * KRS + (16 * s + 8 * hi) * 2); }
            __builtin_amdgcn_sched_barrier(0);
            if (VM & 2) {
#pragma unroll
                for (int s = 0; s < NS; ++s) asm volatile("" :: "v"(ka[s]), "v"(kb[s]), "v"(qr[s]));
            } else {
#pragma unroll
                for (int s = 0; s < NS; ++s) { s0[h] = __builtin_amdgcn_mfma_f32_32x32x16_bf16(ka[s], qr[s], s0[h], 0, 0, 0); s1[h] = __builtin_amdgcn_mfma_f32_32x32x16_bf16(kb[s], qr[s], s1[h], 0, 0, 0); }
            }
        }
        asm volatile("s_nop 15\n\ts_nop 7" : "+v"(s0[0]), "+v"(s1[0]), "+v"(s0[1]), "+v"(s1[1]));
        if (!(VM & 4)) {
            float mxa = max3f(s0[0][0], s0[0][1], s1[0][0]), mxb = max3f(s0[1][0], s0[1][1], s1[1][0]);
#pragma unroll
            for (int r = 0; r < 16; r += 2) { if (r) { mxa = max3f(mxa, s0[0][r], s0[0][r + 1]); mxb = max3f(mxb, s0[1][r], s0[1][r + 1]); mxa = max3f(mxa, s1[0][r], s1[0][r + 1]); mxb = max3f(mxb, s1[1][r], s1[1][r + 1]); }
                else { mxa = fmaxf(mxa, s1[0][1]); mxb = fmaxf(mxb, s1[1][1]); } }
            const float mx = xhalf_max(fmaxf(mxa, mxb)) - m;
            if (first || __any(mx > THR)) {
                const float d = first ? fmaxf(mx, -64.0f) : fmaxf(mx, 0.f), alpha = __builtin_amdgcn_exp2f(-d);
                m += d; first = false;
#pragma unroll
                for (int r = 0; r < 16; ++r) { o0[r] *= alpha; o1[r] *= alpha; }
                lacc *= alpha;
            }
#pragma unroll
            for (int h = 0; h < 2; ++h)
#pragma unroll
                for (int r = 0; r < 16; ++r) { s0[h][r] = __builtin_amdgcn_exp2f(s0[h][r] - m); s1[h][r] = __builtin_amdgcn_exp2f(s1[h][r] - m); lacc += (f32x2){s0[h][r], s1[h][r]}; }
        }
        bf16x8 pb[8];
#pragma unroll
        for (int h = 0; h < 2; ++h)
#pragma unroll
            for (int s = 0; s < 2; ++s) {
                v4u w; w.x = cvtpk(s0[h][8 * s], s0[h][8 * s + 1]); w.y = cvtpk(s0[h][8 * s + 2], s0[h][8 * s + 3]); w.z = cvtpk(s0[h][8 * s + 4], s0[h][8 * s + 5]); w.w = cvtpk(s0[h][8 * s + 6], s0[h][8 * s + 7]);
                pb[4 * h + s] = __builtin_bit_cast(bf16x8, w);
                v4u x; x.x = cvtpk(s1[h][8 * s], s1[h][8 * s + 1]); x.y = cvtpk(s1[h][8 * s + 2], s1[h][8 * s + 3]); x.z = cvtpk(s1[h][8 * s + 4], s1[h][8 * s + 5]); x.w = cvtpk(s1[h][8 * s + 6], s1[h][8 * s + 7]);
                pb[4 * h + 2 + s] = __builtin_bit_cast(bf16x8, x);
            }
        if (VM & 1) { asm volatile("" :: "v"(pb[0]), "v"(pb[1]), "v"(pb[2]), "v"(pb[3]), "v"(pb[4]), "v"(pb[5]), "v"(pb[6]), "v"(pb[7])); } else {
        const LAS unsigned char* vbase = Vb + (4 * hi + ((lane & 15) >> 2)) * VRS + ((lane >> 4) & 1) * 32 + (lane & 3) * 8;
#pragma unroll
        for (int s = 0; s < 8; ++s) {
            const v4i16 a0 = __builtin_amdgcn_ds_read_tr16_b64_v4i16((LAS v4i16*)(vbase + (16 * s) * VRS));
            const v4i16 a1 = __builtin_amdgcn_ds_read_tr16_b64_v4i16((LAS v4i16*)(vbase + (16 * s + 8) * VRS));
            const v4i16 c0_ = __builtin_amdgcn_ds_read_tr16_b64_v4i16((LAS v4i16*)(vbase + (16 * s) * VRS + 64));
            const v4i16 c1_ = __builtin_amdgcn_ds_read_tr16_b64_v4i16((LAS v4i16*)(vbase + (16 * s + 8) * VRS + 64));
            const bf16x8 va = {a0[0], a0[1], a0[2], a0[3], a1[0], a1[1], a1[2], a1[3]};
            const bf16x8 vc = {c0_[0], c0_[1], c0_[2], c0_[3], c1_[0], c1_[1], c1_[2], c1_[3]};
            o0 = __builtin_amdgcn_mfma_f32_32x32x16_bf16(va, pb[s], o0, 0, 0, 0);
            o1 = __builtin_amdgcn_mfma_f32_32x32x16_bf16(vc, pb[s], o1, 0, 0, 0);
        }
        }
        if (!(VM & 8) && j + 1 < nt2) K2_STORE((j + 1) & 1);
        if (!(VM & 16)) __syncthreads();
    }
    const float l = xhalf_sum(lacc.x + lacc.y), inv = 1.0f / l;
    bf16* orow = Op + (size_t)qrow * D;
#pragma unroll
    for (int g = 0; g < 4; ++g) {
        v2u w0; w0.x = pk2(o0[4 * g] * inv, o0[4 * g + 1] * inv); w0.y = pk2(o0[4 * g + 2] * inv, o0[4 * g + 3] * inv);
        v2u w1; w1.x = pk2(o1[4 * g] * inv, o1[4 * g + 1] * inv); w1.y = pk2(o1[4 * g + 2] * inv, o1[4 * g + 3] * inv);
        *(v2u*)(orow + 8 * g + 4 * hi) = w0; *(v2u*)(orow + 32 + 8 * g + 4 * hi) = w1;
    }
#undef K2_LOAD
#undef K2_STORE
}
}

template <int VM = 0>
__device__ __forceinline__ void phase_attn(const Frame& F, int lq) {
    const int l = lq & 3;
    const bf16* P = (const bf16*)(F.ws + WS_PB); const bf16* QD = (const bf16*)(F.ws + WS_QD); const bf16* KD = (const bf16*)(F.ws + WS_KD);
    const bf16* VD = (const bf16*)(F.ws + WS_VD); bf16* O = (bf16*)(F.ws + (lq >= 4 ? WS_ACT : WS_HA));
    unsigned* ctr = (unsigned*)(F.ws + WS_CTL) + CW_QUEUE + 64 * 8 * lq;
    LAS float* bias = (LAS float*)(F.lds + att::BIAS_OFF);
    { const float* nab = INP(I_NABIAS) + l * 4 * 465; for (int i = F.tid; i < 4 * 465; i += NTHR) bias[i] = nab[i] * LOG2E; }
    const float* sinks = INP(I_SINK) + l * 4;
    __syncthreads();
    const float* t32 = (const float*)(F.ws + WS_T32);
    const int nloc = 320 + (l < NL - 1 ? 24 : 0);
    const int q0 = (int)xb_xcc_id();
    for (int qq = 0; qq < 8; ++qq) {
      const int q = (q0 + qq) & 7;
      unsigned* qctr = ctr + 64 * q;
      for (;;) {
        if (F.tid == 0) F.MISC[MI_Q] = __hip_atomic_fetch_add(qctr, 1u, __ATOMIC_RELAXED, __HIP_MEMORY_SCOPE_AGENT);
        __syncthreads();
        const int li = (int)F.MISC[MI_Q];
        __syncthreads();
        if (li >= nloc) break;
        int idx;
        if (li < 128) idx = (q + 8 * (li >> 4)) * 16 + (li & 15);
        else if (li < 192) { const int jx = li - 128; idx = 1024 + (q + 8 * (jx >> 4)) * 16 + (jx & 15); }
        else if (li < 256) { const int jx = li - 192; idx = 1536 + (q + 8 * (jx >> 3)) * 8 + (jx & 7); }
        else if (li < 320) { const int jx = li - 256; idx = 2048 + (q + 8 * (jx >> 4)) * 16 + (jx & 15); }
        else if (li < 328) idx = 2560 + q + 8 * (li - 320);
        else idx = 2624 + q + 8 * (li - 328);
        if (idx < 1024) {
            const int b = idx >> 6, h = (idx >> 4) & 3, qt = idx & 15; const size_t rb = (size_t)b * TT;
            att::unit<96, VM>(F.lds, QD + rb * 384 + h * 96, 384, KD + rb * 384 + h * 96, 384, VD + rb * 256 + h * 64, 256, O + rb * D + 768 + h * 64, 3, qt, 0, 64, 68, 0.10206207261596575f * LOG2E, 0.f, false, bias, t32, nullptr);
        } else if (idx < 2560) {
            idx -= 1024;
            const int grp = idx >> 9, rem = idx & 511, b = rem >> 5; const size_t rb = (size_t)b * TT;
            if (grp == 1) {
                const int h = (rem >> 3) & 3, qt = rem & 7; const int lo = min(max(8 * qt - 4, 0), 56), n1 = min(max(8 * qt + 3, 0), 56) + 7 - lo + 1;
                att::unit2<64, 0, VM>(F.lds, P + rb * NPJ + h * 64, NPJ, P + rb * NPJ + 256 + h * 64, NPJ, P + rb * NPJ + 512 + h * 64, NPJ, O + rb * D + h * 64, 0, qt, lo, n1, n1 + 4,
                                  0.125f * LOG2E, 0.f, 0.f, false, bias + h * 465, t32);
            } else {
                const int g = (rem >> 4) & 1, qt = rem & 15; const bool isc = grp == 2;
                const int lo = isc ? max(4 * qt - 2, 0) : 0, n1 = isc ? min(4 * qt + 5, 63) - lo + 1 : 64;
                const int qc = (isc ? 1280 : 768) + g * 128, kc = (isc ? 1536 : 1024) + g * 64, vc = (isc ? 1664 : 1152) + g * 64;
                att::unit2<64, 1, VM>(F.lds, P + rb * NPJ + qc, NPJ, P + rb * NPJ + kc, NPJ, P + rb * NPJ + vc, NPJ, O + rb * D + (isc ? 512 : 256) + g * 128, isc ? 2 : 1, qt, lo, n1, n1 + 4,
                                  0.125f * LOG2E, isc ? sinks[2 * g] * LOG2E : 0.f, isc ? sinks[2 * g + 1] * LOG2E : 0.f, isc, bias, t32);
            }
        } else if (idx < 2624) {
            const int rem = idx - 2560, b = rem >> 2, isc = (rem >> 1) & 1, g = rem & 1; const size_t rb = (size_t)b * TT;
            const int qc = (isc ? 1280 : 768) + g * 128, kc = (isc ? 1536 : 1024) + g * 64, vc = (isc ? 1664 : 1152) + g * 64;
            att::unit2<64, 1, VM>(F.lds, P + rb * NPJ + qc, NPJ, P + rb * NPJ + kc, NPJ, P + rb * NPJ + vc, NPJ, O + rb * D + (isc ? 512 : 256) + g * 128, isc ? 2 : 1, 16, 0, 0, 4,
                              0.125f * LOG2E, isc ? sinks[2 * g] * LOG2E : 0.f, isc ? sinks[2 * g + 1] * LOG2E : 0.f, isc != 0, bias, t32);
        } else {
            const int rem = idx - 2624, b = rem >> 3, isd = (rem >> 2) & 1, h = rem & 3; const size_t rb = (size_t)b * TT;
            if (isd) att::unit<96, VM>(F.lds, QD + rb * 384 + h * 96, 384, KD + rb * 384 + h * 96, 384, VD + rb * 256 + h * 64, 256, O + rb * D + 768 + h * 64, 3, 16, 0, 0, 4, 0.10206207261596575f * LOG2E, 0.f, false, bias, t32, nullptr);
            else att::unit<64, VM>(F.lds, P + rb * NPJ + h * 64, NPJ, P + rb * NPJ + 256 + h * 64, NPJ, P + rb * NPJ + 512 + h * 64, NPJ, O + rb * D + h * 64, 0, 16, 0, 0, 4, 0.125f * LOG2E, 0.f, false, bias + h * 465, nullptr, nullptr);
        }
    }
    }
}


#define PHASE_FN static __device__ __forceinline__ void
PHASE_FN ph_prologue(GAS unsigned char* ws) { const Frame F = make_frame(ws); phase_prologue(F); }
PHASE_FN ph_ln(GAS unsigned char* ws, int l) { const Frame F = make_frame(ws); phase_ln(F, l); }
PHASE_FN ph_gemm_in(GAS unsigned char* ws, int l) {
    const Frame F = make_frame(ws);
    pg8::Gemm g{(const bf16*)(F.ws + WS_HA), (const bf16*)(F.ws + WS_WIN) + (size_t)l * NPJ * D, M, NPJ, D, D, nullptr}; pg8::StaticOrder S; S.init(M, NPJ, F.G, F.bid);
    pg8::EpiBf16NT<0> E{(bf16*)(F.ws + WS_PB), NPJ, nullptr, 0, 0, 1.f};
    pg8::gemm_phase<pg8::EpiBf16NT<0>, pg8::StaticOrder, true, true>(F.lds, g, S, E);
}
PHASE_FN ph_post(GAS unsigned char* ws, int l) { const Frame F = make_frame(ws); phase_post(F, l); }
PHASE_FN ph_gemm_mla(GAS unsigned char* ws, int l) {
    const Frame F = make_frame(ws);
    pg8::Gemm g{(const bf16*)(F.ws + WS_PB) + 1792, (const bf16*)(F.ws + WS_WD) + (size_t)l * 1024 * 384, M, 1024, 384, NPJ, nullptr}; pg8::StaticOrder S; S.init(M, 1024, F.G, F.bid);
    EpiMla E{(bf16*)(F.ws + WS_QD), (bf16*)(F.ws + WS_KD), (bf16*)(F.ws + WS_VD)};
    pg8::gemm_phase<EpiMla, pg8::StaticOrder, true, true>(F.lds, g, S, E);
}
template <int VM>
PHASE_FN ph_attn(GAS unsigned char* ws, int l) { const Frame F = make_frame(ws); phase_attn<VM>(F, l); }
PHASE_FN ph_gemm_out(GAS unsigned char* ws, int l) {
    const Frame F = make_frame(ws);
    pg8::Gemm g{(const bf16*)(F.ws + WS_HA), (const bf16*)(F.ws + WS_WOUT) + (size_t)l * D * D, M, D, D, D, nullptr};
    pg8::EpiBf16NT<0> E{(bf16*)(F.ws + WS_PB), D, nullptr, 0, 0, 1.f};
    if (l == NL - 1) { LatOrder S{F.G, F.bid}; pg8::gemm_phase<pg8::EpiBf16NT<0>, LatOrder, true, true>(F.lds, g, S, E); }
    else { pg8::StaticOrder S; S.init(M, D, F.G, F.bid); pg8::gemm_phase<pg8::EpiBf16NT<0>, pg8::StaticOrder, true, true>(F.lds, g, S, E); }
}
PHASE_FN ph_route(GAS unsigned char* ws, int l) { const Frame F = make_frame(ws); phase_route(F, l); }
PHASE_FN ph_permute(GAS unsigned char* ws, int l) { const Frame F = make_frame(ws); phase_permute(F, l); }
PHASE_FN ph_gemm_gu(GAS unsigned char* ws, int l) {
    const Frame F = make_frame(ws);
    moe_tables(F);
    pg8::Gemm g{(const bf16*)(F.ws + WS_HA), (const bf16*)(F.ws + WS_WGU) + (size_t)l * 16384 * 1024, MS, 16384, D, D, (const int*)(F.ws + WS_QD)}; MoeOrder S{F.MISC + MI_PST, F.G, F.bid};
    EpiGU E{(bf16*)(F.ws + WS_ACT)};
    pg8::gemm_phase<EpiGU, MoeOrder, true, true, true>(F.lds, g, S, E);
}
PHASE_FN ph_gemm_dn(GAS unsigned char* ws, int l) {
    const Frame F = make_frame(ws);
    moe_tables(F);
    pg8::Gemm g{(const bf16*)(F.ws + WS_ACT), (const bf16*)(F.ws + WS_WDN) + (size_t)l * 16384 * 512, MS, 16384, 512, 512, nullptr}; MoeOrder S{F.MISC + MI_PST, F.G, F.bid};
    pg8::EpiBf16NT<0> E{(bf16*)(F.ws + WS_PB), D, nullptr, 1024, 0, 1.f};
    pg8::gemm_phase<pg8::EpiBf16NT<0>, MoeOrder, true, true>(F.lds, g, S, E);
}


#if MK_DEBUG
#ifndef DBG_MODE
#define DBG_MODE 0
#endif
__device__ __forceinline__ float oracle_attn(const Frame& F, int l, int r, int var, int h, int mode = 0) {
    const bf16* P = (const bf16*)(F.ws + WS_PB); const bf16* QD = (const bf16*)(F.ws + WS_QD); const bf16* KD = (const bf16*)(F.ws + WS_KD); const bf16* VD = (const bf16*)(F.ws + WS_VD);
    const bf16* O = (const bf16*)(F.ws + WS_HA); const float* t32 = (const float*)(F.ws + WS_T32);
    const int b = r / TT, t = r - b * TT; const bool lat = t < SEQ; const size_t rb = (size_t)b * TT;
    const int dk = var == 3 ? 96 : 64;
    const bf16* qp; const bf16* kp; const bf16* vp; int kpitch, vpitch;
    if (var == 3) { qp = QD + (size_t)r * 384 + h * 96; kp = KD + rb * 384 + h * 96; kpitch = 384; vp = VD + rb * 256 + h * 64; vpitch = 256; }
    else { const int qc = var == 0 ? h * 64 : var == 1 ? 768 + h * 64 : 1280 + h * 64, kc = var == 0 ? 256 + h * 64 : var == 1 ? 1024 + (h >> 1) * 64 : 1536 + (h >> 1) * 64,
           vc = var == 0 ? 512 + h * 64 : var == 1 ? 1152 + (h >> 1) * 64 : 1664 + (h >> 1) * 64;
           qp = P + (size_t)r * NPJ + qc; kp = P + rb * NPJ + kc; kpitch = NPJ; vp = P + rb * NPJ + vc; vpitch = NPJ; }
    LAS float* qs = (LAS float*)(F.lds + 65536) + F.wave * 128;
    for (int d = F.lane; d < dk; d += 64) qs[d] = __builtin_bit_cast(float, (unsigned)qp[d] << 16);
    asm volatile("s_waitcnt lgkmcnt(0)" ::: "memory");
    if (var == 3 && lat && F.lane < 32) {
        const int c = F.lane >> 3, e = F.lane & 7, gr = t >> 6, gc = t & 63; const float own = qs[64 + F.lane], par = qs[64 + (F.lane ^ 8)];
        const float cs = t32[((c < 2 ? gr : gc) * 8 + e) * 2], sn = t32[((c < 2 ? gr : gc) * 8 + e) * 2 + 1];
        const float nv = (c & 1) == 0 ? own * cs - par * sn : par * sn + own * cs;
        asm volatile("s_waitcnt lgkmcnt(0)" ::: "memory"); qs[64 + F.lane] = nv; }
    asm volatile("s_waitcnt lgkmcnt(0)" ::: "memory");
    const float scale = var == 3 ? 0.10206207261596575f : 0.125f;
    const int gr = t >> 6, gc = t & 63, r0 = min(max(gr - 4, 0), 56), c0 = min(max(gc - 8, 0), 48);
    float m = -3.0e38f, lsum = 0.f, acc[64];
#pragma unroll
    for (int d = 0; d < 64; ++d) acc[d] = 0.f;
    for (int j = F.lane; j < TT; j += 64) {
        bool ok = true; float bias = 0.f;
        if (!lat) ok = j >= SEQ;
        else if (j < SEQ) {
            if (var == 0) { const int kr = j >> 6, kc2 = j & 63; ok = kr >= r0 && kr <= r0 + 7 && kc2 >= c0 && kc2 <= c0 + 15;
                if (ok) bias = INP(I_NABIAS)[((l * 4 + h) * 15 + (kr - gr + 7)) * 31 + (kc2 - gc + 15)]; }
            else if (var == 2) ok = (j - t <= 128) && (t - j <= 128);
        }
        if (!ok) continue;
        float sc = 0.f; const bf16* kr_ = kp + (size_t)j * kpitch;
        for (int d = 0; d < dk; ++d) sc += qs[d] * __builtin_bit_cast(float, (unsigned)kr_[d] << 16);
        sc = sc * scale + bias;
        const float mn = fmaxf(m, sc), a = expf(m - mn), p = expf(sc - mn); m = mn; lsum = lsum * a + p;
        const bf16* vr = vp + (size_t)j * vpitch;
#pragma unroll
        for (int d = 0; d < 64; ++d) acc[d] = acc[d] * a + p * __builtin_bit_cast(float, (unsigned)vr[d] << 16);
    }
    float mg = m;
#pragma unroll
    for (int o = 1; o < 64; o <<= 1) mg = fmaxf(mg, __shfl_xor(mg, o));
    if (mode >= 1) {
        const unsigned* rec = (const unsigned*)(F.ws + WS_RS) + (size_t)r * 2; const float mk = __builtin_bit_cast(float, rec[0]), lk = __builtin_bit_cast(float, rec[1]);
        const float lref = wave_sum(lsum * expf(m - mg));
        const float lker = lk * exp2f(mk - mg * LOG2E);
        if (mode == 2) return fabsf(mk / LOG2E - mg);
        return fabsf(lker / lref - 1.0f);
    }
    const float f = expf(m - mg); lsum *= f; lsum = wave_sum(lsum);
    if (var == 2) lsum += expf(INP(I_SINK)[l * 4 + h] - mg);
    float err = 0.f, mag = 1.0e-6f;
    const bf16* orow = O + (size_t)r * D + var * 256 + h * 64;
#pragma unroll
    for (int d = 0; d < 64; ++d) { const float ref = wave_sum(acc[d] * f) / lsum; const float got = __builtin_bit_cast(float, (unsigned)orow[d] << 16);
        const float df = fabsf(got - ref); err = (df == df) ? fmaxf(err, df) : 1.0e30f; mag = fmaxf(mag, fabsf(ref)); }
    return err / mag;
}
__device__ __forceinline__ void phase_dump(const Frame& F, int code) {
    float* out = (float*)ptab_get(F, I_OUT);
    for (int r = F.gw; r < M; r += F.ngw) {
        const int b = r / TT, t = r - b * TT; if (t >= SEQ) continue;
        float v[16];
        if (code == 1) ld16bf((const bf16*)(F.ws + WS_HA) + (size_t)r * D, F.lane, v);
        else if (code == 2) ld16bf((const bf16*)(F.ws + WS_PB) + (size_t)r * NPJ, F.lane, v);
        else if (code == 3) ld16bf((const bf16*)(F.ws + WS_PB) + (size_t)r * NPJ + 1024, F.lane, v);
        else if (code == 4) ld16bf((const bf16*)(F.ws + WS_PB) + (size_t)r * NPJ + 1280, F.lane, v);
        else if (code == 5) ld16((const float*)(F.ws + WS_PB) + (size_t)r * D, F.lane, v);
        else if (code == 8) {
            const v4u w0 = *((const v4u*)((const bf16*)(F.ws + WS_HA) + (size_t)r * D) + F.lane), w1 = *((const v4u*)((const bf16*)(F.ws + WS_HA) + (size_t)r * D) + 64 + F.lane);
            float f[8]; int bad0 = 0, bad1 = 0; unpack8(w0, f);
#pragma unroll
            for (int i = 0; i < 8; ++i) { const unsigned u = __builtin_bit_cast(unsigned, f[i]); bad0 |= ((u & 0x7f800000u) == 0x7f800000u) ? 1 : 0; }
            unpack8(w1, f);
#pragma unroll
            for (int i = 0; i < 8; ++i) { const unsigned u = __builtin_bit_cast(unsigned, f[i]); bad1 |= ((u & 0x7f800000u) == 0x7f800000u) ? 1 : 0; }
            const unsigned long long m0 = __ballot(bad0), m1 = __ballot(bad1);
            const bool vA = (m0 & 0xffffffffull) != 0, vB = (m0 >> 32) != 0, vC = (m1 & 0xffffffffull) != 0, vD = (m1 >> 32) != 0;
            const float val = (float)(t + 1) * ((vA ? 1.0f : 0.f) + (vB ? 1.0e2f : 0.f) + (vC ? 1.0e4f : 0.f) + (vD ? 1.0e6f : 0.f));
#pragma unroll
            for (int i = 0; i < 16; ++i) v[i] = val;
        }
        else if (code == 9) { const unsigned cd = ((const unsigned*)(F.ws + WS_RS))[(size_t)r * 2]; float val = 0.f; if (cd) { val = 1.f; for (unsigned k = 0; k < cd; ++k) val *= 10.f; }
#pragma unroll
            for (int i = 0; i < 16; ++i) v[i] = val; }
        else if (code == 10) {
            const v4u w1 = *((const v4u*)((const bf16*)(F.ws + WS_HA) + (size_t)r * D) + 64 + F.lane);
            float f[8]; int bad1 = 0; unpack8(w1, f);
#pragma unroll
            for (int i = 0; i < 8; ++i) { const unsigned u = __builtin_bit_cast(unsigned, f[i]); bad1 |= ((u & 0x7f800000u) == 0x7f800000u) ? 1 : 0; }
            const bool vC = (__ballot(bad1) & 0xffffffffull) != 0;
            const bf16* pc = (const bf16*)(F.ws + WS_PB) + ((size_t)b * TT + SEQ + (t & 255)) * NPJ; int badp = 0;
            for (int c = F.lane; c < 288; c += 64) { const v4u w = *((const v4u*)pc + c); unpack8(w, f);
#pragma unroll
                for (int i = 0; i < 8; ++i) { const unsigned u = __builtin_bit_cast(unsigned, f[i]); badp |= ((u & 0x7f800000u) == 0x7f800000u) ? 1 : 0; } }
            float val = 0.f; if (vC) { val = 1.f; for (int k = 0; k <= (t & 15); ++k) val *= 10.f; }
            if (__any(badp)) val = 1.0e30f;
#pragma unroll
            for (int i = 0; i < 16; ++i) v[i] = val;
        }
        else if (code == 11) {
            const bf16* pr = (const bf16*)(F.ws + WS_PB) + (size_t)r * NPJ; int grp = -1;
            for (int c = F.lane; c < 288; c += 64) { const v4u w = *((const v4u*)pr + c); float f[8]; unpack8(w, f);
#pragma unroll
                for (int i = 0; i < 8; ++i) if (!(fabsf(f[i]) < 1.0e4f)) grp = (c * 8) >> 8; }
#pragma unroll
            for (int o = 1; o < 64; o <<= 1) { const int g2 = __shfl_xor(grp, o); grp = g2 > grp ? g2 : grp; }
            float val = 0.f; if (grp >= 0) { val = 100.f; for (int k = 0; k < grp; ++k) val *= 10.f; }
#pragma unroll
            for (int i = 0; i < 16; ++i) v[i] = val;
        }
        else if (code >= 20 && code < 24) {
            float val = 0.f;
            if ((t & 15) == 5) { for (int h = 0; h < 4; ++h) { const float e = oracle_attn(F, 0, r, code - 20, h); const float cls = e > 1.0e20f ? 3.f : e > 0.5f ? 2.f : e > 0.03f ? 1.f : 0.f; if (cls > 0.f) { float w = cls; for (int k = 0; k <= h; ++k) w *= 10.f; val = fmaxf(val, w); } } }
#pragma unroll
            for (int i = 0; i < 16; ++i) v[i] = val;
        }
        else if (code >= 30 && code < 46) {
            float val = 0.f;
            if ((t & 15) == 5) { const float e = oracle_attn(F, 0, r, (code - 30) >> 2, (code - 30) & 3, DBG_MODE); val = e > 10.f ? 1.0e4f : 1000.f * e; }
#pragma unroll
            for (int i = 0; i < 16; ++i) v[i] = val;
        }
        else if (code == 7) {
            auto bad16 = [&](const bf16* p, int nchunks) { int bad = 0; for (int c = F.lane; c < nchunks; c += 64) { const v4u w = *((const v4u*)p + c); float f[8]; unpack8(w, f);
#pragma unroll
                for (int i = 0; i < 8; ++i) { const unsigned u = __builtin_bit_cast(unsigned, f[i]); bad |= ((u & 0x7f800000u) == 0x7f800000u) ? 1 : 0; } } return __any(bad); };
            const int bP = bad16((const bf16*)(F.ws + WS_PB) + (size_t)r * NPJ, 288), bQ = bad16((const bf16*)(F.ws + WS_QD) + (size_t)r * 384, 48),
                      bK = bad16((const bf16*)(F.ws + WS_KD) + (size_t)r * 384, 48), bV = bad16((const bf16*)(F.ws + WS_VD) + (size_t)r * 256, 32), bO = bad16((const bf16*)(F.ws + WS_HA) + (size_t)r * D, 128);
            const float val = bP ? 1.0e6f : bQ ? 1.0e5f : bK ? 1.0e4f : bV ? 1.0e3f : bO ? 1.0e2f : 0.f;
#pragma unroll
            for (int i = 0; i < 16; ++i) v[i] = val;
        }
#pragma unroll
        for (int i = 0; i < 16; ++i) { const unsigned u = __builtin_bit_cast(unsigned, v[i]); if ((u & 0x7f800000u) == 0x7f800000u) v[i] = 777.0f; }
        st16(out + ((size_t)b * SEQ + t) * D, F.lane, v);
    }
}
static __device__ __forceinline__ void ph_dump(GAS unsigned char* ws, int code) { const Frame F = make_frame(ws); phase_dump(F, code); }
#endif
__global__ void __launch_bounds__(NTHR, 2) mk_fwd(Args args) {
    extern __shared__ __attribute__((aligned(16))) unsigned char lds_raw[];
    LAS unsigned char* lds = (LAS unsigned char*)lds_raw; volatile LAS unsigned* MISC = (volatile LAS unsigned*)(lds + MISC_OFF);
    const int tid = threadIdx.x;
    GAS unsigned char* ws = (GAS unsigned char*)args.ws;
    for (int u = tid; u < (LDS_BYTES - MISC_OFF) / 4; u += NTHR) MISC[u] = 0u;
    __syncthreads();
    if (tid < 28) { const unsigned long long p = tid < 27 ? (unsigned long long)args.in[tid] : (unsigned long long)args.out;
        LAS unsigned* t = (LAS unsigned*)(lds + PTAB_OFF) + 2 * tid; t[0] = (unsigned)p; t[1] = (unsigned)(p >> 32); }
    __syncthreads();
#if MK_MULTI
#define GRID_BAR() do { } while (0)
#else
    XcdBarrier bar = xcd_barrier_post((unsigned*)(ws + WS_CTL) + CW_BAR, MISC + MI_BAR);
#define GRID_BAR() xcd_barrier(bar)
#endif
    const int lo = args.ph_lo, hi = args.ph_hi;
#define IN(k) (lo <= (k) && (k) < hi)
#if MK_TIME
    unsigned long long tcat = 0ull, tb0 = 0ull;
#define TBEG() do { tb0 = __builtin_amdgcn_s_memrealtime(); } while (0)
#define TEND(c) do { if ((c) == MK_TIME - 1) tcat += __builtin_amdgcn_s_memrealtime() - tb0; } while (0)
#define SEAM(k) do { if (IN(k) && IN((k) + 1)) { TBEG(); GRID_BAR(); TEND(1); } } while (0)
#else
#define TBEG() do { } while (0)
#define TEND(c) do { } while (0)
#define SEAM(k) do { if (IN(k) && IN((k) + 1)) GRID_BAR(); } while (0)
#endif

#if MK_DEBUG
    if (lo >= 100) { ph_dump(ws, lo - 100); return; }
#endif
    if (IN(0)) { TBEG(); ph_prologue(ws); TEND(2); } SEAM(0);
    for (int l = 0; l < NL; ++l) {
        const int pb = 1 + 10 * l;
        if (IN(pb + 0)) { TBEG(); ph_ln(ws, l); TEND(0); } SEAM(pb + 0);
        if (IN(pb + 1)) { TBEG(); ph_gemm_in(ws, l); if (MK_DUP & 2) { GRID_BAR(); ph_gemm_in(ws, l); } TEND(3); } SEAM(pb + 1);
        if (IN(pb + 2)) { TBEG(); ph_post(ws, l); TEND(0); } SEAM(pb + 2);
        if (IN(pb + 3)) { TBEG(); ph_gemm_mla(ws, l); if (MK_DUP & 8) { GRID_BAR(); ph_gemm_mla(ws, l); } TEND(3); } SEAM(pb + 3);
        if (IN(pb + 4)) { TBEG(); ph_attn<0>(ws, l); if (MK_DUP & 16) { GRID_BAR(); ph_attn<MK_VM>(ws, l + 4); } TEND(4); } SEAM(pb + 4);
        if (IN(pb + 5)) { TBEG(); ph_gemm_out(ws, l); if (MK_DUP & 32) { GRID_BAR(); ph_gemm_out(ws, l); } TEND(3); } SEAM(pb + 5);
        if (IN(pb + 6)) { TBEG(); ph_route(ws, l); TEND(0); } SEAM(pb + 6);
        if (IN(pb + 7)) { TBEG(); ph_permute(ws, l); if (MK_DUP & 128) { GRID_BAR(); ph_permute(ws, l); } TEND(0); } SEAM(pb + 7);
        if (IN(pb + 8)) { TBEG(); ph_gemm_gu(ws, l); if (MK_DUP & 256) { GRID_BAR(); ph_gemm_gu(ws, l); } TEND(3); } SEAM(pb + 8);
        if (IN(pb + 9)) { TBEG(); ph_gemm_dn(ws, l); if (MK_DUP & 512) { GRID_BAR(); ph_gemm_dn(ws, l); } TEND(3); } SEAM(pb + 9);
    }
    if (IN(NPHASE - 1)) { TBEG(); ph_ln(ws, NL); TEND(0); }
#if MK_TIME
    if (blockIdx.x == 0) { const unsigned long long tw = __builtin_amdgcn_s_memrealtime(); const unsigned long long dl = tcat * (unsigned long long)MK_TMUL; while (__builtin_amdgcn_s_memrealtime() - tw < dl) __builtin_amdgcn_s_sleep(8); }
#endif
#undef IN
#undef SEAM
#undef GRID_BAR
}

extern "C" void kernel_launch(void* const* d_in, const int* in_sizes, int n_in, void* d_out, int out_size, void* d_ws, size_t ws_size, hipStream_t stream) {
    static int grid = 0;
    if (grid == 0) {
        if (n_in != 27 || out_size != NB * SEQ * D || ws_size < WS_END) { fprintf(stderr, "kernel_launch: unexpected problem (n_in %d, out %d, ws %zu < %zu)\n", n_in, out_size, ws_size, (size_t)WS_END); grid = -1; return; }
        int dev = 0, cus = 0, per_cu = 0;
        if (hipGetDevice(&dev) != hipSuccess || hipDeviceGetAttribute(&cus, hipDeviceAttributeMultiprocessorCount, dev) != hipSuccess) { grid = -1; return; }
        if (hipFuncSetAttribute((const void*)mk_fwd, hipFuncAttributeMaxDynamicSharedMemorySize, LDS_BYTES) != hipSuccess) { fprintf(stderr, "kernel_launch: hipFuncSetAttribute failed\n"); grid = -1; return; }
        if (hipOccupancyMaxActiveBlocksPerMultiprocessor(&per_cu, (const void*)mk_fwd, NTHR, LDS_BYTES) != hipSuccess || per_cu < 1) fprintf(stderr, "kernel_launch: occupancy query reports %d\n", per_cu);
        (void)hipGetLastError();
        grid = cus > 1024 ? 1024 : cus;
    }
    if (grid < 0) return;
    (void)hipMemsetAsync((char*)d_ws + WS_CTL, 0, CTL_BYTES, stream);
    Args a{};
    for (int i = 0; i < 27; ++i) a.in[i] = (const float*)d_in[i];
    a.out = (float*)d_out; a.ws = (unsigned char*)d_ws;
#if MK_MULTI
#ifndef DBG_NRUN
#define DBG_NRUN NPHASE
#endif
    for (int p = 0; p < DBG_NRUN; ++p) { a.ph_lo = p; a.ph_hi = p + 1; hipLaunchKernelGGL(mk_fwd, dim3(grid), dim3(NTHR), LDS_BYTES, stream, a); }
#ifdef DBG_DUMP
    a.ph_lo = 100 + DBG_DUMP; a.ph_hi = 101 + DBG_DUMP; hipLaunchKernelGGL(mk_fwd, dim3(grid), dim3(NTHR), LDS_BYTES, stream, a);
#endif
#else
    a.ph_lo = 0; a.ph_hi = NPHASE;
    hipLaunchKernelGGL(mk_fwd, dim3(grid), dim3(NTHR), LDS_BYTES, stream, a);
#endif
}
```

```cpp
#include <hip/hip_runtime.h>
#include <cstdio>
#include <cstdint>
namespace pg8 {
#define PG8_LAS __attribute__((address_space(3)))
typedef unsigned short bf16_t;
typedef short bf16x8 __attribute__((ext_vector_type(8)));
typedef float f32x4 __attribute__((ext_vector_type(4)));
typedef unsigned u32x4 __attribute__((ext_vector_type(4)));
constexpr int BM = 256, BK = 64, HALF = 128, HTB = HALF * BK * 2  , STAGE_BYTES = 8 * HTB, NXCD = 8, WGM = 8;

__host__ __device__ __forceinline__ int lds_byte(int r, int c) { const int st = (r >> 4) * 2 + (c >> 5), rr = r & 15, cc = c & 31, ob = rr * 64 + cc * 2; return st * 1024 + (ob ^ (((ob >> 9) & 1) << 5)); }
__host__ __device__ __forceinline__ void stage_rc(int b, int& R, int& C) { const int st = b / 1024, sb = b % 1024, swz = sb ^ (((sb >> 9) & 1) << 5); R = (st >> 1) * 16 + swz / 64; C = (st & 1) * 32 + (swz % 64) / 2; }
__host__ __device__ __forceinline__ int perm32(int rho) { const int n = rho >> 4, i = rho & 15; return 8 * (i >> 2) + 4 * n + (i & 3); }

struct Unit { int pm, pn; };
struct Gemm { const bf16_t* A; const bf16_t* Bt; int M, N, K, lda; const int* src; };

struct StaticOrder {
    int nM, nN, nwg, G, c;
    __host__ __device__ void init(int M, int N, int G_, int c_) { nM = M / BM; nN = N / BM; nwg = nM * nN; G = G_; c = c_; }
    __host__ __device__ bool next(int i, Unit& u) const {
        const long L = (long)i * G + c; if (L >= nwg) return false;
        int wgid = (int)L; { const int q = nwg / NXCD, r = nwg % NXCD, xcd = wgid % NXCD, off = wgid / NXCD; wgid = (xcd < r ? xcd * (q + 1) : r * (q + 1) + (xcd - r) * q) + off; }
        const int nig = WGM * nN, gid = wgid / nig, fm = gid * WGM, gsz = (nM - fm) < WGM ? (nM - fm) : WGM;
        u.pm = fm + ((wgid % nig) % gsz); u.pn = (wgid % nig) / gsz; return true;
    }
    __device__ __forceinline__ void a_ready(const Unit&) const {}
    __device__ __forceinline__ void done(const Unit&) const {}
};

__device__ __forceinline__ unsigned cvt_pk_bf16(float lo, float hi) { unsigned r; asm volatile("v_cvt_pk_bf16_f32 %0, %1, %2" : "=v"(r) : "v"(lo), "v"(hi)); return r; }
typedef float f32x2 __attribute__((ext_vector_type(2)));
__device__ __forceinline__ f32x2 gelu_pk(f32x2 v) {
    const f32x2 av = __builtin_elementwise_abs(v), d = av * 0.2316418882f + 1.0f;
    f32x2 t; t.x = __builtin_amdgcn_rcpf(d.x); t.y = __builtin_amdgcn_rcpf(d.y);
    f32x2 q = t * 0.5307027145f + (-0.7265760135f); q = q * t + 0.7107068705f; q = q * t + (-0.142248368f); q = q * t + 0.127414796f; q = q * t;
    const f32x2 s = (v * v) * (-0.72134752044f);
    f32x2 e; e.x = __builtin_amdgcn_exp2f(s.x); e.y = __builtin_amdgcn_exp2f(s.y);
    const f32x2 m = v * (q * e), r = v - m;
    f32x2 o; o.x = v.x < 0.f ? m.x : r.x; o.y = v.y < 0.f ? m.y : r.y; return o;
}

template <int ACT  > struct EpiBf16 {
    static constexpr bool PERM = true, AFTER_DRAIN = false; static_assert(ACT == 0 || ACT == 1, "EpiBf16: ACT is 0 (none) or 1 (gelu_pk)");
    bf16_t* O; int ldc; const float* bias; int split_cols; size_t split_stride; float scale0;
    __device__ __forceinline__ void operator()(const f32x4 (&acc)[2][2][4][2], const Unit& u, int wr, int wc, int fr, int fq) const {
        const int row0 = u.pm * BM + wr * 64 + fr; int colt = u.pn * BM; bf16_t* base = O;
        float sc = 1.f; if (split_cols) { const int t = colt / split_cols; base += (size_t)t * split_stride; colt -= t * split_cols; if (t == 0) sc = scale0; }
        const int col0 = colt + wc * 32 + 8 * fq, bcol0 = u.pn * BM + wc * 32 + 8 * fq;
        f32x4 bv[2][2];
#pragma unroll
        for (int bj = 0; bj < 2; ++bj)
#pragma unroll
            for (int n = 0; n < 2; ++n) bv[bj][n] = bias ? *(const f32x4*)(bias + bcol0 + bj * HALF + 4 * n) : (f32x4){0.f, 0.f, 0.f, 0.f};
#pragma unroll
        for (int ai = 0; ai < 2; ++ai)
#pragma unroll
            for (int m = 0; m < 4; ++m) { bf16_t* rowp = base + (size_t)(row0 + ai * HALF + m * 16) * ldc + col0;
#pragma unroll
                for (int bj = 0; bj < 2; ++bj) { f32x4 v0 = acc[ai][bj][m][0] + bv[bj][0], v1 = acc[ai][bj][m][1] + bv[bj][1];
                    if (ACT == 1) { f32x2 a = gelu_pk((f32x2){v0[0], v0[1]}), b = gelu_pk((f32x2){v0[2], v0[3]}), c = gelu_pk((f32x2){v1[0], v1[1]}), d = gelu_pk((f32x2){v1[2], v1[3]});
                        v0 = (f32x4){a.x, a.y, b.x, b.y}; v1 = (f32x4){c.x, c.y, d.x, d.y}; }
                    v0 = v0 * sc; v1 = v1 * sc; u32x4 w; w.x = cvt_pk_bf16(v0[0], v0[1]); w.y = cvt_pk_bf16(v0[2], v0[3]); w.z = cvt_pk_bf16(v1[0], v1[1]); w.w = cvt_pk_bf16(v1[2], v1[3]);
                    *(u32x4*)(rowp + bj * HALF) = w; } }
    }
};
template <int ACT  > struct EpiBf16NT {
    static constexpr bool PERM = true, AFTER_DRAIN = false; static_assert(ACT == 0 || ACT == 1, "EpiBf16: ACT is 0 (none) or 1 (gelu_pk)");
    bf16_t* O; int ldc; const float* bias; int split_cols; size_t split_stride; float scale0;
    __device__ __forceinline__ void operator()(const f32x4 (&acc)[2][2][4][2], const Unit& u, int wr, int wc, int fr, int fq) const {
        const int row0 = u.pm * BM + wr * 64 + fr; int colt = u.pn * BM; bf16_t* base = O;
        float sc = 1.f; if (split_cols) { const int t = colt / split_cols; base += (size_t)t * split_stride; colt -= t * split_cols; if (t == 0) sc = scale0; }
        const int col0 = colt + wc * 32 + 8 * fq, bcol0 = u.pn * BM + wc * 32 + 8 * fq;
        f32x4 bv[2][2];
#pragma unroll
        for (int bj = 0; bj < 2; ++bj)
#pragma unroll
            for (int n = 0; n < 2; ++n) bv[bj][n] = bias ? *(const f32x4*)(bias + bcol0 + bj * HALF + 4 * n) : (f32x4){0.f, 0.f, 0.f, 0.f};
#pragma unroll
        for (int ai = 0; ai < 2; ++ai)
#pragma unroll
            for (int m = 0; m < 4; ++m) { bf16_t* rowp = base + (size_t)(row0 + ai * HALF + m * 16) * ldc + col0;
#pragma unroll
                for (int bj = 0; bj < 2; ++bj) { f32x4 v0 = acc[ai][bj][m][0] + bv[bj][0], v1 = acc[ai][bj][m][1] + bv[bj][1];
                    if (ACT == 1) { f32x2 a = gelu_pk((f32x2){v0[0], v0[1]}), b = gelu_pk((f32x2){v0[2], v0[3]}), c = gelu_pk((f32x2){v1[0], v1[1]}), d = gelu_pk((f32x2){v1[2], v1[3]});
                        v0 = (f32x4){a.x, a.y, b.x, b.y}; v1 = (f32x4){c.x, c.y, d.x, d.y}; }
                    v0 = v0 * sc; v1 = v1 * sc; u32x4 w; w.x = cvt_pk_bf16(v0[0], v0[1]); w.y = cvt_pk_bf16(v0[2], v0[3]); w.z = cvt_pk_bf16(v1[0], v1[1]); w.w = cvt_pk_bf16(v1[2], v1[3]);
                    __builtin_nontemporal_store(w, (u32x4*)(rowp + bj * HALF)); } }
    }
};
struct EpiF32 {
    static constexpr bool PERM = false, AFTER_DRAIN = false;
    float* C; int ldc; const float* bias;
    __device__ __forceinline__ void operator()(const f32x4 (&acc)[2][2][4][2], const Unit& u, int wr, int wc, int fr, int fq) const {
        const int row0 = u.pm * BM + wr * 64 + fr, col0 = u.pn * BM + wc * 32 + 4 * fq;
        f32x4 bv[2][2];
#pragma unroll
        for (int bj = 0; bj < 2; ++bj)
#pragma unroll
            for (int n = 0; n < 2; ++n) bv[bj][n] = bias ? *(const f32x4*)(bias + col0 + bj * HALF + n * 16) : (f32x4){0.f, 0.f, 0.f, 0.f};
#pragma unroll
        for (int ai = 0; ai < 2; ++ai)
#pragma unroll
            for (int m = 0; m < 4; ++m) { float* rowp = C + (size_t)(row0 + ai * HALF + m * 16) * ldc + col0;
#pragma unroll
                for (int bj = 0; bj < 2; ++bj)
#pragma unroll
                    for (int n = 0; n < 2; ++n) *(f32x4*)(rowp + bj * HALF + n * 16) = acc[ai][bj][m][n] + bv[bj][n]; }
    }
};
template <class Epi, class Sched, bool ALIGN_EPI = false, bool SP2 = false, bool GATHER = false>
__device__ __forceinline__ void gemm_phase(PG8_LAS unsigned char* lds, const Gemm g, const Sched& S, const Epi& E) {
    int tid = threadIdx.x; asm volatile("" : "+v"(tid)); const int wid = __builtin_amdgcn_readfirstlane(tid >> 6), lane = tid & 63, wr = wid >> 2, wc = wid & 3, fr = lane & 15, fq = lane >> 4;
    const int K = g.K, nt = K / BK;
    unsigned voffA[2], voffB[2]; int RA[2]; unsigned CA2[2];
#pragma unroll
    for (int i = 0; i < 2; ++i) { int R, C; stage_rc(tid * 16 + i * 8192, R, C); const int Rb = Epi::PERM ? ((R & ~31) + perm32(R & 31)) : R;
        voffA[i] = (unsigned)(R * g.lda + C) * 2u; voffB[i] = (unsigned)(Rb * K + C) * 2u; RA[i] = R; CA2[i] = (unsigned)C * 2u; }
    unsigned gcur[2][2] = {{0u, 0u}, {0u, 0u}}, gnxt[2][2] = {{0u, 0u}, {0u, 0u}};
#define PG8_GOFF(dst, u_) do { _Pragma("unroll") for (int h_ = 0; h_ < 2; ++h_) _Pragma("unroll") for (int i_ = 0; i_ < 2; ++i_) \
        dst[h_][i_] = (unsigned)g.src[(u_).pm * BM + h_ * HALF + RA[i_]] * (unsigned)(g.lda * 2) + CA2[i_]; } while (0)
#define PG8_STAGE_A(bufoff, gbase, h, nx) do { if constexpr (GATHER) { unsigned vs_[2] = {(nx) ? gnxt[h][0] : gcur[h][0], (nx) ? gnxt[h][1] : gcur[h][1]}; PG8_STAGE(bufoff, gbase, vs_); } \
        else { PG8_STAGE(bufoff, (gbase) + ((h) ? hstepA : 0), voffA); } } while (0)
    const size_t kstep = (size_t)(BK * 2);
    const size_t hstepA = (size_t)HALF * g.lda * 2, hstepB = (size_t)HALF * K * 2;
    const size_t tstepA = 2 * hstepA, tstepB = 2 * hstepB;
    const unsigned ldsw = (unsigned)wid * 1024u;
    const int aoff = lds_byte(wr * 64 + fr, fq * 8), boff = lds_byte(wc * 32 + fr, fq * 8);
#define PG8_SA(b, h) (((b) * 2 + (h)) * HTB)
#define PG8_SB(b, h) ((4 + (b) * 2 + (h)) * HTB)
#define PG8_STAGE(bufoff, gbase, voff) do { _Pragma("unroll") for (int _i = 0; _i < 2; ++_i) \
        __builtin_amdgcn_global_load_lds((const unsigned*)((const char*)(gbase) + (voff)[_i]), (PG8_LAS unsigned*)(lds + (bufoff) + ldsw + _i * 8192), 16, 0, 0); } while (0)
#define PG8_LDA(dst, b, h) do { _Pragma("unroll") for (int m = 0; m < 4; ++m) _Pragma("unroll") for (int k = 0; k < 2; ++k) dst[m][k] = *(const PG8_LAS bf16x8*)(lds + PG8_SA(b, h) + aoff + m * 2048 + k * 1024); } while (0)
#define PG8_LDB(dst, b, h) do { _Pragma("unroll") for (int n = 0; n < 2; ++n) _Pragma("unroll") for (int k = 0; k < 2; ++k) dst[n][k] = *(const PG8_LAS bf16x8*)(lds + PG8_SB(b, h) + boff + n * 2048 + k * 1024); } while (0)
#define PG8_MMA(ai, bj, At, Bt) do { __builtin_amdgcn_s_setprio(1); _Pragma("unroll") for (int m = 0; m < 4; ++m) _Pragma("unroll") for (int n = 0; n < 2; ++n) _Pragma("unroll") for (int k = 0; k < 2; ++k) \
        acc[ai][bj][m][n] = __builtin_amdgcn_mfma_f32_16x16x32_bf16(Bt[n][k], At[m][k], acc[ai][bj][m][n], 0, 0, 0); __builtin_amdgcn_s_setprio(0); } while (0)
#define PG8_WAIT_V(n) asm volatile("s_waitcnt vmcnt(" #n ")" ::: "memory")
#define PG8_WAIT_L(n) asm volatile("s_waitcnt lgkmcnt(" #n ")" ::: "memory")
#define PG8_BAR __builtin_amdgcn_s_barrier()
#define PG8_SCHED __builtin_amdgcn_sched_barrier(0)
    Unit cur, nxt; int ui = 0;
    if (!S.next(0, cur)) return;
    f32x4 acc[2][2][4][2];
#pragma unroll
    for (int a = 0; a < 2; ++a)
#pragma unroll
        for (int b = 0; b < 2; ++b)
#pragma unroll
            for (int m = 0; m < 4; ++m)
#pragma unroll
                for (int n = 0; n < 2; ++n) acc[a][b][m][n] = (f32x4){0.f, 0.f, 0.f, 0.f};
    bf16x8 At[4][2], B0[2][2], B1[2][2];
    const char* cA = (const char*)g.A + (GATHER ? (size_t)0 : (size_t)cur.pm * tstepA); const char* cB = (const char*)g.Bt + (size_t)cur.pn * tstepB;
    if constexpr (GATHER) PG8_GOFF(gcur, cur);
    S.a_ready(cur);
    if constexpr (SP2) {
        PG8_STAGE(PG8_SB(0, 0), cB, voffB); PG8_STAGE(PG8_SB(0, 1), cB + hstepB, voffB); PG8_STAGE_A(PG8_SA(0, 0), cA, 0, false); PG8_STAGE_A(PG8_SA(0, 1), cA, 1, false);
        if (wr == 1) PG8_BAR;
        PG8_WAIT_V(2); PG8_BAR;
        PG8_STAGE(PG8_SB(1, 0), cB + kstep, voffB); PG8_STAGE_A(PG8_SA(1, 0), cA + kstep, 0, false); PG8_STAGE(PG8_SB(1, 1), cB + hstepB + kstep, voffB);
        PG8_WAIT_V(6); PG8_BAR;
    } else {
        PG8_STAGE(PG8_SB(0, 0), cB, voffB); PG8_STAGE_A(PG8_SA(0, 0), cA, 0, false); PG8_STAGE(PG8_SB(0, 1), cB + hstepB, voffB); PG8_STAGE_A(PG8_SA(0, 1), cA, 1, false);
        if (wr == 1) PG8_BAR;
        PG8_WAIT_V(4); PG8_BAR;
        PG8_STAGE(PG8_SB(1, 0), cB + kstep, voffB); PG8_STAGE_A(PG8_SA(1, 0), cA + kstep, 0, false); PG8_STAGE(PG8_SB(1, 1), cB + hstepB + kstep, voffB);
        PG8_WAIT_V(6); PG8_BAR;
    }
    for (;;) {
        const bool has_next = S.next(ui + 1, nxt);
        const char* nA = (has_next && !GATHER) ? (const char*)g.A + (size_t)nxt.pm * tstepA : cA; const char* nB = has_next ? (const char*)g.Bt + (size_t)nxt.pn * tstepB : cB;
        if constexpr (GATHER) { if (has_next) PG8_GOFF(gnxt, nxt); else { _Pragma("unroll") for (int h_ = 0; h_ < 2; ++h_) { gnxt[h_][0] = gcur[h_][0]; gnxt[h_][1] = gcur[h_][1]; } } }
#pragma unroll 1
        for (int t = 0; t < nt; t += 2) {
            const bool last = (t == nt - 2);
            const char* a1 = cA + (size_t)(t + 1) * kstep;
            const char* a2 = last ? nA : cA + (size_t)(t + 2) * kstep; const char* b2 = last ? nB : cB + (size_t)(t + 2) * kstep;
            const char* a3 = a2 + kstep; const char* b3 = b2 + kstep;
            if (last && has_next) S.a_ready(nxt);
            if constexpr (SP2) {
            PG8_LDB(B0, 0, 0); PG8_LDB(B1, 0, 1); PG8_SCHED; PG8_LDA(At, 0, 0); PG8_STAGE_A(PG8_SA(1, 1), a1, 1, false);
            PG8_WAIT_V(8); PG8_WAIT_L(0); PG8_BAR; PG8_MMA(0, 0, At, B0); PG8_MMA(0, 1, At, B1); PG8_BAR; PG8_SCHED;
            PG8_LDA(At, 0, 1); PG8_STAGE(PG8_SB(0, 0), b2, voffB); PG8_STAGE(PG8_SB(0, 1), b2 + hstepB, voffB); PG8_STAGE_A(PG8_SA(0, 0), a2, 0, last);
            PG8_WAIT_V(8); PG8_WAIT_L(0); PG8_BAR; PG8_MMA(1, 0, At, B0); PG8_MMA(1, 1, At, B1); PG8_BAR; PG8_SCHED;
            PG8_LDB(B0, 1, 0); PG8_LDB(B1, 1, 1); PG8_SCHED; PG8_LDA(At, 1, 0); PG8_STAGE_A(PG8_SA(0, 1), a2, 1, last);
            PG8_WAIT_V(8); PG8_WAIT_L(0); PG8_BAR; PG8_MMA(0, 0, At, B0); PG8_MMA(0, 1, At, B1); PG8_BAR; PG8_SCHED;
            PG8_LDA(At, 1, 1); PG8_STAGE(PG8_SB(1, 0), b3, voffB); PG8_STAGE(PG8_SB(1, 1), b3 + hstepB, voffB); PG8_STAGE_A(PG8_SA(1, 0), a3, 0, last);
            PG8_WAIT_V(8); PG8_WAIT_L(0); PG8_BAR; PG8_MMA(1, 0, At, B0); PG8_MMA(1, 1, At, B1); PG8_BAR; PG8_SCHED;
            } else {
            PG8_LDB(B0, 0, 0); PG8_SCHED; PG8_LDA(At, 0, 0); PG8_STAGE_A(PG8_SA(1, 1), a1, 1, false);
            PG8_WAIT_L(8); PG8_BAR; PG8_WAIT_L(0); PG8_MMA(0, 0, At, B0); PG8_BAR; PG8_SCHED;
            PG8_LDB(B1, 0, 1); PG8_STAGE(PG8_SB(0, 0), b2, voffB);
            PG8_BAR; PG8_WAIT_L(0); PG8_MMA(0, 1, At, B1); PG8_BAR;
            PG8_LDA(At, 0, 1); PG8_STAGE_A(PG8_SA(0, 0), a2, 0, last);
            PG8_BAR; PG8_WAIT_L(0); PG8_MMA(1, 0, At, B0); PG8_BAR; PG8_SCHED;
            PG8_STAGE(PG8_SB(0, 1), b2 + hstepB, voffB);
            PG8_WAIT_V(6); PG8_BAR; PG8_MMA(1, 1, At, B1); PG8_BAR;
            PG8_LDB(B0, 1, 0); PG8_SCHED; PG8_LDA(At, 1, 0); PG8_STAGE_A(PG8_SA(0, 1), a2, 1, last);
            PG8_WAIT_L(8); PG8_BAR; PG8_WAIT_L(0); PG8_MMA(0, 0, At, B0); PG8_BAR; PG8_SCHED;
            PG8_LDB(B1, 1, 1); PG8_STAGE(PG8_SB(1, 0), b3, voffB);
            PG8_BAR; PG8_WAIT_L(0); PG8_MMA(0, 1, At, B1); PG8_BAR;
            PG8_LDA(At, 1, 1); PG8_STAGE_A(PG8_SA(1, 0), a3, 0, last);
            PG8_BAR; PG8_WAIT_L(0); PG8_MMA(1, 0, At, B0); PG8_BAR; PG8_SCHED;
            PG8_STAGE(PG8_SB(1, 1), b3 + hstepB, voffB);
            PG8_WAIT_V(6); PG8_BAR; PG8_MMA(1, 1, At, B1); PG8_BAR;
            }
        }
        if constexpr (ALIGN_EPI) { if (wr == 0) PG8_BAR; }
        if constexpr (!Epi::AFTER_DRAIN) { E(acc, cur, wr, wc, fr, fq); S.done(cur); }
        if (!has_next) break;
#pragma unroll
        for (int a = 0; a < 2; ++a)
#pragma unroll
            for (int b = 0; b < 2; ++b)
#pragma unroll
                for (int m = 0; m < 4; ++m)
#pragma unroll
                    for (int n = 0; n < 2; ++n) acc[a][b][m][n] = (f32x4){0.f, 0.f, 0.f, 0.f};
        cur = nxt; cA = nA; cB = nB; ++ui;
        if constexpr (GATHER) { _Pragma("unroll") for (int h_ = 0; h_ < 2; ++h_) { gcur[h_][0] = gnxt[h_][0]; gcur[h_][1] = gnxt[h_][1]; } }
        if constexpr (ALIGN_EPI) { if (wr == 1) PG8_BAR; }
    }
    PG8_WAIT_V(0);
    if constexpr (!ALIGN_EPI) { if (wr == 0) PG8_BAR; }
    PG8_BAR;
    if constexpr (Epi::AFTER_DRAIN) { E.fused(acc, cur, wr, wc, fr, fq, lds, wid, lane); S.done(cur); }
#undef PG8_SA
#undef PG8_GOFF
#undef PG8_STAGE_A
#undef PG8_SB
#undef PG8_STAGE
#undef PG8_LDA
#undef PG8_LDB
#undef PG8_MMA
#undef PG8_WAIT_V
#undef PG8_WAIT_L
#undef PG8_BAR
#undef PG8_SCHED
}
}

constexpr int NB = 16, SEQ = 4096, CTX = 256, TT = SEQ + CTX, M = NB * TT, D = 1024, NL = 4;
constexpr int NPJ = 2304, DPROJ = 2208;
constexpr int MS = 143360;
constexpr float EPS = 1e-6f, ALPHA = 1.6817928305074290f, LOG2E = 1.4426950408889634f;
constexpr int NWAVES = 8, NTHR = 512;
#ifndef MK_DEBUG
#define MK_DEBUG 0
#endif
#ifndef MK_TIME
#define MK_TIME 0
#endif
#ifndef MK_TMUL
#define MK_TMUL 1
#endif
#ifndef MK_VM
#define MK_VM 0
#endif
#ifndef MK_DUP
#define MK_DUP 0
#endif
#ifndef MK_MULTI
#define MK_MULTI 0
#endif
constexpr int NPHASE = 2 + 10 * NL;

constexpr size_t WS_CTL = 0, CTL_BYTES = 65536;
constexpr size_t WS_MODS = WS_CTL + CTL_BYTES;
constexpr size_t WS_T64 = WS_MODS + (size_t)NL * 17 * 6144 * 4;
constexpr size_t WS_T32 = WS_T64 + 8192;
constexpr size_t WS_RS = WS_T32 + 4096;
constexpr size_t WS_RT = WS_RS + (size_t)M * 8;
constexpr size_t WS_HIST = WS_RT + (size_t)M * 32;
constexpr size_t WS_XS = WS_HIST + 65536;
constexpr size_t WS_WIN = WS_XS + (size_t)M * D * 2;
constexpr size_t WS_WD = WS_WIN + (size_t)NPJ * D * 2;
constexpr size_t WS_WOUT = WS_WD + (size_t)1024 * 384 * 2;
constexpr size_t WS_WGU = WS_WOUT + (size_t)D * D * 2;
constexpr size_t WS_WDN = WS_WGU + (size_t)16 * 1024 * 1024 * 2;
constexpr size_t WS_HA = WS_WDN + (size_t)16 * 1024 * 512 * 2;
constexpr size_t WS_PB = WS_HA + (size_t)M * D * 2;
constexpr size_t WS_QD = WS_PB + (size_t)M * NPJ * 2;
constexpr size_t WS_KD = WS_QD + (size_t)M * 384 * 2;
constexpr size_t WS_VD = WS_KD + (size_t)M * 384 * 2;
constexpr size_t WS_ACT = WS_VD + (size_t)M * 256 * 2;
constexpr size_t WS_END = WS_ACT + (size_t)MS * 512 * 2;
static_assert(WS_END <= (size_t)1073741824, "d_ws map must fit 1 GiB");
static_assert((size_t)M * NPJ * 2 >= (size_t)MS * D * 2 && (size_t)M * NPJ * 2 >= (size_t)M * D * 4, "region PB overlays");
constexpr int CW_BAR = 0;
constexpr int CW_QUEUE = 4096;

constexpr int RING_BYTES = 131072, MISC_OFF = RING_BYTES, LDS_BYTES = 147456;
constexpr int MI_BAR = 0, MI_Q = 4, MI_TOT = 16, MI_BASE = 32, MI_PST = 48, MI_LH = 80;

#define GAS __attribute__((address_space(1)))
#define LAS __attribute__((address_space(3)))
typedef unsigned short bf16;
typedef unsigned v4u __attribute__((ext_vector_type(4)));
typedef unsigned v2u __attribute__((ext_vector_type(2)));
typedef float f32x4 __attribute__((ext_vector_type(4)));
typedef float f32x2 __attribute__((ext_vector_type(2)));
typedef short bf16x8 __attribute__((ext_vector_type(8)));
typedef float f32x16 __attribute__((ext_vector_type(16)));
typedef short v4i16 __attribute__((ext_vector_type(4)));

__device__ __forceinline__ unsigned f2bf(float f) { unsigned u = __builtin_bit_cast(unsigned, f); return (u + 0x7fffu + ((u >> 16) & 1u)) >> 16; }
__device__ __forceinline__ unsigned pk2(float lo, float hi) { return f2bf(lo) | (f2bf(hi) << 16); }
__device__ __forceinline__ float bflo(unsigned w) { return __builtin_bit_cast(float, w << 16); }
__device__ __forceinline__ float bfhi(unsigned w) { return __builtin_bit_cast(float, w & 0xffff0000u); }
__device__ __forceinline__ void unpack8(v4u w, float (&f)[8]) { f[0] = bflo(w.x); f[1] = bfhi(w.x); f[2] = bflo(w.y); f[3] = bfhi(w.y); f[4] = bflo(w.z); f[5] = bfhi(w.z); f[6] = bflo(w.w); f[7] = bfhi(w.w); }
__device__ __forceinline__ v4u pack8(const float (&f)[8]) { v4u w; w.x = pk2(f[0], f[1]); w.y = pk2(f[2], f[3]); w.z = pk2(f[4], f[5]); w.w = pk2(f[6], f[7]); return w; }
__device__ __forceinline__ float wave_sum(float v) {
    int x = __builtin_bit_cast(int, v);
#define WS_DPP(ctrl, rmask) v += __builtin_bit_cast(float, __builtin_amdgcn_update_dpp(0, x, ctrl, rmask, 0xf, true)); x = __builtin_bit_cast(int, v)
    WS_DPP(0xB1, 0xf);
    WS_DPP(0x4E, 0xf);
    WS_DPP(0x141, 0xf);
    WS_DPP(0x140, 0xf);
    WS_DPP(0x142, 0xa);
    WS_DPP(0x143, 0xc);
#undef WS_DPP
    return __builtin_bit_cast(float, __builtin_amdgcn_readlane(__builtin_bit_cast(int, v), 63));
}

#define XB_TMO      128
#define XB_XCNT(j)  (256  + 64 * (j))
#define XB_XSUB(j)  (1280 + 64 * (j))
#define XB_XGEN(j)  (2304 + 64 * (j))
#define XB_TOP      3328
#define XB_TOPGEN   3392
#define XCD_BAR_WORDS 3456
#define XB_SPIN_CAP (1u << 22)
__device__ __forceinline__ unsigned xb_ld(unsigned* p)              { return __hip_atomic_load(p, __ATOMIC_RELAXED, __HIP_MEMORY_SCOPE_AGENT); }
__device__ __forceinline__ unsigned xb_add(unsigned* p, unsigned v) { return __hip_atomic_fetch_add(p, v, __ATOMIC_RELAXED, __HIP_MEMORY_SCOPE_AGENT); }
__device__ __forceinline__ unsigned xb_xcc_id() { return (unsigned)__builtin_amdgcn_s_getreg((3 << 11) | 20) & 0xFu; }
#define XB_SPIN(cond, bar) do { unsigned _sp = 0; while (cond) { __builtin_amdgcn_s_sleep(1); \
    if ((++_sp & 255u) == 0u) { if (xb_ld(&(bar)[XB_TMO])) break; if (_sp > XB_SPIN_CAP) { atomicAdd(&(bar)[XB_TMO], 1u); break; } } } } while (0)
struct XcdBarrier { unsigned* bar; unsigned x; volatile LAS unsigned* st; };
__device__ __forceinline__ XcdBarrier xcd_barrier_post(unsigned* bar, volatile LAS unsigned* st) {
    XcdBarrier b; b.bar = bar; b.x = xb_xcc_id(); b.st = st;
    if (threadIdx.x == 0) (void)xb_add(&bar[XB_XCNT(b.x)], 1u);
    return b;
}
__device__ __forceinline__ void xcd_barrier_complete(unsigned* bar, unsigned x, unsigned& nloc, unsigned& nx) {
    const unsigned G = gridDim.x * gridDim.y * gridDim.z;
    unsigned sum, cnt, mine, sp = 0u;
    for (;;) {
        sum = 0u; cnt = 0u; mine = 0u;
#pragma unroll
        for (unsigned j = 0; j < 16; ++j) { const unsigned c = xb_ld(&bar[XB_XCNT(j)]); sum += c; cnt += (c > 0u) ? 1u : 0u; mine = (j == x) ? c : mine; }
        if (sum == G) break;
        __builtin_amdgcn_s_sleep(1);
        if ((++sp & 255u) == 0u) { if (xb_ld(&bar[XB_TMO])) break; if (sp > XB_SPIN_CAP) { atomicAdd(&bar[XB_TMO], 1u); break; } }
    }
    nloc = mine > 0u ? mine : 1u; nx = cnt > 0u ? cnt : 1u;
}
__device__ __forceinline__ void xcd_barrier(const XcdBarrier& b) {
    asm volatile("s_waitcnt vmcnt(0)" ::: "memory");
    __syncthreads();
    if (threadIdx.x == 0) {
        unsigned* bar = b.bar;
        __builtin_amdgcn_s_waitcnt(0);
        unsigned nloc = b.st[0], nx = b.st[1];
        if (nloc == 0u) { xcd_barrier_complete(bar, b.x, nloc, nx); b.st[0] = nloc; b.st[1] = nx; }
        const unsigned old = xb_add(&bar[XB_XSUB(b.x)], 1u);
        const unsigned gen = old / nloc;
        if (old + 1u == (gen + 1u) * nloc) {
            __builtin_amdgcn_fence(__ATOMIC_RELEASE, "agent");
            asm volatile("s_waitcnt vmcnt(0)" ::: "memory");
            const unsigned og = xb_add(&bar[XB_TOP], 1u);
            const unsigned tg = og / nx;
            if (og + 1u == (tg + 1u) * nx) xb_add(&bar[XB_TOPGEN], 1u);
            else XB_SPIN(xb_ld(&bar[XB_TOPGEN]) == tg, bar);
            __builtin_amdgcn_fence(__ATOMIC_ACQUIRE, "agent");
            xb_add(&bar[XB_XGEN(b.x)], 1u);
            asm volatile("s_waitcnt vmcnt(0)" ::: "memory");
        } else {
            XB_SPIN(xb_ld(&bar[XB_XGEN(b.x)]) == gen, bar);
            __builtin_amdgcn_fence(__ATOMIC_ACQUIRE, "agent");
            asm volatile("s_waitcnt vmcnt(0)" ::: "memory");
        }
    }
    __syncthreads();
}

struct Args { const float* in[27]; float* out; unsigned char* ws; int ph_lo, ph_hi; };
enum { I_X = 0, I_C, I_CTX, I_CCTX, I_WADA, I_BADA, I_WIN, I_NABIAS, I_GQG, I_GKG, I_SINK, I_MQG, I_WQB, I_MKVG, I_WKVB, I_WOUT, I_LN1G, I_LN1B, I_RGW, I_RGB, I_REW, I_REB, I_WG, I_WU, I_WDN, I_LN2G, I_LN2B };

struct Frame {
    LAS unsigned char* lds; volatile LAS unsigned* MISC;
    int tid, lane, wave, G, gw, ngw, bid;
    GAS unsigned char* ws;
};
__device__ __forceinline__ int opaque_tid() { int t = threadIdx.x; asm volatile("" : "+v"(t)); return t; }
__device__ __forceinline__ int opaque_s(int x) { asm volatile("" : "+s"(x)); return x; }
constexpr int PTAB_OFF = MISC_OFF + 2048, I_OUT = 27;
__device__ __forceinline__ GAS unsigned char* ptab_get(const Frame& F, int i) {
    const LAS unsigned* t = (const LAS unsigned*)(F.lds + PTAB_OFF) + 2 * i;
    const unsigned lo = __builtin_amdgcn_readfirstlane(t[0]), hi = __builtin_amdgcn_readfirstlane(t[1]);
    return (GAS unsigned char*)(((unsigned long long)hi << 32) | lo);
}
#define INP(i) ((const float*)ptab_get(F, (i)))
__device__ __forceinline__ Frame make_frame(GAS unsigned char* ws) {
    extern __shared__ __attribute__((aligned(16))) unsigned char lds_raw[];
    Frame F;
    F.lds = (LAS unsigned char*)lds_raw; F.MISC = (volatile LAS unsigned*)(F.lds + MISC_OFF);
    F.tid = opaque_tid(); F.lane = F.tid & 63; F.wave = __builtin_amdgcn_readfirstlane(F.tid >> 6);
    F.G = opaque_s((int)gridDim.x); F.bid = opaque_s((int)blockIdx.x); F.gw = F.bid * NWAVES + F.wave; F.ngw = F.G * NWAVES;
    { unsigned long long w = (unsigned long long)ws; asm volatile("" : "+s"(w)); F.ws = (GAS unsigned char*)w; }
    return F;
}
typedef _Float16 f16x4 __attribute__((ext_vector_type(4)));
struct RowPtrs { const float* x; const float* ctx; float* out; _Float16* xs; };
__device__ __forceinline__ RowPtrs row_ptrs(const Frame& F) { RowPtrs p; p.x = INP(I_X); p.ctx = INP(I_CTX); p.out = (float*)ptab_get(F, I_OUT); p.xs = (_Float16*)(F.ws + WS_XS); return p; }
__device__ __forceinline__ const float* xin_row(const RowPtrs& P, int r) {
    const int b = r / TT, t = r - b * TT;
    return t < SEQ ? P.x + ((size_t)b * SEQ + t) * D : P.ctx + ((size_t)b * CTX + (t - SEQ)) * D;
}
__device__ __forceinline__ float* out_row(const RowPtrs& P, int r) { const int b = r / TT, t = r - b * TT; return P.out + ((size_t)b * SEQ + t) * D; }
__device__ __forceinline__ void ld16h(const _Float16* p, int lane, float (&v)[16]) {
    const f16x4* q = (const f16x4*)p + lane;
#pragma unroll
    for (int g = 0; g < 4; ++g) { const f32x4 f = __builtin_convertvector(__builtin_nontemporal_load(q + 64 * g), f32x4); v[4 * g] = f.x; v[4 * g + 1] = f.y; v[4 * g + 2] = f.z; v[4 * g + 3] = f.w; }
}
__device__ __forceinline__ void st16h(_Float16* p, int lane, const float (&v)[16]) {
    f16x4* q = (f16x4*)p + lane;
#pragma unroll
    for (int g = 0; g < 4; ++g) __builtin_nontemporal_store(__builtin_convertvector((f32x4){v[4 * g], v[4 * g + 1], v[4 * g + 2], v[4 * g + 3]}, f16x4), q + 64 * g);
}
__device__ __forceinline__ void ld16(const float* p, int lane, float (&v)[16]) {
    const f32x4* q = (const f32x4*)p + lane;
    const f32x4 a = q[0], b = q[64], c = q[128], d = q[192];
    v[0] = a.x; v[1] = a.y; v[2] = a.z; v[3] = a.w; v[4] = b.x; v[5] = b.y; v[6] = b.z; v[7] = b.w;
    v[8] = c.x; v[9] = c.y; v[10] = c.z; v[11] = c.w; v[12] = d.x; v[13] = d.y; v[14] = d.z; v[15] = d.w;
}
__device__ __forceinline__ void st16(float* p, int lane, const float (&v)[16]) {
    f32x4* q = (f32x4*)p + lane;
    q[0] = (f32x4){v[0], v[1], v[2], v[3]}; q[64] = (f32x4){v[4], v[5], v[6], v[7]};
    q[128] = (f32x4){v[8], v[9], v[10], v[11]}; q[192] = (f32x4){v[12], v[13], v[14], v[15]};
}
__device__ __forceinline__ void ld16nt(const float* p, int lane, float (&v)[16]) {
    const f32x4* q = (const f32x4*)p + lane;
    const f32x4 a = __builtin_nontemporal_load(q), b = __builtin_nontemporal_load(q + 64), c = __builtin_nontemporal_load(q + 128), d = __builtin_nontemporal_load(q + 192);
    v[0] = a.x; v[1] = a.y; v[2] = a.z; v[3] = a.w; v[4] = b.x; v[5] = b.y; v[6] = b.z; v[7] = b.w;
    v[8] = c.x; v[9] = c.y; v[10] = c.z; v[11] = c.w; v[12] = d.x; v[13] = d.y; v[14] = d.z; v[15] = d.w;
}
__device__ __forceinline__ void st16nt(float* p, int lane, const float (&v)[16]) {
    f32x4* q = (f32x4*)p + lane;
    __builtin_nontemporal_store((f32x4){v[0], v[1], v[2], v[3]}, q); __builtin_nontemporal_store((f32x4){v[4], v[5], v[6], v[7]}, q + 64);
    __builtin_nontemporal_store((f32x4){v[8], v[9], v[10], v[11]}, q + 128); __builtin_nontemporal_store((f32x4){v[12], v[13], v[14], v[15]}, q + 192);
}
__device__ __forceinline__ void unpack16(const v2u (&w)[4], float (&v)[16]) {
#pragma unroll
    for (int g = 0; g < 4; ++g) { v[4 * g] = bflo(w[g].x); v[4 * g + 1] = bfhi(w[g].x); v[4 * g + 2] = bflo(w[g].y); v[4 * g + 3] = bfhi(w[g].y); }
}
__device__ __forceinline__ void ld16bf_raw(const bf16* p, int lane, v2u (&w)[4]) {
    const v2u* q = (const v2u*)p + lane; w[0] = q[0]; w[1] = q[64]; w[2] = q[128]; w[3] = q[192];
}
__device__ __forceinline__ void ld16bf_raw_nt(const bf16* p, int lane, v2u (&w)[4]) {
    const v2u* q = (const v2u*)p + lane; w[0] = __builtin_nontemporal_load(q); w[1] = __builtin_nontemporal_load(q + 64); w[2] = __builtin_nontemporal_load(q + 128); w[3] = __builtin_nontemporal_load(q + 192);
}
__device__ __forceinline__ void ld16bf(const bf16* p, int lane, float (&v)[16]) { v2u w[4]; ld16bf_raw(p, lane, w); unpack16(w, v); }
__device__ __forceinline__ void ld16bf_nt(const bf16* p, int lane, float (&v)[16]) { v2u w[4]; ld16bf_raw_nt(p, lane, w); unpack16(w, v); }
__device__ __forceinline__ void st16bf(bf16* p, int lane, const float (&v)[16]) {
    v2u* q = (v2u*)p + lane;
#pragma unroll
    for (int g = 0; g < 4; ++g) { v2u w; w.x = pk2(v[4 * g], v[4 * g + 1]); w.y = pk2(v[4 * g + 2], v[4 * g + 3]); q[64 * g] = w; }
}
__device__ __forceinline__ void ln16(float (&v)[16]) {
    float s = 0.f;
#pragma unroll
    for (int i = 0; i < 16; ++i) s += v[i];
    const float mean = wave_sum(s) * (1.0f / D); float q = 0.f;
#pragma unroll
    for (int i = 0; i < 16; ++i) { v[i] -= mean; q += v[i] * v[i]; }
    const float rstd = 1.0f / sqrtf(wave_sum(q) * (1.0f / D) + EPS);
#pragma unroll
    for (int i = 0; i < 16; ++i) v[i] *= rstd;
}

__device__ __forceinline__ int rows_per_wave(int ngw) {
    int rpw = (M + ngw - 1) / ngw;
    if (!((SEQ % rpw) % 4 == 0 && (TT % rpw) == 0 && (rpw % 2) == 0)) rpw = (rpw + 3) & ~3;
    return rpw;
}
template <int TYPE>
__device__ __forceinline__ float conv_src(const float* p0, const float* p1, const float* g0, const float* g1, int l, int k, int n) {
    if (TYPE == 0) return n < DPROJ ? p0[((size_t)l * D + k) * DPROJ + n] : 0.f;
    if (TYPE == 1) { if (n < 384) return k < 256 ? g0[l * 256 + k] * p0[((size_t)l * 256 + k) * 384 + n] : 0.f;
                     if (n < 896) return k >= 256 ? g1[l * 128 + (k - 256)] * p1[((size_t)l * 128 + (k - 256)) * 512 + (n - 384)] : 0.f;
                     return 0.f; }
    if (TYPE == 2) return p0[((size_t)l * D + k) * D + n];
    if (TYPE == 3) { const int e = n >> 10, nn = n & 1023, q = nn >> 3, j = nn & 7;
                     return j < 4 ? p0[(((size_t)l * 16 + e) * D + k) * 512 + 4 * q + j] : p1[(((size_t)l * 16 + e) * D + k) * 512 + 4 * q + (j - 4)]; }
    { const int e = n >> 10, nn = n & 1023; return p0[(((size_t)l * 16 + e) * 512 + k) * D + nn]; }
}
template <int TYPE>
__device__ __forceinline__ void conv_item(const Frame& F, int l, int item, LAS float* scr) {
    constexpr int Nd = TYPE == 0 ? NPJ : TYPE == 1 ? 1024 : TYPE == 2 ? 1024 : 16384, Kd = TYPE == 1 ? 384 : TYPE == 4 ? 512 : 1024;
    bf16* dst = (bf16*)(F.ws + (TYPE == 0 ? WS_WIN : TYPE == 1 ? WS_WD : TYPE == 2 ? WS_WOUT : TYPE == 3 ? WS_WGU : WS_WDN));
    const float* p0 = INP(TYPE == 0 ? I_WIN : TYPE == 1 ? I_WQB : TYPE == 2 ? I_WOUT : TYPE == 3 ? I_WG : I_WDN);
    const float* p1 = INP(TYPE == 1 ? I_WKVB : I_WU); const float* g0 = INP(I_MQG); const float* g1 = INP(I_MKVG);
    constexpr int nblk = Nd / 32; const int kb = item / nblk, nb = item - kb * nblk, k0 = 64 * kb, n0 = 32 * nb, lane = F.lane;
#pragma unroll
    for (int i = 0; i < 32; ++i) { const int kk = 2 * i + (lane >> 5); scr[kk * 33 + (lane & 31)] = conv_src<TYPE>(p0, p1, g0, g1, l, k0 + kk, n0 + (lane & 31)); }
    asm volatile("s_waitcnt lgkmcnt(0)" ::: "memory");
    const int c = lane & 7;
#pragma unroll
    for (int j = 0; j < 4; ++j) { const int n = (lane >> 3) + 8 * j; const LAS float* s = scr + (8 * c) * 33 + n;
        v4u o; o.x = pk2(s[0 * 33], s[1 * 33]); o.y = pk2(s[2 * 33], s[3 * 33]); o.z = pk2(s[4 * 33], s[5 * 33]); o.w = pk2(s[6 * 33], s[7 * 33]);
        *(v4u*)(dst + (size_t)(n0 + n) * Kd + k0 + 8 * c) = o; }
    asm volatile("s_waitcnt lgkmcnt(0)" ::: "memory");
}
__device__ __forceinline__ void phase_prologue(const Frame& F) {
    {
        LAS float* sv = (LAS float*)F.lds;
        LAS float* red = (LAS float*)(F.lds + 17 * 1024 * 4);
        float* mods = (float*)(F.ws + WS_MODS);
        for (int u = F.bid; u < NL * 48; u += F.G) {
            const int l = u / 48, cc = u - l * 48;
            const float* pc = INP(I_C); const float* pcc = INP(I_CCTX);
            for (int i = F.tid; i < 17 * 1024; i += NTHR) { const int mr = i >> 10, k = i & 1023; const float c = mr < 16 ? pc[mr * 1024 + k] : pcc[k]; sv[i] = c / (1.0f + expf(-c)); }
            __syncthreads();
            const int col = F.tid & 127, kg = F.tid >> 7;
            float acc[17];
#pragma unroll
            for (int mr = 0; mr < 17; ++mr) acc[mr] = 0.f;
            const float* w = INP(I_WADA) + ((size_t)l * 1024 + kg * 256) * 6144 + cc * 128 + col;
            for (int k4 = 0; k4 < 256; k4 += 4) {
                const float w0 = w[(size_t)(k4 + 0) * 6144], w1 = w[(size_t)(k4 + 1) * 6144], w2 = w[(size_t)(k4 + 2) * 6144], w3 = w[(size_t)(k4 + 3) * 6144];
#pragma unroll
                for (int mr = 0; mr < 17; ++mr) { const f32x4 s = *(const LAS f32x4*)(sv + mr * 1024 + kg * 256 + k4); acc[mr] += (s.x * w0 + s.y * w1) + (s.z * w2 + s.w * w3); }
            }
#pragma unroll
            for (int mr = 0; mr < 17; ++mr) red[(kg * 17 + mr) * 128 + col] = acc[mr];
            __syncthreads();
            const float* bada = INP(I_BADA);
            for (int i = F.tid; i < 17 * 128; i += NTHR) { const int mr = i >> 7, c = i & 127;
                const float s = (red[(0 * 17 + mr) * 128 + c] + red[(1 * 17 + mr) * 128 + c]) + (red[(2 * 17 + mr) * 128 + c] + red[(3 * 17 + mr) * 128 + c]);
                mods[((size_t)l * 17 + mr) * 6144 + cc * 128 + c] = s + bada[l * 6144 + cc * 128 + c]; }
            __syncthreads();
        }
    }
    {
        float* t64 = (float*)(F.ws + WS_T64); float* t32 = (float*)(F.ws + WS_T32);
        for (int i = F.bid * NTHR + F.tid; i < 64 * 16 + 64 * 8; i += F.G * NTHR) {
            if (i < 1024) { const int p = i >> 4, k = i & 15; const float fr = powf(10000.0f, -(float)k / 16.0f), ang = (float)p * fr; t64[2 * i] = cosf(ang); t64[2 * i + 1] = sinf(ang); }
            else { const int j = i - 1024, p = j >> 3, k = j & 7; const float fr = powf(10000.0f, -(float)k / 8.0f), ang = (float)p * fr; t32[2 * j] = cosf(ang); t32[2 * j + 1] = sinf(ang); }
        }
    }
}
__device__ __forceinline__ void convert_layer_weights(const Frame& F, int l) {
    {
        LAS float* scr = (LAS float*)(F.lds + F.wave * 8448);
        constexpr int I0 = 1152, I1 = 192, I2 = 512, I3 = 8192, I4 = 4096, IL = I0 + I1 + I2 + I3 + I4;
        for (int r0_ = F.gw; r0_ < IL; r0_ += F.ngw) {
            int r = r0_;
            if (r < I0) { conv_item<0>(F, l, r, scr); continue; } r -= I0;
            if (r < I1) { conv_item<1>(F, l, r, scr); continue; } r -= I1;
            if (r < I2) { conv_item<2>(F, l, r, scr); continue; } r -= I2;
            if (r < I3) { conv_item<3>(F, l, r, scr); continue; } r -= I3;
            conv_item<4>(F, l, r, scr);
        }
    }
}

__device__ __forceinline__ void phase_ln(const Frame& F, int l) {
    if (l < NL) convert_layer_weights(F, l);
    constexpr int NR = 4;
    const float* mods = (const float*)(F.ws + WS_MODS); bf16* HA = (bf16*)(F.ws + WS_HA);
    const bf16* Y = (const bf16*)(F.ws + WS_PB); const unsigned* RT = (const unsigned*)(F.ws + WS_RT);
    const int lane = F.lane; const RowPtrs RP = row_ptrs(F);
    const float* ln2g = INP(I_LN2G) + (l > 0 ? l - 1 : 0) * D; const float* ln2b = INP(I_LN2B) + (l > 0 ? l - 1 : 0) * D;
    const int rpw = rows_per_wave(F.ngw), rbeg = F.gw * rpw, rend = min(M, rbeg + rpw);
    float g2[16]; int cur_mr = -1;
    for (int r0 = rbeg; r0 < rend; r0 += NR) {
        float v[NR][16]; v4u rt[NR]; v2u ya[NR][4], yb[NR][4]; bool act[NR];
        const int b0 = r0 / TT, t0 = r0 - b0 * TT; const bool lat = t0 < SEQ; const int mr = lat ? b0 : 16;
        if (l == NL && !lat) continue;
#pragma unroll
        for (int u = 0; u < NR; ++u) {
            const int r = r0 + u; act[u] = r < rend; const int rc = act[u] ? r : r0;
            if (l == 0) ld16nt(xin_row(RP, rc), lane, v[u]); else ld16h(RP.xs + (size_t)rc * D, lane, v[u]);
            rt[u] = *(const v4u*)(RT + (size_t)rc * 8 + 4);
        }
        if (mr != cur_mr) { if (l > 0) ld16(mods + ((size_t)(l - 1) * 17 + mr) * 6144 + 5120, lane, g2); cur_mr = mr; }
        if (l > 0) {
#pragma unroll
            for (int u = 0; u < NR; ++u) { ld16bf_raw_nt(Y + (size_t)rt[u].z * D, lane, ya[u]); ld16bf_raw_nt(Y + (size_t)rt[u].w * D, lane, yb[u]); }
#pragma unroll
            for (int u = 0; u < NR; ++u) {
                float f0[16], f1[16], gg[16], bb[16];
                const float w0 = __uint_as_float(rt[u].x), w1 = __uint_as_float(rt[u].y);
                unpack16(ya[u], f0); unpack16(yb[u], f1);
#pragma unroll
                for (int i = 0; i < 16; ++i) v[u][i] = ALPHA * v[u][i] + g2[i] * (w0 * f0[i] + w1 * f1[i]);
                ld16(ln2g, lane, gg); ld16(ln2b, lane, bb);
                ln16(v[u]);
#pragma unroll
                for (int i = 0; i < 16; ++i) v[u][i] = v[u][i] * gg[i] + bb[i];
                if (act[u]) { if (l == NL) st16nt(out_row(RP, r0 + u), lane, v[u]); else st16h(RP.xs + (size_t)(r0 + u) * D, lane, v[u]); }
            }
        }
        if (l < NL) {
            float sh[16], sc[16]; ld16(mods + ((size_t)l * 17 + mr) * 6144, lane, sh); ld16(mods + ((size_t)l * 17 + mr) * 6144 + 1024, lane, sc);
#pragma unroll
            for (int u = 0; u < NR; ++u) {
                ln16(v[u]);
#pragma unroll
                for (int i = 0; i < 16; ++i) v[u][i] = v[u][i] * (1.0f + sc[i]) + sh[i];
                if (act[u]) st16bf(HA + (size_t)(r0 + u) * D, lane, v[u]);
            }
        }
    }
}

__device__ __forceinline__ void rope8(float (&f)[8], const float (&p)[8], const float* cs, bool first) {
    const f32x4* c4 = (const f32x4*)cs;
#pragma unroll
    for (int q = 0; q < 4; ++q) { const f32x4 t = c4[q];
        f[2 * q] = first ? f[2 * q] * t.x - p[2 * q] * t.y : p[2 * q] * t.y + f[2 * q] * t.x;
        f[2 * q + 1] = first ? f[2 * q + 1] * t.z - p[2 * q + 1] * t.w : p[2 * q + 1] * t.w + f[2 * q + 1] * t.z; }
}
__device__ __forceinline__ void phase_post(const Frame& F, int l) {
    constexpr int NR = 4;
    bf16* P = (bf16*)(F.ws + WS_PB); bf16* KD = (bf16*)(F.ws + WS_KD);
    const float* t64 = (const float*)(F.ws + WS_T64); const float* t32 = (const float*)(F.ws + WS_T32);
    const int lane = F.lane; const float* gains = (lane < 32 ? INP(I_GQG) : INP(I_GKG)) + l * 64;
    const int j = lane & 7, jj = lane & 3;
    float gn[8];
#pragma unroll
    for (int i = 0; i < 8; ++i) gn[i] = gains[j * 8 + i];
    for (int r0 = F.gw; r0 < M; r0 += NR * F.ngw) {
        v4u w0[NR], w1[NR], w2[NR]; int rr[NR]; bool act[NR];
#pragma unroll
        for (int u = 0; u < NR; ++u) { const int r = r0 + u * F.ngw; act[u] = r < M; rr[u] = act[u] ? r : r0; const bf16* prow = P + (size_t)rr[u] * NPJ;
            w0[u] = *((const v4u*)(prow + 768) + lane); w1[u] = *((const v4u*)(prow + 1280) + lane); w2[u] = *((const v4u*)(prow + 1792) + lane); }
#pragma unroll
        for (int u = 0; u < NR; ++u) {
            const int r = rr[u]; const int b = r / TT, t = r - b * TT; const bool lat = t < SEQ; const int gr = (t >> 6) & 63, gc = t & 63;
            bf16* prow = P + (size_t)r * NPJ;
            const float* cs64 = t64 + ((size_t)((j < 4 ? gr : gc) * 16 + (j & 1) * 8)) * 2;
            {
                float f[8]; unpack8(w0[u], f);
                float ss = 0.f;
#pragma unroll
                for (int i = 0; i < 8; ++i) ss += f[i] * f[i];
                ss += __shfl_xor(ss, 1); ss += __shfl_xor(ss, 2); ss += __shfl_xor(ss, 4);
                const float rs = 1.0f / sqrtf(ss * (1.0f / 64.0f) + EPS);
#pragma unroll
                for (int i = 0; i < 8; ++i) f[i] = f[i] * rs * gn[i];
                float p[8];
#pragma unroll
                for (int i = 0; i < 8; ++i) p[i] = __shfl_xor(f[i], 2);
                if (lat) rope8(f, p, cs64, (j & 2) == 0);
                if (lane < 48 && act[u]) *((v4u*)(prow + 768) + lane) = pack8(f);
            }
            {
                float f[8]; unpack8(w1[u], f);
                float p[8];
#pragma unroll
                for (int i = 0; i < 8; ++i) p[i] = __shfl_xor(f[i], 2);
                rope8(f, p, cs64, (j & 2) == 0);
                if (lat && lane < 48 && act[u]) *((v4u*)(prow + 1280) + lane) = pack8(f);
            }
            {
                float f[8]; unpack8(w2[u], f);
                float ss = 0.f;
#pragma unroll
                for (int i = 0; i < 8; ++i) ss += f[i] * f[i];
                ss += __shfl_xor(ss, 1); ss += __shfl_xor(ss, 2); ss += __shfl_xor(ss, 4); ss += __shfl_xor(ss, 8);
                const float s32 = ss + __shfl_xor(ss, 16);
                const float rn = lane < 32 ? 1.0f / sqrtf(s32 * (1.0f / 256.0f) + EPS) : 1.0f / sqrtf(ss * (1.0f / 128.0f) + EPS);
                if (lane < 48 && act[u]) { float fn[8];
#pragma unroll
                    for (int i = 0; i < 8; ++i) fn[i] = f[i] * rn;
                    *((v4u*)(prow + 1792) + lane) = pack8(fn); }
                float p[8];
#pragma unroll
                for (int i = 0; i < 8; ++i) p[i] = __shfl_xor(f[i], 1);
                if (lat) rope8(f, p, t32 + ((size_t)((jj < 2 ? gr : gc) * 8)) * 2, (jj & 1) == 0);
                if (lane >= 48 && lane < 52 && act[u]) { const v4u o = pack8(f);
#pragma unroll
                    for (int h = 0; h < 4; ++h) *(v4u*)(KD + (size_t)r * 384 + h * 96 + 64 + 8 * jj) = o; }
            }
        }
    }
}

__device__ __forceinline__ void phase_route(const Frame& F, int l) {
    const float* mods = (const float*)(F.ws + WS_MODS); bf16* HA = (bf16*)(F.ws + WS_HA);
    const bf16* MIX = (const bf16*)(F.ws + WS_PB); unsigned* RT = (unsigned*)(F.ws + WS_RT); int* HIST = (int*)(F.ws + WS_HIST);
    LAS float* WR = (LAS float*)F.lds;
    { const float* rgw = INP(I_RGW); const float* rew = INP(I_REW);
      for (int i = F.tid; i < 20 * 1024; i += NTHR) { const int jx = i >> 10, k = i & 1023;
        WR[i] = jx < 4 ? rgw[((size_t)l * D + k) * 4 + jx] : rew[((size_t)l * D + k) * 16 + (jx - 4)]; } }
    if (F.tid < 16) F.MISC[MI_LH + F.tid] = 0u;
    __syncthreads();
    LAS float* bias = (LAS float*)(F.lds + 20 * 1024 * 4);
    if (F.tid < 20) bias[F.tid] = F.tid < 4 ? INP(I_RGB)[l * 4 + F.tid] : INP(I_REB)[l * 16 + (F.tid - 4)];
    __syncthreads();
    const RowPtrs RP = row_ptrs(F); const float* ln1g = INP(I_LN1G) + l * D; const float* ln1b = INP(I_LN1B) + l * D;
    constexpr int NR = 2;
    const int rpw = rows_per_wave(F.ngw), rbeg = F.gw * rpw, rend = min(M, rbeg + rpw);
    float g1[16], sh[16], sc[16]; int cur_mr = -1;
    for (int r0 = rbeg; r0 < rend; r0 += NR) {
        if (l == NL - 1 && (r0 % TT) >= SEQ) continue;
        float v[NR][16], mx[NR][16], gg[16], bb[16]; int rr[NR]; bool act[NR];
#pragma unroll
        for (int u = 0; u < NR; ++u) { const int r = r0 + u; act[u] = r < rend; rr[u] = act[u] ? r : r0;
            if (l == 0) ld16nt(xin_row(RP, rr[u]), F.lane, v[u]); else ld16h(RP.xs + (size_t)rr[u] * D, F.lane, v[u]);
            ld16bf_nt(MIX + (size_t)rr[u] * D, F.lane, mx[u]); }
        ld16(ln1g, F.lane, gg); ld16(ln1b, F.lane, bb);
        { const int b = r0 / TT, t = r0 - b * TT, mr = t < SEQ ? b : 16;
          if (mr != cur_mr) { const float* md = mods + ((size_t)l * 17 + mr) * 6144; ld16(md + 2048, F.lane, g1); ld16(md + 3072, F.lane, sh); ld16(md + 4096, F.lane, sc); cur_mr = mr; } }
#pragma unroll
        for (int u = 0; u < NR; ++u) {
#pragma unroll
            for (int i = 0; i < 16; ++i) v[u][i] = ALPHA * v[u][i] + g1[i] * mx[u][i]; }
#pragma unroll
        for (int u = 0; u < NR; ++u) ln16(v[u]);
#pragma unroll
        for (int u = 0; u < NR; ++u) {
#pragma unroll
            for (int i = 0; i < 16; ++i) v[u][i] = v[u][i] * gg[i] + bb[i];
            if (act[u]) st16h(RP.xs + (size_t)rr[u] * D, F.lane, v[u]); }
#pragma unroll
        for (int u = 0; u < NR; ++u) ln16(v[u]);
#pragma unroll
        for (int u = 0; u < NR; ++u) {
#pragma unroll
            for (int i = 0; i < 16; ++i) v[u][i] = v[u][i] * (1.0f + sc[i]) + sh[i];
            if (act[u]) st16bf(HA + (size_t)rr[u] * D, F.lane, v[u]); }
        float lgt[NR][20];
#pragma unroll
        for (int jx = 0; jx < 20; ++jx) {
            const LAS f32x4* wq = (const LAS f32x4*)(WR + jx * 1024);
            const f32x4 w0 = wq[F.lane], w1 = wq[64 + F.lane], w2 = wq[128 + F.lane], w3 = wq[192 + F.lane];
#pragma unroll
            for (int u = 0; u < NR; ++u) {
                const float sm = (v[u][0] * w0.x + v[u][1] * w0.y) + (v[u][2] * w0.z + v[u][3] * w0.w) + (v[u][4] * w1.x + v[u][5] * w1.y) + (v[u][6] * w1.z + v[u][7] * w1.w)
                               + (v[u][8] * w2.x + v[u][9] * w2.y) + (v[u][10] * w2.z + v[u][11] * w2.w) + (v[u][12] * w3.x + v[u][13] * w3.y) + (v[u][14] * w3.z + v[u][15] * w3.w);
                lgt[u][jx] = sm; }
        }
#pragma unroll
        for (int o = 1; o < 64; o <<= 1)
#pragma unroll
            for (int u = 0; u < NR; ++u)
#pragma unroll
                for (int jx = 0; jx < 20; ++jx) lgt[u][jx] += __shfl_xor(lgt[u][jx], o);
#pragma unroll
        for (int u = 0; u < NR; ++u) {
#pragma unroll
            for (int jx = 0; jx < 20; ++jx) lgt[u][jx] += bias[jx];
            int grp = 0; float mg = lgt[u][0];
#pragma unroll
            for (int g = 1; g < 4; ++g) if (lgt[u][g] > mg) { mg = lgt[u][g]; grp = g; }
            float sg = 0.f;
#pragma unroll
            for (int g = 0; g < 4; ++g) sg += expf(lgt[u][g] - mg);
            const float pg = 1.0f / sg;
            float sel[4];
#pragma unroll
            for (int i = 0; i < 4; ++i) sel[i] = grp == 0 ? lgt[u][4 + i] : grp == 1 ? lgt[u][8 + i] : grp == 2 ? lgt[u][12 + i] : lgt[u][16 + i];
            int i1 = 0; float v1 = sel[0];
#pragma unroll
            for (int i = 1; i < 4; ++i) if (sel[i] > v1) { v1 = sel[i]; i1 = i; }
            int i2 = -1; float v2 = -3.0e38f;
#pragma unroll
            for (int i = 0; i < 4; ++i) if (i != i1 && (i2 < 0 || sel[i] > v2)) { v2 = sel[i]; i2 = i; }
            const float ee = expf(v2 - v1), w1 = pg / (1.0f + ee), w2 = pg * ee / (1.0f + ee);
            const int e1 = grp * 4 + i1, e2 = grp * 4 + i2;
            if (F.lane == 0 && act[u]) {
                const unsigned k1 = __hip_atomic_fetch_add((LAS unsigned*)&F.MISC[MI_LH + e1], 1u, __ATOMIC_RELAXED, __HIP_MEMORY_SCOPE_WORKGROUP);
                const unsigned k2 = __hip_atomic_fetch_add((LAS unsigned*)&F.MISC[MI_LH + e2], 1u, __ATOMIC_RELAXED, __HIP_MEMORY_SCOPE_WORKGROUP);
                v4u ra; ra.x = (unsigned)e1; ra.y = (unsigned)e2; ra.z = k1; ra.w = k2;
                v4u rb; rb.x = __builtin_bit_cast(unsigned, w1); rb.y = __builtin_bit_cast(unsigned, w2); rb.z = 0u; rb.w = 0u;
                *(v4u*)(RT + (size_t)rr[u] * 8) = ra; *(v4u*)(RT + (size_t)rr[u] * 8 + 4) = rb;
            }
        }
    }
    __syncthreads();
    if (F.tid < 16) HIST[F.bid * 16 + F.tid] = (int)F.MISC[MI_LH + F.tid];
}
__device__ __forceinline__ void moe_tables(const Frame& F) {
    const int* HIST = (const int*)(F.ws + WS_HIST); LAS int* hl = (LAS int*)F.lds;
    __syncthreads();
    for (int i = F.tid; i < F.G * 16; i += NTHR) hl[i] = HIST[i];
    __syncthreads();
    if (F.tid < 16) { int tot = 0, mine = 0; for (int g = 0; g < F.G; ++g) { const int c = hl[g * 16 + F.tid]; tot += c; mine += (g < F.bid) ? c : 0; }
        F.MISC[MI_TOT + F.tid] = (unsigned)tot; F.MISC[MI_BASE + F.tid] = (unsigned)mine; }
    __syncthreads();
    if (F.tid == 0) { unsigned p = 0; for (int e = 0; e < 16; ++e) { F.MISC[MI_PST + e] = p; F.MISC[MI_BASE + e] += p * 256u; p += (F.MISC[MI_TOT + e] + 255u) >> 8; } F.MISC[MI_PST + 16] = p; }
    __syncthreads();
}
__device__ __forceinline__ void phase_permute(const Frame& F, int l) {
    unsigned* RT = (unsigned*)(F.ws + WS_RT); int* SRC = (int*)(F.ws + WS_QD);
    moe_tables(F);
    const int rpw = rows_per_wave(F.ngw), rbeg = F.gw * rpw, rend = min(M, rbeg + rpw);
    for (int r = rbeg + F.lane; r < rend; r += 64) {
        if (l == NL - 1 && (r % TT) >= SEQ) continue;
        const v4u ra = *(const v4u*)(RT + (size_t)r * 8);
        const unsigned p0 = F.MISC[MI_BASE + (ra.x & 15u)] + ra.z, p1 = F.MISC[MI_BASE + (ra.y & 15u)] + ra.w;
        RT[(size_t)r * 8 + 6] = p0; RT[(size_t)r * 8 + 7] = p1; SRC[p0] = r; SRC[p1] = r;
    }
    if (F.bid == 0) {
        for (int e = 0; e < 16; ++e) { const int beg = (int)F.MISC[MI_PST + e] * 256 + (int)F.MISC[MI_TOT + e], end = (int)F.MISC[MI_PST + e + 1] * 256;
            for (int p = beg + F.tid; p < end; p += NTHR) SRC[p] = 0; }
    }
}

struct EpiMla {
    static constexpr bool PERM = true, AFTER_DRAIN = false;
    bf16* QD; bf16* KD; bf16* VD;
    __device__ __forceinline__ void operator()(const pg8::f32x4 (&acc)[2][2][4][2], const pg8::Unit& u, int wr, int wc, int fr, int fq) const {
#pragma unroll
        for (int bj = 0; bj < 2; ++bj) {
            const int g0 = u.pn * 256 + bj * 128 + wc * 32, col0 = g0 + 8 * fq;
            if (g0 >= 896) continue;
            const int c = col0 - 384, hd = c >> 7, jx = c & 127;
            bf16* dst = g0 < 384 ? QD + col0 : jx < 64 ? KD + hd * 96 + jx : VD + hd * 64 + (jx - 64);
            const int stride = (g0 < 384 || jx < 64) ? 384 : 256;
            dst += (size_t)(u.pm * 256 + wr * 64 + fr) * stride;
#pragma unroll
            for (int ai = 0; ai < 2; ++ai)
#pragma unroll
                for (int m = 0; m < 4; ++m) {
                    v4u o; o.x = pk2(acc[ai][bj][m][0][0], acc[ai][bj][m][0][1]); o.y = pk2(acc[ai][bj][m][0][2], acc[ai][bj][m][0][3]);
                    o.z = pk2(acc[ai][bj][m][1][0], acc[ai][bj][m][1][1]); o.w = pk2(acc[ai][bj][m][1][2], acc[ai][bj][m][1][3]);
                    *(v4u*)(dst + (size_t)(ai * 128 + m * 16) * stride) = o;
                }
        }
    }
};
struct EpiGU {
    static constexpr bool PERM = true, AFTER_DRAIN = false;
    bf16* ACT;
    __device__ __forceinline__ void operator()(const pg8::f32x4 (&acc)[2][2][4][2], const pg8::Unit& u, int wr, int wc, int fr, int fq) const {
#pragma unroll
        for (int ai = 0; ai < 2; ++ai)
#pragma unroll
            for (int m = 0; m < 4; ++m) {
                const int row = u.pm * 256 + ai * 128 + wr * 64 + m * 16 + fr;
#pragma unroll
                for (int bj = 0; bj < 2; ++bj) {
                    const int c = (u.pn & 3) * 256 + bj * 128 + wc * 32 + 8 * fq;
                    float o[4];
#pragma unroll
                    for (int i = 0; i < 4; ++i) { const float g = acc[ai][bj][m][0][i], up = acc[ai][bj][m][1][i]; o[i] = g / (1.0f + __expf(-g)) * up; }
                    v2u w; w.x = pk2(o[0], o[1]); w.y = pk2(o[2], o[3]);
                    *(v2u*)(ACT + (size_t)row * 512 + (c >> 1)) = w;
                }
            }
    }
};
struct MoeOrder {
    volatile LAS unsigned* pst; int G, c;
    __device__ __forceinline__ bool next(int i, pg8::Unit& u) const {
        const int np = (int)pst[16]; int panel, pn;
        if ((G & 7) == 0) { const int x = c & 7, uu = i * (G >> 3) + (c >> 3); panel = (uu >> 2) * 8 + x; pn = uu & 3; }
        else { const int L = i * G + c; panel = L >> 2; pn = L & 3; }
        if (panel >= np) return false;
        int e = 0;
#pragma unroll
        for (int k = 1; k < 16; ++k) e += (panel >= (int)pst[k]) ? 1 : 0;
        u.pm = __builtin_amdgcn_readfirstlane(panel); u.pn = __builtin_amdgcn_readfirstlane(e * 4 + pn); return true;
    }
    __device__ __forceinline__ void a_ready(const pg8::Unit&) const {}
    __device__ __forceinline__ void done(const pg8::Unit&) const {}
};

struct LatOrder {
    int G, c;
    __device__ __forceinline__ bool next(int i, pg8::Unit& u) const {
        int pl, pn;
        if ((G & 7) == 0) { const int x = c & 7, uu = i * (G >> 3) + (c >> 3); pl = (uu >> 2) * 8 + x; pn = uu & 3; } else { const int L = i * G + c; pl = L >> 2; pn = L & 3; }
        if (pl >= NB * 16) return false;
        u.pm = pl + (pl >> 4); u.pn = pn; return true;
    }
    __device__ __forceinline__ void a_ready(const pg8::Unit&) const {}
    __device__ __forceinline__ void done(const pg8::Unit&) const {}
};

#ifndef DBG_VAR
#define DBG_VAR 1
#endif
namespace att {
constexpr int VRS = 192, KBUF = 64 * 208, VBUF = 64 * VRS, BUF = KBUF + VBUF, BIAS_OFF = 4 * BUF;
constexpr float NEG = -30000.0f;
__device__ __forceinline__ int crow(int r, int hi) { return (r & 3) + 8 * (r >> 2) + 4 * hi; }
__device__ __forceinline__ float xhalf_max(float v) { const unsigned a = __builtin_bit_cast(unsigned, v);
    auto rr = __builtin_amdgcn_permlane32_swap(a, a, false, false); const unsigned r0 = rr[0], r1 = rr[1]; return fmaxf(__uint_as_float(r0), __uint_as_float(r1)); }
__device__ __forceinline__ float xhalf_sum(float v) { const unsigned a = __builtin_bit_cast(unsigned, v);
    auto rr = __builtin_amdgcn_permlane32_swap(a, a, false, false); const unsigned r0 = rr[0], r1 = rr[1]; return __uint_as_float(r0) + __uint_as_float(r1); }
__device__ __forceinline__ float max3f(float a, float b, float c) { float r; asm("v_max3_f32 %0, %1, %2, %3" : "=v"(r) : "v"(a), "v"(b), "v"(c)); return r; }
typedef __bf16 bf16x2_t __attribute__((ext_vector_type(2)));
__device__ __forceinline__ unsigned cvtpk(float lo, float hi) { f32x2 v = {lo, hi}; bf16x2_t b = __builtin_convertvector(v, bf16x2_t); return __builtin_bit_cast(unsigned, b); }

template <int DK, int VM = 0>
__device__ __forceinline__ void unit(LAS unsigned char* lds, const bf16* Qp, int qpitch, const bf16* Kp, int kpitch, const bf16* Vp, int vpitch, bf16* Op,
                                     int var, int qt, int lo, int n1, int nt, float qscale, float sinkl2, bool has_sink, const LAS float* bias, const float* t32, unsigned* dbg) {
    constexpr int KRS = DK * 2 + 16, NS = DK / 16, CPK = DK / 8;
    int tid = threadIdx.x; asm volatile("" : "+v"(tid)); const int lane = tid & 63, r32 = lane & 31, hi = lane >> 5, wid = __builtin_amdgcn_readfirstlane(tid >> 6);
    const int qrow = 256 * qt + 32 * wid + r32;
    bf16x8 qr[NS];
#pragma unroll
    for (int s = 0; s < NS; ++s) { const v4u raw = *(const v4u*)(Qp + (size_t)qrow * qpitch + 16 * s + 8 * hi); float f[8]; unpack8(raw, f);
#pragma unroll
        for (int i = 0; i < 8; ++i) f[i] *= qscale;
        if (DK == 96 && s >= 4) {
            float p[8];
#pragma unroll
            for (int i = 0; i < 8; ++i) p[i] = __shfl_xor(f[i], 32);
            if (qt < 16) rope8(f, p, t32 + ((size_t)((s == 4 ? (qrow >> 6) : (qrow & 63)) * 8)) * 2, hi == 0);
        }
        qr[s] = __builtin_bit_cast(bf16x8, pack8(f)); }
    const int kkey0 = tid / CPK, kch0 = tid - kkey0 * CPK, kkey1 = (tid + 512) / CPK, kch1 = (tid + 512) - kkey1 * CPK;
    const int vkey = tid >> 3, vch = tid & 7;
    v4u kreg0, kreg1 = {0u, 0u, 0u, 0u}, vreg;
#define ATT_TROW(j) ((((j) < n1) ? (lo + (j)) : (64 + (j) - n1)) * 64)
#define ATT_LOAD(j) do { const int tr_ = ATT_TROW(j); kreg0 = *(const v4u*)(Kp + (size_t)(tr_ + kkey0) * kpitch + kch0 * 8); \
        if (DK == 96 && tid < 256) kreg1 = *(const v4u*)(Kp + (size_t)(tr_ + kkey1) * kpitch + kch1 * 8); \
        vreg = *(const v4u*)(Vp + (size_t)(tr_ + vkey) * vpitch + vch * 8); } while (0)
#define ATT_STORE(bf) do { LAS unsigned char* b_ = lds + (bf) * BUF; *(LAS v4u*)(b_ + kkey0 * KRS + kch0 * 16) = kreg0; \
        if (DK == 96 && tid < 256) *(LAS v4u*)(b_ + kkey1 * KRS + kch1 * 16) = kreg1; \
        *(LAS v4u*)(b_ + KBUF + vkey * VRS + vch * 16) = vreg; } while (0)
    constexpr float THR = 6.0f;
    float m = 0.f; f32x2 lacc = {0.f, 0.f}; f32x16 o0 = {}, o1 = {}; f32x16 negm = {}; bool first = true;
    const int grw = 4 * qt + (wid >> 1), r0w = min(max(grw - 4, 0), 56), gc = (wid & 1) * 32 + r32, c0 = min(max(gc - 8, 0), 48), i0w = 256 * qt + 32 * wid;
    ATT_LOAD(0); ATT_STORE(0);
    __syncthreads();
    for (int j = 0; j < nt; ++j) {
        if (!(VM & 8) && j + 1 < nt) ATT_LOAD(j + 1);
        const int kt = ATT_TROW(j) >> 6;
        bool actv = true;
        if (kt < 64) { if (var == 0) actv = (kt >= r0w) && (kt <= r0w + 7); else if (var == 2) actv = !((64 * kt - (i0w + 31) > 128) || (i0w - (64 * kt + 63) > 128)); }
        if (actv) {
            const LAS unsigned char* Kb = lds + (j & 1) * BUF; const LAS unsigned char* Vb = Kb + KBUF;
            f32x16 s0 = negm, s1 = negm;
            bf16x8 ka[NS], kb[NS];
#pragma unroll
            for (int s = 0; s < NS; ++s) { ka[s] = *(const LAS bf16x8*)(Kb + r32 * KRS + (16 * s + 8 * hi) * 2); kb[s] = *(const LAS bf16x8*)(Kb + (32 + r32) * KRS + (16 * s + 8 * hi) * 2); }
            __builtin_amdgcn_sched_barrier(0);
            if (VM & 2) {
#pragma unroll
                for (int s = 0; s < NS; ++s) asm volatile("" :: "v"(ka[s]), "v"(kb[s]), "v"(qr[s]));
            } else {
#pragma unroll
            for (int s = 0; s < NS; ++s) { s0 = __builtin_amdgcn_mfma_f32_32x32x16_bf16(ka[s], qr[s], s0, 0, 0, 0); s1 = __builtin_amdgcn_mfma_f32_32x32x16_bf16(kb[s], qr[s], s1, 0, 0, 0); }
            }
            asm volatile("s_nop 15\n\ts_nop 7" : "+v"(s0), "+v"(s1));
            if (kt < 64 && var == 0) {
                const int rowoff = (kt - grw + 7) * 31 - gc + 15;
#pragma unroll
                for (int r = 0; r < 16; ++r) { const int j0 = crow(r, hi), j1 = j0 + 32;
                    const bool v0 = (unsigned)(j0 - c0) < 16u, v1 = (unsigned)(j1 - c0) < 16u;
                    const float b0 = bias[v0 ? rowoff + j0 : 0], b1 = bias[v1 ? rowoff + j1 : 0];
                    s0[r] = v0 ? s0[r] + b0 : NEG; s1[r] = v1 ? s1[r] + b1 : NEG; }
            } else if (kt < 64 && var == 2) {
                const int dbase = 64 * kt - qrow + 128;
#pragma unroll
                for (int r = 0; r < 16; ++r) { const int j0 = crow(r, hi);
                    s0[r] = (unsigned)(dbase + j0) <= 256u ? s0[r] : NEG; s1[r] = (unsigned)(dbase + j0 + 32) <= 256u ? s1[r] : NEG; }
            }
            if (!(VM & 4)) {
            float mxa = max3f(s0[0], s0[1], s1[0]), mxb = max3f(s0[2], s0[3], s1[1]); mxa = max3f(mxa, s1[2], s1[3]);
#pragma unroll
            for (int r = 4; r < 16; r += 4) { mxa = max3f(mxa, s0[r], s0[r + 1]); mxb = max3f(mxb, s0[r + 2], s0[r + 3]); mxa = max3f(mxa, s1[r], s1[r + 1]); mxb = max3f(mxb, s1[r + 2], s1[r + 3]); }
            const float mx = xhalf_max(fmaxf(mxa, mxb));
            if (first || __any(mx > THR)) {
                const float d = first ? fmaxf(mx, -64.0f) : fmaxf(mx, 0.f), alpha = __builtin_amdgcn_exp2f(-d);
                m += d; first = false;
#pragma unroll
                for (int r = 0; r < 16; ++r) { s0[r] -= d; s1[r] -= d; o0[r] *= alpha; o1[r] *= alpha; negm[r] = -m; }
                lacc *= alpha;
            }
#pragma unroll
            for (int r = 0; r < 16; ++r) { s0[r] = __builtin_amdgcn_exp2f(s0[r]); s1[r] = __builtin_amdgcn_exp2f(s1[r]); lacc += (f32x2){s0[r], s1[r]}; }
            }
            bf16x8 pb[4];
#pragma unroll
            for (int s = 0; s < 2; ++s) {
                v4u w; w.x = cvtpk(s0[8 * s], s0[8 * s + 1]); w.y = cvtpk(s0[8 * s + 2], s0[8 * s + 3]); w.z = cvtpk(s0[8 * s + 4], s0[8 * s + 5]); w.w = cvtpk(s0[8 * s + 6], s0[8 * s + 7]);
                pb[s] = __builtin_bit_cast(bf16x8, w);
                v4u x; x.x = cvtpk(s1[8 * s], s1[8 * s + 1]); x.y = cvtpk(s1[8 * s + 2], s1[8 * s + 3]); x.z = cvtpk(s1[8 * s + 4], s1[8 * s + 5]); x.w = cvtpk(s1[8 * s + 6], s1[8 * s + 7]);
                pb[2 + s] = __builtin_bit_cast(bf16x8, x);
            }
            if (VM & 1) { asm volatile("" :: "v"(pb[0]), "v"(pb[1]), "v"(pb[2]), "v"(pb[3])); } else {
            const LAS unsigned char* vbase = Vb + (4 * hi + ((lane & 15) >> 2)) * VRS + ((lane >> 4) & 1) * 32 + (lane & 3) * 8;
#pragma unroll
            for (int s = 0; s < 4; ++s) {
                const v4i16 a0 = __builtin_amdgcn_ds_read_tr16_b64_v4i16((LAS v4i16*)(vbase + (16 * s) * VRS));
                const v4i16 a1 = __builtin_amdgcn_ds_read_tr16_b64_v4i16((LAS v4i16*)(vbase + (16 * s + 8) * VRS));
                const v4i16 c0_ = __builtin_amdgcn_ds_read_tr16_b64_v4i16((LAS v4i16*)(vbase + (16 * s) * VRS + 64));
                const v4i16 c1_ = __builtin_amdgcn_ds_read_tr16_b64_v4i16((LAS v4i16*)(vbase + (16 * s + 8) * VRS + 64));
                const bf16x8 va = {a0[0], a0[1], a0[2], a0[3], a1[0], a1[1], a1[2], a1[3]};
                const bf16x8 vc = {c0_[0], c0_[1], c0_[2], c0_[3], c1_[0], c1_[1], c1_[2], c1_[3]};
                o0 = __builtin_amdgcn_mfma_f32_32x32x16_bf16(va, pb[s], o0, 0, 0, 0);
                o1 = __builtin_amdgcn_mfma_f32_32x32x16_bf16(vc, pb[s], o1, 0, 0, 0);
            }
            }
        }
        if (!(VM & 8) && j + 1 < nt) ATT_STORE((j + 1) & 1);
        if (!(VM & 16)) __syncthreads();
    }
    float l = xhalf_sum(lacc.x + lacc.y);
    const float sterm = has_sink ? __builtin_amdgcn_exp2f(sinkl2 - m) : 0.f;
#if MK_DEBUG
    if (dbg && hi == 0) { dbg[(size_t)qrow * 2] = __builtin_bit_cast(unsigned, m); dbg[(size_t)qrow * 2 + 1] = __builtin_bit_cast(unsigned, l); }
#endif
    if (has_sink) l += sterm;
    const float inv = 1.0f / l;
    bf16* orow = Op + (size_t)qrow * D;
#pragma unroll
    for (int g = 0; g < 4; ++g) {
        v2u w0; w0.x = pk2(o0[4 * g] * inv, o0[4 * g + 1] * inv); w0.y = pk2(o0[4 * g + 2] * inv, o0[4 * g + 3] * inv);
        v2u w1; w1.x = pk2(o1[4 * g] * inv, o1[4 * g + 1] * inv); w1.y = pk2(o1[4 * g + 2] * inv, o1[4 * g + 3] * inv);
        *(v2u*)(orow + 8 * g + 4 * hi) = w0; *(v2u*)(orow + 32 + 8 * g + 4 * hi) = w1;
    }
#undef ATT_TROW
#undef ATT_LOAD
#undef ATT_STORE
}

template <int DK, int MODE, int VM = 0>
__device__ __forceinline__ void unit2(LAS unsigned char* lds, const bf16* Qp, int qpitch, const bf16* Kp, int kpitch, const bf16* Vp, int vpitch, bf16* Op,
                                      int var, int qt, int lo, int n1, int nt, float qscale, float sink0, float sink1, bool has_sink, const LAS float* bias, const float* t32) {
    constexpr int KRS = DK * 2 + 16, NS = DK / 16, CPK = DK / 8;
    int tid = threadIdx.x; asm volatile("" : "+v"(tid)); const int lane = tid & 63, r32 = lane & 31, hi = lane >> 5, wid = __builtin_amdgcn_readfirstlane(tid >> 6);
    const int rowbase = MODE == 0 ? 512 * qt + 64 * wid : 256 * qt + 32 * wid;
    bf16x8 qr[2][NS];
#pragma unroll
    for (int u = 0; u < 2; ++u) {
        const int qrow = rowbase + (MODE == 0 ? 32 * u : 0) + r32;
        const bf16* qp = Qp + (MODE == 1 ? 64 * u : 0) + (size_t)qrow * qpitch;
#pragma unroll
        for (int s = 0; s < NS; ++s) { const v4u raw = *(const v4u*)(qp + 16 * s + 8 * hi); float f[8]; unpack8(raw, f);
#pragma unroll
            for (int i = 0; i < 8; ++i) f[i] *= qscale;
            if (DK == 96 && s >= 4) { float p[8];
#pragma unroll
                for (int i = 0; i < 8; ++i) p[i] = __shfl_xor(f[i], 32);
                rope8(f, p, t32 + ((size_t)((s == 4 ? (qrow >> 6) : (qrow & 63)) * 8)) * 2, hi == 0); }
            qr[u][s] = __builtin_bit_cast(bf16x8, pack8(f)); }
    }
    const int kkey0 = tid / CPK, kch0 = tid - kkey0 * CPK, kkey1 = (tid + 512) / CPK, kch1 = (tid + 512) - kkey1 * CPK;
    const int vkey = tid >> 3, vch = tid & 7;
    v4u kreg0, kreg1 = {0u, 0u, 0u, 0u}, vreg;
#define ATT_TROW(j) ((((j) < n1) ? (lo + (j)) : (64 + (j) - n1)) * 64)
#define ATT_LOAD(j) do { const int tr_ = ATT_TROW(j); kreg0 = *(const v4u*)(Kp + (size_t)(tr_ + kkey0) * kpitch + kch0 * 8); \
        if (DK == 96 && tid < 256) kreg1 = *(const v4u*)(Kp + (size_t)(tr_ + kkey1) * kpitch + kch1 * 8); \
        vreg = *(const v4u*)(Vp + (size_t)(tr_ + vkey) * vpitch + vch * 8); } while (0)
#define ATT_STORE(bf) do { LAS unsigned char* b_ = lds + (bf) * BUF; *(LAS v4u*)(b_ + kkey0 * KRS + kch0 * 16) = kreg0; \
        if (DK == 96 && tid < 256) *(LAS v4u*)(b_ + kkey1 * KRS + kch1 * 16) = kreg1; \
        *(LAS v4u*)(b_ + KBUF + vkey * VRS + vch * 16) = vreg; } while (0)
    constexpr float THR = 6.0f;
    float m = 0.f; f32x2 lacc[2] = {{0.f, 0.f}, {0.f, 0.f}}; f32x16 o0[2] = {{}, {}}, o1[2] = {{}, {}}; bool first = true;
    const int grw = 8 * qt + wid, r0w = min(max(grw - 4, 0), 56), i0w = rowbase;
    ATT_LOAD(0); ATT_STORE(0);
    __syncthreads();
    for (int j = 0; j < nt; ++j) {
        if (!(VM & 8) && j + 1 < nt) ATT_LOAD(j + 1);
        const int kt = ATT_TROW(j) >> 6;
        bool actv = true;
        if (kt < 64) { if (var == 0) actv = (kt >= r0w) && (kt <= r0w + 7); else if (var == 2) actv = !((64 * kt - (i0w + 31) > 128) || (i0w - (64 * kt + 63) > 128)); }
        if (actv) {
            const LAS unsigned char* Kb = lds + (j & 1) * BUF; const LAS unsigned char* Vb = Kb + KBUF;
            f32x16 s0[2] = {{}, {}}, s1[2] = {{}, {}};
#pragma unroll
            for (int s = 0; s < NS; ++s) {
                const bf16x8 ka = *(const LAS bf16x8*)(Kb + r32 * KRS + (16 * s + 8 * hi) * 2);
                const bf16x8 kb = *(const LAS bf16x8*)(Kb + (32 + r32) * KRS + (16 * s + 8 * hi) * 2);
                if (VM & 2) { asm volatile("" :: "v"(ka), "v"(kb), "v"(qr[0][s]), "v"(qr[1][s])); } else {
#pragma unroll
                for (int u = 0; u < 2; ++u) { s0[u] = __builtin_amdgcn_mfma_f32_32x32x16_bf16(ka, qr[u][s], s0[u], 0, 0, 0); s1[u] = __builtin_amdgcn_mfma_f32_32x32x16_bf16(kb, qr[u][s], s1[u], 0, 0, 0); }
                }
            }
            asm volatile("s_nop 15\n\ts_nop 7" : "+v"(s0[0]), "+v"(s1[0]), "+v"(s0[1]), "+v"(s1[1]));
            if (kt < 64 && var == 0) {
#pragma unroll
                for (int u = 0; u < 2; ++u) { const int gc = 32 * u + r32, c0 = min(max(gc - 8, 0), 48), rowoff = (kt - grw + 7) * 31 - gc + 15;
#pragma unroll
                    for (int r = 0; r < 16; ++r) { const int j0 = crow(r, hi), j1 = j0 + 32;
                        const bool v0 = (unsigned)(j0 - c0) < 16u, v1 = (unsigned)(j1 - c0) < 16u;
                        const float b0 = bias[v0 ? rowoff + j0 : 0], b1 = bias[v1 ? rowoff + j1 : 0];
                        s0[u][r] = v0 ? s0[u][r] + b0 : NEG; s1[u][r] = v1 ? s1[u][r] + b1 : NEG; } }
            } else if (kt < 64 && var == 2) {
                const int dbase = 64 * kt - (rowbase + r32) + 128;
#pragma unroll
                for (int r = 0; r < 16; ++r) { const int j0 = crow(r, hi); const bool v0 = (unsigned)(dbase + j0) <= 256u, v1 = (unsigned)(dbase + j0 + 32) <= 256u;
                    s0[0][r] = v0 ? s0[0][r] : NEG; s1[0][r] = v1 ? s1[0][r] : NEG; s0[1][r] = v0 ? s0[1][r] : NEG; s1[1][r] = v1 ? s1[1][r] : NEG; }
            }
            if (!(VM & 4)) {
            float mxa = max3f(s0[0][0], s0[0][1], s1[0][0]), mxb = max3f(s0[1][0], s0[1][1], s1[1][0]);
#pragma unroll
            for (int r = 0; r < 16; r += 2) { if (r) { mxa = max3f(mxa, s0[0][r], s0[0][r + 1]); mxb = max3f(mxb, s0[1][r], s0[1][r + 1]); }
                if (r) { mxa = max3f(mxa, s1[0][r], s1[0][r + 1]); mxb = max3f(mxb, s1[1][r], s1[1][r + 1]); } else { mxa = fmaxf(mxa, s1[0][1]); mxb = fmaxf(mxb, s1[1][1]); } }
            const float mx = xhalf_max(fmaxf(mxa, mxb)) - m;
            if (first || __any(mx > THR)) {
                const float d = first ? fmaxf(mx, -64.0f) : fmaxf(mx, 0.f), alpha = __builtin_amdgcn_exp2f(-d);
                m += d; first = false;
#pragma unroll
                for (int u = 0; u < 2; ++u) {
#pragma unroll
                    for (int r = 0; r < 16; ++r) { o0[u][r] *= alpha; o1[u][r] *= alpha; }
                    lacc[u] *= alpha; }
            }
            }
            bf16x8 pb[2][4];
#pragma unroll
            for (int u = 0; u < 2; ++u) {
                if (!(VM & 4))
#pragma unroll
                for (int r = 0; r < 16; ++r) { s0[u][r] = __builtin_amdgcn_exp2f(s0[u][r] - m); s1[u][r] = __builtin_amdgcn_exp2f(s1[u][r] - m); lacc[u] += (f32x2){s0[u][r], s1[u][r]}; }
#pragma unroll
                for (int s = 0; s < 2; ++s) {
                    v4u w; w.x = cvtpk(s0[u][8 * s], s0[u][8 * s + 1]); w.y = cvtpk(s0[u][8 * s + 2], s0[u][8 * s + 3]); w.z = cvtpk(s0[u][8 * s + 4], s0[u][8 * s + 5]); w.w = cvtpk(s0[u][8 * s + 6], s0[u][8 * s + 7]);
                    pb[u][s] = __builtin_bit_cast(bf16x8, w);
                    v4u x; x.x = cvtpk(s1[u][8 * s], s1[u][8 * s + 1]); x.y = cvtpk(s1[u][8 * s + 2], s1[u][8 * s + 3]); x.z = cvtpk(s1[u][8 * s + 4], s1[u][8 * s + 5]); x.w = cvtpk(s1[u][8 * s + 6], s1[u][8 * s + 7]);
                    pb[u][2 + s] = __builtin_bit_cast(bf16x8, x);
                }
            }
            if (VM & 1) { asm volatile("" :: "v"(pb[0][0]), "v"(pb[0][1]), "v"(pb[0][2]), "v"(pb[0][3]), "v"(pb[1][0]), "v"(pb[1][1]), "v"(pb[1][2]), "v"(pb[1][3])); } else {
            const LAS unsigned char* vbase = Vb + (4 * hi + ((lane & 15) >> 2)) * VRS + ((lane >> 4) & 1) * 32 + (lane & 3) * 8;
#pragma unroll
            for (int s = 0; s < 4; ++s) {
                const v4i16 a0 = __builtin_amdgcn_ds_read_tr16_b64_v4i16((LAS v4i16*)(vbase + (16 * s) * VRS));
                const v4i16 a1 = __builtin_amdgcn_ds_read_tr16_b64_v4i16((LAS v4i16*)(vbase + (16 * s + 8) * VRS));
                const v4i16 c0_ = __builtin_amdgcn_ds_read_tr16_b64_v4i16((LAS v4i16*)(vbase + (16 * s) * VRS + 64));
                const v4i16 c1_ = __builtin_amdgcn_ds_read_tr16_b64_v4i16((LAS v4i16*)(vbase + (16 * s + 8) * VRS + 64));
                const bf16x8 va = {a0[0], a0[1], a0[2], a0[3], a1[0], a1[1], a1[2], a1[3]};
                const bf16x8 vc = {c0_[0], c0_[1], c0_[2], c0_[3], c1_[0], c1_[1], c1_[2], c1_[3]};
#pragma unroll
                for (int u = 0; u < 2; ++u) { o0[u] = __builtin_amdgcn_mfma_f32_32x32x16_bf16(va, pb[u][s], o0[u], 0, 0, 0); o1[u] = __builtin_amdgcn_mfma_f32_32x32x16_bf16(vc, pb[u][s], o1[u], 0, 0, 0); }
            }
            }
        }
        if (!(VM & 8) && j + 1 < nt) ATT_STORE((j + 1) & 1);
        if (!(VM & 16)) __syncthreads();
    }
#pragma unroll
    for (int u = 0; u < 2; ++u) {
        float l = xhalf_sum(lacc[u].x + lacc[u].y);
        if (has_sink) l += __builtin_amdgcn_exp2f((u == 0 ? sink0 : sink1) - m);
        const float inv = 1.0f / l;
        const int qrow = rowbase + (MODE == 0 ? 32 * u : 0) + r32;
        bf16* orow = Op + (MODE == 1 ? 64 * u : 0) + (size_t)qrow * D;
#pragma unroll
        for (int g = 0; g < 4; ++g) {
            v2u w0; w0.x = pk2(o0[u][4 * g] * inv, o0[u][4 * g + 1] * inv); w0.y = pk2(o0[u][4 * g + 2] * inv, o0[u][4 * g + 3] * inv);
            v2u w1; w1.x = pk2(o1[u][4 * g] * inv, o1[u][4 * g + 1] * inv); w1.y = pk2(o1[u][4 * g + 2] * inv, o1[u][4 * g + 3] * inv);
            *(v2u*)(orow + 8 * g + 4 * hi) = w0; *(v2u*)(orow + 32 + 8 * g + 4 * hi) = w1;
        }
    }
#undef ATT_TROW
#undef ATT_LOAD
#undef ATT_STORE
}

template <int VM = 0>
__device__ __forceinline__ void unit_k2(LAS unsigned char* lds, const bf16* Qp, const bf16* Kp, const bf16* Vp, bf16* Op, int qt, int nt2, float qscale, const float* t32) {
    constexpr int DK = 96, KRS = DK * 2 + 16, NS = 6, KB2 = 128 * KRS, BUF2 = KB2 + 128 * VRS;
    int tid = threadIdx.x; asm volatile("" : "+v"(tid)); const int lane = tid & 63, r32 = lane & 31, hi = lane >> 5, wid = __builtin_amdgcn_readfirstlane(tid >> 6);
    const int qrow = 256 * qt + 32 * wid + r32;
    bf16x8 qr[NS];
#pragma unroll
    for (int s = 0; s < NS; ++s) { const v4u raw = *(const v4u*)(Qp + (size_t)qrow * 384 + 16 * s + 8 * hi); float f[8]; unpack8(raw, f);
#pragma unroll
        for (int i = 0; i < 8; ++i) f[i] *= qscale;
        if (s >= 4) { float p[8];
#pragma unroll
            for (int i = 0; i < 8; ++i) p[i] = __shfl_xor(f[i], 32);
            if (qt < 16) rope8(f, p, t32 + ((size_t)((s == 4 ? (qrow >> 6) : (qrow & 63)) * 8)) * 2, hi == 0); }
        qr[s] = __builtin_bit_cast(bf16x8, pack8(f)); }
    int kk[3], kc[3];
#pragma unroll
    for (int i = 0; i < 3; ++i) { const int c = tid + 512 * i; kk[i] = c / 12; kc[i] = c - kk[i] * 12; }
    const int vk0 = tid >> 3, vc0 = tid & 7;
    v4u kreg[3], vreg[2];
#define K2_LOAD(j) do { const size_t tr_ = (size_t)(j) * 128; _Pragma("unroll") for (int i_ = 0; i_ < 3; ++i_) kreg[i_] = *(const v4u*)(Kp + (tr_ + kk[i_]) * 384 + kc[i_] * 8); \
        vreg[0] = *(const v4u*)(Vp + (tr_ + vk0) * 256 + vc0 * 8); vreg[1] = *(const v4u*)(Vp + (tr_ + 64 + vk0) * 256 + vc0 * 8); } while (0)
#define K2_STORE(bf) do { LAS unsigned char* b_ = lds + (bf) * BUF2; _Pragma("unroll") for (int i_ = 0; i_ < 3; ++i_) *(LAS v4u*)(b_ + kk[i_] * KRS + kc[i_] * 16) = kreg[i_]; \
        *(LAS v4u*)(b_ + KB2 + vk0 * VRS + vc0 * 16) = vreg[0]; *(LAS v4u*)(b_ + KB2 + (64 + vk0) * VRS + vc0 * 16) = vreg[1]; } while (0)
    constexpr float THR = 6.0f;
    float m = 0.f; f32x2 lacc = {0.f, 0.f}; f32x16 o0 = {}, o1 = {}; bool first = true;
    K2_LOAD(0); K2_STORE(0);
    __syncthreads();
    for (int j = 0; j < nt2; ++j) {
        if (!(VM & 8) && j + 1 < nt2) K2_LOAD(j + 1);
        const LAS unsigned char* Kb = lds + (j & 1) * BUF2; const LAS unsigned char* Vb = Kb + KB2;
        f32x16 s0[2] = {{}, {}}, s1[2] = {{}, {}};
#pragma unroll
        for (int h = 0; h < 2; ++h) {
            bf16x8 ka[NS], kb[NS];
#pragma unroll
            for (int s = 0; s < NS; ++s) { ka[s] = *(const LAS bf16x8*)(Kb + (64 * h + r32) * KRS + (16 * s + 8 * hi) * 2); kb[s] = *(const LAS bf16x8*)(Kb + (64 * h + 32 + r32) * KRS + (16 * s + 8 * hi) * 2); }
            __builtin_amdgcn_sched_barrier(0);
            if (VM & 2) {
#pragma unroll
                for (int s = 0; s < NS; ++s) asm volatile("" :: "v"(ka[s]), "v"(kb[s]), "v"(qr[s]));
            } else {
#pragma unroll
                for (int s = 0; s < NS; ++s) { s0[h] = __builtin_amdgcn_mfma_f32_32x32x16_bf16(ka[s], qr[s], s0[h], 0, 0, 0); s1[h] = __builtin_amdgcn_mfma_f32_32x32x16_bf16(kb[s], qr[s], s1[h], 0, 0, 0); }
            }
        }
        asm volatile("s_nop 15\n\ts_nop 7" : "+v"(s0[0]), "+v"(s1[0]), "+v"(s0[1]), "+v"(s1[1]));
        if (!(VM & 4)) {
            float mxa = max3f(s0[0][0], s0[0][1], s1[0][0]), mxb = max3f(s0[1][0], s0[1][1], s1[1][0]);
#pragma unroll
            for (int r = 0; r < 16; r += 2) { if (r) { mxa = max3f(mxa, s0[0][r], s0[0][r + 1]); mxb = max3f(mxb, s0[1][r], s0[1][r + 1]); mxa = max3f(mxa, s1[0][r], s1[0][r + 1]); mxb = max3f(mxb, s1[1][r], s1[1][r + 1]); }
                else { mxa = fmaxf(mxa, s1[0][1]); mxb = fmaxf(mxb, s1[1][1]); } }
            const float mx = xhalf_max(fmaxf(mxa, mxb)) - m;
            if (first || __any(mx > THR)) {
                const float d = first ? fmaxf(mx, -64.0f) : fmaxf(mx, 0.f), alpha = __builtin_amdgcn_exp2f(-d);
                m += d; first = false;
#pragma unroll
                for (int r = 0; r < 16; ++r) { o0[r] *= alpha; o1[r] *= alpha; }
                lacc *= alpha;
            }
#pragma unroll
            for (int h = 0; h < 2; ++h)
#pragma unroll
                for (int r = 0; r < 16; ++r) { s0[h][r] = __builtin_amdgcn_exp2f(s0[h][r] - m); s1[h][r] = __builtin_amdgcn_exp2f(s1[h][r] - m); lacc += (f32x2){s0[h][r], s1[h][r]}; }
        }
        bf16x8 pb[8];
#pragma unroll
        for (int h = 0; h < 2; ++h)
#pragma unroll
            for (int s = 0; s < 2; ++s) {
                v4u w; w.x = cvtpk(s0[h][8 * s], s0[h][8 * s + 1]); w.y = cvtpk(s0[h][8 * s + 2], s0[h][8 * s + 3]); w.z = cvtpk(s0[h][8 * s + 4], s0[h][8 * s + 5]); w.w = cvtpk(s0[h][8 * s + 6], s0[h][8 * s + 7]);
                pb[4 * h + s] = __builtin_bit_cast(bf16x8, w);
                v4u x; x.x = cvtpk(s1[h][8 * s], s1[h][8 * s + 1]); x.y = cvtpk(s1[h][8 * s + 2], s1[h][8 * s + 3]); x.z = cvtpk(s1[h][8 * s + 4], s1[h][8 * s + 5]); x.w = cvtpk(s1[h][8 * s + 6], s1[h][8 * s + 7]);
                pb[4 * h + 2 + s] = __builtin_bit_cast(bf16x8, x);
            }
        if (VM & 1) { asm volatile("" :: "v"(pb[0]), "v"(pb[1]), "v"(pb[2]), "v"(pb[3]), "v"(pb[4]), "v"(pb[5]), "v"(pb[6]), "v"(pb[7])); } else {
        const LAS unsigned char* vbase = Vb + (4 * hi + ((lane & 15) >> 2)) * VRS + ((lane >> 4) & 1) * 32 + (lane & 3) * 8;
#pragma unroll
        for (int s = 0; s < 8; ++s) {
            const v4i16 a0 = __builtin_amdgcn_ds_read_tr16_b64_v4i16((LAS v4i16*)(vbase + (16 * s) * VRS));
            const v4i16 a1 = __builtin_amdgcn_ds_read_tr16_b64_v4i16((LAS v4i16*)(vbase + (16 * s + 8) * VRS));
            const v4i16 c0_ = __builtin_amdgcn_ds_read_tr16_b64_v4i16((LAS v4i16*)(vbase + (16 * s) * VRS + 64));
            const v4i16 c1_ = __builtin_amdgcn_ds_read_tr16_b64_v4i16((LAS v4i16*)(vbase + (16 * s + 8) * VRS + 64));
            const bf16x8 va = {a0[0], a0[1], a0[2], a0[3], a1[0], a1[1], a1[2], a1[3]};
            const bf16x8 vc = {c0_[0], c0_[1], c0_[2], c0_[3], c1_[0], c1_[1], c1_[2], c1_[3]};
            o0 = __builtin_amdgcn_mfma_f32_32x32x16_bf16(va, pb[s], o0, 0, 0, 0);
            o1 = __builtin_amdgcn_mfma_f32_32x32x16_bf16(vc, pb[s], o1, 0, 0, 0);
        }
        }
        if (!(VM & 8) && j + 1 < nt2) K2_STORE((j + 1) & 1);
        if (!(VM & 16)) __syncthreads();
    }
    const float l = xhalf_sum(lacc.x + lacc.y), inv = 1.0f / l;
    bf16* orow = Op + (size_t)qrow * D;
#pragma unroll
    for (int g = 0; g < 4; ++g) {
        v2u w0; w0.x = pk2(o0[4 * g] * inv, o0[4 * g + 1] * inv); w0.y = pk2(o0[4 * g + 2] * inv, o0[4 * g + 3] * inv);
        v2u w1; w1.x = pk2(o1[4 * g] * inv, o1[4 * g + 1] * inv); w1.y = pk2(o1[4 * g + 2] * inv, o1[4 * g + 3] * inv);
        *(v2u*)(orow + 8 * g + 4 * hi) = w0; *(v2u*)(orow + 32 + 8 * g + 4 * hi) = w1;
    }
#undef K2_LOAD
#undef K2_STORE
}
}

template <int VM = 0>
__device__ __forceinline__ void phase_attn(const Frame& F, int lq) {
    const int l = lq & 3;
    const bf16* P = (const bf16*)(F.ws + WS_PB); const bf16* QD = (const bf16*)(F.ws + WS_QD); const bf16* KD = (const bf16*)(F.ws + WS_KD);
    const bf16* VD = (const bf16*)(F.ws + WS_VD); bf16* O = (bf16*)(F.ws + (lq >= 4 ? WS_ACT : WS_HA));
    unsigned* ctr = (unsigned*)(F.ws + WS_CTL) + CW_QUEUE + 64 * 8 * lq;
    LAS float* bias = (LAS float*)(F.lds + att::BIAS_OFF);
    { const float* nab = INP(I_NABIAS) + l * 4 * 465; for (int i = F.tid; i < 4 * 465; i += NTHR) bias[i] = nab[i] * LOG2E; }
    const float* sinks = INP(I_SINK) + l * 4;
    __syncthreads();
    const float* t32 = (const float*)(F.ws + WS_T32);
    const int nloc = 320 + (l < NL - 1 ? 24 : 0);
    const int q0 = (int)xb_xcc_id();
    for (int qq = 0; qq < 8; ++qq) {
      const int q = (q0 + qq) & 7;
      unsigned* qctr = ctr + 64 * q;
      for (;;) {
        if (F.tid == 0) F.MISC[MI_Q] = __hip_atomic_fetch_add(qctr, 1u, __ATOMIC_RELAXED, __HIP_MEMORY_SCOPE_AGENT);
        __syncthreads();
        const int li = (int)F.MISC[MI_Q];
        __syncthreads();
        if (li >= nloc) break;
        int idx;
        if (li < 128) idx = (q + 8 * (li >> 4)) * 16 + (li & 15);
        else if (li < 192) { const int jx = li - 128; idx = 1024 + (q + 8 * (jx >> 4)) * 16 + (jx & 15); }
        else if (li < 256) { const int jx = li - 192; idx = 1536 + (q + 8 * (jx >> 3)) * 8 + (jx & 7); }
        else if (li < 320) { const int jx = li - 256; idx = 2048 + (q + 8 * (jx >> 4)) * 16 + (jx & 15); }
        else if (li < 328) idx = 2560 + q + 8 * (li - 320);
        else idx = 2624 + q + 8 * (li - 328);
        if (idx < 1024) {
            const int b = idx >> 6, h = (idx >> 4) & 3, qt = idx & 15; const size_t rb = (size_t)b * TT;
            att::unit<96, VM>(F.lds, QD + rb * 384 + h * 96, 384, KD + rb * 384 + h * 96, 384, VD + rb * 256 + h * 64, 256, O + rb * D + 768 + h * 64, 3, qt, 0, 64, 68, 0.10206207261596575f * LOG2E, 0.f, false, bias, t32, nullptr);
        } else if (idx < 2560) {
            idx -= 1024;
            const int grp = idx >> 9, rem = idx & 511, b = rem >> 5; const size_t rb = (size_t)b * TT;
            if (grp == 1) {
                const int h = (rem >> 3) & 3, qt = rem & 7; const int lo = min(max(8 * qt - 4, 0), 56), n1 = min(max(8 * qt + 3, 0), 56) + 7 - lo + 1;
                att::unit2<64, 0, VM>(F.lds, P + rb * NPJ + h * 64, NPJ, P + rb * NPJ + 256 + h * 64, NPJ, P + rb * NPJ + 512 + h * 64, NPJ, O + rb * D + h * 64, 0, qt, lo, n1, n1 + 4,
                                  0.125f * LOG2E, 0.f, 0.f, false, bias + h * 465, t32);
            } else {
                const int g = (rem >> 4) & 1, qt = rem & 15; const bool isc = grp == 2;
                const int lo = isc ? max(4 * qt - 2, 0) : 0, n1 = isc ? min(4 * qt + 5, 63) - lo + 1 : 64;
                const int qc = (isc ? 1280 : 768) + g * 128, kc = (isc ? 1536 : 1024) + g * 64, vc = (isc ? 1664 : 1152) + g * 64;
                att::unit2<64, 1, VM>(F.lds, P + rb * NPJ + qc, NPJ, P + rb * NPJ + kc, NPJ, P + rb * NPJ + vc, NPJ, O + rb * D + (isc ? 512 : 256) + g * 128, isc ? 2 : 1, qt, lo, n1, n1 + 4,
                                  0.125f * LOG2E, isc ? sinks[2 * g] * LOG2E : 0.f, isc ? sinks[2 * g + 1] * LOG2E : 0.f, isc, bias, t32);
            }
        } else if (idx < 2624) {
            const int rem = idx - 2560, b = rem >> 2, isc = (rem >> 1) & 1, g = rem & 1; const size_t rb = (size_t)b * TT;
            const int qc = (isc ? 1280 : 768) + g * 128, kc = (isc ? 1536 : 1024) + g * 64, vc = (isc ? 1664 : 1152) + g * 64;
            att::unit2<64, 1, VM>(F.lds, P + rb * NPJ + qc, NPJ, P + rb * NPJ + kc, NPJ, P + rb * NPJ + vc, NPJ, O + rb * D + (isc ? 512 : 256) + g * 128, isc ? 2 : 1, 16, 0, 0, 4,
                              0.125f * LOG2E, isc ? sinks[2 * g] * LOG2E : 0.f, isc ? sinks[2 * g + 1] * LOG2E : 0.f, isc != 0, bias, t32);
        } else {
            const int rem = idx - 2624, b = rem >> 3, isd = (rem >> 2) & 1, h = rem & 3; const size_t rb = (size_t)b * TT;
            if (isd) att::unit<96, VM>(F.lds, QD + rb * 384 + h * 96, 384, KD + rb * 384 + h * 96, 384, VD + rb * 256 + h * 64, 256, O + rb * D + 768 + h * 64, 3, 16, 0, 0, 4, 0.10206207261596575f * LOG2E, 0.f, false, bias, t32, nullptr);
            else att::unit<64, VM>(F.lds, P + rb * NPJ + h * 64, NPJ, P + rb * NPJ + 256 + h * 64, NPJ, P + rb * NPJ + 512 + h * 64, NPJ, O + rb * D + h * 64, 0, 16, 0, 0, 4, 0.125f * LOG2E, 0.f, false, bias + h * 465, nullptr, nullptr);
        }
    }
    }
}


#define PHASE_FN static __device__ __forceinline__ void
PHASE_FN ph_prologue(GAS unsigned char* ws) { const Frame F = make_frame(ws); phase_prologue(F); }
PHASE_FN ph_ln(GAS unsigned char* ws, int l) { const Frame F = make_frame(ws); phase_ln(F, l); }
PHASE_FN ph_gemm_in(GAS unsigned char* ws, int l) {
    const Frame F = make_frame(ws);
    pg8::Gemm g{(const bf16*)(F.ws + WS_HA), (const bf16*)(F.ws + WS_WIN), M, NPJ, D, D, nullptr}; pg8::StaticOrder S; S.init(M, NPJ, F.G, F.bid);
    pg8::EpiBf16NT<0> E{(bf16*)(F.ws + WS_PB), NPJ, nullptr, 0, 0, 1.f};
    pg8::gemm_phase<pg8::EpiBf16NT<0>, pg8::StaticOrder, true, true>(F.lds, g, S, E);
}
PHASE_FN ph_post(GAS unsigned char* ws, int l) { const Frame F = make_frame(ws); phase_post(F, l); }
PHASE_FN ph_gemm_mla(GAS unsigned char* ws, int l) {
    const Frame F = make_frame(ws);
    pg8::Gemm g{(const bf16*)(F.ws + WS_PB) + 1792, (const bf16*)(F.ws + WS_WD), M, 1024, 384, NPJ, nullptr}; pg8::StaticOrder S; S.init(M, 1024, F.G, F.bid);
    EpiMla E{(bf16*)(F.ws + WS_QD), (bf16*)(F.ws + WS_KD), (bf16*)(F.ws + WS_VD)};
    pg8::gemm_phase<EpiMla, pg8::StaticOrder, true, true>(F.lds, g, S, E);
}
template <int VM>
PHASE_FN ph_attn(GAS unsigned char* ws, int l) { const Frame F = make_frame(ws); phase_attn<VM>(F, l); }
PHASE_FN ph_gemm_out(GAS unsigned char* ws, int l) {
    const Frame F = make_frame(ws);
    pg8::Gemm g{(const bf16*)(F.ws + WS_HA), (const bf16*)(F.ws + WS_WOUT), M, D, D, D, nullptr};
    pg8::EpiBf16NT<0> E{(bf16*)(F.ws + WS_PB), D, nullptr, 0, 0, 1.f};
    if (l == NL - 1) { LatOrder S{F.G, F.bid}; pg8::gemm_phase<pg8::EpiBf16NT<0>, LatOrder, true, true>(F.lds, g, S, E); }
    else { pg8::StaticOrder S; S.init(M, D, F.G, F.bid); pg8::gemm_phase<pg8::EpiBf16NT<0>, pg8::StaticOrder, true, true>(F.lds, g, S, E); }
}
PHASE_FN ph_route(GAS unsigned char* ws, int l) { const Frame F = make_frame(ws); phase_route(F, l); }
PHASE_FN ph_permute(GAS unsigned char* ws, int l) { const Frame F = make_frame(ws); phase_permute(F, l); }
PHASE_FN ph_gemm_gu(GAS unsigned char* ws, int l) {
    const Frame F = make_frame(ws);
    moe_tables(F);
    pg8::Gemm g{(const bf16*)(F.ws + WS_HA), (const bf16*)(F.ws + WS_WGU), MS, 16384, D, D, (const int*)(F.ws + WS_QD)}; MoeOrder S{F.MISC + MI_PST, F.G, F.bid};
    EpiGU E{(bf16*)(F.ws + WS_ACT)};
    pg8::gemm_phase<EpiGU, MoeOrder, true, true, true>(F.lds, g, S, E);
}
PHASE_FN ph_gemm_dn(GAS unsigned char* ws, int l) {
    const Frame F = make_frame(ws);
    moe_tables(F);
    pg8::Gemm g{(const bf16*)(F.ws + WS_ACT), (const bf16*)(F.ws + WS_WDN), MS, 16384, 512, 512, nullptr}; MoeOrder S{F.MISC + MI_PST, F.G, F.bid};
    pg8::EpiBf16NT<0> E{(bf16*)(F.ws + WS_PB), D, nullptr, 1024, 0, 1.f};
    pg8::gemm_phase<pg8::EpiBf16NT<0>, MoeOrder, true, true>(F.lds, g, S, E);
}


#if MK_DEBUG
#ifndef DBG_MODE
#define DBG_MODE 0
#endif
__device__ __forceinline__ float oracle_attn(const Frame& F, int l, int r, int var, int h, int mode = 0) {
    const bf16* P = (const bf16*)(F.ws + WS_PB); const bf16* QD = (const bf16*)(F.ws + WS_QD); const bf16* KD = (const bf16*)(F.ws + WS_KD); const bf16* VD = (const bf16*)(F.ws + WS_VD);
    const bf16* O = (const bf16*)(F.ws + WS_HA); const float* t32 = (const float*)(F.ws + WS_T32);
    const int b = r / TT, t = r - b * TT; const bool lat = t < SEQ; const size_t rb = (size_t)b * TT;
    const int dk = var == 3 ? 96 : 64;
    const bf16* qp; const bf16* kp; const bf16* vp; int kpitch, vpitch;
    if (var == 3) { qp = QD + (size_t)r * 384 + h * 96; kp = KD + rb * 384 + h * 96; kpitch = 384; vp = VD + rb * 256 + h * 64; vpitch = 256; }
    else { const int qc = var == 0 ? h * 64 : var == 1 ? 768 + h * 64 : 1280 + h * 64, kc = var == 0 ? 256 + h * 64 : var == 1 ? 1024 + (h >> 1) * 64 : 1536 + (h >> 1) * 64,
           vc = var == 0 ? 512 + h * 64 : var == 1 ? 1152 + (h >> 1) * 64 : 1664 + (h >> 1) * 64;
           qp = P + (size_t)r * NPJ + qc; kp = P + rb * NPJ + kc; kpitch = NPJ; vp = P + rb * NPJ + vc; vpitch = NPJ; }
    LAS float* qs = (LAS float*)(F.lds + 65536) + F.wave * 128;
    for (int d = F.lane; d < dk; d += 64) qs[d] = __builtin_bit_cast(float, (unsigned)qp[d] << 16);
    asm volatile("s_waitcnt lgkmcnt(0)" ::: "memory");
    if (var == 3 && lat && F.lane < 32) {
        const int c = F.lane >> 3, e = F.lane & 7, gr = t >> 6, gc = t & 63; const float own = qs[64 + F.lane], par = qs[64 + (F.lane ^ 8)];
        const float cs = t32[((c < 2 ? gr : gc) * 8 + e) * 2], sn = t32[((c < 2 ? gr : gc) * 8 + e) * 2 + 1];
        const float nv = (c & 1) == 0 ? own * cs - par * sn : par * sn + own * cs;
        asm volatile("s_waitcnt lgkmcnt(0)" ::: "memory"); qs[64 + F.lane] = nv; }
    asm volatile("s_waitcnt lgkmcnt(0)" ::: "memory");
    const float scale = var == 3 ? 0.10206207261596575f : 0.125f;
    const int gr = t >> 6, gc = t & 63, r0 = min(max(gr - 4, 0), 56), c0 = min(max(gc - 8, 0), 48);
    float m = -3.0e38f, lsum = 0.f, acc[64];
#pragma unroll
    for (int d = 0; d < 64; ++d) acc[d] = 0.f;
    for (int j = F.lane; j < TT; j += 64) {
        bool ok = true; float bias = 0.f;
        if (!lat) ok = j >= SEQ;
        else if (j < SEQ) {
            if (var == 0) { const int kr = j >> 6, kc2 = j & 63; ok = kr >= r0 && kr <= r0 + 7 && kc2 >= c0 && kc2 <= c0 + 15;
                if (ok) bias = INP(I_NABIAS)[((l * 4 + h) * 15 + (kr - gr + 7)) * 31 + (kc2 - gc + 15)]; }
            else if (var == 2) ok = (j - t <= 128) && (t - j <= 128);
        }
        if (!ok) continue;
        float sc = 0.f; const bf16* kr_ = kp + (size_t)j * kpitch;
        for (int d = 0; d < dk; ++d) sc += qs[d] * __builtin_bit_cast(float, (unsigned)kr_[d] << 16);
        sc = sc * scale + bias;
        const float mn = fmaxf(m, sc), a = expf(m - mn), p = expf(sc - mn); m = mn; lsum = lsum * a + p;
        const bf16* vr = vp + (size_t)j * vpitch;
#pragma unroll
        for (int d = 0; d < 64; ++d) acc[d] = acc[d] * a + p * __builtin_bit_cast(float, (unsigned)vr[d] << 16);
    }
    float mg = m;
#pragma unroll
    for (int o = 1; o < 64; o <<= 1) mg = fmaxf(mg, __shfl_xor(mg, o));
    if (mode >= 1) {
        const unsigned* rec = (const unsigned*)(F.ws + WS_RS) + (size_t)r * 2; const float mk = __builtin_bit_cast(float, rec[0]), lk = __builtin_bit_cast(float, rec[1]);
        const float lref = wave_sum(lsum * expf(m - mg));
        const float lker = lk * exp2f(mk - mg * LOG2E);
        if (mode == 2) return fabsf(mk / LOG2E - mg);
        return fabsf(lker / lref - 1.0f);
    }
    const float f = expf(m - mg); lsum *= f; lsum = wave_sum(lsum);
    if (var == 2) lsum += expf(INP(I_SINK)[l * 4 + h] - mg);
    float err = 0.f, mag = 1.0e-6f;
    const bf16* orow = O + (size_t)r * D + var * 256 + h * 64;
#pragma unroll
    for (int d = 0; d < 64; ++d) { const float ref = wave_sum(acc[d] * f) / lsum; const float got = __builtin_bit_cast(float, (unsigned)orow[d] << 16);
        const float df = fabsf(got - ref); err = (df == df) ? fmaxf(err, df) : 1.0e30f; mag = fmaxf(mag, fabsf(ref)); }
    return err / mag;
}
__device__ __forceinline__ void phase_dump(const Frame& F, int code) {
    float* out = (float*)ptab_get(F, I_OUT);
    for (int r = F.gw; r < M; r += F.ngw) {
        const int b = r / TT, t = r - b * TT; if (t >= SEQ) continue;
        float v[16];
        if (code == 1) ld16bf((const bf16*)(F.ws + WS_HA) + (size_t)r * D, F.lane, v);
        else if (code == 2) ld16bf((const bf16*)(F.ws + WS_PB) + (size_t)r * NPJ, F.lane, v);
        else if (code == 3) ld16bf((const bf16*)(F.ws + WS_PB) + (size_t)r * NPJ + 1024, F.lane, v);
        else if (code == 4) ld16bf((const bf16*)(F.ws + WS_PB) + (size_t)r * NPJ + 1280, F.lane, v);
        else if (code == 5) ld16((const float*)(F.ws + WS_PB) + (size_t)r * D, F.lane, v);
        else if (code == 8) {
            const v4u w0 = *((const v4u*)((const bf16*)(F.ws + WS_HA) + (size_t)r * D) + F.lane), w1 = *((const v4u*)((const bf16*)(F.ws + WS_HA) + (size_t)r * D) + 64 + F.lane);
            float f[8]; int bad0 = 0, bad1 = 0; unpack8(w0, f);
#pragma unroll
            for (int i = 0; i < 8; ++i) { const unsigned u = __builtin_bit_cast(unsigned, f[i]); bad0 |= ((u & 0x7f800000u) == 0x7f800000u) ? 1 : 0; }
            unpack8(w1, f);
#pragma unroll
            for (int i = 0; i < 8; ++i) { const unsigned u = __builtin_bit_cast(unsigned, f[i]); bad1 |= ((u & 0x7f800000u) == 0x7f800000u) ? 1 : 0; }
            const unsigned long long m0 = __ballot(bad0), m1 = __ballot(bad1);
            const bool vA = (m0 & 0xffffffffull) != 0, vB = (m0 >> 32) != 0, vC = (m1 & 0xffffffffull) != 0, vD = (m1 >> 32) != 0;
            const float val = (float)(t + 1) * ((vA ? 1.0f : 0.f) + (vB ? 1.0e2f : 0.f) + (vC ? 1.0e4f : 0.f) + (vD ? 1.0e6f : 0.f));
#pragma unroll
            for (int i = 0; i < 16; ++i) v[i] = val;
        }
        else if (code == 9) { const unsigned cd = ((const unsigned*)(F.ws + WS_RS))[(size_t)r * 2]; float val = 0.f; if (cd) { val = 1.f; for (unsigned k = 0; k < cd; ++k) val *= 10.f; }
#pragma unroll
            for (int i = 0; i < 16; ++i) v[i] = val; }
        else if (code == 10) {
            const v4u w1 = *((const v4u*)((const bf16*)(F.ws + WS_HA) + (size_t)r * D) + 64 + F.lane);
            float f[8]; int bad1 = 0; unpack8(w1, f);
#pragma unroll
            for (int i = 0; i < 8; ++i) { const unsigned u = __builtin_bit_cast(unsigned, f[i]); bad1 |= ((u & 0x7f800000u) == 0x7f800000u) ? 1 : 0; }
            const bool vC = (__ballot(bad1) & 0xffffffffull) != 0;
            const bf16* pc = (const bf16*)(F.ws + WS_PB) + ((size_t)b * TT + SEQ + (t & 255)) * NPJ; int badp = 0;
            for (int c = F.lane; c < 288; c += 64) { const v4u w = *((const v4u*)pc + c); unpack8(w, f);
#pragma unroll
                for (int i = 0; i < 8; ++i) { const unsigned u = __builtin_bit_cast(unsigned, f[i]); badp |= ((u & 0x7f800000u) == 0x7f800000u) ? 1 : 0; } }
            float val = 0.f; if (vC) { val = 1.f; for (int k = 0; k <= (t & 15); ++k) val *= 10.f; }
            if (__any(badp)) val = 1.0e30f;
#pragma unroll
            for (int i = 0; i < 16; ++i) v[i] = val;
        }
        else if (code == 11) {
            const bf16* pr = (const bf16*)(F.ws + WS_PB) + (size_t)r * NPJ; int grp = -1;
            for (int c = F.lane; c < 288; c += 64) { const v4u w = *((const v4u*)pr + c); float f[8]; unpack8(w, f);
#pragma unroll
                for (int i = 0; i < 8; ++i) if (!(fabsf(f[i]) < 1.0e4f)) grp = (c * 8) >> 8; }
#pragma unroll
            for (int o = 1; o < 64; o <<= 1) { const int g2 = __shfl_xor(grp, o); grp = g2 > grp ? g2 : grp; }
            float val = 0.f; if (grp >= 0) { val = 100.f; for (int k = 0; k < grp; ++k) val *= 10.f; }
#pragma unroll
            for (int i = 0; i < 16; ++i) v[i] = val;
        }
        else if (code >= 20 && code < 24) {
            float val = 0.f;
            if ((t & 15) == 5) { for (int h = 0; h < 4; ++h) { const float e = oracle_attn(F, 0, r, code - 20, h); const float cls = e > 1.0e20f ? 3.f : e > 0.5f ? 2.f : e > 0.03f ? 1.f : 0.f; if (cls > 0.f) { float w = cls; for (int k = 0; k <= h; ++k) w *= 10.f; val = fmaxf(val, w); } } }
#pragma unroll
            for (int i = 0; i < 16; ++i) v[i] = val;
        }
        else if (code >= 30 && code < 46) {
            float val = 0.f;
            if ((t & 15) == 5) { const float e = oracle_attn(F, 0, r, (code - 30) >> 2, (code - 30) & 3, DBG_MODE); val = e > 10.f ? 1.0e4f : 1000.f * e; }
#pragma unroll
            for (int i = 0; i < 16; ++i) v[i] = val;
        }
        else if (code == 7) {
            auto bad16 = [&](const bf16* p, int nchunks) { int bad = 0; for (int c = F.lane; c < nchunks; c += 64) { const v4u w = *((const v4u*)p + c); float f[8]; unpack8(w, f);
#pragma unroll
                for (int i = 0; i < 8; ++i) { const unsigned u = __builtin_bit_cast(unsigned, f[i]); bad |= ((u & 0x7f800000u) == 0x7f800000u) ? 1 : 0; } } return __any(bad); };
            const int bP = bad16((const bf16*)(F.ws + WS_PB) + (size_t)r * NPJ, 288), bQ = bad16((const bf16*)(F.ws + WS_QD) + (size_t)r * 384, 48),
                      bK = bad16((const bf16*)(F.ws + WS_KD) + (size_t)r * 384, 48), bV = bad16((const bf16*)(F.ws + WS_VD) + (size_t)r * 256, 32), bO = bad16((const bf16*)(F.ws + WS_HA) + (size_t)r * D, 128);
            const float val = bP ? 1.0e6f : bQ ? 1.0e5f : bK ? 1.0e4f : bV ? 1.0e3f : bO ? 1.0e2f : 0.f;
#pragma unroll
            for (int i = 0; i < 16; ++i) v[i] = val;
        }
#pragma unroll
        for (int i = 0; i < 16; ++i) { const unsigned u = __builtin_bit_cast(unsigned, v[i]); if ((u & 0x7f800000u) == 0x7f800000u) v[i] = 777.0f; }
        st16(out + ((size_t)b * SEQ + t) * D, F.lane, v);
    }
}
static __device__ __forceinline__ void ph_dump(GAS unsigned char* ws, int code) { const Frame F = make_frame(ws); phase_dump(F, code); }
#endif
__global__ void __launch_bounds__(NTHR, 2) mk_fwd(Args args) {
    extern __shared__ __attribute__((aligned(16))) unsigned char lds_raw[];
    LAS unsigned char* lds = (LAS unsigned char*)lds_raw; volatile LAS unsigned* MISC = (volatile LAS unsigned*)(lds + MISC_OFF);
    const int tid = threadIdx.x;
    GAS unsigned char* ws = (GAS unsigned char*)args.ws;
    for (int u = tid; u < (LDS_BYTES - MISC_OFF) / 4; u += NTHR) MISC[u] = 0u;
    __syncthreads();
    if (tid < 28) { const unsigned long long p = tid < 27 ? (unsigned long long)args.in[tid] : (unsigned long long)args.out;
        LAS unsigned* t = (LAS unsigned*)(lds + PTAB_OFF) + 2 * tid; t[0] = (unsigned)p; t[1] = (unsigned)(p >> 32); }
    __syncthreads();
#if MK_MULTI
#define GRID_BAR() do { } while (0)
#else
    XcdBarrier bar = xcd_barrier_post((unsigned*)(ws + WS_CTL) + CW_BAR, MISC + MI_BAR);
#define GRID_BAR() xcd_barrier(bar)
#endif
    const int lo = args.ph_lo, hi = args.ph_hi;
#define IN(k) (lo <= (k) && (k) < hi)
#if MK_TIME
    unsigned long long tcat = 0ull, tb0 = 0ull;
#define TBEG() do { tb0 = __builtin_amdgcn_s_memrealtime(); } while (0)
#define TEND(c) do { if ((c) == MK_TIME - 1) tcat += __builtin_amdgcn_s_memrealtime() - tb0; } while (0)
#define SEAM(k) do { if (IN(k) && IN((k) + 1)) { TBEG(); GRID_BAR(); TEND(1); } } while (0)
#else
#define TBEG() do { } while (0)
#define TEND(c) do { } while (0)
#define SEAM(k) do { if (IN(k) && IN((k) + 1)) GRID_BAR(); } while (0)
#endif

#if MK_DEBUG
    if (lo >= 100) { ph_dump(ws, lo - 100); return; }
#endif
    if (IN(0)) { TBEG(); ph_prologue(ws); TEND(2); } SEAM(0);
    for (int l = 0; l < NL; ++l) {
        const int pb = 1 + 10 * l;
        if (IN(pb + 0)) { TBEG(); ph_ln(ws, l); TEND(0); } SEAM(pb + 0);
        if (IN(pb + 1)) { TBEG(); ph_gemm_in(ws, l); if (MK_DUP & 2) { GRID_BAR(); ph_gemm_in(ws, l); } TEND(3); } SEAM(pb + 1);
        if (IN(pb + 2)) { TBEG(); ph_post(ws, l); TEND(0); } SEAM(pb + 2);
        if (IN(pb + 3)) { TBEG(); ph_gemm_mla(ws, l); if (MK_DUP & 8) { GRID_BAR(); ph_gemm_mla(ws, l); } TEND(3); } SEAM(pb + 3);
        if (IN(pb + 4)) { TBEG(); ph_attn<0>(ws, l); if (MK_DUP & 16) { GRID_BAR(); ph_attn<MK_VM>(ws, l + 4); } TEND(4); } SEAM(pb + 4);
        if (IN(pb + 5)) { TBEG(); ph_gemm_out(ws, l); if (MK_DUP & 32) { GRID_BAR(); ph_gemm_out(ws, l); } TEND(3); } SEAM(pb + 5);
        if (IN(pb + 6)) { TBEG(); ph_route(ws, l); TEND(0); } SEAM(pb + 6);
        if (IN(pb + 7)) { TBEG(); ph_permute(ws, l); if (MK_DUP & 128) { GRID_BAR(); ph_permute(ws, l); } TEND(0); } SEAM(pb + 7);
        if (IN(pb + 8)) { TBEG(); ph_gemm_gu(ws, l); if (MK_DUP & 256) { GRID_BAR(); ph_gemm_gu(ws, l); } TEND(3); } SEAM(pb + 8);
        if (IN(pb + 9)) { TBEG(); ph_gemm_dn(ws, l); if (MK_DUP & 512) { GRID_BAR(); ph_gemm_dn(ws, l); } TEND(3); } SEAM(pb + 9);
    }
    if (IN(NPHASE - 1)) { TBEG(); ph_ln(ws, NL); TEND(0); }
#if MK_TIME
    if (blockIdx.x == 0) { const unsigned long long tw = __builtin_amdgcn_s_memrealtime(); const unsigned long long dl = tcat * (unsigned long long)MK_TMUL; while (__builtin_amdgcn_s_memrealtime() - tw < dl) __builtin_amdgcn_s_sleep(8); }
#endif
#undef IN
#undef SEAM
#undef GRID_BAR
}

extern "C" void kernel_launch(void* const* d_in, const int* in_sizes, int n_in, void* d_out, int out_size, void* d_ws, size_t ws_size, hipStream_t stream) {
    static int grid = 0;
    if (grid == 0) {
        if (n_in != 27 || out_size != NB * SEQ * D || ws_size < WS_END) { fprintf(stderr, "kernel_launch: unexpected problem (n_in %d, out %d, ws %zu < %zu)\n", n_in, out_size, ws_size, (size_t)WS_END); grid = -1; return; }
        int dev = 0, cus = 0, per_cu = 0;
        if (hipGetDevice(&dev) != hipSuccess || hipDeviceGetAttribute(&cus, hipDeviceAttributeMultiprocessorCount, dev) != hipSuccess) { grid = -1; return; }
        if (hipFuncSetAttribute((const void*)mk_fwd, hipFuncAttributeMaxDynamicSharedMemorySize, LDS_BYTES) != hipSuccess) { fprintf(stderr, "kernel_launch: hipFuncSetAttribute failed\n"); grid = -1; return; }
        if (hipOccupancyMaxActiveBlocksPerMultiprocessor(&per_cu, (const void*)mk_fwd, NTHR, LDS_BYTES) != hipSuccess || per_cu < 1) fprintf(stderr, "kernel_launch: occupancy query reports %d\n", per_cu);
        (void)hipGetLastError();
        grid = cus > 1024 ? 1024 : cus;
    }
    if (grid < 0) return;
    (void)hipMemsetAsync((char*)d_ws + WS_CTL, 0, CTL_BYTES, stream);
    Args a{};
    for (int i = 0; i < 27; ++i) a.in[i] = (const float*)d_in[i];
    a.out = (float*)d_out; a.ws = (unsigned char*)d_ws;
#if MK_MULTI
#ifndef DBG_NRUN
#define DBG_NRUN NPHASE
#endif
    for (int p = 0; p < DBG_NRUN; ++p) { a.ph_lo = p; a.ph_hi = p + 1; hipLaunchKernelGGL(mk_fwd, dim3(grid), dim3(NTHR), LDS_BYTES, stream, a); }
#ifdef DBG_DUMP
    a.ph_lo = 100 + DBG_DUMP; a.ph_hi = 101 + DBG_DUMP; hipLaunchKernelGGL(mk_fwd, dim3(grid), dim3(NTHR), LDS_BYTES, stream, a);
#endif
#else
    a.ph_lo = 0; a.ph_hi = NPHASE;
    hipLaunchKernelGGL(mk_fwd, dim3(grid), dim3(NTHR), LDS_BYTES, stream, a);
#endif
}
```

```cpp
#include <hip/hip_runtime.h>
#include <cstdio>
#include <cstdint>
namespace pg8 {
#define PG8_LAS __attribute__((address_space(3)))
typedef unsigned short bf16_t;
typedef short bf16x8 __attribute__((ext_vector_type(8)));
typedef float f32x4 __attribute__((ext_vector_type(4)));
typedef unsigned u32x4 __attribute__((ext_vector_type(4)));
constexpr int BM = 256, BK = 64, HALF = 128, HTB = HALF * BK * 2  , STAGE_BYTES = 8 * HTB, NXCD = 8, WGM = 8;

__host__ __device__ __forceinline__ int lds_byte(int r, int c) { const int st = (r >> 4) * 2 + (c >> 5), rr = r & 15, cc = c & 31, ob = rr * 64 + cc * 2; return st * 1024 + (ob ^ (((ob >> 9) & 1) << 5)); }
__host__ __device__ __forceinline__ void stage_rc(int b, int& R, int& C) { const int st = b / 1024, sb = b % 1024, swz = sb ^ (((sb >> 9) & 1) << 5); R = (st >> 1) * 16 + swz / 64; C = (st & 1) * 32 + (swz % 64) / 2; }
__host__ __device__ __forceinline__ int perm32(int rho) { const int n = rho >> 4, i = rho & 15; return 8 * (i >> 2) + 4 * n + (i & 3); }

struct Unit { int pm, pn; };
struct Gemm { const bf16_t* A; const bf16_t* Bt; int M, N, K, lda; const int* src; };

struct StaticOrder {
    int nM, nN, nwg, G, c;
    __host__ __device__ void init(int M, int N, int G_, int c_) { nM = M / BM; nN = N / BM; nwg = nM * nN; G = G_; c = c_; }
    __host__ __device__ bool next(int i, Unit& u) const {
        const long L = (long)i * G + c; if (L >= nwg) return false;
        int wgid = (int)L; { const int q = nwg / NXCD, r = nwg % NXCD, xcd = wgid % NXCD, off = wgid / NXCD; wgid = (xcd < r ? xcd * (q + 1) : r * (q + 1) + (xcd - r) * q) + off; }
        const int nig = WGM * nN, gid = wgid / nig, fm = gid * WGM, gsz = (nM - fm) < WGM ? (nM - fm) : WGM;
        u.pm = fm + ((wgid % nig) % gsz); u.pn = (wgid % nig) / gsz; return true;
    }
    __device__ __forceinline__ void a_ready(const Unit&) const {}
    __device__ __forceinline__ void done(const Unit&) const {}
};

__device__ __forceinline__ unsigned cvt_pk_bf16(float lo, float hi) { unsigned r; asm volatile("v_cvt_pk_bf16_f32 %0, %1, %2" : "=v"(r) : "v"(lo), "v"(hi)); return r; }
typedef float f32x2 __attribute__((ext_vector_type(2)));
__device__ __forceinline__ f32x2 gelu_pk(f32x2 v) {
    const f32x2 av = __builtin_elementwise_abs(v), d = av * 0.2316418882f + 1.0f;
    f32x2 t; t.x = __builtin_amdgcn_rcpf(d.x); t.y = __builtin_amdgcn_rcpf(d.y);
    f32x2 q = t * 0.5307027145f + (-0.7265760135f); q = q * t + 0.7107068705f; q = q * t + (-0.142248368f); q = q * t + 0.127414796f; q = q * t;
    const f32x2 s = (v * v) * (-0.72134752044f);
    f32x2 e; e.x = __builtin_amdgcn_exp2f(s.x); e.y = __builtin_amdgcn_exp2f(s.y);
    const f32x2 m = v * (q * e), r = v - m;
    f32x2 o; o.x = v.x < 0.f ? m.x : r.x; o.y = v.y < 0.f ? m.y : r.y; return o;
}

template <int ACT  > struct EpiBf16 {
    static constexpr bool PERM = true, AFTER_DRAIN = false; static_assert(ACT == 0 || ACT == 1, "EpiBf16: ACT is 0 (none) or 1 (gelu_pk)");
    bf16_t* O; int ldc; const float* bias; int split_cols; size_t split_stride; float scale0;
    __device__ __forceinline__ void operator()(const f32x4 (&acc)[2][2][4][2], const Unit& u, int wr, int wc, int fr, int fq) const {
        const int row0 = u.pm * BM + wr * 64 + fr; int colt = u.pn * BM; bf16_t* base = O;
        float sc = 1.f; if (split_cols) { const int t = colt / split_cols; base += (size_t)t * split_stride; colt -= t * split_cols; if (t == 0) sc = scale0; }
        const int col0 = colt + wc * 32 + 8 * fq, bcol0 = u.pn * BM + wc * 32 + 8 * fq;
        f32x4 bv[2][2];
#pragma unroll
        for (int bj = 0; bj < 2; ++bj)
#pragma unroll
            for (int n = 0; n < 2; ++n) bv[bj][n] = bias ? *(const f32x4*)(bias + bcol0 + bj * HALF + 4 * n) : (f32x4){0.f, 0.f, 0.f, 0.f};
#pragma unroll
        for (int ai = 0; ai < 2; ++ai)
#pragma unroll
            for (int m = 0; m < 4; ++m) { bf16_t* rowp = base + (size_t)(row0 + ai * HALF + m * 16) * ldc + col0;
#pragma unroll
                for (int bj = 0; bj < 2; ++bj) { f32x4 v0 = acc[ai][bj][m][0] + bv[bj][0], v1 = acc[ai][bj][m][1] + bv[bj][1];
                    if (ACT == 1) { f32x2 a = gelu_pk((f32x2){v0[0], v0[1]}), b = gelu_pk((f32x2){v0[2], v0[3]}), c = gelu_pk((f32x2){v1[0], v1[1]}), d = gelu_pk((f32x2){v1[2], v1[3]});
                        v0 = (f32x4){a.x, a.y, b.x, b.y}; v1 = (f32x4){c.x, c.y, d.x, d.y}; }
                    v0 = v0 * sc; v1 = v1 * sc; u32x4 w; w.x = cvt_pk_bf16(v0[0], v0[1]); w.y = cvt_pk_bf16(v0[2], v0[3]); w.z = cvt_pk_bf16(v1[0], v1[1]); w.w = cvt_pk_bf16(v1[2], v1[3]);
                    *(u32x4*)(rowp + bj * HALF) = w; } }
    }
};
template <int ACT  > struct EpiBf16NT {
    static constexpr bool PERM = true, AFTER_DRAIN = false; static_assert(ACT == 0 || ACT == 1, "EpiBf16: ACT is 0 (none) or 1 (gelu_pk)");
    bf16_t* O; int ldc; const float* bias; int split_cols; size_t split_stride; float scale0;
    __device__ __forceinline__ void operator()(const f32x4 (&acc)[2][2][4][2], const Unit& u, int wr, int wc, int fr, int fq) const {
        const int row0 = u.pm * BM + wr * 64 + fr; int colt = u.pn * BM; bf16_t* base = O;
        float sc = 1.f; if (split_cols) { const int t = colt / split_cols; base += (size_t)t * split_stride; colt -= t * split_cols; if (t == 0) sc = scale0; }
        const int col0 = colt + wc * 32 + 8 * fq, bcol0 = u.pn * BM + wc * 32 + 8 * fq;
        f32x4 bv[2][2];
#pragma unroll
        for (int bj = 0; bj < 2; ++bj)
#pragma unroll
            for (int n = 0; n < 2; ++n) bv[bj][n] = bias ? *(const f32x4*)(bias + bcol0 + bj * HALF + 4 * n) : (f32x4){0.f, 0.f, 0.f, 0.f};
#pragma unroll
        for (int ai = 0; ai < 2; ++ai)
#pragma unroll
            for (int m = 0; m < 4; ++m) { bf16_t* rowp = base + (size_t)(row0 + ai * HALF + m * 16) * ldc + col0;
#pragma unroll
                for (int bj = 0; bj < 2; ++bj) { f32x4 v0 = acc[ai][bj][m][0] + bv[bj][0], v1 = acc[ai][bj][m][1] + bv[bj][1];
                    if (ACT == 1) { f32x2 a = gelu_pk((f32x2){v0[0], v0[1]}), b = gelu_pk((f32x2){v0[2], v0[3]}), c = gelu_pk((f32x2){v1[0], v1[1]}), d = gelu_pk((f32x2){v1[2], v1[3]});
                        v0 = (f32x4){a.x, a.y, b.x, b.y}; v1 = (f32x4){c.x, c.y, d.x, d.y}; }
                    v0 = v0 * sc; v1 = v1 * sc; u32x4 w; w.x = cvt_pk_bf16(v0[0], v0[1]); w.y = cvt_pk_bf16(v0[2], v0[3]); w.z = cvt_pk_bf16(v1[0], v1[1]); w.w = cvt_pk_bf16(v1[2], v1[3]);
                    __builtin_nontemporal_store(w, (u32x4*)(rowp + bj * HALF)); } }
    }
};
struct EpiF32 {
    static constexpr bool PERM = false, AFTER_DRAIN = false;
    float* C; int ldc; const float* bias;
    __device__ __forceinline__ void operator()(const f32x4 (&acc)[2][2][4][2], const Unit& u, int wr, int wc, int fr, int fq) const {
        const int row0 = u.pm * BM + wr * 64 + fr, col0 = u.pn * BM + wc * 32 + 4 * fq;
        f32x4 bv[2][2];
#pragma unroll
        for (int bj = 0; bj < 2; ++bj)
#pragma unroll
            for (int n = 0; n < 2; ++n) bv[bj][n] = bias ? *(const f32x4*)(bias + col0 + bj * HALF + n * 16) : (f32x4){0.f, 0.f, 0.f, 0.f};
#pragma unroll
        for (int ai = 0; ai < 2; ++ai)
#pragma unroll
            for (int m = 0; m < 4; ++m) { float* rowp = C + (size_t)(row0 + ai * HALF + m * 16) * ldc + col0;
#pragma unroll
                for (int bj = 0; bj < 2; ++bj)
#pragma unroll
                    for (int n = 0; n < 2; ++n) *(f32x4*)(rowp + bj * HALF + n * 16) = acc[ai][bj][m][n] + bv[bj][n]; }
    }
};
template <class Epi, class Sched, bool ALIGN_EPI = false, bool SP2 = false, bool GATHER = false>
__device__ __forceinline__ void gemm_phase(PG8_LAS unsigned char* lds, const Gemm g, const Sched& S, const Epi& E) {
    int tid = threadIdx.x; asm volatile("" : "+v"(tid)); const int wid = __builtin_amdgcn_readfirstlane(tid >> 6), lane = tid & 63, wr = wid >> 2, wc = wid & 3, fr = lane & 15, fq = lane >> 4;
    const int K = g.K, nt = K / BK;
    unsigned voffA[2], voffB[2]; int RA[2]; unsigned CA2[2];
#pragma unroll
    for (int i = 0; i < 2; ++i) { int R, C; stage_rc(tid * 16 + i * 8192, R, C); const int Rb = Epi::PERM ? ((R & ~31) + perm32(R & 31)) : R;
        voffA[i] = (unsigned)(R * g.lda + C) * 2u; voffB[i] = (unsigned)(Rb * K + C) * 2u; RA[i] = R; CA2[i] = (unsigned)C * 2u; }
    unsigned gcur[2][2] = {{0u, 0u}, {0u, 0u}}, gnxt[2][2] = {{0u, 0u}, {0u, 0u}};
#define PG8_GOFF(dst, u_) do { _Pragma("unroll") for (int h_ = 0; h_ < 2; ++h_) _Pragma("unroll") for (int i_ = 0; i_ < 2; ++i_) \
        dst[h_][i_] = (unsigned)g.src[(u_).pm * BM + h_ * HALF + RA[i_]] * (unsigned)(g.lda * 2) + CA2[i_]; } while (0)
#define PG8_STAGE_A(bufoff, gbase, h, nx) do { if constexpr (GATHER) { unsigned vs_[2] = {(nx) ? gnxt[h][0] : gcur[h][0], (nx) ? gnxt[h][1] : gcur[h][1]}; PG8_STAGE(bufoff, gbase, vs_); } \
        else { PG8_STAGE(bufoff, (gbase) + ((h) ? hstepA : 0), voffA); } } while (0)
    const size_t kstep = (size_t)(BK * 2);
    const size_t hstepA = (size_t)HALF * g.lda * 2, hstepB = (size_t)HALF * K * 2;
    const size_t tstepA = 2 * hstepA, tstepB = 2 * hstepB;
    const unsigned ldsw = (unsigned)wid * 1024u;
    const int aoff = lds_byte(wr * 64 + fr, fq * 8), boff = lds_byte(wc * 32 + fr, fq * 8);
#define PG8_SA(b, h) (((b) * 2 + (h)) * HTB)
#define PG8_SB(b, h) ((4 + (b) * 2 + (h)) * HTB)
#define PG8_STAGE(bufoff, gbase, voff) do { _Pragma("unroll") for (int _i = 0; _i < 2; ++_i) \
        __builtin_amdgcn_global_load_lds((const unsigned*)((const char*)(gbase) + (voff)[_i]), (PG8_LAS unsigned*)(lds + (bufoff) + ldsw + _i * 8192), 16, 0, 0); } while (0)
#define PG8_LDA(dst, b, h) do { _Pragma("unroll") for (int m = 0; m < 4; ++m) _Pragma("unroll") for (int k = 0; k < 2; ++k) dst[m][k] = *(const PG8_LAS bf16x8*)(lds + PG8_SA(b, h) + aoff + m * 2048 + k * 1024); } while (0)
#define PG8_LDB(dst, b, h) do { _Pragma("unroll") for (int n = 0; n < 2; ++n) _Pragma("unroll") for (int k = 0; k < 2; ++k) dst[n][k] = *(const PG8_LAS bf16x8*)(lds + PG8_SB(b, h) + boff + n * 2048 + k * 1024); } while (0)
#define PG8_MMA(ai, bj, At, Bt) do { __builtin_amdgcn_s_setprio(1); _Pragma("unroll") for (int m = 0; m < 4; ++m) _Pragma("unroll") for (int n = 0; n < 2; ++n) _Pragma("unroll") for (int k = 0; k < 2; ++k) \
        acc[ai][bj][m][n] = __builtin_amdgcn_mfma_f32_16x16x32_bf16(Bt[n][k], At[m][k], acc[ai][bj][m][n], 0, 0, 0); __builtin_amdgcn_s_setprio(0); } while (0)
#define PG8_WAIT_V(n) asm volatile("s_waitcnt vmcnt(" #n ")" ::: "memory")
#define PG8_WAIT_L(n) asm volatile("s_waitcnt lgkmcnt(" #n ")" ::: "memory")
#define PG8_BAR __builtin_amdgcn_s_barrier()
#define PG8_SCHED __builtin_amdgcn_sched_barrier(0)
    Unit cur, nxt; int ui = 0;
    if (!S.next(0, cur)) return;
    f32x4 acc[2][2][4][2];
#pragma unroll
    for (int a = 0; a < 2; ++a)
#pragma unroll
        for (int b = 0; b < 2; ++b)
#pragma unroll
            for (int m = 0; m < 4; ++m)
#pragma unroll
                for (int n = 0; n < 2; ++n) acc[a][b][m][n] = (f32x4){0.f, 0.f, 0.f, 0.f};
    bf16x8 At[4][2], B0[2][2], B1[2][2];
    const char* cA = (const char*)g.A + (GATHER ? (size_t)0 : (size_t)cur.pm * tstepA); const char* cB = (const char*)g.Bt + (size_t)cur.pn * tstepB;
    if constexpr (GATHER) PG8_GOFF(gcur, cur);
    S.a_ready(cur);
    if constexpr (SP2) {
        PG8_STAGE(PG8_SB(0, 0), cB, voffB); PG8_STAGE(PG8_SB(0, 1), cB + hstepB, voffB); PG8_STAGE_A(PG8_SA(0, 0), cA, 0, false); PG8_STAGE_A(PG8_SA(0, 1), cA, 1, false);
        if (wr == 1) PG8_BAR;
        PG8_WAIT_V(2); PG8_BAR;
        PG8_STAGE(PG8_SB(1, 0), cB + kstep, voffB); PG8_STAGE_A(PG8_SA(1, 0), cA + kstep, 0, false); PG8_STAGE(PG8_SB(1, 1), cB + hstepB + kstep, voffB);
        PG8_WAIT_V(6); PG8_BAR;
    } else {
        PG8_STAGE(PG8_SB(0, 0), cB, voffB); PG8_STAGE_A(PG8_SA(0, 0), cA, 0, false); PG8_STAGE(PG8_SB(0, 1), cB + hstepB, voffB); PG8_STAGE_A(PG8_SA(0, 1), cA, 1, false);
        if (wr == 1) PG8_BAR;
        PG8_WAIT_V(4); PG8_BAR;
        PG8_STAGE(PG8_SB(1, 0), cB + kstep, voffB); PG8_STAGE_A(PG8_SA(1, 0), cA + kstep, 0, false); PG8_STAGE(PG8_SB(1, 1), cB + hstepB + kstep, voffB);
        PG8_WAIT_V(6); PG8_BAR;
    }
    for (;;) {
        const bool has_next = S.next(ui + 1, nxt);
        const char* nA = (has_next && !GATHER) ? (const char*)g.A + (size_t)nxt.pm * tstepA : cA; const char* nB = has_next ? (const char*)g.Bt + (size_t)nxt.pn * tstepB : cB;
        if constexpr (GATHER) { if (has_next) PG8_GOFF(gnxt, nxt); else { _Pragma("unroll") for (int h_ = 0; h_ < 2; ++h_) { gnxt[h_][0] = gcur[h_][0]; gnxt[h_][1] = gcur[h_][1]; } } }
#pragma unroll 1
        for (int t = 0; t < nt; t += 2) {
            const bool last = (t == nt - 2);
            const char* a1 = cA + (size_t)(t + 1) * kstep;
            const char* a2 = last ? nA : cA + (size_t)(t + 2) * kstep; const char* b2 = last ? nB : cB + (size_t)(t + 2) * kstep;
            const char* a3 = a2 + kstep; const char* b3 = b2 + kstep;
            if (last && has_next) S.a_ready(nxt);
            if constexpr (SP2) {
            PG8_LDB(B0, 0, 0); PG8_LDB(B1, 0, 1); PG8_SCHED; PG8_LDA(At, 0, 0); PG8_STAGE_A(PG8_SA(1, 1), a1, 1, false);
            PG8_WAIT_V(8); PG8_WAIT_L(0); PG8_BAR; PG8_MMA(0, 0, At, B0); PG8_MMA(0, 1, At, B1); PG8_BAR; PG8_SCHED;
            PG8_LDA(At, 0, 1); PG8_STAGE(PG8_SB(0, 0), b2, voffB); PG8_STAGE(PG8_SB(0, 1), b2 + hstepB, voffB); PG8_STAGE_A(PG8_SA(0, 0), a2, 0, last);
            PG8_WAIT_V(8); PG8_WAIT_L(0); PG8_BAR; PG8_MMA(1, 0, At, B0); PG8_MMA(1, 1, At, B1); PG8_BAR; PG8_SCHED;
            PG8_LDB(B0, 1, 0); PG8_LDB(B1, 1, 1); PG8_SCHED; PG8_LDA(At, 1, 0); PG8_STAGE_A(PG8_SA(0, 1), a2, 1, last);
            PG8_WAIT_V(8); PG8_WAIT_L(0); PG8_BAR; PG8_MMA(0, 0, At, B0); PG8_MMA(0, 1, At, B1); PG8_BAR; PG8_SCHED;
            PG8_LDA(At, 1, 1); PG8_STAGE(PG8_SB(1, 0), b3, voffB); PG8_STAGE(PG8_SB(1, 1), b3 + hstepB, voffB); PG8_STAGE_A(PG8_SA(1, 0), a3, 0, last);
            PG8_WAIT_V(8); PG8_WAIT_L(0); PG8_BAR; PG8_MMA(1, 0, At, B0); PG8_MMA(1, 1, At, B1); PG8_BAR; PG8_SCHED;
            } else {
            PG8_LDB(B0, 0, 0); PG8_SCHED; PG8_LDA(At, 0, 0); PG8_STAGE_A(PG8_SA(1, 1), a1, 1, false);
            PG8_WAIT_L(8); PG8_BAR; PG8_WAIT_L(0); PG8_MMA(0, 0, At, B0); PG8_BAR; PG8_SCHED;
            PG8_LDB(B1, 0, 1); PG8_STAGE(PG8_SB(0, 0), b2, voffB);
            PG8_BAR; PG8_WAIT_L(0); PG8_MMA(0, 1, At, B1); PG8_BAR;
            PG8_LDA(At, 0, 1); PG8_STAGE_A(PG8_SA(0, 0), a2, 0, last);
            PG8_BAR; PG8_WAIT_L(0); PG8_MMA(1, 0, At, B0); PG8_BAR; PG8_SCHED;
            PG8_STAGE(PG8_SB(0, 1), b2 + hstepB, voffB);
            PG8_WAIT_V(6); PG8_BAR; PG8_MMA(1, 1, At, B1); PG8_BAR;
            PG8_LDB(B0, 1, 0); PG8_SCHED; PG8_LDA(At, 1, 0); PG8_STAGE_A(PG8_SA(0, 1), a2, 1, last);
            PG8_WAIT_L(8); PG8_BAR; PG8_WAIT_L(0); PG8_MMA(0, 0, At, B0); PG8_BAR; PG8_SCHED;
            PG8_LDB(B1, 1, 1); PG8_STAGE(PG8_SB(1, 0), b3, voffB);
            PG8_BAR; PG8_WAIT_L(0); PG8_MMA(0, 1, At, B1); PG8_BAR;
            PG8_LDA(At, 1, 1); PG8_STAGE_A(PG8_SA(1, 0), a3, 0, last);
            PG8_BAR; PG8_WAIT_L(0); PG8_MMA(1, 0, At, B0); PG8_BAR; PG8_SCHED;
            PG8_STAGE(PG8_SB(1, 1), b3 + hstepB, voffB);
            PG8_WAIT_V(6); PG8_BAR; PG8_MMA(1, 1, At, B1); PG8_BAR;
            }
        }
        if constexpr (ALIGN_EPI) { if (wr == 0) PG8_BAR; }
        if constexpr (!Epi::AFTER_DRAIN) { E(acc, cur, wr, wc, fr, fq); S.done(cur); }
        if (!has_next) break;
#pragma unroll
        for (int a = 0; a < 2; ++a)
#pragma unroll
            for (int b = 0; b < 2; ++b)
#pragma unroll
                for (int m = 0; m < 4; ++m)
#pragma unroll
                    for (int n = 0; n < 2; ++n) acc[a][b][m][n] = (f32x4){0.f, 0.f, 0.f, 0.f};
        cur = nxt; cA = nA; cB = nB; ++ui;
        if constexpr (GATHER) { _Pragma("unroll") for (int h_ = 0; h_ < 2; ++h_) { gcur[h_][0] = gnxt[h_][0]; gcur[h_][1] = gnxt[h_][1]; } }
        if constexpr (ALIGN_EPI) { if (wr == 1) PG8_BAR; }
    }
    PG8_WAIT_V(0);
    if constexpr (!ALIGN_EPI) { if (wr == 0) PG8_BAR; }
    PG8_BAR;
    if constexpr (Epi::AFTER_DRAIN) { E.fused(acc, cur, wr, wc, fr, fq, lds, wid, lane); S.done(cur); }
#undef PG8_SA
#undef PG8_GOFF
#undef PG8_STAGE_A
#undef PG8_SB
#undef PG8_STAGE
#undef PG8_LDA
#undef PG8_LDB
#undef PG8_MMA
#undef PG8_WAIT_V
#undef PG8_WAIT_L
#undef PG8_BAR
#undef PG8_SCHED
}
}

constexpr int NB = 16, SEQ = 4096, CTX = 256, TT = SEQ + CTX, M = NB * TT, D = 1024, NL = 4;
constexpr int NPJ = 2304, DPROJ = 2208;
constexpr int MS = 143360;
constexpr float EPS = 1e-6f, ALPHA = 1.6817928305074290f, LOG2E = 1.4426950408889634f;
constexpr int NWAVES = 8, NTHR = 512;
#ifndef MK_DEBUG
#define MK_DEBUG 0
#endif
#ifndef MK_TIME
#define MK_TIME 0
#endif
#ifndef MK_TMUL
#define MK_TMUL 1
#endif
#ifndef MK_VM
#define MK_VM 0
#endif
#ifndef MK_DUP
#define MK_DUP 0
#endif
#ifndef MK_MULTI
#define MK_MULTI 0
#endif
constexpr int NPHASE = 2 + 10 * NL;

constexpr size_t WS_CTL = 0, CTL_BYTES = 65536;
constexpr size_t WS_MODS = WS_CTL + CTL_BYTES;
constexpr size_t WS_T64 = WS_MODS + (size_t)NL * 17 * 6144 * 4;
constexpr size_t WS_T32 = WS_T64 + 8192;
constexpr size_t WS_RS = WS_T32 + 4096;
constexpr size_t WS_RT = WS_RS + (size_t)M * 8;
constexpr size_t WS_HIST = WS_RT + (size_t)M * 32;
constexpr size_t WS_XS = WS_HIST + 65536;
constexpr size_t WS_WIN = WS_XS + (size_t)M * D * 2;
constexpr size_t WS_WD = WS_WIN + (size_t)NPJ * D * 2;
constexpr size_t WS_WOUT = WS_WD + (size_t)1024 * 384 * 2;
constexpr size_t WS_WGU = WS_WOUT + (size_t)D * D * 2;
constexpr size_t WS_WDN = WS_WGU + (size_t)16 * 1024 * 1024 * 2;
constexpr size_t WS_HA = WS_WDN + (size_t)16 * 1024 * 512 * 2;
constexpr size_t WS_PB = WS_HA + (size_t)M * D * 2;
constexpr size_t WS_QD = WS_PB + (size_t)M * NPJ * 2;
constexpr size_t WS_KD = WS_QD + (size_t)M * 384 * 2;
constexpr size_t WS_VD = WS_KD + (size_t)M * 384 * 2;
constexpr size_t WS_ACT = WS_VD + (size_t)M * 256 * 2;
constexpr size_t WS_END = WS_ACT + (size_t)MS * 512 * 2;
static_assert(WS_END <= (size_t)1073741824, "d_ws map must fit 1 GiB");
static_assert((size_t)M * NPJ * 2 >= (size_t)MS * D * 2 && (size_t)M * NPJ * 2 >= (size_t)M * D * 4, "region PB overlays");
constexpr int CW_BAR = 0;
constexpr int CW_QUEUE = 4096;

constexpr int RING_BYTES = 131072, MISC_OFF = RING_BYTES, LDS_BYTES = 147456;
constexpr int MI_BAR = 0, MI_Q = 4, MI_TOT = 16, MI_BASE = 32, MI_PST = 48, MI_LH = 80;

#define GAS __attribute__((address_space(1)))
#define LAS __attribute__((address_space(3)))
typedef unsigned short bf16;
typedef unsigned v4u __attribute__((ext_vector_type(4)));
typedef unsigned v2u __attribute__((ext_vector_type(2)));
typedef float f32x4 __attribute__((ext_vector_type(4)));
typedef float f32x2 __attribute__((ext_vector_type(2)));
typedef short bf16x8 __attribute__((ext_vector_type(8)));
typedef float f32x16 __attribute__((ext_vector_type(16)));
typedef short v4i16 __attribute__((ext_vector_type(4)));

__device__ __forceinline__ unsigned f2bf(float f) { unsigned u = __builtin_bit_cast(unsigned, f); return (u + 0x7fffu + ((u >> 16) & 1u)) >> 16; }
__device__ __forceinline__ unsigned pk2(float lo, float hi) { return f2bf(lo) | (f2bf(hi) << 16); }
__device__ __forceinline__ float bflo(unsigned w) { return __builtin_bit_cast(float, w << 16); }
__device__ __forceinline__ float bfhi(unsigned w) { return __builtin_bit_cast(float, w & 0xffff0000u); }
__device__ __forceinline__ void unpack8(v4u w, float (&f)[8]) { f[0] = bflo(w.x); f[1] = bfhi(w.x); f[2] = bflo(w.y); f[3] = bfhi(w.y); f[4] = bflo(w.z); f[5] = bfhi(w.z); f[6] = bflo(w.w); f[7] = bfhi(w.w); }
__device__ __forceinline__ v4u pack8(const float (&f)[8]) { v4u w; w.x = pk2(f[0], f[1]); w.y = pk2(f[2], f[3]); w.z = pk2(f[4], f[5]); w.w = pk2(f[6], f[7]); return w; }
__device__ __forceinline__ float wave_sum(float v) {
    int x = __builtin_bit_cast(int, v);
#define WS_DPP(ctrl, rmask) v += __builtin_bit_cast(float, __builtin_amdgcn_update_dpp(0, x, ctrl, rmask, 0xf, true)); x = __builtin_bit_cast(int, v)
    WS_DPP(0xB1, 0xf);
    WS_DPP(0x4E, 0xf);
    WS_DPP(0x141, 0xf);
    WS_DPP(0x140, 0xf);
    WS_DPP(0x142, 0xa);
    WS_DPP(0x143, 0xc);
#undef WS_DPP
    return __builtin_bit_cast(float, __builtin_amdgcn_readlane(__builtin_bit_cast(int, v), 63));
}

#define XB_TMO      128
#define XB_XCNT(j)  (256  + 64 * (j))
#define XB_XSUB(j)  (1280 + 64 * (j))
#define XB_XGEN(j)  (2304 + 64 * (j))
#define XB_TOP      3328
#define XB_TOPGEN   3392
#define XCD_BAR_WORDS 3456
#define XB_SPIN_CAP (1u << 22)
__device__ __forceinline__ unsigned xb_ld(unsigned* p)              { return __hip_atomic_load(p, __ATOMIC_RELAXED, __HIP_MEMORY_SCOPE_AGENT); }
__device__ __forceinline__ unsigned xb_add(unsigned* p, unsigned v) { return __hip_atomic_fetch_add(p, v, __ATOMIC_RELAXED, __HIP_MEMORY_SCOPE_AGENT); }
__device__ __forceinline__ unsigned xb_xcc_id() { return (unsigned)__builtin_amdgcn_s_getreg((3 << 11) | 20) & 0xFu; }
#define XB_SPIN(cond, bar) do { unsigned _sp = 0; while (cond) { __builtin_amdgcn_s_sleep(1); \
    if ((++_sp & 255u) == 0u) { if (xb_ld(&(bar)[XB_TMO])) break; if (_sp > XB_SPIN_CAP) { atomicAdd(&(bar)[XB_TMO], 1u); break; } } } } while (0)
struct XcdBarrier { unsigned* bar; unsigned x; volatile LAS unsigned* st; };
__device__ __forceinline__ XcdBarrier xcd_barrier_post(unsigned* bar, volatile LAS unsigned* st) {
    XcdBarrier b; b.bar = bar; b.x = xb_xcc_id(); b.st = st;
    if (threadIdx.x == 0) (void)xb_add(&bar[XB_XCNT(b.x)], 1u);
    return b;
}
__device__ __forceinline__ void xcd_barrier_complete(unsigned* bar, unsigned x, unsigned& nloc, unsigned& nx) {
    const unsigned G = gridDim.x * gridDim.y * gridDim.z;
    unsigned sum, cnt, mine, sp = 0u;
    for (;;) {
        sum = 0u; cnt = 0u; mine = 0u;
#pragma unroll
        for (unsigned j = 0; j < 16; ++j) { const unsigned c = xb_ld(&bar[XB_XCNT(j)]); sum += c; cnt += (c > 0u) ? 1u : 0u; mine = (j == x) ? c : mine; }
        if (sum == G) break;
        __builtin_amdgcn_s_sleep(1);
        if ((++sp & 255u) == 0u) { if (xb_ld(&bar[XB_TMO])) break; if (sp > XB_SPIN_CAP) { atomicAdd(&bar[XB_TMO], 1u); break; } }
    }
    nloc = mine > 0u ? mine : 1u; nx = cnt > 0u ? cnt : 1u;
}
__device__ __forceinline__ void xcd_barrier(const XcdBarrier& b) {
    asm volatile("s_waitcnt vmcnt(0)" ::: "memory");
    __syncthreads();
    if (threadIdx.x == 0) {
        unsigned* bar = b.bar;
        __builtin_amdgcn_s_waitcnt(0);
        unsigned nloc = b.st[0], nx = b.st[1];
        if (nloc == 0u) { xcd_barrier_complete(bar, b.x, nloc, nx); b.st[0] = nloc; b.st[1] = nx; }
        const unsigned old = xb_add(&bar[XB_XSUB(b.x)], 1u);
        const unsigned gen = old / nloc;
        if (old + 1u == (gen + 1u) * nloc) {
            __builtin_amdgcn_fence(__ATOMIC_RELEASE, "agent");
            asm volatile("s_waitcnt vmcnt(0)" ::: "memory");
            const unsigned og = xb_add(&bar[XB_TOP], 1u);
            const unsigned tg = og / nx;
            if (og + 1u == (tg + 1u) * nx) xb_add(&bar[XB_TOPGEN], 1u);
            else XB_SPIN(xb_ld(&bar[XB_TOPGEN]) == tg, bar);
            __builtin_amdgcn_fence(__ATOMIC_ACQUIRE, "agent");
            xb_add(&bar[XB_XGEN(b.x)], 1u);
            asm volatile("s_waitcnt vmcnt(0)" ::: "memory");
        } else {
            XB_SPIN(xb_ld(&bar[XB_XGEN(b.x)]) == gen, bar);
            __builtin_amdgcn_fence(__ATOMIC_ACQUIRE, "agent");
            asm volatile("s_waitcnt vmcnt(0)" ::: "memory");
        }
    }
    __syncthreads();
}

struct Args { const float* in[27]; float* out; unsigned char* ws; int ph_lo, ph_hi; };
enum { I_X = 0, I_C, I_CTX, I_CCTX, I_WADA, I_BADA, I_WIN, I_NABIAS, I_GQG, I_GKG, I_SINK, I_MQG, I_WQB, I_MKVG, I_WKVB, I_WOUT, I_LN1G, I_LN1B, I_RGW, I_RGB, I_REW, I_REB, I_WG, I_WU, I_WDN, I_LN2G, I_LN2B };

struct Frame {
    LAS unsigned char* lds; volatile LAS unsigned* MISC;
    int tid, lane, wave, G, gw, ngw, bid;
    GAS unsigned char* ws;
};
__device__ __forceinline__ int opaque_tid() { int t = threadIdx.x; asm volatile("" : "+v"(t)); return t; }
__device__ __forceinline__ int opaque_s(int x) { asm volatile("" : "+s"(x)); return x; }
constexpr int PTAB_OFF = MISC_OFF + 2048, I_OUT = 27;
__device__ __forceinline__ GAS unsigned char* ptab_get(const Frame& F, int i) {
    const LAS unsigned* t = (const LAS unsigned*)(F.lds + PTAB_OFF) + 2 * i;
    const unsigned lo = __builtin_amdgcn_readfirstlane(t[0]), hi = __builtin_amdgcn_readfirstlane(t[1]);
    return (GAS unsigned char*)(((unsigned long long)hi << 32) | lo);
}
#define INP(i) ((const float*)ptab_get(F, (i)))
__device__ __forceinline__ Frame make_frame(GAS unsigned char* ws) {
    extern __shared__ __attribute__((aligned(16))) unsigned char lds_raw[];
    Frame F;
    F.lds = (LAS unsigned char*)lds_raw; F.MISC = (volatile LAS unsigned*)(F.lds + MISC_OFF);
    F.tid = opaque_tid(); F.lane = F.tid & 63; F.wave = __builtin_amdgcn_readfirstlane(F.tid >> 6);
    F.G = opaque_s((int)gridDim.x); F.bid = opaque_s((int)blockIdx.x); F.gw = F.bid * NWAVES + F.wave; F.ngw = F.G * NWAVES;
    { unsigned long long w = (unsigned long long)ws; asm volatile("" : "+s"(w)); F.ws = (GAS unsigned char*)w; }
    return F;
}
typedef _Float16 f16x4 __attribute__((ext_vector_type(4)));
struct RowPtrs { const float* x; const float* ctx; float* out; _Float16* xs; };
__device__ __forceinline__ RowPtrs row_ptrs(const Frame& F) { RowPtrs p; p.x = INP(I_X); p.ctx = INP(I_CTX); p.out = (float*)ptab_get(F, I_OUT); p.xs = (_Float16*)(F.ws + WS_XS); return p; }
__device__ __forceinline__ const float* xin_row(const RowPtrs& P, int r) {
    const int b = r / TT, t = r - b * TT;
    return t < SEQ ? P.x + ((size_t)b * SEQ + t) * D : P.ctx + ((size_t)b * CTX + (t - SEQ)) * D;
}
__device__ __forceinline__ float* out_row(const RowPtrs& P, int r) { const int b = r / TT, t = r - b * TT; return P.out + ((size_t)b * SEQ + t) * D; }
__device__ __forceinline__ void ld16h(const _Float16* p, int lane, float (&v)[16]) {
    const f16x4* q = (const f16x4*)p + lane;
#pragma unroll
    for (int g = 0; g < 4; ++g) { const f32x4 f = __builtin_convertvector(__builtin_nontemporal_load(q + 64 * g), f32x4); v[4 * g] = f.x; v[4 * g + 1] = f.y; v[4 * g + 2] = f.z; v[4 * g + 3] = f.w; }
}
__device__ __forceinline__ void st16h(_Float16* p, int lane, const float (&v)[16]) {
    f16x4* q = (f16x4*)p + lane;
#pragma unroll
    for (int g = 0; g < 4; ++g) __builtin_nontemporal_store(__builtin_convertvector((f32x4){v[4 * g], v[4 * g + 1], v[4 * g + 2], v[4 * g + 3]}, f16x4), q + 64 * g);
}
__device__ __forceinline__ void ld16(const float* p, int lane, float (&v)[16]) {
    const f32x4* q = (const f32x4*)p + lane;
    const f32x4 a = q[0], b = q[64], c = q[128], d = q[192];
    v[0] = a.x; v[1] = a.y; v[2] = a.z; v[3] = a.w; v[4] = b.x; v[5] = b.y; v[6] = b.z; v[7] = b.w;
    v[8] = c.x; v[9] = c.y; v[10] = c.z; v[11] = c.w; v[12] = d.x; v[13] = d.y; v[14] = d.z; v[15] = d.w;
}
__device__ __forceinline__ void st16(float* p, int lane, const float (&v)[16]) {
    f32x4* q = (f32x4*)p + lane;
    q[0] = (f32x4){v[0], v[1], v[2], v[3]}; q[64] = (f32x4){v[4], v[5], v[6], v[7]};
    q[128] = (f32x4){v[8], v[9], v[10], v[11]}; q[192] = (f32x4){v[12], v[13], v[14], v[15]};
}
__device__ __forceinline__ void ld16nt(const float* p, int lane, float (&v)[16]) {
    const f32x4* q = (const f32x4*)p + lane;
    const f32x4 a = __builtin_nontemporal_load(q), b = __builtin_nontemporal_load(q + 64), c = __builtin_nontemporal_load(q + 128), d = __builtin_nontemporal_load(q + 192);
    v[0] = a.x; v[1] = a.y; v[2] = a.z; v[3] = a.w; v[4] = b.x; v[5] = b.y; v[6] = b.z; v[7] = b.w;
    v[8] = c.x; v[9] = c.y; v[10] = c.z; v[11] = c.w; v[12] = d.x; v[13] = d.y; v[14] = d.z; v[15] = d.w;
}
__device__ __forceinline__ void st16nt(float* p, int lane, const float (&v)[16]) {
    f32x4* q = (f32x4*)p + lane;
    __builtin_nontemporal_store((f32x4){v[0], v[1], v[2], v[3]}, q); __builtin_nontemporal_store((f32x4){v[4], v[5], v[6], v[7]}, q + 64);
    __builtin_nontemporal_store((f32x4){v[8], v[9], v[10], v[11]}, q + 128); __builtin_nontemporal_store((f32x4){v[12], v[13], v[14], v[15]}, q + 192);
}
__device__ __forceinline__ void unpack16(const v2u (&w)[4], float (&v)[16]) {
#pragma unroll
    for (int g = 0; g < 4; ++g) { v[4 * g] = bflo(w[g].x); v[4 * g + 1] = bfhi(w[g].x); v[4 * g + 2] = bflo(w[g].y); v[4 * g + 3] = bfhi(w[g].y); }
}
__device__ __forceinline__ void ld16bf_raw(const bf16* p, int lane, v2u (&w)[4]) {
    const v2u* q = (const v2u*)p + lane; w[0] = q[0]; w[1] = q[64]; w[2] = q[128]; w[3] = q[192];
}
__device__ __forceinline__ void ld16bf_raw_nt(const bf16* p, int lane, v2u (&w)[4]) {
    const v2u* q = (const v2u*)p + lane; w[0] = __builtin_nontemporal_load(q); w[1] = __builtin_nontemporal_load(q + 64); w[2] = __builtin_nontemporal_load(q + 128); w[3] = __builtin_nontemporal_load(q + 192);
}
__device__ __forceinline__ void ld16bf(const bf16* p, int lane, float (&v)[16]) { v2u w[4]; ld16bf_raw(p, lane, w); unpack16(w, v); }
__device__ __forceinline__ void ld16bf_nt(const bf16* p, int lane, float (&v)[16]) { v2u w[4]; ld16bf_raw_nt(p, lane, w); unpack16(w, v); }
__device__ __forceinline__ void st16bf(bf16* p, int lane, const float (&v)[16]) {
    v2u* q = (v2u*)p + lane;
#pragma unroll
    for (int g = 0; g < 4; ++g) { v2u w; w.x = pk2(v[4 * g], v[4 * g + 1]); w.y = pk2(v[4 * g + 2], v[4 * g + 3]); q[64 * g] = w; }
}
__device__ __forceinline__ void ln16(float (&v)[16]) {
    float s = 0.f;
#pragma unroll
    for (int i = 0; i < 16; ++i) s += v[i];
    const float mean = wave_sum(s) * (1.0f / D); float q = 0.f;
#pragma unroll
    for (int i = 0; i < 16; ++i) { v[i] -= mean; q += v[i] * v[i]; }
    const float rstd = 1.0f / sqrtf(wave_sum(q) * (1.0f / D) + EPS);
#pragma unroll
    for (int i = 0; i < 16; ++i) v[i] *= rstd;
}

__device__ __forceinline__ int rows_per_wave(int ngw) {
    int rpw = (M + ngw - 1) / ngw;
    if (!((SEQ % rpw) % 4 == 0 && (TT % rpw) == 0 && (rpw % 2) == 0)) rpw = (rpw + 3) & ~3;
    return rpw;
}
template <int TYPE>
__device__ __forceinline__ float conv_src(const float* p0, const float* p1, const float* g0, const float* g1, int l, int k, int n) {
    if (TYPE == 0) return n < DPROJ ? p0[((size_t)l * D + k) * DPROJ + n] : 0.f;
    if (TYPE == 1) { if (n < 384) return k < 256 ? g0[l * 256 + k] * p0[((size_t)l * 256 + k) * 384 + n] : 0.f;
                     if (n < 896) return k >= 256 ? g1[l * 128 + (k - 256)] * p1[((size_t)l * 128 + (k - 256)) * 512 + (n - 384)] : 0.f;
                     return 0.f; }
    if (TYPE == 2) return p0[((size_t)l * D + k) * D + n];
    if (TYPE == 3) { const int e = n >> 10, nn = n & 1023, q = nn >> 3, j = nn & 7;
                     return j < 4 ? p0[(((size_t)l * 16 + e) * D + k) * 512 + 4 * q + j] : p1[(((size_t)l * 16 + e) * D + k) * 512 + 4 * q + (j - 4)]; }
    { const int e = n >> 10, nn = n & 1023; return p0[(((size_t)l * 16 + e) * 512 + k) * D + nn]; }
}
template <int TYPE>
__device__ __forceinline__ void conv_item(const Frame& F, int l, int item, LAS float* scr) {
    constexpr int Nd = TYPE == 0 ? NPJ : TYPE == 1 ? 1024 : TYPE == 2 ? 1024 : 16384, Kd = TYPE == 1 ? 384 : TYPE == 4 ? 512 : 1024;
    bf16* dst = (bf16*)(F.ws + (TYPE == 0 ? WS_WIN : TYPE == 1 ? WS_WD : TYPE == 2 ? WS_WOUT : TYPE == 3 ? WS_WGU : WS_WDN));
    const float* p0 = INP(TYPE == 0 ? I_WIN : TYPE == 1 ? I_WQB : TYPE == 2 ? I_WOUT : TYPE == 3 ? I_WG : I_WDN);
    const float* p1 = INP(TYPE == 1 ? I_WKVB : I_WU); const float* g0 = INP(I_MQG); const float* g1 = INP(I_MKVG);
    constexpr int nblk = Nd / 32; const int kb = item / nblk, nb = item - kb * nblk, k0 = 64 * kb, n0 = 32 * nb, lane = F.lane;
#pragma unroll
    for (int i = 0; i < 32; ++i) { const int kk = 2 * i + (lane >> 5); scr[kk * 33 + (lane & 31)] = conv_src<TYPE>(p0, p1, g0, g1, l, k0 + kk, n0 + (lane & 31)); }
    asm volatile("s_waitcnt lgkmcnt(0)" ::: "memory");
    const int c = lane & 7;
#pragma unroll
    for (int j = 0; j < 4; ++j) { const int n = (lane >> 3) + 8 * j; const LAS float* s = scr + (8 * c) * 33 + n;
        v4u o; o.x = pk2(s[0 * 33], s[1 * 33]); o.y = pk2(s[2 * 33], s[3 * 33]); o.z = pk2(s[4 * 33], s[5 * 33]); o.w = pk2(s[6 * 33], s[7 * 33]);
        *(v4u*)(dst + (size_t)(n0 + n) * Kd + k0 + 8 * c) = o; }
    asm volatile("s_waitcnt lgkmcnt(0)" ::: "memory");
}
__device__ __forceinline__ void phase_prologue(const Frame& F) {
    {
        LAS float* sv = (LAS float*)F.lds;
        LAS float* red = (LAS float*)(F.lds + 17 * 1024 * 4);
        float* mods = (float*)(F.ws + WS_MODS);
        for (int u = F.bid; u < NL * 48; u += F.G) {
            const int l = u / 48, cc = u - l * 48;
            const float* pc = INP(I_C); const float* pcc = INP(I_CCTX);
            for (int i = F.tid; i < 17 * 1024; i += NTHR) { const int mr = i >> 10, k = i & 1023; const float c = mr < 16 ? pc[mr * 1024 + k] : pcc[k]; sv[i] = c / (1.0f + expf(-c)); }
            __syncthreads();
            const int col = F.tid & 127, kg = F.tid >> 7;
            float acc[17];
#pragma unroll
            for (int mr = 0; mr < 17; ++mr) acc[mr] = 0.f;
            const float* w = INP(I_WADA) + ((size_t)l * 1024 + kg * 256) * 6144 + cc * 128 + col;
            for (int k4 = 0; k4 < 256; k4 += 4) {
                const float w0 = w[(size_t)(k4 + 0) * 6144], w1 = w[(size_t)(k4 + 1) * 6144], w2 = w[(size_t)(k4 + 2) * 6144], w3 = w[(size_t)(k4 + 3) * 6144];
#pragma unroll
                for (int mr = 0; mr < 17; ++mr) { const f32x4 s = *(const LAS f32x4*)(sv + mr * 1024 + kg * 256 + k4); acc[mr] += (s.x * w0 + s.y * w1) + (s.z * w2 + s.w * w3); }
            }
#pragma unroll
            for (int mr = 0; mr < 17; ++mr) red[(kg * 17 + mr) * 128 + col] = acc[mr];
            __syncthreads();
            const float* bada = INP(I_BADA);
            for (int i = F.tid; i < 17 * 128; i += NTHR) { const int mr = i >> 7, c = i & 127;
                const float s = (red[(0 * 17 + mr) * 128 + c] + red[(1 * 17 + mr) * 128 + c]) + (red[(2 * 17 + mr) * 128 + c] + red[(3 * 17 + mr) * 128 + c]);
                mods[((size_t)l * 17 + mr) * 6144 + cc * 128 + c] = s + bada[l * 6144 + cc * 128 + c]; }
            __syncthreads();
        }
    }
    {
        float* t64 = (float*)(F.ws + WS_T64); float* t32 = (float*)(F.ws + WS_T32);
        for (int i = F.bid * NTHR + F.tid; i < 64 * 16 + 64 * 8; i += F.G * NTHR) {
            if (i < 1024) { const int p = i >> 4, k = i & 15; const float fr = powf(10000.0f, -(float)k / 16.0f), ang = (float)p * fr; t64[2 * i] = cosf(ang); t64[2 * i + 1] = sinf(ang); }
            else { const int j = i - 1024, p = j >> 3, k = j & 7; const float fr = powf(10000.0f, -(float)k / 8.0f), ang = (float)p * fr; t32[2 * j] = cosf(ang); t32[2 * j + 1] = sinf(ang); }
        }
    }
}
__device__ __forceinline__ void convert_layer_weights(const Frame& F, int l) {
    {
        LAS float* scr = (LAS float*)(F.lds + F.wave * 8448);
        constexpr int I0 = 1152, I1 = 192, I2 = 512, I3 = 8192, I4 = 4096, IL = I0 + I1 + I2 + I3 + I4;
        for (int r0_ = F.gw; r0_ < IL; r0_ += F.ngw) {
            int r = r0_;
            if (r < I0) { conv_item<0>(F, l, r, scr); continue; } r -= I0;
            if (r < I1) { conv_item<1>(F, l, r, scr); continue; } r -= I1;
            if (r < I2) { conv_item<2>(F, l, r, scr); continue; } r -= I2;
            if (r < I3) { conv_item<3>(F, l, r, scr); continue; } r -= I3;
            conv_item<4>(F, l, r, scr);
        }
    }
}

__device__ __forceinline__ void phase_ln(const Frame& F, int l) {
    if (l < NL) convert_layer_weights(F, l);
    constexpr int NR = 4;
    const float* mods = (const float*)(F.ws + WS_MODS); bf16* HA = (bf16*)(F.ws + WS_HA);
    const bf16* Y = (const bf16*)(F.ws + WS_PB); const unsigned* RT = (const unsigned*)(F.ws + WS_RT);
    const int lane = F.lane; const RowPtrs RP = row_ptrs(F);
    const float* ln2g = INP(I_LN2G) + (l > 0 ? l - 1 : 0) * D; const float* ln2b = INP(I_LN2B) + (l > 0 ? l - 1 : 0) * D;
    const int rpw = rows_per_wave(F.ngw), rbeg = F.gw * rpw, rend = min(M, rbeg + rpw);
    float g2[16]; int cur_mr = -1;
    for (int r0 = rbeg; r0 < rend; r0 += NR) {
        float v[NR][16]; v4u rt[NR]; v2u ya[NR][4], yb[NR][4]; bool act[NR];
        const int b0 = r0 / TT, t0 = r0 - b0 * TT; const bool lat = t0 < SEQ; const int mr = lat ? b0 : 16;
        if (l == NL && !lat) continue;
#pragma unroll
        for (int u = 0; u < NR; ++u) {
            const int r = r0 + u; act[u] = r < rend; const int rc = act[u] ? r : r0;
            if (l == 0) ld16nt(xin_row(RP, rc), lane, v[u]); else ld16h(RP.xs + (size_t)rc * D, lane, v[u]);
            rt[u] = *(const v4u*)(RT + (size_t)rc * 8 + 4);
        }
        if (mr != cur_mr) { if (l > 0) ld16(mods + ((size_t)(l - 1) * 17 + mr) * 6144 + 5120, lane, g2); cur_mr = mr; }
        if (l > 0) {
#pragma unroll
            for (int u = 0; u < NR; ++u) { ld16bf_raw_nt(Y + (size_t)rt[u].z * D, lane, ya[u]); ld16bf_raw_nt(Y + (size_t)rt[u].w * D, lane, yb[u]); }
#pragma unroll
            for (int u = 0; u < NR; ++u) {
                float f0[16], f1[16], gg[16], bb[16];
                const float w0 = __uint_as_float(rt[u].x), w1 = __uint_as_float(rt[u].y);
                unpack16(ya[u], f0); unpack16(yb[u], f1);
#pragma unroll
                for (int i = 0; i < 16; ++i) v[u][i] = ALPHA * v[u][i] + g2[i] * (w0 * f0[i] + w1 * f1[i]);
                ld16(ln2g, lane, gg); ld16(ln2b, lane, bb);
                ln16(v[u]);
#pragma unroll
                for (int i = 0; i < 16; ++i) v[u][i] = v[u][i] * gg[i] + bb[i];
                if (act[u]) { if (l == NL) st16nt(out_row(RP, r0 + u), lane, v[u]); else st16h(RP.xs + (size_t)(r0 + u) * D, lane, v[u]); }
            }
        }
        if (l < NL) {
            float sh[16], sc[16]; ld16(mods + ((size_t)l * 17 + mr) * 6144, lane, sh); ld16(mods + ((size_t)l * 17 + mr) * 6144 + 1024, lane, sc);
#pragma unroll
            for (int u = 0; u < NR; ++u) {
                ln16(v[u]);
#pragma unroll
                for (int i = 0; i < 16; ++i) v[u][i] = v[u][i] * (1.0f + sc[i]) + sh[i];
                if (act[u]) st16bf(HA + (size_t)(r0 + u) * D, lane, v[u]);
            }
        }
    }
}

__device__ __forceinline__ void rope8(float (&f)[8], const float (&p)[8], const float* cs, bool first) {
    const f32x4* c4 = (const f32x4*)cs;
#pragma unroll
    for (int q = 0; q < 4; ++q) { const f32x4 t = c4[q];
        f[2 * q] = first ? f[2 * q] * t.x - p[2 * q] * t.y : p[2 * q] * t.y + f[2 * q] * t.x;
        f[2 * q + 1] = first ? f[2 * q + 1] * t.z - p[2 * q + 1] * t.w : p[2 * q + 1] * t.w + f[2 * q + 1] * t.z; }
}
__device__ __forceinline__ void phase_post(const Frame& F, int l) {
    constexpr int NR = 4;
    bf16* P = (bf16*)(F.ws + WS_PB); bf16* KD = (bf16*)(F.ws + WS_KD);
    const float* t64 = (const float*)(F.ws + WS_T64); const float* t32 = (const float*)(F.ws + WS_T32);
    const int lane = F.lane; const float* gains = (lane < 32 ? INP(I_GQG) : INP(I_GKG)) + l * 64;
    const int j = lane & 7, jj = lane & 3;
    float gn[8];
#pragma unroll
    for (int i = 0; i < 8; ++i) gn[i] = gains[j * 8 + i];
    for (int r0 = F.gw; r0 < M; r0 += NR * F.ngw) {
        v4u w0[NR], w1[NR], w2[NR]; int rr[NR]; bool act[NR];
#pragma unroll
        for (int u = 0; u < NR; ++u) { const int r = r0 + u * F.ngw; act[u] = r < M; rr[u] = act[u] ? r : r0; const bf16* prow = P + (size_t)rr[u] * NPJ;
            w0[u] = *((const v4u*)(prow + 768) + lane); w1[u] = *((const v4u*)(prow + 1280) + lane); w2[u] = *((const v4u*)(prow + 1792) + lane); }
#pragma unroll
        for (int u = 0; u < NR; ++u) {
            const int r = rr[u]; const int b = r / TT, t = r - b * TT; const bool lat = t < SEQ; const int gr = (t >> 6) & 63, gc = t & 63;
            bf16* prow = P + (size_t)r * NPJ;
            const float* cs64 = t64 + ((size_t)((j < 4 ? gr : gc) * 16 + (j & 1) * 8)) * 2;
            {
                float f[8]; unpack8(w0[u], f);
                float ss = 0.f;
#pragma unroll
                for (int i = 0; i < 8; ++i) ss += f[i] * f[i];
                ss += __shfl_xor(ss, 1); ss += __shfl_xor(ss, 2); ss += __shfl_xor(ss, 4);
                const float rs = 1.0f / sqrtf(ss * (1.0f / 64.0f) + EPS);
#pragma unroll
                for (int i = 0; i < 8; ++i) f[i] = f[i] * rs * gn[i];
                float p[8];
#pragma unroll
                for (int i = 0; i < 8; ++i) p[i] = __shfl_xor(f[i], 2);
                if (lat) rope8(f, p, cs64, (j & 2) == 0);
                if (lane < 48 && act[u]) *((v4u*)(prow + 768) + lane) = pack8(f);
            }
            {
                float f[8]; unpack8(w1[u], f);
                float p[8];
#pragma unroll
                for (int i = 0; i < 8; ++i) p[i] = __shfl_xor(f[i], 2);
                rope8(f, p, cs64, (j & 2) == 0);
                if (lat && lane < 48 && act[u]) *((v4u*)(prow + 1280) + lane) = pack8(f);
            }
            {
                float f[8]; unpack8(w2[u], f);
                float ss = 0.f;
#pragma unroll
                for (int i = 0; i < 8; ++i) ss += f[i] * f[i];
                ss += __shfl_xor(ss, 1); ss += __shfl_xor(ss, 2); ss += __shfl_xor(ss, 4); ss += __shfl_xor(ss, 8);
                const float s32 = ss + __shfl_xor(ss, 16);
                const float rn = lane < 32 ? 1.0f / sqrtf(s32 * (1.0f / 256.0f) + EPS) : 1.0f / sqrtf(ss * (1.0f / 128.0f) + EPS);
                if (lane < 48 && act[u]) { float fn[8];
#pragma unroll
                    for (int i = 0; i < 8; ++i) fn[i] = f[i] * rn;
                    *((v4u*)(prow + 1792) + lane) = pack8(fn); }
                float p[8];
#pragma unroll
                for (int i = 0; i < 8; ++i) p[i] = __shfl_xor(f[i], 1);
                if (lat) rope8(f, p, t32 + ((size_t)((jj < 2 ? gr : gc) * 8)) * 2, (jj & 1) == 0);
                if (lane >= 48 && lane < 52 && act[u]) { const v4u o = pack8(f);
#pragma unroll
                    for (int h = 0; h < 4; ++h) *(v4u*)(KD + (size_t)r * 384 + h * 96 + 64 + 8 * jj) = o; }
            }
        }
    }
}

__device__ __forceinline__ void phase_route(const Frame& F, int l) {
    const float* mods = (const float*)(F.ws + WS_MODS); bf16* HA = (bf16*)(F.ws + WS_HA);
    const bf16* MIX = (const bf16*)(F.ws + WS_PB); unsigned* RT = (unsigned*)(F.ws + WS_RT); int* HIST = (int*)(F.ws + WS_HIST);
    LAS float* WR = (LAS float*)F.lds;
    { const float* rgw = INP(I_RGW); const float* rew = INP(I_REW);
      for (int i = F.tid; i < 20 * 1024; i += NTHR) { const int jx = i >> 10, k = i & 1023;
        WR[i] = jx < 4 ? rgw[((size_t)l * D + k) * 4 + jx] : rew[((size_t)l * D + k) * 16 + (jx - 4)]; } }
    if (F.tid < 16) F.MISC[MI_LH + F.tid] = 0u;
    __syncthreads();
    LAS float* bias = (LAS float*)(F.lds + 20 * 1024 * 4);
    if (F.tid < 20) bias[F.tid] = F.tid < 4 ? INP(I_RGB)[l * 4 + F.tid] : INP(I_REB)[l * 16 + (F.tid - 4)];
    __syncthreads();
    const RowPtrs RP = row_ptrs(F); const float* ln1g = INP(I_LN1G) + l * D; const float* ln1b = INP(I_LN1B) + l * D;
    constexpr int NR = 2;
    const int rpw = rows_per_wave(F.ngw), rbeg = F.gw * rpw, rend = min(M, rbeg + rpw);
    float g1[16], sh[16], sc[16]; int cur_mr = -1;
    for (int r0 = rbeg; r0 < rend; r0 += NR) {
        if (l == NL - 1 && (r0 % TT) >= SEQ) continue;
        float v[NR][16], mx[NR][16], gg[16], bb[16]; int rr[NR]; bool act[NR];
#pragma unroll
        for (int u = 0; u < NR; ++u) { const int r = r0 + u; act[u] = r < rend; rr[u] = act[u] ? r : r0;
            if (l == 0) ld16nt(xin_row(RP, rr[u]), F.lane, v[u]); else ld16h(RP.xs + (size_t)rr[u] * D, F.lane, v[u]);
            ld16bf_nt(MIX + (size_t)rr[u] * D, F.lane, mx[u]); }
        ld16(ln1g, F.lane, gg); ld16(ln1b, F.lane, bb);
        { const int b = r0 / TT, t = r0 - b * TT, mr = t < SEQ ? b : 16;
          if (mr != cur_mr) { const float* md = mods + ((size_t)l * 17 + mr) * 6144; ld16(md + 2048, F.lane, g1); ld16(md + 3072, F.lane, sh); ld16(md + 4096, F.lane, sc); cur_mr = mr; } }
#pragma unroll
        for (int u = 0; u < NR; ++u) {
#pragma unroll
            for (int i = 0; i < 16; ++i) v[u][i] = ALPHA * v[u][i] + g1[i] * mx[u][i]; }
#pragma unroll
        for (int u = 0; u < NR; ++u) ln16(v[u]);
#pragma unroll
        for (int u = 0; u < NR; ++u) {
#pragma unroll
            for (int i = 0; i < 16; ++i) v[u][i] = v[u][i] * gg[i] + bb[i];
            if (act[u]) st16h(RP.xs + (size_t)rr[u] * D, F.lane, v[u]); }
#pragma unroll
        for (int u = 0; u < NR; ++u) ln16(v[u]);
#pragma unroll
        for (int u = 0; u < NR; ++u) {
#pragma unroll
            for (int i = 0; i < 16; ++i) v[u][i] = v[u][i] * (1.0f + sc[i]) + sh[i];
            if (act[u]) st16bf(HA + (size_t)rr[u] * D, F.lane, v[u]); }
        float lgt[NR][20];
#pragma unroll
        for (int jx = 0; jx < 20; ++jx) {
            const LAS f32x4* wq = (const LAS f32x4*)(WR + jx * 1024);
            const f32x4 w0 = wq[F.lane], w1 = wq[64 + F.lane], w2 = wq[128 + F.lane], w3 = wq[192 + F.lane];
#pragma unroll
            for (int u = 0; u < NR; ++u) {
                const float sm = (v[u][0] * w0.x + v[u][1] * w0.y) + (v[u][2] * w0.z + v[u][3] * w0.w) + (v[u][4] * w1.x + v[u][5] * w1.y) + (v[u][6] * w1.z + v[u][7] * w1.w)
                               + (v[u][8] * w2.x + v[u][9] * w2.y) + (v[u][10] * w2.z + v[u][11] * w2.w) + (v[u][12] * w3.x + v[u][13] * w3.y) + (v[u][14] * w3.z + v[u][15] * w3.w);
                lgt[u][jx] = sm; }
        }
#pragma unroll
        for (int o = 1; o < 64; o <<= 1)
#pragma unroll
            for (int u = 0; u < NR; ++u)
#pragma unroll
                for (int jx = 0; jx < 20; ++jx) lgt[u][jx] += __shfl_xor(lgt[u][jx], o);
#pragma unroll
        for (int u = 0; u < NR; ++u) {
#pragma unroll
            for (int jx = 0; jx < 20; ++jx) lgt[u][jx] += bias[jx];
            int grp = 0; float mg = lgt[u][0];
#pragma unroll
            for (int g = 1; g < 4; ++g) if (lgt[u][g] > mg) { mg = lgt[u][g]; grp = g; }
            float sg = 0.f;
#pragma unroll
            for (int g = 0; g < 4; ++g) sg += expf(lgt[u][g] - mg);
            const float pg = 1.0f / sg;
            float sel[4];
#pragma unroll
            for (int i = 0; i < 4; ++i) sel[i] = grp == 0 ? lgt[u][4 + i] : grp == 1 ? lgt[u][8 + i] : grp == 2 ? lgt[u][12 + i] : lgt[u][16 + i];
            int i1 = 0; float v1 = sel[0];
#pragma unroll
            for (int i = 1; i < 4; ++i) if (sel[i] > v1) { v1 = sel[i]; i1 = i; }
            int i2 = -1; float v2 = -3.0e38f;
#pragma unroll
            for (int i = 0; i < 4; ++i) if (i != i1 && (i2 < 0 || sel[i] > v2)) { v2 = sel[i]; i2 = i; }
            const float ee = expf(v2 - v1), w1 = pg / (1.0f + ee), w2 = pg * ee / (1.0f + ee);
            const int e1 = grp * 4 + i1, e2 = grp * 4 + i2;
            if (F.lane == 0 && act[u]) {
                const unsigned k1 = __hip_atomic_fetch_add((LAS unsigned*)&F.MISC[MI_LH + e1], 1u, __ATOMIC_RELAXED, __HIP_MEMORY_SCOPE_WORKGROUP);
                const unsigned k2 = __hip_atomic_fetch_add((LAS unsigned*)&F.MISC[MI_LH + e2], 1u, __ATOMIC_RELAXED, __HIP_MEMORY_SCOPE_WORKGROUP);
                v4u ra; ra.x = (unsigned)e1; ra.y = (unsigned)e2; ra.z = k1; ra.w = k2;
                v4u rb; rb.x = __builtin_bit_cast(unsigned, w1); rb.y = __builtin_bit_cast(unsigned, w2); rb.z = 0u; rb.w = 0u;
                *(v4u*)(RT + (size_t)rr[u] * 8) = ra; *(v4u*)(RT + (size_t)rr[u] * 8 + 4) = rb;
            }
        }
    }
    __syncthreads();
    if (F.tid < 16) HIST[F.bid * 16 + F.tid] = (int)F.MISC[MI_LH + F.tid];
}
__device__ __forceinline__ void moe_tables(const Frame& F) {
    const int* HIST = (const int*)(F.ws + WS_HIST); LAS int* hl = (LAS int*)F.lds;
    __syncthreads();
    for (int i = F.tid; i < F.G * 16; i += NTHR) hl[i] = HIST[i];
    __syncthreads();
    if (F.tid < 16) { int tot = 0, mine = 0; for (int g = 0; g < F.G; ++g) { const int c = hl[g * 16 + F.tid]; tot += c; mine += (g < F.bid) ? c : 0; }
        F.MISC[MI_TOT + F.tid] = (unsigned)tot; F.MISC[MI_BASE + F.tid] = (unsigned)mine; }
    __syncthreads();
    if (F.tid == 0) { unsigned p = 0; for (int e = 0; e < 16; ++e) { F.MISC[MI_PST + e] = p; F.MISC[MI_BASE + e] += p * 256u; p += (F.MISC[MI_TOT + e] + 255u) >> 8; } F.MISC[MI_PST + 16] = p; }
    __syncthreads();
}
__device__ __forceinline__ void phase_permute(const Frame& F, int l) {
    unsigned* RT = (unsigned*)(F.ws + WS_RT); int* SRC = (int*)(F.ws + WS_QD);
    moe_tables(F);
    const int rpw = rows_per_wave(F.ngw), rbeg = F.gw * rpw, rend = min(M, rbeg + rpw);
    for (int r = rbeg + F.lane; r < rend; r += 64) {
        if (l == NL - 1 && (r % TT) >= SEQ) continue;
        const v4u ra = *(const v4u*)(RT + (size_t)r * 8);
        const unsigned p0 = F.MISC[MI_BASE + (ra.x & 15u)] + ra.z, p1 = F.MISC[MI_BASE + (ra.y & 15u)] + ra.w;
        RT[(size_t)r * 8 + 6] = p0; RT[(size_t)r * 8 + 7] = p1; SRC[p0] = r; SRC[p1] = r;
    }
    if (F.bid == 0) {
        for (int e = 0; e < 16; ++e) { const int beg = (int)F.MISC[MI_PST + e] * 256 + (int)F.MISC[MI_TOT + e], end = (int)F.MISC[MI_PST + e + 1] * 256;
            for (int p = beg + F.tid; p < end; p += NTHR) SRC[p] = 0; }
    }
}

struct EpiMla {
    static constexpr bool PERM = true, AFTER_DRAIN = false;
    bf16* QD; bf16* KD; bf16* VD;
    __device__ __forceinline__ void operator()(const pg8::f32x4 (&acc)[2][2][4][2], const pg8::Unit& u, int wr, int wc, int fr, int fq) const {
#pragma unroll
        for (int bj = 0; bj < 2; ++bj) {
            const int g0 = u.pn * 256 + bj * 128 + wc * 32, col0 = g0 + 8 * fq;
            if (g0 >= 896) continue;
            const int c = col0 - 384, hd = c >> 7, jx = c & 127;
            bf16* dst = g0 < 384 ? QD + col0 : jx < 64 ? KD + hd * 96 + jx : VD + hd * 64 + (jx - 64);
            const int stride = (g0 < 384 || jx < 64) ? 384 : 256;
            dst += (size_t)(u.pm * 256 + wr * 64 + fr) * stride;
#pragma unroll
            for (int ai = 0; ai < 2; ++ai)
#pragma unroll
                for (int m = 0; m < 4; ++m) {
                    v4u o; o.x = pk2(acc[ai][bj][m][0][0], acc[ai][bj][m][0][1]); o.y = pk2(acc[ai][bj][m][0][2], acc[ai][bj][m][0][3]);
                    o.z = pk2(acc[ai][bj][m][1][0], acc[ai][bj][m][1][1]); o.w = pk2(acc[ai][bj][m][1][2], acc[ai][bj][m][1][3]);
                    *(v4u*)(dst + (size_t)(ai * 128 + m * 16) * stride) = o;
                }
        }
    }
};
struct EpiGU {
    static constexpr bool PERM = true, AFTER_DRAIN = false;
    bf16* ACT;
    __device__ __forceinline__ void operator()(const pg8::f32x4 (&acc)[2][2][4][2], const pg8::Unit& u, int wr, int wc, int fr, int fq) const {
#pragma unroll
        for (int ai = 0; ai < 2; ++ai)
#pragma unroll
            for (int m = 0; m < 4; ++m) {
                const int row = u.pm * 256 + ai * 128 + wr * 64 + m * 16 + fr;
#pragma unroll
                for (int bj = 0; bj < 2; ++bj) {
                    const int c = (u.pn & 3) * 256 + bj * 128 + wc * 32 + 8 * fq;
                    float o[4];
#pragma unroll
                    for (int i = 0; i < 4; ++i) { const float g = acc[ai][bj][m][0][i], up = acc[ai][bj][m][1][i]; o[i] = g / (1.0f + __expf(-g)) * up; }
                    v2u w; w.x = pk2(o[0], o[1]); w.y = pk2(o[2], o[3]);
                    *(v2u*)(ACT + (size_t)row * 512 + (c >> 1)) = w;
                }
            }
    }
};
struct MoeOrder {
    volatile LAS unsigned* pst; int G, c;
    __device__ __forceinline__ bool next(int i, pg8::Unit& u) const {
        const int np = (int)pst[16]; int panel, pn;
        if ((G & 7) == 0) { const int x = c & 7, uu = i * (G >> 3) + (c >> 3); panel = (uu >> 2) * 8 + x; pn = uu & 3; }
        else { const int L = i * G + c; panel = L >> 2; pn = L & 3; }
        if (panel >= np) return false;
        int e = 0;
#pragma unroll
        for (int k = 1; k < 16; ++k) e += (panel >= (int)pst[k]) ? 1 : 0;
        u.pm = __builtin_amdgcn_readfirstlane(panel); u.pn = __builtin_amdgcn_readfirstlane(e * 4 + pn); return true;
    }
    __device__ __forceinline__ void a_ready(const pg8::Unit&) const {}
    __device__ __forceinline__ void done(const pg8::Unit&) const {}
};

struct LatOrder {
    int G, c;
    __device__ __forceinline__ bool next(int i, pg8::Unit& u) const {
        int pl, pn;
        if ((G & 7) == 0) { const int x = c & 7, uu = i * (G >> 3) + (c >> 3); pl = (uu >> 2) * 8 + x; pn = uu & 3; } else { const int L = i * G + c; pl = L >> 2; pn = L & 3; }
        if (pl >= NB * 16) return false;
        u.pm = pl + (pl >> 4); u.pn = pn; return true;
    }
    __device__ __forceinline__ void a_ready(const pg8::Unit&) const {}
    __device__ __forceinline__ void done(const pg8::Unit&) const {}
};

#ifndef DBG_VAR
#define DBG_VAR 1
#endif
namespace att {
constexpr int VRS = 192, KBUF = 64 * 208, VBUF = 64 * VRS, BUF = KBUF + VBUF, BIAS_OFF = 4 * BUF;
constexpr float NEG = -30000.0f;
__device__ __forceinline__ int crow(int r, int hi) { return (r & 3) + 8 * (r >> 2) + 4 * hi; }
__device__ __forceinline__ float xhalf_max(float v) { const unsigned a = __builtin_bit_cast(unsigned, v);
    auto rr = __builtin_amdgcn_permlane32_swap(a, a, false, false); const unsigned r0 = rr[0], r1 = rr[1]; return fmaxf(__uint_as_float(r0), __uint_as_float(r1)); }
__device__ __forceinline__ float xhalf_sum(float v) { const unsigned a = __builtin_bit_cast(unsigned, v);
    auto rr = __builtin_amdgcn_permlane32_swap(a, a, false, false); const unsigned r0 = rr[0], r1 = rr[1]; return __uint_as_float(r0) + __uint_as_float(r1); }
__device__ __forceinline__ float max3f(float a, float b, float c) { float r; asm("v_max3_f32 %0, %1, %2, %3" : "=v"(r) : "v"(a), "v"(b), "v"(c)); return r; }
typedef __bf16 bf16x2_t __attribute__((ext_vector_type(2)));
__device__ __forceinline__ unsigned cvtpk(float lo, float hi) { f32x2 v = {lo, hi}; bf16x2_t b = __builtin_convertvector(v, bf16x2_t); return __builtin_bit_cast(unsigned, b); }

template <int DK, int VM = 0>
__device__ __forceinline__ void unit(LAS unsigned char* lds, const bf16* Qp, int qpitch, const bf16* Kp, int kpitch, const bf16* Vp, int vpitch, bf16* Op,
                                     int var, int qt, int lo, int n1, int nt, float qscale, float sinkl2, bool has_sink, const LAS float* bias, const float* t32, unsigned* dbg) {
    constexpr int KRS = DK * 2 + 16, NS = DK / 16, CPK = DK / 8;
    int tid = threadIdx.x; asm volatile("" : "+v"(tid)); const int lane = tid & 63, r32 = lane & 31, hi = lane >> 5, wid = __builtin_amdgcn_readfirstlane(tid >> 6);
    const int qrow = 256 * qt + 32 * wid + r32;
    bf16x8 qr[NS];
#pragma unroll
    for (int s = 0; s < NS; ++s) { const v4u raw = *(const v4u*)(Qp + (size_t)qrow * qpitch + 16 * s + 8 * hi); float f[8]; unpack8(raw, f);
#pragma unroll
        for (int i = 0; i < 8; ++i) f[i] *= qscale;
        if (DK == 96 && s >= 4) {
            float p[8];
#pragma unroll
            for (int i = 0; i < 8; ++i) p[i] = __shfl_xor(f[i], 32);
            if (qt < 16) rope8(f, p, t32 + ((size_t)((s == 4 ? (qrow >> 6) : (qrow & 63)) * 8)) * 2, hi == 0);
        }
        qr[s] = __builtin_bit_cast(bf16x8, pack8(f)); }
    const int kkey0 = tid / CPK, kch0 = tid - kkey0 * CPK, kkey1 = (tid + 512) / CPK, kch1 = (tid + 512) - kkey1 * CPK;
    const int vkey = tid >> 3, vch = tid & 7;
    v4u kreg0, kreg1 = {0u, 0u, 0u, 0u}, vreg;
#define ATT_TROW(j) ((((j) < n1) ? (lo + (j)) : (64 + (j) - n1)) * 64)
#define ATT_LOAD(j) do { const int tr_ = ATT_TROW(j); kreg0 = *(const v4u*)(Kp + (size_t)(tr_ + kkey0) * kpitch + kch0 * 8); \
        if (DK == 96 && tid < 256) kreg1 = *(const v4u*)(Kp + (size_t)(tr_ + kkey1) * kpitch + kch1 * 8); \
        vreg = *(const v4u*)(Vp + (size_t)(tr_ + vkey) * vpitch + vch * 8); } while (0)
#define ATT_STORE(bf) do { LAS unsigned char* b_ = lds + (bf) * BUF; *(LAS v4u*)(b_ + kkey0 * KRS + kch0 * 16) = kreg0; \
        if (DK == 96 && tid < 256) *(LAS v4u*)(b_ + kkey1 * KRS + kch1 * 16) = kreg1; \
        *(LAS v4u*)(b_ + KBUF + vkey * VRS + vch * 16) = vreg; } while (0)
    constexpr float THR = 6.0f;
    float m = 0.f; f32x2 lacc = {0.f, 0.f}; f32x16 o0 = {}, o1 = {}; f32x16 negm = {}; bool first = true;
    const int grw = 4 * qt + (wid >> 1), r0w = min(max(grw - 4, 0), 56), gc = (wid & 1) * 32 + r32, c0 = min(max(gc - 8, 0), 48), i0w = 256 * qt + 32 * wid;
    ATT_LOAD(0); ATT_STORE(0);
    __syncthreads();
    for (int j = 0; j < nt; ++j) {
        if (!(VM & 8) && j + 1 < nt) ATT_LOAD(j + 1);
        const int kt = ATT_TROW(j) >> 6;
        bool actv = true;
        if (kt < 64) { if (var == 0) actv = (kt >= r0w) && (kt <= r0w + 7); else if (var == 2) actv = !((64 * kt - (i0w + 31) > 128) || (i0w - (64 * kt + 63) > 128)); }
        if (actv) {
            const LAS unsigned char* Kb = lds + (j & 1) * BUF; const LAS unsigned char* Vb = Kb + KBUF;
            f32x16 s0 = negm, s1 = negm;
            bf16x8 ka[NS], kb[NS];
#pragma unroll
            for (int s = 0; s < NS; ++s) { ka[s] = *(const LAS bf16x8*)(Kb + r32 * KRS + (16 * s + 8 * hi) * 2); kb[s] = *(const LAS bf16x8*)(Kb + (32 + r32) * KRS + (16 * s + 8 * hi) * 2); }
            __builtin_amdgcn_sched_barrier(0);
            if (VM & 2) {
#pragma unroll
                for (int s = 0; s < NS; ++s) asm volatile("" :: "v"(ka[s]), "v"(kb[s]), "v"(qr[s]));
            } else {
#pragma unroll
            for (int s = 0; s < NS; ++s) { s0 = __builtin_amdgcn_mfma_f32_32x32x16_bf16(ka[s], qr[s], s0, 0, 0, 0); s1 = __builtin_amdgcn_mfma_f32_32x32x16_bf16(kb[s], qr[s], s1, 0, 0, 0); }
            }
            asm volatile("s_nop 15\n\ts_nop 7" : "+v"(s0), "+v"(s1));
            if (kt < 64 && var == 0) {
                const int rowoff = (kt - grw + 7) * 31 - gc + 15;
#pragma unroll
                for (int r = 0; r < 16; ++r) { const int j0 = crow(r, hi), j1 = j0 + 32;
                    const bool v0 = (unsigned)(j0 - c0) < 16u, v1 = (unsigned)(j1 - c0) < 16u;
                    const float b0 = bias[v0 ? rowoff + j0 : 0], b1 = bias[v1 ? rowoff + j1 : 0];
                    s0[r] = v0 ? s0[r] + b0 : NEG; s1[r] = v1 ? s1[r] + b1 : NEG; }
            } else if (kt < 64 && var == 2) {
                const int dbase = 64 * kt - qrow + 128;
#pragma unroll
                for (int r = 0; r < 16; ++r) { const int j0 = crow(r, hi);
                    s0[r] = (unsigned)(dbase + j0) <= 256u ? s0[r] : NEG; s1[r] = (unsigned)(dbase + j0 + 32) <= 256u ? s1[r] : NEG; }
            }
            if (!(VM & 4)) {
            float mxa = max3f(s0[0], s0[1], s1[0]), mxb = max3f(s0[2], s0[3], s1[1]); mxa = max3f(mxa, s1[2], s1[3]);
#pragma unroll
            for (int r = 4; r < 16; r += 4) { mxa = max3f(mxa, s0[r], s0[r + 1]); mxb = max3f(mxb, s0[r + 2], s0[r + 3]); mxa = max3f(mxa, s1[r], s1[r + 1]); mxb = max3f(mxb, s1[r + 2], s1[r + 3]); }
            const float mx = xhalf_max(fmaxf(mxa, mxb));
            if (first || __any(mx > THR)) {
                const float d = first ? fmaxf(mx, -64.0f) : fmaxf(mx, 0.f), alpha = __builtin_amdgcn_exp2f(-d);
                m += d; first = false;
#pragma unroll
                for (int r = 0; r < 16; ++r) { s0[r] -= d; s1[r] -= d; o0[r] *= alpha; o1[r] *= alpha; negm[r] = -m; }
                lacc *= alpha;
            }
#pragma unroll
            for (int r = 0; r < 16; ++r) { s0[r] = __builtin_amdgcn_exp2f(s0[r]); s1[r] = __builtin_amdgcn_exp2f(s1[r]); lacc += (f32x2){s0[r], s1[r]}; }
            }
            bf16x8 pb[4];
#pragma unroll
            for (int s = 0; s < 2; ++s) {
                v4u w; w.x = cvtpk(s0[8 * s], s0[8 * s + 1]); w.y = cvtpk(s0[8 * s + 2], s0[8 * s + 3]); w.z = cvtpk(s0[8 * s + 4], s0[8 * s + 5]); w.w = cvtpk(s0[8 * s + 6], s0[8 * s + 7]);
                pb[s] = __builtin_bit_cast(bf16x8, w);
                v4u x; x.x = cvtpk(s1[8 * s], s1[8 * s + 1]); x.y = cvtpk(s1[8 * s + 2], s1[8 * s + 3]); x.z = cvtpk(s1[8 * s + 4], s1[8 * s + 5]); x.w = cvtpk(s1[8 * s + 6], s1[8 * s + 7]);
                pb[2 + s] = __builtin_bit_cast(bf16x8, x);
            }
            if (VM & 1) { asm volatile("" :: "v"(pb[0]), "v"(pb[1]), "v"(pb[2]), "v"(pb[3])); } else {
            const LAS unsigned char* vbase = Vb + (4 * hi + ((lane & 15) >> 2)) * VRS + ((lane >> 4) & 1) * 32 + (lane & 3) * 8;
#pragma unroll
            for (int s = 0; s < 4; ++s) {
                const v4i16 a0 = __builtin_amdgcn_ds_read_tr16_b64_v4i16((LAS v4i16*)(vbase + (16 * s) * VRS));
                const v4i16 a1 = __builtin_amdgcn_ds_read_tr16_b64_v4i16((LAS v4i16*)(vbase + (16 * s + 8) * VRS));
                const v4i16 c0_ = __builtin_amdgcn_ds_read_tr16_b64_v4i16((LAS v4i16*)(vbase + (16 * s) * VRS + 64));
                const v4i16 c1_ = __builtin_amdgcn_ds_read_tr16_b64_v4i16((LAS v4i16*)(vbase + (16 * s + 8) * VRS + 64));
                const bf16x8 va = {a0[0], a0[1], a0[2], a0[3], a1[0], a1[1], a1[2], a1[3]};
                const bf16x8 vc = {c0_[0], c0_[1], c0_[2], c0_[3], c1_[0], c1_[1], c1_[2], c1_[3]};
                o0 = __builtin_amdgcn_mfma_f32_32x32x16_bf16(va, pb[s], o0, 0, 0, 0);
                o1 = __builtin_amdgcn_mfma_f32_32x32x16_bf16(vc, pb[s], o1, 0, 0, 0);
            }
            }
        }
        if (!(VM & 8) && j + 1 < nt) ATT_STORE((j + 1) & 1);
        if (!(VM & 16)) __syncthreads();
    }
    float l = xhalf_sum(lacc.x + lacc.y);
    const float sterm = has_sink ? __builtin_amdgcn_exp2f(sinkl2 - m) : 0.f;
#if MK_DEBUG
    if (dbg && hi == 0) { dbg[(size_t)qrow * 2] = __builtin_bit_cast(unsigned, m); dbg[(size_t)qrow * 2 + 1] = __builtin_bit_cast(unsigned, l); }
#endif
    if (has_sink) l += sterm;
    const float inv = 1.0f / l;
    bf16* orow = Op + (size_t)qrow * D;
#pragma unroll
    for (int g = 0; g < 4; ++g) {
        v2u w0; w0.x = pk2(o0[4 * g] * inv, o0[4 * g + 1] * inv); w0.y = pk2(o0[4 * g + 2] * inv, o0[4 * g + 3] * inv);
        v2u w1; w1.x = pk2(o1[4 * g] * inv, o1[4 * g + 1] * inv); w1.y = pk2(o1[4 * g + 2] * inv, o1[4 * g + 3] * inv);
        *(v2u*)(orow + 8 * g + 4 * hi) = w0; *(v2u*)(orow + 32 + 8 * g + 4 * hi) = w1;
    }
#undef ATT_TROW
#undef ATT_LOAD
#undef ATT_STORE
}

template <int DK, int MODE, int VM = 0, bool NOREF = false>
__device__ __forceinline__ void unit2(LAS unsigned char* lds, const bf16* Qp, int qpitch, const bf16* Kp, int kpitch, const bf16* Vp, int vpitch, bf16* Op,
                                      int var, int qt, int lo, int n1, int nt, float qscale, float sink0, float sink1, bool has_sink, const LAS float* bias, const float* t32) {
    constexpr int KRS = DK * 2 + 16, NS = DK / 16, CPK = DK / 8;
    int tid = threadIdx.x; asm volatile("" : "+v"(tid)); const int lane = tid & 63, r32 = lane & 31, hi = lane >> 5, wid = __builtin_amdgcn_readfirstlane(tid >> 6);
    const int rowbase = MODE == 0 ? 512 * qt + 64 * wid : 256 * qt + 32 * wid;
    bf16x8 qr[2][NS];
#pragma unroll
    for (int u = 0; u < 2; ++u) {
        const int qrow = rowbase + (MODE == 0 ? 32 * u : 0) + r32;
        const bf16* qp = Qp + (MODE == 1 ? 64 * u : 0) + (size_t)qrow * qpitch;
#pragma unroll
        for (int s = 0; s < NS; ++s) { const v4u raw = *(const v4u*)(qp + 16 * s + 8 * hi); float f[8]; unpack8(raw, f);
#pragma unroll
            for (int i = 0; i < 8; ++i) f[i] *= qscale;
            if (DK == 96 && s >= 4) { float p[8];
#pragma unroll
                for (int i = 0; i < 8; ++i) p[i] = __shfl_xor(f[i], 32);
                rope8(f, p, t32 + ((size_t)((s == 4 ? (qrow >> 6) : (qrow & 63)) * 8)) * 2, hi == 0); }
            qr[u][s] = __builtin_bit_cast(bf16x8, pack8(f)); }
    }
    const int kkey0 = tid / CPK, kch0 = tid - kkey0 * CPK, kkey1 = (tid + 512) / CPK, kch1 = (tid + 512) - kkey1 * CPK;
    const int vkey = tid >> 3, vch = tid & 7;
    v4u kreg0, kreg1 = {0u, 0u, 0u, 0u}, vreg;
#define ATT_TROW(j) ((((j) < n1) ? (lo + (j)) : (64 + (j) - n1)) * 64)
#define ATT_LOAD(j) do { const int tr_ = ATT_TROW(j); kreg0 = *(const v4u*)(Kp + (size_t)(tr_ + kkey0) * kpitch + kch0 * 8); \
        if (DK == 96 && tid < 256) kreg1 = *(const v4u*)(Kp + (size_t)(tr_ + kkey1) * kpitch + kch1 * 8); \
        vreg = *(const v4u*)(Vp + (size_t)(tr_ + vkey) * vpitch + vch * 8); } while (0)
#define ATT_STORE(bf) do { LAS unsigned char* b_ = lds + (bf) * BUF; *(LAS v4u*)(b_ + kkey0 * KRS + kch0 * 16) = kreg0; \
        if (DK == 96 && tid < 256) *(LAS v4u*)(b_ + kkey1 * KRS + kch1 * 16) = kreg1; \
        *(LAS v4u*)(b_ + KBUF + vkey * VRS + vch * 16) = vreg; } while (0)
    constexpr float THR = 6.0f;
    float m = 0.f; f32x2 lacc[2] = {{0.f, 0.f}, {0.f, 0.f}}; f32x16 o0[2] = {{}, {}}, o1[2] = {{}, {}}; bool first = true;
    const int grw = 8 * qt + wid, r0w = min(max(grw - 4, 0), 56), i0w = rowbase;
    ATT_LOAD(0); ATT_STORE(0);
    __syncthreads();
    for (int j = 0; j < nt; ++j) {
        if (!(VM & 8) && j + 1 < nt) ATT_LOAD(j + 1);
        const int kt = ATT_TROW(j) >> 6;
        bool actv = true;
        if (kt < 64) { if (var == 0) actv = (kt >= r0w) && (kt <= r0w + 7); else if (var == 2) actv = !((64 * kt - (i0w + 31) > 128) || (i0w - (64 * kt + 63) > 128)); }
        if (actv) {
            const LAS unsigned char* Kb = lds + (j & 1) * BUF; const LAS unsigned char* Vb = Kb + KBUF;
            f32x16 s0[2] = {{}, {}}, s1[2] = {{}, {}};
#pragma unroll
            for (int s = 0; s < NS; ++s) {
                const bf16x8 ka = *(const LAS bf16x8*)(Kb + r32 * KRS + (16 * s + 8 * hi) * 2);
                const bf16x8 kb = *(const LAS bf16x8*)(Kb + (32 + r32) * KRS + (16 * s + 8 * hi) * 2);
                if (VM & 2) { asm volatile("" :: "v"(ka), "v"(kb), "v"(qr[0][s]), "v"(qr[1][s])); } else {
#pragma unroll
                for (int u = 0; u < 2; ++u) { s0[u] = __builtin_amdgcn_mfma_f32_32x32x16_bf16(ka, qr[u][s], s0[u], 0, 0, 0); s1[u] = __builtin_amdgcn_mfma_f32_32x32x16_bf16(kb, qr[u][s], s1[u], 0, 0, 0); }
                }
            }
            asm volatile("s_nop 15\n\ts_nop 7" : "+v"(s0[0]), "+v"(s1[0]), "+v"(s0[1]), "+v"(s1[1]));
            if (kt < 64 && var == 0) {
#pragma unroll
                for (int u = 0; u < 2; ++u) { const int gc = 32 * u + r32, c0 = min(max(gc - 8, 0), 48), rowoff = (kt - grw + 7) * 31 - gc + 15;
#pragma unroll
                    for (int r = 0; r < 16; ++r) { const int j0 = crow(r, hi), j1 = j0 + 32;
                        const bool v0 = (unsigned)(j0 - c0) < 16u, v1 = (unsigned)(j1 - c0) < 16u;
                        const float b0 = bias[v0 ? rowoff + j0 : 0], b1 = bias[v1 ? rowoff + j1 : 0];
                        s0[u][r] = v0 ? s0[u][r] + b0 : NEG; s1[u][r] = v1 ? s1[u][r] + b1 : NEG; } }
            } else if (kt < 64 && var == 2) {
                const int dbase = 64 * kt - (rowbase + r32) + 128;
#pragma unroll
                for (int r = 0; r < 16; ++r) { const int j0 = crow(r, hi); const bool v0 = (unsigned)(dbase + j0) <= 256u, v1 = (unsigned)(dbase + j0 + 32) <= 256u;
                    s0[0][r] = v0 ? s0[0][r] : NEG; s1[0][r] = v1 ? s1[0][r] : NEG; s0[1][r] = v0 ? s0[1][r] : NEG; s1[1][r] = v1 ? s1[1][r] : NEG; }
            }
            if (!(VM & 4)) {
            if (!NOREF) {
            float mxa = max3f(s0[0][0], s0[0][1], s1[0][0]), mxb = max3f(s0[1][0], s0[1][1], s1[1][0]);
#pragma unroll
            for (int r = 0; r < 16; r += 2) { if (r) { mxa = max3f(mxa, s0[0][r], s0[0][r + 1]); mxb = max3f(mxb, s0[1][r], s0[1][r + 1]); }
                if (r) { mxa = max3f(mxa, s1[0][r], s1[0][r + 1]); mxb = max3f(mxb, s1[1][r], s1[1][r + 1]); } else { mxa = fmaxf(mxa, s1[0][1]); mxb = fmaxf(mxb, s1[1][1]); } }
            const float mx = xhalf_max(fmaxf(mxa, mxb)) - m;
            if (first || __any(mx > THR)) {
                const float d = first ? fmaxf(mx, -64.0f) : fmaxf(mx, 0.f), alpha = __builtin_amdgcn_exp2f(-d);
                m += d; first = false;
#pragma unroll
                for (int u = 0; u < 2; ++u) {
#pragma unroll
                    for (int r = 0; r < 16; ++r) { o0[u][r] *= alpha; o1[u][r] *= alpha; }
                    lacc[u] *= alpha; }
            }
            }
            }
            bf16x8 pb[2][4];
#pragma unroll
            for (int u = 0; u < 2; ++u) {
                if (!(VM & 4))
#pragma unroll
                for (int r = 0; r < 16; ++r) { s0[u][r] = __builtin_amdgcn_exp2f(NOREF ? s0[u][r] : s0[u][r] - m); s1[u][r] = __builtin_amdgcn_exp2f(NOREF ? s1[u][r] : s1[u][r] - m); lacc[u] += (f32x2){s0[u][r], s1[u][r]}; }
#pragma unroll
                for (int s = 0; s < 2; ++s) {
                    v4u w; w.x = cvtpk(s0[u][8 * s], s0[u][8 * s + 1]); w.y = cvtpk(s0[u][8 * s + 2], s0[u][8 * s + 3]); w.z = cvtpk(s0[u][8 * s + 4], s0[u][8 * s + 5]); w.w = cvtpk(s0[u][8 * s + 6], s0[u][8 * s + 7]);
                    pb[u][s] = __builtin_bit_cast(bf16x8, w);
                    v4u x; x.x = cvtpk(s1[u][8 * s], s1[u][8 * s + 1]); x.y = cvtpk(s1[u][8 * s + 2], s1[u][8 * s + 3]); x.z = cvtpk(s1[u][8 * s + 4], s1[u][8 * s + 5]); x.w = cvtpk(s1[u][8 * s + 6], s1[u][8 * s + 7]);
                    pb[u][2 + s] = __builtin_bit_cast(bf16x8, x);
                }
            }
            if (VM & 1) { asm volatile("" :: "v"(pb[0][0]), "v"(pb[0][1]), "v"(pb[0][2]), "v"(pb[0][3]), "v"(pb[1][0]), "v"(pb[1][1]), "v"(pb[1][2]), "v"(pb[1][3])); } else {
            const LAS unsigned char* vbase = Vb + (4 * hi + ((lane & 15) >> 2)) * VRS + ((lane >> 4) & 1) * 32 + (lane & 3) * 8;
#pragma unroll
            for (int s = 0; s < 4; ++s) {
                const v4i16 a0 = __builtin_amdgcn_ds_read_tr16_b64_v4i16((LAS v4i16*)(vbase + (16 * s) * VRS));
                const v4i16 a1 = __builtin_amdgcn_ds_read_tr16_b64_v4i16((LAS v4i16*)(vbase + (16 * s + 8) * VRS));
                const v4i16 c0_ = __builtin_amdgcn_ds_read_tr16_b64_v4i16((LAS v4i16*)(vbase + (16 * s) * VRS + 64));
                const v4i16 c1_ = __builtin_amdgcn_ds_read_tr16_b64_v4i16((LAS v4i16*)(vbase + (16 * s + 8) * VRS + 64));
                const bf16x8 va = {a0[0], a0[1], a0[2], a0[3], a1[0], a1[1], a1[2], a1[3]};
                const bf16x8 vc = {c0_[0], c0_[1], c0_[2], c0_[3], c1_[0], c1_[1], c1_[2], c1_[3]};
#pragma unroll
                for (int u = 0; u < 2; ++u) { o0[u] = __builtin_amdgcn_mfma_f32_32x32x16_bf16(va, pb[u][s], o0[u], 0, 0, 0); o1[u] = __builtin_amdgcn_mfma_f32_32x32x16_bf16(vc, pb[u][s], o1[u], 0, 0, 0); }
            }
            }
        }
        if (!(VM & 8) && j + 1 < nt) ATT_STORE((j + 1) & 1);
        if (!(VM & 16)) __syncthreads();
    }
#pragma unroll
    for (int u = 0; u < 2; ++u) {
        float l = xhalf_sum(lacc[u].x + lacc[u].y);
        if (has_sink) l += __builtin_amdgcn_exp2f((u == 0 ? sink0 : sink1) - m);
        const float inv = 1.0f / l;
        const int qrow = rowbase + (MODE == 0 ? 32 * u : 0) + r32;
        bf16* orow = Op + (MODE == 1 ? 64 * u : 0) + (size_t)qrow * D;
#pragma unroll
        for (int g = 0; g < 4; ++g) {
            v2u w0; w0.x = pk2(o0[u][4 * g] * inv, o0[u][4 * g + 1] * inv); w0.y = pk2(o0[u][4 * g + 2] * inv, o0[u][4 * g + 3] * inv);
            v2u w1; w1.x = pk2(o1[u][4 * g] * inv, o1[u][4 * g + 1] * inv); w1.y = pk2(o1[u][4 * g + 2] * inv, o1[u][4 * g + 3] * inv);
            *(v2u*)(orow + 8 * g + 4 * hi) = w0; *(v2u*)(orow + 32 + 8 * g + 4 * hi) = w1;
        }
    }
#undef ATT_TROW
#undef ATT_LOAD
#undef ATT_STORE
}

template <int VM = 0>
__device__ __forceinline__ void unit_k2(LAS unsigned char* lds, const bf16* Qp, const bf16* Kp, const bf16* Vp, bf16* Op, int qt, int nt2, float qscale, const float* t32) {
    constexpr int DK = 96, KRS = DK * 2 + 16, NS = 6, KB2 = 128 * KRS, BUF2 = KB2 + 128 * VRS;
    int tid = threadIdx.x; asm volatile("" : "+v"(tid)); const int lane = tid & 63, r32 = lane & 31, hi = lane >> 5, wid = __builtin_amdgcn_readfirstlane(tid >> 6);
    const int qrow = 256 * qt + 32 * wid + r32;
    bf16x8 qr[NS];
#pragma unroll
    for (int s = 0; s < NS; ++s) { const v4u raw = *(const v4u*)(Qp + (size_t)qrow * 384 + 16 * s + 8 * hi); float f[8]; unpack8(raw, f);
#pragma unroll
        for (int i = 0; i < 8; ++i) f[i] *= qscale;
        if (s >= 4) { float p[8];
#pragma unroll
            for (int i = 0; i < 8; ++i) p[i] = __shfl_xor(f[i], 32);
            if (qt < 16) rope8(f, p, t32 + ((size_t)((s == 4 ? (qrow >> 6) : (qrow & 63)) * 8)) * 2, hi == 0); }
        qr[s] = __builtin_bit_cast(bf16x8, pack8(f)); }
    int kk[3], kc[3];
#pragma unroll
    for (int i = 0; i < 3; ++i) { const int c = tid + 512 * i; kk[i] = c / 12; kc[i] = c - kk[i] * 12; }
    const int vk0 = tid >> 3, vc0 = tid & 7;
    v4u kreg[3], vreg[2];
#define K2_LOAD(j) do { const size_t tr_ = (size_t)(j) * 128; _Pragma("unroll") for (int i_ = 0; i_ < 3; ++i_) kreg[i_] = *(const v4u*)(Kp + (tr_ + kk[i_]) * 384 + kc[i_] * 8); \
        vreg[0] = *(const v4u*)(Vp + (tr_ + vk0) * 256 + vc0 * 8); vreg[1] = *(const v4u*)(Vp + (tr_ + 64 + vk0) * 256 + vc0 * 8); } while (0)
#define K2_STORE(bf) do { LAS unsigned char* b_ = lds + (bf) * BUF2; _Pragma("unroll") for (int i_ = 0; i_ < 3; ++i_) *(LAS v4u*)(b_ + kk[i_] * KRS + kc[i_] * 16) = kreg[i_]; \
        *(LAS v4u*)(b_ + KB2 + vk0 * VRS + vc0 * 16) = vreg[0]; *(LAS v4u*)(b_ + KB2 + (64 + vk0) * VRS + vc0 * 16) = vreg[1]; } while (0)
    constexpr float THR = 6.0f;
    float m = 0.f; f32x2 lacc = {0.f, 0.f}; f32x16 o0 = {}, o1 = {}; bool first = true;
    K2_LOAD(0); K2_STORE(0);
    __syncthreads();
    for (int j = 0; j < nt2; ++j) {
        if (!(VM & 8) && j + 1 < nt2) K2_LOAD(j + 1);
        const LAS unsigned char* Kb = lds + (j & 1) * BUF2; const LAS unsigned char* Vb = Kb + KB2;
        f32x16 s0[2] = {{}, {}}, s1[2] = {{}, {}};
#pragma unroll
        for (int h = 0; h < 2; ++h) {
            bf16x8 ka[NS], kb[NS];
#pragma unroll
            for (int s = 0; s < NS; ++s) { ka[s] = *(const LAS bf16x8*)(Kb + (64 * h + r32) * KRS + (16 * s + 8 * hi) * 2); kb[s] = *(const LAS bf16x8*)(Kb + (64 * h + 32 + r32) * KRS + (16 * s + 8 * hi) * 2); }
            __builtin_amdgcn_sched_barrier(0);
            if (VM & 2) {
#pragma unroll
                for (int s = 0; s < NS; ++s) asm volatile("" :: "v"(ka[s]), "v"(kb[s]), "v"(qr[s]));
            } else {
#pragma unroll
                for (int s = 0; s < NS; ++s) { s0[h] = __builtin_amdgcn_mfma_f32_32x32x16_bf16(ka[s], qr[s], s0[h], 0, 0, 0); s1[h] = __builtin_amdgcn_mfma_f32_32x32x16_bf16(kb[s], qr[s], s1[h], 0, 0, 0); }
            }
        }
        asm volatile("s_nop 15\n\ts_nop 7" : "+v"(s0[0]), "+v"(s1[0]), "+v"(s0[1]), "+v"(s1[1]));
        if (!(VM & 4)) {
            float mxa = max3f(s0[0][0], s0[0][1], s1[0][0]), mxb = max3f(s0[1][0], s0[1][1], s1[1][0]);
#pragma unroll
            for (int r = 0; r < 16; r += 2) { if (r) { mxa = max3f(mxa, s0[0][r], s0[0][r + 1]); mxb = max3f(mxb, s0[1][r], s0[1][r + 1]); mxa = max3f(mxa, s1[0][r], s1[0][r + 1]); mxb = max3f(mxb, s1[1][r], s1[1][r + 1]); }
                else { mxa = fmaxf(mxa, s1[0][1]); mxb = fmaxf(mxb, s1[1][1]); } }
            const float mx = xhalf_max(fmaxf(mxa, mxb)) - m;
            if (first || __any(mx > THR)) {
                const float d = first ? fmaxf(mx, -64.0f) : fmaxf(mx, 0.f), alpha = __builtin_amdgcn_exp2f(-d);
                m += d; first = false;
#pragma unroll
                for (int r = 0; r < 16; ++r) { o0[r] *= alpha; o1[r] *= alpha; }
                lacc *= alpha;
            }
#pragma unroll
            for (int h = 0; h < 2; ++h)
#pragma unroll
                for (int r = 0; r < 16; ++r) { s0[h][r] = __builtin_amdgcn_exp2f(s0[h][r] - m); s1[h][r] = __builtin_amdgcn_exp2f(s1[h][r] - m); lacc += (f32x2){s0[h][r], s1[h][r]}; }
        }
        bf16x8 pb[8];
#pragma unroll
        for (int h = 0; h < 2; ++h)
#pragma unroll
            for (int s = 0; s < 2; ++s) {
                v4u w; w.x = cvtpk(s0[h][8 * s], s0[h][8 * s + 1]); w.y = cvtpk(s0[h][8 * s + 2], s0[h][8 * s + 3]); w.z = cvtpk(s0[h][8 * s + 4], s0[h][8 * s + 5]); w.w = cvtpk(s0[h][8 * s + 6], s0[h][8 * s + 7]);
                pb[4 * h + s] = __builtin_bit_cast(bf16x8, w);
                v4u x; x.x = cvtpk(s1[h][8 * s], s1[h][8 * s + 1]); x.y = cvtpk(s1[h][8 * s + 2], s1[h][8 * s + 3]); x.z = cvtpk(s1[h][8 * s + 4], s1[h][8 * s + 5]); x.w = cvtpk(s1[h][8 * s + 6], s1[h][8 * s + 7]);
                pb[4 * h + 2 + s] = __builtin_bit_cast(bf16x8, x);
            }
        if (VM & 1) { asm volatile("" :: "v"(pb[0]), "v"(pb[1]), "v"(pb[2]), "v"(pb[3]), "v"(pb[4]), "v"(pb[5]), "v"(pb[6]), "v"(pb[7])); } else {
        const LAS unsigned char* vbase = Vb + (4 * hi + ((lane & 15) >> 2)) * VRS + ((lane >> 4) & 1) * 32 + (lane & 3) * 8;
#pragma unroll
        for (int s = 0; s < 8; ++s) {
            const v4i16 a0 = __builtin_amdgcn_ds_read_tr16_b64_v4i16((LAS v4i16*)(vbase + (16 * s) * VRS));
            const v4i16 a1 = __builtin_amdgcn_ds_read_tr16_b64_v4i16((LAS v4i16*)(vbase + (16 * s + 8) * VRS));
            const v4i16 c0_ = __builtin_amdgcn_ds_read_tr16_b64_v4i16((LAS v4i16*)(vbase + (16 * s) * VRS + 64));
            const v4i16 c1_ = __builtin_amdgcn_ds_read_tr16_b64_v4i16((LAS v4i16*)(vbase + (16 * s + 8) * VRS + 64));
            const bf16x8 va = {a0[0], a0[1], a0[2], a0[3], a1[0], a1[1], a1[2], a1[3]};
            const bf16x8 vc = {c0_[0], c0_[1], c0_[2], c0_[3], c1_[0], c1_[1], c1_[2], c1_[3]};
            o0 = __builtin_amdgcn_mfma_f32_32x32x16_bf16(va, pb[s], o0, 0, 0, 0);
            o1 = __builtin_amdgcn_mfma_f32_32x32x16_bf16(vc, pb[s], o1, 0, 0, 0);
        }
        }
        if (!(VM & 8) && j + 1 < nt2) K2_STORE((j + 1) & 1);
        if (!(VM & 16)) __syncthreads();
    }
    const float l = xhalf_sum(lacc.x + lacc.y), inv = 1.0f / l;
    bf16* orow = Op + (size_t)qrow * D;
#pragma unroll
    for (int g = 0; g < 4; ++g) {
        v2u w0; w0.x = pk2(o0[4 * g] * inv, o0[4 * g + 1] * inv); w0.y = pk2(o0[4 * g + 2] * inv, o0[4 * g + 3] * inv);
        v2u w1; w1.x = pk2(o1[4 * g] * inv, o1[4 * g + 1] * inv); w1.y = pk2(o1[4 * g + 2] * inv, o1[4 * g + 3] * inv);
        *(v2u*)(orow + 8 * g + 4 * hi) = w0; *(v2u*)(orow + 32 + 8 * g + 4 * hi) = w1;
    }
#undef K2_LOAD
#undef K2_STORE
}
}

template <int VM = 0>
__device__ __forceinline__ void phase_attn(const Frame& F, int lq) {
    const int l = lq & 3;
    const bf16* P = (const bf16*)(F.ws + WS_PB); const bf16* QD = (const bf16*)(F.ws + WS_QD); const bf16* KD = (const bf16*)(F.ws + WS_KD);
    const bf16* VD = (const bf16*)(F.ws + WS_VD); bf16* O = (bf16*)(F.ws + (lq >= 4 ? WS_ACT : WS_HA));
    unsigned* ctr = (unsigned*)(F.ws + WS_CTL) + CW_QUEUE + 64 * 8 * lq;
    LAS float* bias = (LAS float*)(F.lds + att::BIAS_OFF);
    { const float* nab = INP(I_NABIAS) + l * 4 * 465; for (int i = F.tid; i < 4 * 465; i += NTHR) bias[i] = nab[i] * LOG2E; }
    const float* sinks = INP(I_SINK) + l * 4;
    __syncthreads();
    const float* t32 = (const float*)(F.ws + WS_T32);
    bool b_bounded;
    { float gq = fabsf(INP(I_GQG)[l * 64 + F.lane]), gk = fabsf(INP(I_GKG)[l * 64 + F.lane]);
#pragma unroll
      for (int o = 1; o < 64; o <<= 1) { gq = fmaxf(gq, __shfl_xor(gq, o)); gk = fmaxf(gk, __shfl_xor(gk, o)); }
      b_bounded = 8.0f * gq * gk * LOG2E < 100.0f; }
    const int nloc = 320 + (l < NL - 1 ? 24 : 0);
    const int q0 = (int)xb_xcc_id();
    for (int qq = 0; qq < 8; ++qq) {
      const int q = (q0 + qq) & 7;
      unsigned* qctr = ctr + 64 * q;
      for (;;) {
        if (F.tid == 0) F.MISC[MI_Q] = __hip_atomic_fetch_add(qctr, 1u, __ATOMIC_RELAXED, __HIP_MEMORY_SCOPE_AGENT);
        __syncthreads();
        const int li = (int)F.MISC[MI_Q];
        __syncthreads();
        if (li >= nloc) break;
        int idx;
        if (li < 128) idx = (q + 8 * (li >> 4)) * 16 + (li & 15);
        else if (li < 192) { const int jx = li - 128; idx = 1024 + (q + 8 * (jx >> 4)) * 16 + (jx & 15); }
        else if (li < 256) { const int jx = li - 192; idx = 1536 + (q + 8 * (jx >> 3)) * 8 + (jx & 7); }
        else if (li < 320) { const int jx = li - 256; idx = 2048 + (q + 8 * (jx >> 4)) * 16 + (jx & 15); }
        else if (li < 328) idx = 2560 + q + 8 * (li - 320);
        else idx = 2624 + q + 8 * (li - 328);
        if (idx < 1024) {
            const int b = idx >> 6, h = (idx >> 4) & 3, qt = idx & 15; const size_t rb = (size_t)b * TT;
            att::unit<96, VM>(F.lds, QD + rb * 384 + h * 96, 384, KD + rb * 384 + h * 96, 384, VD + rb * 256 + h * 64, 256, O + rb * D + 768 + h * 64, 3, qt, 0, 64, 68, 0.10206207261596575f * LOG2E, 0.f, false, bias, t32, nullptr);
        } else if (idx < 2560) {
            idx -= 1024;
            const int grp = idx >> 9, rem = idx & 511, b = rem >> 5; const size_t rb = (size_t)b * TT;
            if (grp == 1) {
                const int h = (rem >> 3) & 3, qt = rem & 7; const int lo = min(max(8 * qt - 4, 0), 56), n1 = min(max(8 * qt + 3, 0), 56) + 7 - lo + 1;
                att::unit2<64, 0, VM>(F.lds, P + rb * NPJ + h * 64, NPJ, P + rb * NPJ + 256 + h * 64, NPJ, P + rb * NPJ + 512 + h * 64, NPJ, O + rb * D + h * 64, 0, qt, lo, n1, n1 + 4,
                                  0.125f * LOG2E, 0.f, 0.f, false, bias + h * 465, t32);
            } else {
                const int g = (rem >> 4) & 1, qt = rem & 15; const bool isc = grp == 2;
                const int lo = isc ? max(4 * qt - 2, 0) : 0, n1 = isc ? min(4 * qt + 5, 63) - lo + 1 : 64;
                const int qc = (isc ? 1280 : 768) + g * 128, kc = (isc ? 1536 : 1024) + g * 64, vc = (isc ? 1664 : 1152) + g * 64;
                if (!isc && b_bounded) att::unit2<64, 1, VM, true>(F.lds, P + rb * NPJ + qc, NPJ, P + rb * NPJ + kc, NPJ, P + rb * NPJ + vc, NPJ, O + rb * D + 256 + g * 128, 1, qt, 0, 64, 68, 0.125f * LOG2E, 0.f, 0.f, false, bias, t32);
                else att::unit2<64, 1, VM>(F.lds, P + rb * NPJ + qc, NPJ, P + rb * NPJ + kc, NPJ, P + rb * NPJ + vc, NPJ, O + rb * D + (isc ? 512 : 256) + g * 128, isc ? 2 : 1, qt, lo, n1, n1 + 4,
                                  0.125f * LOG2E, isc ? sinks[2 * g] * LOG2E : 0.f, isc ? sinks[2 * g + 1] * LOG2E : 0.f, isc, bias, t32);
            }
        } else if (idx < 2624) {
            const int rem = idx - 2560, b = rem >> 2, isc = (rem >> 1) & 1, g = rem & 1; const size_t rb = (size_t)b * TT;
            const int qc = (isc ? 1280 : 768) + g * 128, kc = (isc ? 1536 : 1024) + g * 64, vc = (isc ? 1664 : 1152) + g * 64;
            att::unit2<64, 1, VM>(F.lds, P + rb * NPJ + qc, NPJ, P + rb * NPJ + kc, NPJ, P + rb * NPJ + vc, NPJ, O + rb * D + (isc ? 512 : 256) + g * 128, isc ? 2 : 1, 16, 0, 0, 4,
                              0.125f * LOG2E, isc ? sinks[2 * g] * LOG2E : 0.f, isc ? sinks[2 * g + 1] * LOG2E : 0.f, isc != 0, bias, t32);
        } else {
            const int rem = idx - 2624, b = rem >> 3, isd = (rem >> 2) & 1, h = rem & 3; const size_t rb = (size_t)b * TT;
            if (isd) att::unit<96, VM>(F.lds, QD + rb * 384 + h * 96, 384, KD + rb * 384 + h * 96, 384, VD + rb * 256 + h * 64, 256, O + rb * D + 768 + h * 64, 3, 16, 0, 0, 4, 0.10206207261596575f * LOG2E, 0.f, false, bias, t32, nullptr);
            else att::unit<64, VM>(F.lds, P + rb * NPJ + h * 64, NPJ, P + rb * NPJ + 256 + h * 64, NPJ, P + rb * NPJ + 512 + h * 64, NPJ, O + rb * D + h * 64, 0, 16, 0, 0, 4, 0.125f * LOG2E, 0.f, false, bias + h * 465, nullptr, nullptr);
        }
    }
    }
}


#define PHASE_FN static __device__ __forceinline__ void
PHASE_FN ph_prologue(GAS unsigned char* ws) { const Frame F = make_frame(ws); phase_prologue(F); }
PHASE_FN ph_ln(GAS unsigned char* ws, int l) { const Frame F = make_frame(ws); phase_ln(F, l); }
PHASE_FN ph_gemm_in(GAS unsigned char* ws, int l) {
    const Frame F = make_frame(ws);
    pg8::Gemm g{(const bf16*)(F.ws + WS_HA), (const bf16*)(F.ws + WS_WIN), M, NPJ, D, D, nullptr}; pg8::StaticOrder S; S.init(M, NPJ, F.G, F.bid);
    pg8::EpiBf16NT<0> E{(bf16*)(F.ws + WS_PB), NPJ, nullptr, 0, 0, 1.f};
    pg8::gemm_phase<pg8::EpiBf16NT<0>, pg8::StaticOrder, true, true>(F.lds, g, S, E);
}
PHASE_FN ph_post(GAS unsigned char* ws, int l) { const Frame F = make_frame(ws); phase_post(F, l); }
PHASE_FN ph_gemm_mla(GAS unsigned char* ws, int l) {
    const Frame F = make_frame(ws);
    pg8::Gemm g{(const bf16*)(F.ws + WS_PB) + 1792, (const bf16*)(F.ws + WS_WD), M, 1024, 384, NPJ, nullptr}; pg8::StaticOrder S; S.init(M, 1024, F.G, F.bid);
    EpiMla E{(bf16*)(F.ws + WS_QD), (bf16*)(F.ws + WS_KD), (bf16*)(F.ws + WS_VD)};
    pg8::gemm_phase<EpiMla, pg8::StaticOrder, true, true>(F.lds, g, S, E);
}
template <int VM>
PHASE_FN ph_attn(GAS unsigned char* ws, int l) { const Frame F = make_frame(ws); phase_attn<VM>(F, l); }
PHASE_FN ph_gemm_out(GAS unsigned char* ws, int l) {
    const Frame F = make_frame(ws);
    pg8::Gemm g{(const bf16*)(F.ws + WS_HA), (const bf16*)(F.ws + WS_WOUT), M, D, D, D, nullptr};
    pg8::EpiBf16NT<0> E{(bf16*)(F.ws + WS_PB), D, nullptr, 0, 0, 1.f};
    if (l == NL - 1) { LatOrder S{F.G, F.bid}; pg8::gemm_phase<pg8::EpiBf16NT<0>, LatOrder, true, true>(F.lds, g, S, E); }
    else { pg8::StaticOrder S; S.init(M, D, F.G, F.bid); pg8::gemm_phase<pg8::EpiBf16NT<0>, pg8::StaticOrder, true, true>(F.lds, g, S, E); }
}
PHASE_FN ph_route(GAS unsigned char* ws, int l) { const Frame F = make_frame(ws); phase_route(F, l); }
PHASE_FN ph_permute(GAS unsigned char* ws, int l) { const Frame F = make_frame(ws); phase_permute(F, l); }
PHASE_FN ph_gemm_gu(GAS unsigned char* ws, int l) {
    const Frame F = make_frame(ws);
    moe_tables(F);
    pg8::Gemm g{(const bf16*)(F.ws + WS_HA), (const bf16*)(F.ws + WS_WGU), MS, 16384, D, D, (const int*)(F.ws + WS_QD)}; MoeOrder S{F.MISC + MI_PST, F.G, F.bid};
    EpiGU E{(bf16*)(F.ws + WS_ACT)};
    pg8::gemm_phase<EpiGU, MoeOrder, true, true, true>(F.lds, g, S, E);
}
PHASE_FN ph_gemm_dn(GAS unsigned char* ws, int l) {
    const Frame F = make_frame(ws);
    moe_tables(F);
    pg8::Gemm g{(const bf16*)(F.ws + WS_ACT), (const bf16*)(F.ws + WS_WDN), MS, 16384, 512, 512, nullptr}; MoeOrder S{F.MISC + MI_PST, F.G, F.bid};
    pg8::EpiBf16NT<0> E{(bf16*)(F.ws + WS_PB), D, nullptr, 1024, 0, 1.f};
    pg8::gemm_phase<pg8::EpiBf16NT<0>, MoeOrder, true, true>(F.lds, g, S, E);
}


#if MK_DEBUG
#ifndef DBG_MODE
#define DBG_MODE 0
#endif
__device__ __forceinline__ float oracle_attn(const Frame& F, int l, int r, int var, int h, int mode = 0) {
    const bf16* P = (const bf16*)(F.ws + WS_PB); const bf16* QD = (const bf16*)(F.ws + WS_QD); const bf16* KD = (const bf16*)(F.ws + WS_KD); const bf16* VD = (const bf16*)(F.ws + WS_VD);
    const bf16* O = (const bf16*)(F.ws + WS_HA); const float* t32 = (const float*)(F.ws + WS_T32);
    const int b = r / TT, t = r - b * TT; const bool lat = t < SEQ; const size_t rb = (size_t)b * TT;
    const int dk = var == 3 ? 96 : 64;
    const bf16* qp; const bf16* kp; const bf16* vp; int kpitch, vpitch;
    if (var == 3) { qp = QD + (size_t)r * 384 + h * 96; kp = KD + rb * 384 + h * 96; kpitch = 384; vp = VD + rb * 256 + h * 64; vpitch = 256; }
    else { const int qc = var == 0 ? h * 64 : var == 1 ? 768 + h * 64 : 1280 + h * 64, kc = var == 0 ? 256 + h * 64 : var == 1 ? 1024 + (h >> 1) * 64 : 1536 + (h >> 1) * 64,
           vc = var == 0 ? 512 + h * 64 : var == 1 ? 1152 + (h >> 1) * 64 : 1664 + (h >> 1) * 64;
           qp = P + (size_t)r * NPJ + qc; kp = P + rb * NPJ + kc; kpitch = NPJ; vp = P + rb * NPJ + vc; vpitch = NPJ; }
    LAS float* qs = (LAS float*)(F.lds + 65536) + F.wave * 128;
    for (int d = F.lane; d < dk; d += 64) qs[d] = __builtin_bit_cast(float, (unsigned)qp[d] << 16);
    asm volatile("s_waitcnt lgkmcnt(0)" ::: "memory");
    if (var == 3 && lat && F.lane < 32) {
        const int c = F.lane >> 3, e = F.lane & 7, gr = t >> 6, gc = t & 63; const float own = qs[64 + F.lane], par = qs[64 + (F.lane ^ 8)];
        const float cs = t32[((c < 2 ? gr : gc) * 8 + e) * 2], sn = t32[((c < 2 ? gr : gc) * 8 + e) * 2 + 1];
        const float nv = (c & 1) == 0 ? own * cs - par * sn : par * sn + own * cs;
        asm volatile("s_waitcnt lgkmcnt(0)" ::: "memory"); qs[64 + F.lane] = nv; }
    asm volatile("s_waitcnt lgkmcnt(0)" ::: "memory");
    const float scale = var == 3 ? 0.10206207261596575f : 0.125f;
    const int gr = t >> 6, gc = t & 63, r0 = min(max(gr - 4, 0), 56), c0 = min(max(gc - 8, 0), 48);
    float m = -3.0e38f, lsum = 0.f, acc[64];
#pragma unroll
    for (int d = 0; d < 64; ++d) acc[d] = 0.f;
    for (int j = F.lane; j < TT; j += 64) {
        bool ok = true; float bias = 0.f;
        if (!lat) ok = j >= SEQ;
        else if (j < SEQ) {
            if (var == 0) { const int kr = j >> 6, kc2 = j & 63; ok = kr >= r0 && kr <= r0 + 7 && kc2 >= c0 && kc2 <= c0 + 15;
                if (ok) bias = INP(I_NABIAS)[((l * 4 + h) * 15 + (kr - gr + 7)) * 31 + (kc2 - gc + 15)]; }
            else if (var == 2) ok = (j - t <= 128) && (t - j <= 128);
        }
        if (!ok) continue;
        float sc = 0.f; const bf16* kr_ = kp + (size_t)j * kpitch;
        for (int d = 0; d < dk; ++d) sc += qs[d] * __builtin_bit_cast(float, (unsigned)kr_[d] << 16);
        sc = sc * scale + bias;
        const float mn = fmaxf(m, sc), a = expf(m - mn), p = expf(sc - mn); m = mn; lsum = lsum * a + p;
        const bf16* vr = vp + (size_t)j * vpitch;
#pragma unroll
        for (int d = 0; d < 64; ++d) acc[d] = acc[d] * a + p * __builtin_bit_cast(float, (unsigned)vr[d] << 16);
    }
    float mg = m;
#pragma unroll
    for (int o = 1; o < 64; o <<= 1) mg = fmaxf(mg, __shfl_xor(mg, o));
    if (mode >= 1) {
        const unsigned* rec = (const unsigned*)(F.ws + WS_RS) + (size_t)r * 2; const float mk = __builtin_bit_cast(float, rec[0]), lk = __builtin_bit_cast(float, rec[1]);
        const float lref = wave_sum(lsum * expf(m - mg));
        const float lker = lk * exp2f(mk - mg * LOG2E);
        if (mode == 2) return fabsf(mk / LOG2E - mg);
        return fabsf(lker / lref - 1.0f);
    }
    const float f = expf(m - mg); lsum *= f; lsum = wave_sum(lsum);
    if (var == 2) lsum += expf(INP(I_SINK)[l * 4 + h] - mg);
    float err = 0.f, mag = 1.0e-6f;
    const bf16* orow = O + (size_t)r * D + var * 256 + h * 64;
#pragma unroll
    for (int d = 0; d < 64; ++d) { const float ref = wave_sum(acc[d] * f) / lsum; const float got = __builtin_bit_cast(float, (unsigned)orow[d] << 16);
        const float df = fabsf(got - ref); err = (df == df) ? fmaxf(err, df) : 1.0e30f; mag = fmaxf(mag, fabsf(ref)); }
    return err / mag;
}
__device__ __forceinline__ void phase_dump(const Frame& F, int code) {
    float* out = (float*)ptab_get(F, I_OUT);
    for (int r = F.gw; r < M; r += F.ngw) {
        const int b = r / TT, t = r - b * TT; if (t >= SEQ) continue;
        float v[16];
        if (code == 1) ld16bf((const bf16*)(F.ws + WS_HA) + (size_t)r * D, F.lane, v);
        else if (code == 2) ld16bf((const bf16*)(F.ws + WS_PB) + (size_t)r * NPJ, F.lane, v);
        else if (code == 3) ld16bf((const bf16*)(F.ws + WS_PB) + (size_t)r * NPJ + 1024, F.lane, v);
        else if (code == 4) ld16bf((const bf16*)(F.ws + WS_PB) + (size_t)r * NPJ + 1280, F.lane, v);
        else if (code == 5) ld16((const float*)(F.ws + WS_PB) + (size_t)r * D, F.lane, v);
        else if (code == 8) {
            const v4u w0 = *((const v4u*)((const bf16*)(F.ws + WS_HA) + (size_t)r * D) + F.lane), w1 = *((const v4u*)((const bf16*)(F.ws + WS_HA) + (size_t)r * D) + 64 + F.lane);
            float f[8]; int bad0 = 0, bad1 = 0; unpack8(w0, f);
#pragma unroll
            for (int i = 0; i < 8; ++i) { const unsigned u = __builtin_bit_cast(unsigned, f[i]); bad0 |= ((u & 0x7f800000u) == 0x7f800000u) ? 1 : 0; }
            unpack8(w1, f);
#pragma unroll
            for (int i = 0; i < 8; ++i) { const unsigned u = __builtin_bit_cast(unsigned, f[i]); bad1 |= ((u & 0x7f800000u) == 0x7f800000u) ? 1 : 0; }
            const unsigned long long m0 = __ballot(bad0), m1 = __ballot(bad1);
            const bool vA = (m0 & 0xffffffffull) != 0, vB = (m0 >> 32) != 0, vC = (m1 & 0xffffffffull) != 0, vD = (m1 >> 32) != 0;
            const float val = (float)(t + 1) * ((vA ? 1.0f : 0.f) + (vB ? 1.0e2f : 0.f) + (vC ? 1.0e4f : 0.f) + (vD ? 1.0e6f : 0.f));
#pragma unroll
            for (int i = 0; i < 16; ++i) v[i] = val;
        }
        else if (code == 9) { const unsigned cd = ((const unsigned*)(F.ws + WS_RS))[(size_t)r * 2]; float val = 0.f; if (cd) { val = 1.f; for (unsigned k = 0; k < cd; ++k) val *= 10.f; }
#pragma unroll
            for (int i = 0; i < 16; ++i) v[i] = val; }
        else if (code == 10) {
            const v4u w1 = *((const v4u*)((const bf16*)(F.ws + WS_HA) + (size_t)r * D) + 64 + F.lane);
            float f[8]; int bad1 = 0; unpack8(w1, f);
#pragma unroll
            for (int i = 0; i < 8; ++i) { const unsigned u = __builtin_bit_cast(unsigned, f[i]); bad1 |= ((u & 0x7f800000u) == 0x7f800000u) ? 1 : 0; }
            const bool vC = (__ballot(bad1) & 0xffffffffull) != 0;
            const bf16* pc = (const bf16*)(F.ws + WS_PB) + ((size_t)b * TT + SEQ + (t & 255)) * NPJ; int badp = 0;
            for (int c = F.lane; c < 288; c += 64) { const v4u w = *((const v4u*)pc + c); unpack8(w, f);
#pragma unroll
                for (int i = 0; i < 8; ++i) { const unsigned u = __builtin_bit_cast(unsigned, f[i]); badp |= ((u & 0x7f800000u) == 0x7f800000u) ? 1 : 0; } }
            float val = 0.f; if (vC) { val = 1.f; for (int k = 0; k <= (t & 15); ++k) val *= 10.f; }
            if (__any(badp)) val = 1.0e30f;
#pragma unroll
            for (int i = 0; i < 16; ++i) v[i] = val;
        }
        else if (code == 11) {
            const bf16* pr = (const bf16*)(F.ws + WS_PB) + (size_t)r * NPJ; int grp = -1;
            for (int c = F.lane; c < 288; c += 64) { const v4u w = *((const v4u*)pr + c); float f[8]; unpack8(w, f);
#pragma unroll
                for (int i = 0; i < 8; ++i) if (!(fabsf(f[i]) < 1.0e4f)) grp = (c * 8) >> 8; }
#pragma unroll
            for (int o = 1; o < 64; o <<= 1) { const int g2 = __shfl_xor(grp, o); grp = g2 > grp ? g2 : grp; }
            float val = 0.f; if (grp >= 0) { val = 100.f; for (int k = 0; k < grp; ++k) val *= 10.f; }
#pragma unroll
            for (int i = 0; i < 16; ++i) v[i] = val;
        }
        else if (code >= 20 && code < 24) {
            float val = 0.f;
            if ((t & 15) == 5) { for (int h = 0; h < 4; ++h) { const float e = oracle_attn(F, 0, r, code - 20, h); const float cls = e > 1.0e20f ? 3.f : e > 0.5f ? 2.f : e > 0.03f ? 1.f : 0.f; if (cls > 0.f) { float w = cls; for (int k = 0; k <= h; ++k) w *= 10.f; val = fmaxf(val, w); } } }
#pragma unroll
            for (int i = 0; i < 16; ++i) v[i] = val;
        }
        else if (code >= 30 && code < 46) {
            float val = 0.f;
            if ((t & 15) == 5) { const float e = oracle_attn(F, 0, r, (code - 30) >> 2, (code - 30) & 3, DBG_MODE); val = e > 10.f ? 1.0e4f : 1000.f * e; }
#pragma unroll
            for (int i = 0; i < 16; ++i) v[i] = val;
        }
        else if (code == 7) {
            auto bad16 = [&](const bf16* p, int nchunks) { int bad = 0; for (int c = F.lane; c < nchunks; c += 64) { const v4u w = *((const v4u*)p + c); float f[8]; unpack8(w, f);
#pragma unroll
                for (int i = 0; i < 8; ++i) { const unsigned u = __builtin_bit_cast(unsigned, f[i]); bad |= ((u & 0x7f800000u) == 0x7f800000u) ? 1 : 0; } } return __any(bad); };
            const int bP = bad16((const bf16*)(F.ws + WS_PB) + (size_t)r * NPJ, 288), bQ = bad16((const bf16*)(F.ws + WS_QD) + (size_t)r * 384, 48),
                      bK = bad16((const bf16*)(F.ws + WS_KD) + (size_t)r * 384, 48), bV = bad16((const bf16*)(F.ws + WS_VD) + (size_t)r * 256, 32), bO = bad16((const bf16*)(F.ws + WS_HA) + (size_t)r * D, 128);
            const float val = bP ? 1.0e6f : bQ ? 1.0e5f : bK ? 1.0e4f : bV ? 1.0e3f : bO ? 1.0e2f : 0.f;
#pragma unroll
            for (int i = 0; i < 16; ++i) v[i] = val;
        }
#pragma unroll
        for (int i = 0; i < 16; ++i) { const unsigned u = __builtin_bit_cast(unsigned, v[i]); if ((u & 0x7f800000u) == 0x7f800000u) v[i] = 777.0f; }
        st16(out + ((size_t)b * SEQ + t) * D, F.lane, v);
    }
}
static __device__ __forceinline__ void ph_dump(GAS unsigned char* ws, int code) { const Frame F = make_frame(ws); phase_dump(F, code); }
#endif
__global__ void __launch_bounds__(NTHR, 2) mk_fwd(Args args) {
    extern __shared__ __attribute__((aligned(16))) unsigned char lds_raw[];
    LAS unsigned char* lds = (LAS unsigned char*)lds_raw; volatile LAS unsigned* MISC = (volatile LAS unsigned*)(lds + MISC_OFF);
    const int tid = threadIdx.x;
    GAS unsigned char* ws = (GAS unsigned char*)args.ws;
    for (int u = tid; u < (LDS_BYTES - MISC_OFF) / 4; u += NTHR) MISC[u] = 0u;
    __syncthreads();
    if (tid < 28) { const unsigned long long p = tid < 27 ? (unsigned long long)args.in[tid] : (unsigned long long)args.out;
        LAS unsigned* t = (LAS unsigned*)(lds + PTAB_OFF) + 2 * tid; t[0] = (unsigned)p; t[1] = (unsigned)(p >> 32); }
    __syncthreads();
#if MK_MULTI
#define GRID_BAR() do { } while (0)
#else
    XcdBarrier bar = xcd_barrier_post((unsigned*)(ws + WS_CTL) + CW_BAR, MISC + MI_BAR);
#define GRID_BAR() xcd_barrier(bar)
#endif
    const int lo = args.ph_lo, hi = args.ph_hi;
#define IN(k) (lo <= (k) && (k) < hi)
#if MK_TIME
    unsigned long long tcat = 0ull, tb0 = 0ull;
#define TBEG() do { tb0 = __builtin_amdgcn_s_memrealtime(); } while (0)
#define TEND(c) do { if ((c) == MK_TIME - 1) tcat += __builtin_amdgcn_s_memrealtime() - tb0; } while (0)
#define SEAM(k) do { if (IN(k) && IN((k) + 1)) { TBEG(); GRID_BAR(); TEND(1); } } while (0)
#else
#define TBEG() do { } while (0)
#define TEND(c) do { } while (0)
#define SEAM(k) do { if (IN(k) && IN((k) + 1)) GRID_BAR(); } while (0)
#endif

#if MK_DEBUG
    if (lo >= 100) { ph_dump(ws, lo - 100); return; }
#endif
    if (IN(0)) { TBEG(); ph_prologue(ws); TEND(2); } SEAM(0);
    for (int l = 0; l < NL; ++l) {
        const int pb = 1 + 10 * l;
        if (IN(pb + 0)) { TBEG(); ph_ln(ws, l); TEND(0); } SEAM(pb + 0);
        if (IN(pb + 1)) { TBEG(); ph_gemm_in(ws, l); if (MK_DUP & 2) { GRID_BAR(); ph_gemm_in(ws, l); } TEND(3); } SEAM(pb + 1);
        if (IN(pb + 2)) { TBEG(); ph_post(ws, l); TEND(0); } SEAM(pb + 2);
        if (IN(pb + 3)) { TBEG(); ph_gemm_mla(ws, l); if (MK_DUP & 8) { GRID_BAR(); ph_gemm_mla(ws, l); } TEND(3); } SEAM(pb + 3);
        if (IN(pb + 4)) { TBEG(); ph_attn<0>(ws, l); if (MK_DUP & 16) { GRID_BAR(); ph_attn<MK_VM>(ws, l + 4); } TEND(4); } SEAM(pb + 4);
        if (IN(pb + 5)) { TBEG(); ph_gemm_out(ws, l); if (MK_DUP & 32) { GRID_BAR(); ph_gemm_out(ws, l); } TEND(3); } SEAM(pb + 5);
        if (IN(pb + 6)) { TBEG(); ph_route(ws, l); TEND(0); } SEAM(pb + 6);
        if (IN(pb + 7)) { TBEG(); ph_permute(ws, l); if (MK_DUP & 128) { GRID_BAR(); ph_permute(ws, l); } TEND(0); } SEAM(pb + 7);
        if (IN(pb + 8)) { TBEG(); ph_gemm_gu(ws, l); if (MK_DUP & 256) { GRID_BAR(); ph_gemm_gu(ws, l); } TEND(3); } SEAM(pb + 8);
        if (IN(pb + 9)) { TBEG(); ph_gemm_dn(ws, l); if (MK_DUP & 512) { GRID_BAR(); ph_gemm_dn(ws, l); } TEND(3); } SEAM(pb + 9);
    }
    if (IN(NPHASE - 1)) { TBEG(); ph_ln(ws, NL); TEND(0); }
#if MK_TIME
    if (blockIdx.x == 0) { const unsigned long long tw = __builtin_amdgcn_s_memrealtime(); const unsigned long long dl = tcat * (unsigned long long)MK_TMUL; while (__builtin_amdgcn_s_memrealtime() - tw < dl) __builtin_amdgcn_s_sleep(8); }
#endif
#undef IN
#undef SEAM
#undef GRID_BAR
}

extern "C" void kernel_launch(void* const* d_in, const int* in_sizes, int n_in, void* d_out, int out_size, void* d_ws, size_t ws_size, hipStream_t stream) {
    static int grid = 0;
    if (grid == 0) {
        if (n_in != 27 || out_size != NB * SEQ * D || ws_size < WS_END) { fprintf(stderr, "kernel_launch: unexpected problem (n_in %d, out %d, ws %zu < %zu)\n", n_in, out_size, ws_size, (size_t)WS_END); grid = -1; return; }
        int dev = 0, cus = 0, per_cu = 0;
        if (hipGetDevice(&dev) != hipSuccess || hipDeviceGetAttribute(&cus, hipDeviceAttributeMultiprocessorCount, dev) != hipSuccess) { grid = -1; return; }
        if (hipFuncSetAttribute((const void*)mk_fwd, hipFuncAttributeMaxDynamicSharedMemorySize, LDS_BYTES) != hipSuccess) { fprintf(stderr, "kernel_launch: hipFuncSetAttribute failed\n"); grid = -1; return; }
        if (hipOccupancyMaxActiveBlocksPerMultiprocessor(&per_cu, (const void*)mk_fwd, NTHR, LDS_BYTES) != hipSuccess || per_cu < 1) fprintf(stderr, "kernel_launch: occupancy query reports %d\n", per_cu);
        (void)hipGetLastError();
        grid = cus > 1024 ? 1024 : cus;
    }
    if (grid < 0) return;
    (void)hipMemsetAsync((char*)d_ws + WS_CTL, 0, CTL_BYTES, stream);
    Args a{};
    for (int i = 0; i < 27; ++i) a.in[i] = (const float*)d_in[i];
    a.out = (float*)d_out; a.ws = (unsigned char*)d_ws;
#if MK_MULTI
#ifndef DBG_NRUN
#define DBG_NRUN NPHASE
#endif
    for (int p = 0; p < DBG_NRUN; ++p) { a.ph_lo = p; a.ph_hi = p + 1; hipLaunchKernelGGL(mk_fwd, dim3(grid), dim3(NTHR), LDS_BYTES, stream, a); }
#ifdef DBG_DUMP
    a.ph_lo = 100 + DBG_DUMP; a.ph_hi = 101 + DBG_DUMP; hipLaunchKernelGGL(mk_fwd, dim3(grid), dim3(NTHR), LDS_BYTES, stream, a);
#endif
#else
    a.ph_lo = 0; a.ph_hi = NPHASE;
    hipLaunchKernelGGL(mk_fwd, dim3(grid), dim3(NTHR), LDS_BYTES, stream, a);
#endif
}
```

```cpp
#include <hip/hip_runtime.h>
#include <cstdio>
#include <cstdint>
namespace pg8 {
#define PG8_LAS __attribute__((address_space(3)))
typedef unsigned short bf16_t;
typedef short bf16x8 __attribute__((ext_vector_type(8)));
typedef float f32x4 __attribute__((ext_vector_type(4)));
typedef unsigned u32x4 __attribute__((ext_vector_type(4)));
constexpr int BM = 256, BK = 64, HALF = 128, HTB = HALF * BK * 2  , STAGE_BYTES = 8 * HTB, NXCD = 8, WGM = 8;

__host__ __device__ __forceinline__ int lds_byte(int r, int c) { const int st = (r >> 4) * 2 + (c >> 5), rr = r & 15, cc = c & 31, ob = rr * 64 + cc * 2; return st * 1024 + (ob ^ (((ob >> 9) & 1) << 5)); }
__host__ __device__ __forceinline__ void stage_rc(int b, int& R, int& C) { const int st = b / 1024, sb = b % 1024, swz = sb ^ (((sb >> 9) & 1) << 5); R = (st >> 1) * 16 + swz / 64; C = (st & 1) * 32 + (swz % 64) / 2; }
__host__ __device__ __forceinline__ int perm32(int rho) { const int n = rho >> 4, i = rho & 15; return 8 * (i >> 2) + 4 * n + (i & 3); }

struct Unit { int pm, pn; };
struct Gemm { const bf16_t* A; const bf16_t* Bt; int M, N, K, lda; const int* src; };

struct StaticOrder {
    int nM, nN, nwg, G, c;
    __host__ __device__ void init(int M, int N, int G_, int c_) { nM = M / BM; nN = N / BM; nwg = nM * nN; G = G_; c = c_; }
    __host__ __device__ bool next(int i, Unit& u) const {
        const long L = (long)i * G + c; if (L >= nwg) return false;
        int wgid = (int)L; { const int q = nwg / NXCD, r = nwg % NXCD, xcd = wgid % NXCD, off = wgid / NXCD; wgid = (xcd < r ? xcd * (q + 1) : r * (q + 1) + (xcd - r) * q) + off; }
        const int nig = WGM * nN, gid = wgid / nig, fm = gid * WGM, gsz = (nM - fm) < WGM ? (nM - fm) : WGM;
        u.pm = fm + ((wgid % nig) % gsz); u.pn = (wgid % nig) / gsz; return true;
    }
    __device__ __forceinline__ void a_ready(const Unit&) const {}
    __device__ __forceinline__ void done(const Unit&) const {}
};

__device__ __forceinline__ unsigned cvt_pk_bf16(float lo, float hi) { unsigned r; asm volatile("v_cvt_pk_bf16_f32 %0, %1, %2" : "=v"(r) : "v"(lo), "v"(hi)); return r; }
typedef float f32x2 __attribute__((ext_vector_type(2)));
__device__ __forceinline__ f32x2 gelu_pk(f32x2 v) {
    const f32x2 av = __builtin_elementwise_abs(v), d = av * 0.2316418882f + 1.0f;
    f32x2 t; t.x = __builtin_amdgcn_rcpf(d.x); t.y = __builtin_amdgcn_rcpf(d.y);
    f32x2 q = t * 0.5307027145f + (-0.7265760135f); q = q * t + 0.7107068705f; q = q * t + (-0.142248368f); q = q * t + 0.127414796f; q = q * t;
    const f32x2 s = (v * v) * (-0.72134752044f);
    f32x2 e; e.x = __builtin_amdgcn_exp2f(s.x); e.y = __builtin_amdgcn_exp2f(s.y);
    const f32x2 m = v * (q * e), r = v - m;
    f32x2 o; o.x = v.x < 0.f ? m.x : r.x; o.y = v.y < 0.f ? m.y : r.y; return o;
}

template <int ACT  > struct EpiBf16 {
    static constexpr bool PERM = true, AFTER_DRAIN = false; static_assert(ACT == 0 || ACT == 1, "EpiBf16: ACT is 0 (none) or 1 (gelu_pk)");
    bf16_t* O; int ldc; const float* bias; int split_cols; size_t split_stride; float scale0;
    __device__ __forceinline__ void operator()(const f32x4 (&acc)[2][2][4][2], const Unit& u, int wr, int wc, int fr, int fq) const {
        const int row0 = u.pm * BM + wr * 64 + fr; int colt = u.pn * BM; bf16_t* base = O;
        float sc = 1.f; if (split_cols) { const int t = colt / split_cols; base += (size_t)t * split_stride; colt -= t * split_cols; if (t == 0) sc = scale0; }
        const int col0 = colt + wc * 32 + 8 * fq, bcol0 = u.pn * BM + wc * 32 + 8 * fq;
        f32x4 bv[2][2];
#pragma unroll
        for (int bj = 0; bj < 2; ++bj)
#pragma unroll
            for (int n = 0; n < 2; ++n) bv[bj][n] = bias ? *(const f32x4*)(bias + bcol0 + bj * HALF + 4 * n) : (f32x4){0.f, 0.f, 0.f, 0.f};
#pragma unroll
        for (int ai = 0; ai < 2; ++ai)
#pragma unroll
            for (int m = 0; m < 4; ++m) { bf16_t* rowp = base + (size_t)(row0 + ai * HALF + m * 16) * ldc + col0;
#pragma unroll
                for (int bj = 0; bj < 2; ++bj) { f32x4 v0 = acc[ai][bj][m][0] + bv[bj][0], v1 = acc[ai][bj][m][1] + bv[bj][1];
                    if (ACT == 1) { f32x2 a = gelu_pk((f32x2){v0[0], v0[1]}), b = gelu_pk((f32x2){v0[2], v0[3]}), c = gelu_pk((f32x2){v1[0], v1[1]}), d = gelu_pk((f32x2){v1[2], v1[3]});
                        v0 = (f32x4){a.x, a.y, b.x, b.y}; v1 = (f32x4){c.x, c.y, d.x, d.y}; }
                    v0 = v0 * sc; v1 = v1 * sc; u32x4 w; w.x = cvt_pk_bf16(v0[0], v0[1]); w.y = cvt_pk_bf16(v0[2], v0[3]); w.z = cvt_pk_bf16(v1[0], v1[1]); w.w = cvt_pk_bf16(v1[2], v1[3]);
                    *(u32x4*)(rowp + bj * HALF) = w; } }
    }
};
template <int ACT  > struct EpiBf16NT {
    static constexpr bool PERM = true, AFTER_DRAIN = false; static_assert(ACT == 0 || ACT == 1, "EpiBf16: ACT is 0 (none) or 1 (gelu_pk)");
    bf16_t* O; int ldc; const float* bias; int split_cols; size_t split_stride; float scale0;
    __device__ __forceinline__ void operator()(const f32x4 (&acc)[2][2][4][2], const Unit& u, int wr, int wc, int fr, int fq) const {
        const int row0 = u.pm * BM + wr * 64 + fr; int colt = u.pn * BM; bf16_t* base = O;
        float sc = 1.f; if (split_cols) { const int t = colt / split_cols; base += (size_t)t * split_stride; colt -= t * split_cols; if (t == 0) sc = scale0; }
        const int col0 = colt + wc * 32 + 8 * fq, bcol0 = u.pn * BM + wc * 32 + 8 * fq;
        f32x4 bv[2][2];
#pragma unroll
        for (int bj = 0; bj < 2; ++bj)
#pragma unroll
            for (int n = 0; n < 2; ++n) bv[bj][n] = bias ? *(const f32x4*)(bias + bcol0 + bj * HALF + 4 * n) : (f32x4){0.f, 0.f, 0.f, 0.f};
#pragma unroll
        for (int ai = 0; ai < 2; ++ai)
#pragma unroll
            for (int m = 0; m < 4; ++m) { bf16_t* rowp = base + (size_t)(row0 + ai * HALF + m * 16) * ldc + col0;
#pragma unroll
                for (int bj = 0; bj < 2; ++bj) { f32x4 v0 = acc[ai][bj][m][0] + bv[bj][0], v1 = acc[ai][bj][m][1] + bv[bj][1];
                    if (ACT == 1) { f32x2 a = gelu_pk((f32x2){v0[0], v0[1]}), b = gelu_pk((f32x2){v0[2], v0[3]}), c = gelu_pk((f32x2){v1[0], v1[1]}), d = gelu_pk((f32x2){v1[2], v1[3]});
                        v0 = (f32x4){a.x, a.y, b.x, b.y}; v1 = (f32x4){c.x, c.y, d.x, d.y}; }
                    v0 = v0 * sc; v1 = v1 * sc; u32x4 w; w.x = cvt_pk_bf16(v0[0], v0[1]); w.y = cvt_pk_bf16(v0[2], v0[3]); w.z = cvt_pk_bf16(v1[0], v1[1]); w.w = cvt_pk_bf16(v1[2], v1[3]);
                    __builtin_nontemporal_store(w, (u32x4*)(rowp + bj * HALF)); } }
    }
};
struct EpiF32 {
    static constexpr bool PERM = false, AFTER_DRAIN = false;
    float* C; int ldc; const float* bias;
    __device__ __forceinline__ void operator()(const f32x4 (&acc)[2][2][4][2], const Unit& u, int wr, int wc, int fr, int fq) const {
        const int row0 = u.pm * BM + wr * 64 + fr, col0 = u.pn * BM + wc * 32 + 4 * fq;
        f32x4 bv[2][2];
#pragma unroll
        for (int bj = 0; bj < 2; ++bj)
#pragma unroll
            for (int n = 0; n < 2; ++n) bv[bj][n] = bias ? *(const f32x4*)(bias + col0 + bj * HALF + n * 16) : (f32x4){0.f, 0.f, 0.f, 0.f};
#pragma unroll
        for (int ai = 0; ai < 2; ++ai)
#pragma unroll
            for (int m = 0; m < 4; ++m) { float* rowp = C + (size_t)(row0 + ai * HALF + m * 16) * ldc + col0;
#pragma unroll
                for (int bj = 0; bj < 2; ++bj)
#pragma unroll
                    for (int n = 0; n < 2; ++n) *(f32x4*)(rowp + bj * HALF + n * 16) = acc[ai][bj][m][n] + bv[bj][n]; }
    }
};
template <class Epi, class Sched, bool ALIGN_EPI = false, bool SP2 = false, bool GATHER = false>
__device__ __forceinline__ void gemm_phase(PG8_LAS unsigned char* lds, const Gemm g, const Sched& S, const Epi& E) {
    int tid = threadIdx.x; asm volatile("" : "+v"(tid)); const int wid = __builtin_amdgcn_readfirstlane(tid >> 6), lane = tid & 63, wr = wid >> 2, wc = wid & 3, fr = lane & 15, fq = lane >> 4;
    const int K = g.K, nt = K / BK;
    unsigned voffA[2], voffB[2]; int RA[2]; unsigned CA2[2];
#pragma unroll
    for (int i = 0; i < 2; ++i) { int R, C; stage_rc(tid * 16 + i * 8192, R, C); const int Rb = Epi::PERM ? ((R & ~31) + perm32(R & 31)) : R;
        voffA[i] = (unsigned)(R * g.lda + C) * 2u; voffB[i] = (unsigned)(Rb * K + C) * 2u; RA[i] = R; CA2[i] = (unsigned)C * 2u; }
    unsigned gcur[2][2] = {{0u, 0u}, {0u, 0u}}, gnxt[2][2] = {{0u, 0u}, {0u, 0u}};
#define PG8_GOFF(dst, u_) do { _Pragma("unroll") for (int h_ = 0; h_ < 2; ++h_) _Pragma("unroll") for (int i_ = 0; i_ < 2; ++i_) \
        dst[h_][i_] = (unsigned)g.src[(u_).pm * BM + h_ * HALF + RA[i_]] * (unsigned)(g.lda * 2) + CA2[i_]; } while (0)
#define PG8_STAGE_A(bufoff, gbase, h, nx) do { if constexpr (GATHER) { unsigned vs_[2] = {(nx) ? gnxt[h][0] : gcur[h][0], (nx) ? gnxt[h][1] : gcur[h][1]}; PG8_STAGE(bufoff, gbase, vs_); } \
        else { PG8_STAGE(bufoff, (gbase) + ((h) ? hstepA : 0), voffA); } } while (0)
    const size_t kstep = (size_t)(BK * 2);
    const size_t hstepA = (size_t)HALF * g.lda * 2, hstepB = (size_t)HALF * K * 2;
    const size_t tstepA = 2 * hstepA, tstepB = 2 * hstepB;
    const unsigned ldsw = (unsigned)wid * 1024u;
    const int aoff = lds_byte(wr * 64 + fr, fq * 8), boff = lds_byte(wc * 32 + fr, fq * 8);
#define PG8_SA(b, h) (((b) * 2 + (h)) * HTB)
#define PG8_SB(b, h) ((4 + (b) * 2 + (h)) * HTB)
#define PG8_STAGE(bufoff, gbase, voff) do { _Pragma("unroll") for (int _i = 0; _i < 2; ++_i) \
        __builtin_amdgcn_global_load_lds((const unsigned*)((const char*)(gbase) + (voff)[_i]), (PG8_LAS unsigned*)(lds + (bufoff) + ldsw + _i * 8192), 16, 0, 0); } while (0)
#define PG8_LDA(dst, b, h) do { _Pragma("unroll") for (int m = 0; m < 4; ++m) _Pragma("unroll") for (int k = 0; k < 2; ++k) dst[m][k] = *(const PG8_LAS bf16x8*)(lds + PG8_SA(b, h) + aoff + m * 2048 + k * 1024); } while (0)
#define PG8_LDB(dst, b, h) do { _Pragma("unroll") for (int n = 0; n < 2; ++n) _Pragma("unroll") for (int k = 0; k < 2; ++k) dst[n][k] = *(const PG8_LAS bf16x8*)(lds + PG8_SB(b, h) + boff + n * 2048 + k * 1024); } while (0)
#define PG8_MMA(ai, bj, At, Bt) do { __builtin_amdgcn_s_setprio(1); _Pragma("unroll") for (int m = 0; m < 4; ++m) _Pragma("unroll") for (int n = 0; n < 2; ++n) _Pragma("unroll") for (int k = 0; k < 2; ++k) \
        acc[ai][bj][m][n] = __builtin_amdgcn_mfma_f32_16x16x32_bf16(Bt[n][k], At[m][k], acc[ai][bj][m][n], 0, 0, 0); __builtin_amdgcn_s_setprio(0); } while (0)
#define PG8_WAIT_V(n) asm volatile("s_waitcnt vmcnt(" #n ")" ::: "memory")
#define PG8_WAIT_L(n) asm volatile("s_waitcnt lgkmcnt(" #n ")" ::: "memory")
#define PG8_BAR __builtin_amdgcn_s_barrier()
#define PG8_SCHED __builtin_amdgcn_sched_barrier(0)
    Unit cur, nxt; int ui = 0;
    if (!S.next(0, cur)) return;
    f32x4 acc[2][2][4][2];
#pragma unroll
    for (int a = 0; a < 2; ++a)
#pragma unroll
        for (int b = 0; b < 2; ++b)
#pragma unroll
            for (int m = 0; m < 4; ++m)
#pragma unroll
                for (int n = 0; n < 2; ++n) acc[a][b][m][n] = (f32x4){0.f, 0.f, 0.f, 0.f};
    bf16x8 At[4][2], B0[2][2], B1[2][2];
    const char* cA = (const char*)g.A + (GATHER ? (size_t)0 : (size_t)cur.pm * tstepA); const char* cB = (const char*)g.Bt + (size_t)cur.pn * tstepB;
    if constexpr (GATHER) PG8_GOFF(gcur, cur);
    S.a_ready(cur);
    if constexpr (SP2) {
        PG8_STAGE(PG8_SB(0, 0), cB, voffB); PG8_STAGE(PG8_SB(0, 1), cB + hstepB, voffB); PG8_STAGE_A(PG8_SA(0, 0), cA, 0, false); PG8_STAGE_A(PG8_SA(0, 1), cA, 1, false);
        if (wr == 1) PG8_BAR;
        PG8_WAIT_V(2); PG8_BAR;
        PG8_STAGE(PG8_SB(1, 0), cB + kstep, voffB); PG8_STAGE_A(PG8_SA(1, 0), cA + kstep, 0, false); PG8_STAGE(PG8_SB(1, 1), cB + hstepB + kstep, voffB);
        PG8_WAIT_V(6); PG8_BAR;
    } else {
        PG8_STAGE(PG8_SB(0, 0), cB, voffB); PG8_STAGE_A(PG8_SA(0, 0), cA, 0, false); PG8_STAGE(PG8_SB(0, 1), cB + hstepB, voffB); PG8_STAGE_A(PG8_SA(0, 1), cA, 1, false);
        if (wr == 1) PG8_BAR;
        PG8_WAIT_V(4); PG8_BAR;
        PG8_STAGE(PG8_SB(1, 0), cB + kstep, voffB); PG8_STAGE_A(PG8_SA(1, 0), cA + kstep, 0, false); PG8_STAGE(PG8_SB(1, 1), cB + hstepB + kstep, voffB);
        PG8_WAIT_V(6); PG8_BAR;
    }
    for (;;) {
        const bool has_next = S.next(ui + 1, nxt);
        const char* nA = (has_next && !GATHER) ? (const char*)g.A + (size_t)nxt.pm * tstepA : cA; const char* nB = has_next ? (const char*)g.Bt + (size_t)nxt.pn * tstepB : cB;
        if constexpr (GATHER) { if (has_next) PG8_GOFF(gnxt, nxt); else { _Pragma("unroll") for (int h_ = 0; h_ < 2; ++h_) { gnxt[h_][0] = gcur[h_][0]; gnxt[h_][1] = gcur[h_][1]; } } }
#pragma unroll 1
        for (int t = 0; t < nt; t += 2) {
            const bool last = (t == nt - 2);
            const char* a1 = cA + (size_t)(t + 1) * kstep;
            const char* a2 = last ? nA : cA + (size_t)(t + 2) * kstep; const char* b2 = last ? nB : cB + (size_t)(t + 2) * kstep;
            const char* a3 = a2 + kstep; const char* b3 = b2 + kstep;
            if (last && has_next) S.a_ready(nxt);
            if constexpr (SP2) {
            PG8_LDB(B0, 0, 0); PG8_LDB(B1, 0, 1); PG8_SCHED; PG8_LDA(At, 0, 0); PG8_STAGE_A(PG8_SA(1, 1), a1, 1, false);
            PG8_WAIT_V(8); PG8_WAIT_L(0); PG8_BAR; PG8_MMA(0, 0, At, B0); PG8_MMA(0, 1, At, B1); PG8_BAR; PG8_SCHED;
            PG8_LDA(At, 0, 1); PG8_STAGE(PG8_SB(0, 0), b2, voffB); PG8_STAGE(PG8_SB(0, 1), b2 + hstepB, voffB); PG8_STAGE_A(PG8_SA(0, 0), a2, 0, last);
            PG8_WAIT_V(8); PG8_WAIT_L(0); PG8_BAR; PG8_MMA(1, 0, At, B0); PG8_MMA(1, 1, At, B1); PG8_BAR; PG8_SCHED;
            PG8_LDB(B0, 1, 0); PG8_LDB(B1, 1, 1); PG8_SCHED; PG8_LDA(At, 1, 0); PG8_STAGE_A(PG8_SA(0, 1), a2, 1, last);
            PG8_WAIT_V(8); PG8_WAIT_L(0); PG8_BAR; PG8_MMA(0, 0, At, B0); PG8_MMA(0, 1, At, B1); PG8_BAR; PG8_SCHED;
            PG8_LDA(At, 1, 1); PG8_STAGE(PG8_SB(1, 0), b3, voffB); PG8_STAGE(PG8_SB(1, 1), b3 + hstepB, voffB); PG8_STAGE_A(PG8_SA(1, 0), a3, 0, last);
            PG8_WAIT_V(8); PG8_WAIT_L(0); PG8_BAR; PG8_MMA(1, 0, At, B0); PG8_MMA(1, 1, At, B1); PG8_BAR; PG8_SCHED;
            } else {
            PG8_LDB(B0, 0, 0); PG8_SCHED; PG8_LDA(At, 0, 0); PG8_STAGE_A(PG8_SA(1, 1), a1, 1, false);
            PG8_WAIT_L(8); PG8_BAR; PG8_WAIT_L(0); PG8_MMA(0, 0, At, B0); PG8_BAR; PG8_SCHED;
            PG8_LDB(B1, 0, 1); PG8_STAGE(PG8_SB(0, 0), b2, voffB);
            PG8_BAR; PG8_WAIT_L(0); PG8_MMA(0, 1, At, B1); PG8_BAR;
            PG8_LDA(At, 0, 1); PG8_STAGE_A(PG8_SA(0, 0), a2, 0, last);
            PG8_BAR; PG8_WAIT_L(0); PG8_MMA(1, 0, At, B0); PG8_BAR; PG8_SCHED;
            PG8_STAGE(PG8_SB(0, 1), b2 + hstepB, voffB);
            PG8_WAIT_V(6); PG8_BAR; PG8_MMA(1, 1, At, B1); PG8_BAR;
            PG8_LDB(B0, 1, 0); PG8_SCHED; PG8_LDA(At, 1, 0); PG8_STAGE_A(PG8_SA(0, 1), a2, 1, last);
            PG8_WAIT_L(8); PG8_BAR; PG8_WAIT_L(0); PG8_MMA(0, 0, At, B0); PG8_BAR; PG8_SCHED;
            PG8_LDB(B1, 1, 1); PG8_STAGE(PG8_SB(1, 0), b3, voffB);
            PG8_BAR; PG8_WAIT_L(0); PG8_MMA(0, 1, At, B1); PG8_BAR;
            PG8_LDA(At, 1, 1); PG8_STAGE_A(PG8_SA(1, 0), a3, 0, last);
            PG8_BAR; PG8_WAIT_L(0); PG8_MMA(1, 0, At, B0); PG8_BAR; PG8_SCHED;
            PG8_STAGE(PG8_SB(1, 1), b3 + hstepB, voffB);
            PG8_WAIT_V(6); PG8_BAR; PG8_MMA(1, 1, At, B1); PG8_BAR;
            }
        }
        if constexpr (ALIGN_EPI) { if (wr == 0) PG8_BAR; }
        if constexpr (!Epi::AFTER_DRAIN) { E(acc, cur, wr, wc, fr, fq); S.done(cur); }
        if (!has_next) break;
#pragma unroll
        for (int a = 0; a < 2; ++a)
#pragma unroll
            for (int b = 0; b < 2; ++b)
#pragma unroll
                for (int m = 0; m < 4; ++m)
#pragma unroll
                    for (int n = 0; n < 2; ++n) acc[a][b][m][n] = (f32x4){0.f, 0.f, 0.f, 0.f};
        cur = nxt; cA = nA; cB = nB; ++ui;
        if constexpr (GATHER) { _Pragma("unroll") for (int h_ = 0; h_ < 2; ++h_) { gcur[h_][0] = gnxt[h_][0]; gcur[h_][1] = gnxt[h_][1]; } }
        if constexpr (ALIGN_EPI) { if (wr == 1) PG8_BAR; }
    }
    PG8_WAIT_V(0);
    if constexpr (!ALIGN_EPI) { if (wr == 0) PG8_BAR; }
    PG8_BAR;
    if constexpr (Epi::AFTER_DRAIN) { E.fused(acc, cur, wr, wc, fr, fq, lds, wid, lane); S.done(cur); }
#undef PG8_SA
#undef PG8_GOFF
#undef PG8_STAGE_A
#undef PG8_SB
#undef PG8_STAGE
#undef PG8_LDA
#undef PG8_LDB
#undef PG8_MMA
#undef PG8_WAIT_V
#undef PG8_WAIT_L
#undef PG8_BAR
#undef PG8_SCHED
}
}

constexpr int NB = 16, SEQ = 4096, CTX = 256, TT = SEQ + CTX, M = NB * TT, D = 1024, NL = 4;
constexpr int NPJ = 2304, DPROJ = 2208;
constexpr int MS = 143360;
constexpr float EPS = 1e-6f, ALPHA = 1.6817928305074290f, LOG2E = 1.4426950408889634f;
constexpr int NWAVES = 8, NTHR = 512;
#ifndef MK_DEBUG
#define MK_DEBUG 0
#endif
#ifndef MK_TIME
#define MK_TIME 0
#endif
#ifndef MK_TMUL
#define MK_TMUL 1
#endif
#ifndef MK_VM
#define MK_VM 0
#endif
#ifndef MK_DUP
#define MK_DUP 0
#endif
#ifndef MK_MULTI
#define MK_MULTI 0
#endif
constexpr int NPHASE = 2 + 10 * NL;

constexpr size_t WS_CTL = 0, CTL_BYTES = 65536;
constexpr size_t WS_MODS = WS_CTL + CTL_BYTES;
constexpr size_t WS_T64 = WS_MODS + (size_t)NL * 17 * 6144 * 4;
constexpr size_t WS_T32 = WS_T64 + 8192;
constexpr size_t WS_RS = WS_T32 + 4096;
constexpr size_t WS_RT = WS_RS + (size_t)M * 8;
constexpr size_t WS_HIST = WS_RT + (size_t)M * 32;
constexpr size_t WS_XS = WS_HIST + 65536;
constexpr size_t WS_WIN = WS_XS + (size_t)M * D * 2;
constexpr size_t WS_WD = WS_WIN + (size_t)NPJ * D * 2;
constexpr size_t WS_WOUT = WS_WD + (size_t)1024 * 384 * 2;
constexpr size_t WS_WGU = WS_WOUT + (size_t)D * D * 2;
constexpr size_t WS_WDN = WS_WGU + (size_t)16 * 1024 * 1024 * 2;
constexpr size_t WS_HA = WS_WDN + (size_t)16 * 1024 * 512 * 2;
constexpr size_t WS_PB = WS_HA + (size_t)M * D * 2;
constexpr size_t WS_QD = WS_PB + (size_t)M * NPJ * 2;
constexpr size_t WS_KD = WS_QD + (size_t)M * 384 * 2;
constexpr size_t WS_VD = WS_KD + (size_t)M * 384 * 2;
constexpr size_t WS_ACT = WS_VD + (size_t)M * 256 * 2;
constexpr size_t WS_END = WS_ACT + (size_t)MS * 512 * 2;
static_assert(WS_END <= (size_t)1073741824, "d_ws map must fit 1 GiB");
static_assert((size_t)M * NPJ * 2 >= (size_t)MS * D * 2 && (size_t)M * NPJ * 2 >= (size_t)M * D * 4, "region PB overlays");
constexpr int CW_BAR = 0;
constexpr int CW_QUEUE = 4096;

constexpr int RING_BYTES = 131072, MISC_OFF = RING_BYTES, LDS_BYTES = 147456;
constexpr int MI_BAR = 0, MI_Q = 4, MI_TOT = 16, MI_BASE = 32, MI_PST = 48, MI_LH = 80;

#define GAS __attribute__((address_space(1)))
#define LAS __attribute__((address_space(3)))
typedef unsigned short bf16;
typedef unsigned v4u __attribute__((ext_vector_type(4)));
typedef unsigned v2u __attribute__((ext_vector_type(2)));
typedef float f32x4 __attribute__((ext_vector_type(4)));
typedef float f32x2 __attribute__((ext_vector_type(2)));
typedef short bf16x8 __attribute__((ext_vector_type(8)));
typedef float f32x16 __attribute__((ext_vector_type(16)));
typedef short v4i16 __attribute__((ext_vector_type(4)));

__device__ __forceinline__ unsigned f2bf(float f) { unsigned u = __builtin_bit_cast(unsigned, f); return (u + 0x7fffu + ((u >> 16) & 1u)) >> 16; }
__device__ __forceinline__ unsigned pk2(float lo, float hi) { return f2bf(lo) | (f2bf(hi) << 16); }
__device__ __forceinline__ float bflo(unsigned w) { return __builtin_bit_cast(float, w << 16); }
__device__ __forceinline__ float bfhi(unsigned w) { return __builtin_bit_cast(float, w & 0xffff0000u); }
__device__ __forceinline__ void unpack8(v4u w, float (&f)[8]) { f[0] = bflo(w.x); f[1] = bfhi(w.x); f[2] = bflo(w.y); f[3] = bfhi(w.y); f[4] = bflo(w.z); f[5] = bfhi(w.z); f[6] = bflo(w.w); f[7] = bfhi(w.w); }
__device__ __forceinline__ v4u pack8(const float (&f)[8]) { v4u w; w.x = pk2(f[0], f[1]); w.y = pk2(f[2], f[3]); w.z = pk2(f[4], f[5]); w.w = pk2(f[6], f[7]); return w; }
__device__ __forceinline__ float wave_sum(float v) {
    int x = __builtin_bit_cast(int, v);
#define WS_DPP(ctrl, rmask) v += __builtin_bit_cast(float, __builtin_amdgcn_update_dpp(0, x, ctrl, rmask, 0xf, true)); x = __builtin_bit_cast(int, v)
    WS_DPP(0xB1, 0xf);
    WS_DPP(0x4E, 0xf);
    WS_DPP(0x141, 0xf);
    WS_DPP(0x140, 0xf);
    WS_DPP(0x142, 0xa);
    WS_DPP(0x143, 0xc);
#undef WS_DPP
    return __builtin_bit_cast(float, __builtin_amdgcn_readlane(__builtin_bit_cast(int, v), 63));
}

#define XB_TMO      128
#define XB_XCNT(j)  (256  + 64 * (j))
#define XB_XSUB(j)  (1280 + 64 * (j))
#define XB_XGEN(j)  (2304 + 64 * (j))
#define XB_TOP      3328
#define XB_TOPGEN   3392
#define XCD_BAR_WORDS 3456
#define XB_SPIN_CAP (1u << 22)
__device__ __forceinline__ unsigned xb_ld(unsigned* p)              { return __hip_atomic_load(p, __ATOMIC_RELAXED, __HIP_MEMORY_SCOPE_AGENT); }
__device__ __forceinline__ unsigned xb_add(unsigned* p, unsigned v) { return __hip_atomic_fetch_add(p, v, __ATOMIC_RELAXED, __HIP_MEMORY_SCOPE_AGENT); }
__device__ __forceinline__ unsigned xb_xcc_id() { return (unsigned)__builtin_amdgcn_s_getreg((3 << 11) | 20) & 0xFu; }
#define XB_SPIN(cond, bar) do { unsigned _sp = 0; while (cond) { __builtin_amdgcn_s_sleep(1); \
    if ((++_sp & 255u) == 0u) { if (xb_ld(&(bar)[XB_TMO])) break; if (_sp > XB_SPIN_CAP) { atomicAdd(&(bar)[XB_TMO], 1u); break; } } } } while (0)
struct XcdBarrier { unsigned* bar; unsigned x; volatile LAS unsigned* st; };
__device__ __forceinline__ XcdBarrier xcd_barrier_post(unsigned* bar, volatile LAS unsigned* st) {
    XcdBarrier b; b.bar = bar; b.x = xb_xcc_id(); b.st = st;
    if (threadIdx.x == 0) (void)xb_add(&bar[XB_XCNT(b.x)], 1u);
    return b;
}
__device__ __forceinline__ void xcd_barrier_complete(unsigned* bar, unsigned x, unsigned& nloc, unsigned& nx) {
    const unsigned G = gridDim.x * gridDim.y * gridDim.z;
    unsigned sum, cnt, mine, sp = 0u;
    for (;;) {
        sum = 0u; cnt = 0u; mine = 0u;
#pragma unroll
        for (unsigned j = 0; j < 16; ++j) { const unsigned c = xb_ld(&bar[XB_XCNT(j)]); sum += c; cnt += (c > 0u) ? 1u : 0u; mine = (j == x) ? c : mine; }
        if (sum == G) break;
        __builtin_amdgcn_s_sleep(1);
        if ((++sp & 255u) == 0u) { if (xb_ld(&bar[XB_TMO])) break; if (sp > XB_SPIN_CAP) { atomicAdd(&bar[XB_TMO], 1u); break; } }
    }
    nloc = mine > 0u ? mine : 1u; nx = cnt > 0u ? cnt : 1u;
}
__device__ __forceinline__ void xcd_barrier(const XcdBarrier& b) {
    asm volatile("s_waitcnt vmcnt(0)" ::: "memory");
    __syncthreads();
    if (threadIdx.x == 0) {
        unsigned* bar = b.bar;
        __builtin_amdgcn_s_waitcnt(0);
        unsigned nloc = b.st[0], nx = b.st[1];
        if (nloc == 0u) { xcd_barrier_complete(bar, b.x, nloc, nx); b.st[0] = nloc; b.st[1] = nx; }
        const unsigned old = xb_add(&bar[XB_XSUB(b.x)], 1u);
        const unsigned gen = old / nloc;
        if (old + 1u == (gen + 1u) * nloc) {
            __builtin_amdgcn_fence(__ATOMIC_RELEASE, "agent");
            asm volatile("s_waitcnt vmcnt(0)" ::: "memory");
            const unsigned og = xb_add(&bar[XB_TOP], 1u);
            const unsigned tg = og / nx;
            if (og + 1u == (tg + 1u) * nx) xb_add(&bar[XB_TOPGEN], 1u);
            else XB_SPIN(xb_ld(&bar[XB_TOPGEN]) == tg, bar);
            __builtin_amdgcn_fence(__ATOMIC_ACQUIRE, "agent");
            xb_add(&bar[XB_XGEN(b.x)], 1u);
            asm volatile("s_waitcnt vmcnt(0)" ::: "memory");
        } else {
            XB_SPIN(xb_ld(&bar[XB_XGEN(b.x)]) == gen, bar);
            __builtin_amdgcn_fence(__ATOMIC_ACQUIRE, "agent");
            asm volatile("s_waitcnt vmcnt(0)" ::: "memory");
        }
    }
    __syncthreads();
}

struct Args { const float* in[27]; float* out; unsigned char* ws; int ph_lo, ph_hi; };
enum { I_X = 0, I_C, I_CTX, I_CCTX, I_WADA, I_BADA, I_WIN, I_NABIAS, I_GQG, I_GKG, I_SINK, I_MQG, I_WQB, I_MKVG, I_WKVB, I_WOUT, I_LN1G, I_LN1B, I_RGW, I_RGB, I_REW, I_REB, I_WG, I_WU, I_WDN, I_LN2G, I_LN2B };

struct Frame {
    LAS unsigned char* lds; volatile LAS unsigned* MISC;
    int tid, lane, wave, G, gw, ngw, bid;
    GAS unsigned char* ws;
};
__device__ __forceinline__ int opaque_tid() { int t = threadIdx.x; asm volatile("" : "+v"(t)); return t; }
__device__ __forceinline__ int opaque_s(int x) { asm volatile("" : "+s"(x)); return x; }
constexpr int PTAB_OFF = MISC_OFF + 2048, I_OUT = 27;
__device__ __forceinline__ GAS unsigned char* ptab_get(const Frame& F, int i) {
    const LAS unsigned* t = (const LAS unsigned*)(F.lds + PTAB_OFF) + 2 * i;
    const unsigned lo = __builtin_amdgcn_readfirstlane(t[0]), hi = __builtin_amdgcn_readfirstlane(t[1]);
    return (GAS unsigned char*)(((unsigned long long)hi << 32) | lo);
}
#define INP(i) ((const float*)ptab_get(F, (i)))
__device__ __forceinline__ Frame make_frame(GAS unsigned char* ws) {
    extern __shared__ __attribute__((aligned(16))) unsigned char lds_raw[];
    Frame F;
    F.lds = (LAS unsigned char*)lds_raw; F.MISC = (volatile LAS unsigned*)(F.lds + MISC_OFF);
    F.tid = opaque_tid(); F.lane = F.tid & 63; F.wave = __builtin_amdgcn_readfirstlane(F.tid >> 6);
    F.G = opaque_s((int)gridDim.x); F.bid = opaque_s((int)blockIdx.x); F.gw = F.bid * NWAVES + F.wave; F.ngw = F.G * NWAVES;
    { unsigned long long w = (unsigned long long)ws; asm volatile("" : "+s"(w)); F.ws = (GAS unsigned char*)w; }
    return F;
}
typedef _Float16 f16x4 __attribute__((ext_vector_type(4)));
struct RowPtrs { const float* x; const float* ctx; float* out; _Float16* xs; };
__device__ __forceinline__ RowPtrs row_ptrs(const Frame& F) { RowPtrs p; p.x = INP(I_X); p.ctx = INP(I_CTX); p.out = (float*)ptab_get(F, I_OUT); p.xs = (_Float16*)(F.ws + WS_XS); return p; }
__device__ __forceinline__ const float* xin_row(const RowPtrs& P, int r) {
    const int b = r / TT, t = r - b * TT;
    return t < SEQ ? P.x + ((size_t)b * SEQ + t) * D : P.ctx + ((size_t)b * CTX + (t - SEQ)) * D;
}
__device__ __forceinline__ float* out_row(const RowPtrs& P, int r) { const int b = r / TT, t = r - b * TT; return P.out + ((size_t)b * SEQ + t) * D; }
__device__ __forceinline__ void ld16h(const _Float16* p, int lane, float (&v)[16]) {
    const f16x4* q = (const f16x4*)p + lane;
#pragma unroll
    for (int g = 0; g < 4; ++g) { const f32x4 f = __builtin_convertvector(__builtin_nontemporal_load(q + 64 * g), f32x4); v[4 * g] = f.x; v[4 * g + 1] = f.y; v[4 * g + 2] = f.z; v[4 * g + 3] = f.w; }
}
__device__ __forceinline__ void st16h(_Float16* p, int lane, const float (&v)[16]) {
    f16x4* q = (f16x4*)p + lane;
#pragma unroll
    for (int g = 0; g < 4; ++g) __builtin_nontemporal_store(__builtin_convertvector((f32x4){v[4 * g], v[4 * g + 1], v[4 * g + 2], v[4 * g + 3]}, f16x4), q + 64 * g);
}
__device__ __forceinline__ void ld16(const float* p, int lane, float (&v)[16]) {
    const f32x4* q = (const f32x4*)p + lane;
    const f32x4 a = q[0], b = q[64], c = q[128], d = q[192];
    v[0] = a.x; v[1] = a.y; v[2] = a.z; v[3] = a.w; v[4] = b.x; v[5] = b.y; v[6] = b.z; v[7] = b.w;
    v[8] = c.x; v[9] = c.y; v[10] = c.z; v[11] = c.w; v[12] = d.x; v[13] = d.y; v[14] = d.z; v[15] = d.w;
}
__device__ __forceinline__ void st16(float* p, int lane, const float (&v)[16]) {
    f32x4* q = (f32x4*)p + lane;
    q[0] = (f32x4){v[0], v[1], v[2], v[3]}; q[64] = (f32x4){v[4], v[5], v[6], v[7]};
    q[128] = (f32x4){v[8], v[9], v[10], v[11]}; q[192] = (f32x4){v[12], v[13], v[14], v[15]};
}
__device__ __forceinline__ void ld16nt(const float* p, int lane, float (&v)[16]) {
    const f32x4* q = (const f32x4*)p + lane;
    const f32x4 a = __builtin_nontemporal_load(q), b = __builtin_nontemporal_load(q + 64), c = __builtin_nontemporal_load(q + 128), d = __builtin_nontemporal_load(q + 192);
    v[0] = a.x; v[1] = a.y; v[2] = a.z; v[3] = a.w; v[4] = b.x; v[5] = b.y; v[6] = b.z; v[7] = b.w;
    v[8] = c.x; v[9] = c.y; v[10] = c.z; v[11] = c.w; v[12] = d.x; v[13] = d.y; v[14] = d.z; v[15] = d.w;
}
__device__ __forceinline__ void st16nt(float* p, int lane, const float (&v)[16]) {
    f32x4* q = (f32x4*)p + lane;
    __builtin_nontemporal_store((f32x4){v[0], v[1], v[2], v[3]}, q); __builtin_nontemporal_store((f32x4){v[4], v[5], v[6], v[7]}, q + 64);
    __builtin_nontemporal_store((f32x4){v[8], v[9], v[10], v[11]}, q + 128); __builtin_nontemporal_store((f32x4){v[12], v[13], v[14], v[15]}, q + 192);
}
__device__ __forceinline__ void unpack16(const v2u (&w)[4], float (&v)[16]) {
#pragma unroll
    for (int g = 0; g < 4; ++g) { v[4 * g] = bflo(w[g].x); v[4 * g + 1] = bfhi(w[g].x); v[4 * g + 2] = bflo(w[g].y); v[4 * g + 3] = bfhi(w[g].y); }
}
__device__ __forceinline__ void ld16bf_raw(const bf16* p, int lane, v2u (&w)[4]) {
    const v2u* q = (const v2u*)p + lane; w[0] = q[0]; w[1] = q[64]; w[2] = q[128]; w[3] = q[192];
}
__device__ __forceinline__ void ld16bf_raw_nt(const bf16* p, int lane, v2u (&w)[4]) {
    const v2u* q = (const v2u*)p + lane; w[0] = __builtin_nontemporal_load(q); w[1] = __builtin_nontemporal_load(q + 64); w[2] = __builtin_nontemporal_load(q + 128); w[3] = __builtin_nontemporal_load(q + 192);
}
__device__ __forceinline__ void ld16bf(const bf16* p, int lane, float (&v)[16]) { v2u w[4]; ld16bf_raw(p, lane, w); unpack16(w, v); }
__device__ __forceinline__ void ld16bf_nt(const bf16* p, int lane, float (&v)[16]) { v2u w[4]; ld16bf_raw_nt(p, lane, w); unpack16(w, v); }
__device__ __forceinline__ void st16bf(bf16* p, int lane, const float (&v)[16]) {
    v2u* q = (v2u*)p + lane;
#pragma unroll
    for (int g = 0; g < 4; ++g) { v2u w; w.x = pk2(v[4 * g], v[4 * g + 1]); w.y = pk2(v[4 * g + 2], v[4 * g + 3]); q[64 * g] = w; }
}
__device__ __forceinline__ void ln16(float (&v)[16]) {
    float s = 0.f;
#pragma unroll
    for (int i = 0; i < 16; ++i) s += v[i];
    const float mean = wave_sum(s) * (1.0f / D); float q = 0.f;
#pragma unroll
    for (int i = 0; i < 16; ++i) { v[i] -= mean; q += v[i] * v[i]; }
    const float rstd = 1.0f / sqrtf(wave_sum(q) * (1.0f / D) + EPS);
#pragma unroll
    for (int i = 0; i < 16; ++i) v[i] *= rstd;
}

__device__ __forceinline__ int rows_per_wave(int ngw) {
    int rpw = (M + ngw - 1) / ngw;
    if (!((SEQ % rpw) % 4 == 0 && (TT % rpw) == 0 && (rpw % 2) == 0)) rpw = (rpw + 3) & ~3;
    return rpw;
}
template <int TYPE>
__device__ __forceinline__ float conv_src(const float* p0, const float* p1, const float* g0, const float* g1, int l, int k, int n) {
    if (TYPE == 0) return n < DPROJ ? p0[((size_t)l * D + k) * DPROJ + n] : 0.f;
    if (TYPE == 1) { if (n < 384) return k < 256 ? g0[l * 256 + k] * p0[((size_t)l * 256 + k) * 384 + n] : 0.f;
                     if (n < 896) return k >= 256 ? g1[l * 128 + (k - 256)] * p1[((size_t)l * 128 + (k - 256)) * 512 + (n - 384)] : 0.f;
                     return 0.f; }
    if (TYPE == 2) return p0[((size_t)l * D + k) * D + n];
    if (TYPE == 3) { const int e = n >> 10, nn = n & 1023, q = nn >> 3, j = nn & 7;
                     return j < 4 ? p0[(((size_t)l * 16 + e) * D + k) * 512 + 4 * q + j] : p1[(((size_t)l * 16 + e) * D + k) * 512 + 4 * q + (j - 4)]; }
    { const int e = n >> 10, nn = n & 1023; return p0[(((size_t)l * 16 + e) * 512 + k) * D + nn]; }
}
template <int TYPE>
__device__ __forceinline__ void conv_item(const Frame& F, int l, int item, LAS float* scr) {
    constexpr int Nd = TYPE == 0 ? NPJ : TYPE == 1 ? 1024 : TYPE == 2 ? 1024 : 16384, Kd = TYPE == 1 ? 384 : TYPE == 4 ? 512 : 1024;
    bf16* dst = (bf16*)(F.ws + (TYPE == 0 ? WS_WIN : TYPE == 1 ? WS_WD : TYPE == 2 ? WS_WOUT : TYPE == 3 ? WS_WGU : WS_WDN));
    const float* p0 = INP(TYPE == 0 ? I_WIN : TYPE == 1 ? I_WQB : TYPE == 2 ? I_WOUT : TYPE == 3 ? I_WG : I_WDN);
    const float* p1 = INP(TYPE == 1 ? I_WKVB : I_WU); const float* g0 = INP(I_MQG); const float* g1 = INP(I_MKVG);
    constexpr int nblk = Nd / 32; const int kb = item / nblk, nb = item - kb * nblk, k0 = 64 * kb, n0 = 32 * nb, lane = F.lane;
#pragma unroll
    for (int i = 0; i < 32; ++i) { const int kk = 2 * i + (lane >> 5); scr[kk * 33 + (lane & 31)] = conv_src<TYPE>(p0, p1, g0, g1, l, k0 + kk, n0 + (lane & 31)); }
    asm volatile("s_waitcnt lgkmcnt(0)" ::: "memory");
    const int c = lane & 7;
#pragma unroll
    for (int j = 0; j < 4; ++j) { const int n = (lane >> 3) + 8 * j; const LAS float* s = scr + (8 * c) * 33 + n;
        v4u o; o.x = pk2(s[0 * 33], s[1 * 33]); o.y = pk2(s[2 * 33], s[3 * 33]); o.z = pk2(s[4 * 33], s[5 * 33]); o.w = pk2(s[6 * 33], s[7 * 33]);
        *(v4u*)(dst + (size_t)(n0 + n) * Kd + k0 + 8 * c) = o; }
    asm volatile("s_waitcnt lgkmcnt(0)" ::: "memory");
}
__device__ __forceinline__ void phase_prologue(const Frame& F) {
    {
        LAS float* sv = (LAS float*)F.lds;
        LAS float* red = (LAS float*)(F.lds + 17 * 1024 * 4);
        float* mods = (float*)(F.ws + WS_MODS);
        for (int u = F.bid; u < NL * 48; u += F.G) {
            const int l = u / 48, cc = u - l * 48;
            const float* pc = INP(I_C); const float* pcc = INP(I_CCTX);
            for (int i = F.tid; i < 17 * 1024; i += NTHR) { const int mr = i >> 10, k = i & 1023; const float c = mr < 16 ? pc[mr * 1024 + k] : pcc[k]; sv[i] = c / (1.0f + expf(-c)); }
            __syncthreads();
            const int col = F.tid & 127, kg = F.tid >> 7;
            float acc[17];
#pragma unroll
            for (int mr = 0; mr < 17; ++mr) acc[mr] = 0.f;
            const float* w = INP(I_WADA) + ((size_t)l * 1024 + kg * 256) * 6144 + cc * 128 + col;
            for (int k4 = 0; k4 < 256; k4 += 4) {
                const float w0 = w[(size_t)(k4 + 0) * 6144], w1 = w[(size_t)(k4 + 1) * 6144], w2 = w[(size_t)(k4 + 2) * 6144], w3 = w[(size_t)(k4 + 3) * 6144];
#pragma unroll
                for (int mr = 0; mr < 17; ++mr) { const f32x4 s = *(const LAS f32x4*)(sv + mr * 1024 + kg * 256 + k4); acc[mr] += (s.x * w0 + s.y * w1) + (s.z * w2 + s.w * w3); }
            }
#pragma unroll
            for (int mr = 0; mr < 17; ++mr) red[(kg * 17 + mr) * 128 + col] = acc[mr];
            __syncthreads();
            const float* bada = INP(I_BADA);
            for (int i = F.tid; i < 17 * 128; i += NTHR) { const int mr = i >> 7, c = i & 127;
                const float s = (red[(0 * 17 + mr) * 128 + c] + red[(1 * 17 + mr) * 128 + c]) + (red[(2 * 17 + mr) * 128 + c] + red[(3 * 17 + mr) * 128 + c]);
                mods[((size_t)l * 17 + mr) * 6144 + cc * 128 + c] = s + bada[l * 6144 + cc * 128 + c]; }
            __syncthreads();
        }
    }
    {
        float* t64 = (float*)(F.ws + WS_T64); float* t32 = (float*)(F.ws + WS_T32);
        for (int i = F.bid * NTHR + F.tid; i < 64 * 16 + 64 * 8; i += F.G * NTHR) {
            if (i < 1024) { const int p = i >> 4, k = i & 15; const float fr = powf(10000.0f, -(float)k / 16.0f), ang = (float)p * fr; t64[2 * i] = cosf(ang); t64[2 * i + 1] = sinf(ang); }
            else { const int j = i - 1024, p = j >> 3, k = j & 7; const float fr = powf(10000.0f, -(float)k / 8.0f), ang = (float)p * fr; t32[2 * j] = cosf(ang); t32[2 * j + 1] = sinf(ang); }
        }
    }
}
__device__ __forceinline__ void convert_layer_weights(const Frame& F, int l) {
    {
        LAS float* scr = (LAS float*)(F.lds + F.wave * 8448);
        constexpr int I0 = 1152, I1 = 192, I2 = 512, I3 = 8192, I4 = 4096, IL = I0 + I1 + I2 + I3 + I4;
        for (int r0_ = F.gw; r0_ < IL; r0_ += F.ngw) {
            int r = r0_;
            if (r < I0) { conv_item<0>(F, l, r, scr); continue; } r -= I0;
            if (r < I1) { conv_item<1>(F, l, r, scr); continue; } r -= I1;
            if (r < I2) { conv_item<2>(F, l, r, scr); continue; } r -= I2;
            if (r < I3) { conv_item<3>(F, l, r, scr); continue; } r -= I3;
            conv_item<4>(F, l, r, scr);
        }
    }
}

__device__ __forceinline__ void phase_ln(const Frame& F, int l) {
    if (l < NL) convert_layer_weights(F, l);
    constexpr int NR = 4;
    const float* mods = (const float*)(F.ws + WS_MODS); bf16* HA = (bf16*)(F.ws + WS_HA);
    const bf16* Y = (const bf16*)(F.ws + WS_PB); const unsigned* RT = (const unsigned*)(F.ws + WS_RT);
    const int lane = F.lane; const RowPtrs RP = row_ptrs(F);
    const float* ln2g = INP(I_LN2G) + (l > 0 ? l - 1 : 0) * D; const float* ln2b = INP(I_LN2B) + (l > 0 ? l - 1 : 0) * D;
    const int rpw = rows_per_wave(F.ngw), rbeg = F.gw * rpw, rend = min(M, rbeg + rpw);
    float g2[16]; int cur_mr = -1;
    for (int r0 = rbeg; r0 < rend; r0 += NR) {
        float v[NR][16]; v4u rt[NR]; v2u ya[NR][4], yb[NR][4]; bool act[NR];
        const int b0 = r0 / TT, t0 = r0 - b0 * TT; const bool lat = t0 < SEQ; const int mr = lat ? b0 : 16;
        if (l == NL && !lat) continue;
#pragma unroll
        for (int u = 0; u < NR; ++u) {
            const int r = r0 + u; act[u] = r < rend; const int rc = act[u] ? r : r0;
            if (l == 0) ld16nt(xin_row(RP, rc), lane, v[u]); else ld16h(RP.xs + (size_t)rc * D, lane, v[u]);
            rt[u] = *(const v4u*)(RT + (size_t)rc * 8 + 4);
        }
        if (mr != cur_mr) { if (l > 0) ld16(mods + ((size_t)(l - 1) * 17 + mr) * 6144 + 5120, lane, g2); cur_mr = mr; }
        if (l > 0) {
#pragma unroll
            for (int u = 0; u < NR; ++u) { ld16bf_raw_nt(Y + (size_t)rt[u].z * D, lane, ya[u]); ld16bf_raw_nt(Y + (size_t)rt[u].w * D, lane, yb[u]); }
#pragma unroll
            for (int u = 0; u < NR; ++u) {
                float f0[16], f1[16], gg[16], bb[16];
                const float w0 = __uint_as_float(rt[u].x), w1 = __uint_as_float(rt[u].y);
                unpack16(ya[u], f0); unpack16(yb[u], f1);
#pragma unroll
                for (int i = 0; i < 16; ++i) v[u][i] = ALPHA * v[u][i] + g2[i] * (w0 * f0[i] + w1 * f1[i]);
                ld16(ln2g, lane, gg); ld16(ln2b, lane, bb);
                ln16(v[u]);
#pragma unroll
                for (int i = 0; i < 16; ++i) v[u][i] = v[u][i] * gg[i] + bb[i];
                if (act[u]) { if (l == NL) st16nt(out_row(RP, r0 + u), lane, v[u]); else st16h(RP.xs + (size_t)(r0 + u) * D, lane, v[u]); }
            }
        }
        if (l < NL) {
            float sh[16], sc[16]; ld16(mods + ((size_t)l * 17 + mr) * 6144, lane, sh); ld16(mods + ((size_t)l * 17 + mr) * 6144 + 1024, lane, sc);
#pragma unroll
            for (int u = 0; u < NR; ++u) {
                ln16(v[u]);
#pragma unroll
                for (int i = 0; i < 16; ++i) v[u][i] = v[u][i] * (1.0f + sc[i]) + sh[i];
                if (act[u]) st16bf(HA + (size_t)(r0 + u) * D, lane, v[u]);
            }
        }
    }
}

__device__ __forceinline__ void rope8(float (&f)[8], const float (&p)[8], const float* cs, bool first) {
    const f32x4* c4 = (const f32x4*)cs;
#pragma unroll
    for (int q = 0; q < 4; ++q) { const f32x4 t = c4[q];
        f[2 * q] = first ? f[2 * q] * t.x - p[2 * q] * t.y : p[2 * q] * t.y + f[2 * q] * t.x;
        f[2 * q + 1] = first ? f[2 * q + 1] * t.z - p[2 * q + 1] * t.w : p[2 * q + 1] * t.w + f[2 * q + 1] * t.z; }
}
__device__ __forceinline__ void phase_post(const Frame& F, int l) {
    constexpr int NR = 4;
    bf16* P = (bf16*)(F.ws + WS_PB); bf16* KD = (bf16*)(F.ws + WS_KD);
    const float* t64 = (const float*)(F.ws + WS_T64); const float* t32 = (const float*)(F.ws + WS_T32);
    const int lane = F.lane; const float* gains = (lane < 32 ? INP(I_GQG) : INP(I_GKG)) + l * 64;
    const int j = lane & 7, jj = lane & 3;
    float gn[8];
#pragma unroll
    for (int i = 0; i < 8; ++i) gn[i] = gains[j * 8 + i];
    for (int r0 = F.gw; r0 < M; r0 += NR * F.ngw) {
        v4u w0[NR], w1[NR], w2[NR]; int rr[NR]; bool act[NR];
#pragma unroll
        for (int u = 0; u < NR; ++u) { const int r = r0 + u * F.ngw; act[u] = r < M; rr[u] = act[u] ? r : r0; const bf16* prow = P + (size_t)rr[u] * NPJ;
            w0[u] = *((const v4u*)(prow + 768) + lane); w1[u] = *((const v4u*)(prow + 1280) + lane); w2[u] = *((const v4u*)(prow + 1792) + lane); }
#pragma unroll
        for (int u = 0; u < NR; ++u) {
            const int r = rr[u]; const int b = r / TT, t = r - b * TT; const bool lat = t < SEQ; const int gr = (t >> 6) & 63, gc = t & 63;
            bf16* prow = P + (size_t)r * NPJ;
            const float* cs64 = t64 + ((size_t)((j < 4 ? gr : gc) * 16 + (j & 1) * 8)) * 2;
            {
                float f[8]; unpack8(w0[u], f);
                float ss = 0.f;
#pragma unroll
                for (int i = 0; i < 8; ++i) ss += f[i] * f[i];
                ss += __shfl_xor(ss, 1); ss += __shfl_xor(ss, 2); ss += __shfl_xor(ss, 4);
                const float rs = 1.0f / sqrtf(ss * (1.0f / 64.0f) + EPS);
#pragma unroll
                for (int i = 0; i < 8; ++i) f[i] = f[i] * rs * gn[i];
                float p[8];
#pragma unroll
                for (int i = 0; i < 8; ++i) p[i] = __shfl_xor(f[i], 2);
                if (lat) rope8(f, p, cs64, (j & 2) == 0);
                if (lane < 48 && act[u]) *((v4u*)(prow + 768) + lane) = pack8(f);
            }
            {
                float f[8]; unpack8(w1[u], f);
                float p[8];
#pragma unroll
                for (int i = 0; i < 8; ++i) p[i] = __shfl_xor(f[i], 2);
                rope8(f, p, cs64, (j & 2) == 0);
                if (lat && lane < 48 && act[u]) *((v4u*)(prow + 1280) + lane) = pack8(f);
            }
            {
                float f[8]; unpack8(w2[u], f);
                float ss = 0.f;
#pragma unroll
                for (int i = 0; i < 8; ++i) ss += f[i] * f[i];
                ss += __shfl_xor(ss, 1); ss += __shfl_xor(ss, 2); ss += __shfl_xor(ss, 4); ss += __shfl_xor(ss, 8);
                const float s32 = ss + __shfl_xor(ss, 16);
                const float rn = lane < 32 ? 1.0f / sqrtf(s32 * (1.0f / 256.0f) + EPS) : 1.0f / sqrtf(ss * (1.0f / 128.0f) + EPS);
                if (lane < 48 && act[u]) { float fn[8];
#pragma unroll
                    for (int i = 0; i < 8; ++i) fn[i] = f[i] * rn;
                    *((v4u*)(prow + 1792) + lane) = pack8(fn); }
                float p[8];
#pragma unroll
                for (int i = 0; i < 8; ++i) p[i] = __shfl_xor(f[i], 1);
                if (lat) rope8(f, p, t32 + ((size_t)((jj < 2 ? gr : gc) * 8)) * 2, (jj & 1) == 0);
                if (lane >= 48 && lane < 52 && act[u]) { const v4u o = pack8(f);
#pragma unroll
                    for (int h = 0; h < 4; ++h) *(v4u*)(KD + (size_t)r * 384 + h * 96 + 64 + 8 * jj) = o; }
            }
        }
    }
}

__device__ __forceinline__ void phase_route(const Frame& F, int l) {
    const float* mods = (const float*)(F.ws + WS_MODS); bf16* HA = (bf16*)(F.ws + WS_HA);
    const bf16* MIX = (const bf16*)(F.ws + WS_PB); unsigned* RT = (unsigned*)(F.ws + WS_RT); int* HIST = (int*)(F.ws + WS_HIST);
    LAS float* WR = (LAS float*)F.lds;
    { const float* rgw = INP(I_RGW); const float* rew = INP(I_REW);
      for (int i = F.tid; i < 20 * 1024; i += NTHR) { const int jx = i >> 10, k = i & 1023;
        WR[i] = jx < 4 ? rgw[((size_t)l * D + k) * 4 + jx] : rew[((size_t)l * D + k) * 16 + (jx - 4)]; } }
    if (F.tid < 16) F.MISC[MI_LH + F.tid] = 0u;
    __syncthreads();
    LAS float* bias = (LAS float*)(F.lds + 20 * 1024 * 4);
    if (F.tid < 20) bias[F.tid] = F.tid < 4 ? INP(I_RGB)[l * 4 + F.tid] : INP(I_REB)[l * 16 + (F.tid - 4)];
    __syncthreads();
    const RowPtrs RP = row_ptrs(F); const float* ln1g = INP(I_LN1G) + l * D; const float* ln1b = INP(I_LN1B) + l * D;
    constexpr int NR = 2;
    const int rpw = rows_per_wave(F.ngw), rbeg = F.gw * rpw, rend = min(M, rbeg + rpw);
    float g1[16], sh[16], sc[16]; int cur_mr = -1;
    for (int r0 = rbeg; r0 < rend; r0 += NR) {
        if (l == NL - 1 && (r0 % TT) >= SEQ) continue;
        float v[NR][16], mx[NR][16], gg[16], bb[16]; int rr[NR]; bool act[NR];
#pragma unroll
        for (int u = 0; u < NR; ++u) { const int r = r0 + u; act[u] = r < rend; rr[u] = act[u] ? r : r0;
            if (l == 0) ld16nt(xin_row(RP, rr[u]), F.lane, v[u]); else ld16h(RP.xs + (size_t)rr[u] * D, F.lane, v[u]);
            ld16bf_nt(MIX + (size_t)rr[u] * D, F.lane, mx[u]); }
        ld16(ln1g, F.lane, gg); ld16(ln1b, F.lane, bb);
        { const int b = r0 / TT, t = r0 - b * TT, mr = t < SEQ ? b : 16;
          if (mr != cur_mr) { const float* md = mods + ((size_t)l * 17 + mr) * 6144; ld16(md + 2048, F.lane, g1); ld16(md + 3072, F.lane, sh); ld16(md + 4096, F.lane, sc); cur_mr = mr; } }
#pragma unroll
        for (int u = 0; u < NR; ++u) {
#pragma unroll
            for (int i = 0; i < 16; ++i) v[u][i] = ALPHA * v[u][i] + g1[i] * mx[u][i]; }
#pragma unroll
        for (int u = 0; u < NR; ++u) ln16(v[u]);
#pragma unroll
        for (int u = 0; u < NR; ++u) {
#pragma unroll
            for (int i = 0; i < 16; ++i) v[u][i] = v[u][i] * gg[i] + bb[i];
            if (act[u]) st16h(RP.xs + (size_t)rr[u] * D, F.lane, v[u]); }
#pragma unroll
        for (int u = 0; u < NR; ++u) ln16(v[u]);
#pragma unroll
        for (int u = 0; u < NR; ++u) {
#pragma unroll
            for (int i = 0; i < 16; ++i) v[u][i] = v[u][i] * (1.0f + sc[i]) + sh[i];
            if (act[u]) st16bf(HA + (size_t)rr[u] * D, F.lane, v[u]); }
        float lgt[NR][20];
#pragma unroll
        for (int jx = 0; jx < 20; ++jx) {
            const LAS f32x4* wq = (const LAS f32x4*)(WR + jx * 1024);
            const f32x4 w0 = wq[F.lane], w1 = wq[64 + F.lane], w2 = wq[128 + F.lane], w3 = wq[192 + F.lane];
#pragma unroll
            for (int u = 0; u < NR; ++u) {
                const float sm = (v[u][0] * w0.x + v[u][1] * w0.y) + (v[u][2] * w0.z + v[u][3] * w0.w) + (v[u][4] * w1.x + v[u][5] * w1.y) + (v[u][6] * w1.z + v[u][7] * w1.w)
                               + (v[u][8] * w2.x + v[u][9] * w2.y) + (v[u][10] * w2.z + v[u][11] * w2.w) + (v[u][12] * w3.x + v[u][13] * w3.y) + (v[u][14] * w3.z + v[u][15] * w3.w);
                lgt[u][jx] = sm; }
        }
#pragma unroll
        for (int o = 1; o < 64; o <<= 1)
#pragma unroll
            for (int u = 0; u < NR; ++u)
#pragma unroll
                for (int jx = 0; jx < 20; ++jx) lgt[u][jx] += __shfl_xor(lgt[u][jx], o);
#pragma unroll
        for (int u = 0; u < NR; ++u) {
#pragma unroll
            for (int jx = 0; jx < 20; ++jx) lgt[u][jx] += bias[jx];
            int grp = 0; float mg = lgt[u][0];
#pragma unroll
            for (int g = 1; g < 4; ++g) if (lgt[u][g] > mg) { mg = lgt[u][g]; grp = g; }
            float sg = 0.f;
#pragma unroll
            for (int g = 0; g < 4; ++g) sg += expf(lgt[u][g] - mg);
            const float pg = 1.0f / sg;
            float sel[4];
#pragma unroll
            for (int i = 0; i < 4; ++i) sel[i] = grp == 0 ? lgt[u][4 + i] : grp == 1 ? lgt[u][8 + i] : grp == 2 ? lgt[u][12 + i] : lgt[u][16 + i];
            int i1 = 0; float v1 = sel[0];
#pragma unroll
            for (int i = 1; i < 4; ++i) if (sel[i] > v1) { v1 = sel[i]; i1 = i; }
            int i2 = -1; float v2 = -3.0e38f;
#pragma unroll
            for (int i = 0; i < 4; ++i) if (i != i1 && (i2 < 0 || sel[i] > v2)) { v2 = sel[i]; i2 = i; }
            const float ee = expf(v2 - v1), w1 = pg / (1.0f + ee), w2 = pg * ee / (1.0f + ee);
            const int e1 = grp * 4 + i1, e2 = grp * 4 + i2;
            if (F.lane == 0 && act[u]) {
                const unsigned k1 = __hip_atomic_fetch_add((LAS unsigned*)&F.MISC[MI_LH + e1], 1u, __ATOMIC_RELAXED, __HIP_MEMORY_SCOPE_WORKGROUP);
                const unsigned k2 = __hip_atomic_fetch_add((LAS unsigned*)&F.MISC[MI_LH + e2], 1u, __ATOMIC_RELAXED, __HIP_MEMORY_SCOPE_WORKGROUP);
                v4u ra; ra.x = (unsigned)e1; ra.y = (unsigned)e2; ra.z = k1; ra.w = k2;
                v4u rb; rb.x = __builtin_bit_cast(unsigned, w1); rb.y = __builtin_bit_cast(unsigned, w2); rb.z = 0u; rb.w = 0u;
                *(v4u*)(RT + (size_t)rr[u] * 8) = ra; *(v4u*)(RT + (size_t)rr[u] * 8 + 4) = rb;
            }
        }
    }
    __syncthreads();
    if (F.tid < 16) HIST[F.bid * 16 + F.tid] = (int)F.MISC[MI_LH + F.tid];
}
__device__ __forceinline__ void moe_tables(const Frame& F) {
    const int* HIST = (const int*)(F.ws + WS_HIST); LAS int* hl = (LAS int*)F.lds;
    __syncthreads();
    for (int i = F.tid; i < F.G * 16; i += NTHR) hl[i] = HIST[i];
    __syncthreads();
    if (F.tid < 16) { int tot = 0, mine = 0; for (int g = 0; g < F.G; ++g) { const int c = hl[g * 16 + F.tid]; tot += c; mine += (g < F.bid) ? c : 0; }
        F.MISC[MI_TOT + F.tid] = (unsigned)tot; F.MISC[MI_BASE + F.tid] = (unsigned)mine; }
    __syncthreads();
    if (F.tid == 0) { unsigned p = 0; for (int e = 0; e < 16; ++e) { F.MISC[MI_PST + e] = p; F.MISC[MI_BASE + e] += p * 256u; p += (F.MISC[MI_TOT + e] + 255u) >> 8; } F.MISC[MI_PST + 16] = p; }
    __syncthreads();
}
__device__ __forceinline__ void phase_permute(const Frame& F, int l) {
    unsigned* RT = (unsigned*)(F.ws + WS_RT); int* SRC = (int*)(F.ws + WS_QD);
    moe_tables(F);
    const int rpw = rows_per_wave(F.ngw), rbeg = F.gw * rpw, rend = min(M, rbeg + rpw);
    for (int r = rbeg + F.lane; r < rend; r += 64) {
        if (l == NL - 1 && (r % TT) >= SEQ) continue;
        const v4u ra = *(const v4u*)(RT + (size_t)r * 8);
        const unsigned p0 = F.MISC[MI_BASE + (ra.x & 15u)] + ra.z, p1 = F.MISC[MI_BASE + (ra.y & 15u)] + ra.w;
        RT[(size_t)r * 8 + 6] = p0; RT[(size_t)r * 8 + 7] = p1; SRC[p0] = r; SRC[p1] = r;
    }
    if (F.bid == 0) {
        for (int e = 0; e < 16; ++e) { const int beg = (int)F.MISC[MI_PST + e] * 256 + (int)F.MISC[MI_TOT + e], end = (int)F.MISC[MI_PST + e + 1] * 256;
            for (int p = beg + F.tid; p < end; p += NTHR) SRC[p] = 0; }
    }
}

struct EpiMla {
    static constexpr bool PERM = true, AFTER_DRAIN = false;
    bf16* QD; bf16* KD; bf16* VD;
    __device__ __forceinline__ void operator()(const pg8::f32x4 (&acc)[2][2][4][2], const pg8::Unit& u, int wr, int wc, int fr, int fq) const {
#pragma unroll
        for (int bj = 0; bj < 2; ++bj) {
            const int g0 = u.pn * 256 + bj * 128 + wc * 32, col0 = g0 + 8 * fq;
            if (g0 >= 896) continue;
            const int c = col0 - 384, hd = c >> 7, jx = c & 127;
            bf16* dst = g0 < 384 ? QD + col0 : jx < 64 ? KD + hd * 96 + jx : VD + hd * 64 + (jx - 64);
            const int stride = (g0 < 384 || jx < 64) ? 384 : 256;
            dst += (size_t)(u.pm * 256 + wr * 64 + fr) * stride;
#pragma unroll
            for (int ai = 0; ai < 2; ++ai)
#pragma unroll
                for (int m = 0; m < 4; ++m) {
                    v4u o; o.x = pk2(acc[ai][bj][m][0][0], acc[ai][bj][m][0][1]); o.y = pk2(acc[ai][bj][m][0][2], acc[ai][bj][m][0][3]);
                    o.z = pk2(acc[ai][bj][m][1][0], acc[ai][bj][m][1][1]); o.w = pk2(acc[ai][bj][m][1][2], acc[ai][bj][m][1][3]);
                    *(v4u*)(dst + (size_t)(ai * 128 + m * 16) * stride) = o;
                }
        }
    }
};
struct EpiGU {
    static constexpr bool PERM = true, AFTER_DRAIN = false;
    bf16* ACT;
    __device__ __forceinline__ void operator()(const pg8::f32x4 (&acc)[2][2][4][2], const pg8::Unit& u, int wr, int wc, int fr, int fq) const {
#pragma unroll
        for (int ai = 0; ai < 2; ++ai)
#pragma unroll
            for (int m = 0; m < 4; ++m) {
                const int row = u.pm * 256 + ai * 128 + wr * 64 + m * 16 + fr;
#pragma unroll
                for (int bj = 0; bj < 2; ++bj) {
                    const int c = (u.pn & 3) * 256 + bj * 128 + wc * 32 + 8 * fq;
                    float o[4];
#pragma unroll
                    for (int i = 0; i < 4; ++i) { const float g = acc[ai][bj][m][0][i], up = acc[ai][bj][m][1][i]; o[i] = g / (1.0f + __expf(-g)) * up; }
                    v2u w; w.x = pk2(o[0], o[1]); w.y = pk2(o[2], o[3]);
                    *(v2u*)(ACT + (size_t)row * 512 + (c >> 1)) = w;
                }
            }
    }
};
struct MoeOrder {
    volatile LAS unsigned* pst; int G, c;
    __device__ __forceinline__ bool next(int i, pg8::Unit& u) const {
        const int np = (int)pst[16]; int panel, pn;
        if ((G & 7) == 0) { const int x = c & 7, uu = i * (G >> 3) + (c >> 3); panel = (uu >> 2) * 8 + x; pn = uu & 3; }
        else { const int L = i * G + c; panel = L >> 2; pn = L & 3; }
        if (panel >= np) return false;
        int e = 0;
#pragma unroll
        for (int k = 1; k < 16; ++k) e += (panel >= (int)pst[k]) ? 1 : 0;
        u.pm = __builtin_amdgcn_readfirstlane(panel); u.pn = __builtin_amdgcn_readfirstlane(e * 4 + pn); return true;
    }
    __device__ __forceinline__ void a_ready(const pg8::Unit&) const {}
    __device__ __forceinline__ void done(const pg8::Unit&) const {}
};

struct LatOrder {
    int G, c;
    __device__ __forceinline__ bool next(int i, pg8::Unit& u) const {
        int pl, pn;
        if ((G & 7) == 0) { const int x = c & 7, uu = i * (G >> 3) + (c >> 3); pl = (uu >> 2) * 8 + x; pn = uu & 3; } else { const int L = i * G + c; pl = L >> 2; pn = L & 3; }
        if (pl >= NB * 16) return false;
        u.pm = pl + (pl >> 4); u.pn = pn; return true;
    }
    __device__ __forceinline__ void a_ready(const pg8::Unit&) const {}
    __device__ __forceinline__ void done(const pg8::Unit&) const {}
};

#ifndef DBG_VAR
#define DBG_VAR 1
#endif
namespace att {
constexpr int VRS = 192, KBUF = 64 * 208, VBUF = 64 * VRS, BUF = KBUF + VBUF, BIAS_OFF = 4 * BUF;
constexpr float NEG = -30000.0f;
__device__ __forceinline__ int crow(int r, int hi) { return (r & 3) + 8 * (r >> 2) + 4 * hi; }
__device__ __forceinline__ float xhalf_max(float v) { const unsigned a = __builtin_bit_cast(unsigned, v);
    auto rr = __builtin_amdgcn_permlane32_swap(a, a, false, false); const unsigned r0 = rr[0], r1 = rr[1]; return fmaxf(__uint_as_float(r0), __uint_as_float(r1)); }
__device__ __forceinline__ float xhalf_sum(float v) { const unsigned a = __builtin_bit_cast(unsigned, v);
    auto rr = __builtin_amdgcn_permlane32_swap(a, a, false, false); const unsigned r0 = rr[0], r1 = rr[1]; return __uint_as_float(r0) + __uint_as_float(r1); }
__device__ __forceinline__ float max3f(float a, float b, float c) { float r; asm("v_max3_f32 %0, %1, %2, %3" : "=v"(r) : "v"(a), "v"(b), "v"(c)); return r; }
typedef __bf16 bf16x2_t __attribute__((ext_vector_type(2)));
__device__ __forceinline__ unsigned cvtpk(float lo, float hi) { f32x2 v = {lo, hi}; bf16x2_t b = __builtin_convertvector(v, bf16x2_t); return __builtin_bit_cast(unsigned, b); }

template <int DK, int VM = 0>
__device__ __forceinline__ void unit(LAS unsigned char* lds, const bf16* Qp, int qpitch, const bf16* Kp, int kpitch, const bf16* Vp, int vpitch, bf16* Op,
                                     int var, int qt, int lo, int n1, int nt, float qscale, float sinkl2, bool has_sink, const LAS float* bias, const float* t32, unsigned* dbg) {
    constexpr int KRS = DK * 2 + 16, NS = DK / 16, CPK = DK / 8;
    int tid = threadIdx.x; asm volatile("" : "+v"(tid)); const int lane = tid & 63, r32 = lane & 31, hi = lane >> 5, wid = __builtin_amdgcn_readfirstlane(tid >> 6);
    const int qrow = 256 * qt + 32 * wid + r32;
    bf16x8 qr[NS];
#pragma unroll
    for (int s = 0; s < NS; ++s) { const v4u raw = *(const v4u*)(Qp + (size_t)qrow * qpitch + 16 * s + 8 * hi); float f[8]; unpack8(raw, f);
#pragma unroll
        for (int i = 0; i < 8; ++i) f[i] *= qscale;
        if (DK == 96 && s >= 4) {
            float p[8];
#pragma unroll
            for (int i = 0; i < 8; ++i) p[i] = __shfl_xor(f[i], 32);
            if (qt < 16) rope8(f, p, t32 + ((size_t)((s == 4 ? (qrow >> 6) : (qrow & 63)) * 8)) * 2, hi == 0);
        }
        qr[s] = __builtin_bit_cast(bf16x8, pack8(f)); }
    const int kkey0 = tid / CPK, kch0 = tid - kkey0 * CPK, kkey1 = (tid + 512) / CPK, kch1 = (tid + 512) - kkey1 * CPK;
    const int vkey = tid >> 3, vch = tid & 7;
    v4u kreg0, kreg1 = {0u, 0u, 0u, 0u}, vreg;
#define ATT_TROW(j) ((((j) < n1) ? (lo + (j)) : (64 + (j) - n1)) * 64)
#define ATT_LOAD(j) do { const int tr_ = ATT_TROW(j); kreg0 = *(const v4u*)(Kp + (size_t)(tr_ + kkey0) * kpitch + kch0 * 8); \
        if (DK == 96 && tid < 256) kreg1 = *(const v4u*)(Kp + (size_t)(tr_ + kkey1) * kpitch + kch1 * 8); \
        vreg = *(const v4u*)(Vp + (size_t)(tr_ + vkey) * vpitch + vch * 8); } while (0)
#define ATT_STORE(bf) do { LAS unsigned char* b_ = lds + (bf) * BUF; *(LAS v4u*)(b_ + kkey0 * KRS + kch0 * 16) = kreg0; \
        if (DK == 96 && tid < 256) *(LAS v4u*)(b_ + kkey1 * KRS + kch1 * 16) = kreg1; \
        *(LAS v4u*)(b_ + KBUF + vkey * VRS + vch * 16) = vreg; } while (0)
    constexpr float THR = 6.0f;
    float m = 0.f; f32x2 lacc = {0.f, 0.f}; f32x16 o0 = {}, o1 = {}; f32x16 negm = {}; bool first = true;
    const int grw = 4 * qt + (wid >> 1), r0w = min(max(grw - 4, 0), 56), gc = (wid & 1) * 32 + r32, c0 = min(max(gc - 8, 0), 48), i0w = 256 * qt + 32 * wid;
    ATT_LOAD(0); ATT_STORE(0);
    __syncthreads();
    for (int j = 0; j < nt; ++j) {
        if (!(VM & 8) && j + 1 < nt) ATT_LOAD(j + 1);
        const int kt = ATT_TROW(j) >> 6;
        bool actv = true;
        if (kt < 64) { if (var == 0) actv = (kt >= r0w) && (kt <= r0w + 7); else if (var == 2) actv = !((64 * kt - (i0w + 31) > 128) || (i0w - (64 * kt + 63) > 128)); }
        if (actv) {
            const LAS unsigned char* Kb = lds + (j & 1) * BUF; const LAS unsigned char* Vb = Kb + KBUF;
            f32x16 s0 = negm, s1 = negm;
            bf16x8 ka[NS], kb[NS];
#pragma unroll
            for (int s = 0; s < NS; ++s) { ka[s] = *(const LAS bf16x8*)(Kb + r32 * KRS + (16 * s + 8 * hi) * 2); kb[s] = *(const LAS bf16x8*)(Kb + (32 + r32) * KRS + (16 * s + 8 * hi) * 2); }
            __builtin_amdgcn_sched_barrier(0);
            if (VM & 2) {
#pragma unroll
                for (int s = 0; s < NS; ++s) asm volatile("" :: "v"(ka[s]), "v"(kb[s]), "v"(qr[s]));
            } else {
#pragma unroll
            for (int s = 0; s < NS; ++s) { s0 = __builtin_amdgcn_mfma_f32_32x32x16_bf16(ka[s], qr[s], s0, 0, 0, 0); s1 = __builtin_amdgcn_mfma_f32_32x32x16_bf16(kb[s], qr[s], s1, 0, 0, 0); }
            }
            asm volatile("s_nop 15\n\ts_nop 7" : "+v"(s0), "+v"(s1));
            if (kt < 64 && var == 0) {
                const int rowoff = (kt - grw + 7) * 31 - gc + 15;
#pragma unroll
                for (int r = 0; r < 16; ++r) { const int j0 = crow(r, hi), j1 = j0 + 32;
                    const bool v0 = (unsigned)(j0 - c0) < 16u, v1 = (unsigned)(j1 - c0) < 16u;
                    const float b0 = bias[v0 ? rowoff + j0 : 0], b1 = bias[v1 ? rowoff + j1 : 0];
                    s0[r] = v0 ? s0[r] + b0 : NEG; s1[r] = v1 ? s1[r] + b1 : NEG; }
            } else if (kt < 64 && var == 2) {
                const int dbase = 64 * kt - qrow + 128;
#pragma unroll
                for (int r = 0; r < 16; ++r) { const int j0 = crow(r, hi);
                    s0[r] = (unsigned)(dbase + j0) <= 256u ? s0[r] : NEG; s1[r] = (unsigned)(dbase + j0 + 32) <= 256u ? s1[r] : NEG; }
            }
            if (!(VM & 4)) {
            float mxa = max3f(s0[0], s0[1], s1[0]), mxb = max3f(s0[2], s0[3], s1[1]); mxa = max3f(mxa, s1[2], s1[3]);
#pragma unroll
            for (int r = 4; r < 16; r += 4) { mxa = max3f(mxa, s0[r], s0[r + 1]); mxb = max3f(mxb, s0[r + 2], s0[r + 3]); mxa = max3f(mxa, s1[r], s1[r + 1]); mxb = max3f(mxb, s1[r + 2], s1[r + 3]); }
            const float mx = xhalf_max(fmaxf(mxa, mxb));
            if (first || __any(mx > THR)) {
                const float d = first ? fmaxf(mx, -64.0f) : fmaxf(mx, 0.f), alpha = __builtin_amdgcn_exp2f(-d);
                m += d; first = false;
#pragma unroll
                for (int r = 0; r < 16; ++r) { s0[r] -= d; s1[r] -= d; o0[r] *= alpha; o1[r] *= alpha; negm[r] = -m; }
                lacc *= alpha;
            }
#pragma unroll
            for (int r = 0; r < 16; ++r) { s0[r] = __builtin_amdgcn_exp2f(s0[r]); s1[r] = __builtin_amdgcn_exp2f(s1[r]); lacc += (f32x2){s0[r], s1[r]}; }
            }
            bf16x8 pb[4];
#pragma unroll
            for (int s = 0; s < 2; ++s) {
                v4u w; w.x = cvtpk(s0[8 * s], s0[8 * s + 1]); w.y = cvtpk(s0[8 * s + 2], s0[8 * s + 3]); w.z = cvtpk(s0[8 * s + 4], s0[8 * s + 5]); w.w = cvtpk(s0[8 * s + 6], s0[8 * s + 7]);
                pb[s] = __builtin_bit_cast(bf16x8, w);
                v4u x; x.x = cvtpk(s1[8 * s], s1[8 * s + 1]); x.y = cvtpk(s1[8 * s + 2], s1[8 * s + 3]); x.z = cvtpk(s1[8 * s + 4], s1[8 * s + 5]); x.w = cvtpk(s1[8 * s + 6], s1[8 * s + 7]);
                pb[2 + s] = __builtin_bit_cast(bf16x8, x);
            }
            if (VM & 1) { asm volatile("" :: "v"(pb[0]), "v"(pb[1]), "v"(pb[2]), "v"(pb[3])); } else {
            const LAS unsigned char* vbase = Vb + (4 * hi + ((lane & 15) >> 2)) * VRS + ((lane >> 4) & 1) * 32 + (lane & 3) * 8;
#pragma unroll
            for (int s = 0; s < 4; ++s) {
                const v4i16 a0 = __builtin_amdgcn_ds_read_tr16_b64_v4i16((LAS v4i16*)(vbase + (16 * s) * VRS));
                const v4i16 a1 = __builtin_amdgcn_ds_read_tr16_b64_v4i16((LAS v4i16*)(vbase + (16 * s + 8) * VRS));
                const v4i16 c0_ = __builtin_amdgcn_ds_read_tr16_b64_v4i16((LAS v4i16*)(vbase + (16 * s) * VRS + 64));
                const v4i16 c1_ = __builtin_amdgcn_ds_read_tr16_b64_v4i16((LAS v4i16*)(vbase + (16 * s + 8) * VRS + 64));
                const bf16x8 va = {a0[0], a0[1], a0[2], a0[3], a1[0], a1[1], a1[2], a1[3]};
                const bf16x8 vc = {c0_[0], c0_[1], c0_[2], c0_[3], c1_[0], c1_[1], c1_[2], c1_[3]};
                o0 = __builtin_amdgcn_mfma_f32_32x32x16_bf16(va, pb[s], o0, 0, 0, 0);
                o1 = __builtin_amdgcn_mfma_f32_32x32x16_bf16(vc, pb[s], o1, 0, 0, 0);
            }
            }
        }
        if (!(VM & 8) && j + 1 < nt) ATT_STORE((j + 1) & 1);
        if (!(VM & 16)) __syncthreads();
    }
    float l = xhalf_sum(lacc.x + lacc.y);
    const float sterm = has_sink ? __builtin_amdgcn_exp2f(sinkl2 - m) : 0.f;
#if MK_DEBUG
    if (dbg && hi == 0) { dbg[(size_t)qrow * 2] = __builtin_bit_cast(unsigned, m); dbg[(size_t)qrow * 2 + 1] = __builtin_bit_cast(unsigned, l); }
#endif
    if (has_sink) l += sterm;
    const float inv = 1.0f / l;
    bf16* orow = Op + (size_t)qrow * D;
#pragma unroll
    for (int g = 0; g < 4; ++g) {
        v2u w0; w0.x = pk2(o0[4 * g] * inv, o0[4 * g + 1] * inv); w0.y = pk2(o0[4 * g + 2] * inv, o0[4 * g + 3] * inv);
        v2u w1; w1.x = pk2(o1[4 * g] * inv, o1[4 * g + 1] * inv); w1.y = pk2(o1[4 * g + 2] * inv, o1[4 * g + 3] * inv);
        *(v2u*)(orow + 8 * g + 4 * hi) = w0; *(v2u*)(orow + 32 + 8 * g + 4 * hi) = w1;
    }
#undef ATT_TROW
#undef ATT_LOAD
#undef ATT_STORE
}

template <int DK, int MODE, int VM = 0, bool NOREF = false>
__device__ __forceinline__ void unit2(LAS unsigned char* lds, const bf16* Qp, int qpitch, const bf16* Kp, int kpitch, const bf16* Vp, int vpitch, bf16* Op,
                                      int var, int qt, int lo, int n1, int nt, float qscale, float sink0, float sink1, bool has_sink, const LAS float* bias, const float* t32) {
    constexpr int KRS = DK * 2 + 16, NS = DK / 16, CPK = DK / 8;
    int tid = threadIdx.x; asm volatile("" : "+v"(tid)); const int lane = tid & 63, r32 = lane & 31, hi = lane >> 5, wid = __builtin_amdgcn_readfirstlane(tid >> 6);
    const int rowbase = MODE == 0 ? 512 * qt + 64 * wid : 256 * qt + 32 * wid;
    bf16x8 qr[2][NS];
#pragma unroll
    for (int u = 0; u < 2; ++u) {
        const int qrow = rowbase + (MODE == 0 ? 32 * u : 0) + r32;
        const bf16* qp = Qp + (MODE == 1 ? 64 * u : 0) + (size_t)qrow * qpitch;
#pragma unroll
        for (int s = 0; s < NS; ++s) { const v4u raw = *(const v4u*)(qp + 16 * s + 8 * hi); float f[8]; unpack8(raw, f);
#pragma unroll
            for (int i = 0; i < 8; ++i) f[i] *= qscale;
            if (DK == 96 && s >= 4) { float p[8];
#pragma unroll
                for (int i = 0; i < 8; ++i) p[i] = __shfl_xor(f[i], 32);
                rope8(f, p, t32 + ((size_t)((s == 4 ? (qrow >> 6) : (qrow & 63)) * 8)) * 2, hi == 0); }
            qr[u][s] = __builtin_bit_cast(bf16x8, pack8(f)); }
    }
    const int kkey0 = tid / CPK, kch0 = tid - kkey0 * CPK, kkey1 = (tid + 512) / CPK, kch1 = (tid + 512) - kkey1 * CPK;
    const int vkey = tid >> 3, vch = tid & 7;
    v4u kreg0, kreg1 = {0u, 0u, 0u, 0u}, vreg;
#define ATT_TROW(j) ((((j) < n1) ? (lo + (j)) : (64 + (j) - n1)) * 64)
#define ATT_LOAD(j) do { const int tr_ = ATT_TROW(j); kreg0 = *(const v4u*)(Kp + (size_t)(tr_ + kkey0) * kpitch + kch0 * 8); \
        if (DK == 96 && tid < 256) kreg1 = *(const v4u*)(Kp + (size_t)(tr_ + kkey1) * kpitch + kch1 * 8); \
        vreg = *(const v4u*)(Vp + (size_t)(tr_ + vkey) * vpitch + vch * 8); } while (0)
#define ATT_STORE(bf) do { LAS unsigned char* b_ = lds + (bf) * BUF; *(LAS v4u*)(b_ + kkey0 * KRS + kch0 * 16) = kreg0; \
        if (DK == 96 && tid < 256) *(LAS v4u*)(b_ + kkey1 * KRS + kch1 * 16) = kreg1; \
        *(LAS v4u*)(b_ + KBUF + vkey * VRS + vch * 16) = vreg; } while (0)
    constexpr float THR = 6.0f;
    float m = 0.f; f32x2 lacc[2] = {{0.f, 0.f}, {0.f, 0.f}}; f32x16 o0[2] = {{}, {}}, o1[2] = {{}, {}}; bool first = true;
    const int grw = 8 * qt + wid, r0w = min(max(grw - 4, 0), 56), i0w = rowbase;
    ATT_LOAD(0); ATT_STORE(0);
    __syncthreads();
    for (int j = 0; j < nt; ++j) {
        if (!(VM & 8) && j + 1 < nt) ATT_LOAD(j + 1);
        const int kt = ATT_TROW(j) >> 6;
        bool actv = true;
        if (kt < 64) { if (var == 0) actv = (kt >= r0w) && (kt <= r0w + 7); else if (var == 2) actv = !((64 * kt - (i0w + 31) > 128) || (i0w - (64 * kt + 63) > 128)); }
        if (actv) {
            const LAS unsigned char* Kb = lds + (j & 1) * BUF; const LAS unsigned char* Vb = Kb + KBUF;
            f32x16 s0[2] = {{}, {}}, s1[2] = {{}, {}};
#pragma unroll
            for (int s = 0; s < NS; ++s) {
                const bf16x8 ka = *(const LAS bf16x8*)(Kb + r32 * KRS + (16 * s + 8 * hi) * 2);
                const bf16x8 kb = *(const LAS bf16x8*)(Kb + (32 + r32) * KRS + (16 * s + 8 * hi) * 2);
                if (VM & 2) { asm volatile("" :: "v"(ka), "v"(kb), "v"(qr[0][s]), "v"(qr[1][s])); } else {
#pragma unroll
                for (int u = 0; u < 2; ++u) { s0[u] = __builtin_amdgcn_mfma_f32_32x32x16_bf16(ka, qr[u][s], s0[u], 0, 0, 0); s1[u] = __builtin_amdgcn_mfma_f32_32x32x16_bf16(kb, qr[u][s], s1[u], 0, 0, 0); }
                }
            }
            asm volatile("s_nop 15\n\ts_nop 7" : "+v"(s0[0]), "+v"(s1[0]), "+v"(s0[1]), "+v"(s1[1]));
            if (kt < 64 && var == 0) {
#pragma unroll
                for (int u = 0; u < 2; ++u) { const int gc = 32 * u + r32, c0 = min(max(gc - 8, 0), 48), rowoff = (kt - grw + 7) * 31 - gc + 15;
#pragma unroll
                    for (int r = 0; r < 16; ++r) { const int j0 = crow(r, hi), j1 = j0 + 32;
                        const bool v0 = (unsigned)(j0 - c0) < 16u, v1 = (unsigned)(j1 - c0) < 16u;
                        const float b0 = bias[v0 ? rowoff + j0 : 0], b1 = bias[v1 ? rowoff + j1 : 0];
                        s0[u][r] = v0 ? s0[u][r] + b0 : NEG; s1[u][r] = v1 ? s1[u][r] + b1 : NEG; } }
            } else if (kt < 64 && var == 2) {
                const int dbase = 64 * kt - (rowbase + r32) + 128;
#pragma unroll
                for (int r = 0; r < 16; ++r) { const int j0 = crow(r, hi); const bool v0 = (unsigned)(dbase + j0) <= 256u, v1 = (unsigned)(dbase + j0 + 32) <= 256u;
                    s0[0][r] = v0 ? s0[0][r] : NEG; s1[0][r] = v1 ? s1[0][r] : NEG; s0[1][r] = v0 ? s0[1][r] : NEG; s1[1][r] = v1 ? s1[1][r] : NEG; }
            }
            if (!(VM & 4)) {
            if (!NOREF) {
            float mxa = max3f(s0[0][0], s0[0][1], s1[0][0]), mxb = max3f(s0[1][0], s0[1][1], s1[1][0]);
#pragma unroll
            for (int r = 0; r < 16; r += 2) { if (r) { mxa = max3f(mxa, s0[0][r], s0[0][r + 1]); mxb = max3f(mxb, s0[1][r], s0[1][r + 1]); }
                if (r) { mxa = max3f(mxa, s1[0][r], s1[0][r + 1]); mxb = max3f(mxb, s1[1][r], s1[1][r + 1]); } else { mxa = fmaxf(mxa, s1[0][1]); mxb = fmaxf(mxb, s1[1][1]); } }
            const float mx = xhalf_max(fmaxf(mxa, mxb)) - m;
            if (first || __any(mx > THR)) {
                const float d = first ? fmaxf(mx, -64.0f) : fmaxf(mx, 0.f), alpha = __builtin_amdgcn_exp2f(-d);
                m += d; first = false;
#pragma unroll
                for (int u = 0; u < 2; ++u) {
#pragma unroll
                    for (int r = 0; r < 16; ++r) { o0[u][r] *= alpha; o1[u][r] *= alpha; }
                    lacc[u] *= alpha; }
            }
            }
            }
            bf16x8 pb[2][4];
#pragma unroll
            for (int u = 0; u < 2; ++u) {
                if (!(VM & 4))
#pragma unroll
                for (int r = 0; r < 16; ++r) { s0[u][r] = __builtin_amdgcn_exp2f(NOREF ? s0[u][r] : s0[u][r] - m); s1[u][r] = __builtin_amdgcn_exp2f(NOREF ? s1[u][r] : s1[u][r] - m); lacc[u] += (f32x2){s0[u][r], s1[u][r]}; }
#pragma unroll
                for (int s = 0; s < 2; ++s) {
                    v4u w; w.x = cvtpk(s0[u][8 * s], s0[u][8 * s + 1]); w.y = cvtpk(s0[u][8 * s + 2], s0[u][8 * s + 3]); w.z = cvtpk(s0[u][8 * s + 4], s0[u][8 * s + 5]); w.w = cvtpk(s0[u][8 * s + 6], s0[u][8 * s + 7]);
                    pb[u][s] = __builtin_bit_cast(bf16x8, w);
                    v4u x; x.x = cvtpk(s1[u][8 * s], s1[u][8 * s + 1]); x.y = cvtpk(s1[u][8 * s + 2], s1[u][8 * s + 3]); x.z = cvtpk(s1[u][8 * s + 4], s1[u][8 * s + 5]); x.w = cvtpk(s1[u][8 * s + 6], s1[u][8 * s + 7]);
                    pb[u][2 + s] = __builtin_bit_cast(bf16x8, x);
                }
            }
            if (VM & 1) { asm volatile("" :: "v"(pb[0][0]), "v"(pb[0][1]), "v"(pb[0][2]), "v"(pb[0][3]), "v"(pb[1][0]), "v"(pb[1][1]), "v"(pb[1][2]), "v"(pb[1][3])); } else {
            const LAS unsigned char* vbase = Vb + (4 * hi + ((lane & 15) >> 2)) * VRS + ((lane >> 4) & 1) * 32 + (lane & 3) * 8;
#pragma unroll
            for (int s = 0; s < 4; ++s) {
                const v4i16 a0 = __builtin_amdgcn_ds_read_tr16_b64_v4i16((LAS v4i16*)(vbase + (16 * s) * VRS));
                const v4i16 a1 = __builtin_amdgcn_ds_read_tr16_b64_v4i16((LAS v4i16*)(vbase + (16 * s + 8) * VRS));
                const v4i16 c0_ = __builtin_amdgcn_ds_read_tr16_b64_v4i16((LAS v4i16*)(vbase + (16 * s) * VRS + 64));
                const v4i16 c1_ = __builtin_amdgcn_ds_read_tr16_b64_v4i16((LAS v4i16*)(vbase + (16 * s + 8) * VRS + 64));
                const bf16x8 va = {a0[0], a0[1], a0[2], a0[3], a1[0], a1[1], a1[2], a1[3]};
                const bf16x8 vc = {c0_[0], c0_[1], c0_[2], c0_[3], c1_[0], c1_[1], c1_[2], c1_[3]};
#pragma unroll
                for (int u = 0; u < 2; ++u) { o0[u] = __builtin_amdgcn_mfma_f32_32x32x16_bf16(va, pb[u][s], o0[u], 0, 0, 0); o1[u] = __builtin_amdgcn_mfma_f32_32x32x16_bf16(vc, pb[u][s], o1[u], 0, 0, 0); }
            }
            }
        }
        if (!(VM & 8) && j + 1 < nt) ATT_STORE((j + 1) & 1);
        if (!(VM & 16)) __syncthreads();
    }
#pragma unroll
    for (int u = 0; u < 2; ++u) {
        float l = xhalf_sum(lacc[u].x + lacc[u].y);
        if (has_sink) l += __builtin_amdgcn_exp2f((u == 0 ? sink0 : sink1) - m);
        const float inv = 1.0f / l;
        const int qrow = rowbase + (MODE == 0 ? 32 * u : 0) + r32;
        bf16* orow = Op + (MODE == 1 ? 64 * u : 0) + (size_t)qrow * D;
#pragma unroll
        for (int g = 0; g < 4; ++g) {
            v2u w0; w0.x = pk2(o0[u][4 * g] * inv, o0[u][4 * g + 1] * inv); w0.y = pk2(o0[u][4 * g + 2] * inv, o0[u][4 * g + 3] * inv);
            v2u w1; w1.x = pk2(o1[u][4 * g] * inv, o1[u][4 * g + 1] * inv); w1.y = pk2(o1[u][4 * g + 2] * inv, o1[u][4 * g + 3] * inv);
            *(v2u*)(orow + 8 * g + 4 * hi) = w0; *(v2u*)(orow + 32 + 8 * g + 4 * hi) = w1;
        }
    }
#undef ATT_TROW
#undef ATT_LOAD
#undef ATT_STORE
}

template <int VM = 0>
__device__ __forceinline__ bool unit_d2(LAS unsigned char* lds, const bf16* Qp, const bf16* Kp, const bf16* Vp, bf16* Op, int qt, float qscale, const float* t32, volatile LAS unsigned* flag) {
    constexpr int DK = 96, KRS = DK * 2 + 16, NS = 6, CPK = 12, nt = 68;
    int tid = threadIdx.x; asm volatile("" : "+v"(tid)); const int lane = tid & 63, r32 = lane & 31, hi = lane >> 5, wid = __builtin_amdgcn_readfirstlane(tid >> 6);
    const int rowbase = 512 * qt + 64 * wid;
    bf16x8 qr[2][NS];
#pragma unroll
    for (int u = 0; u < 2; ++u) {
        const int qrow = rowbase + 32 * u + r32;
        const bf16* qp = Qp + (size_t)qrow * 384;
#pragma unroll
        for (int s = 0; s < NS; ++s) { const v4u raw = *(const v4u*)(qp + 16 * s + 8 * hi); float f[8]; unpack8(raw, f);
#pragma unroll
            for (int i = 0; i < 8; ++i) f[i] *= qscale;
            if (s >= 4) { float p[8];
#pragma unroll
                for (int i = 0; i < 8; ++i) p[i] = __shfl_xor(f[i], 32);
                rope8(f, p, t32 + ((size_t)((s == 4 ? (qrow >> 6) : (qrow & 63)) * 8)) * 2, hi == 0); }
            qr[u][s] = __builtin_bit_cast(bf16x8, pack8(f)); }
    }
    const int kkey0 = tid / CPK, kch0 = tid - kkey0 * CPK, kkey1 = (tid + 512) / CPK, kch1 = (tid + 512) - kkey1 * CPK;
    const int vkey = tid >> 3, vch = tid & 7;
    v4u kreg0, kreg1 = {0u, 0u, 0u, 0u}, vreg;
#define D2_LOAD(j) do { const int tr_ = (j) * 64; kreg0 = *(const v4u*)(Kp + (size_t)(tr_ + kkey0) * 384 + kch0 * 8); \
        if (tid < 256) kreg1 = *(const v4u*)(Kp + (size_t)(tr_ + kkey1) * 384 + kch1 * 8); \
        vreg = *(const v4u*)(Vp + (size_t)(tr_ + vkey) * 256 + vch * 8); } while (0)
#define D2_STORE(bf) do { LAS unsigned char* b_ = lds + (bf) * BUF; *(LAS v4u*)(b_ + kkey0 * KRS + kch0 * 16) = kreg0; \
        if (tid < 256) *(LAS v4u*)(b_ + kkey1 * KRS + kch1 * 16) = kreg1; \
        *(LAS v4u*)(b_ + KBUF + vkey * VRS + vch * 16) = vreg; } while (0)
    f32x2 lacc[2] = {{0.f, 0.f}, {0.f, 0.f}}; f32x16 o0[2] = {{}, {}}, o1[2] = {{}, {}};
    D2_LOAD(0); D2_STORE(0);
    if (tid == 0) *flag = 0u;
    __syncthreads();
    for (int j = 0; j < nt; ++j) {
        if (!(VM & 8) && j + 1 < nt) D2_LOAD(j + 1);
        const LAS unsigned char* Kb = lds + (j & 1) * BUF; const LAS unsigned char* Vb = Kb + KBUF;
        const LAS unsigned char* vbase = Vb + (4 * hi + ((lane & 15) >> 2)) * VRS + ((lane >> 4) & 1) * 32 + (lane & 3) * 8;
#pragma unroll
        for (int hf = 0; hf < 2; ++hf) {
            f32x16 sc[2] = {{}, {}};
#pragma unroll
            for (int s = 0; s < NS; ++s) {
                const bf16x8 kf = *(const LAS bf16x8*)(Kb + (32 * hf + r32) * KRS + (16 * s + 8 * hi) * 2);
#pragma unroll
                for (int u = 0; u < 2; ++u) sc[u] = __builtin_amdgcn_mfma_f32_32x32x16_bf16(kf, qr[u][s], sc[u], 0, 0, 0);
            }
            bf16x8 pb[2][2];
#pragma unroll
            for (int u = 0; u < 2; ++u) {
#pragma unroll
                for (int r = 0; r < 16; r += 2) { sc[u][r] = __builtin_amdgcn_exp2f(sc[u][r]); sc[u][r + 1] = __builtin_amdgcn_exp2f(sc[u][r + 1]); lacc[u] += (f32x2){sc[u][r], sc[u][r + 1]}; }
#pragma unroll
                for (int s = 0; s < 2; ++s) {
                    v4u w; w.x = cvtpk(sc[u][8 * s], sc[u][8 * s + 1]); w.y = cvtpk(sc[u][8 * s + 2], sc[u][8 * s + 3]); w.z = cvtpk(sc[u][8 * s + 4], sc[u][8 * s + 5]); w.w = cvtpk(sc[u][8 * s + 6], sc[u][8 * s + 7]);
                    pb[u][s] = __builtin_bit_cast(bf16x8, w);
                }
            }
#pragma unroll
            for (int s2 = 0; s2 < 2; ++s2) { const int s = 2 * hf + s2;
                const v4i16 a0 = __builtin_amdgcn_ds_read_tr16_b64_v4i16((LAS v4i16*)(vbase + (16 * s) * VRS));
                const v4i16 a1 = __builtin_amdgcn_ds_read_tr16_b64_v4i16((LAS v4i16*)(vbase + (16 * s + 8) * VRS));
                const v4i16 c0_ = __builtin_amdgcn_ds_read_tr16_b64_v4i16((LAS v4i16*)(vbase + (16 * s) * VRS + 64));
                const v4i16 c1_ = __builtin_amdgcn_ds_read_tr16_b64_v4i16((LAS v4i16*)(vbase + (16 * s + 8) * VRS + 64));
                const bf16x8 va = {a0[0], a0[1], a0[2], a0[3], a1[0], a1[1], a1[2], a1[3]};
                const bf16x8 vc = {c0_[0], c0_[1], c0_[2], c0_[3], c1_[0], c1_[1], c1_[2], c1_[3]};
#pragma unroll
                for (int u = 0; u < 2; ++u) { o0[u] = __builtin_amdgcn_mfma_f32_32x32x16_bf16(va, pb[u][s2], o0[u], 0, 0, 0); o1[u] = __builtin_amdgcn_mfma_f32_32x32x16_bf16(vc, pb[u][s2], o1[u], 0, 0, 0); }
            }
            __builtin_amdgcn_sched_barrier(0);
        }
        if (!(VM & 8) && j + 1 < nt) D2_STORE((j + 1) & 1);
        __syncthreads();
    }
    float lsum[2]; bool bad = false;
#pragma unroll
    for (int u = 0; u < 2; ++u) { lsum[u] = xhalf_sum(lacc[u].x + lacc[u].y); bad = bad || !(lsum[u] > 8.6736174e-19f && lsum[u] < 1.1529215e18f); }
    if (__any(bad)) { if (lane == 0) *flag = 1u; }
#pragma unroll
    for (int u = 0; u < 2; ++u) {
        const float inv = 1.0f / lsum[u];
        bf16* orow = Op + (size_t)(rowbase + 32 * u + r32) * D;
#pragma unroll
        for (int g = 0; g < 4; ++g) {
            v2u w0; w0.x = pk2(o0[u][4 * g] * inv, o0[u][4 * g + 1] * inv); w0.y = pk2(o0[u][4 * g + 2] * inv, o0[u][4 * g + 3] * inv);
            v2u w1; w1.x = pk2(o1[u][4 * g] * inv, o1[u][4 * g + 1] * inv); w1.y = pk2(o1[u][4 * g + 2] * inv, o1[u][4 * g + 3] * inv);
            *(v2u*)(orow + 8 * g + 4 * hi) = w0; *(v2u*)(orow + 32 + 8 * g + 4 * hi) = w1;
        }
    }
    __syncthreads();
    return *flag == 0u;
#undef D2_LOAD
#undef D2_STORE
}
}

template <int VM = 0>
__device__ __forceinline__ void phase_attn(const Frame& F, int lq) {
    const int l = lq & 3;
    const bf16* P = (const bf16*)(F.ws + WS_PB); const bf16* QD = (const bf16*)(F.ws + WS_QD); const bf16* KD = (const bf16*)(F.ws + WS_KD);
    const bf16* VD = (const bf16*)(F.ws + WS_VD); bf16* O = (bf16*)(F.ws + (lq >= 4 ? WS_ACT : WS_HA));
    unsigned* ctr = (unsigned*)(F.ws + WS_CTL) + CW_QUEUE + 64 * 8 * lq;
    LAS float* bias = (LAS float*)(F.lds + att::BIAS_OFF);
    { const float* nab = INP(I_NABIAS) + l * 4 * 465; for (int i = F.tid; i < 4 * 465; i += NTHR) bias[i] = nab[i] * LOG2E; }
    const float* sinks = INP(I_SINK) + l * 4;
    __syncthreads();
    const float* t32 = (const float*)(F.ws + WS_T32);
    bool b_bounded;
    { float gq = fabsf(INP(I_GQG)[l * 64 + F.lane]), gk = fabsf(INP(I_GKG)[l * 64 + F.lane]);
#pragma unroll
      for (int o = 1; o < 64; o <<= 1) { gq = fmaxf(gq, __shfl_xor(gq, o)); gk = fmaxf(gk, __shfl_xor(gk, o)); }
      b_bounded = 8.0f * gq * gk * LOG2E < 100.0f; }
    const int nloc = 256 + (l < NL - 1 ? 24 : 0);
    const int q0 = (int)xb_xcc_id();
    for (int qq = 0; qq < 8; ++qq) {
      const int q = (q0 + qq) & 7;
      unsigned* qctr = ctr + 64 * q;
      for (;;) {
        if (F.tid == 0) F.MISC[MI_Q] = __hip_atomic_fetch_add(qctr, 1u, __ATOMIC_RELAXED, __HIP_MEMORY_SCOPE_AGENT);
        __syncthreads();
        const int li = (int)F.MISC[MI_Q];
        __syncthreads();
        if (li >= nloc) break;
        int idx;
        if (li < 64) idx = (q + 8 * (li >> 3)) * 8 + (li & 7);
        else if (li < 128) { const int jx = li - 64; idx = 1024 + (q + 8 * (jx >> 4)) * 16 + (jx & 15); }
        else if (li < 192) { const int jx = li - 128; idx = 1536 + (q + 8 * (jx >> 3)) * 8 + (jx & 7); }
        else if (li < 256) { const int jx = li - 192; idx = 2048 + (q + 8 * (jx >> 4)) * 16 + (jx & 15); }
        else if (li < 264) idx = 2560 + q + 8 * (li - 256);
        else idx = 2624 + q + 8 * (li - 264);
        if (idx < 512) {
            const int b = idx >> 5, h = (idx >> 3) & 3, qt = idx & 7; const size_t rb = (size_t)b * TT;
            if (!att::unit_d2<VM>(F.lds, QD + rb * 384 + h * 96, KD + rb * 384 + h * 96, VD + rb * 256 + h * 64, O + rb * D + 768 + h * 64, qt, 0.10206207261596575f * LOG2E, t32, F.MISC + MI_Q + 1)) {
#pragma unroll 1
                for (int k2 = 0; k2 < 2; ++k2)
                    att::unit<96, VM>(F.lds, QD + rb * 384 + h * 96, 384, KD + rb * 384 + h * 96, 384, VD + rb * 256 + h * 64, 256, O + rb * D + 768 + h * 64, 3, 2 * qt + k2, 0, 64, 68, 0.10206207261596575f * LOG2E, 0.f, false, bias, t32, nullptr);
            }
        } else if (idx < 1024) {
        } else if (idx < 2560) {
            idx -= 1024;
            const int grp = idx >> 9, rem = idx & 511, b = rem >> 5; const size_t rb = (size_t)b * TT;
            if (grp == 1) {
                const int h = (rem >> 3) & 3, qt = rem & 7; const int lo = min(max(8 * qt - 4, 0), 56), n1 = min(max(8 * qt + 3, 0), 56) + 7 - lo + 1;
                att::unit2<64, 0, VM>(F.lds, P + rb * NPJ + h * 64, NPJ, P + rb * NPJ + 256 + h * 64, NPJ, P + rb * NPJ + 512 + h * 64, NPJ, O + rb * D + h * 64, 0, qt, lo, n1, n1 + 4,
                                  0.125f * LOG2E, 0.f, 0.f, false, bias + h * 465, t32);
            } else {
                const int g = (rem >> 4) & 1, qt = rem & 15; const bool isc = grp == 2;
                const int lo = isc ? max(4 * qt - 2, 0) : 0, n1 = isc ? min(4 * qt + 5, 63) - lo + 1 : 64;
                const int qc = (isc ? 1280 : 768) + g * 128, kc = (isc ? 1536 : 1024) + g * 64, vc = (isc ? 1664 : 1152) + g * 64;
                if (!isc && b_bounded) att::unit2<64, 1, VM, true>(F.lds, P + rb * NPJ + qc, NPJ, P + rb * NPJ + kc, NPJ, P + rb * NPJ + vc, NPJ, O + rb * D + 256 + g * 128, 1, qt, 0, 64, 68, 0.125f * LOG2E, 0.f, 0.f, false, bias, t32);
                else att::unit2<64, 1, VM>(F.lds, P + rb * NPJ + qc, NPJ, P + rb * NPJ + kc, NPJ, P + rb * NPJ + vc, NPJ, O + rb * D + (isc ? 512 : 256) + g * 128, isc ? 2 : 1, qt, lo, n1, n1 + 4,
                                  0.125f * LOG2E, isc ? sinks[2 * g] * LOG2E : 0.f, isc ? sinks[2 * g + 1] * LOG2E : 0.f, isc, bias, t32);
            }
        } else if (idx < 2624) {
            const int rem = idx - 2560, b = rem >> 2, isc = (rem >> 1) & 1, g = rem & 1; const size_t rb = (size_t)b * TT;
            const int qc = (isc ? 1280 : 768) + g * 128, kc = (isc ? 1536 : 1024) + g * 64, vc = (isc ? 1664 : 1152) + g * 64;
            att::unit2<64, 1, VM>(F.lds, P + rb * NPJ + qc, NPJ, P + rb * NPJ + kc, NPJ, P + rb * NPJ + vc, NPJ, O + rb * D + (isc ? 512 : 256) + g * 128, isc ? 2 : 1, 16, 0, 0, 4,
                              0.125f * LOG2E, isc ? sinks[2 * g] * LOG2E : 0.f, isc ? sinks[2 * g + 1] * LOG2E : 0.f, isc != 0, bias, t32);
        } else {
            const int rem = idx - 2624, b = rem >> 3, isd = (rem >> 2) & 1, h = rem & 3; const size_t rb = (size_t)b * TT;
            if (isd) att::unit<96, VM>(F.lds, QD + rb * 384 + h * 96, 384, KD + rb * 384 + h * 96, 384, VD + rb * 256 + h * 64, 256, O + rb * D + 768 + h * 64, 3, 16, 0, 0, 4, 0.10206207261596575f * LOG2E, 0.f, false, bias, t32, nullptr);
            else att::unit<64, VM>(F.lds, P + rb * NPJ + h * 64, NPJ, P + rb * NPJ + 256 + h * 64, NPJ, P + rb * NPJ + 512 + h * 64, NPJ, O + rb * D + h * 64, 0, 16, 0, 0, 4, 0.125f * LOG2E, 0.f, false, bias + h * 465, nullptr, nullptr);
        }
    }
    }
}


#define PHASE_FN static __device__ __forceinline__ void
PHASE_FN ph_prologue(GAS unsigned char* ws) { const Frame F = make_frame(ws); phase_prologue(F); }
PHASE_FN ph_ln(GAS unsigned char* ws, int l) { const Frame F = make_frame(ws); phase_ln(F, l); }
PHASE_FN ph_gemm_in(GAS unsigned char* ws, int l) {
    const Frame F = make_frame(ws);
    pg8::Gemm g{(const bf16*)(F.ws + WS_HA), (const bf16*)(F.ws + WS_WIN), M, NPJ, D, D, nullptr}; pg8::StaticOrder S; S.init(M, NPJ, F.G, F.bid);
    pg8::EpiBf16NT<0> E{(bf16*)(F.ws + WS_PB), NPJ, nullptr, 0, 0, 1.f};
    pg8::gemm_phase<pg8::EpiBf16NT<0>, pg8::StaticOrder, true, true>(F.lds, g, S, E);
}
PHASE_FN ph_post(GAS unsigned char* ws, int l) { const Frame F = make_frame(ws); phase_post(F, l); }
PHASE_FN ph_gemm_mla(GAS unsigned char* ws, int l) {
    const Frame F = make_frame(ws);
    pg8::Gemm g{(const bf16*)(F.ws + WS_PB) + 1792, (const bf16*)(F.ws + WS_WD), M, 1024, 384, NPJ, nullptr}; pg8::StaticOrder S; S.init(M, 1024, F.G, F.bid);
    EpiMla E{(bf16*)(F.ws + WS_QD), (bf16*)(F.ws + WS_KD), (bf16*)(F.ws + WS_VD)};
    pg8::gemm_phase<EpiMla, pg8::StaticOrder, true, true>(F.lds, g, S, E);
}
template <int VM>
PHASE_FN ph_attn(GAS unsigned char* ws, int l) { const Frame F = make_frame(ws); phase_attn<VM>(F, l); }
PHASE_FN ph_gemm_out(GAS unsigned char* ws, int l) {
    const Frame F = make_frame(ws);
    pg8::Gemm g{(const bf16*)(F.ws + WS_HA), (const bf16*)(F.ws + WS_WOUT), M, D, D, D, nullptr};
    pg8::EpiBf16NT<0> E{(bf16*)(F.ws + WS_PB), D, nullptr, 0, 0, 1.f};
    if (l == NL - 1) { LatOrder S{F.G, F.bid}; pg8::gemm_phase<pg8::EpiBf16NT<0>, LatOrder, true, true>(F.lds, g, S, E); }
    else { pg8::StaticOrder S; S.init(M, D, F.G, F.bid); pg8::gemm_phase<pg8::EpiBf16NT<0>, pg8::StaticOrder, true, true>(F.lds, g, S, E); }
}
PHASE_FN ph_route(GAS unsigned char* ws, int l) { const Frame F = make_frame(ws); phase_route(F, l); }
PHASE_FN ph_permute(GAS unsigned char* ws, int l) { const Frame F = make_frame(ws); phase_permute(F, l); }
PHASE_FN ph_gemm_gu(GAS unsigned char* ws, int l) {
    const Frame F = make_frame(ws);
    moe_tables(F);
    pg8::Gemm g{(const bf16*)(F.ws + WS_HA), (const bf16*)(F.ws + WS_WGU), MS, 16384, D, D, (const int*)(F.ws + WS_QD)}; MoeOrder S{F.MISC + MI_PST, F.G, F.bid};
    EpiGU E{(bf16*)(F.ws + WS_ACT)};
    pg8::gemm_phase<EpiGU, MoeOrder, true, true, true>(F.lds, g, S, E);
}
PHASE_FN ph_gemm_dn(GAS unsigned char* ws, int l) {
    const Frame F = make_frame(ws);
    moe_tables(F);
    pg8::Gemm g{(const bf16*)(F.ws + WS_ACT), (const bf16*)(F.ws + WS_WDN), MS, 16384, 512, 512, nullptr}; MoeOrder S{F.MISC + MI_PST, F.G, F.bid};
    pg8::EpiBf16NT<0> E{(bf16*)(F.ws + WS_PB), D, nullptr, 1024, 0, 1.f};
    pg8::gemm_phase<pg8::EpiBf16NT<0>, MoeOrder, true, true>(F.lds, g, S, E);
}


#if MK_DEBUG
#ifndef DBG_MODE
#define DBG_MODE 0
#endif
__device__ __forceinline__ float oracle_attn(const Frame& F, int l, int r, int var, int h, int mode = 0) {
    const bf16* P = (const bf16*)(F.ws + WS_PB); const bf16* QD = (const bf16*)(F.ws + WS_QD); const bf16* KD = (const bf16*)(F.ws + WS_KD); const bf16* VD = (const bf16*)(F.ws + WS_VD);
    const bf16* O = (const bf16*)(F.ws + WS_HA); const float* t32 = (const float*)(F.ws + WS_T32);
    const int b = r / TT, t = r - b * TT; const bool lat = t < SEQ; const size_t rb = (size_t)b * TT;
    const int dk = var == 3 ? 96 : 64;
    const bf16* qp; const bf16* kp; const bf16* vp; int kpitch, vpitch;
    if (var == 3) { qp = QD + (size_t)r * 384 + h * 96; kp = KD + rb * 384 + h * 96; kpitch = 384; vp = VD + rb * 256 + h * 64; vpitch = 256; }
    else { const int qc = var == 0 ? h * 64 : var == 1 ? 768 + h * 64 : 1280 + h * 64, kc = var == 0 ? 256 + h * 64 : var == 1 ? 1024 + (h >> 1) * 64 : 1536 + (h >> 1) * 64,
           vc = var == 0 ? 512 + h * 64 : var == 1 ? 1152 + (h >> 1) * 64 : 1664 + (h >> 1) * 64;
           qp = P + (size_t)r * NPJ + qc; kp = P + rb * NPJ + kc; kpitch = NPJ; vp = P + rb * NPJ + vc; vpitch = NPJ; }
    LAS float* qs = (LAS float*)(F.lds + 65536) + F.wave * 128;
    for (int d = F.lane; d < dk; d += 64) qs[d] = __builtin_bit_cast(float, (unsigned)qp[d] << 16);
    asm volatile("s_waitcnt lgkmcnt(0)" ::: "memory");
    if (var == 3 && lat && F.lane < 32) {
        const int c = F.lane >> 3, e = F.lane & 7, gr = t >> 6, gc = t & 63; const float own = qs[64 + F.lane], par = qs[64 + (F.lane ^ 8)];
        const float cs = t32[((c < 2 ? gr : gc) * 8 + e) * 2], sn = t32[((c < 2 ? gr : gc) * 8 + e) * 2 + 1];
        const float nv = (c & 1) == 0 ? own * cs - par * sn : par * sn + own * cs;
        asm volatile("s_waitcnt lgkmcnt(0)" ::: "memory"); qs[64 + F.lane] = nv; }
    asm volatile("s_waitcnt lgkmcnt(0)" ::: "memory");
    const float scale = var == 3 ? 0.10206207261596575f : 0.125f;
    const int gr = t >> 6, gc = t & 63, r0 = min(max(gr - 4, 0), 56), c0 = min(max(gc - 8, 0), 48);
    float m = -3.0e38f, lsum = 0.f, acc[64];
#pragma unroll
    for (int d = 0; d < 64; ++d) acc[d] = 0.f;
    for (int j = F.lane; j < TT; j += 64) {
        bool ok = true; float bias = 0.f;
        if (!lat) ok = j >= SEQ;
        else if (j < SEQ) {
            if (var == 0) { const int kr = j >> 6, kc2 = j & 63; ok = kr >= r0 && kr <= r0 + 7 && kc2 >= c0 && kc2 <= c0 + 15;
                if (ok) bias = INP(I_NABIAS)[((l * 4 + h) * 15 + (kr - gr + 7)) * 31 + (kc2 - gc + 15)]; }
            else if (var == 2) ok = (j - t <= 128) && (t - j <= 128);
        }
        if (!ok) continue;
        float sc = 0.f; const bf16* kr_ = kp + (size_t)j * kpitch;
        for (int d = 0; d < dk; ++d) sc += qs[d] * __builtin_bit_cast(float, (unsigned)kr_[d] << 16);
        sc = sc * scale + bias;
        const float mn = fmaxf(m, sc), a = expf(m - mn), p = expf(sc - mn); m = mn; lsum = lsum * a + p;
        const bf16* vr = vp + (size_t)j * vpitch;
#pragma unroll
        for (int d = 0; d < 64; ++d) acc[d] = acc[d] * a + p * __builtin_bit_cast(float, (unsigned)vr[d] << 16);
    }
    float mg = m;
#pragma unroll
    for (int o = 1; o < 64; o <<= 1) mg = fmaxf(mg, __shfl_xor(mg, o));
    if (mode >= 1) {
        const unsigned* rec = (const unsigned*)(F.ws + WS_RS) + (size_t)r * 2; const float mk = __builtin_bit_cast(float, rec[0]), lk = __builtin_bit_cast(float, rec[1]);
        const float lref = wave_sum(lsum * expf(m - mg));
        const float lker = lk * exp2f(mk - mg * LOG2E);
        if (mode == 2) return fabsf(mk / LOG2E - mg);
        return fabsf(lker / lref - 1.0f);
    }
    const float f = expf(m - mg); lsum *= f; lsum = wave_sum(lsum);
    if (var == 2) lsum += expf(INP(I_SINK)[l * 4 + h] - mg);
    float err = 0.f, mag = 1.0e-6f;
    const bf16* orow = O + (size_t)r * D + var * 256 + h * 64;
#pragma unroll
    for (int d = 0; d < 64; ++d) { const float ref = wave_sum(acc[d] * f) / lsum; const float got = __builtin_bit_cast(float, (unsigned)orow[d] << 16);
        const float df = fabsf(got - ref); err = (df == df) ? fmaxf(err, df) : 1.0e30f; mag = fmaxf(mag, fabsf(ref)); }
    return err / mag;
}
__device__ __forceinline__ void phase_dump(const Frame& F, int code) {
    float* out = (float*)ptab_get(F, I_OUT);
    for (int r = F.gw; r < M; r += F.ngw) {
        const int b = r / TT, t = r - b * TT; if (t >= SEQ) continue;
        float v[16];
        if (code == 1) ld16bf((const bf16*)(F.ws + WS_HA) + (size_t)r * D, F.lane, v);
        else if (code == 2) ld16bf((const bf16*)(F.ws + WS_PB) + (size_t)r * NPJ, F.lane, v);
        else if (code == 3) ld16bf((const bf16*)(F.ws + WS_PB) + (size_t)r * NPJ + 1024, F.lane, v);
        else if (code == 4) ld16bf((const bf16*)(F.ws + WS_PB) + (size_t)r * NPJ + 1280, F.lane, v);
        else if (code == 5) ld16((const float*)(F.ws + WS_PB) + (size_t)r * D, F.lane, v);
        else if (code == 8) {
            const v4u w0 = *((const v4u*)((const bf16*)(F.ws + WS_HA) + (size_t)r * D) + F.lane), w1 = *((const v4u*)((const bf16*)(F.ws + WS_HA) + (size_t)r * D) + 64 + F.lane);
            float f[8]; int bad0 = 0, bad1 = 0; unpack8(w0, f);
#pragma unroll
            for (int i = 0; i < 8; ++i) { const unsigned u = __builtin_bit_cast(unsigned, f[i]); bad0 |= ((u & 0x7f800000u) == 0x7f800000u) ? 1 : 0; }
            unpack8(w1, f);
#pragma unroll
            for (int i = 0; i < 8; ++i) { const unsigned u = __builtin_bit_cast(unsigned, f[i]); bad1 |= ((u & 0x7f800000u) == 0x7f800000u) ? 1 : 0; }
            const unsigned long long m0 = __ballot(bad0), m1 = __ballot(bad1);
            const bool vA = (m0 & 0xffffffffull) != 0, vB = (m0 >> 32) != 0, vC = (m1 & 0xffffffffull) != 0, vD = (m1 >> 32) != 0;
            const float val = (float)(t + 1) * ((vA ? 1.0f : 0.f) + (vB ? 1.0e2f : 0.f) + (vC ? 1.0e4f : 0.f) + (vD ? 1.0e6f : 0.f));
#pragma unroll
            for (int i = 0; i < 16; ++i) v[i] = val;
        }
        else if (code == 9) { const unsigned cd = ((const unsigned*)(F.ws + WS_RS))[(size_t)r * 2]; float val = 0.f; if (cd) { val = 1.f; for (unsigned k = 0; k < cd; ++k) val *= 10.f; }
#pragma unroll
            for (int i = 0; i < 16; ++i) v[i] = val; }
        else if (code == 10) {
            const v4u w1 = *((const v4u*)((const bf16*)(F.ws + WS_HA) + (size_t)r * D) + 64 + F.lane);
            float f[8]; int bad1 = 0; unpack8(w1, f);
#pragma unroll
            for (int i = 0; i < 8; ++i) { const unsigned u = __builtin_bit_cast(unsigned, f[i]); bad1 |= ((u & 0x7f800000u) == 0x7f800000u) ? 1 : 0; }
            const bool vC = (__ballot(bad1) & 0xffffffffull) != 0;
            const bf16* pc = (const bf16*)(F.ws + WS_PB) + ((size_t)b * TT + SEQ + (t & 255)) * NPJ; int badp = 0;
            for (int c = F.lane; c < 288; c += 64) { const v4u w = *((const v4u*)pc + c); unpack8(w, f);
#pragma unroll
                for (int i = 0; i < 8; ++i) { const unsigned u = __builtin_bit_cast(unsigned, f[i]); badp |= ((u & 0x7f800000u) == 0x7f800000u) ? 1 : 0; } }
            float val = 0.f; if (vC) { val = 1.f; for (int k = 0; k <= (t & 15); ++k) val *= 10.f; }
            if (__any(badp)) val = 1.0e30f;
#pragma unroll
            for (int i = 0; i < 16; ++i) v[i] = val;
        }
        else if (code == 11) {
            const bf16* pr = (const bf16*)(F.ws + WS_PB) + (size_t)r * NPJ; int grp = -1;
            for (int c = F.lane; c < 288; c += 64) { const v4u w = *((const v4u*)pr + c); float f[8]; unpack8(w, f);
#pragma unroll
                for (int i = 0; i < 8; ++i) if (!(fabsf(f[i]) < 1.0e4f)) grp = (c * 8) >> 8; }
#pragma unroll
            for (int o = 1; o < 64; o <<= 1) { const int g2 = __shfl_xor(grp, o); grp = g2 > grp ? g2 : grp; }
            float val = 0.f; if (grp >= 0) { val = 100.f; for (int k = 0; k < grp; ++k) val *= 10.f; }
#pragma unroll
            for (int i = 0; i < 16; ++i) v[i] = val;
        }
        else if (code >= 20 && code < 24) {
            float val = 0.f;
            if ((t & 15) == 5) { for (int h = 0; h < 4; ++h) { const float e = oracle_attn(F, 0, r, code - 20, h); const float cls = e > 1.0e20f ? 3.f : e > 0.5f ? 2.f : e > 0.03f ? 1.f : 0.f; if (cls > 0.f) { float w = cls; for (int k = 0; k <= h; ++k) w *= 10.f; val = fmaxf(val, w); } } }
#pragma unroll
            for (int i = 0; i < 16; ++i) v[i] = val;
        }
        else if (code >= 30 && code < 46) {
            float val = 0.f;
            if ((t & 15) == 5) { const float e = oracle_attn(F, 0, r, (code - 30) >> 2, (code - 30) & 3, DBG_MODE); val = e > 10.f ? 1.0e4f : 1000.f * e; }
#pragma unroll
            for (int i = 0; i < 16; ++i) v[i] = val;
        }
        else if (code == 7) {
            auto bad16 = [&](const bf16* p, int nchunks) { int bad = 0; for (int c = F.lane; c < nchunks; c += 64) { const v4u w = *((const v4u*)p + c); float f[8]; unpack8(w, f);
#pragma unroll
                for (int i = 0; i < 8; ++i) { const unsigned u = __builtin_bit_cast(unsigned, f[i]); bad |= ((u & 0x7f800000u) == 0x7f800000u) ? 1 : 0; } } return __any(bad); };
            const int bP = bad16((const bf16*)(F.ws + WS_PB) + (size_t)r * NPJ, 288), bQ = bad16((const bf16*)(F.ws + WS_QD) + (size_t)r * 384, 48),
                      bK = bad16((const bf16*)(F.ws + WS_KD) + (size_t)r * 384, 48), bV = bad16((const bf16*)(F.ws + WS_VD) + (size_t)r * 256, 32), bO = bad16((const bf16*)(F.ws + WS_HA) + (size_t)r * D, 128);
            const float val = bP ? 1.0e6f : bQ ? 1.0e5f : bK ? 1.0e4f : bV ? 1.0e3f : bO ? 1.0e2f : 0.f;
#pragma unroll
            for (int i = 0; i < 16; ++i) v[i] = val;
        }
#pragma unroll
        for (int i = 0; i < 16; ++i) { const unsigned u = __builtin_bit_cast(unsigned, v[i]); if ((u & 0x7f800000u) == 0x7f800000u) v[i] = 777.0f; }
        st16(out + ((size_t)b * SEQ + t) * D, F.lane, v);
    }
}
static __device__ __forceinline__ void ph_dump(GAS unsigned char* ws, int code) { const Frame F = make_frame(ws); phase_dump(F, code); }
#endif
__global__ void __launch_bounds__(NTHR, 2) mk_fwd(Args args) {
    extern __shared__ __attribute__((aligned(16))) unsigned char lds_raw[];
    LAS unsigned char* lds = (LAS unsigned char*)lds_raw; volatile LAS unsigned* MISC = (volatile LAS unsigned*)(lds + MISC_OFF);
    const int tid = threadIdx.x;
    GAS unsigned char* ws = (GAS unsigned char*)args.ws;
    for (int u = tid; u < (LDS_BYTES - MISC_OFF) / 4; u += NTHR) MISC[u] = 0u;
    __syncthreads();
    if (tid < 28) { const unsigned long long p = tid < 27 ? (unsigned long long)args.in[tid] : (unsigned long long)args.out;
        LAS unsigned* t = (LAS unsigned*)(lds + PTAB_OFF) + 2 * tid; t[0] = (unsigned)p; t[1] = (unsigned)(p >> 32); }
    __syncthreads();
#if MK_MULTI
#define GRID_BAR() do { } while (0)
#else
    XcdBarrier bar = xcd_barrier_post((unsigned*)(ws + WS_CTL) + CW_BAR, MISC + MI_BAR);
#define GRID_BAR() xcd_barrier(bar)
#endif
    const int lo = args.ph_lo, hi = args.ph_hi;
#define IN(k) (lo <= (k) && (k) < hi)
#if MK_TIME
    unsigned long long tcat = 0ull, tb0 = 0ull;
#define TBEG() do { tb0 = __builtin_amdgcn_s_memrealtime(); } while (0)
#define TEND(c) do { if ((c) == MK_TIME - 1) tcat += __builtin_amdgcn_s_memrealtime() - tb0; } while (0)
#define SEAM(k) do { if (IN(k) && IN((k) + 1)) { TBEG(); GRID_BAR(); TEND(1); } } while (0)
#else
#define TBEG() do { } while (0)
#define TEND(c) do { } while (0)
#define SEAM(k) do { if (IN(k) && IN((k) + 1)) GRID_BAR(); } while (0)
#endif

#if MK_DEBUG
    if (lo >= 100) { ph_dump(ws, lo - 100); return; }
#endif
    if (IN(0)) { TBEG(); ph_prologue(ws); TEND(2); } SEAM(0);
    for (int l = 0; l < NL; ++l) {
        const int pb = 1 + 10 * l;
        if (IN(pb + 0)) { TBEG(); ph_ln(ws, l); TEND(0); } SEAM(pb + 0);
        if (IN(pb + 1)) { TBEG(); ph_gemm_in(ws, l); if (MK_DUP & 2) { GRID_BAR(); ph_gemm_in(ws, l); } TEND(3); } SEAM(pb + 1);
        if (IN(pb + 2)) { TBEG(); ph_post(ws, l); TEND(0); } SEAM(pb + 2);
        if (IN(pb + 3)) { TBEG(); ph_gemm_mla(ws, l); if (MK_DUP & 8) { GRID_BAR(); ph_gemm_mla(ws, l); } TEND(3); } SEAM(pb + 3);
        if (IN(pb + 4)) { TBEG(); ph_attn<0>(ws, l); if (MK_DUP & 16) { GRID_BAR(); ph_attn<MK_VM>(ws, l + 4); } TEND(4); } SEAM(pb + 4);
        if (IN(pb + 5)) { TBEG(); ph_gemm_out(ws, l); if (MK_DUP & 32) { GRID_BAR(); ph_gemm_out(ws, l); } TEND(3); } SEAM(pb + 5);
        if (IN(pb + 6)) { TBEG(); ph_route(ws, l); TEND(0); } SEAM(pb + 6);
        if (IN(pb + 7)) { TBEG(); ph_permute(ws, l); if (MK_DUP & 128) { GRID_BAR(); ph_permute(ws, l); } TEND(0); } SEAM(pb + 7);
        if (IN(pb + 8)) { TBEG(); ph_gemm_gu(ws, l); if (MK_DUP & 256) { GRID_BAR(); ph_gemm_gu(ws, l); } TEND(3); } SEAM(pb + 8);
        if (IN(pb + 9)) { TBEG(); ph_gemm_dn(ws, l); if (MK_DUP & 512) { GRID_BAR(); ph_gemm_dn(ws, l); } TEND(3); } SEAM(pb + 9);
    }
    if (IN(NPHASE - 1)) { TBEG(); ph_ln(ws, NL); TEND(0); }
#if MK_TIME
    if (blockIdx.x == 0) { const unsigned long long tw = __builtin_amdgcn_s_memrealtime(); const unsigned long long dl = tcat * (unsigned long long)MK_TMUL; while (__builtin_amdgcn_s_memrealtime() - tw < dl) __builtin_amdgcn_s_sleep(8); }
#endif
#undef IN
#undef SEAM
#undef GRID_BAR
}

extern "C" void kernel_launch(void* const* d_in, const int* in_sizes, int n_in, void* d_out, int out_size, void* d_ws, size_t ws_size, hipStream_t stream) {
    static int grid = 0;
    if (grid == 0) {
        if (n_in != 27 || out_size != NB * SEQ * D || ws_size < WS_END) { fprintf(stderr, "kernel_launch: unexpected problem (n_in %d, out %d, ws %zu < %zu)\n", n_in, out_size, ws_size, (size_t)WS_END); grid = -1; return; }
        int dev = 0, cus = 0, per_cu = 0;
        if (hipGetDevice(&dev) != hipSuccess || hipDeviceGetAttribute(&cus, hipDeviceAttributeMultiprocessorCount, dev) != hipSuccess) { grid = -1; return; }
        if (hipFuncSetAttribute((const void*)mk_fwd, hipFuncAttributeMaxDynamicSharedMemorySize, LDS_BYTES) != hipSuccess) { fprintf(stderr, "kernel_launch: hipFuncSetAttribute failed\n"); grid = -1; return; }
        if (hipOccupancyMaxActiveBlocksPerMultiprocessor(&per_cu, (const void*)mk_fwd, NTHR, LDS_BYTES) != hipSuccess || per_cu < 1) fprintf(stderr, "kernel_launch: occupancy query reports %d\n", per_cu);
        (void)hipGetLastError();
        grid = cus > 1024 ? 1024 : cus;
    }
    if (grid < 0) return;
    (void)hipMemsetAsync((char*)d_ws + WS_CTL, 0, CTL_BYTES, stream);
    Args a{};
    for (int i = 0; i < 27; ++i) a.in[i] = (const float*)d_in[i];
    a.out = (float*)d_out; a.ws = (unsigned char*)d_ws;
#if MK_MULTI
#ifndef DBG_NRUN
#define DBG_NRUN NPHASE
#endif
    for (int p = 0; p < DBG_NRUN; ++p) { a.ph_lo = p; a.ph_hi = p + 1; hipLaunchKernelGGL(mk_fwd, dim3(grid), dim3(NTHR), LDS_BYTES, stream, a); }
#ifdef DBG_DUMP
    a.ph_lo = 100 + DBG_DUMP; a.ph_hi = 101 + DBG_DUMP; hipLaunchKernelGGL(mk_fwd, dim3(grid), dim3(NTHR), LDS_BYTES, stream, a);
#endif
#else
    a.ph_lo = 0; a.ph_hi = NPHASE;
    hipLaunchKernelGGL(mk_fwd, dim3(grid), dim3(NTHR), LDS_BYTES, stream, a);
#endif
}
```

```cpp
#include <hip/hip_runtime.h>
#include <cstdio>
#include <cstdint>
namespace pg8 {
#define PG8_LAS __attribute__((address_space(3)))
typedef unsigned short bf16_t;
typedef short bf16x8 __attribute__((ext_vector_type(8)));
typedef float f32x4 __attribute__((ext_vector_type(4)));
typedef unsigned u32x4 __attribute__((ext_vector_type(4)));
constexpr int BM = 256, BK = 64, HALF = 128, HTB = HALF * BK * 2  , STAGE_BYTES = 8 * HTB, NXCD = 8, WGM = 8;

__host__ __device__ __forceinline__ int lds_byte(int r, int c) { const int st = (r >> 4) * 2 + (c >> 5), rr = r & 15, cc = c & 31, ob = rr * 64 + cc * 2; return st * 1024 + (ob ^ (((ob >> 9) & 1) << 5)); }
__host__ __device__ __forceinline__ void stage_rc(int b, int& R, int& C) { const int st = b / 1024, sb = b % 1024, swz = sb ^ (((sb >> 9) & 1) << 5); R = (st >> 1) * 16 + swz / 64; C = (st & 1) * 32 + (swz % 64) / 2; }
__host__ __device__ __forceinline__ int perm32(int rho) { const int n = rho >> 4, i = rho & 15; return 8 * (i >> 2) + 4 * n + (i & 3); }

struct Unit { int pm, pn; };
struct Gemm { const bf16_t* A; const bf16_t* Bt; int M, N, K, lda; const int* src; };

struct StaticOrder {
    int nM, nN, nwg, G, c;
    __host__ __device__ void init(int M, int N, int G_, int c_) { nM = M / BM; nN = N / BM; nwg = nM * nN; G = G_; c = c_; }
    __host__ __device__ bool next(int i, Unit& u) const {
        const long L = (long)i * G + c; if (L >= nwg) return false;
        int wgid = (int)L; { const int q = nwg / NXCD, r = nwg % NXCD, xcd = wgid % NXCD, off = wgid / NXCD; wgid = (xcd < r ? xcd * (q + 1) : r * (q + 1) + (xcd - r) * q) + off; }
        const int nig = WGM * nN, gid = wgid / nig, fm = gid * WGM, gsz = (nM - fm) < WGM ? (nM - fm) : WGM;
        u.pm = fm + ((wgid % nig) % gsz); u.pn = (wgid % nig) / gsz; return true;
    }
    __device__ __forceinline__ void a_ready(const Unit&) const {}
    __device__ __forceinline__ void done(const Unit&) const {}
};

__device__ __forceinline__ unsigned cvt_pk_bf16(float lo, float hi) { unsigned r; asm volatile("v_cvt_pk_bf16_f32 %0, %1, %2" : "=v"(r) : "v"(lo), "v"(hi)); return r; }
typedef float f32x2 __attribute__((ext_vector_type(2)));
__device__ __forceinline__ f32x2 gelu_pk(f32x2 v) {
    const f32x2 av = __builtin_elementwise_abs(v), d = av * 0.2316418882f + 1.0f;
    f32x2 t; t.x = __builtin_amdgcn_rcpf(d.x); t.y = __builtin_amdgcn_rcpf(d.y);
    f32x2 q = t * 0.5307027145f + (-0.7265760135f); q = q * t + 0.7107068705f; q = q * t + (-0.142248368f); q = q * t + 0.127414796f; q = q * t;
    const f32x2 s = (v * v) * (-0.72134752044f);
    f32x2 e; e.x = __builtin_amdgcn_exp2f(s.x); e.y = __builtin_amdgcn_exp2f(s.y);
    const f32x2 m = v * (q * e), r = v - m;
    f32x2 o; o.x = v.x < 0.f ? m.x : r.x; o.y = v.y < 0.f ? m.y : r.y; return o;
}

template <int ACT  > struct EpiBf16 {
    static constexpr bool PERM = true, AFTER_DRAIN = false; static_assert(ACT == 0 || ACT == 1, "EpiBf16: ACT is 0 (none) or 1 (gelu_pk)");
    bf16_t* O; int ldc; const float* bias; int split_cols; size_t split_stride; float scale0;
    __device__ __forceinline__ void operator()(const f32x4 (&acc)[2][2][4][2], const Unit& u, int wr, int wc, int fr, int fq) const {
        const int row0 = u.pm * BM + wr * 64 + fr; int colt = u.pn * BM; bf16_t* base = O;
        float sc = 1.f; if (split_cols) { const int t = colt / split_cols; base += (size_t)t * split_stride; colt -= t * split_cols; if (t == 0) sc = scale0; }
        const int col0 = colt + wc * 32 + 8 * fq, bcol0 = u.pn * BM + wc * 32 + 8 * fq;
        f32x4 bv[2][2];
#pragma unroll
        for (int bj = 0; bj < 2; ++bj)
#pragma unroll
            for (int n = 0; n < 2; ++n) bv[bj][n] = bias ? *(const f32x4*)(bias + bcol0 + bj * HALF + 4 * n) : (f32x4){0.f, 0.f, 0.f, 0.f};
#pragma unroll
        for (int ai = 0; ai < 2; ++ai)
#pragma unroll
            for (int m = 0; m < 4; ++m) { bf16_t* rowp = base + (size_t)(row0 + ai * HALF + m * 16) * ldc + col0;
#pragma unroll
                for (int bj = 0; bj < 2; ++bj) { f32x4 v0 = acc[ai][bj][m][0] + bv[bj][0], v1 = acc[ai][bj][m][1] + bv[bj][1];
                    if (ACT == 1) { f32x2 a = gelu_pk((f32x2){v0[0], v0[1]}), b = gelu_pk((f32x2){v0[2], v0[3]}), c = gelu_pk((f32x2){v1[0], v1[1]}), d = gelu_pk((f32x2){v1[2], v1[3]});
                        v0 = (f32x4){a.x, a.y, b.x, b.y}; v1 = (f32x4){c.x, c.y, d.x, d.y}; }
                    v0 = v0 * sc; v1 = v1 * sc; u32x4 w; w.x = cvt_pk_bf16(v0[0], v0[1]); w.y = cvt_pk_bf16(v0[2], v0[3]); w.z = cvt_pk_bf16(v1[0], v1[1]); w.w = cvt_pk_bf16(v1[2], v1[3]);
                    *(u32x4*)(rowp + bj * HALF) = w; } }
    }
};
template <int ACT  > struct EpiBf16NT {
    static constexpr bool PERM = true, AFTER_DRAIN = false; static_assert(ACT == 0 || ACT == 1, "EpiBf16: ACT is 0 (none) or 1 (gelu_pk)");
    bf16_t* O; int ldc; const float* bias; int split_cols; size_t split_stride; float scale0;
    __device__ __forceinline__ void operator()(const f32x4 (&acc)[2][2][4][2], const Unit& u, int wr, int wc, int fr, int fq) const {
        const int row0 = u.pm * BM + wr * 64 + fr; int colt = u.pn * BM; bf16_t* base = O;
        float sc = 1.f; if (split_cols) { const int t = colt / split_cols; base += (size_t)t * split_stride; colt -= t * split_cols; if (t == 0) sc = scale0; }
        const int col0 = colt + wc * 32 + 8 * fq, bcol0 = u.pn * BM + wc * 32 + 8 * fq;
        f32x4 bv[2][2];
#pragma unroll
        for (int bj = 0; bj < 2; ++bj)
#pragma unroll
            for (int n = 0; n < 2; ++n) bv[bj][n] = bias ? *(const f32x4*)(bias + bcol0 + bj * HALF + 4 * n) : (f32x4){0.f, 0.f, 0.f, 0.f};
#pragma unroll
        for (int ai = 0; ai < 2; ++ai)
#pragma unroll
            for (int m = 0; m < 4; ++m) { bf16_t* rowp = base + (size_t)(row0 + ai * HALF + m * 16) * ldc + col0;
#pragma unroll
                for (int bj = 0; bj < 2; ++bj) { f32x4 v0 = acc[ai][bj][m][0] + bv[bj][0], v1 = acc[ai][bj][m][1] + bv[bj][1];
                    if (ACT == 1) { f32x2 a = gelu_pk((f32x2){v0[0], v0[1]}), b = gelu_pk((f32x2){v0[2], v0[3]}), c = gelu_pk((f32x2){v1[0], v1[1]}), d = gelu_pk((f32x2){v1[2], v1[3]});
                        v0 = (f32x4){a.x, a.y, b.x, b.y}; v1 = (f32x4){c.x, c.y, d.x, d.y}; }
                    v0 = v0 * sc; v1 = v1 * sc; u32x4 w; w.x = cvt_pk_bf16(v0[0], v0[1]); w.y = cvt_pk_bf16(v0[2], v0[3]); w.z = cvt_pk_bf16(v1[0], v1[1]); w.w = cvt_pk_bf16(v1[2], v1[3]);
                    __builtin_nontemporal_store(w, (u32x4*)(rowp + bj * HALF)); } }
    }
};
struct EpiF32 {
    static constexpr bool PERM = false, AFTER_DRAIN = false;
    float* C; int ldc; const float* bias;
    __device__ __forceinline__ void operator()(const f32x4 (&acc)[2][2][4][2], const Unit& u, int wr, int wc, int fr, int fq) const {
        const int row0 = u.pm * BM + wr * 64 + fr, col0 = u.pn * BM + wc * 32 + 4 * fq;
        f32x4 bv[2][2];
#pragma unroll
        for (int bj = 0; bj < 2; ++bj)
#pragma unroll
            for (int n = 0; n < 2; ++n) bv[bj][n] = bias ? *(const f32x4*)(bias + col0 + bj * HALF + n * 16) : (f32x4){0.f, 0.f, 0.f, 0.f};
#pragma unroll
        for (int ai = 0; ai < 2; ++ai)
#pragma unroll
            for (int m = 0; m < 4; ++m) { float* rowp = C + (size_t)(row0 + ai * HALF + m * 16) * ldc + col0;
#pragma unroll
                for (int bj = 0; bj < 2; ++bj)
#pragma unroll
                    for (int n = 0; n < 2; ++n) *(f32x4*)(rowp + bj * HALF + n * 16) = acc[ai][bj][m][n] + bv[bj][n]; }
    }
};
template <class Epi, class Sched, bool ALIGN_EPI = false, bool SP2 = false, bool GATHER = false>
__device__ __forceinline__ void gemm_phase(PG8_LAS unsigned char* lds, const Gemm g, const Sched& S, const Epi& E) {
    int tid = threadIdx.x; asm volatile("" : "+v"(tid)); const int wid = __builtin_amdgcn_readfirstlane(tid >> 6), lane = tid & 63, wr = wid >> 2, wc = wid & 3, fr = lane & 15, fq = lane >> 4;
    const int K = g.K, nt = K / BK;
    unsigned voffA[2], voffB[2]; int RA[2]; unsigned CA2[2];
#pragma unroll
    for (int i = 0; i < 2; ++i) { int R, C; stage_rc(tid * 16 + i * 8192, R, C); const int Rb = Epi::PERM ? ((R & ~31) + perm32(R & 31)) : R;
        voffA[i] = (unsigned)(R * g.lda + C) * 2u; voffB[i] = (unsigned)(Rb * K + C) * 2u; RA[i] = R; CA2[i] = (unsigned)C * 2u; }
    unsigned gcur[2][2] = {{0u, 0u}, {0u, 0u}}, gnxt[2][2] = {{0u, 0u}, {0u, 0u}};
#define PG8_GOFF(dst, u_) do { _Pragma("unroll") for (int h_ = 0; h_ < 2; ++h_) _Pragma("unroll") for (int i_ = 0; i_ < 2; ++i_) \
        dst[h_][i_] = (unsigned)g.src[(u_).pm * BM + h_ * HALF + RA[i_]] * (unsigned)(g.lda * 2) + CA2[i_]; } while (0)
#define PG8_STAGE_A(bufoff, gbase, h, nx) do { if constexpr (GATHER) { unsigned vs_[2] = {(nx) ? gnxt[h][0] : gcur[h][0], (nx) ? gnxt[h][1] : gcur[h][1]}; PG8_STAGE(bufoff, gbase, vs_); } \
        else { PG8_STAGE(bufoff, (gbase) + ((h) ? hstepA : 0), voffA); } } while (0)
    const size_t kstep = (size_t)(BK * 2);
    const size_t hstepA = (size_t)HALF * g.lda * 2, hstepB = (size_t)HALF * K * 2;
    const size_t tstepA = 2 * hstepA, tstepB = 2 * hstepB;
    const unsigned ldsw = (unsigned)wid * 1024u;
    const int aoff = lds_byte(wr * 64 + fr, fq * 8), boff = lds_byte(wc * 32 + fr, fq * 8);
#define PG8_SA(b, h) (((b) * 2 + (h)) * HTB)
#define PG8_SB(b, h) ((4 + (b) * 2 + (h)) * HTB)
#define PG8_STAGE(bufoff, gbase, voff) do { _Pragma("unroll") for (int _i = 0; _i < 2; ++_i) \
        __builtin_amdgcn_global_load_lds((const unsigned*)((const char*)(gbase) + (voff)[_i]), (PG8_LAS unsigned*)(lds + (bufoff) + ldsw + _i * 8192), 16, 0, 0); } while (0)
#define PG8_LDA(dst, b, h) do { _Pragma("unroll") for (int m = 0; m < 4; ++m) _Pragma("unroll") for (int k = 0; k < 2; ++k) dst[m][k] = *(const PG8_LAS bf16x8*)(lds + PG8_SA(b, h) + aoff + m * 2048 + k * 1024); } while (0)
#define PG8_LDB(dst, b, h) do { _Pragma("unroll") for (int n = 0; n < 2; ++n) _Pragma("unroll") for (int k = 0; k < 2; ++k) dst[n][k] = *(const PG8_LAS bf16x8*)(lds + PG8_SB(b, h) + boff + n * 2048 + k * 1024); } while (0)
#define PG8_MMA(ai, bj, At, Bt) do { __builtin_amdgcn_s_setprio(1); _Pragma("unroll") for (int m = 0; m < 4; ++m) _Pragma("unroll") for (int n = 0; n < 2; ++n) _Pragma("unroll") for (int k = 0; k < 2; ++k) \
        acc[ai][bj][m][n] = __builtin_amdgcn_mfma_f32_16x16x32_bf16(Bt[n][k], At[m][k], acc[ai][bj][m][n], 0, 0, 0); __builtin_amdgcn_s_setprio(0); } while (0)
#define PG8_WAIT_V(n) asm volatile("s_waitcnt vmcnt(" #n ")" ::: "memory")
#define PG8_WAIT_L(n) asm volatile("s_waitcnt lgkmcnt(" #n ")" ::: "memory")
#define PG8_BAR __builtin_amdgcn_s_barrier()
#define PG8_SCHED __builtin_amdgcn_sched_barrier(0)
    Unit cur, nxt; int ui = 0;
    if (!S.next(0, cur)) return;
    f32x4 acc[2][2][4][2];
#pragma unroll
    for (int a = 0; a < 2; ++a)
#pragma unroll
        for (int b = 0; b < 2; ++b)
#pragma unroll
            for (int m = 0; m < 4; ++m)
#pragma unroll
                for (int n = 0; n < 2; ++n) acc[a][b][m][n] = (f32x4){0.f, 0.f, 0.f, 0.f};
    bf16x8 At[4][2], B0[2][2], B1[2][2];
    const char* cA = (const char*)g.A + (GATHER ? (size_t)0 : (size_t)cur.pm * tstepA); const char* cB = (const char*)g.Bt + (size_t)cur.pn * tstepB;
    if constexpr (GATHER) PG8_GOFF(gcur, cur);
    S.a_ready(cur);
    if constexpr (SP2) {
        PG8_STAGE(PG8_SB(0, 0), cB, voffB); PG8_STAGE(PG8_SB(0, 1), cB + hstepB, voffB); PG8_STAGE_A(PG8_SA(0, 0), cA, 0, false); PG8_STAGE_A(PG8_SA(0, 1), cA, 1, false);
        if (wr == 1) PG8_BAR;
        PG8_WAIT_V(2); PG8_BAR;
        PG8_STAGE(PG8_SB(1, 0), cB + kstep, voffB); PG8_STAGE_A(PG8_SA(1, 0), cA + kstep, 0, false); PG8_STAGE(PG8_SB(1, 1), cB + hstepB + kstep, voffB);
        PG8_WAIT_V(6); PG8_BAR;
    } else {
        PG8_STAGE(PG8_SB(0, 0), cB, voffB); PG8_STAGE_A(PG8_SA(0, 0), cA, 0, false); PG8_STAGE(PG8_SB(0, 1), cB + hstepB, voffB); PG8_STAGE_A(PG8_SA(0, 1), cA, 1, false);
        if (wr == 1) PG8_BAR;
        PG8_WAIT_V(4); PG8_BAR;
        PG8_STAGE(PG8_SB(1, 0), cB + kstep, voffB); PG8_STAGE_A(PG8_SA(1, 0), cA + kstep, 0, false); PG8_STAGE(PG8_SB(1, 1), cB + hstepB + kstep, voffB);
        PG8_WAIT_V(6); PG8_BAR;
    }
    for (;;) {
        const bool has_next = S.next(ui + 1, nxt);
        const char* nA = (has_next && !GATHER) ? (const char*)g.A + (size_t)nxt.pm * tstepA : cA; const char* nB = has_next ? (const char*)g.Bt + (size_t)nxt.pn * tstepB : cB;
        if constexpr (GATHER) { if (has_next) PG8_GOFF(gnxt, nxt); else { _Pragma("unroll") for (int h_ = 0; h_ < 2; ++h_) { gnxt[h_][0] = gcur[h_][0]; gnxt[h_][1] = gcur[h_][1]; } } }
#pragma unroll 1
        for (int t = 0; t < nt; t += 2) {
            const bool last = (t == nt - 2);
            const char* a1 = cA + (size_t)(t + 1) * kstep;
            const char* a2 = last ? nA : cA + (size_t)(t + 2) * kstep; const char* b2 = last ? nB : cB + (size_t)(t + 2) * kstep;
            const char* a3 = a2 + kstep; const char* b3 = b2 + kstep;
            if (last && has_next) S.a_ready(nxt);
            if constexpr (SP2) {
            PG8_LDB(B0, 0, 0); PG8_LDB(B1, 0, 1); PG8_SCHED; PG8_LDA(At, 0, 0); PG8_STAGE_A(PG8_SA(1, 1), a1, 1, false);
            PG8_WAIT_V(8); PG8_WAIT_L(0); PG8_BAR; PG8_MMA(0, 0, At, B0); PG8_MMA(0, 1, At, B1); PG8_BAR; PG8_SCHED;
            PG8_LDA(At, 0, 1); PG8_STAGE(PG8_SB(0, 0), b2, voffB); PG8_STAGE(PG8_SB(0, 1), b2 + hstepB, voffB); PG8_STAGE_A(PG8_SA(0, 0), a2, 0, last);
            PG8_WAIT_V(8); PG8_WAIT_L(0); PG8_BAR; PG8_MMA(1, 0, At, B0); PG8_MMA(1, 1, At, B1); PG8_BAR; PG8_SCHED;
            PG8_LDB(B0, 1, 0); PG8_LDB(B1, 1, 1); PG8_SCHED; PG8_LDA(At, 1, 0); PG8_STAGE_A(PG8_SA(0, 1), a2, 1, last);
            PG8_WAIT_V(8); PG8_WAIT_L(0); PG8_BAR; PG8_MMA(0, 0, At, B0); PG8_MMA(0, 1, At, B1); PG8_BAR; PG8_SCHED;
            PG8_LDA(At, 1, 1); PG8_STAGE(PG8_SB(1, 0), b3, voffB); PG8_STAGE(PG8_SB(1, 1), b3 + hstepB, voffB); PG8_STAGE_A(PG8_SA(1, 0), a3, 0, last);
            PG8_WAIT_V(8); PG8_WAIT_L(0); PG8_BAR; PG8_MMA(1, 0, At, B0); PG8_MMA(1, 1, At, B1); PG8_BAR; PG8_SCHED;
            } else {
            PG8_LDB(B0, 0, 0); PG8_SCHED; PG8_LDA(At, 0, 0); PG8_STAGE_A(PG8_SA(1, 1), a1, 1, false);
            PG8_WAIT_L(8); PG8_BAR; PG8_WAIT_L(0); PG8_MMA(0, 0, At, B0); PG8_BAR; PG8_SCHED;
            PG8_LDB(B1, 0, 1); PG8_STAGE(PG8_SB(0, 0), b2, voffB);
            PG8_BAR; PG8_WAIT_L(0); PG8_MMA(0, 1, At, B1); PG8_BAR;
            PG8_LDA(At, 0, 1); PG8_STAGE_A(PG8_SA(0, 0), a2, 0, last);
            PG8_BAR; PG8_WAIT_L(0); PG8_MMA(1, 0, At, B0); PG8_BAR; PG8_SCHED;
            PG8_STAGE(PG8_SB(0, 1), b2 + hstepB, voffB);
            PG8_WAIT_V(6); PG8_BAR; PG8_MMA(1, 1, At, B1); PG8_BAR;
            PG8_LDB(B0, 1, 0); PG8_SCHED; PG8_LDA(At, 1, 0); PG8_STAGE_A(PG8_SA(0, 1), a2, 1, last);
            PG8_WAIT_L(8); PG8_BAR; PG8_WAIT_L(0); PG8_MMA(0, 0, At, B0); PG8_BAR; PG8_SCHED;
            PG8_LDB(B1, 1, 1); PG8_STAGE(PG8_SB(1, 0), b3, voffB);
            PG8_BAR; PG8_WAIT_L(0); PG8_MMA(0, 1, At, B1); PG8_BAR;
            PG8_LDA(At, 1, 1); PG8_STAGE_A(PG8_SA(1, 0), a3, 0, last);
            PG8_BAR; PG8_WAIT_L(0); PG8_MMA(1, 0, At, B0); PG8_BAR; PG8_SCHED;
            PG8_STAGE(PG8_SB(1, 1), b3 + hstepB, voffB);
            PG8_WAIT_V(6); PG8_BAR; PG8_MMA(1, 1, At, B1); PG8_BAR;
            }
        }
        if constexpr (ALIGN_EPI) { if (wr == 0) PG8_BAR; }
        if constexpr (!Epi::AFTER_DRAIN) { E(acc, cur, wr, wc, fr, fq); S.done(cur); }
        if (!has_next) break;
#pragma unroll
        for (int a = 0; a < 2; ++a)
#pragma unroll
            for (int b = 0; b < 2; ++b)
#pragma unroll
                for (int m = 0; m < 4; ++m)
#pragma unroll
                    for (int n = 0; n < 2; ++n) acc[a][b][m][n] = (f32x4){0.f, 0.f, 0.f, 0.f};
        cur = nxt; cA = nA; cB = nB; ++ui;
        if constexpr (GATHER) { _Pragma("unroll") for (int h_ = 0; h_ < 2; ++h_) { gcur[h_][0] = gnxt[h_][0]; gcur[h_][1] = gnxt[h_][1]; } }
        if constexpr (ALIGN_EPI) { if (wr == 1) PG8_BAR; }
    }
    PG8_WAIT_V(0);
    if constexpr (!ALIGN_EPI) { if (wr == 0) PG8_BAR; }
    PG8_BAR;
    if constexpr (Epi::AFTER_DRAIN) { E.fused(acc, cur, wr, wc, fr, fq, lds, wid, lane); S.done(cur); }
#undef PG8_SA
#undef PG8_GOFF
#undef PG8_STAGE_A
#undef PG8_SB
#undef PG8_STAGE
#undef PG8_LDA
#undef PG8_LDB
#undef PG8_MMA
#undef PG8_WAIT_V
#undef PG8_WAIT_L
#undef PG8_BAR
#undef PG8_SCHED
}
}

constexpr int NB = 16, SEQ = 4096, CTX = 256, TT = SEQ + CTX, M = NB * TT, D = 1024, NL = 4;
constexpr int NPJ = 2304, DPROJ = 2208;
constexpr int MS = 143360;
constexpr float EPS = 1e-6f, ALPHA = 1.6817928305074290f, LOG2E = 1.4426950408889634f;
constexpr int NWAVES = 8, NTHR = 512;
#ifndef MK_DEBUG
#define MK_DEBUG 0
#endif
#ifndef MK_TIME
#define MK_TIME 0
#endif
#ifndef MK_TMUL
#define MK_TMUL 1
#endif
#ifndef MK_VM
#define MK_VM 0
#endif
#ifndef MK_DUP
#define MK_DUP 0
#endif
#ifndef MK_MULTI
#define MK_MULTI 0
#endif
constexpr int NPHASE = 2 + 10 * NL;

constexpr size_t WS_CTL = 0, CTL_BYTES = 65536;
constexpr size_t WS_MODS = WS_CTL + CTL_BYTES;
constexpr size_t WS_T64 = WS_MODS + (size_t)NL * 17 * 6144 * 4;
constexpr size_t WS_T32 = WS_T64 + 8192;
constexpr size_t WS_RS = WS_T32 + 4096;
constexpr size_t WS_RT = WS_RS + (size_t)M * 8;
constexpr size_t WS_HIST = WS_RT + (size_t)M * 32;
constexpr size_t WS_XS = WS_HIST + 65536;
constexpr size_t WS_WIN = WS_XS + (size_t)M * D * 2;
constexpr size_t WS_WD = WS_WIN + (size_t)NPJ * D * 2;
constexpr size_t WS_WOUT = WS_WD + (size_t)1024 * 384 * 2;
constexpr size_t WS_WGU = WS_WOUT + (size_t)D * D * 2;
constexpr size_t WS_WDN = WS_WGU + (size_t)16 * 1024 * 1024 * 2;
constexpr size_t WS_HA = WS_WDN + (size_t)16 * 1024 * 512 * 2;
constexpr size_t WS_PB = WS_HA + (size_t)M * D * 2;
constexpr size_t WS_QD = WS_PB + (size_t)M * NPJ * 2;
constexpr size_t WS_KD = WS_QD + (size_t)M * 384 * 2;
constexpr size_t WS_VD = WS_KD + (size_t)M * 384 * 2;
constexpr size_t WS_ACT = WS_VD + (size_t)M * 256 * 2;
constexpr size_t WS_END = WS_ACT + (size_t)MS * 512 * 2;
static_assert(WS_END <= (size_t)1073741824, "d_ws map must fit 1 GiB");
static_assert((size_t)M * NPJ * 2 >= (size_t)MS * D * 2 && (size_t)M * NPJ * 2 >= (size_t)M * D * 4, "region PB overlays");
constexpr int CW_BAR = 0;
constexpr int CW_QUEUE = 4096;

constexpr int RING_BYTES = 131072, MISC_OFF = RING_BYTES, LDS_BYTES = 147456;
constexpr int MI_BAR = 0, MI_Q = 4, MI_TOT = 16, MI_BASE = 32, MI_PST = 48, MI_LH = 80;

#define GAS __attribute__((address_space(1)))
#define LAS __attribute__((address_space(3)))
typedef unsigned short bf16;
typedef unsigned v4u __attribute__((ext_vector_type(4)));
typedef unsigned v2u __attribute__((ext_vector_type(2)));
typedef float f32x4 __attribute__((ext_vector_type(4)));
typedef float f32x2 __attribute__((ext_vector_type(2)));
typedef short bf16x8 __attribute__((ext_vector_type(8)));
typedef float f32x16 __attribute__((ext_vector_type(16)));
typedef short v4i16 __attribute__((ext_vector_type(4)));

__device__ __forceinline__ unsigned f2bf(float f) { unsigned u = __builtin_bit_cast(unsigned, f); return (u + 0x7fffu + ((u >> 16) & 1u)) >> 16; }
__device__ __forceinline__ unsigned pk2(float lo, float hi) { return f2bf(lo) | (f2bf(hi) << 16); }
__device__ __forceinline__ float bflo(unsigned w) { return __builtin_bit_cast(float, w << 16); }
__device__ __forceinline__ float bfhi(unsigned w) { return __builtin_bit_cast(float, w & 0xffff0000u); }
__device__ __forceinline__ void unpack8(v4u w, float (&f)[8]) { f[0] = bflo(w.x); f[1] = bfhi(w.x); f[2] = bflo(w.y); f[3] = bfhi(w.y); f[4] = bflo(w.z); f[5] = bfhi(w.z); f[6] = bflo(w.w); f[7] = bfhi(w.w); }
__device__ __forceinline__ v4u pack8(const float (&f)[8]) { v4u w; w.x = pk2(f[0], f[1]); w.y = pk2(f[2], f[3]); w.z = pk2(f[4], f[5]); w.w = pk2(f[6], f[7]); return w; }
__device__ __forceinline__ float wave_sum(float v) {
    int x = __builtin_bit_cast(int, v);
#define WS_DPP(ctrl, rmask) v += __builtin_bit_cast(float, __builtin_amdgcn_update_dpp(0, x, ctrl, rmask, 0xf, true)); x = __builtin_bit_cast(int, v)
    WS_DPP(0xB1, 0xf);
    WS_DPP(0x4E, 0xf);
    WS_DPP(0x141, 0xf);
    WS_DPP(0x140, 0xf);
    WS_DPP(0x142, 0xa);
    WS_DPP(0x143, 0xc);
#undef WS_DPP
    return __builtin_bit_cast(float, __builtin_amdgcn_readlane(__builtin_bit_cast(int, v), 63));
}

#define XB_TMO      128
#define XB_XCNT(j)  (256  + 64 * (j))
#define XB_XSUB(j)  (1280 + 64 * (j))
#define XB_XGEN(j)  (2304 + 64 * (j))
#define XB_TOP      3328
#define XB_TOPGEN   3392
#define XCD_BAR_WORDS 3456
#define XB_SPIN_CAP (1u << 22)
__device__ __forceinline__ unsigned xb_ld(unsigned* p)              { return __hip_atomic_load(p, __ATOMIC_RELAXED, __HIP_MEMORY_SCOPE_AGENT); }
__device__ __forceinline__ unsigned xb_add(unsigned* p, unsigned v) { return __hip_atomic_fetch_add(p, v, __ATOMIC_RELAXED, __HIP_MEMORY_SCOPE_AGENT); }
__device__ __forceinline__ unsigned xb_xcc_id() { return (unsigned)__builtin_amdgcn_s_getreg((3 << 11) | 20) & 0xFu; }
#define XB_SPIN(cond, bar) do { unsigned _sp = 0; while (cond) { __builtin_amdgcn_s_sleep(1); \
    if ((++_sp & 255u) == 0u) { if (xb_ld(&(bar)[XB_TMO])) break; if (_sp > XB_SPIN_CAP) { atomicAdd(&(bar)[XB_TMO], 1u); break; } } } } while (0)
struct XcdBarrier { unsigned* bar; unsigned x; volatile LAS unsigned* st; };
__device__ __forceinline__ XcdBarrier xcd_barrier_post(unsigned* bar, volatile LAS unsigned* st) {
    XcdBarrier b; b.bar = bar; b.x = xb_xcc_id(); b.st = st;
    if (threadIdx.x == 0) (void)xb_add(&bar[XB_XCNT(b.x)], 1u);
    return b;
}
__device__ __forceinline__ void xcd_barrier_complete(unsigned* bar, unsigned x, unsigned& nloc, unsigned& nx) {
    const unsigned G = gridDim.x * gridDim.y * gridDim.z;
    unsigned sum, cnt, mine, sp = 0u;
    for (;;) {
        sum = 0u; cnt = 0u; mine = 0u;
#pragma unroll
        for (unsigned j = 0; j < 16; ++j) { const unsigned c = xb_ld(&bar[XB_XCNT(j)]); sum += c; cnt += (c > 0u) ? 1u : 0u; mine = (j == x) ? c : mine; }
        if (sum == G) break;
        __builtin_amdgcn_s_sleep(1);
        if ((++sp & 255u) == 0u) { if (xb_ld(&bar[XB_TMO])) break; if (sp > XB_SPIN_CAP) { atomicAdd(&bar[XB_TMO], 1u); break; } }
    }
    nloc = mine > 0u ? mine : 1u; nx = cnt > 0u ? cnt : 1u;
}
__device__ __forceinline__ void xcd_barrier(const XcdBarrier& b) {
    asm volatile("s_waitcnt vmcnt(0)" ::: "memory");
    __syncthreads();
    if (threadIdx.x == 0) {
        unsigned* bar = b.bar;
        __builtin_amdgcn_s_waitcnt(0);
        unsigned nloc = b.st[0], nx = b.st[1];
        if (nloc == 0u) { xcd_barrier_complete(bar, b.x, nloc, nx); b.st[0] = nloc; b.st[1] = nx; }
        const unsigned old = xb_add(&bar[XB_XSUB(b.x)], 1u);
        const unsigned gen = old / nloc;
        if (old + 1u == (gen + 1u) * nloc) {
            __builtin_amdgcn_fence(__ATOMIC_RELEASE, "agent");
            asm volatile("s_waitcnt vmcnt(0)" ::: "memory");
            const unsigned og = xb_add(&bar[XB_TOP], 1u);
            const unsigned tg = og / nx;
            if (og + 1u == (tg + 1u) * nx) xb_add(&bar[XB_TOPGEN], 1u);
            else XB_SPIN(xb_ld(&bar[XB_TOPGEN]) == tg, bar);
            __builtin_amdgcn_fence(__ATOMIC_ACQUIRE, "agent");
            xb_add(&bar[XB_XGEN(b.x)], 1u);
            asm volatile("s_waitcnt vmcnt(0)" ::: "memory");
        } else {
            XB_SPIN(xb_ld(&bar[XB_XGEN(b.x)]) == gen, bar);
            __builtin_amdgcn_fence(__ATOMIC_ACQUIRE, "agent");
            asm volatile("s_waitcnt vmcnt(0)" ::: "memory");
        }
    }
    __syncthreads();
}

struct Args { const float* in[27]; float* out; unsigned char* ws; int ph_lo, ph_hi; };
enum { I_X = 0, I_C, I_CTX, I_CCTX, I_WADA, I_BADA, I_WIN, I_NABIAS, I_GQG, I_GKG, I_SINK, I_MQG, I_WQB, I_MKVG, I_WKVB, I_WOUT, I_LN1G, I_LN1B, I_RGW, I_RGB, I_REW, I_REB, I_WG, I_WU, I_WDN, I_LN2G, I_LN2B };

struct Frame {
    LAS unsigned char* lds; volatile LAS unsigned* MISC;
    int tid, lane, wave, G, gw, ngw, bid;
    GAS unsigned char* ws;
};
__device__ __forceinline__ int opaque_tid() { int t = threadIdx.x; asm volatile("" : "+v"(t)); return t; }
__device__ __forceinline__ int opaque_s(int x) { asm volatile("" : "+s"(x)); return x; }
constexpr int PTAB_OFF = MISC_OFF + 2048, I_OUT = 27;
__device__ __forceinline__ GAS unsigned char* ptab_get(const Frame& F, int i) {
    const LAS unsigned* t = (const LAS unsigned*)(F.lds + PTAB_OFF) + 2 * i;
    const unsigned lo = __builtin_amdgcn_readfirstlane(t[0]), hi = __builtin_amdgcn_readfirstlane(t[1]);
    return (GAS unsigned char*)(((unsigned long long)hi << 32) | lo);
}
#define INP(i) ((const float*)ptab_get(F, (i)))
__device__ __forceinline__ Frame make_frame(GAS unsigned char* ws) {
    extern __shared__ __attribute__((aligned(16))) unsigned char lds_raw[];
    Frame F;
    F.lds = (LAS unsigned char*)lds_raw; F.MISC = (volatile LAS unsigned*)(F.lds + MISC_OFF);
    F.tid = opaque_tid(); F.lane = F.tid & 63; F.wave = __builtin_amdgcn_readfirstlane(F.tid >> 6);
    F.G = opaque_s((int)gridDim.x); F.bid = opaque_s((int)blockIdx.x); F.gw = F.bid * NWAVES + F.wave; F.ngw = F.G * NWAVES;
    { unsigned long long w = (unsigned long long)ws; asm volatile("" : "+s"(w)); F.ws = (GAS unsigned char*)w; }
    return F;
}
typedef _Float16 f16x4 __attribute__((ext_vector_type(4)));
struct RowPtrs { const float* x; const float* ctx; float* out; _Float16* xs; };
__device__ __forceinline__ RowPtrs row_ptrs(const Frame& F) { RowPtrs p; p.x = INP(I_X); p.ctx = INP(I_CTX); p.out = (float*)ptab_get(F, I_OUT); p.xs = (_Float16*)(F.ws + WS_XS); return p; }
__device__ __forceinline__ const float* xin_row(const RowPtrs& P, int r) {
    const int b = r / TT, t = r - b * TT;
    return t < SEQ ? P.x + ((size_t)b * SEQ + t) * D : P.ctx + ((size_t)b * CTX + (t - SEQ)) * D;
}
__device__ __forceinline__ float* out_row(const RowPtrs& P, int r) { const int b = r / TT, t = r - b * TT; return P.out + ((size_t)b * SEQ + t) * D; }
__device__ __forceinline__ void ld16h(const _Float16* p, int lane, float (&v)[16]) {
    const f16x4* q = (const f16x4*)p + lane;
#pragma unroll
    for (int g = 0; g < 4; ++g) { const f32x4 f = __builtin_convertvector(__builtin_nontemporal_load(q + 64 * g), f32x4); v[4 * g] = f.x; v[4 * g + 1] = f.y; v[4 * g + 2] = f.z; v[4 * g + 3] = f.w; }
}
__device__ __forceinline__ void st16h(_Float16* p, int lane, const float (&v)[16]) {
    f16x4* q = (f16x4*)p + lane;
#pragma unroll
    for (int g = 0; g < 4; ++g) __builtin_nontemporal_store(__builtin_convertvector((f32x4){v[4 * g], v[4 * g + 1], v[4 * g + 2], v[4 * g + 3]}, f16x4), q + 64 * g);
}
__device__ __forceinline__ void ld16(const float* p, int lane, float (&v)[16]) {
    const f32x4* q = (const f32x4*)p + lane;
    const f32x4 a = q[0], b = q[64], c = q[128], d = q[192];
    v[0] = a.x; v[1] = a.y; v[2] = a.z; v[3] = a.w; v[4] = b.x; v[5] = b.y; v[6] = b.z; v[7] = b.w;
    v[8] = c.x; v[9] = c.y; v[10] = c.z; v[11] = c.w; v[12] = d.x; v[13] = d.y; v[14] = d.z; v[15] = d.w;
}
__device__ __forceinline__ void st16(float* p, int lane, const float (&v)[16]) {
    f32x4* q = (f32x4*)p + lane;
    q[0] = (f32x4){v[0], v[1], v[2], v[3]}; q[64] = (f32x4){v[4], v[5], v[6], v[7]};
    q[128] = (f32x4){v[8], v[9], v[10], v[11]}; q[192] = (f32x4){v[12], v[13], v[14], v[15]};
}
__device__ __forceinline__ void ld16nt(const float* p, int lane, float (&v)[16]) {
    const f32x4* q = (const f32x4*)p + lane;
    const f32x4 a = __builtin_nontemporal_load(q), b = __builtin_nontemporal_load(q + 64), c = __builtin_nontemporal_load(q + 128), d = __builtin_nontemporal_load(q + 192);
    v[0] = a.x; v[1] = a.y; v[2] = a.z; v[3] = a.w; v[4] = b.x; v[5] = b.y; v[6] = b.z; v[7] = b.w;
    v[8] = c.x; v[9] = c.y; v[10] = c.z; v[11] = c.w; v[12] = d.x; v[13] = d.y; v[14] = d.z; v[15] = d.w;
}
__device__ __forceinline__ void st16nt(float* p, int lane, const float (&v)[16]) {
    f32x4* q = (f32x4*)p + lane;
    __builtin_nontemporal_store((f32x4){v[0], v[1], v[2], v[3]}, q); __builtin_nontemporal_store((f32x4){v[4], v[5], v[6], v[7]}, q + 64);
    __builtin_nontemporal_store((f32x4){v[8], v[9], v[10], v[11]}, q + 128); __builtin_nontemporal_store((f32x4){v[12], v[13], v[14], v[15]}, q + 192);
}
__device__ __forceinline__ void unpack16(const v2u (&w)[4], float (&v)[16]) {
#pragma unroll
    for (int g = 0; g < 4; ++g) { v[4 * g] = bflo(w[g].x); v[4 * g + 1] = bfhi(w[g].x); v[4 * g + 2] = bflo(w[g].y); v[4 * g + 3] = bfhi(w[g].y); }
}
__device__ __forceinline__ void ld16bf_raw(const bf16* p, int lane, v2u (&w)[4]) {
    const v2u* q = (const v2u*)p + lane; w[0] = q[0]; w[1] = q[64]; w[2] = q[128]; w[3] = q[192];
}
__device__ __forceinline__ void ld16bf_raw_nt(const bf16* p, int lane, v2u (&w)[4]) {
    const v2u* q = (const v2u*)p + lane; w[0] = __builtin_nontemporal_load(q); w[1] = __builtin_nontemporal_load(q + 64); w[2] = __builtin_nontemporal_load(q + 128); w[3] = __builtin_nontemporal_load(q + 192);
}
__device__ __forceinline__ void ld16bf(const bf16* p, int lane, float (&v)[16]) { v2u w[4]; ld16bf_raw(p, lane, w); unpack16(w, v); }
__device__ __forceinline__ void ld16bf_nt(const bf16* p, int lane, float (&v)[16]) { v2u w[4]; ld16bf_raw_nt(p, lane, w); unpack16(w, v); }
__device__ __forceinline__ void st16bf(bf16* p, int lane, const float (&v)[16]) {
    v2u* q = (v2u*)p + lane;
#pragma unroll
    for (int g = 0; g < 4; ++g) { v2u w; w.x = pk2(v[4 * g], v[4 * g + 1]); w.y = pk2(v[4 * g + 2], v[4 * g + 3]); q[64 * g] = w; }
}
__device__ __forceinline__ void ln16(float (&v)[16]) {
    float s = 0.f;
#pragma unroll
    for (int i = 0; i < 16; ++i) s += v[i];
    const float mean = wave_sum(s) * (1.0f / D); float q = 0.f;
#pragma unroll
    for (int i = 0; i < 16; ++i) { v[i] -= mean; q += v[i] * v[i]; }
    const float rstd = 1.0f / sqrtf(wave_sum(q) * (1.0f / D) + EPS);
#pragma unroll
    for (int i = 0; i < 16; ++i) v[i] *= rstd;
}

__device__ __forceinline__ int rows_per_wave(int ngw) {
    int rpw = (M + ngw - 1) / ngw;
    if (!((SEQ % rpw) % 4 == 0 && (TT % rpw) == 0 && (rpw % 2) == 0)) rpw = (rpw + 3) & ~3;
    return rpw;
}
template <int TYPE>
__device__ __forceinline__ float conv_src(const float* p0, const float* p1, const float* g0, const float* g1, int l, int k, int n) {
    if (TYPE == 0) return n < DPROJ ? p0[((size_t)l * D + k) * DPROJ + n] : 0.f;
    if (TYPE == 1) { if (n < 384) return k < 256 ? g0[l * 256 + k] * p0[((size_t)l * 256 + k) * 384 + n] : 0.f;
                     if (n < 896) return k >= 256 ? g1[l * 128 + (k - 256)] * p1[((size_t)l * 128 + (k - 256)) * 512 + (n - 384)] : 0.f;
                     return 0.f; }
    if (TYPE == 2) return p0[((size_t)l * D + k) * D + n];
    if (TYPE == 3) { const int e = n >> 10, nn = n & 1023, q = nn >> 3, j = nn & 7;
                     return j < 4 ? p0[(((size_t)l * 16 + e) * D + k) * 512 + 4 * q + j] : p1[(((size_t)l * 16 + e) * D + k) * 512 + 4 * q + (j - 4)]; }
    { const int e = n >> 10, nn = n & 1023; return p0[(((size_t)l * 16 + e) * 512 + k) * D + nn]; }
}
template <int TYPE>
__device__ __forceinline__ void conv_item(const Frame& F, int l, int item, LAS float* scr) {
    constexpr int Nd = TYPE == 0 ? NPJ : TYPE == 1 ? 1024 : TYPE == 2 ? 1024 : 16384, Kd = TYPE == 1 ? 384 : TYPE == 4 ? 512 : 1024;
    bf16* dst = (bf16*)(F.ws + (TYPE == 0 ? WS_WIN : TYPE == 1 ? WS_WD : TYPE == 2 ? WS_WOUT : TYPE == 3 ? WS_WGU : WS_WDN));
    const float* p0 = INP(TYPE == 0 ? I_WIN : TYPE == 1 ? I_WQB : TYPE == 2 ? I_WOUT : TYPE == 3 ? I_WG : I_WDN);
    const float* p1 = INP(TYPE == 1 ? I_WKVB : I_WU); const float* g0 = INP(I_MQG); const float* g1 = INP(I_MKVG);
    constexpr int nblk = Nd / 32; const int kb = item / nblk, nb = item - kb * nblk, k0 = 64 * kb, n0 = 32 * nb, lane = F.lane;
#pragma unroll
    for (int i = 0; i < 32; ++i) { const int kk = 2 * i + (lane >> 5); scr[kk * 33 + (lane & 31)] = conv_src<TYPE>(p0, p1, g0, g1, l, k0 + kk, n0 + (lane & 31)); }
    asm volatile("s_waitcnt lgkmcnt(0)" ::: "memory");
    const int c = lane & 7;
#pragma unroll
    for (int j = 0; j < 4; ++j) { const int n = (lane >> 3) + 8 * j; const LAS float* s = scr + (8 * c) * 33 + n;
        v4u o; o.x = pk2(s[0 * 33], s[1 * 33]); o.y = pk2(s[2 * 33], s[3 * 33]); o.z = pk2(s[4 * 33], s[5 * 33]); o.w = pk2(s[6 * 33], s[7 * 33]);
        *(v4u*)(dst + (size_t)(n0 + n) * Kd + k0 + 8 * c) = o; }
    asm volatile("s_waitcnt lgkmcnt(0)" ::: "memory");
}
__device__ __forceinline__ void phase_prologue(const Frame& F) {
    {
        LAS float* sv = (LAS float*)F.lds;
        LAS float* red = (LAS float*)(F.lds + 17 * 1024 * 4);
        float* mods = (float*)(F.ws + WS_MODS);
        for (int u = F.bid; u < NL * 48; u += F.G) {
            const int l = u / 48, cc = u - l * 48;
            const float* pc = INP(I_C); const float* pcc = INP(I_CCTX);
            for (int i = F.tid; i < 17 * 1024; i += NTHR) { const int mr = i >> 10, k = i & 1023; const float c = mr < 16 ? pc[mr * 1024 + k] : pcc[k]; sv[i] = c / (1.0f + expf(-c)); }
            __syncthreads();
            const int col = F.tid & 127, kg = F.tid >> 7;
            float acc[17];
#pragma unroll
            for (int mr = 0; mr < 17; ++mr) acc[mr] = 0.f;
            const float* w = INP(I_WADA) + ((size_t)l * 1024 + kg * 256) * 6144 + cc * 128 + col;
            for (int k4 = 0; k4 < 256; k4 += 4) {
                const float w0 = w[(size_t)(k4 + 0) * 6144], w1 = w[(size_t)(k4 + 1) * 6144], w2 = w[(size_t)(k4 + 2) * 6144], w3 = w[(size_t)(k4 + 3) * 6144];
#pragma unroll
                for (int mr = 0; mr < 17; ++mr) { const f32x4 s = *(const LAS f32x4*)(sv + mr * 1024 + kg * 256 + k4); acc[mr] += (s.x * w0 + s.y * w1) + (s.z * w2 + s.w * w3); }
            }
#pragma unroll
            for (int mr = 0; mr < 17; ++mr) red[(kg * 17 + mr) * 128 + col] = acc[mr];
            __syncthreads();
            const float* bada = INP(I_BADA);
            for (int i = F.tid; i < 17 * 128; i += NTHR) { const int mr = i >> 7, c = i & 127;
                const float s = (red[(0 * 17 + mr) * 128 + c] + red[(1 * 17 + mr) * 128 + c]) + (red[(2 * 17 + mr) * 128 + c] + red[(3 * 17 + mr) * 128 + c]);
                mods[((size_t)l * 17 + mr) * 6144 + cc * 128 + c] = s + bada[l * 6144 + cc * 128 + c]; }
            __syncthreads();
        }
    }
    {
        float* t64 = (float*)(F.ws + WS_T64); float* t32 = (float*)(F.ws + WS_T32);
        for (int i = F.bid * NTHR + F.tid; i < 64 * 16 + 64 * 8; i += F.G * NTHR) {
            if (i < 1024) { const int p = i >> 4, k = i & 15; const float fr = powf(10000.0f, -(float)k / 16.0f), ang = (float)p * fr; t64[2 * i] = cosf(ang); t64[2 * i + 1] = sinf(ang); }
            else { const int j = i - 1024, p = j >> 3, k = j & 7; const float fr = powf(10000.0f, -(float)k / 8.0f), ang = (float)p * fr; t32[2 * j] = cosf(ang); t32[2 * j + 1] = sinf(ang); }
        }
    }
}
__device__ __forceinline__ void convert_layer_weights(const Frame& F, int l) {
    {
        LAS float* scr = (LAS float*)(F.lds + F.wave * 8448);
        constexpr int I0 = 1152, I1 = 192, I2 = 512, I3 = 8192, I4 = 4096, IL = I0 + I1 + I2 + I3 + I4;
        for (int r0_ = F.gw; r0_ < IL; r0_ += F.ngw) {
            int r = r0_;
            if (r < I0) { conv_item<0>(F, l, r, scr); continue; } r -= I0;
            if (r < I1) { conv_item<1>(F, l, r, scr); continue; } r -= I1;
            if (r < I2) { conv_item<2>(F, l, r, scr); continue; } r -= I2;
            if (r < I3) { conv_item<3>(F, l, r, scr); continue; } r -= I3;
            conv_item<4>(F, l, r, scr);
        }
    }
}

__device__ __forceinline__ void phase_ln(const Frame& F, int l) {
    if (l < NL) convert_layer_weights(F, l);
    constexpr int NR = 4;
    const float* mods = (const float*)(F.ws + WS_MODS); bf16* HA = (bf16*)(F.ws + WS_HA);
    const bf16* Y = (const bf16*)(F.ws + WS_PB); const unsigned* RT = (const unsigned*)(F.ws + WS_RT);
    const int lane = F.lane; const RowPtrs RP = row_ptrs(F);
    const float* ln2g = INP(I_LN2G) + (l > 0 ? l - 1 : 0) * D; const float* ln2b = INP(I_LN2B) + (l > 0 ? l - 1 : 0) * D;
    const int rpw = rows_per_wave(F.ngw), rbeg = F.gw * rpw, rend = min(M, rbeg + rpw);
    float g2[16]; int cur_mr = -1;
    for (int r0 = rbeg; r0 < rend; r0 += NR) {
        float v[NR][16]; v4u rt[NR]; v2u ya[NR][4], yb[NR][4]; bool act[NR];
        const int b0 = r0 / TT, t0 = r0 - b0 * TT; const bool lat = t0 < SEQ; const int mr = lat ? b0 : 16;
        if (l == NL && !lat) continue;
#pragma unroll
        for (int u = 0; u < NR; ++u) {
            const int r = r0 + u; act[u] = r < rend; const int rc = act[u] ? r : r0;
            if (l == 0) ld16nt(xin_row(RP, rc), lane, v[u]); else ld16h(RP.xs + (size_t)rc * D, lane, v[u]);
            rt[u] = *(const v4u*)(RT + (size_t)rc * 8 + 4);
        }
        if (mr != cur_mr) { if (l > 0) ld16(mods + ((size_t)(l - 1) * 17 + mr) * 6144 + 5120, lane, g2); cur_mr = mr; }
        if (l > 0) {
#pragma unroll
            for (int u = 0; u < NR; ++u) { ld16bf_raw_nt(Y + (size_t)rt[u].z * D, lane, ya[u]); ld16bf_raw_nt(Y + (size_t)rt[u].w * D, lane, yb[u]); }
#pragma unroll
            for (int u = 0; u < NR; ++u) {
                float f0[16], f1[16], gg[16], bb[16];
                const float w0 = __uint_as_float(rt[u].x), w1 = __uint_as_float(rt[u].y);
                unpack16(ya[u], f0); unpack16(yb[u], f1);
#pragma unroll
                for (int i = 0; i < 16; ++i) v[u][i] = ALPHA * v[u][i] + g2[i] * (w0 * f0[i] + w1 * f1[i]);
                ld16(ln2g, lane, gg); ld16(ln2b, lane, bb);
                ln16(v[u]);
#pragma unroll
                for (int i = 0; i < 16; ++i) v[u][i] = v[u][i] * gg[i] + bb[i];
                if (act[u]) { if (l == NL) st16nt(out_row(RP, r0 + u), lane, v[u]); else st16h(RP.xs + (size_t)(r0 + u) * D, lane, v[u]); }
            }
        }
        if (l < NL) {
            float sh[16], sc[16]; ld16(mods + ((size_t)l * 17 + mr) * 6144, lane, sh); ld16(mods + ((size_t)l * 17 + mr) * 6144 + 1024, lane, sc);
#pragma unroll
            for (int u = 0; u < NR; ++u) {
                ln16(v[u]);
#pragma unroll
                for (int i = 0; i < 16; ++i) v[u][i] = v[u][i] * (1.0f + sc[i]) + sh[i];
                if (act[u]) st16bf(HA + (size_t)(r0 + u) * D, lane, v[u]);
            }
        }
    }
}

__device__ __forceinline__ void rope8(float (&f)[8], const float (&p)[8], const float* cs, bool first) {
    const f32x4* c4 = (const f32x4*)cs;
#pragma unroll
    for (int q = 0; q < 4; ++q) { const f32x4 t = c4[q];
        f[2 * q] = first ? f[2 * q] * t.x - p[2 * q] * t.y : p[2 * q] * t.y + f[2 * q] * t.x;
        f[2 * q + 1] = first ? f[2 * q + 1] * t.z - p[2 * q + 1] * t.w : p[2 * q + 1] * t.w + f[2 * q + 1] * t.z; }
}
__device__ __forceinline__ void phase_post(const Frame& F, int l) {
    constexpr int NR = 4;
    bf16* P = (bf16*)(F.ws + WS_PB); bf16* KD = (bf16*)(F.ws + WS_KD);
    const float* t64 = (const float*)(F.ws + WS_T64); const float* t32 = (const float*)(F.ws + WS_T32);
    const int lane = F.lane; const float* gains = (lane < 32 ? INP(I_GQG) : INP(I_GKG)) + l * 64;
    const int j = lane & 7, jj = lane & 3;
    float gn[8];
#pragma unroll
    for (int i = 0; i < 8; ++i) gn[i] = gains[j * 8 + i];
    for (int r0 = F.gw; r0 < M; r0 += NR * F.ngw) {
        v4u w0[NR], w1[NR], w2[NR]; int rr[NR]; bool act[NR];
#pragma unroll
        for (int u = 0; u < NR; ++u) { const int r = r0 + u * F.ngw; act[u] = r < M; rr[u] = act[u] ? r : r0; const bf16* prow = P + (size_t)rr[u] * NPJ;
            w0[u] = *((const v4u*)(prow + 768) + lane); w1[u] = *((const v4u*)(prow + 1280) + lane); w2[u] = *((const v4u*)(prow + 1792) + lane); }
#pragma unroll
        for (int u = 0; u < NR; ++u) {
            const int r = rr[u]; const int b = r / TT, t = r - b * TT; const bool lat = t < SEQ; const int gr = (t >> 6) & 63, gc = t & 63;
            bf16* prow = P + (size_t)r * NPJ;
            const float* cs64 = t64 + ((size_t)((j < 4 ? gr : gc) * 16 + (j & 1) * 8)) * 2;
            {
                float f[8]; unpack8(w0[u], f);
                float ss = 0.f;
#pragma unroll
                for (int i = 0; i < 8; ++i) ss += f[i] * f[i];
                ss += __shfl_xor(ss, 1); ss += __shfl_xor(ss, 2); ss += __shfl_xor(ss, 4);
                const float rs = 1.0f / sqrtf(ss * (1.0f / 64.0f) + EPS);
#pragma unroll
                for (int i = 0; i < 8; ++i) f[i] = f[i] * rs * gn[i];
                float p[8];
#pragma unroll
                for (int i = 0; i < 8; ++i) p[i] = __shfl_xor(f[i], 2);
                if (lat) rope8(f, p, cs64, (j & 2) == 0);
                if (lane < 48 && act[u]) *((v4u*)(prow + 768) + lane) = pack8(f);
            }
            {
                float f[8]; unpack8(w1[u], f);
                float p[8];
#pragma unroll
                for (int i = 0; i < 8; ++i) p[i] = __shfl_xor(f[i], 2);
                rope8(f, p, cs64, (j & 2) == 0);
                if (lat && lane < 48 && act[u]) *((v4u*)(prow + 1280) + lane) = pack8(f);
            }
            {
                float f[8]; unpack8(w2[u], f);
                float ss = 0.f;
#pragma unroll
                for (int i = 0; i < 8; ++i) ss += f[i] * f[i];
                ss += __shfl_xor(ss, 1); ss += __shfl_xor(ss, 2); ss += __shfl_xor(ss, 4); ss += __shfl_xor(ss, 8);
                const float s32 = ss + __shfl_xor(ss, 16);
                const float rn = lane < 32 ? 1.0f / sqrtf(s32 * (1.0f / 256.0f) + EPS) : 1.0f / sqrtf(ss * (1.0f / 128.0f) + EPS);
                if (lane < 48 && act[u]) { float fn[8];
#pragma unroll
                    for (int i = 0; i < 8; ++i) fn[i] = f[i] * rn;
                    *((v4u*)(prow + 1792) + lane) = pack8(fn); }
                float p[8];
#pragma unroll
                for (int i = 0; i < 8; ++i) p[i] = __shfl_xor(f[i], 1);
                if (lat) rope8(f, p, t32 + ((size_t)((jj < 2 ? gr : gc) * 8)) * 2, (jj & 1) == 0);
                if (lane >= 48 && lane < 52 && act[u]) { const v4u o = pack8(f);
#pragma unroll
                    for (int h = 0; h < 4; ++h) *(v4u*)(KD + (size_t)r * 384 + h * 96 + 64 + 8 * jj) = o; }
            }
        }
    }
}

__device__ __forceinline__ void phase_route(const Frame& F, int l) {
    const float* mods = (const float*)(F.ws + WS_MODS); bf16* HA = (bf16*)(F.ws + WS_HA);
    const bf16* MIX = (const bf16*)(F.ws + WS_PB); unsigned* RT = (unsigned*)(F.ws + WS_RT); int* HIST = (int*)(F.ws + WS_HIST);
    LAS float* WR = (LAS float*)F.lds;
    { const float* rgw = INP(I_RGW); const float* rew = INP(I_REW);
      for (int i = F.tid; i < 20 * 1024; i += NTHR) { const int jx = i >> 10, k = i & 1023;
        WR[i] = jx < 4 ? rgw[((size_t)l * D + k) * 4 + jx] : rew[((size_t)l * D + k) * 16 + (jx - 4)]; } }
    if (F.tid < 16) F.MISC[MI_LH + F.tid] = 0u;
    __syncthreads();
    LAS float* bias = (LAS float*)(F.lds + 20 * 1024 * 4);
    if (F.tid < 20) bias[F.tid] = F.tid < 4 ? INP(I_RGB)[l * 4 + F.tid] : INP(I_REB)[l * 16 + (F.tid - 4)];
    __syncthreads();
    const RowPtrs RP = row_ptrs(F); const float* ln1g = INP(I_LN1G) + l * D; const float* ln1b = INP(I_LN1B) + l * D;
    constexpr int NR = 2;
    const int rpw = rows_per_wave(F.ngw), rbeg = F.gw * rpw, rend = min(M, rbeg + rpw);
    float g1[16], sh[16], sc[16]; int cur_mr = -1;
    for (int r0 = rbeg; r0 < rend; r0 += NR) {
        if (l == NL - 1 && (r0 % TT) >= SEQ) continue;
        float v[NR][16], mx[NR][16], gg[16], bb[16]; int rr[NR]; bool act[NR];
#pragma unroll
        for (int u = 0; u < NR; ++u) { const int r = r0 + u; act[u] = r < rend; rr[u] = act[u] ? r : r0;
            if (l == 0) ld16nt(xin_row(RP, rr[u]), F.lane, v[u]); else ld16h(RP.xs + (size_t)rr[u] * D, F.lane, v[u]);
            ld16bf_nt(MIX + (size_t)rr[u] * D, F.lane, mx[u]); }
        ld16(ln1g, F.lane, gg); ld16(ln1b, F.lane, bb);
        { const int b = r0 / TT, t = r0 - b * TT, mr = t < SEQ ? b : 16;
          if (mr != cur_mr) { const float* md = mods + ((size_t)l * 17 + mr) * 6144; ld16(md + 2048, F.lane, g1); ld16(md + 3072, F.lane, sh); ld16(md + 4096, F.lane, sc); cur_mr = mr; } }
#pragma unroll
        for (int u = 0; u < NR; ++u) {
#pragma unroll
            for (int i = 0; i < 16; ++i) v[u][i] = ALPHA * v[u][i] + g1[i] * mx[u][i]; }
#pragma unroll
        for (int u = 0; u < NR; ++u) ln16(v[u]);
#pragma unroll
        for (int u = 0; u < NR; ++u) {
#pragma unroll
            for (int i = 0; i < 16; ++i) v[u][i] = v[u][i] * gg[i] + bb[i];
            if (act[u]) st16h(RP.xs + (size_t)rr[u] * D, F.lane, v[u]); }
#pragma unroll
        for (int u = 0; u < NR; ++u) ln16(v[u]);
#pragma unroll
        for (int u = 0; u < NR; ++u) {
#pragma unroll
            for (int i = 0; i < 16; ++i) v[u][i] = v[u][i] * (1.0f + sc[i]) + sh[i];
            if (act[u]) st16bf(HA + (size_t)rr[u] * D, F.lane, v[u]); }
        float lgt[NR][20];
#pragma unroll
        for (int jx = 0; jx < 20; ++jx) {
            const LAS f32x4* wq = (const LAS f32x4*)(WR + jx * 1024);
            const f32x4 w0 = wq[F.lane], w1 = wq[64 + F.lane], w2 = wq[128 + F.lane], w3 = wq[192 + F.lane];
#pragma unroll
            for (int u = 0; u < NR; ++u) {
                const float sm = (v[u][0] * w0.x + v[u][1] * w0.y) + (v[u][2] * w0.z + v[u][3] * w0.w) + (v[u][4] * w1.x + v[u][5] * w1.y) + (v[u][6] * w1.z + v[u][7] * w1.w)
                               + (v[u][8] * w2.x + v[u][9] * w2.y) + (v[u][10] * w2.z + v[u][11] * w2.w) + (v[u][12] * w3.x + v[u][13] * w3.y) + (v[u][14] * w3.z + v[u][15] * w3.w);
                lgt[u][jx] = sm; }
        }
#pragma unroll
        for (int o = 1; o < 64; o <<= 1)
#pragma unroll
            for (int u = 0; u < NR; ++u)
#pragma unroll
                for (int jx = 0; jx < 20; ++jx) lgt[u][jx] += __shfl_xor(lgt[u][jx], o);
#pragma unroll
        for (int u = 0; u < NR; ++u) {
#pragma unroll
            for (int jx = 0; jx < 20; ++jx) lgt[u][jx] += bias[jx];
            int grp = 0; float mg = lgt[u][0];
#pragma unroll
            for (int g = 1; g < 4; ++g) if (lgt[u][g] > mg) { mg = lgt[u][g]; grp = g; }
            float sg = 0.f;
#pragma unroll
            for (int g = 0; g < 4; ++g) sg += expf(lgt[u][g] - mg);
            const float pg = 1.0f / sg;
            float sel[4];
#pragma unroll
            for (int i = 0; i < 4; ++i) sel[i] = grp == 0 ? lgt[u][4 + i] : grp == 1 ? lgt[u][8 + i] : grp == 2 ? lgt[u][12 + i] : lgt[u][16 + i];
            int i1 = 0; float v1 = sel[0];
#pragma unroll
            for (int i = 1; i < 4; ++i) if (sel[i] > v1) { v1 = sel[i]; i1 = i; }
            int i2 = -1; float v2 = -3.0e38f;
#pragma unroll
            for (int i = 0; i < 4; ++i) if (i != i1 && (i2 < 0 || sel[i] > v2)) { v2 = sel[i]; i2 = i; }
            const float ee = expf(v2 - v1), w1 = pg / (1.0f + ee), w2 = pg * ee / (1.0f + ee);
            const int e1 = grp * 4 + i1, e2 = grp * 4 + i2;
            if (F.lane == 0 && act[u]) {
                const unsigned k1 = __hip_atomic_fetch_add((LAS unsigned*)&F.MISC[MI_LH + e1], 1u, __ATOMIC_RELAXED, __HIP_MEMORY_SCOPE_WORKGROUP);
                const unsigned k2 = __hip_atomic_fetch_add((LAS unsigned*)&F.MISC[MI_LH + e2], 1u, __ATOMIC_RELAXED, __HIP_MEMORY_SCOPE_WORKGROUP);
                v4u ra; ra.x = (unsigned)e1; ra.y = (unsigned)e2; ra.z = k1; ra.w = k2;
                v4u rb; rb.x = __builtin_bit_cast(unsigned, w1); rb.y = __builtin_bit_cast(unsigned, w2); rb.z = 0u; rb.w = 0u;
                *(v4u*)(RT + (size_t)rr[u] * 8) = ra; *(v4u*)(RT + (size_t)rr[u] * 8 + 4) = rb;
            }
        }
    }
    __syncthreads();
    if (F.tid < 16) HIST[F.bid * 16 + F.tid] = (int)F.MISC[MI_LH + F.tid];
}
__device__ __forceinline__ void moe_tables(const Frame& F) {
    const int* HIST = (const int*)(F.ws + WS_HIST); LAS int* hl = (LAS int*)F.lds;
    __syncthreads();
    for (int i = F.tid; i < F.G * 16; i += NTHR) hl[i] = HIST[i];
    __syncthreads();
    if (F.tid < 16) { int tot = 0, mine = 0; for (int g = 0; g < F.G; ++g) { const int c = hl[g * 16 + F.tid]; tot += c; mine += (g < F.bid) ? c : 0; }
        F.MISC[MI_TOT + F.tid] = (unsigned)tot; F.MISC[MI_BASE + F.tid] = (unsigned)mine; }
    __syncthreads();
    if (F.tid == 0) { unsigned p = 0; for (int e = 0; e < 16; ++e) { F.MISC[MI_PST + e] = p; F.MISC[MI_BASE + e] += p * 256u; p += (F.MISC[MI_TOT + e] + 255u) >> 8; } F.MISC[MI_PST + 16] = p; }
    __syncthreads();
}
__device__ __forceinline__ void phase_permute(const Frame& F, int l) {
    unsigned* RT = (unsigned*)(F.ws + WS_RT); int* SRC = (int*)(F.ws + WS_QD);
    moe_tables(F);
    const int rpw = rows_per_wave(F.ngw), rbeg = F.gw * rpw, rend = min(M, rbeg + rpw);
    for (int r = rbeg + F.lane; r < rend; r += 64) {
        if (l == NL - 1 && (r % TT) >= SEQ) continue;
        const v4u ra = *(const v4u*)(RT + (size_t)r * 8);
        const unsigned p0 = F.MISC[MI_BASE + (ra.x & 15u)] + ra.z, p1 = F.MISC[MI_BASE + (ra.y & 15u)] + ra.w;
        RT[(size_t)r * 8 + 6] = p0; RT[(size_t)r * 8 + 7] = p1; SRC[p0] = r; SRC[p1] = r;
    }
    if (F.bid == 0) {
        for (int e = 0; e < 16; ++e) { const int beg = (int)F.MISC[MI_PST + e] * 256 + (int)F.MISC[MI_TOT + e], end = (int)F.MISC[MI_PST + e + 1] * 256;
            for (int p = beg + F.tid; p < end; p += NTHR) SRC[p] = 0; }
    }
}

struct EpiMla {
    static constexpr bool PERM = true, AFTER_DRAIN = false;
    bf16* QD; bf16* KD; bf16* VD;
    __device__ __forceinline__ void operator()(const pg8::f32x4 (&acc)[2][2][4][2], const pg8::Unit& u, int wr, int wc, int fr, int fq) const {
#pragma unroll
        for (int bj = 0; bj < 2; ++bj) {
            const int g0 = u.pn * 256 + bj * 128 + wc * 32, col0 = g0 + 8 * fq;
            if (g0 >= 896) continue;
            const int c = col0 - 384, hd = c >> 7, jx = c & 127;
            bf16* dst = g0 < 384 ? QD + col0 : jx < 64 ? KD + hd * 96 + jx : VD + hd * 64 + (jx - 64);
            const int stride = (g0 < 384 || jx < 64) ? 384 : 256;
            dst += (size_t)(u.pm * 256 + wr * 64 + fr) * stride;
#pragma unroll
            for (int ai = 0; ai < 2; ++ai)
#pragma unroll
                for (int m = 0; m < 4; ++m) {
                    v4u o; o.x = pk2(acc[ai][bj][m][0][0], acc[ai][bj][m][0][1]); o.y = pk2(acc[ai][bj][m][0][2], acc[ai][bj][m][0][3]);
                    o.z = pk2(acc[ai][bj][m][1][0], acc[ai][bj][m][1][1]); o.w = pk2(acc[ai][bj][m][1][2], acc[ai][bj][m][1][3]);
                    *(v4u*)(dst + (size_t)(ai * 128 + m * 16) * stride) = o;
                }
        }
    }
};
struct EpiGU {
    static constexpr bool PERM = true, AFTER_DRAIN = false;
    bf16* ACT;
    __device__ __forceinline__ void operator()(const pg8::f32x4 (&acc)[2][2][4][2], const pg8::Unit& u, int wr, int wc, int fr, int fq) const {
#pragma unroll
        for (int ai = 0; ai < 2; ++ai)
#pragma unroll
            for (int m = 0; m < 4; ++m) {
                const int row = u.pm * 256 + ai * 128 + wr * 64 + m * 16 + fr;
#pragma unroll
                for (int bj = 0; bj < 2; ++bj) {
                    const int c = (u.pn & 3) * 256 + bj * 128 + wc * 32 + 8 * fq;
                    float o[4];
#pragma unroll
                    for (int i = 0; i < 4; ++i) { const float g = acc[ai][bj][m][0][i], up = acc[ai][bj][m][1][i]; o[i] = g / (1.0f + __expf(-g)) * up; }
                    v2u w; w.x = pk2(o[0], o[1]); w.y = pk2(o[2], o[3]);
                    *(v2u*)(ACT + (size_t)row * 512 + (c >> 1)) = w;
                }
            }
    }
};
struct MoeOrder {
    volatile LAS unsigned* pst; int G, c;
    __device__ __forceinline__ bool next(int i, pg8::Unit& u) const {
        const int np = (int)pst[16]; int panel, pn;
        if ((G & 7) == 0) { const int x = c & 7, uu = i * (G >> 3) + (c >> 3); panel = (uu >> 2) * 8 + x; pn = uu & 3; }
        else { const int L = i * G + c; panel = L >> 2; pn = L & 3; }
        if (panel >= np) return false;
        int e = 0;
#pragma unroll
        for (int k = 1; k < 16; ++k) e += (panel >= (int)pst[k]) ? 1 : 0;
        u.pm = __builtin_amdgcn_readfirstlane(panel); u.pn = __builtin_amdgcn_readfirstlane(e * 4 + pn); return true;
    }
    __device__ __forceinline__ void a_ready(const pg8::Unit&) const {}
    __device__ __forceinline__ void done(const pg8::Unit&) const {}
};

struct LatOrder {
    int G, c;
    __device__ __forceinline__ bool next(int i, pg8::Unit& u) const {
        int pl, pn;
        if ((G & 7) == 0) { const int x = c & 7, uu = i * (G >> 3) + (c >> 3); pl = (uu >> 2) * 8 + x; pn = uu & 3; } else { const int L = i * G + c; pl = L >> 2; pn = L & 3; }
        if (pl >= NB * 16) return false;
        u.pm = pl + (pl >> 4); u.pn = pn; return true;
    }
    __device__ __forceinline__ void a_ready(const pg8::Unit&) const {}
    __device__ __forceinline__ void done(const pg8::Unit&) const {}
};

#ifndef DBG_VAR
#define DBG_VAR 1
#endif
namespace att {
constexpr int VRS = 192, KBUF = 64 * 208, VBUF = 64 * VRS, BUF = KBUF + VBUF, BIAS_OFF = 4 * BUF;
constexpr float NEG = -30000.0f;
__device__ __forceinline__ int crow(int r, int hi) { return (r & 3) + 8 * (r >> 2) + 4 * hi; }
__device__ __forceinline__ float xhalf_max(float v) { const unsigned a = __builtin_bit_cast(unsigned, v);
    auto rr = __builtin_amdgcn_permlane32_swap(a, a, false, false); const unsigned r0 = rr[0], r1 = rr[1]; return fmaxf(__uint_as_float(r0), __uint_as_float(r1)); }
__device__ __forceinline__ float xhalf_sum(float v) { const unsigned a = __builtin_bit_cast(unsigned, v);
    auto rr = __builtin_amdgcn_permlane32_swap(a, a, false, false); const unsigned r0 = rr[0], r1 = rr[1]; return __uint_as_float(r0) + __uint_as_float(r1); }
__device__ __forceinline__ float max3f(float a, float b, float c) { float r; asm("v_max3_f32 %0, %1, %2, %3" : "=v"(r) : "v"(a), "v"(b), "v"(c)); return r; }
typedef __bf16 bf16x2_t __attribute__((ext_vector_type(2)));
__device__ __forceinline__ unsigned cvtpk(float lo, float hi) { f32x2 v = {lo, hi}; bf16x2_t b = __builtin_convertvector(v, bf16x2_t); return __builtin_bit_cast(unsigned, b); }

template <int DK, int VM = 0>
__device__ __forceinline__ void unit(LAS unsigned char* lds, const bf16* Qp, int qpitch, const bf16* Kp, int kpitch, const bf16* Vp, int vpitch, bf16* Op,
                                     int var, int qt, int lo, int n1, int nt, float qscale, float sinkl2, bool has_sink, const LAS float* bias, const float* t32, unsigned* dbg) {
    constexpr int KRS = DK * 2 + 16, NS = DK / 16, CPK = DK / 8;
    int tid = threadIdx.x; asm volatile("" : "+v"(tid)); const int lane = tid & 63, r32 = lane & 31, hi = lane >> 5, wid = __builtin_amdgcn_readfirstlane(tid >> 6);
    const int qrow = 256 * qt + 32 * wid + r32;
    bf16x8 qr[NS];
#pragma unroll
    for (int s = 0; s < NS; ++s) { const v4u raw = *(const v4u*)(Qp + (size_t)qrow * qpitch + 16 * s + 8 * hi); float f[8]; unpack8(raw, f);
#pragma unroll
        for (int i = 0; i < 8; ++i) f[i] *= qscale;
        if (DK == 96 && s >= 4) {
            float p[8];
#pragma unroll
            for (int i = 0; i < 8; ++i) p[i] = __shfl_xor(f[i], 32);
            if (qt < 16) rope8(f, p, t32 + ((size_t)((s == 4 ? (qrow >> 6) : (qrow & 63)) * 8)) * 2, hi == 0);
        }
        qr[s] = __builtin_bit_cast(bf16x8, pack8(f)); }
    const int kkey0 = tid / CPK, kch0 = tid - kkey0 * CPK, kkey1 = (tid + 512) / CPK, kch1 = (tid + 512) - kkey1 * CPK;
    const int vkey = tid >> 3, vch = tid & 7;
    v4u kreg0, kreg1 = {0u, 0u, 0u, 0u}, vreg;
#define ATT_TROW(j) ((((j) < n1) ? (lo + (j)) : (64 + (j) - n1)) * 64)
#define ATT_LOAD(j) do { const int tr_ = ATT_TROW(j); kreg0 = *(const v4u*)(Kp + (size_t)(tr_ + kkey0) * kpitch + kch0 * 8); \
        if (DK == 96 && tid < 256) kreg1 = *(const v4u*)(Kp + (size_t)(tr_ + kkey1) * kpitch + kch1 * 8); \
        vreg = *(const v4u*)(Vp + (size_t)(tr_ + vkey) * vpitch + vch * 8); } while (0)
#define ATT_STORE(bf) do { LAS unsigned char* b_ = lds + (bf) * BUF; *(LAS v4u*)(b_ + kkey0 * KRS + kch0 * 16) = kreg0; \
        if (DK == 96 && tid < 256) *(LAS v4u*)(b_ + kkey1 * KRS + kch1 * 16) = kreg1; \
        *(LAS v4u*)(b_ + KBUF + vkey * VRS + vch * 16) = vreg; } while (0)
    constexpr float THR = 6.0f;
    float m = 0.f; f32x2 lacc = {0.f, 0.f}; f32x16 o0 = {}, o1 = {}; f32x16 negm = {}; bool first = true;
    const int grw = 4 * qt + (wid >> 1), r0w = min(max(grw - 4, 0), 56), gc = (wid & 1) * 32 + r32, c0 = min(max(gc - 8, 0), 48), i0w = 256 * qt + 32 * wid;
    ATT_LOAD(0); ATT_STORE(0);
    __syncthreads();
    for (int j = 0; j < nt; ++j) {
        if (!(VM & 8) && j + 1 < nt) ATT_LOAD(j + 1);
        const int kt = ATT_TROW(j) >> 6;
        bool actv = true;
        if (kt < 64) { if (var == 0) actv = (kt >= r0w) && (kt <= r0w + 7); else if (var == 2) actv = !((64 * kt - (i0w + 31) > 128) || (i0w - (64 * kt + 63) > 128)); }
        if (actv) {
            const LAS unsigned char* Kb = lds + (j & 1) * BUF; const LAS unsigned char* Vb = Kb + KBUF;
            f32x16 s0 = negm, s1 = negm;
            bf16x8 ka[NS], kb[NS];
#pragma unroll
            for (int s = 0; s < NS; ++s) { ka[s] = *(const LAS bf16x8*)(Kb + r32 * KRS + (16 * s + 8 * hi) * 2); kb[s] = *(const LAS bf16x8*)(Kb + (32 + r32) * KRS + (16 * s + 8 * hi) * 2); }
            __builtin_amdgcn_sched_barrier(0);
            if (VM & 2) {
#pragma unroll
                for (int s = 0; s < NS; ++s) asm volatile("" :: "v"(ka[s]), "v"(kb[s]), "v"(qr[s]));
            } else {
#pragma unroll
            for (int s = 0; s < NS; ++s) { s0 = __builtin_amdgcn_mfma_f32_32x32x16_bf16(ka[s], qr[s], s0, 0, 0, 0); s1 = __builtin_amdgcn_mfma_f32_32x32x16_bf16(kb[s], qr[s], s1, 0, 0, 0); }
            }
            asm volatile("s_nop 15\n\ts_nop 7" : "+v"(s0), "+v"(s1));
            if (kt < 64 && var == 0) {
                const int rowoff = (kt - grw + 7) * 31 - gc + 15;
#pragma unroll
                for (int r = 0; r < 16; ++r) { const int j0 = crow(r, hi), j1 = j0 + 32;
                    const bool v0 = (unsigned)(j0 - c0) < 16u, v1 = (unsigned)(j1 - c0) < 16u;
                    const float b0 = bias[v0 ? rowoff + j0 : 0], b1 = bias[v1 ? rowoff + j1 : 0];
                    s0[r] = v0 ? s0[r] + b0 : NEG; s1[r] = v1 ? s1[r] + b1 : NEG; }
            } else if (kt < 64 && var == 2) {
                const int dbase = 64 * kt - qrow + 128;
#pragma unroll
                for (int r = 0; r < 16; ++r) { const int j0 = crow(r, hi);
                    s0[r] = (unsigned)(dbase + j0) <= 256u ? s0[r] : NEG; s1[r] = (unsigned)(dbase + j0 + 32) <= 256u ? s1[r] : NEG; }
            }
            if (!(VM & 4)) {
            float mxa = max3f(s0[0], s0[1], s1[0]), mxb = max3f(s0[2], s0[3], s1[1]); mxa = max3f(mxa, s1[2], s1[3]);
#pragma unroll
            for (int r = 4; r < 16; r += 4) { mxa = max3f(mxa, s0[r], s0[r + 1]); mxb = max3f(mxb, s0[r + 2], s0[r + 3]); mxa = max3f(mxa, s1[r], s1[r + 1]); mxb = max3f(mxb, s1[r + 2], s1[r + 3]); }
            const float mx = xhalf_max(fmaxf(mxa, mxb));
            if (first || __any(mx > THR)) {
                const float d = first ? fmaxf(mx, -64.0f) : fmaxf(mx, 0.f), alpha = __builtin_amdgcn_exp2f(-d);
                m += d; first = false;
#pragma unroll
                for (int r = 0; r < 16; ++r) { s0[r] -= d; s1[r] -= d; o0[r] *= alpha; o1[r] *= alpha; negm[r] = -m; }
                lacc *= alpha;
            }
#pragma unroll
            for (int r = 0; r < 16; ++r) { s0[r] = __builtin_amdgcn_exp2f(s0[r]); s1[r] = __builtin_amdgcn_exp2f(s1[r]); lacc += (f32x2){s0[r], s1[r]}; }
            }
            bf16x8 pb[4];
#pragma unroll
            for (int s = 0; s < 2; ++s) {
                v4u w; w.x = cvtpk(s0[8 * s], s0[8 * s + 1]); w.y = cvtpk(s0[8 * s + 2], s0[8 * s + 3]); w.z = cvtpk(s0[8 * s + 4], s0[8 * s + 5]); w.w = cvtpk(s0[8 * s + 6], s0[8 * s + 7]);
                pb[s] = __builtin_bit_cast(bf16x8, w);
                v4u x; x.x = cvtpk(s1[8 * s], s1[8 * s + 1]); x.y = cvtpk(s1[8 * s + 2], s1[8 * s + 3]); x.z = cvtpk(s1[8 * s + 4], s1[8 * s + 5]); x.w = cvtpk(s1[8 * s + 6], s1[8 * s + 7]);
                pb[2 + s] = __builtin_bit_cast(bf16x8, x);
            }
            if (VM & 1) { asm volatile("" :: "v"(pb[0]), "v"(pb[1]), "v"(pb[2]), "v"(pb[3])); } else {
            const LAS unsigned char* vbase = Vb + (4 * hi + ((lane & 15) >> 2)) * VRS + ((lane >> 4) & 1) * 32 + (lane & 3) * 8;
#pragma unroll
            for (int s = 0; s < 4; ++s) {
                const v4i16 a0 = __builtin_amdgcn_ds_read_tr16_b64_v4i16((LAS v4i16*)(vbase + (16 * s) * VRS));
                const v4i16 a1 = __builtin_amdgcn_ds_read_tr16_b64_v4i16((LAS v4i16*)(vbase + (16 * s + 8) * VRS));
                const v4i16 c0_ = __builtin_amdgcn_ds_read_tr16_b64_v4i16((LAS v4i16*)(vbase + (16 * s) * VRS + 64));
                const v4i16 c1_ = __builtin_amdgcn_ds_read_tr16_b64_v4i16((LAS v4i16*)(vbase + (16 * s + 8) * VRS + 64));
                const bf16x8 va = {a0[0], a0[1], a0[2], a0[3], a1[0], a1[1], a1[2], a1[3]};
                const bf16x8 vc = {c0_[0], c0_[1], c0_[2], c0_[3], c1_[0], c1_[1], c1_[2], c1_[3]};
                o0 = __builtin_amdgcn_mfma_f32_32x32x16_bf16(va, pb[s], o0, 0, 0, 0);
                o1 = __builtin_amdgcn_mfma_f32_32x32x16_bf16(vc, pb[s], o1, 0, 0, 0);
            }
            }
        }
        if (!(VM & 8) && j + 1 < nt) ATT_STORE((j + 1) & 1);
        if (!(VM & 16)) __syncthreads();
    }
    float l = xhalf_sum(lacc.x + lacc.y);
    const float sterm = has_sink ? __builtin_amdgcn_exp2f(sinkl2 - m) : 0.f;
#if MK_DEBUG
    if (dbg && hi == 0) { dbg[(size_t)qrow * 2] = __builtin_bit_cast(unsigned, m); dbg[(size_t)qrow * 2 + 1] = __builtin_bit_cast(unsigned, l); }
#endif
    if (has_sink) l += sterm;
    const float inv = 1.0f / l;
    bf16* orow = Op + (size_t)qrow * D;
#pragma unroll
    for (int g = 0; g < 4; ++g) {
        v2u w0; w0.x = pk2(o0[4 * g] * inv, o0[4 * g + 1] * inv); w0.y = pk2(o0[4 * g + 2] * inv, o0[4 * g + 3] * inv);
        v2u w1; w1.x = pk2(o1[4 * g] * inv, o1[4 * g + 1] * inv); w1.y = pk2(o1[4 * g + 2] * inv, o1[4 * g + 3] * inv);
        *(v2u*)(orow + 8 * g + 4 * hi) = w0; *(v2u*)(orow + 32 + 8 * g + 4 * hi) = w1;
    }
#undef ATT_TROW
#undef ATT_LOAD
#undef ATT_STORE
}

template <int DK, int MODE, int VM = 0, bool NOREF = false>
__device__ __forceinline__ void unit2(LAS unsigned char* lds, const bf16* Qp, int qpitch, const bf16* Kp, int kpitch, const bf16* Vp, int vpitch, bf16* Op,
                                      int var, int qt, int lo, int n1, int nt, float qscale, float sink0, float sink1, bool has_sink, const LAS float* bias, const float* t32) {
    constexpr int KRS = DK * 2 + 16, NS = DK / 16, CPK = DK / 8;
    int tid = threadIdx.x; asm volatile("" : "+v"(tid)); const int lane = tid & 63, r32 = lane & 31, hi = lane >> 5, wid = __builtin_amdgcn_readfirstlane(tid >> 6);
    const int rowbase = MODE == 0 ? 512 * qt + 64 * wid : 256 * qt + 32 * wid;
    bf16x8 qr[2][NS];
#pragma unroll
    for (int u = 0; u < 2; ++u) {
        const int qrow = rowbase + (MODE == 0 ? 32 * u : 0) + r32;
        const bf16* qp = Qp + (MODE == 1 ? 64 * u : 0) + (size_t)qrow * qpitch;
#pragma unroll
        for (int s = 0; s < NS; ++s) { const v4u raw = *(const v4u*)(qp + 16 * s + 8 * hi); float f[8]; unpack8(raw, f);
#pragma unroll
            for (int i = 0; i < 8; ++i) f[i] *= qscale;
            if (DK == 96 && s >= 4) { float p[8];
#pragma unroll
                for (int i = 0; i < 8; ++i) p[i] = __shfl_xor(f[i], 32);
                rope8(f, p, t32 + ((size_t)((s == 4 ? (qrow >> 6) : (qrow & 63)) * 8)) * 2, hi == 0); }
            qr[u][s] = __builtin_bit_cast(bf16x8, pack8(f)); }
    }
    const int kkey0 = tid / CPK, kch0 = tid - kkey0 * CPK, kkey1 = (tid + 512) / CPK, kch1 = (tid + 512) - kkey1 * CPK;
    const int vkey = tid >> 3, vch = tid & 7;
    v4u kreg0, kreg1 = {0u, 0u, 0u, 0u}, vreg;
#define ATT_TROW(j) ((((j) < n1) ? (lo + (j)) : (64 + (j) - n1)) * 64)
#define ATT_LOAD(j) do { const int tr_ = ATT_TROW(j); kreg0 = *(const v4u*)(Kp + (size_t)(tr_ + kkey0) * kpitch + kch0 * 8); \
        if (DK == 96 && tid < 256) kreg1 = *(const v4u*)(Kp + (size_t)(tr_ + kkey1) * kpitch + kch1 * 8); \
        vreg = *(const v4u*)(Vp + (size_t)(tr_ + vkey) * vpitch + vch * 8); } while (0)
#define ATT_STORE(bf) do { LAS unsigned char* b_ = lds + (bf) * BUF; *(LAS v4u*)(b_ + kkey0 * KRS + kch0 * 16) = kreg0; \
        if (DK == 96 && tid < 256) *(LAS v4u*)(b_ + kkey1 * KRS + kch1 * 16) = kreg1; \
        *(LAS v4u*)(b_ + KBUF + vkey * VRS + vch * 16) = vreg; } while (0)
    constexpr float THR = 6.0f;
    float m = 0.f; f32x2 lacc[2] = {{0.f, 0.f}, {0.f, 0.f}}; f32x16 o0[2] = {{}, {}}, o1[2] = {{}, {}}; bool first = true;
    const int grw = 8 * qt + wid, r0w = min(max(grw - 4, 0), 56), i0w = rowbase;
    ATT_LOAD(0); ATT_STORE(0);
    __syncthreads();
    for (int j = 0; j < nt; ++j) {
        if (!(VM & 8) && j + 1 < nt) ATT_LOAD(j + 1);
        const int kt = ATT_TROW(j) >> 6;
        bool actv = true;
        if (kt < 64) { if (var == 0) actv = (kt >= r0w) && (kt <= r0w + 7); else if (var == 2) actv = !((64 * kt - (i0w + 31) > 128) || (i0w - (64 * kt + 63) > 128)); }
        if (actv) {
            const LAS unsigned char* Kb = lds + (j & 1) * BUF; const LAS unsigned char* Vb = Kb + KBUF;
            f32x16 s0[2] = {{}, {}}, s1[2] = {{}, {}};
#pragma unroll
            for (int s = 0; s < NS; ++s) {
                const bf16x8 ka = *(const LAS bf16x8*)(Kb + r32 * KRS + (16 * s + 8 * hi) * 2);
                const bf16x8 kb = *(const LAS bf16x8*)(Kb + (32 + r32) * KRS + (16 * s + 8 * hi) * 2);
                if (VM & 2) { asm volatile("" :: "v"(ka), "v"(kb), "v"(qr[0][s]), "v"(qr[1][s])); } else {
#pragma unroll
                for (int u = 0; u < 2; ++u) { s0[u] = __builtin_amdgcn_mfma_f32_32x32x16_bf16(ka, qr[u][s], s0[u], 0, 0, 0); s1[u] = __builtin_amdgcn_mfma_f32_32x32x16_bf16(kb, qr[u][s], s1[u], 0, 0, 0); }
                }
            }
            asm volatile("s_nop 15\n\ts_nop 7" : "+v"(s0[0]), "+v"(s1[0]), "+v"(s0[1]), "+v"(s1[1]));
            if (kt < 64 && var == 0) {
#pragma unroll
                for (int u = 0; u < 2; ++u) { const int gc = 32 * u + r32, c0 = min(max(gc - 8, 0), 48), rowoff = (kt - grw + 7) * 31 - gc + 15;
#pragma unroll
                    for (int r = 0; r < 16; ++r) { const int j0 = crow(r, hi), j1 = j0 + 32;
                        const bool v0 = (unsigned)(j0 - c0) < 16u, v1 = (unsigned)(j1 - c0) < 16u;
                        const float b0 = bias[v0 ? rowoff + j0 : 0], b1 = bias[v1 ? rowoff + j1 : 0];
                        s0[u][r] = v0 ? s0[u][r] + b0 : NEG; s1[u][r] = v1 ? s1[u][r] + b1 : NEG; } }
            } else if (kt < 64 && var == 2) {
                const int dbase = 64 * kt - (rowbase + r32) + 128;
#pragma unroll
                for (int r = 0; r < 16; ++r) { const int j0 = crow(r, hi); const bool v0 = (unsigned)(dbase + j0) <= 256u, v1 = (unsigned)(dbase + j0 + 32) <= 256u;
                    s0[0][r] = v0 ? s0[0][r] : NEG; s1[0][r] = v1 ? s1[0][r] : NEG; s0[1][r] = v0 ? s0[1][r] : NEG; s1[1][r] = v1 ? s1[1][r] : NEG; }
            }
            if (!(VM & 4)) {
            if (!NOREF) {
            float mxa = max3f(s0[0][0], s0[0][1], s1[0][0]), mxb = max3f(s0[1][0], s0[1][1], s1[1][0]);
#pragma unroll
            for (int r = 0; r < 16; r += 2) { if (r) { mxa = max3f(mxa, s0[0][r], s0[0][r + 1]); mxb = max3f(mxb, s0[1][r], s0[1][r + 1]); }
                if (r) { mxa = max3f(mxa, s1[0][r], s1[0][r + 1]); mxb = max3f(mxb, s1[1][r], s1[1][r + 1]); } else { mxa = fmaxf(mxa, s1[0][1]); mxb = fmaxf(mxb, s1[1][1]); } }
            const float mx = xhalf_max(fmaxf(mxa, mxb)) - m;
            if (first || __any(mx > THR)) {
                const float d = first ? fmaxf(mx, -64.0f) : fmaxf(mx, 0.f), alpha = __builtin_amdgcn_exp2f(-d);
                m += d; first = false;
#pragma unroll
                for (int u = 0; u < 2; ++u) {
#pragma unroll
                    for (int r = 0; r < 16; ++r) { o0[u][r] *= alpha; o1[u][r] *= alpha; }
                    lacc[u] *= alpha; }
            }
            }
            }
            bf16x8 pb[2][4];
#pragma unroll
            for (int u = 0; u < 2; ++u) {
                if (!(VM & 4))
#pragma unroll
                for (int r = 0; r < 16; ++r) { s0[u][r] = __builtin_amdgcn_exp2f(NOREF ? s0[u][r] : s0[u][r] - m); s1[u][r] = __builtin_amdgcn_exp2f(NOREF ? s1[u][r] : s1[u][r] - m); lacc[u] += (f32x2){s0[u][r], s1[u][r]}; }
#pragma unroll
                for (int s = 0; s < 2; ++s) {
                    v4u w; w.x = cvtpk(s0[u][8 * s], s0[u][8 * s + 1]); w.y = cvtpk(s0[u][8 * s + 2], s0[u][8 * s + 3]); w.z = cvtpk(s0[u][8 * s + 4], s0[u][8 * s + 5]); w.w = cvtpk(s0[u][8 * s + 6], s0[u][8 * s + 7]);
                    pb[u][s] = __builtin_bit_cast(bf16x8, w);
                    v4u x; x.x = cvtpk(s1[u][8 * s], s1[u][8 * s + 1]); x.y = cvtpk(s1[u][8 * s + 2], s1[u][8 * s + 3]); x.z = cvtpk(s1[u][8 * s + 4], s1[u][8 * s + 5]); x.w = cvtpk(s1[u][8 * s + 6], s1[u][8 * s + 7]);
                    pb[u][2 + s] = __builtin_bit_cast(bf16x8, x);
                }
            }
            if (VM & 1) { asm volatile("" :: "v"(pb[0][0]), "v"(pb[0][1]), "v"(pb[0][2]), "v"(pb[0][3]), "v"(pb[1][0]), "v"(pb[1][1]), "v"(pb[1][2]), "v"(pb[1][3])); } else {
            const LAS unsigned char* vbase = Vb + (4 * hi + ((lane & 15) >> 2)) * VRS + ((lane >> 4) & 1) * 32 + (lane & 3) * 8;
#pragma unroll
            for (int s = 0; s < 4; ++s) {
                const v4i16 a0 = __builtin_amdgcn_ds_read_tr16_b64_v4i16((LAS v4i16*)(vbase + (16 * s) * VRS));
                const v4i16 a1 = __builtin_amdgcn_ds_read_tr16_b64_v4i16((LAS v4i16*)(vbase + (16 * s + 8) * VRS));
                const v4i16 c0_ = __builtin_amdgcn_ds_read_tr16_b64_v4i16((LAS v4i16*)(vbase + (16 * s) * VRS + 64));
                const v4i16 c1_ = __builtin_amdgcn_ds_read_tr16_b64_v4i16((LAS v4i16*)(vbase + (16 * s + 8) * VRS + 64));
                const bf16x8 va = {a0[0], a0[1], a0[2], a0[3], a1[0], a1[1], a1[2], a1[3]};
                const bf16x8 vc = {c0_[0], c0_[1], c0_[2], c0_[3], c1_[0], c1_[1], c1_[2], c1_[3]};
#pragma unroll
                for (int u = 0; u < 2; ++u) { o0[u] = __builtin_amdgcn_mfma_f32_32x32x16_bf16(va, pb[u][s], o0[u], 0, 0, 0); o1[u] = __builtin_amdgcn_mfma_f32_32x32x16_bf16(vc, pb[u][s], o1[u], 0, 0, 0); }
            }
            }
        }
        if (!(VM & 8) && j + 1 < nt) ATT_STORE((j + 1) & 1);
        if (!(VM & 16)) __syncthreads();
    }
#pragma unroll
    for (int u = 0; u < 2; ++u) {
        float l = xhalf_sum(lacc[u].x + lacc[u].y);
        if (has_sink) l += __builtin_amdgcn_exp2f((u == 0 ? sink0 : sink1) - m);
        const float inv = 1.0f / l;
        const int qrow = rowbase + (MODE == 0 ? 32 * u : 0) + r32;
        bf16* orow = Op + (MODE == 1 ? 64 * u : 0) + (size_t)qrow * D;
#pragma unroll
        for (int g = 0; g < 4; ++g) {
            v2u w0; w0.x = pk2(o0[u][4 * g] * inv, o0[u][4 * g + 1] * inv); w0.y = pk2(o0[u][4 * g + 2] * inv, o0[u][4 * g + 3] * inv);
            v2u w1; w1.x = pk2(o1[u][4 * g] * inv, o1[u][4 * g + 1] * inv); w1.y = pk2(o1[u][4 * g + 2] * inv, o1[u][4 * g + 3] * inv);
            *(v2u*)(orow + 8 * g + 4 * hi) = w0; *(v2u*)(orow + 32 + 8 * g + 4 * hi) = w1;
        }
    }
#undef ATT_TROW
#undef ATT_LOAD
#undef ATT_STORE
}

template <int DK, int MODE, int VM = 0>
__device__ __forceinline__ bool unit_h(LAS unsigned char* lds, const bf16* Qp, int qpitch, const bf16* Kp, int kpitch, const bf16* Vp, int vpitch, bf16* Op,
                                       int var, int qt, int lo, int n1, int nt, float qscale, float sink0, float sink1, bool has_sink, const LAS float* bias, const float* t32, volatile LAS unsigned* flag) {
    constexpr int KRS = DK * 2 + 16, NS = DK / 16, CPK = DK / 8;
    int tid = threadIdx.x; asm volatile("" : "+v"(tid)); const int lane = tid & 63, r32 = lane & 31, hi = lane >> 5, wid = __builtin_amdgcn_readfirstlane(tid >> 6);
    const int rowbase = MODE == 0 ? 512 * qt + 64 * wid : 256 * qt + 32 * wid;
    bf16x8 qr[2][NS];
#pragma unroll
    for (int u = 0; u < 2; ++u) {
        const int qrow = rowbase + (MODE == 0 ? 32 * u : 0) + r32;
        const bf16* qp = Qp + (MODE == 1 ? 64 * u : 0) + (size_t)qrow * qpitch;
#pragma unroll
        for (int s = 0; s < NS; ++s) { const v4u raw = *(const v4u*)(qp + 16 * s + 8 * hi); float f[8]; unpack8(raw, f);
#pragma unroll
            for (int i = 0; i < 8; ++i) f[i] *= qscale;
            if (DK == 96 && s >= 4) { float p[8];
#pragma unroll
                for (int i = 0; i < 8; ++i) p[i] = __shfl_xor(f[i], 32);
                rope8(f, p, t32 + ((size_t)((s == 4 ? (qrow >> 6) : (qrow & 63)) * 8)) * 2, hi == 0); }
            qr[u][s] = __builtin_bit_cast(bf16x8, pack8(f)); }
    }
    const int kkey0 = tid / CPK, kch0 = tid - kkey0 * CPK, kkey1 = (tid + 512) / CPK, kch1 = (tid + 512) - kkey1 * CPK;
    const int vkey = tid >> 3, vch = tid & 7;
    v4u kreg0, kreg1 = {0u, 0u, 0u, 0u}, vreg;
#define ATT_TROW(j) ((((j) < n1) ? (lo + (j)) : (64 + (j) - n1)) * 64)
#define ATT_LOAD(j) do { const int tr_ = ATT_TROW(j); kreg0 = *(const v4u*)(Kp + (size_t)(tr_ + kkey0) * kpitch + kch0 * 8); \
        if (DK == 96 && tid < 256) kreg1 = *(const v4u*)(Kp + (size_t)(tr_ + kkey1) * kpitch + kch1 * 8); \
        vreg = *(const v4u*)(Vp + (size_t)(tr_ + vkey) * vpitch + vch * 8); } while (0)
#define ATT_STORE(bf) do { LAS unsigned char* b_ = lds + (bf) * BUF; *(LAS v4u*)(b_ + kkey0 * KRS + kch0 * 16) = kreg0; \
        if (DK == 96 && tid < 256) *(LAS v4u*)(b_ + kkey1 * KRS + kch1 * 16) = kreg1; \
        *(LAS v4u*)(b_ + KBUF + vkey * VRS + vch * 16) = vreg; } while (0)
    f32x2 lacc[2] = {{0.f, 0.f}, {0.f, 0.f}}; f32x16 o0[2] = {{}, {}}, o1[2] = {{}, {}};
    const int grw = 8 * qt + wid, r0w = min(max(grw - 4, 0), 56), i0w = rowbase;
    ATT_LOAD(0); ATT_STORE(0);
    if (tid == 0) *flag = 0u;
    __syncthreads();
    for (int j = 0; j < nt; ++j) {
        if (!(VM & 8) && j + 1 < nt) ATT_LOAD(j + 1);
        const int kt = ATT_TROW(j) >> 6;
        bool actv = true;
        if (kt < 64) { if (var == 0) actv = (kt >= r0w) && (kt <= r0w + 7); else if (var == 2) actv = !((64 * kt - (i0w + 31) > 128) || (i0w - (64 * kt + 63) > 128)); }
        if (actv) {
        const LAS unsigned char* Kb = lds + (j & 1) * BUF; const LAS unsigned char* Vb = Kb + KBUF;
        const LAS unsigned char* vbase = Vb + (4 * hi + ((lane & 15) >> 2)) * VRS + ((lane >> 4) & 1) * 32 + (lane & 3) * 8;
#pragma unroll
        for (int hf = 0; hf < 2; ++hf) {
            f32x16 sc[2] = {{}, {}};
#pragma unroll
            for (int s = 0; s < NS; ++s) {
                const bf16x8 kf = *(const LAS bf16x8*)(Kb + (32 * hf + r32) * KRS + (16 * s + 8 * hi) * 2);
#pragma unroll
                for (int u = 0; u < 2; ++u) sc[u] = __builtin_amdgcn_mfma_f32_32x32x16_bf16(kf, qr[u][s], sc[u], 0, 0, 0);
            }
            if (kt < 64 && var == 0) {
#pragma unroll
                for (int u = 0; u < 2; ++u) { const int gc = 32 * u + r32, c0 = min(max(gc - 8, 0), 48), rowoff = (kt - grw + 7) * 31 - gc + 15;
#pragma unroll
                    for (int r = 0; r < 16; ++r) { const int jj = 32 * hf + crow(r, hi); const bool v = (unsigned)(jj - c0) < 16u;
                        const float bv = bias[v ? rowoff + jj : 0]; sc[u][r] = v ? sc[u][r] + bv : NEG; } }
            } else if (kt < 64 && var == 2) {
                const int dbase = 64 * kt - (rowbase + r32) + 128;
#pragma unroll
                for (int r = 0; r < 16; ++r) { const bool v = (unsigned)(dbase + 32 * hf + crow(r, hi)) <= 256u; sc[0][r] = v ? sc[0][r] : NEG; sc[1][r] = v ? sc[1][r] : NEG; }
            }
            bf16x8 pb[2][2];
#pragma unroll
            for (int u = 0; u < 2; ++u) {
#pragma unroll
                for (int r = 0; r < 16; r += 2) { sc[u][r] = __builtin_amdgcn_exp2f(sc[u][r]); sc[u][r + 1] = __builtin_amdgcn_exp2f(sc[u][r + 1]); lacc[u] += (f32x2){sc[u][r], sc[u][r + 1]}; }
#pragma unroll
                for (int s = 0; s < 2; ++s) {
                    v4u w; w.x = cvtpk(sc[u][8 * s], sc[u][8 * s + 1]); w.y = cvtpk(sc[u][8 * s + 2], sc[u][8 * s + 3]); w.z = cvtpk(sc[u][8 * s + 4], sc[u][8 * s + 5]); w.w = cvtpk(sc[u][8 * s + 6], sc[u][8 * s + 7]);
                    pb[u][s] = __builtin_bit_cast(bf16x8, w);
                }
            }
#pragma unroll
            for (int s2 = 0; s2 < 2; ++s2) { const int s = 2 * hf + s2;
                const v4i16 a0 = __builtin_amdgcn_ds_read_tr16_b64_v4i16((LAS v4i16*)(vbase + (16 * s) * VRS));
                const v4i16 a1 = __builtin_amdgcn_ds_read_tr16_b64_v4i16((LAS v4i16*)(vbase + (16 * s + 8) * VRS));
                const v4i16 c0_ = __builtin_amdgcn_ds_read_tr16_b64_v4i16((LAS v4i16*)(vbase + (16 * s) * VRS + 64));
                const v4i16 c1_ = __builtin_amdgcn_ds_read_tr16_b64_v4i16((LAS v4i16*)(vbase + (16 * s + 8) * VRS + 64));
                const bf16x8 va = {a0[0], a0[1], a0[2], a0[3], a1[0], a1[1], a1[2], a1[3]};
                const bf16x8 vc = {c0_[0], c0_[1], c0_[2], c0_[3], c1_[0], c1_[1], c1_[2], c1_[3]};
#pragma unroll
                for (int u = 0; u < 2; ++u) { o0[u] = __builtin_amdgcn_mfma_f32_32x32x16_bf16(va, pb[u][s2], o0[u], 0, 0, 0); o1[u] = __builtin_amdgcn_mfma_f32_32x32x16_bf16(vc, pb[u][s2], o1[u], 0, 0, 0); }
            }
            __builtin_amdgcn_sched_barrier(0);
        }
        }
        if (!(VM & 8) && j + 1 < nt) ATT_STORE((j + 1) & 1);
        __syncthreads();
    }
    float lsum[2]; bool bad = false;
#pragma unroll
    for (int u = 0; u < 2; ++u) { lsum[u] = xhalf_sum(lacc[u].x + lacc[u].y); bad = bad || !(lsum[u] > 8.6736174e-19f && lsum[u] < 1.1529215e18f);
        if (has_sink) { lsum[u] += __builtin_amdgcn_exp2f(u == 0 ? sink0 : sink1); bad = bad || !(lsum[u] < 1.1529215e18f); } }
    if (__any(bad)) { if (lane == 0) *flag = 1u; }
#pragma unroll
    for (int u = 0; u < 2; ++u) {
        const float inv = 1.0f / lsum[u];
        bf16* orow = Op + (MODE == 1 ? 64 * u : 0) + (size_t)(rowbase + (MODE == 0 ? 32 * u : 0) + r32) * D;
#pragma unroll
        for (int g = 0; g < 4; ++g) {
            v2u w0; w0.x = pk2(o0[u][4 * g] * inv, o0[u][4 * g + 1] * inv); w0.y = pk2(o0[u][4 * g + 2] * inv, o0[u][4 * g + 3] * inv);
            v2u w1; w1.x = pk2(o1[u][4 * g] * inv, o1[u][4 * g + 1] * inv); w1.y = pk2(o1[u][4 * g + 2] * inv, o1[u][4 * g + 3] * inv);
            *(v2u*)(orow + 8 * g + 4 * hi) = w0; *(v2u*)(orow + 32 + 8 * g + 4 * hi) = w1;
        }
    }
    __syncthreads();
    return *flag == 0u;
#undef ATT_TROW
#undef ATT_LOAD
#undef ATT_STORE
}
}

template <int VM = 0>
__device__ __forceinline__ void phase_attn(const Frame& F, int lq) {
    const int l = lq & 3;
    const bf16* P = (const bf16*)(F.ws + WS_PB); const bf16* QD = (const bf16*)(F.ws + WS_QD); const bf16* KD = (const bf16*)(F.ws + WS_KD);
    const bf16* VD = (const bf16*)(F.ws + WS_VD); bf16* O = (bf16*)(F.ws + (lq >= 4 ? WS_ACT : WS_HA));
    unsigned* ctr = (unsigned*)(F.ws + WS_CTL) + CW_QUEUE + 64 * 8 * lq;
    LAS float* bias = (LAS float*)(F.lds + att::BIAS_OFF);
    { const float* nab = INP(I_NABIAS) + l * 4 * 465; for (int i = F.tid; i < 4 * 465; i += NTHR) bias[i] = nab[i] * LOG2E; }
    const float* sinks = INP(I_SINK) + l * 4;
    __syncthreads();
    const float* t32 = (const float*)(F.ws + WS_T32);
    volatile LAS unsigned* flag = F.MISC + MI_Q + 1;
    const int nloc = 256 + (l < NL - 1 ? 24 : 0);
    const int q0 = (int)xb_xcc_id();
    for (int qq = 0; qq < 8; ++qq) {
      const int q = (q0 + qq) & 7;
      unsigned* qctr = ctr + 64 * q;
      for (;;) {
        if (F.tid == 0) F.MISC[MI_Q] = __hip_atomic_fetch_add(qctr, 1u, __ATOMIC_RELAXED, __HIP_MEMORY_SCOPE_AGENT);
        __syncthreads();
        const int li = (int)F.MISC[MI_Q];
        __syncthreads();
        if (li >= nloc) break;
        int idx;
        if (li < 64) idx = (q + 8 * (li >> 3)) * 8 + (li & 7);
        else if (li < 128) { const int jx = li - 64; idx = 1024 + (q + 8 * (jx >> 4)) * 16 + (jx & 15); }
        else if (li < 192) { const int jx = li - 128; idx = 1536 + (q + 8 * (jx >> 3)) * 8 + (jx & 7); }
        else if (li < 256) { const int jx = li - 192; idx = 2048 + (q + 8 * (jx >> 4)) * 16 + (jx & 15); }
        else if (li < 264) idx = 2560 + q + 8 * (li - 256);
        else idx = 2624 + q + 8 * (li - 264);
        if (idx < 512) {
            const int b = idx >> 5, h = (idx >> 3) & 3, qt = idx & 7; const size_t rb = (size_t)b * TT;
            if (!att::unit_h<96, 0, VM>(F.lds, QD + rb * 384 + h * 96, 384, KD + rb * 384 + h * 96, 384, VD + rb * 256 + h * 64, 256, O + rb * D + 768 + h * 64, 3, qt, 0, 64, 68, 0.10206207261596575f * LOG2E, 0.f, 0.f, false, bias, t32, flag)) {
#pragma unroll 1
                for (int k2 = 0; k2 < 2; ++k2)
                    att::unit<96, VM>(F.lds, QD + rb * 384 + h * 96, 384, KD + rb * 384 + h * 96, 384, VD + rb * 256 + h * 64, 256, O + rb * D + 768 + h * 64, 3, 2 * qt + k2, 0, 64, 68, 0.10206207261596575f * LOG2E, 0.f, false, bias, t32, nullptr);
            }
        } else if (idx < 1024) {
        } else if (idx < 2560) {
            idx -= 1024;
            const int grp = idx >> 9, rem = idx & 511, b = rem >> 5; const size_t rb = (size_t)b * TT;
            if (grp == 1) {
                const int h = (rem >> 3) & 3, qt = rem & 7; const int lo = min(max(8 * qt - 4, 0), 56), n1 = min(max(8 * qt + 3, 0), 56) + 7 - lo + 1;
                if (!att::unit_h<64, 0, VM>(F.lds, P + rb * NPJ + h * 64, NPJ, P + rb * NPJ + 256 + h * 64, NPJ, P + rb * NPJ + 512 + h * 64, NPJ, O + rb * D + h * 64, 0, qt, lo, n1, n1 + 4, 0.125f * LOG2E, 0.f, 0.f, false, bias + h * 465, t32, flag))
                att::unit2<64, 0, VM>(F.lds, P + rb * NPJ + h * 64, NPJ, P + rb * NPJ + 256 + h * 64, NPJ, P + rb * NPJ + 512 + h * 64, NPJ, O + rb * D + h * 64, 0, qt, lo, n1, n1 + 4,
                                  0.125f * LOG2E, 0.f, 0.f, false, bias + h * 465, t32);
            } else {
                const int g = (rem >> 4) & 1, qt = rem & 15; const bool isc = grp == 2;
                const int lo = isc ? max(4 * qt - 2, 0) : 0, n1 = isc ? min(4 * qt + 5, 63) - lo + 1 : 64;
                const int qc = (isc ? 1280 : 768) + g * 128, kc = (isc ? 1536 : 1024) + g * 64, vc = (isc ? 1664 : 1152) + g * 64;
                const float sk0 = isc ? sinks[2 * g] * LOG2E : 0.f, sk1 = isc ? sinks[2 * g + 1] * LOG2E : 0.f;
                if (!att::unit_h<64, 1, VM>(F.lds, P + rb * NPJ + qc, NPJ, P + rb * NPJ + kc, NPJ, P + rb * NPJ + vc, NPJ, O + rb * D + (isc ? 512 : 256) + g * 128, isc ? 2 : 1, qt, lo, n1, n1 + 4, 0.125f * LOG2E, sk0, sk1, isc, bias, t32, flag))
                att::unit2<64, 1, VM>(F.lds, P + rb * NPJ + qc, NPJ, P + rb * NPJ + kc, NPJ, P + rb * NPJ + vc, NPJ, O + rb * D + (isc ? 512 : 256) + g * 128, isc ? 2 : 1, qt, lo, n1, n1 + 4,
                                  0.125f * LOG2E, isc ? sinks[2 * g] * LOG2E : 0.f, isc ? sinks[2 * g + 1] * LOG2E : 0.f, isc, bias, t32);
            }
        } else if (idx < 2624) {
            const int rem = idx - 2560, b = rem >> 2, isc = (rem >> 1) & 1, g = rem & 1; const size_t rb = (size_t)b * TT;
            const int qc = (isc ? 1280 : 768) + g * 128, kc = (isc ? 1536 : 1024) + g * 64, vc = (isc ? 1664 : 1152) + g * 64;
            att::unit2<64, 1, VM>(F.lds, P + rb * NPJ + qc, NPJ, P + rb * NPJ + kc, NPJ, P + rb * NPJ + vc, NPJ, O + rb * D + (isc ? 512 : 256) + g * 128, isc ? 2 : 1, 16, 0, 0, 4,
                              0.125f * LOG2E, isc ? sinks[2 * g] * LOG2E : 0.f, isc ? sinks[2 * g + 1] * LOG2E : 0.f, isc != 0, bias, t32);
        } else {
            const int rem = idx - 2624, b = rem >> 3, isd = (rem >> 2) & 1, h = rem & 3; const size_t rb = (size_t)b * TT;
            if (isd) att::unit<96, VM>(F.lds, QD + rb * 384 + h * 96, 384, KD + rb * 384 + h * 96, 384, VD + rb * 256 + h * 64, 256, O + rb * D + 768 + h * 64, 3, 16, 0, 0, 4, 0.10206207261596575f * LOG2E, 0.f, false, bias, t32, nullptr);
            else att::unit<64, VM>(F.lds, P + rb * NPJ + h * 64, NPJ, P + rb * NPJ + 256 + h * 64, NPJ, P + rb * NPJ + 512 + h * 64, NPJ, O + rb * D + h * 64, 0, 16, 0, 0, 4, 0.125f * LOG2E, 0.f, false, bias + h * 465, nullptr, nullptr);
        }
    }
    }
}


#define PHASE_FN static __device__ __forceinline__ void
PHASE_FN ph_prologue(GAS unsigned char* ws) { const Frame F = make_frame(ws); phase_prologue(F); }
PHASE_FN ph_ln(GAS unsigned char* ws, int l) { const Frame F = make_frame(ws); phase_ln(F, l); }
PHASE_FN ph_gemm_in(GAS unsigned char* ws, int l) {
    const Frame F = make_frame(ws);
    pg8::Gemm g{(const bf16*)(F.ws + WS_HA), (const bf16*)(F.ws + WS_WIN), M, NPJ, D, D, nullptr}; pg8::StaticOrder S; S.init(M, NPJ, F.G, F.bid);
    pg8::EpiBf16NT<0> E{(bf16*)(F.ws + WS_PB), NPJ, nullptr, 0, 0, 1.f};
    pg8::gemm_phase<pg8::EpiBf16NT<0>, pg8::StaticOrder, true, true>(F.lds, g, S, E);
}
PHASE_FN ph_post(GAS unsigned char* ws, int l) { const Frame F = make_frame(ws); phase_post(F, l); }
PHASE_FN ph_gemm_mla(GAS unsigned char* ws, int l) {
    const Frame F = make_frame(ws);
    pg8::Gemm g{(const bf16*)(F.ws + WS_PB) + 1792, (const bf16*)(F.ws + WS_WD), M, 1024, 384, NPJ, nullptr}; pg8::StaticOrder S; S.init(M, 1024, F.G, F.bid);
    EpiMla E{(bf16*)(F.ws + WS_QD), (bf16*)(F.ws + WS_KD), (bf16*)(F.ws + WS_VD)};
    pg8::gemm_phase<EpiMla, pg8::StaticOrder, true, true>(F.lds, g, S, E);
}
template <int VM>
PHASE_FN ph_attn(GAS unsigned char* ws, int l) { const Frame F = make_frame(ws); phase_attn<VM>(F, l); }
PHASE_FN ph_gemm_out(GAS unsigned char* ws, int l) {
    const Frame F = make_frame(ws);
    pg8::Gemm g{(const bf16*)(F.ws + WS_HA), (const bf16*)(F.ws + WS_WOUT), M, D, D, D, nullptr};
    pg8::EpiBf16NT<0> E{(bf16*)(F.ws + WS_PB), D, nullptr, 0, 0, 1.f};
    if (l == NL - 1) { LatOrder S{F.G, F.bid}; pg8::gemm_phase<pg8::EpiBf16NT<0>, LatOrder, true, true>(F.lds, g, S, E); }
    else { pg8::StaticOrder S; S.init(M, D, F.G, F.bid); pg8::gemm_phase<pg8::EpiBf16NT<0>, pg8::StaticOrder, true, true>(F.lds, g, S, E); }
}
PHASE_FN ph_route(GAS unsigned char* ws, int l) { const Frame F = make_frame(ws); phase_route(F, l); }
PHASE_FN ph_permute(GAS unsigned char* ws, int l) { const Frame F = make_frame(ws); phase_permute(F, l); }
PHASE_FN ph_gemm_gu(GAS unsigned char* ws, int l) {
    const Frame F = make_frame(ws);
    moe_tables(F);
    pg8::Gemm g{(const bf16*)(F.ws + WS_HA), (const bf16*)(F.ws + WS_WGU), MS, 16384, D, D, (const int*)(F.ws + WS_QD)}; MoeOrder S{F.MISC + MI_PST, F.G, F.bid};
    EpiGU E{(bf16*)(F.ws + WS_ACT)};
    pg8::gemm_phase<EpiGU, MoeOrder, true, true, true>(F.lds, g, S, E);
}
PHASE_FN ph_gemm_dn(GAS unsigned char* ws, int l) {
    const Frame F = make_frame(ws);
    moe_tables(F);
    pg8::Gemm g{(const bf16*)(F.ws + WS_ACT), (const bf16*)(F.ws + WS_WDN), MS, 16384, 512, 512, nullptr}; MoeOrder S{F.MISC + MI_PST, F.G, F.bid};
    pg8::EpiBf16NT<0> E{(bf16*)(F.ws + WS_PB), D, nullptr, 1024, 0, 1.f};
    pg8::gemm_phase<pg8::EpiBf16NT<0>, MoeOrder, true, true>(F.lds, g, S, E);
}


#if MK_DEBUG
#ifndef DBG_MODE
#define DBG_MODE 0
#endif
__device__ __forceinline__ float oracle_attn(const Frame& F, int l, int r, int var, int h, int mode = 0) {
    const bf16* P = (const bf16*)(F.ws + WS_PB); const bf16* QD = (const bf16*)(F.ws + WS_QD); const bf16* KD = (const bf16*)(F.ws + WS_KD); const bf16* VD = (const bf16*)(F.ws + WS_VD);
    const bf16* O = (const bf16*)(F.ws + WS_HA); const float* t32 = (const float*)(F.ws + WS_T32);
    const int b = r / TT, t = r - b * TT; const bool lat = t < SEQ; const size_t rb = (size_t)b * TT;
    const int dk = var == 3 ? 96 : 64;
    const bf16* qp; const bf16* kp; const bf16* vp; int kpitch, vpitch;
    if (var == 3) { qp = QD + (size_t)r * 384 + h * 96; kp = KD + rb * 384 + h * 96; kpitch = 384; vp = VD + rb * 256 + h * 64; vpitch = 256; }
    else { const int qc = var == 0 ? h * 64 : var == 1 ? 768 + h * 64 : 1280 + h * 64, kc = var == 0 ? 256 + h * 64 : var == 1 ? 1024 + (h >> 1) * 64 : 1536 + (h >> 1) * 64,
           vc = var == 0 ? 512 + h * 64 : var == 1 ? 1152 + (h >> 1) * 64 : 1664 + (h >> 1) * 64;
           qp = P + (size_t)r * NPJ + qc; kp = P + rb * NPJ + kc; kpitch = NPJ; vp = P + rb * NPJ + vc; vpitch = NPJ; }
    LAS float* qs = (LAS float*)(F.lds + 65536) + F.wave * 128;
    for (int d = F.lane; d < dk; d += 64) qs[d] = __builtin_bit_cast(float, (unsigned)qp[d] << 16);
    asm volatile("s_waitcnt lgkmcnt(0)" ::: "memory");
    if (var == 3 && lat && F.lane < 32) {
        const int c = F.lane >> 3, e = F.lane & 7, gr = t >> 6, gc = t & 63; const float own = qs[64 + F.lane], par = qs[64 + (F.lane ^ 8)];
        const float cs = t32[((c < 2 ? gr : gc) * 8 + e) * 2], sn = t32[((c < 2 ? gr : gc) * 8 + e) * 2 + 1];
        const float nv = (c & 1) == 0 ? own * cs - par * sn : par * sn + own * cs;
        asm volatile("s_waitcnt lgkmcnt(0)" ::: "memory"); qs[64 + F.lane] = nv; }
    asm volatile("s_waitcnt lgkmcnt(0)" ::: "memory");
    const float scale = var == 3 ? 0.10206207261596575f : 0.125f;
    const int gr = t >> 6, gc = t & 63, r0 = min(max(gr - 4, 0), 56), c0 = min(max(gc - 8, 0), 48);
    float m = -3.0e38f, lsum = 0.f, acc[64];
#pragma unroll
    for (int d = 0; d < 64; ++d) acc[d] = 0.f;
    for (int j = F.lane; j < TT; j += 64) {
        bool ok = true; float bias = 0.f;
        if (!lat) ok = j >= SEQ;
        else if (j < SEQ) {
            if (var == 0) { const int kr = j >> 6, kc2 = j & 63; ok = kr >= r0 && kr <= r0 + 7 && kc2 >= c0 && kc2 <= c0 + 15;
                if (ok) bias = INP(I_NABIAS)[((l * 4 + h) * 15 + (kr - gr + 7)) * 31 + (kc2 - gc + 15)]; }
            else if (var == 2) ok = (j - t <= 128) && (t - j <= 128);
        }
        if (!ok) continue;
        float sc = 0.f; const bf16* kr_ = kp + (size_t)j * kpitch;
        for (int d = 0; d < dk; ++d) sc += qs[d] * __builtin_bit_cast(float, (unsigned)kr_[d] << 16);
        sc = sc * scale + bias;
        const float mn = fmaxf(m, sc), a = expf(m - mn), p = expf(sc - mn); m = mn; lsum = lsum * a + p;
        const bf16* vr = vp + (size_t)j * vpitch;
#pragma unroll
        for (int d = 0; d < 64; ++d) acc[d] = acc[d] * a + p * __builtin_bit_cast(float, (unsigned)vr[d] << 16);
    }
    float mg = m;
#pragma unroll
    for (int o = 1; o < 64; o <<= 1) mg = fmaxf(mg, __shfl_xor(mg, o));
    if (mode >= 1) {
        const unsigned* rec = (const unsigned*)(F.ws + WS_RS) + (size_t)r * 2; const float mk = __builtin_bit_cast(float, rec[0]), lk = __builtin_bit_cast(float, rec[1]);
        const float lref = wave_sum(lsum * expf(m - mg));
        const float lker = lk * exp2f(mk - mg * LOG2E);
        if (mode == 2) return fabsf(mk / LOG2E - mg);
        return fabsf(lker / lref - 1.0f);
    }
    const float f = expf(m - mg); lsum *= f; lsum = wave_sum(lsum);
    if (var == 2) lsum += expf(INP(I_SINK)[l * 4 + h] - mg);
    float err = 0.f, mag = 1.0e-6f;
    const bf16* orow = O + (size_t)r * D + var * 256 + h * 64;
#pragma unroll
    for (int d = 0; d < 64; ++d) { const float ref = wave_sum(acc[d] * f) / lsum; const float got = __builtin_bit_cast(float, (unsigned)orow[d] << 16);
        const float df = fabsf(got - ref); err = (df == df) ? fmaxf(err, df) : 1.0e30f; mag = fmaxf(mag, fabsf(ref)); }
    return err / mag;
}
__device__ __forceinline__ void phase_dump(const Frame& F, int code) {
    float* out = (float*)ptab_get(F, I_OUT);
    for (int r = F.gw; r < M; r += F.ngw) {
        const int b = r / TT, t = r - b * TT; if (t >= SEQ) continue;
        float v[16];
        if (code == 1) ld16bf((const bf16*)(F.ws + WS_HA) + (size_t)r * D, F.lane, v);
        else if (code == 2) ld16bf((const bf16*)(F.ws + WS_PB) + (size_t)r * NPJ, F.lane, v);
        else if (code == 3) ld16bf((const bf16*)(F.ws + WS_PB) + (size_t)r * NPJ + 1024, F.lane, v);
        else if (code == 4) ld16bf((const bf16*)(F.ws + WS_PB) + (size_t)r * NPJ + 1280, F.lane, v);
        else if (code == 5) ld16((const float*)(F.ws + WS_PB) + (size_t)r * D, F.lane, v);
        else if (code == 8) {
            const v4u w0 = *((const v4u*)((const bf16*)(F.ws + WS_HA) + (size_t)r * D) + F.lane), w1 = *((const v4u*)((const bf16*)(F.ws + WS_HA) + (size_t)r * D) + 64 + F.lane);
            float f[8]; int bad0 = 0, bad1 = 0; unpack8(w0, f);
#pragma unroll
            for (int i = 0; i < 8; ++i) { const unsigned u = __builtin_bit_cast(unsigned, f[i]); bad0 |= ((u & 0x7f800000u) == 0x7f800000u) ? 1 : 0; }
            unpack8(w1, f);
#pragma unroll
            for (int i = 0; i < 8; ++i) { const unsigned u = __builtin_bit_cast(unsigned, f[i]); bad1 |= ((u & 0x7f800000u) == 0x7f800000u) ? 1 : 0; }
            const unsigned long long m0 = __ballot(bad0), m1 = __ballot(bad1);
            const bool vA = (m0 & 0xffffffffull) != 0, vB = (m0 >> 32) != 0, vC = (m1 & 0xffffffffull) != 0, vD = (m1 >> 32) != 0;
            const float val = (float)(t + 1) * ((vA ? 1.0f : 0.f) + (vB ? 1.0e2f : 0.f) + (vC ? 1.0e4f : 0.f) + (vD ? 1.0e6f : 0.f));
#pragma unroll
            for (int i = 0; i < 16; ++i) v[i] = val;
        }
        else if (code == 9) { const unsigned cd = ((const unsigned*)(F.ws + WS_RS))[(size_t)r * 2]; float val = 0.f; if (cd) { val = 1.f; for (unsigned k = 0; k < cd; ++k) val *= 10.f; }
#pragma unroll
            for (int i = 0; i < 16; ++i) v[i] = val; }
        else if (code == 10) {
            const v4u w1 = *((const v4u*)((const bf16*)(F.ws + WS_HA) + (size_t)r * D) + 64 + F.lane);
            float f[8]; int bad1 = 0; unpack8(w1, f);
#pragma unroll
            for (int i = 0; i < 8; ++i) { const unsigned u = __builtin_bit_cast(unsigned, f[i]); bad1 |= ((u & 0x7f800000u) == 0x7f800000u) ? 1 : 0; }
            const bool vC = (__ballot(bad1) & 0xffffffffull) != 0;
            const bf16* pc = (const bf16*)(F.ws + WS_PB) + ((size_t)b * TT + SEQ + (t & 255)) * NPJ; int badp = 0;
            for (int c = F.lane; c < 288; c += 64) { const v4u w = *((const v4u*)pc + c); unpack8(w, f);
#pragma unroll
                for (int i = 0; i < 8; ++i) { const unsigned u = __builtin_bit_cast(unsigned, f[i]); badp |= ((u & 0x7f800000u) == 0x7f800000u) ? 1 : 0; } }
            float val = 0.f; if (vC) { val = 1.f; for (int k = 0; k <= (t & 15); ++k) val *= 10.f; }
            if (__any(badp)) val = 1.0e30f;
#pragma unroll
            for (int i = 0; i < 16; ++i) v[i] = val;
        }
        else if (code == 11) {
            const bf16* pr = (const bf16*)(F.ws + WS_PB) + (size_t)r * NPJ; int grp = -1;
            for (int c = F.lane; c < 288; c += 64) { const v4u w = *((const v4u*)pr + c); float f[8]; unpack8(w, f);
#pragma unroll
                for (int i = 0; i < 8; ++i) if (!(fabsf(f[i]) < 1.0e4f)) grp = (c * 8) >> 8; }
#pragma unroll
            for (int o = 1; o < 64; o <<= 1) { const int g2 = __shfl_xor(grp, o); grp = g2 > grp ? g2 : grp; }
            float val = 0.f; if (grp >= 0) { val = 100.f; for (int k = 0; k < grp; ++k) val *= 10.f; }
#pragma unroll
            for (int i = 0; i < 16; ++i) v[i] = val;
        }
        else if (code >= 20 && code < 24) {
            float val = 0.f;
            if ((t & 15) == 5) { for (int h = 0; h < 4; ++h) { const float e = oracle_attn(F, 0, r, code - 20, h); const float cls = e > 1.0e20f ? 3.f : e > 0.5f ? 2.f : e > 0.03f ? 1.f : 0.f; if (cls > 0.f) { float w = cls; for (int k = 0; k <= h; ++k) w *= 10.f; val = fmaxf(val, w); } } }
#pragma unroll
            for (int i = 0; i < 16; ++i) v[i] = val;
        }
        else if (code >= 30 && code < 46) {
            float val = 0.f;
            if ((t & 15) == 5) { const float e = oracle_attn(F, 0, r, (code - 30) >> 2, (code - 30) & 3, DBG_MODE); val = e > 10.f ? 1.0e4f : 1000.f * e; }
#pragma unroll
            for (int i = 0; i < 16; ++i) v[i] = val;
        }
        else if (code == 7) {
            auto bad16 = [&](const bf16* p, int nchunks) { int bad = 0; for (int c = F.lane; c < nchunks; c += 64) { const v4u w = *((const v4u*)p + c); float f[8]; unpack8(w, f);
#pragma unroll
                for (int i = 0; i < 8; ++i) { const unsigned u = __builtin_bit_cast(unsigned, f[i]); bad |= ((u & 0x7f800000u) == 0x7f800000u) ? 1 : 0; } } return __any(bad); };
            const int bP = bad16((const bf16*)(F.ws + WS_PB) + (size_t)r * NPJ, 288), bQ = bad16((const bf16*)(F.ws + WS_QD) + (size_t)r * 384, 48),
                      bK = bad16((const bf16*)(F.ws + WS_KD) + (size_t)r * 384, 48), bV = bad16((const bf16*)(F.ws + WS_VD) + (size_t)r * 256, 32), bO = bad16((const bf16*)(F.ws + WS_HA) + (size_t)r * D, 128);
            const float val = bP ? 1.0e6f : bQ ? 1.0e5f : bK ? 1.0e4f : bV ? 1.0e3f : bO ? 1.0e2f : 0.f;
#pragma unroll
            for (int i = 0; i < 16; ++i) v[i] = val;
        }
#pragma unroll
        for (int i = 0; i < 16; ++i) { const unsigned u = __builtin_bit_cast(unsigned, v[i]); if ((u & 0x7f800000u) == 0x7f800000u) v[i] = 777.0f; }
        st16(out + ((size_t)b * SEQ + t) * D, F.lane, v);
    }
}
static __device__ __forceinline__ void ph_dump(GAS unsigned char* ws, int code) { const Frame F = make_frame(ws); phase_dump(F, code); }
#endif
__global__ void __launch_bounds__(NTHR, 2) mk_fwd(Args args) {
    extern __shared__ __attribute__((aligned(16))) unsigned char lds_raw[];
    LAS unsigned char* lds = (LAS unsigned char*)lds_raw; volatile LAS unsigned* MISC = (volatile LAS unsigned*)(lds + MISC_OFF);
    const int tid = threadIdx.x;
    GAS unsigned char* ws = (GAS unsigned char*)args.ws;
    for (int u = tid; u < (LDS_BYTES - MISC_OFF) / 4; u += NTHR) MISC[u] = 0u;
    __syncthreads();
    if (tid < 28) { const unsigned long long p = tid < 27 ? (unsigned long long)args.in[tid] : (unsigned long long)args.out;
        LAS unsigned* t = (LAS unsigned*)(lds + PTAB_OFF) + 2 * tid; t[0] = (unsigned)p; t[1] = (unsigned)(p >> 32); }
    __syncthreads();
#if MK_MULTI
#define GRID_BAR() do { } while (0)
#else
    XcdBarrier bar = xcd_barrier_post((unsigned*)(ws + WS_CTL) + CW_BAR, MISC + MI_BAR);
#define GRID_BAR() xcd_barrier(bar)
#endif
    const int lo = args.ph_lo, hi = args.ph_hi;
#define IN(k) (lo <= (k) && (k) < hi)
#if MK_TIME
    unsigned long long tcat = 0ull, tb0 = 0ull;
#define TBEG() do { tb0 = __builtin_amdgcn_s_memrealtime(); } while (0)
#define TEND(c) do { if ((c) == MK_TIME - 1) tcat += __builtin_amdgcn_s_memrealtime() - tb0; } while (0)
#define SEAM(k) do { if (IN(k) && IN((k) + 1)) { TBEG(); GRID_BAR(); TEND(1); } } while (0)
#else
#define TBEG() do { } while (0)
#define TEND(c) do { } while (0)
#define SEAM(k) do { if (IN(k) && IN((k) + 1)) GRID_BAR(); } while (0)
#endif

#if MK_DEBUG
    if (lo >= 100) { ph_dump(ws, lo - 100); return; }
#endif
    if (IN(0)) { TBEG(); ph_prologue(ws); TEND(2); } SEAM(0);
    for (int l = 0; l < NL; ++l) {
        const int pb = 1 + 10 * l;
        if (IN(pb + 0)) { TBEG(); ph_ln(ws, l); TEND(0); } SEAM(pb + 0);
        if (IN(pb + 1)) { TBEG(); ph_gemm_in(ws, l); if (MK_DUP & 2) { GRID_BAR(); ph_gemm_in(ws, l); } TEND(3); } SEAM(pb + 1);
        if (IN(pb + 2)) { TBEG(); ph_post(ws, l); TEND(0); } SEAM(pb + 2);
        if (IN(pb + 3)) { TBEG(); ph_gemm_mla(ws, l); if (MK_DUP & 8) { GRID_BAR(); ph_gemm_mla(ws, l); } TEND(3); } SEAM(pb + 3);
        if (IN(pb + 4)) { TBEG(); ph_attn<0>(ws, l); if (MK_DUP & 16) { GRID_BAR(); ph_attn<MK_VM>(ws, l + 4); } TEND(4); } SEAM(pb + 4);
        if (IN(pb + 5)) { TBEG(); ph_gemm_out(ws, l); if (MK_DUP & 32) { GRID_BAR(); ph_gemm_out(ws, l); } TEND(3); } SEAM(pb + 5);
        if (IN(pb + 6)) { TBEG(); ph_route(ws, l); TEND(0); } SEAM(pb + 6);
        if (IN(pb + 7)) { TBEG(); ph_permute(ws, l); if (MK_DUP & 128) { GRID_BAR(); ph_permute(ws, l); } TEND(0); } SEAM(pb + 7);
        if (IN(pb + 8)) { TBEG(); ph_gemm_gu(ws, l); if (MK_DUP & 256) { GRID_BAR(); ph_gemm_gu(ws, l); } TEND(3); } SEAM(pb + 8);
        if (IN(pb + 9)) { TBEG(); ph_gemm_dn(ws, l); if (MK_DUP & 512) { GRID_BAR(); ph_gemm_dn(ws, l); } TEND(3); } SEAM(pb + 9);
    }
    if (IN(NPHASE - 1)) { TBEG(); ph_ln(ws, NL); TEND(0); }
#if MK_TIME
    if (blockIdx.x == 0) { const unsigned long long tw = __builtin_amdgcn_s_memrealtime(); const unsigned long long dl = tcat * (unsigned long long)MK_TMUL; while (__builtin_amdgcn_s_memrealtime() - tw < dl) __builtin_amdgcn_s_sleep(8); }
#endif
#undef IN
#undef SEAM
#undef GRID_BAR
}

extern "C" void kernel_launch(void* const* d_in, const int* in_sizes, int n_in, void* d_out, int out_size, void* d_ws, size_t ws_size, hipStream_t stream) {
    static int grid = 0;
    if (grid == 0) {
        if (n_in != 27 || out_size != NB * SEQ * D || ws_size < WS_END) { fprintf(stderr, "kernel_launch: unexpected problem (n_in %d, out %d, ws %zu < %zu)\n", n_in, out_size, ws_size, (size_t)WS_END); grid = -1; return; }
        int dev = 0, cus = 0, per_cu = 0;
        if (hipGetDevice(&dev) != hipSuccess || hipDeviceGetAttribute(&cus, hipDeviceAttributeMultiprocessorCount, dev) != hipSuccess) { grid = -1; return; }
        if (hipFuncSetAttribute((const void*)mk_fwd, hipFuncAttributeMaxDynamicSharedMemorySize, LDS_BYTES) != hipSuccess) { fprintf(stderr, "kernel_launch: hipFuncSetAttribute failed\n"); grid = -1; return; }
        if (hipOccupancyMaxActiveBlocksPerMultiprocessor(&per_cu, (const void*)mk_fwd, NTHR, LDS_BYTES) != hipSuccess || per_cu < 1) fprintf(stderr, "kernel_launch: occupancy query reports %d\n", per_cu);
        (void)hipGetLastError();
        grid = cus > 1024 ? 1024 : cus;
    }
    if (grid < 0) return;
    (void)hipMemsetAsync((char*)d_ws + WS_CTL, 0, CTL_BYTES, stream);
    Args a{};
    for (int i = 0; i < 27; ++i) a.in[i] = (const float*)d_in[i];
    a.out = (float*)d_out; a.ws = (unsigned char*)d_ws;
#if MK_MULTI
#ifndef DBG_NRUN
#define DBG_NRUN NPHASE
#endif
    for (int p = 0; p < DBG_NRUN; ++p) { a.ph_lo = p; a.ph_hi = p + 1; hipLaunchKernelGGL(mk_fwd, dim3(grid), dim3(NTHR), LDS_BYTES, stream, a); }
#ifdef DBG_DUMP
    a.ph_lo = 100 + DBG_DUMP; a.ph_hi = 101 + DBG_DUMP; hipLaunchKernelGGL(mk_fwd, dim3(grid), dim3(NTHR), LDS_BYTES, stream, a);
#endif
#else
    a.ph_lo = 0; a.ph_hi = NPHASE;
    hipLaunchKernelGGL(mk_fwd, dim3(grid), dim3(NTHR), LDS_BYTES, stream, a);
#endif
}
```

```cpp
#include <hip/hip_runtime.h>
#include <cstdio>
#include <cstdint>
namespace pg8 {
#define PG8_LAS __attribute__((address_space(3)))
typedef unsigned short bf16_t;
typedef short bf16x8 __attribute__((ext_vector_type(8)));
typedef float f32x4 __attribute__((ext_vector_type(4)));
typedef unsigned u32x4 __attribute__((ext_vector_type(4)));
constexpr int BM = 256, BK = 64, HALF = 128, HTB = HALF * BK * 2  , STAGE_BYTES = 8 * HTB, NXCD = 8, WGM = 8;

__host__ __device__ __forceinline__ int lds_byte(int r, int c) { const int st = (r >> 4) * 2 + (c >> 5), rr = r & 15, cc = c & 31, ob = rr * 64 + cc * 2; return st * 1024 + (ob ^ (((ob >> 9) & 1) << 5)); }
__host__ __device__ __forceinline__ void stage_rc(int b, int& R, int& C) { const int st = b / 1024, sb = b % 1024, swz = sb ^ (((sb >> 9) & 1) << 5); R = (st >> 1) * 16 + swz / 64; C = (st & 1) * 32 + (swz % 64) / 2; }
__host__ __device__ __forceinline__ int perm32(int rho) { const int n = rho >> 4, i = rho & 15; return 8 * (i >> 2) + 4 * n + (i & 3); }

struct Unit { int pm, pn; };
struct Gemm { const bf16_t* A; const bf16_t* Bt; int M, N, K, lda; const int* src; };

struct StaticOrder {
    int nM, nN, nwg, G, c;
    __host__ __device__ void init(int M, int N, int G_, int c_) { nM = M / BM; nN = N / BM; nwg = nM * nN; G = G_; c = c_; }
    __host__ __device__ bool next(int i, Unit& u) const {
        const long L = (long)i * G + c; if (L >= nwg) return false;
        int wgid = (int)L; { const int q = nwg / NXCD, r = nwg % NXCD, xcd = wgid % NXCD, off = wgid / NXCD; wgid = (xcd < r ? xcd * (q + 1) : r * (q + 1) + (xcd - r) * q) + off; }
        const int nig = WGM * nN, gid = wgid / nig, fm = gid * WGM, gsz = (nM - fm) < WGM ? (nM - fm) : WGM;
        u.pm = fm + ((wgid % nig) % gsz); u.pn = (wgid % nig) / gsz; return true;
    }
    __device__ __forceinline__ void a_ready(const Unit&) const {}
    __device__ __forceinline__ void done(const Unit&) const {}
};

__device__ __forceinline__ unsigned cvt_pk_bf16(float lo, float hi) { unsigned r; asm volatile("v_cvt_pk_bf16_f32 %0, %1, %2" : "=v"(r) : "v"(lo), "v"(hi)); return r; }
typedef float f32x2 __attribute__((ext_vector_type(2)));
__device__ __forceinline__ f32x2 gelu_pk(f32x2 v) {
    const f32x2 av = __builtin_elementwise_abs(v), d = av * 0.2316418882f + 1.0f;
    f32x2 t; t.x = __builtin_amdgcn_rcpf(d.x); t.y = __builtin_amdgcn_rcpf(d.y);
    f32x2 q = t * 0.5307027145f + (-0.7265760135f); q = q * t + 0.7107068705f; q = q * t + (-0.142248368f); q = q * t + 0.127414796f; q = q * t;
    const f32x2 s = (v * v) * (-0.72134752044f);
    f32x2 e; e.x = __builtin_amdgcn_exp2f(s.x); e.y = __builtin_amdgcn_exp2f(s.y);
    const f32x2 m = v * (q * e), r = v - m;
    f32x2 o; o.x = v.x < 0.f ? m.x : r.x; o.y = v.y < 0.f ? m.y : r.y; return o;
}

template <int ACT  > struct EpiBf16 {
    static constexpr bool PERM = true, AFTER_DRAIN = false; static_assert(ACT == 0 || ACT == 1, "EpiBf16: ACT is 0 (none) or 1 (gelu_pk)");
    bf16_t* O; int ldc; const float* bias; int split_cols; size_t split_stride; float scale0;
    __device__ __forceinline__ void operator()(const f32x4 (&acc)[2][2][4][2], const Unit& u, int wr, int wc, int fr, int fq) const {
        const int row0 = u.pm * BM + wr * 64 + fr; int colt = u.pn * BM; bf16_t* base = O;
        float sc = 1.f; if (split_cols) { const int t = colt / split_cols; base += (size_t)t * split_stride; colt -= t * split_cols; if (t == 0) sc = scale0; }
        const int col0 = colt + wc * 32 + 8 * fq, bcol0 = u.pn * BM + wc * 32 + 8 * fq;
        f32x4 bv[2][2];
#pragma unroll
        for (int bj = 0; bj < 2; ++bj)
#pragma unroll
            for (int n = 0; n < 2; ++n) bv[bj][n] = bias ? *(const f32x4*)(bias + bcol0 + bj * HALF + 4 * n) : (f32x4){0.f, 0.f, 0.f, 0.f};
#pragma unroll
        for (int ai = 0; ai < 2; ++ai)
#pragma unroll
            for (int m = 0; m < 4; ++m) { bf16_t* rowp = base + (size_t)(row0 + ai * HALF + m * 16) * ldc + col0;
#pragma unroll
                for (int bj = 0; bj < 2; ++bj) { f32x4 v0 = acc[ai][bj][m][0] + bv[bj][0], v1 = acc[ai][bj][m][1] + bv[bj][1];
                    if (ACT == 1) { f32x2 a = gelu_pk((f32x2){v0[0], v0[1]}), b = gelu_pk((f32x2){v0[2], v0[3]}), c = gelu_pk((f32x2){v1[0], v1[1]}), d = gelu_pk((f32x2){v1[2], v1[3]});
                        v0 = (f32x4){a.x, a.y, b.x, b.y}; v1 = (f32x4){c.x, c.y, d.x, d.y}; }
                    v0 = v0 * sc; v1 = v1 * sc; u32x4 w; w.x = cvt_pk_bf16(v0[0], v0[1]); w.y = cvt_pk_bf16(v0[2], v0[3]); w.z = cvt_pk_bf16(v1[0], v1[1]); w.w = cvt_pk_bf16(v1[2], v1[3]);
                    *(u32x4*)(rowp + bj * HALF) = w; } }
    }
};
template <int ACT  > struct EpiBf16NT {
    static constexpr bool PERM = true, AFTER_DRAIN = false; static_assert(ACT == 0 || ACT == 1, "EpiBf16: ACT is 0 (none) or 1 (gelu_pk)");
    bf16_t* O; int ldc; const float* bias; int split_cols; size_t split_stride; float scale0;
    __device__ __forceinline__ void operator()(const f32x4 (&acc)[2][2][4][2], const Unit& u, int wr, int wc, int fr, int fq) const {
        const int row0 = u.pm * BM + wr * 64 + fr; int colt = u.pn * BM; bf16_t* base = O;
        float sc = 1.f; if (split_cols) { const int t = colt / split_cols; base += (size_t)t * split_stride; colt -= t * split_cols; if (t == 0) sc = scale0; }
        const int col0 = colt + wc * 32 + 8 * fq, bcol0 = u.pn * BM + wc * 32 + 8 * fq;
        f32x4 bv[2][2];
#pragma unroll
        for (int bj = 0; bj < 2; ++bj)
#pragma unroll
            for (int n = 0; n < 2; ++n) bv[bj][n] = bias ? *(const f32x4*)(bias + bcol0 + bj * HALF + 4 * n) : (f32x4){0.f, 0.f, 0.f, 0.f};
#pragma unroll
        for (int ai = 0; ai < 2; ++ai)
#pragma unroll
            for (int m = 0; m < 4; ++m) { bf16_t* rowp = base + (size_t)(row0 + ai * HALF + m * 16) * ldc + col0;
#pragma unroll
                for (int bj = 0; bj < 2; ++bj) { f32x4 v0 = acc[ai][bj][m][0] + bv[bj][0], v1 = acc[ai][bj][m][1] + bv[bj][1];
                    if (ACT == 1) { f32x2 a = gelu_pk((f32x2){v0[0], v0[1]}), b = gelu_pk((f32x2){v0[2], v0[3]}), c = gelu_pk((f32x2){v1[0], v1[1]}), d = gelu_pk((f32x2){v1[2], v1[3]});
                        v0 = (f32x4){a.x, a.y, b.x, b.y}; v1 = (f32x4){c.x, c.y, d.x, d.y}; }
                    v0 = v0 * sc; v1 = v1 * sc; u32x4 w; w.x = cvt_pk_bf16(v0[0], v0[1]); w.y = cvt_pk_bf16(v0[2], v0[3]); w.z = cvt_pk_bf16(v1[0], v1[1]); w.w = cvt_pk_bf16(v1[2], v1[3]);
                    __builtin_nontemporal_store(w, (u32x4*)(rowp + bj * HALF)); } }
    }
};
struct EpiF32 {
    static constexpr bool PERM = false, AFTER_DRAIN = false;
    float* C; int ldc; const float* bias;
    __device__ __forceinline__ void operator()(const f32x4 (&acc)[2][2][4][2], const Unit& u, int wr, int wc, int fr, int fq) const {
        const int row0 = u.pm * BM + wr * 64 + fr, col0 = u.pn * BM + wc * 32 + 4 * fq;
        f32x4 bv[2][2];
#pragma unroll
        for (int bj = 0; bj < 2; ++bj)
#pragma unroll
            for (int n = 0; n < 2; ++n) bv[bj][n] = bias ? *(const f32x4*)(bias + col0 + bj * HALF + n * 16) : (f32x4){0.f, 0.f, 0.f, 0.f};
#pragma unroll
        for (int ai = 0; ai < 2; ++ai)
#pragma unroll
            for (int m = 0; m < 4; ++m) { float* rowp = C + (size_t)(row0 + ai * HALF + m * 16) * ldc + col0;
#pragma unroll
                for (int bj = 0; bj < 2; ++bj)
#pragma unroll
                    for (int n = 0; n < 2; ++n) *(f32x4*)(rowp + bj * HALF + n * 16) = acc[ai][bj][m][n] + bv[bj][n]; }
    }
};
template <class Epi, class Sched, bool ALIGN_EPI = false, bool SP2 = false, bool GATHER = false>
__device__ __forceinline__ void gemm_phase(PG8_LAS unsigned char* lds, const Gemm g, const Sched& S, const Epi& E) {
    int tid = threadIdx.x; asm volatile("" : "+v"(tid)); const int wid = __builtin_amdgcn_readfirstlane(tid >> 6), lane = tid & 63, wr = wid >> 2, wc = wid & 3, fr = lane & 15, fq = lane >> 4;
    const int K = g.K, nt = K / BK;
    unsigned voffA[2], voffB[2]; int RA[2]; unsigned CA2[2];
#pragma unroll
    for (int i = 0; i < 2; ++i) { int R, C; stage_rc(tid * 16 + i * 8192, R, C); const int Rb = Epi::PERM ? ((R & ~31) + perm32(R & 31)) : R;
        voffA[i] = (unsigned)(R * g.lda + C) * 2u; voffB[i] = (unsigned)(Rb * K + C) * 2u; RA[i] = R; CA2[i] = (unsigned)C * 2u; }
    unsigned gcur[2][2] = {{0u, 0u}, {0u, 0u}}, gnxt[2][2] = {{0u, 0u}, {0u, 0u}};
#define PG8_GOFF(dst, u_) do { _Pragma("unroll") for (int h_ = 0; h_ < 2; ++h_) _Pragma("unroll") for (int i_ = 0; i_ < 2; ++i_) \
        dst[h_][i_] = (unsigned)g.src[(u_).pm * BM + h_ * HALF + RA[i_]] * (unsigned)(g.lda * 2) + CA2[i_]; } while (0)
#define PG8_STAGE_A(bufoff, gbase, h, nx) do { if constexpr (GATHER) { unsigned vs_[2] = {(nx) ? gnxt[h][0] : gcur[h][0], (nx) ? gnxt[h][1] : gcur[h][1]}; PG8_STAGE(bufoff, gbase, vs_); } \
        else { PG8_STAGE(bufoff, (gbase) + ((h) ? hstepA : 0), voffA); } } while (0)
    const size_t kstep = (size_t)(BK * 2);
    const size_t hstepA = (size_t)HALF * g.lda * 2, hstepB = (size_t)HALF * K * 2;
    const size_t tstepA = 2 * hstepA, tstepB = 2 * hstepB;
    const unsigned ldsw = (unsigned)wid * 1024u;
    const int aoff = lds_byte(wr * 64 + fr, fq * 8), boff = lds_byte(wc * 32 + fr, fq * 8);
#define PG8_SA(b, h) (((b) * 2 + (h)) * HTB)
#define PG8_SB(b, h) ((4 + (b) * 2 + (h)) * HTB)
#define PG8_STAGE(bufoff, gbase, voff) do { _Pragma("unroll") for (int _i = 0; _i < 2; ++_i) \
        __builtin_amdgcn_global_load_lds((const unsigned*)((const char*)(gbase) + (voff)[_i]), (PG8_LAS unsigned*)(lds + (bufoff) + ldsw + _i * 8192), 16, 0, 0); } while (0)
#define PG8_LDA(dst, b, h) do { _Pragma("unroll") for (int m = 0; m < 4; ++m) _Pragma("unroll") for (int k = 0; k < 2; ++k) dst[m][k] = *(const PG8_LAS bf16x8*)(lds + PG8_SA(b, h) + aoff + m * 2048 + k * 1024); } while (0)
#define PG8_LDB(dst, b, h) do { _Pragma("unroll") for (int n = 0; n < 2; ++n) _Pragma("unroll") for (int k = 0; k < 2; ++k) dst[n][k] = *(const PG8_LAS bf16x8*)(lds + PG8_SB(b, h) + boff + n * 2048 + k * 1024); } while (0)
#define PG8_MMA(ai, bj, At, Bt) do { __builtin_amdgcn_s_setprio(1); _Pragma("unroll") for (int m = 0; m < 4; ++m) _Pragma("unroll") for (int n = 0; n < 2; ++n) _Pragma("unroll") for (int k = 0; k < 2; ++k) \
        acc[ai][bj][m][n] = __builtin_amdgcn_mfma_f32_16x16x32_bf16(Bt[n][k], At[m][k], acc[ai][bj][m][n], 0, 0, 0); __builtin_amdgcn_s_setprio(0); } while (0)
#define PG8_WAIT_V(n) asm volatile("s_waitcnt vmcnt(" #n ")" ::: "memory")
#define PG8_WAIT_L(n) asm volatile("s_waitcnt lgkmcnt(" #n ")" ::: "memory")
#define PG8_BAR __builtin_amdgcn_s_barrier()
#define PG8_SCHED __builtin_amdgcn_sched_barrier(0)
    Unit cur, nxt; int ui = 0;
    if (!S.next(0, cur)) return;
    f32x4 acc[2][2][4][2];
#pragma unroll
    for (int a = 0; a < 2; ++a)
#pragma unroll
        for (int b = 0; b < 2; ++b)
#pragma unroll
            for (int m = 0; m < 4; ++m)
#pragma unroll
                for (int n = 0; n < 2; ++n) acc[a][b][m][n] = (f32x4){0.f, 0.f, 0.f, 0.f};
    bf16x8 At[4][2], B0[2][2], B1[2][2];
    const char* cA = (const char*)g.A + (GATHER ? (size_t)0 : (size_t)cur.pm * tstepA); const char* cB = (const char*)g.Bt + (size_t)cur.pn * tstepB;
    if constexpr (GATHER) PG8_GOFF(gcur, cur);
    S.a_ready(cur);
    if constexpr (SP2) {
        PG8_STAGE(PG8_SB(0, 0), cB, voffB); PG8_STAGE(PG8_SB(0, 1), cB + hstepB, voffB); PG8_STAGE_A(PG8_SA(0, 0), cA, 0, false); PG8_STAGE_A(PG8_SA(0, 1), cA, 1, false);
        if (wr == 1) PG8_BAR;
        PG8_WAIT_V(2); PG8_BAR;
        PG8_STAGE(PG8_SB(1, 0), cB + kstep, voffB); PG8_STAGE_A(PG8_SA(1, 0), cA + kstep, 0, false); PG8_STAGE(PG8_SB(1, 1), cB + hstepB + kstep, voffB);
        PG8_WAIT_V(6); PG8_BAR;
    } else {
        PG8_STAGE(PG8_SB(0, 0), cB, voffB); PG8_STAGE_A(PG8_SA(0, 0), cA, 0, false); PG8_STAGE(PG8_SB(0, 1), cB + hstepB, voffB); PG8_STAGE_A(PG8_SA(0, 1), cA, 1, false);
        if (wr == 1) PG8_BAR;
        PG8_WAIT_V(4); PG8_BAR;
        PG8_STAGE(PG8_SB(1, 0), cB + kstep, voffB); PG8_STAGE_A(PG8_SA(1, 0), cA + kstep, 0, false); PG8_STAGE(PG8_SB(1, 1), cB + hstepB + kstep, voffB);
        PG8_WAIT_V(6); PG8_BAR;
    }
    for (;;) {
        const bool has_next = S.next(ui + 1, nxt);
        const char* nA = (has_next && !GATHER) ? (const char*)g.A + (size_t)nxt.pm * tstepA : cA; const char* nB = has_next ? (const char*)g.Bt + (size_t)nxt.pn * tstepB : cB;
        if constexpr (GATHER) { if (has_next) PG8_GOFF(gnxt, nxt); else { _Pragma("unroll") for (int h_ = 0; h_ < 2; ++h_) { gnxt[h_][0] = gcur[h_][0]; gnxt[h_][1] = gcur[h_][1]; } } }
#pragma unroll 1
        for (int t = 0; t < nt; t += 2) {
            const bool last = (t == nt - 2);
            const char* a1 = cA + (size_t)(t + 1) * kstep;
            const char* a2 = last ? nA : cA + (size_t)(t + 2) * kstep; const char* b2 = last ? nB : cB + (size_t)(t + 2) * kstep;
            const char* a3 = a2 + kstep; const char* b3 = b2 + kstep;
            if (last && has_next) S.a_ready(nxt);
            if constexpr (SP2) {
            PG8_LDB(B0, 0, 0); PG8_LDB(B1, 0, 1); PG8_SCHED; PG8_LDA(At, 0, 0); PG8_STAGE_A(PG8_SA(1, 1), a1, 1, false);
            PG8_WAIT_V(8); PG8_WAIT_L(0); PG8_BAR; PG8_MMA(0, 0, At, B0); PG8_MMA(0, 1, At, B1); PG8_BAR; PG8_SCHED;
            PG8_LDA(At, 0, 1); PG8_STAGE(PG8_SB(0, 0), b2, voffB); PG8_STAGE(PG8_SB(0, 1), b2 + hstepB, voffB); PG8_STAGE_A(PG8_SA(0, 0), a2, 0, last);
            PG8_WAIT_V(8); PG8_WAIT_L(0); PG8_BAR; PG8_MMA(1, 0, At, B0); PG8_MMA(1, 1, At, B1); PG8_BAR; PG8_SCHED;
            PG8_LDB(B0, 1, 0); PG8_LDB(B1, 1, 1); PG8_SCHED; PG8_LDA(At, 1, 0); PG8_STAGE_A(PG8_SA(0, 1), a2, 1, last);
            PG8_WAIT_V(8); PG8_WAIT_L(0); PG8_BAR; PG8_MMA(0, 0, At, B0); PG8_MMA(0, 1, At, B1); PG8_BAR; PG8_SCHED;
            PG8_LDA(At, 1, 1); PG8_STAGE(PG8_SB(1, 0), b3, voffB); PG8_STAGE(PG8_SB(1, 1), b3 + hstepB, voffB); PG8_STAGE_A(PG8_SA(1, 0), a3, 0, last);
            PG8_WAIT_V(8); PG8_WAIT_L(0); PG8_BAR; PG8_MMA(1, 0, At, B0); PG8_MMA(1, 1, At, B1); PG8_BAR; PG8_SCHED;
            } else {
            PG8_LDB(B0, 0, 0); PG8_SCHED; PG8_LDA(At, 0, 0); PG8_STAGE_A(PG8_SA(1, 1), a1, 1, false);
            PG8_WAIT_L(8); PG8_BAR; PG8_WAIT_L(0); PG8_MMA(0, 0, At, B0); PG8_BAR; PG8_SCHED;
            PG8_LDB(B1, 0, 1); PG8_STAGE(PG8_SB(0, 0), b2, voffB);
            PG8_BAR; PG8_WAIT_L(0); PG8_MMA(0, 1, At, B1); PG8_BAR;
            PG8_LDA(At, 0, 1); PG8_STAGE_A(PG8_SA(0, 0), a2, 0, last);
            PG8_BAR; PG8_WAIT_L(0); PG8_MMA(1, 0, At, B0); PG8_BAR; PG8_SCHED;
            PG8_STAGE(PG8_SB(0, 1), b2 + hstepB, voffB);
            PG8_WAIT_V(6); PG8_BAR; PG8_MMA(1, 1, At, B1); PG8_BAR;
            PG8_LDB(B0, 1, 0); PG8_SCHED; PG8_LDA(At, 1, 0); PG8_STAGE_A(PG8_SA(0, 1), a2, 1, last);
            PG8_WAIT_L(8); PG8_BAR; PG8_WAIT_L(0); PG8_MMA(0, 0, At, B0); PG8_BAR; PG8_SCHED;
            PG8_LDB(B1, 1, 1); PG8_STAGE(PG8_SB(1, 0), b3, voffB);
            PG8_BAR; PG8_WAIT_L(0); PG8_MMA(0, 1, At, B1); PG8_BAR;
            PG8_LDA(At, 1, 1); PG8_STAGE_A(PG8_SA(1, 0), a3, 0, last);
            PG8_BAR; PG8_WAIT_L(0); PG8_MMA(1, 0, At, B0); PG8_BAR; PG8_SCHED;
            PG8_STAGE(PG8_SB(1, 1), b3 + hstepB, voffB);
            PG8_WAIT_V(6); PG8_BAR; PG8_MMA(1, 1, At, B1); PG8_BAR;
            }
        }
        if constexpr (ALIGN_EPI) { if (wr == 0) PG8_BAR; }
        if constexpr (!Epi::AFTER_DRAIN) { E(acc, cur, wr, wc, fr, fq); S.done(cur); }
        if (!has_next) break;
#pragma unroll
        for (int a = 0; a < 2; ++a)
#pragma unroll
            for (int b = 0; b < 2; ++b)
#pragma unroll
                for (int m = 0; m < 4; ++m)
#pragma unroll
                    for (int n = 0; n < 2; ++n) acc[a][b][m][n] = (f32x4){0.f, 0.f, 0.f, 0.f};
        cur = nxt; cA = nA; cB = nB; ++ui;
        if constexpr (GATHER) { _Pragma("unroll") for (int h_ = 0; h_ < 2; ++h_) { gcur[h_][0] = gnxt[h_][0]; gcur[h_][1] = gnxt[h_][1]; } }
        if constexpr (ALIGN_EPI) { if (wr == 1) PG8_BAR; }
    }
    PG8_WAIT_V(0);
    if constexpr (!ALIGN_EPI) { if (wr == 0) PG8_BAR; }
    PG8_BAR;
    if constexpr (Epi::AFTER_DRAIN) { E.fused(acc, cur, wr, wc, fr, fq, lds, wid, lane); S.done(cur); }
#undef PG8_SA
#undef PG8_GOFF
#undef PG8_STAGE_A
#undef PG8_SB
#undef PG8_STAGE
#undef PG8_LDA
#undef PG8_LDB
#undef PG8_MMA
#undef PG8_WAIT_V
#undef PG8_WAIT_L
#undef PG8_BAR
#undef PG8_SCHED
}
}

constexpr int NB = 16, SEQ = 4096, CTX = 256, TT = SEQ + CTX, M = NB * TT, D = 1024, NL = 4;
constexpr int NPJ = 2304, DPROJ = 2208;
constexpr int MS = 143360;
constexpr float EPS = 1e-6f, ALPHA = 1.6817928305074290f, LOG2E = 1.4426950408889634f;
constexpr int NWAVES = 8, NTHR = 512;
#ifndef MK_DEBUG
#define MK_DEBUG 0
#endif
#ifndef MK_TIME
#define MK_TIME 0
#endif
#ifndef MK_TMUL
#define MK_TMUL 1
#endif
#ifndef MK_VM
#define MK_VM 0
#endif
#ifndef MK_DUP
#define MK_DUP 0
#endif
#ifndef MK_MULTI
#define MK_MULTI 0
#endif
constexpr int NPHASE = 2 + 10 * NL;

constexpr size_t WS_CTL = 0, CTL_BYTES = 65536;
constexpr size_t WS_MODS = WS_CTL + CTL_BYTES;
constexpr size_t WS_T64 = WS_MODS + (size_t)NL * 17 * 6144 * 4;
constexpr size_t WS_T32 = WS_T64 + 8192;
constexpr size_t WS_RS = WS_T32 + 4096;
constexpr size_t WS_RT = WS_RS + (size_t)M * 8;
constexpr size_t WS_HIST = WS_RT + (size_t)M * 32;
constexpr size_t WS_XS = WS_HIST + 65536;
constexpr size_t WS_WIN = WS_XS + (size_t)M * D * 2;
constexpr size_t WS_WD = WS_WIN + (size_t)NPJ * D * 2;
constexpr size_t WS_WOUT = WS_WD + (size_t)1024 * 384 * 2;
constexpr size_t WS_WGU = WS_WOUT + (size_t)D * D * 2;
constexpr size_t WS_WDN = WS_WGU + (size_t)16 * 1024 * 1024 * 2;
constexpr size_t WS_HA = WS_WDN + (size_t)16 * 1024 * 512 * 2;
constexpr size_t WS_PB = WS_HA + (size_t)M * D * 2;
constexpr size_t WS_QD = WS_PB + (size_t)M * NPJ * 2;
constexpr size_t WS_KD = WS_QD + (size_t)M * 384 * 2;
constexpr size_t WS_VD = WS_KD + (size_t)M * 384 * 2;
constexpr size_t WS_ACT = WS_VD + (size_t)M * 256 * 2;
constexpr size_t WS_END = WS_ACT + (size_t)MS * 512 * 2;
static_assert(WS_END <= (size_t)1073741824, "d_ws map must fit 1 GiB");
static_assert((size_t)M * NPJ * 2 >= (size_t)MS * D * 2 && (size_t)M * NPJ * 2 >= (size_t)M * D * 4, "region PB overlays");
constexpr int CW_BAR = 0;
constexpr int CW_QUEUE = 4096;

constexpr int RING_BYTES = 131072, MISC_OFF = RING_BYTES, LDS_BYTES = 147456;
constexpr int MI_BAR = 0, MI_Q = 4, MI_TOT = 16, MI_BASE = 32, MI_PST = 48, MI_LH = 80;

#define GAS __attribute__((address_space(1)))
#define LAS __attribute__((address_space(3)))
typedef unsigned short bf16;
typedef unsigned v4u __attribute__((ext_vector_type(4)));
typedef unsigned v2u __attribute__((ext_vector_type(2)));
typedef float f32x4 __attribute__((ext_vector_type(4)));
typedef float f32x2 __attribute__((ext_vector_type(2)));
typedef short bf16x8 __attribute__((ext_vector_type(8)));
typedef float f32x16 __attribute__((ext_vector_type(16)));
typedef short v4i16 __attribute__((ext_vector_type(4)));

__device__ __forceinline__ unsigned f2bf(float f) { unsigned u = __builtin_bit_cast(unsigned, f); return (u + 0x7fffu + ((u >> 16) & 1u)) >> 16; }
__device__ __forceinline__ unsigned pk2(float lo, float hi) { return f2bf(lo) | (f2bf(hi) << 16); }
__device__ __forceinline__ float bflo(unsigned w) { return __builtin_bit_cast(float, w << 16); }
__device__ __forceinline__ float bfhi(unsigned w) { return __builtin_bit_cast(float, w & 0xffff0000u); }
__device__ __forceinline__ void unpack8(v4u w, float (&f)[8]) { f[0] = bflo(w.x); f[1] = bfhi(w.x); f[2] = bflo(w.y); f[3] = bfhi(w.y); f[4] = bflo(w.z); f[5] = bfhi(w.z); f[6] = bflo(w.w); f[7] = bfhi(w.w); }
__device__ __forceinline__ v4u pack8(const float (&f)[8]) { v4u w; w.x = pk2(f[0], f[1]); w.y = pk2(f[2], f[3]); w.z = pk2(f[4], f[5]); w.w = pk2(f[6], f[7]); return w; }
__device__ __forceinline__ float wave_sum(float v) {
    int x = __builtin_bit_cast(int, v);
#define WS_DPP(ctrl, rmask) v += __builtin_bit_cast(float, __builtin_amdgcn_update_dpp(0, x, ctrl, rmask, 0xf, true)); x = __builtin_bit_cast(int, v)
    WS_DPP(0xB1, 0xf);
    WS_DPP(0x4E, 0xf);
    WS_DPP(0x141, 0xf);
    WS_DPP(0x140, 0xf);
    WS_DPP(0x142, 0xa);
    WS_DPP(0x143, 0xc);
#undef WS_DPP
    return __builtin_bit_cast(float, __builtin_amdgcn_readlane(__builtin_bit_cast(int, v), 63));
}

#define XB_TMO      128
#define XB_XCNT(j)  (256  + 64 * (j))
#define XB_XSUB(j)  (1280 + 64 * (j))
#define XB_XGEN(j)  (2304 + 64 * (j))
#define XB_TOP      3328
#define XB_TOPGEN   3392
#define XCD_BAR_WORDS 3456
#define XB_SPIN_CAP (1u << 22)
__device__ __forceinline__ unsigned xb_ld(unsigned* p)              { return __hip_atomic_load(p, __ATOMIC_RELAXED, __HIP_MEMORY_SCOPE_AGENT); }
__device__ __forceinline__ unsigned xb_add(unsigned* p, unsigned v) { return __hip_atomic_fetch_add(p, v, __ATOMIC_RELAXED, __HIP_MEMORY_SCOPE_AGENT); }
__device__ __forceinline__ unsigned xb_xcc_id() { return (unsigned)__builtin_amdgcn_s_getreg((3 << 11) | 20) & 0xFu; }
#define XB_SPIN(cond, bar) do { unsigned _sp = 0; while (cond) { __builtin_amdgcn_s_sleep(1); \
    if ((++_sp & 255u) == 0u) { if (xb_ld(&(bar)[XB_TMO])) break; if (_sp > XB_SPIN_CAP) { atomicAdd(&(bar)[XB_TMO], 1u); break; } } } } while (0)
struct XcdBarrier { unsigned* bar; unsigned x; volatile LAS unsigned* st; };
__device__ __forceinline__ XcdBarrier xcd_barrier_post(unsigned* bar, volatile LAS unsigned* st) {
    XcdBarrier b; b.bar = bar; b.x = xb_xcc_id(); b.st = st;
    if (threadIdx.x == 0) (void)xb_add(&bar[XB_XCNT(b.x)], 1u);
    return b;
}
__device__ __forceinline__ void xcd_barrier_complete(unsigned* bar, unsigned x, unsigned& nloc, unsigned& nx) {
    const unsigned G = gridDim.x * gridDim.y * gridDim.z;
    unsigned sum, cnt, mine, sp = 0u;
    for (;;) {
        sum = 0u; cnt = 0u; mine = 0u;
#pragma unroll
        for (unsigned j = 0; j < 16; ++j) { const unsigned c = xb_ld(&bar[XB_XCNT(j)]); sum += c; cnt += (c > 0u) ? 1u : 0u; mine = (j == x) ? c : mine; }
        if (sum == G) break;
        __builtin_amdgcn_s_sleep(1);
        if ((++sp & 255u) == 0u) { if (xb_ld(&bar[XB_TMO])) break; if (sp > XB_SPIN_CAP) { atomicAdd(&bar[XB_TMO], 1u); break; } }
    }
    nloc = mine > 0u ? mine : 1u; nx = cnt > 0u ? cnt : 1u;
}
__device__ __forceinline__ void xcd_barrier(const XcdBarrier& b) {
    asm volatile("s_waitcnt vmcnt(0)" ::: "memory");
    __syncthreads();
    if (threadIdx.x == 0) {
        unsigned* bar = b.bar;
        __builtin_amdgcn_s_waitcnt(0);
        unsigned nloc = b.st[0], nx = b.st[1];
        if (nloc == 0u) { xcd_barrier_complete(bar, b.x, nloc, nx); b.st[0] = nloc; b.st[1] = nx; }
        const unsigned old = xb_add(&bar[XB_XSUB(b.x)], 1u);
        const unsigned gen = old / nloc;
        if (old + 1u == (gen + 1u) * nloc) {
            __builtin_amdgcn_fence(__ATOMIC_RELEASE, "agent");
            asm volatile("s_waitcnt vmcnt(0)" ::: "memory");
            const unsigned og = xb_add(&bar[XB_TOP], 1u);
            const unsigned tg = og / nx;
            if (og + 1u == (tg + 1u) * nx) xb_add(&bar[XB_TOPGEN], 1u);
            else XB_SPIN(xb_ld(&bar[XB_TOPGEN]) == tg, bar);
            __builtin_amdgcn_fence(__ATOMIC_ACQUIRE, "agent");
            xb_add(&bar[XB_XGEN(b.x)], 1u);
            asm volatile("s_waitcnt vmcnt(0)" ::: "memory");
        } else {
            XB_SPIN(xb_ld(&bar[XB_XGEN(b.x)]) == gen, bar);
            __builtin_amdgcn_fence(__ATOMIC_ACQUIRE, "agent");
            asm volatile("s_waitcnt vmcnt(0)" ::: "memory");
        }
    }
    __syncthreads();
}

struct Args { const float* in[27]; float* out; unsigned char* ws; int ph_lo, ph_hi; };
enum { I_X = 0, I_C, I_CTX, I_CCTX, I_WADA, I_BADA, I_WIN, I_NABIAS, I_GQG, I_GKG, I_SINK, I_MQG, I_WQB, I_MKVG, I_WKVB, I_WOUT, I_LN1G, I_LN1B, I_RGW, I_RGB, I_REW, I_REB, I_WG, I_WU, I_WDN, I_LN2G, I_LN2B };

struct Frame {
    LAS unsigned char* lds; volatile LAS unsigned* MISC;
    int tid, lane, wave, G, gw, ngw, bid;
    GAS unsigned char* ws;
};
__device__ __forceinline__ int opaque_tid() { int t = threadIdx.x; asm volatile("" : "+v"(t)); return t; }
__device__ __forceinline__ int opaque_s(int x) { asm volatile("" : "+s"(x)); return x; }
constexpr int PTAB_OFF = MISC_OFF + 2048, I_OUT = 27;
__device__ __forceinline__ GAS unsigned char* ptab_get(const Frame& F, int i) {
    const LAS unsigned* t = (const LAS unsigned*)(F.lds + PTAB_OFF) + 2 * i;
    const unsigned lo = __builtin_amdgcn_readfirstlane(t[0]), hi = __builtin_amdgcn_readfirstlane(t[1]);
    return (GAS unsigned char*)(((unsigned long long)hi << 32) | lo);
}
#define INP(i) ((const float*)ptab_get(F, (i)))
__device__ __forceinline__ Frame make_frame(GAS unsigned char* ws) {
    extern __shared__ __attribute__((aligned(16))) unsigned char lds_raw[];
    Frame F;
    F.lds = (LAS unsigned char*)lds_raw; F.MISC = (volatile LAS unsigned*)(F.lds + MISC_OFF);
    F.tid = opaque_tid(); F.lane = F.tid & 63; F.wave = __builtin_amdgcn_readfirstlane(F.tid >> 6);
    F.G = opaque_s((int)gridDim.x); F.bid = opaque_s((int)blockIdx.x); F.gw = F.bid * NWAVES + F.wave; F.ngw = F.G * NWAVES;
    { unsigned long long w = (unsigned long long)ws; asm volatile("" : "+s"(w)); F.ws = (GAS unsigned char*)w; }
    return F;
}
typedef _Float16 f16x4 __attribute__((ext_vector_type(4)));
struct RowPtrs { const float* x; const float* ctx; float* out; _Float16* xs; };
__device__ __forceinline__ RowPtrs row_ptrs(const Frame& F) { RowPtrs p; p.x = INP(I_X); p.ctx = INP(I_CTX); p.out = (float*)ptab_get(F, I_OUT); p.xs = (_Float16*)(F.ws + WS_XS); return p; }
__device__ __forceinline__ const float* xin_row(const RowPtrs& P, int r) {
    const int b = r / TT, t = r - b * TT;
    return t < SEQ ? P.x + ((size_t)b * SEQ + t) * D : P.ctx + ((size_t)b * CTX + (t - SEQ)) * D;
}
__device__ __forceinline__ float* out_row(const RowPtrs& P, int r) { const int b = r / TT, t = r - b * TT; return P.out + ((size_t)b * SEQ + t) * D; }
__device__ __forceinline__ void ld16h(const _Float16* p, int lane, float (&v)[16]) {
    const f16x4* q = (const f16x4*)p + lane;
#pragma unroll
    for (int g = 0; g < 4; ++g) { const f32x4 f = __builtin_convertvector(__builtin_nontemporal_load(q + 64 * g), f32x4); v[4 * g] = f.x; v[4 * g + 1] = f.y; v[4 * g + 2] = f.z; v[4 * g + 3] = f.w; }
}
__device__ __forceinline__ void st16h(_Float16* p, int lane, const float (&v)[16]) {
    f16x4* q = (f16x4*)p + lane;
#pragma unroll
    for (int g = 0; g < 4; ++g) __builtin_nontemporal_store(__builtin_convertvector((f32x4){v[4 * g], v[4 * g + 1], v[4 * g + 2], v[4 * g + 3]}, f16x4), q + 64 * g);
}
__device__ __forceinline__ void ld16(const float* p, int lane, float (&v)[16]) {
    const f32x4* q = (const f32x4*)p + lane;
    const f32x4 a = q[0], b = q[64], c = q[128], d = q[192];
    v[0] = a.x; v[1] = a.y; v[2] = a.z; v[3] = a.w; v[4] = b.x; v[5] = b.y; v[6] = b.z; v[7] = b.w;
    v[8] = c.x; v[9] = c.y; v[10] = c.z; v[11] = c.w; v[12] = d.x; v[13] = d.y; v[14] = d.z; v[15] = d.w;
}
__device__ __forceinline__ void st16(float* p, int lane, const float (&v)[16]) {
    f32x4* q = (f32x4*)p + lane;
    q[0] = (f32x4){v[0], v[1], v[2], v[3]}; q[64] = (f32x4){v[4], v[5], v[6], v[7]};
    q[128] = (f32x4){v[8], v[9], v[10], v[11]}; q[192] = (f32x4){v[12], v[13], v[14], v[15]};
}
__device__ __forceinline__ void ld16nt(const float* p, int lane, float (&v)[16]) {
    const f32x4* q = (const f32x4*)p + lane;
    const f32x4 a = __builtin_nontemporal_load(q), b = __builtin_nontemporal_load(q + 64), c = __builtin_nontemporal_load(q + 128), d = __builtin_nontemporal_load(q + 192);
    v[0] = a.x; v[1] = a.y; v[2] = a.z; v[3] = a.w; v[4] = b.x; v[5] = b.y; v[6] = b.z; v[7] = b.w;
    v[8] = c.x; v[9] = c.y; v[10] = c.z; v[11] = c.w; v[12] = d.x; v[13] = d.y; v[14] = d.z; v[15] = d.w;
}
__device__ __forceinline__ void st16nt(float* p, int lane, const float (&v)[16]) {
    f32x4* q = (f32x4*)p + lane;
    __builtin_nontemporal_store((f32x4){v[0], v[1], v[2], v[3]}, q); __builtin_nontemporal_store((f32x4){v[4], v[5], v[6], v[7]}, q + 64);
    __builtin_nontemporal_store((f32x4){v[8], v[9], v[10], v[11]}, q + 128); __builtin_nontemporal_store((f32x4){v[12], v[13], v[14], v[15]}, q + 192);
}
__device__ __forceinline__ void unpack16(const v2u (&w)[4], float (&v)[16]) {
#pragma unroll
    for (int g = 0; g < 4; ++g) { v[4 * g] = bflo(w[g].x); v[4 * g + 1] = bfhi(w[g].x); v[4 * g + 2] = bflo(w[g].y); v[4 * g + 3] = bfhi(w[g].y); }
}
__device__ __forceinline__ void ld16bf_raw(const bf16* p, int lane, v2u (&w)[4]) {
    const v2u* q = (const v2u*)p + lane; w[0] = q[0]; w[1] = q[64]; w[2] = q[128]; w[3] = q[192];
}
__device__ __forceinline__ void ld16bf_raw_nt(const bf16* p, int lane, v2u (&w)[4]) {
    const v2u* q = (const v2u*)p + lane; w[0] = __builtin_nontemporal_load(q); w[1] = __builtin_nontemporal_load(q + 64); w[2] = __builtin_nontemporal_load(q + 128); w[3] = __builtin_nontemporal_load(q + 192);
}
__device__ __forceinline__ void ld16bf(const bf16* p, int lane, float (&v)[16]) { v2u w[4]; ld16bf_raw(p, lane, w); unpack16(w, v); }
__device__ __forceinline__ void ld16bf_nt(const bf16* p, int lane, float (&v)[16]) { v2u w[4]; ld16bf_raw_nt(p, lane, w); unpack16(w, v); }
__device__ __forceinline__ void st16bf(bf16* p, int lane, const float (&v)[16]) {
    v2u* q = (v2u*)p + lane;
#pragma unroll
    for (int g = 0; g < 4; ++g) { v2u w; w.x = pk2(v[4 * g], v[4 * g + 1]); w.y = pk2(v[4 * g + 2], v[4 * g + 3]); q[64 * g] = w; }
}
__device__ __forceinline__ void ln16(float (&v)[16]) {
    float s = 0.f;
#pragma unroll
    for (int i = 0; i < 16; ++i) s += v[i];
    const float mean = wave_sum(s) * (1.0f / D); float q = 0.f;
#pragma unroll
    for (int i = 0; i < 16; ++i) { v[i] -= mean; q += v[i] * v[i]; }
    const float rstd = 1.0f / sqrtf(wave_sum(q) * (1.0f / D) + EPS);
#pragma unroll
    for (int i = 0; i < 16; ++i) v[i] *= rstd;
}

__device__ __forceinline__ int rows_per_wave(int ngw) {
    int rpw = (M + ngw - 1) / ngw;
    if (!((SEQ % rpw) % 4 == 0 && (TT % rpw) == 0 && (rpw % 2) == 0)) rpw = (rpw + 3) & ~3;
    return rpw;
}
template <int TYPE>
__device__ __forceinline__ float conv_src(const float* p0, const float* p1, const float* g0, const float* g1, int l, int k, int n) {
    if (TYPE == 0) return n < DPROJ ? p0[((size_t)l * D + k) * DPROJ + n] : 0.f;
    if (TYPE == 1) { if (n < 384) return k < 256 ? g0[l * 256 + k] * p0[((size_t)l * 256 + k) * 384 + n] : 0.f;
                     if (n < 896) return k >= 256 ? g1[l * 128 + (k - 256)] * p1[((size_t)l * 128 + (k - 256)) * 512 + (n - 384)] : 0.f;
                     return 0.f; }
    if (TYPE == 2) return p0[((size_t)l * D + k) * D + n];
    if (TYPE == 3) { const int e = n >> 10, nn = n & 1023, q = nn >> 3, j = nn & 7;
                     return j < 4 ? p0[(((size_t)l * 16 + e) * D + k) * 512 + 4 * q + j] : p1[(((size_t)l * 16 + e) * D + k) * 512 + 4 * q + (j - 4)]; }
    { const int e = n >> 10, nn = n & 1023; return p0[(((size_t)l * 16 + e) * 512 + k) * D + nn]; }
}
template <int TYPE>
__device__ __forceinline__ void conv_item(const Frame& F, int l, int item, LAS float* scr) {
    constexpr int Nd = TYPE == 0 ? NPJ : TYPE == 1 ? 1024 : TYPE == 2 ? 1024 : 16384, Kd = TYPE == 1 ? 384 : TYPE == 4 ? 512 : 1024;
    bf16* dst = (bf16*)(F.ws + (TYPE == 0 ? WS_WIN : TYPE == 1 ? WS_WD : TYPE == 2 ? WS_WOUT : TYPE == 3 ? WS_WGU : WS_WDN));
    const float* p0 = INP(TYPE == 0 ? I_WIN : TYPE == 1 ? I_WQB : TYPE == 2 ? I_WOUT : TYPE == 3 ? I_WG : I_WDN);
    const float* p1 = INP(TYPE == 1 ? I_WKVB : I_WU); const float* g0 = INP(I_MQG); const float* g1 = INP(I_MKVG);
    constexpr int nblk = Nd / 32; const int kb = item / nblk, nb = item - kb * nblk, k0 = 64 * kb, n0 = 32 * nb, lane = F.lane;
#pragma unroll
    for (int i = 0; i < 32; ++i) { const int kk = 2 * i + (lane >> 5); scr[kk * 33 + (lane & 31)] = conv_src<TYPE>(p0, p1, g0, g1, l, k0 + kk, n0 + (lane & 31)); }
    asm volatile("s_waitcnt lgkmcnt(0)" ::: "memory");
    const int c = lane & 7;
#pragma unroll
    for (int j = 0; j < 4; ++j) { const int n = (lane >> 3) + 8 * j; const LAS float* s = scr + (8 * c) * 33 + n;
        v4u o; o.x = pk2(s[0 * 33], s[1 * 33]); o.y = pk2(s[2 * 33], s[3 * 33]); o.z = pk2(s[4 * 33], s[5 * 33]); o.w = pk2(s[6 * 33], s[7 * 33]);
        *(v4u*)(dst + (size_t)(n0 + n) * Kd + k0 + 8 * c) = o; }
    asm volatile("s_waitcnt lgkmcnt(0)" ::: "memory");
}
__device__ __forceinline__ void phase_prologue(const Frame& F) {
    {
        LAS float* sv = (LAS float*)F.lds;
        LAS float* red = (LAS float*)(F.lds + 17 * 1024 * 4);
        float* mods = (float*)(F.ws + WS_MODS);
        for (int u = F.bid; u < NL * 48; u += F.G) {
            const int l = u / 48, cc = u - l * 48;
            const float* pc = INP(I_C); const float* pcc = INP(I_CCTX);
            for (int i = F.tid; i < 17 * 1024; i += NTHR) { const int mr = i >> 10, k = i & 1023; const float c = mr < 16 ? pc[mr * 1024 + k] : pcc[k]; sv[i] = c / (1.0f + expf(-c)); }
            __syncthreads();
            const int col = F.tid & 127, kg = F.tid >> 7;
            float acc[17];
#pragma unroll
            for (int mr = 0; mr < 17; ++mr) acc[mr] = 0.f;
            const float* w = INP(I_WADA) + ((size_t)l * 1024 + kg * 256) * 6144 + cc * 128 + col;
            for (int k4 = 0; k4 < 256; k4 += 4) {
                const float w0 = w[(size_t)(k4 + 0) * 6144], w1 = w[(size_t)(k4 + 1) * 6144], w2 = w[(size_t)(k4 + 2) * 6144], w3 = w[(size_t)(k4 + 3) * 6144];
#pragma unroll
                for (int mr = 0; mr < 17; ++mr) { const f32x4 s = *(const LAS f32x4*)(sv + mr * 1024 + kg * 256 + k4); acc[mr] += (s.x * w0 + s.y * w1) + (s.z * w2 + s.w * w3); }
            }
#pragma unroll
            for (int mr = 0; mr < 17; ++mr) red[(kg * 17 + mr) * 128 + col] = acc[mr];
            __syncthreads();
            const float* bada = INP(I_BADA);
            for (int i = F.tid; i < 17 * 128; i += NTHR) { const int mr = i >> 7, c = i & 127;
                const float s = (red[(0 * 17 + mr) * 128 + c] + red[(1 * 17 + mr) * 128 + c]) + (red[(2 * 17 + mr) * 128 + c] + red[(3 * 17 + mr) * 128 + c]);
                mods[((size_t)l * 17 + mr) * 6144 + cc * 128 + c] = s + bada[l * 6144 + cc * 128 + c]; }
            __syncthreads();
        }
    }
    {
        float* t64 = (float*)(F.ws + WS_T64); float* t32 = (float*)(F.ws + WS_T32);
        for (int i = F.bid * NTHR + F.tid; i < 64 * 16 + 64 * 8; i += F.G * NTHR) {
            if (i < 1024) { const int p = i >> 4, k = i & 15; const float fr = powf(10000.0f, -(float)k / 16.0f), ang = (float)p * fr; t64[2 * i] = cosf(ang); t64[2 * i + 1] = sinf(ang); }
            else { const int j = i - 1024, p = j >> 3, k = j & 7; const float fr = powf(10000.0f, -(float)k / 8.0f), ang = (float)p * fr; t32[2 * j] = cosf(ang); t32[2 * j + 1] = sinf(ang); }
        }
    }
}
__device__ __forceinline__ void convert_layer_weights(const Frame& F, int l) {
    {
        LAS float* scr = (LAS float*)(F.lds + F.wave * 8448);
        constexpr int I0 = 1152, I1 = 192, I2 = 512, I3 = 8192, I4 = 4096, IL = I0 + I1 + I2 + I3 + I4;
        for (int r0_ = F.gw; r0_ < IL; r0_ += F.ngw) {
            int r = r0_;
            if (r < I0) { conv_item<0>(F, l, r, scr); continue; } r -= I0;
            if (r < I1) { conv_item<1>(F, l, r, scr); continue; } r -= I1;
            if (r < I2) { conv_item<2>(F, l, r, scr); continue; } r -= I2;
            if (r < I3) { conv_item<3>(F, l, r, scr); continue; } r -= I3;
            conv_item<4>(F, l, r, scr);
        }
    }
}

__device__ __forceinline__ void phase_ln(const Frame& F, int l) {
    if (l < NL) convert_layer_weights(F, l);
    constexpr int NR = 4;
    const float* mods = (const float*)(F.ws + WS_MODS); bf16* HA = (bf16*)(F.ws + WS_HA);
    const bf16* Y = (const bf16*)(F.ws + WS_PB); const unsigned* RT = (const unsigned*)(F.ws + WS_RT);
    const int lane = F.lane; const RowPtrs RP = row_ptrs(F);
    const float* ln2g = INP(I_LN2G) + (l > 0 ? l - 1 : 0) * D; const float* ln2b = INP(I_LN2B) + (l > 0 ? l - 1 : 0) * D;
    const int rpw = rows_per_wave(F.ngw), rbeg = F.gw * rpw, rend = min(M, rbeg + rpw);
    float g2[16]; int cur_mr = -1;
    float alpha_l = ALPHA; asm volatile("" : "+v"(alpha_l));
    for (int r0 = rbeg; r0 < rend; r0 += NR) {
        float v[NR][16]; v4u rt[NR]; v2u ya[NR][4], yb[NR][4]; bool act[NR];
        const int b0 = r0 / TT, t0 = r0 - b0 * TT; const bool lat = t0 < SEQ; const int mr = lat ? b0 : 16;
        if (l == NL && !lat) continue;
#pragma unroll
        for (int u = 0; u < NR; ++u) {
            const int r = r0 + u; act[u] = r < rend; const int rc = act[u] ? r : r0;
            if (l == 0) ld16nt(xin_row(RP, rc), lane, v[u]); else ld16h(RP.xs + (size_t)rc * D, lane, v[u]);
            rt[u] = *(const v4u*)(RT + (size_t)rc * 8 + 4);
        }
        if (mr != cur_mr) { if (l > 0) ld16(mods + ((size_t)(l - 1) * 17 + mr) * 6144 + 5120, lane, g2); cur_mr = mr; }
        if (l > 0) {
#pragma unroll
            for (int u = 0; u < NR; ++u) { ld16bf_raw_nt(Y + (size_t)rt[u].z * D, lane, ya[u]); ld16bf_raw_nt(Y + (size_t)rt[u].w * D, lane, yb[u]); }
#pragma unroll
            for (int u = 0; u < NR; ++u) {
                float f0[16], f1[16], gg[16], bb[16];
                const float w0 = __uint_as_float(rt[u].x), w1 = __uint_as_float(rt[u].y);
                unpack16(ya[u], f0); unpack16(yb[u], f1);
#pragma unroll
                for (int i = 0; i < 16; ++i) v[u][i] = alpha_l * v[u][i] + g2[i] * (w0 * f0[i] + w1 * f1[i]);
                ld16(ln2g, lane, gg); ld16(ln2b, lane, bb);
                ln16(v[u]);
#pragma unroll
                for (int i = 0; i < 16; ++i) v[u][i] = v[u][i] * gg[i] + bb[i];
                if (act[u]) { if (l == NL) st16nt(out_row(RP, r0 + u), lane, v[u]); else st16h(RP.xs + (size_t)(r0 + u) * D, lane, v[u]); }
            }
        }
        if (l < NL) {
            float sh[16], sc[16]; ld16(mods + ((size_t)l * 17 + mr) * 6144, lane, sh); ld16(mods + ((size_t)l * 17 + mr) * 6144 + 1024, lane, sc);
#pragma unroll
            for (int u = 0; u < NR; ++u) {
                ln16(v[u]);
#pragma unroll
                for (int i = 0; i < 16; ++i) v[u][i] = v[u][i] * (1.0f + sc[i]) + sh[i];
                if (act[u]) st16bf(HA + (size_t)(r0 + u) * D, lane, v[u]);
            }
        }
    }
}

__device__ __forceinline__ void rope8(float (&f)[8], const float (&p)[8], const float* cs, bool first) {
    const f32x4* c4 = (const f32x4*)cs;
#pragma unroll
    for (int q = 0; q < 4; ++q) { const f32x4 t = c4[q];
        f[2 * q] = first ? f[2 * q] * t.x - p[2 * q] * t.y : p[2 * q] * t.y + f[2 * q] * t.x;
        f[2 * q + 1] = first ? f[2 * q + 1] * t.z - p[2 * q + 1] * t.w : p[2 * q + 1] * t.w + f[2 * q + 1] * t.z; }
}
__device__ __forceinline__ void phase_post(const Frame& F, int l) {
    constexpr int NR = 4;
    bf16* P = (bf16*)(F.ws + WS_PB); bf16* KD = (bf16*)(F.ws + WS_KD);
    const float* t64 = (const float*)(F.ws + WS_T64); const float* t32 = (const float*)(F.ws + WS_T32);
    const int lane = F.lane; const float* gains = (lane < 32 ? INP(I_GQG) : INP(I_GKG)) + l * 64;
    const int j = lane & 7, jj = lane & 3;
    float gn[8];
#pragma unroll
    for (int i = 0; i < 8; ++i) gn[i] = gains[j * 8 + i];
    for (int r0 = F.gw; r0 < M; r0 += NR * F.ngw) {
        v4u w0[NR], w1[NR], w2[NR]; int rr[NR]; bool act[NR];
#pragma unroll
        for (int u = 0; u < NR; ++u) { const int r = r0 + u * F.ngw; act[u] = r < M; rr[u] = act[u] ? r : r0; const bf16* prow = P + (size_t)rr[u] * NPJ;
            w0[u] = *((const v4u*)(prow + 768) + lane); w1[u] = *((const v4u*)(prow + 1280) + lane); w2[u] = *((const v4u*)(prow + 1792) + lane); }
#pragma unroll
        for (int u = 0; u < NR; ++u) {
            const int r = rr[u]; const int b = r / TT, t = r - b * TT; const bool lat = t < SEQ; const int gr = (t >> 6) & 63, gc = t & 63;
            bf16* prow = P + (size_t)r * NPJ;
            const float* cs64 = t64 + ((size_t)((j < 4 ? gr : gc) * 16 + (j & 1) * 8)) * 2;
            {
                float f[8]; unpack8(w0[u], f);
                float ss = 0.f;
#pragma unroll
                for (int i = 0; i < 8; ++i) ss += f[i] * f[i];
                ss += __shfl_xor(ss, 1); ss += __shfl_xor(ss, 2); ss += __shfl_xor(ss, 4);
                const float rs = 1.0f / sqrtf(ss * (1.0f / 64.0f) + EPS);
#pragma unroll
                for (int i = 0; i < 8; ++i) f[i] = f[i] * rs * gn[i];
                float p[8];
#pragma unroll
                for (int i = 0; i < 8; ++i) p[i] = __shfl_xor(f[i], 2);
                if (lat) rope8(f, p, cs64, (j & 2) == 0);
                if (lane < 48 && act[u]) *((v4u*)(prow + 768) + lane) = pack8(f);
            }
            {
                float f[8]; unpack8(w1[u], f);
                float p[8];
#pragma unroll
                for (int i = 0; i < 8; ++i) p[i] = __shfl_xor(f[i], 2);
                rope8(f, p, cs64, (j & 2) == 0);
                if (lat && lane < 48 && act[u]) *((v4u*)(prow + 1280) + lane) = pack8(f);
            }
            {
                float f[8]; unpack8(w2[u], f);
                float ss = 0.f;
#pragma unroll
                for (int i = 0; i < 8; ++i) ss += f[i] * f[i];
                ss += __shfl_xor(ss, 1); ss += __shfl_xor(ss, 2); ss += __shfl_xor(ss, 4); ss += __shfl_xor(ss, 8);
                const float s32 = ss + __shfl_xor(ss, 16);
                const float rn = lane < 32 ? 1.0f / sqrtf(s32 * (1.0f / 256.0f) + EPS) : 1.0f / sqrtf(ss * (1.0f / 128.0f) + EPS);
                if (lane < 48 && act[u]) { float fn[8];
#pragma unroll
                    for (int i = 0; i < 8; ++i) fn[i] = f[i] * rn;
                    *((v4u*)(prow + 1792) + lane) = pack8(fn); }
                float p[8];
#pragma unroll
                for (int i = 0; i < 8; ++i) p[i] = __shfl_xor(f[i], 1);
                if (lat) rope8(f, p, t32 + ((size_t)((jj < 2 ? gr : gc) * 8)) * 2, (jj & 1) == 0);
                if (lane >= 48 && lane < 52 && act[u]) { const v4u o = pack8(f);
#pragma unroll
                    for (int h = 0; h < 4; ++h) *(v4u*)(KD + (size_t)r * 384 + h * 96 + 64 + 8 * jj) = o; }
            }
        }
    }
}

__device__ __forceinline__ void phase_route(const Frame& F, int l) {
    const float* mods = (const float*)(F.ws + WS_MODS); bf16* HA = (bf16*)(F.ws + WS_HA);
    const bf16* MIX = (const bf16*)(F.ws + WS_PB); unsigned* RT = (unsigned*)(F.ws + WS_RT); int* HIST = (int*)(F.ws + WS_HIST);
    LAS float* WR = (LAS float*)F.lds;
    { const float* rgw = INP(I_RGW); const float* rew = INP(I_REW);
      for (int i = F.tid; i < 20 * 1024; i += NTHR) { const int jx = i >> 10, k = i & 1023;
        WR[i] = jx < 4 ? rgw[((size_t)l * D + k) * 4 + jx] : rew[((size_t)l * D + k) * 16 + (jx - 4)]; } }
    if (F.tid < 16) F.MISC[MI_LH + F.tid] = 0u;
    __syncthreads();
    LAS float* bias = (LAS float*)(F.lds + 20 * 1024 * 4);
    if (F.tid < 20) bias[F.tid] = F.tid < 4 ? INP(I_RGB)[l * 4 + F.tid] : INP(I_REB)[l * 16 + (F.tid - 4)];
    __syncthreads();
    const RowPtrs RP = row_ptrs(F);
    LAS float* LNG = (LAS float*)(F.lds + 20 * 1024 * 4 + 128);
    { const float* ln1g = INP(I_LN1G) + l * D; const float* ln1b = INP(I_LN1B) + l * D;
      for (int i = F.tid; i < 1024; i += NTHR) { LNG[i] = ln1g[i]; LNG[1024 + i] = ln1b[i]; } }
    __syncthreads();
    constexpr int NR = 2;
    const LAS unsigned char* wbase = (const LAS unsigned char*)WR + F.lane * 16; asm volatile("" : "+v"(wbase));
    const LAS unsigned char* lbase = (const LAS unsigned char*)LNG + F.lane * 16; asm volatile("" : "+v"(lbase));
#define RT_W4(base_, off_) (*(const LAS f32x4*)((base_) + (off_)))
    const int rpw = rows_per_wave(F.ngw), rbeg = F.gw * rpw, rend = min(M, rbeg + rpw);
    float g1[16], sh[16], sc[16]; int cur_mr = -1;
    float alpha_l = ALPHA; asm volatile("" : "+v"(alpha_l));
    v4u rx[NR][4]; v2u rm[NR][4];
#define RT_ISSUE(r0_) do { _Pragma("unroll") for (int u = 0; u < NR; ++u) { const int r_ = (r0_) + u, rc_ = r_ < rend ? r_ : (r0_); \
        if (l == 0) { const v4u* q_ = (const v4u*)xin_row(RP, rc_) + F.lane; _Pragma("unroll") for (int g = 0; g < 4; ++g) rx[u][g] = __builtin_nontemporal_load(q_ + 64 * g); } \
        else { const v2u* q_ = (const v2u*)(RP.xs + (size_t)rc_ * D) + F.lane; _Pragma("unroll") for (int g = 0; g < 4; ++g) { const v2u t_ = __builtin_nontemporal_load(q_ + 64 * g); rx[u][g].x = t_.x; rx[u][g].y = t_.y; } } \
        ld16bf_raw_nt(MIX + (size_t)rc_ * D, F.lane, rm[u]); } } while (0)
    if (rbeg < rend) RT_ISSUE(rbeg);
    for (int r0 = rbeg; r0 < rend; r0 += NR) {
        float v[NR][16]; int rr[NR]; bool act[NR];
        { const int b = r0 / TT, t = r0 - b * TT, mr = t < SEQ ? b : 16;
          if (mr != cur_mr) { const float* md = mods + ((size_t)l * 17 + mr) * 6144; ld16(md + 2048, F.lane, g1); ld16(md + 3072, F.lane, sh); ld16(md + 4096, F.lane, sc); cur_mr = mr; } }
#pragma unroll
        for (int u = 0; u < NR; ++u) { const int r = r0 + u; act[u] = r < rend; rr[u] = act[u] ? r : r0;
            float mx[16]; unpack16(rm[u], mx);
            if (l == 0) {
#pragma unroll
                for (int g = 0; g < 4; ++g) { v[u][4 * g] = __uint_as_float(rx[u][g].x); v[u][4 * g + 1] = __uint_as_float(rx[u][g].y); v[u][4 * g + 2] = __uint_as_float(rx[u][g].z); v[u][4 * g + 3] = __uint_as_float(rx[u][g].w); }
            } else {
#pragma unroll
                for (int g = 0; g < 4; ++g) { const v2u t = {rx[u][g].x, rx[u][g].y}; const f32x4 f = __builtin_convertvector(__builtin_bit_cast(f16x4, t), f32x4);
                    v[u][4 * g] = f.x; v[u][4 * g + 1] = f.y; v[u][4 * g + 2] = f.z; v[u][4 * g + 3] = f.w; }
            }
#pragma unroll
            for (int i = 0; i < 16; ++i) v[u][i] = alpha_l * v[u][i] + g1[i] * mx[i]; }
        if (r0 + NR < rend) RT_ISSUE(r0 + NR);
        if (l == NL - 1 && (r0 % TT) >= SEQ) continue;
#pragma unroll
        for (int u = 0; u < NR; ++u) ln16(v[u]);
        { float gg[16], bb[16];
#pragma unroll
          for (int g = 0; g < 4; ++g) { const f32x4 a = RT_W4(lbase, 1024 * g), c = RT_W4(lbase, 4096 + 1024 * g);
              gg[4 * g] = a.x; gg[4 * g + 1] = a.y; gg[4 * g + 2] = a.z; gg[4 * g + 3] = a.w; bb[4 * g] = c.x; bb[4 * g + 1] = c.y; bb[4 * g + 2] = c.z; bb[4 * g + 3] = c.w; }
#pragma unroll
          for (int u = 0; u < NR; ++u) {
#pragma unroll
            for (int i = 0; i < 16; ++i) v[u][i] = v[u][i] * gg[i] + bb[i];
            if (act[u]) st16h(RP.xs + (size_t)rr[u] * D, F.lane, v[u]); } }
#pragma unroll
        for (int u = 0; u < NR; ++u) ln16(v[u]);
#pragma unroll
        for (int u = 0; u < NR; ++u) {
#pragma unroll
            for (int i = 0; i < 16; ++i) v[u][i] = v[u][i] * (1.0f + sc[i]) + sh[i];
            if (act[u]) st16bf(HA + (size_t)rr[u] * D, F.lane, v[u]); }
#define RT_DOT(u_, w0, w1, w2, w3) ((v[u_][0] * w0.x + v[u_][1] * w0.y) + (v[u_][2] * w0.z + v[u_][3] * w0.w) + (v[u_][4] * w1.x + v[u_][5] * w1.y) + (v[u_][6] * w1.z + v[u_][7] * w1.w) \
        + (v[u_][8] * w2.x + v[u_][9] * w2.y) + (v[u_][10] * w2.z + v[u_][11] * w2.w) + (v[u_][12] * w3.x + v[u_][13] * w3.y) + (v[u_][14] * w3.z + v[u_][15] * w3.w))
        float gl[NR][4];
#pragma unroll
        for (int jx = 0; jx < 4; ++jx) {
            const f32x4 w0 = RT_W4(wbase, 4096 * jx), w1 = RT_W4(wbase, 4096 * jx + 1024), w2 = RT_W4(wbase, 4096 * jx + 2048), w3 = RT_W4(wbase, 4096 * jx + 3072);
#pragma unroll
            for (int u = 0; u < NR; ++u) gl[u][jx] = RT_DOT(u, w0, w1, w2, w3);
        }
#pragma unroll
        for (int u = 0; u < NR; ++u)
#pragma unroll
            for (int jx = 0; jx < 4; ++jx) gl[u][jx] = wave_sum(gl[u][jx]) + bias[jx];
        int grpv[NR]; float pgv[NR];
#pragma unroll
        for (int u = 0; u < NR; ++u) {
            int grp = 0; float mg = gl[u][0];
#pragma unroll
            for (int g = 1; g < 4; ++g) if (gl[u][g] > mg) { mg = gl[u][g]; grp = g; }
            float sg = 0.f;
#pragma unroll
            for (int g = 0; g < 4; ++g) sg += expf(gl[u][g] - mg);
            grpv[u] = grp; pgv[u] = 1.0f / sg;
        }
        float selv[NR][4];
#pragma unroll
        for (int u = 0; u < NR; ++u) {
            const LAS unsigned char* eb = wbase + (4 + 4 * grpv[u]) * 4096;
#pragma unroll
            for (int i = 0; i < 4; ++i) {
                const f32x4 w0 = RT_W4(eb, 4096 * i), w1 = RT_W4(eb, 4096 * i + 1024), w2 = RT_W4(eb, 4096 * i + 2048), w3 = RT_W4(eb, 4096 * i + 3072);
                selv[u][i] = RT_DOT(u, w0, w1, w2, w3);
            }
        }
#pragma unroll
        for (int u = 0; u < NR; ++u)
#pragma unroll
            for (int i = 0; i < 4; ++i) selv[u][i] = wave_sum(selv[u][i]) + bias[4 + 4 * grpv[u] + i];
#undef RT_DOT
#pragma unroll
        for (int u = 0; u < NR; ++u) {
            const int grp = grpv[u]; const float pg = pgv[u];
            float sel[4];
#pragma unroll
            for (int i = 0; i < 4; ++i) sel[i] = selv[u][i];
            int i1 = 0; float v1 = sel[0];
#pragma unroll
            for (int i = 1; i < 4; ++i) if (sel[i] > v1) { v1 = sel[i]; i1 = i; }
            int i2 = -1; float v2 = -3.0e38f;
#pragma unroll
            for (int i = 0; i < 4; ++i) if (i != i1 && (i2 < 0 || sel[i] > v2)) { v2 = sel[i]; i2 = i; }
            const float ee = expf(v2 - v1), w1 = pg / (1.0f + ee), w2 = pg * ee / (1.0f + ee);
            const int e1 = grp * 4 + i1, e2 = grp * 4 + i2;
            if (F.lane == 0 && act[u]) {
                const unsigned k1 = __hip_atomic_fetch_add((LAS unsigned*)&F.MISC[MI_LH + e1], 1u, __ATOMIC_RELAXED, __HIP_MEMORY_SCOPE_WORKGROUP);
                const unsigned k2 = __hip_atomic_fetch_add((LAS unsigned*)&F.MISC[MI_LH + e2], 1u, __ATOMIC_RELAXED, __HIP_MEMORY_SCOPE_WORKGROUP);
                v4u ra; ra.x = (unsigned)e1; ra.y = (unsigned)e2; ra.z = k1; ra.w = k2;
                v4u rb; rb.x = __builtin_bit_cast(unsigned, w1); rb.y = __builtin_bit_cast(unsigned, w2); rb.z = 0u; rb.w = 0u;
                *(v4u*)(RT + (size_t)rr[u] * 8) = ra; *(v4u*)(RT + (size_t)rr[u] * 8 + 4) = rb;
            }
        }
    }
#undef RT_ISSUE
#undef RT_W4
    __syncthreads();
    if (F.tid < 16) HIST[F.bid * 16 + F.tid] = (int)F.MISC[MI_LH + F.tid];
}
__device__ __forceinline__ void moe_tables(const Frame& F) {
    const int* HIST = (const int*)(F.ws + WS_HIST); LAS int* hl = (LAS int*)F.lds;
    __syncthreads();
    for (int i = F.tid; i < F.G * 16; i += NTHR) hl[i] = HIST[i];
    __syncthreads();
    if (F.tid < 16) { int tot = 0, mine = 0; for (int g = 0; g < F.G; ++g) { const int c = hl[g * 16 + F.tid]; tot += c; mine += (g < F.bid) ? c : 0; }
        F.MISC[MI_TOT + F.tid] = (unsigned)tot; F.MISC[MI_BASE + F.tid] = (unsigned)mine; }
    __syncthreads();
    if (F.tid == 0) { unsigned p = 0; for (int e = 0; e < 16; ++e) { F.MISC[MI_PST + e] = p; F.MISC[MI_BASE + e] += p * 256u; p += (F.MISC[MI_TOT + e] + 255u) >> 8; } F.MISC[MI_PST + 16] = p; }
    __syncthreads();
}
__device__ __forceinline__ void phase_permute(const Frame& F, int l) {
    unsigned* RT = (unsigned*)(F.ws + WS_RT); int* SRC = (int*)(F.ws + WS_QD);
    moe_tables(F);
    const int rpw = rows_per_wave(F.ngw), rbeg = F.gw * rpw, rend = min(M, rbeg + rpw);
    for (int r = rbeg + F.lane; r < rend; r += 64) {
        if (l == NL - 1 && (r % TT) >= SEQ) continue;
        const v4u ra = *(const v4u*)(RT + (size_t)r * 8);
        const unsigned p0 = F.MISC[MI_BASE + (ra.x & 15u)] + ra.z, p1 = F.MISC[MI_BASE + (ra.y & 15u)] + ra.w;
        RT[(size_t)r * 8 + 6] = p0; RT[(size_t)r * 8 + 7] = p1; SRC[p0] = r; SRC[p1] = r;
    }
    if (F.bid == 0) {
        for (int e = 0; e < 16; ++e) { const int beg = (int)F.MISC[MI_PST + e] * 256 + (int)F.MISC[MI_TOT + e], end = (int)F.MISC[MI_PST + e + 1] * 256;
            for (int p = beg + F.tid; p < end; p += NTHR) SRC[p] = 0; }
    }
}

struct EpiMla {
    static constexpr bool PERM = true, AFTER_DRAIN = false;
    bf16* QD; bf16* KD; bf16* VD;
    __device__ __forceinline__ void operator()(const pg8::f32x4 (&acc)[2][2][4][2], const pg8::Unit& u, int wr, int wc, int fr, int fq) const {
#pragma unroll
        for (int bj = 0; bj < 2; ++bj) {
            const int g0 = u.pn * 256 + bj * 128 + wc * 32, col0 = g0 + 8 * fq;
            if (g0 >= 896) continue;
            const int c = col0 - 384, hd = c >> 7, jx = c & 127;
            bf16* dst = g0 < 384 ? QD + col0 : jx < 64 ? KD + hd * 96 + jx : VD + hd * 64 + (jx - 64);
            const int stride = (g0 < 384 || jx < 64) ? 384 : 256;
            dst += (size_t)(u.pm * 256 + wr * 64 + fr) * stride;
#pragma unroll
            for (int ai = 0; ai < 2; ++ai)
#pragma unroll
                for (int m = 0; m < 4; ++m) {
                    v4u o; o.x = pk2(acc[ai][bj][m][0][0], acc[ai][bj][m][0][1]); o.y = pk2(acc[ai][bj][m][0][2], acc[ai][bj][m][0][3]);
                    o.z = pk2(acc[ai][bj][m][1][0], acc[ai][bj][m][1][1]); o.w = pk2(acc[ai][bj][m][1][2], acc[ai][bj][m][1][3]);
                    *(v4u*)(dst + (size_t)(ai * 128 + m * 16) * stride) = o;
                }
        }
    }
};
struct EpiGU {
    static constexpr bool PERM = true, AFTER_DRAIN = false;
    bf16* ACT;
    __device__ __forceinline__ void operator()(const pg8::f32x4 (&acc)[2][2][4][2], const pg8::Unit& u, int wr, int wc, int fr, int fq) const {
#pragma unroll
        for (int ai = 0; ai < 2; ++ai)
#pragma unroll
            for (int m = 0; m < 4; ++m) {
                const int row = u.pm * 256 + ai * 128 + wr * 64 + m * 16 + fr;
#pragma unroll
                for (int bj = 0; bj < 2; ++bj) {
                    const int c = (u.pn & 3) * 256 + bj * 128 + wc * 32 + 8 * fq;
                    float o[4];
#pragma unroll
                    for (int i = 0; i < 4; ++i) { const float g = acc[ai][bj][m][0][i], up = acc[ai][bj][m][1][i]; o[i] = g / (1.0f + __expf(-g)) * up; }
                    v2u w; w.x = pk2(o[0], o[1]); w.y = pk2(o[2], o[3]);
                    *(v2u*)(ACT + (size_t)row * 512 + (c >> 1)) = w;
                }
            }
    }
};
struct MoeOrder {
    volatile LAS unsigned* pst; int G, c;
    __device__ __forceinline__ bool next(int i, pg8::Unit& u) const {
        const int np = (int)pst[16]; int panel, pn;
        if ((G & 7) == 0) { const int x = c & 7, uu = i * (G >> 3) + (c >> 3); panel = (uu >> 2) * 8 + x; pn = uu & 3; }
        else { const int L = i * G + c; panel = L >> 2; pn = L & 3; }
        if (panel >= np) return false;
        int e = 0;
#pragma unroll
        for (int k = 1; k < 16; ++k) e += (panel >= (int)pst[k]) ? 1 : 0;
        u.pm = __builtin_amdgcn_readfirstlane(panel); u.pn = __builtin_amdgcn_readfirstlane(e * 4 + pn); return true;
    }
    __device__ __forceinline__ void a_ready(const pg8::Unit&) const {}
    __device__ __forceinline__ void done(const pg8::Unit&) const {}
};

struct LatOrder {
    int G, c;
    __device__ __forceinline__ bool next(int i, pg8::Unit& u) const {
        int pl, pn;
        if ((G & 7) == 0) { const int x = c & 7, uu = i * (G >> 3) + (c >> 3); pl = (uu >> 2) * 8 + x; pn = uu & 3; } else { const int L = i * G + c; pl = L >> 2; pn = L & 3; }
        if (pl >= NB * 16) return false;
        u.pm = pl + (pl >> 4); u.pn = pn; return true;
    }
    __device__ __forceinline__ void a_ready(const pg8::Unit&) const {}
    __device__ __forceinline__ void done(const pg8::Unit&) const {}
};

#ifndef DBG_VAR
#define DBG_VAR 1
#endif
namespace att {
constexpr int VRS = 192, KBUF = 64 * 208, VBUF = 64 * VRS, BUF = KBUF + VBUF, BIAS_OFF = 4 * BUF;
constexpr float NEG = -30000.0f;
__device__ __forceinline__ int crow(int r, int hi) { return (r & 3) + 8 * (r >> 2) + 4 * hi; }
__device__ __forceinline__ float xhalf_max(float v) { const unsigned a = __builtin_bit_cast(unsigned, v);
    auto rr = __builtin_amdgcn_permlane32_swap(a, a, false, false); const unsigned r0 = rr[0], r1 = rr[1]; return fmaxf(__uint_as_float(r0), __uint_as_float(r1)); }
__device__ __forceinline__ float xhalf_sum(float v) { const unsigned a = __builtin_bit_cast(unsigned, v);
    auto rr = __builtin_amdgcn_permlane32_swap(a, a, false, false); const unsigned r0 = rr[0], r1 = rr[1]; return __uint_as_float(r0) + __uint_as_float(r1); }
__device__ __forceinline__ float max3f(float a, float b, float c) { float r; asm("v_max3_f32 %0, %1, %2, %3" : "=v"(r) : "v"(a), "v"(b), "v"(c)); return r; }
typedef __bf16 bf16x2_t __attribute__((ext_vector_type(2)));
__device__ __forceinline__ unsigned cvtpk(float lo, float hi) { f32x2 v = {lo, hi}; bf16x2_t b = __builtin_convertvector(v, bf16x2_t); return __builtin_bit_cast(unsigned, b); }

template <int DK, int VM = 0>
__device__ __forceinline__ void unit(LAS unsigned char* lds, const bf16* Qp, int qpitch, const bf16* Kp, int kpitch, const bf16* Vp, int vpitch, bf16* Op,
                                     int var, int qt, int lo, int n1, int nt, float qscale, float sinkl2, bool has_sink, const LAS float* bias, const float* t32, unsigned* dbg) {
    constexpr int KRS = DK * 2 + 16, NS = DK / 16, CPK = DK / 8;
    int tid = threadIdx.x; asm volatile("" : "+v"(tid)); const int lane = tid & 63, r32 = lane & 31, hi = lane >> 5, wid = __builtin_amdgcn_readfirstlane(tid >> 6);
    const int qrow = 256 * qt + 32 * wid + r32;
    bf16x8 qr[NS];
#pragma unroll
    for (int s = 0; s < NS; ++s) { const v4u raw = *(const v4u*)(Qp + (size_t)qrow * qpitch + 16 * s + 8 * hi); float f[8]; unpack8(raw, f);
#pragma unroll
        for (int i = 0; i < 8; ++i) f[i] *= qscale;
        if (DK == 96 && s >= 4) {
            float p[8];
#pragma unroll
            for (int i = 0; i < 8; ++i) p[i] = __shfl_xor(f[i], 32);
            if (qt < 16) rope8(f, p, t32 + ((size_t)((s == 4 ? (qrow >> 6) : (qrow & 63)) * 8)) * 2, hi == 0);
        }
        qr[s] = __builtin_bit_cast(bf16x8, pack8(f)); }
    const int kkey0 = tid / CPK, kch0 = tid - kkey0 * CPK, kkey1 = (tid + 512) / CPK, kch1 = (tid + 512) - kkey1 * CPK;
    const int vkey = tid >> 3, vch = tid & 7;
    v4u kreg0, kreg1 = {0u, 0u, 0u, 0u}, vreg;
#define ATT_TROW(j) ((((j) < n1) ? (lo + (j)) : (64 + (j) - n1)) * 64)
#define ATT_LOAD(j) do { const int tr_ = ATT_TROW(j); kreg0 = *(const v4u*)(Kp + (size_t)(tr_ + kkey0) * kpitch + kch0 * 8); \
        if (DK == 96 && tid < 256) kreg1 = *(const v4u*)(Kp + (size_t)(tr_ + kkey1) * kpitch + kch1 * 8); \
        vreg = *(const v4u*)(Vp + (size_t)(tr_ + vkey) * vpitch + vch * 8); } while (0)
#define ATT_STORE(bf) do { LAS unsigned char* b_ = lds + (bf) * BUF; *(LAS v4u*)(b_ + kkey0 * KRS + kch0 * 16) = kreg0; \
        if (DK == 96 && tid < 256) *(LAS v4u*)(b_ + kkey1 * KRS + kch1 * 16) = kreg1; \
        *(LAS v4u*)(b_ + KBUF + vkey * VRS + vch * 16) = vreg; } while (0)
    constexpr float THR = 6.0f;
    float m = 0.f; f32x2 lacc = {0.f, 0.f}; f32x16 o0 = {}, o1 = {}; f32x16 negm = {}; bool first = true;
    const int grw = 4 * qt + (wid >> 1), r0w = min(max(grw - 4, 0), 56), gc = (wid & 1) * 32 + r32, c0 = min(max(gc - 8, 0), 48), i0w = 256 * qt + 32 * wid;
    ATT_LOAD(0); ATT_STORE(0);
    __syncthreads();
    for (int j = 0; j < nt; ++j) {
        if (!(VM & 8) && j + 1 < nt) ATT_LOAD(j + 1);
        const int kt = ATT_TROW(j) >> 6;
        bool actv = true;
        if (kt < 64) { if (var == 0) actv = (kt >= r0w) && (kt <= r0w + 7); else if (var == 2) actv = !((64 * kt - (i0w + 31) > 128) || (i0w - (64 * kt + 63) > 128)); }
        if (actv) {
            const LAS unsigned char* Kb = lds + (j & 1) * BUF; const LAS unsigned char* Vb = Kb + KBUF;
            f32x16 s0 = negm, s1 = negm;
            bf16x8 ka[NS], kb[NS];
#pragma unroll
            for (int s = 0; s < NS; ++s) { ka[s] = *(const LAS bf16x8*)(Kb + r32 * KRS + (16 * s + 8 * hi) * 2); kb[s] = *(const LAS bf16x8*)(Kb + (32 + r32) * KRS + (16 * s + 8 * hi) * 2); }
            __builtin_amdgcn_sched_barrier(0);
            if (VM & 2) {
#pragma unroll
                for (int s = 0; s < NS; ++s) asm volatile("" :: "v"(ka[s]), "v"(kb[s]), "v"(qr[s]));
            } else {
#pragma unroll
            for (int s = 0; s < NS; ++s) { s0 = __builtin_amdgcn_mfma_f32_32x32x16_bf16(ka[s], qr[s], s0, 0, 0, 0); s1 = __builtin_amdgcn_mfma_f32_32x32x16_bf16(kb[s], qr[s], s1, 0, 0, 0); }
            }
            asm volatile("s_nop 15\n\ts_nop 7" : "+v"(s0), "+v"(s1));
            if (kt < 64 && var == 0) {
                const int rowoff = (kt - grw + 7) * 31 - gc + 15;
#pragma unroll
                for (int r = 0; r < 16; ++r) { const int j0 = crow(r, hi), j1 = j0 + 32;
                    const bool v0 = (unsigned)(j0 - c0) < 16u, v1 = (unsigned)(j1 - c0) < 16u;
                    const float b0 = bias[v0 ? rowoff + j0 : 0], b1 = bias[v1 ? rowoff + j1 : 0];
                    s0[r] = v0 ? s0[r] + b0 : NEG; s1[r] = v1 ? s1[r] + b1 : NEG; }
            } else if (kt < 64 && var == 2) {
                const int dbase = 64 * kt - qrow + 128;
#pragma unroll
                for (int r = 0; r < 16; ++r) { const int j0 = crow(r, hi);
                    s0[r] = (unsigned)(dbase + j0) <= 256u ? s0[r] : NEG; s1[r] = (unsigned)(dbase + j0 + 32) <= 256u ? s1[r] : NEG; }
            }
            if (!(VM & 4)) {
            float mxa = max3f(s0[0], s0[1], s1[0]), mxb = max3f(s0[2], s0[3], s1[1]); mxa = max3f(mxa, s1[2], s1[3]);
#pragma unroll
            for (int r = 4; r < 16; r += 4) { mxa = max3f(mxa, s0[r], s0[r + 1]); mxb = max3f(mxb, s0[r + 2], s0[r + 3]); mxa = max3f(mxa, s1[r], s1[r + 1]); mxb = max3f(mxb, s1[r + 2], s1[r + 3]); }
            const float mx = xhalf_max(fmaxf(mxa, mxb));
            if (first || __any(mx > THR)) {
                const float d = first ? fmaxf(mx, -64.0f) : fmaxf(mx, 0.f), alpha = __builtin_amdgcn_exp2f(-d);
                m += d; first = false;
#pragma unroll
                for (int r = 0; r < 16; ++r) { s0[r] -= d; s1[r] -= d; o0[r] *= alpha; o1[r] *= alpha; negm[r] = -m; }
                lacc *= alpha;
            }
#pragma unroll
            for (int r = 0; r < 16; ++r) { s0[r] = __builtin_amdgcn_exp2f(s0[r]); s1[r] = __builtin_amdgcn_exp2f(s1[r]); lacc += (f32x2){s0[r], s1[r]}; }
            }
            bf16x8 pb[4];
#pragma unroll
            for (int s = 0; s < 2; ++s) {
                v4u w; w.x = cvtpk(s0[8 * s], s0[8 * s + 1]); w.y = cvtpk(s0[8 * s + 2], s0[8 * s + 3]); w.z = cvtpk(s0[8 * s + 4], s0[8 * s + 5]); w.w = cvtpk(s0[8 * s + 6], s0[8 * s + 7]);
                pb[s] = __builtin_bit_cast(bf16x8, w);
                v4u x; x.x = cvtpk(s1[8 * s], s1[8 * s + 1]); x.y = cvtpk(s1[8 * s + 2], s1[8 * s + 3]); x.z = cvtpk(s1[8 * s + 4], s1[8 * s + 5]); x.w = cvtpk(s1[8 * s + 6], s1[8 * s + 7]);
                pb[2 + s] = __builtin_bit_cast(bf16x8, x);
            }
            if (VM & 1) { asm volatile("" :: "v"(pb[0]), "v"(pb[1]), "v"(pb[2]), "v"(pb[3])); } else {
            const LAS unsigned char* vbase = Vb + (4 * hi + ((lane & 15) >> 2)) * VRS + ((lane >> 4) & 1) * 32 + (lane & 3) * 8;
#pragma unroll
            for (int s = 0; s < 4; ++s) {
                const v4i16 a0 = __builtin_amdgcn_ds_read_tr16_b64_v4i16((LAS v4i16*)(vbase + (16 * s) * VRS));
                const v4i16 a1 = __builtin_amdgcn_ds_read_tr16_b64_v4i16((LAS v4i16*)(vbase + (16 * s + 8) * VRS));
                const v4i16 c0_ = __builtin_amdgcn_ds_read_tr16_b64_v4i16((LAS v4i16*)(vbase + (16 * s) * VRS + 64));
                const v4i16 c1_ = __builtin_amdgcn_ds_read_tr16_b64_v4i16((LAS v4i16*)(vbase + (16 * s + 8) * VRS + 64));
                const bf16x8 va = {a0[0], a0[1], a0[2], a0[3], a1[0], a1[1], a1[2], a1[3]};
                const bf16x8 vc = {c0_[0], c0_[1], c0_[2], c0_[3], c1_[0], c1_[1], c1_[2], c1_[3]};
                o0 = __builtin_amdgcn_mfma_f32_32x32x16_bf16(va, pb[s], o0, 0, 0, 0);
                o1 = __builtin_amdgcn_mfma_f32_32x32x16_bf16(vc, pb[s], o1, 0, 0, 0);
            }
            }
        }
        if (!(VM & 8) && j + 1 < nt) ATT_STORE((j + 1) & 1);
        if (!(VM & 16)) __syncthreads();
    }
    float l = xhalf_sum(lacc.x + lacc.y);
    const float sterm = has_sink ? __builtin_amdgcn_exp2f(sinkl2 - m) : 0.f;
#if MK_DEBUG
    if (dbg && hi == 0) { dbg[(size_t)qrow * 2] = __builtin_bit_cast(unsigned, m); dbg[(size_t)qrow * 2 + 1] = __builtin_bit_cast(unsigned, l); }
#endif
    if (has_sink) l += sterm;
    const float inv = 1.0f / l;
    bf16* orow = Op + (size_t)qrow * D;
#pragma unroll
    for (int g = 0; g < 4; ++g) {
        v2u w0; w0.x = pk2(o0[4 * g] * inv, o0[4 * g + 1] * inv); w0.y = pk2(o0[4 * g + 2] * inv, o0[4 * g + 3] * inv);
        v2u w1; w1.x = pk2(o1[4 * g] * inv, o1[4 * g + 1] * inv); w1.y = pk2(o1[4 * g + 2] * inv, o1[4 * g + 3] * inv);
        *(v2u*)(orow + 8 * g + 4 * hi) = w0; *(v2u*)(orow + 32 + 8 * g + 4 * hi) = w1;
    }
#undef ATT_TROW
#undef ATT_LOAD
#undef ATT_STORE
}

template <int DK, int MODE, int VM = 0, bool NOREF = false>
__device__ __forceinline__ void unit2(LAS unsigned char* lds, const bf16* Qp, int qpitch, const bf16* Kp, int kpitch, const bf16* Vp, int vpitch, bf16* Op,
                                      int var, int qt, int lo, int n1, int nt, float qscale, float sink0, float sink1, bool has_sink, const LAS float* bias, const float* t32) {
    constexpr int KRS = DK * 2 + 16, NS = DK / 16, CPK = DK / 8;
    int tid = threadIdx.x; asm volatile("" : "+v"(tid)); const int lane = tid & 63, r32 = lane & 31, hi = lane >> 5, wid = __builtin_amdgcn_readfirstlane(tid >> 6);
    const int rowbase = MODE == 0 ? 512 * qt + 64 * wid : 256 * qt + 32 * wid;
    bf16x8 qr[2][NS];
#pragma unroll
    for (int u = 0; u < 2; ++u) {
        const int qrow = rowbase + (MODE == 0 ? 32 * u : 0) + r32;
        const bf16* qp = Qp + (MODE == 1 ? 64 * u : 0) + (size_t)qrow * qpitch;
#pragma unroll
        for (int s = 0; s < NS; ++s) { const v4u raw = *(const v4u*)(qp + 16 * s + 8 * hi); float f[8]; unpack8(raw, f);
#pragma unroll
            for (int i = 0; i < 8; ++i) f[i] *= qscale;
            if (DK == 96 && s >= 4) { float p[8];
#pragma unroll
                for (int i = 0; i < 8; ++i) p[i] = __shfl_xor(f[i], 32);
                rope8(f, p, t32 + ((size_t)((s == 4 ? (qrow >> 6) : (qrow & 63)) * 8)) * 2, hi == 0); }
            qr[u][s] = __builtin_bit_cast(bf16x8, pack8(f)); }
    }
    const int kkey0 = tid / CPK, kch0 = tid - kkey0 * CPK, kkey1 = (tid + 512) / CPK, kch1 = (tid + 512) - kkey1 * CPK;
    const int vkey = tid >> 3, vch = tid & 7;
    v4u kreg0, kreg1 = {0u, 0u, 0u, 0u}, vreg;
#define ATT_TROW(j) ((((j) < n1) ? (lo + (j)) : (64 + (j) - n1)) * 64)
#define ATT_LOAD(j) do { const int tr_ = ATT_TROW(j); kreg0 = *(const v4u*)(Kp + (size_t)(tr_ + kkey0) * kpitch + kch0 * 8); \
        if (DK == 96 && tid < 256) kreg1 = *(const v4u*)(Kp + (size_t)(tr_ + kkey1) * kpitch + kch1 * 8); \
        vreg = *(const v4u*)(Vp + (size_t)(tr_ + vkey) * vpitch + vch * 8); } while (0)
#define ATT_STORE(bf) do { LAS unsigned char* b_ = lds + (bf) * BUF; *(LAS v4u*)(b_ + kkey0 * KRS + kch0 * 16) = kreg0; \
        if (DK == 96 && tid < 256) *(LAS v4u*)(b_ + kkey1 * KRS + kch1 * 16) = kreg1; \
        *(LAS v4u*)(b_ + KBUF + vkey * VRS + vch * 16) = vreg; } while (0)
    constexpr float THR = 6.0f;
    float m = 0.f; f32x2 lacc[2] = {{0.f, 0.f}, {0.f, 0.f}}; f32x16 o0[2] = {{}, {}}, o1[2] = {{}, {}}; bool first = true;
    const int grw = 8 * qt + wid, r0w = min(max(grw - 4, 0), 56), i0w = rowbase;
    ATT_LOAD(0); ATT_STORE(0);
    __syncthreads();
    for (int j = 0; j < nt; ++j) {
        if (!(VM & 8) && j + 1 < nt) ATT_LOAD(j + 1);
        const int kt = ATT_TROW(j) >> 6;
        bool actv = true;
        if (kt < 64) { if (var == 0) actv = (kt >= r0w) && (kt <= r0w + 7); else if (var == 2) actv = !((64 * kt - (i0w + 31) > 128) || (i0w - (64 * kt + 63) > 128)); }
        if (actv) {
            const LAS unsigned char* Kb = lds + (j & 1) * BUF; const LAS unsigned char* Vb = Kb + KBUF;
            f32x16 s0[2] = {{}, {}}, s1[2] = {{}, {}};
#pragma unroll
            for (int s = 0; s < NS; ++s) {
                const bf16x8 ka = *(const LAS bf16x8*)(Kb + r32 * KRS + (16 * s + 8 * hi) * 2);
                const bf16x8 kb = *(const LAS bf16x8*)(Kb + (32 + r32) * KRS + (16 * s + 8 * hi) * 2);
                if (VM & 2) { asm volatile("" :: "v"(ka), "v"(kb), "v"(qr[0][s]), "v"(qr[1][s])); } else {
#pragma unroll
                for (int u = 0; u < 2; ++u) { s0[u] = __builtin_amdgcn_mfma_f32_32x32x16_bf16(ka, qr[u][s], s0[u], 0, 0, 0); s1[u] = __builtin_amdgcn_mfma_f32_32x32x16_bf16(kb, qr[u][s], s1[u], 0, 0, 0); }
                }
            }
            asm volatile("s_nop 15\n\ts_nop 7" : "+v"(s0[0]), "+v"(s1[0]), "+v"(s0[1]), "+v"(s1[1]));
            if (kt < 64 && var == 0) {
#pragma unroll
                for (int u = 0; u < 2; ++u) { const int gc = 32 * u + r32, c0 = min(max(gc - 8, 0), 48), rowoff = (kt - grw + 7) * 31 - gc + 15;
#pragma unroll
                    for (int r = 0; r < 16; ++r) { const int j0 = crow(r, hi), j1 = j0 + 32;
                        const bool v0 = (unsigned)(j0 - c0) < 16u, v1 = (unsigned)(j1 - c0) < 16u;
                        const float b0 = bias[v0 ? rowoff + j0 : 0], b1 = bias[v1 ? rowoff + j1 : 0];
                        s0[u][r] = v0 ? s0[u][r] + b0 : NEG; s1[u][r] = v1 ? s1[u][r] + b1 : NEG; } }
            } else if (kt < 64 && var == 2) {
                const int dbase = 64 * kt - (rowbase + r32) + 128;
#pragma unroll
                for (int r = 0; r < 16; ++r) { const int j0 = crow(r, hi); const bool v0 = (unsigned)(dbase + j0) <= 256u, v1 = (unsigned)(dbase + j0 + 32) <= 256u;
                    s0[0][r] = v0 ? s0[0][r] : NEG; s1[0][r] = v1 ? s1[0][r] : NEG; s0[1][r] = v0 ? s0[1][r] : NEG; s1[1][r] = v1 ? s1[1][r] : NEG; }
            }
            if (!(VM & 4)) {
            if (!NOREF) {
            float mxa = max3f(s0[0][0], s0[0][1], s1[0][0]), mxb = max3f(s0[1][0], s0[1][1], s1[1][0]);
#pragma unroll
            for (int r = 0; r < 16; r += 2) { if (r) { mxa = max3f(mxa, s0[0][r], s0[0][r + 1]); mxb = max3f(mxb, s0[1][r], s0[1][r + 1]); }
                if (r) { mxa = max3f(mxa, s1[0][r], s1[0][r + 1]); mxb = max3f(mxb, s1[1][r], s1[1][r + 1]); } else { mxa = fmaxf(mxa, s1[0][1]); mxb = fmaxf(mxb, s1[1][1]); } }
            const float mx = xhalf_max(fmaxf(mxa, mxb)) - m;
            if (first || __any(mx > THR)) {
                const float d = first ? fmaxf(mx, -64.0f) : fmaxf(mx, 0.f), alpha = __builtin_amdgcn_exp2f(-d);
                m += d; first = false;
#pragma unroll
                for (int u = 0; u < 2; ++u) {
#pragma unroll
                    for (int r = 0; r < 16; ++r) { o0[u][r] *= alpha; o1[u][r] *= alpha; }
                    lacc[u] *= alpha; }
            }
            }
            }
            bf16x8 pb[2][4];
#pragma unroll
            for (int u = 0; u < 2; ++u) {
                if (!(VM & 4))
#pragma unroll
                for (int r = 0; r < 16; ++r) { s0[u][r] = __builtin_amdgcn_exp2f(NOREF ? s0[u][r] : s0[u][r] - m); s1[u][r] = __builtin_amdgcn_exp2f(NOREF ? s1[u][r] : s1[u][r] - m); lacc[u] += (f32x2){s0[u][r], s1[u][r]}; }
#pragma unroll
                for (int s = 0; s < 2; ++s) {
                    v4u w; w.x = cvtpk(s0[u][8 * s], s0[u][8 * s + 1]); w.y = cvtpk(s0[u][8 * s + 2], s0[u][8 * s + 3]); w.z = cvtpk(s0[u][8 * s + 4], s0[u][8 * s + 5]); w.w = cvtpk(s0[u][8 * s + 6], s0[u][8 * s + 7]);
                    pb[u][s] = __builtin_bit_cast(bf16x8, w);
                    v4u x; x.x = cvtpk(s1[u][8 * s], s1[u][8 * s + 1]); x.y = cvtpk(s1[u][8 * s + 2], s1[u][8 * s + 3]); x.z = cvtpk(s1[u][8 * s + 4], s1[u][8 * s + 5]); x.w = cvtpk(s1[u][8 * s + 6], s1[u][8 * s + 7]);
                    pb[u][2 + s] = __builtin_bit_cast(bf16x8, x);
                }
            }
            if (VM & 1) { asm volatile("" :: "v"(pb[0][0]), "v"(pb[0][1]), "v"(pb[0][2]), "v"(pb[0][3]), "v"(pb[1][0]), "v"(pb[1][1]), "v"(pb[1][2]), "v"(pb[1][3])); } else {
            const LAS unsigned char* vbase = Vb + (4 * hi + ((lane & 15) >> 2)) * VRS + ((lane >> 4) & 1) * 32 + (lane & 3) * 8;
#pragma unroll
            for (int s = 0; s < 4; ++s) {
                const v4i16 a0 = __builtin_amdgcn_ds_read_tr16_b64_v4i16((LAS v4i16*)(vbase + (16 * s) * VRS));
                const v4i16 a1 = __builtin_amdgcn_ds_read_tr16_b64_v4i16((LAS v4i16*)(vbase + (16 * s + 8) * VRS));
                const v4i16 c0_ = __builtin_amdgcn_ds_read_tr16_b64_v4i16((LAS v4i16*)(vbase + (16 * s) * VRS + 64));
                const v4i16 c1_ = __builtin_amdgcn_ds_read_tr16_b64_v4i16((LAS v4i16*)(vbase + (16 * s + 8) * VRS + 64));
                const bf16x8 va = {a0[0], a0[1], a0[2], a0[3], a1[0], a1[1], a1[2], a1[3]};
                const bf16x8 vc = {c0_[0], c0_[1], c0_[2], c0_[3], c1_[0], c1_[1], c1_[2], c1_[3]};
#pragma unroll
                for (int u = 0; u < 2; ++u) { o0[u] = __builtin_amdgcn_mfma_f32_32x32x16_bf16(va, pb[u][s], o0[u], 0, 0, 0); o1[u] = __builtin_amdgcn_mfma_f32_32x32x16_bf16(vc, pb[u][s], o1[u], 0, 0, 0); }
            }
            }
        }
        if (!(VM & 8) && j + 1 < nt) ATT_STORE((j + 1) & 1);
        if (!(VM & 16)) __syncthreads();
    }
#pragma unroll
    for (int u = 0; u < 2; ++u) {
        float l = xhalf_sum(lacc[u].x + lacc[u].y);
        if (has_sink) l += __builtin_amdgcn_exp2f((u == 0 ? sink0 : sink1) - m);
        const float inv = 1.0f / l;
        const int qrow = rowbase + (MODE == 0 ? 32 * u : 0) + r32;
        bf16* orow = Op + (MODE == 1 ? 64 * u : 0) + (size_t)qrow * D;
#pragma unroll
        for (int g = 0; g < 4; ++g) {
            v2u w0; w0.x = pk2(o0[u][4 * g] * inv, o0[u][4 * g + 1] * inv); w0.y = pk2(o0[u][4 * g + 2] * inv, o0[u][4 * g + 3] * inv);
            v2u w1; w1.x = pk2(o1[u][4 * g] * inv, o1[u][4 * g + 1] * inv); w1.y = pk2(o1[u][4 * g + 2] * inv, o1[u][4 * g + 3] * inv);
            *(v2u*)(orow + 8 * g + 4 * hi) = w0; *(v2u*)(orow + 32 + 8 * g + 4 * hi) = w1;
        }
    }
#undef ATT_TROW
#undef ATT_LOAD
#undef ATT_STORE
}

template <int DK, int MODE, int VM = 0>
__device__ __forceinline__ bool unit_h(LAS unsigned char* lds, const bf16* Qp, int qpitch, const bf16* Kp, int kpitch, const bf16* Vp, int vpitch, bf16* Op,
                                       int var, int qt, int lo, int n1, int nt, float qscale, float sink0, float sink1, bool has_sink, const LAS float* bias, const float* t32, volatile LAS unsigned* flag) {
    constexpr int KRS = DK * 2 + 16, NS = DK / 16, CPK = DK / 8;
    int tid = threadIdx.x; asm volatile("" : "+v"(tid)); const int lane = tid & 63, r32 = lane & 31, hi = lane >> 5, wid = __builtin_amdgcn_readfirstlane(tid >> 6);
    const int rowbase = MODE == 0 ? 512 * qt + 64 * wid : 256 * qt + 32 * wid;
    bf16x8 qr[2][NS];
#pragma unroll
    for (int u = 0; u < 2; ++u) {
        const int qrow = rowbase + (MODE == 0 ? 32 * u : 0) + r32;
        const bf16* qp = Qp + (MODE == 1 ? 64 * u : 0) + (size_t)qrow * qpitch;
#pragma unroll
        for (int s = 0; s < NS; ++s) { const v4u raw = *(const v4u*)(qp + 16 * s + 8 * hi); float f[8]; unpack8(raw, f);
#pragma unroll
            for (int i = 0; i < 8; ++i) f[i] *= qscale;
            if (DK == 96 && s >= 4) { float p[8];
#pragma unroll
                for (int i = 0; i < 8; ++i) p[i] = __shfl_xor(f[i], 32);
                rope8(f, p, t32 + ((size_t)((s == 4 ? (qrow >> 6) : (qrow & 63)) * 8)) * 2, hi == 0); }
            qr[u][s] = __builtin_bit_cast(bf16x8, pack8(f)); }
    }
    const int kkey0 = tid / CPK, kch0 = tid - kkey0 * CPK, kkey1 = (tid + 512) / CPK, kch1 = (tid + 512) - kkey1 * CPK;
    const int vkey = tid >> 3, vch = tid & 7;
    v4u kreg0, kreg1 = {0u, 0u, 0u, 0u}, vreg;
#define ATT_TROW(j) ((((j) < n1) ? (lo + (j)) : (64 + (j) - n1)) * 64)
#define ATT_LOAD(j) do { const int tr_ = ATT_TROW(j); kreg0 = *(const v4u*)(Kp + (size_t)(tr_ + kkey0) * kpitch + kch0 * 8); \
        if (DK == 96 && tid < 256) kreg1 = *(const v4u*)(Kp + (size_t)(tr_ + kkey1) * kpitch + kch1 * 8); \
        vreg = *(const v4u*)(Vp + (size_t)(tr_ + vkey) * vpitch + vch * 8); } while (0)
#define ATT_STORE(bf) do { LAS unsigned char* b_ = lds + (bf) * BUF; *(LAS v4u*)(b_ + kkey0 * KRS + kch0 * 16) = kreg0; \
        if (DK == 96 && tid < 256) *(LAS v4u*)(b_ + kkey1 * KRS + kch1 * 16) = kreg1; \
        *(LAS v4u*)(b_ + KBUF + vkey * VRS + vch * 16) = vreg; } while (0)
    f32x2 lacc[2] = {{0.f, 0.f}, {0.f, 0.f}}; f32x16 o0[2] = {{}, {}}, o1[2] = {{}, {}};
    const int grw = 8 * qt + wid, r0w = min(max(grw - 4, 0), 56), i0w = rowbase;
    ATT_LOAD(0); ATT_STORE(0);
    if (tid == 0) *flag = 0u;
    __syncthreads();
    for (int j = 0; j < nt; ++j) {
        if (!(VM & 8) && j + 1 < nt) ATT_LOAD(j + 1);
        const int kt = ATT_TROW(j) >> 6;
        bool actv = true;
        if (kt < 64) { if (var == 0) actv = (kt >= r0w) && (kt <= r0w + 7); else if (var == 2) actv = !((64 * kt - (i0w + 31) > 128) || (i0w - (64 * kt + 63) > 128)); }
        if (actv) {
        const LAS unsigned char* Kb = lds + (j & 1) * BUF; const LAS unsigned char* Vb = Kb + KBUF;
        const LAS unsigned char* vbase = Vb + (4 * hi + ((lane & 15) >> 2)) * VRS + ((lane >> 4) & 1) * 32 + (lane & 3) * 8;
#pragma unroll
        for (int hf = 0; hf < 2; ++hf) {
            f32x16 sc[2] = {{}, {}};
#pragma unroll
            for (int s = 0; s < NS; ++s) {
                const bf16x8 kf = *(const LAS bf16x8*)(Kb + (32 * hf + r32) * KRS + (16 * s + 8 * hi) * 2);
#pragma unroll
                for (int u = 0; u < 2; ++u) sc[u] = __builtin_amdgcn_mfma_f32_32x32x16_bf16(kf, qr[u][s], sc[u], 0, 0, 0);
            }
            if (kt < 64 && var == 0) {
#pragma unroll
                for (int u = 0; u < 2; ++u) { const int gc = 32 * u + r32, c0 = min(max(gc - 8, 0), 48), rowoff = (kt - grw + 7) * 31 - gc + 15;
#pragma unroll
                    for (int r = 0; r < 16; ++r) { const int jj = 32 * hf + crow(r, hi); const bool v = (unsigned)(jj - c0) < 16u;
                        const float bv = bias[v ? rowoff + jj : 0]; sc[u][r] = v ? sc[u][r] + bv : NEG; } }
            } else if (kt < 64 && var == 2) {
                const int dbase = 64 * kt - (rowbase + r32) + 128;
#pragma unroll
                for (int r = 0; r < 16; ++r) { const bool v = (unsigned)(dbase + 32 * hf + crow(r, hi)) <= 256u; sc[0][r] = v ? sc[0][r] : NEG; sc[1][r] = v ? sc[1][r] : NEG; }
            }
            bf16x8 pb[2][2];
#pragma unroll
            for (int u = 0; u < 2; ++u) {
#pragma unroll
                for (int r = 0; r < 16; r += 2) { sc[u][r] = __builtin_amdgcn_exp2f(sc[u][r]); sc[u][r + 1] = __builtin_amdgcn_exp2f(sc[u][r + 1]); lacc[u] += (f32x2){sc[u][r], sc[u][r + 1]}; }
#pragma unroll
                for (int s = 0; s < 2; ++s) {
                    v4u w; w.x = cvtpk(sc[u][8 * s], sc[u][8 * s + 1]); w.y = cvtpk(sc[u][8 * s + 2], sc[u][8 * s + 3]); w.z = cvtpk(sc[u][8 * s + 4], sc[u][8 * s + 5]); w.w = cvtpk(sc[u][8 * s + 6], sc[u][8 * s + 7]);
                    pb[u][s] = __builtin_bit_cast(bf16x8, w);
                }
            }
#pragma unroll
            for (int s2 = 0; s2 < 2; ++s2) { const int s = 2 * hf + s2;
                const v4i16 a0 = __builtin_amdgcn_ds_read_tr16_b64_v4i16((LAS v4i16*)(vbase + (16 * s) * VRS));
                const v4i16 a1 = __builtin_amdgcn_ds_read_tr16_b64_v4i16((LAS v4i16*)(vbase + (16 * s + 8) * VRS));
                const v4i16 c0_ = __builtin_amdgcn_ds_read_tr16_b64_v4i16((LAS v4i16*)(vbase + (16 * s) * VRS + 64));
                const v4i16 c1_ = __builtin_amdgcn_ds_read_tr16_b64_v4i16((LAS v4i16*)(vbase + (16 * s + 8) * VRS + 64));
                const bf16x8 va = {a0[0], a0[1], a0[2], a0[3], a1[0], a1[1], a1[2], a1[3]};
                const bf16x8 vc = {c0_[0], c0_[1], c0_[2], c0_[3], c1_[0], c1_[1], c1_[2], c1_[3]};
#pragma unroll
                for (int u = 0; u < 2; ++u) { o0[u] = __builtin_amdgcn_mfma_f32_32x32x16_bf16(va, pb[u][s2], o0[u], 0, 0, 0); o1[u] = __builtin_amdgcn_mfma_f32_32x32x16_bf16(vc, pb[u][s2], o1[u], 0, 0, 0); }
            }
            __builtin_amdgcn_sched_barrier(0);
        }
        }
        if (!(VM & 8) && j + 1 < nt) ATT_STORE((j + 1) & 1);
        __syncthreads();
    }
    float lsum[2]; bool bad = false;
#pragma unroll
    for (int u = 0; u < 2; ++u) { lsum[u] = xhalf_sum(lacc[u].x + lacc[u].y); bad = bad || !(lsum[u] > 8.6736174e-19f && lsum[u] < 1.1529215e18f);
        if (has_sink) { lsum[u] += __builtin_amdgcn_exp2f(u == 0 ? sink0 : sink1); bad = bad || !(lsum[u] < 1.1529215e18f); } }
    if (__any(bad)) { if (lane == 0) *flag = 1u; }
#pragma unroll
    for (int u = 0; u < 2; ++u) {
        const float inv = 1.0f / lsum[u];
        bf16* orow = Op + (MODE == 1 ? 64 * u : 0) + (size_t)(rowbase + (MODE == 0 ? 32 * u : 0) + r32) * D;
#pragma unroll
        for (int g = 0; g < 4; ++g) {
            v2u w0; w0.x = pk2(o0[u][4 * g] * inv, o0[u][4 * g + 1] * inv); w0.y = pk2(o0[u][4 * g + 2] * inv, o0[u][4 * g + 3] * inv);
            v2u w1; w1.x = pk2(o1[u][4 * g] * inv, o1[u][4 * g + 1] * inv); w1.y = pk2(o1[u][4 * g + 2] * inv, o1[u][4 * g + 3] * inv);
            *(v2u*)(orow + 8 * g + 4 * hi) = w0; *(v2u*)(orow + 32 + 8 * g + 4 * hi) = w1;
        }
    }
    __syncthreads();
    return *flag == 0u;
#undef ATT_TROW
#undef ATT_LOAD
#undef ATT_STORE
}
}

template <int VM = 0>
__device__ __forceinline__ void phase_attn(const Frame& F, int lq) {
    const int l = lq & 3;
    const bf16* P = (const bf16*)(F.ws + WS_PB); const bf16* QD = (const bf16*)(F.ws + WS_QD); const bf16* KD = (const bf16*)(F.ws + WS_KD);
    const bf16* VD = (const bf16*)(F.ws + WS_VD); bf16* O = (bf16*)(F.ws + (lq >= 4 ? WS_ACT : WS_HA));
    unsigned* ctr = (unsigned*)(F.ws + WS_CTL) + CW_QUEUE + 64 * 8 * lq;
    LAS float* bias = (LAS float*)(F.lds + att::BIAS_OFF);
    { const float* nab = INP(I_NABIAS) + l * 4 * 465; for (int i = F.tid; i < 4 * 465; i += NTHR) bias[i] = nab[i] * LOG2E; }
    const float* sinks = INP(I_SINK) + l * 4;
    __syncthreads();
    const float* t32 = (const float*)(F.ws + WS_T32);
    volatile LAS unsigned* flag = F.MISC + MI_Q + 1;
    const int nloc = 256 + (l < NL - 1 ? 24 : 0);
    const int q0 = (int)xb_xcc_id();
    for (int qq = 0; qq < 8; ++qq) {
      const int q = (q0 + qq) & 7;
      unsigned* qctr = ctr + 64 * q;
      for (;;) {
        if (F.tid == 0) F.MISC[MI_Q] = __hip_atomic_fetch_add(qctr, 1u, __ATOMIC_RELAXED, __HIP_MEMORY_SCOPE_AGENT);
        __syncthreads();
        const int li = (int)F.MISC[MI_Q];
        __syncthreads();
        if (li >= nloc) break;
        int idx;
        if (li < 64) idx = (q + 8 * (li >> 3)) * 8 + (li & 7);
        else if (li < 128) { const int jx = li - 64; idx = 1024 + (q + 8 * (jx >> 4)) * 16 + (jx & 15); }
        else if (li < 192) { const int jx = li - 128; idx = 1536 + (q + 8 * (jx >> 3)) * 8 + (jx & 7); }
        else if (li < 256) { const int jx = li - 192; idx = 2048 + (q + 8 * (jx >> 4)) * 16 + (jx & 15); }
        else if (li < 264) idx = 2560 + q + 8 * (li - 256);
        else idx = 2624 + q + 8 * (li - 264);
        if (idx < 512) {
            const int b = idx >> 5, h = (idx >> 3) & 3, qt = idx & 7; const size_t rb = (size_t)b * TT;
            if (!att::unit_h<96, 0, VM>(F.lds, QD + rb * 384 + h * 96, 384, KD + rb * 384 + h * 96, 384, VD + rb * 256 + h * 64, 256, O + rb * D + 768 + h * 64, 3, qt, 0, 64, 68, 0.10206207261596575f * LOG2E, 0.f, 0.f, false, bias, t32, flag)) {
#pragma unroll 1
                for (int k2 = 0; k2 < 2; ++k2)
                    att::unit<96, VM>(F.lds, QD + rb * 384 + h * 96, 384, KD + rb * 384 + h * 96, 384, VD + rb * 256 + h * 64, 256, O + rb * D + 768 + h * 64, 3, 2 * qt + k2, 0, 64, 68, 0.10206207261596575f * LOG2E, 0.f, false, bias, t32, nullptr);
            }
        } else if (idx < 1024) {
        } else if (idx < 2560) {
            idx -= 1024;
            const int grp = idx >> 9, rem = idx & 511, b = rem >> 5; const size_t rb = (size_t)b * TT;
            if (grp == 1) {
                const int h = (rem >> 3) & 3, qt = rem & 7; const int lo = min(max(8 * qt - 4, 0), 56), n1 = min(max(8 * qt + 3, 0), 56) + 7 - lo + 1;
                if (!att::unit_h<64, 0, VM>(F.lds, P + rb * NPJ + h * 64, NPJ, P + rb * NPJ + 256 + h * 64, NPJ, P + rb * NPJ + 512 + h * 64, NPJ, O + rb * D + h * 64, 0, qt, lo, n1, n1 + 4, 0.125f * LOG2E, 0.f, 0.f, false, bias + h * 465, t32, flag))
                att::unit2<64, 0, VM>(F.lds, P + rb * NPJ + h * 64, NPJ, P + rb * NPJ + 256 + h * 64, NPJ, P + rb * NPJ + 512 + h * 64, NPJ, O + rb * D + h * 64, 0, qt, lo, n1, n1 + 4,
                                  0.125f * LOG2E, 0.f, 0.f, false, bias + h * 465, t32);
            } else {
                const int g = (rem >> 4) & 1, qt = rem & 15; const bool isc = grp == 2;
                const int lo = isc ? max(4 * qt - 2, 0) : 0, n1 = isc ? min(4 * qt + 5, 63) - lo + 1 : 64;
                const int qc = (isc ? 1280 : 768) + g * 128, kc = (isc ? 1536 : 1024) + g * 64, vc = (isc ? 1664 : 1152) + g * 64;
                const float sk0 = isc ? sinks[2 * g] * LOG2E : 0.f, sk1 = isc ? sinks[2 * g + 1] * LOG2E : 0.f;
                if (!att::unit_h<64, 1, VM>(F.lds, P + rb * NPJ + qc, NPJ, P + rb * NPJ + kc, NPJ, P + rb * NPJ + vc, NPJ, O + rb * D + (isc ? 512 : 256) + g * 128, isc ? 2 : 1, qt, lo, n1, n1 + 4, 0.125f * LOG2E, sk0, sk1, isc, bias, t32, flag))
                att::unit2<64, 1, VM>(F.lds, P + rb * NPJ + qc, NPJ, P + rb * NPJ + kc, NPJ, P + rb * NPJ + vc, NPJ, O + rb * D + (isc ? 512 : 256) + g * 128, isc ? 2 : 1, qt, lo, n1, n1 + 4,
                                  0.125f * LOG2E, isc ? sinks[2 * g] * LOG2E : 0.f, isc ? sinks[2 * g + 1] * LOG2E : 0.f, isc, bias, t32);
            }
        } else if (idx < 2624) {
            const int rem = idx - 2560, b = rem >> 2, isc = (rem >> 1) & 1, g = rem & 1; const size_t rb = (size_t)b * TT;
            const int qc = (isc ? 1280 : 768) + g * 128, kc = (isc ? 1536 : 1024) + g * 64, vc = (isc ? 1664 : 1152) + g * 64;
            att::unit2<64, 1, VM>(F.lds, P + rb * NPJ + qc, NPJ, P + rb * NPJ + kc, NPJ, P + rb * NPJ + vc, NPJ, O + rb * D + (isc ? 512 : 256) + g * 128, isc ? 2 : 1, 16, 0, 0, 4,
                              0.125f * LOG2E, isc ? sinks[2 * g] * LOG2E : 0.f, isc ? sinks[2 * g + 1] * LOG2E : 0.f, isc != 0, bias, t32);
        } else {
            const int rem = idx - 2624, b = rem >> 3, isd = (rem >> 2) & 1, h = rem & 3; const size_t rb = (size_t)b * TT;
            if (isd) att::unit<96, VM>(F.lds, QD + rb * 384 + h * 96, 384, KD + rb * 384 + h * 96, 384, VD + rb * 256 + h * 64, 256, O + rb * D + 768 + h * 64, 3, 16, 0, 0, 4, 0.10206207261596575f * LOG2E, 0.f, false, bias, t32, nullptr);
            else att::unit<64, VM>(F.lds, P + rb * NPJ + h * 64, NPJ, P + rb * NPJ + 256 + h * 64, NPJ, P + rb * NPJ + 512 + h * 64, NPJ, O + rb * D + h * 64, 0, 16, 0, 0, 4, 0.125f * LOG2E, 0.f, false, bias + h * 465, nullptr, nullptr);
        }
    }
    }
}


#define PHASE_FN static __device__ __forceinline__ void
PHASE_FN ph_prologue(GAS unsigned char* ws) { const Frame F = make_frame(ws); phase_prologue(F); }
PHASE_FN ph_ln(GAS unsigned char* ws, int l) { const Frame F = make_frame(ws); phase_ln(F, l); }
PHASE_FN ph_gemm_in(GAS unsigned char* ws, int l) {
    const Frame F = make_frame(ws);
    pg8::Gemm g{(const bf16*)(F.ws + WS_HA), (const bf16*)(F.ws + WS_WIN), M, NPJ, D, D, nullptr}; pg8::StaticOrder S; S.init(M, NPJ, F.G, F.bid);
    pg8::EpiBf16NT<0> E{(bf16*)(F.ws + WS_PB), NPJ, nullptr, 0, 0, 1.f};
    pg8::gemm_phase<pg8::EpiBf16NT<0>, pg8::StaticOrder, true, true>(F.lds, g, S, E);
}
PHASE_FN ph_post(GAS unsigned char* ws, int l) { const Frame F = make_frame(ws); phase_post(F, l); }
PHASE_FN ph_gemm_mla(GAS unsigned char* ws, int l) {
    const Frame F = make_frame(ws);
    pg8::Gemm g{(const bf16*)(F.ws + WS_PB) + 1792, (const bf16*)(F.ws + WS_WD), M, 1024, 384, NPJ, nullptr}; pg8::StaticOrder S; S.init(M, 1024, F.G, F.bid);
    EpiMla E{(bf16*)(F.ws + WS_QD), (bf16*)(F.ws + WS_KD), (bf16*)(F.ws + WS_VD)};
    pg8::gemm_phase<EpiMla, pg8::StaticOrder, true, true>(F.lds, g, S, E);
}
template <int VM>
PHASE_FN ph_attn(GAS unsigned char* ws, int l) { const Frame F = make_frame(ws); phase_attn<VM>(F, l); }
PHASE_FN ph_gemm_out(GAS unsigned char* ws, int l) {
    const Frame F = make_frame(ws);
    pg8::Gemm g{(const bf16*)(F.ws + WS_HA), (const bf16*)(F.ws + WS_WOUT), M, D, D, D, nullptr};
    pg8::EpiBf16NT<0> E{(bf16*)(F.ws + WS_PB), D, nullptr, 0, 0, 1.f};
    if (l == NL - 1) { LatOrder S{F.G, F.bid}; pg8::gemm_phase<pg8::EpiBf16NT<0>, LatOrder, true, true>(F.lds, g, S, E); }
    else { pg8::StaticOrder S; S.init(M, D, F.G, F.bid); pg8::gemm_phase<pg8::EpiBf16NT<0>, pg8::StaticOrder, true, true>(F.lds, g, S, E); }
}
PHASE_FN ph_route(GAS unsigned char* ws, int l) { const Frame F = make_frame(ws); phase_route(F, l); }
PHASE_FN ph_permute(GAS unsigned char* ws, int l) { const Frame F = make_frame(ws); phase_permute(F, l); }
PHASE_FN ph_gemm_gu(GAS unsigned char* ws, int l) {
    const Frame F = make_frame(ws);
    moe_tables(F);
    pg8::Gemm g{(const bf16*)(F.ws + WS_HA), (const bf16*)(F.ws + WS_WGU), MS, 16384, D, D, (const int*)(F.ws + WS_QD)}; MoeOrder S{F.MISC + MI_PST, F.G, F.bid};
    EpiGU E{(bf16*)(F.ws + WS_ACT)};
    pg8::gemm_phase<EpiGU, MoeOrder, true, true, true>(F.lds, g, S, E);
}
PHASE_FN ph_gemm_dn(GAS unsigned char* ws, int l) {
    const Frame F = make_frame(ws);
    moe_tables(F);
    pg8::Gemm g{(const bf16*)(F.ws + WS_ACT), (const bf16*)(F.ws + WS_WDN), MS, 16384, 512, 512, nullptr}; MoeOrder S{F.MISC + MI_PST, F.G, F.bid};
    pg8::EpiBf16NT<0> E{(bf16*)(F.ws + WS_PB), D, nullptr, 1024, 0, 1.f};
    pg8::gemm_phase<pg8::EpiBf16NT<0>, MoeOrder, true, true>(F.lds, g, S, E);
}


#if MK_DEBUG
#ifndef DBG_MODE
#define DBG_MODE 0
#endif
__device__ __forceinline__ float oracle_attn(const Frame& F, int l, int r, int var, int h, int mode = 0) {
    const bf16* P = (const bf16*)(F.ws + WS_PB); const bf16* QD = (const bf16*)(F.ws + WS_QD); const bf16* KD = (const bf16*)(F.ws + WS_KD); const bf16* VD = (const bf16*)(F.ws + WS_VD);
    const bf16* O = (const bf16*)(F.ws + WS_HA); const float* t32 = (const float*)(F.ws + WS_T32);
    const int b = r / TT, t = r - b * TT; const bool lat = t < SEQ; const size_t rb = (size_t)b * TT;
    const int dk = var == 3 ? 96 : 64;
    const bf16* qp; const bf16* kp; const bf16* vp; int kpitch, vpitch;
    if (var == 3) { qp = QD + (size_t)r * 384 + h * 96; kp = KD + rb * 384 + h * 96; kpitch = 384; vp = VD + rb * 256 + h * 64; vpitch = 256; }
    else { const int qc = var == 0 ? h * 64 : var == 1 ? 768 + h * 64 : 1280 + h * 64, kc = var == 0 ? 256 + h * 64 : var == 1 ? 1024 + (h >> 1) * 64 : 1536 + (h >> 1) * 64,
           vc = var == 0 ? 512 + h * 64 : var == 1 ? 1152 + (h >> 1) * 64 : 1664 + (h >> 1) * 64;
           qp = P + (size_t)r * NPJ + qc; kp = P + rb * NPJ + kc; kpitch = NPJ; vp = P + rb * NPJ + vc; vpitch = NPJ; }
    LAS float* qs = (LAS float*)(F.lds + 65536) + F.wave * 128;
    for (int d = F.lane; d < dk; d += 64) qs[d] = __builtin_bit_cast(float, (unsigned)qp[d] << 16);
    asm volatile("s_waitcnt lgkmcnt(0)" ::: "memory");
    if (var == 3 && lat && F.lane < 32) {
        const int c = F.lane >> 3, e = F.lane & 7, gr = t >> 6, gc = t & 63; const float own = qs[64 + F.lane], par = qs[64 + (F.lane ^ 8)];
        const float cs = t32[((c < 2 ? gr : gc) * 8 + e) * 2], sn = t32[((c < 2 ? gr : gc) * 8 + e) * 2 + 1];
        const float nv = (c & 1) == 0 ? own * cs - par * sn : par * sn + own * cs;
        asm volatile("s_waitcnt lgkmcnt(0)" ::: "memory"); qs[64 + F.lane] = nv; }
    asm volatile("s_waitcnt lgkmcnt(0)" ::: "memory");
    const float scale = var == 3 ? 0.10206207261596575f : 0.125f;
    const int gr = t >> 6, gc = t & 63, r0 = min(max(gr - 4, 0), 56), c0 = min(max(gc - 8, 0), 48);
    float m = -3.0e38f, lsum = 0.f, acc[64];
#pragma unroll
    for (int d = 0; d < 64; ++d) acc[d] = 0.f;
    for (int j = F.lane; j < TT; j += 64) {
        bool ok = true; float bias = 0.f;
        if (!lat) ok = j >= SEQ;
        else if (j < SEQ) {
            if (var == 0) { const int kr = j >> 6, kc2 = j & 63; ok = kr >= r0 && kr <= r0 + 7 && kc2 >= c0 && kc2 <= c0 + 15;
                if (ok) bias = INP(I_NABIAS)[((l * 4 + h) * 15 + (kr - gr + 7)) * 31 + (kc2 - gc + 15)]; }
            else if (var == 2) ok = (j - t <= 128) && (t - j <= 128);
        }
        if (!ok) continue;
        float sc = 0.f; const bf16* kr_ = kp + (size_t)j * kpitch;
        for (int d = 0; d < dk; ++d) sc += qs[d] * __builtin_bit_cast(float, (unsigned)kr_[d] << 16);
        sc = sc * scale + bias;
        const float mn = fmaxf(m, sc), a = expf(m - mn), p = expf(sc - mn); m = mn; lsum = lsum * a + p;
        const bf16* vr = vp + (size_t)j * vpitch;
#pragma unroll
        for (int d = 0; d < 64; ++d) acc[d] = acc[d] * a + p * __builtin_bit_cast(float, (unsigned)vr[d] << 16);
    }
    float mg = m;
#pragma unroll
    for (int o = 1; o < 64; o <<= 1) mg = fmaxf(mg, __shfl_xor(mg, o));
    if (mode >= 1) {
        const unsigned* rec = (const unsigned*)(F.ws + WS_RS) + (size_t)r * 2; const float mk = __builtin_bit_cast(float, rec[0]), lk = __builtin_bit_cast(float, rec[1]);
        const float lref = wave_sum(lsum * expf(m - mg));
        const float lker = lk * exp2f(mk - mg * LOG2E);
        if (mode == 2) return fabsf(mk / LOG2E - mg);
        return fabsf(lker / lref - 1.0f);
    }
    const float f = expf(m - mg); lsum *= f; lsum = wave_sum(lsum);
    if (var == 2) lsum += expf(INP(I_SINK)[l * 4 + h] - mg);
    float err = 0.f, mag = 1.0e-6f;
    const bf16* orow = O + (size_t)r * D + var * 256 + h * 64;
#pragma unroll
    for (int d = 0; d < 64; ++d) { const float ref = wave_sum(acc[d] * f) / lsum; const float got = __builtin_bit_cast(float, (unsigned)orow[d] << 16);
        const float df = fabsf(got - ref); err = (df == df) ? fmaxf(err, df) : 1.0e30f; mag = fmaxf(mag, fabsf(ref)); }
    return err / mag;
}
__device__ __forceinline__ void phase_dump(const Frame& F, int code) {
    float* out = (float*)ptab_get(F, I_OUT);
    for (int r = F.gw; r < M; r += F.ngw) {
        const int b = r / TT, t = r - b * TT; if (t >= SEQ) continue;
        float v[16];
        if (code == 1) ld16bf((const bf16*)(F.ws + WS_HA) + (size_t)r * D, F.lane, v);
        else if (code == 2) ld16bf((const bf16*)(F.ws + WS_PB) + (size_t)r * NPJ, F.lane, v);
        else if (code == 3) ld16bf((const bf16*)(F.ws + WS_PB) + (size_t)r * NPJ + 1024, F.lane, v);
        else if (code == 4) ld16bf((const bf16*)(F.ws + WS_PB) + (size_t)r * NPJ + 1280, F.lane, v);
        else if (code == 5) ld16((const float*)(F.ws + WS_PB) + (size_t)r * D, F.lane, v);
        else if (code == 8) {
            const v4u w0 = *((const v4u*)((const bf16*)(F.ws + WS_HA) + (size_t)r * D) + F.lane), w1 = *((const v4u*)((const bf16*)(F.ws + WS_HA) + (size_t)r * D) + 64 + F.lane);
            float f[8]; int bad0 = 0, bad1 = 0; unpack8(w0, f);
#pragma unroll
            for (int i = 0; i < 8; ++i) { const unsigned u = __builtin_bit_cast(unsigned, f[i]); bad0 |= ((u & 0x7f800000u) == 0x7f800000u) ? 1 : 0; }
            unpack8(w1, f);
#pragma unroll
            for (int i = 0; i < 8; ++i) { const unsigned u = __builtin_bit_cast(unsigned, f[i]); bad1 |= ((u & 0x7f800000u) == 0x7f800000u) ? 1 : 0; }
            const unsigned long long m0 = __ballot(bad0), m1 = __ballot(bad1);
            const bool vA = (m0 & 0xffffffffull) != 0, vB = (m0 >> 32) != 0, vC = (m1 & 0xffffffffull) != 0, vD = (m1 >> 32) != 0;
            const float val = (float)(t + 1) * ((vA ? 1.0f : 0.f) + (vB ? 1.0e2f : 0.f) + (vC ? 1.0e4f : 0.f) + (vD ? 1.0e6f : 0.f));
#pragma unroll
            for (int i = 0; i < 16; ++i) v[i] = val;
        }
        else if (code == 9) { const unsigned cd = ((const unsigned*)(F.ws + WS_RS))[(size_t)r * 2]; float val = 0.f; if (cd) { val = 1.f; for (unsigned k = 0; k < cd; ++k) val *= 10.f; }
#pragma unroll
            for (int i = 0; i < 16; ++i) v[i] = val; }
        else if (code == 10) {
            const v4u w1 = *((const v4u*)((const bf16*)(F.ws + WS_HA) + (size_t)r * D) + 64 + F.lane);
            float f[8]; int bad1 = 0; unpack8(w1, f);
#pragma unroll
            for (int i = 0; i < 8; ++i) { const unsigned u = __builtin_bit_cast(unsigned, f[i]); bad1 |= ((u & 0x7f800000u) == 0x7f800000u) ? 1 : 0; }
            const bool vC = (__ballot(bad1) & 0xffffffffull) != 0;
            const bf16* pc = (const bf16*)(F.ws + WS_PB) + ((size_t)b * TT + SEQ + (t & 255)) * NPJ; int badp = 0;
            for (int c = F.lane; c < 288; c += 64) { const v4u w = *((const v4u*)pc + c); unpack8(w, f);
#pragma unroll
                for (int i = 0; i < 8; ++i) { const unsigned u = __builtin_bit_cast(unsigned, f[i]); badp |= ((u & 0x7f800000u) == 0x7f800000u) ? 1 : 0; } }
            float val = 0.f; if (vC) { val = 1.f; for (int k = 0; k <= (t & 15); ++k) val *= 10.f; }
            if (__any(badp)) val = 1.0e30f;
#pragma unroll
            for (int i = 0; i < 16; ++i) v[i] = val;
        }
        else if (code == 11) {
            const bf16* pr = (const bf16*)(F.ws + WS_PB) + (size_t)r * NPJ; int grp = -1;
            for (int c = F.lane; c < 288; c += 64) { const v4u w = *((const v4u*)pr + c); float f[8]; unpack8(w, f);
#pragma unroll
                for (int i = 0; i < 8; ++i) if (!(fabsf(f[i]) < 1.0e4f)) grp = (c * 8) >> 8; }
#pragma unroll
            for (int o = 1; o < 64; o <<= 1) { const int g2 = __shfl_xor(grp, o); grp = g2 > grp ? g2 : grp; }
            float val = 0.f; if (grp >= 0) { val = 100.f; for (int k = 0; k < grp; ++k) val *= 10.f; }
#pragma unroll
            for (int i = 0; i < 16; ++i) v[i] = val;
        }
        else if (code >= 20 && code < 24) {
            float val = 0.f;
            if ((t & 15) == 5) { for (int h = 0; h < 4; ++h) { const float e = oracle_attn(F, 0, r, code - 20, h); const float cls = e > 1.0e20f ? 3.f : e > 0.5f ? 2.f : e > 0.03f ? 1.f : 0.f; if (cls > 0.f) { float w = cls; for (int k = 0; k <= h; ++k) w *= 10.f; val = fmaxf(val, w); } } }
#pragma unroll
            for (int i = 0; i < 16; ++i) v[i] = val;
        }
        else if (code >= 30 && code < 46) {
            float val = 0.f;
            if ((t & 15) == 5) { const float e = oracle_attn(F, 0, r, (code - 30) >> 2, (code - 30) & 3, DBG_MODE); val = e > 10.f ? 1.0e4f : 1000.f * e; }
#pragma unroll
            for (int i = 0; i < 16; ++i) v[i] = val;
        }
        else if (code == 7) {
            auto bad16 = [&](const bf16* p, int nchunks) { int bad = 0; for (int c = F.lane; c < nchunks; c += 64) { const v4u w = *((const v4u*)p + c); float f[8]; unpack8(w, f);
#pragma unroll
                for (int i = 0; i < 8; ++i) { const unsigned u = __builtin_bit_cast(unsigned, f[i]); bad |= ((u & 0x7f800000u) == 0x7f800000u) ? 1 : 0; } } return __any(bad); };
            const int bP = bad16((const bf16*)(F.ws + WS_PB) + (size_t)r * NPJ, 288), bQ = bad16((const bf16*)(F.ws + WS_QD) + (size_t)r * 384, 48),
                      bK = bad16((const bf16*)(F.ws + WS_KD) + (size_t)r * 384, 48), bV = bad16((const bf16*)(F.ws + WS_VD) + (size_t)r * 256, 32), bO = bad16((const bf16*)(F.ws + WS_HA) + (size_t)r * D, 128);
            const float val = bP ? 1.0e6f : bQ ? 1.0e5f : bK ? 1.0e4f : bV ? 1.0e3f : bO ? 1.0e2f : 0.f;
#pragma unroll
            for (int i = 0; i < 16; ++i) v[i] = val;
        }
#pragma unroll
        for (int i = 0; i < 16; ++i) { const unsigned u = __builtin_bit_cast(unsigned, v[i]); if ((u & 0x7f800000u) == 0x7f800000u) v[i] = 777.0f; }
        st16(out + ((size_t)b * SEQ + t) * D, F.lane, v);
    }
}
static __device__ __forceinline__ void ph_dump(GAS unsigned char* ws, int code) { const Frame F = make_frame(ws); phase_dump(F, code); }
#endif
__global__ void __launch_bounds__(NTHR, 2) mk_fwd(Args args) {
    extern __shared__ __attribute__((aligned(16))) unsigned char lds_raw[];
    LAS unsigned char* lds = (LAS unsigned char*)lds_raw; volatile LAS unsigned* MISC = (volatile LAS unsigned*)(lds + MISC_OFF);
    const int tid = threadIdx.x;
    GAS unsigned char* ws = (GAS unsigned char*)args.ws;
    for (int u = tid; u < (LDS_BYTES - MISC_OFF) / 4; u += NTHR) MISC[u] = 0u;
    __syncthreads();
    if (tid < 28) { const unsigned long long p = tid < 27 ? (unsigned long long)args.in[tid] : (unsigned long long)args.out;
        LAS unsigned* t = (LAS unsigned*)(lds + PTAB_OFF) + 2 * tid; t[0] = (unsigned)p; t[1] = (unsigned)(p >> 32); }
    __syncthreads();
#if MK_MULTI
#define GRID_BAR() do { } while (0)
#else
    XcdBarrier bar = xcd_barrier_post((unsigned*)(ws + WS_CTL) + CW_BAR, MISC + MI_BAR);
#define GRID_BAR() xcd_barrier(bar)
#endif
    const int lo = args.ph_lo, hi = args.ph_hi;
#define IN(k) (lo <= (k) && (k) < hi)
#if MK_TIME
    unsigned long long tcat = 0ull, tb0 = 0ull;
#define TBEG() do { tb0 = __builtin_amdgcn_s_memrealtime(); } while (0)
#define TEND(c) do { if ((c) == MK_TIME - 1) tcat += __builtin_amdgcn_s_memrealtime() - tb0; } while (0)
#define SEAM(k) do { if (IN(k) && IN((k) + 1)) { TBEG(); GRID_BAR(); TEND(1); } } while (0)
#else
#define TBEG() do { } while (0)
#define TEND(c) do { } while (0)
#define SEAM(k) do { if (IN(k) && IN((k) + 1)) GRID_BAR(); } while (0)
#endif

#if MK_DEBUG
    if (lo >= 100) { ph_dump(ws, lo - 100); return; }
#endif
    if (IN(0)) { TBEG(); ph_prologue(ws); TEND(2); } SEAM(0);
    for (int l = 0; l < NL; ++l) {
        const int pb = 1 + 10 * l;
        if (IN(pb + 0)) { TBEG(); ph_ln(ws, l); TEND(0); } SEAM(pb + 0);
        if (IN(pb + 1)) { TBEG(); ph_gemm_in(ws, l); if (MK_DUP & 2) { GRID_BAR(); ph_gemm_in(ws, l); } TEND(3); } SEAM(pb + 1);
        if (IN(pb + 2)) { TBEG(); ph_post(ws, l); TEND(0); } SEAM(pb + 2);
        if (IN(pb + 3)) { TBEG(); ph_gemm_mla(ws, l); if (MK_DUP & 8) { GRID_BAR(); ph_gemm_mla(ws, l); } TEND(3); } SEAM(pb + 3);
        if (IN(pb + 4)) { TBEG(); ph_attn<0>(ws, l); if (MK_DUP & 16) { GRID_BAR(); ph_attn<MK_VM>(ws, l + 4); } TEND(4); } SEAM(pb + 4);
        if (IN(pb + 5)) { TBEG(); ph_gemm_out(ws, l); if (MK_DUP & 32) { GRID_BAR(); ph_gemm_out(ws, l); } TEND(3); } SEAM(pb + 5);
        if (IN(pb + 6)) { TBEG(); ph_route(ws, l); TEND(0); } SEAM(pb + 6);
        if (IN(pb + 7)) { TBEG(); ph_permute(ws, l); if (MK_DUP & 128) { GRID_BAR(); ph_permute(ws, l); } TEND(0); } SEAM(pb + 7);
        if (IN(pb + 8)) { TBEG(); ph_gemm_gu(ws, l); if (MK_DUP & 256) { GRID_BAR(); ph_gemm_gu(ws, l); } TEND(3); } SEAM(pb + 8);
        if (IN(pb + 9)) { TBEG(); ph_gemm_dn(ws, l); if (MK_DUP & 512) { GRID_BAR(); ph_gemm_dn(ws, l); } TEND(3); } SEAM(pb + 9);
    }
    if (IN(NPHASE - 1)) { TBEG(); ph_ln(ws, NL); TEND(0); }
#if MK_TIME
    if (blockIdx.x == 0) { const unsigned long long tw = __builtin_amdgcn_s_memrealtime(); const unsigned long long dl = tcat * (unsigned long long)MK_TMUL; while (__builtin_amdgcn_s_memrealtime() - tw < dl) __builtin_amdgcn_s_sleep(8); }
#endif
#undef IN
#undef SEAM
#undef GRID_BAR
}

extern "C" void kernel_launch(void* const* d_in, const int* in_sizes, int n_in, void* d_out, int out_size, void* d_ws, size_t ws_size, hipStream_t stream) {
    static int grid = 0;
    if (grid == 0) {
        if (n_in != 27 || out_size != NB * SEQ * D || ws_size < WS_END) { fprintf(stderr, "kernel_launch: unexpected problem (n_in %d, out %d, ws %zu < %zu)\n", n_in, out_size, ws_size, (size_t)WS_END); grid = -1; return; }
        int dev = 0, cus = 0, per_cu = 0;
        if (hipGetDevice(&dev) != hipSuccess || hipDeviceGetAttribute(&cus, hipDeviceAttributeMultiprocessorCount, dev) != hipSuccess) { grid = -1; return; }
        if (hipFuncSetAttribute((const void*)mk_fwd, hipFuncAttributeMaxDynamicSharedMemorySize, LDS_BYTES) != hipSuccess) { fprintf(stderr, "kernel_launch: hipFuncSetAttribute failed\n"); grid = -1; return; }
        if (hipOccupancyMaxActiveBlocksPerMultiprocessor(&per_cu, (const void*)mk_fwd, NTHR, LDS_BYTES) != hipSuccess || per_cu < 1) fprintf(stderr, "kernel_launch: occupancy query reports %d\n", per_cu);
        (void)hipGetLastError();
        grid = cus > 1024 ? 1024 : cus;
    }
    if (grid < 0) return;
    (void)hipMemsetAsync((char*)d_ws + WS_CTL, 0, CTL_BYTES, stream);
    Args a{};
    for (int i = 0; i < 27; ++i) a.in[i] = (const float*)d_in[i];
    a.out = (float*)d_out; a.ws = (unsigned char*)d_ws;
#if MK_MULTI
#ifndef DBG_NRUN
#define DBG_NRUN NPHASE
#endif
    for (int p = 0; p < DBG_NRUN; ++p) { a.ph_lo = p; a.ph_hi = p + 1; hipLaunchKernelGGL(mk_fwd, dim3(grid), dim3(NTHR), LDS_BYTES, stream, a); }
#ifdef DBG_DUMP
    a.ph_lo = 100 + DBG_DUMP; a.ph_hi = 101 + DBG_DUMP; hipLaunchKernelGGL(mk_fwd, dim3(grid), dim3(NTHR), LDS_BYTES, stream, a);
#endif
#else
    a.ph_lo = 0; a.ph_hi = NPHASE;
    hipLaunchKernelGGL(mk_fwd, dim3(grid), dim3(NTHR), LDS_BYTES, stream, a);
#endif
}
```

```cpp
#include <hip/hip_runtime.h>
#include <cstdio>
#include <cstdint>
namespace pg8 {
#define PG8_LAS __attribute__((address_space(3)))
typedef unsigned short bf16_t;
typedef short bf16x8 __attribute__((ext_vector_type(8)));
typedef float f32x4 __attribute__((ext_vector_type(4)));
typedef unsigned u32x4 __attribute__((ext_vector_type(4)));
constexpr int BM = 256, BK = 64, HALF = 128, HTB = HALF * BK * 2  , STAGE_BYTES = 8 * HTB, NXCD = 8, WGM = 8;

__host__ __device__ __forceinline__ int lds_byte(int r, int c) { const int st = (r >> 4) * 2 + (c >> 5), rr = r & 15, cc = c & 31, ob = rr * 64 + cc * 2; return st * 1024 + (ob ^ (((ob >> 9) & 1) << 5)); }
__host__ __device__ __forceinline__ void stage_rc(int b, int& R, int& C) { const int st = b / 1024, sb = b % 1024, swz = sb ^ (((sb >> 9) & 1) << 5); R = (st >> 1) * 16 + swz / 64; C = (st & 1) * 32 + (swz % 64) / 2; }
__host__ __device__ __forceinline__ int perm32(int rho) { const int n = rho >> 4, i = rho & 15; return 8 * (i >> 2) + 4 * n + (i & 3); }

struct Unit { int pm, pn; };
struct Gemm { const bf16_t* A; const bf16_t* Bt; int M, N, K, lda; const int* src; };

struct StaticOrder {
    int nM, nN, nwg, G, c;
    __host__ __device__ void init(int M, int N, int G_, int c_) { nM = M / BM; nN = N / BM; nwg = nM * nN; G = G_; c = c_; }
    __host__ __device__ bool next(int i, Unit& u) const {
        const long L = (long)i * G + c; if (L >= nwg) return false;
        int wgid = (int)L; { const int q = nwg / NXCD, r = nwg % NXCD, xcd = wgid % NXCD, off = wgid / NXCD; wgid = (xcd < r ? xcd * (q + 1) : r * (q + 1) + (xcd - r) * q) + off; }
        const int nig = WGM * nN, gid = wgid / nig, fm = gid * WGM, gsz = (nM - fm) < WGM ? (nM - fm) : WGM;
        u.pm = fm + ((wgid % nig) % gsz); u.pn = (wgid % nig) / gsz; return true;
    }
    __device__ __forceinline__ void a_ready(const Unit&) const {}
    __device__ __forceinline__ void done(const Unit&) const {}
};

__device__ __forceinline__ unsigned cvt_pk_bf16(float lo, float hi) { unsigned r; asm volatile("v_cvt_pk_bf16_f32 %0, %1, %2" : "=v"(r) : "v"(lo), "v"(hi)); return r; }
typedef float f32x2 __attribute__((ext_vector_type(2)));
__device__ __forceinline__ f32x2 gelu_pk(f32x2 v) {
    const f32x2 av = __builtin_elementwise_abs(v), d = av * 0.2316418882f + 1.0f;
    f32x2 t; t.x = __builtin_amdgcn_rcpf(d.x); t.y = __builtin_amdgcn_rcpf(d.y);
    f32x2 q = t * 0.5307027145f + (-0.7265760135f); q = q * t + 0.7107068705f; q = q * t + (-0.142248368f); q = q * t + 0.127414796f; q = q * t;
    const f32x2 s = (v * v) * (-0.72134752044f);
    f32x2 e; e.x = __builtin_amdgcn_exp2f(s.x); e.y = __builtin_amdgcn_exp2f(s.y);
    const f32x2 m = v * (q * e), r = v - m;
    f32x2 o; o.x = v.x < 0.f ? m.x : r.x; o.y = v.y < 0.f ? m.y : r.y; return o;
}

template <int ACT  > struct EpiBf16 {
    static constexpr bool PERM = true, AFTER_DRAIN = false; static_assert(ACT == 0 || ACT == 1, "EpiBf16: ACT is 0 (none) or 1 (gelu_pk)");
    bf16_t* O; int ldc; const float* bias; int split_cols; size_t split_stride; float scale0;
    __device__ __forceinline__ void operator()(const f32x4 (&acc)[2][2][4][2], const Unit& u, int wr, int wc, int fr, int fq) const {
        const int row0 = u.pm * BM + wr * 64 + fr; int colt = u.pn * BM; bf16_t* base = O;
        float sc = 1.f; if (split_cols) { const int t = colt / split_cols; base += (size_t)t * split_stride; colt -= t * split_cols; if (t == 0) sc = scale0; }
        const int col0 = colt + wc * 32 + 8 * fq, bcol0 = u.pn * BM + wc * 32 + 8 * fq;
        f32x4 bv[2][2];
#pragma unroll
        for (int bj = 0; bj < 2; ++bj)
#pragma unroll
            for (int n = 0; n < 2; ++n) bv[bj][n] = bias ? *(const f32x4*)(bias + bcol0 + bj * HALF + 4 * n) : (f32x4){0.f, 0.f, 0.f, 0.f};
#pragma unroll
        for (int ai = 0; ai < 2; ++ai)
#pragma unroll
            for (int m = 0; m < 4; ++m) { bf16_t* rowp = base + (size_t)(row0 + ai * HALF + m * 16) * ldc + col0;
#pragma unroll
                for (int bj = 0; bj < 2; ++bj) { f32x4 v0 = acc[ai][bj][m][0] + bv[bj][0], v1 = acc[ai][bj][m][1] + bv[bj][1];
                    if (ACT == 1) { f32x2 a = gelu_pk((f32x2){v0[0], v0[1]}), b = gelu_pk((f32x2){v0[2], v0[3]}), c = gelu_pk((f32x2){v1[0], v1[1]}), d = gelu_pk((f32x2){v1[2], v1[3]});
                        v0 = (f32x4){a.x, a.y, b.x, b.y}; v1 = (f32x4){c.x, c.y, d.x, d.y}; }
                    v0 = v0 * sc; v1 = v1 * sc; u32x4 w; w.x = cvt_pk_bf16(v0[0], v0[1]); w.y = cvt_pk_bf16(v0[2], v0[3]); w.z = cvt_pk_bf16(v1[0], v1[1]); w.w = cvt_pk_bf16(v1[2], v1[3]);
                    *(u32x4*)(rowp + bj * HALF) = w; } }
    }
};
template <int ACT  > struct EpiBf16NT {
    static constexpr bool PERM = true, AFTER_DRAIN = false; static_assert(ACT == 0 || ACT == 1, "EpiBf16: ACT is 0 (none) or 1 (gelu_pk)");
    bf16_t* O; int ldc; const float* bias; int split_cols; size_t split_stride; float scale0;
    __device__ __forceinline__ void operator()(const f32x4 (&acc)[2][2][4][2], const Unit& u, int wr, int wc, int fr, int fq) const {
        const int row0 = u.pm * BM + wr * 64 + fr; int colt = u.pn * BM; bf16_t* base = O;
        float sc = 1.f; if (split_cols) { const int t = colt / split_cols; base += (size_t)t * split_stride; colt -= t * split_cols; if (t == 0) sc = scale0; }
        const int col0 = colt + wc * 32 + 8 * fq, bcol0 = u.pn * BM + wc * 32 + 8 * fq;
        f32x4 bv[2][2];
#pragma unroll
        for (int bj = 0; bj < 2; ++bj)
#pragma unroll
            for (int n = 0; n < 2; ++n) bv[bj][n] = bias ? *(const f32x4*)(bias + bcol0 + bj * HALF + 4 * n) : (f32x4){0.f, 0.f, 0.f, 0.f};
#pragma unroll
        for (int ai = 0; ai < 2; ++ai)
#pragma unroll
            for (int m = 0; m < 4; ++m) { bf16_t* rowp = base + (size_t)(row0 + ai * HALF + m * 16) * ldc + col0;
#pragma unroll
                for (int bj = 0; bj < 2; ++bj) { f32x4 v0 = acc[ai][bj][m][0] + bv[bj][0], v1 = acc[ai][bj][m][1] + bv[bj][1];
                    if (ACT == 1) { f32x2 a = gelu_pk((f32x2){v0[0], v0[1]}), b = gelu_pk((f32x2){v0[2], v0[3]}), c = gelu_pk((f32x2){v1[0], v1[1]}), d = gelu_pk((f32x2){v1[2], v1[3]});
                        v0 = (f32x4){a.x, a.y, b.x, b.y}; v1 = (f32x4){c.x, c.y, d.x, d.y}; }
                    v0 = v0 * sc; v1 = v1 * sc; u32x4 w; w.x = cvt_pk_bf16(v0[0], v0[1]); w.y = cvt_pk_bf16(v0[2], v0[3]); w.z = cvt_pk_bf16(v1[0], v1[1]); w.w = cvt_pk_bf16(v1[2], v1[3]);
                    __builtin_nontemporal_store(w, (u32x4*)(rowp + bj * HALF)); } }
    }
};
struct EpiF32 {
    static constexpr bool PERM = false, AFTER_DRAIN = false;
    float* C; int ldc; const float* bias;
    __device__ __forceinline__ void operator()(const f32x4 (&acc)[2][2][4][2], const Unit& u, int wr, int wc, int fr, int fq) const {
        const int row0 = u.pm * BM + wr * 64 + fr, col0 = u.pn * BM + wc * 32 + 4 * fq;
        f32x4 bv[2][2];
#pragma unroll
        for (int bj = 0; bj < 2; ++bj)
#pragma unroll
            for (int n = 0; n < 2; ++n) bv[bj][n] = bias ? *(const f32x4*)(bias + col0 + bj * HALF + n * 16) : (f32x4){0.f, 0.f, 0.f, 0.f};
#pragma unroll
        for (int ai = 0; ai < 2; ++ai)
#pragma unroll
            for (int m = 0; m < 4; ++m) { float* rowp = C + (size_t)(row0 + ai * HALF + m * 16) * ldc + col0;
#pragma unroll
                for (int bj = 0; bj < 2; ++bj)
#pragma unroll
                    for (int n = 0; n < 2; ++n) *(f32x4*)(rowp + bj * HALF + n * 16) = acc[ai][bj][m][n] + bv[bj][n]; }
    }
};
template <class Epi, class Sched, bool ALIGN_EPI = false, bool SP2 = false, bool GATHER = false>
__device__ __forceinline__ void gemm_phase(PG8_LAS unsigned char* lds, const Gemm g, const Sched& S, const Epi& E) {
    int tid = threadIdx.x; asm volatile("" : "+v"(tid)); const int wid = __builtin_amdgcn_readfirstlane(tid >> 6), lane = tid & 63, wr = wid >> 2, wc = wid & 3, fr = lane & 15, fq = lane >> 4;
    const int K = g.K, nt = K / BK;
    unsigned voffA[2], voffB[2]; int RA[2]; unsigned CA2[2];
#pragma unroll
    for (int i = 0; i < 2; ++i) { int R, C; stage_rc(tid * 16 + i * 8192, R, C); const int Rb = Epi::PERM ? ((R & ~31) + perm32(R & 31)) : R;
        voffA[i] = (unsigned)(R * g.lda + C) * 2u; voffB[i] = (unsigned)(Rb * K + C) * 2u; RA[i] = R; CA2[i] = (unsigned)C * 2u; }
    unsigned gcur[2][2] = {{0u, 0u}, {0u, 0u}}, gnxt[2][2] = {{0u, 0u}, {0u, 0u}};
#define PG8_GOFF(dst, u_) do { _Pragma("unroll") for (int h_ = 0; h_ < 2; ++h_) _Pragma("unroll") for (int i_ = 0; i_ < 2; ++i_) \
        dst[h_][i_] = (unsigned)g.src[(u_).pm * BM + h_ * HALF + RA[i_]] * (unsigned)(g.lda * 2) + CA2[i_]; } while (0)
#define PG8_STAGE_A(bufoff, gbase, h, nx) do { if constexpr (GATHER) { unsigned vs_[2] = {(nx) ? gnxt[h][0] : gcur[h][0], (nx) ? gnxt[h][1] : gcur[h][1]}; PG8_STAGE(bufoff, gbase, vs_); } \
        else { PG8_STAGE(bufoff, (gbase) + ((h) ? hstepA : 0), voffA); } } while (0)
    const size_t kstep = (size_t)(BK * 2);
    const size_t hstepA = (size_t)HALF * g.lda * 2, hstepB = (size_t)HALF * K * 2;
    const size_t tstepA = 2 * hstepA, tstepB = 2 * hstepB;
    const unsigned ldsw = (unsigned)wid * 1024u;
    const int aoff = lds_byte(wr * 64 + fr, fq * 8), boff = lds_byte(wc * 32 + fr, fq * 8);
#define PG8_SA(b, h) (((b) * 2 + (h)) * HTB)
#define PG8_SB(b, h) ((4 + (b) * 2 + (h)) * HTB)
#define PG8_STAGE(bufoff, gbase, voff) do { _Pragma("unroll") for (int _i = 0; _i < 2; ++_i) \
        __builtin_amdgcn_global_load_lds((const unsigned*)((const char*)(gbase) + (voff)[_i]), (PG8_LAS unsigned*)(lds + (bufoff) + ldsw + _i * 8192), 16, 0, 0); } while (0)
#define PG8_LDA(dst, b, h) do { _Pragma("unroll") for (int m = 0; m < 4; ++m) _Pragma("unroll") for (int k = 0; k < 2; ++k) dst[m][k] = *(const PG8_LAS bf16x8*)(lds + PG8_SA(b, h) + aoff + m * 2048 + k * 1024); } while (0)
#define PG8_LDB(dst, b, h) do { _Pragma("unroll") for (int n = 0; n < 2; ++n) _Pragma("unroll") for (int k = 0; k < 2; ++k) dst[n][k] = *(const PG8_LAS bf16x8*)(lds + PG8_SB(b, h) + boff + n * 2048 + k * 1024); } while (0)
#define PG8_MMA(ai, bj, At, Bt) do { __builtin_amdgcn_s_setprio(1); _Pragma("unroll") for (int m = 0; m < 4; ++m) _Pragma("unroll") for (int n = 0; n < 2; ++n) _Pragma("unroll") for (int k = 0; k < 2; ++k) \
        acc[ai][bj][m][n] = __builtin_amdgcn_mfma_f32_16x16x32_bf16(Bt[n][k], At[m][k], acc[ai][bj][m][n], 0, 0, 0); __builtin_amdgcn_s_setprio(0); } while (0)
#define PG8_WAIT_V(n) asm volatile("s_waitcnt vmcnt(" #n ")" ::: "memory")
#define PG8_WAIT_L(n) asm volatile("s_waitcnt lgkmcnt(" #n ")" ::: "memory")
#define PG8_BAR __builtin_amdgcn_s_barrier()
#define PG8_SCHED __builtin_amdgcn_sched_barrier(0)
    Unit cur, nxt; int ui = 0;
    if (!S.next(0, cur)) return;
    f32x4 acc[2][2][4][2];
#pragma unroll
    for (int a = 0; a < 2; ++a)
#pragma unroll
        for (int b = 0; b < 2; ++b)
#pragma unroll
            for (int m = 0; m < 4; ++m)
#pragma unroll
                for (int n = 0; n < 2; ++n) acc[a][b][m][n] = (f32x4){0.f, 0.f, 0.f, 0.f};
    bf16x8 At[4][2], B0[2][2], B1[2][2];
    const char* cA = (const char*)g.A + (GATHER ? (size_t)0 : (size_t)cur.pm * tstepA); const char* cB = (const char*)g.Bt + (size_t)cur.pn * tstepB;
    if constexpr (GATHER) PG8_GOFF(gcur, cur);
    S.a_ready(cur);
    if constexpr (SP2) {
        PG8_STAGE(PG8_SB(0, 0), cB, voffB); PG8_STAGE(PG8_SB(0, 1), cB + hstepB, voffB); PG8_STAGE_A(PG8_SA(0, 0), cA, 0, false); PG8_STAGE_A(PG8_SA(0, 1), cA, 1, false);
        if (wr == 1) PG8_BAR;
        PG8_WAIT_V(2); PG8_BAR;
        PG8_STAGE(PG8_SB(1, 0), cB + kstep, voffB); PG8_STAGE_A(PG8_SA(1, 0), cA + kstep, 0, false); PG8_STAGE(PG8_SB(1, 1), cB + hstepB + kstep, voffB);
        PG8_WAIT_V(6); PG8_BAR;
    } else {
        PG8_STAGE(PG8_SB(0, 0), cB, voffB); PG8_STAGE_A(PG8_SA(0, 0), cA, 0, false); PG8_STAGE(PG8_SB(0, 1), cB + hstepB, voffB); PG8_STAGE_A(PG8_SA(0, 1), cA, 1, false);
        if (wr == 1) PG8_BAR;
        PG8_WAIT_V(4); PG8_BAR;
        PG8_STAGE(PG8_SB(1, 0), cB + kstep, voffB); PG8_STAGE_A(PG8_SA(1, 0), cA + kstep, 0, false); PG8_STAGE(PG8_SB(1, 1), cB + hstepB + kstep, voffB);
        PG8_WAIT_V(6); PG8_BAR;
    }
    for (;;) {
        const bool has_next = S.next(ui + 1, nxt);
        const char* nA = (has_next && !GATHER) ? (const char*)g.A + (size_t)nxt.pm * tstepA : cA; const char* nB = has_next ? (const char*)g.Bt + (size_t)nxt.pn * tstepB : cB;
        if constexpr (GATHER) { if (has_next) PG8_GOFF(gnxt, nxt); else { _Pragma("unroll") for (int h_ = 0; h_ < 2; ++h_) { gnxt[h_][0] = gcur[h_][0]; gnxt[h_][1] = gcur[h_][1]; } } }
#pragma unroll 1
        for (int t = 0; t < nt; t += 2) {
            const bool last = (t == nt - 2);
            const char* a1 = cA + (size_t)(t + 1) * kstep;
            const char* a2 = last ? nA : cA + (size_t)(t + 2) * kstep; const char* b2 = last ? nB : cB + (size_t)(t + 2) * kstep;
            const char* a3 = a2 + kstep; const char* b3 = b2 + kstep;
            if (last && has_next) S.a_ready(nxt);
            if constexpr (SP2) {
            PG8_LDB(B0, 0, 0); PG8_LDB(B1, 0, 1); PG8_SCHED; PG8_LDA(At, 0, 0); PG8_STAGE_A(PG8_SA(1, 1), a1, 1, false);
            PG8_WAIT_V(8); PG8_WAIT_L(0); PG8_BAR; PG8_MMA(0, 0, At, B0); PG8_MMA(0, 1, At, B1); PG8_BAR; PG8_SCHED;
            PG8_LDA(At, 0, 1); PG8_STAGE(PG8_SB(0, 0), b2, voffB); PG8_STAGE(PG8_SB(0, 1), b2 + hstepB, voffB); PG8_STAGE_A(PG8_SA(0, 0), a2, 0, last);
            PG8_WAIT_V(8); PG8_WAIT_L(0); PG8_BAR; PG8_MMA(1, 0, At, B0); PG8_MMA(1, 1, At, B1); PG8_BAR; PG8_SCHED;
            PG8_LDB(B0, 1, 0); PG8_LDB(B1, 1, 1); PG8_SCHED; PG8_LDA(At, 1, 0); PG8_STAGE_A(PG8_SA(0, 1), a2, 1, last);
            PG8_WAIT_V(8); PG8_WAIT_L(0); PG8_BAR; PG8_MMA(0, 0, At, B0); PG8_MMA(0, 1, At, B1); PG8_BAR; PG8_SCHED;
            PG8_LDA(At, 1, 1); PG8_STAGE(PG8_SB(1, 0), b3, voffB); PG8_STAGE(PG8_SB(1, 1), b3 + hstepB, voffB); PG8_STAGE_A(PG8_SA(1, 0), a3, 0, last);
            PG8_WAIT_V(8); PG8_WAIT_L(0); PG8_BAR; PG8_MMA(1, 0, At, B0); PG8_MMA(1, 1, At, B1); PG8_BAR; PG8_SCHED;
            } else {
            PG8_LDB(B0, 0, 0); PG8_SCHED; PG8_LDA(At, 0, 0); PG8_STAGE_A(PG8_SA(1, 1), a1, 1, false);
            PG8_WAIT_L(8); PG8_BAR; PG8_WAIT_L(0); PG8_MMA(0, 0, At, B0); PG8_BAR; PG8_SCHED;
            PG8_LDB(B1, 0, 1); PG8_STAGE(PG8_SB(0, 0), b2, voffB);
            PG8_BAR; PG8_WAIT_L(0); PG8_MMA(0, 1, At, B1); PG8_BAR;
            PG8_LDA(At, 0, 1); PG8_STAGE_A(PG8_SA(0, 0), a2, 0, last);
            PG8_BAR; PG8_WAIT_L(0); PG8_MMA(1, 0, At, B0); PG8_BAR; PG8_SCHED;
            PG8_STAGE(PG8_SB(0, 1), b2 + hstepB, voffB);
            PG8_WAIT_V(6); PG8_BAR; PG8_MMA(1, 1, At, B1); PG8_BAR;
            PG8_LDB(B0, 1, 0); PG8_SCHED; PG8_LDA(At, 1, 0); PG8_STAGE_A(PG8_SA(0, 1), a2, 1, last);
            PG8_WAIT_L(8); PG8_BAR; PG8_WAIT_L(0); PG8_MMA(0, 0, At, B0); PG8_BAR; PG8_SCHED;
            PG8_LDB(B1, 1, 1); PG8_STAGE(PG8_SB(1, 0), b3, voffB);
            PG8_BAR; PG8_WAIT_L(0); PG8_MMA(0, 1, At, B1); PG8_BAR;
            PG8_LDA(At, 1, 1); PG8_STAGE_A(PG8_SA(1, 0), a3, 0, last);
            PG8_BAR; PG8_WAIT_L(0); PG8_MMA(1, 0, At, B0); PG8_BAR; PG8_SCHED;
            PG8_STAGE(PG8_SB(1, 1), b3 + hstepB, voffB);
            PG8_WAIT_V(6); PG8_BAR; PG8_MMA(1, 1, At, B1); PG8_BAR;
            }
        }
        if constexpr (ALIGN_EPI) { if (wr == 0) PG8_BAR; }
        if constexpr (!Epi::AFTER_DRAIN) { E(acc, cur, wr, wc, fr, fq); S.done(cur); }
        if (!has_next) break;
#pragma unroll
        for (int a = 0; a < 2; ++a)
#pragma unroll
            for (int b = 0; b < 2; ++b)
#pragma unroll
                for (int m = 0; m < 4; ++m)
#pragma unroll
                    for (int n = 0; n < 2; ++n) acc[a][b][m][n] = (f32x4){0.f, 0.f, 0.f, 0.f};
        cur = nxt; cA = nA; cB = nB; ++ui;
        if constexpr (GATHER) { _Pragma("unroll") for (int h_ = 0; h_ < 2; ++h_) { gcur[h_][0] = gnxt[h_][0]; gcur[h_][1] = gnxt[h_][1]; } }
        if constexpr (ALIGN_EPI) { if (wr == 1) PG8_BAR; }
    }
    PG8_WAIT_V(0);
    if constexpr (!ALIGN_EPI) { if (wr == 0) PG8_BAR; }
    PG8_BAR;
    if constexpr (Epi::AFTER_DRAIN) { E.fused(acc, cur, wr, wc, fr, fq, lds, wid, lane); S.done(cur); }
#undef PG8_SA
#undef PG8_GOFF
#undef PG8_STAGE_A
#undef PG8_SB
#undef PG8_STAGE
#undef PG8_LDA
#undef PG8_LDB
#undef PG8_MMA
#undef PG8_WAIT_V
#undef PG8_WAIT_L
#undef PG8_BAR
#undef PG8_SCHED
}
}

constexpr int NB = 16, SEQ = 4096, CTX = 256, TT = SEQ + CTX, M = NB * TT, D = 1024, NL = 4;
constexpr int NPJ = 2304, DPROJ = 2208;
constexpr int MS = 143360;
constexpr float EPS = 1e-6f, ALPHA = 1.6817928305074290f, LOG2E = 1.4426950408889634f;
constexpr int NWAVES = 8, NTHR = 512;
#ifndef MK_DEBUG
#define MK_DEBUG 0
#endif
#ifndef MK_TIME
#define MK_TIME 0
#endif
#ifndef MK_TMUL
#define MK_TMUL 1
#endif
#ifndef MK_VM
#define MK_VM 0
#endif
#ifndef MK_DUP
#define MK_DUP 0
#endif
#ifndef MK_MULTI
#define MK_MULTI 0
#endif
constexpr int NPHASE = 2 + 10 * NL;

constexpr size_t WS_CTL = 0, CTL_BYTES = 65536;
constexpr size_t WS_MODS = WS_CTL + CTL_BYTES;
constexpr size_t WS_T64 = WS_MODS + (size_t)NL * 17 * 6144 * 4;
constexpr size_t WS_T32 = WS_T64 + 8192;
constexpr size_t WS_RS = WS_T32 + 4096;
constexpr size_t WS_RT = WS_RS + (size_t)M * 8;
constexpr size_t WS_HIST = WS_RT + (size_t)M * 32;
constexpr size_t WS_XS = WS_HIST + 65536;
constexpr size_t WS_WIN = WS_XS + (size_t)M * D * 2;
constexpr size_t WS_WD = WS_WIN + (size_t)NPJ * D * 2;
constexpr size_t WS_WOUT = WS_WD + (size_t)1024 * 384 * 2;
constexpr size_t WS_WGU = WS_WOUT + (size_t)D * D * 2;
constexpr size_t WS_WDN = WS_WGU + (size_t)16 * 1024 * 1024 * 2;
constexpr size_t WS_HA = WS_WDN + (size_t)16 * 1024 * 512 * 2;
constexpr size_t WS_PB = WS_HA + (size_t)M * D * 2;
constexpr size_t WS_QD = WS_PB + (size_t)M * NPJ * 2;
constexpr size_t WS_KD = WS_QD + (size_t)M * 384 * 2;
constexpr size_t WS_VD = WS_KD + (size_t)M * 384 * 2;
constexpr size_t WS_ACT = WS_VD + (size_t)M * 256 * 2;
constexpr size_t WS_END = WS_ACT + (size_t)MS * 512 * 2;
static_assert(WS_END <= (size_t)1073741824, "d_ws map must fit 1 GiB");
static_assert((size_t)M * NPJ * 2 >= (size_t)MS * D * 2 && (size_t)M * NPJ * 2 >= (size_t)M * D * 4, "region PB overlays");
constexpr int CW_BAR = 0;
constexpr int CW_QUEUE = 4096;

constexpr int RING_BYTES = 131072, MISC_OFF = RING_BYTES, LDS_BYTES = 147456;
constexpr int MI_BAR = 0, MI_Q = 4, MI_TOT = 16, MI_BASE = 32, MI_PST = 48, MI_LH = 80;

#define GAS __attribute__((address_space(1)))
#define LAS __attribute__((address_space(3)))
typedef unsigned short bf16;
typedef unsigned v4u __attribute__((ext_vector_type(4)));
typedef unsigned v2u __attribute__((ext_vector_type(2)));
typedef float f32x4 __attribute__((ext_vector_type(4)));
typedef float f32x2 __attribute__((ext_vector_type(2)));
typedef short bf16x8 __attribute__((ext_vector_type(8)));
typedef float f32x16 __attribute__((ext_vector_type(16)));
typedef short v4i16 __attribute__((ext_vector_type(4)));

__device__ __forceinline__ unsigned f2bf(float f) { unsigned u = __builtin_bit_cast(unsigned, f); return (u + 0x7fffu + ((u >> 16) & 1u)) >> 16; }
__device__ __forceinline__ unsigned pk2(float lo, float hi) { return f2bf(lo) | (f2bf(hi) << 16); }
__device__ __forceinline__ float bflo(unsigned w) { return __builtin_bit_cast(float, w << 16); }
__device__ __forceinline__ float bfhi(unsigned w) { return __builtin_bit_cast(float, w & 0xffff0000u); }
__device__ __forceinline__ void unpack8(v4u w, float (&f)[8]) { f[0] = bflo(w.x); f[1] = bfhi(w.x); f[2] = bflo(w.y); f[3] = bfhi(w.y); f[4] = bflo(w.z); f[5] = bfhi(w.z); f[6] = bflo(w.w); f[7] = bfhi(w.w); }
__device__ __forceinline__ v4u pack8(const float (&f)[8]) { v4u w; w.x = pk2(f[0], f[1]); w.y = pk2(f[2], f[3]); w.z = pk2(f[4], f[5]); w.w = pk2(f[6], f[7]); return w; }
__device__ __forceinline__ float wave_sum(float v) {
    int x = __builtin_bit_cast(int, v);
#define WS_DPP(ctrl, rmask) v += __builtin_bit_cast(float, __builtin_amdgcn_update_dpp(0, x, ctrl, rmask, 0xf, true)); x = __builtin_bit_cast(int, v)
    WS_DPP(0xB1, 0xf);
    WS_DPP(0x4E, 0xf);
    WS_DPP(0x141, 0xf);
    WS_DPP(0x140, 0xf);
    WS_DPP(0x142, 0xa);
    WS_DPP(0x143, 0xc);
#undef WS_DPP
    return __builtin_bit_cast(float, __builtin_amdgcn_readlane(__builtin_bit_cast(int, v), 63));
}

#define XB_TMO      128
#define XB_XCNT(j)  (256  + 64 * (j))
#define XB_XSUB(j)  (1280 + 64 * (j))
#define XB_XGEN(j)  (2304 + 64 * (j))
#define XB_TOP      3328
#define XB_TOPGEN   3392
#define XCD_BAR_WORDS 3456
#define XB_SPIN_CAP (1u << 22)
__device__ __forceinline__ unsigned xb_ld(unsigned* p)              { return __hip_atomic_load(p, __ATOMIC_RELAXED, __HIP_MEMORY_SCOPE_AGENT); }
__device__ __forceinline__ unsigned xb_add(unsigned* p, unsigned v) { return __hip_atomic_fetch_add(p, v, __ATOMIC_RELAXED, __HIP_MEMORY_SCOPE_AGENT); }
__device__ __forceinline__ unsigned xb_xcc_id() { return (unsigned)__builtin_amdgcn_s_getreg((3 << 11) | 20) & 0xFu; }
#define XB_SPIN(cond, bar) do { unsigned _sp = 0; while (cond) { __builtin_amdgcn_s_sleep(1); \
    if ((++_sp & 255u) == 0u) { if (xb_ld(&(bar)[XB_TMO])) break; if (_sp > XB_SPIN_CAP) { atomicAdd(&(bar)[XB_TMO], 1u); break; } } } } while (0)
struct XcdBarrier { unsigned* bar; unsigned x; volatile LAS unsigned* st; };
__device__ __forceinline__ XcdBarrier xcd_barrier_post(unsigned* bar, volatile LAS unsigned* st) {
    XcdBarrier b; b.bar = bar; b.x = xb_xcc_id(); b.st = st;
    if (threadIdx.x == 0) (void)xb_add(&bar[XB_XCNT(b.x)], 1u);
    return b;
}
__device__ __forceinline__ void xcd_barrier_complete(unsigned* bar, unsigned x, unsigned& nloc, unsigned& nx) {
    const unsigned G = gridDim.x * gridDim.y * gridDim.z;
    unsigned sum, cnt, mine, sp = 0u;
    for (;;) {
        sum = 0u; cnt = 0u; mine = 0u;
#pragma unroll
        for (unsigned j = 0; j < 16; ++j) { const unsigned c = xb_ld(&bar[XB_XCNT(j)]); sum += c; cnt += (c > 0u) ? 1u : 0u; mine = (j == x) ? c : mine; }
        if (sum == G) break;
        __builtin_amdgcn_s_sleep(1);
        if ((++sp & 255u) == 0u) { if (xb_ld(&bar[XB_TMO])) break; if (sp > XB_SPIN_CAP) { atomicAdd(&bar[XB_TMO], 1u); break; } }
    }
    nloc = mine > 0u ? mine : 1u; nx = cnt > 0u ? cnt : 1u;
}
__device__ __forceinline__ void xcd_barrier(const XcdBarrier& b) {
    asm volatile("s_waitcnt vmcnt(0)" ::: "memory");
    __syncthreads();
    if (threadIdx.x == 0) {
        unsigned* bar = b.bar;
        __builtin_amdgcn_s_waitcnt(0);
        unsigned nloc = b.st[0], nx = b.st[1];
        if (nloc == 0u) { xcd_barrier_complete(bar, b.x, nloc, nx); b.st[0] = nloc; b.st[1] = nx; }
        const unsigned old = xb_add(&bar[XB_XSUB(b.x)], 1u);
        const unsigned gen = old / nloc;
        if (old + 1u == (gen + 1u) * nloc) {
            __builtin_amdgcn_fence(__ATOMIC_RELEASE, "agent");
            asm volatile("s_waitcnt vmcnt(0)" ::: "memory");
            const unsigned og = xb_add(&bar[XB_TOP], 1u);
            const unsigned tg = og / nx;
            if (og + 1u == (tg + 1u) * nx) xb_add(&bar[XB_TOPGEN], 1u);
            else XB_SPIN(xb_ld(&bar[XB_TOPGEN]) == tg, bar);
            __builtin_amdgcn_fence(__ATOMIC_ACQUIRE, "agent");
            xb_add(&bar[XB_XGEN(b.x)], 1u);
            asm volatile("s_waitcnt vmcnt(0)" ::: "memory");
        } else {
            XB_SPIN(xb_ld(&bar[XB_XGEN(b.x)]) == gen, bar);
            __builtin_amdgcn_fence(__ATOMIC_ACQUIRE, "agent");
            asm volatile("s_waitcnt vmcnt(0)" ::: "memory");
        }
    }
    __syncthreads();
}

struct Args { const float* in[27]; float* out; unsigned char* ws; int ph_lo, ph_hi; };
enum { I_X = 0, I_C, I_CTX, I_CCTX, I_WADA, I_BADA, I_WIN, I_NABIAS, I_GQG, I_GKG, I_SINK, I_MQG, I_WQB, I_MKVG, I_WKVB, I_WOUT, I_LN1G, I_LN1B, I_RGW, I_RGB, I_REW, I_REB, I_WG, I_WU, I_WDN, I_LN2G, I_LN2B };

struct Frame {
    LAS unsigned char* lds; volatile LAS unsigned* MISC;
    int tid, lane, wave, G, gw, ngw, bid;
    GAS unsigned char* ws;
};
__device__ __forceinline__ int opaque_tid() { int t = threadIdx.x; asm volatile("" : "+v"(t)); return t; }
__device__ __forceinline__ int opaque_s(int x) { asm volatile("" : "+s"(x)); return x; }
constexpr int PTAB_OFF = MISC_OFF + 2048, I_OUT = 27;
__device__ __forceinline__ GAS unsigned char* ptab_get(const Frame& F, int i) {
    const LAS unsigned* t = (const LAS unsigned*)(F.lds + PTAB_OFF) + 2 * i;
    const unsigned lo = __builtin_amdgcn_readfirstlane(t[0]), hi = __builtin_amdgcn_readfirstlane(t[1]);
    return (GAS unsigned char*)(((unsigned long long)hi << 32) | lo);
}
#define INP(i) ((const float*)ptab_get(F, (i)))
__device__ __forceinline__ Frame make_frame(GAS unsigned char* ws) {
    extern __shared__ __attribute__((aligned(16))) unsigned char lds_raw[];
    Frame F;
    F.lds = (LAS unsigned char*)lds_raw; F.MISC = (volatile LAS unsigned*)(F.lds + MISC_OFF);
    F.tid = opaque_tid(); F.lane = F.tid & 63; F.wave = __builtin_amdgcn_readfirstlane(F.tid >> 6);
    F.G = opaque_s((int)gridDim.x); F.bid = opaque_s((int)blockIdx.x); F.gw = F.bid * NWAVES + F.wave; F.ngw = F.G * NWAVES;
    { unsigned long long w = (unsigned long long)ws; asm volatile("" : "+s"(w)); F.ws = (GAS unsigned char*)w; }
    return F;
}
typedef _Float16 f16x4 __attribute__((ext_vector_type(4)));
struct RowPtrs { const float* x; const float* ctx; float* out; _Float16* xs; };
__device__ __forceinline__ RowPtrs row_ptrs(const Frame& F) { RowPtrs p; p.x = INP(I_X); p.ctx = INP(I_CTX); p.out = (float*)ptab_get(F, I_OUT); p.xs = (_Float16*)(F.ws + WS_XS); return p; }
__device__ __forceinline__ const float* xin_row(const RowPtrs& P, int r) {
    const int b = r / TT, t = r - b * TT;
    return t < SEQ ? P.x + ((size_t)b * SEQ + t) * D : P.ctx + ((size_t)b * CTX + (t - SEQ)) * D;
}
__device__ __forceinline__ float* out_row(const RowPtrs& P, int r) { const int b = r / TT, t = r - b * TT; return P.out + ((size_t)b * SEQ + t) * D; }
__device__ __forceinline__ void ld16h(const _Float16* p, int lane, float (&v)[16]) {
    const f16x4* q = (const f16x4*)p + lane;
#pragma unroll
    for (int g = 0; g < 4; ++g) { const f32x4 f = __builtin_convertvector(__builtin_nontemporal_load(q + 64 * g), f32x4); v[4 * g] = f.x; v[4 * g + 1] = f.y; v[4 * g + 2] = f.z; v[4 * g + 3] = f.w; }
}
__device__ __forceinline__ void st16h(_Float16* p, int lane, const float (&v)[16]) {
    f16x4* q = (f16x4*)p + lane;
#pragma unroll
    for (int g = 0; g < 4; ++g) __builtin_nontemporal_store(__builtin_convertvector((f32x4){v[4 * g], v[4 * g + 1], v[4 * g + 2], v[4 * g + 3]}, f16x4), q + 64 * g);
}
__device__ __forceinline__ void ld16(const float* p, int lane, float (&v)[16]) {
    const f32x4* q = (const f32x4*)p + lane;
    const f32x4 a = q[0], b = q[64], c = q[128], d = q[192];
    v[0] = a.x; v[1] = a.y; v[2] = a.z; v[3] = a.w; v[4] = b.x; v[5] = b.y; v[6] = b.z; v[7] = b.w;
    v[8] = c.x; v[9] = c.y; v[10] = c.z; v[11] = c.w; v[12] = d.x; v[13] = d.y; v[14] = d.z; v[15] = d.w;
}
__device__ __forceinline__ void st16(float* p, int lane, const float (&v)[16]) {
    f32x4* q = (f32x4*)p + lane;
    q[0] = (f32x4){v[0], v[1], v[2], v[3]}; q[64] = (f32x4){v[4], v[5], v[6], v[7]};
    q[128] = (f32x4){v[8], v[9], v[10], v[11]}; q[192] = (f32x4){v[12], v[13], v[14], v[15]};
}
__device__ __forceinline__ void ld16nt(const float* p, int lane, float (&v)[16]) {
    const f32x4* q = (const f32x4*)p + lane;
    const f32x4 a = __builtin_nontemporal_load(q), b = __builtin_nontemporal_load(q + 64), c = __builtin_nontemporal_load(q + 128), d = __builtin_nontemporal_load(q + 192);
    v[0] = a.x; v[1] = a.y; v[2] = a.z; v[3] = a.w; v[4] = b.x; v[5] = b.y; v[6] = b.z; v[7] = b.w;
    v[8] = c.x; v[9] = c.y; v[10] = c.z; v[11] = c.w; v[12] = d.x; v[13] = d.y; v[14] = d.z; v[15] = d.w;
}
__device__ __forceinline__ void st16nt(float* p, int lane, const float (&v)[16]) {
    f32x4* q = (f32x4*)p + lane;
    __builtin_nontemporal_store((f32x4){v[0], v[1], v[2], v[3]}, q); __builtin_nontemporal_store((f32x4){v[4], v[5], v[6], v[7]}, q + 64);
    __builtin_nontemporal_store((f32x4){v[8], v[9], v[10], v[11]}, q + 128); __builtin_nontemporal_store((f32x4){v[12], v[13], v[14], v[15]}, q + 192);
}
__device__ __forceinline__ void unpack16(const v2u (&w)[4], float (&v)[16]) {
#pragma unroll
    for (int g = 0; g < 4; ++g) { v[4 * g] = bflo(w[g].x); v[4 * g + 1] = bfhi(w[g].x); v[4 * g + 2] = bflo(w[g].y); v[4 * g + 3] = bfhi(w[g].y); }
}
__device__ __forceinline__ void ld16bf_raw(const bf16* p, int lane, v2u (&w)[4]) {
    const v2u* q = (const v2u*)p + lane; w[0] = q[0]; w[1] = q[64]; w[2] = q[128]; w[3] = q[192];
}
__device__ __forceinline__ void ld16bf_raw_nt(const bf16* p, int lane, v2u (&w)[4]) {
    const v2u* q = (const v2u*)p + lane; w[0] = __builtin_nontemporal_load(q); w[1] = __builtin_nontemporal_load(q + 64); w[2] = __builtin_nontemporal_load(q + 128); w[3] = __builtin_nontemporal_load(q + 192);
}
__device__ __forceinline__ void ld16bf(const bf16* p, int lane, float (&v)[16]) { v2u w[4]; ld16bf_raw(p, lane, w); unpack16(w, v); }
__device__ __forceinline__ void ld16bf_nt(const bf16* p, int lane, float (&v)[16]) { v2u w[4]; ld16bf_raw_nt(p, lane, w); unpack16(w, v); }
__device__ __forceinline__ void st16bf(bf16* p, int lane, const float (&v)[16]) {
    v2u* q = (v2u*)p + lane;
#pragma unroll
    for (int g = 0; g < 4; ++g) { v2u w; w.x = pk2(v[4 * g], v[4 * g + 1]); w.y = pk2(v[4 * g + 2], v[4 * g + 3]); q[64 * g] = w; }
}
__device__ __forceinline__ void ln16(float (&v)[16]) {
    float s = 0.f;
#pragma unroll
    for (int i = 0; i < 16; ++i) s += v[i];
    const float mean = wave_sum(s) * (1.0f / D); float q = 0.f;
#pragma unroll
    for (int i = 0; i < 16; ++i) { v[i] -= mean; q += v[i] * v[i]; }
    const float rstd = 1.0f / sqrtf(wave_sum(q) * (1.0f / D) + EPS);
#pragma unroll
    for (int i = 0; i < 16; ++i) v[i] *= rstd;
}

__device__ __forceinline__ int rows_per_wave(int ngw) {
    int rpw = (M + ngw - 1) / ngw;
    if (!((SEQ % rpw) % 4 == 0 && (TT % rpw) == 0 && (rpw % 2) == 0)) rpw = (rpw + 3) & ~3;
    return rpw;
}
template <int TYPE>
__device__ __forceinline__ float conv_src(const float* p0, const float* p1, const float* g0, const float* g1, int l, int k, int n) {
    if (TYPE == 0) return n < DPROJ ? p0[((size_t)l * D + k) * DPROJ + n] : 0.f;
    if (TYPE == 1) { if (n < 384) return k < 256 ? g0[l * 256 + k] * p0[((size_t)l * 256 + k) * 384 + n] : 0.f;
                     if (n < 896) return k >= 256 ? g1[l * 128 + (k - 256)] * p1[((size_t)l * 128 + (k - 256)) * 512 + (n - 384)] : 0.f;
                     return 0.f; }
    if (TYPE == 2) return p0[((size_t)l * D + k) * D + n];
    if (TYPE == 3) { const int e = n >> 10, nn = n & 1023, q = nn >> 3, j = nn & 7;
                     return j < 4 ? p0[(((size_t)l * 16 + e) * D + k) * 512 + 4 * q + j] : p1[(((size_t)l * 16 + e) * D + k) * 512 + 4 * q + (j - 4)]; }
    { const int e = n >> 10, nn = n & 1023; return p0[(((size_t)l * 16 + e) * 512 + k) * D + nn]; }
}
template <int TYPE>
__device__ __forceinline__ void conv_item(const Frame& F, int l, int item, LAS float* scr) {
    constexpr int Nd = TYPE == 0 ? NPJ : TYPE == 1 ? 1024 : TYPE == 2 ? 1024 : 16384, Kd = TYPE == 1 ? 384 : TYPE == 4 ? 512 : 1024;
    bf16* dst = (bf16*)(F.ws + (TYPE == 0 ? WS_WIN : TYPE == 1 ? WS_WD : TYPE == 2 ? WS_WOUT : TYPE == 3 ? WS_WGU : WS_WDN));
    const float* p0 = INP(TYPE == 0 ? I_WIN : TYPE == 1 ? I_WQB : TYPE == 2 ? I_WOUT : TYPE == 3 ? I_WG : I_WDN);
    const float* p1 = INP(TYPE == 1 ? I_WKVB : I_WU); const float* g0 = INP(I_MQG); const float* g1 = INP(I_MKVG);
    constexpr int nblk = Nd / 32; const int kb = item / nblk, nb = item - kb * nblk, k0 = 64 * kb, n0 = 32 * nb, lane = F.lane;
#pragma unroll
    for (int i = 0; i < 32; ++i) { const int kk = 2 * i + (lane >> 5); scr[kk * 33 + (lane & 31)] = conv_src<TYPE>(p0, p1, g0, g1, l, k0 + kk, n0 + (lane & 31)); }
    asm volatile("s_waitcnt lgkmcnt(0)" ::: "memory");
    const int c = lane & 7;
#pragma unroll
    for (int j = 0; j < 4; ++j) { const int n = (lane >> 3) + 8 * j; const LAS float* s = scr + (8 * c) * 33 + n;
        v4u o; o.x = pk2(s[0 * 33], s[1 * 33]); o.y = pk2(s[2 * 33], s[3 * 33]); o.z = pk2(s[4 * 33], s[5 * 33]); o.w = pk2(s[6 * 33], s[7 * 33]);
        *(v4u*)(dst + (size_t)(n0 + n) * Kd + k0 + 8 * c) = o; }
    asm volatile("s_waitcnt lgkmcnt(0)" ::: "memory");
}
__device__ __forceinline__ void phase_prologue(const Frame& F) {
    {
        LAS float* sv = (LAS float*)F.lds;
        LAS float* red = (LAS float*)(F.lds + 17 * 1024 * 4);
        float* mods = (float*)(F.ws + WS_MODS);
        for (int u = F.bid; u < NL * 48; u += F.G) {
            const int l = u / 48, cc = u - l * 48;
            const float* pc = INP(I_C); const float* pcc = INP(I_CCTX);
            for (int i = F.tid; i < 17 * 1024; i += NTHR) { const int mr = i >> 10, k = i & 1023; const float c = mr < 16 ? pc[mr * 1024 + k] : pcc[k]; sv[i] = c / (1.0f + expf(-c)); }
            __syncthreads();
            const int col = F.tid & 127, kg = F.tid >> 7;
            float acc[17];
#pragma unroll
            for (int mr = 0; mr < 17; ++mr) acc[mr] = 0.f;
            const float* w = INP(I_WADA) + ((size_t)l * 1024 + kg * 256) * 6144 + cc * 128 + col;
            for (int k4 = 0; k4 < 256; k4 += 4) {
                const float w0 = w[(size_t)(k4 + 0) * 6144], w1 = w[(size_t)(k4 + 1) * 6144], w2 = w[(size_t)(k4 + 2) * 6144], w3 = w[(size_t)(k4 + 3) * 6144];
#pragma unroll
                for (int mr = 0; mr < 17; ++mr) { const f32x4 s = *(const LAS f32x4*)(sv + mr * 1024 + kg * 256 + k4); acc[mr] += (s.x * w0 + s.y * w1) + (s.z * w2 + s.w * w3); }
            }
#pragma unroll
            for (int mr = 0; mr < 17; ++mr) red[(kg * 17 + mr) * 128 + col] = acc[mr];
            __syncthreads();
            const float* bada = INP(I_BADA);
            for (int i = F.tid; i < 17 * 128; i += NTHR) { const int mr = i >> 7, c = i & 127;
                const float s = (red[(0 * 17 + mr) * 128 + c] + red[(1 * 17 + mr) * 128 + c]) + (red[(2 * 17 + mr) * 128 + c] + red[(3 * 17 + mr) * 128 + c]);
                mods[((size_t)l * 17 + mr) * 6144 + cc * 128 + c] = s + bada[l * 6144 + cc * 128 + c]; }
            __syncthreads();
        }
    }
    {
        float* t64 = (float*)(F.ws + WS_T64); float* t32 = (float*)(F.ws + WS_T32);
        for (int i = F.bid * NTHR + F.tid; i < 64 * 16 + 64 * 8; i += F.G * NTHR) {
            if (i < 1024) { const int p = i >> 4, k = i & 15; const float fr = powf(10000.0f, -(float)k / 16.0f), ang = (float)p * fr; t64[2 * i] = cosf(ang); t64[2 * i + 1] = sinf(ang); }
            else { const int j = i - 1024, p = j >> 3, k = j & 7; const float fr = powf(10000.0f, -(float)k / 8.0f), ang = (float)p * fr; t32[2 * j] = cosf(ang); t32[2 * j + 1] = sinf(ang); }
        }
    }
}
__device__ __forceinline__ void convert_layer_weights(const Frame& F, int l) {
    {
        LAS float* scr = (LAS float*)(F.lds + F.wave * 8448);
        constexpr int I0 = 1152, I1 = 192, I2 = 512, I3 = 8192, I4 = 4096, IL = I0 + I1 + I2 + I3 + I4;
        for (int r0_ = F.gw; r0_ < IL; r0_ += F.ngw) {
            int r = r0_;
            if (r < I0) { conv_item<0>(F, l, r, scr); continue; } r -= I0;
            if (r < I1) { conv_item<1>(F, l, r, scr); continue; } r -= I1;
            if (r < I2) { conv_item<2>(F, l, r, scr); continue; } r -= I2;
            if (r < I3) { conv_item<3>(F, l, r, scr); continue; } r -= I3;
            conv_item<4>(F, l, r, scr);
        }
    }
}

__device__ __forceinline__ void phase_ln(const Frame& F, int l) {
    if (l < NL) convert_layer_weights(F, l);
    constexpr int NR = 4;
    const float* mods = (const float*)(F.ws + WS_MODS); bf16* HA = (bf16*)(F.ws + WS_HA);
    const bf16* Y = (const bf16*)(F.ws + WS_PB); const unsigned* RT = (const unsigned*)(F.ws + WS_RT);
    const int lane = F.lane; const RowPtrs RP = row_ptrs(F);
    const float* ln2g = INP(I_LN2G) + (l > 0 ? l - 1 : 0) * D; const float* ln2b = INP(I_LN2B) + (l > 0 ? l - 1 : 0) * D;
    const int rpw = rows_per_wave(F.ngw), rbeg = F.gw * rpw, rend = min(M, rbeg + rpw);
    float g2[16]; int cur_mr = -1;
    float alpha_l = ALPHA; asm volatile("" : "+v"(alpha_l));
    for (int r0 = rbeg; r0 < rend; r0 += NR) {
        float v[NR][16]; v4u rt[NR]; v2u ya[NR][4], yb[NR][4]; bool act[NR];
        const int b0 = r0 / TT, t0 = r0 - b0 * TT; const bool lat = t0 < SEQ; const int mr = lat ? b0 : 16;
        if (l == NL && !lat) continue;
#pragma unroll
        for (int u = 0; u < NR; ++u) {
            const int r = r0 + u; act[u] = r < rend; const int rc = act[u] ? r : r0;
            if (l == 0) ld16nt(xin_row(RP, rc), lane, v[u]); else ld16h(RP.xs + (size_t)rc * D, lane, v[u]);
            rt[u] = *(const v4u*)(RT + (size_t)rc * 8 + 4);
        }
        if (mr != cur_mr) { if (l > 0) ld16(mods + ((size_t)(l - 1) * 17 + mr) * 6144 + 5120, lane, g2); cur_mr = mr; }
        if (l > 0) {
#pragma unroll
            for (int u = 0; u < NR; ++u) { ld16bf_raw_nt(Y + (size_t)rt[u].z * D, lane, ya[u]); ld16bf_raw_nt(Y + (size_t)rt[u].w * D, lane, yb[u]); }
#pragma unroll
            for (int u = 0; u < NR; ++u) {
                float f0[16], f1[16], gg[16], bb[16];
                const float w0 = __uint_as_float(rt[u].x), w1 = __uint_as_float(rt[u].y);
                unpack16(ya[u], f0); unpack16(yb[u], f1);
#pragma unroll
                for (int i = 0; i < 16; ++i) v[u][i] = alpha_l * v[u][i] + g2[i] * (w0 * f0[i] + w1 * f1[i]);
                ld16(ln2g, lane, gg); ld16(ln2b, lane, bb);
                ln16(v[u]);
#pragma unroll
                for (int i = 0; i < 16; ++i) v[u][i] = v[u][i] * gg[i] + bb[i];
                if (act[u]) { if (l == NL) st16nt(out_row(RP, r0 + u), lane, v[u]); else st16h(RP.xs + (size_t)(r0 + u) * D, lane, v[u]); }
            }
        }
        if (l < NL) {
            float sh[16], sc[16]; ld16(mods + ((size_t)l * 17 + mr) * 6144, lane, sh); ld16(mods + ((size_t)l * 17 + mr) * 6144 + 1024, lane, sc);
#pragma unroll
            for (int u = 0; u < NR; ++u) {
                ln16(v[u]);
#pragma unroll
                for (int i = 0; i < 16; ++i) v[u][i] = v[u][i] * (1.0f + sc[i]) + sh[i];
                if (act[u]) st16bf(HA + (size_t)(r0 + u) * D, lane, v[u]);
            }
        }
    }
}

__device__ __forceinline__ void rope8(float (&f)[8], const float (&p)[8], const float* cs, bool first) {
    const f32x4* c4 = (const f32x4*)cs;
#pragma unroll
    for (int q = 0; q < 4; ++q) { const f32x4 t = c4[q];
        f[2 * q] = first ? f[2 * q] * t.x - p[2 * q] * t.y : p[2 * q] * t.y + f[2 * q] * t.x;
        f[2 * q + 1] = first ? f[2 * q + 1] * t.z - p[2 * q + 1] * t.w : p[2 * q + 1] * t.w + f[2 * q + 1] * t.z; }
}
__device__ __forceinline__ void phase_post(const Frame& F, int l) {
    constexpr int NR = 4;
    bf16* P = (bf16*)(F.ws + WS_PB); bf16* KD = (bf16*)(F.ws + WS_KD);
    const float* t64 = (const float*)(F.ws + WS_T64); const float* t32 = (const float*)(F.ws + WS_T32);
    const int lane = F.lane; const float* gains = (lane < 32 ? INP(I_GQG) : INP(I_GKG)) + l * 64;
    const int j = lane & 7, jj = lane & 3;
    float gn[8];
#pragma unroll
    for (int i = 0; i < 8; ++i) gn[i] = gains[j * 8 + i];
    for (int r0 = F.gw; r0 < M; r0 += NR * F.ngw) {
        v4u w0[NR], w1[NR], w2[NR]; int rr[NR]; bool act[NR];
#pragma unroll
        for (int u = 0; u < NR; ++u) { const int r = r0 + u * F.ngw; act[u] = r < M; rr[u] = act[u] ? r : r0; const bf16* prow = P + (size_t)rr[u] * NPJ;
            w0[u] = *((const v4u*)(prow + 768) + lane); w1[u] = *((const v4u*)(prow + 1280) + lane); w2[u] = *((const v4u*)(prow + 1792) + lane); }
#pragma unroll
        for (int u = 0; u < NR; ++u) {
            const int r = rr[u]; const int b = r / TT, t = r - b * TT; const bool lat = t < SEQ; const int gr = (t >> 6) & 63, gc = t & 63;
            bf16* prow = P + (size_t)r * NPJ;
            const float* cs64 = t64 + ((size_t)((j < 4 ? gr : gc) * 16 + (j & 1) * 8)) * 2;
            {
                float f[8]; unpack8(w0[u], f);
                float ss = 0.f;
#pragma unroll
                for (int i = 0; i < 8; ++i) ss += f[i] * f[i];
                ss += __shfl_xor(ss, 1); ss += __shfl_xor(ss, 2); ss += __shfl_xor(ss, 4);
                const float rs = 1.0f / sqrtf(ss * (1.0f / 64.0f) + EPS);
#pragma unroll
                for (int i = 0; i < 8; ++i) f[i] = f[i] * rs * gn[i];
                float p[8];
#pragma unroll
                for (int i = 0; i < 8; ++i) p[i] = __shfl_xor(f[i], 2);
                if (lat) rope8(f, p, cs64, (j & 2) == 0);
                if (lane < 48 && act[u]) *((v4u*)(prow + 768) + lane) = pack8(f);
            }
            {
                float f[8]; unpack8(w1[u], f);
                float p[8];
#pragma unroll
                for (int i = 0; i < 8; ++i) p[i] = __shfl_xor(f[i], 2);
                rope8(f, p, cs64, (j & 2) == 0);
                if (lat && lane < 48 && act[u]) *((v4u*)(prow + 1280) + lane) = pack8(f);
            }
            {
                float f[8]; unpack8(w2[u], f);
                float ss = 0.f;
#pragma unroll
                for (int i = 0; i < 8; ++i) ss += f[i] * f[i];
                ss += __shfl_xor(ss, 1); ss += __shfl_xor(ss, 2); ss += __shfl_xor(ss, 4); ss += __shfl_xor(ss, 8);
                const float s32 = ss + __shfl_xor(ss, 16);
                const float rn = lane < 32 ? 1.0f / sqrtf(s32 * (1.0f / 256.0f) + EPS) : 1.0f / sqrtf(ss * (1.0f / 128.0f) + EPS);
                if (lane < 48 && act[u]) { float fn[8];
#pragma unroll
                    for (int i = 0; i < 8; ++i) fn[i] = f[i] * rn;
                    *((v4u*)(prow + 1792) + lane) = pack8(fn); }
                float p[8];
#pragma unroll
                for (int i = 0; i < 8; ++i) p[i] = __shfl_xor(f[i], 1);
                if (lat) rope8(f, p, t32 + ((size_t)((jj < 2 ? gr : gc) * 8)) * 2, (jj & 1) == 0);
                if (lane >= 48 && lane < 52 && act[u]) { const v4u o = pack8(f);
#pragma unroll
                    for (int h = 0; h < 4; ++h) *(v4u*)(KD + (size_t)r * 384 + h * 96 + 64 + 8 * jj) = o; }
            }
        }
    }
}

__device__ __forceinline__ void phase_route(const Frame& F, int l) {
    const float* mods = (const float*)(F.ws + WS_MODS); bf16* HA = (bf16*)(F.ws + WS_HA);
    const bf16* MIX = (const bf16*)(F.ws + WS_PB); unsigned* RT = (unsigned*)(F.ws + WS_RT); int* HIST = (int*)(F.ws + WS_HIST);
    LAS float* WR = (LAS float*)F.lds;
    { const float* rgw = INP(I_RGW); const float* rew = INP(I_REW);
      for (int i = F.tid; i < 20 * 1024; i += NTHR) { const int jx = i >> 10, k = i & 1023;
        WR[i] = jx < 4 ? rgw[((size_t)l * D + k) * 4 + jx] : rew[((size_t)l * D + k) * 16 + (jx - 4)]; } }
    if (F.tid < 16) F.MISC[MI_LH + F.tid] = 0u;
    __syncthreads();
    LAS float* bias = (LAS float*)(F.lds + 20 * 1024 * 4);
    if (F.tid < 20) bias[F.tid] = F.tid < 4 ? INP(I_RGB)[l * 4 + F.tid] : INP(I_REB)[l * 16 + (F.tid - 4)];
    __syncthreads();
    const RowPtrs RP = row_ptrs(F);
    LAS float* LNG = (LAS float*)(F.lds + 20 * 1024 * 4 + 128);
    { const float* ln1g = INP(I_LN1G) + l * D; const float* ln1b = INP(I_LN1B) + l * D;
      for (int i = F.tid; i < 1024; i += NTHR) { LNG[i] = ln1g[i]; LNG[1024 + i] = ln1b[i]; } }
    __syncthreads();
    constexpr int NR = 2;
    const LAS unsigned char* wbase = (const LAS unsigned char*)WR + F.lane * 16; asm volatile("" : "+v"(wbase));
    const LAS unsigned char* lbase = (const LAS unsigned char*)LNG + F.lane * 16; asm volatile("" : "+v"(lbase));
#define RT_W4(base_, off_) (*(const LAS f32x4*)((base_) + (off_)))
    const int rpw = rows_per_wave(F.ngw), rbeg = F.gw * rpw, rend = min(M, rbeg + rpw);
    float g1[16], sh[16], sc[16]; int cur_mr = -1;
    float alpha_l = ALPHA; asm volatile("" : "+v"(alpha_l));
    v4u rx[NR][4]; v2u rm[NR][4];
#define RT_ISSUE(r0_) do { _Pragma("unroll") for (int u = 0; u < NR; ++u) { const int r_ = (r0_) + u, rc_ = r_ < rend ? r_ : (r0_); \
        if (l == 0) { const v4u* q_ = (const v4u*)xin_row(RP, rc_) + F.lane; _Pragma("unroll") for (int g = 0; g < 4; ++g) rx[u][g] = __builtin_nontemporal_load(q_ + 64 * g); } \
        else { const v2u* q_ = (const v2u*)(RP.xs + (size_t)rc_ * D) + F.lane; _Pragma("unroll") for (int g = 0; g < 4; ++g) { const v2u t_ = __builtin_nontemporal_load(q_ + 64 * g); rx[u][g].x = t_.x; rx[u][g].y = t_.y; } } \
        ld16bf_raw_nt(MIX + (size_t)rc_ * D, F.lane, rm[u]); } } while (0)
    if (rbeg < rend) RT_ISSUE(rbeg);
    for (int r0 = rbeg; r0 < rend; r0 += NR) {
        float v[NR][16]; int rr[NR]; bool act[NR];
        { const int b = r0 / TT, t = r0 - b * TT, mr = t < SEQ ? b : 16;
          if (mr != cur_mr) { const float* md = mods + ((size_t)l * 17 + mr) * 6144; ld16(md + 2048, F.lane, g1); ld16(md + 3072, F.lane, sh); ld16(md + 4096, F.lane, sc); cur_mr = mr; } }
#pragma unroll
        for (int u = 0; u < NR; ++u) { const int r = r0 + u; act[u] = r < rend; rr[u] = act[u] ? r : r0;
            float mx[16]; unpack16(rm[u], mx);
            if (l == 0) {
#pragma unroll
                for (int g = 0; g < 4; ++g) { v[u][4 * g] = __uint_as_float(rx[u][g].x); v[u][4 * g + 1] = __uint_as_float(rx[u][g].y); v[u][4 * g + 2] = __uint_as_float(rx[u][g].z); v[u][4 * g + 3] = __uint_as_float(rx[u][g].w); }
            } else {
#pragma unroll
                for (int g = 0; g < 4; ++g) { const v2u t = {rx[u][g].x, rx[u][g].y}; const f32x4 f = __builtin_convertvector(__builtin_bit_cast(f16x4, t), f32x4);
                    v[u][4 * g] = f.x; v[u][4 * g + 1] = f.y; v[u][4 * g + 2] = f.z; v[u][4 * g + 3] = f.w; }
            }
#pragma unroll
            for (int i = 0; i < 16; ++i) v[u][i] = alpha_l * v[u][i] + g1[i] * mx[i]; }
        if (r0 + NR < rend) RT_ISSUE(r0 + NR);
        if (l == NL - 1 && (r0 % TT) >= SEQ) continue;
#pragma unroll
        for (int u = 0; u < NR; ++u) ln16(v[u]);
        { float gg[16], bb[16];
#pragma unroll
          for (int g = 0; g < 4; ++g) { const f32x4 a = RT_W4(lbase, 1024 * g), c = RT_W4(lbase, 4096 + 1024 * g);
              gg[4 * g] = a.x; gg[4 * g + 1] = a.y; gg[4 * g + 2] = a.z; gg[4 * g + 3] = a.w; bb[4 * g] = c.x; bb[4 * g + 1] = c.y; bb[4 * g + 2] = c.z; bb[4 * g + 3] = c.w; }
#pragma unroll
          for (int u = 0; u < NR; ++u) {
#pragma unroll
            for (int i = 0; i < 16; ++i) v[u][i] = v[u][i] * gg[i] + bb[i];
            if (act[u]) st16h(RP.xs + (size_t)rr[u] * D, F.lane, v[u]); } }
#pragma unroll
        for (int u = 0; u < NR; ++u) ln16(v[u]);
#pragma unroll
        for (int u = 0; u < NR; ++u) {
#pragma unroll
            for (int i = 0; i < 16; ++i) v[u][i] = v[u][i] * (1.0f + sc[i]) + sh[i];
            if (act[u]) st16bf(HA + (size_t)rr[u] * D, F.lane, v[u]); }
#define RT_DOT(u_, w0, w1, w2, w3) ((v[u_][0] * w0.x + v[u_][1] * w0.y) + (v[u_][2] * w0.z + v[u_][3] * w0.w) + (v[u_][4] * w1.x + v[u_][5] * w1.y) + (v[u_][6] * w1.z + v[u_][7] * w1.w) \
        + (v[u_][8] * w2.x + v[u_][9] * w2.y) + (v[u_][10] * w2.z + v[u_][11] * w2.w) + (v[u_][12] * w3.x + v[u_][13] * w3.y) + (v[u_][14] * w3.z + v[u_][15] * w3.w))
        float gl[NR][4];
#pragma unroll
        for (int jx = 0; jx < 4; ++jx) {
            const f32x4 w0 = RT_W4(wbase, 4096 * jx), w1 = RT_W4(wbase, 4096 * jx + 1024), w2 = RT_W4(wbase, 4096 * jx + 2048), w3 = RT_W4(wbase, 4096 * jx + 3072);
#pragma unroll
            for (int u = 0; u < NR; ++u) gl[u][jx] = RT_DOT(u, w0, w1, w2, w3);
        }
#pragma unroll
        for (int u = 0; u < NR; ++u)
#pragma unroll
            for (int jx = 0; jx < 4; ++jx) gl[u][jx] = wave_sum(gl[u][jx]) + bias[jx];
        int grpv[NR]; float pgv[NR];
#pragma unroll
        for (int u = 0; u < NR; ++u) {
            int grp = 0; float mg = gl[u][0];
#pragma unroll
            for (int g = 1; g < 4; ++g) if (gl[u][g] > mg) { mg = gl[u][g]; grp = g; }
            float sg = 0.f;
#pragma unroll
            for (int g = 0; g < 4; ++g) sg += expf(gl[u][g] - mg);
            grpv[u] = grp; pgv[u] = 1.0f / sg;
        }
        float selv[NR][4];
#pragma unroll
        for (int u = 0; u < NR; ++u) {
            const LAS unsigned char* eb = wbase + (4 + 4 * grpv[u]) * 4096;
#pragma unroll
            for (int i = 0; i < 4; ++i) {
                const f32x4 w0 = RT_W4(eb, 4096 * i), w1 = RT_W4(eb, 4096 * i + 1024), w2 = RT_W4(eb, 4096 * i + 2048), w3 = RT_W4(eb, 4096 * i + 3072);
                selv[u][i] = RT_DOT(u, w0, w1, w2, w3);
            }
        }
#pragma unroll
        for (int u = 0; u < NR; ++u)
#pragma unroll
            for (int i = 0; i < 4; ++i) selv[u][i] = wave_sum(selv[u][i]) + bias[4 + 4 * grpv[u] + i];
#undef RT_DOT
#pragma unroll
        for (int u = 0; u < NR; ++u) {
            const int grp = grpv[u]; const float pg = pgv[u];
            float sel[4];
#pragma unroll
            for (int i = 0; i < 4; ++i) sel[i] = selv[u][i];
            int i1 = 0; float v1 = sel[0];
#pragma unroll
            for (int i = 1; i < 4; ++i) if (sel[i] > v1) { v1 = sel[i]; i1 = i; }
            int i2 = -1; float v2 = -3.0e38f;
#pragma unroll
            for (int i = 0; i < 4; ++i) if (i != i1 && (i2 < 0 || sel[i] > v2)) { v2 = sel[i]; i2 = i; }
            const float ee = expf(v2 - v1), w1 = pg / (1.0f + ee), w2 = pg * ee / (1.0f + ee);
            const int e1 = grp * 4 + i1, e2 = grp * 4 + i2;
            if (F.lane == 0 && act[u]) {
                const unsigned k1 = __hip_atomic_fetch_add((LAS unsigned*)&F.MISC[MI_LH + e1], 1u, __ATOMIC_RELAXED, __HIP_MEMORY_SCOPE_WORKGROUP);
                const unsigned k2 = __hip_atomic_fetch_add((LAS unsigned*)&F.MISC[MI_LH + e2], 1u, __ATOMIC_RELAXED, __HIP_MEMORY_SCOPE_WORKGROUP);
                v4u ra; ra.x = (unsigned)e1; ra.y = (unsigned)e2; ra.z = k1; ra.w = k2;
                v4u rb; rb.x = __builtin_bit_cast(unsigned, w1); rb.y = __builtin_bit_cast(unsigned, w2); rb.z = 0u; rb.w = 0u;
                *(v4u*)(RT + (size_t)rr[u] * 8) = ra; *(v4u*)(RT + (size_t)rr[u] * 8 + 4) = rb;
            }
        }
    }
#undef RT_ISSUE
#undef RT_W4
    __syncthreads();
    if (F.tid < 16) HIST[F.bid * 16 + F.tid] = (int)F.MISC[MI_LH + F.tid];
}
__device__ __forceinline__ void moe_tables(const Frame& F) {
    const int* HIST = (const int*)(F.ws + WS_HIST); LAS int* hl = (LAS int*)F.lds;
    __syncthreads();
    for (int i = F.tid; i < F.G * 16; i += NTHR) hl[i] = HIST[i];
    __syncthreads();
    if (F.tid < 16) { int tot = 0, mine = 0; for (int g = 0; g < F.G; ++g) { const int c = hl[g * 16 + F.tid]; tot += c; mine += (g < F.bid) ? c : 0; }
        F.MISC[MI_TOT + F.tid] = (unsigned)tot; F.MISC[MI_BASE + F.tid] = (unsigned)mine; }
    __syncthreads();
    if (F.tid == 0) { unsigned p = 0; for (int e = 0; e < 16; ++e) { F.MISC[MI_PST + e] = p; F.MISC[MI_BASE + e] += p * 256u; p += (F.MISC[MI_TOT + e] + 255u) >> 8; } F.MISC[MI_PST + 16] = p; }
    __syncthreads();
}
__device__ __forceinline__ void phase_permute(const Frame& F, int l) {
    unsigned* RT = (unsigned*)(F.ws + WS_RT); int* SRC = (int*)(F.ws + WS_QD);
    moe_tables(F);
    const int rpw = rows_per_wave(F.ngw), rbeg = F.gw * rpw, rend = min(M, rbeg + rpw);
    for (int r = rbeg + F.lane; r < rend; r += 64) {
        if (l == NL - 1 && (r % TT) >= SEQ) continue;
        const v4u ra = *(const v4u*)(RT + (size_t)r * 8);
        const unsigned p0 = F.MISC[MI_BASE + (ra.x & 15u)] + ra.z, p1 = F.MISC[MI_BASE + (ra.y & 15u)] + ra.w;
        RT[(size_t)r * 8 + 6] = p0; RT[(size_t)r * 8 + 7] = p1; SRC[p0] = r; SRC[p1] = r;
    }
    if (F.bid == 0) {
        for (int e = 0; e < 16; ++e) { const int beg = (int)F.MISC[MI_PST + e] * 256 + (int)F.MISC[MI_TOT + e], end = (int)F.MISC[MI_PST + e + 1] * 256;
            for (int p = beg + F.tid; p < end; p += NTHR) SRC[p] = 0; }
    }
}

struct EpiMla {
    static constexpr bool PERM = true, AFTER_DRAIN = false;
    bf16* QD; bf16* KD; bf16* VD;
    __device__ __forceinline__ void operator()(const pg8::f32x4 (&acc)[2][2][4][2], const pg8::Unit& u, int wr, int wc, int fr, int fq) const {
#pragma unroll
        for (int bj = 0; bj < 2; ++bj) {
            const int g0 = u.pn * 256 + bj * 128 + wc * 32, col0 = g0 + 8 * fq;
            if (g0 >= 896) continue;
            const int c = col0 - 384, hd = c >> 7, jx = c & 127;
            bf16* dst = g0 < 384 ? QD + col0 : jx < 64 ? KD + hd * 96 + jx : VD + hd * 64 + (jx - 64);
            const int stride = (g0 < 384 || jx < 64) ? 384 : 256;
            dst += (size_t)(u.pm * 256 + wr * 64 + fr) * stride;
#pragma unroll
            for (int ai = 0; ai < 2; ++ai)
#pragma unroll
                for (int m = 0; m < 4; ++m) {
                    v4u o; o.x = pk2(acc[ai][bj][m][0][0], acc[ai][bj][m][0][1]); o.y = pk2(acc[ai][bj][m][0][2], acc[ai][bj][m][0][3]);
                    o.z = pk2(acc[ai][bj][m][1][0], acc[ai][bj][m][1][1]); o.w = pk2(acc[ai][bj][m][1][2], acc[ai][bj][m][1][3]);
                    *(v4u*)(dst + (size_t)(ai * 128 + m * 16) * stride) = o;
                }
        }
    }
};
struct EpiGU {
    static constexpr bool PERM = true, AFTER_DRAIN = false;
    bf16* ACT;
    __device__ __forceinline__ void operator()(const pg8::f32x4 (&acc)[2][2][4][2], const pg8::Unit& u, int wr, int wc, int fr, int fq) const {
#pragma unroll
        for (int ai = 0; ai < 2; ++ai)
#pragma unroll
            for (int m = 0; m < 4; ++m) {
                const int row = u.pm * 256 + ai * 128 + wr * 64 + m * 16 + fr;
#pragma unroll
                for (int bj = 0; bj < 2; ++bj) {
                    const int c = (u.pn & 3) * 256 + bj * 128 + wc * 32 + 8 * fq;
                    float o[4];
#pragma unroll
                    for (int i = 0; i < 4; ++i) { const float g = acc[ai][bj][m][0][i], up = acc[ai][bj][m][1][i]; o[i] = g / (1.0f + __expf(-g)) * up; }
                    v2u w; w.x = pk2(o[0], o[1]); w.y = pk2(o[2], o[3]);
                    *(v2u*)(ACT + (size_t)row * 512 + (c >> 1)) = w;
                }
            }
    }
};
struct MoeOrder {
    volatile LAS unsigned* pst; int G, c;
    __device__ __forceinline__ bool next(int i, pg8::Unit& u) const {
        const int np = (int)pst[16]; int panel, pn;
        if ((G & 7) == 0) { const int x = c & 7, uu = i * (G >> 3) + (c >> 3); panel = (uu >> 2) * 8 + x; pn = uu & 3; }
        else { const int L = i * G + c; panel = L >> 2; pn = L & 3; }
        if (panel >= np) return false;
        int e = 0;
#pragma unroll
        for (int k = 1; k < 16; ++k) e += (panel >= (int)pst[k]) ? 1 : 0;
        u.pm = __builtin_amdgcn_readfirstlane(panel); u.pn = __builtin_amdgcn_readfirstlane(e * 4 + pn); return true;
    }
    __device__ __forceinline__ void a_ready(const pg8::Unit&) const {}
    __device__ __forceinline__ void done(const pg8::Unit&) const {}
};

struct LatOrder {
    int G, c;
    __device__ __forceinline__ bool next(int i, pg8::Unit& u) const {
        int pl, pn;
        if ((G & 7) == 0) { const int x = c & 7, uu = i * (G >> 3) + (c >> 3); pl = (uu >> 2) * 8 + x; pn = uu & 3; } else { const int L = i * G + c; pl = L >> 2; pn = L & 3; }
        if (pl >= NB * 16) return false;
        u.pm = pl + (pl >> 4); u.pn = pn; return true;
    }
    __device__ __forceinline__ void a_ready(const pg8::Unit&) const {}
    __device__ __forceinline__ void done(const pg8::Unit&) const {}
};

#ifndef DBG_VAR
#define DBG_VAR 1
#endif
namespace att {
constexpr int VRS = 192, KBUF = 64 * 208, VBUF = 64 * VRS, BUF = KBUF + VBUF, BIAS_OFF = 4 * BUF;
constexpr float NEG = -30000.0f;
__device__ __forceinline__ int crow(int r, int hi) { return (r & 3) + 8 * (r >> 2) + 4 * hi; }
__device__ __forceinline__ float xhalf_max(float v) { const unsigned a = __builtin_bit_cast(unsigned, v);
    auto rr = __builtin_amdgcn_permlane32_swap(a, a, false, false); const unsigned r0 = rr[0], r1 = rr[1]; return fmaxf(__uint_as_float(r0), __uint_as_float(r1)); }
__device__ __forceinline__ float xhalf_sum(float v) { const unsigned a = __builtin_bit_cast(unsigned, v);
    auto rr = __builtin_amdgcn_permlane32_swap(a, a, false, false); const unsigned r0 = rr[0], r1 = rr[1]; return __uint_as_float(r0) + __uint_as_float(r1); }
__device__ __forceinline__ float max3f(float a, float b, float c) { float r; asm("v_max3_f32 %0, %1, %2, %3" : "=v"(r) : "v"(a), "v"(b), "v"(c)); return r; }
typedef __bf16 bf16x2_t __attribute__((ext_vector_type(2)));
__device__ __forceinline__ unsigned cvtpk(float lo, float hi) { f32x2 v = {lo, hi}; bf16x2_t b = __builtin_convertvector(v, bf16x2_t); return __builtin_bit_cast(unsigned, b); }

template <int DK, int VM = 0>
__device__ __forceinline__ void unit(LAS unsigned char* lds, const bf16* Qp, int qpitch, const bf16* Kp, int kpitch, const bf16* Vp, int vpitch, bf16* Op,
                                     int var, int qt, int lo, int n1, int nt, float qscale, float sinkl2, bool has_sink, const LAS float* bias, const float* t32, unsigned* dbg) {
    constexpr int KRS = DK * 2 + 16, NS = DK / 16, CPK = DK / 8;
    int tid = threadIdx.x; asm volatile("" : "+v"(tid)); const int lane = tid & 63, r32 = lane & 31, hi = lane >> 5, wid = __builtin_amdgcn_readfirstlane(tid >> 6);
    const int qrow = 256 * qt + 32 * wid + r32;
    bf16x8 qr[NS];
#pragma unroll
    for (int s = 0; s < NS; ++s) { const v4u raw = *(const v4u*)(Qp + (size_t)qrow * qpitch + 16 * s + 8 * hi); float f[8]; unpack8(raw, f);
#pragma unroll
        for (int i = 0; i < 8; ++i) f[i] *= qscale;
        if (DK == 96 && s >= 4) {
            float p[8];
#pragma unroll
            for (int i = 0; i < 8; ++i) p[i] = __shfl_xor(f[i], 32);
            if (qt < 16) rope8(f, p, t32 + ((size_t)((s == 4 ? (qrow >> 6) : (qrow & 63)) * 8)) * 2, hi == 0);
        }
        qr[s] = __builtin_bit_cast(bf16x8, pack8(f)); }
    const int kkey0 = tid / CPK, kch0 = tid - kkey0 * CPK, kkey1 = (tid + 512) / CPK, kch1 = (tid + 512) - kkey1 * CPK;
    const int vkey = tid >> 3, vch = tid & 7;
    v4u kreg0, kreg1 = {0u, 0u, 0u, 0u}, vreg;
#define ATT_TROW(j) ((((j) < n1) ? (lo + (j)) : (64 + (j) - n1)) * 64)
#define ATT_LOAD(j) do { const int tr_ = ATT_TROW(j); kreg0 = *(const v4u*)(Kp + (size_t)(tr_ + kkey0) * kpitch + kch0 * 8); \
        if (DK == 96 && tid < 256) kreg1 = *(const v4u*)(Kp + (size_t)(tr_ + kkey1) * kpitch + kch1 * 8); \
        vreg = *(const v4u*)(Vp + (size_t)(tr_ + vkey) * vpitch + vch * 8); } while (0)
#define ATT_STORE(bf) do { LAS unsigned char* b_ = lds + (bf) * BUF; *(LAS v4u*)(b_ + kkey0 * KRS + kch0 * 16) = kreg0; \
        if (DK == 96 && tid < 256) *(LAS v4u*)(b_ + kkey1 * KRS + kch1 * 16) = kreg1; \
        *(LAS v4u*)(b_ + KBUF + vkey * VRS + vch * 16) = vreg; } while (0)
    constexpr float THR = 6.0f;
    float m = 0.f; f32x2 lacc = {0.f, 0.f}; f32x16 o0 = {}, o1 = {}; f32x16 negm = {}; bool first = true;
    const int grw = 4 * qt + (wid >> 1), r0w = min(max(grw - 4, 0), 56), gc = (wid & 1) * 32 + r32, c0 = min(max(gc - 8, 0), 48), i0w = 256 * qt + 32 * wid;
    ATT_LOAD(0); ATT_STORE(0);
    __syncthreads();
    for (int j = 0; j < nt; ++j) {
        if (!(VM & 8) && j + 1 < nt) ATT_LOAD(j + 1);
        const int kt = ATT_TROW(j) >> 6;
        bool actv = true;
        if (kt < 64) { if (var == 0) actv = (kt >= r0w) && (kt <= r0w + 7); else if (var == 2) actv = !((64 * kt - (i0w + 31) > 128) || (i0w - (64 * kt + 63) > 128)); }
        if (actv) {
            const LAS unsigned char* Kb = lds + (j & 1) * BUF; const LAS unsigned char* Vb = Kb + KBUF;
            f32x16 s0 = negm, s1 = negm;
            bf16x8 ka[NS], kb[NS];
#pragma unroll
            for (int s = 0; s < NS; ++s) { ka[s] = *(const LAS bf16x8*)(Kb + r32 * KRS + (16 * s + 8 * hi) * 2); kb[s] = *(const LAS bf16x8*)(Kb + (32 + r32) * KRS + (16 * s + 8 * hi) * 2); }
            __builtin_amdgcn_sched_barrier(0);
            if (VM & 2) {
#pragma unroll
                for (int s = 0; s < NS; ++s) asm volatile("" :: "v"(ka[s]), "v"(kb[s]), "v"(qr[s]));
            } else {
#pragma unroll
            for (int s = 0; s < NS; ++s) { s0 = __builtin_amdgcn_mfma_f32_32x32x16_bf16(ka[s], qr[s], s0, 0, 0, 0); s1 = __builtin_amdgcn_mfma_f32_32x32x16_bf16(kb[s], qr[s], s1, 0, 0, 0); }
            }
            asm volatile("s_nop 15\n\ts_nop 7" : "+v"(s0), "+v"(s1));
            if (kt < 64 && var == 0) {
                const int rowoff = (kt - grw + 7) * 31 - gc + 15;
#pragma unroll
                for (int r = 0; r < 16; ++r) { const int j0 = crow(r, hi), j1 = j0 + 32;
                    const bool v0 = (unsigned)(j0 - c0) < 16u, v1 = (unsigned)(j1 - c0) < 16u;
                    const float b0 = bias[v0 ? rowoff + j0 : 0], b1 = bias[v1 ? rowoff + j1 : 0];
                    s0[r] = v0 ? s0[r] + b0 : NEG; s1[r] = v1 ? s1[r] + b1 : NEG; }
            } else if (kt < 64 && var == 2) {
                const int dbase = 64 * kt - qrow + 128;
#pragma unroll
                for (int r = 0; r < 16; ++r) { const int j0 = crow(r, hi);
                    s0[r] = (unsigned)(dbase + j0) <= 256u ? s0[r] : NEG; s1[r] = (unsigned)(dbase + j0 + 32) <= 256u ? s1[r] : NEG; }
            }
            if (!(VM & 4)) {
            float mxa = max3f(s0[0], s0[1], s1[0]), mxb = max3f(s0[2], s0[3], s1[1]); mxa = max3f(mxa, s1[2], s1[3]);
#pragma unroll
            for (int r = 4; r < 16; r += 4) { mxa = max3f(mxa, s0[r], s0[r + 1]); mxb = max3f(mxb, s0[r + 2], s0[r + 3]); mxa = max3f(mxa, s1[r], s1[r + 1]); mxb = max3f(mxb, s1[r + 2], s1[r + 3]); }
            const float mx = xhalf_max(fmaxf(mxa, mxb));
            if (first || __any(mx > THR)) {
                const float d = first ? fmaxf(mx, -64.0f) : fmaxf(mx, 0.f), alpha = __builtin_amdgcn_exp2f(-d);
                m += d; first = false;
#pragma unroll
                for (int r = 0; r < 16; ++r) { s0[r] -= d; s1[r] -= d; o0[r] *= alpha; o1[r] *= alpha; negm[r] = -m; }
                lacc *= alpha;
            }
#pragma unroll
            for (int r = 0; r < 16; ++r) { s0[r] = __builtin_amdgcn_exp2f(s0[r]); s1[r] = __builtin_amdgcn_exp2f(s1[r]); lacc += (f32x2){s0[r], s1[r]}; }
            }
            bf16x8 pb[4];
#pragma unroll
            for (int s = 0; s < 2; ++s) {
                v4u w; w.x = cvtpk(s0[8 * s], s0[8 * s + 1]); w.y = cvtpk(s0[8 * s + 2], s0[8 * s + 3]); w.z = cvtpk(s0[8 * s + 4], s0[8 * s + 5]); w.w = cvtpk(s0[8 * s + 6], s0[8 * s + 7]);
                pb[s] = __builtin_bit_cast(bf16x8, w);
                v4u x; x.x = cvtpk(s1[8 * s], s1[8 * s + 1]); x.y = cvtpk(s1[8 * s + 2], s1[8 * s + 3]); x.z = cvtpk(s1[8 * s + 4], s1[8 * s + 5]); x.w = cvtpk(s1[8 * s + 6], s1[8 * s + 7]);
                pb[2 + s] = __builtin_bit_cast(bf16x8, x);
            }
            if (VM & 1) { asm volatile("" :: "v"(pb[0]), "v"(pb[1]), "v"(pb[2]), "v"(pb[3])); } else {
            const LAS unsigned char* vbase = Vb + (4 * hi + ((lane & 15) >> 2)) * VRS + ((lane >> 4) & 1) * 32 + (lane & 3) * 8;
#pragma unroll
            for (int s = 0; s < 4; ++s) {
                const v4i16 a0 = __builtin_amdgcn_ds_read_tr16_b64_v4i16((LAS v4i16*)(vbase + (16 * s) * VRS));
                const v4i16 a1 = __builtin_amdgcn_ds_read_tr16_b64_v4i16((LAS v4i16*)(vbase + (16 * s + 8) * VRS));
                const v4i16 c0_ = __builtin_amdgcn_ds_read_tr16_b64_v4i16((LAS v4i16*)(vbase + (16 * s) * VRS + 64));
                const v4i16 c1_ = __builtin_amdgcn_ds_read_tr16_b64_v4i16((LAS v4i16*)(vbase + (16 * s + 8) * VRS + 64));
                const bf16x8 va = {a0[0], a0[1], a0[2], a0[3], a1[0], a1[1], a1[2], a1[3]};
                const bf16x8 vc = {c0_[0], c0_[1], c0_[2], c0_[3], c1_[0], c1_[1], c1_[2], c1_[3]};
                o0 = __builtin_amdgcn_mfma_f32_32x32x16_bf16(va, pb[s], o0, 0, 0, 0);
                o1 = __builtin_amdgcn_mfma_f32_32x32x16_bf16(vc, pb[s], o1, 0, 0, 0);
            }
            }
        }
        if (!(VM & 8) && j + 1 < nt) ATT_STORE((j + 1) & 1);
        if (!(VM & 16)) __syncthreads();
    }
    float l = xhalf_sum(lacc.x + lacc.y);
    const float sterm = has_sink ? __builtin_amdgcn_exp2f(sinkl2 - m) : 0.f;
#if MK_DEBUG
    if (dbg && hi == 0) { dbg[(size_t)qrow * 2] = __builtin_bit_cast(unsigned, m); dbg[(size_t)qrow * 2 + 1] = __builtin_bit_cast(unsigned, l); }
#endif
    if (has_sink) l += sterm;
    const float inv = 1.0f / l;
    bf16* orow = Op + (size_t)qrow * D;
#pragma unroll
    for (int g = 0; g < 4; ++g) {
        v2u w0; w0.x = pk2(o0[4 * g] * inv, o0[4 * g + 1] * inv); w0.y = pk2(o0[4 * g + 2] * inv, o0[4 * g + 3] * inv);
        v2u w1; w1.x = pk2(o1[4 * g] * inv, o1[4 * g + 1] * inv); w1.y = pk2(o1[4 * g + 2] * inv, o1[4 * g + 3] * inv);
        *(v2u*)(orow + 8 * g + 4 * hi) = w0; *(v2u*)(orow + 32 + 8 * g + 4 * hi) = w1;
    }
#undef ATT_TROW
#undef ATT_LOAD
#undef ATT_STORE
}

template <int DK, int MODE, int VM = 0, bool NOREF = false>
__device__ __forceinline__ void unit2(LAS unsigned char* lds, const bf16* Qp, int qpitch, const bf16* Kp, int kpitch, const bf16* Vp, int vpitch, bf16* Op,
                                      int var, int qt, int lo, int n1, int nt, float qscale, float sink0, float sink1, bool has_sink, const LAS float* bias, const float* t32) {
    constexpr int KRS = DK * 2 + 16, NS = DK / 16, CPK = DK / 8;
    int tid = threadIdx.x; asm volatile("" : "+v"(tid)); const int lane = tid & 63, r32 = lane & 31, hi = lane >> 5, wid = __builtin_amdgcn_readfirstlane(tid >> 6);
    const int rowbase = MODE == 0 ? 512 * qt + 64 * wid : 256 * qt + 32 * wid;
    bf16x8 qr[2][NS];
#pragma unroll
    for (int u = 0; u < 2; ++u) {
        const int qrow = rowbase + (MODE == 0 ? 32 * u : 0) + r32;
        const bf16* qp = Qp + (MODE == 1 ? 64 * u : 0) + (size_t)qrow * qpitch;
#pragma unroll
        for (int s = 0; s < NS; ++s) { const v4u raw = *(const v4u*)(qp + 16 * s + 8 * hi); float f[8]; unpack8(raw, f);
#pragma unroll
            for (int i = 0; i < 8; ++i) f[i] *= qscale;
            if (DK == 96 && s >= 4) { float p[8];
#pragma unroll
                for (int i = 0; i < 8; ++i) p[i] = __shfl_xor(f[i], 32);
                rope8(f, p, t32 + ((size_t)((s == 4 ? (qrow >> 6) : (qrow & 63)) * 8)) * 2, hi == 0); }
            qr[u][s] = __builtin_bit_cast(bf16x8, pack8(f)); }
    }
    const int kkey0 = tid / CPK, kch0 = tid - kkey0 * CPK, kkey1 = (tid + 512) / CPK, kch1 = (tid + 512) - kkey1 * CPK;
    const int vkey = tid >> 3, vch = tid & 7;
    v4u kreg0, kreg1 = {0u, 0u, 0u, 0u}, vreg;
#define ATT_TROW(j) ((((j) < n1) ? (lo + (j)) : (64 + (j) - n1)) * 64)
#define ATT_LOAD(j) do { const int tr_ = ATT_TROW(j); kreg0 = *(const v4u*)(Kp + (size_t)(tr_ + kkey0) * kpitch + kch0 * 8); \
        if (DK == 96 && tid < 256) kreg1 = *(const v4u*)(Kp + (size_t)(tr_ + kkey1) * kpitch + kch1 * 8); \
        vreg = *(const v4u*)(Vp + (size_t)(tr_ + vkey) * vpitch + vch * 8); } while (0)
#define ATT_STORE(bf) do { LAS unsigned char* b_ = lds + (bf) * BUF; *(LAS v4u*)(b_ + kkey0 * KRS + kch0 * 16) = kreg0; \
        if (DK == 96 && tid < 256) *(LAS v4u*)(b_ + kkey1 * KRS + kch1 * 16) = kreg1; \
        *(LAS v4u*)(b_ + KBUF + vkey * VRS + vch * 16) = vreg; } while (0)
    constexpr float THR = 6.0f;
    float m = 0.f; f32x2 lacc[2] = {{0.f, 0.f}, {0.f, 0.f}}; f32x16 o0[2] = {{}, {}}, o1[2] = {{}, {}}; bool first = true;
    const int grw = 8 * qt + wid, r0w = min(max(grw - 4, 0), 56), i0w = rowbase;
    ATT_LOAD(0); ATT_STORE(0);
    __syncthreads();
    for (int j = 0; j < nt; ++j) {
        if (!(VM & 8) && j + 1 < nt) ATT_LOAD(j + 1);
        const int kt = ATT_TROW(j) >> 6;
        bool actv = true;
        if (kt < 64) { if (var == 0) actv = (kt >= r0w) && (kt <= r0w + 7); else if (var == 2) actv = !((64 * kt - (i0w + 31) > 128) || (i0w - (64 * kt + 63) > 128)); }
        if (actv) {
            const LAS unsigned char* Kb = lds + (j & 1) * BUF; const LAS unsigned char* Vb = Kb + KBUF;
            f32x16 s0[2] = {{}, {}}, s1[2] = {{}, {}};
#pragma unroll
            for (int s = 0; s < NS; ++s) {
                const bf16x8 ka = *(const LAS bf16x8*)(Kb + r32 * KRS + (16 * s + 8 * hi) * 2);
                const bf16x8 kb = *(const LAS bf16x8*)(Kb + (32 + r32) * KRS + (16 * s + 8 * hi) * 2);
                if (VM & 2) { asm volatile("" :: "v"(ka), "v"(kb), "v"(qr[0][s]), "v"(qr[1][s])); } else {
#pragma unroll
                for (int u = 0; u < 2; ++u) { s0[u] = __builtin_amdgcn_mfma_f32_32x32x16_bf16(ka, qr[u][s], s0[u], 0, 0, 0); s1[u] = __builtin_amdgcn_mfma_f32_32x32x16_bf16(kb, qr[u][s], s1[u], 0, 0, 0); }
                }
            }
            asm volatile("s_nop 15\n\ts_nop 7" : "+v"(s0[0]), "+v"(s1[0]), "+v"(s0[1]), "+v"(s1[1]));
            if (kt < 64 && var == 0) {
#pragma unroll
                for (int u = 0; u < 2; ++u) { const int gc = 32 * u + r32, c0 = min(max(gc - 8, 0), 48), rowoff = (kt - grw + 7) * 31 - gc + 15;
#pragma unroll
                    for (int r = 0; r < 16; ++r) { const int j0 = crow(r, hi), j1 = j0 + 32;
                        const bool v0 = (unsigned)(j0 - c0) < 16u, v1 = (unsigned)(j1 - c0) < 16u;
                        const float b0 = bias[v0 ? rowoff + j0 : 0], b1 = bias[v1 ? rowoff + j1 : 0];
                        s0[u][r] = v0 ? s0[u][r] + b0 : NEG; s1[u][r] = v1 ? s1[u][r] + b1 : NEG; } }
            } else if (kt < 64 && var == 2) {
                const int dbase = 64 * kt - (rowbase + r32) + 128;
#pragma unroll
                for (int r = 0; r < 16; ++r) { const int j0 = crow(r, hi); const bool v0 = (unsigned)(dbase + j0) <= 256u, v1 = (unsigned)(dbase + j0 + 32) <= 256u;
                    s0[0][r] = v0 ? s0[0][r] : NEG; s1[0][r] = v1 ? s1[0][r] : NEG; s0[1][r] = v0 ? s0[1][r] : NEG; s1[1][r] = v1 ? s1[1][r] : NEG; }
            }
            if (!(VM & 4)) {
            if (!NOREF) {
            float mxa = max3f(s0[0][0], s0[0][1], s1[0][0]), mxb = max3f(s0[1][0], s0[1][1], s1[1][0]);
#pragma unroll
            for (int r = 0; r < 16; r += 2) { if (r) { mxa = max3f(mxa, s0[0][r], s0[0][r + 1]); mxb = max3f(mxb, s0[1][r], s0[1][r + 1]); }
                if (r) { mxa = max3f(mxa, s1[0][r], s1[0][r + 1]); mxb = max3f(mxb, s1[1][r], s1[1][r + 1]); } else { mxa = fmaxf(mxa, s1[0][1]); mxb = fmaxf(mxb, s1[1][1]); } }
            const float mx = xhalf_max(fmaxf(mxa, mxb)) - m;
            if (first || __any(mx > THR)) {
                const float d = first ? fmaxf(mx, -64.0f) : fmaxf(mx, 0.f), alpha = __builtin_amdgcn_exp2f(-d);
                m += d; first = false;
#pragma unroll
                for (int u = 0; u < 2; ++u) {
#pragma unroll
                    for (int r = 0; r < 16; ++r) { o0[u][r] *= alpha; o1[u][r] *= alpha; }
                    lacc[u] *= alpha; }
            }
            }
            }
            bf16x8 pb[2][4];
#pragma unroll
            for (int u = 0; u < 2; ++u) {
                if (!(VM & 4))
#pragma unroll
                for (int r = 0; r < 16; ++r) { s0[u][r] = __builtin_amdgcn_exp2f(NOREF ? s0[u][r] : s0[u][r] - m); s1[u][r] = __builtin_amdgcn_exp2f(NOREF ? s1[u][r] : s1[u][r] - m); lacc[u] += (f32x2){s0[u][r], s1[u][r]}; }
#pragma unroll
                for (int s = 0; s < 2; ++s) {
                    v4u w; w.x = cvtpk(s0[u][8 * s], s0[u][8 * s + 1]); w.y = cvtpk(s0[u][8 * s + 2], s0[u][8 * s + 3]); w.z = cvtpk(s0[u][8 * s + 4], s0[u][8 * s + 5]); w.w = cvtpk(s0[u][8 * s + 6], s0[u][8 * s + 7]);
                    pb[u][s] = __builtin_bit_cast(bf16x8, w);
                    v4u x; x.x = cvtpk(s1[u][8 * s], s1[u][8 * s + 1]); x.y = cvtpk(s1[u][8 * s + 2], s1[u][8 * s + 3]); x.z = cvtpk(s1[u][8 * s + 4], s1[u][8 * s + 5]); x.w = cvtpk(s1[u][8 * s + 6], s1[u][8 * s + 7]);
                    pb[u][2 + s] = __builtin_bit_cast(bf16x8, x);
                }
            }
            if (VM & 1) { asm volatile("" :: "v"(pb[0][0]), "v"(pb[0][1]), "v"(pb[0][2]), "v"(pb[0][3]), "v"(pb[1][0]), "v"(pb[1][1]), "v"(pb[1][2]), "v"(pb[1][3])); } else {
            const LAS unsigned char* vbase = Vb + (4 * hi + ((lane & 15) >> 2)) * VRS + ((lane >> 4) & 1) * 32 + (lane & 3) * 8;
#pragma unroll
            for (int s = 0; s < 4; ++s) {
                const v4i16 a0 = __builtin_amdgcn_ds_read_tr16_b64_v4i16((LAS v4i16*)(vbase + (16 * s) * VRS));
                const v4i16 a1 = __builtin_amdgcn_ds_read_tr16_b64_v4i16((LAS v4i16*)(vbase + (16 * s + 8) * VRS));
                const v4i16 c0_ = __builtin_amdgcn_ds_read_tr16_b64_v4i16((LAS v4i16*)(vbase + (16 * s) * VRS + 64));
                const v4i16 c1_ = __builtin_amdgcn_ds_read_tr16_b64_v4i16((LAS v4i16*)(vbase + (16 * s + 8) * VRS + 64));
                const bf16x8 va = {a0[0], a0[1], a0[2], a0[3], a1[0], a1[1], a1[2], a1[3]};
                const bf16x8 vc = {c0_[0], c0_[1], c0_[2], c0_[3], c1_[0], c1_[1], c1_[2], c1_[3]};
#pragma unroll
                for (int u = 0; u < 2; ++u) { o0[u] = __builtin_amdgcn_mfma_f32_32x32x16_bf16(va, pb[u][s], o0[u], 0, 0, 0); o1[u] = __builtin_amdgcn_mfma_f32_32x32x16_bf16(vc, pb[u][s], o1[u], 0, 0, 0); }
            }
            }
        }
        if (!(VM & 8) && j + 1 < nt) ATT_STORE((j + 1) & 1);
        if (!(VM & 16)) __syncthreads();
    }
#pragma unroll
    for (int u = 0; u < 2; ++u) {
        float l = xhalf_sum(lacc[u].x + lacc[u].y);
        if (has_sink) l += __builtin_amdgcn_exp2f((u == 0 ? sink0 : sink1) - m);
        const float inv = 1.0f / l;
        const int qrow = rowbase + (MODE == 0 ? 32 * u : 0) + r32;
        bf16* orow = Op + (MODE == 1 ? 64 * u : 0) + (size_t)qrow * D;
#pragma unroll
        for (int g = 0; g < 4; ++g) {
            v2u w0; w0.x = pk2(o0[u][4 * g] * inv, o0[u][4 * g + 1] * inv); w0.y = pk2(o0[u][4 * g + 2] * inv, o0[u][4 * g + 3] * inv);
            v2u w1; w1.x = pk2(o1[u][4 * g] * inv, o1[u][4 * g + 1] * inv); w1.y = pk2(o1[u][4 * g + 2] * inv, o1[u][4 * g + 3] * inv);
            *(v2u*)(orow + 8 * g + 4 * hi) = w0; *(v2u*)(orow + 32 + 8 * g + 4 * hi) = w1;
        }
    }
#undef ATT_TROW
#undef ATT_LOAD
#undef ATT_STORE
}

template <int DK, int MODE, int VM = 0>
__device__ __forceinline__ bool unit_h(LAS unsigned char* lds, const bf16* Qp, int qpitch, const bf16* Kp, int kpitch, const bf16* Vp, int vpitch, bf16* Op,
                                       int var, int qt, int lo, int n1, int nt, float qscale, float sink0, float sink1, bool has_sink, const LAS float* bias, const float* t32, volatile LAS unsigned* flag) {
    constexpr int KRS = DK * 2 + 16, NS = DK / 16, CPK = DK / 8;
    int tid = threadIdx.x; asm volatile("" : "+v"(tid)); const int lane = tid & 63, r32 = lane & 31, hi = lane >> 5, wid = __builtin_amdgcn_readfirstlane(tid >> 6);
    const int rowbase = MODE == 0 ? 512 * qt + 64 * wid : 256 * qt + 32 * wid;
    bf16x8 qr[2][NS];
#pragma unroll
    for (int u = 0; u < 2; ++u) {
        const int qrow = rowbase + (MODE == 0 ? 32 * u : 0) + r32;
        const bf16* qp = Qp + (MODE == 1 ? 64 * u : 0) + (size_t)qrow * qpitch;
#pragma unroll
        for (int s = 0; s < NS; ++s) { const v4u raw = *(const v4u*)(qp + 16 * s + 8 * hi); float f[8]; unpack8(raw, f);
#pragma unroll
            for (int i = 0; i < 8; ++i) f[i] *= qscale;
            if (DK == 96 && s >= 4) { float p[8];
#pragma unroll
                for (int i = 0; i < 8; ++i) p[i] = __shfl_xor(f[i], 32);
                rope8(f, p, t32 + ((size_t)((s == 4 ? (qrow >> 6) : (qrow & 63)) * 8)) * 2, hi == 0); }
            qr[u][s] = __builtin_bit_cast(bf16x8, pack8(f)); }
    }
    const int kkey0 = tid / CPK, kch0 = tid - kkey0 * CPK, kkey1 = (tid + 512) / CPK, kch1 = (tid + 512) - kkey1 * CPK;
    const int vkey = tid >> 3, vch = tid & 7;
    v4u kreg0, kreg1 = {0u, 0u, 0u, 0u}, vreg;
#define ATT_TROW(j) ((((j) < n1) ? (lo + (j)) : (64 + (j) - n1)) * 64)
#define ATT_LOAD(j) do { const int tr_ = ATT_TROW(j); kreg0 = *(const v4u*)(Kp + (size_t)(tr_ + kkey0) * kpitch + kch0 * 8); \
        if (DK == 96 && tid < 256) kreg1 = *(const v4u*)(Kp + (size_t)(tr_ + kkey1) * kpitch + kch1 * 8); \
        vreg = *(const v4u*)(Vp + (size_t)(tr_ + vkey) * vpitch + vch * 8); } while (0)
#define ATT_STORE(bf) do { LAS unsigned char* b_ = lds + (bf) * BUF; *(LAS v4u*)(b_ + kkey0 * KRS + kch0 * 16) = kreg0; \
        if (DK == 96 && tid < 256) *(LAS v4u*)(b_ + kkey1 * KRS + kch1 * 16) = kreg1; \
        *(LAS v4u*)(b_ + KBUF + vkey * VRS + vch * 16) = vreg; } while (0)
    f32x2 lacc[2] = {{0.f, 0.f}, {0.f, 0.f}}; f32x16 o0[2] = {{}, {}}, o1[2] = {{}, {}};
    const int grw = 8 * qt + wid, r0w = min(max(grw - 4, 0), 56), i0w = rowbase;
    ATT_LOAD(0); ATT_STORE(0);
    if (tid == 0) *flag = 0u;
    __syncthreads();
    for (int j = 0; j < nt; ++j) {
        if (!(VM & 8) && j + 1 < nt) ATT_LOAD(j + 1);
        const int kt = ATT_TROW(j) >> 6;
        bool actv = true;
        if (kt < 64) { if (var == 0) actv = (kt >= r0w) && (kt <= r0w + 7); else if (var == 2) actv = !((64 * kt - (i0w + 31) > 128) || (i0w - (64 * kt + 63) > 128)); }
        if (actv) {
        const LAS unsigned char* Kb = lds + (j & 1) * BUF; const LAS unsigned char* Vb = Kb + KBUF;
        const LAS unsigned char* vbase = Vb + (4 * hi + ((lane & 15) >> 2)) * VRS + ((lane >> 4) & 1) * 32 + (lane & 3) * 8;
#pragma unroll
        for (int hf = 0; hf < 2; ++hf) {
            f32x16 sc[2] = {{}, {}};
#pragma unroll
            for (int s = 0; s < NS; ++s) {
                const bf16x8 kf = *(const LAS bf16x8*)(Kb + (32 * hf + r32) * KRS + (16 * s + 8 * hi) * 2);
#pragma unroll
                for (int u = 0; u < 2; ++u) sc[u] = __builtin_amdgcn_mfma_f32_32x32x16_bf16(kf, qr[u][s], sc[u], 0, 0, 0);
            }
            if (kt < 64 && var == 0) {
#pragma unroll
                for (int u = 0; u < 2; ++u) { const int gc = 32 * u + r32, c0 = min(max(gc - 8, 0), 48), rowoff = (kt - grw + 7) * 31 - gc + 15;
                    const LAS unsigned char* bb = (const LAS unsigned char*)(bias + rowoff + 4 * hi); asm volatile("" : "+v"(bb));
                    float bv[16];
#pragma unroll
                    for (int r = 0; r < 16; ++r) bv[r] = *(const LAS float*)(bb + 4 * (32 * hf + (r & 3) + 8 * (r >> 2)));
                    asm volatile("" : "+v"(bv[0]), "+v"(bv[1]), "+v"(bv[2]), "+v"(bv[3]), "+v"(bv[4]), "+v"(bv[5]), "+v"(bv[6]), "+v"(bv[7]),
                                      "+v"(bv[8]), "+v"(bv[9]), "+v"(bv[10]), "+v"(bv[11]), "+v"(bv[12]), "+v"(bv[13]), "+v"(bv[14]), "+v"(bv[15]));
#pragma unroll
                    for (int r = 0; r < 16; ++r) { const int jj = 32 * hf + crow(r, hi); const bool v = (unsigned)(jj - c0) < 16u; sc[u][r] = v ? sc[u][r] + bv[r] : NEG; } }
            } else if (kt < 64 && var == 2) {
                const int dbase = 64 * kt - (rowbase + r32) + 128;
#pragma unroll
                for (int r = 0; r < 16; ++r) { const bool v = (unsigned)(dbase + 32 * hf + crow(r, hi)) <= 256u; sc[0][r] = v ? sc[0][r] : NEG; sc[1][r] = v ? sc[1][r] : NEG; }
            }
            bf16x8 pb[2][2];
#pragma unroll
            for (int u = 0; u < 2; ++u) {
#pragma unroll
                for (int r = 0; r < 16; r += 2) { sc[u][r] = __builtin_amdgcn_exp2f(sc[u][r]); sc[u][r + 1] = __builtin_amdgcn_exp2f(sc[u][r + 1]); lacc[u] += (f32x2){sc[u][r], sc[u][r + 1]}; }
#pragma unroll
                for (int s = 0; s < 2; ++s) {
                    v4u w; w.x = cvtpk(sc[u][8 * s], sc[u][8 * s + 1]); w.y = cvtpk(sc[u][8 * s + 2], sc[u][8 * s + 3]); w.z = cvtpk(sc[u][8 * s + 4], sc[u][8 * s + 5]); w.w = cvtpk(sc[u][8 * s + 6], sc[u][8 * s + 7]);
                    pb[u][s] = __builtin_bit_cast(bf16x8, w);
                }
            }
#pragma unroll
            for (int s2 = 0; s2 < 2; ++s2) { const int s = 2 * hf + s2;
                const v4i16 a0 = __builtin_amdgcn_ds_read_tr16_b64_v4i16((LAS v4i16*)(vbase + (16 * s) * VRS));
                const v4i16 a1 = __builtin_amdgcn_ds_read_tr16_b64_v4i16((LAS v4i16*)(vbase + (16 * s + 8) * VRS));
                const v4i16 c0_ = __builtin_amdgcn_ds_read_tr16_b64_v4i16((LAS v4i16*)(vbase + (16 * s) * VRS + 64));
                const v4i16 c1_ = __builtin_amdgcn_ds_read_tr16_b64_v4i16((LAS v4i16*)(vbase + (16 * s + 8) * VRS + 64));
                const bf16x8 va = {a0[0], a0[1], a0[2], a0[3], a1[0], a1[1], a1[2], a1[3]};
                const bf16x8 vc = {c0_[0], c0_[1], c0_[2], c0_[3], c1_[0], c1_[1], c1_[2], c1_[3]};
#pragma unroll
                for (int u = 0; u < 2; ++u) { o0[u] = __builtin_amdgcn_mfma_f32_32x32x16_bf16(va, pb[u][s2], o0[u], 0, 0, 0); o1[u] = __builtin_amdgcn_mfma_f32_32x32x16_bf16(vc, pb[u][s2], o1[u], 0, 0, 0); }
            }
            __builtin_amdgcn_sched_barrier(0);
        }
        }
        if (!(VM & 8) && j + 1 < nt) ATT_STORE((j + 1) & 1);
        __syncthreads();
    }
    float lsum[2]; bool bad = false;
#pragma unroll
    for (int u = 0; u < 2; ++u) { lsum[u] = xhalf_sum(lacc[u].x + lacc[u].y); bad = bad || !(lsum[u] > 8.6736174e-19f && lsum[u] < 1.1529215e18f);
        if (has_sink) { lsum[u] += __builtin_amdgcn_exp2f(u == 0 ? sink0 : sink1); bad = bad || !(lsum[u] < 1.1529215e18f); } }
    if (__any(bad)) { if (lane == 0) *flag = 1u; }
#pragma unroll
    for (int u = 0; u < 2; ++u) {
        const float inv = 1.0f / lsum[u];
        bf16* orow = Op + (MODE == 1 ? 64 * u : 0) + (size_t)(rowbase + (MODE == 0 ? 32 * u : 0) + r32) * D;
#pragma unroll
        for (int g = 0; g < 4; ++g) {
            v2u w0; w0.x = pk2(o0[u][4 * g] * inv, o0[u][4 * g + 1] * inv); w0.y = pk2(o0[u][4 * g + 2] * inv, o0[u][4 * g + 3] * inv);
            v2u w1; w1.x = pk2(o1[u][4 * g] * inv, o1[u][4 * g + 1] * inv); w1.y = pk2(o1[u][4 * g + 2] * inv, o1[u][4 * g + 3] * inv);
            *(v2u*)(orow + 8 * g + 4 * hi) = w0; *(v2u*)(orow + 32 + 8 * g + 4 * hi) = w1;
        }
    }
    __syncthreads();
    return *flag == 0u;
#undef ATT_TROW
#undef ATT_LOAD
#undef ATT_STORE
}
}

template <int VM = 0>
__device__ __forceinline__ void phase_attn(const Frame& F, int lq) {
    const int l = lq & 3;
    const bf16* P = (const bf16*)(F.ws + WS_PB); const bf16* QD = (const bf16*)(F.ws + WS_QD); const bf16* KD = (const bf16*)(F.ws + WS_KD);
    const bf16* VD = (const bf16*)(F.ws + WS_VD); bf16* O = (bf16*)(F.ws + (lq >= 4 ? WS_ACT : WS_HA));
    unsigned* ctr = (unsigned*)(F.ws + WS_CTL) + CW_QUEUE + 64 * 8 * lq;
    LAS float* bias = (LAS float*)(F.lds + att::BIAS_OFF);
    { const float* nab = INP(I_NABIAS) + l * 4 * 465; for (int i = F.tid; i < 4 * 465; i += NTHR) bias[i] = nab[i] * LOG2E; }
    const float* sinks = INP(I_SINK) + l * 4;
    __syncthreads();
    const float* t32 = (const float*)(F.ws + WS_T32);
    volatile LAS unsigned* flag = F.MISC + MI_Q + 1;
    const int nloc = 256 + (l < NL - 1 ? 24 : 0);
    const int q0 = (int)xb_xcc_id();
    for (int qq = 0; qq < 8; ++qq) {
      const int q = (q0 + qq) & 7;
      unsigned* qctr = ctr + 64 * q;
      for (;;) {
        if (F.tid == 0) F.MISC[MI_Q] = __hip_atomic_fetch_add(qctr, 1u, __ATOMIC_RELAXED, __HIP_MEMORY_SCOPE_AGENT);
        __syncthreads();
        const int li = (int)F.MISC[MI_Q];
        __syncthreads();
        if (li >= nloc) break;
        int idx;
        if (li < 64) idx = (q + 8 * (li >> 3)) * 8 + (li & 7);
        else if (li < 128) { const int jx = li - 64; idx = 1024 + (q + 8 * (jx >> 4)) * 16 + (jx & 15); }
        else if (li < 192) { const int jx = li - 128; idx = 1536 + (q + 8 * (jx >> 3)) * 8 + (jx & 7); }
        else if (li < 256) { const int jx = li - 192; idx = 2048 + (q + 8 * (jx >> 4)) * 16 + (jx & 15); }
        else if (li < 264) idx = 2560 + q + 8 * (li - 256);
        else idx = 2624 + q + 8 * (li - 264);
        if (idx < 512) {
            const int b = idx >> 5, h = (idx >> 3) & 3, qt = idx & 7; const size_t rb = (size_t)b * TT;
            if (!att::unit_h<96, 0, VM>(F.lds, QD + rb * 384 + h * 96, 384, KD + rb * 384 + h * 96, 384, VD + rb * 256 + h * 64, 256, O + rb * D + 768 + h * 64, 3, qt, 0, 64, 68, 0.10206207261596575f * LOG2E, 0.f, 0.f, false, bias, t32, flag)) {
#pragma unroll 1
                for (int k2 = 0; k2 < 2; ++k2)
                    att::unit<96, VM>(F.lds, QD + rb * 384 + h * 96, 384, KD + rb * 384 + h * 96, 384, VD + rb * 256 + h * 64, 256, O + rb * D + 768 + h * 64, 3, 2 * qt + k2, 0, 64, 68, 0.10206207261596575f * LOG2E, 0.f, false, bias, t32, nullptr);
            }
        } else if (idx < 1024) {
        } else if (idx < 2560) {
            idx -= 1024;
            const int grp = idx >> 9, rem = idx & 511, b = rem >> 5; const size_t rb = (size_t)b * TT;
            if (grp == 1) {
                const int h = (rem >> 3) & 3, qt = rem & 7; const int lo = min(max(8 * qt - 4, 0), 56), n1 = min(max(8 * qt + 3, 0), 56) + 7 - lo + 1;
                if (!att::unit_h<64, 0, VM>(F.lds, P + rb * NPJ + h * 64, NPJ, P + rb * NPJ + 256 + h * 64, NPJ, P + rb * NPJ + 512 + h * 64, NPJ, O + rb * D + h * 64, 0, qt, lo, n1, n1 + 4, 0.125f * LOG2E, 0.f, 0.f, false, bias + h * 465, t32, flag))
                att::unit2<64, 0, VM>(F.lds, P + rb * NPJ + h * 64, NPJ, P + rb * NPJ + 256 + h * 64, NPJ, P + rb * NPJ + 512 + h * 64, NPJ, O + rb * D + h * 64, 0, qt, lo, n1, n1 + 4,
                                  0.125f * LOG2E, 0.f, 0.f, false, bias + h * 465, t32);
            } else {
                const int g = (rem >> 4) & 1, qt = rem & 15; const bool isc = grp == 2;
                const int lo = isc ? max(4 * qt - 2, 0) : 0, n1 = isc ? min(4 * qt + 5, 63) - lo + 1 : 64;
                const int qc = (isc ? 1280 : 768) + g * 128, kc = (isc ? 1536 : 1024) + g * 64, vc = (isc ? 1664 : 1152) + g * 64;
                const float sk0 = isc ? sinks[2 * g] * LOG2E : 0.f, sk1 = isc ? sinks[2 * g + 1] * LOG2E : 0.f;
                if (!att::unit_h<64, 1, VM>(F.lds, P + rb * NPJ + qc, NPJ, P + rb * NPJ + kc, NPJ, P + rb * NPJ + vc, NPJ, O + rb * D + (isc ? 512 : 256) + g * 128, isc ? 2 : 1, qt, lo, n1, n1 + 4, 0.125f * LOG2E, sk0, sk1, isc, bias, t32, flag))
                att::unit2<64, 1, VM>(F.lds, P + rb * NPJ + qc, NPJ, P + rb * NPJ + kc, NPJ, P + rb * NPJ + vc, NPJ, O + rb * D + (isc ? 512 : 256) + g * 128, isc ? 2 : 1, qt, lo, n1, n1 + 4,
                                  0.125f * LOG2E, isc ? sinks[2 * g] * LOG2E : 0.f, isc ? sinks[2 * g + 1] * LOG2E : 0.f, isc, bias, t32);
            }
        } else if (idx < 2624) {
            const int rem = idx - 2560, b = rem >> 2, isc = (rem >> 1) & 1, g = rem & 1; const size_t rb = (size_t)b * TT;
            const int qc = (isc ? 1280 : 768) + g * 128, kc = (isc ? 1536 : 1024) + g * 64, vc = (isc ? 1664 : 1152) + g * 64;
            att::unit2<64, 1, VM>(F.lds, P + rb * NPJ + qc, NPJ, P + rb * NPJ + kc, NPJ, P + rb * NPJ + vc, NPJ, O + rb * D + (isc ? 512 : 256) + g * 128, isc ? 2 : 1, 16, 0, 0, 4,
                              0.125f * LOG2E, isc ? sinks[2 * g] * LOG2E : 0.f, isc ? sinks[2 * g + 1] * LOG2E : 0.f, isc != 0, bias, t32);
        } else {
            const int rem = idx - 2624, b = rem >> 3, isd = (rem >> 2) & 1, h = rem & 3; const size_t rb = (size_t)b * TT;
            if (isd) att::unit<96, VM>(F.lds, QD + rb * 384 + h * 96, 384, KD + rb * 384 + h * 96, 384, VD + rb * 256 + h * 64, 256, O + rb * D + 768 + h * 64, 3, 16, 0, 0, 4, 0.10206207261596575f * LOG2E, 0.f, false, bias, t32, nullptr);
            else att::unit<64, VM>(F.lds, P + rb * NPJ + h * 64, NPJ, P + rb * NPJ + 256 + h * 64, NPJ, P + rb * NPJ + 512 + h * 64, NPJ, O + rb * D + h * 64, 0, 16, 0, 0, 4, 0.125f * LOG2E, 0.f, false, bias + h * 465, nullptr, nullptr);
        }
    }
    }
}


#define PHASE_FN static __device__ __forceinline__ void
PHASE_FN ph_prologue(GAS unsigned char* ws) { const Frame F = make_frame(ws); phase_prologue(F); }
PHASE_FN ph_ln(GAS unsigned char* ws, int l) { const Frame F = make_frame(ws); phase_ln(F, l); }
PHASE_FN ph_gemm_in(GAS unsigned char* ws, int l) {
    const Frame F = make_frame(ws);
    pg8::Gemm g{(const bf16*)(F.ws + WS_HA), (const bf16*)(F.ws + WS_WIN), M, NPJ, D, D, nullptr}; pg8::StaticOrder S; S.init(M, NPJ, F.G, F.bid);
    pg8::EpiBf16NT<0> E{(bf16*)(F.ws + WS_PB), NPJ, nullptr, 0, 0, 1.f};
    pg8::gemm_phase<pg8::EpiBf16NT<0>, pg8::StaticOrder, true, true>(F.lds, g, S, E);
}
PHASE_FN ph_post(GAS unsigned char* ws, int l) { const Frame F = make_frame(ws); phase_post(F, l); }
PHASE_FN ph_gemm_mla(GAS unsigned char* ws, int l) {
    const Frame F = make_frame(ws);
    pg8::Gemm g{(const bf16*)(F.ws + WS_PB) + 1792, (const bf16*)(F.ws + WS_WD), M, 1024, 384, NPJ, nullptr}; pg8::StaticOrder S; S.init(M, 1024, F.G, F.bid);
    EpiMla E{(bf16*)(F.ws + WS_QD), (bf16*)(F.ws + WS_KD), (bf16*)(F.ws + WS_VD)};
    pg8::gemm_phase<EpiMla, pg8::StaticOrder, true, true>(F.lds, g, S, E);
}
template <int VM>
PHASE_FN ph_attn(GAS unsigned char* ws, int l) { const Frame F = make_frame(ws); phase_attn<VM>(F, l); }
PHASE_FN ph_gemm_out(GAS unsigned char* ws, int l) {
    const Frame F = make_frame(ws);
    pg8::Gemm g{(const bf16*)(F.ws + WS_HA), (const bf16*)(F.ws + WS_WOUT), M, D, D, D, nullptr};
    pg8::EpiBf16NT<0> E{(bf16*)(F.ws + WS_PB), D, nullptr, 0, 0, 1.f};
    if (l == NL - 1) { LatOrder S{F.G, F.bid}; pg8::gemm_phase<pg8::EpiBf16NT<0>, LatOrder, true, true>(F.lds, g, S, E); }
    else { pg8::StaticOrder S; S.init(M, D, F.G, F.bid); pg8::gemm_phase<pg8::EpiBf16NT<0>, pg8::StaticOrder, true, true>(F.lds, g, S, E); }
}
PHASE_FN ph_route(GAS unsigned char* ws, int l) { const Frame F = make_frame(ws); phase_route(F, l); }
PHASE_FN ph_permute(GAS unsigned char* ws, int l) { const Frame F = make_frame(ws); phase_permute(F, l); }
PHASE_FN ph_gemm_gu(GAS unsigned char* ws, int l) {
    const Frame F = make_frame(ws);
    moe_tables(F);
    pg8::Gemm g{(const bf16*)(F.ws + WS_HA), (const bf16*)(F.ws + WS_WGU), MS, 16384, D, D, (const int*)(F.ws + WS_QD)}; MoeOrder S{F.MISC + MI_PST, F.G, F.bid};
    EpiGU E{(bf16*)(F.ws + WS_ACT)};
    pg8::gemm_phase<EpiGU, MoeOrder, true, true, true>(F.lds, g, S, E);
}
PHASE_FN ph_gemm_dn(GAS unsigned char* ws, int l) {
    const Frame F = make_frame(ws);
    moe_tables(F);
    pg8::Gemm g{(const bf16*)(F.ws + WS_ACT), (const bf16*)(F.ws + WS_WDN), MS, 16384, 512, 512, nullptr}; MoeOrder S{F.MISC + MI_PST, F.G, F.bid};
    pg8::EpiBf16NT<0> E{(bf16*)(F.ws + WS_PB), D, nullptr, 1024, 0, 1.f};
    pg8::gemm_phase<pg8::EpiBf16NT<0>, MoeOrder, true, true>(F.lds, g, S, E);
}


#if MK_DEBUG
#ifndef DBG_MODE
#define DBG_MODE 0
#endif
__device__ __forceinline__ float oracle_attn(const Frame& F, int l, int r, int var, int h, int mode = 0) {
    const bf16* P = (const bf16*)(F.ws + WS_PB); const bf16* QD = (const bf16*)(F.ws + WS_QD); const bf16* KD = (const bf16*)(F.ws + WS_KD); const bf16* VD = (const bf16*)(F.ws + WS_VD);
    const bf16* O = (const bf16*)(F.ws + WS_HA); const float* t32 = (const float*)(F.ws + WS_T32);
    const int b = r / TT, t = r - b * TT; const bool lat = t < SEQ; const size_t rb = (size_t)b * TT;
    const int dk = var == 3 ? 96 : 64;
    const bf16* qp; const bf16* kp; const bf16* vp; int kpitch, vpitch;
    if (var == 3) { qp = QD + (size_t)r * 384 + h * 96; kp = KD + rb * 384 + h * 96; kpitch = 384; vp = VD + rb * 256 + h * 64; vpitch = 256; }
    else { const int qc = var == 0 ? h * 64 : var == 1 ? 768 + h * 64 : 1280 + h * 64, kc = var == 0 ? 256 + h * 64 : var == 1 ? 1024 + (h >> 1) * 64 : 1536 + (h >> 1) * 64,
           vc = var == 0 ? 512 + h * 64 : var == 1 ? 1152 + (h >> 1) * 64 : 1664 + (h >> 1) * 64;
           qp = P + (size_t)r * NPJ + qc; kp = P + rb * NPJ + kc; kpitch = NPJ; vp = P + rb * NPJ + vc; vpitch = NPJ; }
    LAS float* qs = (LAS float*)(F.lds + 65536) + F.wave * 128;
    for (int d = F.lane; d < dk; d += 64) qs[d] = __builtin_bit_cast(float, (unsigned)qp[d] << 16);
    asm volatile("s_waitcnt lgkmcnt(0)" ::: "memory");
    if (var == 3 && lat && F.lane < 32) {
        const int c = F.lane >> 3, e = F.lane & 7, gr = t >> 6, gc = t & 63; const float own = qs[64 + F.lane], par = qs[64 + (F.lane ^ 8)];
        const float cs = t32[((c < 2 ? gr : gc) * 8 + e) * 2], sn = t32[((c < 2 ? gr : gc) * 8 + e) * 2 + 1];
        const float nv = (c & 1) == 0 ? own * cs - par * sn : par * sn + own * cs;
        asm volatile("s_waitcnt lgkmcnt(0)" ::: "memory"); qs[64 + F.lane] = nv; }
    asm volatile("s_waitcnt lgkmcnt(0)" ::: "memory");
    const float scale = var == 3 ? 0.10206207261596575f : 0.125f;
    const int gr = t >> 6, gc = t & 63, r0 = min(max(gr - 4, 0), 56), c0 = min(max(gc - 8, 0), 48);
    float m = -3.0e38f, lsum = 0.f, acc[64];
#pragma unroll
    for (int d = 0; d < 64; ++d) acc[d] = 0.f;
    for (int j = F.lane; j < TT; j += 64) {
        bool ok = true; float bias = 0.f;
        if (!lat) ok = j >= SEQ;
        else if (j < SEQ) {
            if (var == 0) { const int kr = j >> 6, kc2 = j & 63; ok = kr >= r0 && kr <= r0 + 7 && kc2 >= c0 && kc2 <= c0 + 15;
                if (ok) bias = INP(I_NABIAS)[((l * 4 + h) * 15 + (kr - gr + 7)) * 31 + (kc2 - gc + 15)]; }
            else if (var == 2) ok = (j - t <= 128) && (t - j <= 128);
        }
        if (!ok) continue;
        float sc = 0.f; const bf16* kr_ = kp + (size_t)j * kpitch;
        for (int d = 0; d < dk; ++d) sc += qs[d] * __builtin_bit_cast(float, (unsigned)kr_[d] << 16);
        sc = sc * scale + bias;
        const float mn = fmaxf(m, sc), a = expf(m - mn), p = expf(sc - mn); m = mn; lsum = lsum * a + p;
        const bf16* vr = vp + (size_t)j * vpitch;
#pragma unroll
        for (int d = 0; d < 64; ++d) acc[d] = acc[d] * a + p * __builtin_bit_cast(float, (unsigned)vr[d] << 16);
    }
    float mg = m;
#pragma unroll
    for (int o = 1; o < 64; o <<= 1) mg = fmaxf(mg, __shfl_xor(mg, o));
    if (mode >= 1) {
        const unsigned* rec = (const unsigned*)(F.ws + WS_RS) + (size_t)r * 2; const float mk = __builtin_bit_cast(float, rec[0]), lk = __builtin_bit_cast(float, rec[1]);
        const float lref = wave_sum(lsum * expf(m - mg));
        const float lker = lk * exp2f(mk - mg * LOG2E);
        if (mode == 2) return fabsf(mk / LOG2E - mg);
        return fabsf(lker / lref - 1.0f);
    }
    const float f = expf(m - mg); lsum *= f; lsum = wave_sum(lsum);
    if (var == 2) lsum += expf(INP(I_SINK)[l * 4 + h] - mg);
    float err = 0.f, mag = 1.0e-6f;
    const bf16* orow = O + (size_t)r * D + var * 256 + h * 64;
#pragma unroll
    for (int d = 0; d < 64; ++d) { const float ref = wave_sum(acc[d] * f) / lsum; const float got = __builtin_bit_cast(float, (unsigned)orow[d] << 16);
        const float df = fabsf(got - ref); err = (df == df) ? fmaxf(err, df) : 1.0e30f; mag = fmaxf(mag, fabsf(ref)); }
    return err / mag;
}
__device__ __forceinline__ void phase_dump(const Frame& F, int code) {
    float* out = (float*)ptab_get(F, I_OUT);
    for (int r = F.gw; r < M; r += F.ngw) {
        const int b = r / TT, t = r - b * TT; if (t >= SEQ) continue;
        float v[16];
        if (code == 1) ld16bf((const bf16*)(F.ws + WS_HA) + (size_t)r * D, F.lane, v);
        else if (code == 2) ld16bf((const bf16*)(F.ws + WS_PB) + (size_t)r * NPJ, F.lane, v);
        else if (code == 3) ld16bf((const bf16*)(F.ws + WS_PB) + (size_t)r * NPJ + 1024, F.lane, v);
        else if (code == 4) ld16bf((const bf16*)(F.ws + WS_PB) + (size_t)r * NPJ + 1280, F.lane, v);
        else if (code == 5) ld16((const float*)(F.ws + WS_PB) + (size_t)r * D, F.lane, v);
        else if (code == 8) {
            const v4u w0 = *((const v4u*)((const bf16*)(F.ws + WS_HA) + (size_t)r * D) + F.lane), w1 = *((const v4u*)((const bf16*)(F.ws + WS_HA) + (size_t)r * D) + 64 + F.lane);
            float f[8]; int bad0 = 0, bad1 = 0; unpack8(w0, f);
#pragma unroll
            for (int i = 0; i < 8; ++i) { const unsigned u = __builtin_bit_cast(unsigned, f[i]); bad0 |= ((u & 0x7f800000u) == 0x7f800000u) ? 1 : 0; }
            unpack8(w1, f);
#pragma unroll
            for (int i = 0; i < 8; ++i) { const unsigned u = __builtin_bit_cast(unsigned, f[i]); bad1 |= ((u & 0x7f800000u) == 0x7f800000u) ? 1 : 0; }
            const unsigned long long m0 = __ballot(bad0), m1 = __ballot(bad1);
            const bool vA = (m0 & 0xffffffffull) != 0, vB = (m0 >> 32) != 0, vC = (m1 & 0xffffffffull) != 0, vD = (m1 >> 32) != 0;
            const float val = (float)(t + 1) * ((vA ? 1.0f : 0.f) + (vB ? 1.0e2f : 0.f) + (vC ? 1.0e4f : 0.f) + (vD ? 1.0e6f : 0.f));
#pragma unroll
            for (int i = 0; i < 16; ++i) v[i] = val;
        }
        else if (code == 9) { const unsigned cd = ((const unsigned*)(F.ws + WS_RS))[(size_t)r * 2]; float val = 0.f; if (cd) { val = 1.f; for (unsigned k = 0; k < cd; ++k) val *= 10.f; }
#pragma unroll
            for (int i = 0; i < 16; ++i) v[i] = val; }
        else if (code == 10) {
            const v4u w1 = *((const v4u*)((const bf16*)(F.ws + WS_HA) + (size_t)r * D) + 64 + F.lane);
            float f[8]; int bad1 = 0; unpack8(w1, f);
#pragma unroll
            for (int i = 0; i < 8; ++i) { const unsigned u = __builtin_bit_cast(unsigned, f[i]); bad1 |= ((u & 0x7f800000u) == 0x7f800000u) ? 1 : 0; }
            const bool vC = (__ballot(bad1) & 0xffffffffull) != 0;
            const bf16* pc = (const bf16*)(F.ws + WS_PB) + ((size_t)b * TT + SEQ + (t & 255)) * NPJ; int badp = 0;
            for (int c = F.lane; c < 288; c += 64) { const v4u w = *((const v4u*)pc + c); unpack8(w, f);
#pragma unroll
                for (int i = 0; i < 8; ++i) { const unsigned u = __builtin_bit_cast(unsigned, f[i]); badp |= ((u & 0x7f800000u) == 0x7f800000u) ? 1 : 0; } }
            float val = 0.f; if (vC) { val = 1.f; for (int k = 0; k <= (t & 15); ++k) val *= 10.f; }
            if (__any(badp)) val = 1.0e30f;
#pragma unroll
            for (int i = 0; i < 16; ++i) v[i] = val;
        }
        else if (code == 11) {
            const bf16* pr = (const bf16*)(F.ws + WS_PB) + (size_t)r * NPJ; int grp = -1;
            for (int c = F.lane; c < 288; c += 64) { const v4u w = *((const v4u*)pr + c); float f[8]; unpack8(w, f);
#pragma unroll
                for (int i = 0; i < 8; ++i) if (!(fabsf(f[i]) < 1.0e4f)) grp = (c * 8) >> 8; }
#pragma unroll
            for (int o = 1; o < 64; o <<= 1) { const int g2 = __shfl_xor(grp, o); grp = g2 > grp ? g2 : grp; }
            float val = 0.f; if (grp >= 0) { val = 100.f; for (int k = 0; k < grp; ++k) val *= 10.f; }
#pragma unroll
            for (int i = 0; i < 16; ++i) v[i] = val;
        }
        else if (code >= 20 && code < 24) {
            float val = 0.f;
            if ((t & 15) == 5) { for (int h = 0; h < 4; ++h) { const float e = oracle_attn(F, 0, r, code - 20, h); const float cls = e > 1.0e20f ? 3.f : e > 0.5f ? 2.f : e > 0.03f ? 1.f : 0.f; if (cls > 0.f) { float w = cls; for (int k = 0; k <= h; ++k) w *= 10.f; val = fmaxf(val, w); } } }
#pragma unroll
            for (int i = 0; i < 16; ++i) v[i] = val;
        }
        else if (code >= 30 && code < 46) {
            float val = 0.f;
            if ((t & 15) == 5) { const float e = oracle_attn(F, 0, r, (code - 30) >> 2, (code - 30) & 3, DBG_MODE); val = e > 10.f ? 1.0e4f : 1000.f * e; }
#pragma unroll
            for (int i = 0; i < 16; ++i) v[i] = val;
        }
        else if (code == 7) {
            auto bad16 = [&](const bf16* p, int nchunks) { int bad = 0; for (int c = F.lane; c < nchunks; c += 64) { const v4u w = *((const v4u*)p + c); float f[8]; unpack8(w, f);
#pragma unroll
                for (int i = 0; i < 8; ++i) { const unsigned u = __builtin_bit_cast(unsigned, f[i]); bad |= ((u & 0x7f800000u) == 0x7f800000u) ? 1 : 0; } } return __any(bad); };
            const int bP = bad16((const bf16*)(F.ws + WS_PB) + (size_t)r * NPJ, 288), bQ = bad16((const bf16*)(F.ws + WS_QD) + (size_t)r * 384, 48),
                      bK = bad16((const bf16*)(F.ws + WS_KD) + (size_t)r * 384, 48), bV = bad16((const bf16*)(F.ws + WS_VD) + (size_t)r * 256, 32), bO = bad16((const bf16*)(F.ws + WS_HA) + (size_t)r * D, 128);
            const float val = bP ? 1.0e6f : bQ ? 1.0e5f : bK ? 1.0e4f : bV ? 1.0e3f : bO ? 1.0e2f : 0.f;
#pragma unroll
            for (int i = 0; i < 16; ++i) v[i] = val;
        }
#pragma unroll
        for (int i = 0; i < 16; ++i) { const unsigned u = __builtin_bit_cast(unsigned, v[i]); if ((u & 0x7f800000u) == 0x7f800000u) v[i] = 777.0f; }
        st16(out + ((size_t)b * SEQ + t) * D, F.lane, v);
    }
}
static __device__ __forceinline__ void ph_dump(GAS unsigned char* ws, int code) { const Frame F = make_frame(ws); phase_dump(F, code); }
#endif
__global__ void __launch_bounds__(NTHR, 2) mk_fwd(Args args) {
    extern __shared__ __attribute__((aligned(16))) unsigned char lds_raw[];
    LAS unsigned char* lds = (LAS unsigned char*)lds_raw; volatile LAS unsigned* MISC = (volatile LAS unsigned*)(lds + MISC_OFF);
    const int tid = threadIdx.x;
    GAS unsigned char* ws = (GAS unsigned char*)args.ws;
    for (int u = tid; u < (LDS_BYTES - MISC_OFF) / 4; u += NTHR) MISC[u] = 0u;
    __syncthreads();
    if (tid < 28) { const unsigned long long p = tid < 27 ? (unsigned long long)args.in[tid] : (unsigned long long)args.out;
        LAS unsigned* t = (LAS unsigned*)(lds + PTAB_OFF) + 2 * tid; t[0] = (unsigned)p; t[1] = (unsigned)(p >> 32); }
    __syncthreads();
#if MK_MULTI
#define GRID_BAR() do { } while (0)
#else
    XcdBarrier bar = xcd_barrier_post((unsigned*)(ws + WS_CTL) + CW_BAR, MISC + MI_BAR);
#define GRID_BAR() xcd_barrier(bar)
#endif
    const int lo = args.ph_lo, hi = args.ph_hi;
#define IN(k) (lo <= (k) && (k) < hi)
#if MK_TIME
    unsigned long long tcat = 0ull, tb0 = 0ull;
#define TBEG() do { tb0 = __builtin_amdgcn_s_memrealtime(); } while (0)
#define TEND(c) do { if ((c) == MK_TIME - 1) tcat += __builtin_amdgcn_s_memrealtime() - tb0; } while (0)
#define SEAM(k) do { if (IN(k) && IN((k) + 1)) { TBEG(); GRID_BAR(); TEND(1); } } while (0)
#else
#define TBEG() do { } while (0)
#define TEND(c) do { } while (0)
#define SEAM(k) do { if (IN(k) && IN((k) + 1)) GRID_BAR(); } while (0)
#endif

#if MK_DEBUG
    if (lo >= 100) { ph_dump(ws, lo - 100); return; }
#endif
    if (IN(0)) { TBEG(); ph_prologue(ws); TEND(2); } SEAM(0);
    for (int l = 0; l < NL; ++l) {
        const int pb = 1 + 10 * l;
        if (IN(pb + 0)) { TBEG(); ph_ln(ws, l); TEND(0); } SEAM(pb + 0);
        if (IN(pb + 1)) { TBEG(); ph_gemm_in(ws, l); if (MK_DUP & 2) { GRID_BAR(); ph_gemm_in(ws, l); } TEND(3); } SEAM(pb + 1);
        if (IN(pb + 2)) { TBEG(); ph_post(ws, l); TEND(0); } SEAM(pb + 2);
        if (IN(pb + 3)) { TBEG(); ph_gemm_mla(ws, l); if (MK_DUP & 8) { GRID_BAR(); ph_gemm_mla(ws, l); } TEND(3); } SEAM(pb + 3);
        if (IN(pb + 4)) { TBEG(); ph_attn<0>(ws, l); if (MK_DUP & 16) { GRID_BAR(); ph_attn<MK_VM>(ws, l + 4); } TEND(4); } SEAM(pb + 4);
        if (IN(pb + 5)) { TBEG(); ph_gemm_out(ws, l); if (MK_DUP & 32) { GRID_BAR(); ph_gemm_out(ws, l); } TEND(3); } SEAM(pb + 5);
        if (IN(pb + 6)) { TBEG(); ph_route(ws, l); TEND(0); } SEAM(pb + 6);
        if (IN(pb + 7)) { TBEG(); ph_permute(ws, l); if (MK_DUP & 128) { GRID_BAR(); ph_permute(ws, l); } TEND(0); } SEAM(pb + 7);
        if (IN(pb + 8)) { TBEG(); ph_gemm_gu(ws, l); if (MK_DUP & 256) { GRID_BAR(); ph_gemm_gu(ws, l); } TEND(3); } SEAM(pb + 8);
        if (IN(pb + 9)) { TBEG(); ph_gemm_dn(ws, l); if (MK_DUP & 512) { GRID_BAR(); ph_gemm_dn(ws, l); } TEND(3); } SEAM(pb + 9);
    }
    if (IN(NPHASE - 1)) { TBEG(); ph_ln(ws, NL); TEND(0); }
#if MK_TIME
    if (blockIdx.x == 0) { const unsigned long long tw = __builtin_amdgcn_s_memrealtime(); const unsigned long long dl = tcat * (unsigned long long)MK_TMUL; while (__builtin_amdgcn_s_memrealtime() - tw < dl) __builtin_amdgcn_s_sleep(8); }
#endif
#undef IN
#undef SEAM
#undef GRID_BAR
}

extern "C" void kernel_launch(void* const* d_in, const int* in_sizes, int n_in, void* d_out, int out_size, void* d_ws, size_t ws_size, hipStream_t stream) {
    static int grid = 0;
    if (grid == 0) {
        if (n_in != 27 || out_size != NB * SEQ * D || ws_size < WS_END) { fprintf(stderr, "kernel_launch: unexpected problem (n_in %d, out %d, ws %zu < %zu)\n", n_in, out_size, ws_size, (size_t)WS_END); grid = -1; return; }
        int dev = 0, cus = 0, per_cu = 0;
        if (hipGetDevice(&dev) != hipSuccess || hipDeviceGetAttribute(&cus, hipDeviceAttributeMultiprocessorCount, dev) != hipSuccess) { grid = -1; return; }
        if (hipFuncSetAttribute((const void*)mk_fwd, hipFuncAttributeMaxDynamicSharedMemorySize, LDS_BYTES) != hipSuccess) { fprintf(stderr, "kernel_launch: hipFuncSetAttribute failed\n"); grid = -1; return; }
        if (hipOccupancyMaxActiveBlocksPerMultiprocessor(&per_cu, (const void*)mk_fwd, NTHR, LDS_BYTES) != hipSuccess || per_cu < 1) fprintf(stderr, "kernel_launch: occupancy query reports %d\n", per_cu);
        (void)hipGetLastError();
        grid = cus > 1024 ? 1024 : cus;
    }
    if (grid < 0) return;
    (void)hipMemsetAsync((char*)d_ws + WS_CTL, 0, CTL_BYTES, stream);
    Args a{};
    for (int i = 0; i < 27; ++i) a.in[i] = (const float*)d_in[i];
    a.out = (float*)d_out; a.ws = (unsigned char*)d_ws;
#if MK_MULTI
#ifndef DBG_NRUN
#define DBG_NRUN NPHASE
#endif
    for (int p = 0; p < DBG_NRUN; ++p) { a.ph_lo = p; a.ph_hi = p + 1; hipLaunchKernelGGL(mk_fwd, dim3(grid), dim3(NTHR), LDS_BYTES, stream, a); }
#ifdef DBG_DUMP
    a.ph_lo = 100 + DBG_DUMP; a.ph_hi = 101 + DBG_DUMP; hipLaunchKernelGGL(mk_fwd, dim3(grid), dim3(NTHR), LDS_BYTES, stream, a);
#endif
#else
    a.ph_lo = 0; a.ph_hi = NPHASE;
    hipLaunchKernelGGL(mk_fwd, dim3(grid), dim3(NTHR), LDS_BYTES, stream, a);
#endif
}
```

```cpp
#include <hip/hip_runtime.h>
#include <cstdio>
#include <cstdint>
namespace pg8 {
#define PG8_LAS __attribute__((address_space(3)))
typedef unsigned short bf16_t;
typedef short bf16x8 __attribute__((ext_vector_type(8)));
typedef float f32x4 __attribute__((ext_vector_type(4)));
typedef unsigned u32x4 __attribute__((ext_vector_type(4)));
constexpr int BM = 256, BK = 64, HALF = 128, HTB = HALF * BK * 2  , STAGE_BYTES = 8 * HTB, NXCD = 8, WGM = 8;

__host__ __device__ __forceinline__ int lds_byte(int r, int c) { const int st = (r >> 4) * 2 + (c >> 5), rr = r & 15, cc = c & 31, ob = rr * 64 + cc * 2; return st * 1024 + (ob ^ (((ob >> 9) & 1) << 5)); }
__host__ __device__ __forceinline__ void stage_rc(int b, int& R, int& C) { const int st = b / 1024, sb = b % 1024, swz = sb ^ (((sb >> 9) & 1) << 5); R = (st >> 1) * 16 + swz / 64; C = (st & 1) * 32 + (swz % 64) / 2; }
__host__ __device__ __forceinline__ int perm32(int rho) { const int n = rho >> 4, i = rho & 15; return 8 * (i >> 2) + 4 * n + (i & 3); }

struct Unit { int pm, pn; };
struct Gemm { const bf16_t* A; const bf16_t* Bt; int M, N, K, lda; const int* src; };

struct StaticOrder {
    int nM, nN, nwg, G, c;
    __host__ __device__ void init(int M, int N, int G_, int c_) { nM = M / BM; nN = N / BM; nwg = nM * nN; G = G_; c = c_; }
    __host__ __device__ bool next(int i, Unit& u) const {
        const long L = (long)i * G + c; if (L >= nwg) return false;
        int wgid = (int)L; { const int q = nwg / NXCD, r = nwg % NXCD, xcd = wgid % NXCD, off = wgid / NXCD; wgid = (xcd < r ? xcd * (q + 1) : r * (q + 1) + (xcd - r) * q) + off; }
        const int nig = WGM * nN, gid = wgid / nig, fm = gid * WGM, gsz = (nM - fm) < WGM ? (nM - fm) : WGM;
        u.pm = fm + ((wgid % nig) % gsz); u.pn = (wgid % nig) / gsz; return true;
    }
    __device__ __forceinline__ void a_ready(const Unit&) const {}
    __device__ __forceinline__ void done(const Unit&) const {}
};

__device__ __forceinline__ unsigned cvt_pk_bf16(float lo, float hi) { unsigned r; asm volatile("v_cvt_pk_bf16_f32 %0, %1, %2" : "=v"(r) : "v"(lo), "v"(hi)); return r; }
typedef float f32x2 __attribute__((ext_vector_type(2)));
__device__ __forceinline__ f32x2 gelu_pk(f32x2 v) {
    const f32x2 av = __builtin_elementwise_abs(v), d = av * 0.2316418882f + 1.0f;
    f32x2 t; t.x = __builtin_amdgcn_rcpf(d.x); t.y = __builtin_amdgcn_rcpf(d.y);
    f32x2 q = t * 0.5307027145f + (-0.7265760135f); q = q * t + 0.7107068705f; q = q * t + (-0.142248368f); q = q * t + 0.127414796f; q = q * t;
    const f32x2 s = (v * v) * (-0.72134752044f);
    f32x2 e; e.x = __builtin_amdgcn_exp2f(s.x); e.y = __builtin_amdgcn_exp2f(s.y);
    const f32x2 m = v * (q * e), r = v - m;
    f32x2 o; o.x = v.x < 0.f ? m.x : r.x; o.y = v.y < 0.f ? m.y : r.y; return o;
}

template <int ACT  > struct EpiBf16 {
    static constexpr bool PERM = true, AFTER_DRAIN = false; static_assert(ACT == 0 || ACT == 1, "EpiBf16: ACT is 0 (none) or 1 (gelu_pk)");
    bf16_t* O; int ldc; const float* bias; int split_cols; size_t split_stride; float scale0;
    __device__ __forceinline__ void operator()(const f32x4 (&acc)[2][2][4][2], const Unit& u, int wr, int wc, int fr, int fq) const {
        const int row0 = u.pm * BM + wr * 64 + fr; int colt = u.pn * BM; bf16_t* base = O;
        float sc = 1.f; if (split_cols) { const int t = colt / split_cols; base += (size_t)t * split_stride; colt -= t * split_cols; if (t == 0) sc = scale0; }
        const int col0 = colt + wc * 32 + 8 * fq, bcol0 = u.pn * BM + wc * 32 + 8 * fq;
        f32x4 bv[2][2];
#pragma unroll
        for (int bj = 0; bj < 2; ++bj)
#pragma unroll
            for (int n = 0; n < 2; ++n) bv[bj][n] = bias ? *(const f32x4*)(bias + bcol0 + bj * HALF + 4 * n) : (f32x4){0.f, 0.f, 0.f, 0.f};
#pragma unroll
        for (int ai = 0; ai < 2; ++ai)
#pragma unroll
            for (int m = 0; m < 4; ++m) { bf16_t* rowp = base + (size_t)(row0 + ai * HALF + m * 16) * ldc + col0;
#pragma unroll
                for (int bj = 0; bj < 2; ++bj) { f32x4 v0 = acc[ai][bj][m][0] + bv[bj][0], v1 = acc[ai][bj][m][1] + bv[bj][1];
                    if (ACT == 1) { f32x2 a = gelu_pk((f32x2){v0[0], v0[1]}), b = gelu_pk((f32x2){v0[2], v0[3]}), c = gelu_pk((f32x2){v1[0], v1[1]}), d = gelu_pk((f32x2){v1[2], v1[3]});
                        v0 = (f32x4){a.x, a.y, b.x, b.y}; v1 = (f32x4){c.x, c.y, d.x, d.y}; }
                    v0 = v0 * sc; v1 = v1 * sc; u32x4 w; w.x = cvt_pk_bf16(v0[0], v0[1]); w.y = cvt_pk_bf16(v0[2], v0[3]); w.z = cvt_pk_bf16(v1[0], v1[1]); w.w = cvt_pk_bf16(v1[2], v1[3]);
                    *(u32x4*)(rowp + bj * HALF) = w; } }
    }
};
template <int ACT  > struct EpiBf16NT {
    static constexpr bool PERM = true, AFTER_DRAIN = false; static_assert(ACT == 0 || ACT == 1, "EpiBf16: ACT is 0 (none) or 1 (gelu_pk)");
    bf16_t* O; int ldc; const float* bias; int split_cols; size_t split_stride; float scale0;
    __device__ __forceinline__ void operator()(const f32x4 (&acc)[2][2][4][2], const Unit& u, int wr, int wc, int fr, int fq) const {
        const int row0 = u.pm * BM + wr * 64 + fr; int colt = u.pn * BM; bf16_t* base = O;
        float sc = 1.f; if (split_cols) { const int t = colt / split_cols; base += (size_t)t * split_stride; colt -= t * split_cols; if (t == 0) sc = scale0; }
        const int col0 = colt + wc * 32 + 8 * fq, bcol0 = u.pn * BM + wc * 32 + 8 * fq;
        f32x4 bv[2][2];
#pragma unroll
        for (int bj = 0; bj < 2; ++bj)
#pragma unroll
            for (int n = 0; n < 2; ++n) bv[bj][n] = bias ? *(const f32x4*)(bias + bcol0 + bj * HALF + 4 * n) : (f32x4){0.f, 0.f, 0.f, 0.f};
#pragma unroll
        for (int ai = 0; ai < 2; ++ai)
#pragma unroll
            for (int m = 0; m < 4; ++m) { bf16_t* rowp = base + (size_t)(row0 + ai * HALF + m * 16) * ldc + col0;
#pragma unroll
                for (int bj = 0; bj < 2; ++bj) { f32x4 v0 = acc[ai][bj][m][0] + bv[bj][0], v1 = acc[ai][bj][m][1] + bv[bj][1];
                    if (ACT == 1) { f32x2 a = gelu_pk((f32x2){v0[0], v0[1]}), b = gelu_pk((f32x2){v0[2], v0[3]}), c = gelu_pk((f32x2){v1[0], v1[1]}), d = gelu_pk((f32x2){v1[2], v1[3]});
                        v0 = (f32x4){a.x, a.y, b.x, b.y}; v1 = (f32x4){c.x, c.y, d.x, d.y}; }
                    v0 = v0 * sc; v1 = v1 * sc; u32x4 w; w.x = cvt_pk_bf16(v0[0], v0[1]); w.y = cvt_pk_bf16(v0[2], v0[3]); w.z = cvt_pk_bf16(v1[0], v1[1]); w.w = cvt_pk_bf16(v1[2], v1[3]);
                    __builtin_nontemporal_store(w, (u32x4*)(rowp + bj * HALF)); } }
    }
};
struct EpiF32 {
    static constexpr bool PERM = false, AFTER_DRAIN = false;
    float* C; int ldc; const float* bias;
    __device__ __forceinline__ void operator()(const f32x4 (&acc)[2][2][4][2], const Unit& u, int wr, int wc, int fr, int fq) const {
        const int row0 = u.pm * BM + wr * 64 + fr, col0 = u.pn * BM + wc * 32 + 4 * fq;
        f32x4 bv[2][2];
#pragma unroll
        for (int bj = 0; bj < 2; ++bj)
#pragma unroll
            for (int n = 0; n < 2; ++n) bv[bj][n] = bias ? *(const f32x4*)(bias + col0 + bj * HALF + n * 16) : (f32x4){0.f, 0.f, 0.f, 0.f};
#pragma unroll
        for (int ai = 0; ai < 2; ++ai)
#pragma unroll
            for (int m = 0; m < 4; ++m) { float* rowp = C + (size_t)(row0 + ai * HALF + m * 16) * ldc + col0;
#pragma unroll
                for (int bj = 0; bj < 2; ++bj)
#pragma unroll
                    for (int n = 0; n < 2; ++n) *(f32x4*)(rowp + bj * HALF + n * 16) = acc[ai][bj][m][n] + bv[bj][n]; }
    }
};
template <class Epi, class Sched, bool ALIGN_EPI = false, bool SP2 = false, bool GATHER = false>
__device__ __forceinline__ void gemm_phase(PG8_LAS unsigned char* lds, const Gemm g, const Sched& S, const Epi& E) {
    int tid = threadIdx.x; asm volatile("" : "+v"(tid)); const int wid = __builtin_amdgcn_readfirstlane(tid >> 6), lane = tid & 63, wr = wid >> 2, wc = wid & 3, fr = lane & 15, fq = lane >> 4;
    const int K = g.K, nt = K / BK;
    unsigned voffA[2], voffB[2]; int RA[2]; unsigned CA2[2];
#pragma unroll
    for (int i = 0; i < 2; ++i) { int R, C; stage_rc(tid * 16 + i * 8192, R, C); const int Rb = Epi::PERM ? ((R & ~31) + perm32(R & 31)) : R;
        voffA[i] = (unsigned)(R * g.lda + C) * 2u; voffB[i] = (unsigned)(Rb * K + C) * 2u; RA[i] = R; CA2[i] = (unsigned)C * 2u; }
    unsigned gcur[2][2] = {{0u, 0u}, {0u, 0u}}, gnxt[2][2] = {{0u, 0u}, {0u, 0u}};
#define PG8_GOFF(dst, u_) do { _Pragma("unroll") for (int h_ = 0; h_ < 2; ++h_) _Pragma("unroll") for (int i_ = 0; i_ < 2; ++i_) \
        dst[h_][i_] = (unsigned)g.src[(u_).pm * BM + h_ * HALF + RA[i_]] * (unsigned)(g.lda * 2) + CA2[i_]; } while (0)
#define PG8_STAGE_A(bufoff, gbase, h, nx) do { if constexpr (GATHER) { unsigned vs_[2] = {(nx) ? gnxt[h][0] : gcur[h][0], (nx) ? gnxt[h][1] : gcur[h][1]}; PG8_STAGE(bufoff, gbase, vs_); } \
        else { PG8_STAGE(bufoff, (gbase) + ((h) ? hstepA : 0), voffA); } } while (0)
    const size_t kstep = (size_t)(BK * 2);
    const size_t hstepA = (size_t)HALF * g.lda * 2, hstepB = (size_t)HALF * K * 2;
    const size_t tstepA = 2 * hstepA, tstepB = 2 * hstepB;
    const unsigned ldsw = (unsigned)wid * 1024u;
    const int aoff = lds_byte(wr * 64 + fr, fq * 8), boff = lds_byte(wc * 32 + fr, fq * 8);
#define PG8_SA(b, h) (((b) * 2 + (h)) * HTB)
#define PG8_SB(b, h) ((4 + (b) * 2 + (h)) * HTB)
#define PG8_STAGE(bufoff, gbase, voff) do { _Pragma("unroll") for (int _i = 0; _i < 2; ++_i) \
        __builtin_amdgcn_global_load_lds((const unsigned*)((const char*)(gbase) + (voff)[_i]), (PG8_LAS unsigned*)(lds + (bufoff) + ldsw + _i * 8192), 16, 0, 0); } while (0)
#define PG8_LDA(dst, b, h) do { _Pragma("unroll") for (int m = 0; m < 4; ++m) _Pragma("unroll") for (int k = 0; k < 2; ++k) dst[m][k] = *(const PG8_LAS bf16x8*)(lds + PG8_SA(b, h) + aoff + m * 2048 + k * 1024); } while (0)
#define PG8_LDB(dst, b, h) do { _Pragma("unroll") for (int n = 0; n < 2; ++n) _Pragma("unroll") for (int k = 0; k < 2; ++k) dst[n][k] = *(const PG8_LAS bf16x8*)(lds + PG8_SB(b, h) + boff + n * 2048 + k * 1024); } while (0)
#define PG8_MMA(ai, bj, At, Bt) do { __builtin_amdgcn_s_setprio(1); _Pragma("unroll") for (int m = 0; m < 4; ++m) _Pragma("unroll") for (int n = 0; n < 2; ++n) _Pragma("unroll") for (int k = 0; k < 2; ++k) \
        acc[ai][bj][m][n] = __builtin_amdgcn_mfma_f32_16x16x32_bf16(Bt[n][k], At[m][k], acc[ai][bj][m][n], 0, 0, 0); __builtin_amdgcn_s_setprio(0); } while (0)
#define PG8_WAIT_V(n) asm volatile("s_waitcnt vmcnt(" #n ")" ::: "memory")
#define PG8_WAIT_L(n) asm volatile("s_waitcnt lgkmcnt(" #n ")" ::: "memory")
#define PG8_BAR __builtin_amdgcn_s_barrier()
#define PG8_SCHED __builtin_amdgcn_sched_barrier(0)
    Unit cur, nxt; int ui = 0;
    if (!S.next(0, cur)) return;
    f32x4 acc[2][2][4][2];
#pragma unroll
    for (int a = 0; a < 2; ++a)
#pragma unroll
        for (int b = 0; b < 2; ++b)
#pragma unroll
            for (int m = 0; m < 4; ++m)
#pragma unroll
                for (int n = 0; n < 2; ++n) acc[a][b][m][n] = (f32x4){0.f, 0.f, 0.f, 0.f};
    bf16x8 At[4][2], B0[2][2], B1[2][2];
    const char* cA = (const char*)g.A + (GATHER ? (size_t)0 : (size_t)cur.pm * tstepA); const char* cB = (const char*)g.Bt + (size_t)cur.pn * tstepB;
    if constexpr (GATHER) PG8_GOFF(gcur, cur);
    S.a_ready(cur);
    if constexpr (SP2) {
        PG8_STAGE(PG8_SB(0, 0), cB, voffB); PG8_STAGE(PG8_SB(0, 1), cB + hstepB, voffB); PG8_STAGE_A(PG8_SA(0, 0), cA, 0, false); PG8_STAGE_A(PG8_SA(0, 1), cA, 1, false);
        if (wr == 1) PG8_BAR;
        PG8_WAIT_V(2); PG8_BAR;
        PG8_STAGE(PG8_SB(1, 0), cB + kstep, voffB); PG8_STAGE_A(PG8_SA(1, 0), cA + kstep, 0, false); PG8_STAGE(PG8_SB(1, 1), cB + hstepB + kstep, voffB);
        PG8_WAIT_V(6); PG8_BAR;
    } else {
        PG8_STAGE(PG8_SB(0, 0), cB, voffB); PG8_STAGE_A(PG8_SA(0, 0), cA, 0, false); PG8_STAGE(PG8_SB(0, 1), cB + hstepB, voffB); PG8_STAGE_A(PG8_SA(0, 1), cA, 1, false);
        if (wr == 1) PG8_BAR;
        PG8_WAIT_V(4); PG8_BAR;
        PG8_STAGE(PG8_SB(1, 0), cB + kstep, voffB); PG8_STAGE_A(PG8_SA(1, 0), cA + kstep, 0, false); PG8_STAGE(PG8_SB(1, 1), cB + hstepB + kstep, voffB);
        PG8_WAIT_V(6); PG8_BAR;
    }
    for (;;) {
        const bool has_next = S.next(ui + 1, nxt);
        const char* nA = (has_next && !GATHER) ? (const char*)g.A + (size_t)nxt.pm * tstepA : cA; const char* nB = has_next ? (const char*)g.Bt + (size_t)nxt.pn * tstepB : cB;
        if constexpr (GATHER) { if (has_next) PG8_GOFF(gnxt, nxt); else { _Pragma("unroll") for (int h_ = 0; h_ < 2; ++h_) { gnxt[h_][0] = gcur[h_][0]; gnxt[h_][1] = gcur[h_][1]; } } }
#pragma unroll 1
        for (int t = 0; t < nt; t += 2) {
            const bool last = (t == nt - 2);
            const char* a1 = cA + (size_t)(t + 1) * kstep;
            const char* a2 = last ? nA : cA + (size_t)(t + 2) * kstep; const char* b2 = last ? nB : cB + (size_t)(t + 2) * kstep;
            const char* a3 = a2 + kstep; const char* b3 = b2 + kstep;
            if (last && has_next) S.a_ready(nxt);
            if constexpr (SP2) {
            PG8_LDB(B0, 0, 0); PG8_LDB(B1, 0, 1); PG8_SCHED; PG8_LDA(At, 0, 0); PG8_STAGE_A(PG8_SA(1, 1), a1, 1, false);
            PG8_WAIT_V(8); PG8_WAIT_L(0); PG8_BAR; PG8_MMA(0, 0, At, B0); PG8_MMA(0, 1, At, B1); PG8_BAR; PG8_SCHED;
            PG8_LDA(At, 0, 1); PG8_STAGE(PG8_SB(0, 0), b2, voffB); PG8_STAGE(PG8_SB(0, 1), b2 + hstepB, voffB); PG8_STAGE_A(PG8_SA(0, 0), a2, 0, last);
            PG8_WAIT_V(8); PG8_WAIT_L(0); PG8_BAR; PG8_MMA(1, 0, At, B0); PG8_MMA(1, 1, At, B1); PG8_BAR; PG8_SCHED;
            PG8_LDB(B0, 1, 0); PG8_LDB(B1, 1, 1); PG8_SCHED; PG8_LDA(At, 1, 0); PG8_STAGE_A(PG8_SA(0, 1), a2, 1, last);
            PG8_WAIT_V(8); PG8_WAIT_L(0); PG8_BAR; PG8_MMA(0, 0, At, B0); PG8_MMA(0, 1, At, B1); PG8_BAR; PG8_SCHED;
            PG8_LDA(At, 1, 1); PG8_STAGE(PG8_SB(1, 0), b3, voffB); PG8_STAGE(PG8_SB(1, 1), b3 + hstepB, voffB); PG8_STAGE_A(PG8_SA(1, 0), a3, 0, last);
            PG8_WAIT_V(8); PG8_WAIT_L(0); PG8_BAR; PG8_MMA(1, 0, At, B0); PG8_MMA(1, 1, At, B1); PG8_BAR; PG8_SCHED;
            } else {
            PG8_LDB(B0, 0, 0); PG8_SCHED; PG8_LDA(At, 0, 0); PG8_STAGE_A(PG8_SA(1, 1), a1, 1, false);
            PG8_WAIT_L(8); PG8_BAR; PG8_WAIT_L(0); PG8_MMA(0, 0, At, B0); PG8_BAR; PG8_SCHED;
            PG8_LDB(B1, 0, 1); PG8_STAGE(PG8_SB(0, 0), b2, voffB);
            PG8_BAR; PG8_WAIT_L(0); PG8_MMA(0, 1, At, B1); PG8_BAR;
            PG8_LDA(At, 0, 1); PG8_STAGE_A(PG8_SA(0, 0), a2, 0, last);
            PG8_BAR; PG8_WAIT_L(0); PG8_MMA(1, 0, At, B0); PG8_BAR; PG8_SCHED;
            PG8_STAGE(PG8_SB(0, 1), b2 + hstepB, voffB);
            PG8_WAIT_V(6); PG8_BAR; PG8_MMA(1, 1, At, B1); PG8_BAR;
            PG8_LDB(B0, 1, 0); PG8_SCHED; PG8_LDA(At, 1, 0); PG8_STAGE_A(PG8_SA(0, 1), a2, 1, last);
            PG8_WAIT_L(8); PG8_BAR; PG8_WAIT_L(0); PG8_MMA(0, 0, At, B0); PG8_BAR; PG8_SCHED;
            PG8_LDB(B1, 1, 1); PG8_STAGE(PG8_SB(1, 0), b3, voffB);
            PG8_BAR; PG8_WAIT_L(0); PG8_MMA(0, 1, At, B1); PG8_BAR;
            PG8_LDA(At, 1, 1); PG8_STAGE_A(PG8_SA(1, 0), a3, 0, last);
            PG8_BAR; PG8_WAIT_L(0); PG8_MMA(1, 0, At, B0); PG8_BAR; PG8_SCHED;
            PG8_STAGE(PG8_SB(1, 1), b3 + hstepB, voffB);
            PG8_WAIT_V(6); PG8_BAR; PG8_MMA(1, 1, At, B1); PG8_BAR;
            }
        }
        if constexpr (ALIGN_EPI) { if (wr == 0) PG8_BAR; }
        if constexpr (!Epi::AFTER_DRAIN) { E(acc, cur, wr, wc, fr, fq); S.done(cur); }
        if (!has_next) break;
#pragma unroll
        for (int a = 0; a < 2; ++a)
#pragma unroll
            for (int b = 0; b < 2; ++b)
#pragma unroll
                for (int m = 0; m < 4; ++m)
#pragma unroll
                    for (int n = 0; n < 2; ++n) acc[a][b][m][n] = (f32x4){0.f, 0.f, 0.f, 0.f};
        cur = nxt; cA = nA; cB = nB; ++ui;
        if constexpr (GATHER) { _Pragma("unroll") for (int h_ = 0; h_ < 2; ++h_) { gcur[h_][0] = gnxt[h_][0]; gcur[h_][1] = gnxt[h_][1]; } }
        if constexpr (ALIGN_EPI) { if (wr == 1) PG8_BAR; }
    }
    PG8_WAIT_V(0);
    if constexpr (!ALIGN_EPI) { if (wr == 0) PG8_BAR; }
    PG8_BAR;
    if constexpr (Epi::AFTER_DRAIN) { E.fused(acc, cur, wr, wc, fr, fq, lds, wid, lane); S.done(cur); }
#undef PG8_SA
#undef PG8_GOFF
#undef PG8_STAGE_A
#undef PG8_SB
#undef PG8_STAGE
#undef PG8_LDA
#undef PG8_LDB
#undef PG8_MMA
#undef PG8_WAIT_V
#undef PG8_WAIT_L
#undef PG8_BAR
#undef PG8_SCHED
}
}

constexpr int NB = 16, SEQ = 4096, CTX = 256, TT = SEQ + CTX, M = NB * TT, D = 1024, NL = 4;
constexpr int NPJ = 2304, DPROJ = 2208;
constexpr int MS = 143360;
constexpr float EPS = 1e-6f, ALPHA = 1.6817928305074290f, LOG2E = 1.4426950408889634f;
constexpr int NWAVES = 8, NTHR = 512;
#ifndef MK_DEBUG
#define MK_DEBUG 0
#endif
#ifndef MK_TIME
#define MK_TIME 0
#endif
#ifndef MK_TMUL
#define MK_TMUL 1
#endif
#ifndef MK_VM
#define MK_VM 0
#endif
#ifndef MK_DUP
#define MK_DUP 0
#endif
#ifndef MK_MULTI
#define MK_MULTI 0
#endif
constexpr int NPHASE = 2 + 10 * NL;

constexpr size_t WS_CTL = 0, CTL_BYTES = 65536;
constexpr size_t WS_MODS = WS_CTL + CTL_BYTES;
constexpr size_t WS_T64 = WS_MODS + (size_t)NL * 17 * 6144 * 4;
constexpr size_t WS_T32 = WS_T64 + 8192;
constexpr size_t WS_RS = WS_T32 + 4096;
constexpr size_t WS_RT = WS_RS + (size_t)M * 8;
constexpr size_t WS_HIST = WS_RT + (size_t)M * 32;
constexpr size_t WS_XS = WS_HIST + 65536;
constexpr size_t WS_WIN = WS_XS + (size_t)M * D * 2;
constexpr size_t WS_WD = WS_WIN + (size_t)NPJ * D * 2;
constexpr size_t WS_WOUT = WS_WD + (size_t)1024 * 384 * 2;
constexpr size_t WS_WGU = WS_WOUT + (size_t)D * D * 2;
constexpr size_t WS_WDN = WS_WGU + (size_t)16 * 1024 * 1024 * 2;
constexpr size_t WS_HA = WS_WDN + (size_t)16 * 1024 * 512 * 2;
constexpr size_t WS_PB = WS_HA + (size_t)M * D * 2;
constexpr size_t WS_QD = WS_PB + (size_t)M * NPJ * 2;
constexpr size_t WS_KD = WS_QD + (size_t)M * 384 * 2;
constexpr size_t WS_VD = WS_KD + (size_t)M * 384 * 2;
constexpr size_t WS_ACT = WS_VD + (size_t)M * 256 * 2;
constexpr size_t WS_END = WS_ACT + (size_t)MS * 512 * 2;
static_assert(WS_END <= (size_t)1073741824, "d_ws map must fit 1 GiB");
static_assert((size_t)M * NPJ * 2 >= (size_t)MS * D * 2 && (size_t)M * NPJ * 2 >= (size_t)M * D * 4, "region PB overlays");
constexpr int CW_BAR = 0;
constexpr int CW_QUEUE = 4096;

constexpr int RING_BYTES = 131072, MISC_OFF = RING_BYTES, LDS_BYTES = 147456;
constexpr int MI_BAR = 0, MI_Q = 4, MI_TOT = 16, MI_BASE = 32, MI_PST = 48, MI_LH = 80;

#define GAS __attribute__((address_space(1)))
#define LAS __attribute__((address_space(3)))
typedef unsigned short bf16;
typedef unsigned v4u __attribute__((ext_vector_type(4)));
typedef unsigned v2u __attribute__((ext_vector_type(2)));
typedef float f32x4 __attribute__((ext_vector_type(4)));
typedef float f32x2 __attribute__((ext_vector_type(2)));
typedef short bf16x8 __attribute__((ext_vector_type(8)));
typedef float f32x16 __attribute__((ext_vector_type(16)));
typedef short v4i16 __attribute__((ext_vector_type(4)));

__device__ __forceinline__ unsigned f2bf(float f) { unsigned u = __builtin_bit_cast(unsigned, f); return (u + 0x7fffu + ((u >> 16) & 1u)) >> 16; }
__device__ __forceinline__ unsigned pk2(float lo, float hi) { return f2bf(lo) | (f2bf(hi) << 16); }
__device__ __forceinline__ float bflo(unsigned w) { return __builtin_bit_cast(float, w << 16); }
__device__ __forceinline__ float bfhi(unsigned w) { return __builtin_bit_cast(float, w & 0xffff0000u); }
__device__ __forceinline__ void unpack8(v4u w, float (&f)[8]) { f[0] = bflo(w.x); f[1] = bfhi(w.x); f[2] = bflo(w.y); f[3] = bfhi(w.y); f[4] = bflo(w.z); f[5] = bfhi(w.z); f[6] = bflo(w.w); f[7] = bfhi(w.w); }
__device__ __forceinline__ v4u pack8(const float (&f)[8]) { v4u w; w.x = pk2(f[0], f[1]); w.y = pk2(f[2], f[3]); w.z = pk2(f[4], f[5]); w.w = pk2(f[6], f[7]); return w; }
__device__ __forceinline__ float wave_sum(float v) {
    int x = __builtin_bit_cast(int, v);
#define WS_DPP(ctrl, rmask) v += __builtin_bit_cast(float, __builtin_amdgcn_update_dpp(0, x, ctrl, rmask, 0xf, true)); x = __builtin_bit_cast(int, v)
    WS_DPP(0xB1, 0xf);
    WS_DPP(0x4E, 0xf);
    WS_DPP(0x141, 0xf);
    WS_DPP(0x140, 0xf);
    WS_DPP(0x142, 0xa);
    WS_DPP(0x143, 0xc);
#undef WS_DPP
    return __builtin_bit_cast(float, __builtin_amdgcn_readlane(__builtin_bit_cast(int, v), 63));
}

#define XB_TMO      128
#define XB_XCNT(j)  (256  + 64 * (j))
#define XB_XSUB(j)  (1280 + 64 * (j))
#define XB_XGEN(j)  (2304 + 64 * (j))
#define XB_TOP      3328
#define XB_TOPGEN   3392
#define XCD_BAR_WORDS 3456
#define XB_SPIN_CAP (1u << 22)
__device__ __forceinline__ unsigned xb_ld(unsigned* p)              { return __hip_atomic_load(p, __ATOMIC_RELAXED, __HIP_MEMORY_SCOPE_AGENT); }
__device__ __forceinline__ unsigned xb_add(unsigned* p, unsigned v) { return __hip_atomic_fetch_add(p, v, __ATOMIC_RELAXED, __HIP_MEMORY_SCOPE_AGENT); }
__device__ __forceinline__ unsigned xb_xcc_id() { return (unsigned)__builtin_amdgcn_s_getreg((3 << 11) | 20) & 0xFu; }
#define XB_SPIN(cond, bar) do { unsigned _sp = 0; while (cond) { __builtin_amdgcn_s_sleep(1); \
    if ((++_sp & 255u) == 0u) { if (xb_ld(&(bar)[XB_TMO])) break; if (_sp > XB_SPIN_CAP) { atomicAdd(&(bar)[XB_TMO], 1u); break; } } } } while (0)
struct XcdBarrier { unsigned* bar; unsigned x; volatile LAS unsigned* st; };
__device__ __forceinline__ XcdBarrier xcd_barrier_post(unsigned* bar, volatile LAS unsigned* st) {
    XcdBarrier b; b.bar = bar; b.x = xb_xcc_id(); b.st = st;
    if (threadIdx.x == 0) (void)xb_add(&bar[XB_XCNT(b.x)], 1u);
    return b;
}
__device__ __forceinline__ void xcd_barrier_complete(unsigned* bar, unsigned x, unsigned& nloc, unsigned& nx) {
    const unsigned G = gridDim.x * gridDim.y * gridDim.z;
    unsigned sum, cnt, mine, sp = 0u;
    for (;;) {
        sum = 0u; cnt = 0u; mine = 0u;
#pragma unroll
        for (unsigned j = 0; j < 16; ++j) { const unsigned c = xb_ld(&bar[XB_XCNT(j)]); sum += c; cnt += (c > 0u) ? 1u : 0u; mine = (j == x) ? c : mine; }
        if (sum == G) break;
        __builtin_amdgcn_s_sleep(1);
        if ((++sp & 255u) == 0u) { if (xb_ld(&bar[XB_TMO])) break; if (sp > XB_SPIN_CAP) { atomicAdd(&bar[XB_TMO], 1u); break; } }
    }
    nloc = mine > 0u ? mine : 1u; nx = cnt > 0u ? cnt : 1u;
}
__device__ __forceinline__ void xcd_barrier(const XcdBarrier& b) {
    asm volatile("s_waitcnt vmcnt(0)" ::: "memory");
    __syncthreads();
    if (threadIdx.x == 0) {
        unsigned* bar = b.bar;
        __builtin_amdgcn_s_waitcnt(0);
        unsigned nloc = b.st[0], nx = b.st[1];
        if (nloc == 0u) { xcd_barrier_complete(bar, b.x, nloc, nx); b.st[0] = nloc; b.st[1] = nx; }
        const unsigned old = xb_add(&bar[XB_XSUB(b.x)], 1u);
        const unsigned gen = old / nloc;
        if (old + 1u == (gen + 1u) * nloc) {
            __builtin_amdgcn_fence(__ATOMIC_RELEASE, "agent");
            asm volatile("s_waitcnt vmcnt(0)" ::: "memory");
            const unsigned og = xb_add(&bar[XB_TOP], 1u);
            const unsigned tg = og / nx;
            if (og + 1u == (tg + 1u) * nx) xb_add(&bar[XB_TOPGEN], 1u);
            else XB_SPIN(xb_ld(&bar[XB_TOPGEN]) == tg, bar);
            __builtin_amdgcn_fence(__ATOMIC_ACQUIRE, "agent");
            xb_add(&bar[XB_XGEN(b.x)], 1u);
            asm volatile("s_waitcnt vmcnt(0)" ::: "memory");
        } else {
            XB_SPIN(xb_ld(&bar[XB_XGEN(b.x)]) == gen, bar);
            __builtin_amdgcn_fence(__ATOMIC_ACQUIRE, "agent");
            asm volatile("s_waitcnt vmcnt(0)" ::: "memory");
        }
    }
    __syncthreads();
}

struct Args { const float* in[27]; float* out; unsigned char* ws; int ph_lo, ph_hi; };
enum { I_X = 0, I_C, I_CTX, I_CCTX, I_WADA, I_BADA, I_WIN, I_NABIAS, I_GQG, I_GKG, I_SINK, I_MQG, I_WQB, I_MKVG, I_WKVB, I_WOUT, I_LN1G, I_LN1B, I_RGW, I_RGB, I_REW, I_REB, I_WG, I_WU, I_WDN, I_LN2G, I_LN2B };

struct Frame {
    LAS unsigned char* lds; volatile LAS unsigned* MISC;
    int tid, lane, wave, G, gw, ngw, bid;
    GAS unsigned char* ws;
};
__device__ __forceinline__ int opaque_tid() { int t = threadIdx.x; asm volatile("" : "+v"(t)); return t; }
__device__ __forceinline__ int opaque_s(int x) { asm volatile("" : "+s"(x)); return x; }
constexpr int PTAB_OFF = MISC_OFF + 2048, I_OUT = 27;
__device__ __forceinline__ GAS unsigned char* ptab_get(const Frame& F, int i) {
    const LAS unsigned* t = (const LAS unsigned*)(F.lds + PTAB_OFF) + 2 * i;
    const unsigned lo = __builtin_amdgcn_readfirstlane(t[0]), hi = __builtin_amdgcn_readfirstlane(t[1]);
    return (GAS unsigned char*)(((unsigned long long)hi << 32) | lo);
}
#define INP(i) ((const float*)ptab_get(F, (i)))
__device__ __forceinline__ Frame make_frame(GAS unsigned char* ws) {
    extern __shared__ __attribute__((aligned(16))) unsigned char lds_raw[];
    Frame F;
    F.lds = (LAS unsigned char*)lds_raw; F.MISC = (volatile LAS unsigned*)(F.lds + MISC_OFF);
    F.tid = opaque_tid(); F.lane = F.tid & 63; F.wave = __builtin_amdgcn_readfirstlane(F.tid >> 6);
    F.G = opaque_s((int)gridDim.x); F.bid = opaque_s((int)blockIdx.x); F.gw = F.bid * NWAVES + F.wave; F.ngw = F.G * NWAVES;
    { unsigned long long w = (unsigned long long)ws; asm volatile("" : "+s"(w)); F.ws = (GAS unsigned char*)w; }
    return F;
}
typedef _Float16 f16x4 __attribute__((ext_vector_type(4)));
struct RowPtrs { const float* x; const float* ctx; float* out; _Float16* xs; };
__device__ __forceinline__ RowPtrs row_ptrs(const Frame& F) { RowPtrs p; p.x = INP(I_X); p.ctx = INP(I_CTX); p.out = (float*)ptab_get(F, I_OUT); p.xs = (_Float16*)(F.ws + WS_XS); return p; }
__device__ __forceinline__ const float* xin_row(const RowPtrs& P, int r) {
    const int b = r / TT, t = r - b * TT;
    return t < SEQ ? P.x + ((size_t)b * SEQ + t) * D : P.ctx + ((size_t)b * CTX + (t - SEQ)) * D;
}
__device__ __forceinline__ float* out_row(const RowPtrs& P, int r) { const int b = r / TT, t = r - b * TT; return P.out + ((size_t)b * SEQ + t) * D; }
__device__ __forceinline__ void ld16h(const _Float16* p, int lane, float (&v)[16]) {
    const f16x4* q = (const f16x4*)p + lane;
#pragma unroll
    for (int g = 0; g < 4; ++g) { const f32x4 f = __builtin_convertvector(__builtin_nontemporal_load(q + 64 * g), f32x4); v[4 * g] = f.x; v[4 * g + 1] = f.y; v[4 * g + 2] = f.z; v[4 * g + 3] = f.w; }
}
__device__ __forceinline__ void st16h(_Float16* p, int lane, const float (&v)[16]) {
    f16x4* q = (f16x4*)p + lane;
#pragma unroll
    for (int g = 0; g < 4; ++g) __builtin_nontemporal_store(__builtin_convertvector((f32x4){v[4 * g], v[4 * g + 1], v[4 * g + 2], v[4 * g + 3]}, f16x4), q + 64 * g);
}
__device__ __forceinline__ void ld16(const float* p, int lane, float (&v)[16]) {
    const f32x4* q = (const f32x4*)p + lane;
    const f32x4 a = q[0], b = q[64], c = q[128], d = q[192];
    v[0] = a.x; v[1] = a.y; v[2] = a.z; v[3] = a.w; v[4] = b.x; v[5] = b.y; v[6] = b.z; v[7] = b.w;
    v[8] = c.x; v[9] = c.y; v[10] = c.z; v[11] = c.w; v[12] = d.x; v[13] = d.y; v[14] = d.z; v[15] = d.w;
}
__device__ __forceinline__ void st16(float* p, int lane, const float (&v)[16]) {
    f32x4* q = (f32x4*)p + lane;
    q[0] = (f32x4){v[0], v[1], v[2], v[3]}; q[64] = (f32x4){v[4], v[5], v[6], v[7]};
    q[128] = (f32x4){v[8], v[9], v[10], v[11]}; q[192] = (f32x4){v[12], v[13], v[14], v[15]};
}
__device__ __forceinline__ void ld16nt(const float* p, int lane, float (&v)[16]) {
    const f32x4* q = (const f32x4*)p + lane;
    const f32x4 a = __builtin_nontemporal_load(q), b = __builtin_nontemporal_load(q + 64), c = __builtin_nontemporal_load(q + 128), d = __builtin_nontemporal_load(q + 192);
    v[0] = a.x; v[1] = a.y; v[2] = a.z; v[3] = a.w; v[4] = b.x; v[5] = b.y; v[6] = b.z; v[7] = b.w;
    v[8] = c.x; v[9] = c.y; v[10] = c.z; v[11] = c.w; v[12] = d.x; v[13] = d.y; v[14] = d.z; v[15] = d.w;
}
__device__ __forceinline__ void st16nt(float* p, int lane, const float (&v)[16]) {
    f32x4* q = (f32x4*)p + lane;
    __builtin_nontemporal_store((f32x4){v[0], v[1], v[2], v[3]}, q); __builtin_nontemporal_store((f32x4){v[4], v[5], v[6], v[7]}, q + 64);
    __builtin_nontemporal_store((f32x4){v[8], v[9], v[10], v[11]}, q + 128); __builtin_nontemporal_store((f32x4){v[12], v[13], v[14], v[15]}, q + 192);
}
__device__ __forceinline__ void unpack16(const v2u (&w)[4], float (&v)[16]) {
#pragma unroll
    for (int g = 0; g < 4; ++g) { v[4 * g] = bflo(w[g].x); v[4 * g + 1] = bfhi(w[g].x); v[4 * g + 2] = bflo(w[g].y); v[4 * g + 3] = bfhi(w[g].y); }
}
__device__ __forceinline__ void ld16bf_raw(const bf16* p, int lane, v2u (&w)[4]) {
    const v2u* q = (const v2u*)p + lane; w[0] = q[0]; w[1] = q[64]; w[2] = q[128]; w[3] = q[192];
}
__device__ __forceinline__ void ld16bf_raw_nt(const bf16* p, int lane, v2u (&w)[4]) {
    const v2u* q = (const v2u*)p + lane; w[0] = __builtin_nontemporal_load(q); w[1] = __builtin_nontemporal_load(q + 64); w[2] = __builtin_nontemporal_load(q + 128); w[3] = __builtin_nontemporal_load(q + 192);
}
__device__ __forceinline__ void ld16bf(const bf16* p, int lane, float (&v)[16]) { v2u w[4]; ld16bf_raw(p, lane, w); unpack16(w, v); }
__device__ __forceinline__ void ld16bf_nt(const bf16* p, int lane, float (&v)[16]) { v2u w[4]; ld16bf_raw_nt(p, lane, w); unpack16(w, v); }
__device__ __forceinline__ void st16bf(bf16* p, int lane, const float (&v)[16]) {
    v2u* q = (v2u*)p + lane;
#pragma unroll
    for (int g = 0; g < 4; ++g) { v2u w; w.x = pk2(v[4 * g], v[4 * g + 1]); w.y = pk2(v[4 * g + 2], v[4 * g + 3]); q[64 * g] = w; }
}
__device__ __forceinline__ void ln16(float (&v)[16]) {
    float s = 0.f;
#pragma unroll
    for (int i = 0; i < 16; ++i) s += v[i];
    const float mean = wave_sum(s) * (1.0f / D); float q = 0.f;
#pragma unroll
    for (int i = 0; i < 16; ++i) { v[i] -= mean; q += v[i] * v[i]; }
    const float rstd = 1.0f / sqrtf(wave_sum(q) * (1.0f / D) + EPS);
#pragma unroll
    for (int i = 0; i < 16; ++i) v[i] *= rstd;
}

__device__ __forceinline__ int rows_per_wave(int ngw) {
    int rpw = (M + ngw - 1) / ngw;
    if (!((SEQ % rpw) % 4 == 0 && (TT % rpw) == 0 && (rpw % 2) == 0)) rpw = (rpw + 3) & ~3;
    return rpw;
}
template <int TYPE>
__device__ __forceinline__ float conv_src(const float* p0, const float* p1, const float* g0, const float* g1, int l, int k, int n) {
    if (TYPE == 0) return n < DPROJ ? p0[((size_t)l * D + k) * DPROJ + n] : 0.f;
    if (TYPE == 1) { if (n < 384) return k < 256 ? g0[l * 256 + k] * p0[((size_t)l * 256 + k) * 384 + n] : 0.f;
                     if (n < 896) return k >= 256 ? g1[l * 128 + (k - 256)] * p1[((size_t)l * 128 + (k - 256)) * 512 + (n - 384)] : 0.f;
                     return 0.f; }
    if (TYPE == 2) return p0[((size_t)l * D + k) * D + n];
    if (TYPE == 3) { const int e = n >> 10, nn = n & 1023, q = nn >> 3, j = nn & 7;
                     return j < 4 ? p0[(((size_t)l * 16 + e) * D + k) * 512 + 4 * q + j] : p1[(((size_t)l * 16 + e) * D + k) * 512 + 4 * q + (j - 4)]; }
    { const int e = n >> 10, nn = n & 1023; return p0[(((size_t)l * 16 + e) * 512 + k) * D + nn]; }
}
template <int TYPE>
__device__ __forceinline__ void conv_item(const Frame& F, int l, int item, LAS float* scr) {
    constexpr int Nd = TYPE == 0 ? NPJ : TYPE == 1 ? 1024 : TYPE == 2 ? 1024 : 16384, Kd = TYPE == 1 ? 384 : TYPE == 4 ? 512 : 1024;
    bf16* dst = (bf16*)(F.ws + (TYPE == 0 ? WS_WIN : TYPE == 1 ? WS_WD : TYPE == 2 ? WS_WOUT : TYPE == 3 ? WS_WGU : WS_WDN));
    const float* p0 = INP(TYPE == 0 ? I_WIN : TYPE == 1 ? I_WQB : TYPE == 2 ? I_WOUT : TYPE == 3 ? I_WG : I_WDN);
    const float* p1 = INP(TYPE == 1 ? I_WKVB : I_WU); const float* g0 = INP(I_MQG); const float* g1 = INP(I_MKVG);
    constexpr int nblk = Nd / 32; const int kb = item / nblk, nb = item - kb * nblk, k0 = 64 * kb, n0 = 32 * nb, lane = F.lane;
#pragma unroll
    for (int i = 0; i < 32; ++i) { const int kk = 2 * i + (lane >> 5); scr[kk * 33 + (lane & 31)] = conv_src<TYPE>(p0, p1, g0, g1, l, k0 + kk, n0 + (lane & 31)); }
    asm volatile("s_waitcnt lgkmcnt(0)" ::: "memory");
    const int c = lane & 7;
#pragma unroll
    for (int j = 0; j < 4; ++j) { const int n = (lane >> 3) + 8 * j; const LAS float* s = scr + (8 * c) * 33 + n;
        v4u o; o.x = pk2(s[0 * 33], s[1 * 33]); o.y = pk2(s[2 * 33], s[3 * 33]); o.z = pk2(s[4 * 33], s[5 * 33]); o.w = pk2(s[6 * 33], s[7 * 33]);
        *(v4u*)(dst + (size_t)(n0 + n) * Kd + k0 + 8 * c) = o; }
    asm volatile("s_waitcnt lgkmcnt(0)" ::: "memory");
}
__device__ __forceinline__ void phase_prologue(const Frame& F) {
    {
        LAS float* sv = (LAS float*)F.lds;
        LAS float* red = (LAS float*)(F.lds + 17 * 1024 * 4);
        float* mods = (float*)(F.ws + WS_MODS);
        for (int u = F.bid; u < NL * 48; u += F.G) {
            const int l = u / 48, cc = u - l * 48;
            const float* pc = INP(I_C); const float* pcc = INP(I_CCTX);
            for (int i = F.tid; i < 17 * 1024; i += NTHR) { const int mr = i >> 10, k = i & 1023; const float c = mr < 16 ? pc[mr * 1024 + k] : pcc[k]; sv[i] = c / (1.0f + expf(-c)); }
            __syncthreads();
            const int col = F.tid & 127, kg = F.tid >> 7;
            float acc[17];
#pragma unroll
            for (int mr = 0; mr < 17; ++mr) acc[mr] = 0.f;
            const float* w = INP(I_WADA) + ((size_t)l * 1024 + kg * 256) * 6144 + cc * 128 + col;
            for (int k4 = 0; k4 < 256; k4 += 4) {
                const float w0 = w[(size_t)(k4 + 0) * 6144], w1 = w[(size_t)(k4 + 1) * 6144], w2 = w[(size_t)(k4 + 2) * 6144], w3 = w[(size_t)(k4 + 3) * 6144];
#pragma unroll
                for (int mr = 0; mr < 17; ++mr) { const f32x4 s = *(const LAS f32x4*)(sv + mr * 1024 + kg * 256 + k4); acc[mr] += (s.x * w0 + s.y * w1) + (s.z * w2 + s.w * w3); }
            }
#pragma unroll
            for (int mr = 0; mr < 17; ++mr) red[(kg * 17 + mr) * 128 + col] = acc[mr];
            __syncthreads();
            const float* bada = INP(I_BADA);
            for (int i = F.tid; i < 17 * 128; i += NTHR) { const int mr = i >> 7, c = i & 127;
                const float s = (red[(0 * 17 + mr) * 128 + c] + red[(1 * 17 + mr) * 128 + c]) + (red[(2 * 17 + mr) * 128 + c] + red[(3 * 17 + mr) * 128 + c]);
                mods[((size_t)l * 17 + mr) * 6144 + cc * 128 + c] = s + bada[l * 6144 + cc * 128 + c]; }
            __syncthreads();
        }
    }
    {
        float* t64 = (float*)(F.ws + WS_T64); float* t32 = (float*)(F.ws + WS_T32);
        for (int i = F.bid * NTHR + F.tid; i < 64 * 16 + 64 * 8; i += F.G * NTHR) {
            if (i < 1024) { const int p = i >> 4, k = i & 15; const float fr = powf(10000.0f, -(float)k / 16.0f), ang = (float)p * fr; t64[2 * i] = cosf(ang); t64[2 * i + 1] = sinf(ang); }
            else { const int j = i - 1024, p = j >> 3, k = j & 7; const float fr = powf(10000.0f, -(float)k / 8.0f), ang = (float)p * fr; t32[2 * j] = cosf(ang); t32[2 * j + 1] = sinf(ang); }
        }
    }
}
__device__ __forceinline__ void convert_layer_weights(const Frame& F, int l) {
    {
        LAS float* scr = (LAS float*)(F.lds + F.wave * 8448);
        constexpr int I0 = 1152, I1 = 192, I2 = 512, I3 = 8192, I4 = 4096, IL = I0 + I1 + I2 + I3 + I4;
        for (int r0_ = F.gw; r0_ < IL; r0_ += F.ngw) {
            int r = r0_;
            if (r < I0) { conv_item<0>(F, l, r, scr); continue; } r -= I0;
            if (r < I1) { conv_item<1>(F, l, r, scr); continue; } r -= I1;
            if (r < I2) { conv_item<2>(F, l, r, scr); continue; } r -= I2;
            if (r < I3) { conv_item<3>(F, l, r, scr); continue; } r -= I3;
            conv_item<4>(F, l, r, scr);
        }
    }
}

__device__ __forceinline__ void phase_ln(const Frame& F, int l) {
    if (l < NL) convert_layer_weights(F, l);
    constexpr int NR = 4;
    const float* mods = (const float*)(F.ws + WS_MODS); bf16* HA = (bf16*)(F.ws + WS_HA);
    const bf16* Y = (const bf16*)(F.ws + WS_PB); const unsigned* RT = (const unsigned*)(F.ws + WS_RT);
    const int lane = F.lane; const RowPtrs RP = row_ptrs(F);
    const float* ln2g = INP(I_LN2G) + (l > 0 ? l - 1 : 0) * D; const float* ln2b = INP(I_LN2B) + (l > 0 ? l - 1 : 0) * D;
    const int rpw = rows_per_wave(F.ngw), rbeg = F.gw * rpw, rend = min(M, rbeg + rpw);
    float g2[16]; int cur_mr = -1;
    float alpha_l = ALPHA; asm volatile("" : "+v"(alpha_l));
    for (int r0 = rbeg; r0 < rend; r0 += NR) {
        float v[NR][16]; v4u rt[NR]; v2u ya[NR][4], yb[NR][4]; bool act[NR];
        const int b0 = r0 / TT, t0 = r0 - b0 * TT; const bool lat = t0 < SEQ; const int mr = lat ? b0 : 16;
        if (l == NL && !lat) continue;
#pragma unroll
        for (int u = 0; u < NR; ++u) {
            const int r = r0 + u; act[u] = r < rend; const int rc = act[u] ? r : r0;
            if (l == 0) ld16nt(xin_row(RP, rc), lane, v[u]); else ld16h(RP.xs + (size_t)rc * D, lane, v[u]);
            rt[u] = *(const v4u*)(RT + (size_t)rc * 8 + 4);
        }
        if (mr != cur_mr) { if (l > 0) ld16(mods + ((size_t)(l - 1) * 17 + mr) * 6144 + 5120, lane, g2); cur_mr = mr; }
        if (l > 0) {
#pragma unroll
            for (int u = 0; u < NR; ++u) { ld16bf_raw_nt(Y + (size_t)rt[u].z * D, lane, ya[u]); ld16bf_raw_nt(Y + (size_t)rt[u].w * D, lane, yb[u]); }
#pragma unroll
            for (int u = 0; u < NR; ++u) {
                float f0[16], f1[16], gg[16], bb[16];
                const float w0 = __uint_as_float(rt[u].x), w1 = __uint_as_float(rt[u].y);
                unpack16(ya[u], f0); unpack16(yb[u], f1);
#pragma unroll
                for (int i = 0; i < 16; ++i) v[u][i] = alpha_l * v[u][i] + g2[i] * (w0 * f0[i] + w1 * f1[i]);
                ld16(ln2g, lane, gg); ld16(ln2b, lane, bb);
                ln16(v[u]);
#pragma unroll
                for (int i = 0; i < 16; ++i) v[u][i] = v[u][i] * gg[i] + bb[i];
                if (act[u]) { if (l == NL) st16nt(out_row(RP, r0 + u), lane, v[u]); else st16h(RP.xs + (size_t)(r0 + u) * D, lane, v[u]); }
            }
        }
        if (l < NL) {
            float sh[16], sc[16]; ld16(mods + ((size_t)l * 17 + mr) * 6144, lane, sh); ld16(mods + ((size_t)l * 17 + mr) * 6144 + 1024, lane, sc);
#pragma unroll
            for (int u = 0; u < NR; ++u) {
                ln16(v[u]);
#pragma unroll
                for (int i = 0; i < 16; ++i) v[u][i] = v[u][i] * (1.0f + sc[i]) + sh[i];
                if (act[u]) st16bf(HA + (size_t)(r0 + u) * D, lane, v[u]);
            }
        }
    }
}

__device__ __forceinline__ void rope8(float (&f)[8], const float (&p)[8], const float* cs, bool first) {
    const f32x4* c4 = (const f32x4*)cs;
#pragma unroll
    for (int q = 0; q < 4; ++q) { const f32x4 t = c4[q];
        f[2 * q] = first ? f[2 * q] * t.x - p[2 * q] * t.y : p[2 * q] * t.y + f[2 * q] * t.x;
        f[2 * q + 1] = first ? f[2 * q + 1] * t.z - p[2 * q + 1] * t.w : p[2 * q + 1] * t.w + f[2 * q + 1] * t.z; }
}
__device__ __forceinline__ void phase_post(const Frame& F, int l) {
    constexpr int NR = 4;
    bf16* P = (bf16*)(F.ws + WS_PB); bf16* KD = (bf16*)(F.ws + WS_KD);
    const float* t64 = (const float*)(F.ws + WS_T64); const float* t32 = (const float*)(F.ws + WS_T32);
    const int lane = F.lane; const float* gains = (lane < 32 ? INP(I_GQG) : INP(I_GKG)) + l * 64;
    const int j = lane & 7, jj = lane & 3;
    float gn[8];
#pragma unroll
    for (int i = 0; i < 8; ++i) gn[i] = gains[j * 8 + i];
    for (int r0 = F.gw; r0 < M; r0 += NR * F.ngw) {
        v4u w0[NR], w1[NR], w2[NR]; int rr[NR]; bool act[NR];
#pragma unroll
        for (int u = 0; u < NR; ++u) { const int r = r0 + u * F.ngw; act[u] = r < M; rr[u] = act[u] ? r : r0; const bf16* prow = P + (size_t)rr[u] * NPJ;
            w0[u] = *((const v4u*)(prow + 768) + lane); w1[u] = *((const v4u*)(prow + 1280) + lane); w2[u] = *((const v4u*)(prow + 1792) + lane); }
#pragma unroll
        for (int u = 0; u < NR; ++u) {
            const int r = rr[u]; const int b = r / TT, t = r - b * TT; const bool lat = t < SEQ; const int gr = (t >> 6) & 63, gc = t & 63;
            bf16* prow = P + (size_t)r * NPJ;
            const float* cs64 = t64 + ((size_t)((j < 4 ? gr : gc) * 16 + (j & 1) * 8)) * 2;
            {
                float f[8]; unpack8(w0[u], f);
                float ss = 0.f;
#pragma unroll
                for (int i = 0; i < 8; ++i) ss += f[i] * f[i];
                ss += __shfl_xor(ss, 1); ss += __shfl_xor(ss, 2); ss += __shfl_xor(ss, 4);
                const float rs = 1.0f / sqrtf(ss * (1.0f / 64.0f) + EPS);
#pragma unroll
                for (int i = 0; i < 8; ++i) f[i] = f[i] * rs * gn[i];
                float p[8];
#pragma unroll
                for (int i = 0; i < 8; ++i) p[i] = __shfl_xor(f[i], 2);
                if (lat) rope8(f, p, cs64, (j & 2) == 0);
                if (lane < 48 && act[u]) *((v4u*)(prow + 768) + lane) = pack8(f);
            }
            {
                float f[8]; unpack8(w1[u], f);
                float p[8];
#pragma unroll
                for (int i = 0; i < 8; ++i) p[i] = __shfl_xor(f[i], 2);
                rope8(f, p, cs64, (j & 2) == 0);
                if (lat && lane < 48 && act[u]) *((v4u*)(prow + 1280) + lane) = pack8(f);
            }
            {
                float f[8]; unpack8(w2[u], f);
                float ss = 0.f;
#pragma unroll
                for (int i = 0; i < 8; ++i) ss += f[i] * f[i];
                ss += __shfl_xor(ss, 1); ss += __shfl_xor(ss, 2); ss += __shfl_xor(ss, 4); ss += __shfl_xor(ss, 8);
                const float s32 = ss + __shfl_xor(ss, 16);
                const float rn = lane < 32 ? 1.0f / sqrtf(s32 * (1.0f / 256.0f) + EPS) : 1.0f / sqrtf(ss * (1.0f / 128.0f) + EPS);
                if (lane < 48 && act[u]) { float fn[8];
#pragma unroll
                    for (int i = 0; i < 8; ++i) fn[i] = f[i] * rn;
                    *((v4u*)(prow + 1792) + lane) = pack8(fn); }
                float p[8];
#pragma unroll
                for (int i = 0; i < 8; ++i) p[i] = __shfl_xor(f[i], 1);
                if (lat) rope8(f, p, t32 + ((size_t)((jj < 2 ? gr : gc) * 8)) * 2, (jj & 1) == 0);
                if (lane >= 48 && lane < 52 && act[u]) { const v4u o = pack8(f);
#pragma unroll
                    for (int h = 0; h < 4; ++h) *(v4u*)(KD + (size_t)r * 384 + h * 96 + 64 + 8 * jj) = o; }
            }
        }
    }
}

__device__ __forceinline__ void phase_route(const Frame& F, int l) {
    const float* mods = (const float*)(F.ws + WS_MODS); bf16* HA = (bf16*)(F.ws + WS_HA);
    const bf16* MIX = (const bf16*)(F.ws + WS_PB); unsigned* RT = (unsigned*)(F.ws + WS_RT); int* HIST = (int*)(F.ws + WS_HIST);
    LAS float* WR = (LAS float*)F.lds;
    { const float* rgw = INP(I_RGW); const float* rew = INP(I_REW);
      for (int i = F.tid; i < 20 * 1024; i += NTHR) { const int jx = i >> 10, k = i & 1023;
        WR[i] = jx < 4 ? rgw[((size_t)l * D + k) * 4 + jx] : rew[((size_t)l * D + k) * 16 + (jx - 4)]; } }
    if (F.tid < 16) F.MISC[MI_LH + F.tid] = 0u;
    __syncthreads();
    LAS float* bias = (LAS float*)(F.lds + 20 * 1024 * 4);
    if (F.tid < 20) bias[F.tid] = F.tid < 4 ? INP(I_RGB)[l * 4 + F.tid] : INP(I_REB)[l * 16 + (F.tid - 4)];
    __syncthreads();
    const RowPtrs RP = row_ptrs(F);
    LAS float* LNG = (LAS float*)(F.lds + 20 * 1024 * 4 + 128);
    { const float* ln1g = INP(I_LN1G) + l * D; const float* ln1b = INP(I_LN1B) + l * D;
      for (int i = F.tid; i < 1024; i += NTHR) { LNG[i] = ln1g[i]; LNG[1024 + i] = ln1b[i]; } }
    __syncthreads();
    constexpr int NR = 2;
    const LAS unsigned char* wbase = (const LAS unsigned char*)WR + F.lane * 16; asm volatile("" : "+v"(wbase));
    const LAS unsigned char* lbase = (const LAS unsigned char*)LNG + F.lane * 16; asm volatile("" : "+v"(lbase));
#define RT_W4(base_, off_) (*(const LAS f32x4*)((base_) + (off_)))
    const int rpw = rows_per_wave(F.ngw), rbeg = F.gw * rpw, rend = min(M, rbeg + rpw);
    float g1[16], sh[16], sc[16]; int cur_mr = -1;
    float alpha_l = ALPHA; asm volatile("" : "+v"(alpha_l));
    v4u rx[NR][4]; v2u rm[NR][4];
#define RT_ISSUE(r0_) do { _Pragma("unroll") for (int u = 0; u < NR; ++u) { const int r_ = (r0_) + u, rc_ = r_ < rend ? r_ : (r0_); \
        if (l == 0) { const v4u* q_ = (const v4u*)xin_row(RP, rc_) + F.lane; _Pragma("unroll") for (int g = 0; g < 4; ++g) rx[u][g] = __builtin_nontemporal_load(q_ + 64 * g); } \
        else { const v2u* q_ = (const v2u*)(RP.xs + (size_t)rc_ * D) + F.lane; _Pragma("unroll") for (int g = 0; g < 4; ++g) { const v2u t_ = __builtin_nontemporal_load(q_ + 64 * g); rx[u][g].x = t_.x; rx[u][g].y = t_.y; } } \
        ld16bf_raw_nt(MIX + (size_t)rc_ * D, F.lane, rm[u]); } } while (0)
    if (rbeg < rend) RT_ISSUE(rbeg);
    for (int r0 = rbeg; r0 < rend; r0 += NR) {
        float v[NR][16]; int rr[NR]; bool act[NR];
        { const int b = r0 / TT, t = r0 - b * TT, mr = t < SEQ ? b : 16;
          if (mr != cur_mr) { const float* md = mods + ((size_t)l * 17 + mr) * 6144; ld16(md + 2048, F.lane, g1); ld16(md + 3072, F.lane, sh); ld16(md + 4096, F.lane, sc); cur_mr = mr; } }
#pragma unroll
        for (int u = 0; u < NR; ++u) { const int r = r0 + u; act[u] = r < rend; rr[u] = act[u] ? r : r0;
            float mx[16]; unpack16(rm[u], mx);
            if (l == 0) {
#pragma unroll
                for (int g = 0; g < 4; ++g) { v[u][4 * g] = __uint_as_float(rx[u][g].x); v[u][4 * g + 1] = __uint_as_float(rx[u][g].y); v[u][4 * g + 2] = __uint_as_float(rx[u][g].z); v[u][4 * g + 3] = __uint_as_float(rx[u][g].w); }
            } else {
#pragma unroll
                for (int g = 0; g < 4; ++g) { const v2u t = {rx[u][g].x, rx[u][g].y}; const f32x4 f = __builtin_convertvector(__builtin_bit_cast(f16x4, t), f32x4);
                    v[u][4 * g] = f.x; v[u][4 * g + 1] = f.y; v[u][4 * g + 2] = f.z; v[u][4 * g + 3] = f.w; }
            }
#pragma unroll
            for (int i = 0; i < 16; ++i) v[u][i] = alpha_l * v[u][i] + g1[i] * mx[i]; }
        if (r0 + NR < rend) RT_ISSUE(r0 + NR);
        if (l == NL - 1 && (r0 % TT) >= SEQ) continue;
#pragma unroll
        for (int u = 0; u < NR; ++u) ln16(v[u]);
        { float gg[16], bb[16];
#pragma unroll
          for (int g = 0; g < 4; ++g) { const f32x4 a = RT_W4(lbase, 1024 * g), c = RT_W4(lbase, 4096 + 1024 * g);
              gg[4 * g] = a.x; gg[4 * g + 1] = a.y; gg[4 * g + 2] = a.z; gg[4 * g + 3] = a.w; bb[4 * g] = c.x; bb[4 * g + 1] = c.y; bb[4 * g + 2] = c.z; bb[4 * g + 3] = c.w; }
#pragma unroll
          for (int u = 0; u < NR; ++u) {
#pragma unroll
            for (int i = 0; i < 16; ++i) v[u][i] = v[u][i] * gg[i] + bb[i];
            if (act[u]) st16h(RP.xs + (size_t)rr[u] * D, F.lane, v[u]); } }
#pragma unroll
        for (int u = 0; u < NR; ++u) ln16(v[u]);
#pragma unroll
        for (int u = 0; u < NR; ++u) {
#pragma unroll
            for (int i = 0; i < 16; ++i) v[u][i] = v[u][i] * (1.0f + sc[i]) + sh[i];
            if (act[u]) st16bf(HA + (size_t)rr[u] * D, F.lane, v[u]); }
#define RT_DOT(u_, w0, w1, w2, w3) ((v[u_][0] * w0.x + v[u_][1] * w0.y) + (v[u_][2] * w0.z + v[u_][3] * w0.w) + (v[u_][4] * w1.x + v[u_][5] * w1.y) + (v[u_][6] * w1.z + v[u_][7] * w1.w) \
        + (v[u_][8] * w2.x + v[u_][9] * w2.y) + (v[u_][10] * w2.z + v[u_][11] * w2.w) + (v[u_][12] * w3.x + v[u_][13] * w3.y) + (v[u_][14] * w3.z + v[u_][15] * w3.w))
        float gl[NR][4];
#pragma unroll
        for (int jx = 0; jx < 4; ++jx) {
            const f32x4 w0 = RT_W4(wbase, 4096 * jx), w1 = RT_W4(wbase, 4096 * jx + 1024), w2 = RT_W4(wbase, 4096 * jx + 2048), w3 = RT_W4(wbase, 4096 * jx + 3072);
#pragma unroll
            for (int u = 0; u < NR; ++u) gl[u][jx] = RT_DOT(u, w0, w1, w2, w3);
        }
#pragma unroll
        for (int u = 0; u < NR; ++u)
#pragma unroll
            for (int jx = 0; jx < 4; ++jx) gl[u][jx] = wave_sum(gl[u][jx]) + bias[jx];
        int grpv[NR]; float pgv[NR];
#pragma unroll
        for (int u = 0; u < NR; ++u) {
            int grp = 0; float mg = gl[u][0];
#pragma unroll
            for (int g = 1; g < 4; ++g) if (gl[u][g] > mg) { mg = gl[u][g]; grp = g; }
            float sg = 0.f;
#pragma unroll
            for (int g = 0; g < 4; ++g) sg += expf(gl[u][g] - mg);
            grpv[u] = grp; pgv[u] = 1.0f / sg;
        }
        float selv[NR][4];
#pragma unroll
        for (int u = 0; u < NR; ++u) {
            const LAS unsigned char* eb = wbase + (4 + 4 * grpv[u]) * 4096;
#pragma unroll
            for (int i = 0; i < 4; ++i) {
                const f32x4 w0 = RT_W4(eb, 4096 * i), w1 = RT_W4(eb, 4096 * i + 1024), w2 = RT_W4(eb, 4096 * i + 2048), w3 = RT_W4(eb, 4096 * i + 3072);
                selv[u][i] = RT_DOT(u, w0, w1, w2, w3);
            }
        }
#pragma unroll
        for (int u = 0; u < NR; ++u)
#pragma unroll
            for (int i = 0; i < 4; ++i) selv[u][i] = wave_sum(selv[u][i]) + bias[4 + 4 * grpv[u] + i];
#undef RT_DOT
#pragma unroll
        for (int u = 0; u < NR; ++u) {
            const int grp = grpv[u]; const float pg = pgv[u];
            float sel[4];
#pragma unroll
            for (int i = 0; i < 4; ++i) sel[i] = selv[u][i];
            int i1 = 0; float v1 = sel[0];
#pragma unroll
            for (int i = 1; i < 4; ++i) if (sel[i] > v1) { v1 = sel[i]; i1 = i; }
            int i2 = -1; float v2 = -3.0e38f;
#pragma unroll
            for (int i = 0; i < 4; ++i) if (i != i1 && (i2 < 0 || sel[i] > v2)) { v2 = sel[i]; i2 = i; }
            const float ee = expf(v2 - v1), w1 = pg / (1.0f + ee), w2 = pg * ee / (1.0f + ee);
            const int e1 = grp * 4 + i1, e2 = grp * 4 + i2;
            if (F.lane == 0 && act[u]) {
                const unsigned k1 = __hip_atomic_fetch_add((LAS unsigned*)&F.MISC[MI_LH + e1], 1u, __ATOMIC_RELAXED, __HIP_MEMORY_SCOPE_WORKGROUP);
                const unsigned k2 = __hip_atomic_fetch_add((LAS unsigned*)&F.MISC[MI_LH + e2], 1u, __ATOMIC_RELAXED, __HIP_MEMORY_SCOPE_WORKGROUP);
                v4u ra; ra.x = (unsigned)e1; ra.y = (unsigned)e2; ra.z = k1; ra.w = k2;
                v4u rb; rb.x = __builtin_bit_cast(unsigned, w1); rb.y = __builtin_bit_cast(unsigned, w2); rb.z = 0u; rb.w = 0u;
                *(v4u*)(RT + (size_t)rr[u] * 8) = ra; *(v4u*)(RT + (size_t)rr[u] * 8 + 4) = rb;
            }
        }
    }
#undef RT_ISSUE
#undef RT_W4
    __syncthreads();
    if (F.tid < 16) HIST[F.bid * 16 + F.tid] = (int)F.MISC[MI_LH + F.tid];
}
__device__ __forceinline__ void moe_tables(const Frame& F) {
    const int* HIST = (const int*)(F.ws + WS_HIST); LAS int* hl = (LAS int*)F.lds;
    __syncthreads();
    for (int i = F.tid; i < F.G * 16; i += NTHR) hl[i] = HIST[i];
    __syncthreads();
    if (F.tid < 16) { int tot = 0, mine = 0; for (int g = 0; g < F.G; ++g) { const int c = hl[g * 16 + F.tid]; tot += c; mine += (g < F.bid) ? c : 0; }
        F.MISC[MI_TOT + F.tid] = (unsigned)tot; F.MISC[MI_BASE + F.tid] = (unsigned)mine; }
    __syncthreads();
    if (F.tid == 0) { unsigned p = 0; for (int e = 0; e < 16; ++e) { F.MISC[MI_PST + e] = p; F.MISC[MI_BASE + e] += p * 256u; p += (F.MISC[MI_TOT + e] + 255u) >> 8; } F.MISC[MI_PST + 16] = p; }
    __syncthreads();
}
__device__ __forceinline__ void phase_permute(const Frame& F, int l) {
    unsigned* RT = (unsigned*)(F.ws + WS_RT); int* SRC = (int*)(F.ws + WS_QD);
    moe_tables(F);
    const int rpw = rows_per_wave(F.ngw), rbeg = F.gw * rpw, rend = min(M, rbeg + rpw);
    for (int r = rbeg + F.lane; r < rend; r += 64) {
        if (l == NL - 1 && (r % TT) >= SEQ) continue;
        const v4u ra = *(const v4u*)(RT + (size_t)r * 8);
        const unsigned p0 = F.MISC[MI_BASE + (ra.x & 15u)] + ra.z, p1 = F.MISC[MI_BASE + (ra.y & 15u)] + ra.w;
        RT[(size_t)r * 8 + 6] = p0; RT[(size_t)r * 8 + 7] = p1; SRC[p0] = r; SRC[p1] = r;
    }
    if (F.bid == 0) {
        for (int e = 0; e < 16; ++e) { const int beg = (int)F.MISC[MI_PST + e] * 256 + (int)F.MISC[MI_TOT + e], end = (int)F.MISC[MI_PST + e + 1] * 256;
            for (int p = beg + F.tid; p < end; p += NTHR) SRC[p] = 0; }
    }
}

struct EpiMla {
    static constexpr bool PERM = true, AFTER_DRAIN = false;
    bf16* QD; bf16* KD; bf16* VD;
    __device__ __forceinline__ void operator()(const pg8::f32x4 (&acc)[2][2][4][2], const pg8::Unit& u, int wr, int wc, int fr, int fq) const {
#pragma unroll
        for (int bj = 0; bj < 2; ++bj) {
            const int g0 = u.pn * 256 + bj * 128 + wc * 32, col0 = g0 + 8 * fq;
            if (g0 >= 896) continue;
            const int c = col0 - 384, hd = c >> 7, jx = c & 127;
            bf16* dst = g0 < 384 ? QD + col0 : jx < 64 ? KD + hd * 96 + jx : VD + hd * 64 + (jx - 64);
            const int stride = (g0 < 384 || jx < 64) ? 384 : 256;
            dst += (size_t)(u.pm * 256 + wr * 64 + fr) * stride;
#pragma unroll
            for (int ai = 0; ai < 2; ++ai)
#pragma unroll
                for (int m = 0; m < 4; ++m) {
                    v4u o; o.x = pk2(acc[ai][bj][m][0][0], acc[ai][bj][m][0][1]); o.y = pk2(acc[ai][bj][m][0][2], acc[ai][bj][m][0][3]);
                    o.z = pk2(acc[ai][bj][m][1][0], acc[ai][bj][m][1][1]); o.w = pk2(acc[ai][bj][m][1][2], acc[ai][bj][m][1][3]);
                    *(v4u*)(dst + (size_t)(ai * 128 + m * 16) * stride) = o;
                }
        }
    }
};
struct EpiGU {
    static constexpr bool PERM = true, AFTER_DRAIN = false;
    bf16* ACT;
    __device__ __forceinline__ void operator()(const pg8::f32x4 (&acc)[2][2][4][2], const pg8::Unit& u, int wr, int wc, int fr, int fq) const {
#pragma unroll
        for (int ai = 0; ai < 2; ++ai)
#pragma unroll
            for (int m = 0; m < 4; ++m) {
                const int row = u.pm * 256 + ai * 128 + wr * 64 + m * 16 + fr;
#pragma unroll
                for (int bj = 0; bj < 2; ++bj) {
                    const int c = (u.pn & 3) * 256 + bj * 128 + wc * 32 + 8 * fq;
                    float o[4];
#pragma unroll
                    for (int i = 0; i < 4; ++i) { const float g = acc[ai][bj][m][0][i], up = acc[ai][bj][m][1][i]; o[i] = g / (1.0f + __expf(-g)) * up; }
                    v2u w; w.x = pk2(o[0], o[1]); w.y = pk2(o[2], o[3]);
                    *(v2u*)(ACT + (size_t)row * 512 + (c >> 1)) = w;
                }
            }
    }
};
struct MoeOrder {
    volatile LAS unsigned* pst; int G, c;
    __device__ __forceinline__ bool next(int i, pg8::Unit& u) const {
        const int np = (int)pst[16]; int panel, pn;
        if ((G & 7) == 0) { const int x = c & 7, uu = i * (G >> 3) + (c >> 3); panel = (uu >> 2) * 8 + x; pn = uu & 3; }
        else { const int L = i * G + c; panel = L >> 2; pn = L & 3; }
        if (panel >= np) return false;
        int e = 0;
#pragma unroll
        for (int k = 1; k < 16; ++k) e += (panel >= (int)pst[k]) ? 1 : 0;
        u.pm = __builtin_amdgcn_readfirstlane(panel); u.pn = __builtin_amdgcn_readfirstlane(e * 4 + pn); return true;
    }
    __device__ __forceinline__ void a_ready(const pg8::Unit&) const {}
    __device__ __forceinline__ void done(const pg8::Unit&) const {}
};

struct LatOrder {
    int G, c;
    __device__ __forceinline__ bool next(int i, pg8::Unit& u) const {
        int pl, pn;
        if ((G & 7) == 0) { const int x = c & 7, uu = i * (G >> 3) + (c >> 3); pl = (uu >> 2) * 8 + x; pn = uu & 3; } else { const int L = i * G + c; pl = L >> 2; pn = L & 3; }
        if (pl >= NB * 16) return false;
        u.pm = pl + (pl >> 4); u.pn = pn; return true;
    }
    __device__ __forceinline__ void a_ready(const pg8::Unit&) const {}
    __device__ __forceinline__ void done(const pg8::Unit&) const {}
};

#ifndef DBG_VAR
#define DBG_VAR 1
#endif
namespace att {
constexpr int VRS = 192, KBUF = 64 * 208, VBUF = 64 * VRS, BUF = KBUF + VBUF, BIAS_OFF = 4 * BUF;
constexpr float NEG = -30000.0f;
__device__ __forceinline__ int crow(int r, int hi) { return (r & 3) + 8 * (r >> 2) + 4 * hi; }
__device__ __forceinline__ float xhalf_max(float v) { const unsigned a = __builtin_bit_cast(unsigned, v);
    auto rr = __builtin_amdgcn_permlane32_swap(a, a, false, false); const unsigned r0 = rr[0], r1 = rr[1]; return fmaxf(__uint_as_float(r0), __uint_as_float(r1)); }
__device__ __forceinline__ float xhalf_sum(float v) { const unsigned a = __builtin_bit_cast(unsigned, v);
    auto rr = __builtin_amdgcn_permlane32_swap(a, a, false, false); const unsigned r0 = rr[0], r1 = rr[1]; return __uint_as_float(r0) + __uint_as_float(r1); }
__device__ __forceinline__ float max3f(float a, float b, float c) { float r; asm("v_max3_f32 %0, %1, %2, %3" : "=v"(r) : "v"(a), "v"(b), "v"(c)); return r; }
typedef __bf16 bf16x2_t __attribute__((ext_vector_type(2)));
__device__ __forceinline__ unsigned cvtpk(float lo, float hi) { f32x2 v = {lo, hi}; bf16x2_t b = __builtin_convertvector(v, bf16x2_t); return __builtin_bit_cast(unsigned, b); }

template <int DK, int VM = 0>
__device__ __forceinline__ void unit(LAS unsigned char* lds, const bf16* Qp, int qpitch, const bf16* Kp, int kpitch, const bf16* Vp, int vpitch, bf16* Op,
                                     int var, int qt, int lo, int n1, int nt, float qscale, float sinkl2, bool has_sink, const LAS float* bias, const float* t32, unsigned* dbg) {
    constexpr int KRS = DK * 2 + 16, NS = DK / 16, CPK = DK / 8;
    int tid = threadIdx.x; asm volatile("" : "+v"(tid)); const int lane = tid & 63, r32 = lane & 31, hi = lane >> 5, wid = __builtin_amdgcn_readfirstlane(tid >> 6);
    const int qrow = 256 * qt + 32 * wid + r32;
    bf16x8 qr[NS];
#pragma unroll
    for (int s = 0; s < NS; ++s) { const v4u raw = *(const v4u*)(Qp + (size_t)qrow * qpitch + 16 * s + 8 * hi); float f[8]; unpack8(raw, f);
#pragma unroll
        for (int i = 0; i < 8; ++i) f[i] *= qscale;
        if (DK == 96 && s >= 4) {
            float p[8];
#pragma unroll
            for (int i = 0; i < 8; ++i) p[i] = __shfl_xor(f[i], 32);
            if (qt < 16) rope8(f, p, t32 + ((size_t)((s == 4 ? (qrow >> 6) : (qrow & 63)) * 8)) * 2, hi == 0);
        }
        qr[s] = __builtin_bit_cast(bf16x8, pack8(f)); }
    const int kkey0 = tid / CPK, kch0 = tid - kkey0 * CPK, kkey1 = (tid + 512) / CPK, kch1 = (tid + 512) - kkey1 * CPK;
    const int vkey = tid >> 3, vch = tid & 7;
    v4u kreg0, kreg1 = {0u, 0u, 0u, 0u}, vreg;
#define ATT_TROW(j) ((((j) < n1) ? (lo + (j)) : (64 + (j) - n1)) * 64)
#define ATT_LOAD(j) do { const int tr_ = ATT_TROW(j); kreg0 = *(const v4u*)(Kp + (size_t)(tr_ + kkey0) * kpitch + kch0 * 8); \
        if (DK == 96 && tid < 256) kreg1 = *(const v4u*)(Kp + (size_t)(tr_ + kkey1) * kpitch + kch1 * 8); \
        vreg = *(const v4u*)(Vp + (size_t)(tr_ + vkey) * vpitch + vch * 8); } while (0)
#define ATT_STORE(bf) do { LAS unsigned char* b_ = lds + (bf) * BUF; *(LAS v4u*)(b_ + kkey0 * KRS + kch0 * 16) = kreg0; \
        if (DK == 96 && tid < 256) *(LAS v4u*)(b_ + kkey1 * KRS + kch1 * 16) = kreg1; \
        *(LAS v4u*)(b_ + KBUF + vkey * VRS + vch * 16) = vreg; } while (0)
    constexpr float THR = 6.0f;
    float m = 0.f; f32x2 lacc = {0.f, 0.f}; f32x16 o0 = {}, o1 = {}; f32x16 negm = {}; bool first = true;
    const int grw = 4 * qt + (wid >> 1), r0w = min(max(grw - 4, 0), 56), gc = (wid & 1) * 32 + r32, c0 = min(max(gc - 8, 0), 48), i0w = 256 * qt + 32 * wid;
    ATT_LOAD(0); ATT_STORE(0);
    __syncthreads();
    for (int j = 0; j < nt; ++j) {
        if (!(VM & 8) && j + 1 < nt) ATT_LOAD(j + 1);
        const int kt = ATT_TROW(j) >> 6;
        bool actv = true;
        if (kt < 64) { if (var == 0) actv = (kt >= r0w) && (kt <= r0w + 7); else if (var == 2) actv = !((64 * kt - (i0w + 31) > 128) || (i0w - (64 * kt + 63) > 128)); }
        if (actv) {
            const LAS unsigned char* Kb = lds + (j & 1) * BUF; const LAS unsigned char* Vb = Kb + KBUF;
            f32x16 s0 = negm, s1 = negm;
            bf16x8 ka[NS], kb[NS];
#pragma unroll
            for (int s = 0; s < NS; ++s) { ka[s] = *(const LAS bf16x8*)(Kb + r32 * KRS + (16 * s + 8 * hi) * 2); kb[s] = *(const LAS bf16x8*)(Kb + (32 + r32) * KRS + (16 * s + 8 * hi) * 2); }
            __builtin_amdgcn_sched_barrier(0);
            if (VM & 2) {
#pragma unroll
                for (int s = 0; s < NS; ++s) asm volatile("" :: "v"(ka[s]), "v"(kb[s]), "v"(qr[s]));
            } else {
#pragma unroll
            for (int s = 0; s < NS; ++s) { s0 = __builtin_amdgcn_mfma_f32_32x32x16_bf16(ka[s], qr[s], s0, 0, 0, 0); s1 = __builtin_amdgcn_mfma_f32_32x32x16_bf16(kb[s], qr[s], s1, 0, 0, 0); }
            }
            asm volatile("s_nop 15\n\ts_nop 7" : "+v"(s0), "+v"(s1));
            if (kt < 64 && var == 0) {
                const int rowoff = (kt - grw + 7) * 31 - gc + 15;
#pragma unroll
                for (int r = 0; r < 16; ++r) { const int j0 = crow(r, hi), j1 = j0 + 32;
                    const bool v0 = (unsigned)(j0 - c0) < 16u, v1 = (unsigned)(j1 - c0) < 16u;
                    const float b0 = bias[v0 ? rowoff + j0 : 0], b1 = bias[v1 ? rowoff + j1 : 0];
                    s0[r] = v0 ? s0[r] + b0 : NEG; s1[r] = v1 ? s1[r] + b1 : NEG; }
            } else if (kt < 64 && var == 2) {
                const int dbase = 64 * kt - qrow + 128;
#pragma unroll
                for (int r = 0; r < 16; ++r) { const int j0 = crow(r, hi);
                    s0[r] = (unsigned)(dbase + j0) <= 256u ? s0[r] : NEG; s1[r] = (unsigned)(dbase + j0 + 32) <= 256u ? s1[r] : NEG; }
            }
            if (!(VM & 4)) {
            float mxa = max3f(s0[0], s0[1], s1[0]), mxb = max3f(s0[2], s0[3], s1[1]); mxa = max3f(mxa, s1[2], s1[3]);
#pragma unroll
            for (int r = 4; r < 16; r += 4) { mxa = max3f(mxa, s0[r], s0[r + 1]); mxb = max3f(mxb, s0[r + 2], s0[r + 3]); mxa = max3f(mxa, s1[r], s1[r + 1]); mxb = max3f(mxb, s1[r + 2], s1[r + 3]); }
            const float mx = xhalf_max(fmaxf(mxa, mxb));
            if (first || __any(mx > THR)) {
                const float d = first ? fmaxf(mx, -64.0f) : fmaxf(mx, 0.f), alpha = __builtin_amdgcn_exp2f(-d);
                m += d; first = false;
#pragma unroll
                for (int r = 0; r < 16; ++r) { s0[r] -= d; s1[r] -= d; o0[r] *= alpha; o1[r] *= alpha; negm[r] = -m; }
                lacc *= alpha;
            }
#pragma unroll
            for (int r = 0; r < 16; ++r) { s0[r] = __builtin_amdgcn_exp2f(s0[r]); s1[r] = __builtin_amdgcn_exp2f(s1[r]); lacc += (f32x2){s0[r], s1[r]}; }
            }
            bf16x8 pb[4];
#pragma unroll
            for (int s = 0; s < 2; ++s) {
                v4u w; w.x = cvtpk(s0[8 * s], s0[8 * s + 1]); w.y = cvtpk(s0[8 * s + 2], s0[8 * s + 3]); w.z = cvtpk(s0[8 * s + 4], s0[8 * s + 5]); w.w = cvtpk(s0[8 * s + 6], s0[8 * s + 7]);
                pb[s] = __builtin_bit_cast(bf16x8, w);
                v4u x; x.x = cvtpk(s1[8 * s], s1[8 * s + 1]); x.y = cvtpk(s1[8 * s + 2], s1[8 * s + 3]); x.z = cvtpk(s1[8 * s + 4], s1[8 * s + 5]); x.w = cvtpk(s1[8 * s + 6], s1[8 * s + 7]);
                pb[2 + s] = __builtin_bit_cast(bf16x8, x);
            }
            if (VM & 1) { asm volatile("" :: "v"(pb[0]), "v"(pb[1]), "v"(pb[2]), "v"(pb[3])); } else {
            const LAS unsigned char* vbase = Vb + (4 * hi + ((lane & 15) >> 2)) * VRS + ((lane >> 4) & 1) * 32 + (lane & 3) * 8;
#pragma unroll
            for (int s = 0; s < 4; ++s) {
                const v4i16 a0 = __builtin_amdgcn_ds_read_tr16_b64_v4i16((LAS v4i16*)(vbase + (16 * s) * VRS));
                const v4i16 a1 = __builtin_amdgcn_ds_read_tr16_b64_v4i16((LAS v4i16*)(vbase + (16 * s + 8) * VRS));
                const v4i16 c0_ = __builtin_amdgcn_ds_read_tr16_b64_v4i16((LAS v4i16*)(vbase + (16 * s) * VRS + 64));
                const v4i16 c1_ = __builtin_amdgcn_ds_read_tr16_b64_v4i16((LAS v4i16*)(vbase + (16 * s + 8) * VRS + 64));
                const bf16x8 va = {a0[0], a0[1], a0[2], a0[3], a1[0], a1[1], a1[2], a1[3]};
                const bf16x8 vc = {c0_[0], c0_[1], c0_[2], c0_[3], c1_[0], c1_[1], c1_[2], c1_[3]};
                o0 = __builtin_amdgcn_mfma_f32_32x32x16_bf16(va, pb[s], o0, 0, 0, 0);
                o1 = __builtin_amdgcn_mfma_f32_32x32x16_bf16(vc, pb[s], o1, 0, 0, 0);
            }
            }
        }
        if (!(VM & 8) && j + 1 < nt) ATT_STORE((j + 1) & 1);
        if (!(VM & 16)) __syncthreads();
    }
    float l = xhalf_sum(lacc.x + lacc.y);
    const float sterm = has_sink ? __builtin_amdgcn_exp2f(sinkl2 - m) : 0.f;
#if MK_DEBUG
    if (dbg && hi == 0) { dbg[(size_t)qrow * 2] = __builtin_bit_cast(unsigned, m); dbg[(size_t)qrow * 2 + 1] = __builtin_bit_cast(unsigned, l); }
#endif
    if (has_sink) l += sterm;
    const float inv = 1.0f / l;
    bf16* orow = Op + (size_t)qrow * D;
#pragma unroll
    for (int g = 0; g < 4; ++g) {
        v2u w0; w0.x = pk2(o0[4 * g] * inv, o0[4 * g + 1] * inv); w0.y = pk2(o0[4 * g + 2] * inv, o0[4 * g + 3] * inv);
        v2u w1; w1.x = pk2(o1[4 * g] * inv, o1[4 * g + 1] * inv); w1.y = pk2(o1[4 * g + 2] * inv, o1[4 * g + 3] * inv);
        *(v2u*)(orow + 8 * g + 4 * hi) = w0; *(v2u*)(orow + 32 + 8 * g + 4 * hi) = w1;
    }
#undef ATT_TROW
#undef ATT_LOAD
#undef ATT_STORE
}

template <int DK, int MODE, int VM = 0, bool NOREF = false>
__device__ __forceinline__ void unit2(LAS unsigned char* lds, const bf16* Qp, int qpitch, const bf16* Kp, int kpitch, const bf16* Vp, int vpitch, bf16* Op,
                                      int var, int qt, int lo, int n1, int nt, float qscale, float sink0, float sink1, bool has_sink, const LAS float* bias, const float* t32) {
    constexpr int KRS = DK * 2 + 16, NS = DK / 16, CPK = DK / 8;
    int tid = threadIdx.x; asm volatile("" : "+v"(tid)); const int lane = tid & 63, r32 = lane & 31, hi = lane >> 5, wid = __builtin_amdgcn_readfirstlane(tid >> 6);
    const int rowbase = MODE == 0 ? 512 * qt + 64 * wid : 256 * qt + 32 * wid;
    bf16x8 qr[2][NS];
#pragma unroll
    for (int u = 0; u < 2; ++u) {
        const int qrow = rowbase + (MODE == 0 ? 32 * u : 0) + r32;
        const bf16* qp = Qp + (MODE == 1 ? 64 * u : 0) + (size_t)qrow * qpitch;
#pragma unroll
        for (int s = 0; s < NS; ++s) { const v4u raw = *(const v4u*)(qp + 16 * s + 8 * hi); float f[8]; unpack8(raw, f);
#pragma unroll
            for (int i = 0; i < 8; ++i) f[i] *= qscale;
            if (DK == 96 && s >= 4) { float p[8];
#pragma unroll
                for (int i = 0; i < 8; ++i) p[i] = __shfl_xor(f[i], 32);
                rope8(f, p, t32 + ((size_t)((s == 4 ? (qrow >> 6) : (qrow & 63)) * 8)) * 2, hi == 0); }
            qr[u][s] = __builtin_bit_cast(bf16x8, pack8(f)); }
    }
    const int kkey0 = tid / CPK, kch0 = tid - kkey0 * CPK, kkey1 = (tid + 512) / CPK, kch1 = (tid + 512) - kkey1 * CPK;
    const int vkey = tid >> 3, vch = tid & 7;
    v4u kreg0, kreg1 = {0u, 0u, 0u, 0u}, vreg;
#define ATT_TROW(j) ((((j) < n1) ? (lo + (j)) : (64 + (j) - n1)) * 64)
#define ATT_LOAD(j) do { const int tr_ = ATT_TROW(j); kreg0 = *(const v4u*)(Kp + (size_t)(tr_ + kkey0) * kpitch + kch0 * 8); \
        if (DK == 96 && tid < 256) kreg1 = *(const v4u*)(Kp + (size_t)(tr_ + kkey1) * kpitch + kch1 * 8); \
        vreg = *(const v4u*)(Vp + (size_t)(tr_ + vkey) * vpitch + vch * 8); } while (0)
#define ATT_STORE(bf) do { LAS unsigned char* b_ = lds + (bf) * BUF; *(LAS v4u*)(b_ + kkey0 * KRS + kch0 * 16) = kreg0; \
        if (DK == 96 && tid < 256) *(LAS v4u*)(b_ + kkey1 * KRS + kch1 * 16) = kreg1; \
        *(LAS v4u*)(b_ + KBUF + vkey * VRS + vch * 16) = vreg; } while (0)
    constexpr float THR = 6.0f;
    float m = 0.f; f32x2 lacc[2] = {{0.f, 0.f}, {0.f, 0.f}}; f32x16 o0[2] = {{}, {}}, o1[2] = {{}, {}}; bool first = true;
    const int grw = 8 * qt + wid, r0w = min(max(grw - 4, 0), 56), i0w = rowbase;
    ATT_LOAD(0); ATT_STORE(0);
    __syncthreads();
    for (int j = 0; j < nt; ++j) {
        if (!(VM & 8) && j + 1 < nt) ATT_LOAD(j + 1);
        const int kt = ATT_TROW(j) >> 6;
        bool actv = true;
        if (kt < 64) { if (var == 0) actv = (kt >= r0w) && (kt <= r0w + 7); else if (var == 2) actv = !((64 * kt - (i0w + 31) > 128) || (i0w - (64 * kt + 63) > 128)); }
        if (actv) {
            const LAS unsigned char* Kb = lds + (j & 1) * BUF; const LAS unsigned char* Vb = Kb + KBUF;
            f32x16 s0[2] = {{}, {}}, s1[2] = {{}, {}};
#pragma unroll
            for (int s = 0; s < NS; ++s) {
                const bf16x8 ka = *(const LAS bf16x8*)(Kb + r32 * KRS + (16 * s + 8 * hi) * 2);
                const bf16x8 kb = *(const LAS bf16x8*)(Kb + (32 + r32) * KRS + (16 * s + 8 * hi) * 2);
                if (VM & 2) { asm volatile("" :: "v"(ka), "v"(kb), "v"(qr[0][s]), "v"(qr[1][s])); } else {
#pragma unroll
                for (int u = 0; u < 2; ++u) { s0[u] = __builtin_amdgcn_mfma_f32_32x32x16_bf16(ka, qr[u][s], s0[u], 0, 0, 0); s1[u] = __builtin_amdgcn_mfma_f32_32x32x16_bf16(kb, qr[u][s], s1[u], 0, 0, 0); }
                }
            }
            asm volatile("s_nop 15\n\ts_nop 7" : "+v"(s0[0]), "+v"(s1[0]), "+v"(s0[1]), "+v"(s1[1]));
            if (kt < 64 && var == 0) {
#pragma unroll
                for (int u = 0; u < 2; ++u) { const int gc = 32 * u + r32, c0 = min(max(gc - 8, 0), 48), rowoff = (kt - grw + 7) * 31 - gc + 15;
#pragma unroll
                    for (int r = 0; r < 16; ++r) { const int j0 = crow(r, hi), j1 = j0 + 32;
                        const bool v0 = (unsigned)(j0 - c0) < 16u, v1 = (unsigned)(j1 - c0) < 16u;
                        const float b0 = bias[v0 ? rowoff + j0 : 0], b1 = bias[v1 ? rowoff + j1 : 0];
                        s0[u][r] = v0 ? s0[u][r] + b0 : NEG; s1[u][r] = v1 ? s1[u][r] + b1 : NEG; } }
            } else if (kt < 64 && var == 2) {
                const int dbase = 64 * kt - (rowbase + r32) + 128;
#pragma unroll
                for (int r = 0; r < 16; ++r) { const int j0 = crow(r, hi); const bool v0 = (unsigned)(dbase + j0) <= 256u, v1 = (unsigned)(dbase + j0 + 32) <= 256u;
                    s0[0][r] = v0 ? s0[0][r] : NEG; s1[0][r] = v1 ? s1[0][r] : NEG; s0[1][r] = v0 ? s0[1][r] : NEG; s1[1][r] = v1 ? s1[1][r] : NEG; }
            }
            if (!(VM & 4)) {
            if (!NOREF) {
            float mxa = max3f(s0[0][0], s0[0][1], s1[0][0]), mxb = max3f(s0[1][0], s0[1][1], s1[1][0]);
#pragma unroll
            for (int r = 0; r < 16; r += 2) { if (r) { mxa = max3f(mxa, s0[0][r], s0[0][r + 1]); mxb = max3f(mxb, s0[1][r], s0[1][r + 1]); }
                if (r) { mxa = max3f(mxa, s1[0][r], s1[0][r + 1]); mxb = max3f(mxb, s1[1][r], s1[1][r + 1]); } else { mxa = fmaxf(mxa, s1[0][1]); mxb = fmaxf(mxb, s1[1][1]); } }
            const float mx = xhalf_max(fmaxf(mxa, mxb)) - m;
            if (first || __any(mx > THR)) {
                const float d = first ? fmaxf(mx, -64.0f) : fmaxf(mx, 0.f), alpha = __builtin_amdgcn_exp2f(-d);
                m += d; first = false;
#pragma unroll
                for (int u = 0; u < 2; ++u) {
#pragma unroll
                    for (int r = 0; r < 16; ++r) { o0[u][r] *= alpha; o1[u][r] *= alpha; }
                    lacc[u] *= alpha; }
            }
            }
            }
            bf16x8 pb[2][4];
#pragma unroll
            for (int u = 0; u < 2; ++u) {
                if (!(VM & 4))
#pragma unroll
                for (int r = 0; r < 16; ++r) { s0[u][r] = __builtin_amdgcn_exp2f(NOREF ? s0[u][r] : s0[u][r] - m); s1[u][r] = __builtin_amdgcn_exp2f(NOREF ? s1[u][r] : s1[u][r] - m); lacc[u] += (f32x2){s0[u][r], s1[u][r]}; }
#pragma unroll
                for (int s = 0; s < 2; ++s) {
                    v4u w; w.x = cvtpk(s0[u][8 * s], s0[u][8 * s + 1]); w.y = cvtpk(s0[u][8 * s + 2], s0[u][8 * s + 3]); w.z = cvtpk(s0[u][8 * s + 4], s0[u][8 * s + 5]); w.w = cvtpk(s0[u][8 * s + 6], s0[u][8 * s + 7]);
                    pb[u][s] = __builtin_bit_cast(bf16x8, w);
                    v4u x; x.x = cvtpk(s1[u][8 * s], s1[u][8 * s + 1]); x.y = cvtpk(s1[u][8 * s + 2], s1[u][8 * s + 3]); x.z = cvtpk(s1[u][8 * s + 4], s1[u][8 * s + 5]); x.w = cvtpk(s1[u][8 * s + 6], s1[u][8 * s + 7]);
                    pb[u][2 + s] = __builtin_bit_cast(bf16x8, x);
                }
            }
            if (VM & 1) { asm volatile("" :: "v"(pb[0][0]), "v"(pb[0][1]), "v"(pb[0][2]), "v"(pb[0][3]), "v"(pb[1][0]), "v"(pb[1][1]), "v"(pb[1][2]), "v"(pb[1][3])); } else {
            const LAS unsigned char* vbase = Vb + (4 * hi + ((lane & 15) >> 2)) * VRS + ((lane >> 4) & 1) * 32 + (lane & 3) * 8;
#pragma unroll
            for (int s = 0; s < 4; ++s) {
                const v4i16 a0 = __builtin_amdgcn_ds_read_tr16_b64_v4i16((LAS v4i16*)(vbase + (16 * s) * VRS));
                const v4i16 a1 = __builtin_amdgcn_ds_read_tr16_b64_v4i16((LAS v4i16*)(vbase + (16 * s + 8) * VRS));
                const v4i16 c0_ = __builtin_amdgcn_ds_read_tr16_b64_v4i16((LAS v4i16*)(vbase + (16 * s) * VRS + 64));
                const v4i16 c1_ = __builtin_amdgcn_ds_read_tr16_b64_v4i16((LAS v4i16*)(vbase + (16 * s + 8) * VRS + 64));
                const bf16x8 va = {a0[0], a0[1], a0[2], a0[3], a1[0], a1[1], a1[2], a1[3]};
                const bf16x8 vc = {c0_[0], c0_[1], c0_[2], c0_[3], c1_[0], c1_[1], c1_[2], c1_[3]};
#pragma unroll
                for (int u = 0; u < 2; ++u) { o0[u] = __builtin_amdgcn_mfma_f32_32x32x16_bf16(va, pb[u][s], o0[u], 0, 0, 0); o1[u] = __builtin_amdgcn_mfma_f32_32x32x16_bf16(vc, pb[u][s], o1[u], 0, 0, 0); }
            }
            }
        }
        if (!(VM & 8) && j + 1 < nt) ATT_STORE((j + 1) & 1);
        if (!(VM & 16)) __syncthreads();
    }
#pragma unroll
    for (int u = 0; u < 2; ++u) {
        float l = xhalf_sum(lacc[u].x + lacc[u].y);
        if (has_sink) l += __builtin_amdgcn_exp2f((u == 0 ? sink0 : sink1) - m);
        const float inv = 1.0f / l;
        const int qrow = rowbase + (MODE == 0 ? 32 * u : 0) + r32;
        bf16* orow = Op + (MODE == 1 ? 64 * u : 0) + (size_t)qrow * D;
#pragma unroll
        for (int g = 0; g < 4; ++g) {
            v2u w0; w0.x = pk2(o0[u][4 * g] * inv, o0[u][4 * g + 1] * inv); w0.y = pk2(o0[u][4 * g + 2] * inv, o0[u][4 * g + 3] * inv);
            v2u w1; w1.x = pk2(o1[u][4 * g] * inv, o1[u][4 * g + 1] * inv); w1.y = pk2(o1[u][4 * g + 2] * inv, o1[u][4 * g + 3] * inv);
            *(v2u*)(orow + 8 * g + 4 * hi) = w0; *(v2u*)(orow + 32 + 8 * g + 4 * hi) = w1;
        }
    }
#undef ATT_TROW
#undef ATT_LOAD
#undef ATT_STORE
}

#define ATT_BAR() do { asm volatile("s_waitcnt lgkmcnt(0)" ::: "memory"); __builtin_amdgcn_s_barrier(); asm volatile("" ::: "memory"); } while (0)
template <int DK, int MODE, int VM = 0>
__device__ __forceinline__ bool unit_h(LAS unsigned char* lds, const bf16* Qp, int qpitch, const bf16* Kp, int kpitch, const bf16* Vp, int vpitch, bf16* Op,
                                       int var, int qt, int lo, int n1, int nt, float qscale, float sink0, float sink1, bool has_sink, const LAS float* bias, const float* t32, volatile LAS unsigned* flag) {
    constexpr int KRS = DK * 2 + 16, NS = DK / 16, CPK = DK / 8;
    int tid = threadIdx.x; asm volatile("" : "+v"(tid)); const int lane = tid & 63, r32 = lane & 31, hi = lane >> 5, wid = __builtin_amdgcn_readfirstlane(tid >> 6);
    const int rowbase = MODE == 0 ? 512 * qt + 64 * wid : 256 * qt + 32 * wid;
    const int kkey0 = tid / CPK, kch0 = tid - kkey0 * CPK, kkey1 = (tid + 512) / CPK, kch1 = (tid + 512) - kkey1 * CPK;
    const int vkey = tid >> 3, vch = tid & 7;
    v4u kreg0, kreg1 = {0u, 0u, 0u, 0u}, vreg;
#define ATT_TROW(j) ((((j) < n1) ? (lo + (j)) : (64 + (j) - n1)) * 64)
#define ATT_LOAD(j) do { const int tr_ = ATT_TROW(j); kreg0 = *(const v4u*)(Kp + (size_t)(tr_ + kkey0) * kpitch + kch0 * 8); \
        if (DK == 96 && tid < 256) kreg1 = *(const v4u*)(Kp + (size_t)(tr_ + kkey1) * kpitch + kch1 * 8); \
        vreg = *(const v4u*)(Vp + (size_t)(tr_ + vkey) * vpitch + vch * 8); } while (0)
#define ATT_STORE(bf) do { LAS unsigned char* b_ = lds + (bf) * BUF; *(LAS v4u*)(b_ + kkey0 * KRS + kch0 * 16) = kreg0; \
        if (DK == 96 && tid < 256) *(LAS v4u*)(b_ + kkey1 * KRS + kch1 * 16) = kreg1; \
        *(LAS v4u*)(b_ + KBUF + vkey * VRS + vch * 16) = vreg; } while (0)
    ATT_LOAD(0);
    bf16x8 qr[2][NS];
#pragma unroll
    for (int u = 0; u < 2; ++u) {
        const int qrow = rowbase + (MODE == 0 ? 32 * u : 0) + r32;
        const bf16* qp = Qp + (MODE == 1 ? 64 * u : 0) + (size_t)qrow * qpitch;
#pragma unroll
        for (int s = 0; s < NS; ++s) { const v4u raw = *(const v4u*)(qp + 16 * s + 8 * hi); float f[8]; unpack8(raw, f);
#pragma unroll
            for (int i = 0; i < 8; ++i) f[i] *= qscale;
            if (DK == 96 && s >= 4) { float p[8];
#pragma unroll
                for (int i = 0; i < 8; ++i) p[i] = __shfl_xor(f[i], 32);
                rope8(f, p, t32 + ((size_t)((s == 4 ? (qrow >> 6) : (qrow & 63)) * 8)) * 2, hi == 0); }
            qr[u][s] = __builtin_bit_cast(bf16x8, pack8(f)); }
    }
    f32x2 lacc[2] = {{0.f, 0.f}, {0.f, 0.f}}; f32x16 o0[2] = {{}, {}}, o1[2] = {{}, {}};
    const int grw = 8 * qt + wid, r0w = min(max(grw - 4, 0), 56), i0w = rowbase;
    ATT_STORE(0);
    if (tid == 0) *flag = 0u;
    ATT_BAR();
    for (int j = 0; j < nt; ++j) {
        if (!(VM & 8) && j + 1 < nt) ATT_LOAD(j + 1);
        const int kt = ATT_TROW(j) >> 6;
        bool actv = true;
        if (kt < 64) { if (var == 0) actv = (kt >= r0w) && (kt <= r0w + 7); else if (var == 2) actv = !((64 * kt - (i0w + 31) > 128) || (i0w - (64 * kt + 63) > 128)); }
        if (actv) {
        const LAS unsigned char* Kb = lds + (j & 1) * BUF; const LAS unsigned char* Vb = Kb + KBUF;
        const LAS unsigned char* vbase = Vb + (4 * hi + ((lane & 15) >> 2)) * VRS + ((lane >> 4) & 1) * 32 + (lane & 3) * 8;
#pragma unroll
        for (int hf = 0; hf < 2; ++hf) {
            f32x16 sc[2] = {{}, {}};
#pragma unroll
            for (int s = 0; s < NS; ++s) {
                const bf16x8 kf = *(const LAS bf16x8*)(Kb + (32 * hf + r32) * KRS + (16 * s + 8 * hi) * 2);
#pragma unroll
                for (int u = 0; u < 2; ++u) sc[u] = __builtin_amdgcn_mfma_f32_32x32x16_bf16(kf, qr[u][s], sc[u], 0, 0, 0);
            }
            if (kt < 64 && var == 0) {
#pragma unroll
                for (int u = 0; u < 2; ++u) { const int gc = 32 * u + r32, c0 = min(max(gc - 8, 0), 48), rowoff = (kt - grw + 7) * 31 - gc + 15;
                    const LAS unsigned char* bb = (const LAS unsigned char*)(bias + rowoff + 4 * hi); asm volatile("" : "+v"(bb));
                    float bv[16];
#pragma unroll
                    for (int r = 0; r < 16; ++r) bv[r] = *(const LAS float*)(bb + 4 * (32 * hf + (r & 3) + 8 * (r >> 2)));
                    asm volatile("" : "+v"(bv[0]), "+v"(bv[1]), "+v"(bv[2]), "+v"(bv[3]), "+v"(bv[4]), "+v"(bv[5]), "+v"(bv[6]), "+v"(bv[7]),
                                      "+v"(bv[8]), "+v"(bv[9]), "+v"(bv[10]), "+v"(bv[11]), "+v"(bv[12]), "+v"(bv[13]), "+v"(bv[14]), "+v"(bv[15]));
#pragma unroll
                    for (int r = 0; r < 16; ++r) { const int jj = 32 * hf + crow(r, hi); const bool v = (unsigned)(jj - c0) < 16u; sc[u][r] = v ? sc[u][r] + bv[r] : NEG; } }
            } else if (kt < 64 && var == 2) {
                const int dbase = 64 * kt - (rowbase + r32) + 128;
#pragma unroll
                for (int r = 0; r < 16; ++r) { const bool v = (unsigned)(dbase + 32 * hf + crow(r, hi)) <= 256u; sc[0][r] = v ? sc[0][r] : NEG; sc[1][r] = v ? sc[1][r] : NEG; }
            }
            bf16x8 pb[2][2];
#pragma unroll
            for (int u = 0; u < 2; ++u) {
#pragma unroll
                for (int r = 0; r < 16; r += 2) { sc[u][r] = __builtin_amdgcn_exp2f(sc[u][r]); sc[u][r + 1] = __builtin_amdgcn_exp2f(sc[u][r + 1]); lacc[u] += (f32x2){sc[u][r], sc[u][r + 1]}; }
#pragma unroll
                for (int s = 0; s < 2; ++s) {
                    v4u w; w.x = cvtpk(sc[u][8 * s], sc[u][8 * s + 1]); w.y = cvtpk(sc[u][8 * s + 2], sc[u][8 * s + 3]); w.z = cvtpk(sc[u][8 * s + 4], sc[u][8 * s + 5]); w.w = cvtpk(sc[u][8 * s + 6], sc[u][8 * s + 7]);
                    pb[u][s] = __builtin_bit_cast(bf16x8, w);
                }
            }
#pragma unroll
            for (int s2 = 0; s2 < 2; ++s2) { const int s = 2 * hf + s2;
                const v4i16 a0 = __builtin_amdgcn_ds_read_tr16_b64_v4i16((LAS v4i16*)(vbase + (16 * s) * VRS));
                const v4i16 a1 = __builtin_amdgcn_ds_read_tr16_b64_v4i16((LAS v4i16*)(vbase + (16 * s + 8) * VRS));
                const v4i16 c0_ = __builtin_amdgcn_ds_read_tr16_b64_v4i16((LAS v4i16*)(vbase + (16 * s) * VRS + 64));
                const v4i16 c1_ = __builtin_amdgcn_ds_read_tr16_b64_v4i16((LAS v4i16*)(vbase + (16 * s + 8) * VRS + 64));
                const bf16x8 va = {a0[0], a0[1], a0[2], a0[3], a1[0], a1[1], a1[2], a1[3]};
                const bf16x8 vc = {c0_[0], c0_[1], c0_[2], c0_[3], c1_[0], c1_[1], c1_[2], c1_[3]};
#pragma unroll
                for (int u = 0; u < 2; ++u) { o0[u] = __builtin_amdgcn_mfma_f32_32x32x16_bf16(va, pb[u][s2], o0[u], 0, 0, 0); o1[u] = __builtin_amdgcn_mfma_f32_32x32x16_bf16(vc, pb[u][s2], o1[u], 0, 0, 0); }
            }
            __builtin_amdgcn_sched_barrier(0);
        }
        }
        if (!(VM & 8) && j + 1 < nt) ATT_STORE((j + 1) & 1);
        ATT_BAR();
    }
    float lsum[2]; bool bad = false;
#pragma unroll
    for (int u = 0; u < 2; ++u) { lsum[u] = xhalf_sum(lacc[u].x + lacc[u].y); bad = bad || !(lsum[u] > 8.6736174e-19f && lsum[u] < 1.1529215e18f);
        if (has_sink) { lsum[u] += __builtin_amdgcn_exp2f(u == 0 ? sink0 : sink1); bad = bad || !(lsum[u] < 1.1529215e18f); } }
    if (__any(bad)) { if (lane == 0) *flag = 1u; }
#pragma unroll
    for (int u = 0; u < 2; ++u) {
        const float inv = 1.0f / lsum[u];
        bf16* orow = Op + (MODE == 1 ? 64 * u : 0) + (size_t)(rowbase + (MODE == 0 ? 32 * u : 0) + r32) * D;
#pragma unroll
        for (int g = 0; g < 4; ++g) {
            v2u w0; w0.x = pk2(o0[u][4 * g] * inv, o0[u][4 * g + 1] * inv); w0.y = pk2(o0[u][4 * g + 2] * inv, o0[u][4 * g + 3] * inv);
            v2u w1; w1.x = pk2(o1[u][4 * g] * inv, o1[u][4 * g + 1] * inv); w1.y = pk2(o1[u][4 * g + 2] * inv, o1[u][4 * g + 3] * inv);
            *(v2u*)(orow + 8 * g + 4 * hi) = w0; *(v2u*)(orow + 32 + 8 * g + 4 * hi) = w1;
        }
    }
    ATT_BAR();
    return *flag == 0u;
#undef ATT_TROW
#undef ATT_LOAD
#undef ATT_STORE
}
}

template <int VM = 0>
__device__ __forceinline__ void phase_attn(const Frame& F, int lq) {
    const int l = lq & 3;
    const bf16* P = (const bf16*)(F.ws + WS_PB); const bf16* QD = (const bf16*)(F.ws + WS_QD); const bf16* KD = (const bf16*)(F.ws + WS_KD);
    const bf16* VD = (const bf16*)(F.ws + WS_VD); bf16* O = (bf16*)(F.ws + (lq >= 4 ? WS_ACT : WS_HA));
    unsigned* ctr = (unsigned*)(F.ws + WS_CTL) + CW_QUEUE + 64 * 8 * lq;
    LAS float* bias = (LAS float*)(F.lds + att::BIAS_OFF);
    { const float* nab = INP(I_NABIAS) + l * 4 * 465; for (int i = F.tid; i < 4 * 465; i += NTHR) bias[i] = nab[i] * LOG2E; }
    const float* sinks = INP(I_SINK) + l * 4;
    __syncthreads();
    const float* t32 = (const float*)(F.ws + WS_T32);
    volatile LAS unsigned* flag = F.MISC + MI_Q + 1;
    const int nloc = 256 + (l < NL - 1 ? 24 : 0);
    const int q0 = (int)xb_xcc_id();
    for (int qq = 0; qq < 8; ++qq) {
      const int q = (q0 + qq) & 7;
      unsigned* qctr = ctr + 64 * q;
      for (;;) {
        if (F.tid == 0) F.MISC[MI_Q] = __hip_atomic_fetch_add(qctr, 1u, __ATOMIC_RELAXED, __HIP_MEMORY_SCOPE_AGENT);
        ATT_BAR();
        const int li = (int)F.MISC[MI_Q];
        ATT_BAR();
        if (li >= nloc) break;
        int idx;
        if (li < 64) idx = (q + 8 * (li >> 3)) * 8 + (li & 7);
        else if (li < 128) { const int jx = li - 64; idx = 1024 + (q + 8 * (jx >> 4)) * 16 + (jx & 15); }
        else if (li < 192) { const int jx = li - 128; idx = 1536 + (q + 8 * (jx >> 3)) * 8 + (jx & 7); }
        else if (li < 256) { const int jx = li - 192; idx = 2048 + (q + 8 * (jx >> 4)) * 16 + (jx & 15); }
        else if (li < 264) idx = 2560 + q + 8 * (li - 256);
        else idx = 2624 + q + 8 * (li - 264);
        if (idx < 512) {
            const int b = idx >> 5, h = (idx >> 3) & 3, qt = idx & 7; const size_t rb = (size_t)b * TT;
            if (!att::unit_h<96, 0, VM>(F.lds, QD + rb * 384 + h * 96, 384, KD + rb * 384 + h * 96, 384, VD + rb * 256 + h * 64, 256, O + rb * D + 768 + h * 64, 3, qt, 0, 64, 68, 0.10206207261596575f * LOG2E, 0.f, 0.f, false, bias, t32, flag)) {
                __syncthreads();
#pragma unroll 1
                for (int k2 = 0; k2 < 2; ++k2)
                    att::unit<96, VM>(F.lds, QD + rb * 384 + h * 96, 384, KD + rb * 384 + h * 96, 384, VD + rb * 256 + h * 64, 256, O + rb * D + 768 + h * 64, 3, 2 * qt + k2, 0, 64, 68, 0.10206207261596575f * LOG2E, 0.f, false, bias, t32, nullptr);
            }
        } else if (idx < 1024) {
        } else if (idx < 2560) {
            idx -= 1024;
            const int grp = idx >> 9, rem = idx & 511, b = rem >> 5; const size_t rb = (size_t)b * TT;
            if (grp == 1) {
                const int h = (rem >> 3) & 3, qt = rem & 7; const int lo = min(max(8 * qt - 4, 0), 56), n1 = min(max(8 * qt + 3, 0), 56) + 7 - lo + 1;
                if (!att::unit_h<64, 0, VM>(F.lds, P + rb * NPJ + h * 64, NPJ, P + rb * NPJ + 256 + h * 64, NPJ, P + rb * NPJ + 512 + h * 64, NPJ, O + rb * D + h * 64, 0, qt, lo, n1, n1 + 4, 0.125f * LOG2E, 0.f, 0.f, false, bias + h * 465, t32, flag)) { __syncthreads();
                att::unit2<64, 0, VM>(F.lds, P + rb * NPJ + h * 64, NPJ, P + rb * NPJ + 256 + h * 64, NPJ, P + rb * NPJ + 512 + h * 64, NPJ, O + rb * D + h * 64, 0, qt, lo, n1, n1 + 4,
                                  0.125f * LOG2E, 0.f, 0.f, false, bias + h * 465, t32); }
            } else {
                const int g = (rem >> 4) & 1, qt = rem & 15; const bool isc = grp == 2;
                const int lo = isc ? max(4 * qt - 2, 0) : 0, n1 = isc ? min(4 * qt + 5, 63) - lo + 1 : 64;
                const int qc = (isc ? 1280 : 768) + g * 128, kc = (isc ? 1536 : 1024) + g * 64, vc = (isc ? 1664 : 1152) + g * 64;
                const float sk0 = isc ? sinks[2 * g] * LOG2E : 0.f, sk1 = isc ? sinks[2 * g + 1] * LOG2E : 0.f;
                if (!att::unit_h<64, 1, VM>(F.lds, P + rb * NPJ + qc, NPJ, P + rb * NPJ + kc, NPJ, P + rb * NPJ + vc, NPJ, O + rb * D + (isc ? 512 : 256) + g * 128, isc ? 2 : 1, qt, lo, n1, n1 + 4, 0.125f * LOG2E, sk0, sk1, isc, bias, t32, flag)) { __syncthreads();
                att::unit2<64, 1, VM>(F.lds, P + rb * NPJ + qc, NPJ, P + rb * NPJ + kc, NPJ, P + rb * NPJ + vc, NPJ, O + rb * D + (isc ? 512 : 256) + g * 128, isc ? 2 : 1, qt, lo, n1, n1 + 4,
                                  0.125f * LOG2E, isc ? sinks[2 * g] * LOG2E : 0.f, isc ? sinks[2 * g + 1] * LOG2E : 0.f, isc, bias, t32); }
            }
        } else if (idx < 2624) {
            const int rem = idx - 2560, b = rem >> 2, isc = (rem >> 1) & 1, g = rem & 1; const size_t rb = (size_t)b * TT;
            const int qc = (isc ? 1280 : 768) + g * 128, kc = (isc ? 1536 : 1024) + g * 64, vc = (isc ? 1664 : 1152) + g * 64;
            att::unit2<64, 1, VM>(F.lds, P + rb * NPJ + qc, NPJ, P + rb * NPJ + kc, NPJ, P + rb * NPJ + vc, NPJ, O + rb * D + (isc ? 512 : 256) + g * 128, isc ? 2 : 1, 16, 0, 0, 4,
                              0.125f * LOG2E, isc ? sinks[2 * g] * LOG2E : 0.f, isc ? sinks[2 * g + 1] * LOG2E : 0.f, isc != 0, bias, t32);
        } else {
            const int rem = idx - 2624, b = rem >> 3, isd = (rem >> 2) & 1, h = rem & 3; const size_t rb = (size_t)b * TT;
            if (isd) att::unit<96, VM>(F.lds, QD + rb * 384 + h * 96, 384, KD + rb * 384 + h * 96, 384, VD + rb * 256 + h * 64, 256, O + rb * D + 768 + h * 64, 3, 16, 0, 0, 4, 0.10206207261596575f * LOG2E, 0.f, false, bias, t32, nullptr);
            else att::unit<64, VM>(F.lds, P + rb * NPJ + h * 64, NPJ, P + rb * NPJ + 256 + h * 64, NPJ, P + rb * NPJ + 512 + h * 64, NPJ, O + rb * D + h * 64, 0, 16, 0, 0, 4, 0.125f * LOG2E, 0.f, false, bias + h * 465, nullptr, nullptr);
        }
    }
    }
}


#define PHASE_FN static __device__ __forceinline__ void
PHASE_FN ph_prologue(GAS unsigned char* ws) { const Frame F = make_frame(ws); phase_prologue(F); }
PHASE_FN ph_ln(GAS unsigned char* ws, int l) { const Frame F = make_frame(ws); phase_ln(F, l); }
PHASE_FN ph_gemm_in(GAS unsigned char* ws, int l) {
    const Frame F = make_frame(ws);
    pg8::Gemm g{(const bf16*)(F.ws + WS_HA), (const bf16*)(F.ws + WS_WIN), M, NPJ, D, D, nullptr}; pg8::StaticOrder S; S.init(M, NPJ, F.G, F.bid);
    pg8::EpiBf16NT<0> E{(bf16*)(F.ws + WS_PB), NPJ, nullptr, 0, 0, 1.f};
    pg8::gemm_phase<pg8::EpiBf16NT<0>, pg8::StaticOrder, true, true>(F.lds, g, S, E);
}
PHASE_FN ph_post(GAS unsigned char* ws, int l) { const Frame F = make_frame(ws); phase_post(F, l); }
PHASE_FN ph_gemm_mla(GAS unsigned char* ws, int l) {
    const Frame F = make_frame(ws);
    pg8::Gemm g{(const bf16*)(F.ws + WS_PB) + 1792, (const bf16*)(F.ws + WS_WD), M, 1024, 384, NPJ, nullptr}; pg8::StaticOrder S; S.init(M, 1024, F.G, F.bid);
    EpiMla E{(bf16*)(F.ws + WS_QD), (bf16*)(F.ws + WS_KD), (bf16*)(F.ws + WS_VD)};
    pg8::gemm_phase<EpiMla, pg8::StaticOrder, true, true>(F.lds, g, S, E);
}
template <int VM>
PHASE_FN ph_attn(GAS unsigned char* ws, int l) { const Frame F = make_frame(ws); phase_attn<VM>(F, l); }
PHASE_FN ph_gemm_out(GAS unsigned char* ws, int l) {
    const Frame F = make_frame(ws);
    pg8::Gemm g{(const bf16*)(F.ws + WS_HA), (const bf16*)(F.ws + WS_WOUT), M, D, D, D, nullptr};
    pg8::EpiBf16NT<0> E{(bf16*)(F.ws + WS_PB), D, nullptr, 0, 0, 1.f};
    if (l == NL - 1) { LatOrder S{F.G, F.bid}; pg8::gemm_phase<pg8::EpiBf16NT<0>, LatOrder, true, true>(F.lds, g, S, E); }
    else { pg8::StaticOrder S; S.init(M, D, F.G, F.bid); pg8::gemm_phase<pg8::EpiBf16NT<0>, pg8::StaticOrder, true, true>(F.lds, g, S, E); }
}
PHASE_FN ph_route(GAS unsigned char* ws, int l) { const Frame F = make_frame(ws); phase_route(F, l); }
PHASE_FN ph_permute(GAS unsigned char* ws, int l) { const Frame F = make_frame(ws); phase_permute(F, l); }
PHASE_FN ph_gemm_gu(GAS unsigned char* ws, int l) {
    const Frame F = make_frame(ws);
    moe_tables(F);
    pg8::Gemm g{(const bf16*)(F.ws + WS_HA), (const bf16*)(F.ws + WS_WGU), MS, 16384, D, D, (const int*)(F.ws + WS_QD)}; MoeOrder S{F.MISC + MI_PST, F.G, F.bid};
    EpiGU E{(bf16*)(F.ws + WS_ACT)};
    pg8::gemm_phase<EpiGU, MoeOrder, true, true, true>(F.lds, g, S, E);
}
PHASE_FN ph_gemm_dn(GAS unsigned char* ws, int l) {
    const Frame F = make_frame(ws);
    moe_tables(F);
    pg8::Gemm g{(const bf16*)(F.ws + WS_ACT), (const bf16*)(F.ws + WS_WDN), MS, 16384, 512, 512, nullptr}; MoeOrder S{F.MISC + MI_PST, F.G, F.bid};
    pg8::EpiBf16NT<0> E{(bf16*)(F.ws + WS_PB), D, nullptr, 1024, 0, 1.f};
    pg8::gemm_phase<pg8::EpiBf16NT<0>, MoeOrder, true, true>(F.lds, g, S, E);
}


#if MK_DEBUG
#ifndef DBG_MODE
#define DBG_MODE 0
#endif
__device__ __forceinline__ float oracle_attn(const Frame& F, int l, int r, int var, int h, int mode = 0) {
    const bf16* P = (const bf16*)(F.ws + WS_PB); const bf16* QD = (const bf16*)(F.ws + WS_QD); const bf16* KD = (const bf16*)(F.ws + WS_KD); const bf16* VD = (const bf16*)(F.ws + WS_VD);
    const bf16* O = (const bf16*)(F.ws + WS_HA); const float* t32 = (const float*)(F.ws + WS_T32);
    const int b = r / TT, t = r - b * TT; const bool lat = t < SEQ; const size_t rb = (size_t)b * TT;
    const int dk = var == 3 ? 96 : 64;
    const bf16* qp; const bf16* kp; const bf16* vp; int kpitch, vpitch;
    if (var == 3) { qp = QD + (size_t)r * 384 + h * 96; kp = KD + rb * 384 + h * 96; kpitch = 384; vp = VD + rb * 256 + h * 64; vpitch = 256; }
    else { const int qc = var == 0 ? h * 64 : var == 1 ? 768 + h * 64 : 1280 + h * 64, kc = var == 0 ? 256 + h * 64 : var == 1 ? 1024 + (h >> 1) * 64 : 1536 + (h >> 1) * 64,
           vc = var == 0 ? 512 + h * 64 : var == 1 ? 1152 + (h >> 1) * 64 : 1664 + (h >> 1) * 64;
           qp = P + (size_t)r * NPJ + qc; kp = P + rb * NPJ + kc; kpitch = NPJ; vp = P + rb * NPJ + vc; vpitch = NPJ; }
    LAS float* qs = (LAS float*)(F.lds + 65536) + F.wave * 128;
    for (int d = F.lane; d < dk; d += 64) qs[d] = __builtin_bit_cast(float, (unsigned)qp[d] << 16);
    asm volatile("s_waitcnt lgkmcnt(0)" ::: "memory");
    if (var == 3 && lat && F.lane < 32) {
        const int c = F.lane >> 3, e = F.lane & 7, gr = t >> 6, gc = t & 63; const float own = qs[64 + F.lane], par = qs[64 + (F.lane ^ 8)];
        const float cs = t32[((c < 2 ? gr : gc) * 8 + e) * 2], sn = t32[((c < 2 ? gr : gc) * 8 + e) * 2 + 1];
        const float nv = (c & 1) == 0 ? own * cs - par * sn : par * sn + own * cs;
        asm volatile("s_waitcnt lgkmcnt(0)" ::: "memory"); qs[64 + F.lane] = nv; }
    asm volatile("s_waitcnt lgkmcnt(0)" ::: "memory");
    const float scale = var == 3 ? 0.10206207261596575f : 0.125f;
    const int gr = t >> 6, gc = t & 63, r0 = min(max(gr - 4, 0), 56), c0 = min(max(gc - 8, 0), 48);
    float m = -3.0e38f, lsum = 0.f, acc[64];
#pragma unroll
    for (int d = 0; d < 64; ++d) acc[d] = 0.f;
    for (int j = F.lane; j < TT; j += 64) {
        bool ok = true; float bias = 0.f;
        if (!lat) ok = j >= SEQ;
        else if (j < SEQ) {
            if (var == 0) { const int kr = j >> 6, kc2 = j & 63; ok = kr >= r0 && kr <= r0 + 7 && kc2 >= c0 && kc2 <= c0 + 15;
                if (ok) bias = INP(I_NABIAS)[((l * 4 + h) * 15 + (kr - gr + 7)) * 31 + (kc2 - gc + 15)]; }
            else if (var == 2) ok = (j - t <= 128) && (t - j <= 128);
        }
        if (!ok) continue;
        float sc = 0.f; const bf16* kr_ = kp + (size_t)j * kpitch;
        for (int d = 0; d < dk; ++d) sc += qs[d] * __builtin_bit_cast(float, (unsigned)kr_[d] << 16);
        sc = sc * scale + bias;
        const float mn = fmaxf(m, sc), a = expf(m - mn), p = expf(sc - mn); m = mn; lsum = lsum * a + p;
        const bf16* vr = vp + (size_t)j * vpitch;
#pragma unroll
        for (int d = 0; d < 64; ++d) acc[d] = acc[d] * a + p * __builtin_bit_cast(float, (unsigned)vr[d] << 16);
    }
    float mg = m;
#pragma unroll
    for (int o = 1; o < 64; o <<= 1) mg = fmaxf(mg, __shfl_xor(mg, o));
    if (mode >= 1) {
        const unsigned* rec = (const unsigned*)(F.ws + WS_RS) + (size_t)r * 2; const float mk = __builtin_bit_cast(float, rec[0]), lk = __builtin_bit_cast(float, rec[1]);
        const float lref = wave_sum(lsum * expf(m - mg));
        const float lker = lk * exp2f(mk - mg * LOG2E);
        if (mode == 2) return fabsf(mk / LOG2E - mg);
        return fabsf(lker / lref - 1.0f);
    }
    const float f = expf(m - mg); lsum *= f; lsum = wave_sum(lsum);
    if (var == 2) lsum += expf(INP(I_SINK)[l * 4 + h] - mg);
    float err = 0.f, mag = 1.0e-6f;
    const bf16* orow = O + (size_t)r * D + var * 256 + h * 64;
#pragma unroll
    for (int d = 0; d < 64; ++d) { const float ref = wave_sum(acc[d] * f) / lsum; const float got = __builtin_bit_cast(float, (unsigned)orow[d] << 16);
        const float df = fabsf(got - ref); err = (df == df) ? fmaxf(err, df) : 1.0e30f; mag = fmaxf(mag, fabsf(ref)); }
    return err / mag;
}
__device__ __forceinline__ void phase_dump(const Frame& F, int code) {
    float* out = (float*)ptab_get(F, I_OUT);
    for (int r = F.gw; r < M; r += F.ngw) {
        const int b = r / TT, t = r - b * TT; if (t >= SEQ) continue;
        float v[16];
        if (code == 1) ld16bf((const bf16*)(F.ws + WS_HA) + (size_t)r * D, F.lane, v);
        else if (code == 2) ld16bf((const bf16*)(F.ws + WS_PB) + (size_t)r * NPJ, F.lane, v);
        else if (code == 3) ld16bf((const bf16*)(F.ws + WS_PB) + (size_t)r * NPJ + 1024, F.lane, v);
        else if (code == 4) ld16bf((const bf16*)(F.ws + WS_PB) + (size_t)r * NPJ + 1280, F.lane, v);
        else if (code == 5) ld16((const float*)(F.ws + WS_PB) + (size_t)r * D, F.lane, v);
        else if (code == 8) {
            const v4u w0 = *((const v4u*)((const bf16*)(F.ws + WS_HA) + (size_t)r * D) + F.lane), w1 = *((const v4u*)((const bf16*)(F.ws + WS_HA) + (size_t)r * D) + 64 + F.lane);
            float f[8]; int bad0 = 0, bad1 = 0; unpack8(w0, f);
#pragma unroll
            for (int i = 0; i < 8; ++i) { const unsigned u = __builtin_bit_cast(unsigned, f[i]); bad0 |= ((u & 0x7f800000u) == 0x7f800000u) ? 1 : 0; }
            unpack8(w1, f);
#pragma unroll
            for (int i = 0; i < 8; ++i) { const unsigned u = __builtin_bit_cast(unsigned, f[i]); bad1 |= ((u & 0x7f800000u) == 0x7f800000u) ? 1 : 0; }
            const unsigned long long m0 = __ballot(bad0), m1 = __ballot(bad1);
            const bool vA = (m0 & 0xffffffffull) != 0, vB = (m0 >> 32) != 0, vC = (m1 & 0xffffffffull) != 0, vD = (m1 >> 32) != 0;
            const float val = (float)(t + 1) * ((vA ? 1.0f : 0.f) + (vB ? 1.0e2f : 0.f) + (vC ? 1.0e4f : 0.f) + (vD ? 1.0e6f : 0.f));
#pragma unroll
            for (int i = 0; i < 16; ++i) v[i] = val;
        }
        else if (code == 9) { const unsigned cd = ((const unsigned*)(F.ws + WS_RS))[(size_t)r * 2]; float val = 0.f; if (cd) { val = 1.f; for (unsigned k = 0; k < cd; ++k) val *= 10.f; }
#pragma unroll
            for (int i = 0; i < 16; ++i) v[i] = val; }
        else if (code == 10) {
            const v4u w1 = *((const v4u*)((const bf16*)(F.ws + WS_HA) + (size_t)r * D) + 64 + F.lane);
            float f[8]; int bad1 = 0; unpack8(w1, f);
#pragma unroll
            for (int i = 0; i < 8; ++i) { const unsigned u = __builtin_bit_cast(unsigned, f[i]); bad1 |= ((u & 0x7f800000u) == 0x7f800000u) ? 1 : 0; }
            const bool vC = (__ballot(bad1) & 0xffffffffull) != 0;
            const bf16* pc = (const bf16*)(F.ws + WS_PB) + ((size_t)b * TT + SEQ + (t & 255)) * NPJ; int badp = 0;
            for (int c = F.lane; c < 288; c += 64) { const v4u w = *((const v4u*)pc + c); unpack8(w, f);
#pragma unroll
                for (int i = 0; i < 8; ++i) { const unsigned u = __builtin_bit_cast(unsigned, f[i]); badp |= ((u & 0x7f800000u) == 0x7f800000u) ? 1 : 0; } }
            float val = 0.f; if (vC) { val = 1.f; for (int k = 0; k <= (t & 15); ++k) val *= 10.f; }
            if (__any(badp)) val = 1.0e30f;
#pragma unroll
            for (int i = 0; i < 16; ++i) v[i] = val;
        }
        else if (code == 11) {
            const bf16* pr = (const bf16*)(F.ws + WS_PB) + (size_t)r * NPJ; int grp = -1;
            for (int c = F.lane; c < 288; c += 64) { const v4u w = *((const v4u*)pr + c); float f[8]; unpack8(w, f);
#pragma unroll
                for (int i = 0; i < 8; ++i) if (!(fabsf(f[i]) < 1.0e4f)) grp = (c * 8) >> 8; }
#pragma unroll
            for (int o = 1; o < 64; o <<= 1) { const int g2 = __shfl_xor(grp, o); grp = g2 > grp ? g2 : grp; }
            float val = 0.f; if (grp >= 0) { val = 100.f; for (int k = 0; k < grp; ++k) val *= 10.f; }
#pragma unroll
            for (int i = 0; i < 16; ++i) v[i] = val;
        }
        else if (code >= 20 && code < 24) {
            float val = 0.f;
            if ((t & 15) == 5) { for (int h = 0; h < 4; ++h) { const float e = oracle_attn(F, 0, r, code - 20, h); const float cls = e > 1.0e20f ? 3.f : e > 0.5f ? 2.f : e > 0.03f ? 1.f : 0.f; if (cls > 0.f) { float w = cls; for (int k = 0; k <= h; ++k) w *= 10.f; val = fmaxf(val, w); } } }
#pragma unroll
            for (int i = 0; i < 16; ++i) v[i] = val;
        }
        else if (code >= 30 && code < 46) {
            float val = 0.f;
            if ((t & 15) == 5) { const float e = oracle_attn(F, 0, r, (code - 30) >> 2, (code - 30) & 3, DBG_MODE); val = e > 10.f ? 1.0e4f : 1000.f * e; }
#pragma unroll
            for (int i = 0; i < 16; ++i) v[i] = val;
        }
        else if (code == 7) {
            auto bad16 = [&](const bf16* p, int nchunks) { int bad = 0; for (int c = F.lane; c < nchunks; c += 64) { const v4u w = *((const v4u*)p + c); float f[8]; unpack8(w, f);
#pragma unroll
                for (int i = 0; i < 8; ++i) { const unsigned u = __builtin_bit_cast(unsigned, f[i]); bad |= ((u & 0x7f800000u) == 0x7f800000u) ? 1 : 0; } } return __any(bad); };
            const int bP = bad16((const bf16*)(F.ws + WS_PB) + (size_t)r * NPJ, 288), bQ = bad16((const bf16*)(F.ws + WS_QD) + (size_t)r * 384, 48),
                      bK = bad16((const bf16*)(F.ws + WS_KD) + (size_t)r * 384, 48), bV = bad16((const bf16*)(F.ws + WS_VD) + (size_t)r * 256, 32), bO = bad16((const bf16*)(F.ws + WS_HA) + (size_t)r * D, 128);
            const float val = bP ? 1.0e6f : bQ ? 1.0e5f : bK ? 1.0e4f : bV ? 1.0e3f : bO ? 1.0e2f : 0.f;
#pragma unroll
            for (int i = 0; i < 16; ++i) v[i] = val;
        }
#pragma unroll
        for (int i = 0; i < 16; ++i) { const unsigned u = __builtin_bit_cast(unsigned, v[i]); if ((u & 0x7f800000u) == 0x7f800000u) v[i] = 777.0f; }
        st16(out + ((size_t)b * SEQ + t) * D, F.lane, v);
    }
}
static __device__ __forceinline__ void ph_dump(GAS unsigned char* ws, int code) { const Frame F = make_frame(ws); phase_dump(F, code); }
#endif
__global__ void __launch_bounds__(NTHR, 2) mk_fwd(Args args) {
    extern __shared__ __attribute__((aligned(16))) unsigned char lds_raw[];
    LAS unsigned char* lds = (LAS unsigned char*)lds_raw; volatile LAS unsigned* MISC = (volatile LAS unsigned*)(lds + MISC_OFF);
    const int tid = threadIdx.x;
    GAS unsigned char* ws = (GAS unsigned char*)args.ws;
    for (int u = tid; u < (LDS_BYTES - MISC_OFF) / 4; u += NTHR) MISC[u] = 0u;
    __syncthreads();
    if (tid < 28) { const unsigned long long p = tid < 27 ? (unsigned long long)args.in[tid] : (unsigned long long)args.out;
        LAS unsigned* t = (LAS unsigned*)(lds + PTAB_OFF) + 2 * tid; t[0] = (unsigned)p; t[1] = (unsigned)(p >> 32); }
    __syncthreads();
#if MK_MULTI
#define GRID_BAR() do { } while (0)
#else
    XcdBarrier bar = xcd_barrier_post((unsigned*)(ws + WS_CTL) + CW_BAR, MISC + MI_BAR);
#define GRID_BAR() xcd_barrier(bar)
#endif
    const int lo = args.ph_lo, hi = args.ph_hi;
#define IN(k) (lo <= (k) && (k) < hi)
#if MK_TIME
    unsigned long long tcat = 0ull, tb0 = 0ull;
#define TBEG() do { tb0 = __builtin_amdgcn_s_memrealtime(); } while (0)
#define TEND(c) do { if ((c) == MK_TIME - 1) tcat += __builtin_amdgcn_s_memrealtime() - tb0; } while (0)
#define SEAM(k) do { if (IN(k) && IN((k) + 1)) { TBEG(); GRID_BAR(); TEND(1); } } while (0)
#else
#define TBEG() do { } while (0)
#define TEND(c) do { } while (0)
#define SEAM(k) do { if (IN(k) && IN((k) + 1)) GRID_BAR(); } while (0)
#endif

#if MK_DEBUG
    if (lo >= 100) { ph_dump(ws, lo - 100); return; }
#endif
    if (IN(0)) { TBEG(); ph_prologue(ws); TEND(2); } SEAM(0);
    for (int l = 0; l < NL; ++l) {
        const int pb = 1 + 10 * l;
        if (IN(pb + 0)) { TBEG(); ph_ln(ws, l); TEND(0); } SEAM(pb + 0);
        if (IN(pb + 1)) { TBEG(); ph_gemm_in(ws, l); if (MK_DUP & 2) { GRID_BAR(); ph_gemm_in(ws, l); } TEND(3); } SEAM(pb + 1);
        if (IN(pb + 2)) { TBEG(); ph_post(ws, l); TEND(0); } SEAM(pb + 2);
        if (IN(pb + 3)) { TBEG(); ph_gemm_mla(ws, l); if (MK_DUP & 8) { GRID_BAR(); ph_gemm_mla(ws, l); } TEND(3); } SEAM(pb + 3);
        if (IN(pb + 4)) { TBEG(); ph_attn<0>(ws, l); if (MK_DUP & 16) { GRID_BAR(); ph_attn<MK_VM>(ws, l + 4); } TEND(4); } SEAM(pb + 4);
        if (IN(pb + 5)) { TBEG(); ph_gemm_out(ws, l); if (MK_DUP & 32) { GRID_BAR(); ph_gemm_out(ws, l); } TEND(3); } SEAM(pb + 5);
        if (IN(pb + 6)) { TBEG(); ph_route(ws, l); TEND(0); } SEAM(pb + 6);
        if (IN(pb + 7)) { TBEG(); ph_permute(ws, l); if (MK_DUP & 128) { GRID_BAR(); ph_permute(ws, l); } TEND(0); } SEAM(pb + 7);
        if (IN(pb + 8)) { TBEG(); ph_gemm_gu(ws, l); if (MK_DUP & 256) { GRID_BAR(); ph_gemm_gu(ws, l); } TEND(3); } SEAM(pb + 8);
        if (IN(pb + 9)) { TBEG(); ph_gemm_dn(ws, l); if (MK_DUP & 512) { GRID_BAR(); ph_gemm_dn(ws, l); } TEND(3); } SEAM(pb + 9);
    }
    if (IN(NPHASE - 1)) { TBEG(); ph_ln(ws, NL); TEND(0); }
#if MK_TIME
    if (blockIdx.x == 0) { const unsigned long long tw = __builtin_amdgcn_s_memrealtime(); const unsigned long long dl = tcat * (unsigned long long)MK_TMUL; while (__builtin_amdgcn_s_memrealtime() - tw < dl) __builtin_amdgcn_s_sleep(8); }
#endif
#undef IN
#undef SEAM
#undef GRID_BAR
}

extern "C" void kernel_launch(void* const* d_in, const int* in_sizes, int n_in, void* d_out, int out_size, void* d_ws, size_t ws_size, hipStream_t stream) {
    static int grid = 0;
    if (grid == 0) {
        if (n_in != 27 || out_size != NB * SEQ * D || ws_size < WS_END) { fprintf(stderr, "kernel_launch: unexpected problem (n_in %d, out %d, ws %zu < %zu)\n", n_in, out_size, ws_size, (size_t)WS_END); grid = -1; return; }
        int dev = 0, cus = 0, per_cu = 0;
        if (hipGetDevice(&dev) != hipSuccess || hipDeviceGetAttribute(&cus, hipDeviceAttributeMultiprocessorCount, dev) != hipSuccess) { grid = -1; return; }
        if (hipFuncSetAttribute((const void*)mk_fwd, hipFuncAttributeMaxDynamicSharedMemorySize, LDS_BYTES) != hipSuccess) { fprintf(stderr, "kernel_launch: hipFuncSetAttribute failed\n"); grid = -1; return; }
        if (hipOccupancyMaxActiveBlocksPerMultiprocessor(&per_cu, (const void*)mk_fwd, NTHR, LDS_BYTES) != hipSuccess || per_cu < 1) fprintf(stderr, "kernel_launch: occupancy query reports %d\n", per_cu);
        (void)hipGetLastError();
        grid = cus > 1024 ? 1024 : cus;
    }
    if (grid < 0) return;
    (void)hipMemsetAsync((char*)d_ws + WS_CTL, 0, CTL_BYTES, stream);
    Args a{};
    for (int i = 0; i < 27; ++i) a.in[i] = (const float*)d_in[i];
    a.out = (float*)d_out; a.ws = (unsigned char*)d_ws;
#if MK_MULTI
#ifndef DBG_NRUN
#define DBG_NRUN NPHASE
#endif
    for (int p = 0; p < DBG_NRUN; ++p) { a.ph_lo = p; a.ph_hi = p + 1; hipLaunchKernelGGL(mk_fwd, dim3(grid), dim3(NTHR), LDS_BYTES, stream, a); }
#ifdef DBG_DUMP
    a.ph_lo = 100 + DBG_DUMP; a.ph_hi = 101 + DBG_DUMP; hipLaunchKernelGGL(mk_fwd, dim3(grid), dim3(NTHR), LDS_BYTES, stream, a);
#endif
#else
    a.ph_lo = 0; a.ph_hi = NPHASE;
    hipLaunchKernelGGL(mk_fwd, dim3(grid), dim3(NTHR), LDS_BYTES, stream, a);
#endif
}
```

```cpp
#include <hip/hip_runtime.h>
#include <cstdio>
#include <cstdint>
namespace pg8 {
#define PG8_LAS __attribute__((address_space(3)))
typedef unsigned short bf16_t;
typedef short bf16x8 __attribute__((ext_vector_type(8)));
typedef float f32x4 __attribute__((ext_vector_type(4)));
typedef unsigned u32x4 __attribute__((ext_vector_type(4)));
constexpr int BM = 256, BK = 64, HALF = 128, HTB = HALF * BK * 2  , STAGE_BYTES = 8 * HTB, NXCD = 8, WGM = 8;

__host__ __device__ __forceinline__ int lds_byte(int r, int c) { const int st = (r >> 4) * 2 + (c >> 5), rr = r & 15, cc = c & 31, ob = rr * 64 + cc * 2; return st * 1024 + (ob ^ (((ob >> 9) & 1) << 5)); }
__host__ __device__ __forceinline__ void stage_rc(int b, int& R, int& C) { const int st = b / 1024, sb = b % 1024, swz = sb ^ (((sb >> 9) & 1) << 5); R = (st >> 1) * 16 + swz / 64; C = (st & 1) * 32 + (swz % 64) / 2; }
__host__ __device__ __forceinline__ int perm32(int rho) { const int n = rho >> 4, i = rho & 15; return 8 * (i >> 2) + 4 * n + (i & 3); }

struct Unit { int pm, pn; };
struct Gemm { const bf16_t* A; const bf16_t* Bt; int M, N, K, lda; const int* src; };

struct StaticOrder {
    int nM, nN, nwg, G, c;
    __host__ __device__ void init(int M, int N, int G_, int c_) { nM = M / BM; nN = N / BM; nwg = nM * nN; G = G_; c = c_; }
    __host__ __device__ bool next(int i, Unit& u) const {
        const long L = (long)i * G + c; if (L >= nwg) return false;
        int wgid = (int)L; { const int q = nwg / NXCD, r = nwg % NXCD, xcd = wgid % NXCD, off = wgid / NXCD; wgid = (xcd < r ? xcd * (q + 1) : r * (q + 1) + (xcd - r) * q) + off; }
        const int nig = WGM * nN, gid = wgid / nig, fm = gid * WGM, gsz = (nM - fm) < WGM ? (nM - fm) : WGM;
        u.pm = fm + ((wgid % nig) % gsz); u.pn = (wgid % nig) / gsz; return true;
    }
    __device__ __forceinline__ void a_ready(const Unit&) const {}
    __device__ __forceinline__ void done(const Unit&) const {}
};

__device__ __forceinline__ unsigned cvt_pk_bf16(float lo, float hi) { unsigned r; asm volatile("v_cvt_pk_bf16_f32 %0, %1, %2" : "=v"(r) : "v"(lo), "v"(hi)); return r; }
typedef float f32x2 __attribute__((ext_vector_type(2)));
__device__ __forceinline__ f32x2 gelu_pk(f32x2 v) {
    const f32x2 av = __builtin_elementwise_abs(v), d = av * 0.2316418882f + 1.0f;
    f32x2 t; t.x = __builtin_amdgcn_rcpf(d.x); t.y = __builtin_amdgcn_rcpf(d.y);
    f32x2 q = t * 0.5307027145f + (-0.7265760135f); q = q * t + 0.7107068705f; q = q * t + (-0.142248368f); q = q * t + 0.127414796f; q = q * t;
    const f32x2 s = (v * v) * (-0.72134752044f);
    f32x2 e; e.x = __builtin_amdgcn_exp2f(s.x); e.y = __builtin_amdgcn_exp2f(s.y);
    const f32x2 m = v * (q * e), r = v - m;
    f32x2 o; o.x = v.x < 0.f ? m.x : r.x; o.y = v.y < 0.f ? m.y : r.y; return o;
}

template <int ACT  > struct EpiBf16 {
    static constexpr bool PERM = true, AFTER_DRAIN = false; static_assert(ACT == 0 || ACT == 1, "EpiBf16: ACT is 0 (none) or 1 (gelu_pk)");
    bf16_t* O; int ldc; const float* bias; int split_cols; size_t split_stride; float scale0;
    __device__ __forceinline__ void operator()(const f32x4 (&acc)[2][2][4][2], const Unit& u, int wr, int wc, int fr, int fq) const {
        const int row0 = u.pm * BM + wr * 64 + fr; int colt = u.pn * BM; bf16_t* base = O;
        float sc = 1.f; if (split_cols) { const int t = colt / split_cols; base += (size_t)t * split_stride; colt -= t * split_cols; if (t == 0) sc = scale0; }
        const int col0 = colt + wc * 32 + 8 * fq, bcol0 = u.pn * BM + wc * 32 + 8 * fq;
        f32x4 bv[2][2];
#pragma unroll
        for (int bj = 0; bj < 2; ++bj)
#pragma unroll
            for (int n = 0; n < 2; ++n) bv[bj][n] = bias ? *(const f32x4*)(bias + bcol0 + bj * HALF + 4 * n) : (f32x4){0.f, 0.f, 0.f, 0.f};
#pragma unroll
        for (int ai = 0; ai < 2; ++ai)
#pragma unroll
            for (int m = 0; m < 4; ++m) { bf16_t* rowp = base + (size_t)(row0 + ai * HALF + m * 16) * ldc + col0;
#pragma unroll
                for (int bj = 0; bj < 2; ++bj) { f32x4 v0 = acc[ai][bj][m][0] + bv[bj][0], v1 = acc[ai][bj][m][1] + bv[bj][1];
                    if (ACT == 1) { f32x2 a = gelu_pk((f32x2){v0[0], v0[1]}), b = gelu_pk((f32x2){v0[2], v0[3]}), c = gelu_pk((f32x2){v1[0], v1[1]}), d = gelu_pk((f32x2){v1[2], v1[3]});
                        v0 = (f32x4){a.x, a.y, b.x, b.y}; v1 = (f32x4){c.x, c.y, d.x, d.y}; }
                    v0 = v0 * sc; v1 = v1 * sc; u32x4 w; w.x = cvt_pk_bf16(v0[0], v0[1]); w.y = cvt_pk_bf16(v0[2], v0[3]); w.z = cvt_pk_bf16(v1[0], v1[1]); w.w = cvt_pk_bf16(v1[2], v1[3]);
                    *(u32x4*)(rowp + bj * HALF) = w; } }
    }
};
template <int ACT  > struct EpiBf16NT {
    static constexpr bool PERM = true, AFTER_DRAIN = false; static_assert(ACT == 0 || ACT == 1, "EpiBf16: ACT is 0 (none) or 1 (gelu_pk)");
    bf16_t* O; int ldc; const float* bias; int split_cols; size_t split_stride; float scale0;
    __device__ __forceinline__ void operator()(const f32x4 (&acc)[2][2][4][2], const Unit& u, int wr, int wc, int fr, int fq) const {
        const int row0 = u.pm * BM + wr * 64 + fr; int colt = u.pn * BM; bf16_t* base = O;
        float sc = 1.f; if (split_cols) { const int t = colt / split_cols; base += (size_t)t * split_stride; colt -= t * split_cols; if (t == 0) sc = scale0; }
        const int col0 = colt + wc * 32 + 8 * fq, bcol0 = u.pn * BM + wc * 32 + 8 * fq;
        f32x4 bv[2][2];
#pragma unroll
        for (int bj = 0; bj < 2; ++bj)
#pragma unroll
            for (int n = 0; n < 2; ++n) bv[bj][n] = bias ? *(const f32x4*)(bias + bcol0 + bj * HALF + 4 * n) : (f32x4){0.f, 0.f, 0.f, 0.f};
#pragma unroll
        for (int ai = 0; ai < 2; ++ai)
#pragma unroll
            for (int m = 0; m < 4; ++m) { bf16_t* rowp = base + (size_t)(row0 + ai * HALF + m * 16) * ldc + col0;
#pragma unroll
                for (int bj = 0; bj < 2; ++bj) { f32x4 v0 = acc[ai][bj][m][0] + bv[bj][0], v1 = acc[ai][bj][m][1] + bv[bj][1];
                    if (ACT == 1) { f32x2 a = gelu_pk((f32x2){v0[0], v0[1]}), b = gelu_pk((f32x2){v0[2], v0[3]}), c = gelu_pk((f32x2){v1[0], v1[1]}), d = gelu_pk((f32x2){v1[2], v1[3]});
                        v0 = (f32x4){a.x, a.y, b.x, b.y}; v1 = (f32x4){c.x, c.y, d.x, d.y}; }
                    v0 = v0 * sc; v1 = v1 * sc; u32x4 w; w.x = cvt_pk_bf16(v0[0], v0[1]); w.y = cvt_pk_bf16(v0[2], v0[3]); w.z = cvt_pk_bf16(v1[0], v1[1]); w.w = cvt_pk_bf16(v1[2], v1[3]);
                    __builtin_nontemporal_store(w, (u32x4*)(rowp + bj * HALF)); } }
    }
};
struct EpiF32 {
    static constexpr bool PERM = false, AFTER_DRAIN = false;
    float* C; int ldc; const float* bias;
    __device__ __forceinline__ void operator()(const f32x4 (&acc)[2][2][4][2], const Unit& u, int wr, int wc, int fr, int fq) const {
        const int row0 = u.pm * BM + wr * 64 + fr, col0 = u.pn * BM + wc * 32 + 4 * fq;
        f32x4 bv[2][2];
#pragma unroll
        for (int bj = 0; bj < 2; ++bj)
#pragma unroll
            for (int n = 0; n < 2; ++n) bv[bj][n] = bias ? *(const f32x4*)(bias + col0 + bj * HALF + n * 16) : (f32x4){0.f, 0.f, 0.f, 0.f};
#pragma unroll
        for (int ai = 0; ai < 2; ++ai)
#pragma unroll
            for (int m = 0; m < 4; ++m) { float* rowp = C + (size_t)(row0 + ai * HALF + m * 16) * ldc + col0;
#pragma unroll
                for (int bj = 0; bj < 2; ++bj)
#pragma unroll
                    for (int n = 0; n < 2; ++n) *(f32x4*)(rowp + bj * HALF + n * 16) = acc[ai][bj][m][n] + bv[bj][n]; }
    }
};
template <class Epi, class Sched, bool ALIGN_EPI = false, bool SP2 = false, bool GATHER = false>
__device__ __forceinline__ void gemm_phase(PG8_LAS unsigned char* lds, const Gemm g, const Sched& S, const Epi& E) {
    int tid = threadIdx.x; asm volatile("" : "+v"(tid)); const int wid = __builtin_amdgcn_readfirstlane(tid >> 6), lane = tid & 63, wr = wid >> 2, wc = wid & 3, fr = lane & 15, fq = lane >> 4;
    const int K = g.K, nt = K / BK;
    unsigned voffA[2], voffB[2]; int RA[2]; unsigned CA2[2];
#pragma unroll
    for (int i = 0; i < 2; ++i) { int R, C; stage_rc(tid * 16 + i * 8192, R, C); const int Rb = Epi::PERM ? ((R & ~31) + perm32(R & 31)) : R;
        voffA[i] = (unsigned)(R * g.lda + C) * 2u; voffB[i] = (unsigned)(Rb * K + C) * 2u; RA[i] = R; CA2[i] = (unsigned)C * 2u; }
    unsigned gcur[2][2] = {{0u, 0u}, {0u, 0u}}, gnxt[2][2] = {{0u, 0u}, {0u, 0u}};
#define PG8_GOFF(dst, u_) do { _Pragma("unroll") for (int h_ = 0; h_ < 2; ++h_) _Pragma("unroll") for (int i_ = 0; i_ < 2; ++i_) \
        dst[h_][i_] = (unsigned)g.src[(u_).pm * BM + h_ * HALF + RA[i_]] * (unsigned)(g.lda * 2) + CA2[i_]; } while (0)
#define PG8_STAGE_A(bufoff, gbase, h, nx) do { if constexpr (GATHER) { unsigned vs_[2] = {(nx) ? gnxt[h][0] : gcur[h][0], (nx) ? gnxt[h][1] : gcur[h][1]}; PG8_STAGE(bufoff, gbase, vs_); } \
        else { PG8_STAGE(bufoff, (gbase) + ((h) ? hstepA : 0), voffA); } } while (0)
    const size_t kstep = (size_t)(BK * 2);
    const size_t hstepA = (size_t)HALF * g.lda * 2, hstepB = (size_t)HALF * K * 2;
    const size_t tstepA = 2 * hstepA, tstepB = 2 * hstepB;
    const unsigned ldsw = (unsigned)wid * 1024u;
    const int aoff = lds_byte(wr * 64 + fr, fq * 8), boff = lds_byte(wc * 32 + fr, fq * 8);
#define PG8_SA(b, h) (((b) * 2 + (h)) * HTB)
#define PG8_SB(b, h) ((4 + (b) * 2 + (h)) * HTB)
#define PG8_STAGE(bufoff, gbase, voff) do { _Pragma("unroll") for (int _i = 0; _i < 2; ++_i) \
        __builtin_amdgcn_global_load_lds((const unsigned*)((const char*)(gbase) + (voff)[_i]), (PG8_LAS unsigned*)(lds + (bufoff) + ldsw + _i * 8192), 16, 0, 0); } while (0)
#define PG8_LDA(dst, b, h) do { _Pragma("unroll") for (int m = 0; m < 4; ++m) _Pragma("unroll") for (int k = 0; k < 2; ++k) dst[m][k] = *(const PG8_LAS bf16x8*)(lds + PG8_SA(b, h) + aoff + m * 2048 + k * 1024); } while (0)
#define PG8_LDB(dst, b, h) do { _Pragma("unroll") for (int n = 0; n < 2; ++n) _Pragma("unroll") for (int k = 0; k < 2; ++k) dst[n][k] = *(const PG8_LAS bf16x8*)(lds + PG8_SB(b, h) + boff + n * 2048 + k * 1024); } while (0)
#define PG8_MMA(ai, bj, At, Bt) do { __builtin_amdgcn_s_setprio(1); _Pragma("unroll") for (int m = 0; m < 4; ++m) _Pragma("unroll") for (int n = 0; n < 2; ++n) _Pragma("unroll") for (int k = 0; k < 2; ++k) \
        acc[ai][bj][m][n] = __builtin_amdgcn_mfma_f32_16x16x32_bf16(Bt[n][k], At[m][k], acc[ai][bj][m][n], 0, 0, 0); __builtin_amdgcn_s_setprio(0); } while (0)
#define PG8_WAIT_V(n) asm volatile("s_waitcnt vmcnt(" #n ")" ::: "memory")
#define PG8_WAIT_L(n) asm volatile("s_waitcnt lgkmcnt(" #n ")" ::: "memory")
#define PG8_BAR __builtin_amdgcn_s_barrier()
#define PG8_SCHED __builtin_amdgcn_sched_barrier(0)
    Unit cur, nxt; int ui = 0;
    if (!S.next(0, cur)) return;
    f32x4 acc[2][2][4][2];
#pragma unroll
    for (int a = 0; a < 2; ++a)
#pragma unroll
        for (int b = 0; b < 2; ++b)
#pragma unroll
            for (int m = 0; m < 4; ++m)
#pragma unroll
                for (int n = 0; n < 2; ++n) acc[a][b][m][n] = (f32x4){0.f, 0.f, 0.f, 0.f};
    bf16x8 At[4][2], B0[2][2], B1[2][2];
    const char* cA = (const char*)g.A + (GATHER ? (size_t)0 : (size_t)cur.pm * tstepA); const char* cB = (const char*)g.Bt + (size_t)cur.pn * tstepB;
    if constexpr (GATHER) PG8_GOFF(gcur, cur);
    S.a_ready(cur);
    if constexpr (SP2) {
        PG8_STAGE(PG8_SB(0, 0), cB, voffB); PG8_STAGE(PG8_SB(0, 1), cB + hstepB, voffB); PG8_STAGE_A(PG8_SA(0, 0), cA, 0, false); PG8_STAGE_A(PG8_SA(0, 1), cA, 1, false);
        if (wr == 1) PG8_BAR;
        PG8_WAIT_V(2); PG8_BAR;
        PG8_STAGE(PG8_SB(1, 0), cB + kstep, voffB); PG8_STAGE_A(PG8_SA(1, 0), cA + kstep, 0, false); PG8_STAGE(PG8_SB(1, 1), cB + hstepB + kstep, voffB);
        PG8_WAIT_V(6); PG8_BAR;
    } else {
        PG8_STAGE(PG8_SB(0, 0), cB, voffB); PG8_STAGE_A(PG8_SA(0, 0), cA, 0, false); PG8_STAGE(PG8_SB(0, 1), cB + hstepB, voffB); PG8_STAGE_A(PG8_SA(0, 1), cA, 1, false);
        if (wr == 1) PG8_BAR;
        PG8_WAIT_V(4); PG8_BAR;
        PG8_STAGE(PG8_SB(1, 0), cB + kstep, voffB); PG8_STAGE_A(PG8_SA(1, 0), cA + kstep, 0, false); PG8_STAGE(PG8_SB(1, 1), cB + hstepB + kstep, voffB);
        PG8_WAIT_V(6); PG8_BAR;
    }
    for (;;) {
        const bool has_next = S.next(ui + 1, nxt);
        const char* nA = (has_next && !GATHER) ? (const char*)g.A + (size_t)nxt.pm * tstepA : cA; const char* nB = has_next ? (const char*)g.Bt + (size_t)nxt.pn * tstepB : cB;
        if constexpr (GATHER) { if (has_next) PG8_GOFF(gnxt, nxt); else { _Pragma("unroll") for (int h_ = 0; h_ < 2; ++h_) { gnxt[h_][0] = gcur[h_][0]; gnxt[h_][1] = gcur[h_][1]; } } }
#pragma unroll 1
        for (int t = 0; t < nt; t += 2) {
            const bool last = (t == nt - 2);
            const char* a1 = cA + (size_t)(t + 1) * kstep;
            const char* a2 = last ? nA : cA + (size_t)(t + 2) * kstep; const char* b2 = last ? nB : cB + (size_t)(t + 2) * kstep;
            const char* a3 = a2 + kstep; const char* b3 = b2 + kstep;
            if (last && has_next) S.a_ready(nxt);
            if constexpr (SP2) {
            PG8_LDB(B0, 0, 0); PG8_LDB(B1, 0, 1); PG8_SCHED; PG8_LDA(At, 0, 0); PG8_STAGE_A(PG8_SA(1, 1), a1, 1, false);
            PG8_WAIT_V(8); PG8_WAIT_L(0); PG8_BAR; PG8_MMA(0, 0, At, B0); PG8_MMA(0, 1, At, B1); PG8_BAR; PG8_SCHED;
            PG8_LDA(At, 0, 1); PG8_STAGE(PG8_SB(0, 0), b2, voffB); PG8_STAGE(PG8_SB(0, 1), b2 + hstepB, voffB); PG8_STAGE_A(PG8_SA(0, 0), a2, 0, last);
            PG8_WAIT_V(8); PG8_WAIT_L(0); PG8_BAR; PG8_MMA(1, 0, At, B0); PG8_MMA(1, 1, At, B1); PG8_BAR; PG8_SCHED;
            PG8_LDB(B0, 1, 0); PG8_LDB(B1, 1, 1); PG8_SCHED; PG8_LDA(At, 1, 0); PG8_STAGE_A(PG8_SA(0, 1), a2, 1, last);
            PG8_WAIT_V(8); PG8_WAIT_L(0); PG8_BAR; PG8_MMA(0, 0, At, B0); PG8_MMA(0, 1, At, B1); PG8_BAR; PG8_SCHED;
            PG8_LDA(At, 1, 1); PG8_STAGE(PG8_SB(1, 0), b3, voffB); PG8_STAGE(PG8_SB(1, 1), b3 + hstepB, voffB); PG8_STAGE_A(PG8_SA(1, 0), a3, 0, last);
            PG8_WAIT_V(8); PG8_WAIT_L(0); PG8_BAR; PG8_MMA(1, 0, At, B0); PG8_MMA(1, 1, At, B1); PG8_BAR; PG8_SCHED;
            } else {
            PG8_LDB(B0, 0, 0); PG8_SCHED; PG8_LDA(At, 0, 0); PG8_STAGE_A(PG8_SA(1, 1), a1, 1, false);
            PG8_WAIT_L(8); PG8_BAR; PG8_WAIT_L(0); PG8_MMA(0, 0, At, B0); PG8_BAR; PG8_SCHED;
            PG8_LDB(B1, 0, 1); PG8_STAGE(PG8_SB(0, 0), b2, voffB);
            PG8_BAR; PG8_WAIT_L(0); PG8_MMA(0, 1, At, B1); PG8_BAR;
            PG8_LDA(At, 0, 1); PG8_STAGE_A(PG8_SA(0, 0), a2, 0, last);
            PG8_BAR; PG8_WAIT_L(0); PG8_MMA(1, 0, At, B0); PG8_BAR; PG8_SCHED;
            PG8_STAGE(PG8_SB(0, 1), b2 + hstepB, voffB);
            PG8_WAIT_V(6); PG8_BAR; PG8_MMA(1, 1, At, B1); PG8_BAR;
            PG8_LDB(B0, 1, 0); PG8_SCHED; PG8_LDA(At, 1, 0); PG8_STAGE_A(PG8_SA(0, 1), a2, 1, last);
            PG8_WAIT_L(8); PG8_BAR; PG8_WAIT_L(0); PG8_MMA(0, 0, At, B0); PG8_BAR; PG8_SCHED;
            PG8_LDB(B1, 1, 1); PG8_STAGE(PG8_SB(1, 0), b3, voffB);
            PG8_BAR; PG8_WAIT_L(0); PG8_MMA(0, 1, At, B1); PG8_BAR;
            PG8_LDA(At, 1, 1); PG8_STAGE_A(PG8_SA(1, 0), a3, 0, last);
            PG8_BAR; PG8_WAIT_L(0); PG8_MMA(1, 0, At, B0); PG8_BAR; PG8_SCHED;
            PG8_STAGE(PG8_SB(1, 1), b3 + hstepB, voffB);
            PG8_WAIT_V(6); PG8_BAR; PG8_MMA(1, 1, At, B1); PG8_BAR;
            }
        }
        if constexpr (ALIGN_EPI) { if (wr == 0) PG8_BAR; }
        if constexpr (!Epi::AFTER_DRAIN) { E(acc, cur, wr, wc, fr, fq); S.done(cur); }
        if (!has_next) break;
#pragma unroll
        for (int a = 0; a < 2; ++a)
#pragma unroll
            for (int b = 0; b < 2; ++b)
#pragma unroll
                for (int m = 0; m < 4; ++m)
#pragma unroll
                    for (int n = 0; n < 2; ++n) acc[a][b][m][n] = (f32x4){0.f, 0.f, 0.f, 0.f};
        cur = nxt; cA = nA; cB = nB; ++ui;
        if constexpr (GATHER) { _Pragma("unroll") for (int h_ = 0; h_ < 2; ++h_) { gcur[h_][0] = gnxt[h_][0]; gcur[h_][1] = gnxt[h_][1]; } }
        if constexpr (ALIGN_EPI) { if (wr == 1) PG8_BAR; }
    }
    PG8_WAIT_V(0);
    if constexpr (!ALIGN_EPI) { if (wr == 0) PG8_BAR; }
    PG8_BAR;
    if constexpr (Epi::AFTER_DRAIN) { E.fused(acc, cur, wr, wc, fr, fq, lds, wid, lane); S.done(cur); }
#undef PG8_SA
#undef PG8_GOFF
#undef PG8_STAGE_A
#undef PG8_SB
#undef PG8_STAGE
#undef PG8_LDA
#undef PG8_LDB
#undef PG8_MMA
#undef PG8_WAIT_V
#undef PG8_WAIT_L
#undef PG8_BAR
#undef PG8_SCHED
}
}

constexpr int NB = 16, SEQ = 4096, CTX = 256, TT = SEQ + CTX, M = NB * TT, D = 1024, NL = 4;
constexpr int NPJ = 2304, DPROJ = 2208;
constexpr int MS = 143360;
constexpr float EPS = 1e-6f, ALPHA = 1.6817928305074290f, LOG2E = 1.4426950408889634f;
constexpr int NWAVES = 8, NTHR = 512;
#ifndef MK_DEBUG
#define MK_DEBUG 0
#endif
#ifndef MK_TIME
#define MK_TIME 0
#endif
#ifndef MK_TMUL
#define MK_TMUL 1
#endif
#ifndef MK_VM
#define MK_VM 0
#endif
#ifndef MK_DUP
#define MK_DUP 0
#endif
#ifndef MK_MULTI
#define MK_MULTI 0
#endif
constexpr int NPHASE = 2 + 10 * NL;

constexpr size_t WS_CTL = 0, CTL_BYTES = 65536;
constexpr size_t WS_MODS = WS_CTL + CTL_BYTES;
constexpr size_t WS_T64 = WS_MODS + (size_t)NL * 17 * 6144 * 4;
constexpr size_t WS_T32 = WS_T64 + 8192;
constexpr size_t WS_RS = WS_T32 + 4096;
constexpr size_t WS_RT = WS_RS + (size_t)M * 8;
constexpr size_t WS_HIST = WS_RT + (size_t)M * 32;
constexpr size_t WS_XS = WS_HIST + 65536;
constexpr size_t WS_WIN = WS_XS + (size_t)M * D * 2;
constexpr size_t WS_WD = WS_WIN + (size_t)NPJ * D * 2;
constexpr size_t WS_WOUT = WS_WD + (size_t)1024 * 384 * 2;
constexpr size_t WS_WGU = WS_WOUT + (size_t)D * D * 2;
constexpr size_t WS_WDN = WS_WGU + (size_t)16 * 1024 * 1024 * 2;
constexpr size_t WS_HA = WS_WDN + (size_t)16 * 1024 * 512 * 2;
constexpr size_t WS_PB = WS_HA + (size_t)M * D * 2;
constexpr size_t WS_QD = WS_PB + (size_t)M * NPJ * 2;
constexpr size_t WS_KD = WS_QD + (size_t)M * 384 * 2;
constexpr size_t WS_VD = WS_KD + (size_t)M * 384 * 2;
constexpr size_t WS_ACT = WS_VD + (size_t)M * 256 * 2;
constexpr size_t WS_END = WS_ACT + (size_t)MS * 512 * 2;
static_assert(WS_END <= (size_t)1073741824, "d_ws map must fit 1 GiB");
static_assert((size_t)M * NPJ * 2 >= (size_t)MS * D * 2 && (size_t)M * NPJ * 2 >= (size_t)M * D * 4, "region PB overlays");
constexpr int CW_BAR = 0;
constexpr int CW_QUEUE = 4096;

constexpr int RING_BYTES = 131072, MISC_OFF = RING_BYTES, LDS_BYTES = 147456;
constexpr int MI_BAR = 0, MI_Q = 4, MI_TOT = 16, MI_BASE = 32, MI_PST = 48, MI_LH = 80;

#define GAS __attribute__((address_space(1)))
#define LAS __attribute__((address_space(3)))
typedef unsigned short bf16;
typedef unsigned v4u __attribute__((ext_vector_type(4)));
typedef unsigned v2u __attribute__((ext_vector_type(2)));
typedef float f32x4 __attribute__((ext_vector_type(4)));
typedef float f32x2 __attribute__((ext_vector_type(2)));
typedef short bf16x8 __attribute__((ext_vector_type(8)));
typedef float f32x16 __attribute__((ext_vector_type(16)));
typedef short v4i16 __attribute__((ext_vector_type(4)));

__device__ __forceinline__ unsigned f2bf(float f) { unsigned u = __builtin_bit_cast(unsigned, f); return (u + 0x7fffu + ((u >> 16) & 1u)) >> 16; }
typedef __bf16 bf16x2_hw __attribute__((ext_vector_type(2)));
__device__ __forceinline__ unsigned pk2(float lo, float hi) { f32x2 v = {lo, hi}; const bf16x2_hw b = __builtin_convertvector(v, bf16x2_hw); return __builtin_bit_cast(unsigned, b); }
__device__ __forceinline__ float bflo(unsigned w) { return __builtin_bit_cast(float, w << 16); }
__device__ __forceinline__ float bfhi(unsigned w) { return __builtin_bit_cast(float, w & 0xffff0000u); }
__device__ __forceinline__ void unpack8(v4u w, float (&f)[8]) { f[0] = bflo(w.x); f[1] = bfhi(w.x); f[2] = bflo(w.y); f[3] = bfhi(w.y); f[4] = bflo(w.z); f[5] = bfhi(w.z); f[6] = bflo(w.w); f[7] = bfhi(w.w); }
__device__ __forceinline__ v4u pack8(const float (&f)[8]) { v4u w; w.x = pk2(f[0], f[1]); w.y = pk2(f[2], f[3]); w.z = pk2(f[4], f[5]); w.w = pk2(f[6], f[7]); return w; }
__device__ __forceinline__ float wave_sum(float v) {
    int x = __builtin_bit_cast(int, v);
#define WS_DPP(ctrl, rmask) v += __builtin_bit_cast(float, __builtin_amdgcn_update_dpp(0, x, ctrl, rmask, 0xf, true)); x = __builtin_bit_cast(int, v)
    WS_DPP(0xB1, 0xf);
    WS_DPP(0x4E, 0xf);
    WS_DPP(0x141, 0xf);
    WS_DPP(0x140, 0xf);
    WS_DPP(0x142, 0xa);
    WS_DPP(0x143, 0xc);
#undef WS_DPP
    return __builtin_bit_cast(float, __builtin_amdgcn_readlane(__builtin_bit_cast(int, v), 63));
}

#define XB_TMO      128
#define XB_XCNT(j)  (256  + 64 * (j))
#define XB_XSUB(j)  (1280 + 64 * (j))
#define XB_XGEN(j)  (2304 + 64 * (j))
#define XB_TOP      3328
#define XB_TOPGEN   3392
#define XCD_BAR_WORDS 3456
#define XB_SPIN_CAP (1u << 22)
__device__ __forceinline__ unsigned xb_ld(unsigned* p)              { return __hip_atomic_load(p, __ATOMIC_RELAXED, __HIP_MEMORY_SCOPE_AGENT); }
__device__ __forceinline__ unsigned xb_add(unsigned* p, unsigned v) { return __hip_atomic_fetch_add(p, v, __ATOMIC_RELAXED, __HIP_MEMORY_SCOPE_AGENT); }
__device__ __forceinline__ unsigned xb_xcc_id() { return (unsigned)__builtin_amdgcn_s_getreg((3 << 11) | 20) & 0xFu; }
#define XB_SPIN(cond, bar) do { unsigned _sp = 0; while (cond) { __builtin_amdgcn_s_sleep(1); \
    if ((++_sp & 255u) == 0u) { if (xb_ld(&(bar)[XB_TMO])) break; if (_sp > XB_SPIN_CAP) { atomicAdd(&(bar)[XB_TMO], 1u); break; } } } } while (0)
struct XcdBarrier { unsigned* bar; unsigned x; volatile LAS unsigned* st; };
__device__ __forceinline__ XcdBarrier xcd_barrier_post(unsigned* bar, volatile LAS unsigned* st) {
    XcdBarrier b; b.bar = bar; b.x = xb_xcc_id(); b.st = st;
    if (threadIdx.x == 0) (void)xb_add(&bar[XB_XCNT(b.x)], 1u);
    return b;
}
__device__ __forceinline__ void xcd_barrier_complete(unsigned* bar, unsigned x, unsigned& nloc, unsigned& nx) {
    const unsigned G = gridDim.x * gridDim.y * gridDim.z;
    unsigned sum, cnt, mine, sp = 0u;
    for (;;) {
        sum = 0u; cnt = 0u; mine = 0u;
#pragma unroll
        for (unsigned j = 0; j < 16; ++j) { const unsigned c = xb_ld(&bar[XB_XCNT(j)]); sum += c; cnt += (c > 0u) ? 1u : 0u; mine = (j == x) ? c : mine; }
        if (sum == G) break;
        __builtin_amdgcn_s_sleep(1);
        if ((++sp & 255u) == 0u) { if (xb_ld(&bar[XB_TMO])) break; if (sp > XB_SPIN_CAP) { atomicAdd(&bar[XB_TMO], 1u); break; } }
    }
    nloc = mine > 0u ? mine : 1u; nx = cnt > 0u ? cnt : 1u;
}
__device__ __forceinline__ void xcd_barrier(const XcdBarrier& b) {
    asm volatile("s_waitcnt vmcnt(0)" ::: "memory");
    __syncthreads();
    if (threadIdx.x == 0) {
        unsigned* bar = b.bar;
        __builtin_amdgcn_s_waitcnt(0);
        unsigned nloc = b.st[0], nx = b.st[1];
        if (nloc == 0u) { xcd_barrier_complete(bar, b.x, nloc, nx); b.st[0] = nloc; b.st[1] = nx; }
        const unsigned old = xb_add(&bar[XB_XSUB(b.x)], 1u);
        const unsigned gen = old / nloc;
        if (old + 1u == (gen + 1u) * nloc) {
            __builtin_amdgcn_fence(__ATOMIC_RELEASE, "agent");
            asm volatile("s_waitcnt vmcnt(0)" ::: "memory");
            const unsigned og = xb_add(&bar[XB_TOP], 1u);
            const unsigned tg = og / nx;
            if (og + 1u == (tg + 1u) * nx) xb_add(&bar[XB_TOPGEN], 1u);
            else XB_SPIN(xb_ld(&bar[XB_TOPGEN]) == tg, bar);
            __builtin_amdgcn_fence(__ATOMIC_ACQUIRE, "agent");
            xb_add(&bar[XB_XGEN(b.x)], 1u);
            asm volatile("s_waitcnt vmcnt(0)" ::: "memory");
        } else {
            XB_SPIN(xb_ld(&bar[XB_XGEN(b.x)]) == gen, bar);
            __builtin_amdgcn_fence(__ATOMIC_ACQUIRE, "agent");
            asm volatile("s_waitcnt vmcnt(0)" ::: "memory");
        }
    }
    __syncthreads();
}

struct Args { const float* in[27]; float* out; unsigned char* ws; int ph_lo, ph_hi; };
enum { I_X = 0, I_C, I_CTX, I_CCTX, I_WADA, I_BADA, I_WIN, I_NABIAS, I_GQG, I_GKG, I_SINK, I_MQG, I_WQB, I_MKVG, I_WKVB, I_WOUT, I_LN1G, I_LN1B, I_RGW, I_RGB, I_REW, I_REB, I_WG, I_WU, I_WDN, I_LN2G, I_LN2B };

struct Frame {
    LAS unsigned char* lds; volatile LAS unsigned* MISC;
    int tid, lane, wave, G, gw, ngw, bid;
    GAS unsigned char* ws;
};
__device__ __forceinline__ int opaque_tid() { int t = threadIdx.x; asm volatile("" : "+v"(t)); return t; }
__device__ __forceinline__ int opaque_s(int x) { asm volatile("" : "+s"(x)); return x; }
constexpr int PTAB_OFF = MISC_OFF + 2048, I_OUT = 27;
__device__ __forceinline__ GAS unsigned char* ptab_get(const Frame& F, int i) {
    const LAS unsigned* t = (const LAS unsigned*)(F.lds + PTAB_OFF) + 2 * i;
    const unsigned lo = __builtin_amdgcn_readfirstlane(t[0]), hi = __builtin_amdgcn_readfirstlane(t[1]);
    return (GAS unsigned char*)(((unsigned long long)hi << 32) | lo);
}
#define INP(i) ((const float*)ptab_get(F, (i)))
__device__ __forceinline__ Frame make_frame(GAS unsigned char* ws) {
    extern __shared__ __attribute__((aligned(16))) unsigned char lds_raw[];
    Frame F;
    F.lds = (LAS unsigned char*)lds_raw; F.MISC = (volatile LAS unsigned*)(F.lds + MISC_OFF);
    F.tid = opaque_tid(); F.lane = F.tid & 63; F.wave = __builtin_amdgcn_readfirstlane(F.tid >> 6);
    F.G = opaque_s((int)gridDim.x); F.bid = opaque_s((int)blockIdx.x); F.gw = F.bid * NWAVES + F.wave; F.ngw = F.G * NWAVES;
    { unsigned long long w = (unsigned long long)ws; asm volatile("" : "+s"(w)); F.ws = (GAS unsigned char*)w; }
    return F;
}
typedef _Float16 f16x4 __attribute__((ext_vector_type(4)));
struct RowPtrs { const float* x; const float* ctx; float* out; _Float16* xs; };
__device__ __forceinline__ RowPtrs row_ptrs(const Frame& F) { RowPtrs p; p.x = INP(I_X); p.ctx = INP(I_CTX); p.out = (float*)ptab_get(F, I_OUT); p.xs = (_Float16*)(F.ws + WS_XS); return p; }
__device__ __forceinline__ const float* xin_row(const RowPtrs& P, int r) {
    const int b = r / TT, t = r - b * TT;
    return t < SEQ ? P.x + ((size_t)b * SEQ + t) * D : P.ctx + ((size_t)b * CTX + (t - SEQ)) * D;
}
__device__ __forceinline__ float* out_row(const RowPtrs& P, int r) { const int b = r / TT, t = r - b * TT; return P.out + ((size_t)b * SEQ + t) * D; }
__device__ __forceinline__ void ld16h(const _Float16* p, int lane, float (&v)[16]) {
    const f16x4* q = (const f16x4*)p + lane;
#pragma unroll
    for (int g = 0; g < 4; ++g) { const f32x4 f = __builtin_convertvector(__builtin_nontemporal_load(q + 64 * g), f32x4); v[4 * g] = f.x; v[4 * g + 1] = f.y; v[4 * g + 2] = f.z; v[4 * g + 3] = f.w; }
}
__device__ __forceinline__ void st16h(_Float16* p, int lane, const float (&v)[16]) {
    f16x4* q = (f16x4*)p + lane;
#pragma unroll
    for (int g = 0; g < 4; ++g) __builtin_nontemporal_store(__builtin_convertvector((f32x4){v[4 * g], v[4 * g + 1], v[4 * g + 2], v[4 * g + 3]}, f16x4), q + 64 * g);
}
__device__ __forceinline__ void ld16(const float* p, int lane, float (&v)[16]) {
    const f32x4* q = (const f32x4*)p + lane;
    const f32x4 a = q[0], b = q[64], c = q[128], d = q[192];
    v[0] = a.x; v[1] = a.y; v[2] = a.z; v[3] = a.w; v[4] = b.x; v[5] = b.y; v[6] = b.z; v[7] = b.w;
    v[8] = c.x; v[9] = c.y; v[10] = c.z; v[11] = c.w; v[12] = d.x; v[13] = d.y; v[14] = d.z; v[15] = d.w;
}
__device__ __forceinline__ void st16(float* p, int lane, const float (&v)[16]) {
    f32x4* q = (f32x4*)p + lane;
    q[0] = (f32x4){v[0], v[1], v[2], v[3]}; q[64] = (f32x4){v[4], v[5], v[6], v[7]};
    q[128] = (f32x4){v[8], v[9], v[10], v[11]}; q[192] = (f32x4){v[12], v[13], v[14], v[15]};
}
__device__ __forceinline__ void ld16nt(const float* p, int lane, float (&v)[16]) {
    const f32x4* q = (const f32x4*)p + lane;
    const f32x4 a = __builtin_nontemporal_load(q), b = __builtin_nontemporal_load(q + 64), c = __builtin_nontemporal_load(q + 128), d = __builtin_nontemporal_load(q + 192);
    v[0] = a.x; v[1] = a.y; v[2] = a.z; v[3] = a.w; v[4] = b.x; v[5] = b.y; v[6] = b.z; v[7] = b.w;
    v[8] = c.x; v[9] = c.y; v[10] = c.z; v[11] = c.w; v[12] = d.x; v[13] = d.y; v[14] = d.z; v[15] = d.w;
}
__device__ __forceinline__ void st16nt(float* p, int lane, const float (&v)[16]) {
    f32x4* q = (f32x4*)p + lane;
    __builtin_nontemporal_store((f32x4){v[0], v[1], v[2], v[3]}, q); __builtin_nontemporal_store((f32x4){v[4], v[5], v[6], v[7]}, q + 64);
    __builtin_nontemporal_store((f32x4){v[8], v[9], v[10], v[11]}, q + 128); __builtin_nontemporal_store((f32x4){v[12], v[13], v[14], v[15]}, q + 192);
}
__device__ __forceinline__ void unpack16(const v2u (&w)[4], float (&v)[16]) {
#pragma unroll
    for (int g = 0; g < 4; ++g) { v[4 * g] = bflo(w[g].x); v[4 * g + 1] = bfhi(w[g].x); v[4 * g + 2] = bflo(w[g].y); v[4 * g + 3] = bfhi(w[g].y); }
}
__device__ __forceinline__ void ld16bf_raw(const bf16* p, int lane, v2u (&w)[4]) {
    const v2u* q = (const v2u*)p + lane; w[0] = q[0]; w[1] = q[64]; w[2] = q[128]; w[3] = q[192];
}
__device__ __forceinline__ void ld16bf_raw_nt(const bf16* p, int lane, v2u (&w)[4]) {
    const v2u* q = (const v2u*)p + lane; w[0] = __builtin_nontemporal_load(q); w[1] = __builtin_nontemporal_load(q + 64); w[2] = __builtin_nontemporal_load(q + 128); w[3] = __builtin_nontemporal_load(q + 192);
}
__device__ __forceinline__ void ld16bf(const bf16* p, int lane, float (&v)[16]) { v2u w[4]; ld16bf_raw(p, lane, w); unpack16(w, v); }
__device__ __forceinline__ void ld16bf_nt(const bf16* p, int lane, float (&v)[16]) { v2u w[4]; ld16bf_raw_nt(p, lane, w); unpack16(w, v); }
__device__ __forceinline__ void st16bf(bf16* p, int lane, const float (&v)[16]) {
    v2u* q = (v2u*)p + lane;
#pragma unroll
    for (int g = 0; g < 4; ++g) { v2u w; w.x = pk2(v[4 * g], v[4 * g + 1]); w.y = pk2(v[4 * g + 2], v[4 * g + 3]); q[64 * g] = w; }
}
__device__ __forceinline__ void ln16(float (&v)[16]) {
    float s = 0.f;
#pragma unroll
    for (int i = 0; i < 16; ++i) s += v[i];
    const float mean = wave_sum(s) * (1.0f / D); float q = 0.f;
#pragma unroll
    for (int i = 0; i < 16; ++i) { v[i] -= mean; q += v[i] * v[i]; }
    const float rstd = __builtin_amdgcn_rsqf(wave_sum(q) * (1.0f / D) + EPS);
#pragma unroll
    for (int i = 0; i < 16; ++i) v[i] *= rstd;
}

__device__ __forceinline__ int rows_per_wave(int ngw) {
    int rpw = (M + ngw - 1) / ngw;
    if (!((SEQ % rpw) % 4 == 0 && (TT % rpw) == 0 && (rpw % 2) == 0)) rpw = (rpw + 3) & ~3;
    return rpw;
}
template <int TYPE>
__device__ __forceinline__ float conv_src(const float* p0, const float* p1, const float* g0, const float* g1, int l, int k, int n) {
    if (TYPE == 0) return n < DPROJ ? p0[((size_t)l * D + k) * DPROJ + n] : 0.f;
    if (TYPE == 1) { if (n < 384) return k < 256 ? g0[l * 256 + k] * p0[((size_t)l * 256 + k) * 384 + n] : 0.f;
                     if (n < 896) return k >= 256 ? g1[l * 128 + (k - 256)] * p1[((size_t)l * 128 + (k - 256)) * 512 + (n - 384)] : 0.f;
                     return 0.f; }
    if (TYPE == 2) return p0[((size_t)l * D + k) * D + n];
    if (TYPE == 3) { const int e = n >> 10, nn = n & 1023, q = nn >> 3, j = nn & 7;
                     return j < 4 ? p0[(((size_t)l * 16 + e) * D + k) * 512 + 4 * q + j] : p1[(((size_t)l * 16 + e) * D + k) * 512 + 4 * q + (j - 4)]; }
    { const int e = n >> 10, nn = n & 1023; return p0[(((size_t)l * 16 + e) * 512 + k) * D + nn]; }
}
template <int TYPE>
__device__ __forceinline__ void conv_item(const Frame& F, int l, int item, LAS float* scr) {
    constexpr int Nd = TYPE == 0 ? NPJ : TYPE == 1 ? 1024 : TYPE == 2 ? 1024 : 16384, Kd = TYPE == 1 ? 384 : TYPE == 4 ? 512 : 1024;
    bf16* dst = (bf16*)(F.ws + (TYPE == 0 ? WS_WIN : TYPE == 1 ? WS_WD : TYPE == 2 ? WS_WOUT : TYPE == 3 ? WS_WGU : WS_WDN));
    const float* p0 = INP(TYPE == 0 ? I_WIN : TYPE == 1 ? I_WQB : TYPE == 2 ? I_WOUT : TYPE == 3 ? I_WG : I_WDN);
    const float* p1 = INP(TYPE == 1 ? I_WKVB : I_WU); const float* g0 = INP(I_MQG); const float* g1 = INP(I_MKVG);
    constexpr int nblk = Nd / 32; const int kb = item / nblk, nb = item - kb * nblk, k0 = 64 * kb, n0 = 32 * nb, lane = F.lane;
#pragma unroll
    for (int i = 0; i < 32; ++i) { const int kk = 2 * i + (lane >> 5); scr[kk * 33 + (lane & 31)] = conv_src<TYPE>(p0, p1, g0, g1, l, k0 + kk, n0 + (lane & 31)); }
    asm volatile("s_waitcnt lgkmcnt(0)" ::: "memory");
    const int c = lane & 7;
#pragma unroll
    for (int j = 0; j < 4; ++j) { const int n = (lane >> 3) + 8 * j; const LAS float* s = scr + (8 * c) * 33 + n;
        v4u o; o.x = pk2(s[0 * 33], s[1 * 33]); o.y = pk2(s[2 * 33], s[3 * 33]); o.z = pk2(s[4 * 33], s[5 * 33]); o.w = pk2(s[6 * 33], s[7 * 33]);
        *(v4u*)(dst + (size_t)(n0 + n) * Kd + k0 + 8 * c) = o; }
    asm volatile("s_waitcnt lgkmcnt(0)" ::: "memory");
}
__device__ __forceinline__ void phase_prologue(const Frame& F) {
    {
        LAS float* sv = (LAS float*)F.lds;
        LAS float* red = (LAS float*)(F.lds + 17 * 1024 * 4);
        float* mods = (float*)(F.ws + WS_MODS);
        for (int u = F.bid; u < NL * 48; u += F.G) {
            const int l = u / 48, cc = u - l * 48;
            const float* pc = INP(I_C); const float* pcc = INP(I_CCTX);
            for (int i = F.tid; i < 17 * 1024; i += NTHR) { const int mr = i >> 10, k = i & 1023; const float c = mr < 16 ? pc[mr * 1024 + k] : pcc[k]; sv[i] = c / (1.0f + expf(-c)); }
            __syncthreads();
            const int col = F.tid & 127, kg = F.tid >> 7;
            float acc[17];
#pragma unroll
            for (int mr = 0; mr < 17; ++mr) acc[mr] = 0.f;
            const float* w = INP(I_WADA) + ((size_t)l * 1024 + kg * 256) * 6144 + cc * 128 + col;
            for (int k4 = 0; k4 < 256; k4 += 4) {
                const float w0 = w[(size_t)(k4 + 0) * 6144], w1 = w[(size_t)(k4 + 1) * 6144], w2 = w[(size_t)(k4 + 2) * 6144], w3 = w[(size_t)(k4 + 3) * 6144];
#pragma unroll
                for (int mr = 0; mr < 17; ++mr) { const f32x4 s = *(const LAS f32x4*)(sv + mr * 1024 + kg * 256 + k4); acc[mr] += (s.x * w0 + s.y * w1) + (s.z * w2 + s.w * w3); }
            }
#pragma unroll
            for (int mr = 0; mr < 17; ++mr) red[(kg * 17 + mr) * 128 + col] = acc[mr];
            __syncthreads();
            const float* bada = INP(I_BADA);
            for (int i = F.tid; i < 17 * 128; i += NTHR) { const int mr = i >> 7, c = i & 127;
                const float s = (red[(0 * 17 + mr) * 128 + c] + red[(1 * 17 + mr) * 128 + c]) + (red[(2 * 17 + mr) * 128 + c] + red[(3 * 17 + mr) * 128 + c]);
                mods[((size_t)l * 17 + mr) * 6144 + cc * 128 + c] = s + bada[l * 6144 + cc * 128 + c]; }
            __syncthreads();
        }
    }
    {
        float* t64 = (float*)(F.ws + WS_T64); float* t32 = (float*)(F.ws + WS_T32);
        for (int i = F.bid * NTHR + F.tid; i < 64 * 16 + 64 * 8; i += F.G * NTHR) {
            if (i < 1024) { const int p = i >> 4, k = i & 15; const float fr = powf(10000.0f, -(float)k / 16.0f), ang = (float)p * fr; t64[2 * i] = cosf(ang); t64[2 * i + 1] = sinf(ang); }
            else { const int j = i - 1024, p = j >> 3, k = j & 7; const float fr = powf(10000.0f, -(float)k / 8.0f), ang = (float)p * fr; t32[2 * j] = cosf(ang); t32[2 * j + 1] = sinf(ang); }
        }
    }
}
__device__ __forceinline__ void convert_layer_weights(const Frame& F, int l) {
    {
        LAS float* scr = (LAS float*)(F.lds + F.wave * 8448);
        constexpr int I0 = 1152, I1 = 192, I2 = 512, I3 = 8192, I4 = 4096, IL = I0 + I1 + I2 + I3 + I4;
        for (int r0_ = F.gw; r0_ < IL; r0_ += F.ngw) {
            int r = r0_;
            if (r < I0) { conv_item<0>(F, l, r, scr); continue; } r -= I0;
            if (r < I1) { conv_item<1>(F, l, r, scr); continue; } r -= I1;
            if (r < I2) { conv_item<2>(F, l, r, scr); continue; } r -= I2;
            if (r < I3) { conv_item<3>(F, l, r, scr); continue; } r -= I3;
            conv_item<4>(F, l, r, scr);
        }
    }
}

__device__ __forceinline__ void phase_ln(const Frame& F, int l) {
    if (l < NL) convert_layer_weights(F, l);
    constexpr int NR = 4;
    const float* mods = (const float*)(F.ws + WS_MODS); bf16* HA = (bf16*)(F.ws + WS_HA);
    const bf16* Y = (const bf16*)(F.ws + WS_PB); const unsigned* RT = (const unsigned*)(F.ws + WS_RT);
    const int lane = F.lane; const RowPtrs RP = row_ptrs(F);
    const float* ln2g = INP(I_LN2G) + (l > 0 ? l - 1 : 0) * D; const float* ln2b = INP(I_LN2B) + (l > 0 ? l - 1 : 0) * D;
    const int rpw = rows_per_wave(F.ngw), rbeg = F.gw * rpw, rend = min(M, rbeg + rpw);
    float g2[16]; int cur_mr = -1;
    float alpha_l = ALPHA; asm volatile("" : "+v"(alpha_l));
    for (int r0 = rbeg; r0 < rend; r0 += NR) {
        float v[NR][16]; v4u rt[NR]; v2u ya[NR][4], yb[NR][4]; bool act[NR];
        const int b0 = r0 / TT, t0 = r0 - b0 * TT; const bool lat = t0 < SEQ; const int mr = lat ? b0 : 16;
        if (l == NL && !lat) continue;
#pragma unroll
        for (int u = 0; u < NR; ++u) {
            const int r = r0 + u; act[u] = r < rend; const int rc = act[u] ? r : r0;
            if (l == 0) ld16nt(xin_row(RP, rc), lane, v[u]); else ld16h(RP.xs + (size_t)rc * D, lane, v[u]);
            rt[u] = *(const v4u*)(RT + (size_t)rc * 8 + 4);
        }
        if (mr != cur_mr) { if (l > 0) ld16(mods + ((size_t)(l - 1) * 17 + mr) * 6144 + 5120, lane, g2); cur_mr = mr; }
        if (l > 0) {
#pragma unroll
            for (int u = 0; u < NR; ++u) { ld16bf_raw_nt(Y + (size_t)rt[u].z * D, lane, ya[u]); ld16bf_raw_nt(Y + (size_t)rt[u].w * D, lane, yb[u]); }
#pragma unroll
            for (int u = 0; u < NR; ++u) {
                float f0[16], f1[16], gg[16], bb[16];
                const float w0 = __uint_as_float(rt[u].x), w1 = __uint_as_float(rt[u].y);
                unpack16(ya[u], f0); unpack16(yb[u], f1);
#pragma unroll
                for (int i = 0; i < 16; ++i) v[u][i] = alpha_l * v[u][i] + g2[i] * (w0 * f0[i] + w1 * f1[i]);
                ld16(ln2g, lane, gg); ld16(ln2b, lane, bb);
                ln16(v[u]);
#pragma unroll
                for (int i = 0; i < 16; ++i) v[u][i] = v[u][i] * gg[i] + bb[i];
                if (act[u]) { if (l == NL) st16nt(out_row(RP, r0 + u), lane, v[u]); else st16h(RP.xs + (size_t)(r0 + u) * D, lane, v[u]); }
            }
        }
        if (l < NL) {
            float sh[16], sc[16]; ld16(mods + ((size_t)l * 17 + mr) * 6144, lane, sh); ld16(mods + ((size_t)l * 17 + mr) * 6144 + 1024, lane, sc);
#pragma unroll
            for (int u = 0; u < NR; ++u) {
                ln16(v[u]);
#pragma unroll
                for (int i = 0; i < 16; ++i) v[u][i] = v[u][i] * (1.0f + sc[i]) + sh[i];
                if (act[u]) st16bf(HA + (size_t)(r0 + u) * D, lane, v[u]);
            }
        }
    }
}

__device__ __forceinline__ void rope8(float (&f)[8], const float (&p)[8], const float* cs, bool first) {
    const f32x4* c4 = (const f32x4*)cs;
#pragma unroll
    for (int q = 0; q < 4; ++q) { const f32x4 t = c4[q];
        f[2 * q] = first ? f[2 * q] * t.x - p[2 * q] * t.y : p[2 * q] * t.y + f[2 * q] * t.x;
        f[2 * q + 1] = first ? f[2 * q + 1] * t.z - p[2 * q + 1] * t.w : p[2 * q + 1] * t.w + f[2 * q + 1] * t.z; }
}
#define DPPF(v, ctrl) __builtin_bit_cast(float, __builtin_amdgcn_update_dpp(0, __builtin_bit_cast(int, (v)), (ctrl), 0xf, 0xf, true))
__device__ __forceinline__ float dpp_xor1(float v) { return DPPF(v, 0xB1); }
__device__ __forceinline__ float dpp_xor2(float v) { return DPPF(v, 0x4E); }
__device__ __forceinline__ float dpp_hmir(float v) { return DPPF(v, 0x141); }
__device__ __forceinline__ float dpp_mir(float v) { return DPPF(v, 0x140); }
__device__ __forceinline__ void phase_post(const Frame& F, int l) {
    constexpr int NR = 4;
    bf16* P = (bf16*)(F.ws + WS_PB); bf16* KD = (bf16*)(F.ws + WS_KD);
    const float* t64 = (const float*)(F.ws + WS_T64); const float* t32 = (const float*)(F.ws + WS_T32);
    const int lane = F.lane; const float* gains = (lane < 32 ? INP(I_GQG) : INP(I_GKG)) + l * 64;
    const int j = lane & 7, jj = lane & 3;
    float gn[8];
#pragma unroll
    for (int i = 0; i < 8; ++i) gn[i] = gains[j * 8 + i];
    for (int r0 = F.gw; r0 < M; r0 += NR * F.ngw) {
        v4u w0[NR], w1[NR], w2[NR]; int rr[NR]; bool act[NR];
#pragma unroll
        for (int u = 0; u < NR; ++u) { const int r = r0 + u * F.ngw; act[u] = r < M; rr[u] = act[u] ? r : r0; const bf16* prow = P + (size_t)rr[u] * NPJ;
            w0[u] = *((const v4u*)(prow + 768) + lane); w1[u] = *((const v4u*)(prow + 1280) + lane); w2[u] = *((const v4u*)(prow + 1792) + lane); }
#pragma unroll
        for (int u = 0; u < NR; ++u) {
            const int r = rr[u]; const int b = r / TT, t = r - b * TT; const bool lat = t < SEQ; const int gr = (t >> 6) & 63, gc = t & 63;
            bf16* prow = P + (size_t)r * NPJ;
            const float* cs64 = t64 + ((size_t)((j < 4 ? gr : gc) * 16 + (j & 1) * 8)) * 2;
            {
                float f[8]; unpack8(w0[u], f);
                float ss = 0.f;
#pragma unroll
                for (int i = 0; i < 8; ++i) ss += f[i] * f[i];
                ss += dpp_xor1(ss); ss += dpp_xor2(ss); ss += dpp_hmir(ss);
                const float rs = __builtin_amdgcn_rsqf(ss * (1.0f / 64.0f) + EPS);
#pragma unroll
                for (int i = 0; i < 8; ++i) f[i] = f[i] * rs * gn[i];
                float p[8];
#pragma unroll
                for (int i = 0; i < 8; ++i) p[i] = dpp_xor2(f[i]);
                if (lat) rope8(f, p, cs64, (j & 2) == 0);
                if (lane < 48 && act[u]) *((v4u*)(prow + 768) + lane) = pack8(f);
            }
            {
                float f[8]; unpack8(w1[u], f);
                float p[8];
#pragma unroll
                for (int i = 0; i < 8; ++i) p[i] = dpp_xor2(f[i]);
                rope8(f, p, cs64, (j & 2) == 0);
                if (lat && lane < 48 && act[u]) *((v4u*)(prow + 1280) + lane) = pack8(f);
            }
            {
                float f[8]; unpack8(w2[u], f);
                float ss = 0.f;
#pragma unroll
                for (int i = 0; i < 8; ++i) ss += f[i] * f[i];
                ss += dpp_xor1(ss); ss += dpp_xor2(ss); ss += dpp_hmir(ss); ss += dpp_mir(ss);
                const float s32 = __builtin_bit_cast(float, __builtin_amdgcn_readlane(__builtin_bit_cast(int, ss), 0)) + __builtin_bit_cast(float, __builtin_amdgcn_readlane(__builtin_bit_cast(int, ss), 16));
                const float rn = __builtin_amdgcn_rsqf(lane < 32 ? s32 * (1.0f / 256.0f) + EPS : ss * (1.0f / 128.0f) + EPS);
                if (lane < 48 && act[u]) { float fn[8];
#pragma unroll
                    for (int i = 0; i < 8; ++i) fn[i] = f[i] * rn;
                    *((v4u*)(prow + 1792) + lane) = pack8(fn); }
                float p[8];
#pragma unroll
                for (int i = 0; i < 8; ++i) p[i] = dpp_xor1(f[i]);
                if (lat) rope8(f, p, t32 + ((size_t)((jj < 2 ? gr : gc) * 8)) * 2, (jj & 1) == 0);
                if (lane >= 48 && lane < 52 && act[u]) { const v4u o = pack8(f);
#pragma unroll
                    for (int h = 0; h < 4; ++h) *(v4u*)(KD + (size_t)r * 384 + h * 96 + 64 + 8 * jj) = o; }
            }
        }
    }
}

__device__ __forceinline__ void phase_route(const Frame& F, int l) {
    const float* mods = (const float*)(F.ws + WS_MODS); bf16* HA = (bf16*)(F.ws + WS_HA);
    const bf16* MIX = (const bf16*)(F.ws + WS_PB); unsigned* RT = (unsigned*)(F.ws + WS_RT); int* HIST = (int*)(F.ws + WS_HIST);
    LAS float* WR = (LAS float*)F.lds;
    { const float* rgw = INP(I_RGW); const float* rew = INP(I_REW);
      for (int i = F.tid; i < 20 * 1024; i += NTHR) { const int jx = i >> 10, k = i & 1023;
        WR[i] = jx < 4 ? rgw[((size_t)l * D + k) * 4 + jx] : rew[((size_t)l * D + k) * 16 + (jx - 4)]; } }
    if (F.tid < 16) F.MISC[MI_LH + F.tid] = 0u;
    __syncthreads();
    LAS float* bias = (LAS float*)(F.lds + 20 * 1024 * 4);
    if (F.tid < 20) bias[F.tid] = F.tid < 4 ? INP(I_RGB)[l * 4 + F.tid] : INP(I_REB)[l * 16 + (F.tid - 4)];
    __syncthreads();
    const RowPtrs RP = row_ptrs(F);
    LAS float* LNG = (LAS float*)(F.lds + 20 * 1024 * 4 + 128);
    { const float* ln1g = INP(I_LN1G) + l * D; const float* ln1b = INP(I_LN1B) + l * D;
      for (int i = F.tid; i < 1024; i += NTHR) { LNG[i] = ln1g[i]; LNG[1024 + i] = ln1b[i]; } }
    __syncthreads();
    constexpr int NR = 2;
    const LAS unsigned char* wbase = (const LAS unsigned char*)WR + F.lane * 16; asm volatile("" : "+v"(wbase));
    const LAS unsigned char* lbase = (const LAS unsigned char*)LNG + F.lane * 16; asm volatile("" : "+v"(lbase));
#define RT_W4(base_, off_) (*(const LAS f32x4*)((base_) + (off_)))
    const int rpw = rows_per_wave(F.ngw), rbeg = F.gw * rpw, rend = min(M, rbeg + rpw);
    float g1[16], sh[16], sc[16]; int cur_mr = -1;
    float alpha_l = ALPHA; asm volatile("" : "+v"(alpha_l));
    v4u rx[NR][4]; v2u rm[NR][4];
#define RT_ISSUE(r0_) do { _Pragma("unroll") for (int u = 0; u < NR; ++u) { const int r_ = (r0_) + u, rc_ = r_ < rend ? r_ : (r0_); \
        if (l == 0) { const v4u* q_ = (const v4u*)xin_row(RP, rc_) + F.lane; _Pragma("unroll") for (int g = 0; g < 4; ++g) rx[u][g] = __builtin_nontemporal_load(q_ + 64 * g); } \
        else { const v2u* q_ = (const v2u*)(RP.xs + (size_t)rc_ * D) + F.lane; _Pragma("unroll") for (int g = 0; g < 4; ++g) { const v2u t_ = __builtin_nontemporal_load(q_ + 64 * g); rx[u][g].x = t_.x; rx[u][g].y = t_.y; } } \
        ld16bf_raw_nt(MIX + (size_t)rc_ * D, F.lane, rm[u]); } } while (0)
    if (rbeg < rend) RT_ISSUE(rbeg);
    for (int r0 = rbeg; r0 < rend; r0 += NR) {
        float v[NR][16]; int rr[NR]; bool act[NR];
        { const int b = r0 / TT, t = r0 - b * TT, mr = t < SEQ ? b : 16;
          if (mr != cur_mr) { const float* md = mods + ((size_t)l * 17 + mr) * 6144; ld16(md + 2048, F.lane, g1); ld16(md + 3072, F.lane, sh); ld16(md + 4096, F.lane, sc); cur_mr = mr; } }
#pragma unroll
        for (int u = 0; u < NR; ++u) { const int r = r0 + u; act[u] = r < rend; rr[u] = act[u] ? r : r0;
            float mx[16]; unpack16(rm[u], mx);
            if (l == 0) {
#pragma unroll
                for (int g = 0; g < 4; ++g) { v[u][4 * g] = __uint_as_float(rx[u][g].x); v[u][4 * g + 1] = __uint_as_float(rx[u][g].y); v[u][4 * g + 2] = __uint_as_float(rx[u][g].z); v[u][4 * g + 3] = __uint_as_float(rx[u][g].w); }
            } else {
#pragma unroll
                for (int g = 0; g < 4; ++g) { const v2u t = {rx[u][g].x, rx[u][g].y}; const f32x4 f = __builtin_convertvector(__builtin_bit_cast(f16x4, t), f32x4);
                    v[u][4 * g] = f.x; v[u][4 * g + 1] = f.y; v[u][4 * g + 2] = f.z; v[u][4 * g + 3] = f.w; }
            }
#pragma unroll
            for (int i = 0; i < 16; ++i) v[u][i] = alpha_l * v[u][i] + g1[i] * mx[i]; }
        if (r0 + NR < rend) RT_ISSUE(r0 + NR);
        if (l == NL - 1 && (r0 % TT) >= SEQ) continue;
#pragma unroll
        for (int u = 0; u < NR; ++u) ln16(v[u]);
        { float gg[16], bb[16];
#pragma unroll
          for (int g = 0; g < 4; ++g) { const f32x4 a = RT_W4(lbase, 1024 * g), c = RT_W4(lbase, 4096 + 1024 * g);
              gg[4 * g] = a.x; gg[4 * g + 1] = a.y; gg[4 * g + 2] = a.z; gg[4 * g + 3] = a.w; bb[4 * g] = c.x; bb[4 * g + 1] = c.y; bb[4 * g + 2] = c.z; bb[4 * g + 3] = c.w; }
#pragma unroll
          for (int u = 0; u < NR; ++u) {
#pragma unroll
            for (int i = 0; i < 16; ++i) v[u][i] = v[u][i] * gg[i] + bb[i];
            if (act[u]) st16h(RP.xs + (size_t)rr[u] * D, F.lane, v[u]); } }
#pragma unroll
        for (int u = 0; u < NR; ++u) ln16(v[u]);
#pragma unroll
        for (int u = 0; u < NR; ++u) {
#pragma unroll
            for (int i = 0; i < 16; ++i) v[u][i] = v[u][i] * (1.0f + sc[i]) + sh[i];
            if (act[u]) st16bf(HA + (size_t)rr[u] * D, F.lane, v[u]); }
#define RT_DOT(u_, w0, w1, w2, w3) ((v[u_][0] * w0.x + v[u_][1] * w0.y) + (v[u_][2] * w0.z + v[u_][3] * w0.w) + (v[u_][4] * w1.x + v[u_][5] * w1.y) + (v[u_][6] * w1.z + v[u_][7] * w1.w) \
        + (v[u_][8] * w2.x + v[u_][9] * w2.y) + (v[u_][10] * w2.z + v[u_][11] * w2.w) + (v[u_][12] * w3.x + v[u_][13] * w3.y) + (v[u_][14] * w3.z + v[u_][15] * w3.w))
        float gl[NR][4];
#pragma unroll
        for (int jx = 0; jx < 4; ++jx) {
            const f32x4 w0 = RT_W4(wbase, 4096 * jx), w1 = RT_W4(wbase, 4096 * jx + 1024), w2 = RT_W4(wbase, 4096 * jx + 2048), w3 = RT_W4(wbase, 4096 * jx + 3072);
#pragma unroll
            for (int u = 0; u < NR; ++u) gl[u][jx] = RT_DOT(u, w0, w1, w2, w3);
        }
#pragma unroll
        for (int u = 0; u < NR; ++u)
#pragma unroll
            for (int jx = 0; jx < 4; ++jx) gl[u][jx] = wave_sum(gl[u][jx]) + bias[jx];
        int grpv[NR]; float pgv[NR];
#pragma unroll
        for (int u = 0; u < NR; ++u) {
            int grp = 0; float mg = gl[u][0];
#pragma unroll
            for (int g = 1; g < 4; ++g) if (gl[u][g] > mg) { mg = gl[u][g]; grp = g; }
            float sg = 0.f;
#pragma unroll
            for (int g = 0; g < 4; ++g) sg += __builtin_amdgcn_exp2f((gl[u][g] - mg) * LOG2E);
            grpv[u] = grp; pgv[u] = __builtin_amdgcn_rcpf(sg);
        }
        float selv[NR][4];
#pragma unroll
        for (int u = 0; u < NR; ++u) {
            const LAS unsigned char* eb = wbase + (4 + 4 * grpv[u]) * 4096;
#pragma unroll
            for (int i = 0; i < 4; ++i) {
                const f32x4 w0 = RT_W4(eb, 4096 * i), w1 = RT_W4(eb, 4096 * i + 1024), w2 = RT_W4(eb, 4096 * i + 2048), w3 = RT_W4(eb, 4096 * i + 3072);
                selv[u][i] = RT_DOT(u, w0, w1, w2, w3);
            }
        }
#pragma unroll
        for (int u = 0; u < NR; ++u)
#pragma unroll
            for (int i = 0; i < 4; ++i) selv[u][i] = wave_sum(selv[u][i]) + bias[4 + 4 * grpv[u] + i];
#undef RT_DOT
#pragma unroll
        for (int u = 0; u < NR; ++u) {
            const int grp = grpv[u]; const float pg = pgv[u];
            float sel[4];
#pragma unroll
            for (int i = 0; i < 4; ++i) sel[i] = selv[u][i];
            int i1 = 0; float v1 = sel[0];
#pragma unroll
            for (int i = 1; i < 4; ++i) if (sel[i] > v1) { v1 = sel[i]; i1 = i; }
            int i2 = -1; float v2 = -3.0e38f;
#pragma unroll
            for (int i = 0; i < 4; ++i) if (i != i1 && (i2 < 0 || sel[i] > v2)) { v2 = sel[i]; i2 = i; }
            const float ee = __builtin_amdgcn_exp2f((v2 - v1) * LOG2E), rq = __builtin_amdgcn_rcpf(1.0f + ee), w1 = pg * rq, w2 = pg * ee * rq;
            const int e1 = grp * 4 + i1, e2 = grp * 4 + i2;
            if (F.lane == 0 && act[u]) {
                const unsigned k1 = __hip_atomic_fetch_add((LAS unsigned*)&F.MISC[MI_LH + e1], 1u, __ATOMIC_RELAXED, __HIP_MEMORY_SCOPE_WORKGROUP);
                const unsigned k2 = __hip_atomic_fetch_add((LAS unsigned*)&F.MISC[MI_LH + e2], 1u, __ATOMIC_RELAXED, __HIP_MEMORY_SCOPE_WORKGROUP);
                v4u ra; ra.x = (unsigned)e1; ra.y = (unsigned)e2; ra.z = k1; ra.w = k2;
                v4u rb; rb.x = __builtin_bit_cast(unsigned, w1); rb.y = __builtin_bit_cast(unsigned, w2); rb.z = 0u; rb.w = 0u;
                *(v4u*)(RT + (size_t)rr[u] * 8) = ra; *(v4u*)(RT + (size_t)rr[u] * 8 + 4) = rb;
            }
        }
    }
#undef RT_ISSUE
#undef RT_W4
    __syncthreads();
    if (F.tid < 16) HIST[F.bid * 16 + F.tid] = (int)F.MISC[MI_LH + F.tid];
}
__device__ __forceinline__ void moe_tables(const Frame& F) {
    const int* HIST = (const int*)(F.ws + WS_HIST); LAS int* hl = (LAS int*)F.lds;
    __syncthreads();
    for (int i = F.tid; i < F.G * 16; i += NTHR) hl[i] = HIST[i];
    __syncthreads();
    if (F.tid < 16) { int tot = 0, mine = 0; for (int g = 0; g < F.G; ++g) { const int c = hl[g * 16 + F.tid]; tot += c; mine += (g < F.bid) ? c : 0; }
        F.MISC[MI_TOT + F.tid] = (unsigned)tot; F.MISC[MI_BASE + F.tid] = (unsigned)mine; }
    __syncthreads();
    if (F.tid == 0) { unsigned p = 0; for (int e = 0; e < 16; ++e) { F.MISC[MI_PST + e] = p; F.MISC[MI_BASE + e] += p * 256u; p += (F.MISC[MI_TOT + e] + 255u) >> 8; } F.MISC[MI_PST + 16] = p; }
    __syncthreads();
}
__device__ __forceinline__ void phase_permute(const Frame& F, int l) {
    unsigned* RT = (unsigned*)(F.ws + WS_RT); int* SRC = (int*)(F.ws + WS_QD);
    moe_tables(F);
    const int rpw = rows_per_wave(F.ngw), rbeg = F.gw * rpw, rend = min(M, rbeg + rpw);
    for (int r = rbeg + F.lane; r < rend; r += 64) {
        if (l == NL - 1 && (r % TT) >= SEQ) continue;
        const v4u ra = *(const v4u*)(RT + (size_t)r * 8);
        const unsigned p0 = F.MISC[MI_BASE + (ra.x & 15u)] + ra.z, p1 = F.MISC[MI_BASE + (ra.y & 15u)] + ra.w;
        RT[(size_t)r * 8 + 6] = p0; RT[(size_t)r * 8 + 7] = p1; SRC[p0] = r; SRC[p1] = r;
    }
    if (F.bid == 0) {
        for (int e = 0; e < 16; ++e) { const int beg = (int)F.MISC[MI_PST + e] * 256 + (int)F.MISC[MI_TOT + e], end = (int)F.MISC[MI_PST + e + 1] * 256;
            for (int p = beg + F.tid; p < end; p += NTHR) SRC[p] = 0; }
    }
}

struct EpiMla {
    static constexpr bool PERM = true, AFTER_DRAIN = false;
    bf16* QD; bf16* KD; bf16* VD;
    __device__ __forceinline__ void operator()(const pg8::f32x4 (&acc)[2][2][4][2], const pg8::Unit& u, int wr, int wc, int fr, int fq) const {
#pragma unroll
        for (int bj = 0; bj < 2; ++bj) {
            const int g0 = u.pn * 256 + bj * 128 + wc * 32, col0 = g0 + 8 * fq;
            if (g0 >= 896) continue;
            const int c = col0 - 384, hd = c >> 7, jx = c & 127;
            bf16* dst = g0 < 384 ? QD + col0 : jx < 64 ? KD + hd * 96 + jx : VD + hd * 64 + (jx - 64);
            const int stride = (g0 < 384 || jx < 64) ? 384 : 256;
            dst += (size_t)(u.pm * 256 + wr * 64 + fr) * stride;
#pragma unroll
            for (int ai = 0; ai < 2; ++ai)
#pragma unroll
                for (int m = 0; m < 4; ++m) {
                    v4u o; o.x = pk2(acc[ai][bj][m][0][0], acc[ai][bj][m][0][1]); o.y = pk2(acc[ai][bj][m][0][2], acc[ai][bj][m][0][3]);
                    o.z = pk2(acc[ai][bj][m][1][0], acc[ai][bj][m][1][1]); o.w = pk2(acc[ai][bj][m][1][2], acc[ai][bj][m][1][3]);
                    *(v4u*)(dst + (size_t)(ai * 128 + m * 16) * stride) = o;
                }
        }
    }
};
struct EpiGU {
    static constexpr bool PERM = true, AFTER_DRAIN = false;
    bf16* ACT;
    __device__ __forceinline__ void operator()(const pg8::f32x4 (&acc)[2][2][4][2], const pg8::Unit& u, int wr, int wc, int fr, int fq) const {
#pragma unroll
        for (int ai = 0; ai < 2; ++ai)
#pragma unroll
            for (int m = 0; m < 4; ++m) {
                const int row = u.pm * 256 + ai * 128 + wr * 64 + m * 16 + fr;
#pragma unroll
                for (int bj = 0; bj < 2; ++bj) {
                    const int c = (u.pn & 3) * 256 + bj * 128 + wc * 32 + 8 * fq;
                    float o[4];
#pragma unroll
                    for (int i = 0; i < 4; ++i) { const float g = acc[ai][bj][m][0][i], up = acc[ai][bj][m][1][i]; o[i] = g * __builtin_amdgcn_rcpf(1.0f + __expf(-g)) * up; }
                    v2u w; w.x = pk2(o[0], o[1]); w.y = pk2(o[2], o[3]);
                    *(v2u*)(ACT + (size_t)row * 512 + (c >> 1)) = w;
                }
            }
    }
};
struct MoeOrder {
    volatile LAS unsigned* pst; int G, c;
    __device__ __forceinline__ bool next(int i, pg8::Unit& u) const {
        const int np = (int)pst[16]; int panel, pn;
        if ((G & 7) == 0) { const int x = c & 7, uu = i * (G >> 3) + (c >> 3); panel = (uu >> 2) * 8 + x; pn = uu & 3; }
        else { const int L = i * G + c; panel = L >> 2; pn = L & 3; }
        if (panel >= np) return false;
        int e = 0;
#pragma unroll
        for (int k = 1; k < 16; ++k) e += (panel >= (int)pst[k]) ? 1 : 0;
        u.pm = __builtin_amdgcn_readfirstlane(panel); u.pn = __builtin_amdgcn_readfirstlane(e * 4 + pn); return true;
    }
    __device__ __forceinline__ void a_ready(const pg8::Unit&) const {}
    __device__ __forceinline__ void done(const pg8::Unit&) const {}
};

struct LatOrder {
    int G, c;
    __device__ __forceinline__ bool next(int i, pg8::Unit& u) const {
        int pl, pn;
        if ((G & 7) == 0) { const int x = c & 7, uu = i * (G >> 3) + (c >> 3); pl = (uu >> 2) * 8 + x; pn = uu & 3; } else { const int L = i * G + c; pl = L >> 2; pn = L & 3; }
        if (pl >= NB * 16) return false;
        u.pm = pl + (pl >> 4); u.pn = pn; return true;
    }
    __device__ __forceinline__ void a_ready(const pg8::Unit&) const {}
    __device__ __forceinline__ void done(const pg8::Unit&) const {}
};

#ifndef DBG_VAR
#define DBG_VAR 1
#endif
namespace att {
constexpr int VRS = 192, KBUF = 64 * 208, VBUF = 64 * VRS, BUF = KBUF + VBUF, BIAS_OFF = 4 * BUF;
constexpr float NEG = -30000.0f;
__device__ __forceinline__ int crow(int r, int hi) { return (r & 3) + 8 * (r >> 2) + 4 * hi; }
__device__ __forceinline__ float xhalf_max(float v) { const unsigned a = __builtin_bit_cast(unsigned, v);
    auto rr = __builtin_amdgcn_permlane32_swap(a, a, false, false); const unsigned r0 = rr[0], r1 = rr[1]; return fmaxf(__uint_as_float(r0), __uint_as_float(r1)); }
__device__ __forceinline__ float xhalf_sum(float v) { const unsigned a = __builtin_bit_cast(unsigned, v);
    auto rr = __builtin_amdgcn_permlane32_swap(a, a, false, false); const unsigned r0 = rr[0], r1 = rr[1]; return __uint_as_float(r0) + __uint_as_float(r1); }
__device__ __forceinline__ float max3f(float a, float b, float c) { float r; asm("v_max3_f32 %0, %1, %2, %3" : "=v"(r) : "v"(a), "v"(b), "v"(c)); return r; }
typedef __bf16 bf16x2_t __attribute__((ext_vector_type(2)));
__device__ __forceinline__ unsigned cvtpk(float lo, float hi) { f32x2 v = {lo, hi}; bf16x2_t b = __builtin_convertvector(v, bf16x2_t); return __builtin_bit_cast(unsigned, b); }

template <int DK, int VM = 0>
__device__ __forceinline__ void unit(LAS unsigned char* lds, const bf16* Qp, int qpitch, const bf16* Kp, int kpitch, const bf16* Vp, int vpitch, bf16* Op,
                                     int var, int qt, int lo, int n1, int nt, float qscale, float sinkl2, bool has_sink, const LAS float* bias, const float* t32, unsigned* dbg) {
    constexpr int KRS = DK * 2 + 16, NS = DK / 16, CPK = DK / 8;
    int tid = threadIdx.x; asm volatile("" : "+v"(tid)); const int lane = tid & 63, r32 = lane & 31, hi = lane >> 5, wid = __builtin_amdgcn_readfirstlane(tid >> 6);
    const int qrow = 256 * qt + 32 * wid + r32;
    bf16x8 qr[NS];
#pragma unroll
    for (int s = 0; s < NS; ++s) { const v4u raw = *(const v4u*)(Qp + (size_t)qrow * qpitch + 16 * s + 8 * hi); float f[8]; unpack8(raw, f);
#pragma unroll
        for (int i = 0; i < 8; ++i) f[i] *= qscale;
        if (DK == 96 && s >= 4) {
            float p[8];
#pragma unroll
            for (int i = 0; i < 8; ++i) p[i] = __shfl_xor(f[i], 32);
            if (qt < 16) rope8(f, p, t32 + ((size_t)((s == 4 ? (qrow >> 6) : (qrow & 63)) * 8)) * 2, hi == 0);
        }
        qr[s] = __builtin_bit_cast(bf16x8, pack8(f)); }
    const int kkey0 = tid / CPK, kch0 = tid - kkey0 * CPK, kkey1 = (tid + 512) / CPK, kch1 = (tid + 512) - kkey1 * CPK;
    const int vkey = tid >> 3, vch = tid & 7;
    v4u kreg0, kreg1 = {0u, 0u, 0u, 0u}, vreg;
#define ATT_TROW(j) ((((j) < n1) ? (lo + (j)) : (64 + (j) - n1)) * 64)
#define ATT_LOAD(j) do { const int tr_ = ATT_TROW(j); kreg0 = *(const v4u*)(Kp + (size_t)(tr_ + kkey0) * kpitch + kch0 * 8); \
        if (DK == 96 && tid < 256) kreg1 = *(const v4u*)(Kp + (size_t)(tr_ + kkey1) * kpitch + kch1 * 8); \
        vreg = *(const v4u*)(Vp + (size_t)(tr_ + vkey) * vpitch + vch * 8); } while (0)
#define ATT_STORE(bf) do { LAS unsigned char* b_ = lds + (bf) * BUF; *(LAS v4u*)(b_ + kkey0 * KRS + kch0 * 16) = kreg0; \
        if (DK == 96 && tid < 256) *(LAS v4u*)(b_ + kkey1 * KRS + kch1 * 16) = kreg1; \
        *(LAS v4u*)(b_ + KBUF + vkey * VRS + vch * 16) = vreg; } while (0)
    constexpr float THR = 6.0f;
    float m = 0.f; f32x2 lacc = {0.f, 0.f}; f32x16 o0 = {}, o1 = {}; f32x16 negm = {}; bool first = true;
    const int grw = 4 * qt + (wid >> 1), r0w = min(max(grw - 4, 0), 56), gc = (wid & 1) * 32 + r32, c0 = min(max(gc - 8, 0), 48), i0w = 256 * qt + 32 * wid;
    ATT_LOAD(0); ATT_STORE(0);
    __syncthreads();
    for (int j = 0; j < nt; ++j) {
        if (!(VM & 8) && j + 1 < nt) ATT_LOAD(j + 1);
        const int kt = ATT_TROW(j) >> 6;
        bool actv = true;
        if (kt < 64) { if (var == 0) actv = (kt >= r0w) && (kt <= r0w + 7); else if (var == 2) actv = !((64 * kt - (i0w + 31) > 128) || (i0w - (64 * kt + 63) > 128)); }
        if (actv) {
            const LAS unsigned char* Kb = lds + (j & 1) * BUF; const LAS unsigned char* Vb = Kb + KBUF;
            f32x16 s0 = negm, s1 = negm;
            bf16x8 ka[NS], kb[NS];
#pragma unroll
            for (int s = 0; s < NS; ++s) { ka[s] = *(const LAS bf16x8*)(Kb + r32 * KRS + (16 * s + 8 * hi) * 2); kb[s] = *(const LAS bf16x8*)(Kb + (32 + r32) * KRS + (16 * s + 8 * hi) * 2); }
            __builtin_amdgcn_sched_barrier(0);
            if (VM & 2) {
#pragma unroll
                for (int s = 0; s < NS; ++s) asm volatile("" :: "v"(ka[s]), "v"(kb[s]), "v"(qr[s]));
            } else {
#pragma unroll
            for (int s = 0; s < NS; ++s) { s0 = __builtin_amdgcn_mfma_f32_32x32x16_bf16(ka[s], qr[s], s0, 0, 0, 0); s1 = __builtin_amdgcn_mfma_f32_32x32x16_bf16(kb[s], qr[s], s1, 0, 0, 0); }
            }
            asm volatile("s_nop 15\n\ts_nop 7" : "+v"(s0), "+v"(s1));
            if (kt < 64 && var == 0) {
                const int rowoff = (kt - grw + 7) * 31 - gc + 15;
#pragma unroll
                for (int r = 0; r < 16; ++r) { const int j0 = crow(r, hi), j1 = j0 + 32;
                    const bool v0 = (unsigned)(j0 - c0) < 16u, v1 = (unsigned)(j1 - c0) < 16u;
                    const float b0 = bias[v0 ? rowoff + j0 : 0], b1 = bias[v1 ? rowoff + j1 : 0];
                    s0[r] = v0 ? s0[r] + b0 : NEG; s1[r] = v1 ? s1[r] + b1 : NEG; }
            } else if (kt < 64 && var == 2) {
                const int dbase = 64 * kt - qrow + 128;
#pragma unroll
                for (int r = 0; r < 16; ++r) { const int j0 = crow(r, hi);
                    s0[r] = (unsigned)(dbase + j0) <= 256u ? s0[r] : NEG; s1[r] = (unsigned)(dbase + j0 + 32) <= 256u ? s1[r] : NEG; }
            }
            if (!(VM & 4)) {
            float mxa = max3f(s0[0], s0[1], s1[0]), mxb = max3f(s0[2], s0[3], s1[1]); mxa = max3f(mxa, s1[2], s1[3]);
#pragma unroll
            for (int r = 4; r < 16; r += 4) { mxa = max3f(mxa, s0[r], s0[r + 1]); mxb = max3f(mxb, s0[r + 2], s0[r + 3]); mxa = max3f(mxa, s1[r], s1[r + 1]); mxb = max3f(mxb, s1[r + 2], s1[r + 3]); }
            const float mx = xhalf_max(fmaxf(mxa, mxb));
            if (first || __any(mx > THR)) {
                const float d = first ? fmaxf(mx, -64.0f) : fmaxf(mx, 0.f), alpha = __builtin_amdgcn_exp2f(-d);
                m += d; first = false;
#pragma unroll
                for (int r = 0; r < 16; ++r) { s0[r] -= d; s1[r] -= d; o0[r] *= alpha; o1[r] *= alpha; negm[r] = -m; }
                lacc *= alpha;
            }
#pragma unroll
            for (int r = 0; r < 16; ++r) { s0[r] = __builtin_amdgcn_exp2f(s0[r]); s1[r] = __builtin_amdgcn_exp2f(s1[r]); lacc += (f32x2){s0[r], s1[r]}; }
            }
            bf16x8 pb[4];
#pragma unroll
            for (int s = 0; s < 2; ++s) {
                v4u w; w.x = cvtpk(s0[8 * s], s0[8 * s + 1]); w.y = cvtpk(s0[8 * s + 2], s0[8 * s + 3]); w.z = cvtpk(s0[8 * s + 4], s0[8 * s + 5]); w.w = cvtpk(s0[8 * s + 6], s0[8 * s + 7]);
                pb[s] = __builtin_bit_cast(bf16x8, w);
                v4u x; x.x = cvtpk(s1[8 * s], s1[8 * s + 1]); x.y = cvtpk(s1[8 * s + 2], s1[8 * s + 3]); x.z = cvtpk(s1[8 * s + 4], s1[8 * s + 5]); x.w = cvtpk(s1[8 * s + 6], s1[8 * s + 7]);
                pb[2 + s] = __builtin_bit_cast(bf16x8, x);
            }
            if (VM & 1) { asm volatile("" :: "v"(pb[0]), "v"(pb[1]), "v"(pb[2]), "v"(pb[3])); } else {
            const LAS unsigned char* vbase = Vb + (4 * hi + ((lane & 15) >> 2)) * VRS + ((lane >> 4) & 1) * 32 + (lane & 3) * 8;
#pragma unroll
            for (int s = 0; s < 4; ++s) {
                const v4i16 a0 = __builtin_amdgcn_ds_read_tr16_b64_v4i16((LAS v4i16*)(vbase + (16 * s) * VRS));
                const v4i16 a1 = __builtin_amdgcn_ds_read_tr16_b64_v4i16((LAS v4i16*)(vbase + (16 * s + 8) * VRS));
                const v4i16 c0_ = __builtin_amdgcn_ds_read_tr16_b64_v4i16((LAS v4i16*)(vbase + (16 * s) * VRS + 64));
                const v4i16 c1_ = __builtin_amdgcn_ds_read_tr16_b64_v4i16((LAS v4i16*)(vbase + (16 * s + 8) * VRS + 64));
                const bf16x8 va = {a0[0], a0[1], a0[2], a0[3], a1[0], a1[1], a1[2], a1[3]};
                const bf16x8 vc = {c0_[0], c0_[1], c0_[2], c0_[3], c1_[0], c1_[1], c1_[2], c1_[3]};
                o0 = __builtin_amdgcn_mfma_f32_32x32x16_bf16(va, pb[s], o0, 0, 0, 0);
                o1 = __builtin_amdgcn_mfma_f32_32x32x16_bf16(vc, pb[s], o1, 0, 0, 0);
            }
            }
        }
        if (!(VM & 8) && j + 1 < nt) ATT_STORE((j + 1) & 1);
        if (!(VM & 16)) __syncthreads();
    }
    float l = xhalf_sum(lacc.x + lacc.y);
    const float sterm = has_sink ? __builtin_amdgcn_exp2f(sinkl2 - m) : 0.f;
#if MK_DEBUG
    if (dbg && hi == 0) { dbg[(size_t)qrow * 2] = __builtin_bit_cast(unsigned, m); dbg[(size_t)qrow * 2 + 1] = __builtin_bit_cast(unsigned, l); }
#endif
    if (has_sink) l += sterm;
    const float inv = 1.0f / l;
    bf16* orow = Op + (size_t)qrow * D;
#pragma unroll
    for (int g = 0; g < 4; ++g) {
        v2u w0; w0.x = pk2(o0[4 * g] * inv, o0[4 * g + 1] * inv); w0.y = pk2(o0[4 * g + 2] * inv, o0[4 * g + 3] * inv);
        v2u w1; w1.x = pk2(o1[4 * g] * inv, o1[4 * g + 1] * inv); w1.y = pk2(o1[4 * g + 2] * inv, o1[4 * g + 3] * inv);
        *(v2u*)(orow + 8 * g + 4 * hi) = w0; *(v2u*)(orow + 32 + 8 * g + 4 * hi) = w1;
    }
#undef ATT_TROW
#undef ATT_LOAD
#undef ATT_STORE
}

template <int DK, int MODE, int VM = 0, bool NOREF = false>
__device__ __forceinline__ void unit2(LAS unsigned char* lds, const bf16* Qp, int qpitch, const bf16* Kp, int kpitch, const bf16* Vp, int vpitch, bf16* Op,
                                      int var, int qt, int lo, int n1, int nt, float qscale, float sink0, float sink1, bool has_sink, const LAS float* bias, const float* t32) {
    constexpr int KRS = DK * 2 + 16, NS = DK / 16, CPK = DK / 8;
    int tid = threadIdx.x; asm volatile("" : "+v"(tid)); const int lane = tid & 63, r32 = lane & 31, hi = lane >> 5, wid = __builtin_amdgcn_readfirstlane(tid >> 6);
    const int rowbase = MODE == 0 ? 512 * qt + 64 * wid : 256 * qt + 32 * wid;
    bf16x8 qr[2][NS];
#pragma unroll
    for (int u = 0; u < 2; ++u) {
        const int qrow = rowbase + (MODE == 0 ? 32 * u : 0) + r32;
        const bf16* qp = Qp + (MODE == 1 ? 64 * u : 0) + (size_t)qrow * qpitch;
#pragma unroll
        for (int s = 0; s < NS; ++s) { const v4u raw = *(const v4u*)(qp + 16 * s + 8 * hi); float f[8]; unpack8(raw, f);
#pragma unroll
            for (int i = 0; i < 8; ++i) f[i] *= qscale;
            if (DK == 96 && s >= 4) { float p[8];
#pragma unroll
                for (int i = 0; i < 8; ++i) p[i] = __shfl_xor(f[i], 32);
                rope8(f, p, t32 + ((size_t)((s == 4 ? (qrow >> 6) : (qrow & 63)) * 8)) * 2, hi == 0); }
            qr[u][s] = __builtin_bit_cast(bf16x8, pack8(f)); }
    }
    const int kkey0 = tid / CPK, kch0 = tid - kkey0 * CPK, kkey1 = (tid + 512) / CPK, kch1 = (tid + 512) - kkey1 * CPK;
    const int vkey = tid >> 3, vch = tid & 7;
    v4u kreg0, kreg1 = {0u, 0u, 0u, 0u}, vreg;
#define ATT_TROW(j) ((((j) < n1) ? (lo + (j)) : (64 + (j) - n1)) * 64)
#define ATT_LOAD(j) do { const int tr_ = ATT_TROW(j); kreg0 = *(const v4u*)(Kp + (size_t)(tr_ + kkey0) * kpitch + kch0 * 8); \
        if (DK == 96 && tid < 256) kreg1 = *(const v4u*)(Kp + (size_t)(tr_ + kkey1) * kpitch + kch1 * 8); \
        vreg = *(const v4u*)(Vp + (size_t)(tr_ + vkey) * vpitch + vch * 8); } while (0)
#define ATT_STORE(bf) do { LAS unsigned char* b_ = lds + (bf) * BUF; *(LAS v4u*)(b_ + kkey0 * KRS + kch0 * 16) = kreg0; \
        if (DK == 96 && tid < 256) *(LAS v4u*)(b_ + kkey1 * KRS + kch1 * 16) = kreg1; \
        *(LAS v4u*)(b_ + KBUF + vkey * VRS + vch * 16) = vreg; } while (0)
    constexpr float THR = 6.0f;
    float m = 0.f; f32x2 lacc[2] = {{0.f, 0.f}, {0.f, 0.f}}; f32x16 o0[2] = {{}, {}}, o1[2] = {{}, {}}; bool first = true;
    const int grw = 8 * qt + wid, r0w = min(max(grw - 4, 0), 56), i0w = rowbase;
    ATT_LOAD(0); ATT_STORE(0);
    __syncthreads();
    for (int j = 0; j < nt; ++j) {
        if (!(VM & 8) && j + 1 < nt) ATT_LOAD(j + 1);
        const int kt = ATT_TROW(j) >> 6;
        bool actv = true;
        if (kt < 64) { if (var == 0) actv = (kt >= r0w) && (kt <= r0w + 7); else if (var == 2) actv = !((64 * kt - (i0w + 31) > 128) || (i0w - (64 * kt + 63) > 128)); }
        if (actv) {
            const LAS unsigned char* Kb = lds + (j & 1) * BUF; const LAS unsigned char* Vb = Kb + KBUF;
            f32x16 s0[2] = {{}, {}}, s1[2] = {{}, {}};
#pragma unroll
            for (int s = 0; s < NS; ++s) {
                const bf16x8 ka = *(const LAS bf16x8*)(Kb + r32 * KRS + (16 * s + 8 * hi) * 2);
                const bf16x8 kb = *(const LAS bf16x8*)(Kb + (32 + r32) * KRS + (16 * s + 8 * hi) * 2);
                if (VM & 2) { asm volatile("" :: "v"(ka), "v"(kb), "v"(qr[0][s]), "v"(qr[1][s])); } else {
#pragma unroll
                for (int u = 0; u < 2; ++u) { s0[u] = __builtin_amdgcn_mfma_f32_32x32x16_bf16(ka, qr[u][s], s0[u], 0, 0, 0); s1[u] = __builtin_amdgcn_mfma_f32_32x32x16_bf16(kb, qr[u][s], s1[u], 0, 0, 0); }
                }
            }
            asm volatile("s_nop 15\n\ts_nop 7" : "+v"(s0[0]), "+v"(s1[0]), "+v"(s0[1]), "+v"(s1[1]));
            if (kt < 64 && var == 0) {
#pragma unroll
                for (int u = 0; u < 2; ++u) { const int gc = 32 * u + r32, c0 = min(max(gc - 8, 0), 48), rowoff = (kt - grw + 7) * 31 - gc + 15;
#pragma unroll
                    for (int r = 0; r < 16; ++r) { const int j0 = crow(r, hi), j1 = j0 + 32;
                        const bool v0 = (unsigned)(j0 - c0) < 16u, v1 = (unsigned)(j1 - c0) < 16u;
                        const float b0 = bias[v0 ? rowoff + j0 : 0], b1 = bias[v1 ? rowoff + j1 : 0];
                        s0[u][r] = v0 ? s0[u][r] + b0 : NEG; s1[u][r] = v1 ? s1[u][r] + b1 : NEG; } }
            } else if (kt < 64 && var == 2) {
                const int dbase = 64 * kt - (rowbase + r32) + 128;
#pragma unroll
                for (int r = 0; r < 16; ++r) { const int j0 = crow(r, hi); const bool v0 = (unsigned)(dbase + j0) <= 256u, v1 = (unsigned)(dbase + j0 + 32) <= 256u;
                    s0[0][r] = v0 ? s0[0][r] : NEG; s1[0][r] = v1 ? s1[0][r] : NEG; s0[1][r] = v0 ? s0[1][r] : NEG; s1[1][r] = v1 ? s1[1][r] : NEG; }
            }
            if (!(VM & 4)) {
            if (!NOREF) {
            float mxa = max3f(s0[0][0], s0[0][1], s1[0][0]), mxb = max3f(s0[1][0], s0[1][1], s1[1][0]);
#pragma unroll
            for (int r = 0; r < 16; r += 2) { if (r) { mxa = max3f(mxa, s0[0][r], s0[0][r + 1]); mxb = max3f(mxb, s0[1][r], s0[1][r + 1]); }
                if (r) { mxa = max3f(mxa, s1[0][r], s1[0][r + 1]); mxb = max3f(mxb, s1[1][r], s1[1][r + 1]); } else { mxa = fmaxf(mxa, s1[0][1]); mxb = fmaxf(mxb, s1[1][1]); } }
            const float mx = xhalf_max(fmaxf(mxa, mxb)) - m;
            if (first || __any(mx > THR)) {
                const float d = first ? fmaxf(mx, -64.0f) : fmaxf(mx, 0.f), alpha = __builtin_amdgcn_exp2f(-d);
                m += d; first = false;
#pragma unroll
                for (int u = 0; u < 2; ++u) {
#pragma unroll
                    for (int r = 0; r < 16; ++r) { o0[u][r] *= alpha; o1[u][r] *= alpha; }
                    lacc[u] *= alpha; }
            }
            }
            }
            bf16x8 pb[2][4];
#pragma unroll
            for (int u = 0; u < 2; ++u) {
                if (!(VM & 4))
#pragma unroll
                for (int r = 0; r < 16; ++r) { s0[u][r] = __builtin_amdgcn_exp2f(NOREF ? s0[u][r] : s0[u][r] - m); s1[u][r] = __builtin_amdgcn_exp2f(NOREF ? s1[u][r] : s1[u][r] - m); lacc[u] += (f32x2){s0[u][r], s1[u][r]}; }
#pragma unroll
                for (int s = 0; s < 2; ++s) {
                    v4u w; w.x = cvtpk(s0[u][8 * s], s0[u][8 * s + 1]); w.y = cvtpk(s0[u][8 * s + 2], s0[u][8 * s + 3]); w.z = cvtpk(s0[u][8 * s + 4], s0[u][8 * s + 5]); w.w = cvtpk(s0[u][8 * s + 6], s0[u][8 * s + 7]);
                    pb[u][s] = __builtin_bit_cast(bf16x8, w);
                    v4u x; x.x = cvtpk(s1[u][8 * s], s1[u][8 * s + 1]); x.y = cvtpk(s1[u][8 * s + 2], s1[u][8 * s + 3]); x.z = cvtpk(s1[u][8 * s + 4], s1[u][8 * s + 5]); x.w = cvtpk(s1[u][8 * s + 6], s1[u][8 * s + 7]);
                    pb[u][2 + s] = __builtin_bit_cast(bf16x8, x);
                }
            }
            if (VM & 1) { asm volatile("" :: "v"(pb[0][0]), "v"(pb[0][1]), "v"(pb[0][2]), "v"(pb[0][3]), "v"(pb[1][0]), "v"(pb[1][1]), "v"(pb[1][2]), "v"(pb[1][3])); } else {
            const LAS unsigned char* vbase = Vb + (4 * hi + ((lane & 15) >> 2)) * VRS + ((lane >> 4) & 1) * 32 + (lane & 3) * 8;
#pragma unroll
            for (int s = 0; s < 4; ++s) {
                const v4i16 a0 = __builtin_amdgcn_ds_read_tr16_b64_v4i16((LAS v4i16*)(vbase + (16 * s) * VRS));
                const v4i16 a1 = __builtin_amdgcn_ds_read_tr16_b64_v4i16((LAS v4i16*)(vbase + (16 * s + 8) * VRS));
                const v4i16 c0_ = __builtin_amdgcn_ds_read_tr16_b64_v4i16((LAS v4i16*)(vbase + (16 * s) * VRS + 64));
                const v4i16 c1_ = __builtin_amdgcn_ds_read_tr16_b64_v4i16((LAS v4i16*)(vbase + (16 * s + 8) * VRS + 64));
                const bf16x8 va = {a0[0], a0[1], a0[2], a0[3], a1[0], a1[1], a1[2], a1[3]};
                const bf16x8 vc = {c0_[0], c0_[1], c0_[2], c0_[3], c1_[0], c1_[1], c1_[2], c1_[3]};
#pragma unroll
                for (int u = 0; u < 2; ++u) { o0[u] = __builtin_amdgcn_mfma_f32_32x32x16_bf16(va, pb[u][s], o0[u], 0, 0, 0); o1[u] = __builtin_amdgcn_mfma_f32_32x32x16_bf16(vc, pb[u][s], o1[u], 0, 0, 0); }
            }
            }
        }
        if (!(VM & 8) && j + 1 < nt) ATT_STORE((j + 1) & 1);
        if (!(VM & 16)) __syncthreads();
    }
#pragma unroll
    for (int u = 0; u < 2; ++u) {
        float l = xhalf_sum(lacc[u].x + lacc[u].y);
        if (has_sink) l += __builtin_amdgcn_exp2f((u == 0 ? sink0 : sink1) - m);
        const float inv = 1.0f / l;
        const int qrow = rowbase + (MODE == 0 ? 32 * u : 0) + r32;
        bf16* orow = Op + (MODE == 1 ? 64 * u : 0) + (size_t)qrow * D;
#pragma unroll
        for (int g = 0; g < 4; ++g) {
            v2u w0; w0.x = pk2(o0[u][4 * g] * inv, o0[u][4 * g + 1] * inv); w0.y = pk2(o0[u][4 * g + 2] * inv, o0[u][4 * g + 3] * inv);
            v2u w1; w1.x = pk2(o1[u][4 * g] * inv, o1[u][4 * g + 1] * inv); w1.y = pk2(o1[u][4 * g + 2] * inv, o1[u][4 * g + 3] * inv);
            *(v2u*)(orow + 8 * g + 4 * hi) = w0; *(v2u*)(orow + 32 + 8 * g + 4 * hi) = w1;
        }
    }
#undef ATT_TROW
#undef ATT_LOAD
#undef ATT_STORE
}

#define ATT_BAR() do { asm volatile("s_waitcnt lgkmcnt(0)" ::: "memory"); __builtin_amdgcn_s_barrier(); asm volatile("" ::: "memory"); } while (0)
template <int DK, int MODE, int VM = 0>
__device__ __forceinline__ bool unit_h(LAS unsigned char* lds, const bf16* Qp, int qpitch, const bf16* Kp, int kpitch, const bf16* Vp, int vpitch, bf16* Op,
                                       int var, int qt, int lo, int n1, int nt, float qscale, float sink0, float sink1, bool has_sink, const LAS float* bias, const float* t32, volatile LAS unsigned* flag) {
    constexpr int KRS = DK * 2 + 16, NS = DK / 16, CPK = DK / 8;
    int tid = threadIdx.x; asm volatile("" : "+v"(tid)); const int lane = tid & 63, r32 = lane & 31, hi = lane >> 5, wid = __builtin_amdgcn_readfirstlane(tid >> 6);
    const int rowbase = MODE == 0 ? 512 * qt + 64 * wid : 256 * qt + 32 * wid;
    const int kkey0 = tid / CPK, kch0 = tid - kkey0 * CPK, kkey1 = (tid + 512) / CPK, kch1 = (tid + 512) - kkey1 * CPK;
    const int vkey = tid >> 3, vch = tid & 7;
    v4u kreg0, kreg1 = {0u, 0u, 0u, 0u}, vreg;
#define ATT_TROW(j) ((((j) < n1) ? (lo + (j)) : (64 + (j) - n1)) * 64)
#define ATT_LOAD(j) do { const int tr_ = ATT_TROW(j); kreg0 = *(const v4u*)(Kp + (size_t)(tr_ + kkey0) * kpitch + kch0 * 8); \
        if (DK == 96 && tid < 256) kreg1 = *(const v4u*)(Kp + (size_t)(tr_ + kkey1) * kpitch + kch1 * 8); \
        vreg = *(const v4u*)(Vp + (size_t)(tr_ + vkey) * vpitch + vch * 8); } while (0)
#define ATT_STORE(bf) do { LAS unsigned char* b_ = lds + (bf) * BUF; *(LAS v4u*)(b_ + kkey0 * KRS + kch0 * 16) = kreg0; \
        if (DK == 96 && tid < 256) *(LAS v4u*)(b_ + kkey1 * KRS + kch1 * 16) = kreg1; \
        *(LAS v4u*)(b_ + KBUF + vkey * VRS + vch * 16) = vreg; } while (0)
    ATT_LOAD(0);
    bf16x8 qr[2][NS];
#pragma unroll
    for (int u = 0; u < 2; ++u) {
        const int qrow = rowbase + (MODE == 0 ? 32 * u : 0) + r32;
        const bf16* qp = Qp + (MODE == 1 ? 64 * u : 0) + (size_t)qrow * qpitch;
#pragma unroll
        for (int s = 0; s < NS; ++s) { const v4u raw = *(const v4u*)(qp + 16 * s + 8 * hi); float f[8]; unpack8(raw, f);
#pragma unroll
            for (int i = 0; i < 8; ++i) f[i] *= qscale;
            if (DK == 96 && s >= 4) { float p[8];
#pragma unroll
                for (int i = 0; i < 8; ++i) p[i] = __shfl_xor(f[i], 32);
                rope8(f, p, t32 + ((size_t)((s == 4 ? (qrow >> 6) : (qrow & 63)) * 8)) * 2, hi == 0); }
            qr[u][s] = __builtin_bit_cast(bf16x8, pack8(f)); }
    }
    f32x2 lacc[2] = {{0.f, 0.f}, {0.f, 0.f}}; f32x16 o0[2] = {{}, {}}, o1[2] = {{}, {}};
    const int grw = 8 * qt + wid, r0w = min(max(grw - 4, 0), 56), i0w = rowbase;
    ATT_STORE(0);
    if (tid == 0) *flag = 0u;
    ATT_BAR();
    for (int j = 0; j < nt; ++j) {
        if (!(VM & 8) && j + 1 < nt) ATT_LOAD(j + 1);
        const int kt = ATT_TROW(j) >> 6;
        bool actv = true;
        if (kt < 64) { if (var == 0) actv = (kt >= r0w) && (kt <= r0w + 7); else if (var == 2) actv = !((64 * kt - (i0w + 31) > 128) || (i0w - (64 * kt + 63) > 128)); }
        if (actv) {
        const LAS unsigned char* Kb = lds + (j & 1) * BUF; const LAS unsigned char* Vb = Kb + KBUF;
        const LAS unsigned char* vbase = Vb + (4 * hi + ((lane & 15) >> 2)) * VRS + ((lane >> 4) & 1) * 32 + (lane & 3) * 8;
#pragma unroll
        for (int hf = 0; hf < 2; ++hf) {
            f32x16 sc[2] = {{}, {}};
#pragma unroll
            for (int s = 0; s < NS; ++s) {
                const bf16x8 kf = *(const LAS bf16x8*)(Kb + (32 * hf + r32) * KRS + (16 * s + 8 * hi) * 2);
#pragma unroll
                for (int u = 0; u < 2; ++u) sc[u] = __builtin_amdgcn_mfma_f32_32x32x16_bf16(kf, qr[u][s], sc[u], 0, 0, 0);
            }
            if (kt < 64 && var == 0) {
#pragma unroll
                for (int u = 0; u < 2; ++u) { const int gc = 32 * u + r32, c0 = min(max(gc - 8, 0), 48), rowoff = (kt - grw + 7) * 31 - gc + 15;
                    const LAS unsigned char* bb = (const LAS unsigned char*)(bias + rowoff + 4 * hi); asm volatile("" : "+v"(bb));
                    float bv[16];
#pragma unroll
                    for (int r = 0; r < 16; ++r) bv[r] = *(const LAS float*)(bb + 4 * (32 * hf + (r & 3) + 8 * (r >> 2)));
                    asm volatile("" : "+v"(bv[0]), "+v"(bv[1]), "+v"(bv[2]), "+v"(bv[3]), "+v"(bv[4]), "+v"(bv[5]), "+v"(bv[6]), "+v"(bv[7]),
                                      "+v"(bv[8]), "+v"(bv[9]), "+v"(bv[10]), "+v"(bv[11]), "+v"(bv[12]), "+v"(bv[13]), "+v"(bv[14]), "+v"(bv[15]));
#pragma unroll
                    for (int r = 0; r < 16; ++r) { const int jj = 32 * hf + crow(r, hi); const bool v = (unsigned)(jj - c0) < 16u; sc[u][r] = v ? sc[u][r] + bv[r] : NEG; } }
            } else if (kt < 64 && var == 2) {
                const int dbase = 64 * kt - (rowbase + r32) + 128;
#pragma unroll
                for (int r = 0; r < 16; ++r) { const bool v = (unsigned)(dbase + 32 * hf + crow(r, hi)) <= 256u; sc[0][r] = v ? sc[0][r] : NEG; sc[1][r] = v ? sc[1][r] : NEG; }
            }
            bf16x8 pb[2][2];
#pragma unroll
            for (int u = 0; u < 2; ++u) {
#pragma unroll
                for (int r = 0; r < 16; r += 2) { sc[u][r] = __builtin_amdgcn_exp2f(sc[u][r]); sc[u][r + 1] = __builtin_amdgcn_exp2f(sc[u][r + 1]); lacc[u] += (f32x2){sc[u][r], sc[u][r + 1]}; }
#pragma unroll
                for (int s = 0; s < 2; ++s) {
                    v4u w; w.x = cvtpk(sc[u][8 * s], sc[u][8 * s + 1]); w.y = cvtpk(sc[u][8 * s + 2], sc[u][8 * s + 3]); w.z = cvtpk(sc[u][8 * s + 4], sc[u][8 * s + 5]); w.w = cvtpk(sc[u][8 * s + 6], sc[u][8 * s + 7]);
                    pb[u][s] = __builtin_bit_cast(bf16x8, w);
                }
            }
#pragma unroll
            for (int s2 = 0; s2 < 2; ++s2) { const int s = 2 * hf + s2;
                const v4i16 a0 = __builtin_amdgcn_ds_read_tr16_b64_v4i16((LAS v4i16*)(vbase + (16 * s) * VRS));
                const v4i16 a1 = __builtin_amdgcn_ds_read_tr16_b64_v4i16((LAS v4i16*)(vbase + (16 * s + 8) * VRS));
                const v4i16 c0_ = __builtin_amdgcn_ds_read_tr16_b64_v4i16((LAS v4i16*)(vbase + (16 * s) * VRS + 64));
                const v4i16 c1_ = __builtin_amdgcn_ds_read_tr16_b64_v4i16((LAS v4i16*)(vbase + (16 * s + 8) * VRS + 64));
                const bf16x8 va = {a0[0], a0[1], a0[2], a0[3], a1[0], a1[1], a1[2], a1[3]};
                const bf16x8 vc = {c0_[0], c0_[1], c0_[2], c0_[3], c1_[0], c1_[1], c1_[2], c1_[3]};
#pragma unroll
                for (int u = 0; u < 2; ++u) { o0[u] = __builtin_amdgcn_mfma_f32_32x32x16_bf16(va, pb[u][s2], o0[u], 0, 0, 0); o1[u] = __builtin_amdgcn_mfma_f32_32x32x16_bf16(vc, pb[u][s2], o1[u], 0, 0, 0); }
            }
            __builtin_amdgcn_sched_barrier(0);
        }
        }
        if (!(VM & 8) && j + 1 < nt) ATT_STORE((j + 1) & 1);
        ATT_BAR();
    }
    float lsum[2]; bool bad = false;
#pragma unroll
    for (int u = 0; u < 2; ++u) { lsum[u] = xhalf_sum(lacc[u].x + lacc[u].y); bad = bad || !(lsum[u] > 8.6736174e-19f && lsum[u] < 1.1529215e18f);
        if (has_sink) { lsum[u] += __builtin_amdgcn_exp2f(u == 0 ? sink0 : sink1); bad = bad || !(lsum[u] < 1.1529215e18f); } }
    if (__any(bad)) { if (lane == 0) *flag = 1u; }
#pragma unroll
    for (int u = 0; u < 2; ++u) {
        const float inv = __builtin_amdgcn_rcpf(lsum[u]);
        bf16* orow = Op + (MODE == 1 ? 64 * u : 0) + (size_t)(rowbase + (MODE == 0 ? 32 * u : 0) + r32) * D;
#pragma unroll
        for (int g = 0; g < 4; ++g) {
            v2u w0; w0.x = pk2(o0[u][4 * g] * inv, o0[u][4 * g + 1] * inv); w0.y = pk2(o0[u][4 * g + 2] * inv, o0[u][4 * g + 3] * inv);
            v2u w1; w1.x = pk2(o1[u][4 * g] * inv, o1[u][4 * g + 1] * inv); w1.y = pk2(o1[u][4 * g + 2] * inv, o1[u][4 * g + 3] * inv);
            *(v2u*)(orow + 8 * g + 4 * hi) = w0; *(v2u*)(orow + 32 + 8 * g + 4 * hi) = w1;
        }
    }
    ATT_BAR();
    return *flag == 0u;
#undef ATT_TROW
#undef ATT_LOAD
#undef ATT_STORE
}
}

template <int VM = 0>
__device__ __forceinline__ void phase_attn(const Frame& F, int lq) {
    const int l = lq & 3;
    const bf16* P = (const bf16*)(F.ws + WS_PB); const bf16* QD = (const bf16*)(F.ws + WS_QD); const bf16* KD = (const bf16*)(F.ws + WS_KD);
    const bf16* VD = (const bf16*)(F.ws + WS_VD); bf16* O = (bf16*)(F.ws + (lq >= 4 ? WS_ACT : WS_HA));
    unsigned* ctr = (unsigned*)(F.ws + WS_CTL) + CW_QUEUE + 64 * 8 * lq;
    LAS float* bias = (LAS float*)(F.lds + att::BIAS_OFF);
    { const float* nab = INP(I_NABIAS) + l * 4 * 465; for (int i = F.tid; i < 4 * 465; i += NTHR) bias[i] = nab[i] * LOG2E; }
    const float* sinks = INP(I_SINK) + l * 4;
    __syncthreads();
    const float* t32 = (const float*)(F.ws + WS_T32);
    volatile LAS unsigned* flag = F.MISC + MI_Q + 1;
    const int nloc = 256 + (l < NL - 1 ? 24 : 0);
    const int q0 = (int)xb_xcc_id();
    for (int qq = 0; qq < 8; ++qq) {
      const int q = (q0 + qq) & 7;
      unsigned* qctr = ctr + 64 * q;
      for (;;) {
        if (F.tid == 0) F.MISC[MI_Q] = __hip_atomic_fetch_add(qctr, 1u, __ATOMIC_RELAXED, __HIP_MEMORY_SCOPE_AGENT);
        ATT_BAR();
        const int li = (int)F.MISC[MI_Q];
        ATT_BAR();
        if (li >= nloc) break;
        int idx;
        if (li < 64) idx = (q + 8 * (li >> 3)) * 8 + (li & 7);
        else if (li < 128) { const int jx = li - 64; idx = 1024 + (q + 8 * (jx >> 4)) * 16 + (jx & 15); }
        else if (li < 192) { const int jx = li - 128; idx = 1536 + (q + 8 * (jx >> 3)) * 8 + (jx & 7); }
        else if (li < 256) { const int jx = li - 192; idx = 2048 + (q + 8 * (jx >> 4)) * 16 + (jx & 15); }
        else if (li < 264) idx = 2560 + q + 8 * (li - 256);
        else idx = 2624 + q + 8 * (li - 264);
        if (idx < 512) {
            const int b = idx >> 5, h = (idx >> 3) & 3, qt = idx & 7; const size_t rb = (size_t)b * TT;
            if (!att::unit_h<96, 0, VM>(F.lds, QD + rb * 384 + h * 96, 384, KD + rb * 384 + h * 96, 384, VD + rb * 256 + h * 64, 256, O + rb * D + 768 + h * 64, 3, qt, 0, 64, 68, 0.10206207261596575f * LOG2E, 0.f, 0.f, false, bias, t32, flag)) {
                __syncthreads();
#pragma unroll 1
                for (int k2 = 0; k2 < 2; ++k2)
                    att::unit<96, VM>(F.lds, QD + rb * 384 + h * 96, 384, KD + rb * 384 + h * 96, 384, VD + rb * 256 + h * 64, 256, O + rb * D + 768 + h * 64, 3, 2 * qt + k2, 0, 64, 68, 0.10206207261596575f * LOG2E, 0.f, false, bias, t32, nullptr);
            }
        } else if (idx < 1024) {
        } else if (idx < 2560) {
            idx -= 1024;
            const int grp = idx >> 9, rem = idx & 511, b = rem >> 5; const size_t rb = (size_t)b * TT;
            if (grp == 1) {
                const int h = (rem >> 3) & 3, qt = rem & 7; const int lo = min(max(8 * qt - 4, 0), 56), n1 = min(max(8 * qt + 3, 0), 56) + 7 - lo + 1;
                if (!att::unit_h<64, 0, VM>(F.lds, P + rb * NPJ + h * 64, NPJ, P + rb * NPJ + 256 + h * 64, NPJ, P + rb * NPJ + 512 + h * 64, NPJ, O + rb * D + h * 64, 0, qt, lo, n1, n1 + 4, 0.125f * LOG2E, 0.f, 0.f, false, bias + h * 465, t32, flag)) { __syncthreads();
                att::unit2<64, 0, VM>(F.lds, P + rb * NPJ + h * 64, NPJ, P + rb * NPJ + 256 + h * 64, NPJ, P + rb * NPJ + 512 + h * 64, NPJ, O + rb * D + h * 64, 0, qt, lo, n1, n1 + 4,
                                  0.125f * LOG2E, 0.f, 0.f, false, bias + h * 465, t32); }
            } else {
                const int g = (rem >> 4) & 1, qt = rem & 15; const bool isc = grp == 2;
                const int lo = isc ? max(4 * qt - 2, 0) : 0, n1 = isc ? min(4 * qt + 5, 63) - lo + 1 : 64;
                const int qc = (isc ? 1280 : 768) + g * 128, kc = (isc ? 1536 : 1024) + g * 64, vc = (isc ? 1664 : 1152) + g * 64;
                const float sk0 = isc ? sinks[2 * g] * LOG2E : 0.f, sk1 = isc ? sinks[2 * g + 1] * LOG2E : 0.f;
                if (!att::unit_h<64, 1, VM>(F.lds, P + rb * NPJ + qc, NPJ, P + rb * NPJ + kc, NPJ, P + rb * NPJ + vc, NPJ, O + rb * D + (isc ? 512 : 256) + g * 128, isc ? 2 : 1, qt, lo, n1, n1 + 4, 0.125f * LOG2E, sk0, sk1, isc, bias, t32, flag)) { __syncthreads();
                att::unit2<64, 1, VM>(F.lds, P + rb * NPJ + qc, NPJ, P + rb * NPJ + kc, NPJ, P + rb * NPJ + vc, NPJ, O + rb * D + (isc ? 512 : 256) + g * 128, isc ? 2 : 1, qt, lo, n1, n1 + 4,
                                  0.125f * LOG2E, isc ? sinks[2 * g] * LOG2E : 0.f, isc ? sinks[2 * g + 1] * LOG2E : 0.f, isc, bias, t32); }
            }
        } else if (idx < 2624) {
            const int rem = idx - 2560, b = rem >> 2, isc = (rem >> 1) & 1, g = rem & 1; const size_t rb = (size_t)b * TT;
            const int qc = (isc ? 1280 : 768) + g * 128, kc = (isc ? 1536 : 1024) + g * 64, vc = (isc ? 1664 : 1152) + g * 64;
            att::unit2<64, 1, VM>(F.lds, P + rb * NPJ + qc, NPJ, P + rb * NPJ + kc, NPJ, P + rb * NPJ + vc, NPJ, O + rb * D + (isc ? 512 : 256) + g * 128, isc ? 2 : 1, 16, 0, 0, 4,
                              0.125f * LOG2E, isc ? sinks[2 * g] * LOG2E : 0.f, isc ? sinks[2 * g + 1] * LOG2E : 0.f, isc != 0, bias, t32);
        } else {
            const int rem = idx - 2624, b = rem >> 3, isd = (rem >> 2) & 1, h = rem & 3; const size_t rb = (size_t)b * TT;
            if (isd) att::unit<96, VM>(F.lds, QD + rb * 384 + h * 96, 384, KD + rb * 384 + h * 96, 384, VD + rb * 256 + h * 64, 256, O + rb * D + 768 + h * 64, 3, 16, 0, 0, 4, 0.10206207261596575f * LOG2E, 0.f, false, bias, t32, nullptr);
            else att::unit<64, VM>(F.lds, P + rb * NPJ + h * 64, NPJ, P + rb * NPJ + 256 + h * 64, NPJ, P + rb * NPJ + 512 + h * 64, NPJ, O + rb * D + h * 64, 0, 16, 0, 0, 4, 0.125f * LOG2E, 0.f, false, bias + h * 465, nullptr, nullptr);
        }
    }
    }
}


#define PHASE_FN static __device__ __forceinline__ void
PHASE_FN ph_prologue(GAS unsigned char* ws) { const Frame F = make_frame(ws); phase_prologue(F); }
PHASE_FN ph_ln(GAS unsigned char* ws, int l) { const Frame F = make_frame(ws); phase_ln(F, l); }
PHASE_FN ph_gemm_in(GAS unsigned char* ws, int l) {
    const Frame F = make_frame(ws);
    pg8::Gemm g{(const bf16*)(F.ws + WS_HA), (const bf16*)(F.ws + WS_WIN), M, NPJ, D, D, nullptr}; pg8::StaticOrder S; S.init(M, NPJ, F.G, F.bid);
    pg8::EpiBf16NT<0> E{(bf16*)(F.ws + WS_PB), NPJ, nullptr, 0, 0, 1.f};
    pg8::gemm_phase<pg8::EpiBf16NT<0>, pg8::StaticOrder, true, true>(F.lds, g, S, E);
}
PHASE_FN ph_post(GAS unsigned char* ws, int l) { const Frame F = make_frame(ws); phase_post(F, l); }
PHASE_FN ph_gemm_mla(GAS unsigned char* ws, int l) {
    const Frame F = make_frame(ws);
    pg8::Gemm g{(const bf16*)(F.ws + WS_PB) + 1792, (const bf16*)(F.ws + WS_WD), M, 1024, 384, NPJ, nullptr}; pg8::StaticOrder S; S.init(M, 1024, F.G, F.bid);
    EpiMla E{(bf16*)(F.ws + WS_QD), (bf16*)(F.ws + WS_KD), (bf16*)(F.ws + WS_VD)};
    pg8::gemm_phase<EpiMla, pg8::StaticOrder, true, true>(F.lds, g, S, E);
}
template <int VM>
PHASE_FN ph_attn(GAS unsigned char* ws, int l) { const Frame F = make_frame(ws); phase_attn<VM>(F, l); }
PHASE_FN ph_gemm_out(GAS unsigned char* ws, int l) {
    const Frame F = make_frame(ws);
    pg8::Gemm g{(const bf16*)(F.ws + WS_HA), (const bf16*)(F.ws + WS_WOUT), M, D, D, D, nullptr};
    pg8::EpiBf16NT<0> E{(bf16*)(F.ws + WS_PB), D, nullptr, 0, 0, 1.f};
    if (l == NL - 1) { LatOrder S{F.G, F.bid}; pg8::gemm_phase<pg8::EpiBf16NT<0>, LatOrder, true, true>(F.lds, g, S, E); }
    else { pg8::StaticOrder S; S.init(M, D, F.G, F.bid); pg8::gemm_phase<pg8::EpiBf16NT<0>, pg8::StaticOrder, true, true>(F.lds, g, S, E); }
}
PHASE_FN ph_route(GAS unsigned char* ws, int l) { const Frame F = make_frame(ws); phase_route(F, l); }
PHASE_FN ph_permute(GAS unsigned char* ws, int l) { const Frame F = make_frame(ws); phase_permute(F, l); }
PHASE_FN ph_gemm_gu(GAS unsigned char* ws, int l) {
    const Frame F = make_frame(ws);
    moe_tables(F);
    pg8::Gemm g{(const bf16*)(F.ws + WS_HA), (const bf16*)(F.ws + WS_WGU), MS, 16384, D, D, (const int*)(F.ws + WS_QD)}; MoeOrder S{F.MISC + MI_PST, F.G, F.bid};
    EpiGU E{(bf16*)(F.ws + WS_ACT)};
    pg8::gemm_phase<EpiGU, MoeOrder, true, true, true>(F.lds, g, S, E);
}
PHASE_FN ph_gemm_dn(GAS unsigned char* ws, int l) {
    const Frame F = make_frame(ws);
    moe_tables(F);
    pg8::Gemm g{(const bf16*)(F.ws + WS_ACT), (const bf16*)(F.ws + WS_WDN), MS, 16384, 512, 512, nullptr}; MoeOrder S{F.MISC + MI_PST, F.G, F.bid};
    pg8::EpiBf16NT<0> E{(bf16*)(F.ws + WS_PB), D, nullptr, 1024, 0, 1.f};
    pg8::gemm_phase<pg8::EpiBf16NT<0>, MoeOrder, true, true>(F.lds, g, S, E);
}


#if MK_DEBUG
#ifndef DBG_MODE
#define DBG_MODE 0
#endif
__device__ __forceinline__ float oracle_attn(const Frame& F, int l, int r, int var, int h, int mode = 0) {
    const bf16* P = (const bf16*)(F.ws + WS_PB); const bf16* QD = (const bf16*)(F.ws + WS_QD); const bf16* KD = (const bf16*)(F.ws + WS_KD); const bf16* VD = (const bf16*)(F.ws + WS_VD);
    const bf16* O = (const bf16*)(F.ws + WS_HA); const float* t32 = (const float*)(F.ws + WS_T32);
    const int b = r / TT, t = r - b * TT; const bool lat = t < SEQ; const size_t rb = (size_t)b * TT;
    const int dk = var == 3 ? 96 : 64;
    const bf16* qp; const bf16* kp; const bf16* vp; int kpitch, vpitch;
    if (var == 3) { qp = QD + (size_t)r * 384 + h * 96; kp = KD + rb * 384 + h * 96; kpitch = 384; vp = VD + rb * 256 + h * 64; vpitch = 256; }
    else { const int qc = var == 0 ? h * 64 : var == 1 ? 768 + h * 64 : 1280 + h * 64, kc = var == 0 ? 256 + h * 64 : var == 1 ? 1024 + (h >> 1) * 64 : 1536 + (h >> 1) * 64,
           vc = var == 0 ? 512 + h * 64 : var == 1 ? 1152 + (h >> 1) * 64 : 1664 + (h >> 1) * 64;
           qp = P + (size_t)r * NPJ + qc; kp = P + rb * NPJ + kc; kpitch = NPJ; vp = P + rb * NPJ + vc; vpitch = NPJ; }
    LAS float* qs = (LAS float*)(F.lds + 65536) + F.wave * 128;
    for (int d = F.lane; d < dk; d += 64) qs[d] = __builtin_bit_cast(float, (unsigned)qp[d] << 16);
    asm volatile("s_waitcnt lgkmcnt(0)" ::: "memory");
    if (var == 3 && lat && F.lane < 32) {
        const int c = F.lane >> 3, e = F.lane & 7, gr = t >> 6, gc = t & 63; const float own = qs[64 + F.lane], par = qs[64 + (F.lane ^ 8)];
        const float cs = t32[((c < 2 ? gr : gc) * 8 + e) * 2], sn = t32[((c < 2 ? gr : gc) * 8 + e) * 2 + 1];
        const float nv = (c & 1) == 0 ? own * cs - par * sn : par * sn + own * cs;
        asm volatile("s_waitcnt lgkmcnt(0)" ::: "memory"); qs[64 + F.lane] = nv; }
    asm volatile("s_waitcnt lgkmcnt(0)" ::: "memory");
    const float scale = var == 3 ? 0.10206207261596575f : 0.125f;
    const int gr = t >> 6, gc = t & 63, r0 = min(max(gr - 4, 0), 56), c0 = min(max(gc - 8, 0), 48);
    float m = -3.0e38f, lsum = 0.f, acc[64];
#pragma unroll
    for (int d = 0; d < 64; ++d) acc[d] = 0.f;
    for (int j = F.lane; j < TT; j += 64) {
        bool ok = true; float bias = 0.f;
        if (!lat) ok = j >= SEQ;
        else if (j < SEQ) {
            if (var == 0) { const int kr = j >> 6, kc2 = j & 63; ok = kr >= r0 && kr <= r0 + 7 && kc2 >= c0 && kc2 <= c0 + 15;
                if (ok) bias = INP(I_NABIAS)[((l * 4 + h) * 15 + (kr - gr + 7)) * 31 + (kc2 - gc + 15)]; }
            else if (var == 2) ok = (j - t <= 128) && (t - j <= 128);
        }
        if (!ok) continue;
        float sc = 0.f; const bf16* kr_ = kp + (size_t)j * kpitch;
        for (int d = 0; d < dk; ++d) sc += qs[d] * __builtin_bit_cast(float, (unsigned)kr_[d] << 16);
        sc = sc * scale + bias;
        const float mn = fmaxf(m, sc), a = expf(m - mn), p = expf(sc - mn); m = mn; lsum = lsum * a + p;
        const bf16* vr = vp + (size_t)j * vpitch;
#pragma unroll
        for (int d = 0; d < 64; ++d) acc[d] = acc[d] * a + p * __builtin_bit_cast(float, (unsigned)vr[d] << 16);
    }
    float mg = m;
#pragma unroll
    for (int o = 1; o < 64; o <<= 1) mg = fmaxf(mg, __shfl_xor(mg, o));
    if (mode >= 1) {
        const unsigned* rec = (const unsigned*)(F.ws + WS_RS) + (size_t)r * 2; const float mk = __builtin_bit_cast(float, rec[0]), lk = __builtin_bit_cast(float, rec[1]);
        const float lref = wave_sum(lsum * expf(m - mg));
        const float lker = lk * exp2f(mk - mg * LOG2E);
        if (mode == 2) return fabsf(mk / LOG2E - mg);
        return fabsf(lker / lref - 1.0f);
    }
    const float f = expf(m - mg); lsum *= f; lsum = wave_sum(lsum);
    if (var == 2) lsum += expf(INP(I_SINK)[l * 4 + h] - mg);
    float err = 0.f, mag = 1.0e-6f;
    const bf16* orow = O + (size_t)r * D + var * 256 + h * 64;
#pragma unroll
    for (int d = 0; d < 64; ++d) { const float ref = wave_sum(acc[d] * f) / lsum; const float got = __builtin_bit_cast(float, (unsigned)orow[d] << 16);
        const float df = fabsf(got - ref); err = (df == df) ? fmaxf(err, df) : 1.0e30f; mag = fmaxf(mag, fabsf(ref)); }
    return err / mag;
}
__device__ __forceinline__ void phase_dump(const Frame& F, int code) {
    float* out = (float*)ptab_get(F, I_OUT);
    for (int r = F.gw; r < M; r += F.ngw) {
        const int b = r / TT, t = r - b * TT; if (t >= SEQ) continue;
        float v[16];
        if (code == 1) ld16bf((const bf16*)(F.ws + WS_HA) + (size_t)r * D, F.lane, v);
        else if (code == 2) ld16bf((const bf16*)(F.ws + WS_PB) + (size_t)r * NPJ, F.lane, v);
        else if (code == 3) ld16bf((const bf16*)(F.ws + WS_PB) + (size_t)r * NPJ + 1024, F.lane, v);
        else if (code == 4) ld16bf((const bf16*)(F.ws + WS_PB) + (size_t)r * NPJ + 1280, F.lane, v);
        else if (code == 5) ld16((const float*)(F.ws + WS_PB) + (size_t)r * D, F.lane, v);
        else if (code == 8) {
            const v4u w0 = *((const v4u*)((const bf16*)(F.ws + WS_HA) + (size_t)r * D) + F.lane), w1 = *((const v4u*)((const bf16*)(F.ws + WS_HA) + (size_t)r * D) + 64 + F.lane);
            float f[8]; int bad0 = 0, bad1 = 0; unpack8(w0, f);
#pragma unroll
            for (int i = 0; i < 8; ++i) { const unsigned u = __builtin_bit_cast(unsigned, f[i]); bad0 |= ((u & 0x7f800000u) == 0x7f800000u) ? 1 : 0; }
            unpack8(w1, f);
#pragma unroll
            for (int i = 0; i < 8; ++i) { const unsigned u = __builtin_bit_cast(unsigned, f[i]); bad1 |= ((u & 0x7f800000u) == 0x7f800000u) ? 1 : 0; }
            const unsigned long long m0 = __ballot(bad0), m1 = __ballot(bad1);
            const bool vA = (m0 & 0xffffffffull) != 0, vB = (m0 >> 32) != 0, vC = (m1 & 0xffffffffull) != 0, vD = (m1 >> 32) != 0;
            const float val = (float)(t + 1) * ((vA ? 1.0f : 0.f) + (vB ? 1.0e2f : 0.f) + (vC ? 1.0e4f : 0.f) + (vD ? 1.0e6f : 0.f));
#pragma unroll
            for (int i = 0; i < 16; ++i) v[i] = val;
        }
        else if (code == 9) { const unsigned cd = ((const unsigned*)(F.ws + WS_RS))[(size_t)r * 2]; float val = 0.f; if (cd) { val = 1.f; for (unsigned k = 0; k < cd; ++k) val *= 10.f; }
#pragma unroll
            for (int i = 0; i < 16; ++i) v[i] = val; }
        else if (code == 10) {
            const v4u w1 = *((const v4u*)((const bf16*)(F.ws + WS_HA) + (size_t)r * D) + 64 + F.lane);
            float f[8]; int bad1 = 0; unpack8(w1, f);
#pragma unroll
            for (int i = 0; i < 8; ++i) { const unsigned u = __builtin_bit_cast(unsigned, f[i]); bad1 |= ((u & 0x7f800000u) == 0x7f800000u) ? 1 : 0; }
            const bool vC = (__ballot(bad1) & 0xffffffffull) != 0;
            const bf16* pc = (const bf16*)(F.ws + WS_PB) + ((size_t)b * TT + SEQ + (t & 255)) * NPJ; int badp = 0;
            for (int c = F.lane; c < 288; c += 64) { const v4u w = *((const v4u*)pc + c); unpack8(w, f);
#pragma unroll
                for (int i = 0; i < 8; ++i) { const unsigned u = __builtin_bit_cast(unsigned, f[i]); badp |= ((u & 0x7f800000u) == 0x7f800000u) ? 1 : 0; } }
            float val = 0.f; if (vC) { val = 1.f; for (int k = 0; k <= (t & 15); ++k) val *= 10.f; }
            if (__any(badp)) val = 1.0e30f;
#pragma unroll
            for (int i = 0; i < 16; ++i) v[i] = val;
        }
        else if (code == 11) {
            const bf16* pr = (const bf16*)(F.ws + WS_PB) + (size_t)r * NPJ; int grp = -1;
            for (int c = F.lane; c < 288; c += 64) { const v4u w = *((const v4u*)pr + c); float f[8]; unpack8(w, f);
#pragma unroll
                for (int i = 0; i < 8; ++i) if (!(fabsf(f[i]) < 1.0e4f)) grp = (c * 8) >> 8; }
#pragma unroll
            for (int o = 1; o < 64; o <<= 1) { const int g2 = __shfl_xor(grp, o); grp = g2 > grp ? g2 : grp; }
            float val = 0.f; if (grp >= 0) { val = 100.f; for (int k = 0; k < grp; ++k) val *= 10.f; }
#pragma unroll
            for (int i = 0; i < 16; ++i) v[i] = val;
        }
        else if (code >= 20 && code < 24) {
            float val = 0.f;
            if ((t & 15) == 5) { for (int h = 0; h < 4; ++h) { const float e = oracle_attn(F, 0, r, code - 20, h); const float cls = e > 1.0e20f ? 3.f : e > 0.5f ? 2.f : e > 0.03f ? 1.f : 0.f; if (cls > 0.f) { float w = cls; for (int k = 0; k <= h; ++k) w *= 10.f; val = fmaxf(val, w); } } }
#pragma unroll
            for (int i = 0; i < 16; ++i) v[i] = val;
        }
        else if (code >= 30 && code < 46) {
            float val = 0.f;
            if ((t & 15) == 5) { const float e = oracle_attn(F, 0, r, (code - 30) >> 2, (code - 30) & 3, DBG_MODE); val = e > 10.f ? 1.0e4f : 1000.f * e; }
#pragma unroll
            for (int i = 0; i < 16; ++i) v[i] = val;
        }
        else if (code == 7) {
            auto bad16 = [&](const bf16* p, int nchunks) { int bad = 0; for (int c = F.lane; c < nchunks; c += 64) { const v4u w = *((const v4u*)p + c); float f[8]; unpack8(w, f);
#pragma unroll
                for (int i = 0; i < 8; ++i) { const unsigned u = __builtin_bit_cast(unsigned, f[i]); bad |= ((u & 0x7f800000u) == 0x7f800000u) ? 1 : 0; } } return __any(bad); };
            const int bP = bad16((const bf16*)(F.ws + WS_PB) + (size_t)r * NPJ, 288), bQ = bad16((const bf16*)(F.ws + WS_QD) + (size_t)r * 384, 48),
                      bK = bad16((const bf16*)(F.ws + WS_KD) + (size_t)r * 384, 48), bV = bad16((const bf16*)(F.ws + WS_VD) + (size_t)r * 256, 32), bO = bad16((const bf16*)(F.ws + WS_HA) + (size_t)r * D, 128);
            const float val = bP ? 1.0e6f : bQ ? 1.0e5f : bK ? 1.0e4f : bV ? 1.0e3f : bO ? 1.0e2f : 0.f;
#pragma unroll
            for (int i = 0; i < 16; ++i) v[i] = val;
        }
#pragma unroll
        for (int i = 0; i < 16; ++i) { const unsigned u = __builtin_bit_cast(unsigned, v[i]); if ((u & 0x7f800000u) == 0x7f800000u) v[i] = 777.0f; }
        st16(out + ((size_t)b * SEQ + t) * D, F.lane, v);
    }
}
static __device__ __forceinline__ void ph_dump(GAS unsigned char* ws, int code) { const Frame F = make_frame(ws); phase_dump(F, code); }
#endif
__global__ void __launch_bounds__(NTHR, 2) mk_fwd(Args args) {
    extern __shared__ __attribute__((aligned(16))) unsigned char lds_raw[];
    LAS unsigned char* lds = (LAS unsigned char*)lds_raw; volatile LAS unsigned* MISC = (volatile LAS unsigned*)(lds + MISC_OFF);
    const int tid = threadIdx.x;
    GAS unsigned char* ws = (GAS unsigned char*)args.ws;
    for (int u = tid; u < (LDS_BYTES - MISC_OFF) / 4; u += NTHR) MISC[u] = 0u;
    __syncthreads();
    if (tid < 28) { const unsigned long long p = tid < 27 ? (unsigned long long)args.in[tid] : (unsigned long long)args.out;
        LAS unsigned* t = (LAS unsigned*)(lds + PTAB_OFF) + 2 * tid; t[0] = (unsigned)p; t[1] = (unsigned)(p >> 32); }
    __syncthreads();
#if MK_MULTI
#define GRID_BAR() do { } while (0)
#else
    XcdBarrier bar = xcd_barrier_post((unsigned*)(ws + WS_CTL) + CW_BAR, MISC + MI_BAR);
#define GRID_BAR() xcd_barrier(bar)
#endif
    const int lo = args.ph_lo, hi = args.ph_hi;
#define IN(k) (lo <= (k) && (k) < hi)
#if MK_TIME
    unsigned long long tcat = 0ull, tb0 = 0ull;
#define TBEG() do { tb0 = __builtin_amdgcn_s_memrealtime(); } while (0)
#define TEND(c) do { if ((c) == MK_TIME - 1) tcat += __builtin_amdgcn_s_memrealtime() - tb0; } while (0)
#define SEAM(k) do { if (IN(k) && IN((k) + 1)) { TBEG(); GRID_BAR(); TEND(1); } } while (0)
#else
#define TBEG() do { } while (0)
#define TEND(c) do { } while (0)
#define SEAM(k) do { if (IN(k) && IN((k) + 1)) GRID_BAR(); } while (0)
#endif

#if MK_DEBUG
    if (lo >= 100) { ph_dump(ws, lo - 100); return; }
#endif
    if (IN(0)) { TBEG(); ph_prologue(ws); TEND(2); } SEAM(0);
    for (int l = 0; l < NL; ++l) {
        const int pb = 1 + 10 * l;
        if (IN(pb + 0)) { TBEG(); ph_ln(ws, l); TEND(0); } SEAM(pb + 0);
        if (IN(pb + 1)) { TBEG(); ph_gemm_in(ws, l); if (MK_DUP & 2) { GRID_BAR(); ph_gemm_in(ws, l); } TEND(3); } SEAM(pb + 1);
        if (IN(pb + 2)) { TBEG(); ph_post(ws, l); TEND(0); } SEAM(pb + 2);
        if (IN(pb + 3)) { TBEG(); ph_gemm_mla(ws, l); if (MK_DUP & 8) { GRID_BAR(); ph_gemm_mla(ws, l); } TEND(3); } SEAM(pb + 3);
        if (IN(pb + 4)) { TBEG(); ph_attn<0>(ws, l); if (MK_DUP & 16) { GRID_BAR(); ph_attn<MK_VM>(ws, l + 4); } TEND(4); } SEAM(pb + 4);
        if (IN(pb + 5)) { TBEG(); ph_gemm_out(ws, l); if (MK_DUP & 32) { GRID_BAR(); ph_gemm_out(ws, l); } TEND(3); } SEAM(pb + 5);
        if (IN(pb + 6)) { TBEG(); ph_route(ws, l); TEND(0); } SEAM(pb + 6);
        if (IN(pb + 7)) { TBEG(); ph_permute(ws, l); if (MK_DUP & 128) { GRID_BAR(); ph_permute(ws, l); } TEND(0); } SEAM(pb + 7);
        if (IN(pb + 8)) { TBEG(); ph_gemm_gu(ws, l); if (MK_DUP & 256) { GRID_BAR(); ph_gemm_gu(ws, l); } TEND(3); } SEAM(pb + 8);
        if (IN(pb + 9)) { TBEG(); ph_gemm_dn(ws, l); if (MK_DUP & 512) { GRID_BAR(); ph_gemm_dn(ws, l); } TEND(3); } SEAM(pb + 9);
    }
    if (IN(NPHASE - 1)) { TBEG(); ph_ln(ws, NL); TEND(0); }
#if MK_TIME
    if (blockIdx.x == 0) { const unsigned long long tw = __builtin_amdgcn_s_memrealtime(); const unsigned long long dl = tcat * (unsigned long long)MK_TMUL; while (__builtin_amdgcn_s_memrealtime() - tw < dl) __builtin_amdgcn_s_sleep(8); }
#endif
#undef IN
#undef SEAM
#undef GRID_BAR
}

extern "C" void kernel_launch(void* const* d_in, const int* in_sizes, int n_in, void* d_out, int out_size, void* d_ws, size_t ws_size, hipStream_t stream) {
    static int grid = 0;
    if (grid == 0) {
        if (n_in != 27 || out_size != NB * SEQ * D || ws_size < WS_END) { fprintf(stderr, "kernel_launch: unexpected problem (n_in %d, out %d, ws %zu < %zu)\n", n_in, out_size, ws_size, (size_t)WS_END); grid = -1; return; }
        int dev = 0, cus = 0, per_cu = 0;
        if (hipGetDevice(&dev) != hipSuccess || hipDeviceGetAttribute(&cus, hipDeviceAttributeMultiprocessorCount, dev) != hipSuccess) { grid = -1; return; }
        if (hipFuncSetAttribute((const void*)mk_fwd, hipFuncAttributeMaxDynamicSharedMemorySize, LDS_BYTES) != hipSuccess) { fprintf(stderr, "kernel_launch: hipFuncSetAttribute failed\n"); grid = -1; return; }
        if (hipOccupancyMaxActiveBlocksPerMultiprocessor(&per_cu, (const void*)mk_fwd, NTHR, LDS_BYTES) != hipSuccess || per_cu < 1) fprintf(stderr, "kernel_launch: occupancy query reports %d\n", per_cu);
        (void)hipGetLastError();
        grid = cus > 1024 ? 1024 : cus;
    }
    if (grid < 0) return;
    (void)hipMemsetAsync((char*)d_ws + WS_CTL, 0, CTL_BYTES, stream);
    Args a{};
    for (int i = 0; i < 27; ++i) a.in[i] = (const float*)d_in[i];
    a.out = (float*)d_out; a.ws = (unsigned char*)d_ws;
#if MK_MULTI
#ifndef DBG_NRUN
#define DBG_NRUN NPHASE
#endif
    for (int p = 0; p < DBG_NRUN; ++p) { a.ph_lo = p; a.ph_hi = p + 1; hipLaunchKernelGGL(mk_fwd, dim3(grid), dim3(NTHR), LDS_BYTES, stream, a); }
#ifdef DBG_DUMP
    a.ph_lo = 100 + DBG_DUMP; a.ph_hi = 101 + DBG_DUMP; hipLaunchKernelGGL(mk_fwd, dim3(grid), dim3(NTHR), LDS_BYTES, stream, a);
#endif
#else
    a.ph_lo = 0; a.ph_hi = NPHASE;
    hipLaunchKernelGGL(mk_fwd, dim3(grid), dim3(NTHR), LDS_BYTES, stream, a);
#endif
}
```

```cpp
#include <hip/hip_runtime.h>
#include <cstdio>
#include <cstdint>
namespace pg8 {
#define PG8_LAS __attribute__((address_space(3)))
typedef unsigned short bf16_t;
typedef short bf16x8 __attribute__((ext_vector_type(8)));
typedef float f32x4 __attribute__((ext_vector_type(4)));
typedef unsigned u32x4 __attribute__((ext_vector_type(4)));
constexpr int BM = 256, BK = 64, HALF = 128, HTB = HALF * BK * 2  , STAGE_BYTES = 8 * HTB, NXCD = 8, WGM = 8;

__host__ __device__ __forceinline__ int lds_byte(int r, int c) { const int st = (r >> 4) * 2 + (c >> 5), rr = r & 15, cc = c & 31, ob = rr * 64 + cc * 2; return st * 1024 + (ob ^ (((ob >> 9) & 1) << 5)); }
__host__ __device__ __forceinline__ void stage_rc(int b, int& R, int& C) { const int st = b / 1024, sb = b % 1024, swz = sb ^ (((sb >> 9) & 1) << 5); R = (st >> 1) * 16 + swz / 64; C = (st & 1) * 32 + (swz % 64) / 2; }
__host__ __device__ __forceinline__ int perm32(int rho) { const int n = rho >> 4, i = rho & 15; return 8 * (i >> 2) + 4 * n + (i & 3); }

struct Unit { int pm, pn; };
struct Gemm { const bf16_t* A; const bf16_t* Bt; int M, N, K, lda; const int* src; };

struct StaticOrder {
    int nM, nN, nwg, G, c;
    __host__ __device__ void init(int M, int N, int G_, int c_) { nM = M / BM; nN = N / BM; nwg = nM * nN; G = G_; c = c_; }
    __host__ __device__ bool next(int i, Unit& u) const {
        const long L = (long)i * G + c; if (L >= nwg) return false;
        int wgid = (int)L; { const int q = nwg / NXCD, r = nwg % NXCD, xcd = wgid % NXCD, off = wgid / NXCD; wgid = (xcd < r ? xcd * (q + 1) : r * (q + 1) + (xcd - r) * q) + off; }
        const int nig = WGM * nN, gid = wgid / nig, fm = gid * WGM, gsz = (nM - fm) < WGM ? (nM - fm) : WGM;
        u.pm = fm + ((wgid % nig) % gsz); u.pn = (wgid % nig) / gsz; return true;
    }
    __device__ __forceinline__ void a_ready(const Unit&) const {}
    __device__ __forceinline__ void done(const Unit&) const {}
};

__device__ __forceinline__ unsigned cvt_pk_bf16(float lo, float hi) { unsigned r; asm volatile("v_cvt_pk_bf16_f32 %0, %1, %2" : "=v"(r) : "v"(lo), "v"(hi)); return r; }
typedef float f32x2 __attribute__((ext_vector_type(2)));
__device__ __forceinline__ f32x2 gelu_pk(f32x2 v) {
    const f32x2 av = __builtin_elementwise_abs(v), d = av * 0.2316418882f + 1.0f;
    f32x2 t; t.x = __builtin_amdgcn_rcpf(d.x); t.y = __builtin_amdgcn_rcpf(d.y);
    f32x2 q = t * 0.5307027145f + (-0.7265760135f); q = q * t + 0.7107068705f; q = q * t + (-0.142248368f); q = q * t + 0.127414796f; q = q * t;
    const f32x2 s = (v * v) * (-0.72134752044f);
    f32x2 e; e.x = __builtin_amdgcn_exp2f(s.x); e.y = __builtin_amdgcn_exp2f(s.y);
    const f32x2 m = v * (q * e), r = v - m;
    f32x2 o; o.x = v.x < 0.f ? m.x : r.x; o.y = v.y < 0.f ? m.y : r.y; return o;
}

template <int ACT  > struct EpiBf16 {
    static constexpr bool PERM = true, AFTER_DRAIN = false; static_assert(ACT == 0 || ACT == 1, "EpiBf16: ACT is 0 (none) or 1 (gelu_pk)");
    bf16_t* O; int ldc; const float* bias; int split_cols; size_t split_stride; float scale0;
    __device__ __forceinline__ void operator()(const f32x4 (&acc)[2][2][4][2], const Unit& u, int wr, int wc, int fr, int fq) const {
        const int row0 = u.pm * BM + wr * 64 + fr; int colt = u.pn * BM; bf16_t* base = O;
        float sc = 1.f; if (split_cols) { const int t = colt / split_cols; base += (size_t)t * split_stride; colt -= t * split_cols; if (t == 0) sc = scale0; }
        const int col0 = colt + wc * 32 + 8 * fq, bcol0 = u.pn * BM + wc * 32 + 8 * fq;
        f32x4 bv[2][2];
#pragma unroll
        for (int bj = 0; bj < 2; ++bj)
#pragma unroll
            for (int n = 0; n < 2; ++n) bv[bj][n] = bias ? *(const f32x4*)(bias + bcol0 + bj * HALF + 4 * n) : (f32x4){0.f, 0.f, 0.f, 0.f};
#pragma unroll
        for (int ai = 0; ai < 2; ++ai)
#pragma unroll
            for (int m = 0; m < 4; ++m) { bf16_t* rowp = base + (size_t)(row0 + ai * HALF + m * 16) * ldc + col0;
#pragma unroll
                for (int bj = 0; bj < 2; ++bj) { f32x4 v0 = acc[ai][bj][m][0] + bv[bj][0], v1 = acc[ai][bj][m][1] + bv[bj][1];
                    if (ACT == 1) { f32x2 a = gelu_pk((f32x2){v0[0], v0[1]}), b = gelu_pk((f32x2){v0[2], v0[3]}), c = gelu_pk((f32x2){v1[0], v1[1]}), d = gelu_pk((f32x2){v1[2], v1[3]});
                        v0 = (f32x4){a.x, a.y, b.x, b.y}; v1 = (f32x4){c.x, c.y, d.x, d.y}; }
                    v0 = v0 * sc; v1 = v1 * sc; u32x4 w; w.x = cvt_pk_bf16(v0[0], v0[1]); w.y = cvt_pk_bf16(v0[2], v0[3]); w.z = cvt_pk_bf16(v1[0], v1[1]); w.w = cvt_pk_bf16(v1[2], v1[3]);
                    *(u32x4*)(rowp + bj * HALF) = w; } }
    }
};
template <int ACT  > struct EpiBf16NT {
    static constexpr bool PERM = true, AFTER_DRAIN = false; static_assert(ACT == 0 || ACT == 1, "EpiBf16: ACT is 0 (none) or 1 (gelu_pk)");
    bf16_t* O; int ldc; const float* bias; int split_cols; size_t split_stride; float scale0;
    __device__ __forceinline__ void operator()(const f32x4 (&acc)[2][2][4][2], const Unit& u, int wr, int wc, int fr, int fq) const {
        const int row0 = u.pm * BM + wr * 64 + fr; int colt = u.pn * BM; bf16_t* base = O;
        float sc = 1.f; if (split_cols) { const int t = colt / split_cols; base += (size_t)t * split_stride; colt -= t * split_cols; if (t == 0) sc = scale0; }
        const int col0 = colt + wc * 32 + 8 * fq, bcol0 = u.pn * BM + wc * 32 + 8 * fq;
        f32x4 bv[2][2];
#pragma unroll
        for (int bj = 0; bj < 2; ++bj)
#pragma unroll
            for (int n = 0; n < 2; ++n) bv[bj][n] = bias ? *(const f32x4*)(bias + bcol0 + bj * HALF + 4 * n) : (f32x4){0.f, 0.f, 0.f, 0.f};
#pragma unroll
        for (int ai = 0; ai < 2; ++ai)
#pragma unroll
            for (int m = 0; m < 4; ++m) { bf16_t* rowp = base + (size_t)(row0 + ai * HALF + m * 16) * ldc + col0;
#pragma unroll
                for (int bj = 0; bj < 2; ++bj) { f32x4 v0 = acc[ai][bj][m][0] + bv[bj][0], v1 = acc[ai][bj][m][1] + bv[bj][1];
                    if (ACT == 1) { f32x2 a = gelu_pk((f32x2){v0[0], v0[1]}), b = gelu_pk((f32x2){v0[2], v0[3]}), c = gelu_pk((f32x2){v1[0], v1[1]}), d = gelu_pk((f32x2){v1[2], v1[3]});
                        v0 = (f32x4){a.x, a.y, b.x, b.y}; v1 = (f32x4){c.x, c.y, d.x, d.y}; }
                    v0 = v0 * sc; v1 = v1 * sc; u32x4 w; w.x = cvt_pk_bf16(v0[0], v0[1]); w.y = cvt_pk_bf16(v0[2], v0[3]); w.z = cvt_pk_bf16(v1[0], v1[1]); w.w = cvt_pk_bf16(v1[2], v1[3]);
                    __builtin_nontemporal_store(w, (u32x4*)(rowp + bj * HALF)); } }
    }
};
struct EpiF32 {
    static constexpr bool PERM = false, AFTER_DRAIN = false;
    float* C; int ldc; const float* bias;
    __device__ __forceinline__ void operator()(const f32x4 (&acc)[2][2][4][2], const Unit& u, int wr, int wc, int fr, int fq) const {
        const int row0 = u.pm * BM + wr * 64 + fr, col0 = u.pn * BM + wc * 32 + 4 * fq;
        f32x4 bv[2][2];
#pragma unroll
        for (int bj = 0; bj < 2; ++bj)
#pragma unroll
            for (int n = 0; n < 2; ++n) bv[bj][n] = bias ? *(const f32x4*)(bias + col0 + bj * HALF + n * 16) : (f32x4){0.f, 0.f, 0.f, 0.f};
#pragma unroll
        for (int ai = 0; ai < 2; ++ai)
#pragma unroll
            for (int m = 0; m < 4; ++m) { float* rowp = C + (size_t)(row0 + ai * HALF + m * 16) * ldc + col0;
#pragma unroll
                for (int bj = 0; bj < 2; ++bj)
#pragma unroll
                    for (int n = 0; n < 2; ++n) *(f32x4*)(rowp + bj * HALF + n * 16) = acc[ai][bj][m][n] + bv[bj][n]; }
    }
};
template <class Epi, class Sched, bool ALIGN_EPI = false, bool SP2 = false, bool GATHER = false>
__device__ __forceinline__ void gemm_phase(PG8_LAS unsigned char* lds, const Gemm g, const Sched& S, const Epi& E) {
    int tid = threadIdx.x; asm volatile("" : "+v"(tid)); const int wid = __builtin_amdgcn_readfirstlane(tid >> 6), lane = tid & 63, wr = wid >> 2, wc = wid & 3, fr = lane & 15, fq = lane >> 4;
    const int K = g.K, nt = K / BK;
    unsigned voffA[2], voffB[2]; int RA[2]; unsigned CA2[2];
#pragma unroll
    for (int i = 0; i < 2; ++i) { int R, C; stage_rc(tid * 16 + i * 8192, R, C); const int Rb = Epi::PERM ? ((R & ~31) + perm32(R & 31)) : R;
        voffA[i] = (unsigned)(R * g.lda + C) * 2u; voffB[i] = (unsigned)(Rb * K + C) * 2u; RA[i] = R; CA2[i] = (unsigned)C * 2u; }
    unsigned gcur[2][2] = {{0u, 0u}, {0u, 0u}}, gnxt[2][2] = {{0u, 0u}, {0u, 0u}};
#define PG8_GOFF(dst, u_) do { _Pragma("unroll") for (int h_ = 0; h_ < 2; ++h_) _Pragma("unroll") for (int i_ = 0; i_ < 2; ++i_) \
        dst[h_][i_] = (unsigned)g.src[(u_).pm * BM + h_ * HALF + RA[i_]] * (unsigned)(g.lda * 2) + CA2[i_]; } while (0)
#define PG8_STAGE_A(bufoff, gbase, h, nx) do { if constexpr (GATHER) { unsigned vs_[2] = {(nx) ? gnxt[h][0] : gcur[h][0], (nx) ? gnxt[h][1] : gcur[h][1]}; PG8_STAGE(bufoff, gbase, vs_); } \
        else { PG8_STAGE(bufoff, (gbase) + ((h) ? hstepA : 0), voffA); } } while (0)
    const size_t kstep = (size_t)(BK * 2);
    const size_t hstepA = (size_t)HALF * g.lda * 2, hstepB = (size_t)HALF * K * 2;
    const size_t tstepA = 2 * hstepA, tstepB = 2 * hstepB;
    const unsigned ldsw = (unsigned)wid * 1024u;
    const int aoff = lds_byte(wr * 64 + fr, fq * 8), boff = lds_byte(wc * 32 + fr, fq * 8);
#define PG8_SA(b, h) (((b) * 2 + (h)) * HTB)
#define PG8_SB(b, h) ((4 + (b) * 2 + (h)) * HTB)
#define PG8_STAGE(bufoff, gbase, voff) do { _Pragma("unroll") for (int _i = 0; _i < 2; ++_i) \
        __builtin_amdgcn_global_load_lds((const unsigned*)((const char*)(gbase) + (voff)[_i]), (PG8_LAS unsigned*)(lds + (bufoff) + ldsw + _i * 8192), 16, 0, 0); } while (0)
#define PG8_LDA(dst, b, h) do { _Pragma("unroll") for (int m = 0; m < 4; ++m) _Pragma("unroll") for (int k = 0; k < 2; ++k) dst[m][k] = *(const PG8_LAS bf16x8*)(lds + PG8_SA(b, h) + aoff + m * 2048 + k * 1024); } while (0)
#define PG8_LDB(dst, b, h) do { _Pragma("unroll") for (int n = 0; n < 2; ++n) _Pragma("unroll") for (int k = 0; k < 2; ++k) dst[n][k] = *(const PG8_LAS bf16x8*)(lds + PG8_SB(b, h) + boff + n * 2048 + k * 1024); } while (0)
#define PG8_MMA(ai, bj, At, Bt) do { __builtin_amdgcn_s_setprio(1); _Pragma("unroll") for (int m = 0; m < 4; ++m) _Pragma("unroll") for (int n = 0; n < 2; ++n) _Pragma("unroll") for (int k = 0; k < 2; ++k) \
        acc[ai][bj][m][n] = __builtin_amdgcn_mfma_f32_16x16x32_bf16(Bt[n][k], At[m][k], acc[ai][bj][m][n], 0, 0, 0); __builtin_amdgcn_s_setprio(0); } while (0)
#define PG8_WAIT_V(n) asm volatile("s_waitcnt vmcnt(" #n ")" ::: "memory")
#define PG8_WAIT_L(n) asm volatile("s_waitcnt lgkmcnt(" #n ")" ::: "memory")
#define PG8_BAR __builtin_amdgcn_s_barrier()
#define PG8_SCHED __builtin_amdgcn_sched_barrier(0)
    Unit cur, nxt; int ui = 0;
    if (!S.next(0, cur)) return;
    f32x4 acc[2][2][4][2];
#pragma unroll
    for (int a = 0; a < 2; ++a)
#pragma unroll
        for (int b = 0; b < 2; ++b)
#pragma unroll
            for (int m = 0; m < 4; ++m)
#pragma unroll
                for (int n = 0; n < 2; ++n) acc[a][b][m][n] = (f32x4){0.f, 0.f, 0.f, 0.f};
    bf16x8 At[4][2], B0[2][2], B1[2][2];
    const char* cA = (const char*)g.A + (GATHER ? (size_t)0 : (size_t)cur.pm * tstepA); const char* cB = (const char*)g.Bt + (size_t)cur.pn * tstepB;
    if constexpr (GATHER) PG8_GOFF(gcur, cur);
    S.a_ready(cur);
    if constexpr (SP2) {
        PG8_STAGE(PG8_SB(0, 0), cB, voffB); PG8_STAGE(PG8_SB(0, 1), cB + hstepB, voffB); PG8_STAGE_A(PG8_SA(0, 0), cA, 0, false); PG8_STAGE_A(PG8_SA(0, 1), cA, 1, false);
        if (wr == 1) PG8_BAR;
        PG8_WAIT_V(2); PG8_BAR;
        PG8_STAGE(PG8_SB(1, 0), cB + kstep, voffB); PG8_STAGE_A(PG8_SA(1, 0), cA + kstep, 0, false); PG8_STAGE(PG8_SB(1, 1), cB + hstepB + kstep, voffB);
        PG8_WAIT_V(6); PG8_BAR;
    } else {
        PG8_STAGE(PG8_SB(0, 0), cB, voffB); PG8_STAGE_A(PG8_SA(0, 0), cA, 0, false); PG8_STAGE(PG8_SB(0, 1), cB + hstepB, voffB); PG8_STAGE_A(PG8_SA(0, 1), cA, 1, false);
        if (wr == 1) PG8_BAR;
        PG8_WAIT_V(4); PG8_BAR;
        PG8_STAGE(PG8_SB(1, 0), cB + kstep, voffB); PG8_STAGE_A(PG8_SA(1, 0), cA + kstep, 0, false); PG8_STAGE(PG8_SB(1, 1), cB + hstepB + kstep, voffB);
        PG8_WAIT_V(6); PG8_BAR;
    }
    for (;;) {
        const bool has_next = S.next(ui + 1, nxt);
        const char* nA = (has_next && !GATHER) ? (const char*)g.A + (size_t)nxt.pm * tstepA : cA; const char* nB = has_next ? (const char*)g.Bt + (size_t)nxt.pn * tstepB : cB;
        if constexpr (GATHER) { if (has_next) PG8_GOFF(gnxt, nxt); else { _Pragma("unroll") for (int h_ = 0; h_ < 2; ++h_) { gnxt[h_][0] = gcur[h_][0]; gnxt[h_][1] = gcur[h_][1]; } } }
#pragma unroll 1
        for (int t = 0; t < nt; t += 2) {
            const bool last = (t == nt - 2);
            const char* a1 = cA + (size_t)(t + 1) * kstep;
            const char* a2 = last ? nA : cA + (size_t)(t + 2) * kstep; const char* b2 = last ? nB : cB + (size_t)(t + 2) * kstep;
            const char* a3 = a2 + kstep; const char* b3 = b2 + kstep;
            if (last && has_next) S.a_ready(nxt);
            if constexpr (SP2) {
            PG8_LDB(B0, 0, 0); PG8_LDB(B1, 0, 1); PG8_SCHED; PG8_LDA(At, 0, 0); PG8_STAGE_A(PG8_SA(1, 1), a1, 1, false);
            PG8_WAIT_V(8); PG8_WAIT_L(0); PG8_BAR; PG8_MMA(0, 0, At, B0); PG8_MMA(0, 1, At, B1); PG8_BAR; PG8_SCHED;
            PG8_LDA(At, 0, 1); PG8_STAGE(PG8_SB(0, 0), b2, voffB); PG8_STAGE(PG8_SB(0, 1), b2 + hstepB, voffB); PG8_STAGE_A(PG8_SA(0, 0), a2, 0, last);
            PG8_WAIT_V(8); PG8_WAIT_L(0); PG8_BAR; PG8_MMA(1, 0, At, B0); PG8_MMA(1, 1, At, B1); PG8_BAR; PG8_SCHED;
            PG8_LDB(B0, 1, 0); PG8_LDB(B1, 1, 1); PG8_SCHED; PG8_LDA(At, 1, 0); PG8_STAGE_A(PG8_SA(0, 1), a2, 1, last);
            PG8_WAIT_V(8); PG8_WAIT_L(0); PG8_BAR; PG8_MMA(0, 0, At, B0); PG8_MMA(0, 1, At, B1); PG8_BAR; PG8_SCHED;
            PG8_LDA(At, 1, 1); PG8_STAGE(PG8_SB(1, 0), b3, voffB); PG8_STAGE(PG8_SB(1, 1), b3 + hstepB, voffB); PG8_STAGE_A(PG8_SA(1, 0), a3, 0, last);
            PG8_WAIT_V(8); PG8_WAIT_L(0); PG8_BAR; PG8_MMA(1, 0, At, B0); PG8_MMA(1, 1, At, B1); PG8_BAR; PG8_SCHED;
            } else {
            PG8_LDB(B0, 0, 0); PG8_SCHED; PG8_LDA(At, 0, 0); PG8_STAGE_A(PG8_SA(1, 1), a1, 1, false);
            PG8_WAIT_L(8); PG8_BAR; PG8_WAIT_L(0); PG8_MMA(0, 0, At, B0); PG8_BAR; PG8_SCHED;
            PG8_LDB(B1, 0, 1); PG8_STAGE(PG8_SB(0, 0), b2, voffB);
            PG8_BAR; PG8_WAIT_L(0); PG8_MMA(0, 1, At, B1); PG8_BAR;
            PG8_LDA(At, 0, 1); PG8_STAGE_A(PG8_SA(0, 0), a2, 0, last);
            PG8_BAR; PG8_WAIT_L(0); PG8_MMA(1, 0, At, B0); PG8_BAR; PG8_SCHED;
            PG8_STAGE(PG8_SB(0, 1), b2 + hstepB, voffB);
            PG8_WAIT_V(6); PG8_BAR; PG8_MMA(1, 1, At, B1); PG8_BAR;
            PG8_LDB(B0, 1, 0); PG8_SCHED; PG8_LDA(At, 1, 0); PG8_STAGE_A(PG8_SA(0, 1), a2, 1, last);
            PG8_WAIT_L(8); PG8_BAR; PG8_WAIT_L(0); PG8_MMA(0, 0, At, B0); PG8_BAR; PG8_SCHED;
            PG8_LDB(B1, 1, 1); PG8_STAGE(PG8_SB(1, 0), b3, voffB);
            PG8_BAR; PG8_WAIT_L(0); PG8_MMA(0, 1, At, B1); PG8_BAR;
            PG8_LDA(At, 1, 1); PG8_STAGE_A(PG8_SA(1, 0), a3, 0, last);
            PG8_BAR; PG8_WAIT_L(0); PG8_MMA(1, 0, At, B0); PG8_BAR; PG8_SCHED;
            PG8_STAGE(PG8_SB(1, 1), b3 + hstepB, voffB);
            PG8_WAIT_V(6); PG8_BAR; PG8_MMA(1, 1, At, B1); PG8_BAR;
            }
        }
        if constexpr (ALIGN_EPI) { if (wr == 0) PG8_BAR; }
        if constexpr (!Epi::AFTER_DRAIN) { E(acc, cur, wr, wc, fr, fq); S.done(cur); }
        if (!has_next) break;
#pragma unroll
        for (int a = 0; a < 2; ++a)
#pragma unroll
            for (int b = 0; b < 2; ++b)
#pragma unroll
                for (int m = 0; m < 4; ++m)
#pragma unroll
                    for (int n = 0; n < 2; ++n) acc[a][b][m][n] = (f32x4){0.f, 0.f, 0.f, 0.f};
        cur = nxt; cA = nA; cB = nB; ++ui;
        if constexpr (GATHER) { _Pragma("unroll") for (int h_ = 0; h_ < 2; ++h_) { gcur[h_][0] = gnxt[h_][0]; gcur[h_][1] = gnxt[h_][1]; } }
        if constexpr (ALIGN_EPI) { if (wr == 1) PG8_BAR; }
    }
    PG8_WAIT_V(0);
    if constexpr (!ALIGN_EPI) { if (wr == 0) PG8_BAR; }
    PG8_BAR;
    if constexpr (Epi::AFTER_DRAIN) { E.fused(acc, cur, wr, wc, fr, fq, lds, wid, lane); S.done(cur); }
#undef PG8_SA
#undef PG8_GOFF
#undef PG8_STAGE_A
#undef PG8_SB
#undef PG8_STAGE
#undef PG8_LDA
#undef PG8_LDB
#undef PG8_MMA
#undef PG8_WAIT_V
#undef PG8_WAIT_L
#undef PG8_BAR
#undef PG8_SCHED
}
}

constexpr int NB = 16, SEQ = 4096, CTX = 256, TT = SEQ + CTX, M = NB * TT, D = 1024, NL = 4;
constexpr int NPJ = 2304, DPROJ = 2208;
constexpr int MS = 143360;
constexpr float EPS = 1e-6f, ALPHA = 1.6817928305074290f, LOG2E = 1.4426950408889634f;
constexpr int NWAVES = 8, NTHR = 512;
#ifndef MK_DEBUG
#define MK_DEBUG 0
#endif
#ifndef MK_TIME
#define MK_TIME 0
#endif
#ifndef MK_TMUL
#define MK_TMUL 1
#endif
#ifndef MK_VM
#define MK_VM 0
#endif
#ifndef MK_DUP
#define MK_DUP 0
#endif
#ifndef MK_MULTI
#define MK_MULTI 0
#endif
constexpr int NPHASE = 2 + 10 * NL;

constexpr size_t WS_CTL = 0, CTL_BYTES = 65536;
constexpr size_t WS_MODS = WS_CTL + CTL_BYTES;
constexpr size_t WS_T64 = WS_MODS + (size_t)NL * 17 * 6144 * 4;
constexpr size_t WS_T32 = WS_T64 + 8192;
constexpr size_t WS_RS = WS_T32 + 4096;
constexpr size_t WS_RT = WS_RS + (size_t)M * 8;
constexpr size_t WS_HIST = WS_RT + (size_t)M * 32;
constexpr size_t WS_XS = WS_HIST + 65536;
constexpr size_t WS_WIN = WS_XS + (size_t)M * D * 2;
constexpr size_t WS_WD = WS_WIN + (size_t)NPJ * D * 2;
constexpr size_t WS_WOUT = WS_WD + (size_t)1024 * 384 * 2;
constexpr size_t WS_WGU = WS_WOUT + (size_t)D * D * 2;
constexpr size_t WS_WDN = WS_WGU + (size_t)16 * 1024 * 1024 * 2;
constexpr size_t WS_HA = WS_WDN + (size_t)16 * 1024 * 512 * 2;
constexpr size_t WS_PB = WS_HA + (size_t)M * D * 2;
constexpr size_t WS_QD = WS_PB + (size_t)M * NPJ * 2;
constexpr size_t WS_KD = WS_QD + (size_t)M * 384 * 2;
constexpr size_t WS_VD = WS_KD + (size_t)M * 384 * 2;
constexpr size_t WS_ACT = WS_VD + (size_t)M * 256 * 2;
constexpr size_t WS_END = WS_ACT + (size_t)MS * 512 * 2;
static_assert(WS_END <= (size_t)1073741824, "d_ws map must fit 1 GiB");
static_assert((size_t)M * NPJ * 2 >= (size_t)MS * D * 2 && (size_t)M * NPJ * 2 >= (size_t)M * D * 4, "region PB overlays");
constexpr int CW_BAR = 0;
constexpr int CW_QUEUE = 4096;

constexpr int RING_BYTES = 131072, MISC_OFF = RING_BYTES, LDS_BYTES = 147456;
constexpr int MI_BAR = 0, MI_Q = 4, MI_TOT = 16, MI_BASE = 32, MI_PST = 48, MI_LH = 80;

#define GAS __attribute__((address_space(1)))
#define LAS __attribute__((address_space(3)))
typedef unsigned short bf16;
typedef unsigned v4u __attribute__((ext_vector_type(4)));
typedef unsigned v2u __attribute__((ext_vector_type(2)));
typedef float f32x4 __attribute__((ext_vector_type(4)));
typedef float f32x2 __attribute__((ext_vector_type(2)));
typedef short bf16x8 __attribute__((ext_vector_type(8)));
typedef float f32x16 __attribute__((ext_vector_type(16)));
typedef short v4i16 __attribute__((ext_vector_type(4)));

__device__ __forceinline__ unsigned f2bf(float f) { unsigned u = __builtin_bit_cast(unsigned, f); return (u + 0x7fffu + ((u >> 16) & 1u)) >> 16; }
typedef __bf16 bf16x2_hw __attribute__((ext_vector_type(2)));
__device__ __forceinline__ unsigned pk2(float lo, float hi) { f32x2 v = {lo, hi}; const bf16x2_hw b = __builtin_convertvector(v, bf16x2_hw); return __builtin_bit_cast(unsigned, b); }
__device__ __forceinline__ float bflo(unsigned w) { return __builtin_bit_cast(float, w << 16); }
__device__ __forceinline__ float bfhi(unsigned w) { return __builtin_bit_cast(float, w & 0xffff0000u); }
__device__ __forceinline__ void unpack8(v4u w, float (&f)[8]) { f[0] = bflo(w.x); f[1] = bfhi(w.x); f[2] = bflo(w.y); f[3] = bfhi(w.y); f[4] = bflo(w.z); f[5] = bfhi(w.z); f[6] = bflo(w.w); f[7] = bfhi(w.w); }
__device__ __forceinline__ v4u pack8(const float (&f)[8]) { v4u w; w.x = pk2(f[0], f[1]); w.y = pk2(f[2], f[3]); w.z = pk2(f[4], f[5]); w.w = pk2(f[6], f[7]); return w; }
__device__ __forceinline__ float wave_sum(float v) {
    int x = __builtin_bit_cast(int, v);
#define WS_DPP(ctrl, rmask) v += __builtin_bit_cast(float, __builtin_amdgcn_update_dpp(0, x, ctrl, rmask, 0xf, true)); x = __builtin_bit_cast(int, v)
    WS_DPP(0xB1, 0xf);
    WS_DPP(0x4E, 0xf);
    WS_DPP(0x141, 0xf);
    WS_DPP(0x140, 0xf);
    WS_DPP(0x142, 0xa);
    WS_DPP(0x143, 0xc);
#undef WS_DPP
    return __builtin_bit_cast(float, __builtin_amdgcn_readlane(__builtin_bit_cast(int, v), 63));
}

#define XB_TMO      128
#define XB_XCNT(j)  (256  + 64 * (j))
#define XB_XSUB(j)  (1280 + 64 * (j))
#define XB_XGEN(j)  (2304 + 64 * (j))
#define XB_TOP      3328
#define XB_TOPGEN   3392
#define XCD_BAR_WORDS 3456
#define XB_SPIN_CAP (1u << 22)
__device__ __forceinline__ unsigned xb_ld(unsigned* p)              { return __hip_atomic_load(p, __ATOMIC_RELAXED, __HIP_MEMORY_SCOPE_AGENT); }
__device__ __forceinline__ unsigned xb_add(unsigned* p, unsigned v) { return __hip_atomic_fetch_add(p, v, __ATOMIC_RELAXED, __HIP_MEMORY_SCOPE_AGENT); }
__device__ __forceinline__ unsigned xb_xcc_id() { return (unsigned)__builtin_amdgcn_s_getreg((3 << 11) | 20) & 0xFu; }
#define XB_SPIN(cond, bar) do { unsigned _sp = 0; while (cond) { __builtin_amdgcn_s_sleep(1); \
    if ((++_sp & 255u) == 0u) { if (xb_ld(&(bar)[XB_TMO])) break; if (_sp > XB_SPIN_CAP) { atomicAdd(&(bar)[XB_TMO], 1u); break; } } } } while (0)
struct XcdBarrier { unsigned* bar; unsigned x; volatile LAS unsigned* st; };
__device__ __forceinline__ XcdBarrier xcd_barrier_post(unsigned* bar, volatile LAS unsigned* st) {
    XcdBarrier b; b.bar = bar; b.x = xb_xcc_id(); b.st = st;
    if (threadIdx.x == 0) (void)xb_add(&bar[XB_XCNT(b.x)], 1u);
    return b;
}
__device__ __forceinline__ void xcd_barrier_complete(unsigned* bar, unsigned x, unsigned& nloc, unsigned& nx) {
    const unsigned G = gridDim.x * gridDim.y * gridDim.z;
    unsigned sum, cnt, mine, sp = 0u;
    for (;;) {
        sum = 0u; cnt = 0u; mine = 0u;
#pragma unroll
        for (unsigned j = 0; j < 16; ++j) { const unsigned c = xb_ld(&bar[XB_XCNT(j)]); sum += c; cnt += (c > 0u) ? 1u : 0u; mine = (j == x) ? c : mine; }
        if (sum == G) break;
        __builtin_amdgcn_s_sleep(1);
        if ((++sp & 255u) == 0u) { if (xb_ld(&bar[XB_TMO])) break; if (sp > XB_SPIN_CAP) { atomicAdd(&bar[XB_TMO], 1u); break; } }
    }
    nloc = mine > 0u ? mine : 1u; nx = cnt > 0u ? cnt : 1u;
}
__device__ __forceinline__ void xcd_barrier(const XcdBarrier& b) {
    asm volatile("s_waitcnt vmcnt(0)" ::: "memory");
    __syncthreads();
    if (threadIdx.x == 0) {
        unsigned* bar = b.bar;
        __builtin_amdgcn_s_waitcnt(0);
        unsigned nloc = b.st[0], nx = b.st[1];
        if (nloc == 0u) { xcd_barrier_complete(bar, b.x, nloc, nx); b.st[0] = nloc; b.st[1] = nx; }
        const unsigned old = xb_add(&bar[XB_XSUB(b.x)], 1u);
        const unsigned gen = old / nloc;
        if (old + 1u == (gen + 1u) * nloc) {
            __builtin_amdgcn_fence(__ATOMIC_RELEASE, "agent");
            asm volatile("s_waitcnt vmcnt(0)" ::: "memory");
            const unsigned og = xb_add(&bar[XB_TOP], 1u);
            const unsigned tg = og / nx;
            if (og + 1u == (tg + 1u) * nx) xb_add(&bar[XB_TOPGEN], 1u);
            else XB_SPIN(xb_ld(&bar[XB_TOPGEN]) == tg, bar);
            __builtin_amdgcn_fence(__ATOMIC_ACQUIRE, "agent");
            xb_add(&bar[XB_XGEN(b.x)], 1u);
            asm volatile("s_waitcnt vmcnt(0)" ::: "memory");
        } else {
            XB_SPIN(xb_ld(&bar[XB_XGEN(b.x)]) == gen, bar);
            __builtin_amdgcn_fence(__ATOMIC_ACQUIRE, "agent");
            asm volatile("s_waitcnt vmcnt(0)" ::: "memory");
        }
    }
    __syncthreads();
}

struct Args { const float* in[27]; float* out; unsigned char* ws; int ph_lo, ph_hi; };
enum { I_X = 0, I_C, I_CTX, I_CCTX, I_WADA, I_BADA, I_WIN, I_NABIAS, I_GQG, I_GKG, I_SINK, I_MQG, I_WQB, I_MKVG, I_WKVB, I_WOUT, I_LN1G, I_LN1B, I_RGW, I_RGB, I_REW, I_REB, I_WG, I_WU, I_WDN, I_LN2G, I_LN2B };

struct Frame {
    LAS unsigned char* lds; volatile LAS unsigned* MISC;
    int tid, lane, wave, G, gw, ngw, bid;
    GAS unsigned char* ws;
};
__device__ __forceinline__ int opaque_tid() { int t = threadIdx.x; asm volatile("" : "+v"(t)); return t; }
__device__ __forceinline__ int opaque_s(int x) { asm volatile("" : "+s"(x)); return x; }
constexpr int PTAB_OFF = MISC_OFF + 2048, I_OUT = 27;
__device__ __forceinline__ GAS unsigned char* ptab_get(const Frame& F, int i) {
    const LAS unsigned* t = (const LAS unsigned*)(F.lds + PTAB_OFF) + 2 * i;
    const unsigned lo = __builtin_amdgcn_readfirstlane(t[0]), hi = __builtin_amdgcn_readfirstlane(t[1]);
    return (GAS unsigned char*)(((unsigned long long)hi << 32) | lo);
}
#define INP(i) ((const float*)ptab_get(F, (i)))
__device__ __forceinline__ Frame make_frame(GAS unsigned char* ws) {
    extern __shared__ __attribute__((aligned(16))) unsigned char lds_raw[];
    Frame F;
    F.lds = (LAS unsigned char*)lds_raw; F.MISC = (volatile LAS unsigned*)(F.lds + MISC_OFF);
    F.tid = opaque_tid(); F.lane = F.tid & 63; F.wave = __builtin_amdgcn_readfirstlane(F.tid >> 6);
    F.G = opaque_s((int)gridDim.x); F.bid = opaque_s((int)blockIdx.x); F.gw = F.bid * NWAVES + F.wave; F.ngw = F.G * NWAVES;
    { unsigned long long w = (unsigned long long)ws; asm volatile("" : "+s"(w)); F.ws = (GAS unsigned char*)w; }
    return F;
}
typedef _Float16 f16x4 __attribute__((ext_vector_type(4)));
struct RowPtrs { const float* x; const float* ctx; float* out; _Float16* xs; };
__device__ __forceinline__ RowPtrs row_ptrs(const Frame& F) { RowPtrs p; p.x = INP(I_X); p.ctx = INP(I_CTX); p.out = (float*)ptab_get(F, I_OUT); p.xs = (_Float16*)(F.ws + WS_XS); return p; }
__device__ __forceinline__ const float* xin_row(const RowPtrs& P, int r) {
    const int b = r / TT, t = r - b * TT;
    return t < SEQ ? P.x + ((size_t)b * SEQ + t) * D : P.ctx + ((size_t)b * CTX + (t - SEQ)) * D;
}
__device__ __forceinline__ float* out_row(const RowPtrs& P, int r) { const int b = r / TT, t = r - b * TT; return P.out + ((size_t)b * SEQ + t) * D; }
__device__ __forceinline__ void ld16h(const _Float16* p, int lane, float (&v)[16]) {
    const f16x4* q = (const f16x4*)p + lane;
#pragma unroll
    for (int g = 0; g < 4; ++g) { const f32x4 f = __builtin_convertvector(__builtin_nontemporal_load(q + 64 * g), f32x4); v[4 * g] = f.x; v[4 * g + 1] = f.y; v[4 * g + 2] = f.z; v[4 * g + 3] = f.w; }
}
__device__ __forceinline__ void st16h(_Float16* p, int lane, const float (&v)[16]) {
    f16x4* q = (f16x4*)p + lane;
#pragma unroll
    for (int g = 0; g < 4; ++g) __builtin_nontemporal_store(__builtin_convertvector((f32x4){v[4 * g], v[4 * g + 1], v[4 * g + 2], v[4 * g + 3]}, f16x4), q + 64 * g);
}
__device__ __forceinline__ void ld16(const float* p, int lane, float (&v)[16]) {
    const f32x4* q = (const f32x4*)p + lane;
    const f32x4 a = q[0], b = q[64], c = q[128], d = q[192];
    v[0] = a.x; v[1] = a.y; v[2] = a.z; v[3] = a.w; v[4] = b.x; v[5] = b.y; v[6] = b.z; v[7] = b.w;
    v[8] = c.x; v[9] = c.y; v[10] = c.z; v[11] = c.w; v[12] = d.x; v[13] = d.y; v[14] = d.z; v[15] = d.w;
}
__device__ __forceinline__ void st16(float* p, int lane, const float (&v)[16]) {
    f32x4* q = (f32x4*)p + lane;
    q[0] = (f32x4){v[0], v[1], v[2], v[3]}; q[64] = (f32x4){v[4], v[5], v[6], v[7]};
    q[128] = (f32x4){v[8], v[9], v[10], v[11]}; q[192] = (f32x4){v[12], v[13], v[14], v[15]};
}
__device__ __forceinline__ void ld16nt(const float* p, int lane, float (&v)[16]) {
    const f32x4* q = (const f32x4*)p + lane;
    const f32x4 a = __builtin_nontemporal_load(q), b = __builtin_nontemporal_load(q + 64), c = __builtin_nontemporal_load(q + 128), d = __builtin_nontemporal_load(q + 192);
    v[0] = a.x; v[1] = a.y; v[2] = a.z; v[3] = a.w; v[4] = b.x; v[5] = b.y; v[6] = b.z; v[7] = b.w;
    v[8] = c.x; v[9] = c.y; v[10] = c.z; v[11] = c.w; v[12] = d.x; v[13] = d.y; v[14] = d.z; v[15] = d.w;
}
__device__ __forceinline__ void st16nt(float* p, int lane, const float (&v)[16]) {
    f32x4* q = (f32x4*)p + lane;
    __builtin_nontemporal_store((f32x4){v[0], v[1], v[2], v[3]}, q); __builtin_nontemporal_store((f32x4){v[4], v[5], v[6], v[7]}, q + 64);
    __builtin_nontemporal_store((f32x4){v[8], v[9], v[10], v[11]}, q + 128); __builtin_nontemporal_store((f32x4){v[12], v[13], v[14], v[15]}, q + 192);
}
__device__ __forceinline__ void unpack16(const v2u (&w)[4], float (&v)[16]) {
#pragma unroll
    for (int g = 0; g < 4; ++g) { v[4 * g] = bflo(w[g].x); v[4 * g + 1] = bfhi(w[g].x); v[4 * g + 2] = bflo(w[g].y); v[4 * g + 3] = bfhi(w[g].y); }
}
__device__ __forceinline__ void ld16bf_raw(const bf16* p, int lane, v2u (&w)[4]) {
    const v2u* q = (const v2u*)p + lane; w[0] = q[0]; w[1] = q[64]; w[2] = q[128]; w[3] = q[192];
}
__device__ __forceinline__ void ld16bf_raw_nt(const bf16* p, int lane, v2u (&w)[4]) {
    const v2u* q = (const v2u*)p + lane; w[0] = __builtin_nontemporal_load(q); w[1] = __builtin_nontemporal_load(q + 64); w[2] = __builtin_nontemporal_load(q + 128); w[3] = __builtin_nontemporal_load(q + 192);
}
__device__ __forceinline__ void ld16bf(const bf16* p, int lane, float (&v)[16]) { v2u w[4]; ld16bf_raw(p, lane, w); unpack16(w, v); }
__device__ __forceinline__ void ld16bf_nt(const bf16* p, int lane, float (&v)[16]) { v2u w[4]; ld16bf_raw_nt(p, lane, w); unpack16(w, v); }
__device__ __forceinline__ void st16bf(bf16* p, int lane, const float (&v)[16]) {
    v2u* q = (v2u*)p + lane;
#pragma unroll
    for (int g = 0; g < 4; ++g) { v2u w; w.x = pk2(v[4 * g], v[4 * g + 1]); w.y = pk2(v[4 * g + 2], v[4 * g + 3]); q[64 * g] = w; }
}
__device__ __forceinline__ void ln16(float (&v)[16]) {
    float s = 0.f;
#pragma unroll
    for (int i = 0; i < 16; ++i) s += v[i];
    const float mean = wave_sum(s) * (1.0f / D); float q = 0.f;
#pragma unroll
    for (int i = 0; i < 16; ++i) { v[i] -= mean; q += v[i] * v[i]; }
    const float rstd = __builtin_amdgcn_rsqf(wave_sum(q) * (1.0f / D) + EPS);
#pragma unroll
    for (int i = 0; i < 16; ++i) v[i] *= rstd;
}

__device__ __forceinline__ int rows_per_wave(int ngw) {
    int rpw = (M + ngw - 1) / ngw;
    if (!((SEQ % rpw) % 4 == 0 && (TT % rpw) == 0 && (rpw % 2) == 0)) rpw = (rpw + 3) & ~3;
    return rpw;
}
template <int TYPE>
__device__ __forceinline__ float conv_src(const float* p0, const float* p1, const float* g0, const float* g1, int l, int k, int n) {
    if (TYPE == 0) return n < DPROJ ? p0[((size_t)l * D + k) * DPROJ + n] : 0.f;
    if (TYPE == 1) { if (n < 384) return k < 256 ? g0[l * 256 + k] * p0[((size_t)l * 256 + k) * 384 + n] : 0.f;
                     if (n < 896) return k >= 256 ? g1[l * 128 + (k - 256)] * p1[((size_t)l * 128 + (k - 256)) * 512 + (n - 384)] : 0.f;
                     return 0.f; }
    if (TYPE == 2) return p0[((size_t)l * D + k) * D + n];
    if (TYPE == 3) { const int e = n >> 10, nn = n & 1023, q = nn >> 3, j = nn & 7;
                     return j < 4 ? p0[(((size_t)l * 16 + e) * D + k) * 512 + 4 * q + j] : p1[(((size_t)l * 16 + e) * D + k) * 512 + 4 * q + (j - 4)]; }
    { const int e = n >> 10, nn = n & 1023; return p0[(((size_t)l * 16 + e) * 512 + k) * D + nn]; }
}
template <int TYPE>
__device__ __forceinline__ void conv_item(const Frame& F, int l, int item, LAS float* scr) {
    constexpr int Nd = TYPE == 0 ? NPJ : TYPE == 1 ? 1024 : TYPE == 2 ? 1024 : 16384, Kd = TYPE == 1 ? 384 : TYPE == 4 ? 512 : 1024;
    bf16* dst = (bf16*)(F.ws + (TYPE == 0 ? WS_WIN : TYPE == 1 ? WS_WD : TYPE == 2 ? WS_WOUT : TYPE == 3 ? WS_WGU : WS_WDN));
    const float* p0 = INP(TYPE == 0 ? I_WIN : TYPE == 1 ? I_WQB : TYPE == 2 ? I_WOUT : TYPE == 3 ? I_WG : I_WDN);
    const float* p1 = INP(TYPE == 1 ? I_WKVB : I_WU); const float* g0 = INP(I_MQG); const float* g1 = INP(I_MKVG);
    constexpr int nblk = Nd / 32; const int kb = item / nblk, nb = item - kb * nblk, k0 = 64 * kb, n0 = 32 * nb, lane = F.lane;
#pragma unroll
    for (int i = 0; i < 32; ++i) { const int kk = 2 * i + (lane >> 5); scr[kk * 33 + (lane & 31)] = conv_src<TYPE>(p0, p1, g0, g1, l, k0 + kk, n0 + (lane & 31)); }
    asm volatile("s_waitcnt lgkmcnt(0)" ::: "memory");
    const int c = lane & 7;
#pragma unroll
    for (int j = 0; j < 4; ++j) { const int n = (lane >> 3) + 8 * j; const LAS float* s = scr + (8 * c) * 33 + n;
        v4u o; o.x = pk2(s[0 * 33], s[1 * 33]); o.y = pk2(s[2 * 33], s[3 * 33]); o.z = pk2(s[4 * 33], s[5 * 33]); o.w = pk2(s[6 * 33], s[7 * 33]);
        *(v4u*)(dst + (size_t)(n0 + n) * Kd + k0 + 8 * c) = o; }
    asm volatile("s_waitcnt lgkmcnt(0)" ::: "memory");
}
__device__ __forceinline__ void phase_prologue(const Frame& F) {
    {
        LAS float* sv = (LAS float*)F.lds;
        LAS float* red = (LAS float*)(F.lds + 17 * 1024 * 4);
        float* mods = (float*)(F.ws + WS_MODS);
        for (int u = F.bid; u < NL * 48; u += F.G) {
            const int l = u / 48, cc = u - l * 48;
            const float* pc = INP(I_C); const float* pcc = INP(I_CCTX);
            for (int i = F.tid; i < 17 * 1024; i += NTHR) { const int mr = i >> 10, k = i & 1023; const float c = mr < 16 ? pc[mr * 1024 + k] : pcc[k]; sv[i] = c / (1.0f + expf(-c)); }
            __syncthreads();
            const int col = F.tid & 127, kg = F.tid >> 7;
            float acc[17];
#pragma unroll
            for (int mr = 0; mr < 17; ++mr) acc[mr] = 0.f;
            const float* w = INP(I_WADA) + ((size_t)l * 1024 + kg * 256) * 6144 + cc * 128 + col;
            for (int k4 = 0; k4 < 256; k4 += 4) {
                const float w0 = w[(size_t)(k4 + 0) * 6144], w1 = w[(size_t)(k4 + 1) * 6144], w2 = w[(size_t)(k4 + 2) * 6144], w3 = w[(size_t)(k4 + 3) * 6144];
#pragma unroll
                for (int mr = 0; mr < 17; ++mr) { const f32x4 s = *(const LAS f32x4*)(sv + mr * 1024 + kg * 256 + k4); acc[mr] += (s.x * w0 + s.y * w1) + (s.z * w2 + s.w * w3); }
            }
#pragma unroll
            for (int mr = 0; mr < 17; ++mr) red[(kg * 17 + mr) * 128 + col] = acc[mr];
            __syncthreads();
            const float* bada = INP(I_BADA);
            for (int i = F.tid; i < 17 * 128; i += NTHR) { const int mr = i >> 7, c = i & 127;
                const float s = (red[(0 * 17 + mr) * 128 + c] + red[(1 * 17 + mr) * 128 + c]) + (red[(2 * 17 + mr) * 128 + c] + red[(3 * 17 + mr) * 128 + c]);
                mods[((size_t)l * 17 + mr) * 6144 + cc * 128 + c] = s + bada[l * 6144 + cc * 128 + c]; }
            __syncthreads();
        }
    }
    {
        float* t64 = (float*)(F.ws + WS_T64); float* t32 = (float*)(F.ws + WS_T32);
        for (int i = F.bid * NTHR + F.tid; i < 64 * 16 + 64 * 8; i += F.G * NTHR) {
            if (i < 1024) { const int p = i >> 4, k = i & 15; const float fr = powf(10000.0f, -(float)k / 16.0f), ang = (float)p * fr; t64[2 * i] = cosf(ang); t64[2 * i + 1] = sinf(ang); }
            else { const int j = i - 1024, p = j >> 3, k = j & 7; const float fr = powf(10000.0f, -(float)k / 8.0f), ang = (float)p * fr; t32[2 * j] = cosf(ang); t32[2 * j + 1] = sinf(ang); }
        }
    }
}
__device__ __forceinline__ void convert_layer_weights(const Frame& F, int l) {
    {
        LAS float* scr = (LAS float*)(F.lds + F.wave * 8448);
        constexpr int I0 = 1152, I1 = 192, I2 = 512, I3 = 8192, I4 = 4096, IL = I0 + I1 + I2 + I3 + I4;
        for (int r0_ = F.gw; r0_ < IL; r0_ += F.ngw) {
            int r = r0_;
            if (r < I0) { conv_item<0>(F, l, r, scr); continue; } r -= I0;
            if (r < I1) { conv_item<1>(F, l, r, scr); continue; } r -= I1;
            if (r < I2) { conv_item<2>(F, l, r, scr); continue; } r -= I2;
            if (r < I3) { conv_item<3>(F, l, r, scr); continue; } r -= I3;
            conv_item<4>(F, l, r, scr);
        }
    }
}

__device__ __forceinline__ void phase_ln(const Frame& F, int l) {
    if (l < NL) convert_layer_weights(F, l);
    constexpr int NR = 4;
    const float* mods = (const float*)(F.ws + WS_MODS); bf16* HA = (bf16*)(F.ws + WS_HA);
    const bf16* Y = (const bf16*)(F.ws + WS_PB); const unsigned* RT = (const unsigned*)(F.ws + WS_RT);
    const int lane = F.lane; const RowPtrs RP = row_ptrs(F);
    const float* ln2g = INP(I_LN2G) + (l > 0 ? l - 1 : 0) * D; const float* ln2b = INP(I_LN2B) + (l > 0 ? l - 1 : 0) * D;
    const int rpw = rows_per_wave(F.ngw), rbeg = F.gw * rpw, rend = min(M, rbeg + rpw);
    float g2[16]; int cur_mr = -1;
    float alpha_l = ALPHA; asm volatile("" : "+v"(alpha_l));
    for (int r0 = rbeg; r0 < rend; r0 += NR) {
        float v[NR][16]; v4u rt[NR]; v2u ya[NR][4], yb[NR][4]; bool act[NR];
        const int b0 = r0 / TT, t0 = r0 - b0 * TT; const bool lat = t0 < SEQ; const int mr = lat ? b0 : 16;
        if (l == NL && !lat) continue;
#pragma unroll
        for (int u = 0; u < NR; ++u) {
            const int r = r0 + u; act[u] = r < rend; const int rc = act[u] ? r : r0;
            if (l == 0) ld16nt(xin_row(RP, rc), lane, v[u]); else ld16h(RP.xs + (size_t)rc * D, lane, v[u]);
            rt[u] = *(const v4u*)(RT + (size_t)rc * 8 + 4);
        }
        if (mr != cur_mr) { if (l > 0) ld16(mods + ((size_t)(l - 1) * 17 + mr) * 6144 + 5120, lane, g2); cur_mr = mr; }
        if (l > 0) {
#pragma unroll
            for (int u = 0; u < NR; ++u) { ld16bf_raw_nt(Y + (size_t)rt[u].z * D, lane, ya[u]); ld16bf_raw_nt(Y + (size_t)rt[u].w * D, lane, yb[u]); }
#pragma unroll
            for (int u = 0; u < NR; ++u) {
                float f0[16], f1[16], gg[16], bb[16];
                const float w0 = __uint_as_float(rt[u].x), w1 = __uint_as_float(rt[u].y);
                unpack16(ya[u], f0); unpack16(yb[u], f1);
#pragma unroll
                for (int i = 0; i < 16; ++i) v[u][i] = alpha_l * v[u][i] + g2[i] * (w0 * f0[i] + w1 * f1[i]);
                ld16(ln2g, lane, gg); ld16(ln2b, lane, bb);
                ln16(v[u]);
#pragma unroll
                for (int i = 0; i < 16; ++i) v[u][i] = v[u][i] * gg[i] + bb[i];
                if (act[u]) { if (l == NL) st16nt(out_row(RP, r0 + u), lane, v[u]); else st16h(RP.xs + (size_t)(r0 + u) * D, lane, v[u]); }
            }
        }
        if (l < NL) {
            float sh[16], sc[16]; ld16(mods + ((size_t)l * 17 + mr) * 6144, lane, sh); ld16(mods + ((size_t)l * 17 + mr) * 6144 + 1024, lane, sc);
#pragma unroll
            for (int u = 0; u < NR; ++u) {
                ln16(v[u]);
#pragma unroll
                for (int i = 0; i < 16; ++i) v[u][i] = v[u][i] * (1.0f + sc[i]) + sh[i];
                if (act[u]) st16bf(HA + (size_t)(r0 + u) * D, lane, v[u]);
            }
        }
    }
}

__device__ __forceinline__ void rope8(float (&f)[8], const float (&p)[8], const float* cs, bool first) {
    const f32x4* c4 = (const f32x4*)cs;
#pragma unroll
    for (int q = 0; q < 4; ++q) { const f32x4 t = c4[q];
        f[2 * q] = first ? f[2 * q] * t.x - p[2 * q] * t.y : p[2 * q] * t.y + f[2 * q] * t.x;
        f[2 * q + 1] = first ? f[2 * q + 1] * t.z - p[2 * q + 1] * t.w : p[2 * q + 1] * t.w + f[2 * q + 1] * t.z; }
}
#define DPPF(v, ctrl) __builtin_bit_cast(float, __builtin_amdgcn_update_dpp(0, __builtin_bit_cast(int, (v)), (ctrl), 0xf, 0xf, true))
__device__ __forceinline__ float dpp_xor1(float v) { return DPPF(v, 0xB1); }
__device__ __forceinline__ float dpp_xor2(float v) { return DPPF(v, 0x4E); }
__device__ __forceinline__ float dpp_hmir(float v) { return DPPF(v, 0x141); }
__device__ __forceinline__ float dpp_mir(float v) { return DPPF(v, 0x140); }
__device__ __forceinline__ void phase_post(const Frame& F, int l) {
    constexpr int NR = 4;
    bf16* P = (bf16*)(F.ws + WS_PB); bf16* KD = (bf16*)(F.ws + WS_KD);
    const float* t64 = (const float*)(F.ws + WS_T64); const float* t32 = (const float*)(F.ws + WS_T32);
    const int lane = F.lane; const float* gains = (lane < 32 ? INP(I_GQG) : INP(I_GKG)) + l * 64;
    const int j = lane & 7, jj = lane & 3;
    float gn[8];
#pragma unroll
    for (int i = 0; i < 8; ++i) gn[i] = gains[j * 8 + i];
    for (int r0 = F.gw; r0 < M; r0 += NR * F.ngw) {
        v4u w0[NR], w1[NR], w2[NR]; int rr[NR]; bool act[NR];
#pragma unroll
        for (int u = 0; u < NR; ++u) { const int r = r0 + u * F.ngw; act[u] = r < M; rr[u] = act[u] ? r : r0; const bf16* prow = P + (size_t)rr[u] * NPJ;
            w0[u] = *((const v4u*)(prow + 768) + lane); w1[u] = *((const v4u*)(prow + 1280) + lane); w2[u] = *((const v4u*)(prow + 1792) + lane); }
#pragma unroll
        for (int u = 0; u < NR; ++u) {
            const int r = rr[u]; const int b = r / TT, t = r - b * TT; const bool lat = t < SEQ; const int gr = (t >> 6) & 63, gc = t & 63;
            bf16* prow = P + (size_t)r * NPJ;
            const float* cs64 = t64 + ((size_t)((j < 4 ? gr : gc) * 16 + (j & 1) * 8)) * 2;
            {
                float f[8]; unpack8(w0[u], f);
                float ss = 0.f;
#pragma unroll
                for (int i = 0; i < 8; ++i) ss += f[i] * f[i];
                ss += dpp_xor1(ss); ss += dpp_xor2(ss); ss += dpp_hmir(ss);
                const float rs = __builtin_amdgcn_rsqf(ss * (1.0f / 64.0f) + EPS);
#pragma unroll
                for (int i = 0; i < 8; ++i) f[i] = f[i] * rs * gn[i];
                float p[8];
#pragma unroll
                for (int i = 0; i < 8; ++i) p[i] = dpp_xor2(f[i]);
                if (lat) rope8(f, p, cs64, (j & 2) == 0);
                if (lane < 48 && act[u]) *((v4u*)(prow + 768) + lane) = pack8(f);
            }
            {
                float f[8]; unpack8(w1[u], f);
                float p[8];
#pragma unroll
                for (int i = 0; i < 8; ++i) p[i] = dpp_xor2(f[i]);
                rope8(f, p, cs64, (j & 2) == 0);
                if (lat && lane < 48 && act[u]) *((v4u*)(prow + 1280) + lane) = pack8(f);
            }
            {
                float f[8]; unpack8(w2[u], f);
                float ss = 0.f;
#pragma unroll
                for (int i = 0; i < 8; ++i) ss += f[i] * f[i];
                ss += dpp_xor1(ss); ss += dpp_xor2(ss); ss += dpp_hmir(ss); ss += dpp_mir(ss);
                const float s32 = __builtin_bit_cast(float, __builtin_amdgcn_readlane(__builtin_bit_cast(int, ss), 0)) + __builtin_bit_cast(float, __builtin_amdgcn_readlane(__builtin_bit_cast(int, ss), 16));
                const float rn = __builtin_amdgcn_rsqf(lane < 32 ? s32 * (1.0f / 256.0f) + EPS : ss * (1.0f / 128.0f) + EPS);
                if (lane < 48 && act[u]) { float fn[8];
#pragma unroll
                    for (int i = 0; i < 8; ++i) fn[i] = f[i] * rn;
                    *((v4u*)(prow + 1792) + lane) = pack8(fn); }
                float p[8];
#pragma unroll
                for (int i = 0; i < 8; ++i) p[i] = dpp_xor1(f[i]);
                if (lat) rope8(f, p, t32 + ((size_t)((jj < 2 ? gr : gc) * 8)) * 2, (jj & 1) == 0);
                if (lane >= 48 && lane < 52 && act[u]) { const v4u o = pack8(f);
#pragma unroll
                    for (int h = 0; h < 4; ++h) *(v4u*)(KD + (size_t)r * 384 + h * 96 + 64 + 8 * jj) = o; }
            }
        }
    }
}

__device__ __forceinline__ float rt_dot(const float (&x)[16], f32x4 w0, f32x4 w1, f32x4 w2, f32x4 w3) {
    float a = x[0] * w0.x, b = x[8] * w2.x;
    a = __builtin_fmaf(x[1], w0.y, a); b = __builtin_fmaf(x[9], w2.y, b); a = __builtin_fmaf(x[2], w0.z, a); b = __builtin_fmaf(x[10], w2.z, b);
    a = __builtin_fmaf(x[3], w0.w, a); b = __builtin_fmaf(x[11], w2.w, b); a = __builtin_fmaf(x[4], w1.x, a); b = __builtin_fmaf(x[12], w3.x, b);
    a = __builtin_fmaf(x[5], w1.y, a); b = __builtin_fmaf(x[13], w3.y, b); a = __builtin_fmaf(x[6], w1.z, a); b = __builtin_fmaf(x[14], w3.z, b);
    a = __builtin_fmaf(x[7], w1.w, a); b = __builtin_fmaf(x[15], w3.w, b);
    return a + b;
}
__device__ __forceinline__ void reduce4(float& a, float& b, float& c, float& d) {
    auto r1 = __builtin_amdgcn_permlane32_swap(__builtin_bit_cast(unsigned, a), __builtin_bit_cast(unsigned, b), false, false); const unsigned x0 = r1[0], x1 = r1[1];
    auto r2 = __builtin_amdgcn_permlane32_swap(__builtin_bit_cast(unsigned, c), __builtin_bit_cast(unsigned, d), false, false); const unsigned y0 = r2[0], y1 = r2[1];
    const float X = __uint_as_float(x0) + __uint_as_float(x1), Y = __uint_as_float(y0) + __uint_as_float(y1);
    auto r3 = __builtin_amdgcn_permlane16_swap(__builtin_bit_cast(unsigned, X), __builtin_bit_cast(unsigned, Y), false, false); const unsigned z0 = r3[0], z1 = r3[1];
    float z = __uint_as_float(z0) + __uint_as_float(z1);
    z += dpp_xor1(z); z += dpp_xor2(z); z += dpp_hmir(z); z += dpp_mir(z);
    const int zi = __builtin_bit_cast(int, z);
    a = __builtin_bit_cast(float, __builtin_amdgcn_readlane(zi, 0)); c = __builtin_bit_cast(float, __builtin_amdgcn_readlane(zi, 16));
    b = __builtin_bit_cast(float, __builtin_amdgcn_readlane(zi, 32)); d = __builtin_bit_cast(float, __builtin_amdgcn_readlane(zi, 48));
}
__device__ __forceinline__ void ln16_pair(float (&v0)[16], float (&v1)[16]) {
    float s0 = 0.f, q0 = 0.f, s1 = 0.f, q1 = 0.f;
#pragma unroll
    for (int i = 0; i < 16; ++i) { s0 += v0[i]; q0 = __builtin_fmaf(v0[i], v0[i], q0); s1 += v1[i]; q1 = __builtin_fmaf(v1[i], v1[i], q1); }
    reduce4(s0, q0, s1, q1);
    const float m0 = s0 * (1.0f / D), m1 = s1 * (1.0f / D);
    const float r0 = __builtin_amdgcn_rsqf(fmaxf(q0 * (1.0f / D) - m0 * m0, 0.f) + EPS), r1 = __builtin_amdgcn_rsqf(fmaxf(q1 * (1.0f / D) - m1 * m1, 0.f) + EPS);
    const float c0 = -m0 * r0, c1 = -m1 * r1;
#pragma unroll
    for (int i = 0; i < 16; ++i) { v0[i] = __builtin_fmaf(v0[i], r0, c0); v1[i] = __builtin_fmaf(v1[i], r1, c1); }
}
__device__ __forceinline__ void phase_route(const Frame& F, int l) {
    const float* mods = (const float*)(F.ws + WS_MODS); bf16* HA = (bf16*)(F.ws + WS_HA);
    const bf16* MIX = (const bf16*)(F.ws + WS_PB); unsigned* RT = (unsigned*)(F.ws + WS_RT); int* HIST = (int*)(F.ws + WS_HIST);
    LAS float* WR = (LAS float*)F.lds;
    { const float* rgw = INP(I_RGW); const float* rew = INP(I_REW);
      for (int i = F.tid; i < 20 * 1024; i += NTHR) { const int jx = i >> 10, k = i & 1023;
        WR[i] = jx < 4 ? rgw[((size_t)l * D + k) * 4 + jx] : rew[((size_t)l * D + k) * 16 + (jx - 4)]; } }
    if (F.tid < 16) F.MISC[MI_LH + F.tid] = 0u;
    __syncthreads();
    LAS float* bias = (LAS float*)(F.lds + 20 * 1024 * 4);
    if (F.tid < 20) bias[F.tid] = F.tid < 4 ? INP(I_RGB)[l * 4 + F.tid] : INP(I_REB)[l * 16 + (F.tid - 4)];
    __syncthreads();
    const RowPtrs RP = row_ptrs(F);
    LAS float* LNG = (LAS float*)(F.lds + 20 * 1024 * 4 + 128);
    { const float* ln1g = INP(I_LN1G) + l * D; const float* ln1b = INP(I_LN1B) + l * D;
      for (int i = F.tid; i < 1024; i += NTHR) { LNG[i] = ln1g[i]; LNG[1024 + i] = ln1b[i]; } }
    __syncthreads();
    constexpr int NR = 2;
    const LAS unsigned char* wbase = (const LAS unsigned char*)WR + F.lane * 16; asm volatile("" : "+v"(wbase));
    const LAS unsigned char* lbase = (const LAS unsigned char*)LNG + F.lane * 16; asm volatile("" : "+v"(lbase));
#define RT_W4(base_, off_) (*(const LAS f32x4*)((base_) + (off_)))
    const int rpw = rows_per_wave(F.ngw), rbeg = F.gw * rpw, rend = min(M, rbeg + rpw);
    float g1[16], sh[16], sc[16]; int cur_mr = -1;
    float alpha_l = ALPHA; asm volatile("" : "+v"(alpha_l));
    v4u rx[NR][4]; v2u rm[NR][4];
#define RT_ISSUE(r0_) do { _Pragma("unroll") for (int u = 0; u < NR; ++u) { const int r_ = (r0_) + u, rc_ = r_ < rend ? r_ : (r0_); \
        if (l == 0) { const v4u* q_ = (const v4u*)xin_row(RP, rc_) + F.lane; _Pragma("unroll") for (int g = 0; g < 4; ++g) rx[u][g] = __builtin_nontemporal_load(q_ + 64 * g); } \
        else { const v2u* q_ = (const v2u*)(RP.xs + (size_t)rc_ * D) + F.lane; _Pragma("unroll") for (int g = 0; g < 4; ++g) { const v2u t_ = __builtin_nontemporal_load(q_ + 64 * g); rx[u][g].x = t_.x; rx[u][g].y = t_.y; } } \
        ld16bf_raw_nt(MIX + (size_t)rc_ * D, F.lane, rm[u]); } } while (0)
    if (rbeg < rend) RT_ISSUE(rbeg);
    for (int r0 = rbeg; r0 < rend; r0 += NR) {
        float v[NR][16]; int rr[NR]; bool act[NR];
        { const int b = r0 / TT, t = r0 - b * TT, mr = t < SEQ ? b : 16;
          if (mr != cur_mr) { const float* md = mods + ((size_t)l * 17 + mr) * 6144; ld16(md + 2048, F.lane, g1); ld16(md + 3072, F.lane, sh); ld16(md + 4096, F.lane, sc); cur_mr = mr; } }
#pragma unroll
        for (int u = 0; u < NR; ++u) { const int r = r0 + u; act[u] = r < rend; rr[u] = act[u] ? r : r0;
            float mx[16]; unpack16(rm[u], mx);
            if (l == 0) {
#pragma unroll
                for (int g = 0; g < 4; ++g) { v[u][4 * g] = __uint_as_float(rx[u][g].x); v[u][4 * g + 1] = __uint_as_float(rx[u][g].y); v[u][4 * g + 2] = __uint_as_float(rx[u][g].z); v[u][4 * g + 3] = __uint_as_float(rx[u][g].w); }
            } else {
#pragma unroll
                for (int g = 0; g < 4; ++g) { const v2u t = {rx[u][g].x, rx[u][g].y}; const f32x4 f = __builtin_convertvector(__builtin_bit_cast(f16x4, t), f32x4);
                    v[u][4 * g] = f.x; v[u][4 * g + 1] = f.y; v[u][4 * g + 2] = f.z; v[u][4 * g + 3] = f.w; }
            }
#pragma unroll
            for (int i = 0; i < 16; ++i) v[u][i] = alpha_l * v[u][i] + g1[i] * mx[i]; }
        if (r0 + NR < rend) RT_ISSUE(r0 + NR);
        if (l == NL - 1 && (r0 % TT) >= SEQ) continue;
        ln16_pair(v[0], v[1]);
        { float gg[16], bb[16];
#pragma unroll
          for (int g = 0; g < 4; ++g) { const f32x4 a = RT_W4(lbase, 1024 * g), c = RT_W4(lbase, 4096 + 1024 * g);
              gg[4 * g] = a.x; gg[4 * g + 1] = a.y; gg[4 * g + 2] = a.z; gg[4 * g + 3] = a.w; bb[4 * g] = c.x; bb[4 * g + 1] = c.y; bb[4 * g + 2] = c.z; bb[4 * g + 3] = c.w; }
#pragma unroll
          for (int u = 0; u < NR; ++u) {
#pragma unroll
            for (int i = 0; i < 16; ++i) v[u][i] = v[u][i] * gg[i] + bb[i];
            if (act[u]) st16h(RP.xs + (size_t)rr[u] * D, F.lane, v[u]); } }
        ln16_pair(v[0], v[1]);
#pragma unroll
        for (int u = 0; u < NR; ++u) {
#pragma unroll
            for (int i = 0; i < 16; ++i) v[u][i] = v[u][i] * (1.0f + sc[i]) + sh[i];
            if (act[u]) st16bf(HA + (size_t)rr[u] * D, F.lane, v[u]); }
#define RT_DOT(u_, w0, w1, w2, w3) rt_dot(v[u_], w0, w1, w2, w3)
        float gl[NR][4];
#pragma unroll
        for (int jx = 0; jx < 4; ++jx) {
            const f32x4 w0 = RT_W4(wbase, 4096 * jx), w1 = RT_W4(wbase, 4096 * jx + 1024), w2 = RT_W4(wbase, 4096 * jx + 2048), w3 = RT_W4(wbase, 4096 * jx + 3072);
#pragma unroll
            for (int u = 0; u < NR; ++u) gl[u][jx] = RT_DOT(u, w0, w1, w2, w3);
        }
#pragma unroll
        for (int u = 0; u < NR; ++u) { reduce4(gl[u][0], gl[u][1], gl[u][2], gl[u][3]);
#pragma unroll
            for (int jx = 0; jx < 4; ++jx) gl[u][jx] += bias[jx]; }
        int grpv[NR]; float pgv[NR];
#pragma unroll
        for (int u = 0; u < NR; ++u) {
            int grp = 0; float mg = gl[u][0];
#pragma unroll
            for (int g = 1; g < 4; ++g) if (gl[u][g] > mg) { mg = gl[u][g]; grp = g; }
            float sg = 0.f;
#pragma unroll
            for (int g = 0; g < 4; ++g) sg += __builtin_amdgcn_exp2f((gl[u][g] - mg) * LOG2E);
            grpv[u] = grp; pgv[u] = __builtin_amdgcn_rcpf(sg);
        }
        float selv[NR][4];
#pragma unroll
        for (int u = 0; u < NR; ++u) {
            const LAS unsigned char* eb = wbase + (4 + 4 * grpv[u]) * 4096;
#pragma unroll
            for (int i = 0; i < 4; ++i) {
                const f32x4 w0 = RT_W4(eb, 4096 * i), w1 = RT_W4(eb, 4096 * i + 1024), w2 = RT_W4(eb, 4096 * i + 2048), w3 = RT_W4(eb, 4096 * i + 3072);
                selv[u][i] = RT_DOT(u, w0, w1, w2, w3);
            }
        }
#pragma unroll
        for (int u = 0; u < NR; ++u) { reduce4(selv[u][0], selv[u][1], selv[u][2], selv[u][3]);
#pragma unroll
            for (int i = 0; i < 4; ++i) selv[u][i] += bias[4 + 4 * grpv[u] + i]; }
#undef RT_DOT
#pragma unroll
        for (int u = 0; u < NR; ++u) {
            const int grp = grpv[u]; const float pg = pgv[u];
            float sel[4];
#pragma unroll
            for (int i = 0; i < 4; ++i) sel[i] = selv[u][i];
            int i1 = 0; float v1 = sel[0];
#pragma unroll
            for (int i = 1; i < 4; ++i) if (sel[i] > v1) { v1 = sel[i]; i1 = i; }
            int i2 = -1; float v2 = -3.0e38f;
#pragma unroll
            for (int i = 0; i < 4; ++i) if (i != i1 && (i2 < 0 || sel[i] > v2)) { v2 = sel[i]; i2 = i; }
            const float ee = __builtin_amdgcn_exp2f((v2 - v1) * LOG2E), rq = __builtin_amdgcn_rcpf(1.0f + ee), w1 = pg * rq, w2 = pg * ee * rq;
            const int e1 = grp * 4 + i1, e2 = grp * 4 + i2;
            if (F.lane == 0 && act[u]) {
                const unsigned k1 = __hip_atomic_fetch_add((LAS unsigned*)&F.MISC[MI_LH + e1], 1u, __ATOMIC_RELAXED, __HIP_MEMORY_SCOPE_WORKGROUP);
                const unsigned k2 = __hip_atomic_fetch_add((LAS unsigned*)&F.MISC[MI_LH + e2], 1u, __ATOMIC_RELAXED, __HIP_MEMORY_SCOPE_WORKGROUP);
                v4u ra; ra.x = (unsigned)e1; ra.y = (unsigned)e2; ra.z = k1; ra.w = k2;
                v4u rb; rb.x = __builtin_bit_cast(unsigned, w1); rb.y = __builtin_bit_cast(unsigned, w2); rb.z = 0u; rb.w = 0u;
                *(v4u*)(RT + (size_t)rr[u] * 8) = ra; *(v4u*)(RT + (size_t)rr[u] * 8 + 4) = rb;
            }
        }
    }
#undef RT_ISSUE
#undef RT_W4
    __syncthreads();
    if (F.tid < 16) HIST[F.bid * 16 + F.tid] = (int)F.MISC[MI_LH + F.tid];
}
__device__ __forceinline__ void moe_tables(const Frame& F) {
    const int* HIST = (const int*)(F.ws + WS_HIST); LAS int* hl = (LAS int*)F.lds;
    __syncthreads();
    for (int i = F.tid; i < F.G * 16; i += NTHR) hl[i] = HIST[i];
    __syncthreads();
    if (F.tid < 16) { int tot = 0, mine = 0; for (int g = 0; g < F.G; ++g) { const int c = hl[g * 16 + F.tid]; tot += c; mine += (g < F.bid) ? c : 0; }
        F.MISC[MI_TOT + F.tid] = (unsigned)tot; F.MISC[MI_BASE + F.tid] = (unsigned)mine; }
    __syncthreads();
    if (F.tid == 0) { unsigned p = 0; for (int e = 0; e < 16; ++e) { F.MISC[MI_PST + e] = p; F.MISC[MI_BASE + e] += p * 256u; p += (F.MISC[MI_TOT + e] + 255u) >> 8; } F.MISC[MI_PST + 16] = p; }
    __syncthreads();
}
__device__ __forceinline__ void phase_permute(const Frame& F, int l) {
    unsigned* RT = (unsigned*)(F.ws + WS_RT); int* SRC = (int*)(F.ws + WS_QD);
    moe_tables(F);
    const int rpw = rows_per_wave(F.ngw), rbeg = F.gw * rpw, rend = min(M, rbeg + rpw);
    for (int r = rbeg + F.lane; r < rend; r += 64) {
        if (l == NL - 1 && (r % TT) >= SEQ) continue;
        const v4u ra = *(const v4u*)(RT + (size_t)r * 8);
        const unsigned p0 = F.MISC[MI_BASE + (ra.x & 15u)] + ra.z, p1 = F.MISC[MI_BASE + (ra.y & 15u)] + ra.w;
        RT[(size_t)r * 8 + 6] = p0; RT[(size_t)r * 8 + 7] = p1; SRC[p0] = r; SRC[p1] = r;
    }
    if (F.bid == 0) {
        for (int e = 0; e < 16; ++e) { const int beg = (int)F.MISC[MI_PST + e] * 256 + (int)F.MISC[MI_TOT + e], end = (int)F.MISC[MI_PST + e + 1] * 256;
            for (int p = beg + F.tid; p < end; p += NTHR) SRC[p] = 0; }
    }
}

struct EpiMla {
    static constexpr bool PERM = true, AFTER_DRAIN = false;
    bf16* QD; bf16* KD; bf16* VD;
    __device__ __forceinline__ void operator()(const pg8::f32x4 (&acc)[2][2][4][2], const pg8::Unit& u, int wr, int wc, int fr, int fq) const {
#pragma unroll
        for (int bj = 0; bj < 2; ++bj) {
            const int g0 = u.pn * 256 + bj * 128 + wc * 32, col0 = g0 + 8 * fq;
            if (g0 >= 896) continue;
            const int c = col0 - 384, hd = c >> 7, jx = c & 127;
            bf16* dst = g0 < 384 ? QD + col0 : jx < 64 ? KD + hd * 96 + jx : VD + hd * 64 + (jx - 64);
            const int stride = (g0 < 384 || jx < 64) ? 384 : 256;
            dst += (size_t)(u.pm * 256 + wr * 64 + fr) * stride;
#pragma unroll
            for (int ai = 0; ai < 2; ++ai)
#pragma unroll
                for (int m = 0; m < 4; ++m) {
                    v4u o; o.x = pk2(acc[ai][bj][m][0][0], acc[ai][bj][m][0][1]); o.y = pk2(acc[ai][bj][m][0][2], acc[ai][bj][m][0][3]);
                    o.z = pk2(acc[ai][bj][m][1][0], acc[ai][bj][m][1][1]); o.w = pk2(acc[ai][bj][m][1][2], acc[ai][bj][m][1][3]);
                    *(v4u*)(dst + (size_t)(ai * 128 + m * 16) * stride) = o;
                }
        }
    }
};
struct EpiGU {
    static constexpr bool PERM = true, AFTER_DRAIN = false;
    bf16* ACT;
    __device__ __forceinline__ void operator()(const pg8::f32x4 (&acc)[2][2][4][2], const pg8::Unit& u, int wr, int wc, int fr, int fq) const {
#pragma unroll
        for (int ai = 0; ai < 2; ++ai)
#pragma unroll
            for (int m = 0; m < 4; ++m) {
                const int row = u.pm * 256 + ai * 128 + wr * 64 + m * 16 + fr;
#pragma unroll
                for (int bj = 0; bj < 2; ++bj) {
                    const int c = (u.pn & 3) * 256 + bj * 128 + wc * 32 + 8 * fq;
                    float o[4];
#pragma unroll
                    for (int i = 0; i < 4; ++i) { const float g = acc[ai][bj][m][0][i], up = acc[ai][bj][m][1][i]; o[i] = g * __builtin_amdgcn_rcpf(1.0f + __expf(-g)) * up; }
                    v2u w; w.x = pk2(o[0], o[1]); w.y = pk2(o[2], o[3]);
                    *(v2u*)(ACT + (size_t)row * 512 + (c >> 1)) = w;
                }
            }
    }
};
struct MoeOrder {
    volatile LAS unsigned* pst; int G, c;
    __device__ __forceinline__ bool next(int i, pg8::Unit& u) const {
        const int np = (int)pst[16]; int panel, pn;
        if ((G & 7) == 0) { const int x = c & 7, uu = i * (G >> 3) + (c >> 3); panel = (uu >> 2) * 8 + x; pn = uu & 3; }
        else { const int L = i * G + c; panel = L >> 2; pn = L & 3; }
        if (panel >= np) return false;
        int e = 0;
#pragma unroll
        for (int k = 1; k < 16; ++k) e += (panel >= (int)pst[k]) ? 1 : 0;
        u.pm = __builtin_amdgcn_readfirstlane(panel); u.pn = __builtin_amdgcn_readfirstlane(e * 4 + pn); return true;
    }
    __device__ __forceinline__ void a_ready(const pg8::Unit&) const {}
    __device__ __forceinline__ void done(const pg8::Unit&) const {}
};

struct LatOrder {
    int G, c;
    __device__ __forceinline__ bool next(int i, pg8::Unit& u) const {
        int pl, pn;
        if ((G & 7) == 0) { const int x = c & 7, uu = i * (G >> 3) + (c >> 3); pl = (uu >> 2) * 8 + x; pn = uu & 3; } else { const int L = i * G + c; pl = L >> 2; pn = L & 3; }
        if (pl >= NB * 16) return false;
        u.pm = pl + (pl >> 4); u.pn = pn; return true;
    }
    __device__ __forceinline__ void a_ready(const pg8::Unit&) const {}
    __device__ __forceinline__ void done(const pg8::Unit&) const {}
};

#ifndef DBG_VAR
#define DBG_VAR 1
#endif
namespace att {
constexpr int VRS = 192, KBUF = 64 * 208, VBUF = 64 * VRS, BUF = KBUF + VBUF, BIAS_OFF = 4 * BUF;
constexpr float NEG = -30000.0f;
__device__ __forceinline__ int crow(int r, int hi) { return (r & 3) + 8 * (r >> 2) + 4 * hi; }
__device__ __forceinline__ float xhalf_max(float v) { const unsigned a = __builtin_bit_cast(unsigned, v);
    auto rr = __builtin_amdgcn_permlane32_swap(a, a, false, false); const unsigned r0 = rr[0], r1 = rr[1]; return fmaxf(__uint_as_float(r0), __uint_as_float(r1)); }
__device__ __forceinline__ float xhalf_sum(float v) { const unsigned a = __builtin_bit_cast(unsigned, v);
    auto rr = __builtin_amdgcn_permlane32_swap(a, a, false, false); const unsigned r0 = rr[0], r1 = rr[1]; return __uint_as_float(r0) + __uint_as_float(r1); }
__device__ __forceinline__ float max3f(float a, float b, float c) { float r; asm("v_max3_f32 %0, %1, %2, %3" : "=v"(r) : "v"(a), "v"(b), "v"(c)); return r; }
typedef __bf16 bf16x2_t __attribute__((ext_vector_type(2)));
__device__ __forceinline__ unsigned cvtpk(float lo, float hi) { f32x2 v = {lo, hi}; bf16x2_t b = __builtin_convertvector(v, bf16x2_t); return __builtin_bit_cast(unsigned, b); }

template <int DK, int VM = 0>
__device__ __forceinline__ void unit(LAS unsigned char* lds, const bf16* Qp, int qpitch, const bf16* Kp, int kpitch, const bf16* Vp, int vpitch, bf16* Op,
                                     int var, int qt, int lo, int n1, int nt, float qscale, float sinkl2, bool has_sink, const LAS float* bias, const float* t32, unsigned* dbg) {
    constexpr int KRS = DK * 2 + 16, NS = DK / 16, CPK = DK / 8;
    int tid = threadIdx.x; asm volatile("" : "+v"(tid)); const int lane = tid & 63, r32 = lane & 31, hi = lane >> 5, wid = __builtin_amdgcn_readfirstlane(tid >> 6);
    const int qrow = 256 * qt + 32 * wid + r32;
    bf16x8 qr[NS];
#pragma unroll
    for (int s = 0; s < NS; ++s) { const v4u raw = *(const v4u*)(Qp + (size_t)qrow * qpitch + 16 * s + 8 * hi); float f[8]; unpack8(raw, f);
#pragma unroll
        for (int i = 0; i < 8; ++i) f[i] *= qscale;
        if (DK == 96 && s >= 4) {
            float p[8];
#pragma unroll
            for (int i = 0; i < 8; ++i) p[i] = __shfl_xor(f[i], 32);
            if (qt < 16) rope8(f, p, t32 + ((size_t)((s == 4 ? (qrow >> 6) : (qrow & 63)) * 8)) * 2, hi == 0);
        }
        qr[s] = __builtin_bit_cast(bf16x8, pack8(f)); }
    const int kkey0 = tid / CPK, kch0 = tid - kkey0 * CPK, kkey1 = (tid + 512) / CPK, kch1 = (tid + 512) - kkey1 * CPK;
    const int vkey = tid >> 3, vch = tid & 7;
    v4u kreg0, kreg1 = {0u, 0u, 0u, 0u}, vreg;
#define ATT_TROW(j) ((((j) < n1) ? (lo + (j)) : (64 + (j) - n1)) * 64)
#define ATT_LOAD(j) do { const int tr_ = ATT_TROW(j); kreg0 = *(const v4u*)(Kp + (size_t)(tr_ + kkey0) * kpitch + kch0 * 8); \
        if (DK == 96 && tid < 256) kreg1 = *(const v4u*)(Kp + (size_t)(tr_ + kkey1) * kpitch + kch1 * 8); \
        vreg = *(const v4u*)(Vp + (size_t)(tr_ + vkey) * vpitch + vch * 8); } while (0)
#define ATT_STORE(bf) do { LAS unsigned char* b_ = lds + (bf) * BUF; *(LAS v4u*)(b_ + kkey0 * KRS + kch0 * 16) = kreg0; \
        if (DK == 96 && tid < 256) *(LAS v4u*)(b_ + kkey1 * KRS + kch1 * 16) = kreg1; \
        *(LAS v4u*)(b_ + KBUF + vkey * VRS + vch * 16) = vreg; } while (0)
    constexpr float THR = 6.0f;
    float m = 0.f; f32x2 lacc = {0.f, 0.f}; f32x16 o0 = {}, o1 = {}; f32x16 negm = {}; bool first = true;
    const int grw = 4 * qt + (wid >> 1), r0w = min(max(grw - 4, 0), 56), gc = (wid & 1) * 32 + r32, c0 = min(max(gc - 8, 0), 48), i0w = 256 * qt + 32 * wid;
    ATT_LOAD(0); ATT_STORE(0);
    __syncthreads();
    for (int j = 0; j < nt; ++j) {
        if (!(VM & 8) && j + 1 < nt) ATT_LOAD(j + 1);
        const int kt = ATT_TROW(j) >> 6;
        bool actv = true;
        if (kt < 64) { if (var == 0) actv = (kt >= r0w) && (kt <= r0w + 7); else if (var == 2) actv = !((64 * kt - (i0w + 31) > 128) || (i0w - (64 * kt + 63) > 128)); }
        if (actv) {
            const LAS unsigned char* Kb = lds + (j & 1) * BUF; const LAS unsigned char* Vb = Kb + KBUF;
            f32x16 s0 = negm, s1 = negm;
            bf16x8 ka[NS], kb[NS];
#pragma unroll
            for (int s = 0; s < NS; ++s) { ka[s] = *(const LAS bf16x8*)(Kb + r32 * KRS + (16 * s + 8 * hi) * 2); kb[s] = *(const LAS bf16x8*)(Kb + (32 + r32) * KRS + (16 * s + 8 * hi) * 2); }
            __builtin_amdgcn_sched_barrier(0);
            if (VM & 2) {
#pragma unroll
                for (int s = 0; s < NS; ++s) asm volatile("" :: "v"(ka[s]), "v"(kb[s]), "v"(qr[s]));
            } else {
#pragma unroll
            for (int s = 0; s < NS; ++s) { s0 = __builtin_amdgcn_mfma_f32_32x32x16_bf16(ka[s], qr[s], s0, 0, 0, 0); s1 = __builtin_amdgcn_mfma_f32_32x32x16_bf16(kb[s], qr[s], s1, 0, 0, 0); }
            }
            asm volatile("s_nop 15\n\ts_nop 7" : "+v"(s0), "+v"(s1));
            if (kt < 64 && var == 0) {
                const int rowoff = (kt - grw + 7) * 31 - gc + 15;
#pragma unroll
                for (int r = 0; r < 16; ++r) { const int j0 = crow(r, hi), j1 = j0 + 32;
                    const bool v0 = (unsigned)(j0 - c0) < 16u, v1 = (unsigned)(j1 - c0) < 16u;
                    const float b0 = bias[v0 ? rowoff + j0 : 0], b1 = bias[v1 ? rowoff + j1 : 0];
                    s0[r] = v0 ? s0[r] + b0 : NEG; s1[r] = v1 ? s1[r] + b1 : NEG; }
            } else if (kt < 64 && var == 2) {
                const int dbase = 64 * kt - qrow + 128;
#pragma unroll
                for (int r = 0; r < 16; ++r) { const int j0 = crow(r, hi);
                    s0[r] = (unsigned)(dbase + j0) <= 256u ? s0[r] : NEG; s1[r] = (unsigned)(dbase + j0 + 32) <= 256u ? s1[r] : NEG; }
            }
            if (!(VM & 4)) {
            float mxa = max3f(s0[0], s0[1], s1[0]), mxb = max3f(s0[2], s0[3], s1[1]); mxa = max3f(mxa, s1[2], s1[3]);
#pragma unroll
            for (int r = 4; r < 16; r += 4) { mxa = max3f(mxa, s0[r], s0[r + 1]); mxb = max3f(mxb, s0[r + 2], s0[r + 3]); mxa = max3f(mxa, s1[r], s1[r + 1]); mxb = max3f(mxb, s1[r + 2], s1[r + 3]); }
            const float mx = xhalf_max(fmaxf(mxa, mxb));
            if (first || __any(mx > THR)) {
                const float d = first ? fmaxf(mx, -64.0f) : fmaxf(mx, 0.f), alpha = __builtin_amdgcn_exp2f(-d);
                m += d; first = false;
#pragma unroll
                for (int r = 0; r < 16; ++r) { s0[r] -= d; s1[r] -= d; o0[r] *= alpha; o1[r] *= alpha; negm[r] = -m; }
                lacc *= alpha;
            }
#pragma unroll
            for (int r = 0; r < 16; ++r) { s0[r] = __builtin_amdgcn_exp2f(s0[r]); s1[r] = __builtin_amdgcn_exp2f(s1[r]); lacc += (f32x2){s0[r], s1[r]}; }
            }
            bf16x8 pb[4];
#pragma unroll
            for (int s = 0; s < 2; ++s) {
                v4u w; w.x = cvtpk(s0[8 * s], s0[8 * s + 1]); w.y = cvtpk(s0[8 * s + 2], s0[8 * s + 3]); w.z = cvtpk(s0[8 * s + 4], s0[8 * s + 5]); w.w = cvtpk(s0[8 * s + 6], s0[8 * s + 7]);
                pb[s] = __builtin_bit_cast(bf16x8, w);
                v4u x; x.x = cvtpk(s1[8 * s], s1[8 * s + 1]); x.y = cvtpk(s1[8 * s + 2], s1[8 * s + 3]); x.z = cvtpk(s1[8 * s + 4], s1[8 * s + 5]); x.w = cvtpk(s1[8 * s + 6], s1[8 * s + 7]);
                pb[2 + s] = __builtin_bit_cast(bf16x8, x);
            }
            if (VM & 1) { asm volatile("" :: "v"(pb[0]), "v"(pb[1]), "v"(pb[2]), "v"(pb[3])); } else {
            const LAS unsigned char* vbase = Vb + (4 * hi + ((lane & 15) >> 2)) * VRS + ((lane >> 4) & 1) * 32 + (lane & 3) * 8;
#pragma unroll
            for (int s = 0; s < 4; ++s) {
                const v4i16 a0 = __builtin_amdgcn_ds_read_tr16_b64_v4i16((LAS v4i16*)(vbase + (16 * s) * VRS));
                const v4i16 a1 = __builtin_amdgcn_ds_read_tr16_b64_v4i16((LAS v4i16*)(vbase + (16 * s + 8) * VRS));
                const v4i16 c0_ = __builtin_amdgcn_ds_read_tr16_b64_v4i16((LAS v4i16*)(vbase + (16 * s) * VRS + 64));
                const v4i16 c1_ = __builtin_amdgcn_ds_read_tr16_b64_v4i16((LAS v4i16*)(vbase + (16 * s + 8) * VRS + 64));
                const bf16x8 va = {a0[0], a0[1], a0[2], a0[3], a1[0], a1[1], a1[2], a1[3]};
                const bf16x8 vc = {c0_[0], c0_[1], c0_[2], c0_[3], c1_[0], c1_[1], c1_[2], c1_[3]};
                o0 = __builtin_amdgcn_mfma_f32_32x32x16_bf16(va, pb[s], o0, 0, 0, 0);
                o1 = __builtin_amdgcn_mfma_f32_32x32x16_bf16(vc, pb[s], o1, 0, 0, 0);
            }
            }
        }
        if (!(VM & 8) && j + 1 < nt) ATT_STORE((j + 1) & 1);
        if (!(VM & 16)) __syncthreads();
    }
    float l = xhalf_sum(lacc.x + lacc.y);
    const float sterm = has_sink ? __builtin_amdgcn_exp2f(sinkl2 - m) : 0.f;
#if MK_DEBUG
    if (dbg && hi == 0) { dbg[(size_t)qrow * 2] = __builtin_bit_cast(unsigned, m); dbg[(size_t)qrow * 2 + 1] = __builtin_bit_cast(unsigned, l); }
#endif
    if (has_sink) l += sterm;
    const float inv = 1.0f / l;
    bf16* orow = Op + (size_t)qrow * D;
#pragma unroll
    for (int g = 0; g < 4; ++g) {
        v2u w0; w0.x = pk2(o0[4 * g] * inv, o0[4 * g + 1] * inv); w0.y = pk2(o0[4 * g + 2] * inv, o0[4 * g + 3] * inv);
        v2u w1; w1.x = pk2(o1[4 * g] * inv, o1[4 * g + 1] * inv); w1.y = pk2(o1[4 * g + 2] * inv, o1[4 * g + 3] * inv);
        *(v2u*)(orow + 8 * g + 4 * hi) = w0; *(v2u*)(orow + 32 + 8 * g + 4 * hi) = w1;
    }
#undef ATT_TROW
#undef ATT_LOAD
#undef ATT_STORE
}

template <int DK, int MODE, int VM = 0, bool NOREF = false>
__device__ __forceinline__ void unit2(LAS unsigned char* lds, const bf16* Qp, int qpitch, const bf16* Kp, int kpitch, const bf16* Vp, int vpitch, bf16* Op,
                                      int var, int qt, int lo, int n1, int nt, float qscale, float sink0, float sink1, bool has_sink, const LAS float* bias, const float* t32) {
    constexpr int KRS = DK * 2 + 16, NS = DK / 16, CPK = DK / 8;
    int tid = threadIdx.x; asm volatile("" : "+v"(tid)); const int lane = tid & 63, r32 = lane & 31, hi = lane >> 5, wid = __builtin_amdgcn_readfirstlane(tid >> 6);
    const int rowbase = MODE == 0 ? 512 * qt + 64 * wid : 256 * qt + 32 * wid;
    bf16x8 qr[2][NS];
#pragma unroll
    for (int u = 0; u < 2; ++u) {
        const int qrow = rowbase + (MODE == 0 ? 32 * u : 0) + r32;
        const bf16* qp = Qp + (MODE == 1 ? 64 * u : 0) + (size_t)qrow * qpitch;
#pragma unroll
        for (int s = 0; s < NS; ++s) { const v4u raw = *(const v4u*)(qp + 16 * s + 8 * hi); float f[8]; unpack8(raw, f);
#pragma unroll
            for (int i = 0; i < 8; ++i) f[i] *= qscale;
            if (DK == 96 && s >= 4) { float p[8];
#pragma unroll
                for (int i = 0; i < 8; ++i) p[i] = __shfl_xor(f[i], 32);
                rope8(f, p, t32 + ((size_t)((s == 4 ? (qrow >> 6) : (qrow & 63)) * 8)) * 2, hi == 0); }
            qr[u][s] = __builtin_bit_cast(bf16x8, pack8(f)); }
    }
    const int kkey0 = tid / CPK, kch0 = tid - kkey0 * CPK, kkey1 = (tid + 512) / CPK, kch1 = (tid + 512) - kkey1 * CPK;
    const int vkey = tid >> 3, vch = tid & 7;
    v4u kreg0, kreg1 = {0u, 0u, 0u, 0u}, vreg;
#define ATT_TROW(j) ((((j) < n1) ? (lo + (j)) : (64 + (j) - n1)) * 64)
#define ATT_LOAD(j) do { const int tr_ = ATT_TROW(j); kreg0 = *(const v4u*)(Kp + (size_t)(tr_ + kkey0) * kpitch + kch0 * 8); \
        if (DK == 96 && tid < 256) kreg1 = *(const v4u*)(Kp + (size_t)(tr_ + kkey1) * kpitch + kch1 * 8); \
        vreg = *(const v4u*)(Vp + (size_t)(tr_ + vkey) * vpitch + vch * 8); } while (0)
#define ATT_STORE(bf) do { LAS unsigned char* b_ = lds + (bf) * BUF; *(LAS v4u*)(b_ + kkey0 * KRS + kch0 * 16) = kreg0; \
        if (DK == 96 && tid < 256) *(LAS v4u*)(b_ + kkey1 * KRS + kch1 * 16) = kreg1; \
        *(LAS v4u*)(b_ + KBUF + vkey * VRS + vch * 16) = vreg; } while (0)
    constexpr float THR = 6.0f;
    float m = 0.f; f32x2 lacc[2] = {{0.f, 0.f}, {0.f, 0.f}}; f32x16 o0[2] = {{}, {}}, o1[2] = {{}, {}}; bool first = true;
    const int grw = 8 * qt + wid, r0w = min(max(grw - 4, 0), 56), i0w = rowbase;
    ATT_LOAD(0); ATT_STORE(0);
    __syncthreads();
    for (int j = 0; j < nt; ++j) {
        if (!(VM & 8) && j + 1 < nt) ATT_LOAD(j + 1);
        const int kt = ATT_TROW(j) >> 6;
        bool actv = true;
        if (kt < 64) { if (var == 0) actv = (kt >= r0w) && (kt <= r0w + 7); else if (var == 2) actv = !((64 * kt - (i0w + 31) > 128) || (i0w - (64 * kt + 63) > 128)); }
        if (actv) {
            const LAS unsigned char* Kb = lds + (j & 1) * BUF; const LAS unsigned char* Vb = Kb + KBUF;
            f32x16 s0[2] = {{}, {}}, s1[2] = {{}, {}};
#pragma unroll
            for (int s = 0; s < NS; ++s) {
                const bf16x8 ka = *(const LAS bf16x8*)(Kb + r32 * KRS + (16 * s + 8 * hi) * 2);
                const bf16x8 kb = *(const LAS bf16x8*)(Kb + (32 + r32) * KRS + (16 * s + 8 * hi) * 2);
                if (VM & 2) { asm volatile("" :: "v"(ka), "v"(kb), "v"(qr[0][s]), "v"(qr[1][s])); } else {
#pragma unroll
                for (int u = 0; u < 2; ++u) { s0[u] = __builtin_amdgcn_mfma_f32_32x32x16_bf16(ka, qr[u][s], s0[u], 0, 0, 0); s1[u] = __builtin_amdgcn_mfma_f32_32x32x16_bf16(kb, qr[u][s], s1[u], 0, 0, 0); }
                }
            }
            asm volatile("s_nop 15\n\ts_nop 7" : "+v"(s0[0]), "+v"(s1[0]), "+v"(s0[1]), "+v"(s1[1]));
            if (kt < 64 && var == 0) {
#pragma unroll
                for (int u = 0; u < 2; ++u) { const int gc = 32 * u + r32, c0 = min(max(gc - 8, 0), 48), rowoff = (kt - grw + 7) * 31 - gc + 15;
#pragma unroll
                    for (int r = 0; r < 16; ++r) { const int j0 = crow(r, hi), j1 = j0 + 32;
                        const bool v0 = (unsigned)(j0 - c0) < 16u, v1 = (unsigned)(j1 - c0) < 16u;
                        const float b0 = bias[v0 ? rowoff + j0 : 0], b1 = bias[v1 ? rowoff + j1 : 0];
                        s0[u][r] = v0 ? s0[u][r] + b0 : NEG; s1[u][r] = v1 ? s1[u][r] + b1 : NEG; } }
            } else if (kt < 64 && var == 2) {
                const int dbase = 64 * kt - (rowbase + r32) + 128;
#pragma unroll
                for (int r = 0; r < 16; ++r) { const int j0 = crow(r, hi); const bool v0 = (unsigned)(dbase + j0) <= 256u, v1 = (unsigned)(dbase + j0 + 32) <= 256u;
                    s0[0][r] = v0 ? s0[0][r] : NEG; s1[0][r] = v1 ? s1[0][r] : NEG; s0[1][r] = v0 ? s0[1][r] : NEG; s1[1][r] = v1 ? s1[1][r] : NEG; }
            }
            if (!(VM & 4)) {
            if (!NOREF) {
            float mxa = max3f(s0[0][0], s0[0][1], s1[0][0]), mxb = max3f(s0[1][0], s0[1][1], s1[1][0]);
#pragma unroll
            for (int r = 0; r < 16; r += 2) { if (r) { mxa = max3f(mxa, s0[0][r], s0[0][r + 1]); mxb = max3f(mxb, s0[1][r], s0[1][r + 1]); }
                if (r) { mxa = max3f(mxa, s1[0][r], s1[0][r + 1]); mxb = max3f(mxb, s1[1][r], s1[1][r + 1]); } else { mxa = fmaxf(mxa, s1[0][1]); mxb = fmaxf(mxb, s1[1][1]); } }
            const float mx = xhalf_max(fmaxf(mxa, mxb)) - m;
            if (first || __any(mx > THR)) {
                const float d = first ? fmaxf(mx, -64.0f) : fmaxf(mx, 0.f), alpha = __builtin_amdgcn_exp2f(-d);
                m += d; first = false;
#pragma unroll
                for (int u = 0; u < 2; ++u) {
#pragma unroll
                    for (int r = 0; r < 16; ++r) { o0[u][r] *= alpha; o1[u][r] *= alpha; }
                    lacc[u] *= alpha; }
            }
            }
            }
            bf16x8 pb[2][4];
#pragma unroll
            for (int u = 0; u < 2; ++u) {
                if (!(VM & 4))
#pragma unroll
                for (int r = 0; r < 16; ++r) { s0[u][r] = __builtin_amdgcn_exp2f(NOREF ? s0[u][r] : s0[u][r] - m); s1[u][r] = __builtin_amdgcn_exp2f(NOREF ? s1[u][r] : s1[u][r] - m); lacc[u] += (f32x2){s0[u][r], s1[u][r]}; }
#pragma unroll
                for (int s = 0; s < 2; ++s) {
                    v4u w; w.x = cvtpk(s0[u][8 * s], s0[u][8 * s + 1]); w.y = cvtpk(s0[u][8 * s + 2], s0[u][8 * s + 3]); w.z = cvtpk(s0[u][8 * s + 4], s0[u][8 * s + 5]); w.w = cvtpk(s0[u][8 * s + 6], s0[u][8 * s + 7]);
                    pb[u][s] = __builtin_bit_cast(bf16x8, w);
                    v4u x; x.x = cvtpk(s1[u][8 * s], s1[u][8 * s + 1]); x.y = cvtpk(s1[u][8 * s + 2], s1[u][8 * s + 3]); x.z = cvtpk(s1[u][8 * s + 4], s1[u][8 * s + 5]); x.w = cvtpk(s1[u][8 * s + 6], s1[u][8 * s + 7]);
                    pb[u][2 + s] = __builtin_bit_cast(bf16x8, x);
                }
            }
            if (VM & 1) { asm volatile("" :: "v"(pb[0][0]), "v"(pb[0][1]), "v"(pb[0][2]), "v"(pb[0][3]), "v"(pb[1][0]), "v"(pb[1][1]), "v"(pb[1][2]), "v"(pb[1][3])); } else {
            const LAS unsigned char* vbase = Vb + (4 * hi + ((lane & 15) >> 2)) * VRS + ((lane >> 4) & 1) * 32 + (lane & 3) * 8;
#pragma unroll
            for (int s = 0; s < 4; ++s) {
                const v4i16 a0 = __builtin_amdgcn_ds_read_tr16_b64_v4i16((LAS v4i16*)(vbase + (16 * s) * VRS));
                const v4i16 a1 = __builtin_amdgcn_ds_read_tr16_b64_v4i16((LAS v4i16*)(vbase + (16 * s + 8) * VRS));
                const v4i16 c0_ = __builtin_amdgcn_ds_read_tr16_b64_v4i16((LAS v4i16*)(vbase + (16 * s) * VRS + 64));
                const v4i16 c1_ = __builtin_amdgcn_ds_read_tr16_b64_v4i16((LAS v4i16*)(vbase + (16 * s + 8) * VRS + 64));
                const bf16x8 va = {a0[0], a0[1], a0[2], a0[3], a1[0], a1[1], a1[2], a1[3]};
                const bf16x8 vc = {c0_[0], c0_[1], c0_[2], c0_[3], c1_[0], c1_[1], c1_[2], c1_[3]};
#pragma unroll
                for (int u = 0; u < 2; ++u) { o0[u] = __builtin_amdgcn_mfma_f32_32x32x16_bf16(va, pb[u][s], o0[u], 0, 0, 0); o1[u] = __builtin_amdgcn_mfma_f32_32x32x16_bf16(vc, pb[u][s], o1[u], 0, 0, 0); }
            }
            }
        }
        if (!(VM & 8) && j + 1 < nt) ATT_STORE((j + 1) & 1);
        if (!(VM & 16)) __syncthreads();
    }
#pragma unroll
    for (int u = 0; u < 2; ++u) {
        float l = xhalf_sum(lacc[u].x + lacc[u].y);
        if (has_sink) l += __builtin_amdgcn_exp2f((u == 0 ? sink0 : sink1) - m);
        const float inv = 1.0f / l;
        const int qrow = rowbase + (MODE == 0 ? 32 * u : 0) + r32;
        bf16* orow = Op + (MODE == 1 ? 64 * u : 0) + (size_t)qrow * D;
#pragma unroll
        for (int g = 0; g < 4; ++g) {
            v2u w0; w0.x = pk2(o0[u][4 * g] * inv, o0[u][4 * g + 1] * inv); w0.y = pk2(o0[u][4 * g + 2] * inv, o0[u][4 * g + 3] * inv);
            v2u w1; w1.x = pk2(o1[u][4 * g] * inv, o1[u][4 * g + 1] * inv); w1.y = pk2(o1[u][4 * g + 2] * inv, o1[u][4 * g + 3] * inv);
            *(v2u*)(orow + 8 * g + 4 * hi) = w0; *(v2u*)(orow + 32 + 8 * g + 4 * hi) = w1;
        }
    }
#undef ATT_TROW
#undef ATT_LOAD
#undef ATT_STORE
}

#define ATT_BAR() do { asm volatile("s_waitcnt lgkmcnt(0)" ::: "memory"); __builtin_amdgcn_s_barrier(); asm volatile("" ::: "memory"); } while (0)
template <int DK, int MODE, int VM = 0>
__device__ __forceinline__ bool unit_h(LAS unsigned char* lds, const bf16* Qp, int qpitch, const bf16* Kp, int kpitch, const bf16* Vp, int vpitch, bf16* Op,
                                       int var, int qt, int lo, int n1, int nt, float qscale, float sink0, float sink1, bool has_sink, const LAS float* bias, const float* t32, volatile LAS unsigned* flag) {
    constexpr int KRS = DK * 2 + 16, NS = DK / 16, CPK = DK / 8;
    int tid = threadIdx.x; asm volatile("" : "+v"(tid)); const int lane = tid & 63, r32 = lane & 31, hi = lane >> 5, wid = __builtin_amdgcn_readfirstlane(tid >> 6);
    const int rowbase = MODE == 0 ? 512 * qt + 64 * wid : 256 * qt + 32 * wid;
    const int kkey0 = tid / CPK, kch0 = tid - kkey0 * CPK, kkey1 = (tid + 512) / CPK, kch1 = (tid + 512) - kkey1 * CPK;
    const int vkey = tid >> 3, vch = tid & 7;
    v4u kreg0, kreg1 = {0u, 0u, 0u, 0u}, vreg;
#define ATT_TROW(j) ((((j) < n1) ? (lo + (j)) : (64 + (j) - n1)) * 64)
#define ATT_LOAD(j) do { const int tr_ = ATT_TROW(j); kreg0 = *(const v4u*)(Kp + (size_t)(tr_ + kkey0) * kpitch + kch0 * 8); \
        if (DK == 96 && tid < 256) kreg1 = *(const v4u*)(Kp + (size_t)(tr_ + kkey1) * kpitch + kch1 * 8); \
        vreg = *(const v4u*)(Vp + (size_t)(tr_ + vkey) * vpitch + vch * 8); } while (0)
#define ATT_STORE(bf) do { LAS unsigned char* b_ = lds + (bf) * BUF; *(LAS v4u*)(b_ + kkey0 * KRS + kch0 * 16) = kreg0; \
        if (DK == 96 && tid < 256) *(LAS v4u*)(b_ + kkey1 * KRS + kch1 * 16) = kreg1; \
        *(LAS v4u*)(b_ + KBUF + vkey * VRS + vch * 16) = vreg; } while (0)
    ATT_LOAD(0);
    bf16x8 qr[2][NS];
#pragma unroll
    for (int u = 0; u < 2; ++u) {
        const int qrow = rowbase + (MODE == 0 ? 32 * u : 0) + r32;
        const bf16* qp = Qp + (MODE == 1 ? 64 * u : 0) + (size_t)qrow * qpitch;
#pragma unroll
        for (int s = 0; s < NS; ++s) { const v4u raw = *(const v4u*)(qp + 16 * s + 8 * hi); float f[8]; unpack8(raw, f);
#pragma unroll
            for (int i = 0; i < 8; ++i) f[i] *= qscale;
            if (DK == 96 && s >= 4) { float p[8];
#pragma unroll
                for (int i = 0; i < 8; ++i) p[i] = __shfl_xor(f[i], 32);
                rope8(f, p, t32 + ((size_t)((s == 4 ? (qrow >> 6) : (qrow & 63)) * 8)) * 2, hi == 0); }
            qr[u][s] = __builtin_bit_cast(bf16x8, pack8(f)); }
    }
    f32x2 lacc[2] = {{0.f, 0.f}, {0.f, 0.f}}; f32x16 o0[2] = {{}, {}}, o1[2] = {{}, {}};
    const int grw = 8 * qt + wid, r0w = min(max(grw - 4, 0), 56), i0w = rowbase;
    ATT_STORE(0);
    if (tid == 0) *flag = 0u;
    ATT_BAR();
    for (int j = 0; j < nt; ++j) {
        if (!(VM & 8) && j + 1 < nt) ATT_LOAD(j + 1);
        const int kt = ATT_TROW(j) >> 6;
        bool actv = true;
        if (kt < 64) { if (var == 0) actv = (kt >= r0w) && (kt <= r0w + 7); else if (var == 2) actv = !((64 * kt - (i0w + 31) > 128) || (i0w - (64 * kt + 63) > 128)); }
        if (actv) {
        const LAS unsigned char* Kb = lds + (j & 1) * BUF; const LAS unsigned char* Vb = Kb + KBUF;
        const LAS unsigned char* vbase = Vb + (4 * hi + ((lane & 15) >> 2)) * VRS + ((lane >> 4) & 1) * 32 + (lane & 3) * 8;
#pragma unroll
        for (int hf = 0; hf < 2; ++hf) {
            f32x16 sc[2] = {{}, {}};
#pragma unroll
            for (int s = 0; s < NS; ++s) {
                const bf16x8 kf = *(const LAS bf16x8*)(Kb + (32 * hf + r32) * KRS + (16 * s + 8 * hi) * 2);
#pragma unroll
                for (int u = 0; u < 2; ++u) sc[u] = __builtin_amdgcn_mfma_f32_32x32x16_bf16(kf, qr[u][s], sc[u], 0, 0, 0);
            }
            if (kt < 64 && var == 0) {
#pragma unroll
                for (int u = 0; u < 2; ++u) { const int gc = 32 * u + r32, c0 = min(max(gc - 8, 0), 48), rowoff = (kt - grw + 7) * 31 - gc + 15;
                    const LAS unsigned char* bb = (const LAS unsigned char*)(bias + rowoff + 4 * hi); asm volatile("" : "+v"(bb));
                    float bv[16];
#pragma unroll
                    for (int r = 0; r < 16; ++r) bv[r] = *(const LAS float*)(bb + 4 * (32 * hf + (r & 3) + 8 * (r >> 2)));
                    asm volatile("" : "+v"(bv[0]), "+v"(bv[1]), "+v"(bv[2]), "+v"(bv[3]), "+v"(bv[4]), "+v"(bv[5]), "+v"(bv[6]), "+v"(bv[7]),
                                      "+v"(bv[8]), "+v"(bv[9]), "+v"(bv[10]), "+v"(bv[11]), "+v"(bv[12]), "+v"(bv[13]), "+v"(bv[14]), "+v"(bv[15]));
#pragma unroll
                    for (int r = 0; r < 16; ++r) { const int jj = 32 * hf + crow(r, hi); const bool v = (unsigned)(jj - c0) < 16u; sc[u][r] = v ? sc[u][r] + bv[r] : NEG; } }
            } else if (kt < 64 && var == 2) {
                const int dbase = 64 * kt - (rowbase + r32) + 128;
#pragma unroll
                for (int r = 0; r < 16; ++r) { const bool v = (unsigned)(dbase + 32 * hf + crow(r, hi)) <= 256u; sc[0][r] = v ? sc[0][r] : NEG; sc[1][r] = v ? sc[1][r] : NEG; }
            }
            bf16x8 pb[2][2];
#pragma unroll
            for (int u = 0; u < 2; ++u) {
#pragma unroll
                for (int r = 0; r < 16; r += 2) { sc[u][r] = __builtin_amdgcn_exp2f(sc[u][r]); sc[u][r + 1] = __builtin_amdgcn_exp2f(sc[u][r + 1]); lacc[u] += (f32x2){sc[u][r], sc[u][r + 1]}; }
#pragma unroll
                for (int s = 0; s < 2; ++s) {
                    v4u w; w.x = cvtpk(sc[u][8 * s], sc[u][8 * s + 1]); w.y = cvtpk(sc[u][8 * s + 2], sc[u][8 * s + 3]); w.z = cvtpk(sc[u][8 * s + 4], sc[u][8 * s + 5]); w.w = cvtpk(sc[u][8 * s + 6], sc[u][8 * s + 7]);
                    pb[u][s] = __builtin_bit_cast(bf16x8, w);
                }
            }
#pragma unroll
            for (int s2 = 0; s2 < 2; ++s2) { const int s = 2 * hf + s2;
                const v4i16 a0 = __builtin_amdgcn_ds_read_tr16_b64_v4i16((LAS v4i16*)(vbase + (16 * s) * VRS));
                const v4i16 a1 = __builtin_amdgcn_ds_read_tr16_b64_v4i16((LAS v4i16*)(vbase + (16 * s + 8) * VRS));
                const v4i16 c0_ = __builtin_amdgcn_ds_read_tr16_b64_v4i16((LAS v4i16*)(vbase + (16 * s) * VRS + 64));
                const v4i16 c1_ = __builtin_amdgcn_ds_read_tr16_b64_v4i16((LAS v4i16*)(vbase + (16 * s + 8) * VRS + 64));
                const bf16x8 va = {a0[0], a0[1], a0[2], a0[3], a1[0], a1[1], a1[2], a1[3]};
                const bf16x8 vc = {c0_[0], c0_[1], c0_[2], c0_[3], c1_[0], c1_[1], c1_[2], c1_[3]};
#pragma unroll
                for (int u = 0; u < 2; ++u) { o0[u] = __builtin_amdgcn_mfma_f32_32x32x16_bf16(va, pb[u][s2], o0[u], 0, 0, 0); o1[u] = __builtin_amdgcn_mfma_f32_32x32x16_bf16(vc, pb[u][s2], o1[u], 0, 0, 0); }
            }
            __builtin_amdgcn_sched_barrier(0);
        }
        }
        if (!(VM & 8) && j + 1 < nt) ATT_STORE((j + 1) & 1);
        ATT_BAR();
    }
    float lsum[2]; bool bad = false;
#pragma unroll
    for (int u = 0; u < 2; ++u) { lsum[u] = xhalf_sum(lacc[u].x + lacc[u].y); bad = bad || !(lsum[u] > 8.6736174e-19f && lsum[u] < 1.1529215e18f);
        if (has_sink) { lsum[u] += __builtin_amdgcn_exp2f(u == 0 ? sink0 : sink1); bad = bad || !(lsum[u] < 1.1529215e18f); } }
    if (__any(bad)) { if (lane == 0) *flag = 1u; }
#pragma unroll
    for (int u = 0; u < 2; ++u) {
        const float inv = __builtin_amdgcn_rcpf(lsum[u]);
        bf16* orow = Op + (MODE == 1 ? 64 * u : 0) + (size_t)(rowbase + (MODE == 0 ? 32 * u : 0) + r32) * D;
#pragma unroll
        for (int g = 0; g < 4; ++g) {
            v2u w0; w0.x = pk2(o0[u][4 * g] * inv, o0[u][4 * g + 1] * inv); w0.y = pk2(o0[u][4 * g + 2] * inv, o0[u][4 * g + 3] * inv);
            v2u w1; w1.x = pk2(o1[u][4 * g] * inv, o1[u][4 * g + 1] * inv); w1.y = pk2(o1[u][4 * g + 2] * inv, o1[u][4 * g + 3] * inv);
            *(v2u*)(orow + 8 * g + 4 * hi) = w0; *(v2u*)(orow + 32 + 8 * g + 4 * hi) = w1;
        }
    }
    ATT_BAR();
    return *flag == 0u;
#undef ATT_TROW
#undef ATT_LOAD
#undef ATT_STORE
}
}

template <int VM = 0>
__device__ __forceinline__ void phase_attn(const Frame& F, int lq) {
    const int l = lq & 3;
    const bf16* P = (const bf16*)(F.ws + WS_PB); const bf16* QD = (const bf16*)(F.ws + WS_QD); const bf16* KD = (const bf16*)(F.ws + WS_KD);
    const bf16* VD = (const bf16*)(F.ws + WS_VD); bf16* O = (bf16*)(F.ws + (lq >= 4 ? WS_ACT : WS_HA));
    unsigned* ctr = (unsigned*)(F.ws + WS_CTL) + CW_QUEUE + 64 * 8 * lq;
    LAS float* bias = (LAS float*)(F.lds + att::BIAS_OFF);
    { const float* nab = INP(I_NABIAS) + l * 4 * 465; for (int i = F.tid; i < 4 * 465; i += NTHR) bias[i] = nab[i] * LOG2E; }
    const float* sinks = INP(I_SINK) + l * 4;
    __syncthreads();
    const float* t32 = (const float*)(F.ws + WS_T32);
    volatile LAS unsigned* flag = F.MISC + MI_Q + 1;
    const int nloc = 256 + (l < NL - 1 ? 24 : 0);
    const int q0 = (int)xb_xcc_id();
    for (int qq = 0; qq < 8; ++qq) {
      const int q = (q0 + qq) & 7;
      unsigned* qctr = ctr + 64 * q;
      for (;;) {
        if (F.tid == 0) F.MISC[MI_Q] = __hip_atomic_fetch_add(qctr, 1u, __ATOMIC_RELAXED, __HIP_MEMORY_SCOPE_AGENT);
        ATT_BAR();
        const int li = (int)F.MISC[MI_Q];
        ATT_BAR();
        if (li >= nloc) break;
        int idx;
        if (li < 64) idx = (q + 8 * (li >> 3)) * 8 + (li & 7);
        else if (li < 128) { const int jx = li - 64; idx = 1024 + (q + 8 * (jx >> 4)) * 16 + (jx & 15); }
        else if (li < 192) { const int jx = li - 128; idx = 1536 + (q + 8 * (jx >> 3)) * 8 + (jx & 7); }
        else if (li < 256) { const int jx = li - 192; idx = 2048 + (q + 8 * (jx >> 4)) * 16 + (jx & 15); }
        else if (li < 264) idx = 2560 + q + 8 * (li - 256);
        else idx = 2624 + q + 8 * (li - 264);
        if (idx < 512) {
            const int b = idx >> 5, h = (idx >> 3) & 3, qt = idx & 7; const size_t rb = (size_t)b * TT;
            if (!att::unit_h<96, 0, VM>(F.lds, QD + rb * 384 + h * 96, 384, KD + rb * 384 + h * 96, 384, VD + rb * 256 + h * 64, 256, O + rb * D + 768 + h * 64, 3, qt, 0, 64, 68, 0.10206207261596575f * LOG2E, 0.f, 0.f, false, bias, t32, flag)) {
                __syncthreads();
#pragma unroll 1
                for (int k2 = 0; k2 < 2; ++k2)
                    att::unit<96, VM>(F.lds, QD + rb * 384 + h * 96, 384, KD + rb * 384 + h * 96, 384, VD + rb * 256 + h * 64, 256, O + rb * D + 768 + h * 64, 3, 2 * qt + k2, 0, 64, 68, 0.10206207261596575f * LOG2E, 0.f, false, bias, t32, nullptr);
            }
        } else if (idx < 1024) {
        } else if (idx < 2560) {
            idx -= 1024;
            const int grp = idx >> 9, rem = idx & 511, b = rem >> 5; const size_t rb = (size_t)b * TT;
            if (grp == 1) {
                const int h = (rem >> 3) & 3, qt = rem & 7; const int lo = min(max(8 * qt - 4, 0), 56), n1 = min(max(8 * qt + 3, 0), 56) + 7 - lo + 1;
                if (!att::unit_h<64, 0, VM>(F.lds, P + rb * NPJ + h * 64, NPJ, P + rb * NPJ + 256 + h * 64, NPJ, P + rb * NPJ + 512 + h * 64, NPJ, O + rb * D + h * 64, 0, qt, lo, n1, n1 + 4, 0.125f * LOG2E, 0.f, 0.f, false, bias + h * 465, t32, flag)) { __syncthreads();
                att::unit2<64, 0, VM>(F.lds, P + rb * NPJ + h * 64, NPJ, P + rb * NPJ + 256 + h * 64, NPJ, P + rb * NPJ + 512 + h * 64, NPJ, O + rb * D + h * 64, 0, qt, lo, n1, n1 + 4,
                                  0.125f * LOG2E, 0.f, 0.f, false, bias + h * 465, t32); }
            } else {
                const int g = (rem >> 4) & 1, qt = rem & 15; const bool isc = grp == 2;
                const int lo = isc ? max(4 * qt - 2, 0) : 0, n1 = isc ? min(4 * qt + 5, 63) - lo + 1 : 64;
                const int qc = (isc ? 1280 : 768) + g * 128, kc = (isc ? 1536 : 1024) + g * 64, vc = (isc ? 1664 : 1152) + g * 64;
                const float sk0 = isc ? sinks[2 * g] * LOG2E : 0.f, sk1 = isc ? sinks[2 * g + 1] * LOG2E : 0.f;
                if (!att::unit_h<64, 1, VM>(F.lds, P + rb * NPJ + qc, NPJ, P + rb * NPJ + kc, NPJ, P + rb * NPJ + vc, NPJ, O + rb * D + (isc ? 512 : 256) + g * 128, isc ? 2 : 1, qt, lo, n1, n1 + 4, 0.125f * LOG2E, sk0, sk1, isc, bias, t32, flag)) { __syncthreads();
                att::unit2<64, 1, VM>(F.lds, P + rb * NPJ + qc, NPJ, P + rb * NPJ + kc, NPJ, P + rb * NPJ + vc, NPJ, O + rb * D + (isc ? 512 : 256) + g * 128, isc ? 2 : 1, qt, lo, n1, n1 + 4,
                                  0.125f * LOG2E, isc ? sinks[2 * g] * LOG2E : 0.f, isc ? sinks[2 * g + 1] * LOG2E : 0.f, isc, bias, t32); }
            }
        } else if (idx < 2624) {
            const int rem = idx - 2560, b = rem >> 2, isc = (rem >> 1) & 1, g = rem & 1; const size_t rb = (size_t)b * TT;
            const int qc = (isc ? 1280 : 768) + g * 128, kc = (isc ? 1536 : 1024) + g * 64, vc = (isc ? 1664 : 1152) + g * 64;
            att::unit2<64, 1, VM>(F.lds, P + rb * NPJ + qc, NPJ, P + rb * NPJ + kc, NPJ, P + rb * NPJ + vc, NPJ, O + rb * D + (isc ? 512 : 256) + g * 128, isc ? 2 : 1, 16, 0, 0, 4,
                              0.125f * LOG2E, isc ? sinks[2 * g] * LOG2E : 0.f, isc ? sinks[2 * g + 1] * LOG2E : 0.f, isc != 0, bias, t32);
        } else {
            const int rem = idx - 2624, b = rem >> 3, isd = (rem >> 2) & 1, h = rem & 3; const size_t rb = (size_t)b * TT;
            if (isd) att::unit<96, VM>(F.lds, QD + rb * 384 + h * 96, 384, KD + rb * 384 + h * 96, 384, VD + rb * 256 + h * 64, 256, O + rb * D + 768 + h * 64, 3, 16, 0, 0, 4, 0.10206207261596575f * LOG2E, 0.f, false, bias, t32, nullptr);
            else att::unit<64, VM>(F.lds, P + rb * NPJ + h * 64, NPJ, P + rb * NPJ + 256 + h * 64, NPJ, P + rb * NPJ + 512 + h * 64, NPJ, O + rb * D + h * 64, 0, 16, 0, 0, 4, 0.125f * LOG2E, 0.f, false, bias + h * 465, nullptr, nullptr);
        }
    }
    }
}


#define PHASE_FN static __device__ __forceinline__ void
PHASE_FN ph_prologue(GAS unsigned char* ws) { const Frame F = make_frame(ws); phase_prologue(F); }
PHASE_FN ph_ln(GAS unsigned char* ws, int l) { const Frame F = make_frame(ws); phase_ln(F, l); }
PHASE_FN ph_gemm_in(GAS unsigned char* ws, int l) {
    const Frame F = make_frame(ws);
    pg8::Gemm g{(const bf16*)(F.ws + WS_HA), (const bf16*)(F.ws + WS_WIN), M, NPJ, D, D, nullptr}; pg8::StaticOrder S; S.init(M, NPJ, F.G, F.bid);
    pg8::EpiBf16NT<0> E{(bf16*)(F.ws + WS_PB), NPJ, nullptr, 0, 0, 1.f};
    pg8::gemm_phase<pg8::EpiBf16NT<0>, pg8::StaticOrder, true, true>(F.lds, g, S, E);
}
PHASE_FN ph_post(GAS unsigned char* ws, int l) { const Frame F = make_frame(ws); phase_post(F, l); }
PHASE_FN ph_gemm_mla(GAS unsigned char* ws, int l) {
    const Frame F = make_frame(ws);
    pg8::Gemm g{(const bf16*)(F.ws + WS_PB) + 1792, (const bf16*)(F.ws + WS_WD), M, 1024, 384, NPJ, nullptr}; pg8::StaticOrder S; S.init(M, 1024, F.G, F.bid);
    EpiMla E{(bf16*)(F.ws + WS_QD), (bf16*)(F.ws + WS_KD), (bf16*)(F.ws + WS_VD)};
    pg8::gemm_phase<EpiMla, pg8::StaticOrder, true, true>(F.lds, g, S, E);
}
template <int VM>
PHASE_FN ph_attn(GAS unsigned char* ws, int l) { const Frame F = make_frame(ws); phase_attn<VM>(F, l); }
PHASE_FN ph_gemm_out(GAS unsigned char* ws, int l) {
    const Frame F = make_frame(ws);
    pg8::Gemm g{(const bf16*)(F.ws + WS_HA), (const bf16*)(F.ws + WS_WOUT), M, D, D, D, nullptr};
    pg8::EpiBf16NT<0> E{(bf16*)(F.ws + WS_PB), D, nullptr, 0, 0, 1.f};
    if (l == NL - 1) { LatOrder S{F.G, F.bid}; pg8::gemm_phase<pg8::EpiBf16NT<0>, LatOrder, true, true>(F.lds, g, S, E); }
    else { pg8::StaticOrder S; S.init(M, D, F.G, F.bid); pg8::gemm_phase<pg8::EpiBf16NT<0>, pg8::StaticOrder, true, true>(F.lds, g, S, E); }
}
PHASE_FN ph_route(GAS unsigned char* ws, int l) { const Frame F = make_frame(ws); phase_route(F, l); }
PHASE_FN ph_permute(GAS unsigned char* ws, int l) { const Frame F = make_frame(ws); phase_permute(F, l); }
PHASE_FN ph_gemm_gu(GAS unsigned char* ws, int l) {
    const Frame F = make_frame(ws);
    moe_tables(F);
    pg8::Gemm g{(const bf16*)(F.ws + WS_HA), (const bf16*)(F.ws + WS_WGU), MS, 16384, D, D, (const int*)(F.ws + WS_QD)}; MoeOrder S{F.MISC + MI_PST, F.G, F.bid};
    EpiGU E{(bf16*)(F.ws + WS_ACT)};
    pg8::gemm_phase<EpiGU, MoeOrder, true, true, true>(F.lds, g, S, E);
}
PHASE_FN ph_gemm_dn(GAS unsigned char* ws, int l) {
    const Frame F = make_frame(ws);
    moe_tables(F);
    pg8::Gemm g{(const bf16*)(F.ws + WS_ACT), (const bf16*)(F.ws + WS_WDN), MS, 16384, 512, 512, nullptr}; MoeOrder S{F.MISC + MI_PST, F.G, F.bid};
    pg8::EpiBf16NT<0> E{(bf16*)(F.ws + WS_PB), D, nullptr, 1024, 0, 1.f};
    pg8::gemm_phase<pg8::EpiBf16NT<0>, MoeOrder, true, true>(F.lds, g, S, E);
}


#if MK_DEBUG
#ifndef DBG_MODE
#define DBG_MODE 0
#endif
__device__ __forceinline__ float oracle_attn(const Frame& F, int l, int r, int var, int h, int mode = 0) {
    const bf16* P = (const bf16*)(F.ws + WS_PB); const bf16* QD = (const bf16*)(F.ws + WS_QD); const bf16* KD = (const bf16*)(F.ws + WS_KD); const bf16* VD = (const bf16*)(F.ws + WS_VD);
    const bf16* O = (const bf16*)(F.ws + WS_HA); const float* t32 = (const float*)(F.ws + WS_T32);
    const int b = r / TT, t = r - b * TT; const bool lat = t < SEQ; const size_t rb = (size_t)b * TT;
    const int dk = var == 3 ? 96 : 64;
    const bf16* qp; const bf16* kp; const bf16* vp; int kpitch, vpitch;
    if (var == 3) { qp = QD + (size_t)r * 384 + h * 96; kp = KD + rb * 384 + h * 96; kpitch = 384; vp = VD + rb * 256 + h * 64; vpitch = 256; }
    else { const int qc = var == 0 ? h * 64 : var == 1 ? 768 + h * 64 : 1280 + h * 64, kc = var == 0 ? 256 + h * 64 : var == 1 ? 1024 + (h >> 1) * 64 : 1536 + (h >> 1) * 64,
           vc = var == 0 ? 512 + h * 64 : var == 1 ? 1152 + (h >> 1) * 64 : 1664 + (h >> 1) * 64;
           qp = P + (size_t)r * NPJ + qc; kp = P + rb * NPJ + kc; kpitch = NPJ; vp = P + rb * NPJ + vc; vpitch = NPJ; }
    LAS float* qs = (LAS float*)(F.lds + 65536) + F.wave * 128;
    for (int d = F.lane; d < dk; d += 64) qs[d] = __builtin_bit_cast(float, (unsigned)qp[d] << 16);
    asm volatile("s_waitcnt lgkmcnt(0)" ::: "memory");
    if (var == 3 && lat && F.lane < 32) {
        const int c = F.lane >> 3, e = F.lane & 7, gr = t >> 6, gc = t & 63; const float own = qs[64 + F.lane], par = qs[64 + (F.lane ^ 8)];
        const float cs = t32[((c < 2 ? gr : gc) * 8 + e) * 2], sn = t32[((c < 2 ? gr : gc) * 8 + e) * 2 + 1];
        const float nv = (c & 1) == 0 ? own * cs - par * sn : par * sn + own * cs;
        asm volatile("s_waitcnt lgkmcnt(0)" ::: "memory"); qs[64 + F.lane] = nv; }
    asm volatile("s_waitcnt lgkmcnt(0)" ::: "memory");
    const float scale = var == 3 ? 0.10206207261596575f : 0.125f;
    const int gr = t >> 6, gc = t & 63, r0 = min(max(gr - 4, 0), 56), c0 = min(max(gc - 8, 0), 48);
    float m = -3.0e38f, lsum = 0.f, acc[64];
#pragma unroll
    for (int d = 0; d < 64; ++d) acc[d] = 0.f;
    for (int j = F.lane; j < TT; j += 64) {
        bool ok = true; float bias = 0.f;
        if (!lat) ok = j >= SEQ;
        else if (j < SEQ) {
            if (var == 0) { const int kr = j >> 6, kc2 = j & 63; ok = kr >= r0 && kr <= r0 + 7 && kc2 >= c0 && kc2 <= c0 + 15;
                if (ok) bias = INP(I_NABIAS)[((l * 4 + h) * 15 + (kr - gr + 7)) * 31 + (kc2 - gc + 15)]; }
            else if (var == 2) ok = (j - t <= 128) && (t - j <= 128);
        }
        if (!ok) continue;
        float sc = 0.f; const bf16* kr_ = kp + (size_t)j * kpitch;
        for (int d = 0; d < dk; ++d) sc += qs[d] * __builtin_bit_cast(float, (unsigned)kr_[d] << 16);
        sc = sc * scale + bias;
        const float mn = fmaxf(m, sc), a = expf(m - mn), p = expf(sc - mn); m = mn; lsum = lsum * a + p;
        const bf16* vr = vp + (size_t)j * vpitch;
#pragma unroll
        for (int d = 0; d < 64; ++d) acc[d] = acc[d] * a + p * __builtin_bit_cast(float, (unsigned)vr[d] << 16);
    }
    float mg = m;
#pragma unroll
    for (int o = 1; o < 64; o <<= 1) mg = fmaxf(mg, __shfl_xor(mg, o));
    if (mode >= 1) {
        const unsigned* rec = (const unsigned*)(F.ws + WS_RS) + (size_t)r * 2; const float mk = __builtin_bit_cast(float, rec[0]), lk = __builtin_bit_cast(float, rec[1]);
        const float lref = wave_sum(lsum * expf(m - mg));
        const float lker = lk * exp2f(mk - mg * LOG2E);
        if (mode == 2) return fabsf(mk / LOG2E - mg);
        return fabsf(lker / lref - 1.0f);
    }
    const float f = expf(m - mg); lsum *= f; lsum = wave_sum(lsum);
    if (var == 2) lsum += expf(INP(I_SINK)[l * 4 + h] - mg);
    float err = 0.f, mag = 1.0e-6f;
    const bf16* orow = O + (size_t)r * D + var * 256 + h * 64;
#pragma unroll
    for (int d = 0; d < 64; ++d) { const float ref = wave_sum(acc[d] * f) / lsum; const float got = __builtin_bit_cast(float, (unsigned)orow[d] << 16);
        const float df = fabsf(got - ref); err = (df == df) ? fmaxf(err, df) : 1.0e30f; mag = fmaxf(mag, fabsf(ref)); }
    return err / mag;
}
__device__ __forceinline__ void phase_dump(const Frame& F, int code) {
    float* out = (float*)ptab_get(F, I_OUT);
    for (int r = F.gw; r < M; r += F.ngw) {
        const int b = r / TT, t = r - b * TT; if (t >= SEQ) continue;
        float v[16];
        if (code == 1) ld16bf((const bf16*)(F.ws + WS_HA) + (size_t)r * D, F.lane, v);
        else if (code == 2) ld16bf((const bf16*)(F.ws + WS_PB) + (size_t)r * NPJ, F.lane, v);
        else if (code == 3) ld16bf((const bf16*)(F.ws + WS_PB) + (size_t)r * NPJ + 1024, F.lane, v);
        else if (code == 4) ld16bf((const bf16*)(F.ws + WS_PB) + (size_t)r * NPJ + 1280, F.lane, v);
        else if (code == 5) ld16((const float*)(F.ws + WS_PB) + (size_t)r * D, F.lane, v);
        else if (code == 8) {
            const v4u w0 = *((const v4u*)((const bf16*)(F.ws + WS_HA) + (size_t)r * D) + F.lane), w1 = *((const v4u*)((const bf16*)(F.ws + WS_HA) + (size_t)r * D) + 64 + F.lane);
            float f[8]; int bad0 = 0, bad1 = 0; unpack8(w0, f);
#pragma unroll
            for (int i = 0; i < 8; ++i) { const unsigned u = __builtin_bit_cast(unsigned, f[i]); bad0 |= ((u & 0x7f800000u) == 0x7f800000u) ? 1 : 0; }
            unpack8(w1, f);
#pragma unroll
            for (int i = 0; i < 8; ++i) { const unsigned u = __builtin_bit_cast(unsigned, f[i]); bad1 |= ((u & 0x7f800000u) == 0x7f800000u) ? 1 : 0; }
            const unsigned long long m0 = __ballot(bad0), m1 = __ballot(bad1);
            const bool vA = (m0 & 0xffffffffull) != 0, vB = (m0 >> 32) != 0, vC = (m1 & 0xffffffffull) != 0, vD = (m1 >> 32) != 0;
            const float val = (float)(t + 1) * ((vA ? 1.0f : 0.f) + (vB ? 1.0e2f : 0.f) + (vC ? 1.0e4f : 0.f) + (vD ? 1.0e6f : 0.f));
#pragma unroll
            for (int i = 0; i < 16; ++i) v[i] = val;
        }
        else if (code == 9) { const unsigned cd = ((const unsigned*)(F.ws + WS_RS))[(size_t)r * 2]; float val = 0.f; if (cd) { val = 1.f; for (unsigned k = 0; k < cd; ++k) val *= 10.f; }
#pragma unroll
            for (int i = 0; i < 16; ++i) v[i] = val; }
        else if (code == 10) {
            const v4u w1 = *((const v4u*)((const bf16*)(F.ws + WS_HA) + (size_t)r * D) + 64 + F.lane);
            float f[8]; int bad1 = 0; unpack8(w1, f);
#pragma unroll
            for (int i = 0; i < 8; ++i) { const unsigned u = __builtin_bit_cast(unsigned, f[i]); bad1 |= ((u & 0x7f800000u) == 0x7f800000u) ? 1 : 0; }
            const bool vC = (__ballot(bad1) & 0xffffffffull) != 0;
            const bf16* pc = (const bf16*)(F.ws + WS_PB) + ((size_t)b * TT + SEQ + (t & 255)) * NPJ; int badp = 0;
            for (int c = F.lane; c < 288; c += 64) { const v4u w = *((const v4u*)pc + c); unpack8(w, f);
#pragma unroll
                for (int i = 0; i < 8; ++i) { const unsigned u = __builtin_bit_cast(unsigned, f[i]); badp |= ((u & 0x7f800000u) == 0x7f800000u) ? 1 : 0; } }
            float val = 0.f; if (vC) { val = 1.f; for (int k = 0; k <= (t & 15); ++k) val *= 10.f; }
            if (__any(badp)) val = 1.0e30f;
#pragma unroll
            for (int i = 0; i < 16; ++i) v[i] = val;
        }
        else if (code == 11) {
            const bf16* pr = (const bf16*)(F.ws + WS_PB) + (size_t)r * NPJ; int grp = -1;
            for (int c = F.lane; c < 288; c += 64) { const v4u w = *((const v4u*)pr + c); float f[8]; unpack8(w, f);
#pragma unroll
                for (int i = 0; i < 8; ++i) if (!(fabsf(f[i]) < 1.0e4f)) grp = (c * 8) >> 8; }
#pragma unroll
            for (int o = 1; o < 64; o <<= 1) { const int g2 = __shfl_xor(grp, o); grp = g2 > grp ? g2 : grp; }
            float val = 0.f; if (grp >= 0) { val = 100.f; for (int k = 0; k < grp; ++k) val *= 10.f; }
#pragma unroll
            for (int i = 0; i < 16; ++i) v[i] = val;
        }
        else if (code >= 20 && code < 24) {
            float val = 0.f;
            if ((t & 15) == 5) { for (int h = 0; h < 4; ++h) { const float e = oracle_attn(F, 0, r, code - 20, h); const float cls = e > 1.0e20f ? 3.f : e > 0.5f ? 2.f : e > 0.03f ? 1.f : 0.f; if (cls > 0.f) { float w = cls; for (int k = 0; k <= h; ++k) w *= 10.f; val = fmaxf(val, w); } } }
#pragma unroll
            for (int i = 0; i < 16; ++i) v[i] = val;
        }
        else if (code >= 30 && code < 46) {
            float val = 0.f;
            if ((t & 15) == 5) { const float e = oracle_attn(F, 0, r, (code - 30) >> 2, (code - 30) & 3, DBG_MODE); val = e > 10.f ? 1.0e4f : 1000.f * e; }
#pragma unroll
            for (int i = 0; i < 16; ++i) v[i] = val;
        }
        else if (code == 7) {
            auto bad16 = [&](const bf16* p, int nchunks) { int bad = 0; for (int c = F.lane; c < nchunks; c += 64) { const v4u w = *((const v4u*)p + c); float f[8]; unpack8(w, f);
#pragma unroll
                for (int i = 0; i < 8; ++i) { const unsigned u = __builtin_bit_cast(unsigned, f[i]); bad |= ((u & 0x7f800000u) == 0x7f800000u) ? 1 : 0; } } return __any(bad); };
            const int bP = bad16((const bf16*)(F.ws + WS_PB) + (size_t)r * NPJ, 288), bQ = bad16((const bf16*)(F.ws + WS_QD) + (size_t)r * 384, 48),
                      bK = bad16((const bf16*)(F.ws + WS_KD) + (size_t)r * 384, 48), bV = bad16((const bf16*)(F.ws + WS_VD) + (size_t)r * 256, 32), bO = bad16((const bf16*)(F.ws + WS_HA) + (size_t)r * D, 128);
            const float val = bP ? 1.0e6f : bQ ? 1.0e5f : bK ? 1.0e4f : bV ? 1.0e3f : bO ? 1.0e2f : 0.f;
#pragma unroll
            for (int i = 0; i < 16; ++i) v[i] = val;
        }
#pragma unroll
        for (int i = 0; i < 16; ++i) { const unsigned u = __builtin_bit_cast(unsigned, v[i]); if ((u & 0x7f800000u) == 0x7f800000u) v[i] = 777.0f; }
        st16(out + ((size_t)b * SEQ + t) * D, F.lane, v);
    }
}
static __device__ __forceinline__ void ph_dump(GAS unsigned char* ws, int code) { const Frame F = make_frame(ws); phase_dump(F, code); }
#endif
__global__ void __launch_bounds__(NTHR, 2) mk_fwd(Args args) {
    extern __shared__ __attribute__((aligned(16))) unsigned char lds_raw[];
    LAS unsigned char* lds = (LAS unsigned char*)lds_raw; volatile LAS unsigned* MISC = (volatile LAS unsigned*)(lds + MISC_OFF);
    const int tid = threadIdx.x;
    GAS unsigned char* ws = (GAS unsigned char*)args.ws;
    for (int u = tid; u < (LDS_BYTES - MISC_OFF) / 4; u += NTHR) MISC[u] = 0u;
    __syncthreads();
    if (tid < 28) { const unsigned long long p = tid < 27 ? (unsigned long long)args.in[tid] : (unsigned long long)args.out;
        LAS unsigned* t = (LAS unsigned*)(lds + PTAB_OFF) + 2 * tid; t[0] = (unsigned)p; t[1] = (unsigned)(p >> 32); }
    __syncthreads();
#if MK_MULTI
#define GRID_BAR() do { } while (0)
#else
    XcdBarrier bar = xcd_barrier_post((unsigned*)(ws + WS_CTL) + CW_BAR, MISC + MI_BAR);
#define GRID_BAR() xcd_barrier(bar)
#endif
    const int lo = args.ph_lo, hi = args.ph_hi;
#define IN(k) (lo <= (k) && (k) < hi)
#if MK_TIME
    unsigned long long tcat = 0ull, tb0 = 0ull;
#define TBEG() do { tb0 = __builtin_amdgcn_s_memrealtime(); } while (0)
#define TEND(c) do { if ((c) == MK_TIME - 1) tcat += __builtin_amdgcn_s_memrealtime() - tb0; } while (0)
#define SEAM(k) do { if (IN(k) && IN((k) + 1)) { TBEG(); GRID_BAR(); TEND(1); } } while (0)
#else
#define TBEG() do { } while (0)
#define TEND(c) do { } while (0)
#define SEAM(k) do { if (IN(k) && IN((k) + 1)) GRID_BAR(); } while (0)
#endif

#if MK_DEBUG
    if (lo >= 100) { ph_dump(ws, lo - 100); return; }
#endif
    if (IN(0)) { TBEG(); ph_prologue(ws); TEND(2); } SEAM(0);
    for (int l = 0; l < NL; ++l) {
        const int pb = 1 + 10 * l;
        if (IN(pb + 0)) { TBEG(); ph_ln(ws, l); TEND(0); } SEAM(pb + 0);
        if (IN(pb + 1)) { TBEG(); ph_gemm_in(ws, l); if (MK_DUP & 2) { GRID_BAR(); ph_gemm_in(ws, l); } TEND(3); } SEAM(pb + 1);
        if (IN(pb + 2)) { TBEG(); ph_post(ws, l); TEND(0); } SEAM(pb + 2);
        if (IN(pb + 3)) { TBEG(); ph_gemm_mla(ws, l); if (MK_DUP & 8) { GRID_BAR(); ph_gemm_mla(ws, l); } TEND(3); } SEAM(pb + 3);
        if (IN(pb + 4)) { TBEG(); ph_attn<0>(ws, l); if (MK_DUP & 16) { GRID_BAR(); ph_attn<MK_VM>(ws, l + 4); } TEND(4); } SEAM(pb + 4);
        if (IN(pb + 5)) { TBEG(); ph_gemm_out(ws, l); if (MK_DUP & 32) { GRID_BAR(); ph_gemm_out(ws, l); } TEND(3); } SEAM(pb + 5);
        if (IN(pb + 6)) { TBEG(); ph_route(ws, l); TEND(0); } SEAM(pb + 6);
        if (IN(pb + 7)) { TBEG(); ph_permute(ws, l); if (MK_DUP & 128) { GRID_BAR(); ph_permute(ws, l); } TEND(0); } SEAM(pb + 7);
        if (IN(pb + 8)) { TBEG(); ph_gemm_gu(ws, l); if (MK_DUP & 256) { GRID_BAR(); ph_gemm_gu(ws, l); } TEND(3); } SEAM(pb + 8);
        if (IN(pb + 9)) { TBEG(); ph_gemm_dn(ws, l); if (MK_DUP & 512) { GRID_BAR(); ph_gemm_dn(ws, l); } TEND(3); } SEAM(pb + 9);
    }
    if (IN(NPHASE - 1)) { TBEG(); ph_ln(ws, NL); TEND(0); }
#if MK_TIME
    if (blockIdx.x == 0) { const unsigned long long tw = __builtin_amdgcn_s_memrealtime(); const unsigned long long dl = tcat * (unsigned long long)MK_TMUL; while (__builtin_amdgcn_s_memrealtime() - tw < dl) __builtin_amdgcn_s_sleep(8); }
#endif
#undef IN
#undef SEAM
#undef GRID_BAR
}

extern "C" void kernel_launch(void* const* d_in, const int* in_sizes, int n_in, void* d_out, int out_size, void* d_ws, size_t ws_size, hipStream_t stream) {
    static int grid = 0;
    if (grid == 0) {
        if (n_in != 27 || out_size != NB * SEQ * D || ws_size < WS_END) { fprintf(stderr, "kernel_launch: unexpected problem (n_in %d, out %d, ws %zu < %zu)\n", n_in, out_size, ws_size, (size_t)WS_END); grid = -1; return; }
        int dev = 0, cus = 0, per_cu = 0;
        if (hipGetDevice(&dev) != hipSuccess || hipDeviceGetAttribute(&cus, hipDeviceAttributeMultiprocessorCount, dev) != hipSuccess) { grid = -1; return; }
        if (hipFuncSetAttribute((const void*)mk_fwd, hipFuncAttributeMaxDynamicSharedMemorySize, LDS_BYTES) != hipSuccess) { fprintf(stderr, "kernel_launch: hipFuncSetAttribute failed\n"); grid = -1; return; }
        if (hipOccupancyMaxActiveBlocksPerMultiprocessor(&per_cu, (const void*)mk_fwd, NTHR, LDS_BYTES) != hipSuccess || per_cu < 1) fprintf(stderr, "kernel_launch: occupancy query reports %d\n", per_cu);
        (void)hipGetLastError();
        grid = cus > 1024 ? 1024 : cus;
    }
    if (grid < 0) return;
    (void)hipMemsetAsync((char*)d_ws + WS_CTL, 0, CTL_BYTES, stream);
    Args a{};
    for (int i = 0; i < 27; ++i) a.in[i] = (const float*)d_in[i];
    a.out = (float*)d_out; a.ws = (unsigned char*)d_ws;
#if MK_MULTI
#ifndef DBG_NRUN
#define DBG_NRUN NPHASE
#endif
    for (int p = 0; p < DBG_NRUN; ++p) { a.ph_lo = p; a.ph_hi = p + 1; hipLaunchKernelGGL(mk_fwd, dim3(grid), dim3(NTHR), LDS_BYTES, stream, a); }
#ifdef DBG_DUMP
    a.ph_lo = 100 + DBG_DUMP; a.ph_hi = 101 + DBG_DUMP; hipLaunchKernelGGL(mk_fwd, dim3(grid), dim3(NTHR), LDS_BYTES, stream, a);
#endif
#else
    a.ph_lo = 0; a.ph_hi = NPHASE;
    hipLaunchKernelGGL(mk_fwd, dim3(grid), dim3(NTHR), LDS_BYTES, stream, a);
#endif
}
```

```cpp
#include <hip/hip_runtime.h>
#include <cstdio>
#include <cstdint>
namespace pg8 {
#define PG8_LAS __attribute__((address_space(3)))
typedef unsigned short bf16_t;
typedef short bf16x8 __attribute__((ext_vector_type(8)));
typedef float f32x4 __attribute__((ext_vector_type(4)));
typedef unsigned u32x4 __attribute__((ext_vector_type(4)));
constexpr int BM = 256, BK = 64, HALF = 128, HTB = HALF * BK * 2  , STAGE_BYTES = 8 * HTB, NXCD = 8, WGM = 8;

__host__ __device__ __forceinline__ int lds_byte(int r, int c) { const int st = (r >> 4) * 2 + (c >> 5), rr = r & 15, cc = c & 31, ob = rr * 64 + cc * 2; return st * 1024 + (ob ^ (((ob >> 9) & 1) << 5)); }
__host__ __device__ __forceinline__ void stage_rc(int b, int& R, int& C) { const int st = b / 1024, sb = b % 1024, swz = sb ^ (((sb >> 9) & 1) << 5); R = (st >> 1) * 16 + swz / 64; C = (st & 1) * 32 + (swz % 64) / 2; }
__host__ __device__ __forceinline__ int perm32(int rho) { const int n = rho >> 4, i = rho & 15; return 8 * (i >> 2) + 4 * n + (i & 3); }

struct Unit { int pm, pn; };
struct Gemm { const bf16_t* A; const bf16_t* Bt; int M, N, K, lda; const int* src; };

struct StaticOrder {
    int nM, nN, nwg, G, c;
    __host__ __device__ void init(int M, int N, int G_, int c_) { nM = M / BM; nN = N / BM; nwg = nM * nN; G = G_; c = c_; }
    __host__ __device__ bool next(int i, Unit& u) const {
        const long L = (long)i * G + c; if (L >= nwg) return false;
        int wgid = (int)L; { const int q = nwg / NXCD, r = nwg % NXCD, xcd = wgid % NXCD, off = wgid / NXCD; wgid = (xcd < r ? xcd * (q + 1) : r * (q + 1) + (xcd - r) * q) + off; }
        const int nig = WGM * nN, gid = wgid / nig, fm = gid * WGM, gsz = (nM - fm) < WGM ? (nM - fm) : WGM;
        u.pm = fm + ((wgid % nig) % gsz); u.pn = (wgid % nig) / gsz; return true;
    }
    __device__ __forceinline__ void a_ready(const Unit&) const {}
    __device__ __forceinline__ void done(const Unit&) const {}
};

__device__ __forceinline__ unsigned cvt_pk_bf16(float lo, float hi) { unsigned r; asm volatile("v_cvt_pk_bf16_f32 %0, %1, %2" : "=v"(r) : "v"(lo), "v"(hi)); return r; }
typedef float f32x2 __attribute__((ext_vector_type(2)));
__device__ __forceinline__ f32x2 gelu_pk(f32x2 v) {
    const f32x2 av = __builtin_elementwise_abs(v), d = av * 0.2316418882f + 1.0f;
    f32x2 t; t.x = __builtin_amdgcn_rcpf(d.x); t.y = __builtin_amdgcn_rcpf(d.y);
    f32x2 q = t * 0.5307027145f + (-0.7265760135f); q = q * t + 0.7107068705f; q = q * t + (-0.142248368f); q = q * t + 0.127414796f; q = q * t;
    const f32x2 s = (v * v) * (-0.72134752044f);
    f32x2 e; e.x = __builtin_amdgcn_exp2f(s.x); e.y = __builtin_amdgcn_exp2f(s.y);
    const f32x2 m = v * (q * e), r = v - m;
    f32x2 o; o.x = v.x < 0.f ? m.x : r.x; o.y = v.y < 0.f ? m.y : r.y; return o;
}

template <int ACT  > struct EpiBf16 {
    static constexpr bool PERM = true, AFTER_DRAIN = false; static_assert(ACT == 0 || ACT == 1, "EpiBf16: ACT is 0 (none) or 1 (gelu_pk)");
    bf16_t* O; int ldc; const float* bias; int split_cols; size_t split_stride; float scale0;
    __device__ __forceinline__ void operator()(const f32x4 (&acc)[2][2][4][2], const Unit& u, int wr, int wc, int fr, int fq) const {
        const int row0 = u.pm * BM + wr * 64 + fr; int colt = u.pn * BM; bf16_t* base = O;
        float sc = 1.f; if (split_cols) { const int t = colt / split_cols; base += (size_t)t * split_stride; colt -= t * split_cols; if (t == 0) sc = scale0; }
        const int col0 = colt + wc * 32 + 8 * fq, bcol0 = u.pn * BM + wc * 32 + 8 * fq;
        f32x4 bv[2][2];
#pragma unroll
        for (int bj = 0; bj < 2; ++bj)
#pragma unroll
            for (int n = 0; n < 2; ++n) bv[bj][n] = bias ? *(const f32x4*)(bias + bcol0 + bj * HALF + 4 * n) : (f32x4){0.f, 0.f, 0.f, 0.f};
#pragma unroll
        for (int ai = 0; ai < 2; ++ai)
#pragma unroll
            for (int m = 0; m < 4; ++m) { bf16_t* rowp = base + (size_t)(row0 + ai * HALF + m * 16) * ldc + col0;
#pragma unroll
                for (int bj = 0; bj < 2; ++bj) { f32x4 v0 = acc[ai][bj][m][0] + bv[bj][0], v1 = acc[ai][bj][m][1] + bv[bj][1];
                    if (ACT == 1) { f32x2 a = gelu_pk((f32x2){v0[0], v0[1]}), b = gelu_pk((f32x2){v0[2], v0[3]}), c = gelu_pk((f32x2){v1[0], v1[1]}), d = gelu_pk((f32x2){v1[2], v1[3]});
                        v0 = (f32x4){a.x, a.y, b.x, b.y}; v1 = (f32x4){c.x, c.y, d.x, d.y}; }
                    v0 = v0 * sc; v1 = v1 * sc; u32x4 w; w.x = cvt_pk_bf16(v0[0], v0[1]); w.y = cvt_pk_bf16(v0[2], v0[3]); w.z = cvt_pk_bf16(v1[0], v1[1]); w.w = cvt_pk_bf16(v1[2], v1[3]);
                    *(u32x4*)(rowp + bj * HALF) = w; } }
    }
};
template <int ACT  > struct EpiBf16NT {
    static constexpr bool PERM = true, AFTER_DRAIN = false; static_assert(ACT == 0 || ACT == 1, "EpiBf16: ACT is 0 (none) or 1 (gelu_pk)");
    bf16_t* O; int ldc; const float* bias; int split_cols; size_t split_stride; float scale0;
    __device__ __forceinline__ void operator()(const f32x4 (&acc)[2][2][4][2], const Unit& u, int wr, int wc, int fr, int fq) const {
        const int row0 = u.pm * BM + wr * 64 + fr; int colt = u.pn * BM; bf16_t* base = O;
        float sc = 1.f; if (split_cols) { const int t = colt / split_cols; base += (size_t)t * split_stride; colt -= t * split_cols; if (t == 0) sc = scale0; }
        const int col0 = colt + wc * 32 + 8 * fq, bcol0 = u.pn * BM + wc * 32 + 8 * fq;
        f32x4 bv[2][2];
#pragma unroll
        for (int bj = 0; bj < 2; ++bj)
#pragma unroll
            for (int n = 0; n < 2; ++n) bv[bj][n] = bias ? *(const f32x4*)(bias + bcol0 + bj * HALF + 4 * n) : (f32x4){0.f, 0.f, 0.f, 0.f};
#pragma unroll
        for (int ai = 0; ai < 2; ++ai)
#pragma unroll
            for (int m = 0; m < 4; ++m) { bf16_t* rowp = base + (size_t)(row0 + ai * HALF + m * 16) * ldc + col0;
#pragma unroll
                for (int bj = 0; bj < 2; ++bj) { f32x4 v0 = acc[ai][bj][m][0] + bv[bj][0], v1 = acc[ai][bj][m][1] + bv[bj][1];
                    if (ACT == 1) { f32x2 a = gelu_pk((f32x2){v0[0], v0[1]}), b = gelu_pk((f32x2){v0[2], v0[3]}), c = gelu_pk((f32x2){v1[0], v1[1]}), d = gelu_pk((f32x2){v1[2], v1[3]});
                        v0 = (f32x4){a.x, a.y, b.x, b.y}; v1 = (f32x4){c.x, c.y, d.x, d.y}; }
                    v0 = v0 * sc; v1 = v1 * sc; u32x4 w; w.x = cvt_pk_bf16(v0[0], v0[1]); w.y = cvt_pk_bf16(v0[2], v0[3]); w.z = cvt_pk_bf16(v1[0], v1[1]); w.w = cvt_pk_bf16(v1[2], v1[3]);
                    __builtin_nontemporal_store(w, (u32x4*)(rowp + bj * HALF)); } }
    }
};
struct EpiF32 {
    static constexpr bool PERM = false, AFTER_DRAIN = false;
    float* C; int ldc; const float* bias;
    __device__ __forceinline__ void operator()(const f32x4 (&acc)[2][2][4][2], const Unit& u, int wr, int wc, int fr, int fq) const {
        const int row0 = u.pm * BM + wr * 64 + fr, col0 = u.pn * BM + wc * 32 + 4 * fq;
        f32x4 bv[2][2];
#pragma unroll
        for (int bj = 0; bj < 2; ++bj)
#pragma unroll
            for (int n = 0; n < 2; ++n) bv[bj][n] = bias ? *(const f32x4*)(bias + col0 + bj * HALF + n * 16) : (f32x4){0.f, 0.f, 0.f, 0.f};
#pragma unroll
        for (int ai = 0; ai < 2; ++ai)
#pragma unroll
            for (int m = 0; m < 4; ++m) { float* rowp = C + (size_t)(row0 + ai * HALF + m * 16) * ldc + col0;
#pragma unroll
                for (int bj = 0; bj < 2; ++bj)
#pragma unroll
                    for (int n = 0; n < 2; ++n) *(f32x4*)(rowp + bj * HALF + n * 16) = acc[ai][bj][m][n] + bv[bj][n]; }
    }
};
template <class Epi, class Sched, bool ALIGN_EPI = false, bool SP2 = false, bool GATHER = false>
__device__ __forceinline__ void gemm_phase(PG8_LAS unsigned char* lds, const Gemm g, const Sched& S, const Epi& E) {
    int tid = threadIdx.x; asm volatile("" : "+v"(tid)); const int wid = __builtin_amdgcn_readfirstlane(tid >> 6), lane = tid & 63, wr = wid >> 2, wc = wid & 3, fr = lane & 15, fq = lane >> 4;
    const int K = g.K, nt = K / BK;
    unsigned voffA[2], voffB[2]; int RA[2]; unsigned CA2[2];
#pragma unroll
    for (int i = 0; i < 2; ++i) { int R, C; stage_rc(tid * 16 + i * 8192, R, C); const int Rb = Epi::PERM ? ((R & ~31) + perm32(R & 31)) : R;
        voffA[i] = (unsigned)(R * g.lda + C) * 2u; voffB[i] = (unsigned)(Rb * K + C) * 2u; RA[i] = R; CA2[i] = (unsigned)C * 2u; }
    unsigned gcur[2][2] = {{0u, 0u}, {0u, 0u}}, gnxt[2][2] = {{0u, 0u}, {0u, 0u}};
#define PG8_GOFF(dst, u_) do { _Pragma("unroll") for (int h_ = 0; h_ < 2; ++h_) _Pragma("unroll") for (int i_ = 0; i_ < 2; ++i_) \
        dst[h_][i_] = (unsigned)g.src[(u_).pm * BM + h_ * HALF + RA[i_]] * (unsigned)(g.lda * 2) + CA2[i_]; } while (0)
#define PG8_STAGE_A(bufoff, gbase, h, nx) do { if constexpr (GATHER) { unsigned vs_[2] = {(nx) ? gnxt[h][0] : gcur[h][0], (nx) ? gnxt[h][1] : gcur[h][1]}; PG8_STAGE(bufoff, gbase, vs_); } \
        else { PG8_STAGE(bufoff, (gbase) + ((h) ? hstepA : 0), voffA); } } while (0)
    const size_t kstep = (size_t)(BK * 2);
    const size_t hstepA = (size_t)HALF * g.lda * 2, hstepB = (size_t)HALF * K * 2;
    const size_t tstepA = 2 * hstepA, tstepB = 2 * hstepB;
    const unsigned ldsw = (unsigned)wid * 1024u;
    const int aoff = lds_byte(wr * 64 + fr, fq * 8), boff = lds_byte(wc * 32 + fr, fq * 8);
#define PG8_SA(b, h) (((b) * 2 + (h)) * HTB)
#define PG8_SB(b, h) ((4 + (b) * 2 + (h)) * HTB)
#define PG8_STAGE(bufoff, gbase, voff) do { _Pragma("unroll") for (int _i = 0; _i < 2; ++_i) \
        __builtin_amdgcn_global_load_lds((const unsigned*)((const char*)(gbase) + (voff)[_i]), (PG8_LAS unsigned*)(lds + (bufoff) + ldsw + _i * 8192), 16, 0, 0); } while (0)
#define PG8_LDA(dst, b, h) do { _Pragma("unroll") for (int m = 0; m < 4; ++m) _Pragma("unroll") for (int k = 0; k < 2; ++k) dst[m][k] = *(const PG8_LAS bf16x8*)(lds + PG8_SA(b, h) + aoff + m * 2048 + k * 1024); } while (0)
#define PG8_LDB(dst, b, h) do { _Pragma("unroll") for (int n = 0; n < 2; ++n) _Pragma("unroll") for (int k = 0; k < 2; ++k) dst[n][k] = *(const PG8_LAS bf16x8*)(lds + PG8_SB(b, h) + boff + n * 2048 + k * 1024); } while (0)
#define PG8_MMA(ai, bj, At, Bt) do { __builtin_amdgcn_s_setprio(1); _Pragma("unroll") for (int m = 0; m < 4; ++m) _Pragma("unroll") for (int n = 0; n < 2; ++n) _Pragma("unroll") for (int k = 0; k < 2; ++k) \
        acc[ai][bj][m][n] = __builtin_amdgcn_mfma_f32_16x16x32_bf16(Bt[n][k], At[m][k], acc[ai][bj][m][n], 0, 0, 0); __builtin_amdgcn_s_setprio(0); } while (0)
#define PG8_WAIT_V(n) asm volatile("s_waitcnt vmcnt(" #n ")" ::: "memory")
#define PG8_WAIT_L(n) asm volatile("s_waitcnt lgkmcnt(" #n ")" ::: "memory")
#define PG8_BAR __builtin_amdgcn_s_barrier()
#define PG8_SCHED __builtin_amdgcn_sched_barrier(0)
    Unit cur, nxt; int ui = 0;
    if (!S.next(0, cur)) return;
    f32x4 acc[2][2][4][2];
#pragma unroll
    for (int a = 0; a < 2; ++a)
#pragma unroll
        for (int b = 0; b < 2; ++b)
#pragma unroll
            for (int m = 0; m < 4; ++m)
#pragma unroll
                for (int n = 0; n < 2; ++n) acc[a][b][m][n] = (f32x4){0.f, 0.f, 0.f, 0.f};
    bf16x8 At[4][2], B0[2][2], B1[2][2];
    const char* cA = (const char*)g.A + (GATHER ? (size_t)0 : (size_t)cur.pm * tstepA); const char* cB = (const char*)g.Bt + (size_t)cur.pn * tstepB;
    if constexpr (GATHER) PG8_GOFF(gcur, cur);
    S.a_ready(cur);
    if constexpr (SP2) {
        PG8_STAGE(PG8_SB(0, 0), cB, voffB); PG8_STAGE(PG8_SB(0, 1), cB + hstepB, voffB); PG8_STAGE_A(PG8_SA(0, 0), cA, 0, false); PG8_STAGE_A(PG8_SA(0, 1), cA, 1, false);
        if (wr == 1) PG8_BAR;
        PG8_WAIT_V(2); PG8_BAR;
        PG8_STAGE(PG8_SB(1, 0), cB + kstep, voffB); PG8_STAGE_A(PG8_SA(1, 0), cA + kstep, 0, false); PG8_STAGE(PG8_SB(1, 1), cB + hstepB + kstep, voffB);
        PG8_WAIT_V(6); PG8_BAR;
    } else {
        PG8_STAGE(PG8_SB(0, 0), cB, voffB); PG8_STAGE_A(PG8_SA(0, 0), cA, 0, false); PG8_STAGE(PG8_SB(0, 1), cB + hstepB, voffB); PG8_STAGE_A(PG8_SA(0, 1), cA, 1, false);
        if (wr == 1) PG8_BAR;
        PG8_WAIT_V(4); PG8_BAR;
        PG8_STAGE(PG8_SB(1, 0), cB + kstep, voffB); PG8_STAGE_A(PG8_SA(1, 0), cA + kstep, 0, false); PG8_STAGE(PG8_SB(1, 1), cB + hstepB + kstep, voffB);
        PG8_WAIT_V(6); PG8_BAR;
    }
    for (;;) {
        const bool has_next = S.next(ui + 1, nxt);
        const char* nA = (has_next && !GATHER) ? (const char*)g.A + (size_t)nxt.pm * tstepA : cA; const char* nB = has_next ? (const char*)g.Bt + (size_t)nxt.pn * tstepB : cB;
        if constexpr (GATHER) { if (has_next) PG8_GOFF(gnxt, nxt); else { _Pragma("unroll") for (int h_ = 0; h_ < 2; ++h_) { gnxt[h_][0] = gcur[h_][0]; gnxt[h_][1] = gcur[h_][1]; } } }
#pragma unroll 1
        for (int t = 0; t < nt; t += 2) {
            const bool last = (t == nt - 2);
            const char* a1 = cA + (size_t)(t + 1) * kstep;
            const char* a2 = last ? nA : cA + (size_t)(t + 2) * kstep; const char* b2 = last ? nB : cB + (size_t)(t + 2) * kstep;
            const char* a3 = a2 + kstep; const char* b3 = b2 + kstep;
            if (last && has_next) S.a_ready(nxt);
            if constexpr (SP2) {
            PG8_LDB(B0, 0, 0); PG8_LDB(B1, 0, 1); PG8_SCHED; PG8_LDA(At, 0, 0); PG8_STAGE_A(PG8_SA(1, 1), a1, 1, false);
            PG8_WAIT_V(8); PG8_WAIT_L(0); PG8_BAR; PG8_MMA(0, 0, At, B0); PG8_MMA(0, 1, At, B1); PG8_BAR; PG8_SCHED;
            PG8_LDA(At, 0, 1); PG8_STAGE(PG8_SB(0, 0), b2, voffB); PG8_STAGE(PG8_SB(0, 1), b2 + hstepB, voffB); PG8_STAGE_A(PG8_SA(0, 0), a2, 0, last);
            PG8_WAIT_V(8); PG8_WAIT_L(0); PG8_BAR; PG8_MMA(1, 0, At, B0); PG8_MMA(1, 1, At, B1); PG8_BAR; PG8_SCHED;
            PG8_LDB(B0, 1, 0); PG8_LDB(B1, 1, 1); PG8_SCHED; PG8_LDA(At, 1, 0); PG8_STAGE_A(PG8_SA(0, 1), a2, 1, last);
            PG8_WAIT_V(8); PG8_WAIT_L(0); PG8_BAR; PG8_MMA(0, 0, At, B0); PG8_MMA(0, 1, At, B1); PG8_BAR; PG8_SCHED;
            PG8_LDA(At, 1, 1); PG8_STAGE(PG8_SB(1, 0), b3, voffB); PG8_STAGE(PG8_SB(1, 1), b3 + hstepB, voffB); PG8_STAGE_A(PG8_SA(1, 0), a3, 0, last);
            PG8_WAIT_V(8); PG8_WAIT_L(0); PG8_BAR; PG8_MMA(1, 0, At, B0); PG8_MMA(1, 1, At, B1); PG8_BAR; PG8_SCHED;
            } else {
            PG8_LDB(B0, 0, 0); PG8_SCHED; PG8_LDA(At, 0, 0); PG8_STAGE_A(PG8_SA(1, 1), a1, 1, false);
            PG8_WAIT_L(8); PG8_BAR; PG8_WAIT_L(0); PG8_MMA(0, 0, At, B0); PG8_BAR; PG8_SCHED;
            PG8_LDB(B1, 0, 1); PG8_STAGE(PG8_SB(0, 0), b2, voffB);
            PG8_BAR; PG8_WAIT_L(0); PG8_MMA(0, 1, At, B1); PG8_BAR;
            PG8_LDA(At, 0, 1); PG8_STAGE_A(PG8_SA(0, 0), a2, 0, last);
            PG8_BAR; PG8_WAIT_L(0); PG8_MMA(1, 0, At, B0); PG8_BAR; PG8_SCHED;
            PG8_STAGE(PG8_SB(0, 1), b2 + hstepB, voffB);
            PG8_WAIT_V(6); PG8_BAR; PG8_MMA(1, 1, At, B1); PG8_BAR;
            PG8_LDB(B0, 1, 0); PG8_SCHED; PG8_LDA(At, 1, 0); PG8_STAGE_A(PG8_SA(0, 1), a2, 1, last);
            PG8_WAIT_L(8); PG8_BAR; PG8_WAIT_L(0); PG8_MMA(0, 0, At, B0); PG8_BAR; PG8_SCHED;
            PG8_LDB(B1, 1, 1); PG8_STAGE(PG8_SB(1, 0), b3, voffB);
            PG8_BAR; PG8_WAIT_L(0); PG8_MMA(0, 1, At, B1); PG8_BAR;
            PG8_LDA(At, 1, 1); PG8_STAGE_A(PG8_SA(1, 0), a3, 0, last);
            PG8_BAR; PG8_WAIT_L(0); PG8_MMA(1, 0, At, B0); PG8_BAR; PG8_SCHED;
            PG8_STAGE(PG8_SB(1, 1), b3 + hstepB, voffB);
            PG8_WAIT_V(6); PG8_BAR; PG8_MMA(1, 1, At, B1); PG8_BAR;
            }
        }
        if constexpr (ALIGN_EPI) { if (wr == 0) PG8_BAR; }
        if constexpr (!Epi::AFTER_DRAIN) { E(acc, cur, wr, wc, fr, fq); S.done(cur); }
        if (!has_next) break;
#pragma unroll
        for (int a = 0; a < 2; ++a)
#pragma unroll
            for (int b = 0; b < 2; ++b)
#pragma unroll
                for (int m = 0; m < 4; ++m)
#pragma unroll
                    for (int n = 0; n < 2; ++n) acc[a][b][m][n] = (f32x4){0.f, 0.f, 0.f, 0.f};
        cur = nxt; cA = nA; cB = nB; ++ui;
        if constexpr (GATHER) { _Pragma("unroll") for (int h_ = 0; h_ < 2; ++h_) { gcur[h_][0] = gnxt[h_][0]; gcur[h_][1] = gnxt[h_][1]; } }
        if constexpr (ALIGN_EPI) { if (wr == 1) PG8_BAR; }
    }
    PG8_WAIT_V(0);
    if constexpr (!ALIGN_EPI) { if (wr == 0) PG8_BAR; }
    PG8_BAR;
    if constexpr (Epi::AFTER_DRAIN) { E.fused(acc, cur, wr, wc, fr, fq, lds, wid, lane); S.done(cur); }
#undef PG8_SA
#undef PG8_GOFF
#undef PG8_STAGE_A
#undef PG8_SB
#undef PG8_STAGE
#undef PG8_LDA
#undef PG8_LDB
#undef PG8_MMA
#undef PG8_WAIT_V
#undef PG8_WAIT_L
#undef PG8_BAR
#undef PG8_SCHED
}
}

constexpr int NB = 16, SEQ = 4096, CTX = 256, TT = SEQ + CTX, M = NB * TT, D = 1024, NL = 4;
constexpr int NPJ = 2304, DPROJ = 2208;
constexpr int MS = 143360;
constexpr float EPS = 1e-6f, ALPHA = 1.6817928305074290f, LOG2E = 1.4426950408889634f;
constexpr int NWAVES = 8, NTHR = 512;
#ifndef MK_DEBUG
#define MK_DEBUG 0
#endif
#ifndef MK_TIME
#define MK_TIME 0
#endif
#ifndef MK_TMUL
#define MK_TMUL 1
#endif
#ifndef MK_VM
#define MK_VM 0
#endif
#ifndef MK_DUP
#define MK_DUP 0
#endif
#ifndef MK_MULTI
#define MK_MULTI 0
#endif
constexpr int NPHASE = 2 + 10 * NL;

constexpr size_t WS_CTL = 0, CTL_BYTES = 65536;
constexpr size_t WS_MODS = WS_CTL + CTL_BYTES;
constexpr size_t WS_T64 = WS_MODS + (size_t)NL * 17 * 6144 * 4;
constexpr size_t WS_T32 = WS_T64 + 8192;
constexpr size_t WS_RS = WS_T32 + 4096;
constexpr size_t WS_RT = WS_RS + (size_t)M * 8;
constexpr size_t WS_HIST = WS_RT + (size_t)M * 32;
constexpr size_t WS_XS = WS_HIST + 65536;
constexpr size_t WS_WIN = WS_XS + (size_t)M * D * 2;
constexpr size_t WS_WD = WS_WIN + (size_t)NPJ * D * 2;
constexpr size_t WS_WOUT = WS_WD + (size_t)1024 * 384 * 2;
constexpr size_t WS_WGU = WS_WOUT + (size_t)D * D * 2;
constexpr size_t WS_WDN = WS_WGU + (size_t)16 * 1024 * 1024 * 2;
constexpr size_t WS_HA = WS_WDN + (size_t)16 * 1024 * 512 * 2;
constexpr size_t WS_PB = WS_HA + (size_t)M * D * 2;
constexpr size_t WS_QD = WS_PB + (size_t)M * NPJ * 2;
constexpr size_t WS_KD = WS_QD + (size_t)M * 384 * 2;
constexpr size_t WS_VD = WS_KD + (size_t)M * 384 * 2;
constexpr size_t WS_ACT = WS_VD + (size_t)M * 256 * 2;
constexpr size_t WS_END = WS_ACT + (size_t)MS * 512 * 2;
static_assert(WS_END <= (size_t)1073741824, "d_ws map must fit 1 GiB");
static_assert((size_t)M * NPJ * 2 >= (size_t)MS * D * 2 && (size_t)M * NPJ * 2 >= (size_t)M * D * 4, "region PB overlays");
constexpr int CW_BAR = 0;
constexpr int CW_LNQ = 12288;
constexpr int CW_QUEUE = 4096;

constexpr int RING_BYTES = 131072, MISC_OFF = RING_BYTES, LDS_BYTES = 147456;
constexpr int MI_BAR = 0, MI_Q = 4, MI_TOT = 16, MI_BASE = 32, MI_PST = 48, MI_LH = 80;

#define GAS __attribute__((address_space(1)))
#define LAS __attribute__((address_space(3)))
typedef unsigned short bf16;
typedef unsigned v4u __attribute__((ext_vector_type(4)));
typedef unsigned v2u __attribute__((ext_vector_type(2)));
typedef float f32x4 __attribute__((ext_vector_type(4)));
typedef float f32x2 __attribute__((ext_vector_type(2)));
typedef short bf16x8 __attribute__((ext_vector_type(8)));
typedef float f32x16 __attribute__((ext_vector_type(16)));
typedef short v4i16 __attribute__((ext_vector_type(4)));

__device__ __forceinline__ unsigned f2bf(float f) { unsigned u = __builtin_bit_cast(unsigned, f); return (u + 0x7fffu + ((u >> 16) & 1u)) >> 16; }
typedef __bf16 bf16x2_hw __attribute__((ext_vector_type(2)));
__device__ __forceinline__ unsigned pk2(float lo, float hi) { f32x2 v = {lo, hi}; const bf16x2_hw b = __builtin_convertvector(v, bf16x2_hw); return __builtin_bit_cast(unsigned, b); }
__device__ __forceinline__ float bflo(unsigned w) { return __builtin_bit_cast(float, w << 16); }
__device__ __forceinline__ float bfhi(unsigned w) { return __builtin_bit_cast(float, w & 0xffff0000u); }
__device__ __forceinline__ void unpack8(v4u w, float (&f)[8]) { f[0] = bflo(w.x); f[1] = bfhi(w.x); f[2] = bflo(w.y); f[3] = bfhi(w.y); f[4] = bflo(w.z); f[5] = bfhi(w.z); f[6] = bflo(w.w); f[7] = bfhi(w.w); }
__device__ __forceinline__ v4u pack8(const float (&f)[8]) { v4u w; w.x = pk2(f[0], f[1]); w.y = pk2(f[2], f[3]); w.z = pk2(f[4], f[5]); w.w = pk2(f[6], f[7]); return w; }
__device__ __forceinline__ float wave_sum(float v) {
    int x = __builtin_bit_cast(int, v);
#define WS_DPP(ctrl, rmask) v += __builtin_bit_cast(float, __builtin_amdgcn_update_dpp(0, x, ctrl, rmask, 0xf, true)); x = __builtin_bit_cast(int, v)
    WS_DPP(0xB1, 0xf);
    WS_DPP(0x4E, 0xf);
    WS_DPP(0x141, 0xf);
    WS_DPP(0x140, 0xf);
    WS_DPP(0x142, 0xa);
    WS_DPP(0x143, 0xc);
#undef WS_DPP
    return __builtin_bit_cast(float, __builtin_amdgcn_readlane(__builtin_bit_cast(int, v), 63));
}

#define XB_TMO      128
#define XB_XCNT(j)  (256  + 64 * (j))
#define XB_XSUB(j)  (1280 + 64 * (j))
#define XB_XGEN(j)  (2304 + 64 * (j))
#define XB_TOP      3328
#define XB_TOPGEN   3392
#define XCD_BAR_WORDS 3456
#define XB_SPIN_CAP (1u << 22)
__device__ __forceinline__ unsigned xb_ld(unsigned* p)              { return __hip_atomic_load(p, __ATOMIC_RELAXED, __HIP_MEMORY_SCOPE_AGENT); }
__device__ __forceinline__ unsigned xb_add(unsigned* p, unsigned v) { return __hip_atomic_fetch_add(p, v, __ATOMIC_RELAXED, __HIP_MEMORY_SCOPE_AGENT); }
__device__ __forceinline__ unsigned xb_xcc_id() { return (unsigned)__builtin_amdgcn_s_getreg((3 << 11) | 20) & 0xFu; }
#define XB_SPIN(cond, bar) do { unsigned _sp = 0; while (cond) { __builtin_amdgcn_s_sleep(1); \
    if ((++_sp & 255u) == 0u) { if (xb_ld(&(bar)[XB_TMO])) break; if (_sp > XB_SPIN_CAP) { atomicAdd(&(bar)[XB_TMO], 1u); break; } } } } while (0)
struct XcdBarrier { unsigned* bar; unsigned x; volatile LAS unsigned* st; };
__device__ __forceinline__ XcdBarrier xcd_barrier_post(unsigned* bar, volatile LAS unsigned* st) {
    XcdBarrier b; b.bar = bar; b.x = xb_xcc_id(); b.st = st;
    if (threadIdx.x == 0) (void)xb_add(&bar[XB_XCNT(b.x)], 1u);
    return b;
}
__device__ __forceinline__ void xcd_barrier_complete(unsigned* bar, unsigned x, unsigned& nloc, unsigned& nx) {
    const unsigned G = gridDim.x * gridDim.y * gridDim.z;
    unsigned sum, cnt, mine, sp = 0u;
    for (;;) {
        sum = 0u; cnt = 0u; mine = 0u;
#pragma unroll
        for (unsigned j = 0; j < 16; ++j) { const unsigned c = xb_ld(&bar[XB_XCNT(j)]); sum += c; cnt += (c > 0u) ? 1u : 0u; mine = (j == x) ? c : mine; }
        if (sum == G) break;
        __builtin_amdgcn_s_sleep(1);
        if ((++sp & 255u) == 0u) { if (xb_ld(&bar[XB_TMO])) break; if (sp > XB_SPIN_CAP) { atomicAdd(&bar[XB_TMO], 1u); break; } }
    }
    nloc = mine > 0u ? mine : 1u; nx = cnt > 0u ? cnt : 1u;
}
__device__ __forceinline__ void xcd_barrier(const XcdBarrier& b) {
    asm volatile("s_waitcnt vmcnt(0)" ::: "memory");
    __syncthreads();
    if (threadIdx.x == 0) {
        unsigned* bar = b.bar;
        __builtin_amdgcn_s_waitcnt(0);
        unsigned nloc = b.st[0], nx = b.st[1];
        if (nloc == 0u) { xcd_barrier_complete(bar, b.x, nloc, nx); b.st[0] = nloc; b.st[1] = nx; }
        const unsigned old = xb_add(&bar[XB_XSUB(b.x)], 1u);
        const unsigned gen = old / nloc;
        if (old + 1u == (gen + 1u) * nloc) {
            __builtin_amdgcn_fence(__ATOMIC_RELEASE, "agent");
            asm volatile("s_waitcnt vmcnt(0)" ::: "memory");
            const unsigned og = xb_add(&bar[XB_TOP], 1u);
            const unsigned tg = og / nx;
            if (og + 1u == (tg + 1u) * nx) xb_add(&bar[XB_TOPGEN], 1u);
            else XB_SPIN(xb_ld(&bar[XB_TOPGEN]) == tg, bar);
            __builtin_amdgcn_fence(__ATOMIC_ACQUIRE, "agent");
            xb_add(&bar[XB_XGEN(b.x)], 1u);
            asm volatile("s_waitcnt vmcnt(0)" ::: "memory");
        } else {
            XB_SPIN(xb_ld(&bar[XB_XGEN(b.x)]) == gen, bar);
            __builtin_amdgcn_fence(__ATOMIC_ACQUIRE, "agent");
            asm volatile("s_waitcnt vmcnt(0)" ::: "memory");
        }
    }
    __syncthreads();
}

struct Args { const float* in[27]; float* out; unsigned char* ws; int ph_lo, ph_hi; };
enum { I_X = 0, I_C, I_CTX, I_CCTX, I_WADA, I_BADA, I_WIN, I_NABIAS, I_GQG, I_GKG, I_SINK, I_MQG, I_WQB, I_MKVG, I_WKVB, I_WOUT, I_LN1G, I_LN1B, I_RGW, I_RGB, I_REW, I_REB, I_WG, I_WU, I_WDN, I_LN2G, I_LN2B };

struct Frame {
    LAS unsigned char* lds; volatile LAS unsigned* MISC;
    int tid, lane, wave, G, gw, ngw, bid;
    GAS unsigned char* ws;
};
__device__ __forceinline__ int opaque_tid() { int t = threadIdx.x; asm volatile("" : "+v"(t)); return t; }
__device__ __forceinline__ int opaque_s(int x) { asm volatile("" : "+s"(x)); return x; }
constexpr int PTAB_OFF = MISC_OFF + 2048, I_OUT = 27;
__device__ __forceinline__ GAS unsigned char* ptab_get(const Frame& F, int i) {
    const LAS unsigned* t = (const LAS unsigned*)(F.lds + PTAB_OFF) + 2 * i;
    const unsigned lo = __builtin_amdgcn_readfirstlane(t[0]), hi = __builtin_amdgcn_readfirstlane(t[1]);
    return (GAS unsigned char*)(((unsigned long long)hi << 32) | lo);
}
#define INP(i) ((const float*)ptab_get(F, (i)))
__device__ __forceinline__ Frame make_frame(GAS unsigned char* ws) {
    extern __shared__ __attribute__((aligned(16))) unsigned char lds_raw[];
    Frame F;
    F.lds = (LAS unsigned char*)lds_raw; F.MISC = (volatile LAS unsigned*)(F.lds + MISC_OFF);
    F.tid = opaque_tid(); F.lane = F.tid & 63; F.wave = __builtin_amdgcn_readfirstlane(F.tid >> 6);
    F.G = opaque_s((int)gridDim.x); F.bid = opaque_s((int)blockIdx.x); F.gw = F.bid * NWAVES + F.wave; F.ngw = F.G * NWAVES;
    { unsigned long long w = (unsigned long long)ws; asm volatile("" : "+s"(w)); F.ws = (GAS unsigned char*)w; }
    return F;
}
typedef _Float16 f16x4 __attribute__((ext_vector_type(4)));
struct RowPtrs { const float* x; const float* ctx; float* out; _Float16* xs; };
__device__ __forceinline__ RowPtrs row_ptrs(const Frame& F) { RowPtrs p; p.x = INP(I_X); p.ctx = INP(I_CTX); p.out = (float*)ptab_get(F, I_OUT); p.xs = (_Float16*)(F.ws + WS_XS); return p; }
__device__ __forceinline__ const float* xin_row(const RowPtrs& P, int r) {
    const int b = r / TT, t = r - b * TT;
    return t < SEQ ? P.x + ((size_t)b * SEQ + t) * D : P.ctx + ((size_t)b * CTX + (t - SEQ)) * D;
}
__device__ __forceinline__ float* out_row(const RowPtrs& P, int r) { const int b = r / TT, t = r - b * TT; return P.out + ((size_t)b * SEQ + t) * D; }
__device__ __forceinline__ void ld16h(const _Float16* p, int lane, float (&v)[16]) {
    const f16x4* q = (const f16x4*)p + lane;
#pragma unroll
    for (int g = 0; g < 4; ++g) { const f32x4 f = __builtin_convertvector(__builtin_nontemporal_load(q + 64 * g), f32x4); v[4 * g] = f.x; v[4 * g + 1] = f.y; v[4 * g + 2] = f.z; v[4 * g + 3] = f.w; }
}
__device__ __forceinline__ void st16h(_Float16* p, int lane, const float (&v)[16]) {
    f16x4* q = (f16x4*)p + lane;
#pragma unroll
    for (int g = 0; g < 4; ++g) __builtin_nontemporal_store(__builtin_convertvector((f32x4){v[4 * g], v[4 * g + 1], v[4 * g + 2], v[4 * g + 3]}, f16x4), q + 64 * g);
}
__device__ __forceinline__ void ld16(const float* p, int lane, float (&v)[16]) {
    const f32x4* q = (const f32x4*)p + lane;
    const f32x4 a = q[0], b = q[64], c = q[128], d = q[192];
    v[0] = a.x; v[1] = a.y; v[2] = a.z; v[3] = a.w; v[4] = b.x; v[5] = b.y; v[6] = b.z; v[7] = b.w;
    v[8] = c.x; v[9] = c.y; v[10] = c.z; v[11] = c.w; v[12] = d.x; v[13] = d.y; v[14] = d.z; v[15] = d.w;
}
__device__ __forceinline__ void st16(float* p, int lane, const float (&v)[16]) {
    f32x4* q = (f32x4*)p + lane;
    q[0] = (f32x4){v[0], v[1], v[2], v[3]}; q[64] = (f32x4){v[4], v[5], v[6], v[7]};
    q[128] = (f32x4){v[8], v[9], v[10], v[11]}; q[192] = (f32x4){v[12], v[13], v[14], v[15]};
}
__device__ __forceinline__ void ld16nt(const float* p, int lane, float (&v)[16]) {
    const f32x4* q = (const f32x4*)p + lane;
    const f32x4 a = __builtin_nontemporal_load(q), b = __builtin_nontemporal_load(q + 64), c = __builtin_nontemporal_load(q + 128), d = __builtin_nontemporal_load(q + 192);
    v[0] = a.x; v[1] = a.y; v[2] = a.z; v[3] = a.w; v[4] = b.x; v[5] = b.y; v[6] = b.z; v[7] = b.w;
    v[8] = c.x; v[9] = c.y; v[10] = c.z; v[11] = c.w; v[12] = d.x; v[13] = d.y; v[14] = d.z; v[15] = d.w;
}
__device__ __forceinline__ void st16nt(float* p, int lane, const float (&v)[16]) {
    f32x4* q = (f32x4*)p + lane;
    __builtin_nontemporal_store((f32x4){v[0], v[1], v[2], v[3]}, q); __builtin_nontemporal_store((f32x4){v[4], v[5], v[6], v[7]}, q + 64);
    __builtin_nontemporal_store((f32x4){v[8], v[9], v[10], v[11]}, q + 128); __builtin_nontemporal_store((f32x4){v[12], v[13], v[14], v[15]}, q + 192);
}
__device__ __forceinline__ void unpack16(const v2u (&w)[4], float (&v)[16]) {
#pragma unroll
    for (int g = 0; g < 4; ++g) { v[4 * g] = bflo(w[g].x); v[4 * g + 1] = bfhi(w[g].x); v[4 * g + 2] = bflo(w[g].y); v[4 * g + 3] = bfhi(w[g].y); }
}
__device__ __forceinline__ void ld16bf_raw(const bf16* p, int lane, v2u (&w)[4]) {
    const v2u* q = (const v2u*)p + lane; w[0] = q[0]; w[1] = q[64]; w[2] = q[128]; w[3] = q[192];
}
__device__ __forceinline__ void ld16bf_raw_nt(const bf16* p, int lane, v2u (&w)[4]) {
    const v2u* q = (const v2u*)p + lane; w[0] = __builtin_nontemporal_load(q); w[1] = __builtin_nontemporal_load(q + 64); w[2] = __builtin_nontemporal_load(q + 128); w[3] = __builtin_nontemporal_load(q + 192);
}
__device__ __forceinline__ void ld16bf(const bf16* p, int lane, float (&v)[16]) { v2u w[4]; ld16bf_raw(p, lane, w); unpack16(w, v); }
__device__ __forceinline__ void ld16bf_nt(const bf16* p, int lane, float (&v)[16]) { v2u w[4]; ld16bf_raw_nt(p, lane, w); unpack16(w, v); }
__device__ __forceinline__ void st16bf(bf16* p, int lane, const float (&v)[16]) {
    v2u* q = (v2u*)p + lane;
#pragma unroll
    for (int g = 0; g < 4; ++g) { v2u w; w.x = pk2(v[4 * g], v[4 * g + 1]); w.y = pk2(v[4 * g + 2], v[4 * g + 3]); q[64 * g] = w; }
}
__device__ __forceinline__ void ln16(float (&v)[16]) {
    float s = 0.f;
#pragma unroll
    for (int i = 0; i < 16; ++i) s += v[i];
    const float mean = wave_sum(s) * (1.0f / D); float q = 0.f;
#pragma unroll
    for (int i = 0; i < 16; ++i) { v[i] -= mean; q += v[i] * v[i]; }
    const float rstd = __builtin_amdgcn_rsqf(wave_sum(q) * (1.0f / D) + EPS);
#pragma unroll
    for (int i = 0; i < 16; ++i) v[i] *= rstd;
}

__device__ __forceinline__ int rows_per_wave(int ngw) {
    int rpw = (M + ngw - 1) / ngw;
    if (!((SEQ % rpw) % 4 == 0 && (TT % rpw) == 0 && (rpw % 2) == 0)) rpw = (rpw + 3) & ~3;
    return rpw;
}
template <int TYPE>
__device__ __forceinline__ float conv_src(const float* p0, const float* p1, const float* g0, const float* g1, int l, int k, int n) {
    if (TYPE == 0) return n < DPROJ ? p0[((size_t)l * D + k) * DPROJ + n] : 0.f;
    if (TYPE == 1) { if (n < 384) return k < 256 ? g0[l * 256 + k] * p0[((size_t)l * 256 + k) * 384 + n] : 0.f;
                     if (n < 896) return k >= 256 ? g1[l * 128 + (k - 256)] * p1[((size_t)l * 128 + (k - 256)) * 512 + (n - 384)] : 0.f;
                     return 0.f; }
    if (TYPE == 2) return p0[((size_t)l * D + k) * D + n];
    if (TYPE == 3) { const int e = n >> 10, nn = n & 1023, q = nn >> 3, j = nn & 7;
                     return j < 4 ? p0[(((size_t)l * 16 + e) * D + k) * 512 + 4 * q + j] : p1[(((size_t)l * 16 + e) * D + k) * 512 + 4 * q + (j - 4)]; }
    { const int e = n >> 10, nn = n & 1023; return p0[(((size_t)l * 16 + e) * 512 + k) * D + nn]; }
}
template <int TYPE>
__device__ __forceinline__ void conv_item(const Frame& F, int l, int item, LAS float* scr) {
    constexpr int Nd = TYPE == 0 ? NPJ : TYPE == 1 ? 1024 : TYPE == 2 ? 1024 : 16384, Kd = TYPE == 1 ? 384 : TYPE == 4 ? 512 : 1024;
    bf16* dst = (bf16*)(F.ws + (TYPE == 0 ? WS_WIN : TYPE == 1 ? WS_WD : TYPE == 2 ? WS_WOUT : TYPE == 3 ? WS_WGU : WS_WDN));
    const float* p0 = INP(TYPE == 0 ? I_WIN : TYPE == 1 ? I_WQB : TYPE == 2 ? I_WOUT : TYPE == 3 ? I_WG : I_WDN);
    const float* p1 = INP(TYPE == 1 ? I_WKVB : I_WU); const float* g0 = INP(I_MQG); const float* g1 = INP(I_MKVG);
    constexpr int nblk = Nd / 32; const int kb = item / nblk, nb = item - kb * nblk, k0 = 64 * kb, n0 = 32 * nb, lane = F.lane;
#pragma unroll
    for (int i = 0; i < 32; ++i) { const int kk = 2 * i + (lane >> 5); scr[kk * 33 + (lane & 31)] = conv_src<TYPE>(p0, p1, g0, g1, l, k0 + kk, n0 + (lane & 31)); }
    asm volatile("s_waitcnt lgkmcnt(0)" ::: "memory");
    const int c = lane & 7;
#pragma unroll
    for (int j = 0; j < 4; ++j) { const int n = (lane >> 3) + 8 * j; const LAS float* s = scr + (8 * c) * 33 + n;
        v4u o; o.x = pk2(s[0 * 33], s[1 * 33]); o.y = pk2(s[2 * 33], s[3 * 33]); o.z = pk2(s[4 * 33], s[5 * 33]); o.w = pk2(s[6 * 33], s[7 * 33]);
        *(v4u*)(dst + (size_t)(n0 + n) * Kd + k0 + 8 * c) = o; }
    asm volatile("s_waitcnt lgkmcnt(0)" ::: "memory");
}
__device__ __forceinline__ void phase_prologue(const Frame& F) {
    {
        LAS float* sv = (LAS float*)F.lds;
        LAS float* red = (LAS float*)(F.lds + 17 * 1024 * 4);
        float* mods = (float*)(F.ws + WS_MODS);
        for (int u = F.bid; u < NL * 48; u += F.G) {
            const int l = u / 48, cc = u - l * 48;
            const float* pc = INP(I_C); const float* pcc = INP(I_CCTX);
            for (int i = F.tid; i < 17 * 1024; i += NTHR) { const int mr = i >> 10, k = i & 1023; const float c = mr < 16 ? pc[mr * 1024 + k] : pcc[k]; sv[i] = c / (1.0f + expf(-c)); }
            __syncthreads();
            const int col = F.tid & 127, kg = F.tid >> 7;
            float acc[17];
#pragma unroll
            for (int mr = 0; mr < 17; ++mr) acc[mr] = 0.f;
            const float* w = INP(I_WADA) + ((size_t)l * 1024 + kg * 256) * 6144 + cc * 128 + col;
            for (int k4 = 0; k4 < 256; k4 += 4) {
                const float w0 = w[(size_t)(k4 + 0) * 6144], w1 = w[(size_t)(k4 + 1) * 6144], w2 = w[(size_t)(k4 + 2) * 6144], w3 = w[(size_t)(k4 + 3) * 6144];
#pragma unroll
                for (int mr = 0; mr < 17; ++mr) { const f32x4 s = *(const LAS f32x4*)(sv + mr * 1024 + kg * 256 + k4); acc[mr] += (s.x * w0 + s.y * w1) + (s.z * w2 + s.w * w3); }
            }
#pragma unroll
            for (int mr = 0; mr < 17; ++mr) red[(kg * 17 + mr) * 128 + col] = acc[mr];
            __syncthreads();
            const float* bada = INP(I_BADA);
            for (int i = F.tid; i < 17 * 128; i += NTHR) { const int mr = i >> 7, c = i & 127;
                const float s = (red[(0 * 17 + mr) * 128 + c] + red[(1 * 17 + mr) * 128 + c]) + (red[(2 * 17 + mr) * 128 + c] + red[(3 * 17 + mr) * 128 + c]);
                mods[((size_t)l * 17 + mr) * 6144 + cc * 128 + c] = s + bada[l * 6144 + cc * 128 + c]; }
            __syncthreads();
        }
    }
    {
        float* t64 = (float*)(F.ws + WS_T64); float* t32 = (float*)(F.ws + WS_T32);
        for (int i = F.bid * NTHR + F.tid; i < 64 * 16 + 64 * 8; i += F.G * NTHR) {
            if (i < 1024) { const int p = i >> 4, k = i & 15; const float fr = powf(10000.0f, -(float)k / 16.0f), ang = (float)p * fr; t64[2 * i] = cosf(ang); t64[2 * i + 1] = sinf(ang); }
            else { const int j = i - 1024, p = j >> 3, k = j & 7; const float fr = powf(10000.0f, -(float)k / 8.0f), ang = (float)p * fr; t32[2 * j] = cosf(ang); t32[2 * j + 1] = sinf(ang); }
        }
    }
}
__device__ __forceinline__ void convert_layer_weights(const Frame& F, int l) {
    {
        LAS float* scr = (LAS float*)(F.lds + F.wave * 8448);
        constexpr int I0 = 1152, I1 = 192, I2 = 512, I3 = 8192, I4 = 4096, IL = I0 + I1 + I2 + I3 + I4;
        for (int r0_ = F.gw; r0_ < IL; r0_ += F.ngw) {
            int r = r0_;
            if (r < I0) { conv_item<0>(F, l, r, scr); continue; } r -= I0;
            if (r < I1) { conv_item<1>(F, l, r, scr); continue; } r -= I1;
            if (r < I2) { conv_item<2>(F, l, r, scr); continue; } r -= I2;
            if (r < I3) { conv_item<3>(F, l, r, scr); continue; } r -= I3;
            conv_item<4>(F, l, r, scr);
        }
    }
}

__device__ __forceinline__ void phase_ln(const Frame& F, int l) {
    if (l < NL) convert_layer_weights(F, l);
    constexpr int NR = 4;
    const float* mods = (const float*)(F.ws + WS_MODS); bf16* HA = (bf16*)(F.ws + WS_HA);
    const bf16* Y = (const bf16*)(F.ws + WS_PB); const unsigned* RT = (const unsigned*)(F.ws + WS_RT);
    const int lane = F.lane; const RowPtrs RP = row_ptrs(F);
    const float* ln2g = INP(I_LN2G) + (l > 0 ? l - 1 : 0) * D; const float* ln2b = INP(I_LN2B) + (l > 0 ? l - 1 : 0) * D;
    const int rpw = rows_per_wave(F.ngw), rbeg = F.gw * rpw, ngrp = (rpw + NR - 1) / NR, nstat = ngrp > 2 ? ngrp - 2 : 0, ntail = ngrp - nstat;
    const int NT = ((M + rpw - 1) / rpw) * ntail;
    unsigned* lnq = (unsigned*)(F.ws + WS_CTL) + CW_LNQ + 64 * l;
    float g2[16]; int cur_mr = -1;
    float alpha_l = ALPHA; asm volatile("" : "+v"(alpha_l));
    unsigned nxt_v = 0u; bool have = false; int git = 0;
#define LN_GRAB() do { if (lane == 0) nxt_v = __hip_atomic_fetch_add(lnq, 1u, __ATOMIC_RELAXED, __HIP_MEMORY_SCOPE_AGENT); have = true; } while (0)
    for (;;) {
        int r0, rend;
        if (git < nstat) { r0 = rbeg + git * NR; rend = min(M, rbeg + rpw); ++git; if (git == nstat) LN_GRAB(); if (r0 >= rend) continue; }
        else {
            if (!have) LN_GRAB();
            const int c = (int)__builtin_amdgcn_readfirstlane(nxt_v); if (c >= NT) break;
            LN_GRAB();
            const int ow = c / ntail, sub = c - ow * ntail, ob = ow * rpw; r0 = ob + (nstat + sub) * NR; rend = min(M, ob + rpw); if (r0 >= rend) continue;
        }
        float v[NR][16]; v4u rt[NR]; v2u ya[NR][4], yb[NR][4]; bool act[NR];
        const int b0 = r0 / TT, t0 = r0 - b0 * TT; const bool lat = t0 < SEQ; const int mr = lat ? b0 : 16;
        if (l == NL && !lat) continue;
#pragma unroll
        for (int u = 0; u < NR; ++u) {
            const int r = r0 + u; act[u] = r < rend; const int rc = act[u] ? r : r0;
            if (l == 0) ld16nt(xin_row(RP, rc), lane, v[u]); else ld16h(RP.xs + (size_t)rc * D, lane, v[u]);
            rt[u] = *(const v4u*)(RT + (size_t)rc * 8 + 4);
        }
        if (mr != cur_mr) { if (l > 0) ld16(mods + ((size_t)(l - 1) * 17 + mr) * 6144 + 5120, lane, g2); cur_mr = mr; }
        if (l > 0) {
#pragma unroll
            for (int u = 0; u < NR; ++u) { ld16bf_raw_nt(Y + (size_t)rt[u].z * D, lane, ya[u]); ld16bf_raw_nt(Y + (size_t)rt[u].w * D, lane, yb[u]); }
#pragma unroll
            for (int u = 0; u < NR; ++u) {
                float f0[16], f1[16], gg[16], bb[16];
                const float w0 = __uint_as_float(rt[u].x), w1 = __uint_as_float(rt[u].y);
                unpack16(ya[u], f0); unpack16(yb[u], f1);
#pragma unroll
                for (int i = 0; i < 16; ++i) v[u][i] = alpha_l * v[u][i] + g2[i] * (w0 * f0[i] + w1 * f1[i]);
                ld16(ln2g, lane, gg); ld16(ln2b, lane, bb);
                ln16(v[u]);
#pragma unroll
                for (int i = 0; i < 16; ++i) v[u][i] = v[u][i] * gg[i] + bb[i];
                if (act[u]) { if (l == NL) st16nt(out_row(RP, r0 + u), lane, v[u]); else st16h(RP.xs + (size_t)(r0 + u) * D, lane, v[u]); }
            }
        }
        if (l < NL) {
            float sh[16], sc[16]; ld16(mods + ((size_t)l * 17 + mr) * 6144, lane, sh); ld16(mods + ((size_t)l * 17 + mr) * 6144 + 1024, lane, sc);
#pragma unroll
            for (int u = 0; u < NR; ++u) {
                ln16(v[u]);
#pragma unroll
                for (int i = 0; i < 16; ++i) v[u][i] = v[u][i] * (1.0f + sc[i]) + sh[i];
                if (act[u]) st16bf(HA + (size_t)(r0 + u) * D, lane, v[u]);
            }
        }
    }
}

#undef LN_GRAB
__device__ __forceinline__ void rope8(float (&f)[8], const float (&p)[8], const float* cs, bool first) {
    const f32x4* c4 = (const f32x4*)cs;
#pragma unroll
    for (int q = 0; q < 4; ++q) { const f32x4 t = c4[q];
        f[2 * q] = first ? f[2 * q] * t.x - p[2 * q] * t.y : p[2 * q] * t.y + f[2 * q] * t.x;
        f[2 * q + 1] = first ? f[2 * q + 1] * t.z - p[2 * q + 1] * t.w : p[2 * q + 1] * t.w + f[2 * q + 1] * t.z; }
}
#define DPPF(v, ctrl) __builtin_bit_cast(float, __builtin_amdgcn_update_dpp(0, __builtin_bit_cast(int, (v)), (ctrl), 0xf, 0xf, true))
__device__ __forceinline__ float dpp_xor1(float v) { return DPPF(v, 0xB1); }
__device__ __forceinline__ float dpp_xor2(float v) { return DPPF(v, 0x4E); }
__device__ __forceinline__ float dpp_hmir(float v) { return DPPF(v, 0x141); }
__device__ __forceinline__ float dpp_mir(float v) { return DPPF(v, 0x140); }
__device__ __forceinline__ void phase_post(const Frame& F, int l) {
    constexpr int NR = 4;
    bf16* P = (bf16*)(F.ws + WS_PB); bf16* KD = (bf16*)(F.ws + WS_KD);
    const float* t64 = (const float*)(F.ws + WS_T64); const float* t32 = (const float*)(F.ws + WS_T32);
    const int lane = F.lane; const float* gains = (lane < 32 ? INP(I_GQG) : INP(I_GKG)) + l * 64;
    const int j = lane & 7, jj = lane & 3;
    float gn[8];
#pragma unroll
    for (int i = 0; i < 8; ++i) gn[i] = gains[j * 8 + i];
    for (int r0 = F.gw; r0 < M; r0 += NR * F.ngw) {
        v4u w0[NR], w1[NR], w2[NR]; int rr[NR]; bool act[NR];
#pragma unroll
        for (int u = 0; u < NR; ++u) { const int r = r0 + u * F.ngw; act[u] = r < M; rr[u] = act[u] ? r : r0; const bf16* prow = P + (size_t)rr[u] * NPJ;
            w0[u] = *((const v4u*)(prow + 768) + lane); w1[u] = *((const v4u*)(prow + 1280) + lane); w2[u] = *((const v4u*)(prow + 1792) + lane); }
#pragma unroll
        for (int u = 0; u < NR; ++u) {
            const int r = rr[u]; const int b = r / TT, t = r - b * TT; const bool lat = t < SEQ; const int gr = (t >> 6) & 63, gc = t & 63;
            bf16* prow = P + (size_t)r * NPJ;
            const float* cs64 = t64 + ((size_t)((j < 4 ? gr : gc) * 16 + (j & 1) * 8)) * 2;
            {
                float f[8]; unpack8(w0[u], f);
                float ss = 0.f;
#pragma unroll
                for (int i = 0; i < 8; ++i) ss += f[i] * f[i];
                ss += dpp_xor1(ss); ss += dpp_xor2(ss); ss += dpp_hmir(ss);
                const float rs = __builtin_amdgcn_rsqf(ss * (1.0f / 64.0f) + EPS);
#pragma unroll
                for (int i = 0; i < 8; ++i) f[i] = f[i] * rs * gn[i];
                float p[8];
#pragma unroll
                for (int i = 0; i < 8; ++i) p[i] = dpp_xor2(f[i]);
                if (lat) rope8(f, p, cs64, (j & 2) == 0);
                if (lane < 48 && act[u]) *((v4u*)(prow + 768) + lane) = pack8(f);
            }
            {
                float f[8]; unpack8(w1[u], f);
                float p[8];
#pragma unroll
                for (int i = 0; i < 8; ++i) p[i] = dpp_xor2(f[i]);
                rope8(f, p, cs64, (j & 2) == 0);
                if (lat && lane < 48 && act[u]) *((v4u*)(prow + 1280) + lane) = pack8(f);
            }
            {
                float f[8]; unpack8(w2[u], f);
                float ss = 0.f;
#pragma unroll
                for (int i = 0; i < 8; ++i) ss += f[i] * f[i];
                ss += dpp_xor1(ss); ss += dpp_xor2(ss); ss += dpp_hmir(ss); ss += dpp_mir(ss);
                const float s32 = __builtin_bit_cast(float, __builtin_amdgcn_readlane(__builtin_bit_cast(int, ss), 0)) + __builtin_bit_cast(float, __builtin_amdgcn_readlane(__builtin_bit_cast(int, ss), 16));
                const float rn = __builtin_amdgcn_rsqf(lane < 32 ? s32 * (1.0f / 256.0f) + EPS : ss * (1.0f / 128.0f) + EPS);
                if (lane < 48 && act[u]) { float fn[8];
#pragma unroll
                    for (int i = 0; i < 8; ++i) fn[i] = f[i] * rn;
                    *((v4u*)(prow + 1792) + lane) = pack8(fn); }
                float p[8];
#pragma unroll
                for (int i = 0; i < 8; ++i) p[i] = dpp_xor1(f[i]);
                if (lat) rope8(f, p, t32 + ((size_t)((jj < 2 ? gr : gc) * 8)) * 2, (jj & 1) == 0);
                if (lane >= 48 && lane < 52 && act[u]) { const v4u o = pack8(f);
#pragma unroll
                    for (int h = 0; h < 4; ++h) *(v4u*)(KD + (size_t)r * 384 + h * 96 + 64 + 8 * jj) = o; }
            }
        }
    }
}

__device__ __forceinline__ float rt_dot(const float (&x)[16], f32x4 w0, f32x4 w1, f32x4 w2, f32x4 w3) {
    float a = x[0] * w0.x, b = x[8] * w2.x;
    a = __builtin_fmaf(x[1], w0.y, a); b = __builtin_fmaf(x[9], w2.y, b); a = __builtin_fmaf(x[2], w0.z, a); b = __builtin_fmaf(x[10], w2.z, b);
    a = __builtin_fmaf(x[3], w0.w, a); b = __builtin_fmaf(x[11], w2.w, b); a = __builtin_fmaf(x[4], w1.x, a); b = __builtin_fmaf(x[12], w3.x, b);
    a = __builtin_fmaf(x[5], w1.y, a); b = __builtin_fmaf(x[13], w3.y, b); a = __builtin_fmaf(x[6], w1.z, a); b = __builtin_fmaf(x[14], w3.z, b);
    a = __builtin_fmaf(x[7], w1.w, a); b = __builtin_fmaf(x[15], w3.w, b);
    return a + b;
}
__device__ __forceinline__ void reduce4(float& a, float& b, float& c, float& d) {
    auto r1 = __builtin_amdgcn_permlane32_swap(__builtin_bit_cast(unsigned, a), __builtin_bit_cast(unsigned, b), false, false); const unsigned x0 = r1[0], x1 = r1[1];
    auto r2 = __builtin_amdgcn_permlane32_swap(__builtin_bit_cast(unsigned, c), __builtin_bit_cast(unsigned, d), false, false); const unsigned y0 = r2[0], y1 = r2[1];
    const float X = __uint_as_float(x0) + __uint_as_float(x1), Y = __uint_as_float(y0) + __uint_as_float(y1);
    auto r3 = __builtin_amdgcn_permlane16_swap(__builtin_bit_cast(unsigned, X), __builtin_bit_cast(unsigned, Y), false, false); const unsigned z0 = r3[0], z1 = r3[1];
    float z = __uint_as_float(z0) + __uint_as_float(z1);
    z += dpp_xor1(z); z += dpp_xor2(z); z += dpp_hmir(z); z += dpp_mir(z);
    const int zi = __builtin_bit_cast(int, z);
    a = __builtin_bit_cast(float, __builtin_amdgcn_readlane(zi, 0)); c = __builtin_bit_cast(float, __builtin_amdgcn_readlane(zi, 16));
    b = __builtin_bit_cast(float, __builtin_amdgcn_readlane(zi, 32)); d = __builtin_bit_cast(float, __builtin_amdgcn_readlane(zi, 48));
}
__device__ __forceinline__ void ln16_pair(float (&v0)[16], float (&v1)[16]) {
    float s0 = 0.f, q0 = 0.f, s1 = 0.f, q1 = 0.f;
#pragma unroll
    for (int i = 0; i < 16; ++i) { s0 += v0[i]; q0 = __builtin_fmaf(v0[i], v0[i], q0); s1 += v1[i]; q1 = __builtin_fmaf(v1[i], v1[i], q1); }
    reduce4(s0, q0, s1, q1);
    const float m0 = s0 * (1.0f / D), m1 = s1 * (1.0f / D);
    const float r0 = __builtin_amdgcn_rsqf(fmaxf(q0 * (1.0f / D) - m0 * m0, 0.f) + EPS), r1 = __builtin_amdgcn_rsqf(fmaxf(q1 * (1.0f / D) - m1 * m1, 0.f) + EPS);
    const float c0 = -m0 * r0, c1 = -m1 * r1;
#pragma unroll
    for (int i = 0; i < 16; ++i) { v0[i] = __builtin_fmaf(v0[i], r0, c0); v1[i] = __builtin_fmaf(v1[i], r1, c1); }
}
__device__ __forceinline__ void phase_route(const Frame& F, int l) {
    const float* mods = (const float*)(F.ws + WS_MODS); bf16* HA = (bf16*)(F.ws + WS_HA);
    const bf16* MIX = (const bf16*)(F.ws + WS_PB); unsigned* RT = (unsigned*)(F.ws + WS_RT); int* HIST = (int*)(F.ws + WS_HIST);
    LAS float* WR = (LAS float*)F.lds;
    { const float* rgw = INP(I_RGW); const float* rew = INP(I_REW);
      for (int i = F.tid; i < 20 * 1024; i += NTHR) { const int jx = i >> 10, k = i & 1023;
        WR[i] = jx < 4 ? rgw[((size_t)l * D + k) * 4 + jx] : rew[((size_t)l * D + k) * 16 + (jx - 4)]; } }
    if (F.tid < 16) F.MISC[MI_LH + F.tid] = 0u;
    __syncthreads();
    LAS float* bias = (LAS float*)(F.lds + 20 * 1024 * 4);
    if (F.tid < 20) bias[F.tid] = F.tid < 4 ? INP(I_RGB)[l * 4 + F.tid] : INP(I_REB)[l * 16 + (F.tid - 4)];
    __syncthreads();
    const RowPtrs RP = row_ptrs(F);
    LAS float* LNG = (LAS float*)(F.lds + 20 * 1024 * 4 + 128);
    { const float* ln1g = INP(I_LN1G) + l * D; const float* ln1b = INP(I_LN1B) + l * D;
      for (int i = F.tid; i < 1024; i += NTHR) { LNG[i] = ln1g[i]; LNG[1024 + i] = ln1b[i]; } }
    __syncthreads();
    constexpr int NR = 2;
    const LAS unsigned char* wbase = (const LAS unsigned char*)WR + F.lane * 16; asm volatile("" : "+v"(wbase));
    const LAS unsigned char* lbase = (const LAS unsigned char*)LNG + F.lane * 16; asm volatile("" : "+v"(lbase));
#define RT_W4(base_, off_) (*(const LAS f32x4*)((base_) + (off_)))
    const int rpw = rows_per_wave(F.ngw), rbeg = F.gw * rpw, rend = min(M, rbeg + rpw);
    float g1[16], sh[16], sc[16]; int cur_mr = -1;
    float alpha_l = ALPHA; asm volatile("" : "+v"(alpha_l));
    v4u rx[NR][4]; v2u rm[NR][4];
#define RT_ISSUE(r0_) do { _Pragma("unroll") for (int u = 0; u < NR; ++u) { const int r_ = (r0_) + u, rc_ = r_ < rend ? r_ : (r0_); \
        if (l == 0) { const v4u* q_ = (const v4u*)xin_row(RP, rc_) + F.lane; _Pragma("unroll") for (int g = 0; g < 4; ++g) rx[u][g] = __builtin_nontemporal_load(q_ + 64 * g); } \
        else { const v2u* q_ = (const v2u*)(RP.xs + (size_t)rc_ * D) + F.lane; _Pragma("unroll") for (int g = 0; g < 4; ++g) { const v2u t_ = __builtin_nontemporal_load(q_ + 64 * g); rx[u][g].x = t_.x; rx[u][g].y = t_.y; } } \
        ld16bf_raw_nt(MIX + (size_t)rc_ * D, F.lane, rm[u]); } } while (0)
    if (rbeg < rend) RT_ISSUE(rbeg);
    for (int r0 = rbeg; r0 < rend; r0 += NR) {
        float v[NR][16]; int rr[NR]; bool act[NR];
        { const int b = r0 / TT, t = r0 - b * TT, mr = t < SEQ ? b : 16;
          if (mr != cur_mr) { const float* md = mods + ((size_t)l * 17 + mr) * 6144; ld16(md + 2048, F.lane, g1); ld16(md + 3072, F.lane, sh); ld16(md + 4096, F.lane, sc); cur_mr = mr; } }
#pragma unroll
        for (int u = 0; u < NR; ++u) { const int r = r0 + u; act[u] = r < rend; rr[u] = act[u] ? r : r0;
            float mx[16]; unpack16(rm[u], mx);
            if (l == 0) {
#pragma unroll
                for (int g = 0; g < 4; ++g) { v[u][4 * g] = __uint_as_float(rx[u][g].x); v[u][4 * g + 1] = __uint_as_float(rx[u][g].y); v[u][4 * g + 2] = __uint_as_float(rx[u][g].z); v[u][4 * g + 3] = __uint_as_float(rx[u][g].w); }
            } else {
#pragma unroll
                for (int g = 0; g < 4; ++g) { const v2u t = {rx[u][g].x, rx[u][g].y}; const f32x4 f = __builtin_convertvector(__builtin_bit_cast(f16x4, t), f32x4);
                    v[u][4 * g] = f.x; v[u][4 * g + 1] = f.y; v[u][4 * g + 2] = f.z; v[u][4 * g + 3] = f.w; }
            }
#pragma unroll
            for (int i = 0; i < 16; ++i) v[u][i] = alpha_l * v[u][i] + g1[i] * mx[i]; }
        if (r0 + NR < rend) RT_ISSUE(r0 + NR);
        if (l == NL - 1 && (r0 % TT) >= SEQ) continue;
        ln16_pair(v[0], v[1]);
        { float gg[16], bb[16];
#pragma unroll
          for (int g = 0; g < 4; ++g) { const f32x4 a = RT_W4(lbase, 1024 * g), c = RT_W4(lbase, 4096 + 1024 * g);
              gg[4 * g] = a.x; gg[4 * g + 1] = a.y; gg[4 * g + 2] = a.z; gg[4 * g + 3] = a.w; bb[4 * g] = c.x; bb[4 * g + 1] = c.y; bb[4 * g + 2] = c.z; bb[4 * g + 3] = c.w; }
#pragma unroll
          for (int u = 0; u < NR; ++u) {
#pragma unroll
            for (int i = 0; i < 16; ++i) v[u][i] = v[u][i] * gg[i] + bb[i];
            if (act[u]) st16h(RP.xs + (size_t)rr[u] * D, F.lane, v[u]); } }
        ln16_pair(v[0], v[1]);
#pragma unroll
        for (int u = 0; u < NR; ++u) {
#pragma unroll
            for (int i = 0; i < 16; ++i) v[u][i] = v[u][i] * (1.0f + sc[i]) + sh[i];
            if (act[u]) st16bf(HA + (size_t)rr[u] * D, F.lane, v[u]); }
#define RT_DOT(u_, w0, w1, w2, w3) rt_dot(v[u_], w0, w1, w2, w3)
        float gl[NR][4];
#pragma unroll
        for (int jx = 0; jx < 4; ++jx) {
            const f32x4 w0 = RT_W4(wbase, 4096 * jx), w1 = RT_W4(wbase, 4096 * jx + 1024), w2 = RT_W4(wbase, 4096 * jx + 2048), w3 = RT_W4(wbase, 4096 * jx + 3072);
#pragma unroll
            for (int u = 0; u < NR; ++u) gl[u][jx] = RT_DOT(u, w0, w1, w2, w3);
        }
#pragma unroll
        for (int u = 0; u < NR; ++u) { reduce4(gl[u][0], gl[u][1], gl[u][2], gl[u][3]);
#pragma unroll
            for (int jx = 0; jx < 4; ++jx) gl[u][jx] += bias[jx]; }
        int grpv[NR]; float pgv[NR];
#pragma unroll
        for (int u = 0; u < NR; ++u) {
            int grp = 0; float mg = gl[u][0];
#pragma unroll
            for (int g = 1; g < 4; ++g) if (gl[u][g] > mg) { mg = gl[u][g]; grp = g; }
            float sg = 0.f;
#pragma unroll
            for (int g = 0; g < 4; ++g) sg += __builtin_amdgcn_exp2f((gl[u][g] - mg) * LOG2E);
            grpv[u] = grp; pgv[u] = __builtin_amdgcn_rcpf(sg);
        }
        float selv[NR][4];
#pragma unroll
        for (int u = 0; u < NR; ++u) {
            const LAS unsigned char* eb = wbase + (4 + 4 * grpv[u]) * 4096;
#pragma unroll
            for (int i = 0; i < 4; ++i) {
                const f32x4 w0 = RT_W4(eb, 4096 * i), w1 = RT_W4(eb, 4096 * i + 1024), w2 = RT_W4(eb, 4096 * i + 2048), w3 = RT_W4(eb, 4096 * i + 3072);
                selv[u][i] = RT_DOT(u, w0, w1, w2, w3);
            }
        }
#pragma unroll
        for (int u = 0; u < NR; ++u) { reduce4(selv[u][0], selv[u][1], selv[u][2], selv[u][3]);
#pragma unroll
            for (int i = 0; i < 4; ++i) selv[u][i] += bias[4 + 4 * grpv[u] + i]; }
#undef RT_DOT
#pragma unroll
        for (int u = 0; u < NR; ++u) {
            const int grp = grpv[u]; const float pg = pgv[u];
            float sel[4];
#pragma unroll
            for (int i = 0; i < 4; ++i) sel[i] = selv[u][i];
            int i1 = 0; float v1 = sel[0];
#pragma unroll
            for (int i = 1; i < 4; ++i) if (sel[i] > v1) { v1 = sel[i]; i1 = i; }
            int i2 = -1; float v2 = -3.0e38f;
#pragma unroll
            for (int i = 0; i < 4; ++i) if (i != i1 && (i2 < 0 || sel[i] > v2)) { v2 = sel[i]; i2 = i; }
            const float ee = __builtin_amdgcn_exp2f((v2 - v1) * LOG2E), rq = __builtin_amdgcn_rcpf(1.0f + ee), w1 = pg * rq, w2 = pg * ee * rq;
            const int e1 = grp * 4 + i1, e2 = grp * 4 + i2;
            if (F.lane == 0 && act[u]) {
                const unsigned k1 = __hip_atomic_fetch_add((LAS unsigned*)&F.MISC[MI_LH + e1], 1u, __ATOMIC_RELAXED, __HIP_MEMORY_SCOPE_WORKGROUP);
                const unsigned k2 = __hip_atomic_fetch_add((LAS unsigned*)&F.MISC[MI_LH + e2], 1u, __ATOMIC_RELAXED, __HIP_MEMORY_SCOPE_WORKGROUP);
                v4u ra; ra.x = (unsigned)e1; ra.y = (unsigned)e2; ra.z = k1; ra.w = k2;
                v4u rb; rb.x = __builtin_bit_cast(unsigned, w1); rb.y = __builtin_bit_cast(unsigned, w2); rb.z = 0u; rb.w = 0u;
                *(v4u*)(RT + (size_t)rr[u] * 8) = ra; *(v4u*)(RT + (size_t)rr[u] * 8 + 4) = rb;
            }
        }
    }
#undef RT_ISSUE
#undef RT_W4
    __syncthreads();
    if (F.tid < 16) HIST[F.bid * 16 + F.tid] = (int)F.MISC[MI_LH + F.tid];
}
__device__ __forceinline__ void moe_tables(const Frame& F) {
    const int* HIST = (const int*)(F.ws + WS_HIST); LAS int* hl = (LAS int*)F.lds;
    __syncthreads();
    for (int i = F.tid; i < F.G * 16; i += NTHR) hl[i] = HIST[i];
    __syncthreads();
    if (F.tid < 16) { int tot = 0, mine = 0; for (int g = 0; g < F.G; ++g) { const int c = hl[g * 16 + F.tid]; tot += c; mine += (g < F.bid) ? c : 0; }
        F.MISC[MI_TOT + F.tid] = (unsigned)tot; F.MISC[MI_BASE + F.tid] = (unsigned)mine; }
    __syncthreads();
    if (F.tid == 0) { unsigned p = 0; for (int e = 0; e < 16; ++e) { F.MISC[MI_PST + e] = p; F.MISC[MI_BASE + e] += p * 256u; p += (F.MISC[MI_TOT + e] + 255u) >> 8; } F.MISC[MI_PST + 16] = p; }
    __syncthreads();
}
__device__ __forceinline__ void phase_permute(const Frame& F, int l) {
    unsigned* RT = (unsigned*)(F.ws + WS_RT); int* SRC = (int*)(F.ws + WS_QD);
    moe_tables(F);
    const int rpw = rows_per_wave(F.ngw), rbeg = F.gw * rpw, rend = min(M, rbeg + rpw);
    for (int r = rbeg + F.lane; r < rend; r += 64) {
        if (l == NL - 1 && (r % TT) >= SEQ) continue;
        const v4u ra = *(const v4u*)(RT + (size_t)r * 8);
        const unsigned p0 = F.MISC[MI_BASE + (ra.x & 15u)] + ra.z, p1 = F.MISC[MI_BASE + (ra.y & 15u)] + ra.w;
        RT[(size_t)r * 8 + 6] = p0; RT[(size_t)r * 8 + 7] = p1; SRC[p0] = r; SRC[p1] = r;
    }
    if (F.bid == 0) {
        for (int e = 0; e < 16; ++e) { const int beg = (int)F.MISC[MI_PST + e] * 256 + (int)F.MISC[MI_TOT + e], end = (int)F.MISC[MI_PST + e + 1] * 256;
            for (int p = beg + F.tid; p < end; p += NTHR) SRC[p] = 0; }
    }
}

struct EpiMla {
    static constexpr bool PERM = true, AFTER_DRAIN = false;
    bf16* QD; bf16* KD; bf16* VD;
    __device__ __forceinline__ void operator()(const pg8::f32x4 (&acc)[2][2][4][2], const pg8::Unit& u, int wr, int wc, int fr, int fq) const {
#pragma unroll
        for (int bj = 0; bj < 2; ++bj) {
            const int g0 = u.pn * 256 + bj * 128 + wc * 32, col0 = g0 + 8 * fq;
            if (g0 >= 896) continue;
            const int c = col0 - 384, hd = c >> 7, jx = c & 127;
            bf16* dst = g0 < 384 ? QD + col0 : jx < 64 ? KD + hd * 96 + jx : VD + hd * 64 + (jx - 64);
            const int stride = (g0 < 384 || jx < 64) ? 384 : 256;
            dst += (size_t)(u.pm * 256 + wr * 64 + fr) * stride;
#pragma unroll
            for (int ai = 0; ai < 2; ++ai)
#pragma unroll
                for (int m = 0; m < 4; ++m) {
                    v4u o; o.x = pk2(acc[ai][bj][m][0][0], acc[ai][bj][m][0][1]); o.y = pk2(acc[ai][bj][m][0][2], acc[ai][bj][m][0][3]);
                    o.z = pk2(acc[ai][bj][m][1][0], acc[ai][bj][m][1][1]); o.w = pk2(acc[ai][bj][m][1][2], acc[ai][bj][m][1][3]);
                    *(v4u*)(dst + (size_t)(ai * 128 + m * 16) * stride) = o;
                }
        }
    }
};
struct EpiGU {
    static constexpr bool PERM = true, AFTER_DRAIN = false;
    bf16* ACT;
    __device__ __forceinline__ void operator()(const pg8::f32x4 (&acc)[2][2][4][2], const pg8::Unit& u, int wr, int wc, int fr, int fq) const {
#pragma unroll
        for (int ai = 0; ai < 2; ++ai)
#pragma unroll
            for (int m = 0; m < 4; ++m) {
                const int row = u.pm * 256 + ai * 128 + wr * 64 + m * 16 + fr;
#pragma unroll
                for (int bj = 0; bj < 2; ++bj) {
                    const int c = (u.pn & 3) * 256 + bj * 128 + wc * 32 + 8 * fq;
                    float o[4];
#pragma unroll
                    for (int i = 0; i < 4; ++i) { const float g = acc[ai][bj][m][0][i], up = acc[ai][bj][m][1][i]; o[i] = g * __builtin_amdgcn_rcpf(1.0f + __expf(-g)) * up; }
                    v2u w; w.x = pk2(o[0], o[1]); w.y = pk2(o[2], o[3]);
                    *(v2u*)(ACT + (size_t)row * 512 + (c >> 1)) = w;
                }
            }
    }
};
struct MoeOrder {
    volatile LAS unsigned* pst; int G, c;
    __device__ __forceinline__ bool next(int i, pg8::Unit& u) const {
        const int np = (int)pst[16]; int panel, pn;
        if ((G & 7) == 0) { const int x = c & 7, uu = i * (G >> 3) + (c >> 3); panel = (uu >> 2) * 8 + x; pn = uu & 3; }
        else { const int L = i * G + c; panel = L >> 2; pn = L & 3; }
        if (panel >= np) return false;
        int e = 0;
#pragma unroll
        for (int k = 1; k < 16; ++k) e += (panel >= (int)pst[k]) ? 1 : 0;
        u.pm = __builtin_amdgcn_readfirstlane(panel); u.pn = __builtin_amdgcn_readfirstlane(e * 4 + pn); return true;
    }
    __device__ __forceinline__ void a_ready(const pg8::Unit&) const {}
    __device__ __forceinline__ void done(const pg8::Unit&) const {}
};

struct LatOrder {
    int G, c;
    __device__ __forceinline__ bool next(int i, pg8::Unit& u) const {
        int pl, pn;
        if ((G & 7) == 0) { const int x = c & 7, uu = i * (G >> 3) + (c >> 3); pl = (uu >> 2) * 8 + x; pn = uu & 3; } else { const int L = i * G + c; pl = L >> 2; pn = L & 3; }
        if (pl >= NB * 16) return false;
        u.pm = pl + (pl >> 4); u.pn = pn; return true;
    }
    __device__ __forceinline__ void a_ready(const pg8::Unit&) const {}
    __device__ __forceinline__ void done(const pg8::Unit&) const {}
};

#ifndef DBG_VAR
#define DBG_VAR 1
#endif
namespace att {
constexpr int VRS = 192, KBUF = 64 * 208, VBUF = 64 * VRS, BUF = KBUF + VBUF, BIAS_OFF = 4 * BUF;
constexpr float NEG = -30000.0f;
__device__ __forceinline__ int crow(int r, int hi) { return (r & 3) + 8 * (r >> 2) + 4 * hi; }
__device__ __forceinline__ float xhalf_max(float v) { const unsigned a = __builtin_bit_cast(unsigned, v);
    auto rr = __builtin_amdgcn_permlane32_swap(a, a, false, false); const unsigned r0 = rr[0], r1 = rr[1]; return fmaxf(__uint_as_float(r0), __uint_as_float(r1)); }
__device__ __forceinline__ float xhalf_sum(float v) { const unsigned a = __builtin_bit_cast(unsigned, v);
    auto rr = __builtin_amdgcn_permlane32_swap(a, a, false, false); const unsigned r0 = rr[0], r1 = rr[1]; return __uint_as_float(r0) + __uint_as_float(r1); }
__device__ __forceinline__ float max3f(float a, float b, float c) { float r; asm("v_max3_f32 %0, %1, %2, %3" : "=v"(r) : "v"(a), "v"(b), "v"(c)); return r; }
typedef __bf16 bf16x2_t __attribute__((ext_vector_type(2)));
__device__ __forceinline__ unsigned cvtpk(float lo, float hi) { f32x2 v = {lo, hi}; bf16x2_t b = __builtin_convertvector(v, bf16x2_t); return __builtin_bit_cast(unsigned, b); }

template <int DK, int VM = 0>
__device__ __forceinline__ void unit(LAS unsigned char* lds, const bf16* Qp, int qpitch, const bf16* Kp, int kpitch, const bf16* Vp, int vpitch, bf16* Op,
                                     int var, int qt, int lo, int n1, int nt, float qscale, float sinkl2, bool has_sink, const LAS float* bias, const float* t32, unsigned* dbg) {
    constexpr int KRS = DK * 2 + 16, NS = DK / 16, CPK = DK / 8;
    int tid = threadIdx.x; asm volatile("" : "+v"(tid)); const int lane = tid & 63, r32 = lane & 31, hi = lane >> 5, wid = __builtin_amdgcn_readfirstlane(tid >> 6);
    const int qrow = 256 * qt + 32 * wid + r32;
    bf16x8 qr[NS];
#pragma unroll
    for (int s = 0; s < NS; ++s) { const v4u raw = *(const v4u*)(Qp + (size_t)qrow * qpitch + 16 * s + 8 * hi); float f[8]; unpack8(raw, f);
#pragma unroll
        for (int i = 0; i < 8; ++i) f[i] *= qscale;
        if (DK == 96 && s >= 4) {
            float p[8];
#pragma unroll
            for (int i = 0; i < 8; ++i) p[i] = __shfl_xor(f[i], 32);
            if (qt < 16) rope8(f, p, t32 + ((size_t)((s == 4 ? (qrow >> 6) : (qrow & 63)) * 8)) * 2, hi == 0);
        }
        qr[s] = __builtin_bit_cast(bf16x8, pack8(f)); }
    const int kkey0 = tid / CPK, kch0 = tid - kkey0 * CPK, kkey1 = (tid + 512) / CPK, kch1 = (tid + 512) - kkey1 * CPK;
    const int vkey = tid >> 3, vch = tid & 7;
    v4u kreg0, kreg1 = {0u, 0u, 0u, 0u}, vreg;
#define ATT_TROW(j) ((((j) < n1) ? (lo + (j)) : (64 + (j) - n1)) * 64)
#define ATT_LOAD(j) do { const int tr_ = ATT_TROW(j); kreg0 = *(const v4u*)(Kp + (size_t)(tr_ + kkey0) * kpitch + kch0 * 8); \
        if (DK == 96 && tid < 256) kreg1 = *(const v4u*)(Kp + (size_t)(tr_ + kkey1) * kpitch + kch1 * 8); \
        vreg = *(const v4u*)(Vp + (size_t)(tr_ + vkey) * vpitch + vch * 8); } while (0)
#define ATT_STORE(bf) do { LAS unsigned char* b_ = lds + (bf) * BUF; *(LAS v4u*)(b_ + kkey0 * KRS + kch0 * 16) = kreg0; \
        if (DK == 96 && tid < 256) *(LAS v4u*)(b_ + kkey1 * KRS + kch1 * 16) = kreg1; \
        *(LAS v4u*)(b_ + KBUF + vkey * VRS + vch * 16) = vreg; } while (0)
    constexpr float THR = 6.0f;
    float m = 0.f; f32x2 lacc = {0.f, 0.f}; f32x16 o0 = {}, o1 = {}; f32x16 negm = {}; bool first = true;
    const int grw = 4 * qt + (wid >> 1), r0w = min(max(grw - 4, 0), 56), gc = (wid & 1) * 32 + r32, c0 = min(max(gc - 8, 0), 48), i0w = 256 * qt + 32 * wid;
    ATT_LOAD(0); ATT_STORE(0);
    __syncthreads();
    for (int j = 0; j < nt; ++j) {
        if (!(VM & 8) && j + 1 < nt) ATT_LOAD(j + 1);
        const int kt = ATT_TROW(j) >> 6;
        bool actv = true;
        if (kt < 64) { if (var == 0) actv = (kt >= r0w) && (kt <= r0w + 7); else if (var == 2) actv = !((64 * kt - (i0w + 31) > 128) || (i0w - (64 * kt + 63) > 128)); }
        if (actv) {
            const LAS unsigned char* Kb = lds + (j & 1) * BUF; const LAS unsigned char* Vb = Kb + KBUF;
            f32x16 s0 = negm, s1 = negm;
            bf16x8 ka[NS], kb[NS];
#pragma unroll
            for (int s = 0; s < NS; ++s) { ka[s] = *(const LAS bf16x8*)(Kb + r32 * KRS + (16 * s + 8 * hi) * 2); kb[s] = *(const LAS bf16x8*)(Kb + (32 + r32) * KRS + (16 * s + 8 * hi) * 2); }
            __builtin_amdgcn_sched_barrier(0);
            if (VM & 2) {
#pragma unroll
                for (int s = 0; s < NS; ++s) asm volatile("" :: "v"(ka[s]), "v"(kb[s]), "v"(qr[s]));
            } else {
#pragma unroll
            for (int s = 0; s < NS; ++s) { s0 = __builtin_amdgcn_mfma_f32_32x32x16_bf16(ka[s], qr[s], s0, 0, 0, 0); s1 = __builtin_amdgcn_mfma_f32_32x32x16_bf16(kb[s], qr[s], s1, 0, 0, 0); }
            }
            asm volatile("s_nop 15\n\ts_nop 7" : "+v"(s0), "+v"(s1));
            if (kt < 64 && var == 0) {
                const int rowoff = (kt - grw + 7) * 31 - gc + 15;
#pragma unroll
                for (int r = 0; r < 16; ++r) { const int j0 = crow(r, hi), j1 = j0 + 32;
                    const bool v0 = (unsigned)(j0 - c0) < 16u, v1 = (unsigned)(j1 - c0) < 16u;
                    const float b0 = bias[v0 ? rowoff + j0 : 0], b1 = bias[v1 ? rowoff + j1 : 0];
                    s0[r] = v0 ? s0[r] + b0 : NEG; s1[r] = v1 ? s1[r] + b1 : NEG; }
            } else if (kt < 64 && var == 2) {
                const int dbase = 64 * kt - qrow + 128;
#pragma unroll
                for (int r = 0; r < 16; ++r) { const int j0 = crow(r, hi);
                    s0[r] = (unsigned)(dbase + j0) <= 256u ? s0[r] : NEG; s1[r] = (unsigned)(dbase + j0 + 32) <= 256u ? s1[r] : NEG; }
            }
            if (!(VM & 4)) {
            float mxa = max3f(s0[0], s0[1], s1[0]), mxb = max3f(s0[2], s0[3], s1[1]); mxa = max3f(mxa, s1[2], s1[3]);
#pragma unroll
            for (int r = 4; r < 16; r += 4) { mxa = max3f(mxa, s0[r], s0[r + 1]); mxb = max3f(mxb, s0[r + 2], s0[r + 3]); mxa = max3f(mxa, s1[r], s1[r + 1]); mxb = max3f(mxb, s1[r + 2], s1[r + 3]); }
            const float mx = xhalf_max(fmaxf(mxa, mxb));
            if (first || __any(mx > THR)) {
                const float d = first ? fmaxf(mx, -64.0f) : fmaxf(mx, 0.f), alpha = __builtin_amdgcn_exp2f(-d);
                m += d; first = false;
#pragma unroll
                for (int r = 0; r < 16; ++r) { s0[r] -= d; s1[r] -= d; o0[r] *= alpha; o1[r] *= alpha; negm[r] = -m; }
                lacc *= alpha;
            }
#pragma unroll
            for (int r = 0; r < 16; ++r) { s0[r] = __builtin_amdgcn_exp2f(s0[r]); s1[r] = __builtin_amdgcn_exp2f(s1[r]); lacc += (f32x2){s0[r], s1[r]}; }
            }
            bf16x8 pb[4];
#pragma unroll
            for (int s = 0; s < 2; ++s) {
                v4u w; w.x = cvtpk(s0[8 * s], s0[8 * s + 1]); w.y = cvtpk(s0[8 * s + 2], s0[8 * s + 3]); w.z = cvtpk(s0[8 * s + 4], s0[8 * s + 5]); w.w = cvtpk(s0[8 * s + 6], s0[8 * s + 7]);
                pb[s] = __builtin_bit_cast(bf16x8, w);
                v4u x; x.x = cvtpk(s1[8 * s], s1[8 * s + 1]); x.y = cvtpk(s1[8 * s + 2], s1[8 * s + 3]); x.z = cvtpk(s1[8 * s + 4], s1[8 * s + 5]); x.w = cvtpk(s1[8 * s + 6], s1[8 * s + 7]);
                pb[2 + s] = __builtin_bit_cast(bf16x8, x);
            }
            if (VM & 1) { asm volatile("" :: "v"(pb[0]), "v"(pb[1]), "v"(pb[2]), "v"(pb[3])); } else {
            const LAS unsigned char* vbase = Vb + (4 * hi + ((lane & 15) >> 2)) * VRS + ((lane >> 4) & 1) * 32 + (lane & 3) * 8;
#pragma unroll
            for (int s = 0; s < 4; ++s) {
                const v4i16 a0 = __builtin_amdgcn_ds_read_tr16_b64_v4i16((LAS v4i16*)(vbase + (16 * s) * VRS));
                const v4i16 a1 = __builtin_amdgcn_ds_read_tr16_b64_v4i16((LAS v4i16*)(vbase + (16 * s + 8) * VRS));
                const v4i16 c0_ = __builtin_amdgcn_ds_read_tr16_b64_v4i16((LAS v4i16*)(vbase + (16 * s) * VRS + 64));
                const v4i16 c1_ = __builtin_amdgcn_ds_read_tr16_b64_v4i16((LAS v4i16*)(vbase + (16 * s + 8) * VRS + 64));
                const bf16x8 va = {a0[0], a0[1], a0[2], a0[3], a1[0], a1[1], a1[2], a1[3]};
                const bf16x8 vc = {c0_[0], c0_[1], c0_[2], c0_[3], c1_[0], c1_[1], c1_[2], c1_[3]};
                o0 = __builtin_amdgcn_mfma_f32_32x32x16_bf16(va, pb[s], o0, 0, 0, 0);
                o1 = __builtin_amdgcn_mfma_f32_32x32x16_bf16(vc, pb[s], o1, 0, 0, 0);
            }
            }
        }
        if (!(VM & 8) && j + 1 < nt) ATT_STORE((j + 1) & 1);
        if (!(VM & 16)) __syncthreads();
    }
    float l = xhalf_sum(lacc.x + lacc.y);
    const float sterm = has_sink ? __builtin_amdgcn_exp2f(sinkl2 - m) : 0.f;
#if MK_DEBUG
    if (dbg && hi == 0) { dbg[(size_t)qrow * 2] = __builtin_bit_cast(unsigned, m); dbg[(size_t)qrow * 2 + 1] = __builtin_bit_cast(unsigned, l); }
#endif
    if (has_sink) l += sterm;
    const float inv = 1.0f / l;
    bf16* orow = Op + (size_t)qrow * D;
#pragma unroll
    for (int g = 0; g < 4; ++g) {
        v2u w0; w0.x = pk2(o0[4 * g] * inv, o0[4 * g + 1] * inv); w0.y = pk2(o0[4 * g + 2] * inv, o0[4 * g + 3] * inv);
        v2u w1; w1.x = pk2(o1[4 * g] * inv, o1[4 * g + 1] * inv); w1.y = pk2(o1[4 * g + 2] * inv, o1[4 * g + 3] * inv);
        *(v2u*)(orow + 8 * g + 4 * hi) = w0; *(v2u*)(orow + 32 + 8 * g + 4 * hi) = w1;
    }
#undef ATT_TROW
#undef ATT_LOAD
#undef ATT_STORE
}

template <int DK, int MODE, int VM = 0, bool NOREF = false>
__device__ __forceinline__ void unit2(LAS unsigned char* lds, const bf16* Qp, int qpitch, const bf16* Kp, int kpitch, const bf16* Vp, int vpitch, bf16* Op,
                                      int var, int qt, int lo, int n1, int nt, float qscale, float sink0, float sink1, bool has_sink, const LAS float* bias, const float* t32) {
    constexpr int KRS = DK * 2 + 16, NS = DK / 16, CPK = DK / 8;
    int tid = threadIdx.x; asm volatile("" : "+v"(tid)); const int lane = tid & 63, r32 = lane & 31, hi = lane >> 5, wid = __builtin_amdgcn_readfirstlane(tid >> 6);
    const int rowbase = MODE == 0 ? 512 * qt + 64 * wid : 256 * qt + 32 * wid;
    bf16x8 qr[2][NS];
#pragma unroll
    for (int u = 0; u < 2; ++u) {
        const int qrow = rowbase + (MODE == 0 ? 32 * u : 0) + r32;
        const bf16* qp = Qp + (MODE == 1 ? 64 * u : 0) + (size_t)qrow * qpitch;
#pragma unroll
        for (int s = 0; s < NS; ++s) { const v4u raw = *(const v4u*)(qp + 16 * s + 8 * hi); float f[8]; unpack8(raw, f);
#pragma unroll
            for (int i = 0; i < 8; ++i) f[i] *= qscale;
            if (DK == 96 && s >= 4) { float p[8];
#pragma unroll
                for (int i = 0; i < 8; ++i) p[i] = __shfl_xor(f[i], 32);
                rope8(f, p, t32 + ((size_t)((s == 4 ? (qrow >> 6) : (qrow & 63)) * 8)) * 2, hi == 0); }
            qr[u][s] = __builtin_bit_cast(bf16x8, pack8(f)); }
    }
    const int kkey0 = tid / CPK, kch0 = tid - kkey0 * CPK, kkey1 = (tid + 512) / CPK, kch1 = (tid + 512) - kkey1 * CPK;
    const int vkey = tid >> 3, vch = tid & 7;
    v4u kreg0, kreg1 = {0u, 0u, 0u, 0u}, vreg;
#define ATT_TROW(j) ((((j) < n1) ? (lo + (j)) : (64 + (j) - n1)) * 64)
#define ATT_LOAD(j) do { const int tr_ = ATT_TROW(j); kreg0 = *(const v4u*)(Kp + (size_t)(tr_ + kkey0) * kpitch + kch0 * 8); \
        if (DK == 96 && tid < 256) kreg1 = *(const v4u*)(Kp + (size_t)(tr_ + kkey1) * kpitch + kch1 * 8); \
        vreg = *(const v4u*)(Vp + (size_t)(tr_ + vkey) * vpitch + vch * 8); } while (0)
#define ATT_STORE(bf) do { LAS unsigned char* b_ = lds + (bf) * BUF; *(LAS v4u*)(b_ + kkey0 * KRS + kch0 * 16) = kreg0; \
        if (DK == 96 && tid < 256) *(LAS v4u*)(b_ + kkey1 * KRS + kch1 * 16) = kreg1; \
        *(LAS v4u*)(b_ + KBUF + vkey * VRS + vch * 16) = vreg; } while (0)
    constexpr float THR = 6.0f;
    float m = 0.f; f32x2 lacc[2] = {{0.f, 0.f}, {0.f, 0.f}}; f32x16 o0[2] = {{}, {}}, o1[2] = {{}, {}}; bool first = true;
    const int grw = 8 * qt + wid, r0w = min(max(grw - 4, 0), 56), i0w = rowbase;
    ATT_LOAD(0); ATT_STORE(0);
    __syncthreads();
    for (int j = 0; j < nt; ++j) {
        if (!(VM & 8) && j + 1 < nt) ATT_LOAD(j + 1);
        const int kt = ATT_TROW(j) >> 6;
        bool actv = true;
        if (kt < 64) { if (var == 0) actv = (kt >= r0w) && (kt <= r0w + 7); else if (var == 2) actv = !((64 * kt - (i0w + 31) > 128) || (i0w - (64 * kt + 63) > 128)); }
        if (actv) {
            const LAS unsigned char* Kb = lds + (j & 1) * BUF; const LAS unsigned char* Vb = Kb + KBUF;
            f32x16 s0[2] = {{}, {}}, s1[2] = {{}, {}};
#pragma unroll
            for (int s = 0; s < NS; ++s) {
                const bf16x8 ka = *(const LAS bf16x8*)(Kb + r32 * KRS + (16 * s + 8 * hi) * 2);
                const bf16x8 kb = *(const LAS bf16x8*)(Kb + (32 + r32) * KRS + (16 * s + 8 * hi) * 2);
                if (VM & 2) { asm volatile("" :: "v"(ka), "v"(kb), "v"(qr[0][s]), "v"(qr[1][s])); } else {
#pragma unroll
                for (int u = 0; u < 2; ++u) { s0[u] = __builtin_amdgcn_mfma_f32_32x32x16_bf16(ka, qr[u][s], s0[u], 0, 0, 0); s1[u] = __builtin_amdgcn_mfma_f32_32x32x16_bf16(kb, qr[u][s], s1[u], 0, 0, 0); }
                }
            }
            asm volatile("s_nop 15\n\ts_nop 7" : "+v"(s0[0]), "+v"(s1[0]), "+v"(s0[1]), "+v"(s1[1]));
            if (kt < 64 && var == 0) {
#pragma unroll
                for (int u = 0; u < 2; ++u) { const int gc = 32 * u + r32, c0 = min(max(gc - 8, 0), 48), rowoff = (kt - grw + 7) * 31 - gc + 15;
#pragma unroll
                    for (int r = 0; r < 16; ++r) { const int j0 = crow(r, hi), j1 = j0 + 32;
                        const bool v0 = (unsigned)(j0 - c0) < 16u, v1 = (unsigned)(j1 - c0) < 16u;
                        const float b0 = bias[v0 ? rowoff + j0 : 0], b1 = bias[v1 ? rowoff + j1 : 0];
                        s0[u][r] = v0 ? s0[u][r] + b0 : NEG; s1[u][r] = v1 ? s1[u][r] + b1 : NEG; } }
            } else if (kt < 64 && var == 2) {
                const int dbase = 64 * kt - (rowbase + r32) + 128;
#pragma unroll
                for (int r = 0; r < 16; ++r) { const int j0 = crow(r, hi); const bool v0 = (unsigned)(dbase + j0) <= 256u, v1 = (unsigned)(dbase + j0 + 32) <= 256u;
                    s0[0][r] = v0 ? s0[0][r] : NEG; s1[0][r] = v1 ? s1[0][r] : NEG; s0[1][r] = v0 ? s0[1][r] : NEG; s1[1][r] = v1 ? s1[1][r] : NEG; }
            }
            if (!(VM & 4)) {
            if (!NOREF) {
            float mxa = max3f(s0[0][0], s0[0][1], s1[0][0]), mxb = max3f(s0[1][0], s0[1][1], s1[1][0]);
#pragma unroll
            for (int r = 0; r < 16; r += 2) { if (r) { mxa = max3f(mxa, s0[0][r], s0[0][r + 1]); mxb = max3f(mxb, s0[1][r], s0[1][r + 1]); }
                if (r) { mxa = max3f(mxa, s1[0][r], s1[0][r + 1]); mxb = max3f(mxb, s1[1][r], s1[1][r + 1]); } else { mxa = fmaxf(mxa, s1[0][1]); mxb = fmaxf(mxb, s1[1][1]); } }
            const float mx = xhalf_max(fmaxf(mxa, mxb)) - m;
            if (first || __any(mx > THR)) {
                const float d = first ? fmaxf(mx, -64.0f) : fmaxf(mx, 0.f), alpha = __builtin_amdgcn_exp2f(-d);
                m += d; first = false;
#pragma unroll
                for (int u = 0; u < 2; ++u) {
#pragma unroll
                    for (int r = 0; r < 16; ++r) { o0[u][r] *= alpha; o1[u][r] *= alpha; }
                    lacc[u] *= alpha; }
            }
            }
            }
            bf16x8 pb[2][4];
#pragma unroll
            for (int u = 0; u < 2; ++u) {
                if (!(VM & 4))
#pragma unroll
                for (int r = 0; r < 16; ++r) { s0[u][r] = __builtin_amdgcn_exp2f(NOREF ? s0[u][r] : s0[u][r] - m); s1[u][r] = __builtin_amdgcn_exp2f(NOREF ? s1[u][r] : s1[u][r] - m); lacc[u] += (f32x2){s0[u][r], s1[u][r]}; }
#pragma unroll
                for (int s = 0; s < 2; ++s) {
                    v4u w; w.x = cvtpk(s0[u][8 * s], s0[u][8 * s + 1]); w.y = cvtpk(s0[u][8 * s + 2], s0[u][8 * s + 3]); w.z = cvtpk(s0[u][8 * s + 4], s0[u][8 * s + 5]); w.w = cvtpk(s0[u][8 * s + 6], s0[u][8 * s + 7]);
                    pb[u][s] = __builtin_bit_cast(bf16x8, w);
                    v4u x; x.x = cvtpk(s1[u][8 * s], s1[u][8 * s + 1]); x.y = cvtpk(s1[u][8 * s + 2], s1[u][8 * s + 3]); x.z = cvtpk(s1[u][8 * s + 4], s1[u][8 * s + 5]); x.w = cvtpk(s1[u][8 * s + 6], s1[u][8 * s + 7]);
                    pb[u][2 + s] = __builtin_bit_cast(bf16x8, x);
                }
            }
            if (VM & 1) { asm volatile("" :: "v"(pb[0][0]), "v"(pb[0][1]), "v"(pb[0][2]), "v"(pb[0][3]), "v"(pb[1][0]), "v"(pb[1][1]), "v"(pb[1][2]), "v"(pb[1][3])); } else {
            const LAS unsigned char* vbase = Vb + (4 * hi + ((lane & 15) >> 2)) * VRS + ((lane >> 4) & 1) * 32 + (lane & 3) * 8;
#pragma unroll
            for (int s = 0; s < 4; ++s) {
                const v4i16 a0 = __builtin_amdgcn_ds_read_tr16_b64_v4i16((LAS v4i16*)(vbase + (16 * s) * VRS));
                const v4i16 a1 = __builtin_amdgcn_ds_read_tr16_b64_v4i16((LAS v4i16*)(vbase + (16 * s + 8) * VRS));
                const v4i16 c0_ = __builtin_amdgcn_ds_read_tr16_b64_v4i16((LAS v4i16*)(vbase + (16 * s) * VRS + 64));
                const v4i16 c1_ = __builtin_amdgcn_ds_read_tr16_b64_v4i16((LAS v4i16*)(vbase + (16 * s + 8) * VRS + 64));
                const bf16x8 va = {a0[0], a0[1], a0[2], a0[3], a1[0], a1[1], a1[2], a1[3]};
                const bf16x8 vc = {c0_[0], c0_[1], c0_[2], c0_[3], c1_[0], c1_[1], c1_[2], c1_[3]};
#pragma unroll
                for (int u = 0; u < 2; ++u) { o0[u] = __builtin_amdgcn_mfma_f32_32x32x16_bf16(va, pb[u][s], o0[u], 0, 0, 0); o1[u] = __builtin_amdgcn_mfma_f32_32x32x16_bf16(vc, pb[u][s], o1[u], 0, 0, 0); }
            }
            }
        }
        if (!(VM & 8) && j + 1 < nt) ATT_STORE((j + 1) & 1);
        if (!(VM & 16)) __syncthreads();
    }
#pragma unroll
    for (int u = 0; u < 2; ++u) {
        float l = xhalf_sum(lacc[u].x + lacc[u].y);
        if (has_sink) l += __builtin_amdgcn_exp2f((u == 0 ? sink0 : sink1) - m);
        const float inv = 1.0f / l;
        const int qrow = rowbase + (MODE == 0 ? 32 * u : 0) + r32;
        bf16* orow = Op + (MODE == 1 ? 64 * u : 0) + (size_t)qrow * D;
#pragma unroll
        for (int g = 0; g < 4; ++g) {
            v2u w0; w0.x = pk2(o0[u][4 * g] * inv, o0[u][4 * g + 1] * inv); w0.y = pk2(o0[u][4 * g + 2] * inv, o0[u][4 * g + 3] * inv);
            v2u w1; w1.x = pk2(o1[u][4 * g] * inv, o1[u][4 * g + 1] * inv); w1.y = pk2(o1[u][4 * g + 2] * inv, o1[u][4 * g + 3] * inv);
            *(v2u*)(orow + 8 * g + 4 * hi) = w0; *(v2u*)(orow + 32 + 8 * g + 4 * hi) = w1;
        }
    }
#undef ATT_TROW
#undef ATT_LOAD
#undef ATT_STORE
}

#define ATT_BAR() do { asm volatile("s_waitcnt lgkmcnt(0)" ::: "memory"); __builtin_amdgcn_s_barrier(); asm volatile("" ::: "memory"); } while (0)
template <int DK, int MODE, int VM = 0>
__device__ __forceinline__ bool unit_h(LAS unsigned char* lds, const bf16* Qp, int qpitch, const bf16* Kp, int kpitch, const bf16* Vp, int vpitch, bf16* Op,
                                       int var, int qt, int lo, int n1, int nt, float qscale, float sink0, float sink1, bool has_sink, const LAS float* bias, const float* t32, volatile LAS unsigned* flag) {
    constexpr int KRS = DK * 2 + 16, NS = DK / 16, CPK = DK / 8;
    int tid = threadIdx.x; asm volatile("" : "+v"(tid)); const int lane = tid & 63, r32 = lane & 31, hi = lane >> 5, wid = __builtin_amdgcn_readfirstlane(tid >> 6);
    const int rowbase = MODE == 0 ? 512 * qt + 64 * wid : 256 * qt + 32 * wid;
    const int kkey0 = tid / CPK, kch0 = tid - kkey0 * CPK, kkey1 = (tid + 512) / CPK, kch1 = (tid + 512) - kkey1 * CPK;
    const int vkey = tid >> 3, vch = tid & 7;
    v4u kreg0, kreg1 = {0u, 0u, 0u, 0u}, vreg;
#define ATT_TROW(j) ((((j) < n1) ? (lo + (j)) : (64 + (j) - n1)) * 64)
#define ATT_LOAD(j) do { const int tr_ = ATT_TROW(j); kreg0 = *(const v4u*)(Kp + (size_t)(tr_ + kkey0) * kpitch + kch0 * 8); \
        if (DK == 96 && tid < 256) kreg1 = *(const v4u*)(Kp + (size_t)(tr_ + kkey1) * kpitch + kch1 * 8); \
        vreg = *(const v4u*)(Vp + (size_t)(tr_ + vkey) * vpitch + vch * 8); } while (0)
#define ATT_STORE(bf) do { LAS unsigned char* b_ = lds + (bf) * BUF; *(LAS v4u*)(b_ + kkey0 * KRS + kch0 * 16) = kreg0; \
        if (DK == 96 && tid < 256) *(LAS v4u*)(b_ + kkey1 * KRS + kch1 * 16) = kreg1; \
        *(LAS v4u*)(b_ + KBUF + vkey * VRS + vch * 16) = vreg; } while (0)
    ATT_LOAD(0);
    bf16x8 qr[2][NS];
#pragma unroll
    for (int u = 0; u < 2; ++u) {
        const int qrow = rowbase + (MODE == 0 ? 32 * u : 0) + r32;
        const bf16* qp = Qp + (MODE == 1 ? 64 * u : 0) + (size_t)qrow * qpitch;
#pragma unroll
        for (int s = 0; s < NS; ++s) { const v4u raw = *(const v4u*)(qp + 16 * s + 8 * hi); float f[8]; unpack8(raw, f);
#pragma unroll
            for (int i = 0; i < 8; ++i) f[i] *= qscale;
            if (DK == 96 && s >= 4) { float p[8];
#pragma unroll
                for (int i = 0; i < 8; ++i) p[i] = __shfl_xor(f[i], 32);
                rope8(f, p, t32 + ((size_t)((s == 4 ? (qrow >> 6) : (qrow & 63)) * 8)) * 2, hi == 0); }
            qr[u][s] = __builtin_bit_cast(bf16x8, pack8(f)); }
    }
    f32x2 lacc[2] = {{0.f, 0.f}, {0.f, 0.f}}; f32x16 o0[2] = {{}, {}}, o1[2] = {{}, {}};
    const int grw = 8 * qt + wid, r0w = min(max(grw - 4, 0), 56), i0w = rowbase;
    ATT_STORE(0);
    if (tid == 0) *flag = 0u;
    ATT_BAR();
    for (int j = 0; j < nt; ++j) {
        if (!(VM & 8) && j + 1 < nt) ATT_LOAD(j + 1);
        const int kt = ATT_TROW(j) >> 6;
        bool actv = true;
        if (kt < 64) { if (var == 0) actv = (kt >= r0w) && (kt <= r0w + 7); else if (var == 2) actv = !((64 * kt - (i0w + 31) > 128) || (i0w - (64 * kt + 63) > 128)); }
        if (actv) {
        const LAS unsigned char* Kb = lds + (j & 1) * BUF; const LAS unsigned char* Vb = Kb + KBUF;
        const LAS unsigned char* vbase = Vb + (4 * hi + ((lane & 15) >> 2)) * VRS + ((lane >> 4) & 1) * 32 + (lane & 3) * 8;
#pragma unroll
        for (int hf = 0; hf < 2; ++hf) {
            f32x16 sc[2] = {{}, {}};
#pragma unroll
            for (int s = 0; s < NS; ++s) {
                const bf16x8 kf = *(const LAS bf16x8*)(Kb + (32 * hf + r32) * KRS + (16 * s + 8 * hi) * 2);
#pragma unroll
                for (int u = 0; u < 2; ++u) sc[u] = __builtin_amdgcn_mfma_f32_32x32x16_bf16(kf, qr[u][s], sc[u], 0, 0, 0);
            }
            if (kt < 64 && var == 0) {
#pragma unroll
                for (int u = 0; u < 2; ++u) { const int gc = 32 * u + r32, c0 = min(max(gc - 8, 0), 48), rowoff = (kt - grw + 7) * 31 - gc + 15;
                    const LAS unsigned char* bb = (const LAS unsigned char*)(bias + rowoff + 4 * hi); asm volatile("" : "+v"(bb));
                    float bv[16];
#pragma unroll
                    for (int r = 0; r < 16; ++r) bv[r] = *(const LAS float*)(bb + 4 * (32 * hf + (r & 3) + 8 * (r >> 2)));
                    asm volatile("" : "+v"(bv[0]), "+v"(bv[1]), "+v"(bv[2]), "+v"(bv[3]), "+v"(bv[4]), "+v"(bv[5]), "+v"(bv[6]), "+v"(bv[7]),
                                      "+v"(bv[8]), "+v"(bv[9]), "+v"(bv[10]), "+v"(bv[11]), "+v"(bv[12]), "+v"(bv[13]), "+v"(bv[14]), "+v"(bv[15]));
#pragma unroll
                    for (int r = 0; r < 16; ++r) { const int jj = 32 * hf + crow(r, hi); const bool v = (unsigned)(jj - c0) < 16u; sc[u][r] = v ? sc[u][r] + bv[r] : NEG; } }
            } else if (kt < 64 && var == 2) {
                const int dbase = 64 * kt - (rowbase + r32) + 128;
#pragma unroll
                for (int r = 0; r < 16; ++r) { const bool v = (unsigned)(dbase + 32 * hf + crow(r, hi)) <= 256u; sc[0][r] = v ? sc[0][r] : NEG; sc[1][r] = v ? sc[1][r] : NEG; }
            }
            bf16x8 pb[2][2];
#pragma unroll
            for (int u = 0; u < 2; ++u) {
#pragma unroll
                for (int r = 0; r < 16; r += 2) { sc[u][r] = __builtin_amdgcn_exp2f(sc[u][r]); sc[u][r + 1] = __builtin_amdgcn_exp2f(sc[u][r + 1]); lacc[u] += (f32x2){sc[u][r], sc[u][r + 1]}; }
#pragma unroll
                for (int s = 0; s < 2; ++s) {
                    v4u w; w.x = cvtpk(sc[u][8 * s], sc[u][8 * s + 1]); w.y = cvtpk(sc[u][8 * s + 2], sc[u][8 * s + 3]); w.z = cvtpk(sc[u][8 * s + 4], sc[u][8 * s + 5]); w.w = cvtpk(sc[u][8 * s + 6], sc[u][8 * s + 7]);
                    pb[u][s] = __builtin_bit_cast(bf16x8, w);
                }
            }
#pragma unroll
            for (int s2 = 0; s2 < 2; ++s2) { const int s = 2 * hf + s2;
                const v4i16 a0 = __builtin_amdgcn_ds_read_tr16_b64_v4i16((LAS v4i16*)(vbase + (16 * s) * VRS));
                const v4i16 a1 = __builtin_amdgcn_ds_read_tr16_b64_v4i16((LAS v4i16*)(vbase + (16 * s + 8) * VRS));
                const v4i16 c0_ = __builtin_amdgcn_ds_read_tr16_b64_v4i16((LAS v4i16*)(vbase + (16 * s) * VRS + 64));
                const v4i16 c1_ = __builtin_amdgcn_ds_read_tr16_b64_v4i16((LAS v4i16*)(vbase + (16 * s + 8) * VRS + 64));
                const bf16x8 va = {a0[0], a0[1], a0[2], a0[3], a1[0], a1[1], a1[2], a1[3]};
                const bf16x8 vc = {c0_[0], c0_[1], c0_[2], c0_[3], c1_[0], c1_[1], c1_[2], c1_[3]};
#pragma unroll
                for (int u = 0; u < 2; ++u) { o0[u] = __builtin_amdgcn_mfma_f32_32x32x16_bf16(va, pb[u][s2], o0[u], 0, 0, 0); o1[u] = __builtin_amdgcn_mfma_f32_32x32x16_bf16(vc, pb[u][s2], o1[u], 0, 0, 0); }
            }
            __builtin_amdgcn_sched_barrier(0);
        }
        }
        if (!(VM & 8) && j + 1 < nt) ATT_STORE((j + 1) & 1);
        ATT_BAR();
    }
    float lsum[2]; bool bad = false;
#pragma unroll
    for (int u = 0; u < 2; ++u) { lsum[u] = xhalf_sum(lacc[u].x + lacc[u].y); bad = bad || !(lsum[u] > 8.6736174e-19f && lsum[u] < 1.1529215e18f);
        if (has_sink) { lsum[u] += __builtin_amdgcn_exp2f(u == 0 ? sink0 : sink1); bad = bad || !(lsum[u] < 1.1529215e18f); } }
    if (__any(bad)) { if (lane == 0) *flag = 1u; }
#pragma unroll
    for (int u = 0; u < 2; ++u) {
        const float inv = __builtin_amdgcn_rcpf(lsum[u]);
        bf16* orow = Op + (MODE == 1 ? 64 * u : 0) + (size_t)(rowbase + (MODE == 0 ? 32 * u : 0) + r32) * D;
#pragma unroll
        for (int g = 0; g < 4; ++g) {
            v2u w0; w0.x = pk2(o0[u][4 * g] * inv, o0[u][4 * g + 1] * inv); w0.y = pk2(o0[u][4 * g + 2] * inv, o0[u][4 * g + 3] * inv);
            v2u w1; w1.x = pk2(o1[u][4 * g] * inv, o1[u][4 * g + 1] * inv); w1.y = pk2(o1[u][4 * g + 2] * inv, o1[u][4 * g + 3] * inv);
            *(v2u*)(orow + 8 * g + 4 * hi) = w0; *(v2u*)(orow + 32 + 8 * g + 4 * hi) = w1;
        }
    }
    ATT_BAR();
    return *flag == 0u;
#undef ATT_TROW
#undef ATT_LOAD
#undef ATT_STORE
}
}

template <int VM = 0>
__device__ __forceinline__ void phase_attn(const Frame& F, int lq) {
    const int l = lq & 3;
    const bf16* P = (const bf16*)(F.ws + WS_PB); const bf16* QD = (const bf16*)(F.ws + WS_QD); const bf16* KD = (const bf16*)(F.ws + WS_KD);
    const bf16* VD = (const bf16*)(F.ws + WS_VD); bf16* O = (bf16*)(F.ws + (lq >= 4 ? WS_ACT : WS_HA));
    unsigned* ctr = (unsigned*)(F.ws + WS_CTL) + CW_QUEUE + 64 * 8 * lq;
    LAS float* bias = (LAS float*)(F.lds + att::BIAS_OFF);
    { const float* nab = INP(I_NABIAS) + l * 4 * 465; for (int i = F.tid; i < 4 * 465; i += NTHR) bias[i] = nab[i] * LOG2E; }
    const float* sinks = INP(I_SINK) + l * 4;
    __syncthreads();
    const float* t32 = (const float*)(F.ws + WS_T32);
    volatile LAS unsigned* flag = F.MISC + MI_Q + 1;
    const int nloc = 256 + (l < NL - 1 ? 24 : 0);
    const int q0 = (int)xb_xcc_id();
    for (int qq = 0; qq < 8; ++qq) {
      const int q = (q0 + qq) & 7;
      unsigned* qctr = ctr + 64 * q;
      for (;;) {
        if (F.tid == 0) F.MISC[MI_Q] = __hip_atomic_fetch_add(qctr, 1u, __ATOMIC_RELAXED, __HIP_MEMORY_SCOPE_AGENT);
        ATT_BAR();
        const int li = (int)F.MISC[MI_Q];
        ATT_BAR();
        if (li >= nloc) break;
        int idx;
        if (li < 64) idx = (q + 8 * (li >> 3)) * 8 + (li & 7);
        else if (li < 128) { const int jx = li - 64; idx = 1024 + (q + 8 * (jx >> 4)) * 16 + (jx & 15); }
        else if (li < 192) { const int jx = li - 128; idx = 1536 + (q + 8 * (jx >> 3)) * 8 + (jx & 7); }
        else if (li < 256) { const int jx = li - 192; idx = 2048 + (q + 8 * (jx >> 4)) * 16 + (jx & 15); }
        else if (li < 264) idx = 2560 + q + 8 * (li - 256);
        else idx = 2624 + q + 8 * (li - 264);
        if (idx < 512) {
            const int b = idx >> 5, h = (idx >> 3) & 3, qt = idx & 7; const size_t rb = (size_t)b * TT;
            if (!att::unit_h<96, 0, VM>(F.lds, QD + rb * 384 + h * 96, 384, KD + rb * 384 + h * 96, 384, VD + rb * 256 + h * 64, 256, O + rb * D + 768 + h * 64, 3, qt, 0, 64, 68, 0.10206207261596575f * LOG2E, 0.f, 0.f, false, bias, t32, flag)) {
                __syncthreads();
#pragma unroll 1
                for (int k2 = 0; k2 < 2; ++k2)
                    att::unit<96, VM>(F.lds, QD + rb * 384 + h * 96, 384, KD + rb * 384 + h * 96, 384, VD + rb * 256 + h * 64, 256, O + rb * D + 768 + h * 64, 3, 2 * qt + k2, 0, 64, 68, 0.10206207261596575f * LOG2E, 0.f, false, bias, t32, nullptr);
            }
        } else if (idx < 1024) {
        } else if (idx < 2560) {
            idx -= 1024;
            const int grp = idx >> 9, rem = idx & 511, b = rem >> 5; const size_t rb = (size_t)b * TT;
            if (grp == 1) {
                const int h = (rem >> 3) & 3, qt = rem & 7; const int lo = min(max(8 * qt - 4, 0), 56), n1 = min(max(8 * qt + 3, 0), 56) + 7 - lo + 1;
                if (!att::unit_h<64, 0, VM>(F.lds, P + rb * NPJ + h * 64, NPJ, P + rb * NPJ + 256 + h * 64, NPJ, P + rb * NPJ + 512 + h * 64, NPJ, O + rb * D + h * 64, 0, qt, lo, n1, n1 + 4, 0.125f * LOG2E, 0.f, 0.f, false, bias + h * 465, t32, flag)) { __syncthreads();
                att::unit2<64, 0, VM>(F.lds, P + rb * NPJ + h * 64, NPJ, P + rb * NPJ + 256 + h * 64, NPJ, P + rb * NPJ + 512 + h * 64, NPJ, O + rb * D + h * 64, 0, qt, lo, n1, n1 + 4,
                                  0.125f * LOG2E, 0.f, 0.f, false, bias + h * 465, t32); }
            } else {
                const int g = (rem >> 4) & 1, qt = rem & 15; const bool isc = grp == 2;
                const int lo = isc ? max(4 * qt - 2, 0) : 0, n1 = isc ? min(4 * qt + 5, 63) - lo + 1 : 64;
                const int qc = (isc ? 1280 : 768) + g * 128, kc = (isc ? 1536 : 1024) + g * 64, vc = (isc ? 1664 : 1152) + g * 64;
                const float sk0 = isc ? sinks[2 * g] * LOG2E : 0.f, sk1 = isc ? sinks[2 * g + 1] * LOG2E : 0.f;
                if (!att::unit_h<64, 1, VM>(F.lds, P + rb * NPJ + qc, NPJ, P + rb * NPJ + kc, NPJ, P + rb * NPJ + vc, NPJ, O + rb * D + (isc ? 512 : 256) + g * 128, isc ? 2 : 1, qt, lo, n1, n1 + 4, 0.125f * LOG2E, sk0, sk1, isc, bias, t32, flag)) { __syncthreads();
                att::unit2<64, 1, VM>(F.lds, P + rb * NPJ + qc, NPJ, P + rb * NPJ + kc, NPJ, P + rb * NPJ + vc, NPJ, O + rb * D + (isc ? 512 : 256) + g * 128, isc ? 2 : 1, qt, lo, n1, n1 + 4,
                                  0.125f * LOG2E, isc ? sinks[2 * g] * LOG2E : 0.f, isc ? sinks[2 * g + 1] * LOG2E : 0.f, isc, bias, t32); }
            }
        } else if (idx < 2624) {
            const int rem = idx - 2560, b = rem >> 2, isc = (rem >> 1) & 1, g = rem & 1; const size_t rb = (size_t)b * TT;
            const int qc = (isc ? 1280 : 768) + g * 128, kc = (isc ? 1536 : 1024) + g * 64, vc = (isc ? 1664 : 1152) + g * 64;
            att::unit2<64, 1, VM>(F.lds, P + rb * NPJ + qc, NPJ, P + rb * NPJ + kc, NPJ, P + rb * NPJ + vc, NPJ, O + rb * D + (isc ? 512 : 256) + g * 128, isc ? 2 : 1, 16, 0, 0, 4,
                              0.125f * LOG2E, isc ? sinks[2 * g] * LOG2E : 0.f, isc ? sinks[2 * g + 1] * LOG2E : 0.f, isc != 0, bias, t32);
        } else {
            const int rem = idx - 2624, b = rem >> 3, isd = (rem >> 2) & 1, h = rem & 3; const size_t rb = (size_t)b * TT;
            if (isd) att::unit<96, VM>(F.lds, QD + rb * 384 + h * 96, 384, KD + rb * 384 + h * 96, 384, VD + rb * 256 + h * 64, 256, O + rb * D + 768 + h * 64, 3, 16, 0, 0, 4, 0.10206207261596575f * LOG2E, 0.f, false, bias, t32, nullptr);
            else att::unit<64, VM>(F.lds, P + rb * NPJ + h * 64, NPJ, P + rb * NPJ + 256 + h * 64, NPJ, P + rb * NPJ + 512 + h * 64, NPJ, O + rb * D + h * 64, 0, 16, 0, 0, 4, 0.125f * LOG2E, 0.f, false, bias + h * 465, nullptr, nullptr);
        }
    }
    }
}


#define PHASE_FN static __device__ __forceinline__ void
PHASE_FN ph_prologue(GAS unsigned char* ws) { const Frame F = make_frame(ws); phase_prologue(F); }
PHASE_FN ph_ln(GAS unsigned char* ws, int l) { const Frame F = make_frame(ws); phase_ln(F, l); }
PHASE_FN ph_gemm_in(GAS unsigned char* ws, int l) {
    const Frame F = make_frame(ws);
    pg8::Gemm g{(const bf16*)(F.ws + WS_HA), (const bf16*)(F.ws + WS_WIN), M, NPJ, D, D, nullptr}; pg8::StaticOrder S; S.init(M, NPJ, F.G, F.bid);
    pg8::EpiBf16NT<0> E{(bf16*)(F.ws + WS_PB), NPJ, nullptr, 0, 0, 1.f};
    pg8::gemm_phase<pg8::EpiBf16NT<0>, pg8::StaticOrder, true, true>(F.lds, g, S, E);
}
PHASE_FN ph_post(GAS unsigned char* ws, int l) { const Frame F = make_frame(ws); phase_post(F, l); }
PHASE_FN ph_gemm_mla(GAS unsigned char* ws, int l) {
    const Frame F = make_frame(ws);
    pg8::Gemm g{(const bf16*)(F.ws + WS_PB) + 1792, (const bf16*)(F.ws + WS_WD), M, 1024, 384, NPJ, nullptr}; pg8::StaticOrder S; S.init(M, 1024, F.G, F.bid);
    EpiMla E{(bf16*)(F.ws + WS_QD), (bf16*)(F.ws + WS_KD), (bf16*)(F.ws + WS_VD)};
    pg8::gemm_phase<EpiMla, pg8::StaticOrder, true, true>(F.lds, g, S, E);
}
template <int VM>
PHASE_FN ph_attn(GAS unsigned char* ws, int l) { const Frame F = make_frame(ws); phase_attn<VM>(F, l); }
PHASE_FN ph_gemm_out(GAS unsigned char* ws, int l) {
    const Frame F = make_frame(ws);
    pg8::Gemm g{(const bf16*)(F.ws + WS_HA), (const bf16*)(F.ws + WS_WOUT), M, D, D, D, nullptr};
    pg8::EpiBf16NT<0> E{(bf16*)(F.ws + WS_PB), D, nullptr, 0, 0, 1.f};
    if (l == NL - 1) { LatOrder S{F.G, F.bid}; pg8::gemm_phase<pg8::EpiBf16NT<0>, LatOrder, true, true>(F.lds, g, S, E); }
    else { pg8::StaticOrder S; S.init(M, D, F.G, F.bid); pg8::gemm_phase<pg8::EpiBf16NT<0>, pg8::StaticOrder, true, true>(F.lds, g, S, E); }
}
PHASE_FN ph_route(GAS unsigned char* ws, int l) { const Frame F = make_frame(ws); phase_route(F, l); }
PHASE_FN ph_permute(GAS unsigned char* ws, int l) { const Frame F = make_frame(ws); phase_permute(F, l); }
PHASE_FN ph_gemm_gu(GAS unsigned char* ws, int l) {
    const Frame F = make_frame(ws);
    moe_tables(F);
    pg8::Gemm g{(const bf16*)(F.ws + WS_HA), (const bf16*)(F.ws + WS_WGU), MS, 16384, D, D, (const int*)(F.ws + WS_QD)}; MoeOrder S{F.MISC + MI_PST, F.G, F.bid};
    EpiGU E{(bf16*)(F.ws + WS_ACT)};
    pg8::gemm_phase<EpiGU, MoeOrder, true, true, true>(F.lds, g, S, E);
}
PHASE_FN ph_gemm_dn(GAS unsigned char* ws, int l) {
    const Frame F = make_frame(ws);
    moe_tables(F);
    pg8::Gemm g{(const bf16*)(F.ws + WS_ACT), (const bf16*)(F.ws + WS_WDN), MS, 16384, 512, 512, nullptr}; MoeOrder S{F.MISC + MI_PST, F.G, F.bid};
    pg8::EpiBf16NT<0> E{(bf16*)(F.ws + WS_PB), D, nullptr, 1024, 0, 1.f};
    pg8::gemm_phase<pg8::EpiBf16NT<0>, MoeOrder, true, true>(F.lds, g, S, E);
}


#if MK_DEBUG
#ifndef DBG_MODE
#define DBG_MODE 0
#endif
__device__ __forceinline__ float oracle_attn(const Frame& F, int l, int r, int var, int h, int mode = 0) {
    const bf16* P = (const bf16*)(F.ws + WS_PB); const bf16* QD = (const bf16*)(F.ws + WS_QD); const bf16* KD = (const bf16*)(F.ws + WS_KD); const bf16* VD = (const bf16*)(F.ws + WS_VD);
    const bf16* O = (const bf16*)(F.ws + WS_HA); const float* t32 = (const float*)(F.ws + WS_T32);
    const int b = r / TT, t = r - b * TT; const bool lat = t < SEQ; const size_t rb = (size_t)b * TT;
    const int dk = var == 3 ? 96 : 64;
    const bf16* qp; const bf16* kp; const bf16* vp; int kpitch, vpitch;
    if (var == 3) { qp = QD + (size_t)r * 384 + h * 96; kp = KD + rb * 384 + h * 96; kpitch = 384; vp = VD + rb * 256 + h * 64; vpitch = 256; }
    else { const int qc = var == 0 ? h * 64 : var == 1 ? 768 + h * 64 : 1280 + h * 64, kc = var == 0 ? 256 + h * 64 : var == 1 ? 1024 + (h >> 1) * 64 : 1536 + (h >> 1) * 64,
           vc = var == 0 ? 512 + h * 64 : var == 1 ? 1152 + (h >> 1) * 64 : 1664 + (h >> 1) * 64;
           qp = P + (size_t)r * NPJ + qc; kp = P + rb * NPJ + kc; kpitch = NPJ; vp = P + rb * NPJ + vc; vpitch = NPJ; }
    LAS float* qs = (LAS float*)(F.lds + 65536) + F.wave * 128;
    for (int d = F.lane; d < dk; d += 64) qs[d] = __builtin_bit_cast(float, (unsigned)qp[d] << 16);
    asm volatile("s_waitcnt lgkmcnt(0)" ::: "memory");
    if (var == 3 && lat && F.lane < 32) {
        const int c = F.lane >> 3, e = F.lane & 7, gr = t >> 6, gc = t & 63; const float own = qs[64 + F.lane], par = qs[64 + (F.lane ^ 8)];
        const float cs = t32[((c < 2 ? gr : gc) * 8 + e) * 2], sn = t32[((c < 2 ? gr : gc) * 8 + e) * 2 + 1];
        const float nv = (c & 1) == 0 ? own * cs - par * sn : par * sn + own * cs;
        asm volatile("s_waitcnt lgkmcnt(0)" ::: "memory"); qs[64 + F.lane] = nv; }
    asm volatile("s_waitcnt lgkmcnt(0)" ::: "memory");
    const float scale = var == 3 ? 0.10206207261596575f : 0.125f;
    const int gr = t >> 6, gc = t & 63, r0 = min(max(gr - 4, 0), 56), c0 = min(max(gc - 8, 0), 48);
    float m = -3.0e38f, lsum = 0.f, acc[64];
#pragma unroll
    for (int d = 0; d < 64; ++d) acc[d] = 0.f;
    for (int j = F.lane; j < TT; j += 64) {
        bool ok = true; float bias = 0.f;
        if (!lat) ok = j >= SEQ;
        else if (j < SEQ) {
            if (var == 0) { const int kr = j >> 6, kc2 = j & 63; ok = kr >= r0 && kr <= r0 + 7 && kc2 >= c0 && kc2 <= c0 + 15;
                if (ok) bias = INP(I_NABIAS)[((l * 4 + h) * 15 + (kr - gr + 7)) * 31 + (kc2 - gc + 15)]; }
            else if (var == 2) ok = (j - t <= 128) && (t - j <= 128);
        }
        if (!ok) continue;
        float sc = 0.f; const bf16* kr_ = kp + (size_t)j * kpitch;
        for (int d = 0; d < dk; ++d) sc += qs[d] * __builtin_bit_cast(float, (unsigned)kr_[d] << 16);
        sc = sc * scale + bias;
        const float mn = fmaxf(m, sc), a = expf(m - mn), p = expf(sc - mn); m = mn; lsum = lsum * a + p;
        const bf16* vr = vp + (size_t)j * vpitch;
#pragma unroll
        for (int d = 0; d < 64; ++d) acc[d] = acc[d] * a + p * __builtin_bit_cast(float, (unsigned)vr[d] << 16);
    }
    float mg = m;
#pragma unroll
    for (int o = 1; o < 64; o <<= 1) mg = fmaxf(mg, __shfl_xor(mg, o));
    if (mode >= 1) {
        const unsigned* rec = (const unsigned*)(F.ws + WS_RS) + (size_t)r * 2; const float mk = __builtin_bit_cast(float, rec[0]), lk = __builtin_bit_cast(float, rec[1]);
        const float lref = wave_sum(lsum * expf(m - mg));
        const float lker = lk * exp2f(mk - mg * LOG2E);
        if (mode == 2) return fabsf(mk / LOG2E - mg);
        return fabsf(lker / lref - 1.0f);
    }
    const float f = expf(m - mg); lsum *= f; lsum = wave_sum(lsum);
    if (var == 2) lsum += expf(INP(I_SINK)[l * 4 + h] - mg);
    float err = 0.f, mag = 1.0e-6f;
    const bf16* orow = O + (size_t)r * D + var * 256 + h * 64;
#pragma unroll
    for (int d = 0; d < 64; ++d) { const float ref = wave_sum(acc[d] * f) / lsum; const float got = __builtin_bit_cast(float, (unsigned)orow[d] << 16);
        const float df = fabsf(got - ref); err = (df == df) ? fmaxf(err, df) : 1.0e30f; mag = fmaxf(mag, fabsf(ref)); }
    return err / mag;
}
__device__ __forceinline__ void phase_dump(const Frame& F, int code) {
    float* out = (float*)ptab_get(F, I_OUT);
    for (int r = F.gw; r < M; r += F.ngw) {
        const int b = r / TT, t = r - b * TT; if (t >= SEQ) continue;
        float v[16];
        if (code == 1) ld16bf((const bf16*)(F.ws + WS_HA) + (size_t)r * D, F.lane, v);
        else if (code == 2) ld16bf((const bf16*)(F.ws + WS_PB) + (size_t)r * NPJ, F.lane, v);
        else if (code == 3) ld16bf((const bf16*)(F.ws + WS_PB) + (size_t)r * NPJ + 1024, F.lane, v);
        else if (code == 4) ld16bf((const bf16*)(F.ws + WS_PB) + (size_t)r * NPJ + 1280, F.lane, v);
        else if (code == 5) ld16((const float*)(F.ws + WS_PB) + (size_t)r * D, F.lane, v);
        else if (code == 8) {
            const v4u w0 = *((const v4u*)((const bf16*)(F.ws + WS_HA) + (size_t)r * D) + F.lane), w1 = *((const v4u*)((const bf16*)(F.ws + WS_HA) + (size_t)r * D) + 64 + F.lane);
            float f[8]; int bad0 = 0, bad1 = 0; unpack8(w0, f);
#pragma unroll
            for (int i = 0; i < 8; ++i) { const unsigned u = __builtin_bit_cast(unsigned, f[i]); bad0 |= ((u & 0x7f800000u) == 0x7f800000u) ? 1 : 0; }
            unpack8(w1, f);
#pragma unroll
            for (int i = 0; i < 8; ++i) { const unsigned u = __builtin_bit_cast(unsigned, f[i]); bad1 |= ((u & 0x7f800000u) == 0x7f800000u) ? 1 : 0; }
            const unsigned long long m0 = __ballot(bad0), m1 = __ballot(bad1);
            const bool vA = (m0 & 0xffffffffull) != 0, vB = (m0 >> 32) != 0, vC = (m1 & 0xffffffffull) != 0, vD = (m1 >> 32) != 0;
            const float val = (float)(t + 1) * ((vA ? 1.0f : 0.f) + (vB ? 1.0e2f : 0.f) + (vC ? 1.0e4f : 0.f) + (vD ? 1.0e6f : 0.f));
#pragma unroll
            for (int i = 0; i < 16; ++i) v[i] = val;
        }
        else if (code == 9) { const unsigned cd = ((const unsigned*)(F.ws + WS_RS))[(size_t)r * 2]; float val = 0.f; if (cd) { val = 1.f; for (unsigned k = 0; k < cd; ++k) val *= 10.f; }
#pragma unroll
            for (int i = 0; i < 16; ++i) v[i] = val; }
        else if (code == 10) {
            const v4u w1 = *((const v4u*)((const bf16*)(F.ws + WS_HA) + (size_t)r * D) + 64 + F.lane);
            float f[8]; int bad1 = 0; unpack8(w1, f);
#pragma unroll
            for (int i = 0; i < 8; ++i) { const unsigned u = __builtin_bit_cast(unsigned, f[i]); bad1 |= ((u & 0x7f800000u) == 0x7f800000u) ? 1 : 0; }
            const bool vC = (__ballot(bad1) & 0xffffffffull) != 0;
            const bf16* pc = (const bf16*)(F.ws + WS_PB) + ((size_t)b * TT + SEQ + (t & 255)) * NPJ; int badp = 0;
            for (int c = F.lane; c < 288; c += 64) { const v4u w = *((const v4u*)pc + c); unpack8(w, f);
#pragma unroll
                for (int i = 0; i < 8; ++i) { const unsigned u = __builtin_bit_cast(unsigned, f[i]); badp |= ((u & 0x7f800000u) == 0x7f800000u) ? 1 : 0; } }
            float val = 0.f; if (vC) { val = 1.f; for (int k = 0; k <= (t & 15); ++k) val *= 10.f; }
            if (__any(badp)) val = 1.0e30f;
#pragma unroll
            for (int i = 0; i < 16; ++i) v[i] = val;
        }
        else if (code == 11) {
            const bf16* pr = (const bf16*)(F.ws + WS_PB) + (size_t)r * NPJ; int grp = -1;
            for (int c = F.lane; c < 288; c += 64) { const v4u w = *((const v4u*)pr + c); float f[8]; unpack8(w, f);
#pragma unroll
                for (int i = 0; i < 8; ++i) if (!(fabsf(f[i]) < 1.0e4f)) grp = (c * 8) >> 8; }
#pragma unroll
            for (int o = 1; o < 64; o <<= 1) { const int g2 = __shfl_xor(grp, o); grp = g2 > grp ? g2 : grp; }
            float val = 0.f; if (grp >= 0) { val = 100.f; for (int k = 0; k < grp; ++k) val *= 10.f; }
#pragma unroll
            for (int i = 0; i < 16; ++i) v[i] = val;
        }
        else if (code >= 20 && code < 24) {
            float val = 0.f;
            if ((t & 15) == 5) { for (int h = 0; h < 4; ++h) { const float e = oracle_attn(F, 0, r, code - 20, h); const float cls = e > 1.0e20f ? 3.f : e > 0.5f ? 2.f : e > 0.03f ? 1.f : 0.f; if (cls > 0.f) { float w = cls; for (int k = 0; k <= h; ++k) w *= 10.f; val = fmaxf(val, w); } } }
#pragma unroll
            for (int i = 0; i < 16; ++i) v[i] = val;
        }
        else if (code >= 30 && code < 46) {
            float val = 0.f;
            if ((t & 15) == 5) { const float e = oracle_attn(F, 0, r, (code - 30) >> 2, (code - 30) & 3, DBG_MODE); val = e > 10.f ? 1.0e4f : 1000.f * e; }
#pragma unroll
            for (int i = 0; i < 16; ++i) v[i] = val;
        }
        else if (code == 7) {
            auto bad16 = [&](const bf16* p, int nchunks) { int bad = 0; for (int c = F.lane; c < nchunks; c += 64) { const v4u w = *((const v4u*)p + c); float f[8]; unpack8(w, f);
#pragma unroll
                for (int i = 0; i < 8; ++i) { const unsigned u = __builtin_bit_cast(unsigned, f[i]); bad |= ((u & 0x7f800000u) == 0x7f800000u) ? 1 : 0; } } return __any(bad); };
            const int bP = bad16((const bf16*)(F.ws + WS_PB) + (size_t)r * NPJ, 288), bQ = bad16((const bf16*)(F.ws + WS_QD) + (size_t)r * 384, 48),
                      bK = bad16((const bf16*)(F.ws + WS_KD) + (size_t)r * 384, 48), bV = bad16((const bf16*)(F.ws + WS_VD) + (size_t)r * 256, 32), bO = bad16((const bf16*)(F.ws + WS_HA) + (size_t)r * D, 128);
            const float val = bP ? 1.0e6f : bQ ? 1.0e5f : bK ? 1.0e4f : bV ? 1.0e3f : bO ? 1.0e2f : 0.f;
#pragma unroll
            for (int i = 0; i < 16; ++i) v[i] = val;
        }
#pragma unroll
        for (int i = 0; i < 16; ++i) { const unsigned u = __builtin_bit_cast(unsigned, v[i]); if ((u & 0x7f800000u) == 0x7f800000u) v[i] = 777.0f; }
        st16(out + ((size_t)b * SEQ + t) * D, F.lane, v);
    }
}
static __device__ __forceinline__ void ph_dump(GAS unsigned char* ws, int code) { const Frame F = make_frame(ws); phase_dump(F, code); }
#endif
__global__ void __launch_bounds__(NTHR, 2) mk_fwd(Args args) {
    extern __shared__ __attribute__((aligned(16))) unsigned char lds_raw[];
    LAS unsigned char* lds = (LAS unsigned char*)lds_raw; volatile LAS unsigned* MISC = (volatile LAS unsigned*)(lds + MISC_OFF);
    const int tid = threadIdx.x;
    GAS unsigned char* ws = (GAS unsigned char*)args.ws;
    for (int u = tid; u < (LDS_BYTES - MISC_OFF) / 4; u += NTHR) MISC[u] = 0u;
    __syncthreads();
    if (tid < 28) { const unsigned long long p = tid < 27 ? (unsigned long long)args.in[tid] : (unsigned long long)args.out;
        LAS unsigned* t = (LAS unsigned*)(lds + PTAB_OFF) + 2 * tid; t[0] = (unsigned)p; t[1] = (unsigned)(p >> 32); }
    __syncthreads();
#if MK_MULTI
#define GRID_BAR() do { } while (0)
#else
    XcdBarrier bar = xcd_barrier_post((unsigned*)(ws + WS_CTL) + CW_BAR, MISC + MI_BAR);
#define GRID_BAR() xcd_barrier(bar)
#endif
    const int lo = args.ph_lo, hi = args.ph_hi;
#define IN(k) (lo <= (k) && (k) < hi)
#if MK_TIME
    unsigned long long tcat = 0ull, tb0 = 0ull;
#define TBEG() do { tb0 = __builtin_amdgcn_s_memrealtime(); } while (0)
#define TEND(c) do { if ((c) == MK_TIME - 1) tcat += __builtin_amdgcn_s_memrealtime() - tb0; } while (0)
#define SEAM(k) do { if (IN(k) && IN((k) + 1)) { TBEG(); GRID_BAR(); TEND(1); } } while (0)
#else
#define TBEG() do { } while (0)
#define TEND(c) do { } while (0)
#define SEAM(k) do { if (IN(k) && IN((k) + 1)) GRID_BAR(); } while (0)
#endif

#if MK_DEBUG
    if (lo >= 100) { ph_dump(ws, lo - 100); return; }
#endif
    if (IN(0)) { TBEG(); ph_prologue(ws); TEND(2); } SEAM(0);
    for (int l = 0; l < NL; ++l) {
        const int pb = 1 + 10 * l;
        if (IN(pb + 0)) { TBEG(); ph_ln(ws, l); TEND(0); } SEAM(pb + 0);
        if (IN(pb + 1)) { TBEG(); ph_gemm_in(ws, l); if (MK_DUP & 2) { GRID_BAR(); ph_gemm_in(ws, l); } TEND(3); } SEAM(pb + 1);
        if (IN(pb + 2)) { TBEG(); ph_post(ws, l); TEND(0); } SEAM(pb + 2);
        if (IN(pb + 3)) { TBEG(); ph_gemm_mla(ws, l); if (MK_DUP & 8) { GRID_BAR(); ph_gemm_mla(ws, l); } TEND(3); } SEAM(pb + 3);
        if (IN(pb + 4)) { TBEG(); ph_attn<0>(ws, l); if (MK_DUP & 16) { GRID_BAR(); ph_attn<MK_VM>(ws, l + 4); } TEND(4); } SEAM(pb + 4);
        if (IN(pb + 5)) { TBEG(); ph_gemm_out(ws, l); if (MK_DUP & 32) { GRID_BAR(); ph_gemm_out(ws, l); } TEND(3); } SEAM(pb + 5);
        if (IN(pb + 6)) { TBEG(); ph_route(ws, l); TEND(0); } SEAM(pb + 6);
        if (IN(pb + 7)) { TBEG(); ph_permute(ws, l); if (MK_DUP & 128) { GRID_BAR(); ph_permute(ws, l); } TEND(0); } SEAM(pb + 7);
        if (IN(pb + 8)) { TBEG(); ph_gemm_gu(ws, l); if (MK_DUP & 256) { GRID_BAR(); ph_gemm_gu(ws, l); } TEND(3); } SEAM(pb + 8);
        if (IN(pb + 9)) { TBEG(); ph_gemm_dn(ws, l); if (MK_DUP & 512) { GRID_BAR(); ph_gemm_dn(ws, l); } TEND(3); } SEAM(pb + 9);
    }
    if (IN(NPHASE - 1)) { TBEG(); ph_ln(ws, NL); TEND(0); }
#if MK_TIME
    if (blockIdx.x == 0) { const unsigned long long tw = __builtin_amdgcn_s_memrealtime(); const unsigned long long dl = tcat * (unsigned long long)MK_TMUL; while (__builtin_amdgcn_s_memrealtime() - tw < dl) __builtin_amdgcn_s_sleep(8); }
#endif
#undef IN
#undef SEAM
#undef GRID_BAR
}

extern "C" void kernel_launch(void* const* d_in, const int* in_sizes, int n_in, void* d_out, int out_size, void* d_ws, size_t ws_size, hipStream_t stream) {
    static int grid = 0;
    if (grid == 0) {
        if (n_in != 27 || out_size != NB * SEQ * D || ws_size < WS_END) { fprintf(stderr, "kernel_launch: unexpected problem (n_in %d, out %d, ws %zu < %zu)\n", n_in, out_size, ws_size, (size_t)WS_END); grid = -1; return; }
        int dev = 0, cus = 0, per_cu = 0;
        if (hipGetDevice(&dev) != hipSuccess || hipDeviceGetAttribute(&cus, hipDeviceAttributeMultiprocessorCount, dev) != hipSuccess) { grid = -1; return; }
        if (hipFuncSetAttribute((const void*)mk_fwd, hipFuncAttributeMaxDynamicSharedMemorySize, LDS_BYTES) != hipSuccess) { fprintf(stderr, "kernel_launch: hipFuncSetAttribute failed\n"); grid = -1; return; }
        if (hipOccupancyMaxActiveBlocksPerMultiprocessor(&per_cu, (const void*)mk_fwd, NTHR, LDS_BYTES) != hipSuccess || per_cu < 1) fprintf(stderr, "kernel_launch: occupancy query reports %d\n", per_cu);
        (void)hipGetLastError();
        grid = cus > 1024 ? 1024 : cus;
    }
    if (grid < 0) return;
    (void)hipMemsetAsync((char*)d_ws + WS_CTL, 0, CTL_BYTES, stream);
    Args a{};
    for (int i = 0; i < 27; ++i) a.in[i] = (const float*)d_in[i];
    a.out = (float*)d_out; a.ws = (unsigned char*)d_ws;
#if MK_MULTI
#ifndef DBG_NRUN
#define DBG_NRUN NPHASE
#endif
    for (int p = 0; p < DBG_NRUN; ++p) { a.ph_lo = p; a.ph_hi = p + 1; hipLaunchKernelGGL(mk_fwd, dim3(grid), dim3(NTHR), LDS_BYTES, stream, a); }
#ifdef DBG_DUMP
    a.ph_lo = 100 + DBG_DUMP; a.ph_hi = 101 + DBG_DUMP; hipLaunchKernelGGL(mk_fwd, dim3(grid), dim3(NTHR), LDS_BYTES, stream, a);
#endif
#else
    a.ph_lo = 0; a.ph_hi = NPHASE;
    hipLaunchKernelGGL(mk_fwd, dim3(grid), dim3(NTHR), LDS_BYTES, stream, a);
#endif
}
```

```cpp
#include <hip/hip_runtime.h>
#include <cstdio>
#include <cstdint>
namespace pg8 {
#define PG8_LAS __attribute__((address_space(3)))
typedef unsigned short bf16_t;
typedef short bf16x8 __attribute__((ext_vector_type(8)));
typedef float f32x4 __attribute__((ext_vector_type(4)));
typedef unsigned u32x4 __attribute__((ext_vector_type(4)));
constexpr int BM = 256, BK = 64, HALF = 128, HTB = HALF * BK * 2  , STAGE_BYTES = 8 * HTB, NXCD = 8, WGM = 8;

__host__ __device__ __forceinline__ int lds_byte(int r, int c) { const int st = (r >> 4) * 2 + (c >> 5), rr = r & 15, cc = c & 31, ob = rr * 64 + cc * 2; return st * 1024 + (ob ^ (((ob >> 9) & 1) << 5)); }
__host__ __device__ __forceinline__ void stage_rc(int b, int& R, int& C) { const int st = b / 1024, sb = b % 1024, swz = sb ^ (((sb >> 9) & 1) << 5); R = (st >> 1) * 16 + swz / 64; C = (st & 1) * 32 + (swz % 64) / 2; }
__host__ __device__ __forceinline__ int perm32(int rho) { const int n = rho >> 4, i = rho & 15; return 8 * (i >> 2) + 4 * n + (i & 3); }

struct Unit { int pm, pn; };
struct Gemm { const bf16_t* A; const bf16_t* Bt; int M, N, K, lda; const int* src; };

struct StaticOrder {
    int nM, nN, nwg, G, c;
    __host__ __device__ void init(int M, int N, int G_, int c_) { nM = M / BM; nN = N / BM; nwg = nM * nN; G = G_; c = c_; }
    __host__ __device__ bool next(int i, Unit& u) const {
        const long L = (long)i * G + c; if (L >= nwg) return false;
        int wgid = (int)L; { const int q = nwg / NXCD, r = nwg % NXCD, xcd = wgid % NXCD, off = wgid / NXCD; wgid = (xcd < r ? xcd * (q + 1) : r * (q + 1) + (xcd - r) * q) + off; }
        const int nig = WGM * nN, gid = wgid / nig, fm = gid * WGM, gsz = (nM - fm) < WGM ? (nM - fm) : WGM;
        u.pm = fm + ((wgid % nig) % gsz); u.pn = (wgid % nig) / gsz; return true;
    }
    __device__ __forceinline__ void a_ready(const Unit&) const {}
    __device__ __forceinline__ void done(const Unit&) const {}
};

__device__ __forceinline__ unsigned cvt_pk_bf16(float lo, float hi) { unsigned r; asm volatile("v_cvt_pk_bf16_f32 %0, %1, %2" : "=v"(r) : "v"(lo), "v"(hi)); return r; }
typedef float f32x2 __attribute__((ext_vector_type(2)));
__device__ __forceinline__ f32x2 gelu_pk(f32x2 v) {
    const f32x2 av = __builtin_elementwise_abs(v), d = av * 0.2316418882f + 1.0f;
    f32x2 t; t.x = __builtin_amdgcn_rcpf(d.x); t.y = __builtin_amdgcn_rcpf(d.y);
    f32x2 q = t * 0.5307027145f + (-0.7265760135f); q = q * t + 0.7107068705f; q = q * t + (-0.142248368f); q = q * t + 0.127414796f; q = q * t;
    const f32x2 s = (v * v) * (-0.72134752044f);
    f32x2 e; e.x = __builtin_amdgcn_exp2f(s.x); e.y = __builtin_amdgcn_exp2f(s.y);
    const f32x2 m = v * (q * e), r = v - m;
    f32x2 o; o.x = v.x < 0.f ? m.x : r.x; o.y = v.y < 0.f ? m.y : r.y; return o;
}

template <int ACT  > struct EpiBf16 {
    static constexpr bool PERM = true, AFTER_DRAIN = false; static_assert(ACT == 0 || ACT == 1, "EpiBf16: ACT is 0 (none) or 1 (gelu_pk)");
    bf16_t* O; int ldc; const float* bias; int split_cols; size_t split_stride; float scale0;
    __device__ __forceinline__ void operator()(const f32x4 (&acc)[2][2][4][2], const Unit& u, int wr, int wc, int fr, int fq) const {
        const int row0 = u.pm * BM + wr * 64 + fr; int colt = u.pn * BM; bf16_t* base = O;
        float sc = 1.f; if (split_cols) { const int t = colt / split_cols; base += (size_t)t * split_stride; colt -= t * split_cols; if (t == 0) sc = scale0; }
        const int col0 = colt + wc * 32 + 8 * fq, bcol0 = u.pn * BM + wc * 32 + 8 * fq;
        f32x4 bv[2][2];
#pragma unroll
        for (int bj = 0; bj < 2; ++bj)
#pragma unroll
            for (int n = 0; n < 2; ++n) bv[bj][n] = bias ? *(const f32x4*)(bias + bcol0 + bj * HALF + 4 * n) : (f32x4){0.f, 0.f, 0.f, 0.f};
#pragma unroll
        for (int ai = 0; ai < 2; ++ai)
#pragma unroll
            for (int m = 0; m < 4; ++m) { bf16_t* rowp = base + (size_t)(row0 + ai * HALF + m * 16) * ldc + col0;
#pragma unroll
                for (int bj = 0; bj < 2; ++bj) { f32x4 v0 = acc[ai][bj][m][0] + bv[bj][0], v1 = acc[ai][bj][m][1] + bv[bj][1];
                    if (ACT == 1) { f32x2 a = gelu_pk((f32x2){v0[0], v0[1]}), b = gelu_pk((f32x2){v0[2], v0[3]}), c = gelu_pk((f32x2){v1[0], v1[1]}), d = gelu_pk((f32x2){v1[2], v1[3]});
                        v0 = (f32x4){a.x, a.y, b.x, b.y}; v1 = (f32x4){c.x, c.y, d.x, d.y}; }
                    v0 = v0 * sc; v1 = v1 * sc; u32x4 w; w.x = cvt_pk_bf16(v0[0], v0[1]); w.y = cvt_pk_bf16(v0[2], v0[3]); w.z = cvt_pk_bf16(v1[0], v1[1]); w.w = cvt_pk_bf16(v1[2], v1[3]);
                    *(u32x4*)(rowp + bj * HALF) = w; } }
    }
};
template <int ACT  > struct EpiBf16NT {
    static constexpr bool PERM = true, AFTER_DRAIN = false; static_assert(ACT == 0 || ACT == 1, "EpiBf16: ACT is 0 (none) or 1 (gelu_pk)");
    bf16_t* O; int ldc; const float* bias; int split_cols; size_t split_stride; float scale0;
    __device__ __forceinline__ void operator()(const f32x4 (&acc)[2][2][4][2], const Unit& u, int wr, int wc, int fr, int fq) const {
        const int row0 = u.pm * BM + wr * 64 + fr; int colt = u.pn * BM; bf16_t* base = O;
        float sc = 1.f; if (split_cols) { const int t = colt / split_cols; base += (size_t)t * split_stride; colt -= t * split_cols; if (t == 0) sc = scale0; }
        const int col0 = colt + wc * 32 + 8 * fq, bcol0 = u.pn * BM + wc * 32 + 8 * fq;
        f32x4 bv[2][2];
#pragma unroll
        for (int bj = 0; bj < 2; ++bj)
#pragma unroll
            for (int n = 0; n < 2; ++n) bv[bj][n] = bias ? *(const f32x4*)(bias + bcol0 + bj * HALF + 4 * n) : (f32x4){0.f, 0.f, 0.f, 0.f};
#pragma unroll
        for (int ai = 0; ai < 2; ++ai)
#pragma unroll
            for (int m = 0; m < 4; ++m) { bf16_t* rowp = base + (size_t)(row0 + ai * HALF + m * 16) * ldc + col0;
#pragma unroll
                for (int bj = 0; bj < 2; ++bj) { f32x4 v0 = acc[ai][bj][m][0] + bv[bj][0], v1 = acc[ai][bj][m][1] + bv[bj][1];
                    if (ACT == 1) { f32x2 a = gelu_pk((f32x2){v0[0], v0[1]}), b = gelu_pk((f32x2){v0[2], v0[3]}), c = gelu_pk((f32x2){v1[0], v1[1]}), d = gelu_pk((f32x2){v1[2], v1[3]});
                        v0 = (f32x4){a.x, a.y, b.x, b.y}; v1 = (f32x4){c.x, c.y, d.x, d.y}; }
                    v0 = v0 * sc; v1 = v1 * sc; u32x4 w; w.x = cvt_pk_bf16(v0[0], v0[1]); w.y = cvt_pk_bf16(v0[2], v0[3]); w.z = cvt_pk_bf16(v1[0], v1[1]); w.w = cvt_pk_bf16(v1[2], v1[3]);
                    __builtin_nontemporal_store(w, (u32x4*)(rowp + bj * HALF)); } }
    }
};
struct EpiF32 {
    static constexpr bool PERM = false, AFTER_DRAIN = false;
    float* C; int ldc; const float* bias;
    __device__ __forceinline__ void operator()(const f32x4 (&acc)[2][2][4][2], const Unit& u, int wr, int wc, int fr, int fq) const {
        const int row0 = u.pm * BM + wr * 64 + fr, col0 = u.pn * BM + wc * 32 + 4 * fq;
        f32x4 bv[2][2];
#pragma unroll
        for (int bj = 0; bj < 2; ++bj)
#pragma unroll
            for (int n = 0; n < 2; ++n) bv[bj][n] = bias ? *(const f32x4*)(bias + col0 + bj * HALF + n * 16) : (f32x4){0.f, 0.f, 0.f, 0.f};
#pragma unroll
        for (int ai = 0; ai < 2; ++ai)
#pragma unroll
            for (int m = 0; m < 4; ++m) { float* rowp = C + (size_t)(row0 + ai * HALF + m * 16) * ldc + col0;
#pragma unroll
                for (int bj = 0; bj < 2; ++bj)
#pragma unroll
                    for (int n = 0; n < 2; ++n) *(f32x4*)(rowp + bj * HALF + n * 16) = acc[ai][bj][m][n] + bv[bj][n]; }
    }
};
template <class Epi, class Sched, bool ALIGN_EPI = false, bool SP2 = false, bool GATHER = false>
__device__ __forceinline__ void gemm_phase(PG8_LAS unsigned char* lds, const Gemm g, const Sched& S, const Epi& E) {
    int tid = threadIdx.x; asm volatile("" : "+v"(tid)); const int wid = __builtin_amdgcn_readfirstlane(tid >> 6), lane = tid & 63, wr = wid >> 2, wc = wid & 3, fr = lane & 15, fq = lane >> 4;
    const int K = g.K, nt = K / BK;
    unsigned voffA[2], voffB[2]; int RA[2]; unsigned CA2[2];
#pragma unroll
    for (int i = 0; i < 2; ++i) { int R, C; stage_rc(tid * 16 + i * 8192, R, C); const int Rb = Epi::PERM ? ((R & ~31) + perm32(R & 31)) : R;
        voffA[i] = (unsigned)(R * g.lda + C) * 2u; voffB[i] = (unsigned)(Rb * K + C) * 2u; RA[i] = R; CA2[i] = (unsigned)C * 2u; }
    unsigned gcur[2][2] = {{0u, 0u}, {0u, 0u}}, gnxt[2][2] = {{0u, 0u}, {0u, 0u}};
#define PG8_GOFF(dst, u_) do { _Pragma("unroll") for (int h_ = 0; h_ < 2; ++h_) _Pragma("unroll") for (int i_ = 0; i_ < 2; ++i_) \
        dst[h_][i_] = (unsigned)g.src[(u_).pm * BM + h_ * HALF + RA[i_]] * (unsigned)(g.lda * 2) + CA2[i_]; } while (0)
#define PG8_STAGE_A(bufoff, gbase, h, nx) do { if constexpr (GATHER) { unsigned vs_[2] = {(nx) ? gnxt[h][0] : gcur[h][0], (nx) ? gnxt[h][1] : gcur[h][1]}; PG8_STAGE(bufoff, gbase, vs_); } \
        else { PG8_STAGE(bufoff, (gbase) + ((h) ? hstepA : 0), voffA); } } while (0)
    const size_t kstep = (size_t)(BK * 2);
    const size_t hstepA = (size_t)HALF * g.lda * 2, hstepB = (size_t)HALF * K * 2;
    const size_t tstepA = 2 * hstepA, tstepB = 2 * hstepB;
    const unsigned ldsw = (unsigned)wid * 1024u;
    const int aoff = lds_byte(wr * 64 + fr, fq * 8), boff = lds_byte(wc * 32 + fr, fq * 8);
#define PG8_SA(b, h) (((b) * 2 + (h)) * HTB)
#define PG8_SB(b, h) ((4 + (b) * 2 + (h)) * HTB)
#define PG8_STAGE(bufoff, gbase, voff) do { _Pragma("unroll") for (int _i = 0; _i < 2; ++_i) \
        __builtin_amdgcn_global_load_lds((const unsigned*)((const char*)(gbase) + (voff)[_i]), (PG8_LAS unsigned*)(lds + (bufoff) + ldsw + _i * 8192), 16, 0, 0); } while (0)
#define PG8_LDA(dst, b, h) do { _Pragma("unroll") for (int m = 0; m < 4; ++m) _Pragma("unroll") for (int k = 0; k < 2; ++k) dst[m][k] = *(const PG8_LAS bf16x8*)(lds + PG8_SA(b, h) + aoff + m * 2048 + k * 1024); } while (0)
#define PG8_LDB(dst, b, h) do { _Pragma("unroll") for (int n = 0; n < 2; ++n) _Pragma("unroll") for (int k = 0; k < 2; ++k) dst[n][k] = *(const PG8_LAS bf16x8*)(lds + PG8_SB(b, h) + boff + n * 2048 + k * 1024); } while (0)
#define PG8_MMA(ai, bj, At, Bt) do { __builtin_amdgcn_s_setprio(1); _Pragma("unroll") for (int m = 0; m < 4; ++m) _Pragma("unroll") for (int n = 0; n < 2; ++n) _Pragma("unroll") for (int k = 0; k < 2; ++k) \
        acc[ai][bj][m][n] = __builtin_amdgcn_mfma_f32_16x16x32_bf16(Bt[n][k], At[m][k], acc[ai][bj][m][n], 0, 0, 0); __builtin_amdgcn_s_setprio(0); } while (0)
#define PG8_WAIT_V(n) asm volatile("s_waitcnt vmcnt(" #n ")" ::: "memory")
#define PG8_WAIT_L(n) asm volatile("s_waitcnt lgkmcnt(" #n ")" ::: "memory")
#define PG8_BAR __builtin_amdgcn_s_barrier()
#define PG8_SCHED __builtin_amdgcn_sched_barrier(0)
    Unit cur, nxt; int ui = 0;
    if (!S.next(0, cur)) return;
    f32x4 acc[2][2][4][2];
#pragma unroll
    for (int a = 0; a < 2; ++a)
#pragma unroll
        for (int b = 0; b < 2; ++b)
#pragma unroll
            for (int m = 0; m < 4; ++m)
#pragma unroll
                for (int n = 0; n < 2; ++n) acc[a][b][m][n] = (f32x4){0.f, 0.f, 0.f, 0.f};
    bf16x8 At[4][2], B0[2][2], B1[2][2];
    const char* cA = (const char*)g.A + (GATHER ? (size_t)0 : (size_t)cur.pm * tstepA); const char* cB = (const char*)g.Bt + (size_t)cur.pn * tstepB;
    if constexpr (GATHER) PG8_GOFF(gcur, cur);
    S.a_ready(cur);
    if constexpr (SP2) {
        PG8_STAGE(PG8_SB(0, 0), cB, voffB); PG8_STAGE(PG8_SB(0, 1), cB + hstepB, voffB); PG8_STAGE_A(PG8_SA(0, 0), cA, 0, false); PG8_STAGE_A(PG8_SA(0, 1), cA, 1, false);
        if (wr == 1) PG8_BAR;
        PG8_WAIT_V(2); PG8_BAR;
        PG8_STAGE(PG8_SB(1, 0), cB + kstep, voffB); PG8_STAGE_A(PG8_SA(1, 0), cA + kstep, 0, false); PG8_STAGE(PG8_SB(1, 1), cB + hstepB + kstep, voffB);
        PG8_WAIT_V(6); PG8_BAR;
    } else {
        PG8_STAGE(PG8_SB(0, 0), cB, voffB); PG8_STAGE_A(PG8_SA(0, 0), cA, 0, false); PG8_STAGE(PG8_SB(0, 1), cB + hstepB, voffB); PG8_STAGE_A(PG8_SA(0, 1), cA, 1, false);
        if (wr == 1) PG8_BAR;
        PG8_WAIT_V(4); PG8_BAR;
        PG8_STAGE(PG8_SB(1, 0), cB + kstep, voffB); PG8_STAGE_A(PG8_SA(1, 0), cA + kstep, 0, false); PG8_STAGE(PG8_SB(1, 1), cB + hstepB + kstep, voffB);
        PG8_WAIT_V(6); PG8_BAR;
    }
    for (;;) {
        const bool has_next = S.next(ui + 1, nxt);
        const char* nA = (has_next && !GATHER) ? (const char*)g.A + (size_t)nxt.pm * tstepA : cA; const char* nB = has_next ? (const char*)g.Bt + (size_t)nxt.pn * tstepB : cB;
        if constexpr (GATHER) { if (has_next) PG8_GOFF(gnxt, nxt); else { _Pragma("unroll") for (int h_ = 0; h_ < 2; ++h_) { gnxt[h_][0] = gcur[h_][0]; gnxt[h_][1] = gcur[h_][1]; } } }
#pragma unroll 1
        for (int t = 0; t < nt; t += 2) {
            const bool last = (t == nt - 2);
            const char* a1 = cA + (size_t)(t + 1) * kstep;
            const char* a2 = last ? nA : cA + (size_t)(t + 2) * kstep; const char* b2 = last ? nB : cB + (size_t)(t + 2) * kstep;
            const char* a3 = a2 + kstep; const char* b3 = b2 + kstep;
            if (last && has_next) S.a_ready(nxt);
            if constexpr (SP2) {
            PG8_LDB(B0, 0, 0); PG8_LDB(B1, 0, 1); PG8_SCHED; PG8_LDA(At, 0, 0); PG8_STAGE_A(PG8_SA(1, 1), a1, 1, false);
            PG8_WAIT_V(8); PG8_WAIT_L(0); PG8_BAR; PG8_MMA(0, 0, At, B0); PG8_MMA(0, 1, At, B1); PG8_BAR; PG8_SCHED;
            PG8_LDA(At, 0, 1); PG8_STAGE(PG8_SB(0, 0), b2, voffB); PG8_STAGE(PG8_SB(0, 1), b2 + hstepB, voffB); PG8_STAGE_A(PG8_SA(0, 0), a2, 0, last);
            PG8_WAIT_V(8); PG8_WAIT_L(0); PG8_BAR; PG8_MMA(1, 0, At, B0); PG8_MMA(1, 1, At, B1); PG8_BAR; PG8_SCHED;
            PG8_LDB(B0, 1, 0); PG8_LDB(B1, 1, 1); PG8_SCHED; PG8_LDA(At, 1, 0); PG8_STAGE_A(PG8_SA(0, 1), a2, 1, last);
            PG8_WAIT_V(8); PG8_WAIT_L(0); PG8_BAR; PG8_MMA(0, 0, At, B0); PG8_MMA(0, 1, At, B1); PG8_BAR; PG8_SCHED;
            PG8_LDA(At, 1, 1); PG8_STAGE(PG8_SB(1, 0), b3, voffB); PG8_STAGE(PG8_SB(1, 1), b3 + hstepB, voffB); PG8_STAGE_A(PG8_SA(1, 0), a3, 0, last);
            PG8_WAIT_V(8); PG8_WAIT_L(0); PG8_BAR; PG8_MMA(1, 0, At, B0); PG8_MMA(1, 1, At, B1); PG8_BAR; PG8_SCHED;
            } else {
            PG8_LDB(B0, 0, 0); PG8_SCHED; PG8_LDA(At, 0, 0); PG8_STAGE_A(PG8_SA(1, 1), a1, 1, false);
            PG8_WAIT_L(8); PG8_BAR; PG8_WAIT_L(0); PG8_MMA(0, 0, At, B0); PG8_BAR; PG8_SCHED;
            PG8_LDB(B1, 0, 1); PG8_STAGE(PG8_SB(0, 0), b2, voffB);
            PG8_BAR; PG8_WAIT_L(0); PG8_MMA(0, 1, At, B1); PG8_BAR;
            PG8_LDA(At, 0, 1); PG8_STAGE_A(PG8_SA(0, 0), a2, 0, last);
            PG8_BAR; PG8_WAIT_L(0); PG8_MMA(1, 0, At, B0); PG8_BAR; PG8_SCHED;
            PG8_STAGE(PG8_SB(0, 1), b2 + hstepB, voffB);
            PG8_WAIT_V(6); PG8_BAR; PG8_MMA(1, 1, At, B1); PG8_BAR;
            PG8_LDB(B0, 1, 0); PG8_SCHED; PG8_LDA(At, 1, 0); PG8_STAGE_A(PG8_SA(0, 1), a2, 1, last);
            PG8_WAIT_L(8); PG8_BAR; PG8_WAIT_L(0); PG8_MMA(0, 0, At, B0); PG8_BAR; PG8_SCHED;
            PG8_LDB(B1, 1, 1); PG8_STAGE(PG8_SB(1, 0), b3, voffB);
            PG8_BAR; PG8_WAIT_L(0); PG8_MMA(0, 1, At, B1); PG8_BAR;
            PG8_LDA(At, 1, 1); PG8_STAGE_A(PG8_SA(1, 0), a3, 0, last);
            PG8_BAR; PG8_WAIT_L(0); PG8_MMA(1, 0, At, B0); PG8_BAR; PG8_SCHED;
            PG8_STAGE(PG8_SB(1, 1), b3 + hstepB, voffB);
            PG8_WAIT_V(6); PG8_BAR; PG8_MMA(1, 1, At, B1); PG8_BAR;
            }
        }
        if constexpr (ALIGN_EPI) { if (wr == 0) PG8_BAR; }
        if constexpr (!Epi::AFTER_DRAIN) { E(acc, cur, wr, wc, fr, fq); S.done(cur); }
        if (!has_next) break;
#pragma unroll
        for (int a = 0; a < 2; ++a)
#pragma unroll
            for (int b = 0; b < 2; ++b)
#pragma unroll
                for (int m = 0; m < 4; ++m)
#pragma unroll
                    for (int n = 0; n < 2; ++n) acc[a][b][m][n] = (f32x4){0.f, 0.f, 0.f, 0.f};
        cur = nxt; cA = nA; cB = nB; ++ui;
        if constexpr (GATHER) { _Pragma("unroll") for (int h_ = 0; h_ < 2; ++h_) { gcur[h_][0] = gnxt[h_][0]; gcur[h_][1] = gnxt[h_][1]; } }
        if constexpr (ALIGN_EPI) { if (wr == 1) PG8_BAR; }
    }
    PG8_WAIT_V(0);
    if constexpr (!ALIGN_EPI) { if (wr == 0) PG8_BAR; }
    PG8_BAR;
    if constexpr (Epi::AFTER_DRAIN) { E.fused(acc, cur, wr, wc, fr, fq, lds, wid, lane); S.done(cur); }
#undef PG8_SA
#undef PG8_GOFF
#undef PG8_STAGE_A
#undef PG8_SB
#undef PG8_STAGE
#undef PG8_LDA
#undef PG8_LDB
#undef PG8_MMA
#undef PG8_WAIT_V
#undef PG8_WAIT_L
#undef PG8_BAR
#undef PG8_SCHED
}
}

constexpr int NB = 16, SEQ = 4096, CTX = 256, TT = SEQ + CTX, M = NB * TT, D = 1024, NL = 4;
constexpr int NPJ = 2304, DPROJ = 2208;
constexpr int MS = 143360;
constexpr float EPS = 1e-6f, ALPHA = 1.6817928305074290f, LOG2E = 1.4426950408889634f;
constexpr int NWAVES = 8, NTHR = 512;
#ifndef MK_DEBUG
#define MK_DEBUG 0
#endif
#ifndef MK_TIME
#define MK_TIME 0
#endif
#ifndef MK_TMUL
#define MK_TMUL 1
#endif
#ifndef MK_VM
#define MK_VM 0
#endif
#ifndef MK_DUP
#define MK_DUP 0
#endif
#ifndef MK_MULTI
#define MK_MULTI 0
#endif
constexpr int NPHASE = 2 + 10 * NL;

constexpr size_t WS_CTL = 0, CTL_BYTES = 65536;
constexpr size_t WS_MODS = WS_CTL + CTL_BYTES;
constexpr size_t WS_T64 = WS_MODS + (size_t)NL * 17 * 6144 * 4;
constexpr size_t WS_T32 = WS_T64 + 8192;
constexpr size_t WS_RS = WS_T32 + 4096;
constexpr size_t WS_RT = WS_RS + (size_t)M * 8;
constexpr size_t WS_HIST = WS_RT + (size_t)M * 32;
constexpr size_t WS_XS = WS_HIST + 65536;
constexpr size_t WS_WIN = WS_XS + (size_t)M * D * 2;
constexpr size_t WS_WD = WS_WIN + (size_t)NPJ * D * 2;
constexpr size_t WS_WOUT = WS_WD + (size_t)1024 * 384 * 2;
constexpr size_t WS_WGU = WS_WOUT + (size_t)D * D * 2;
constexpr size_t WS_WDN = WS_WGU + (size_t)16 * 1024 * 1024 * 2;
constexpr size_t WS_HA = WS_WDN + (size_t)16 * 1024 * 512 * 2;
constexpr size_t WS_PB = WS_HA + (size_t)M * D * 2;
constexpr size_t WS_QD = WS_PB + (size_t)M * NPJ * 2;
constexpr size_t WS_KD = WS_QD + (size_t)M * 384 * 2;
constexpr size_t WS_VD = WS_KD + (size_t)M * 384 * 2;
constexpr size_t WS_ACT = WS_VD + (size_t)M * 256 * 2;
constexpr size_t WS_END = WS_ACT + (size_t)MS * 512 * 2;
static_assert(WS_END <= (size_t)1073741824, "d_ws map must fit 1 GiB");
static_assert((size_t)M * NPJ * 2 >= (size_t)MS * D * 2 && (size_t)M * NPJ * 2 >= (size_t)M * D * 4, "region PB overlays");
constexpr int CW_BAR = 0;
constexpr int CW_QUEUE = 4096;

constexpr int RING_BYTES = 131072, MISC_OFF = RING_BYTES, LDS_BYTES = 147456;
constexpr int MI_BAR = 0, MI_Q = 4, MI_TOT = 16, MI_BASE = 32, MI_PST = 48, MI_LH = 80;

#define GAS __attribute__((address_space(1)))
#define LAS __attribute__((address_space(3)))
typedef unsigned short bf16;
typedef unsigned v4u __attribute__((ext_vector_type(4)));
typedef unsigned v2u __attribute__((ext_vector_type(2)));
typedef float f32x4 __attribute__((ext_vector_type(4)));
typedef float f32x2 __attribute__((ext_vector_type(2)));
typedef short bf16x8 __attribute__((ext_vector_type(8)));
typedef float f32x16 __attribute__((ext_vector_type(16)));
typedef short v4i16 __attribute__((ext_vector_type(4)));

__device__ __forceinline__ unsigned f2bf(float f) { unsigned u = __builtin_bit_cast(unsigned, f); return (u + 0x7fffu + ((u >> 16) & 1u)) >> 16; }
typedef __bf16 bf16x2_hw __attribute__((ext_vector_type(2)));
__device__ __forceinline__ unsigned pk2(float lo, float hi) { f32x2 v = {lo, hi}; const bf16x2_hw b = __builtin_convertvector(v, bf16x2_hw); return __builtin_bit_cast(unsigned, b); }
__device__ __forceinline__ float bflo(unsigned w) { return __builtin_bit_cast(float, w << 16); }
__device__ __forceinline__ float bfhi(unsigned w) { return __builtin_bit_cast(float, w & 0xffff0000u); }
__device__ __forceinline__ void unpack8(v4u w, float (&f)[8]) { f[0] = bflo(w.x); f[1] = bfhi(w.x); f[2] = bflo(w.y); f[3] = bfhi(w.y); f[4] = bflo(w.z); f[5] = bfhi(w.z); f[6] = bflo(w.w); f[7] = bfhi(w.w); }
__device__ __forceinline__ v4u pack8(const float (&f)[8]) { v4u w; w.x = pk2(f[0], f[1]); w.y = pk2(f[2], f[3]); w.z = pk2(f[4], f[5]); w.w = pk2(f[6], f[7]); return w; }
__device__ __forceinline__ float wave_sum(float v) {
    int x = __builtin_bit_cast(int, v);
#define WS_DPP(ctrl, rmask) v += __builtin_bit_cast(float, __builtin_amdgcn_update_dpp(0, x, ctrl, rmask, 0xf, true)); x = __builtin_bit_cast(int, v)
    WS_DPP(0xB1, 0xf);
    WS_DPP(0x4E, 0xf);
    WS_DPP(0x141, 0xf);
    WS_DPP(0x140, 0xf);
    WS_DPP(0x142, 0xa);
    WS_DPP(0x143, 0xc);
#undef WS_DPP
    return __builtin_bit_cast(float, __builtin_amdgcn_readlane(__builtin_bit_cast(int, v), 63));
}

#define XB_TMO      128
#define XB_XCNT(j)  (256  + 64 * (j))
#define XB_XSUB(j)  (1280 + 64 * (j))
#define XB_XGEN(j)  (2304 + 64 * (j))
#define XB_TOP      3328
#define XB_TOPGEN   3392
#define XCD_BAR_WORDS 3456
#define XB_SPIN_CAP (1u << 22)
__device__ __forceinline__ unsigned xb_ld(unsigned* p)              { return __hip_atomic_load(p, __ATOMIC_RELAXED, __HIP_MEMORY_SCOPE_AGENT); }
__device__ __forceinline__ unsigned xb_add(unsigned* p, unsigned v) { return __hip_atomic_fetch_add(p, v, __ATOMIC_RELAXED, __HIP_MEMORY_SCOPE_AGENT); }
__device__ __forceinline__ unsigned xb_xcc_id() { return (unsigned)__builtin_amdgcn_s_getreg((3 << 11) | 20) & 0xFu; }
#define XB_SPIN(cond, bar) do { unsigned _sp = 0; while (cond) { __builtin_amdgcn_s_sleep(1); \
    if ((++_sp & 255u) == 0u) { if (xb_ld(&(bar)[XB_TMO])) break; if (_sp > XB_SPIN_CAP) { atomicAdd(&(bar)[XB_TMO], 1u); break; } } } } while (0)
struct XcdBarrier { unsigned* bar; unsigned x; volatile LAS unsigned* st; };
__device__ __forceinline__ XcdBarrier xcd_barrier_post(unsigned* bar, volatile LAS unsigned* st) {
    XcdBarrier b; b.bar = bar; b.x = xb_xcc_id(); b.st = st;
    if (threadIdx.x == 0) (void)xb_add(&bar[XB_XCNT(b.x)], 1u);
    return b;
}
__device__ __forceinline__ void xcd_barrier_complete(unsigned* bar, unsigned x, unsigned& nloc, unsigned& nx) {
    const unsigned G = gridDim.x * gridDim.y * gridDim.z;
    unsigned sum, cnt, mine, sp = 0u;
    for (;;) {
        sum = 0u; cnt = 0u; mine = 0u;
#pragma unroll
        for (unsigned j = 0; j < 16; ++j) { const unsigned c = xb_ld(&bar[XB_XCNT(j)]); sum += c; cnt += (c > 0u) ? 1u : 0u; mine = (j == x) ? c : mine; }
        if (sum == G) break;
        __builtin_amdgcn_s_sleep(1);
        if ((++sp & 255u) == 0u) { if (xb_ld(&bar[XB_TMO])) break; if (sp > XB_SPIN_CAP) { atomicAdd(&bar[XB_TMO], 1u); break; } }
    }
    nloc = mine > 0u ? mine : 1u; nx = cnt > 0u ? cnt : 1u;
}
__device__ __forceinline__ void xcd_barrier(const XcdBarrier& b) {
    asm volatile("s_waitcnt vmcnt(0)" ::: "memory");
    __syncthreads();
    if (threadIdx.x == 0) {
        unsigned* bar = b.bar;
        __builtin_amdgcn_s_waitcnt(0);
        unsigned nloc = b.st[0], nx = b.st[1];
        if (nloc == 0u) { xcd_barrier_complete(bar, b.x, nloc, nx); b.st[0] = nloc; b.st[1] = nx; }
        const unsigned old = xb_add(&bar[XB_XSUB(b.x)], 1u);
        const unsigned gen = old / nloc;
        if (old + 1u == (gen + 1u) * nloc) {
            __builtin_amdgcn_fence(__ATOMIC_RELEASE, "agent");
            asm volatile("s_waitcnt vmcnt(0)" ::: "memory");
            const unsigned og = xb_add(&bar[XB_TOP], 1u);
            const unsigned tg = og / nx;
            if (og + 1u == (tg + 1u) * nx) xb_add(&bar[XB_TOPGEN], 1u);
            else XB_SPIN(xb_ld(&bar[XB_TOPGEN]) == tg, bar);
            __builtin_amdgcn_fence(__ATOMIC_ACQUIRE, "agent");
            xb_add(&bar[XB_XGEN(b.x)], 1u);
            asm volatile("s_waitcnt vmcnt(0)" ::: "memory");
        } else {
            XB_SPIN(xb_ld(&bar[XB_XGEN(b.x)]) == gen, bar);
            __builtin_amdgcn_fence(__ATOMIC_ACQUIRE, "agent");
            asm volatile("s_waitcnt vmcnt(0)" ::: "memory");
        }
    }
    __syncthreads();
}

struct Args { const float* in[27]; float* out; unsigned char* ws; int ph_lo, ph_hi; };
enum { I_X = 0, I_C, I_CTX, I_CCTX, I_WADA, I_BADA, I_WIN, I_NABIAS, I_GQG, I_GKG, I_SINK, I_MQG, I_WQB, I_MKVG, I_WKVB, I_WOUT, I_LN1G, I_LN1B, I_RGW, I_RGB, I_REW, I_REB, I_WG, I_WU, I_WDN, I_LN2G, I_LN2B };

struct Frame {
    LAS unsigned char* lds; volatile LAS unsigned* MISC;
    int tid, lane, wave, G, gw, ngw, bid;
    GAS unsigned char* ws;
};
__device__ __forceinline__ int opaque_tid() { int t = threadIdx.x; asm volatile("" : "+v"(t)); return t; }
__device__ __forceinline__ int opaque_s(int x) { asm volatile("" : "+s"(x)); return x; }
constexpr int PTAB_OFF = MISC_OFF + 2048, I_OUT = 27;
__device__ __forceinline__ GAS unsigned char* ptab_get(const Frame& F, int i) {
    const LAS unsigned* t = (const LAS unsigned*)(F.lds + PTAB_OFF) + 2 * i;
    const unsigned lo = __builtin_amdgcn_readfirstlane(t[0]), hi = __builtin_amdgcn_readfirstlane(t[1]);
    return (GAS unsigned char*)(((unsigned long long)hi << 32) | lo);
}
#define INP(i) ((const float*)ptab_get(F, (i)))
__device__ __forceinline__ Frame make_frame(GAS unsigned char* ws) {
    extern __shared__ __attribute__((aligned(16))) unsigned char lds_raw[];
    Frame F;
    F.lds = (LAS unsigned char*)lds_raw; F.MISC = (volatile LAS unsigned*)(F.lds + MISC_OFF);
    F.tid = opaque_tid(); F.lane = F.tid & 63; F.wave = __builtin_amdgcn_readfirstlane(F.tid >> 6);
    F.G = opaque_s((int)gridDim.x); F.bid = opaque_s((int)blockIdx.x); F.gw = F.bid * NWAVES + F.wave; F.ngw = F.G * NWAVES;
    { unsigned long long w = (unsigned long long)ws; asm volatile("" : "+s"(w)); F.ws = (GAS unsigned char*)w; }
    return F;
}
typedef _Float16 f16x4 __attribute__((ext_vector_type(4)));
struct RowPtrs { const float* x; const float* ctx; float* out; _Float16* xs; };
__device__ __forceinline__ RowPtrs row_ptrs(const Frame& F) { RowPtrs p; p.x = INP(I_X); p.ctx = INP(I_CTX); p.out = (float*)ptab_get(F, I_OUT); p.xs = (_Float16*)(F.ws + WS_XS); return p; }
__device__ __forceinline__ const float* xin_row(const RowPtrs& P, int r) {
    const int b = r / TT, t = r - b * TT;
    return t < SEQ ? P.x + ((size_t)b * SEQ + t) * D : P.ctx + ((size_t)b * CTX + (t - SEQ)) * D;
}
__device__ __forceinline__ float* out_row(const RowPtrs& P, int r) { const int b = r / TT, t = r - b * TT; return P.out + ((size_t)b * SEQ + t) * D; }
__device__ __forceinline__ void ld16h(const _Float16* p, int lane, float (&v)[16]) {
    const f16x4* q = (const f16x4*)p + lane;
#pragma unroll
    for (int g = 0; g < 4; ++g) { const f32x4 f = __builtin_convertvector(__builtin_nontemporal_load(q + 64 * g), f32x4); v[4 * g] = f.x; v[4 * g + 1] = f.y; v[4 * g + 2] = f.z; v[4 * g + 3] = f.w; }
}
__device__ __forceinline__ void st16h(_Float16* p, int lane, const float (&v)[16]) {
    f16x4* q = (f16x4*)p + lane;
#pragma unroll
    for (int g = 0; g < 4; ++g) __builtin_nontemporal_store(__builtin_convertvector((f32x4){v[4 * g], v[4 * g + 1], v[4 * g + 2], v[4 * g + 3]}, f16x4), q + 64 * g);
}
__device__ __forceinline__ void ld16(const float* p, int lane, float (&v)[16]) {
    const f32x4* q = (const f32x4*)p + lane;
    const f32x4 a = q[0], b = q[64], c = q[128], d = q[192];
    v[0] = a.x; v[1] = a.y; v[2] = a.z; v[3] = a.w; v[4] = b.x; v[5] = b.y; v[6] = b.z; v[7] = b.w;
    v[8] = c.x; v[9] = c.y; v[10] = c.z; v[11] = c.w; v[12] = d.x; v[13] = d.y; v[14] = d.z; v[15] = d.w;
}
__device__ __forceinline__ void st16(float* p, int lane, const float (&v)[16]) {
    f32x4* q = (f32x4*)p + lane;
    q[0] = (f32x4){v[0], v[1], v[2], v[3]}; q[64] = (f32x4){v[4], v[5], v[6], v[7]};
    q[128] = (f32x4){v[8], v[9], v[10], v[11]}; q[192] = (f32x4){v[12], v[13], v[14], v[15]};
}
__device__ __forceinline__ void ld16nt(const float* p, int lane, float (&v)[16]) {
    const f32x4* q = (const f32x4*)p + lane;
    const f32x4 a = __builtin_nontemporal_load(q), b = __builtin_nontemporal_load(q + 64), c = __builtin_nontemporal_load(q + 128), d = __builtin_nontemporal_load(q + 192);
    v[0] = a.x; v[1] = a.y; v[2] = a.z; v[3] = a.w; v[4] = b.x; v[5] = b.y; v[6] = b.z; v[7] = b.w;
    v[8] = c.x; v[9] = c.y; v[10] = c.z; v[11] = c.w; v[12] = d.x; v[13] = d.y; v[14] = d.z; v[15] = d.w;
}
__device__ __forceinline__ void st16nt(float* p, int lane, const float (&v)[16]) {
    f32x4* q = (f32x4*)p + lane;
    __builtin_nontemporal_store((f32x4){v[0], v[1], v[2], v[3]}, q); __builtin_nontemporal_store((f32x4){v[4], v[5], v[6], v[7]}, q + 64);
    __builtin_nontemporal_store((f32x4){v[8], v[9], v[10], v[11]}, q + 128); __builtin_nontemporal_store((f32x4){v[12], v[13], v[14], v[15]}, q + 192);
}
__device__ __forceinline__ void unpack16(const v2u (&w)[4], float (&v)[16]) {
#pragma unroll
    for (int g = 0; g < 4; ++g) { v[4 * g] = bflo(w[g].x); v[4 * g + 1] = bfhi(w[g].x); v[4 * g + 2] = bflo(w[g].y); v[4 * g + 3] = bfhi(w[g].y); }
}
__device__ __forceinline__ void ld16bf_raw(const bf16* p, int lane, v2u (&w)[4]) {
    const v2u* q = (const v2u*)p + lane; w[0] = q[0]; w[1] = q[64]; w[2] = q[128]; w[3] = q[192];
}
__device__ __forceinline__ void ld16bf_raw_nt(const bf16* p, int lane, v2u (&w)[4]) {
    const v2u* q = (const v2u*)p + lane; w[0] = __builtin_nontemporal_load(q); w[1] = __builtin_nontemporal_load(q + 64); w[2] = __builtin_nontemporal_load(q + 128); w[3] = __builtin_nontemporal_load(q + 192);
}
__device__ __forceinline__ void ld16bf(const bf16* p, int lane, float (&v)[16]) { v2u w[4]; ld16bf_raw(p, lane, w); unpack16(w, v); }
__device__ __forceinline__ void ld16bf_nt(const bf16* p, int lane, float (&v)[16]) { v2u w[4]; ld16bf_raw_nt(p, lane, w); unpack16(w, v); }
__device__ __forceinline__ void st16bf(bf16* p, int lane, const float (&v)[16]) {
    v2u* q = (v2u*)p + lane;
#pragma unroll
    for (int g = 0; g < 4; ++g) { v2u w; w.x = pk2(v[4 * g], v[4 * g + 1]); w.y = pk2(v[4 * g + 2], v[4 * g + 3]); q[64 * g] = w; }
}
__device__ __forceinline__ void ln16(float (&v)[16]) {
    float s = 0.f;
#pragma unroll
    for (int i = 0; i < 16; ++i) s += v[i];
    const float mean = wave_sum(s) * (1.0f / D); float q = 0.f;
#pragma unroll
    for (int i = 0; i < 16; ++i) { v[i] -= mean; q += v[i] * v[i]; }
    const float rstd = __builtin_amdgcn_rsqf(wave_sum(q) * (1.0f / D) + EPS);
#pragma unroll
    for (int i = 0; i < 16; ++i) v[i] *= rstd;
}

__device__ __forceinline__ int rows_per_wave(int ngw) {
    int rpw = (M + ngw - 1) / ngw;
    if (!((SEQ % rpw) % 4 == 0 && (TT % rpw) == 0 && (rpw % 2) == 0)) rpw = (rpw + 3) & ~3;
    return rpw;
}
template <int TYPE>
__device__ __forceinline__ float conv_src(const float* p0, const float* p1, const float* g0, const float* g1, int l, int k, int n) {
    if (TYPE == 0) return n < DPROJ ? p0[((size_t)l * D + k) * DPROJ + n] : 0.f;
    if (TYPE == 1) { if (n < 384) return k < 256 ? g0[l * 256 + k] * p0[((size_t)l * 256 + k) * 384 + n] : 0.f;
                     if (n < 896) return k >= 256 ? g1[l * 128 + (k - 256)] * p1[((size_t)l * 128 + (k - 256)) * 512 + (n - 384)] : 0.f;
                     return 0.f; }
    if (TYPE == 2) return p0[((size_t)l * D + k) * D + n];
    if (TYPE == 3) { const int e = n >> 10, nn = n & 1023, q = nn >> 3, j = nn & 7;
                     return j < 4 ? p0[(((size_t)l * 16 + e) * D + k) * 512 + 4 * q + j] : p1[(((size_t)l * 16 + e) * D + k) * 512 + 4 * q + (j - 4)]; }
    { const int e = n >> 10, nn = n & 1023; return p0[(((size_t)l * 16 + e) * 512 + k) * D + nn]; }
}
template <int TYPE>
__device__ __forceinline__ void conv_item(const Frame& F, int l, int item, LAS float* scr) {
    constexpr int Nd = TYPE == 0 ? NPJ : TYPE == 1 ? 1024 : TYPE == 2 ? 1024 : 16384, Kd = TYPE == 1 ? 384 : TYPE == 4 ? 512 : 1024;
    bf16* dst = (bf16*)(F.ws + (TYPE == 0 ? WS_WIN : TYPE == 1 ? WS_WD : TYPE == 2 ? WS_WOUT : TYPE == 3 ? WS_WGU : WS_WDN));
    const float* p0 = INP(TYPE == 0 ? I_WIN : TYPE == 1 ? I_WQB : TYPE == 2 ? I_WOUT : TYPE == 3 ? I_WG : I_WDN);
    const float* p1 = INP(TYPE == 1 ? I_WKVB : I_WU); const float* g0 = INP(I_MQG); const float* g1 = INP(I_MKVG);
    constexpr int nblk = Nd / 32; const int kb = item / nblk, nb = item - kb * nblk, k0 = 64 * kb, n0 = 32 * nb, lane = F.lane;
#pragma unroll
    for (int i = 0; i < 32; ++i) { const int kk = 2 * i + (lane >> 5); scr[kk * 33 + (lane & 31)] = conv_src<TYPE>(p0, p1, g0, g1, l, k0 + kk, n0 + (lane & 31)); }
    asm volatile("s_waitcnt lgkmcnt(0)" ::: "memory");
    const int c = lane & 7;
#pragma unroll
    for (int j = 0; j < 4; ++j) { const int n = (lane >> 3) + 8 * j; const LAS float* s = scr + (8 * c) * 33 + n;
        v4u o; o.x = pk2(s[0 * 33], s[1 * 33]); o.y = pk2(s[2 * 33], s[3 * 33]); o.z = pk2(s[4 * 33], s[5 * 33]); o.w = pk2(s[6 * 33], s[7 * 33]);
        *(v4u*)(dst + (size_t)(n0 + n) * Kd + k0 + 8 * c) = o; }
    asm volatile("s_waitcnt lgkmcnt(0)" ::: "memory");
}
__device__ __forceinline__ void phase_prologue(const Frame& F) {
    {
        LAS float* sv = (LAS float*)F.lds;
        LAS float* red = (LAS float*)(F.lds + 17 * 1024 * 4);
        float* mods = (float*)(F.ws + WS_MODS);
        for (int u = F.bid; u < NL * 48; u += F.G) {
            const int l = u / 48, cc = u - l * 48;
            const float* pc = INP(I_C); const float* pcc = INP(I_CCTX);
            for (int i = F.tid; i < 17 * 1024; i += NTHR) { const int mr = i >> 10, k = i & 1023; const float c = mr < 16 ? pc[mr * 1024 + k] : pcc[k]; sv[i] = c / (1.0f + expf(-c)); }
            __syncthreads();
            const int col = F.tid & 127, kg = F.tid >> 7;
            float acc[17];
#pragma unroll
            for (int mr = 0; mr < 17; ++mr) acc[mr] = 0.f;
            const float* w = INP(I_WADA) + ((size_t)l * 1024 + kg * 256) * 6144 + cc * 128 + col;
            for (int k4 = 0; k4 < 256; k4 += 4) {
                const float w0 = w[(size_t)(k4 + 0) * 6144], w1 = w[(size_t)(k4 + 1) * 6144], w2 = w[(size_t)(k4 + 2) * 6144], w3 = w[(size_t)(k4 + 3) * 6144];
#pragma unroll
                for (int mr = 0; mr < 17; ++mr) { const f32x4 s = *(const LAS f32x4*)(sv + mr * 1024 + kg * 256 + k4); acc[mr] += (s.x * w0 + s.y * w1) + (s.z * w2 + s.w * w3); }
            }
#pragma unroll
            for (int mr = 0; mr < 17; ++mr) red[(kg * 17 + mr) * 128 + col] = acc[mr];
            __syncthreads();
            const float* bada = INP(I_BADA);
            for (int i = F.tid; i < 17 * 128; i += NTHR) { const int mr = i >> 7, c = i & 127;
                const float s = (red[(0 * 17 + mr) * 128 + c] + red[(1 * 17 + mr) * 128 + c]) + (red[(2 * 17 + mr) * 128 + c] + red[(3 * 17 + mr) * 128 + c]);
                mods[((size_t)l * 17 + mr) * 6144 + cc * 128 + c] = s + bada[l * 6144 + cc * 128 + c]; }
            __syncthreads();
        }
    }
    {
        float* t64 = (float*)(F.ws + WS_T64); float* t32 = (float*)(F.ws + WS_T32);
        for (int i = F.bid * NTHR + F.tid; i < 64 * 16 + 64 * 8; i += F.G * NTHR) {
            if (i < 1024) { const int p = i >> 4, k = i & 15; const float fr = powf(10000.0f, -(float)k / 16.0f), ang = (float)p * fr; t64[2 * i] = cosf(ang); t64[2 * i + 1] = sinf(ang); }
            else { const int j = i - 1024, p = j >> 3, k = j & 7; const float fr = powf(10000.0f, -(float)k / 8.0f), ang = (float)p * fr; t32[2 * j] = cosf(ang); t32[2 * j + 1] = sinf(ang); }
        }
    }
}
__device__ __forceinline__ void convert_layer_weights(const Frame& F, int l) {
    {
        LAS float* scr = (LAS float*)(F.lds + F.wave * 8448);
        constexpr int I0 = 1152, I1 = 192, I2 = 512, I3 = 8192, I4 = 4096, IL = I0 + I1 + I2 + I3 + I4;
        for (int r0_ = F.gw; r0_ < IL; r0_ += F.ngw) {
            int r = r0_;
            if (r < I0) { conv_item<0>(F, l, r, scr); continue; } r -= I0;
            if (r < I1) { conv_item<1>(F, l, r, scr); continue; } r -= I1;
            if (r < I2) { conv_item<2>(F, l, r, scr); continue; } r -= I2;
            if (r < I3) { conv_item<3>(F, l, r, scr); continue; } r -= I3;
            conv_item<4>(F, l, r, scr);
        }
    }
}

__device__ __forceinline__ void phase_ln(const Frame& F, int l) {
    if (l < NL) convert_layer_weights(F, l);
    constexpr int NR = 4;
    const float* mods = (const float*)(F.ws + WS_MODS); bf16* HA = (bf16*)(F.ws + WS_HA);
    const bf16* Y = (const bf16*)(F.ws + WS_PB); const unsigned* RT = (const unsigned*)(F.ws + WS_RT);
    const int lane = F.lane; const RowPtrs RP = row_ptrs(F);
    const float* ln2g = INP(I_LN2G) + (l > 0 ? l - 1 : 0) * D; const float* ln2b = INP(I_LN2B) + (l > 0 ? l - 1 : 0) * D;
    const int rpw = rows_per_wave(F.ngw), rbeg = F.gw * rpw, rend = min(M, rbeg + rpw);
    float g2[16]; int cur_mr = -1;
    float alpha_l = ALPHA; asm volatile("" : "+v"(alpha_l));
    for (int r0 = rbeg; r0 < rend; r0 += NR) {
        float v[NR][16]; v4u rt[NR]; v2u ya[NR][4], yb[NR][4]; bool act[NR];
        const int b0 = r0 / TT, t0 = r0 - b0 * TT; const bool lat = t0 < SEQ; const int mr = lat ? b0 : 16;
        if (l == NL && !lat) continue;
#pragma unroll
        for (int u = 0; u < NR; ++u) {
            const int r = r0 + u; act[u] = r < rend; const int rc = act[u] ? r : r0;
            if (l == 0) ld16nt(xin_row(RP, rc), lane, v[u]); else ld16h(RP.xs + (size_t)rc * D, lane, v[u]);
            rt[u] = *(const v4u*)(RT + (size_t)rc * 8 + 4);
        }
        if (mr != cur_mr) { if (l > 0) ld16(mods + ((size_t)(l - 1) * 17 + mr) * 6144 + 5120, lane, g2); cur_mr = mr; }
        if (l > 0) {
#pragma unroll
            for (int u = 0; u < NR; ++u) { ld16bf_raw_nt(Y + (size_t)rt[u].z * D, lane, ya[u]); ld16bf_raw_nt(Y + (size_t)rt[u].w * D, lane, yb[u]); }
#pragma unroll
            for (int u = 0; u < NR; ++u) {
                float f0[16], f1[16], gg[16], bb[16];
                const float w0 = __uint_as_float(rt[u].x), w1 = __uint_as_float(rt[u].y);
                unpack16(ya[u], f0); unpack16(yb[u], f1);
#pragma unroll
                for (int i = 0; i < 16; ++i) v[u][i] = alpha_l * v[u][i] + g2[i] * (w0 * f0[i] + w1 * f1[i]);
                ld16(ln2g, lane, gg); ld16(ln2b, lane, bb);
                ln16(v[u]);
#pragma unroll
                for (int i = 0; i < 16; ++i) v[u][i] = v[u][i] * gg[i] + bb[i];
                if (act[u]) { if (l == NL) st16nt(out_row(RP, r0 + u), lane, v[u]); else st16h(RP.xs + (size_t)(r0 + u) * D, lane, v[u]); }
            }
        }
        if (l < NL) {
            float sh[16], sc[16]; ld16(mods + ((size_t)l * 17 + mr) * 6144, lane, sh); ld16(mods + ((size_t)l * 17 + mr) * 6144 + 1024, lane, sc);
#pragma unroll
            for (int u = 0; u < NR; ++u) {
                ln16(v[u]);
#pragma unroll
                for (int i = 0; i < 16; ++i) v[u][i] = v[u][i] * (1.0f + sc[i]) + sh[i];
                if (act[u]) st16bf(HA + (size_t)(r0 + u) * D, lane, v[u]);
            }
        }
    }
}

__device__ __forceinline__ void rope8(float (&f)[8], const float (&p)[8], const float* cs, bool first) {
    const f32x4* c4 = (const f32x4*)cs;
#pragma unroll
    for (int q = 0; q < 4; ++q) { const f32x4 t = c4[q];
        f[2 * q] = first ? f[2 * q] * t.x - p[2 * q] * t.y : p[2 * q] * t.y + f[2 * q] * t.x;
        f[2 * q + 1] = first ? f[2 * q + 1] * t.z - p[2 * q + 1] * t.w : p[2 * q + 1] * t.w + f[2 * q + 1] * t.z; }
}
#define DPPF(v, ctrl) __builtin_bit_cast(float, __builtin_amdgcn_update_dpp(0, __builtin_bit_cast(int, (v)), (ctrl), 0xf, 0xf, true))
__device__ __forceinline__ float dpp_xor1(float v) { return DPPF(v, 0xB1); }
__device__ __forceinline__ float dpp_xor2(float v) { return DPPF(v, 0x4E); }
__device__ __forceinline__ float dpp_hmir(float v) { return DPPF(v, 0x141); }
__device__ __forceinline__ float dpp_mir(float v) { return DPPF(v, 0x140); }
__device__ __forceinline__ void phase_post(const Frame& F, int l) {
    constexpr int NR = 4;
    bf16* P = (bf16*)(F.ws + WS_PB); bf16* KD = (bf16*)(F.ws + WS_KD);
    const float* t64 = (const float*)(F.ws + WS_T64); const float* t32 = (const float*)(F.ws + WS_T32);
    const int lane = F.lane; const float* gains = (lane < 32 ? INP(I_GQG) : INP(I_GKG)) + l * 64;
    const int j = lane & 7, jj = lane & 3;
    float gn[8];
#pragma unroll
    for (int i = 0; i < 8; ++i) gn[i] = gains[j * 8 + i];
    for (int r0 = F.gw; r0 < M; r0 += NR * F.ngw) {
        v4u w0[NR], w1[NR], w2[NR]; int rr[NR]; bool act[NR];
#pragma unroll
        for (int u = 0; u < NR; ++u) { const int r = r0 + u * F.ngw; act[u] = r < M; rr[u] = act[u] ? r : r0; const bf16* prow = P + (size_t)rr[u] * NPJ;
            w0[u] = *((const v4u*)(prow + 768) + lane); w1[u] = *((const v4u*)(prow + 1280) + lane); w2[u] = *((const v4u*)(prow + 1792) + lane); }
#pragma unroll
        for (int u = 0; u < NR; ++u) {
            const int r = rr[u]; const int b = r / TT, t = r - b * TT; const bool lat = t < SEQ; const int gr = (t >> 6) & 63, gc = t & 63;
            bf16* prow = P + (size_t)r * NPJ;
            const float* cs64 = t64 + ((size_t)((j < 4 ? gr : gc) * 16 + (j & 1) * 8)) * 2;
            {
                float f[8]; unpack8(w0[u], f);
                float ss = 0.f;
#pragma unroll
                for (int i = 0; i < 8; ++i) ss += f[i] * f[i];
                ss += dpp_xor1(ss); ss += dpp_xor2(ss); ss += dpp_hmir(ss);
                const float rs = __builtin_amdgcn_rsqf(ss * (1.0f / 64.0f) + EPS);
#pragma unroll
                for (int i = 0; i < 8; ++i) f[i] = f[i] * rs * gn[i];
                float p[8];
#pragma unroll
                for (int i = 0; i < 8; ++i) p[i] = dpp_xor2(f[i]);
                if (lat) rope8(f, p, cs64, (j & 2) == 0);
                if (lane < 48 && act[u]) *((v4u*)(prow + 768) + lane) = pack8(f);
            }
            {
                float f[8]; unpack8(w1[u], f);
                float p[8];
#pragma unroll
                for (int i = 0; i < 8; ++i) p[i] = dpp_xor2(f[i]);
                rope8(f, p, cs64, (j & 2) == 0);
                if (lat && lane < 48 && act[u]) *((v4u*)(prow + 1280) + lane) = pack8(f);
            }
            {
                float f[8]; unpack8(w2[u], f);
                float ss = 0.f;
#pragma unroll
                for (int i = 0; i < 8; ++i) ss += f[i] * f[i];
                ss += dpp_xor1(ss); ss += dpp_xor2(ss); ss += dpp_hmir(ss); ss += dpp_mir(ss);
                const float s32 = __builtin_bit_cast(float, __builtin_amdgcn_readlane(__builtin_bit_cast(int, ss), 0)) + __builtin_bit_cast(float, __builtin_amdgcn_readlane(__builtin_bit_cast(int, ss), 16));
                const float rn = __builtin_amdgcn_rsqf(lane < 32 ? s32 * (1.0f / 256.0f) + EPS : ss * (1.0f / 128.0f) + EPS);
                if (lane < 48 && act[u]) { float fn[8];
#pragma unroll
                    for (int i = 0; i < 8; ++i) fn[i] = f[i] * rn;
                    *((v4u*)(prow + 1792) + lane) = pack8(fn); }
                float p[8];
#pragma unroll
                for (int i = 0; i < 8; ++i) p[i] = dpp_xor1(f[i]);
                if (lat) rope8(f, p, t32 + ((size_t)((jj < 2 ? gr : gc) * 8)) * 2, (jj & 1) == 0);
                if (lane >= 48 && lane < 52 && act[u]) { const v4u o = pack8(f);
#pragma unroll
                    for (int h = 0; h < 4; ++h) *(v4u*)(KD + (size_t)r * 384 + h * 96 + 64 + 8 * jj) = o; }
            }
        }
    }
}

__device__ __forceinline__ float rt_dot(const float (&x)[16], f32x4 w0, f32x4 w1, f32x4 w2, f32x4 w3) {
    float a = x[0] * w0.x, b = x[8] * w2.x;
    a = __builtin_fmaf(x[1], w0.y, a); b = __builtin_fmaf(x[9], w2.y, b); a = __builtin_fmaf(x[2], w0.z, a); b = __builtin_fmaf(x[10], w2.z, b);
    a = __builtin_fmaf(x[3], w0.w, a); b = __builtin_fmaf(x[11], w2.w, b); a = __builtin_fmaf(x[4], w1.x, a); b = __builtin_fmaf(x[12], w3.x, b);
    a = __builtin_fmaf(x[5], w1.y, a); b = __builtin_fmaf(x[13], w3.y, b); a = __builtin_fmaf(x[6], w1.z, a); b = __builtin_fmaf(x[14], w3.z, b);
    a = __builtin_fmaf(x[7], w1.w, a); b = __builtin_fmaf(x[15], w3.w, b);
    return a + b;
}
__device__ __forceinline__ void reduce4(float& a, float& b, float& c, float& d) {
    auto r1 = __builtin_amdgcn_permlane32_swap(__builtin_bit_cast(unsigned, a), __builtin_bit_cast(unsigned, b), false, false); const unsigned x0 = r1[0], x1 = r1[1];
    auto r2 = __builtin_amdgcn_permlane32_swap(__builtin_bit_cast(unsigned, c), __builtin_bit_cast(unsigned, d), false, false); const unsigned y0 = r2[0], y1 = r2[1];
    const float X = __uint_as_float(x0) + __uint_as_float(x1), Y = __uint_as_float(y0) + __uint_as_float(y1);
    auto r3 = __builtin_amdgcn_permlane16_swap(__builtin_bit_cast(unsigned, X), __builtin_bit_cast(unsigned, Y), false, false); const unsigned z0 = r3[0], z1 = r3[1];
    float z = __uint_as_float(z0) + __uint_as_float(z1);
    z += dpp_xor1(z); z += dpp_xor2(z); z += dpp_hmir(z); z += dpp_mir(z);
    const int zi = __builtin_bit_cast(int, z);
    a = __builtin_bit_cast(float, __builtin_amdgcn_readlane(zi, 0)); c = __builtin_bit_cast(float, __builtin_amdgcn_readlane(zi, 16));
    b = __builtin_bit_cast(float, __builtin_amdgcn_readlane(zi, 32)); d = __builtin_bit_cast(float, __builtin_amdgcn_readlane(zi, 48));
}
__device__ __forceinline__ void ln16_pair(float (&v0)[16], float (&v1)[16]) {
    float s0 = 0.f, q0 = 0.f, s1 = 0.f, q1 = 0.f;
#pragma unroll
    for (int i = 0; i < 16; ++i) { s0 += v0[i]; q0 = __builtin_fmaf(v0[i], v0[i], q0); s1 += v1[i]; q1 = __builtin_fmaf(v1[i], v1[i], q1); }
    reduce4(s0, q0, s1, q1);
    const float m0 = s0 * (1.0f / D), m1 = s1 * (1.0f / D);
    const float r0 = __builtin_amdgcn_rsqf(fmaxf(q0 * (1.0f / D) - m0 * m0, 0.f) + EPS), r1 = __builtin_amdgcn_rsqf(fmaxf(q1 * (1.0f / D) - m1 * m1, 0.f) + EPS);
    const float c0 = -m0 * r0, c1 = -m1 * r1;
#pragma unroll
    for (int i = 0; i < 16; ++i) { v0[i] = __builtin_fmaf(v0[i], r0, c0); v1[i] = __builtin_fmaf(v1[i], r1, c1); }
}
__device__ __forceinline__ void phase_route(const Frame& F, int l) {
    const float* mods = (const float*)(F.ws + WS_MODS); bf16* HA = (bf16*)(F.ws + WS_HA);
    const bf16* MIX = (const bf16*)(F.ws + WS_PB); unsigned* RT = (unsigned*)(F.ws + WS_RT); int* HIST = (int*)(F.ws + WS_HIST);
    LAS float* WR = (LAS float*)F.lds;
    { const float* rgw = INP(I_RGW); const float* rew = INP(I_REW);
      for (int i = F.tid; i < 20 * 1024; i += NTHR) { const int jx = i >> 10, k = i & 1023;
        WR[i] = jx < 4 ? rgw[((size_t)l * D + k) * 4 + jx] : rew[((size_t)l * D + k) * 16 + (jx - 4)]; } }
    if (F.tid < 16) F.MISC[MI_LH + F.tid] = 0u;
    __syncthreads();
    LAS float* bias = (LAS float*)(F.lds + 20 * 1024 * 4);
    if (F.tid < 20) bias[F.tid] = F.tid < 4 ? INP(I_RGB)[l * 4 + F.tid] : INP(I_REB)[l * 16 + (F.tid - 4)];
    __syncthreads();
    const RowPtrs RP = row_ptrs(F);
    LAS float* LNG = (LAS float*)(F.lds + 20 * 1024 * 4 + 128);
    { const float* ln1g = INP(I_LN1G) + l * D; const float* ln1b = INP(I_LN1B) + l * D;
      for (int i = F.tid; i < 1024; i += NTHR) { LNG[i] = ln1g[i]; LNG[1024 + i] = ln1b[i]; } }
    __syncthreads();
    constexpr int NR = 2;
    const LAS unsigned char* wbase = (const LAS unsigned char*)WR + F.lane * 16; asm volatile("" : "+v"(wbase));
    const LAS unsigned char* lbase = (const LAS unsigned char*)LNG + F.lane * 16; asm volatile("" : "+v"(lbase));
#define RT_W4(base_, off_) (*(const LAS f32x4*)((base_) + (off_)))
    const int rpw = rows_per_wave(F.ngw), rbeg = F.gw * rpw, rend = min(M, rbeg + rpw);
    float g1[16], sh[16], sc[16]; int cur_mr = -1;
    float alpha_l = ALPHA; asm volatile("" : "+v"(alpha_l));
    v4u rx[NR][4]; v2u rm[NR][4];
#define RT_ISSUE(r0_) do { _Pragma("unroll") for (int u = 0; u < NR; ++u) { const int r_ = (r0_) + u, rc_ = r_ < rend ? r_ : (r0_); \
        if (l == 0) { const v4u* q_ = (const v4u*)xin_row(RP, rc_) + F.lane; _Pragma("unroll") for (int g = 0; g < 4; ++g) rx[u][g] = __builtin_nontemporal_load(q_ + 64 * g); } \
        else { const v2u* q_ = (const v2u*)(RP.xs + (size_t)rc_ * D) + F.lane; _Pragma("unroll") for (int g = 0; g < 4; ++g) { const v2u t_ = __builtin_nontemporal_load(q_ + 64 * g); rx[u][g].x = t_.x; rx[u][g].y = t_.y; } } \
        ld16bf_raw_nt(MIX + (size_t)rc_ * D, F.lane, rm[u]); } } while (0)
    if (rbeg < rend) RT_ISSUE(rbeg);
    for (int r0 = rbeg; r0 < rend; r0 += NR) {
        float v[NR][16]; int rr[NR]; bool act[NR];
        { const int b = r0 / TT, t = r0 - b * TT, mr = t < SEQ ? b : 16;
          if (mr != cur_mr) { const float* md = mods + ((size_t)l * 17 + mr) * 6144; ld16(md + 2048, F.lane, g1); ld16(md + 3072, F.lane, sh); ld16(md + 4096, F.lane, sc); cur_mr = mr; } }
#pragma unroll
        for (int u = 0; u < NR; ++u) { const int r = r0 + u; act[u] = r < rend; rr[u] = act[u] ? r : r0;
            float mx[16]; unpack16(rm[u], mx);
            if (l == 0) {
#pragma unroll
                for (int g = 0; g < 4; ++g) { v[u][4 * g] = __uint_as_float(rx[u][g].x); v[u][4 * g + 1] = __uint_as_float(rx[u][g].y); v[u][4 * g + 2] = __uint_as_float(rx[u][g].z); v[u][4 * g + 3] = __uint_as_float(rx[u][g].w); }
            } else {
#pragma unroll
                for (int g = 0; g < 4; ++g) { const v2u t = {rx[u][g].x, rx[u][g].y}; const f32x4 f = __builtin_convertvector(__builtin_bit_cast(f16x4, t), f32x4);
                    v[u][4 * g] = f.x; v[u][4 * g + 1] = f.y; v[u][4 * g + 2] = f.z; v[u][4 * g + 3] = f.w; }
            }
#pragma unroll
            for (int i = 0; i < 16; ++i) v[u][i] = alpha_l * v[u][i] + g1[i] * mx[i]; }
        if (r0 + NR < rend) RT_ISSUE(r0 + NR);
        if (l == NL - 1 && (r0 % TT) >= SEQ) continue;
        ln16_pair(v[0], v[1]);
        { float gg[16], bb[16];
#pragma unroll
          for (int g = 0; g < 4; ++g) { const f32x4 a = RT_W4(lbase, 1024 * g), c = RT_W4(lbase, 4096 + 1024 * g);
              gg[4 * g] = a.x; gg[4 * g + 1] = a.y; gg[4 * g + 2] = a.z; gg[4 * g + 3] = a.w; bb[4 * g] = c.x; bb[4 * g + 1] = c.y; bb[4 * g + 2] = c.z; bb[4 * g + 3] = c.w; }
#pragma unroll
          for (int u = 0; u < NR; ++u) {
#pragma unroll
            for (int i = 0; i < 16; ++i) v[u][i] = v[u][i] * gg[i] + bb[i];
            if (act[u]) st16h(RP.xs + (size_t)rr[u] * D, F.lane, v[u]); } }
        ln16_pair(v[0], v[1]);
#pragma unroll
        for (int u = 0; u < NR; ++u) {
#pragma unroll
            for (int i = 0; i < 16; ++i) v[u][i] = v[u][i] * (1.0f + sc[i]) + sh[i];
            if (act[u]) st16bf(HA + (size_t)rr[u] * D, F.lane, v[u]); }
#define RT_DOT(u_, w0, w1, w2, w3) rt_dot(v[u_], w0, w1, w2, w3)
        float gl[NR][4];
#pragma unroll
        for (int jx = 0; jx < 4; ++jx) {
            const f32x4 w0 = RT_W4(wbase, 4096 * jx), w1 = RT_W4(wbase, 4096 * jx + 1024), w2 = RT_W4(wbase, 4096 * jx + 2048), w3 = RT_W4(wbase, 4096 * jx + 3072);
#pragma unroll
            for (int u = 0; u < NR; ++u) gl[u][jx] = RT_DOT(u, w0, w1, w2, w3);
        }
#pragma unroll
        for (int u = 0; u < NR; ++u) { reduce4(gl[u][0], gl[u][1], gl[u][2], gl[u][3]);
#pragma unroll
            for (int jx = 0; jx < 4; ++jx) gl[u][jx] += bias[jx]; }
        int grpv[NR]; float pgv[NR];
#pragma unroll
        for (int u = 0; u < NR; ++u) {
            int grp = 0; float mg = gl[u][0];
#pragma unroll
            for (int g = 1; g < 4; ++g) if (gl[u][g] > mg) { mg = gl[u][g]; grp = g; }
            float sg = 0.f;
#pragma unroll
            for (int g = 0; g < 4; ++g) sg += __builtin_amdgcn_exp2f((gl[u][g] - mg) * LOG2E);
            grpv[u] = grp; pgv[u] = __builtin_amdgcn_rcpf(sg);
        }
        float selv[NR][4];
#pragma unroll
        for (int u = 0; u < NR; ++u) {
            const LAS unsigned char* eb = wbase + (4 + 4 * grpv[u]) * 4096;
#pragma unroll
            for (int i = 0; i < 4; ++i) {
                const f32x4 w0 = RT_W4(eb, 4096 * i), w1 = RT_W4(eb, 4096 * i + 1024), w2 = RT_W4(eb, 4096 * i + 2048), w3 = RT_W4(eb, 4096 * i + 3072);
                selv[u][i] = RT_DOT(u, w0, w1, w2, w3);
            }
        }
#pragma unroll
        for (int u = 0; u < NR; ++u) { reduce4(selv[u][0], selv[u][1], selv[u][2], selv[u][3]);
#pragma unroll
            for (int i = 0; i < 4; ++i) selv[u][i] += bias[4 + 4 * grpv[u] + i]; }
#undef RT_DOT
#pragma unroll
        for (int u = 0; u < NR; ++u) {
            const int grp = grpv[u]; const float pg = pgv[u];
            float sel[4];
#pragma unroll
            for (int i = 0; i < 4; ++i) sel[i] = selv[u][i];
            int i1 = 0; float v1 = sel[0];
#pragma unroll
            for (int i = 1; i < 4; ++i) if (sel[i] > v1) { v1 = sel[i]; i1 = i; }
            int i2 = -1; float v2 = -3.0e38f;
#pragma unroll
            for (int i = 0; i < 4; ++i) if (i != i1 && (i2 < 0 || sel[i] > v2)) { v2 = sel[i]; i2 = i; }
            const float ee = __builtin_amdgcn_exp2f((v2 - v1) * LOG2E), rq = __builtin_amdgcn_rcpf(1.0f + ee), w1 = pg * rq, w2 = pg * ee * rq;
            const int e1 = grp * 4 + i1, e2 = grp * 4 + i2;
            if (F.lane == 0 && act[u]) {
                const unsigned k1 = __hip_atomic_fetch_add((LAS unsigned*)&F.MISC[MI_LH + e1], 1u, __ATOMIC_RELAXED, __HIP_MEMORY_SCOPE_WORKGROUP);
                const unsigned k2 = __hip_atomic_fetch_add((LAS unsigned*)&F.MISC[MI_LH + e2], 1u, __ATOMIC_RELAXED, __HIP_MEMORY_SCOPE_WORKGROUP);
                v4u ra; ra.x = (unsigned)e1; ra.y = (unsigned)e2; ra.z = k1; ra.w = k2;
                v4u rb; rb.x = __builtin_bit_cast(unsigned, w1); rb.y = __builtin_bit_cast(unsigned, w2); rb.z = 0u; rb.w = 0u;
                *(v4u*)(RT + (size_t)rr[u] * 8) = ra; *(v4u*)(RT + (size_t)rr[u] * 8 + 4) = rb;
            }
        }
    }
#undef RT_ISSUE
#undef RT_W4
    __syncthreads();
    if (F.tid < 16) HIST[F.bid * 16 + F.tid] = (int)F.MISC[MI_LH + F.tid];
}
__device__ __forceinline__ void moe_tables(const Frame& F) {
    const int* HIST = (const int*)(F.ws + WS_HIST); LAS int* hl = (LAS int*)F.lds;
    __syncthreads();
    for (int i = F.tid; i < F.G * 16; i += NTHR) hl[i] = HIST[i];
    __syncthreads();
    if (F.tid < 16) { int tot = 0, mine = 0; for (int g = 0; g < F.G; ++g) { const int c = hl[g * 16 + F.tid]; tot += c; mine += (g < F.bid) ? c : 0; }
        F.MISC[MI_TOT + F.tid] = (unsigned)tot; F.MISC[MI_BASE + F.tid] = (unsigned)mine; }
    __syncthreads();
    if (F.tid == 0) { unsigned p = 0; for (int e = 0; e < 16; ++e) { F.MISC[MI_PST + e] = p; F.MISC[MI_BASE + e] += p * 256u; p += (F.MISC[MI_TOT + e] + 255u) >> 8; } F.MISC[MI_PST + 16] = p; }
    __syncthreads();
}
__device__ __forceinline__ void phase_permute(const Frame& F, int l) {
    unsigned* RT = (unsigned*)(F.ws + WS_RT); int* SRC = (int*)(F.ws + WS_QD);
    moe_tables(F);
    const int rpw = rows_per_wave(F.ngw), rbeg = F.gw * rpw, rend = min(M, rbeg + rpw);
    for (int r = rbeg + F.lane; r < rend; r += 64) {
        if (l == NL - 1 && (r % TT) >= SEQ) continue;
        const v4u ra = *(const v4u*)(RT + (size_t)r * 8);
        const unsigned p0 = F.MISC[MI_BASE + (ra.x & 15u)] + ra.z, p1 = F.MISC[MI_BASE + (ra.y & 15u)] + ra.w;
        RT[(size_t)r * 8 + 6] = p0; RT[(size_t)r * 8 + 7] = p1; SRC[p0] = r; SRC[p1] = r;
    }
    if (F.bid == 0) {
        for (int e = 0; e < 16; ++e) { const int beg = (int)F.MISC[MI_PST + e] * 256 + (int)F.MISC[MI_TOT + e], end = (int)F.MISC[MI_PST + e + 1] * 256;
            for (int p = beg + F.tid; p < end; p += NTHR) SRC[p] = 0; }
    }
}

struct EpiMla {
    static constexpr bool PERM = true, AFTER_DRAIN = false;
    bf16* QD; bf16* KD; bf16* VD;
    __device__ __forceinline__ void operator()(const pg8::f32x4 (&acc)[2][2][4][2], const pg8::Unit& u, int wr, int wc, int fr, int fq) const {
#pragma unroll
        for (int bj = 0; bj < 2; ++bj) {
            const int g0 = u.pn * 256 + bj * 128 + wc * 32, col0 = g0 + 8 * fq;
            if (g0 >= 896) continue;
            const int c = col0 - 384, hd = c >> 7, jx = c & 127;
            bf16* dst = g0 < 384 ? QD + col0 : jx < 64 ? KD + hd * 96 + jx : VD + hd * 64 + (jx - 64);
            const int stride = (g0 < 384 || jx < 64) ? 384 : 256;
            dst += (size_t)(u.pm * 256 + wr * 64 + fr) * stride;
#pragma unroll
            for (int ai = 0; ai < 2; ++ai)
#pragma unroll
                for (int m = 0; m < 4; ++m) {
                    v4u o; o.x = pk2(acc[ai][bj][m][0][0], acc[ai][bj][m][0][1]); o.y = pk2(acc[ai][bj][m][0][2], acc[ai][bj][m][0][3]);
                    o.z = pk2(acc[ai][bj][m][1][0], acc[ai][bj][m][1][1]); o.w = pk2(acc[ai][bj][m][1][2], acc[ai][bj][m][1][3]);
                    *(v4u*)(dst + (size_t)(ai * 128 + m * 16) * stride) = o;
                }
        }
    }
};
struct EpiGU {
    static constexpr bool PERM = true, AFTER_DRAIN = false;
    bf16* ACT;
    __device__ __forceinline__ void operator()(const pg8::f32x4 (&acc)[2][2][4][2], const pg8::Unit& u, int wr, int wc, int fr, int fq) const {
#pragma unroll
        for (int ai = 0; ai < 2; ++ai)
#pragma unroll
            for (int m = 0; m < 4; ++m) {
                const int row = u.pm * 256 + ai * 128 + wr * 64 + m * 16 + fr;
#pragma unroll
                for (int bj = 0; bj < 2; ++bj) {
                    const int c = (u.pn & 3) * 256 + bj * 128 + wc * 32 + 8 * fq;
                    float o[4];
#pragma unroll
                    for (int i = 0; i < 4; ++i) { const float g = acc[ai][bj][m][0][i], up = acc[ai][bj][m][1][i]; o[i] = g * __builtin_amdgcn_rcpf(1.0f + __expf(-g)) * up; }
                    v2u w; w.x = pk2(o[0], o[1]); w.y = pk2(o[2], o[3]);
                    *(v2u*)(ACT + (size_t)row * 512 + (c >> 1)) = w;
                }
            }
    }
};
struct MoeOrder {
    volatile LAS unsigned* pst; int G, c;
    __device__ __forceinline__ bool next(int i, pg8::Unit& u) const {
        const int np = (int)pst[16]; int panel, pn;
        if ((G & 7) == 0) { const int x = c & 7, uu = i * (G >> 3) + (c >> 3); panel = (uu >> 2) * 8 + x; pn = uu & 3; }
        else { const int L = i * G + c; panel = L >> 2; pn = L & 3; }
        if (panel >= np) return false;
        int e = 0;
#pragma unroll
        for (int k = 1; k < 16; ++k) e += (panel >= (int)pst[k]) ? 1 : 0;
        u.pm = __builtin_amdgcn_readfirstlane(panel); u.pn = __builtin_amdgcn_readfirstlane(e * 4 + pn); return true;
    }
    __device__ __forceinline__ void a_ready(const pg8::Unit&) const {}
    __device__ __forceinline__ void done(const pg8::Unit&) const {}
};

struct LatOrder {
    int G, c;
    __device__ __forceinline__ bool next(int i, pg8::Unit& u) const {
        int pl, pn;
        if ((G & 7) == 0) { const int x = c & 7, uu = i * (G >> 3) + (c >> 3); pl = (uu >> 2) * 8 + x; pn = uu & 3; } else { const int L = i * G + c; pl = L >> 2; pn = L & 3; }
        if (pl >= NB * 16) return false;
        u.pm = pl + (pl >> 4); u.pn = pn; return true;
    }
    __device__ __forceinline__ void a_ready(const pg8::Unit&) const {}
    __device__ __forceinline__ void done(const pg8::Unit&) const {}
};

#ifndef DBG_VAR
#define DBG_VAR 1
#endif
namespace att {
constexpr int VRS = 192, KBUF = 64 * 208, VBUF = 64 * VRS, BUF = KBUF + VBUF, BIAS_OFF = 4 * BUF;
constexpr float NEG = -30000.0f;
__device__ __forceinline__ int crow(int r, int hi) { return (r & 3) + 8 * (r >> 2) + 4 * hi; }
__device__ __forceinline__ float xhalf_max(float v) { const unsigned a = __builtin_bit_cast(unsigned, v);
    auto rr = __builtin_amdgcn_permlane32_swap(a, a, false, false); const unsigned r0 = rr[0], r1 = rr[1]; return fmaxf(__uint_as_float(r0), __uint_as_float(r1)); }
__device__ __forceinline__ float xhalf_sum(float v) { const unsigned a = __builtin_bit_cast(unsigned, v);
    auto rr = __builtin_amdgcn_permlane32_swap(a, a, false, false); const unsigned r0 = rr[0], r1 = rr[1]; return __uint_as_float(r0) + __uint_as_float(r1); }
__device__ __forceinline__ float max3f(float a, float b, float c) { float r; asm("v_max3_f32 %0, %1, %2, %3" : "=v"(r) : "v"(a), "v"(b), "v"(c)); return r; }
typedef __bf16 bf16x2_t __attribute__((ext_vector_type(2)));
__device__ __forceinline__ unsigned cvtpk(float lo, float hi) { f32x2 v = {lo, hi}; bf16x2_t b = __builtin_convertvector(v, bf16x2_t); return __builtin_bit_cast(unsigned, b); }

template <int DK, int VM = 0>
__device__ __forceinline__ void unit(LAS unsigned char* lds, const bf16* Qp, int qpitch, const bf16* Kp, int kpitch, const bf16* Vp, int vpitch, bf16* Op,
                                     int var, int qt, int lo, int n1, int nt, float qscale, float sinkl2, bool has_sink, const LAS float* bias, const float* t32, unsigned* dbg) {
    constexpr int KRS = DK * 2 + 16, NS = DK / 16, CPK = DK / 8;
    int tid = threadIdx.x; asm volatile("" : "+v"(tid)); const int lane = tid & 63, r32 = lane & 31, hi = lane >> 5, wid = __builtin_amdgcn_readfirstlane(tid >> 6);
    const int qrow = 256 * qt + 32 * wid + r32;
    bf16x8 qr[NS];
#pragma unroll
    for (int s = 0; s < NS; ++s) { const v4u raw = *(const v4u*)(Qp + (size_t)qrow * qpitch + 16 * s + 8 * hi); float f[8]; unpack8(raw, f);
#pragma unroll
        for (int i = 0; i < 8; ++i) f[i] *= qscale;
        if (DK == 96 && s >= 4) {
            float p[8];
#pragma unroll
            for (int i = 0; i < 8; ++i) p[i] = __shfl_xor(f[i], 32);
            if (qt < 16) rope8(f, p, t32 + ((size_t)((s == 4 ? (qrow >> 6) : (qrow & 63)) * 8)) * 2, hi == 0);
        }
        qr[s] = __builtin_bit_cast(bf16x8, pack8(f)); }
    const int kkey0 = tid / CPK, kch0 = tid - kkey0 * CPK, kkey1 = (tid + 512) / CPK, kch1 = (tid + 512) - kkey1 * CPK;
    const int vkey = tid >> 3, vch = tid & 7;
    v4u kreg0, kreg1 = {0u, 0u, 0u, 0u}, vreg;
#define ATT_TROW(j) ((((j) < n1) ? (lo + (j)) : (64 + (j) - n1)) * 64)
#define ATT_LOAD(j) do { const int tr_ = ATT_TROW(j); kreg0 = *(const v4u*)(Kp + (size_t)(tr_ + kkey0) * kpitch + kch0 * 8); \
        if (DK == 96 && tid < 256) kreg1 = *(const v4u*)(Kp + (size_t)(tr_ + kkey1) * kpitch + kch1 * 8); \
        vreg = *(const v4u*)(Vp + (size_t)(tr_ + vkey) * vpitch + vch * 8); } while (0)
#define ATT_STORE(bf) do { LAS unsigned char* b_ = lds + (bf) * BUF; *(LAS v4u*)(b_ + kkey0 * KRS + kch0 * 16) = kreg0; \
        if (DK == 96 && tid < 256) *(LAS v4u*)(b_ + kkey1 * KRS + kch1 * 16) = kreg1; \
        *(LAS v4u*)(b_ + KBUF + vkey * VRS + vch * 16) = vreg; } while (0)
    constexpr float THR = 6.0f;
    float m = 0.f; f32x2 lacc = {0.f, 0.f}; f32x16 o0 = {}, o1 = {}; f32x16 negm = {}; bool first = true;
    const int grw = 4 * qt + (wid >> 1), r0w = min(max(grw - 4, 0), 56), gc = (wid & 1) * 32 + r32, c0 = min(max(gc - 8, 0), 48), i0w = 256 * qt + 32 * wid;
    ATT_LOAD(0); ATT_STORE(0);
    __syncthreads();
    for (int j = 0; j < nt; ++j) {
        if (!(VM & 8) && j + 1 < nt) ATT_LOAD(j + 1);
        const int kt = ATT_TROW(j) >> 6;
        bool actv = true;
        if (kt < 64) { if (var == 0) actv = (kt >= r0w) && (kt <= r0w + 7); else if (var == 2) actv = !((64 * kt - (i0w + 31) > 128) || (i0w - (64 * kt + 63) > 128)); }
        if (actv) {
            const LAS unsigned char* Kb = lds + (j & 1) * BUF; const LAS unsigned char* Vb = Kb + KBUF;
            f32x16 s0 = negm, s1 = negm;
            bf16x8 ka[NS], kb[NS];
#pragma unroll
            for (int s = 0; s < NS; ++s) { ka[s] = *(const LAS bf16x8*)(Kb + r32 * KRS + (16 * s + 8 * hi) * 2); kb[s] = *(const LAS bf16x8*)(Kb + (32 + r32) * KRS + (16 * s + 8 * hi) * 2); }
            __builtin_amdgcn_sched_barrier(0);
            if (VM & 2) {
#pragma unroll
                for (int s = 0; s < NS; ++s) asm volatile("" :: "v"(ka[s]), "v"(kb[s]), "v"(qr[s]));
            } else {
#pragma unroll
            for (int s = 0; s < NS; ++s) { s0 = __builtin_amdgcn_mfma_f32_32x32x16_bf16(ka[s], qr[s], s0, 0, 0, 0); s1 = __builtin_amdgcn_mfma_f32_32x32x16_bf16(kb[s], qr[s], s1, 0, 0, 0); }
            }
            asm volatile("s_nop 15\n\ts_nop 7" : "+v"(s0), "+v"(s1));
            if (kt < 64 && var == 0) {
                const int rowoff = (kt - grw + 7) * 31 - gc + 15;
#pragma unroll
                for (int r = 0; r < 16; ++r) { const int j0 = crow(r, hi), j1 = j0 + 32;
                    const bool v0 = (unsigned)(j0 - c0) < 16u, v1 = (unsigned)(j1 - c0) < 16u;
                    const float b0 = bias[v0 ? rowoff + j0 : 0], b1 = bias[v1 ? rowoff + j1 : 0];
                    s0[r] = v0 ? s0[r] + b0 : NEG; s1[r] = v1 ? s1[r] + b1 : NEG; }
            } else if (kt < 64 && var == 2) {
                const int dbase = 64 * kt - qrow + 128;
#pragma unroll
                for (int r = 0; r < 16; ++r) { const int j0 = crow(r, hi);
                    s0[r] = (unsigned)(dbase + j0) <= 256u ? s0[r] : NEG; s1[r] = (unsigned)(dbase + j0 + 32) <= 256u ? s1[r] : NEG; }
            }
            if (!(VM & 4)) {
            float mxa = max3f(s0[0], s0[1], s1[0]), mxb = max3f(s0[2], s0[3], s1[1]); mxa = max3f(mxa, s1[2], s1[3]);
#pragma unroll
            for (int r = 4; r < 16; r += 4) { mxa = max3f(mxa, s0[r], s0[r + 1]); mxb = max3f(mxb, s0[r + 2], s0[r + 3]); mxa = max3f(mxa, s1[r], s1[r + 1]); mxb = max3f(mxb, s1[r + 2], s1[r + 3]); }
            const float mx = xhalf_max(fmaxf(mxa, mxb));
            if (first || __any(mx > THR)) {
                const float d = first ? fmaxf(mx, -64.0f) : fmaxf(mx, 0.f), alpha = __builtin_amdgcn_exp2f(-d);
                m += d; first = false;
#pragma unroll
                for (int r = 0; r < 16; ++r) { s0[r] -= d; s1[r] -= d; o0[r] *= alpha; o1[r] *= alpha; negm[r] = -m; }
                lacc *= alpha;
            }
#pragma unroll
            for (int r = 0; r < 16; ++r) { s0[r] = __builtin_amdgcn_exp2f(s0[r]); s1[r] = __builtin_amdgcn_exp2f(s1[r]); lacc += (f32x2){s0[r], s1[r]}; }
            }
            bf16x8 pb[4];
#pragma unroll
            for (int s = 0; s < 2; ++s) {
                v4u w; w.x = cvtpk(s0[8 * s], s0[8 * s + 1]); w.y = cvtpk(s0[8 * s + 2], s0[8 * s + 3]); w.z = cvtpk(s0[8 * s + 4], s0[8 * s + 5]); w.w = cvtpk(s0[8 * s + 6], s0[8 * s + 7]);
                pb[s] = __builtin_bit_cast(bf16x8, w);
                v4u x; x.x = cvtpk(s1[8 * s], s1[8 * s + 1]); x.y = cvtpk(s1[8 * s + 2], s1[8 * s + 3]); x.z = cvtpk(s1[8 * s + 4], s1[8 * s + 5]); x.w = cvtpk(s1[8 * s + 6], s1[8 * s + 7]);
                pb[2 + s] = __builtin_bit_cast(bf16x8, x);
            }
            if (VM & 1) { asm volatile("" :: "v"(pb[0]), "v"(pb[1]), "v"(pb[2]), "v"(pb[3])); } else {
            const LAS unsigned char* vbase = Vb + (4 * hi + ((lane & 15) >> 2)) * VRS + ((lane >> 4) & 1) * 32 + (lane & 3) * 8;
#pragma unroll
            for (int s = 0; s < 4; ++s) {
                const v4i16 a0 = __builtin_amdgcn_ds_read_tr16_b64_v4i16((LAS v4i16*)(vbase + (16 * s) * VRS));
                const v4i16 a1 = __builtin_amdgcn_ds_read_tr16_b64_v4i16((LAS v4i16*)(vbase + (16 * s + 8) * VRS));
                const v4i16 c0_ = __builtin_amdgcn_ds_read_tr16_b64_v4i16((LAS v4i16*)(vbase + (16 * s) * VRS + 64));
                const v4i16 c1_ = __builtin_amdgcn_ds_read_tr16_b64_v4i16((LAS v4i16*)(vbase + (16 * s + 8) * VRS + 64));
                const bf16x8 va = {a0[0], a0[1], a0[2], a0[3], a1[0], a1[1], a1[2], a1[3]};
                const bf16x8 vc = {c0_[0], c0_[1], c0_[2], c0_[3], c1_[0], c1_[1], c1_[2], c1_[3]};
                o0 = __builtin_amdgcn_mfma_f32_32x32x16_bf16(va, pb[s], o0, 0, 0, 0);
                o1 = __builtin_amdgcn_mfma_f32_32x32x16_bf16(vc, pb[s], o1, 0, 0, 0);
            }
            }
        }
        if (!(VM & 8) && j + 1 < nt) ATT_STORE((j + 1) & 1);
        if (!(VM & 16)) __syncthreads();
    }
    float l = xhalf_sum(lacc.x + lacc.y);
    const float sterm = has_sink ? __builtin_amdgcn_exp2f(sinkl2 - m) : 0.f;
#if MK_DEBUG
    if (dbg && hi == 0) { dbg[(size_t)qrow * 2] = __builtin_bit_cast(unsigned, m); dbg[(size_t)qrow * 2 + 1] = __builtin_bit_cast(unsigned, l); }
#endif
    if (has_sink) l += sterm;
    const float inv = 1.0f / l;
    bf16* orow = Op + (size_t)qrow * D;
#pragma unroll
    for (int g = 0; g < 4; ++g) {
        v2u w0; w0.x = pk2(o0[4 * g] * inv, o0[4 * g + 1] * inv); w0.y = pk2(o0[4 * g + 2] * inv, o0[4 * g + 3] * inv);
        v2u w1; w1.x = pk2(o1[4 * g] * inv, o1[4 * g + 1] * inv); w1.y = pk2(o1[4 * g + 2] * inv, o1[4 * g + 3] * inv);
        *(v2u*)(orow + 8 * g + 4 * hi) = w0; *(v2u*)(orow + 32 + 8 * g + 4 * hi) = w1;
    }
#undef ATT_TROW
#undef ATT_LOAD
#undef ATT_STORE
}

template <int DK, int MODE, int VM = 0, bool NOREF = false>
__device__ __forceinline__ void unit2(LAS unsigned char* lds, const bf16* Qp, int qpitch, const bf16* Kp, int kpitch, const bf16* Vp, int vpitch, bf16* Op,
                                      int var, int qt, int lo, int n1, int nt, float qscale, float sink0, float sink1, bool has_sink, const LAS float* bias, const float* t32) {
    constexpr int KRS = DK * 2 + 16, NS = DK / 16, CPK = DK / 8;
    int tid = threadIdx.x; asm volatile("" : "+v"(tid)); const int lane = tid & 63, r32 = lane & 31, hi = lane >> 5, wid = __builtin_amdgcn_readfirstlane(tid >> 6);
    const int rowbase = MODE == 0 ? 512 * qt + 64 * wid : 256 * qt + 32 * wid;
    bf16x8 qr[2][NS];
#pragma unroll
    for (int u = 0; u < 2; ++u) {
        const int qrow = rowbase + (MODE == 0 ? 32 * u : 0) + r32;
        const bf16* qp = Qp + (MODE == 1 ? 64 * u : 0) + (size_t)qrow * qpitch;
#pragma unroll
        for (int s = 0; s < NS; ++s) { const v4u raw = *(const v4u*)(qp + 16 * s + 8 * hi); float f[8]; unpack8(raw, f);
#pragma unroll
            for (int i = 0; i < 8; ++i) f[i] *= qscale;
            if (DK == 96 && s >= 4) { float p[8];
#pragma unroll
                for (int i = 0; i < 8; ++i) p[i] = __shfl_xor(f[i], 32);
                rope8(f, p, t32 + ((size_t)((s == 4 ? (qrow >> 6) : (qrow & 63)) * 8)) * 2, hi == 0); }
            qr[u][s] = __builtin_bit_cast(bf16x8, pack8(f)); }
    }
    const int kkey0 = tid / CPK, kch0 = tid - kkey0 * CPK, kkey1 = (tid + 512) / CPK, kch1 = (tid + 512) - kkey1 * CPK;
    const int vkey = tid >> 3, vch = tid & 7;
    v4u kreg0, kreg1 = {0u, 0u, 0u, 0u}, vreg;
#define ATT_TROW(j) ((((j) < n1) ? (lo + (j)) : (64 + (j) - n1)) * 64)
#define ATT_LOAD(j) do { const int tr_ = ATT_TROW(j); kreg0 = *(const v4u*)(Kp + (size_t)(tr_ + kkey0) * kpitch + kch0 * 8); \
        if (DK == 96 && tid < 256) kreg1 = *(const v4u*)(Kp + (size_t)(tr_ + kkey1) * kpitch + kch1 * 8); \
        vreg = *(const v4u*)(Vp + (size_t)(tr_ + vkey) * vpitch + vch * 8); } while (0)
#define ATT_STORE(bf) do { LAS unsigned char* b_ = lds + (bf) * BUF; *(LAS v4u*)(b_ + kkey0 * KRS + kch0 * 16) = kreg0; \
        if (DK == 96 && tid < 256) *(LAS v4u*)(b_ + kkey1 * KRS + kch1 * 16) = kreg1; \
        *(LAS v4u*)(b_ + KBUF + vkey * VRS + vch * 16) = vreg; } while (0)
    constexpr float THR = 6.0f;
    float m = 0.f; f32x2 lacc[2] = {{0.f, 0.f}, {0.f, 0.f}}; f32x16 o0[2] = {{}, {}}, o1[2] = {{}, {}}; bool first = true;
    const int grw = 8 * qt + wid, r0w = min(max(grw - 4, 0), 56), i0w = rowbase;
    ATT_LOAD(0); ATT_STORE(0);
    __syncthreads();
    for (int j = 0; j < nt; ++j) {
        if (!(VM & 8) && j + 1 < nt) ATT_LOAD(j + 1);
        const int kt = ATT_TROW(j) >> 6;
        bool actv = true;
        if (kt < 64) { if (var == 0) actv = (kt >= r0w) && (kt <= r0w + 7); else if (var == 2) actv = !((64 * kt - (i0w + 31) > 128) || (i0w - (64 * kt + 63) > 128)); }
        if (actv) {
            const LAS unsigned char* Kb = lds + (j & 1) * BUF; const LAS unsigned char* Vb = Kb + KBUF;
            f32x16 s0[2] = {{}, {}}, s1[2] = {{}, {}};
#pragma unroll
            for (int s = 0; s < NS; ++s) {
                const bf16x8 ka = *(const LAS bf16x8*)(Kb + r32 * KRS + (16 * s + 8 * hi) * 2);
                const bf16x8 kb = *(const LAS bf16x8*)(Kb + (32 + r32) * KRS + (16 * s + 8 * hi) * 2);
                if (VM & 2) { asm volatile("" :: "v"(ka), "v"(kb), "v"(qr[0][s]), "v"(qr[1][s])); } else {
#pragma unroll
                for (int u = 0; u < 2; ++u) { s0[u] = __builtin_amdgcn_mfma_f32_32x32x16_bf16(ka, qr[u][s], s0[u], 0, 0, 0); s1[u] = __builtin_amdgcn_mfma_f32_32x32x16_bf16(kb, qr[u][s], s1[u], 0, 0, 0); }
                }
            }
            asm volatile("s_nop 15\n\ts_nop 7" : "+v"(s0[0]), "+v"(s1[0]), "+v"(s0[1]), "+v"(s1[1]));
            if (kt < 64 && var == 0) {
#pragma unroll
                for (int u = 0; u < 2; ++u) { const int gc = 32 * u + r32, c0 = min(max(gc - 8, 0), 48), rowoff = (kt - grw + 7) * 31 - gc + 15;
#pragma unroll
                    for (int r = 0; r < 16; ++r) { const int j0 = crow(r, hi), j1 = j0 + 32;
                        const bool v0 = (unsigned)(j0 - c0) < 16u, v1 = (unsigned)(j1 - c0) < 16u;
                        const float b0 = bias[v0 ? rowoff + j0 : 0], b1 = bias[v1 ? rowoff + j1 : 0];
                        s0[u][r] = v0 ? s0[u][r] + b0 : NEG; s1[u][r] = v1 ? s1[u][r] + b1 : NEG; } }
            } else if (kt < 64 && var == 2) {
                const int dbase = 64 * kt - (rowbase + r32) + 128;
#pragma unroll
                for (int r = 0; r < 16; ++r) { const int j0 = crow(r, hi); const bool v0 = (unsigned)(dbase + j0) <= 256u, v1 = (unsigned)(dbase + j0 + 32) <= 256u;
                    s0[0][r] = v0 ? s0[0][r] : NEG; s1[0][r] = v1 ? s1[0][r] : NEG; s0[1][r] = v0 ? s0[1][r] : NEG; s1[1][r] = v1 ? s1[1][r] : NEG; }
            }
            if (!(VM & 4)) {
            if (!NOREF) {
            float mxa = max3f(s0[0][0], s0[0][1], s1[0][0]), mxb = max3f(s0[1][0], s0[1][1], s1[1][0]);
#pragma unroll
            for (int r = 0; r < 16; r += 2) { if (r) { mxa = max3f(mxa, s0[0][r], s0[0][r + 1]); mxb = max3f(mxb, s0[1][r], s0[1][r + 1]); }
                if (r) { mxa = max3f(mxa, s1[0][r], s1[0][r + 1]); mxb = max3f(mxb, s1[1][r], s1[1][r + 1]); } else { mxa = fmaxf(mxa, s1[0][1]); mxb = fmaxf(mxb, s1[1][1]); } }
            const float mx = xhalf_max(fmaxf(mxa, mxb)) - m;
            if (first || __any(mx > THR)) {
                const float d = first ? fmaxf(mx, -64.0f) : fmaxf(mx, 0.f), alpha = __builtin_amdgcn_exp2f(-d);
                m += d; first = false;
#pragma unroll
                for (int u = 0; u < 2; ++u) {
#pragma unroll
                    for (int r = 0; r < 16; ++r) { o0[u][r] *= alpha; o1[u][r] *= alpha; }
                    lacc[u] *= alpha; }
            }
            }
            }
            bf16x8 pb[2][4];
#pragma unroll
            for (int u = 0; u < 2; ++u) {
                if (!(VM & 4))
#pragma unroll
                for (int r = 0; r < 16; ++r) { s0[u][r] = __builtin_amdgcn_exp2f(NOREF ? s0[u][r] : s0[u][r] - m); s1[u][r] = __builtin_amdgcn_exp2f(NOREF ? s1[u][r] : s1[u][r] - m); lacc[u] += (f32x2){s0[u][r], s1[u][r]}; }
#pragma unroll
                for (int s = 0; s < 2; ++s) {
                    v4u w; w.x = cvtpk(s0[u][8 * s], s0[u][8 * s + 1]); w.y = cvtpk(s0[u][8 * s + 2], s0[u][8 * s + 3]); w.z = cvtpk(s0[u][8 * s + 4], s0[u][8 * s + 5]); w.w = cvtpk(s0[u][8 * s + 6], s0[u][8 * s + 7]);
                    pb[u][s] = __builtin_bit_cast(bf16x8, w);
                    v4u x; x.x = cvtpk(s1[u][8 * s], s1[u][8 * s + 1]); x.y = cvtpk(s1[u][8 * s + 2], s1[u][8 * s + 3]); x.z = cvtpk(s1[u][8 * s + 4], s1[u][8 * s + 5]); x.w = cvtpk(s1[u][8 * s + 6], s1[u][8 * s + 7]);
                    pb[u][2 + s] = __builtin_bit_cast(bf16x8, x);
                }
            }
            if (VM & 1) { asm volatile("" :: "v"(pb[0][0]), "v"(pb[0][1]), "v"(pb[0][2]), "v"(pb[0][3]), "v"(pb[1][0]), "v"(pb[1][1]), "v"(pb[1][2]), "v"(pb[1][3])); } else {
            const LAS unsigned char* vbase = Vb + (4 * hi + ((lane & 15) >> 2)) * VRS + ((lane >> 4) & 1) * 32 + (lane & 3) * 8;
#pragma unroll
            for (int s = 0; s < 4; ++s) {
                const v4i16 a0 = __builtin_amdgcn_ds_read_tr16_b64_v4i16((LAS v4i16*)(vbase + (16 * s) * VRS));
                const v4i16 a1 = __builtin_amdgcn_ds_read_tr16_b64_v4i16((LAS v4i16*)(vbase + (16 * s + 8) * VRS));
                const v4i16 c0_ = __builtin_amdgcn_ds_read_tr16_b64_v4i16((LAS v4i16*)(vbase + (16 * s) * VRS + 64));
                const v4i16 c1_ = __builtin_amdgcn_ds_read_tr16_b64_v4i16((LAS v4i16*)(vbase + (16 * s + 8) * VRS + 64));
                const bf16x8 va = {a0[0], a0[1], a0[2], a0[3], a1[0], a1[1], a1[2], a1[3]};
                const bf16x8 vc = {c0_[0], c0_[1], c0_[2], c0_[3], c1_[0], c1_[1], c1_[2], c1_[3]};
#pragma unroll
                for (int u = 0; u < 2; ++u) { o0[u] = __builtin_amdgcn_mfma_f32_32x32x16_bf16(va, pb[u][s], o0[u], 0, 0, 0); o1[u] = __builtin_amdgcn_mfma_f32_32x32x16_bf16(vc, pb[u][s], o1[u], 0, 0, 0); }
            }
            }
        }
        if (!(VM & 8) && j + 1 < nt) ATT_STORE((j + 1) & 1);
        if (!(VM & 16)) __syncthreads();
    }
#pragma unroll
    for (int u = 0; u < 2; ++u) {
        float l = xhalf_sum(lacc[u].x + lacc[u].y);
        if (has_sink) l += __builtin_amdgcn_exp2f((u == 0 ? sink0 : sink1) - m);
        const float inv = 1.0f / l;
        const int qrow = rowbase + (MODE == 0 ? 32 * u : 0) + r32;
        bf16* orow = Op + (MODE == 1 ? 64 * u : 0) + (size_t)qrow * D;
#pragma unroll
        for (int g = 0; g < 4; ++g) {
            v2u w0; w0.x = pk2(o0[u][4 * g] * inv, o0[u][4 * g + 1] * inv); w0.y = pk2(o0[u][4 * g + 2] * inv, o0[u][4 * g + 3] * inv);
            v2u w1; w1.x = pk2(o1[u][4 * g] * inv, o1[u][4 * g + 1] * inv); w1.y = pk2(o1[u][4 * g + 2] * inv, o1[u][4 * g + 3] * inv);
            *(v2u*)(orow + 8 * g + 4 * hi) = w0; *(v2u*)(orow + 32 + 8 * g + 4 * hi) = w1;
        }
    }
#undef ATT_TROW
#undef ATT_LOAD
#undef ATT_STORE
}

#define ATT_BAR() do { asm volatile("s_waitcnt lgkmcnt(0)" ::: "memory"); __builtin_amdgcn_s_barrier(); asm volatile("" ::: "memory"); } while (0)
template <int N> struct IC { static constexpr int v = N; };
template <int DK, int MODE, int VM = 0>
__device__ __forceinline__ bool unit_h(LAS unsigned char* lds, const bf16* Qp, int qpitch, const bf16* Kp, int kpitch, const bf16* Vp, int vpitch, bf16* Op,
                                       int var, int qt, int lo, int n1, int nt, float qscale, float sink0, float sink1, bool has_sink, const LAS float* bias, const float* t32, volatile LAS unsigned* flag) {
    constexpr int KRS = DK * 2 + 16, NS = DK / 16, CPK = DK / 8;
    int tid = threadIdx.x; asm volatile("" : "+v"(tid)); const int lane = tid & 63, r32 = lane & 31, hi = lane >> 5, wid = __builtin_amdgcn_readfirstlane(tid >> 6);
    const int rowbase = MODE == 0 ? 512 * qt + 64 * wid : 256 * qt + 32 * wid;
    const int kkey0 = tid / CPK, kch0 = tid - kkey0 * CPK, kkey1 = (tid + 512) / CPK, kch1 = (tid + 512) - kkey1 * CPK;
    const int vkey = tid >> 3, vch = tid & 7;
    constexpr int PD = DK == 96 ? 1 : 2;
    v4u kreg0[2], kreg1[2] = {{0u, 0u, 0u, 0u}, {0u, 0u, 0u, 0u}}, vreg[2];
#define ATT_TROW(j) ((((j) < n1) ? (lo + (j)) : (64 + (j) - n1)) * 64)
#define ATT_LOAD(j, S) do { const int tr_ = ATT_TROW(j); kreg0[S] = *(const v4u*)(Kp + (size_t)(tr_ + kkey0) * kpitch + kch0 * 8); \
        if (DK == 96 && tid < 256) kreg1[S] = *(const v4u*)(Kp + (size_t)(tr_ + kkey1) * kpitch + kch1 * 8); \
        vreg[S] = *(const v4u*)(Vp + (size_t)(tr_ + vkey) * vpitch + vch * 8); } while (0)
#define ATT_STORE(bf, S) do { LAS unsigned char* b_ = lds + (bf) * BUF; *(LAS v4u*)(b_ + kkey0 * KRS + kch0 * 16) = kreg0[S]; \
        if (DK == 96 && tid < 256) *(LAS v4u*)(b_ + kkey1 * KRS + kch1 * 16) = kreg1[S]; \
        *(LAS v4u*)(b_ + KBUF + vkey * VRS + vch * 16) = vreg[S]; } while (0)
    ATT_LOAD(0, PD - 1);
    bf16x8 qr[2][NS];
#pragma unroll
    for (int u = 0; u < 2; ++u) {
        const int qrow = rowbase + (MODE == 0 ? 32 * u : 0) + r32;
        const bf16* qp = Qp + (MODE == 1 ? 64 * u : 0) + (size_t)qrow * qpitch;
#pragma unroll
        for (int s = 0; s < NS; ++s) { const v4u raw = *(const v4u*)(qp + 16 * s + 8 * hi); float f[8]; unpack8(raw, f);
#pragma unroll
            for (int i = 0; i < 8; ++i) f[i] *= qscale;
            if (DK == 96 && s >= 4) { float p[8];
#pragma unroll
                for (int i = 0; i < 8; ++i) p[i] = __shfl_xor(f[i], 32);
                rope8(f, p, t32 + ((size_t)((s == 4 ? (qrow >> 6) : (qrow & 63)) * 8)) * 2, hi == 0); }
            qr[u][s] = __builtin_bit_cast(bf16x8, pack8(f)); }
    }
    f32x2 lacc[2] = {{0.f, 0.f}, {0.f, 0.f}}; f32x16 o0[2] = {{}, {}}, o1[2] = {{}, {}};
    const int grw = 8 * qt + wid, r0w = min(max(grw - 4, 0), 56), i0w = rowbase;
    ATT_STORE(0, PD - 1);
    if (PD == 2 && nt > 1) ATT_LOAD(1, 1);
    if (tid == 0) *flag = 0u;
    ATT_BAR();
    auto tile = [&](const int j, auto LS) __attribute__((always_inline)) {
        constexpr int SL = decltype(LS)::v, SS = PD == 1 ? SL : (SL ^ 1);
        if (j + PD < nt) ATT_LOAD(j + PD, SL);
        const int kt = ATT_TROW(j) >> 6;
        bool actv = true;
        if (kt < 64) { if (var == 0) actv = (kt >= r0w) && (kt <= r0w + 7); else if (var == 2) actv = !((64 * kt - (i0w + 31) > 128) || (i0w - (64 * kt + 63) > 128)); }
        if (actv) {
        const LAS unsigned char* Kb = lds + (j & 1) * BUF; const LAS unsigned char* Vb = Kb + KBUF;
        const LAS unsigned char* vbase = Vb + (4 * hi + ((lane & 15) >> 2)) * VRS + ((lane >> 4) & 1) * 32 + (lane & 3) * 8;
#pragma unroll
        for (int hf = 0; hf < 2; ++hf) {
            f32x16 sc[2] = {{}, {}};
#pragma unroll
            for (int s = 0; s < NS; ++s) {
                const bf16x8 kf = *(const LAS bf16x8*)(Kb + (32 * hf + r32) * KRS + (16 * s + 8 * hi) * 2);
#pragma unroll
                for (int u = 0; u < 2; ++u) sc[u] = __builtin_amdgcn_mfma_f32_32x32x16_bf16(kf, qr[u][s], sc[u], 0, 0, 0);
            }
            if (kt < 64 && var == 0) {
#pragma unroll
                for (int u = 0; u < 2; ++u) { const int gc = 32 * u + r32, c0 = min(max(gc - 8, 0), 48), rowoff = (kt - grw + 7) * 31 - gc + 15;
                    const LAS unsigned char* bb = (const LAS unsigned char*)(bias + rowoff + 4 * hi); asm volatile("" : "+v"(bb));
                    float bv[16];
#pragma unroll
                    for (int r = 0; r < 16; ++r) bv[r] = *(const LAS float*)(bb + 4 * (32 * hf + (r & 3) + 8 * (r >> 2)));
                    asm volatile("" : "+v"(bv[0]), "+v"(bv[1]), "+v"(bv[2]), "+v"(bv[3]), "+v"(bv[4]), "+v"(bv[5]), "+v"(bv[6]), "+v"(bv[7]),
                                      "+v"(bv[8]), "+v"(bv[9]), "+v"(bv[10]), "+v"(bv[11]), "+v"(bv[12]), "+v"(bv[13]), "+v"(bv[14]), "+v"(bv[15]));
#pragma unroll
                    for (int r = 0; r < 16; ++r) { const int jj = 32 * hf + crow(r, hi); const bool v = (unsigned)(jj - c0) < 16u; sc[u][r] = v ? sc[u][r] + bv[r] : NEG; } }
            } else if (kt < 64 && var == 2) {
                const int dbase = 64 * kt - (rowbase + r32) + 128;
#pragma unroll
                for (int r = 0; r < 16; ++r) { const bool v = (unsigned)(dbase + 32 * hf + crow(r, hi)) <= 256u; sc[0][r] = v ? sc[0][r] : NEG; sc[1][r] = v ? sc[1][r] : NEG; }
            }
            bf16x8 pb[2][2];
#pragma unroll
            for (int u = 0; u < 2; ++u) {
#pragma unroll
                for (int r = 0; r < 16; r += 2) { sc[u][r] = __builtin_amdgcn_exp2f(sc[u][r]); sc[u][r + 1] = __builtin_amdgcn_exp2f(sc[u][r + 1]); lacc[u] += (f32x2){sc[u][r], sc[u][r + 1]}; }
#pragma unroll
                for (int s = 0; s < 2; ++s) {
                    v4u w; w.x = cvtpk(sc[u][8 * s], sc[u][8 * s + 1]); w.y = cvtpk(sc[u][8 * s + 2], sc[u][8 * s + 3]); w.z = cvtpk(sc[u][8 * s + 4], sc[u][8 * s + 5]); w.w = cvtpk(sc[u][8 * s + 6], sc[u][8 * s + 7]);
                    pb[u][s] = __builtin_bit_cast(bf16x8, w);
                }
            }
#pragma unroll
            for (int s2 = 0; s2 < 2; ++s2) { const int s = 2 * hf + s2;
                const v4i16 a0 = __builtin_amdgcn_ds_read_tr16_b64_v4i16((LAS v4i16*)(vbase + (16 * s) * VRS));
                const v4i16 a1 = __builtin_amdgcn_ds_read_tr16_b64_v4i16((LAS v4i16*)(vbase + (16 * s + 8) * VRS));
                const v4i16 c0_ = __builtin_amdgcn_ds_read_tr16_b64_v4i16((LAS v4i16*)(vbase + (16 * s) * VRS + 64));
                const v4i16 c1_ = __builtin_amdgcn_ds_read_tr16_b64_v4i16((LAS v4i16*)(vbase + (16 * s + 8) * VRS + 64));
                const bf16x8 va = {a0[0], a0[1], a0[2], a0[3], a1[0], a1[1], a1[2], a1[3]};
                const bf16x8 vc = {c0_[0], c0_[1], c0_[2], c0_[3], c1_[0], c1_[1], c1_[2], c1_[3]};
#pragma unroll
                for (int u = 0; u < 2; ++u) { o0[u] = __builtin_amdgcn_mfma_f32_32x32x16_bf16(va, pb[u][s2], o0[u], 0, 0, 0); o1[u] = __builtin_amdgcn_mfma_f32_32x32x16_bf16(vc, pb[u][s2], o1[u], 0, 0, 0); }
            }
            __builtin_amdgcn_sched_barrier(0);
        }
        }
        if (j + 1 < nt) ATT_STORE((j + 1) & 1, SS);
        ATT_BAR();
    };
    if (PD == 1) { for (int j = 0; j < nt; ++j) tile(j, IC<0>{}); }
    else { for (int j = 0; j < nt; j += 2) { tile(j, IC<0>{}); if (j + 1 < nt) tile(j + 1, IC<1>{}); } }
    float lsum[2]; bool bad = false;
#pragma unroll
    for (int u = 0; u < 2; ++u) { lsum[u] = xhalf_sum(lacc[u].x + lacc[u].y); bad = bad || !(lsum[u] > 8.6736174e-19f && lsum[u] < 1.1529215e18f);
        if (has_sink) { lsum[u] += __builtin_amdgcn_exp2f(u == 0 ? sink0 : sink1); bad = bad || !(lsum[u] < 1.1529215e18f); } }
    if (__any(bad)) { if (lane == 0) *flag = 1u; }
#pragma unroll
    for (int u = 0; u < 2; ++u) {
        const float inv = __builtin_amdgcn_rcpf(lsum[u]);
        bf16* orow = Op + (MODE == 1 ? 64 * u : 0) + (size_t)(rowbase + (MODE == 0 ? 32 * u : 0) + r32) * D;
#pragma unroll
        for (int g = 0; g < 4; ++g) {
            v2u w0; w0.x = pk2(o0[u][4 * g] * inv, o0[u][4 * g + 1] * inv); w0.y = pk2(o0[u][4 * g + 2] * inv, o0[u][4 * g + 3] * inv);
            v2u w1; w1.x = pk2(o1[u][4 * g] * inv, o1[u][4 * g + 1] * inv); w1.y = pk2(o1[u][4 * g + 2] * inv, o1[u][4 * g + 3] * inv);
            *(v2u*)(orow + 8 * g + 4 * hi) = w0; *(v2u*)(orow + 32 + 8 * g + 4 * hi) = w1;
        }
    }
    ATT_BAR();
    return *flag == 0u;
#undef ATT_TROW
#undef ATT_LOAD
#undef ATT_STORE
}
}

template <int VM = 0>
__device__ __forceinline__ void phase_attn(const Frame& F, int lq) {
    const int l = lq & 3;
    const bf16* P = (const bf16*)(F.ws + WS_PB); const bf16* QD = (const bf16*)(F.ws + WS_QD); const bf16* KD = (const bf16*)(F.ws + WS_KD);
    const bf16* VD = (const bf16*)(F.ws + WS_VD); bf16* O = (bf16*)(F.ws + (lq >= 4 ? WS_ACT : WS_HA));
    unsigned* ctr = (unsigned*)(F.ws + WS_CTL) + CW_QUEUE + 64 * 8 * lq;
    LAS float* bias = (LAS float*)(F.lds + att::BIAS_OFF);
    { const float* nab = INP(I_NABIAS) + l * 4 * 465; for (int i = F.tid; i < 4 * 465; i += NTHR) bias[i] = nab[i] * LOG2E; }
    const float* sinks = INP(I_SINK) + l * 4;
    __syncthreads();
    const float* t32 = (const float*)(F.ws + WS_T32);
    volatile LAS unsigned* flag = F.MISC + MI_Q + 1;
    const int nloc = 256 + (l < NL - 1 ? 24 : 0);
    const int q0 = (int)xb_xcc_id();
    for (int qq = 0; qq < 8; ++qq) {
      const int q = (q0 + qq) & 7;
      unsigned* qctr = ctr + 64 * q;
      for (;;) {
        if (F.tid == 0) F.MISC[MI_Q] = __hip_atomic_fetch_add(qctr, 1u, __ATOMIC_RELAXED, __HIP_MEMORY_SCOPE_AGENT);
        ATT_BAR();
        const int li = (int)F.MISC[MI_Q];
        ATT_BAR();
        if (li >= nloc) break;
        int idx;
        if (li < 64) idx = (q + 8 * (li >> 3)) * 8 + (li & 7);
        else if (li < 128) { const int jx = li - 64; idx = 1024 + (q + 8 * (jx >> 4)) * 16 + (jx & 15); }
        else if (li < 192) { const int jx = li - 128; idx = 1536 + (q + 8 * (jx >> 3)) * 8 + (jx & 7); }
        else if (li < 256) { const int jx = li - 192; idx = 2048 + (q + 8 * (jx >> 4)) * 16 + (jx & 15); }
        else if (li < 264) idx = 2560 + q + 8 * (li - 256);
        else idx = 2624 + q + 8 * (li - 264);
        if (idx < 512) {
            const int b = idx >> 5, h = (idx >> 3) & 3, qt = idx & 7; const size_t rb = (size_t)b * TT;
            if (!att::unit_h<96, 0, VM>(F.lds, QD + rb * 384 + h * 96, 384, KD + rb * 384 + h * 96, 384, VD + rb * 256 + h * 64, 256, O + rb * D + 768 + h * 64, 3, qt, 0, 64, 68, 0.10206207261596575f * LOG2E, 0.f, 0.f, false, bias, t32, flag)) {
                __syncthreads();
#pragma unroll 1
                for (int k2 = 0; k2 < 2; ++k2)
                    att::unit<96, VM>(F.lds, QD + rb * 384 + h * 96, 384, KD + rb * 384 + h * 96, 384, VD + rb * 256 + h * 64, 256, O + rb * D + 768 + h * 64, 3, 2 * qt + k2, 0, 64, 68, 0.10206207261596575f * LOG2E, 0.f, false, bias, t32, nullptr);
            }
        } else if (idx < 1024) {
        } else if (idx < 2560) {
            idx -= 1024;
            const int grp = idx >> 9, rem = idx & 511, b = rem >> 5; const size_t rb = (size_t)b * TT;
            if (grp == 1) {
                const int h = (rem >> 3) & 3, qt = rem & 7; const int lo = min(max(8 * qt - 4, 0), 56), n1 = min(max(8 * qt + 3, 0), 56) + 7 - lo + 1;
                if (!att::unit_h<64, 0, VM>(F.lds, P + rb * NPJ + h * 64, NPJ, P + rb * NPJ + 256 + h * 64, NPJ, P + rb * NPJ + 512 + h * 64, NPJ, O + rb * D + h * 64, 0, qt, lo, n1, n1 + 4, 0.125f * LOG2E, 0.f, 0.f, false, bias + h * 465, t32, flag)) { __syncthreads();
                att::unit2<64, 0, VM>(F.lds, P + rb * NPJ + h * 64, NPJ, P + rb * NPJ + 256 + h * 64, NPJ, P + rb * NPJ + 512 + h * 64, NPJ, O + rb * D + h * 64, 0, qt, lo, n1, n1 + 4,
                                  0.125f * LOG2E, 0.f, 0.f, false, bias + h * 465, t32); }
            } else {
                const int g = (rem >> 4) & 1, qt = rem & 15; const bool isc = grp == 2;
                const int lo = isc ? max(4 * qt - 2, 0) : 0, n1 = isc ? min(4 * qt + 5, 63) - lo + 1 : 64;
                const int qc = (isc ? 1280 : 768) + g * 128, kc = (isc ? 1536 : 1024) + g * 64, vc = (isc ? 1664 : 1152) + g * 64;
                const float sk0 = isc ? sinks[2 * g] * LOG2E : 0.f, sk1 = isc ? sinks[2 * g + 1] * LOG2E : 0.f;
                if (!att::unit_h<64, 1, VM>(F.lds, P + rb * NPJ + qc, NPJ, P + rb * NPJ + kc, NPJ, P + rb * NPJ + vc, NPJ, O + rb * D + (isc ? 512 : 256) + g * 128, isc ? 2 : 1, qt, lo, n1, n1 + 4, 0.125f * LOG2E, sk0, sk1, isc, bias, t32, flag)) { __syncthreads();
                att::unit2<64, 1, VM>(F.lds, P + rb * NPJ + qc, NPJ, P + rb * NPJ + kc, NPJ, P + rb * NPJ + vc, NPJ, O + rb * D + (isc ? 512 : 256) + g * 128, isc ? 2 : 1, qt, lo, n1, n1 + 4,
                                  0.125f * LOG2E, isc ? sinks[2 * g] * LOG2E : 0.f, isc ? sinks[2 * g + 1] * LOG2E : 0.f, isc, bias, t32); }
            }
        } else if (idx < 2624) {
            const int rem = idx - 2560, b = rem >> 2, isc = (rem >> 1) & 1, g = rem & 1; const size_t rb = (size_t)b * TT;
            const int qc = (isc ? 1280 : 768) + g * 128, kc = (isc ? 1536 : 1024) + g * 64, vc = (isc ? 1664 : 1152) + g * 64;
            att::unit2<64, 1, VM>(F.lds, P + rb * NPJ + qc, NPJ, P + rb * NPJ + kc, NPJ, P + rb * NPJ + vc, NPJ, O + rb * D + (isc ? 512 : 256) + g * 128, isc ? 2 : 1, 16, 0, 0, 4,
                              0.125f * LOG2E, isc ? sinks[2 * g] * LOG2E : 0.f, isc ? sinks[2 * g + 1] * LOG2E : 0.f, isc != 0, bias, t32);
        } else {
            const int rem = idx - 2624, b = rem >> 3, isd = (rem >> 2) & 1, h = rem & 3; const size_t rb = (size_t)b * TT;
            if (isd) att::unit<96, VM>(F.lds, QD + rb * 384 + h * 96, 384, KD + rb * 384 + h * 96, 384, VD + rb * 256 + h * 64, 256, O + rb * D + 768 + h * 64, 3, 16, 0, 0, 4, 0.10206207261596575f * LOG2E, 0.f, false, bias, t32, nullptr);
            else att::unit<64, VM>(F.lds, P + rb * NPJ + h * 64, NPJ, P + rb * NPJ + 256 + h * 64, NPJ, P + rb * NPJ + 512 + h * 64, NPJ, O + rb * D + h * 64, 0, 16, 0, 0, 4, 0.125f * LOG2E, 0.f, false, bias + h * 465, nullptr, nullptr);
        }
    }
    }
}


#define PHASE_FN static __device__ __forceinline__ void
PHASE_FN ph_prologue(GAS unsigned char* ws) { const Frame F = make_frame(ws); phase_prologue(F); }
PHASE_FN ph_ln(GAS unsigned char* ws, int l) { const Frame F = make_frame(ws); phase_ln(F, l); }
PHASE_FN ph_gemm_in(GAS unsigned char* ws, int l) {
    const Frame F = make_frame(ws);
    pg8::Gemm g{(const bf16*)(F.ws + WS_HA), (const bf16*)(F.ws + WS_WIN), M, NPJ, D, D, nullptr}; pg8::StaticOrder S; S.init(M, NPJ, F.G, F.bid);
    pg8::EpiBf16NT<0> E{(bf16*)(F.ws + WS_PB), NPJ, nullptr, 0, 0, 1.f};
    pg8::gemm_phase<pg8::EpiBf16NT<0>, pg8::StaticOrder, true, true>(F.lds, g, S, E);
}
PHASE_FN ph_post(GAS unsigned char* ws, int l) { const Frame F = make_frame(ws); phase_post(F, l); }
PHASE_FN ph_gemm_mla(GAS unsigned char* ws, int l) {
    const Frame F = make_frame(ws);
    pg8::Gemm g{(const bf16*)(F.ws + WS_PB) + 1792, (const bf16*)(F.ws + WS_WD), M, 1024, 384, NPJ, nullptr}; pg8::StaticOrder S; S.init(M, 1024, F.G, F.bid);
    EpiMla E{(bf16*)(F.ws + WS_QD), (bf16*)(F.ws + WS_KD), (bf16*)(F.ws + WS_VD)};
    pg8::gemm_phase<EpiMla, pg8::StaticOrder, true, true>(F.lds, g, S, E);
}
template <int VM>
PHASE_FN ph_attn(GAS unsigned char* ws, int l) { const Frame F = make_frame(ws); phase_attn<VM>(F, l); }
PHASE_FN ph_gemm_out(GAS unsigned char* ws, int l) {
    const Frame F = make_frame(ws);
    pg8::Gemm g{(const bf16*)(F.ws + WS_HA), (const bf16*)(F.ws + WS_WOUT), M, D, D, D, nullptr};
    pg8::EpiBf16NT<0> E{(bf16*)(F.ws + WS_PB), D, nullptr, 0, 0, 1.f};
    if (l == NL - 1) { LatOrder S{F.G, F.bid}; pg8::gemm_phase<pg8::EpiBf16NT<0>, LatOrder, true, true>(F.lds, g, S, E); }
    else { pg8::StaticOrder S; S.init(M, D, F.G, F.bid); pg8::gemm_phase<pg8::EpiBf16NT<0>, pg8::StaticOrder, true, true>(F.lds, g, S, E); }
}
PHASE_FN ph_route(GAS unsigned char* ws, int l) { const Frame F = make_frame(ws); phase_route(F, l); }
PHASE_FN ph_permute(GAS unsigned char* ws, int l) { const Frame F = make_frame(ws); phase_permute(F, l); }
PHASE_FN ph_gemm_gu(GAS unsigned char* ws, int l) {
    const Frame F = make_frame(ws);
    moe_tables(F);
    pg8::Gemm g{(const bf16*)(F.ws + WS_HA), (const bf16*)(F.ws + WS_WGU), MS, 16384, D, D, (const int*)(F.ws + WS_QD)}; MoeOrder S{F.MISC + MI_PST, F.G, F.bid};
    EpiGU E{(bf16*)(F.ws + WS_ACT)};
    pg8::gemm_phase<EpiGU, MoeOrder, true, true, true>(F.lds, g, S, E);
}
PHASE_FN ph_gemm_dn(GAS unsigned char* ws, int l) {
    const Frame F = make_frame(ws);
    moe_tables(F);
    pg8::Gemm g{(const bf16*)(F.ws + WS_ACT), (const bf16*)(F.ws + WS_WDN), MS, 16384, 512, 512, nullptr}; MoeOrder S{F.MISC + MI_PST, F.G, F.bid};
    pg8::EpiBf16NT<0> E{(bf16*)(F.ws + WS_PB), D, nullptr, 1024, 0, 1.f};
    pg8::gemm_phase<pg8::EpiBf16NT<0>, MoeOrder, true, true>(F.lds, g, S, E);
}


#if MK_DEBUG
#ifndef DBG_MODE
#define DBG_MODE 0
#endif
__device__ __forceinline__ float oracle_attn(const Frame& F, int l, int r, int var, int h, int mode = 0) {
    const bf16* P = (const bf16*)(F.ws + WS_PB); const bf16* QD = (const bf16*)(F.ws + WS_QD); const bf16* KD = (const bf16*)(F.ws + WS_KD); const bf16* VD = (const bf16*)(F.ws + WS_VD);
    const bf16* O = (const bf16*)(F.ws + WS_HA); const float* t32 = (const float*)(F.ws + WS_T32);
    const int b = r / TT, t = r - b * TT; const bool lat = t < SEQ; const size_t rb = (size_t)b * TT;
    const int dk = var == 3 ? 96 : 64;
    const bf16* qp; const bf16* kp; const bf16* vp; int kpitch, vpitch;
    if (var == 3) { qp = QD + (size_t)r * 384 + h * 96; kp = KD + rb * 384 + h * 96; kpitch = 384; vp = VD + rb * 256 + h * 64; vpitch = 256; }
    else { const int qc = var == 0 ? h * 64 : var == 1 ? 768 + h * 64 : 1280 + h * 64, kc = var == 0 ? 256 + h * 64 : var == 1 ? 1024 + (h >> 1) * 64 : 1536 + (h >> 1) * 64,
           vc = var == 0 ? 512 + h * 64 : var == 1 ? 1152 + (h >> 1) * 64 : 1664 + (h >> 1) * 64;
           qp = P + (size_t)r * NPJ + qc; kp = P + rb * NPJ + kc; kpitch = NPJ; vp = P + rb * NPJ + vc; vpitch = NPJ; }
    LAS float* qs = (LAS float*)(F.lds + 65536) + F.wave * 128;
    for (int d = F.lane; d < dk; d += 64) qs[d] = __builtin_bit_cast(float, (unsigned)qp[d] << 16);
    asm volatile("s_waitcnt lgkmcnt(0)" ::: "memory");
    if (var == 3 && lat && F.lane < 32) {
        const int c = F.lane >> 3, e = F.lane & 7, gr = t >> 6, gc = t & 63; const float own = qs[64 + F.lane], par = qs[64 + (F.lane ^ 8)];
        const float cs = t32[((c < 2 ? gr : gc) * 8 + e) * 2], sn = t32[((c < 2 ? gr : gc) * 8 + e) * 2 + 1];
        const float nv = (c & 1) == 0 ? own * cs - par * sn : par * sn + own * cs;
        asm volatile("s_waitcnt lgkmcnt(0)" ::: "memory"); qs[64 + F.lane] = nv; }
    asm volatile("s_waitcnt lgkmcnt(0)" ::: "memory");
    const float scale = var == 3 ? 0.10206207261596575f : 0.125f;
    const int gr = t >> 6, gc = t & 63, r0 = min(max(gr - 4, 0), 56), c0 = min(max(gc - 8, 0), 48);
    float m = -3.0e38f, lsum = 0.f, acc[64];
#pragma unroll
    for (int d = 0; d < 64; ++d) acc[d] = 0.f;
    for (int j = F.lane; j < TT; j += 64) {
        bool ok = true; float bias = 0.f;
        if (!lat) ok = j >= SEQ;
        else if (j < SEQ) {
            if (var == 0) { const int kr = j >> 6, kc2 = j & 63; ok = kr >= r0 && kr <= r0 + 7 && kc2 >= c0 && kc2 <= c0 + 15;
                if (ok) bias = INP(I_NABIAS)[((l * 4 + h) * 15 + (kr - gr + 7)) * 31 + (kc2 - gc + 15)]; }
            else if (var == 2) ok = (j - t <= 128) && (t - j <= 128);
        }
        if (!ok) continue;
        float sc = 0.f; const bf16* kr_ = kp + (size_t)j * kpitch;
        for (int d = 0; d < dk; ++d) sc += qs[d] * __builtin_bit_cast(float, (unsigned)kr_[d] << 16);
        sc = sc * scale + bias;
        const float mn = fmaxf(m, sc), a = expf(m - mn), p = expf(sc - mn); m = mn; lsum = lsum * a + p;
        const bf16* vr = vp + (size_t)j * vpitch;
#pragma unroll
        for (int d = 0; d < 64; ++d) acc[d] = acc[d] * a + p * __builtin_bit_cast(float, (unsigned)vr[d] << 16);
    }
    float mg = m;
#pragma unroll
    for (int o = 1; o < 64; o <<= 1) mg = fmaxf(mg, __shfl_xor(mg, o));
    if (mode >= 1) {
        const unsigned* rec = (const unsigned*)(F.ws + WS_RS) + (size_t)r * 2; const float mk = __builtin_bit_cast(float, rec[0]), lk = __builtin_bit_cast(float, rec[1]);
        const float lref = wave_sum(lsum * expf(m - mg));
        const float lker = lk * exp2f(mk - mg * LOG2E);
        if (mode == 2) return fabsf(mk / LOG2E - mg);
        return fabsf(lker / lref - 1.0f);
    }
    const float f = expf(m - mg); lsum *= f; lsum = wave_sum(lsum);
    if (var == 2) lsum += expf(INP(I_SINK)[l * 4 + h] - mg);
    float err = 0.f, mag = 1.0e-6f;
    const bf16* orow = O + (size_t)r * D + var * 256 + h * 64;
#pragma unroll
    for (int d = 0; d < 64; ++d) { const float ref = wave_sum(acc[d] * f) / lsum; const float got = __builtin_bit_cast(float, (unsigned)orow[d] << 16);
        const float df = fabsf(got - ref); err = (df == df) ? fmaxf(err, df) : 1.0e30f; mag = fmaxf(mag, fabsf(ref)); }
    return err / mag;
}
__device__ __forceinline__ void phase_dump(const Frame& F, int code) {
    float* out = (float*)ptab_get(F, I_OUT);
    for (int r = F.gw; r < M; r += F.ngw) {
        const int b = r / TT, t = r - b * TT; if (t >= SEQ) continue;
        float v[16];
        if (code == 1) ld16bf((const bf16*)(F.ws + WS_HA) + (size_t)r * D, F.lane, v);
        else if (code == 2) ld16bf((const bf16*)(F.ws + WS_PB) + (size_t)r * NPJ, F.lane, v);
        else if (code == 3) ld16bf((const bf16*)(F.ws + WS_PB) + (size_t)r * NPJ + 1024, F.lane, v);
        else if (code == 4) ld16bf((const bf16*)(F.ws + WS_PB) + (size_t)r * NPJ + 1280, F.lane, v);
        else if (code == 5) ld16((const float*)(F.ws + WS_PB) + (size_t)r * D, F.lane, v);
        else if (code == 8) {
            const v4u w0 = *((const v4u*)((const bf16*)(F.ws + WS_HA) + (size_t)r * D) + F.lane), w1 = *((const v4u*)((const bf16*)(F.ws + WS_HA) + (size_t)r * D) + 64 + F.lane);
            float f[8]; int bad0 = 0, bad1 = 0; unpack8(w0, f);
#pragma unroll
            for (int i = 0; i < 8; ++i) { const unsigned u = __builtin_bit_cast(unsigned, f[i]); bad0 |= ((u & 0x7f800000u) == 0x7f800000u) ? 1 : 0; }
            unpack8(w1, f);
#pragma unroll
            for (int i = 0; i < 8; ++i) { const unsigned u = __builtin_bit_cast(unsigned, f[i]); bad1 |= ((u & 0x7f800000u) == 0x7f800000u) ? 1 : 0; }
            const unsigned long long m0 = __ballot(bad0), m1 = __ballot(bad1);
            const bool vA = (m0 & 0xffffffffull) != 0, vB = (m0 >> 32) != 0, vC = (m1 & 0xffffffffull) != 0, vD = (m1 >> 32) != 0;
            const float val = (float)(t + 1) * ((vA ? 1.0f : 0.f) + (vB ? 1.0e2f : 0.f) + (vC ? 1.0e4f : 0.f) + (vD ? 1.0e6f : 0.f));
#pragma unroll
            for (int i = 0; i < 16; ++i) v[i] = val;
        }
        else if (code == 9) { const unsigned cd = ((const unsigned*)(F.ws + WS_RS))[(size_t)r * 2]; float val = 0.f; if (cd) { val = 1.f; for (unsigned k = 0; k < cd; ++k) val *= 10.f; }
#pragma unroll
            for (int i = 0; i < 16; ++i) v[i] = val; }
        else if (code == 10) {
            const v4u w1 = *((const v4u*)((const bf16*)(F.ws + WS_HA) + (size_t)r * D) + 64 + F.lane);
            float f[8]; int bad1 = 0; unpack8(w1, f);
#pragma unroll
            for (int i = 0; i < 8; ++i) { const unsigned u = __builtin_bit_cast(unsigned, f[i]); bad1 |= ((u & 0x7f800000u) == 0x7f800000u) ? 1 : 0; }
            const bool vC = (__ballot(bad1) & 0xffffffffull) != 0;
            const bf16* pc = (const bf16*)(F.ws + WS_PB) + ((size_t)b * TT + SEQ + (t & 255)) * NPJ; int badp = 0;
            for (int c = F.lane; c < 288; c += 64) { const v4u w = *((const v4u*)pc + c); unpack8(w, f);
#pragma unroll
                for (int i = 0; i < 8; ++i) { const unsigned u = __builtin_bit_cast(unsigned, f[i]); badp |= ((u & 0x7f800000u) == 0x7f800000u) ? 1 : 0; } }
            float val = 0.f; if (vC) { val = 1.f; for (int k = 0; k <= (t & 15); ++k) val *= 10.f; }
            if (__any(badp)) val = 1.0e30f;
#pragma unroll
            for (int i = 0; i < 16; ++i) v[i] = val;
        }
        else if (code == 11) {
            const bf16* pr = (const bf16*)(F.ws + WS_PB) + (size_t)r * NPJ; int grp = -1;
            for (int c = F.lane; c < 288; c += 64) { const v4u w = *((const v4u*)pr + c); float f[8]; unpack8(w, f);
#pragma unroll
                for (int i = 0; i < 8; ++i) if (!(fabsf(f[i]) < 1.0e4f)) grp = (c * 8) >> 8; }
#pragma unroll
            for (int o = 1; o < 64; o <<= 1) { const int g2 = __shfl_xor(grp, o); grp = g2 > grp ? g2 : grp; }
            float val = 0.f; if (grp >= 0) { val = 100.f; for (int k = 0; k < grp; ++k) val *= 10.f; }
#pragma unroll
            for (int i = 0; i < 16; ++i) v[i] = val;
        }
        else if (code >= 20 && code < 24) {
            float val = 0.f;
            if ((t & 15) == 5) { for (int h = 0; h < 4; ++h) { const float e = oracle_attn(F, 0, r, code - 20, h); const float cls = e > 1.0e20f ? 3.f : e > 0.5f ? 2.f : e > 0.03f ? 1.f : 0.f; if (cls > 0.f) { float w = cls; for (int k = 0; k <= h; ++k) w *= 10.f; val = fmaxf(val, w); } } }
#pragma unroll
            for (int i = 0; i < 16; ++i) v[i] = val;
        }
        else if (code >= 30 && code < 46) {
            float val = 0.f;
            if ((t & 15) == 5) { const float e = oracle_attn(F, 0, r, (code - 30) >> 2, (code - 30) & 3, DBG_MODE); val = e > 10.f ? 1.0e4f : 1000.f * e; }
#pragma unroll
            for (int i = 0; i < 16; ++i) v[i] = val;
        }
        else if (code == 7) {
            auto bad16 = [&](const bf16* p, int nchunks) { int bad = 0; for (int c = F.lane; c < nchunks; c += 64) { const v4u w = *((const v4u*)p + c); float f[8]; unpack8(w, f);
#pragma unroll
                for (int i = 0; i < 8; ++i) { const unsigned u = __builtin_bit_cast(unsigned, f[i]); bad |= ((u & 0x7f800000u) == 0x7f800000u) ? 1 : 0; } } return __any(bad); };
            const int bP = bad16((const bf16*)(F.ws + WS_PB) + (size_t)r * NPJ, 288), bQ = bad16((const bf16*)(F.ws + WS_QD) + (size_t)r * 384, 48),
                      bK = bad16((const bf16*)(F.ws + WS_KD) + (size_t)r * 384, 48), bV = bad16((const bf16*)(F.ws + WS_VD) + (size_t)r * 256, 32), bO = bad16((const bf16*)(F.ws + WS_HA) + (size_t)r * D, 128);
            const float val = bP ? 1.0e6f : bQ ? 1.0e5f : bK ? 1.0e4f : bV ? 1.0e3f : bO ? 1.0e2f : 0.f;
#pragma unroll
            for (int i = 0; i < 16; ++i) v[i] = val;
        }
#pragma unroll
        for (int i = 0; i < 16; ++i) { const unsigned u = __builtin_bit_cast(unsigned, v[i]); if ((u & 0x7f800000u) == 0x7f800000u) v[i] = 777.0f; }
        st16(out + ((size_t)b * SEQ + t) * D, F.lane, v);
    }
}
static __device__ __forceinline__ void ph_dump(GAS unsigned char* ws, int code) { const Frame F = make_frame(ws); phase_dump(F, code); }
#endif
__global__ void __launch_bounds__(NTHR, 2) mk_fwd(Args args) {
    extern __shared__ __attribute__((aligned(16))) unsigned char lds_raw[];
    LAS unsigned char* lds = (LAS unsigned char*)lds_raw; volatile LAS unsigned* MISC = (volatile LAS unsigned*)(lds + MISC_OFF);
    const int tid = threadIdx.x;
    GAS unsigned char* ws = (GAS unsigned char*)args.ws;
    for (int u = tid; u < (LDS_BYTES - MISC_OFF) / 4; u += NTHR) MISC[u] = 0u;
    __syncthreads();
    if (tid < 28) { const unsigned long long p = tid < 27 ? (unsigned long long)args.in[tid] : (unsigned long long)args.out;
        LAS unsigned* t = (LAS unsigned*)(lds + PTAB_OFF) + 2 * tid; t[0] = (unsigned)p; t[1] = (unsigned)(p >> 32); }
    __syncthreads();
#if MK_MULTI
#define GRID_BAR() do { } while (0)
#else
    XcdBarrier bar = xcd_barrier_post((unsigned*)(ws + WS_CTL) + CW_BAR, MISC + MI_BAR);
#define GRID_BAR() xcd_barrier(bar)
#endif
    const int lo = args.ph_lo, hi = args.ph_hi;
#define IN(k) (lo <= (k) && (k) < hi)
#if MK_TIME
    unsigned long long tcat = 0ull, tb0 = 0ull;
#define TBEG() do { tb0 = __builtin_amdgcn_s_memrealtime(); } while (0)
#define TEND(c) do { if ((c) == MK_TIME - 1) tcat += __builtin_amdgcn_s_memrealtime() - tb0; } while (0)
#define SEAM(k) do { if (IN(k) && IN((k) + 1)) { TBEG(); GRID_BAR(); TEND(1); } } while (0)
#else
#define TBEG() do { } while (0)
#define TEND(c) do { } while (0)
#define SEAM(k) do { if (IN(k) && IN((k) + 1)) GRID_BAR(); } while (0)
#endif

#if MK_DEBUG
    if (lo >= 100) { ph_dump(ws, lo - 100); return; }
#endif
    if (IN(0)) { TBEG(); ph_prologue(ws); TEND(2); } SEAM(0);
    for (int l = 0; l < NL; ++l) {
        const int pb = 1 + 10 * l;
        if (IN(pb + 0)) { TBEG(); ph_ln(ws, l); TEND(0); } SEAM(pb + 0);
        if (IN(pb + 1)) { TBEG(); ph_gemm_in(ws, l); if (MK_DUP & 2) { GRID_BAR(); ph_gemm_in(ws, l); } TEND(3); } SEAM(pb + 1);
        if (IN(pb + 2)) { TBEG(); ph_post(ws, l); TEND(0); } SEAM(pb + 2);
        if (IN(pb + 3)) { TBEG(); ph_gemm_mla(ws, l); if (MK_DUP & 8) { GRID_BAR(); ph_gemm_mla(ws, l); } TEND(3); } SEAM(pb + 3);
        if (IN(pb + 4)) { TBEG(); ph_attn<0>(ws, l); if (MK_DUP & 16) { GRID_BAR(); ph_attn<MK_VM>(ws, l + 4); } TEND(4); } SEAM(pb + 4);
        if (IN(pb + 5)) { TBEG(); ph_gemm_out(ws, l); if (MK_DUP & 32) { GRID_BAR(); ph_gemm_out(ws, l); } TEND(3); } SEAM(pb + 5);
        if (IN(pb + 6)) { TBEG(); ph_route(ws, l); TEND(0); } SEAM(pb + 6);
        if (IN(pb + 7)) { TBEG(); ph_permute(ws, l); if (MK_DUP & 128) { GRID_BAR(); ph_permute(ws, l); } TEND(0); } SEAM(pb + 7);
        if (IN(pb + 8)) { TBEG(); ph_gemm_gu(ws, l); if (MK_DUP & 256) { GRID_BAR(); ph_gemm_gu(ws, l); } TEND(3); } SEAM(pb + 8);
        if (IN(pb + 9)) { TBEG(); ph_gemm_dn(ws, l); if (MK_DUP & 512) { GRID_BAR(); ph_gemm_dn(ws, l); } TEND(3); } SEAM(pb + 9);
    }
    if (IN(NPHASE - 1)) { TBEG(); ph_ln(ws, NL); TEND(0); }
#if MK_TIME
    if (blockIdx.x == 0) { const unsigned long long tw = __builtin_amdgcn_s_memrealtime(); const unsigned long long dl = tcat * (unsigned long long)MK_TMUL; while (__builtin_amdgcn_s_memrealtime() - tw < dl) __builtin_amdgcn_s_sleep(8); }
#endif
#undef IN
#undef SEAM
#undef GRID_BAR
}

extern "C" void kernel_launch(void* const* d_in, const int* in_sizes, int n_in, void* d_out, int out_size, void* d_ws, size_t ws_size, hipStream_t stream) {
    static int grid = 0;
    if (grid == 0) {
        if (n_in != 27 || out_size != NB * SEQ * D || ws_size < WS_END) { fprintf(stderr, "kernel_launch: unexpected problem (n_in %d, out %d, ws %zu < %zu)\n", n_in, out_size, ws_size, (size_t)WS_END); grid = -1; return; }
        int dev = 0, cus = 0, per_cu = 0;
        if (hipGetDevice(&dev) != hipSuccess || hipDeviceGetAttribute(&cus, hipDeviceAttributeMultiprocessorCount, dev) != hipSuccess) { grid = -1; return; }
        if (hipFuncSetAttribute((const void*)mk_fwd, hipFuncAttributeMaxDynamicSharedMemorySize, LDS_BYTES) != hipSuccess) { fprintf(stderr, "kernel_launch: hipFuncSetAttribute failed\n"); grid = -1; return; }
        if (hipOccupancyMaxActiveBlocksPerMultiprocessor(&per_cu, (const void*)mk_fwd, NTHR, LDS_BYTES) != hipSuccess || per_cu < 1) fprintf(stderr, "kernel_launch: occupancy query reports %d\n", per_cu);
        (void)hipGetLastError();
        grid = cus > 1024 ? 1024 : cus;
    }
    if (grid < 0) return;
    (void)hipMemsetAsync((char*)d_ws + WS_CTL, 0, CTL_BYTES, stream);
    Args a{};
    for (int i = 0; i < 27; ++i) a.in[i] = (const float*)d_in[i];
    a.out = (float*)d_out; a.ws = (unsigned char*)d_ws;
#if MK_MULTI
#ifndef DBG_NRUN
#define DBG_NRUN NPHASE
#endif
    for (int p = 0; p < DBG_NRUN; ++p) { a.ph_lo = p; a.ph_hi = p + 1; hipLaunchKernelGGL(mk_fwd, dim3(grid), dim3(NTHR), LDS_BYTES, stream, a); }
#ifdef DBG_DUMP
    a.ph_lo = 100 + DBG_DUMP; a.ph_hi = 101 + DBG_DUMP; hipLaunchKernelGGL(mk_fwd, dim3(grid), dim3(NTHR), LDS_BYTES, stream, a);
#endif
#else
    a.ph_lo = 0; a.ph_hi = NPHASE;
    hipLaunchKernelGGL(mk_fwd, dim3(grid), dim3(NTHR), LDS_BYTES, stream, a);
#endif
}
```

```cpp
#include <hip/hip_runtime.h>
#include <cstdio>
#include <cstdint>
namespace pg8 {
#define PG8_LAS __attribute__((address_space(3)))
typedef unsigned short bf16_t;
typedef short bf16x8 __attribute__((ext_vector_type(8)));
typedef float f32x4 __attribute__((ext_vector_type(4)));
typedef unsigned u32x4 __attribute__((ext_vector_type(4)));
constexpr int BM = 256, BK = 64, HALF = 128, HTB = HALF * BK * 2  , STAGE_BYTES = 8 * HTB, NXCD = 8, WGM = 8;

__host__ __device__ __forceinline__ int lds_byte(int r, int c) { const int st = (r >> 4) * 2 + (c >> 5), rr = r & 15, cc = c & 31, ob = rr * 64 + cc * 2; return st * 1024 + (ob ^ (((ob >> 9) & 1) << 5)); }
__host__ __device__ __forceinline__ void stage_rc(int b, int& R, int& C) { const int st = b / 1024, sb = b % 1024, swz = sb ^ (((sb >> 9) & 1) << 5); R = (st >> 1) * 16 + swz / 64; C = (st & 1) * 32 + (swz % 64) / 2; }
__host__ __device__ __forceinline__ int perm32(int rho) { const int n = rho >> 4, i = rho & 15; return 8 * (i >> 2) + 4 * n + (i & 3); }

struct Unit { int pm, pn; };
struct Gemm { const bf16_t* A; const bf16_t* Bt; int M, N, K, lda; const int* src; };

struct StaticOrder {
    int nM, nN, nwg, G, c;
    __host__ __device__ void init(int M, int N, int G_, int c_) { nM = M / BM; nN = N / BM; nwg = nM * nN; G = G_; c = c_; }
    __host__ __device__ bool next(int i, Unit& u) const {
        const long L = (long)i * G + c; if (L >= nwg) return false;
        int wgid = (int)L; { const int q = nwg / NXCD, r = nwg % NXCD, xcd = wgid % NXCD, off = wgid / NXCD; wgid = (xcd < r ? xcd * (q + 1) : r * (q + 1) + (xcd - r) * q) + off; }
        const int nig = WGM * nN, gid = wgid / nig, fm = gid * WGM, gsz = (nM - fm) < WGM ? (nM - fm) : WGM;
        u.pm = fm + ((wgid % nig) % gsz); u.pn = (wgid % nig) / gsz; return true;
    }
    __device__ __forceinline__ void a_ready(const Unit&) const {}
    __device__ __forceinline__ void done(const Unit&) const {}
};

__device__ __forceinline__ unsigned cvt_pk_bf16(float lo, float hi) { unsigned r; asm volatile("v_cvt_pk_bf16_f32 %0, %1, %2" : "=v"(r) : "v"(lo), "v"(hi)); return r; }
typedef float f32x2 __attribute__((ext_vector_type(2)));
__device__ __forceinline__ f32x2 gelu_pk(f32x2 v) {
    const f32x2 av = __builtin_elementwise_abs(v), d = av * 0.2316418882f + 1.0f;
    f32x2 t; t.x = __builtin_amdgcn_rcpf(d.x); t.y = __builtin_amdgcn_rcpf(d.y);
    f32x2 q = t * 0.5307027145f + (-0.7265760135f); q = q * t + 0.7107068705f; q = q * t + (-0.142248368f); q = q * t + 0.127414796f; q = q * t;
    const f32x2 s = (v * v) * (-0.72134752044f);
    f32x2 e; e.x = __builtin_amdgcn_exp2f(s.x); e.y = __builtin_amdgcn_exp2f(s.y);
    const f32x2 m = v * (q * e), r = v - m;
    f32x2 o; o.x = v.x < 0.f ? m.x : r.x; o.y = v.y < 0.f ? m.y : r.y; return o;
}

template <int ACT  > struct EpiBf16 {
    static constexpr bool PERM = true, AFTER_DRAIN = false; static_assert(ACT == 0 || ACT == 1, "EpiBf16: ACT is 0 (none) or 1 (gelu_pk)");
    bf16_t* O; int ldc; const float* bias; int split_cols; size_t split_stride; float scale0;
    __device__ __forceinline__ void operator()(const f32x4 (&acc)[2][2][4][2], const Unit& u, int wr, int wc, int fr, int fq) const {
        const int row0 = u.pm * BM + wr * 64 + fr; int colt = u.pn * BM; bf16_t* base = O;
        float sc = 1.f; if (split_cols) { const int t = colt / split_cols; base += (size_t)t * split_stride; colt -= t * split_cols; if (t == 0) sc = scale0; }
        const int col0 = colt + wc * 32 + 8 * fq, bcol0 = u.pn * BM + wc * 32 + 8 * fq;
        f32x4 bv[2][2];
#pragma unroll
        for (int bj = 0; bj < 2; ++bj)
#pragma unroll
            for (int n = 0; n < 2; ++n) bv[bj][n] = bias ? *(const f32x4*)(bias + bcol0 + bj * HALF + 4 * n) : (f32x4){0.f, 0.f, 0.f, 0.f};
#pragma unroll
        for (int ai = 0; ai < 2; ++ai)
#pragma unroll
            for (int m = 0; m < 4; ++m) { bf16_t* rowp = base + (size_t)(row0 + ai * HALF + m * 16) * ldc + col0;
#pragma unroll
                for (int bj = 0; bj < 2; ++bj) { f32x4 v0 = acc[ai][bj][m][0] + bv[bj][0], v1 = acc[ai][bj][m][1] + bv[bj][1];
                    if (ACT == 1) { f32x2 a = gelu_pk((f32x2){v0[0], v0[1]}), b = gelu_pk((f32x2){v0[2], v0[3]}), c = gelu_pk((f32x2){v1[0], v1[1]}), d = gelu_pk((f32x2){v1[2], v1[3]});
                        v0 = (f32x4){a.x, a.y, b.x, b.y}; v1 = (f32x4){c.x, c.y, d.x, d.y}; }
                    v0 = v0 * sc; v1 = v1 * sc; u32x4 w; w.x = cvt_pk_bf16(v0[0], v0[1]); w.y = cvt_pk_bf16(v0[2], v0[3]); w.z = cvt_pk_bf16(v1[0], v1[1]); w.w = cvt_pk_bf16(v1[2], v1[3]);
                    *(u32x4*)(rowp + bj * HALF) = w; } }
    }
};
template <int ACT  > struct EpiBf16NT {
    static constexpr bool PERM = true, AFTER_DRAIN = false; static_assert(ACT == 0 || ACT == 1, "EpiBf16: ACT is 0 (none) or 1 (gelu_pk)");
    bf16_t* O; int ldc; const float* bias; int split_cols; size_t split_stride; float scale0;
    __device__ __forceinline__ void operator()(const f32x4 (&acc)[2][2][4][2], const Unit& u, int wr, int wc, int fr, int fq) const {
        const int row0 = u.pm * BM + wr * 64 + fr; int colt = u.pn * BM; bf16_t* base = O;
        float sc = 1.f; if (split_cols) { const int t = colt / split_cols; base += (size_t)t * split_stride; colt -= t * split_cols; if (t == 0) sc = scale0; }
        const int col0 = colt + wc * 32 + 8 * fq, bcol0 = u.pn * BM + wc * 32 + 8 * fq;
        f32x4 bv[2][2];
#pragma unroll
        for (int bj = 0; bj < 2; ++bj)
#pragma unroll
            for (int n = 0; n < 2; ++n) bv[bj][n] = bias ? *(const f32x4*)(bias + bcol0 + bj * HALF + 4 * n) : (f32x4){0.f, 0.f, 0.f, 0.f};
#pragma unroll
        for (int ai = 0; ai < 2; ++ai)
#pragma unroll
            for (int m = 0; m < 4; ++m) { bf16_t* rowp = base + (size_t)(row0 + ai * HALF + m * 16) * ldc + col0;
#pragma unroll
                for (int bj = 0; bj < 2; ++bj) { f32x4 v0 = acc[ai][bj][m][0] + bv[bj][0], v1 = acc[ai][bj][m][1] + bv[bj][1];
                    if (ACT == 1) { f32x2 a = gelu_pk((f32x2){v0[0], v0[1]}), b = gelu_pk((f32x2){v0[2], v0[3]}), c = gelu_pk((f32x2){v1[0], v1[1]}), d = gelu_pk((f32x2){v1[2], v1[3]});
                        v0 = (f32x4){a.x, a.y, b.x, b.y}; v1 = (f32x4){c.x, c.y, d.x, d.y}; }
                    v0 = v0 * sc; v1 = v1 * sc; u32x4 w; w.x = cvt_pk_bf16(v0[0], v0[1]); w.y = cvt_pk_bf16(v0[2], v0[3]); w.z = cvt_pk_bf16(v1[0], v1[1]); w.w = cvt_pk_bf16(v1[2], v1[3]);
                    __builtin_nontemporal_store(w, (u32x4*)(rowp + bj * HALF)); } }
    }
};
struct EpiF32 {
    static constexpr bool PERM = false, AFTER_DRAIN = false;
    float* C; int ldc; const float* bias;
    __device__ __forceinline__ void operator()(const f32x4 (&acc)[2][2][4][2], const Unit& u, int wr, int wc, int fr, int fq) const {
        const int row0 = u.pm * BM + wr * 64 + fr, col0 = u.pn * BM + wc * 32 + 4 * fq;
        f32x4 bv[2][2];
#pragma unroll
        for (int bj = 0; bj < 2; ++bj)
#pragma unroll
            for (int n = 0; n < 2; ++n) bv[bj][n] = bias ? *(const f32x4*)(bias + col0 + bj * HALF + n * 16) : (f32x4){0.f, 0.f, 0.f, 0.f};
#pragma unroll
        for (int ai = 0; ai < 2; ++ai)
#pragma unroll
            for (int m = 0; m < 4; ++m) { float* rowp = C + (size_t)(row0 + ai * HALF + m * 16) * ldc + col0;
#pragma unroll
                for (int bj = 0; bj < 2; ++bj)
#pragma unroll
                    for (int n = 0; n < 2; ++n) *(f32x4*)(rowp + bj * HALF + n * 16) = acc[ai][bj][m][n] + bv[bj][n]; }
    }
};
template <class Epi, class Sched, bool ALIGN_EPI = false, bool SP2 = false, bool GATHER = false>
__device__ __forceinline__ void gemm_phase(PG8_LAS unsigned char* lds, const Gemm g, const Sched& S, const Epi& E) {
    int tid = threadIdx.x; asm volatile("" : "+v"(tid)); const int wid = __builtin_amdgcn_readfirstlane(tid >> 6), lane = tid & 63, wr = wid >> 2, wc = wid & 3, fr = lane & 15, fq = lane >> 4;
    const int K = g.K, nt = K / BK;
    unsigned voffA[2], voffB[2]; int RA[2]; unsigned CA2[2];
#pragma unroll
    for (int i = 0; i < 2; ++i) { int R, C; stage_rc(tid * 16 + i * 8192, R, C); const int Rb = Epi::PERM ? ((R & ~31) + perm32(R & 31)) : R;
        voffA[i] = (unsigned)(R * g.lda + C) * 2u; voffB[i] = (unsigned)(Rb * K + C) * 2u; RA[i] = R; CA2[i] = (unsigned)C * 2u; }
    unsigned gcur[2][2] = {{0u, 0u}, {0u, 0u}}, gnxt[2][2] = {{0u, 0u}, {0u, 0u}};
#define PG8_GOFF(dst, u_) do { _Pragma("unroll") for (int h_ = 0; h_ < 2; ++h_) _Pragma("unroll") for (int i_ = 0; i_ < 2; ++i_) \
        dst[h_][i_] = (unsigned)g.src[(u_).pm * BM + h_ * HALF + RA[i_]] * (unsigned)(g.lda * 2) + CA2[i_]; } while (0)
#define PG8_STAGE_A(bufoff, gbase, h, nx) do { if constexpr (GATHER) { unsigned vs_[2] = {(nx) ? gnxt[h][0] : gcur[h][0], (nx) ? gnxt[h][1] : gcur[h][1]}; PG8_STAGE(bufoff, gbase, vs_); } \
        else { PG8_STAGE(bufoff, (gbase) + ((h) ? hstepA : 0), voffA); } } while (0)
    const size_t kstep = (size_t)(BK * 2);
    const size_t hstepA = (size_t)HALF * g.lda * 2, hstepB = (size_t)HALF * K * 2;
    const size_t tstepA = 2 * hstepA, tstepB = 2 * hstepB;
    const unsigned ldsw = (unsigned)wid * 1024u;
    const int aoff = lds_byte(wr * 64 + fr, fq * 8), boff = lds_byte(wc * 32 + fr, fq * 8);
#define PG8_SA(b, h) (((b) * 2 + (h)) * HTB)
#define PG8_SB(b, h) ((4 + (b) * 2 + (h)) * HTB)
#define PG8_STAGE(bufoff, gbase, voff) do { _Pragma("unroll") for (int _i = 0; _i < 2; ++_i) \
        __builtin_amdgcn_global_load_lds((const unsigned*)((const char*)(gbase) + (voff)[_i]), (PG8_LAS unsigned*)(lds + (bufoff) + ldsw + _i * 8192), 16, 0, 0); } while (0)
#define PG8_LDA(dst, b, h) do { _Pragma("unroll") for (int m = 0; m < 4; ++m) _Pragma("unroll") for (int k = 0; k < 2; ++k) dst[m][k] = *(const PG8_LAS bf16x8*)(lds + PG8_SA(b, h) + aoff + m * 2048 + k * 1024); } while (0)
#define PG8_LDB(dst, b, h) do { _Pragma("unroll") for (int n = 0; n < 2; ++n) _Pragma("unroll") for (int k = 0; k < 2; ++k) dst[n][k] = *(const PG8_LAS bf16x8*)(lds + PG8_SB(b, h) + boff + n * 2048 + k * 1024); } while (0)
#define PG8_MMA(ai, bj, At, Bt) do { __builtin_amdgcn_s_setprio(1); _Pragma("unroll") for (int m = 0; m < 4; ++m) _Pragma("unroll") for (int n = 0; n < 2; ++n) _Pragma("unroll") for (int k = 0; k < 2; ++k) \
        acc[ai][bj][m][n] = __builtin_amdgcn_mfma_f32_16x16x32_bf16(Bt[n][k], At[m][k], acc[ai][bj][m][n], 0, 0, 0); __builtin_amdgcn_s_setprio(0); } while (0)
#define PG8_WAIT_V(n) asm volatile("s_waitcnt vmcnt(" #n ")" ::: "memory")
#define PG8_WAIT_L(n) asm volatile("s_waitcnt lgkmcnt(" #n ")" ::: "memory")
#define PG8_BAR __builtin_amdgcn_s_barrier()
#define PG8_SCHED __builtin_amdgcn_sched_barrier(0)
    Unit cur, nxt; int ui = 0;
    if (!S.next(0, cur)) return;
    f32x4 acc[2][2][4][2];
#pragma unroll
    for (int a = 0; a < 2; ++a)
#pragma unroll
        for (int b = 0; b < 2; ++b)
#pragma unroll
            for (int m = 0; m < 4; ++m)
#pragma unroll
                for (int n = 0; n < 2; ++n) acc[a][b][m][n] = (f32x4){0.f, 0.f, 0.f, 0.f};
    bf16x8 At[4][2], B0[2][2], B1[2][2];
    const char* cA = (const char*)g.A + (GATHER ? (size_t)0 : (size_t)cur.pm * tstepA); const char* cB = (const char*)g.Bt + (size_t)cur.pn * tstepB;
    if constexpr (GATHER) PG8_GOFF(gcur, cur);
    S.a_ready(cur);
    if constexpr (SP2) {
        PG8_STAGE(PG8_SB(0, 0), cB, voffB); PG8_STAGE(PG8_SB(0, 1), cB + hstepB, voffB); PG8_STAGE_A(PG8_SA(0, 0), cA, 0, false); PG8_STAGE_A(PG8_SA(0, 1), cA, 1, false);
        if (wr == 1) PG8_BAR;
        PG8_WAIT_V(2); PG8_BAR;
        PG8_STAGE(PG8_SB(1, 0), cB + kstep, voffB); PG8_STAGE_A(PG8_SA(1, 0), cA + kstep, 0, false); PG8_STAGE(PG8_SB(1, 1), cB + hstepB + kstep, voffB);
        PG8_WAIT_V(6); PG8_BAR;
    } else {
        PG8_STAGE(PG8_SB(0, 0), cB, voffB); PG8_STAGE_A(PG8_SA(0, 0), cA, 0, false); PG8_STAGE(PG8_SB(0, 1), cB + hstepB, voffB); PG8_STAGE_A(PG8_SA(0, 1), cA, 1, false);
        if (wr == 1) PG8_BAR;
        PG8_WAIT_V(4); PG8_BAR;
        PG8_STAGE(PG8_SB(1, 0), cB + kstep, voffB); PG8_STAGE_A(PG8_SA(1, 0), cA + kstep, 0, false); PG8_STAGE(PG8_SB(1, 1), cB + hstepB + kstep, voffB);
        PG8_WAIT_V(6); PG8_BAR;
    }
    for (;;) {
        const bool has_next = S.next(ui + 1, nxt);
        const char* nA = (has_next && !GATHER) ? (const char*)g.A + (size_t)nxt.pm * tstepA : cA; const char* nB = has_next ? (const char*)g.Bt + (size_t)nxt.pn * tstepB : cB;
        if constexpr (GATHER) { if (has_next) PG8_GOFF(gnxt, nxt); else { _Pragma("unroll") for (int h_ = 0; h_ < 2; ++h_) { gnxt[h_][0] = gcur[h_][0]; gnxt[h_][1] = gcur[h_][1]; } } }
#pragma unroll 1
        for (int t = 0; t < nt; t += 2) {
            const bool last = (t == nt - 2);
            const char* a1 = cA + (size_t)(t + 1) * kstep;
            const char* a2 = last ? nA : cA + (size_t)(t + 2) * kstep; const char* b2 = last ? nB : cB + (size_t)(t + 2) * kstep;
            const char* a3 = a2 + kstep; const char* b3 = b2 + kstep;
            if (last && has_next) S.a_ready(nxt);
            if constexpr (SP2) {
            PG8_LDB(B0, 0, 0); PG8_LDB(B1, 0, 1); PG8_SCHED; PG8_LDA(At, 0, 0); PG8_STAGE_A(PG8_SA(1, 1), a1, 1, false);
            PG8_WAIT_V(8); PG8_WAIT_L(0); PG8_BAR; PG8_MMA(0, 0, At, B0); PG8_MMA(0, 1, At, B1); PG8_BAR; PG8_SCHED;
            PG8_LDA(At, 0, 1); PG8_STAGE(PG8_SB(0, 0), b2, voffB); PG8_STAGE(PG8_SB(0, 1), b2 + hstepB, voffB); PG8_STAGE_A(PG8_SA(0, 0), a2, 0, last);
            PG8_WAIT_V(8); PG8_WAIT_L(0); PG8_BAR; PG8_MMA(1, 0, At, B0); PG8_MMA(1, 1, At, B1); PG8_BAR; PG8_SCHED;
            PG8_LDB(B0, 1, 0); PG8_LDB(B1, 1, 1); PG8_SCHED; PG8_LDA(At, 1, 0); PG8_STAGE_A(PG8_SA(0, 1), a2, 1, last);
            PG8_WAIT_V(8); PG8_WAIT_L(0); PG8_BAR; PG8_MMA(0, 0, At, B0); PG8_MMA(0, 1, At, B1); PG8_BAR; PG8_SCHED;
            PG8_LDA(At, 1, 1); PG8_STAGE(PG8_SB(1, 0), b3, voffB); PG8_STAGE(PG8_SB(1, 1), b3 + hstepB, voffB); PG8_STAGE_A(PG8_SA(1, 0), a3, 0, last);
            PG8_WAIT_V(8); PG8_WAIT_L(0); PG8_BAR; PG8_MMA(1, 0, At, B0); PG8_MMA(1, 1, At, B1); PG8_BAR; PG8_SCHED;
            } else {
            PG8_LDB(B0, 0, 0); PG8_SCHED; PG8_LDA(At, 0, 0); PG8_STAGE_A(PG8_SA(1, 1), a1, 1, false);
            PG8_WAIT_L(8); PG8_BAR; PG8_WAIT_L(0); PG8_MMA(0, 0, At, B0); PG8_BAR; PG8_SCHED;
            PG8_LDB(B1, 0, 1); PG8_STAGE(PG8_SB(0, 0), b2, voffB);
            PG8_BAR; PG8_WAIT_L(0); PG8_MMA(0, 1, At, B1); PG8_BAR;
            PG8_LDA(At, 0, 1); PG8_STAGE_A(PG8_SA(0, 0), a2, 0, last);
            PG8_BAR; PG8_WAIT_L(0); PG8_MMA(1, 0, At, B0); PG8_BAR; PG8_SCHED;
            PG8_STAGE(PG8_SB(0, 1), b2 + hstepB, voffB);
            PG8_WAIT_V(6); PG8_BAR; PG8_MMA(1, 1, At, B1); PG8_BAR;
            PG8_LDB(B0, 1, 0); PG8_SCHED; PG8_LDA(At, 1, 0); PG8_STAGE_A(PG8_SA(0, 1), a2, 1, last);
            PG8_WAIT_L(8); PG8_BAR; PG8_WAIT_L(0); PG8_MMA(0, 0, At, B0); PG8_BAR; PG8_SCHED;
            PG8_LDB(B1, 1, 1); PG8_STAGE(PG8_SB(1, 0), b3, voffB);
            PG8_BAR; PG8_WAIT_L(0); PG8_MMA(0, 1, At, B1); PG8_BAR;
            PG8_LDA(At, 1, 1); PG8_STAGE_A(PG8_SA(1, 0), a3, 0, last);
            PG8_BAR; PG8_WAIT_L(0); PG8_MMA(1, 0, At, B0); PG8_BAR; PG8_SCHED;
            PG8_STAGE(PG8_SB(1, 1), b3 + hstepB, voffB);
            PG8_WAIT_V(6); PG8_BAR; PG8_MMA(1, 1, At, B1); PG8_BAR;
            }
        }
        if constexpr (ALIGN_EPI) { if (wr == 0) PG8_BAR; }
        if constexpr (!Epi::AFTER_DRAIN) { E(acc, cur, wr, wc, fr, fq); S.done(cur); }
        if (!has_next) break;
#pragma unroll
        for (int a = 0; a < 2; ++a)
#pragma unroll
            for (int b = 0; b < 2; ++b)
#pragma unroll
                for (int m = 0; m < 4; ++m)
#pragma unroll
                    for (int n = 0; n < 2; ++n) acc[a][b][m][n] = (f32x4){0.f, 0.f, 0.f, 0.f};
        cur = nxt; cA = nA; cB = nB; ++ui;
        if constexpr (GATHER) { _Pragma("unroll") for (int h_ = 0; h_ < 2; ++h_) { gcur[h_][0] = gnxt[h_][0]; gcur[h_][1] = gnxt[h_][1]; } }
        if constexpr (ALIGN_EPI) { if (wr == 1) PG8_BAR; }
    }
    PG8_WAIT_V(0);
    if constexpr (!ALIGN_EPI) { if (wr == 0) PG8_BAR; }
    PG8_BAR;
    if constexpr (Epi::AFTER_DRAIN) { E.fused(acc, cur, wr, wc, fr, fq, lds, wid, lane); S.done(cur); }
#undef PG8_SA
#undef PG8_GOFF
#undef PG8_STAGE_A
#undef PG8_SB
#undef PG8_STAGE
#undef PG8_LDA
#undef PG8_LDB
#undef PG8_MMA
#undef PG8_WAIT_V
#undef PG8_WAIT_L
#undef PG8_BAR
#undef PG8_SCHED
}
}

constexpr int NB = 16, SEQ = 4096, CTX = 256, TT = SEQ + CTX, M = NB * TT, D = 1024, NL = 4;
constexpr int NPJ = 2304, DPROJ = 2208;
constexpr int MS = 143360;
constexpr float EPS = 1e-6f, ALPHA = 1.6817928305074290f, LOG2E = 1.4426950408889634f;
constexpr int NWAVES = 8, NTHR = 512;
#ifndef MK_DEBUG
#define MK_DEBUG 0
#endif
#ifndef MK_TIME
#define MK_TIME 0
#endif
#ifndef MK_TMUL
#define MK_TMUL 1
#endif
#ifndef MK_VM
#define MK_VM 0
#endif
#ifndef MK_DUP
#define MK_DUP 0
#endif
#ifndef MK_MULTI
#define MK_MULTI 0
#endif
constexpr int NPHASE = 2 + 10 * NL;

constexpr size_t WS_CTL = 0, CTL_BYTES = 65536;
constexpr size_t WS_MODS = WS_CTL + CTL_BYTES;
constexpr size_t WS_T64 = WS_MODS + (size_t)NL * 17 * 6144 * 4;
constexpr size_t WS_T32 = WS_T64 + 8192;
constexpr size_t WS_RS = WS_T32 + 4096;
constexpr size_t WS_RT = WS_RS + (size_t)M * 8;
constexpr size_t WS_HIST = WS_RT + (size_t)M * 32;
constexpr size_t WS_XS = WS_HIST + 65536;
constexpr size_t WS_WIN = WS_XS + (size_t)M * D * 2;
constexpr size_t WS_WD = WS_WIN + (size_t)NPJ * D * 2;
constexpr size_t WS_WOUT = WS_WD + (size_t)1024 * 384 * 2;
constexpr size_t WS_WGU = WS_WOUT + (size_t)D * D * 2;
constexpr size_t WS_WDN = WS_WGU + (size_t)16 * 1024 * 1024 * 2;
constexpr size_t WS_HA = WS_WDN + (size_t)16 * 1024 * 512 * 2;
constexpr size_t WS_PB = WS_HA + (size_t)M * D * 2;
constexpr size_t WS_QD = WS_PB + (size_t)M * NPJ * 2;
constexpr size_t WS_KD = WS_QD + (size_t)M * 384 * 2;
constexpr size_t WS_VD = WS_KD + (size_t)M * 384 * 2;
constexpr size_t WS_ACT = WS_VD + (size_t)M * 256 * 2;
constexpr size_t WS_END = WS_ACT + (size_t)MS * 512 * 2;
static_assert(WS_END <= (size_t)1073741824, "d_ws map must fit 1 GiB");
static_assert((size_t)M * NPJ * 2 >= (size_t)MS * D * 2 && (size_t)M * NPJ * 2 >= (size_t)M * D * 4, "region PB overlays");
constexpr int CW_BAR = 0;
constexpr int CW_QUEUE = 4096;

constexpr int RING_BYTES = 131072, MISC_OFF = RING_BYTES, LDS_BYTES = 147456;
constexpr int MI_BAR = 0, MI_Q = 4, MI_TOT = 16, MI_BASE = 32, MI_PST = 48, MI_LH = 80;

#define GAS __attribute__((address_space(1)))
#define LAS __attribute__((address_space(3)))
typedef unsigned short bf16;
typedef unsigned v4u __attribute__((ext_vector_type(4)));
typedef unsigned v2u __attribute__((ext_vector_type(2)));
typedef float f32x4 __attribute__((ext_vector_type(4)));
typedef float f32x2 __attribute__((ext_vector_type(2)));
typedef short bf16x8 __attribute__((ext_vector_type(8)));
typedef float f32x16 __attribute__((ext_vector_type(16)));
typedef short v4i16 __attribute__((ext_vector_type(4)));

__device__ __forceinline__ unsigned f2bf(float f) { unsigned u = __builtin_bit_cast(unsigned, f); return (u + 0x7fffu + ((u >> 16) & 1u)) >> 16; }
typedef __bf16 bf16x2_hw __attribute__((ext_vector_type(2)));
__device__ __forceinline__ unsigned pk2(float lo, float hi) { f32x2 v = {lo, hi}; const bf16x2_hw b = __builtin_convertvector(v, bf16x2_hw); return __builtin_bit_cast(unsigned, b); }
__device__ __forceinline__ float bflo(unsigned w) { return __builtin_bit_cast(float, w << 16); }
__device__ __forceinline__ float bfhi(unsigned w) { return __builtin_bit_cast(float, w & 0xffff0000u); }
__device__ __forceinline__ void unpack8(v4u w, float (&f)[8]) { f[0] = bflo(w.x); f[1] = bfhi(w.x); f[2] = bflo(w.y); f[3] = bfhi(w.y); f[4] = bflo(w.z); f[5] = bfhi(w.z); f[6] = bflo(w.w); f[7] = bfhi(w.w); }
__device__ __forceinline__ v4u pack8(const float (&f)[8]) { v4u w; w.x = pk2(f[0], f[1]); w.y = pk2(f[2], f[3]); w.z = pk2(f[4], f[5]); w.w = pk2(f[6], f[7]); return w; }
__device__ __forceinline__ float wave_sum(float v) {
    int x = __builtin_bit_cast(int, v);
#define WS_DPP(ctrl, rmask) v += __builtin_bit_cast(float, __builtin_amdgcn_update_dpp(0, x, ctrl, rmask, 0xf, true)); x = __builtin_bit_cast(int, v)
    WS_DPP(0xB1, 0xf);
    WS_DPP(0x4E, 0xf);
    WS_DPP(0x141, 0xf);
    WS_DPP(0x140, 0xf);
    WS_DPP(0x142, 0xa);
    WS_DPP(0x143, 0xc);
#undef WS_DPP
    return __builtin_bit_cast(float, __builtin_amdgcn_readlane(__builtin_bit_cast(int, v), 63));
}

#define XB_TMO      128
#define XB_XCNT(j)  (256  + 64 * (j))
#define XB_XSUB(j)  (1280 + 64 * (j))
#define XB_XGEN(j)  (2304 + 64 * (j))
#define XB_TOP      3328
#define XB_TOPGEN   3392
#define XCD_BAR_WORDS 3456
#define XB_SPIN_CAP (1u << 22)
__device__ __forceinline__ unsigned xb_ld(unsigned* p)              { return __hip_atomic_load(p, __ATOMIC_RELAXED, __HIP_MEMORY_SCOPE_AGENT); }
__device__ __forceinline__ unsigned xb_add(unsigned* p, unsigned v) { return __hip_atomic_fetch_add(p, v, __ATOMIC_RELAXED, __HIP_MEMORY_SCOPE_AGENT); }
__device__ __forceinline__ unsigned xb_xcc_id() { return (unsigned)__builtin_amdgcn_s_getreg((3 << 11) | 20) & 0xFu; }
#define XB_SPIN(cond, bar) do { unsigned _sp = 0; while (cond) { __builtin_amdgcn_s_sleep(1); \
    if ((++_sp & 255u) == 0u) { if (xb_ld(&(bar)[XB_TMO])) break; if (_sp > XB_SPIN_CAP) { atomicAdd(&(bar)[XB_TMO], 1u); break; } } } } while (0)
struct XcdBarrier { unsigned* bar; unsigned x; volatile LAS unsigned* st; };
__device__ __forceinline__ XcdBarrier xcd_barrier_post(unsigned* bar, volatile LAS unsigned* st) {
    XcdBarrier b; b.bar = bar; b.x = xb_xcc_id(); b.st = st;
    if (threadIdx.x == 0) (void)xb_add(&bar[XB_XCNT(b.x)], 1u);
    return b;
}
__device__ __forceinline__ void xcd_barrier_complete(unsigned* bar, unsigned x, unsigned& nloc, unsigned& nx) {
    const unsigned G = gridDim.x * gridDim.y * gridDim.z;
    unsigned sum, cnt, mine, sp = 0u;
    for (;;) {
        sum = 0u; cnt = 0u; mine = 0u;
#pragma unroll
        for (unsigned j = 0; j < 16; ++j) { const unsigned c = xb_ld(&bar[XB_XCNT(j)]); sum += c; cnt += (c > 0u) ? 1u : 0u; mine = (j == x) ? c : mine; }
        if (sum == G) break;
        __builtin_amdgcn_s_sleep(1);
        if ((++sp & 255u) == 0u) { if (xb_ld(&bar[XB_TMO])) break; if (sp > XB_SPIN_CAP) { atomicAdd(&bar[XB_TMO], 1u); break; } }
    }
    nloc = mine > 0u ? mine : 1u; nx = cnt > 0u ? cnt : 1u;
}
__device__ __forceinline__ void xcd_barrier(const XcdBarrier& b) {
    asm volatile("s_waitcnt vmcnt(0)" ::: "memory");
    __syncthreads();
    if (threadIdx.x == 0) {
        unsigned* bar = b.bar;
        __builtin_amdgcn_s_waitcnt(0);
        unsigned nloc = b.st[0], nx = b.st[1];
        if (nloc == 0u) { xcd_barrier_complete(bar, b.x, nloc, nx); b.st[0] = nloc; b.st[1] = nx; }
        const unsigned old = xb_add(&bar[XB_XSUB(b.x)], 1u);
        const unsigned gen = old / nloc;
        if (old + 1u == (gen + 1u) * nloc) {
            __builtin_amdgcn_fence(__ATOMIC_RELEASE, "agent");
            asm volatile("s_waitcnt vmcnt(0)" ::: "memory");
            const unsigned og = xb_add(&bar[XB_TOP], 1u);
            const unsigned tg = og / nx;
            if (og + 1u == (tg + 1u) * nx) xb_add(&bar[XB_TOPGEN], 1u);
            else XB_SPIN(xb_ld(&bar[XB_TOPGEN]) == tg, bar);
            __builtin_amdgcn_fence(__ATOMIC_ACQUIRE, "agent");
            xb_add(&bar[XB_XGEN(b.x)], 1u);
            asm volatile("s_waitcnt vmcnt(0)" ::: "memory");
        } else {
            XB_SPIN(xb_ld(&bar[XB_XGEN(b.x)]) == gen, bar);
            __builtin_amdgcn_fence(__ATOMIC_ACQUIRE, "agent");
            asm volatile("s_waitcnt vmcnt(0)" ::: "memory");
        }
    }
    __syncthreads();
}

struct Args { const float* in[27]; float* out; unsigned char* ws; int ph_lo, ph_hi; };
enum { I_X = 0, I_C, I_CTX, I_CCTX, I_WADA, I_BADA, I_WIN, I_NABIAS, I_GQG, I_GKG, I_SINK, I_MQG, I_WQB, I_MKVG, I_WKVB, I_WOUT, I_LN1G, I_LN1B, I_RGW, I_RGB, I_REW, I_REB, I_WG, I_WU, I_WDN, I_LN2G, I_LN2B };

struct Frame {
    LAS unsigned char* lds; volatile LAS unsigned* MISC;
    int tid, lane, wave, G, gw, ngw, bid;
    GAS unsigned char* ws;
};
__device__ __forceinline__ int opaque_tid() { int t = threadIdx.x; asm volatile("" : "+v"(t)); return t; }
__device__ __forceinline__ int opaque_s(int x) { asm volatile("" : "+s"(x)); return x; }
constexpr int PTAB_OFF = MISC_OFF + 2048, I_OUT = 27;
__device__ __forceinline__ GAS unsigned char* ptab_get(const Frame& F, int i) {
    const LAS unsigned* t = (const LAS unsigned*)(F.lds + PTAB_OFF) + 2 * i;
    const unsigned lo = __builtin_amdgcn_readfirstlane(t[0]), hi = __builtin_amdgcn_readfirstlane(t[1]);
    return (GAS unsigned char*)(((unsigned long long)hi << 32) | lo);
}
#define INP(i) ((const float*)ptab_get(F, (i)))
__device__ __forceinline__ Frame make_frame(GAS unsigned char* ws) {
    extern __shared__ __attribute__((aligned(16))) unsigned char lds_raw[];
    Frame F;
    F.lds = (LAS unsigned char*)lds_raw; F.MISC = (volatile LAS unsigned*)(F.lds + MISC_OFF);
    F.tid = opaque_tid(); F.lane = F.tid & 63; F.wave = __builtin_amdgcn_readfirstlane(F.tid >> 6);
    F.G = opaque_s((int)gridDim.x); F.bid = opaque_s((int)blockIdx.x); F.gw = F.bid * NWAVES + F.wave; F.ngw = F.G * NWAVES;
    { unsigned long long w = (unsigned long long)ws; asm volatile("" : "+s"(w)); F.ws = (GAS unsigned char*)w; }
    return F;
}
typedef _Float16 f16x4 __attribute__((ext_vector_type(4)));
struct RowPtrs { const float* x; const float* ctx; float* out; _Float16* xs; };
__device__ __forceinline__ RowPtrs row_ptrs(const Frame& F) { RowPtrs p; p.x = INP(I_X); p.ctx = INP(I_CTX); p.out = (float*)ptab_get(F, I_OUT); p.xs = (_Float16*)(F.ws + WS_XS); return p; }
__device__ __forceinline__ const float* xin_row(const RowPtrs& P, int r) {
    const int b = r / TT, t = r - b * TT;
    return t < SEQ ? P.x + ((size_t)b * SEQ + t) * D : P.ctx + ((size_t)b * CTX + (t - SEQ)) * D;
}
__device__ __forceinline__ float* out_row(const RowPtrs& P, int r) { const int b = r / TT, t = r - b * TT; return P.out + ((size_t)b * SEQ + t) * D; }
__device__ __forceinline__ void ld16h(const _Float16* p, int lane, float (&v)[16]) {
    const f16x4* q = (const f16x4*)p + lane;
#pragma unroll
    for (int g = 0; g < 4; ++g) { const f32x4 f = __builtin_convertvector(__builtin_nontemporal_load(q + 64 * g), f32x4); v[4 * g] = f.x; v[4 * g + 1] = f.y; v[4 * g + 2] = f.z; v[4 * g + 3] = f.w; }
}
__device__ __forceinline__ void st16h(_Float16* p, int lane, const float (&v)[16]) {
    f16x4* q = (f16x4*)p + lane;
#pragma unroll
    for (int g = 0; g < 4; ++g) __builtin_nontemporal_store(__builtin_convertvector((f32x4){v[4 * g], v[4 * g + 1], v[4 * g + 2], v[4 * g + 3]}, f16x4), q + 64 * g);
}
__device__ __forceinline__ void ld16(const float* p, int lane, float (&v)[16]) {
    const f32x4* q = (const f32x4*)p + lane;
    const f32x4 a = q[0], b = q[64], c = q[128], d = q[192];
    v[0] = a.x; v[1] = a.y; v[2] = a.z; v[3] = a.w; v[4] = b.x; v[5] = b.y; v[6] = b.z; v[7] = b.w;
    v[8] = c.x; v[9] = c.y; v[10] = c.z; v[11] = c.w; v[12] = d.x; v[13] = d.y; v[14] = d.z; v[15] = d.w;
}
__device__ __forceinline__ void st16(float* p, int lane, const float (&v)[16]) {
    f32x4* q = (f32x4*)p + lane;
    q[0] = (f32x4){v[0], v[1], v[2], v[3]}; q[64] = (f32x4){v[4], v[5], v[6], v[7]};
    q[128] = (f32x4){v[8], v[9], v[10], v[11]}; q[192] = (f32x4){v[12], v[13], v[14], v[15]};
}
__device__ __forceinline__ void ld16nt(const float* p, int lane, float (&v)[16]) {
    const f32x4* q = (const f32x4*)p + lane;
    const f32x4 a = __builtin_nontemporal_load(q), b = __builtin_nontemporal_load(q + 64), c = __builtin_nontemporal_load(q + 128), d = __builtin_nontemporal_load(q + 192);
    v[0] = a.x; v[1] = a.y; v[2] = a.z; v[3] = a.w; v[4] = b.x; v[5] = b.y; v[6] = b.z; v[7] = b.w;
    v[8] = c.x; v[9] = c.y; v[10] = c.z; v[11] = c.w; v[12] = d.x; v[13] = d.y; v[14] = d.z; v[15] = d.w;
}
__device__ __forceinline__ void st16nt(float* p, int lane, const float (&v)[16]) {
    f32x4* q = (f32x4*)p + lane;
    __builtin_nontemporal_store((f32x4){v[0], v[1], v[2], v[3]}, q); __builtin_nontemporal_store((f32x4){v[4], v[5], v[6], v[7]}, q + 64);
    __builtin_nontemporal_store((f32x4){v[8], v[9], v[10], v[11]}, q + 128); __builtin_nontemporal_store((f32x4){v[12], v[13], v[14], v[15]}, q + 192);
}
__device__ __forceinline__ void unpack16(const v2u (&w)[4], float (&v)[16]) {
#pragma unroll
    for (int g = 0; g < 4; ++g) { v[4 * g] = bflo(w[g].x); v[4 * g + 1] = bfhi(w[g].x); v[4 * g + 2] = bflo(w[g].y); v[4 * g + 3] = bfhi(w[g].y); }
}
__device__ __forceinline__ void ld16bf_raw(const bf16* p, int lane, v2u (&w)[4]) {
    const v2u* q = (const v2u*)p + lane; w[0] = q[0]; w[1] = q[64]; w[2] = q[128]; w[3] = q[192];
}
__device__ __forceinline__ void ld16bf_raw_nt(const bf16* p, int lane, v2u (&w)[4]) {
    const v2u* q = (const v2u*)p + lane; w[0] = __builtin_nontemporal_load(q); w[1] = __builtin_nontemporal_load(q + 64); w[2] = __builtin_nontemporal_load(q + 128); w[3] = __builtin_nontemporal_load(q + 192);
}
__device__ __forceinline__ void ld16bf(const bf16* p, int lane, float (&v)[16]) { v2u w[4]; ld16bf_raw(p, lane, w); unpack16(w, v); }
__device__ __forceinline__ void ld16bf_nt(const bf16* p, int lane, float (&v)[16]) { v2u w[4]; ld16bf_raw_nt(p, lane, w); unpack16(w, v); }
__device__ __forceinline__ void st16bf(bf16* p, int lane, const float (&v)[16]) {
    v2u* q = (v2u*)p + lane;
#pragma unroll
    for (int g = 0; g < 4; ++g) { v2u w; w.x = pk2(v[4 * g], v[4 * g + 1]); w.y = pk2(v[4 * g + 2], v[4 * g + 3]); q[64 * g] = w; }
}
__device__ __forceinline__ void ln16(float (&v)[16]) {
    float s = 0.f;
#pragma unroll
    for (int i = 0; i < 16; ++i) s += v[i];
    const float mean = wave_sum(s) * (1.0f / D); float q = 0.f;
#pragma unroll
    for (int i = 0; i < 16; ++i) { v[i] -= mean; q += v[i] * v[i]; }
    const float rstd = __builtin_amdgcn_rsqf(wave_sum(q) * (1.0f / D) + EPS);
#pragma unroll
    for (int i = 0; i < 16; ++i) v[i] *= rstd;
}

__device__ __forceinline__ int rows_per_wave(int ngw) {
    int rpw = (M + ngw - 1) / ngw;
    if (!((SEQ % rpw) % 4 == 0 && (TT % rpw) == 0 && (rpw % 2) == 0)) rpw = (rpw + 3) & ~3;
    return rpw;
}
template <int TYPE>
__device__ __forceinline__ float conv_src(const float* p0, const float* p1, const float* g0, const float* g1, int l, int k, int n) {
    if (TYPE == 0) return n < DPROJ ? p0[((size_t)l * D + k) * DPROJ + n] : 0.f;
    if (TYPE == 1) { if (n < 384) return k < 256 ? g0[l * 256 + k] * p0[((size_t)l * 256 + k) * 384 + n] : 0.f;
                     if (n < 896) return k >= 256 ? g1[l * 128 + (k - 256)] * p1[((size_t)l * 128 + (k - 256)) * 512 + (n - 384)] : 0.f;
                     return 0.f; }
    if (TYPE == 2) return p0[((size_t)l * D + k) * D + n];
    if (TYPE == 3) { const int e = n >> 10, nn = n & 1023, q = nn >> 3, j = nn & 7;
                     return j < 4 ? p0[(((size_t)l * 16 + e) * D + k) * 512 + 4 * q + j] : p1[(((size_t)l * 16 + e) * D + k) * 512 + 4 * q + (j - 4)]; }
    { const int e = n >> 10, nn = n & 1023; return p0[(((size_t)l * 16 + e) * 512 + k) * D + nn]; }
}
template <int TYPE>
__device__ __forceinline__ void conv_item(const Frame& F, int l, int item, LAS float* scr) {
    constexpr int Nd = TYPE == 0 ? NPJ : TYPE == 1 ? 1024 : TYPE == 2 ? 1024 : 16384, Kd = TYPE == 1 ? 384 : TYPE == 4 ? 512 : 1024;
    bf16* dst = (bf16*)(F.ws + (TYPE == 0 ? WS_WIN : TYPE == 1 ? WS_WD : TYPE == 2 ? WS_WOUT : TYPE == 3 ? WS_WGU : WS_WDN));
    const float* p0 = INP(TYPE == 0 ? I_WIN : TYPE == 1 ? I_WQB : TYPE == 2 ? I_WOUT : TYPE == 3 ? I_WG : I_WDN);
    const float* p1 = INP(TYPE == 1 ? I_WKVB : I_WU); const float* g0 = INP(I_MQG); const float* g1 = INP(I_MKVG);
    constexpr int nblk = Nd / 32; const int kb = item / nblk, nb = item - kb * nblk, k0 = 64 * kb, n0 = 32 * nb, lane = F.lane;
#pragma unroll
    for (int i = 0; i < 32; ++i) { const int kk = 2 * i + (lane >> 5); scr[kk * 33 + (lane & 31)] = conv_src<TYPE>(p0, p1, g0, g1, l, k0 + kk, n0 + (lane & 31)); }
    asm volatile("s_waitcnt lgkmcnt(0)" ::: "memory");
    const int c = lane & 7;
#pragma unroll
    for (int j = 0; j < 4; ++j) { const int n = (lane >> 3) + 8 * j; const LAS float* s = scr + (8 * c) * 33 + n;
        v4u o; o.x = pk2(s[0 * 33], s[1 * 33]); o.y = pk2(s[2 * 33], s[3 * 33]); o.z = pk2(s[4 * 33], s[5 * 33]); o.w = pk2(s[6 * 33], s[7 * 33]);
        *(v4u*)(dst + (size_t)(n0 + n) * Kd + k0 + 8 * c) = o; }
    asm volatile("s_waitcnt lgkmcnt(0)" ::: "memory");
}
__device__ __forceinline__ void phase_prologue(const Frame& F) {
    {
        LAS float* sv = (LAS float*)F.lds;
        LAS float* red = (LAS float*)(F.lds + 17 * 1024 * 4);
        float* mods = (float*)(F.ws + WS_MODS);
        for (int u = F.bid; u < NL * 48; u += F.G) {
            const int l = u / 48, cc = u - l * 48;
            const float* pc = INP(I_C); const float* pcc = INP(I_CCTX);
            for (int i = F.tid; i < 17 * 1024; i += NTHR) { const int mr = i >> 10, k = i & 1023; const float c = mr < 16 ? pc[mr * 1024 + k] : pcc[k]; sv[i] = c / (1.0f + expf(-c)); }
            __syncthreads();
            const int col = F.tid & 127, kg = F.tid >> 7;
            float acc[17];
#pragma unroll
            for (int mr = 0; mr < 17; ++mr) acc[mr] = 0.f;
            const float* w = INP(I_WADA) + ((size_t)l * 1024 + kg * 256) * 6144 + cc * 128 + col;
            for (int k4 = 0; k4 < 256; k4 += 4) {
                const float w0 = w[(size_t)(k4 + 0) * 6144], w1 = w[(size_t)(k4 + 1) * 6144], w2 = w[(size_t)(k4 + 2) * 6144], w3 = w[(size_t)(k4 + 3) * 6144];
#pragma unroll
                for (int mr = 0; mr < 17; ++mr) { const f32x4 s = *(const LAS f32x4*)(sv + mr * 1024 + kg * 256 + k4); acc[mr] += (s.x * w0 + s.y * w1) + (s.z * w2 + s.w * w3); }
            }
#pragma unroll
            for (int mr = 0; mr < 17; ++mr) red[(kg * 17 + mr) * 128 + col] = acc[mr];
            __syncthreads();
            const float* bada = INP(I_BADA);
            for (int i = F.tid; i < 17 * 128; i += NTHR) { const int mr = i >> 7, c = i & 127;
                const float s = (red[(0 * 17 + mr) * 128 + c] + red[(1 * 17 + mr) * 128 + c]) + (red[(2 * 17 + mr) * 128 + c] + red[(3 * 17 + mr) * 128 + c]);
                mods[((size_t)l * 17 + mr) * 6144 + cc * 128 + c] = s + bada[l * 6144 + cc * 128 + c]; }
            __syncthreads();
        }
    }
    {
        float* t64 = (float*)(F.ws + WS_T64); float* t32 = (float*)(F.ws + WS_T32);
        for (int i = F.bid * NTHR + F.tid; i < 64 * 16 + 64 * 8; i += F.G * NTHR) {
            if (i < 1024) { const int p = i >> 4, k = i & 15; const float fr = powf(10000.0f, -(float)k / 16.0f), ang = (float)p * fr; t64[2 * i] = cosf(ang); t64[2 * i + 1] = sinf(ang); }
            else { const int j = i - 1024, p = j >> 3, k = j & 7; const float fr = powf(10000.0f, -(float)k / 8.0f), ang = (float)p * fr; t32[2 * j] = cosf(ang); t32[2 * j + 1] = sinf(ang); }
        }
    }
}
__device__ __forceinline__ void convert_layer_weights(const Frame& F, int l) {
    {
        LAS float* scr = (LAS float*)(F.lds + F.wave * 8448);
        constexpr int I0 = 1152, I1 = 192, I2 = 512, I3 = 8192, I4 = 4096, IL = I0 + I1 + I2 + I3 + I4;
        for (int r0_ = F.gw; r0_ < IL; r0_ += F.ngw) {
            int r = r0_;
            if (r < I0) { conv_item<0>(F, l, r, scr); continue; } r -= I0;
            if (r < I1) { conv_item<1>(F, l, r, scr); continue; } r -= I1;
            if (r < I2) { conv_item<2>(F, l, r, scr); continue; } r -= I2;
            if (r < I3) { conv_item<3>(F, l, r, scr); continue; } r -= I3;
            conv_item<4>(F, l, r, scr);
        }
    }
}

__device__ __forceinline__ void phase_ln(const Frame& F, int l) {
    if (l < NL) convert_layer_weights(F, l);
    constexpr int NR = 4;
    const float* mods = (const float*)(F.ws + WS_MODS); bf16* HA = (bf16*)(F.ws + WS_HA);
    const bf16* Y = (const bf16*)(F.ws + WS_PB); const unsigned* RT = (const unsigned*)(F.ws + WS_RT);
    const int lane = F.lane; const RowPtrs RP = row_ptrs(F);
    const float* ln2g = INP(I_LN2G) + (l > 0 ? l - 1 : 0) * D; const float* ln2b = INP(I_LN2B) + (l > 0 ? l - 1 : 0) * D;
    const int rpw = rows_per_wave(F.ngw), rbeg = F.gw * rpw, rend = min(M, rbeg + rpw);
    float g2[16]; int cur_mr = -1;
    float alpha_l = ALPHA; asm volatile("" : "+v"(alpha_l));
    for (int r0 = rbeg; r0 < rend; r0 += NR) {
        float v[NR][16]; v4u rt[NR]; v2u ya[NR][4], yb[NR][4]; bool act[NR];
        const int b0 = r0 / TT, t0 = r0 - b0 * TT; const bool lat = t0 < SEQ; const int mr = lat ? b0 : 16;
        if (l == NL && !lat) continue;
#pragma unroll
        for (int u = 0; u < NR; ++u) {
            const int r = r0 + u; act[u] = r < rend; const int rc = act[u] ? r : r0;
            if (l == 0) ld16nt(xin_row(RP, rc), lane, v[u]); else ld16h(RP.xs + (size_t)rc * D, lane, v[u]);
            rt[u] = *(const v4u*)(RT + (size_t)rc * 8 + 4);
        }
        if (mr != cur_mr) { if (l > 0) ld16(mods + ((size_t)(l - 1) * 17 + mr) * 6144 + 5120, lane, g2); cur_mr = mr; }
        if (l > 0) {
#pragma unroll
            for (int u = 0; u < NR; ++u) { ld16bf_raw_nt(Y + (size_t)rt[u].z * D, lane, ya[u]); ld16bf_raw_nt(Y + (size_t)rt[u].w * D, lane, yb[u]); }
#pragma unroll
            for (int u = 0; u < NR; ++u) {
                float f0[16], f1[16], gg[16], bb[16];
                const float w0 = __uint_as_float(rt[u].x), w1 = __uint_as_float(rt[u].y);
                unpack16(ya[u], f0); unpack16(yb[u], f1);
#pragma unroll
                for (int i = 0; i < 16; ++i) v[u][i] = alpha_l * v[u][i] + g2[i] * (w0 * f0[i] + w1 * f1[i]);
                ld16(ln2g, lane, gg); ld16(ln2b, lane, bb);
                ln16(v[u]);
#pragma unroll
                for (int i = 0; i < 16; ++i) v[u][i] = v[u][i] * gg[i] + bb[i];
                if (act[u]) { if (l == NL) st16nt(out_row(RP, r0 + u), lane, v[u]); else st16h(RP.xs + (size_t)(r0 + u) * D, lane, v[u]); }
            }
        }
        if (l < NL) {
            float sh[16], sc[16]; ld16(mods + ((size_t)l * 17 + mr) * 6144, lane, sh); ld16(mods + ((size_t)l * 17 + mr) * 6144 + 1024, lane, sc);
#pragma unroll
            for (int u = 0; u < NR; ++u) {
                ln16(v[u]);
#pragma unroll
                for (int i = 0; i < 16; ++i) v[u][i] = v[u][i] * (1.0f + sc[i]) + sh[i];
                if (act[u]) st16bf(HA + (size_t)(r0 + u) * D, lane, v[u]);
            }
        }
    }
}

__device__ __forceinline__ void rope8(float (&f)[8], const float (&p)[8], const float* cs, bool first) {
    const f32x4* c4 = (const f32x4*)cs;
#pragma unroll
    for (int q = 0; q < 4; ++q) { const f32x4 t = c4[q];
        f[2 * q] = first ? f[2 * q] * t.x - p[2 * q] * t.y : p[2 * q] * t.y + f[2 * q] * t.x;
        f[2 * q + 1] = first ? f[2 * q + 1] * t.z - p[2 * q + 1] * t.w : p[2 * q + 1] * t.w + f[2 * q + 1] * t.z; }
}
#define DPPF(v, ctrl) __builtin_bit_cast(float, __builtin_amdgcn_update_dpp(0, __builtin_bit_cast(int, (v)), (ctrl), 0xf, 0xf, true))
__device__ __forceinline__ float dpp_xor1(float v) { return DPPF(v, 0xB1); }
__device__ __forceinline__ float dpp_xor2(float v) { return DPPF(v, 0x4E); }
__device__ __forceinline__ float dpp_hmir(float v) { return DPPF(v, 0x141); }
__device__ __forceinline__ float dpp_mir(float v) { return DPPF(v, 0x140); }
__device__ __forceinline__ void phase_post(const Frame& F, int l) {
    constexpr int NR = 4;
    bf16* P = (bf16*)(F.ws + WS_PB); bf16* KD = (bf16*)(F.ws + WS_KD);
    const float* t64 = (const float*)(F.ws + WS_T64); const float* t32 = (const float*)(F.ws + WS_T32);
    const int lane = F.lane; const float* gains = (lane < 32 ? INP(I_GQG) : INP(I_GKG)) + l * 64;
    const int j = lane & 7, jj = lane & 3;
    float gn[8];
#pragma unroll
    for (int i = 0; i < 8; ++i) gn[i] = gains[j * 8 + i];
    for (int r0 = F.gw; r0 < M; r0 += NR * F.ngw) {
        v4u w0[NR], w1[NR], w2[NR]; int rr[NR]; bool act[NR];
#pragma unroll
        for (int u = 0; u < NR; ++u) { const int r = r0 + u * F.ngw; act[u] = r < M; rr[u] = act[u] ? r : r0; const bf16* prow = P + (size_t)rr[u] * NPJ;
            w0[u] = *((const v4u*)(prow + 768) + lane); w1[u] = *((const v4u*)(prow + 1280) + lane); w2[u] = *((const v4u*)(prow + 1792) + lane); }
#pragma unroll
        for (int u = 0; u < NR; ++u) {
            const int r = rr[u]; const int b = r / TT, t = r - b * TT; const bool lat = t < SEQ; const int gr = (t >> 6) & 63, gc = t & 63;
            bf16* prow = P + (size_t)r * NPJ;
            const float* cs64 = t64 + ((size_t)((j < 4 ? gr : gc) * 16 + (j & 1) * 8)) * 2;
            {
                float f[8]; unpack8(w0[u], f);
                float ss = 0.f;
#pragma unroll
                for (int i = 0; i < 8; ++i) ss += f[i] * f[i];
                ss += dpp_xor1(ss); ss += dpp_xor2(ss); ss += dpp_hmir(ss);
                const float rs = __builtin_amdgcn_rsqf(ss * (1.0f / 64.0f) + EPS);
#pragma unroll
                for (int i = 0; i < 8; ++i) f[i] = f[i] * rs * gn[i];
                float p[8];
#pragma unroll
                for (int i = 0; i < 8; ++i) p[i] = dpp_xor2(f[i]);
                if (lat) rope8(f, p, cs64, (j & 2) == 0);
                if (lane < 48 && act[u]) *((v4u*)(prow + 768) + lane) = pack8(f);
            }
            {
                float f[8]; unpack8(w1[u], f);
                float p[8];
#pragma unroll
                for (int i = 0; i < 8; ++i) p[i] = dpp_xor2(f[i]);
                rope8(f, p, cs64, (j & 2) == 0);
                if (lat && lane < 48 && act[u]) *((v4u*)(prow + 1280) + lane) = pack8(f);
            }
            {
                float f[8]; unpack8(w2[u], f);
                float ss = 0.f;
#pragma unroll
                for (int i = 0; i < 8; ++i) ss += f[i] * f[i];
                ss += dpp_xor1(ss); ss += dpp_xor2(ss); ss += dpp_hmir(ss); ss += dpp_mir(ss);
                const float s32 = __builtin_bit_cast(float, __builtin_amdgcn_readlane(__builtin_bit_cast(int, ss), 0)) + __builtin_bit_cast(float, __builtin_amdgcn_readlane(__builtin_bit_cast(int, ss), 16));
                const float rn = __builtin_amdgcn_rsqf(lane < 32 ? s32 * (1.0f / 256.0f) + EPS : ss * (1.0f / 128.0f) + EPS);
                if (lane < 48 && act[u]) { float fn[8];
#pragma unroll
                    for (int i = 0; i < 8; ++i) fn[i] = f[i] * rn;
                    *((v4u*)(prow + 1792) + lane) = pack8(fn); }
                float p[8];
#pragma unroll
                for (int i = 0; i < 8; ++i) p[i] = dpp_xor1(f[i]);
                if (lat) rope8(f, p, t32 + ((size_t)((jj < 2 ? gr : gc) * 8)) * 2, (jj & 1) == 0);
                if (lane >= 48 && lane < 52 && act[u]) { const v4u o = pack8(f);
#pragma unroll
                    for (int h = 0; h < 4; ++h) *(v4u*)(KD + (size_t)r * 384 + h * 96 + 64 + 8 * jj) = o; }
            }
        }
    }
}

__device__ __forceinline__ float rt_dot(const float (&x)[16], f32x4 w0, f32x4 w1, f32x4 w2, f32x4 w3) {
    float a = x[0] * w0.x, b = x[8] * w2.x;
    a = __builtin_fmaf(x[1], w0.y, a); b = __builtin_fmaf(x[9], w2.y, b); a = __builtin_fmaf(x[2], w0.z, a); b = __builtin_fmaf(x[10], w2.z, b);
    a = __builtin_fmaf(x[3], w0.w, a); b = __builtin_fmaf(x[11], w2.w, b); a = __builtin_fmaf(x[4], w1.x, a); b = __builtin_fmaf(x[12], w3.x, b);
    a = __builtin_fmaf(x[5], w1.y, a); b = __builtin_fmaf(x[13], w3.y, b); a = __builtin_fmaf(x[6], w1.z, a); b = __builtin_fmaf(x[14], w3.z, b);
    a = __builtin_fmaf(x[7], w1.w, a); b = __builtin_fmaf(x[15], w3.w, b);
    return a + b;
}
__device__ __forceinline__ void reduce4(float& a, float& b, float& c, float& d) {
    auto r1 = __builtin_amdgcn_permlane32_swap(__builtin_bit_cast(unsigned, a), __builtin_bit_cast(unsigned, b), false, false); const unsigned x0 = r1[0], x1 = r1[1];
    auto r2 = __builtin_amdgcn_permlane32_swap(__builtin_bit_cast(unsigned, c), __builtin_bit_cast(unsigned, d), false, false); const unsigned y0 = r2[0], y1 = r2[1];
    const float X = __uint_as_float(x0) + __uint_as_float(x1), Y = __uint_as_float(y0) + __uint_as_float(y1);
    auto r3 = __builtin_amdgcn_permlane16_swap(__builtin_bit_cast(unsigned, X), __builtin_bit_cast(unsigned, Y), false, false); const unsigned z0 = r3[0], z1 = r3[1];
    float z = __uint_as_float(z0) + __uint_as_float(z1);
    z += dpp_xor1(z); z += dpp_xor2(z); z += dpp_hmir(z); z += dpp_mir(z);
    const int zi = __builtin_bit_cast(int, z);
    a = __builtin_bit_cast(float, __builtin_amdgcn_readlane(zi, 0)); c = __builtin_bit_cast(float, __builtin_amdgcn_readlane(zi, 16));
    b = __builtin_bit_cast(float, __builtin_amdgcn_readlane(zi, 32)); d = __builtin_bit_cast(float, __builtin_amdgcn_readlane(zi, 48));
}
__device__ __forceinline__ void ln16_pair(float (&v0)[16], float (&v1)[16]) {
    float s0 = 0.f, q0 = 0.f, s1 = 0.f, q1 = 0.f;
#pragma unroll
    for (int i = 0; i < 16; ++i) { s0 += v0[i]; q0 = __builtin_fmaf(v0[i], v0[i], q0); s1 += v1[i]; q1 = __builtin_fmaf(v1[i], v1[i], q1); }
    reduce4(s0, q0, s1, q1);
    const float m0 = s0 * (1.0f / D), m1 = s1 * (1.0f / D);
    const float r0 = __builtin_amdgcn_rsqf(fmaxf(q0 * (1.0f / D) - m0 * m0, 0.f) + EPS), r1 = __builtin_amdgcn_rsqf(fmaxf(q1 * (1.0f / D) - m1 * m1, 0.f) + EPS);
    const float c0 = -m0 * r0, c1 = -m1 * r1;
#pragma unroll
    for (int i = 0; i < 16; ++i) { v0[i] = __builtin_fmaf(v0[i], r0, c0); v1[i] = __builtin_fmaf(v1[i], r1, c1); }
}
__device__ __forceinline__ void phase_route(const Frame& F, int l) {
    const float* mods = (const float*)(F.ws + WS_MODS); bf16* HA = (bf16*)(F.ws + WS_HA);
    const bf16* MIX = (const bf16*)(F.ws + WS_PB); unsigned* RT = (unsigned*)(F.ws + WS_RT); int* HIST = (int*)(F.ws + WS_HIST);
    LAS float* WR = (LAS float*)F.lds;
    { const float* rgw = INP(I_RGW); const float* rew = INP(I_REW);
      for (int i = F.tid; i < 20 * 1024; i += NTHR) { const int jx = i >> 10, k = i & 1023;
        WR[i] = jx < 4 ? rgw[((size_t)l * D + k) * 4 + jx] : rew[((size_t)l * D + k) * 16 + (jx - 4)]; } }
    if (F.tid < 16) F.MISC[MI_LH + F.tid] = 0u;
    __syncthreads();
    LAS float* bias = (LAS float*)(F.lds + 20 * 1024 * 4);
    if (F.tid < 20) bias[F.tid] = F.tid < 4 ? INP(I_RGB)[l * 4 + F.tid] : INP(I_REB)[l * 16 + (F.tid - 4)];
    __syncthreads();
    const RowPtrs RP = row_ptrs(F);
    LAS float* LNG = (LAS float*)(F.lds + 20 * 1024 * 4 + 128);
    { const float* ln1g = INP(I_LN1G) + l * D; const float* ln1b = INP(I_LN1B) + l * D;
      for (int i = F.tid; i < 1024; i += NTHR) { LNG[i] = ln1g[i]; LNG[1024 + i] = ln1b[i]; } }
    __syncthreads();
    constexpr int NR = 2;
    const LAS unsigned char* wbase = (const LAS unsigned char*)WR + F.lane * 16; asm volatile("" : "+v"(wbase));
    const LAS unsigned char* lbase = (const LAS unsigned char*)LNG + F.lane * 16; asm volatile("" : "+v"(lbase));
#define RT_W4(base_, off_) (*(const LAS f32x4*)((base_) + (off_)))
    const int rpw = rows_per_wave(F.ngw), rbeg = F.gw * rpw, rend = min(M, rbeg + rpw);
    float g1[16], sh[16], sc[16]; int cur_mr = -1;
    float alpha_l = ALPHA; asm volatile("" : "+v"(alpha_l));
    v4u rx[NR][4]; v2u rm[NR][4];
#define RT_ISSUE(r0_) do { _Pragma("unroll") for (int u = 0; u < NR; ++u) { const int r_ = (r0_) + u, rc_ = r_ < rend ? r_ : (r0_); \
        if (l == 0) { const v4u* q_ = (const v4u*)xin_row(RP, rc_) + F.lane; _Pragma("unroll") for (int g = 0; g < 4; ++g) rx[u][g] = __builtin_nontemporal_load(q_ + 64 * g); } \
        else { const v2u* q_ = (const v2u*)(RP.xs + (size_t)rc_ * D) + F.lane; _Pragma("unroll") for (int g = 0; g < 4; ++g) { const v2u t_ = __builtin_nontemporal_load(q_ + 64 * g); rx[u][g].x = t_.x; rx[u][g].y = t_.y; } } \
        ld16bf_raw_nt(MIX + (size_t)rc_ * D, F.lane, rm[u]); } } while (0)
    if (rbeg < rend) RT_ISSUE(rbeg);
    for (int r0 = rbeg; r0 < rend; r0 += NR) {
        float v[NR][16]; int rr[NR]; bool act[NR];
        { const int b = r0 / TT, t = r0 - b * TT, mr = t < SEQ ? b : 16;
          if (mr != cur_mr) { const float* md = mods + ((size_t)l * 17 + mr) * 6144; ld16(md + 2048, F.lane, g1); ld16(md + 3072, F.lane, sh); ld16(md + 4096, F.lane, sc); cur_mr = mr; } }
#pragma unroll
        for (int u = 0; u < NR; ++u) { const int r = r0 + u; act[u] = r < rend; rr[u] = act[u] ? r : r0;
            float mx[16]; unpack16(rm[u], mx);
            if (l == 0) {
#pragma unroll
                for (int g = 0; g < 4; ++g) { v[u][4 * g] = __uint_as_float(rx[u][g].x); v[u][4 * g + 1] = __uint_as_float(rx[u][g].y); v[u][4 * g + 2] = __uint_as_float(rx[u][g].z); v[u][4 * g + 3] = __uint_as_float(rx[u][g].w); }
            } else {
#pragma unroll
                for (int g = 0; g < 4; ++g) { const v2u t = {rx[u][g].x, rx[u][g].y}; const f32x4 f = __builtin_convertvector(__builtin_bit_cast(f16x4, t), f32x4);
                    v[u][4 * g] = f.x; v[u][4 * g + 1] = f.y; v[u][4 * g + 2] = f.z; v[u][4 * g + 3] = f.w; }
            }
#pragma unroll
            for (int i = 0; i < 16; ++i) v[u][i] = alpha_l * v[u][i] + g1[i] * mx[i]; }
        if (r0 + NR < rend) RT_ISSUE(r0 + NR);
        if (l == NL - 1 && (r0 % TT) >= SEQ) continue;
        ln16_pair(v[0], v[1]);
        { float gg[16], bb[16];
#pragma unroll
          for (int g = 0; g < 4; ++g) { const f32x4 a = RT_W4(lbase, 1024 * g), c = RT_W4(lbase, 4096 + 1024 * g);
              gg[4 * g] = a.x; gg[4 * g + 1] = a.y; gg[4 * g + 2] = a.z; gg[4 * g + 3] = a.w; bb[4 * g] = c.x; bb[4 * g + 1] = c.y; bb[4 * g + 2] = c.z; bb[4 * g + 3] = c.w; }
#pragma unroll
          for (int u = 0; u < NR; ++u) {
#pragma unroll
            for (int i = 0; i < 16; ++i) v[u][i] = v[u][i] * gg[i] + bb[i];
            if (act[u]) st16h(RP.xs + (size_t)rr[u] * D, F.lane, v[u]); } }
        ln16_pair(v[0], v[1]);
#pragma unroll
        for (int u = 0; u < NR; ++u) {
#pragma unroll
            for (int i = 0; i < 16; ++i) v[u][i] = v[u][i] * (1.0f + sc[i]) + sh[i];
            if (act[u]) st16bf(HA + (size_t)rr[u] * D, F.lane, v[u]); }
#define RT_DOT(u_, w0, w1, w2, w3) rt_dot(v[u_], w0, w1, w2, w3)
        float gl[NR][4];
#pragma unroll
        for (int jx = 0; jx < 4; ++jx) {
            const f32x4 w0 = RT_W4(wbase, 4096 * jx), w1 = RT_W4(wbase, 4096 * jx + 1024), w2 = RT_W4(wbase, 4096 * jx + 2048), w3 = RT_W4(wbase, 4096 * jx + 3072);
#pragma unroll
            for (int u = 0; u < NR; ++u) gl[u][jx] = RT_DOT(u, w0, w1, w2, w3);
        }
#pragma unroll
        for (int u = 0; u < NR; ++u) { reduce4(gl[u][0], gl[u][1], gl[u][2], gl[u][3]);
#pragma unroll
            for (int jx = 0; jx < 4; ++jx) gl[u][jx] += bias[jx]; }
        int grpv[NR]; float pgv[NR];
#pragma unroll
        for (int u = 0; u < NR; ++u) {
            int grp = 0; float mg = gl[u][0];
#pragma unroll
            for (int g = 1; g < 4; ++g) if (gl[u][g] > mg) { mg = gl[u][g]; grp = g; }
            float sg = 0.f;
#pragma unroll
            for (int g = 0; g < 4; ++g) sg += __builtin_amdgcn_exp2f((gl[u][g] - mg) * LOG2E);
            grpv[u] = grp; pgv[u] = __builtin_amdgcn_rcpf(sg);
        }
        float selv[NR][4];
#pragma unroll
        for (int u = 0; u < NR; ++u) {
            const LAS unsigned char* eb = wbase + (4 + 4 * grpv[u]) * 4096;
#pragma unroll
            for (int i = 0; i < 4; ++i) {
                const f32x4 w0 = RT_W4(eb, 4096 * i), w1 = RT_W4(eb, 4096 * i + 1024), w2 = RT_W4(eb, 4096 * i + 2048), w3 = RT_W4(eb, 4096 * i + 3072);
                selv[u][i] = RT_DOT(u, w0, w1, w2, w3);
            }
        }
#pragma unroll
        for (int u = 0; u < NR; ++u) { reduce4(selv[u][0], selv[u][1], selv[u][2], selv[u][3]);
#pragma unroll
            for (int i = 0; i < 4; ++i) selv[u][i] += bias[4 + 4 * grpv[u] + i]; }
#undef RT_DOT
#pragma unroll
        for (int u = 0; u < NR; ++u) {
            const int grp = grpv[u]; const float pg = pgv[u];
            float sel[4];
#pragma unroll
            for (int i = 0; i < 4; ++i) sel[i] = selv[u][i];
            int i1 = 0; float v1 = sel[0];
#pragma unroll
            for (int i = 1; i < 4; ++i) if (sel[i] > v1) { v1 = sel[i]; i1 = i; }
            int i2 = -1; float v2 = -3.0e38f;
#pragma unroll
            for (int i = 0; i < 4; ++i) if (i != i1 && (i2 < 0 || sel[i] > v2)) { v2 = sel[i]; i2 = i; }
            const float ee = __builtin_amdgcn_exp2f((v2 - v1) * LOG2E), rq = __builtin_amdgcn_rcpf(1.0f + ee), w1 = pg * rq, w2 = pg * ee * rq;
            const int e1 = grp * 4 + i1, e2 = grp * 4 + i2;
            if (F.lane == 0 && act[u]) {
                const unsigned k1 = __hip_atomic_fetch_add((LAS unsigned*)&F.MISC[MI_LH + e1], 1u, __ATOMIC_RELAXED, __HIP_MEMORY_SCOPE_WORKGROUP);
                const unsigned k2 = __hip_atomic_fetch_add((LAS unsigned*)&F.MISC[MI_LH + e2], 1u, __ATOMIC_RELAXED, __HIP_MEMORY_SCOPE_WORKGROUP);
                v4u ra; ra.x = (unsigned)e1; ra.y = (unsigned)e2; ra.z = k1; ra.w = k2;
                v4u rb; rb.x = __builtin_bit_cast(unsigned, w1); rb.y = __builtin_bit_cast(unsigned, w2); rb.z = 0u; rb.w = 0u;
                *(v4u*)(RT + (size_t)rr[u] * 8) = ra; *(v4u*)(RT + (size_t)rr[u] * 8 + 4) = rb;
            }
        }
    }
#undef RT_ISSUE
#undef RT_W4
    __syncthreads();
    if (F.tid < 16) HIST[F.bid * 16 + F.tid] = (int)F.MISC[MI_LH + F.tid];
}
__device__ __forceinline__ void moe_tables(const Frame& F) {
    const int* HIST = (const int*)(F.ws + WS_HIST); LAS int* hl = (LAS int*)F.lds;
    __syncthreads();
    for (int i = F.tid; i < F.G * 16; i += NTHR) hl[i] = HIST[i];
    __syncthreads();
    if (F.tid < 16) { int tot = 0, mine = 0; for (int g = 0; g < F.G; ++g) { const int c = hl[g * 16 + F.tid]; tot += c; mine += (g < F.bid) ? c : 0; }
        F.MISC[MI_TOT + F.tid] = (unsigned)tot; F.MISC[MI_BASE + F.tid] = (unsigned)mine; }
    __syncthreads();
    if (F.tid == 0) { unsigned p = 0; for (int e = 0; e < 16; ++e) { F.MISC[MI_PST + e] = p; F.MISC[MI_BASE + e] += p * 256u; p += (F.MISC[MI_TOT + e] + 255u) >> 8; } F.MISC[MI_PST + 16] = p; }
    __syncthreads();
}
__device__ __forceinline__ void phase_permute(const Frame& F, int l) {
    unsigned* RT = (unsigned*)(F.ws + WS_RT); int* SRC = (int*)(F.ws + WS_QD);
    moe_tables(F);
    const int rpw = rows_per_wave(F.ngw), rbeg = F.gw * rpw, rend = min(M, rbeg + rpw);
    for (int r = rbeg + F.lane; r < rend; r += 64) {
        if (l == NL - 1 && (r % TT) >= SEQ) continue;
        const v4u ra = *(const v4u*)(RT + (size_t)r * 8);
        const unsigned p0 = F.MISC[MI_BASE + (ra.x & 15u)] + ra.z, p1 = F.MISC[MI_BASE + (ra.y & 15u)] + ra.w;
        RT[(size_t)r * 8 + 6] = p0; RT[(size_t)r * 8 + 7] = p1; SRC[p0] = r; SRC[p1] = r;
    }
    if (F.bid == 0) {
        for (int e = 0; e < 16; ++e) { const int beg = (int)F.MISC[MI_PST + e] * 256 + (int)F.MISC[MI_TOT + e], end = (int)F.MISC[MI_PST + e + 1] * 256;
            for (int p = beg + F.tid; p < end; p += NTHR) SRC[p] = 0; }
    }
}

struct EpiMla {
    static constexpr bool PERM = true, AFTER_DRAIN = false;
    bf16* QD; bf16* KD; bf16* VD;
    __device__ __forceinline__ void operator()(const pg8::f32x4 (&acc)[2][2][4][2], const pg8::Unit& u, int wr, int wc, int fr, int fq) const {
#pragma unroll
        for (int bj = 0; bj < 2; ++bj) {
            const int g0 = u.pn * 256 + bj * 128 + wc * 32, col0 = g0 + 8 * fq;
            if (g0 >= 896) continue;
            const int c = col0 - 384, hd = c >> 7, jx = c & 127;
            bf16* dst = g0 < 384 ? QD + col0 : jx < 64 ? KD + hd * 96 + jx : VD + hd * 64 + (jx - 64);
            const int stride = (g0 < 384 || jx < 64) ? 384 : 256;
            dst += (size_t)(u.pm * 256 + wr * 64 + fr) * stride;
#pragma unroll
            for (int ai = 0; ai < 2; ++ai)
#pragma unroll
                for (int m = 0; m < 4; ++m) {
                    v4u o; o.x = pk2(acc[ai][bj][m][0][0], acc[ai][bj][m][0][1]); o.y = pk2(acc[ai][bj][m][0][2], acc[ai][bj][m][0][3]);
                    o.z = pk2(acc[ai][bj][m][1][0], acc[ai][bj][m][1][1]); o.w = pk2(acc[ai][bj][m][1][2], acc[ai][bj][m][1][3]);
                    *(v4u*)(dst + (size_t)(ai * 128 + m * 16) * stride) = o;
                }
        }
    }
};
struct EpiGU {
    static constexpr bool PERM = true, AFTER_DRAIN = false;
    bf16* ACT;
    __device__ __forceinline__ void operator()(const pg8::f32x4 (&acc)[2][2][4][2], const pg8::Unit& u, int wr, int wc, int fr, int fq) const {
#pragma unroll
        for (int ai = 0; ai < 2; ++ai)
#pragma unroll
            for (int m = 0; m < 4; ++m) {
                const int row = u.pm * 256 + ai * 128 + wr * 64 + m * 16 + fr;
#pragma unroll
                for (int bj = 0; bj < 2; ++bj) {
                    const int c = (u.pn & 3) * 256 + bj * 128 + wc * 32 + 8 * fq;
                    float o[4];
#pragma unroll
                    for (int i = 0; i < 4; ++i) { const float g = acc[ai][bj][m][0][i], up = acc[ai][bj][m][1][i]; o[i] = g * __builtin_amdgcn_rcpf(1.0f + __expf(-g)) * up; }
                    v2u w; w.x = pk2(o[0], o[1]); w.y = pk2(o[2], o[3]);
                    *(v2u*)(ACT + (size_t)row * 512 + (c >> 1)) = w;
                }
            }
    }
};
struct MoeOrder {
    volatile LAS unsigned* pst; int G, c;
    __device__ __forceinline__ bool next(int i, pg8::Unit& u) const {
        const int np = (int)pst[16]; int panel, pn;
        if ((G & 7) == 0) { const int x = c & 7, uu = i * (G >> 3) + (c >> 3); panel = (uu >> 2) * 8 + x; pn = uu & 3; }
        else { const int L = i * G + c; panel = L >> 2; pn = L & 3; }
        if (panel >= np) return false;
        int e = 0;
#pragma unroll
        for (int k = 1; k < 16; ++k) e += (panel >= (int)pst[k]) ? 1 : 0;
        u.pm = __builtin_amdgcn_readfirstlane(panel); u.pn = __builtin_amdgcn_readfirstlane(e * 4 + pn); return true;
    }
    __device__ __forceinline__ void a_ready(const pg8::Unit&) const {}
    __device__ __forceinline__ void done(const pg8::Unit&) const {}
};

struct LatOrder {
    int G, c;
    __device__ __forceinline__ bool next(int i, pg8::Unit& u) const {
        int pl, pn;
        if ((G & 7) == 0) { const int x = c & 7, uu = i * (G >> 3) + (c >> 3); pl = (uu >> 2) * 8 + x; pn = uu & 3; } else { const int L = i * G + c; pl = L >> 2; pn = L & 3; }
        if (pl >= NB * 16) return false;
        u.pm = pl + (pl >> 4); u.pn = pn; return true;
    }
    __device__ __forceinline__ void a_ready(const pg8::Unit&) const {}
    __device__ __forceinline__ void done(const pg8::Unit&) const {}
};

#ifndef DBG_VAR
#define DBG_VAR 1
#endif
namespace att {
constexpr int VRS = 192, KBUF = 64 * 208, VBUF = 64 * VRS, BUF = KBUF + VBUF, BIAS_OFF = 4 * BUF;
constexpr float NEG = -30000.0f;
__device__ __forceinline__ int crow(int r, int hi) { return (r & 3) + 8 * (r >> 2) + 4 * hi; }
__device__ __forceinline__ float xhalf_max(float v) { const unsigned a = __builtin_bit_cast(unsigned, v);
    auto rr = __builtin_amdgcn_permlane32_swap(a, a, false, false); const unsigned r0 = rr[0], r1 = rr[1]; return fmaxf(__uint_as_float(r0), __uint_as_float(r1)); }
__device__ __forceinline__ float xhalf_sum(float v) { const unsigned a = __builtin_bit_cast(unsigned, v);
    auto rr = __builtin_amdgcn_permlane32_swap(a, a, false, false); const unsigned r0 = rr[0], r1 = rr[1]; return __uint_as_float(r0) + __uint_as_float(r1); }
__device__ __forceinline__ float max3f(float a, float b, float c) { float r; asm("v_max3_f32 %0, %1, %2, %3" : "=v"(r) : "v"(a), "v"(b), "v"(c)); return r; }
typedef __bf16 bf16x2_t __attribute__((ext_vector_type(2)));
__device__ __forceinline__ unsigned cvtpk(float lo, float hi) { f32x2 v = {lo, hi}; bf16x2_t b = __builtin_convertvector(v, bf16x2_t); return __builtin_bit_cast(unsigned, b); }

template <int DK, int VM = 0>
__device__ __forceinline__ void unit(LAS unsigned char* lds, const bf16* Qp, int qpitch, const bf16* Kp, int kpitch, const bf16* Vp, int vpitch, bf16* Op,
                                     int var, int qt, int lo, int n1, int nt, float qscale, float sinkl2, bool has_sink, const LAS float* bias, const float* t32, unsigned* dbg) {
    constexpr int KRS = DK * 2 + 16, NS = DK / 16, CPK = DK / 8;
    int tid = threadIdx.x; asm volatile("" : "+v"(tid)); const int lane = tid & 63, r32 = lane & 31, hi = lane >> 5, wid = __builtin_amdgcn_readfirstlane(tid >> 6);
    const int qrow = 256 * qt + 32 * wid + r32;
    bf16x8 qr[NS];
#pragma unroll
    for (int s = 0; s < NS; ++s) { const v4u raw = *(const v4u*)(Qp + (size_t)qrow * qpitch + 16 * s + 8 * hi); float f[8]; unpack8(raw, f);
#pragma unroll
        for (int i = 0; i < 8; ++i) f[i] *= qscale;
        if (DK == 96 && s >= 4) {
            float p[8];
#pragma unroll
            for (int i = 0; i < 8; ++i) p[i] = __shfl_xor(f[i], 32);
            if (qt < 16) rope8(f, p, t32 + ((size_t)((s == 4 ? (qrow >> 6) : (qrow & 63)) * 8)) * 2, hi == 0);
        }
        qr[s] = __builtin_bit_cast(bf16x8, pack8(f)); }
    const int kkey0 = tid / CPK, kch0 = tid - kkey0 * CPK, kkey1 = (tid + 512) / CPK, kch1 = (tid + 512) - kkey1 * CPK;
    const int vkey = tid >> 3, vch = tid & 7;
    v4u kreg0, kreg1 = {0u, 0u, 0u, 0u}, vreg;
#define ATT_TROW(j) ((((j) < n1) ? (lo + (j)) : (64 + (j) - n1)) * 64)
#define ATT_LOAD(j) do { const int tr_ = ATT_TROW(j); kreg0 = *(const v4u*)(Kp + (size_t)(tr_ + kkey0) * kpitch + kch0 * 8); \
        if (DK == 96 && tid < 256) kreg1 = *(const v4u*)(Kp + (size_t)(tr_ + kkey1) * kpitch + kch1 * 8); \
        vreg = *(const v4u*)(Vp + (size_t)(tr_ + vkey) * vpitch + vch * 8); } while (0)
#define ATT_STORE(bf) do { LAS unsigned char* b_ = lds + (bf) * BUF; *(LAS v4u*)(b_ + kkey0 * KRS + kch0 * 16) = kreg0; \
        if (DK == 96 && tid < 256) *(LAS v4u*)(b_ + kkey1 * KRS + kch1 * 16) = kreg1; \
        *(LAS v4u*)(b_ + KBUF + vkey * VRS + vch * 16) = vreg; } while (0)
    constexpr float THR = 6.0f;
    float m = 0.f; f32x2 lacc = {0.f, 0.f}; f32x16 o0 = {}, o1 = {}; f32x16 negm = {}; bool first = true;
    const int grw = 4 * qt + (wid >> 1), r0w = min(max(grw - 4, 0), 56), gc = (wid & 1) * 32 + r32, c0 = min(max(gc - 8, 0), 48), i0w = 256 * qt + 32 * wid;
    ATT_LOAD(0); ATT_STORE(0);
    __syncthreads();
    for (int j = 0; j < nt; ++j) {
        if (!(VM & 8) && j + 1 < nt) ATT_LOAD(j + 1);
        const int kt = ATT_TROW(j) >> 6;
        bool actv = true;
        if (kt < 64) { if (var == 0) actv = (kt >= r0w) && (kt <= r0w + 7); else if (var == 2) actv = !((64 * kt - (i0w + 31) > 128) || (i0w - (64 * kt + 63) > 128)); }
        if (actv) {
            const LAS unsigned char* Kb = lds + (j & 1) * BUF; const LAS unsigned char* Vb = Kb + KBUF;
            f32x16 s0 = negm, s1 = negm;
            bf16x8 ka[NS], kb[NS];
#pragma unroll
            for (int s = 0; s < NS; ++s) { ka[s] = *(const LAS bf16x8*)(Kb + r32 * KRS + (16 * s + 8 * hi) * 2); kb[s] = *(const LAS bf16x8*)(Kb + (32 + r32) * KRS + (16 * s + 8 * hi) * 2); }
            __builtin_amdgcn_sched_barrier(0);
            if (VM & 2) {
#pragma unroll
                for (int s = 0; s < NS; ++s) asm volatile("" :: "v"(ka[s]), "v"(kb[s]), "v"(qr[s]));
            } else {
#pragma unroll
            for (int s = 0; s < NS; ++s) { s0 = __builtin_amdgcn_mfma_f32_32x32x16_bf16(ka[s], qr[s], s0, 0, 0, 0); s1 = __builtin_amdgcn_mfma_f32_32x32x16_bf16(kb[s], qr[s], s1, 0, 0, 0); }
            }
            asm volatile("s_nop 15\n\ts_nop 7" : "+v"(s0), "+v"(s1));
            if (kt < 64 && var == 0) {
                const int rowoff = (kt - grw + 7) * 31 - gc + 15;
#pragma unroll
                for (int r = 0; r < 16; ++r) { const int j0 = crow(r, hi), j1 = j0 + 32;
                    const bool v0 = (unsigned)(j0 - c0) < 16u, v1 = (unsigned)(j1 - c0) < 16u;
                    const float b0 = bias[v0 ? rowoff + j0 : 0], b1 = bias[v1 ? rowoff + j1 : 0];
                    s0[r] = v0 ? s0[r] + b0 : NEG; s1[r] = v1 ? s1[r] + b1 : NEG; }
            } else if (kt < 64 && var == 2) {
                const int dbase = 64 * kt - qrow + 128;
#pragma unroll
                for (int r = 0; r < 16; ++r) { const int j0 = crow(r, hi);
                    s0[r] = (unsigned)(dbase + j0) <= 256u ? s0[r] : NEG; s1[r] = (unsigned)(dbase + j0 + 32) <= 256u ? s1[r] : NEG; }
            }
            if (!(VM & 4)) {
            float mxa = max3f(s0[0], s0[1], s1[0]), mxb = max3f(s0[2], s0[3], s1[1]); mxa = max3f(mxa, s1[2], s1[3]);
#pragma unroll
            for (int r = 4; r < 16; r += 4) { mxa = max3f(mxa, s0[r], s0[r + 1]); mxb = max3f(mxb, s0[r + 2], s0[r + 3]); mxa = max3f(mxa, s1[r], s1[r + 1]); mxb = max3f(mxb, s1[r + 2], s1[r + 3]); }
            const float mx = xhalf_max(fmaxf(mxa, mxb));
            if (first || __any(mx > THR)) {
                const float d = first ? fmaxf(mx, -64.0f) : fmaxf(mx, 0.f), alpha = __builtin_amdgcn_exp2f(-d);
                m += d; first = false;
#pragma unroll
                for (int r = 0; r < 16; ++r) { s0[r] -= d; s1[r] -= d; o0[r] *= alpha; o1[r] *= alpha; negm[r] = -m; }
                lacc *= alpha;
            }
#pragma unroll
            for (int r = 0; r < 16; ++r) { s0[r] = __builtin_amdgcn_exp2f(s0[r]); s1[r] = __builtin_amdgcn_exp2f(s1[r]); lacc += (f32x2){s0[r], s1[r]}; }
            }
            bf16x8 pb[4];
#pragma unroll
            for (int s = 0; s < 2; ++s) {
                v4u w; w.x = cvtpk(s0[8 * s], s0[8 * s + 1]); w.y = cvtpk(s0[8 * s + 2], s0[8 * s + 3]); w.z = cvtpk(s0[8 * s + 4], s0[8 * s + 5]); w.w = cvtpk(s0[8 * s + 6], s0[8 * s + 7]);
                pb[s] = __builtin_bit_cast(bf16x8, w);
                v4u x; x.x = cvtpk(s1[8 * s], s1[8 * s + 1]); x.y = cvtpk(s1[8 * s + 2], s1[8 * s + 3]); x.z = cvtpk(s1[8 * s + 4], s1[8 * s + 5]); x.w = cvtpk(s1[8 * s + 6], s1[8 * s + 7]);
                pb[2 + s] = __builtin_bit_cast(bf16x8, x);
            }
            if (VM & 1) { asm volatile("" :: "v"(pb[0]), "v"(pb[1]), "v"(pb[2]), "v"(pb[3])); } else {
            const LAS unsigned char* vbase = Vb + (4 * hi + ((lane & 15) >> 2)) * VRS + ((lane >> 4) & 1) * 32 + (lane & 3) * 8;
#pragma unroll
            for (int s = 0; s < 4; ++s) {
                const v4i16 a0 = __builtin_amdgcn_ds_read_tr16_b64_v4i16((LAS v4i16*)(vbase + (16 * s) * VRS));
                const v4i16 a1 = __builtin_amdgcn_ds_read_tr16_b64_v4i16((LAS v4i16*)(vbase + (16 * s + 8) * VRS));
                const v4i16 c0_ = __builtin_amdgcn_ds_read_tr16_b64_v4i16((LAS v4i16*)(vbase + (16 * s) * VRS + 64));
                const v4i16 c1_ = __builtin_amdgcn_ds_read_tr16_b64_v4i16((LAS v4i16*)(vbase + (16 * s + 8) * VRS + 64));
                const bf16x8 va = {a0[0], a0[1], a0[2], a0[3], a1[0], a1[1], a1[2], a1[3]};
                const bf16x8 vc = {c0_[0], c0_[1], c0_[2], c0_[3], c1_[0], c1_[1], c1_[2], c1_[3]};
                o0 = __builtin_amdgcn_mfma_f32_32x32x16_bf16(va, pb[s], o0, 0, 0, 0);
                o1 = __builtin_amdgcn_mfma_f32_32x32x16_bf16(vc, pb[s], o1, 0, 0, 0);
            }
            }
        }
        if (!(VM & 8) && j + 1 < nt) ATT_STORE((j + 1) & 1);
        if (!(VM & 16)) __syncthreads();
    }
    float l = xhalf_sum(lacc.x + lacc.y);
    const float sterm = has_sink ? __builtin_amdgcn_exp2f(sinkl2 - m) : 0.f;
#if MK_DEBUG
    if (dbg && hi == 0) { dbg[(size_t)qrow * 2] = __builtin_bit_cast(unsigned, m); dbg[(size_t)qrow * 2 + 1] = __builtin_bit_cast(unsigned, l); }
#endif
    if (has_sink) l += sterm;
    const float inv = 1.0f / l;
    bf16* orow = Op + (size_t)qrow * D;
#pragma unroll
    for (int g = 0; g < 4; ++g) {
        v2u w0; w0.x = pk2(o0[4 * g] * inv, o0[4 * g + 1] * inv); w0.y = pk2(o0[4 * g + 2] * inv, o0[4 * g + 3] * inv);
        v2u w1; w1.x = pk2(o1[4 * g] * inv, o1[4 * g + 1] * inv); w1.y = pk2(o1[4 * g + 2] * inv, o1[4 * g + 3] * inv);
        *(v2u*)(orow + 8 * g + 4 * hi) = w0; *(v2u*)(orow + 32 + 8 * g + 4 * hi) = w1;
    }
#undef ATT_TROW
#undef ATT_LOAD
#undef ATT_STORE
}

template <int DK, int MODE, int VM = 0, bool NOREF = false>
__device__ __forceinline__ void unit2(LAS unsigned char* lds, const bf16* Qp, int qpitch, const bf16* Kp, int kpitch, const bf16* Vp, int vpitch, bf16* Op,
                                      int var, int qt, int lo, int n1, int nt, float qscale, float sink0, float sink1, bool has_sink, const LAS float* bias, const float* t32) {
    constexpr int KRS = DK * 2 + 16, NS = DK / 16, CPK = DK / 8;
    int tid = threadIdx.x; asm volatile("" : "+v"(tid)); const int lane = tid & 63, r32 = lane & 31, hi = lane >> 5, wid = __builtin_amdgcn_readfirstlane(tid >> 6);
    const int rowbase = MODE == 0 ? 512 * qt + 64 * wid : 256 * qt + 32 * wid;
    bf16x8 qr[2][NS];
#pragma unroll
    for (int u = 0; u < 2; ++u) {
        const int qrow = rowbase + (MODE == 0 ? 32 * u : 0) + r32;
        const bf16* qp = Qp + (MODE == 1 ? 64 * u : 0) + (size_t)qrow * qpitch;
#pragma unroll
        for (int s = 0; s < NS; ++s) { const v4u raw = *(const v4u*)(qp + 16 * s + 8 * hi); float f[8]; unpack8(raw, f);
#pragma unroll
            for (int i = 0; i < 8; ++i) f[i] *= qscale;
            if (DK == 96 && s >= 4) { float p[8];
#pragma unroll
                for (int i = 0; i < 8; ++i) p[i] = __shfl_xor(f[i], 32);
                rope8(f, p, t32 + ((size_t)((s == 4 ? (qrow >> 6) : (qrow & 63)) * 8)) * 2, hi == 0); }
            qr[u][s] = __builtin_bit_cast(bf16x8, pack8(f)); }
    }
    const int kkey0 = tid / CPK, kch0 = tid - kkey0 * CPK, kkey1 = (tid + 512) / CPK, kch1 = (tid + 512) - kkey1 * CPK;
    const int vkey = tid >> 3, vch = tid & 7;
    v4u kreg0, kreg1 = {0u, 0u, 0u, 0u}, vreg;
#define ATT_TROW(j) ((((j) < n1) ? (lo + (j)) : (64 + (j) - n1)) * 64)
#define ATT_LOAD(j) do { const int tr_ = ATT_TROW(j); kreg0 = *(const v4u*)(Kp + (size_t)(tr_ + kkey0) * kpitch + kch0 * 8); \
        if (DK == 96 && tid < 256) kreg1 = *(const v4u*)(Kp + (size_t)(tr_ + kkey1) * kpitch + kch1 * 8); \
        vreg = *(const v4u*)(Vp + (size_t)(tr_ + vkey) * vpitch + vch * 8); } while (0)
#define ATT_STORE(bf) do { LAS unsigned char* b_ = lds + (bf) * BUF; *(LAS v4u*)(b_ + kkey0 * KRS + kch0 * 16) = kreg0; \
        if (DK == 96 && tid < 256) *(LAS v4u*)(b_ + kkey1 * KRS + kch1 * 16) = kreg1; \
        *(LAS v4u*)(b_ + KBUF + vkey * VRS + vch * 16) = vreg; } while (0)
    constexpr float THR = 6.0f;
    float m = 0.f; f32x2 lacc[2] = {{0.f, 0.f}, {0.f, 0.f}}; f32x16 o0[2] = {{}, {}}, o1[2] = {{}, {}}; bool first = true;
    const int grw = 8 * qt + wid, r0w = min(max(grw - 4, 0), 56), i0w = rowbase;
    ATT_LOAD(0); ATT_STORE(0);
    __syncthreads();
    for (int j = 0; j < nt; ++j) {
        if (!(VM & 8) && j + 1 < nt) ATT_LOAD(j + 1);
        const int kt = ATT_TROW(j) >> 6;
        bool actv = true;
        if (kt < 64) { if (var == 0) actv = (kt >= r0w) && (kt <= r0w + 7); else if (var == 2) actv = !((64 * kt - (i0w + 31) > 128) || (i0w - (64 * kt + 63) > 128)); }
        if (actv) {
            const LAS unsigned char* Kb = lds + (j & 1) * BUF; const LAS unsigned char* Vb = Kb + KBUF;
            f32x16 s0[2] = {{}, {}}, s1[2] = {{}, {}};
#pragma unroll
            for (int s = 0; s < NS; ++s) {
                const bf16x8 ka = *(const LAS bf16x8*)(Kb + r32 * KRS + (16 * s + 8 * hi) * 2);
                const bf16x8 kb = *(const LAS bf16x8*)(Kb + (32 + r32) * KRS + (16 * s + 8 * hi) * 2);
                if (VM & 2) { asm volatile("" :: "v"(ka), "v"(kb), "v"(qr[0][s]), "v"(qr[1][s])); } else {
#pragma unroll
                for (int u = 0; u < 2; ++u) { s0[u] = __builtin_amdgcn_mfma_f32_32x32x16_bf16(ka, qr[u][s], s0[u], 0, 0, 0); s1[u] = __builtin_amdgcn_mfma_f32_32x32x16_bf16(kb, qr[u][s], s1[u], 0, 0, 0); }
                }
            }
            asm volatile("s_nop 15\n\ts_nop 7" : "+v"(s0[0]), "+v"(s1[0]), "+v"(s0[1]), "+v"(s1[1]));
            if (kt < 64 && var == 0) {
#pragma unroll
                for (int u = 0; u < 2; ++u) { const int gc = 32 * u + r32, c0 = min(max(gc - 8, 0), 48), rowoff = (kt - grw + 7) * 31 - gc + 15;
#pragma unroll
                    for (int r = 0; r < 16; ++r) { const int j0 = crow(r, hi), j1 = j0 + 32;
                        const bool v0 = (unsigned)(j0 - c0) < 16u, v1 = (unsigned)(j1 - c0) < 16u;
                        const float b0 = bias[v0 ? rowoff + j0 : 0], b1 = bias[v1 ? rowoff + j1 : 0];
                        s0[u][r] = v0 ? s0[u][r] + b0 : NEG; s1[u][r] = v1 ? s1[u][r] + b1 : NEG; } }
            } else if (kt < 64 && var == 2) {
                const int dbase = 64 * kt - (rowbase + r32) + 128;
#pragma unroll
                for (int r = 0; r < 16; ++r) { const int j0 = crow(r, hi); const bool v0 = (unsigned)(dbase + j0) <= 256u, v1 = (unsigned)(dbase + j0 + 32) <= 256u;
                    s0[0][r] = v0 ? s0[0][r] : NEG; s1[0][r] = v1 ? s1[0][r] : NEG; s0[1][r] = v0 ? s0[1][r] : NEG; s1[1][r] = v1 ? s1[1][r] : NEG; }
            }
            if (!(VM & 4)) {
            if (!NOREF) {
            float mxa = max3f(s0[0][0], s0[0][1], s1[0][0]), mxb = max3f(s0[1][0], s0[1][1], s1[1][0]);
#pragma unroll
            for (int r = 0; r < 16; r += 2) { if (r) { mxa = max3f(mxa, s0[0][r], s0[0][r + 1]); mxb = max3f(mxb, s0[1][r], s0[1][r + 1]); }
                if (r) { mxa = max3f(mxa, s1[0][r], s1[0][r + 1]); mxb = max3f(mxb, s1[1][r], s1[1][r + 1]); } else { mxa = fmaxf(mxa, s1[0][1]); mxb = fmaxf(mxb, s1[1][1]); } }
            const float mx = xhalf_max(fmaxf(mxa, mxb)) - m;
            if (first || __any(mx > THR)) {
                const float d = first ? fmaxf(mx, -64.0f) : fmaxf(mx, 0.f), alpha = __builtin_amdgcn_exp2f(-d);
                m += d; first = false;
#pragma unroll
                for (int u = 0; u < 2; ++u) {
#pragma unroll
                    for (int r = 0; r < 16; ++r) { o0[u][r] *= alpha; o1[u][r] *= alpha; }
                    lacc[u] *= alpha; }
            }
            }
            }
            bf16x8 pb[2][4];
#pragma unroll
            for (int u = 0; u < 2; ++u) {
                if (!(VM & 4))
#pragma unroll
                for (int r = 0; r < 16; ++r) { s0[u][r] = __builtin_amdgcn_exp2f(NOREF ? s0[u][r] : s0[u][r] - m); s1[u][r] = __builtin_amdgcn_exp2f(NOREF ? s1[u][r] : s1[u][r] - m); lacc[u] += (f32x2){s0[u][r], s1[u][r]}; }
#pragma unroll
                for (int s = 0; s < 2; ++s) {
                    v4u w; w.x = cvtpk(s0[u][8 * s], s0[u][8 * s + 1]); w.y = cvtpk(s0[u][8 * s + 2], s0[u][8 * s + 3]); w.z = cvtpk(s0[u][8 * s + 4], s0[u][8 * s + 5]); w.w = cvtpk(s0[u][8 * s + 6], s0[u][8 * s + 7]);
                    pb[u][s] = __builtin_bit_cast(bf16x8, w);
                    v4u x; x.x = cvtpk(s1[u][8 * s], s1[u][8 * s + 1]); x.y = cvtpk(s1[u][8 * s + 2], s1[u][8 * s + 3]); x.z = cvtpk(s1[u][8 * s + 4], s1[u][8 * s + 5]); x.w = cvtpk(s1[u][8 * s + 6], s1[u][8 * s + 7]);
                    pb[u][2 + s] = __builtin_bit_cast(bf16x8, x);
                }
            }
            if (VM & 1) { asm volatile("" :: "v"(pb[0][0]), "v"(pb[0][1]), "v"(pb[0][2]), "v"(pb[0][3]), "v"(pb[1][0]), "v"(pb[1][1]), "v"(pb[1][2]), "v"(pb[1][3])); } else {
            const LAS unsigned char* vbase = Vb + (4 * hi + ((lane & 15) >> 2)) * VRS + ((lane >> 4) & 1) * 32 + (lane & 3) * 8;
#pragma unroll
            for (int s = 0; s < 4; ++s) {
                const v4i16 a0 = __builtin_amdgcn_ds_read_tr16_b64_v4i16((LAS v4i16*)(vbase + (16 * s) * VRS));
                const v4i16 a1 = __builtin_amdgcn_ds_read_tr16_b64_v4i16((LAS v4i16*)(vbase + (16 * s + 8) * VRS));
                const v4i16 c0_ = __builtin_amdgcn_ds_read_tr16_b64_v4i16((LAS v4i16*)(vbase + (16 * s) * VRS + 64));
                const v4i16 c1_ = __builtin_amdgcn_ds_read_tr16_b64_v4i16((LAS v4i16*)(vbase + (16 * s + 8) * VRS + 64));
                const bf16x8 va = {a0[0], a0[1], a0[2], a0[3], a1[0], a1[1], a1[2], a1[3]};
                const bf16x8 vc = {c0_[0], c0_[1], c0_[2], c0_[3], c1_[0], c1_[1], c1_[2], c1_[3]};
#pragma unroll
                for (int u = 0; u < 2; ++u) { o0[u] = __builtin_amdgcn_mfma_f32_32x32x16_bf16(va, pb[u][s], o0[u], 0, 0, 0); o1[u] = __builtin_amdgcn_mfma_f32_32x32x16_bf16(vc, pb[u][s], o1[u], 0, 0, 0); }
            }
            }
        }
        if (!(VM & 8) && j + 1 < nt) ATT_STORE((j + 1) & 1);
        if (!(VM & 16)) __syncthreads();
    }
#pragma unroll
    for (int u = 0; u < 2; ++u) {
        float l = xhalf_sum(lacc[u].x + lacc[u].y);
        if (has_sink) l += __builtin_amdgcn_exp2f((u == 0 ? sink0 : sink1) - m);
        const float inv = 1.0f / l;
        const int qrow = rowbase + (MODE == 0 ? 32 * u : 0) + r32;
        bf16* orow = Op + (MODE == 1 ? 64 * u : 0) + (size_t)qrow * D;
#pragma unroll
        for (int g = 0; g < 4; ++g) {
            v2u w0; w0.x = pk2(o0[u][4 * g] * inv, o0[u][4 * g + 1] * inv); w0.y = pk2(o0[u][4 * g + 2] * inv, o0[u][4 * g + 3] * inv);
            v2u w1; w1.x = pk2(o1[u][4 * g] * inv, o1[u][4 * g + 1] * inv); w1.y = pk2(o1[u][4 * g + 2] * inv, o1[u][4 * g + 3] * inv);
            *(v2u*)(orow + 8 * g + 4 * hi) = w0; *(v2u*)(orow + 32 + 8 * g + 4 * hi) = w1;
        }
    }
#undef ATT_TROW
#undef ATT_LOAD
#undef ATT_STORE
}

#define ATT_BAR() do { asm volatile("s_waitcnt lgkmcnt(0)" ::: "memory"); __builtin_amdgcn_s_barrier(); asm volatile("" ::: "memory"); } while (0)
template <int N> struct IC { static constexpr int v = N; };
template <int DK, int MODE, int VM = 0>
__device__ __forceinline__ bool unit_h(LAS unsigned char* lds, const bf16* Qp, int qpitch, const bf16* Kp, int kpitch, const bf16* Vp, int vpitch, bf16* Op,
                                       int var, int qt, int lo, int n1, int nt, float qscale, float sink0, float sink1, bool has_sink, const LAS float* bias, const float* t32, volatile LAS unsigned* flag) {
    constexpr int KRS = DK * 2 + 16, NS = DK / 16, CPK = DK / 8;
    int tid = threadIdx.x; asm volatile("" : "+v"(tid)); const int lane = tid & 63, r32 = lane & 31, hi = lane >> 5, wid = __builtin_amdgcn_readfirstlane(tid >> 6);
    const int rowbase = MODE == 0 ? 512 * qt + 64 * wid : 256 * qt + 32 * wid;
    const int kkey0 = tid / CPK, kch0 = tid - kkey0 * CPK, kkey1 = (tid + 512) / CPK, kch1 = (tid + 512) - kkey1 * CPK;
    const int vkey = tid >> 3, vch = tid & 7;
    constexpr int PD = DK == 96 ? 1 : 2;
    v4u kreg0[2], kreg1[2] = {{0u, 0u, 0u, 0u}, {0u, 0u, 0u, 0u}}, vreg[2];
#define ATT_TROW(j) ((((j) < n1) ? (lo + (j)) : (64 + (j) - n1)) * 64)
#define ATT_LOAD(j, S) do { const int tr_ = ATT_TROW(j); kreg0[S] = *(const v4u*)(Kp + (size_t)(tr_ + kkey0) * kpitch + kch0 * 8); \
        if (DK == 96 && tid < 256) kreg1[S] = *(const v4u*)(Kp + (size_t)(tr_ + kkey1) * kpitch + kch1 * 8); \
        vreg[S] = *(const v4u*)(Vp + (size_t)(tr_ + vkey) * vpitch + vch * 8); } while (0)
#define ATT_STORE(bf, S) do { LAS unsigned char* b_ = lds + (bf) * BUF; *(LAS v4u*)(b_ + kkey0 * KRS + kch0 * 16) = kreg0[S]; \
        if (DK == 96 && tid < 256) *(LAS v4u*)(b_ + kkey1 * KRS + kch1 * 16) = kreg1[S]; \
        *(LAS v4u*)(b_ + KBUF + vkey * VRS + vch * 16) = vreg[S]; } while (0)
    ATT_LOAD(0, PD - 1);
    bf16x8 qr[2][NS];
#pragma unroll
    for (int u = 0; u < 2; ++u) {
        const int qrow = rowbase + (MODE == 0 ? 32 * u : 0) + r32;
        const bf16* qp = Qp + (MODE == 1 ? 64 * u : 0) + (size_t)qrow * qpitch;
#pragma unroll
        for (int s = 0; s < NS; ++s) { const v4u raw = *(const v4u*)(qp + 16 * s + 8 * hi); float f[8]; unpack8(raw, f);
#pragma unroll
            for (int i = 0; i < 8; ++i) f[i] *= qscale;
            if (DK == 96 && s >= 4) { float p[8];
#pragma unroll
                for (int i = 0; i < 8; ++i) p[i] = __shfl_xor(f[i], 32);
                rope8(f, p, t32 + ((size_t)((s == 4 ? (qrow >> 6) : (qrow & 63)) * 8)) * 2, hi == 0); }
            qr[u][s] = __builtin_bit_cast(bf16x8, pack8(f)); }
    }
    f32x2 lacc[2] = {{0.f, 0.f}, {0.f, 0.f}}; f32x16 o0[2] = {{}, {}}, o1[2] = {{}, {}};
    const int grw = 8 * qt + wid, r0w = min(max(grw - 4, 0), 56), i0w = rowbase;
    ATT_STORE(0, PD - 1);
    if (PD == 2 && nt > 1) ATT_LOAD(1, 1);
    if (tid == 0) *flag = 0u;
    ATT_BAR();
    auto tile = [&](const int j, auto LS) __attribute__((always_inline)) {
        constexpr int SL = decltype(LS)::v, SS = PD == 1 ? SL : (SL ^ 1);
        if (j + PD < nt) ATT_LOAD(j + PD, SL);
        const int kt = ATT_TROW(j) >> 6;
        bool actv = true;
        if (kt < 64) { if (var == 0) actv = (kt >= r0w) && (kt <= r0w + 7); else if (var == 2) actv = !((64 * kt - (i0w + 31) > 128) || (i0w - (64 * kt + 63) > 128)); }
        if (actv) {
        const LAS unsigned char* Kb = lds + (j & 1) * BUF; const LAS unsigned char* Vb = Kb + KBUF;
        const LAS unsigned char* vbase = Vb + (4 * hi + ((lane & 15) >> 2)) * VRS + ((lane >> 4) & 1) * 32 + (lane & 3) * 8;
#pragma unroll
        for (int hf = 0; hf < 2; ++hf) {
            f32x16 sc[2] = {{}, {}};
#pragma unroll
            for (int s = 0; s < NS; ++s) {
                const bf16x8 kf = *(const LAS bf16x8*)(Kb + (32 * hf + r32) * KRS + (16 * s + 8 * hi) * 2);
#pragma unroll
                for (int u = 0; u < 2; ++u) sc[u] = __builtin_amdgcn_mfma_f32_32x32x16_bf16(kf, qr[u][s], sc[u], 0, 0, 0);
            }
            if (kt < 64 && var == 0) {
#pragma unroll
                for (int u = 0; u < 2; ++u) { const int gc = 32 * u + r32, c0 = min(max(gc - 8, 0), 48), rowoff = (kt - grw + 7) * 31 - gc + 15;
                    const LAS unsigned char* bb = (const LAS unsigned char*)(bias + rowoff + 4 * hi); asm volatile("" : "+v"(bb));
                    float bv[16];
#pragma unroll
                    for (int r = 0; r < 16; ++r) bv[r] = *(const LAS float*)(bb + 4 * (32 * hf + (r & 3) + 8 * (r >> 2)));
                    asm volatile("" : "+v"(bv[0]), "+v"(bv[1]), "+v"(bv[2]), "+v"(bv[3]), "+v"(bv[4]), "+v"(bv[5]), "+v"(bv[6]), "+v"(bv[7]),
                                      "+v"(bv[8]), "+v"(bv[9]), "+v"(bv[10]), "+v"(bv[11]), "+v"(bv[12]), "+v"(bv[13]), "+v"(bv[14]), "+v"(bv[15]));
#pragma unroll
                    for (int r = 0; r < 16; ++r) { const int jj = 32 * hf + crow(r, hi); const bool v = (unsigned)(jj - c0) < 16u; sc[u][r] = v ? sc[u][r] + bv[r] : NEG; } }
            } else if (kt < 64 && var == 2) {
                const int dbase = 64 * kt - (rowbase + r32) + 128;
#pragma unroll
                for (int r = 0; r < 16; ++r) { const bool v = (unsigned)(dbase + 32 * hf + crow(r, hi)) <= 256u; sc[0][r] = v ? sc[0][r] : NEG; sc[1][r] = v ? sc[1][r] : NEG; }
            }
            bf16x8 pb[2][2];
#pragma unroll
            for (int u = 0; u < 2; ++u) {
#pragma unroll
                for (int r = 0; r < 16; r += 2) { sc[u][r] = __builtin_amdgcn_exp2f(sc[u][r]); sc[u][r + 1] = __builtin_amdgcn_exp2f(sc[u][r + 1]); lacc[u] += (f32x2){sc[u][r], sc[u][r + 1]}; }
#pragma unroll
                for (int s = 0; s < 2; ++s) {
                    v4u w; w.x = cvtpk(sc[u][8 * s], sc[u][8 * s + 1]); w.y = cvtpk(sc[u][8 * s + 2], sc[u][8 * s + 3]); w.z = cvtpk(sc[u][8 * s + 4], sc[u][8 * s + 5]); w.w = cvtpk(sc[u][8 * s + 6], sc[u][8 * s + 7]);
                    pb[u][s] = __builtin_bit_cast(bf16x8, w);
                }
            }
#pragma unroll
            for (int s2 = 0; s2 < 2; ++s2) { const int s = 2 * hf + s2;
                const v4i16 a0 = __builtin_amdgcn_ds_read_tr16_b64_v4i16((LAS v4i16*)(vbase + (16 * s) * VRS));
                const v4i16 a1 = __builtin_amdgcn_ds_read_tr16_b64_v4i16((LAS v4i16*)(vbase + (16 * s + 8) * VRS));
                const v4i16 c0_ = __builtin_amdgcn_ds_read_tr16_b64_v4i16((LAS v4i16*)(vbase + (16 * s) * VRS + 64));
                const v4i16 c1_ = __builtin_amdgcn_ds_read_tr16_b64_v4i16((LAS v4i16*)(vbase + (16 * s + 8) * VRS + 64));
                const bf16x8 va = {a0[0], a0[1], a0[2], a0[3], a1[0], a1[1], a1[2], a1[3]};
                const bf16x8 vc = {c0_[0], c0_[1], c0_[2], c0_[3], c1_[0], c1_[1], c1_[2], c1_[3]};
#pragma unroll
                for (int u = 0; u < 2; ++u) { o0[u] = __builtin_amdgcn_mfma_f32_32x32x16_bf16(va, pb[u][s2], o0[u], 0, 0, 0); o1[u] = __builtin_amdgcn_mfma_f32_32x32x16_bf16(vc, pb[u][s2], o1[u], 0, 0, 0); }
            }
            __builtin_amdgcn_sched_barrier(0);
        }
        }
        if (j + 1 < nt) ATT_STORE((j + 1) & 1, SS);
        ATT_BAR();
    };
    if (PD == 1) { for (int j = 0; j < nt; ++j) tile(j, IC<0>{}); }
    else { for (int j = 0; j < nt; j += 2) { tile(j, IC<0>{}); if (j + 1 < nt) tile(j + 1, IC<1>{}); } }
    float lsum[2]; bool bad = false;
#pragma unroll
    for (int u = 0; u < 2; ++u) { lsum[u] = xhalf_sum(lacc[u].x + lacc[u].y); bad = bad || !(lsum[u] > 8.6736174e-19f && lsum[u] < 1.1529215e18f);
        if (has_sink) { lsum[u] += __builtin_amdgcn_exp2f(u == 0 ? sink0 : sink1); bad = bad || !(lsum[u] < 1.1529215e18f); } }
    if (__any(bad)) { if (lane == 0) *flag = 1u; }
#pragma unroll
    for (int u = 0; u < 2; ++u) {
        const float inv = __builtin_amdgcn_rcpf(lsum[u]);
        bf16* orow = Op + (MODE == 1 ? 64 * u : 0) + (size_t)(rowbase + (MODE == 0 ? 32 * u : 0) + r32) * D;
#pragma unroll
        for (int g = 0; g < 4; ++g) {
            v2u w0; w0.x = pk2(o0[u][4 * g] * inv, o0[u][4 * g + 1] * inv); w0.y = pk2(o0[u][4 * g + 2] * inv, o0[u][4 * g + 3] * inv);
            v2u w1; w1.x = pk2(o1[u][4 * g] * inv, o1[u][4 * g + 1] * inv); w1.y = pk2(o1[u][4 * g + 2] * inv, o1[u][4 * g + 3] * inv);
            *(v2u*)(orow + 8 * g + 4 * hi) = w0; *(v2u*)(orow + 32 + 8 * g + 4 * hi) = w1;
        }
    }
    ATT_BAR();
    return *flag == 0u;
#undef ATT_TROW
#undef ATT_LOAD
#undef ATT_STORE
}
}

template <int VM = 0>
__device__ __forceinline__ void phase_attn(const Frame& F, int lq) {
    const int l = lq & 3;
    const bf16* P = (const bf16*)(F.ws + WS_PB); const bf16* QD = (const bf16*)(F.ws + WS_QD); const bf16* KD = (const bf16*)(F.ws + WS_KD);
    const bf16* VD = (const bf16*)(F.ws + WS_VD); bf16* O = (bf16*)(F.ws + (lq >= 4 ? WS_ACT : WS_HA));
    unsigned* ctr = (unsigned*)(F.ws + WS_CTL) + CW_QUEUE + 64 * 8 * lq;
    LAS float* bias = (LAS float*)(F.lds + att::BIAS_OFF);
    { const float* nab = INP(I_NABIAS) + l * 4 * 465; for (int i = F.tid; i < 4 * 465; i += NTHR) bias[i] = nab[i] * LOG2E; }
    const float* sinks = INP(I_SINK) + l * 4;
    __syncthreads();
    const float* t32 = (const float*)(F.ws + WS_T32);
    volatile LAS unsigned* flag = F.MISC + MI_Q + 1;
    const int nloc = 256 + (l < NL - 1 ? 24 : 0);
    const int q0 = (int)xb_xcc_id();
    for (int qq = 0; qq < 8; ++qq) {
      const int q = (q0 + qq) & 7;
      unsigned* qctr = ctr + 64 * q;
      unsigned nxt = 0xffffffffu;
      for (;;) {
        if (F.tid == 0) { if (nxt == 0xffffffffu) nxt = __hip_atomic_fetch_add(qctr, 1u, __ATOMIC_RELAXED, __HIP_MEMORY_SCOPE_AGENT); F.MISC[MI_Q] = nxt; nxt = 0xffffffffu; }
        ATT_BAR();
        const int li = (int)F.MISC[MI_Q];
        ATT_BAR();
        if (li >= nloc) break;
        if (F.tid == 0 && li < 160) nxt = __hip_atomic_fetch_add(qctr, 1u, __ATOMIC_RELAXED, __HIP_MEMORY_SCOPE_AGENT);
        int idx;
        if (li < 64) idx = (q + 8 * (li >> 3)) * 8 + (li & 7);
        else if (li < 128) { const int jx = li - 64; idx = 1024 + (q + 8 * (jx >> 4)) * 16 + (jx & 15); }
        else if (li < 192) { const int jx = li - 128; idx = 1536 + (q + 8 * (jx >> 3)) * 8 + (jx & 7); }
        else if (li < 256) { const int jx = li - 192; idx = 2048 + (q + 8 * (jx >> 4)) * 16 + (jx & 15); }
        else if (li < 264) idx = 2560 + q + 8 * (li - 256);
        else idx = 2624 + q + 8 * (li - 264);
        if (idx < 512) {
            const int b = idx >> 5, h = (idx >> 3) & 3, qt = idx & 7; const size_t rb = (size_t)b * TT;
            if (!att::unit_h<96, 0, VM>(F.lds, QD + rb * 384 + h * 96, 384, KD + rb * 384 + h * 96, 384, VD + rb * 256 + h * 64, 256, O + rb * D + 768 + h * 64, 3, qt, 0, 64, 68, 0.10206207261596575f * LOG2E, 0.f, 0.f, false, bias, t32, flag)) {
                __syncthreads();
#pragma unroll 1
                for (int k2 = 0; k2 < 2; ++k2)
                    att::unit<96, VM>(F.lds, QD + rb * 384 + h * 96, 384, KD + rb * 384 + h * 96, 384, VD + rb * 256 + h * 64, 256, O + rb * D + 768 + h * 64, 3, 2 * qt + k2, 0, 64, 68, 0.10206207261596575f * LOG2E, 0.f, false, bias, t32, nullptr);
            }
        } else if (idx < 1024) {
        } else if (idx < 2560) {
            idx -= 1024;
            const int grp = idx >> 9, rem = idx & 511, b = rem >> 5; const size_t rb = (size_t)b * TT;
            if (grp == 1) {
                const int h = (rem >> 3) & 3, qt = rem & 7; const int lo = min(max(8 * qt - 4, 0), 56), n1 = min(max(8 * qt + 3, 0), 56) + 7 - lo + 1;
                if (!att::unit_h<64, 0, VM>(F.lds, P + rb * NPJ + h * 64, NPJ, P + rb * NPJ + 256 + h * 64, NPJ, P + rb * NPJ + 512 + h * 64, NPJ, O + rb * D + h * 64, 0, qt, lo, n1, n1 + 4, 0.125f * LOG2E, 0.f, 0.f, false, bias + h * 465, t32, flag)) { __syncthreads();
                att::unit2<64, 0, VM>(F.lds, P + rb * NPJ + h * 64, NPJ, P + rb * NPJ + 256 + h * 64, NPJ, P + rb * NPJ + 512 + h * 64, NPJ, O + rb * D + h * 64, 0, qt, lo, n1, n1 + 4,
                                  0.125f * LOG2E, 0.f, 0.f, false, bias + h * 465, t32); }
            } else {
                const int g = (rem >> 4) & 1, qt = rem & 15; const bool isc = grp == 2;
                const int lo = isc ? max(4 * qt - 2, 0) : 0, n1 = isc ? min(4 * qt + 5, 63) - lo + 1 : 64;
                const int qc = (isc ? 1280 : 768) + g * 128, kc = (isc ? 1536 : 1024) + g * 64, vc = (isc ? 1664 : 1152) + g * 64;
                const float sk0 = isc ? sinks[2 * g] * LOG2E : 0.f, sk1 = isc ? sinks[2 * g + 1] * LOG2E : 0.f;
                if (!att::unit_h<64, 1, VM>(F.lds, P + rb * NPJ + qc, NPJ, P + rb * NPJ + kc, NPJ, P + rb * NPJ + vc, NPJ, O + rb * D + (isc ? 512 : 256) + g * 128, isc ? 2 : 1, qt, lo, n1, n1 + 4, 0.125f * LOG2E, sk0, sk1, isc, bias, t32, flag)) { __syncthreads();
                att::unit2<64, 1, VM>(F.lds, P + rb * NPJ + qc, NPJ, P + rb * NPJ + kc, NPJ, P + rb * NPJ + vc, NPJ, O + rb * D + (isc ? 512 : 256) + g * 128, isc ? 2 : 1, qt, lo, n1, n1 + 4,
                                  0.125f * LOG2E, isc ? sinks[2 * g] * LOG2E : 0.f, isc ? sinks[2 * g + 1] * LOG2E : 0.f, isc, bias, t32); }
            }
        } else if (idx < 2624) {
            const int rem = idx - 2560, b = rem >> 2, isc = (rem >> 1) & 1, g = rem & 1; const size_t rb = (size_t)b * TT;
            const int qc = (isc ? 1280 : 768) + g * 128, kc = (isc ? 1536 : 1024) + g * 64, vc = (isc ? 1664 : 1152) + g * 64;
            att::unit2<64, 1, VM>(F.lds, P + rb * NPJ + qc, NPJ, P + rb * NPJ + kc, NPJ, P + rb * NPJ + vc, NPJ, O + rb * D + (isc ? 512 : 256) + g * 128, isc ? 2 : 1, 16, 0, 0, 4,
                              0.125f * LOG2E, isc ? sinks[2 * g] * LOG2E : 0.f, isc ? sinks[2 * g + 1] * LOG2E : 0.f, isc != 0, bias, t32);
        } else {
            const int rem = idx - 2624, b = rem >> 3, isd = (rem >> 2) & 1, h = rem & 3; const size_t rb = (size_t)b * TT;
            if (isd) att::unit<96, VM>(F.lds, QD + rb * 384 + h * 96, 384, KD + rb * 384 + h * 96, 384, VD + rb * 256 + h * 64, 256, O + rb * D + 768 + h * 64, 3, 16, 0, 0, 4, 0.10206207261596575f * LOG2E, 0.f, false, bias, t32, nullptr);
            else att::unit<64, VM>(F.lds, P + rb * NPJ + h * 64, NPJ, P + rb * NPJ + 256 + h * 64, NPJ, P + rb * NPJ + 512 + h * 64, NPJ, O + rb * D + h * 64, 0, 16, 0, 0, 4, 0.125f * LOG2E, 0.f, false, bias + h * 465, nullptr, nullptr);
        }
    }
    }
}


#define PHASE_FN static __device__ __forceinline__ void
PHASE_FN ph_prologue(GAS unsigned char* ws) { const Frame F = make_frame(ws); phase_prologue(F); }
PHASE_FN ph_ln(GAS unsigned char* ws, int l) { const Frame F = make_frame(ws); phase_ln(F, l); }
PHASE_FN ph_gemm_in(GAS unsigned char* ws, int l) {
    const Frame F = make_frame(ws);
    pg8::Gemm g{(const bf16*)(F.ws + WS_HA), (const bf16*)(F.ws + WS_WIN), M, NPJ, D, D, nullptr}; pg8::StaticOrder S; S.init(M, NPJ, F.G, F.bid);
    pg8::EpiBf16NT<0> E{(bf16*)(F.ws + WS_PB), NPJ, nullptr, 0, 0, 1.f};
    pg8::gemm_phase<pg8::EpiBf16NT<0>, pg8::StaticOrder, true, true>(F.lds, g, S, E);
}
PHASE_FN ph_post(GAS unsigned char* ws, int l) { const Frame F = make_frame(ws); phase_post(F, l); }
PHASE_FN ph_gemm_mla(GAS unsigned char* ws, int l) {
    const Frame F = make_frame(ws);
    pg8::Gemm g{(const bf16*)(F.ws + WS_PB) + 1792, (const bf16*)(F.ws + WS_WD), M, 1024, 384, NPJ, nullptr}; pg8::StaticOrder S; S.init(M, 1024, F.G, F.bid);
    EpiMla E{(bf16*)(F.ws + WS_QD), (bf16*)(F.ws + WS_KD), (bf16*)(F.ws + WS_VD)};
    pg8::gemm_phase<EpiMla, pg8::StaticOrder, true, true>(F.lds, g, S, E);
}
template <int VM>
PHASE_FN ph_attn(GAS unsigned char* ws, int l) { const Frame F = make_frame(ws); phase_attn<VM>(F, l); }
PHASE_FN ph_gemm_out(GAS unsigned char* ws, int l) {
    const Frame F = make_frame(ws);
    pg8::Gemm g{(const bf16*)(F.ws + WS_HA), (const bf16*)(F.ws + WS_WOUT), M, D, D, D, nullptr};
    pg8::EpiBf16NT<0> E{(bf16*)(F.ws + WS_PB), D, nullptr, 0, 0, 1.f};
    if (l == NL - 1) { LatOrder S{F.G, F.bid}; pg8::gemm_phase<pg8::EpiBf16NT<0>, LatOrder, true, true>(F.lds, g, S, E); }
    else { pg8::StaticOrder S; S.init(M, D, F.G, F.bid); pg8::gemm_phase<pg8::EpiBf16NT<0>, pg8::StaticOrder, true, true>(F.lds, g, S, E); }
}
PHASE_FN ph_route(GAS unsigned char* ws, int l) { const Frame F = make_frame(ws); phase_route(F, l); }
PHASE_FN ph_permute(GAS unsigned char* ws, int l) { const Frame F = make_frame(ws); phase_permute(F, l); }
PHASE_FN ph_gemm_gu(GAS unsigned char* ws, int l) {
    const Frame F = make_frame(ws);
    moe_tables(F);
    pg8::Gemm g{(const bf16*)(F.ws + WS_HA), (const bf16*)(F.ws + WS_WGU), MS, 16384, D, D, (const int*)(F.ws + WS_QD)}; MoeOrder S{F.MISC + MI_PST, F.G, F.bid};
    EpiGU E{(bf16*)(F.ws + WS_ACT)};
    pg8::gemm_phase<EpiGU, MoeOrder, true, true, true>(F.lds, g, S, E);
}
PHASE_FN ph_gemm_dn(GAS unsigned char* ws, int l) {
    const Frame F = make_frame(ws);
    moe_tables(F);
    pg8::Gemm g{(const bf16*)(F.ws + WS_ACT), (const bf16*)(F.ws + WS_WDN), MS, 16384, 512, 512, nullptr}; MoeOrder S{F.MISC + MI_PST, F.G, F.bid};
    pg8::EpiBf16NT<0> E{(bf16*)(F.ws + WS_PB), D, nullptr, 1024, 0, 1.f};
    pg8::gemm_phase<pg8::EpiBf16NT<0>, MoeOrder, true, true>(F.lds, g, S, E);
}


#if MK_DEBUG
#ifndef DBG_MODE
#define DBG_MODE 0
#endif
__device__ __forceinline__ float oracle_attn(const Frame& F, int l, int r, int var, int h, int mode = 0) {
    const bf16* P = (const bf16*)(F.ws + WS_PB); const bf16* QD = (const bf16*)(F.ws + WS_QD); const bf16* KD = (const bf16*)(F.ws + WS_KD); const bf16* VD = (const bf16*)(F.ws + WS_VD);
    const bf16* O = (const bf16*)(F.ws + WS_HA); const float* t32 = (const float*)(F.ws + WS_T32);
    const int b = r / TT, t = r - b * TT; const bool lat = t < SEQ; const size_t rb = (size_t)b * TT;
    const int dk = var == 3 ? 96 : 64;
    const bf16* qp; const bf16* kp; const bf16* vp; int kpitch, vpitch;
    if (var == 3) { qp = QD + (size_t)r * 384 + h * 96; kp = KD + rb * 384 + h * 96; kpitch = 384; vp = VD + rb * 256 + h * 64; vpitch = 256; }
    else { const int qc = var == 0 ? h * 64 : var == 1 ? 768 + h * 64 : 1280 + h * 64, kc = var == 0 ? 256 + h * 64 : var == 1 ? 1024 + (h >> 1) * 64 : 1536 + (h >> 1) * 64,
           vc = var == 0 ? 512 + h * 64 : var == 1 ? 1152 + (h >> 1) * 64 : 1664 + (h >> 1) * 64;
           qp = P + (size_t)r * NPJ + qc; kp = P + rb * NPJ + kc; kpitch = NPJ; vp = P + rb * NPJ + vc; vpitch = NPJ; }
    LAS float* qs = (LAS float*)(F.lds + 65536) + F.wave * 128;
    for (int d = F.lane; d < dk; d += 64) qs[d] = __builtin_bit_cast(float, (unsigned)qp[d] << 16);
    asm volatile("s_waitcnt lgkmcnt(0)" ::: "memory");
    if (var == 3 && lat && F.lane < 32) {
        const int c = F.lane >> 3, e = F.lane & 7, gr = t >> 6, gc = t & 63; const float own = qs[64 + F.lane], par = qs[64 + (F.lane ^ 8)];
        const float cs = t32[((c < 2 ? gr : gc) * 8 + e) * 2], sn = t32[((c < 2 ? gr : gc) * 8 + e) * 2 + 1];
        const float nv = (c & 1) == 0 ? own * cs - par * sn : par * sn + own * cs;
        asm volatile("s_waitcnt lgkmcnt(0)" ::: "memory"); qs[64 + F.lane] = nv; }
    asm volatile("s_waitcnt lgkmcnt(0)" ::: "memory");
    const float scale = var == 3 ? 0.10206207261596575f : 0.125f;
    const int gr = t >> 6, gc = t & 63, r0 = min(max(gr - 4, 0), 56), c0 = min(max(gc - 8, 0), 48);
    float m = -3.0e38f, lsum = 0.f, acc[64];
#pragma unroll
    for (int d = 0; d < 64; ++d) acc[d] = 0.f;
    for (int j = F.lane; j < TT; j += 64) {
        bool ok = true; float bias = 0.f;
        if (!lat) ok = j >= SEQ;
        else if (j < SEQ) {
            if (var == 0) { const int kr = j >> 6, kc2 = j & 63; ok = kr >= r0 && kr <= r0 + 7 && kc2 >= c0 && kc2 <= c0 + 15;
                if (ok) bias = INP(I_NABIAS)[((l * 4 + h) * 15 + (kr - gr + 7)) * 31 + (kc2 - gc + 15)]; }
            else if (var == 2) ok = (j - t <= 128) && (t - j <= 128);
        }
        if (!ok) continue;
        float sc = 0.f; const bf16* kr_ = kp + (size_t)j * kpitch;
        for (int d = 0; d < dk; ++d) sc += qs[d] * __builtin_bit_cast(float, (unsigned)kr_[d] << 16);
        sc = sc * scale + bias;
        const float mn = fmaxf(m, sc), a = expf(m - mn), p = expf(sc - mn); m = mn; lsum = lsum * a + p;
        const bf16* vr = vp + (size_t)j * vpitch;
#pragma unroll
        for (int d = 0; d < 64; ++d) acc[d] = acc[d] * a + p * __builtin_bit_cast(float, (unsigned)vr[d] << 16);
    }
    float mg = m;
#pragma unroll
    for (int o = 1; o < 64; o <<= 1) mg = fmaxf(mg, __shfl_xor(mg, o));
    if (mode >= 1) {
        const unsigned* rec = (const unsigned*)(F.ws + WS_RS) + (size_t)r * 2; const float mk = __builtin_bit_cast(float, rec[0]), lk = __builtin_bit_cast(float, rec[1]);
        const float lref = wave_sum(lsum * expf(m - mg));
        const float lker = lk * exp2f(mk - mg * LOG2E);
        if (mode == 2) return fabsf(mk / LOG2E - mg);
        return fabsf(lker / lref - 1.0f);
    }
    const float f = expf(m - mg); lsum *= f; lsum = wave_sum(lsum);
    if (var == 2) lsum += expf(INP(I_SINK)[l * 4 + h] - mg);
    float err = 0.f, mag = 1.0e-6f;
    const bf16* orow = O + (size_t)r * D + var * 256 + h * 64;
#pragma unroll
    for (int d = 0; d < 64; ++d) { const float ref = wave_sum(acc[d] * f) / lsum; const float got = __builtin_bit_cast(float, (unsigned)orow[d] << 16);
        const float df = fabsf(got - ref); err = (df == df) ? fmaxf(err, df) : 1.0e30f; mag = fmaxf(mag, fabsf(ref)); }
    return err / mag;
}
__device__ __forceinline__ void phase_dump(const Frame& F, int code) {
    float* out = (float*)ptab_get(F, I_OUT);
    for (int r = F.gw; r < M; r += F.ngw) {
        const int b = r / TT, t = r - b * TT; if (t >= SEQ) continue;
        float v[16];
        if (code == 1) ld16bf((const bf16*)(F.ws + WS_HA) + (size_t)r * D, F.lane, v);
        else if (code == 2) ld16bf((const bf16*)(F.ws + WS_PB) + (size_t)r * NPJ, F.lane, v);
        else if (code == 3) ld16bf((const bf16*)(F.ws + WS_PB) + (size_t)r * NPJ + 1024, F.lane, v);
        else if (code == 4) ld16bf((const bf16*)(F.ws + WS_PB) + (size_t)r * NPJ + 1280, F.lane, v);
        else if (code == 5) ld16((const float*)(F.ws + WS_PB) + (size_t)r * D, F.lane, v);
        else if (code == 8) {
            const v4u w0 = *((const v4u*)((const bf16*)(F.ws + WS_HA) + (size_t)r * D) + F.lane), w1 = *((const v4u*)((const bf16*)(F.ws + WS_HA) + (size_t)r * D) + 64 + F.lane);
            float f[8]; int bad0 = 0, bad1 = 0; unpack8(w0, f);
#pragma unroll
            for (int i = 0; i < 8; ++i) { const unsigned u = __builtin_bit_cast(unsigned, f[i]); bad0 |= ((u & 0x7f800000u) == 0x7f800000u) ? 1 : 0; }
            unpack8(w1, f);
#pragma unroll
            for (int i = 0; i < 8; ++i) { const unsigned u = __builtin_bit_cast(unsigned, f[i]); bad1 |= ((u & 0x7f800000u) == 0x7f800000u) ? 1 : 0; }
            const unsigned long long m0 = __ballot(bad0), m1 = __ballot(bad1);
            const bool vA = (m0 & 0xffffffffull) != 0, vB = (m0 >> 32) != 0, vC = (m1 & 0xffffffffull) != 0, vD = (m1 >> 32) != 0;
            const float val = (float)(t + 1) * ((vA ? 1.0f : 0.f) + (vB ? 1.0e2f : 0.f) + (vC ? 1.0e4f : 0.f) + (vD ? 1.0e6f : 0.f));
#pragma unroll
            for (int i = 0; i < 16; ++i) v[i] = val;
        }
        else if (code == 9) { const unsigned cd = ((const unsigned*)(F.ws + WS_RS))[(size_t)r * 2]; float val = 0.f; if (cd) { val = 1.f; for (unsigned k = 0; k < cd; ++k) val *= 10.f; }
#pragma unroll
            for (int i = 0; i < 16; ++i) v[i] = val; }
        else if (code == 10) {
            const v4u w1 = *((const v4u*)((const bf16*)(F.ws + WS_HA) + (size_t)r * D) + 64 + F.lane);
            float f[8]; int bad1 = 0; unpack8(w1, f);
#pragma unroll
            for (int i = 0; i < 8; ++i) { const unsigned u = __builtin_bit_cast(unsigned, f[i]); bad1 |= ((u & 0x7f800000u) == 0x7f800000u) ? 1 : 0; }
            const bool vC = (__ballot(bad1) & 0xffffffffull) != 0;
            const bf16* pc = (const bf16*)(F.ws + WS_PB) + ((size_t)b * TT + SEQ + (t & 255)) * NPJ; int badp = 0;
            for (int c = F.lane; c < 288; c += 64) { const v4u w = *((const v4u*)pc + c); unpack8(w, f);
#pragma unroll
                for (int i = 0; i < 8; ++i) { const unsigned u = __builtin_bit_cast(unsigned, f[i]); badp |= ((u & 0x7f800000u) == 0x7f800000u) ? 1 : 0; } }
            float val = 0.f; if (vC) { val = 1.f; for (int k = 0; k <= (t & 15); ++k) val *= 10.f; }
            if (__any(badp)) val = 1.0e30f;
#pragma unroll
            for (int i = 0; i < 16; ++i) v[i] = val;
        }
        else if (code == 11) {
            const bf16* pr = (const bf16*)(F.ws + WS_PB) + (size_t)r * NPJ; int grp = -1;
            for (int c = F.lane; c < 288; c += 64) { const v4u w = *((const v4u*)pr + c); float f[8]; unpack8(w, f);
#pragma unroll
                for (int i = 0; i < 8; ++i) if (!(fabsf(f[i]) < 1.0e4f)) grp = (c * 8) >> 8; }
#pragma unroll
            for (int o = 1; o < 64; o <<= 1) { const int g2 = __shfl_xor(grp, o); grp = g2 > grp ? g2 : grp; }
            float val = 0.f; if (grp >= 0) { val = 100.f; for (int k = 0; k < grp; ++k) val *= 10.f; }
#pragma unroll
            for (int i = 0; i < 16; ++i) v[i] = val;
        }
        else if (code >= 20 && code < 24) {
            float val = 0.f;
            if ((t & 15) == 5) { for (int h = 0; h < 4; ++h) { const float e = oracle_attn(F, 0, r, code - 20, h); const float cls = e > 1.0e20f ? 3.f : e > 0.5f ? 2.f : e > 0.03f ? 1.f : 0.f; if (cls > 0.f) { float w = cls; for (int k = 0; k <= h; ++k) w *= 10.f; val = fmaxf(val, w); } } }
#pragma unroll
            for (int i = 0; i < 16; ++i) v[i] = val;
        }
        else if (code >= 30 && code < 46) {
            float val = 0.f;
            if ((t & 15) == 5) { const float e = oracle_attn(F, 0, r, (code - 30) >> 2, (code - 30) & 3, DBG_MODE); val = e > 10.f ? 1.0e4f : 1000.f * e; }
#pragma unroll
            for (int i = 0; i < 16; ++i) v[i] = val;
        }
        else if (code == 7) {
            auto bad16 = [&](const bf16* p, int nchunks) { int bad = 0; for (int c = F.lane; c < nchunks; c += 64) { const v4u w = *((const v4u*)p + c); float f[8]; unpack8(w, f);
#pragma unroll
                for (int i = 0; i < 8; ++i) { const unsigned u = __builtin_bit_cast(unsigned, f[i]); bad |= ((u & 0x7f800000u) == 0x7f800000u) ? 1 : 0; } } return __any(bad); };
            const int bP = bad16((const bf16*)(F.ws + WS_PB) + (size_t)r * NPJ, 288), bQ = bad16((const bf16*)(F.ws + WS_QD) + (size_t)r * 384, 48),
                      bK = bad16((const bf16*)(F.ws + WS_KD) + (size_t)r * 384, 48), bV = bad16((const bf16*)(F.ws + WS_VD) + (size_t)r * 256, 32), bO = bad16((const bf16*)(F.ws + WS_HA) + (size_t)r * D, 128);
            const float val = bP ? 1.0e6f : bQ ? 1.0e5f : bK ? 1.0e4f : bV ? 1.0e3f : bO ? 1.0e2f : 0.f;
#pragma unroll
            for (int i = 0; i < 16; ++i) v[i] = val;
        }
#pragma unroll
        for (int i = 0; i < 16; ++i) { const unsigned u = __builtin_bit_cast(unsigned, v[i]); if ((u & 0x7f800000u) == 0x7f800000u) v[i] = 777.0f; }
        st16(out + ((size_t)b * SEQ + t) * D, F.lane, v);
    }
}
static __device__ __forceinline__ void ph_dump(GAS unsigned char* ws, int code) { const Frame F = make_frame(ws); phase_dump(F, code); }
#endif
__global__ void __launch_bounds__(NTHR, 2) mk_fwd(Args args) {
    extern __shared__ __attribute__((aligned(16))) unsigned char lds_raw[];
    LAS unsigned char* lds = (LAS unsigned char*)lds_raw; volatile LAS unsigned* MISC = (volatile LAS unsigned*)(lds + MISC_OFF);
    const int tid = threadIdx.x;
    GAS unsigned char* ws = (GAS unsigned char*)args.ws;
    for (int u = tid; u < (LDS_BYTES - MISC_OFF) / 4; u += NTHR) MISC[u] = 0u;
    __syncthreads();
    if (tid < 28) { const unsigned long long p = tid < 27 ? (unsigned long long)args.in[tid] : (unsigned long long)args.out;
        LAS unsigned* t = (LAS unsigned*)(lds + PTAB_OFF) + 2 * tid; t[0] = (unsigned)p; t[1] = (unsigned)(p >> 32); }
    __syncthreads();
#if MK_MULTI
#define GRID_BAR() do { } while (0)
#else
    XcdBarrier bar = xcd_barrier_post((unsigned*)(ws + WS_CTL) + CW_BAR, MISC + MI_BAR);
#define GRID_BAR() xcd_barrier(bar)
#endif
    const int lo = args.ph_lo, hi = args.ph_hi;
#define IN(k) (lo <= (k) && (k) < hi)
#if MK_TIME
    unsigned long long tcat = 0ull, tb0 = 0ull;
#define TBEG() do { tb0 = __builtin_amdgcn_s_memrealtime(); } while (0)
#define TEND(c) do { if ((c) == MK_TIME - 1) tcat += __builtin_amdgcn_s_memrealtime() - tb0; } while (0)
#define SEAM(k) do { if (IN(k) && IN((k) + 1)) { TBEG(); GRID_BAR(); TEND(1); } } while (0)
#else
#define TBEG() do { } while (0)
#define TEND(c) do { } while (0)
#define SEAM(k) do { if (IN(k) && IN((k) + 1)) GRID_BAR(); } while (0)
#endif

#if MK_DEBUG
    if (lo >= 100) { ph_dump(ws, lo - 100); return; }
#endif
    if (IN(0)) { TBEG(); ph_prologue(ws); TEND(2); } SEAM(0);
    for (int l = 0; l < NL; ++l) {
        const int pb = 1 + 10 * l;
        if (IN(pb + 0)) { TBEG(); ph_ln(ws, l); TEND(0); } SEAM(pb + 0);
        if (IN(pb + 1)) { TBEG(); ph_gemm_in(ws, l); if (MK_DUP & 2) { GRID_BAR(); ph_gemm_in(ws, l); } TEND(3); } SEAM(pb + 1);
        if (IN(pb + 2)) { TBEG(); ph_post(ws, l); TEND(0); } SEAM(pb + 2);
        if (IN(pb + 3)) { TBEG(); ph_gemm_mla(ws, l); if (MK_DUP & 8) { GRID_BAR(); ph_gemm_mla(ws, l); } TEND(3); } SEAM(pb + 3);
        if (IN(pb + 4)) { TBEG(); ph_attn<0>(ws, l); if (MK_DUP & 16) { GRID_BAR(); ph_attn<MK_VM>(ws, l + 4); } TEND(4); } SEAM(pb + 4);
        if (IN(pb + 5)) { TBEG(); ph_gemm_out(ws, l); if (MK_DUP & 32) { GRID_BAR(); ph_gemm_out(ws, l); } TEND(3); } SEAM(pb + 5);
        if (IN(pb + 6)) { TBEG(); ph_route(ws, l); TEND(0); } SEAM(pb + 6);
        if (IN(pb + 7)) { TBEG(); ph_permute(ws, l); if (MK_DUP & 128) { GRID_BAR(); ph_permute(ws, l); } TEND(0); } SEAM(pb + 7);
        if (IN(pb + 8)) { TBEG(); ph_gemm_gu(ws, l); if (MK_DUP & 256) { GRID_BAR(); ph_gemm_gu(ws, l); } TEND(3); } SEAM(pb + 8);
        if (IN(pb + 9)) { TBEG(); ph_gemm_dn(ws, l); if (MK_DUP & 512) { GRID_BAR(); ph_gemm_dn(ws, l); } TEND(3); } SEAM(pb + 9);
    }
    if (IN(NPHASE - 1)) { TBEG(); ph_ln(ws, NL); TEND(0); }
#if MK_TIME
    if (blockIdx.x == 0) { const unsigned long long tw = __builtin_amdgcn_s_memrealtime(); const unsigned long long dl = tcat * (unsigned long long)MK_TMUL; while (__builtin_amdgcn_s_memrealtime() - tw < dl) __builtin_amdgcn_s_sleep(8); }
#endif
#undef IN
#undef SEAM
#undef GRID_BAR
}

extern "C" void kernel_launch(void* const* d_in, const int* in_sizes, int n_in, void* d_out, int out_size, void* d_ws, size_t ws_size, hipStream_t stream) {
    static int grid = 0;
    if (grid == 0) {
        if (n_in != 27 || out_size != NB * SEQ * D || ws_size < WS_END) { fprintf(stderr, "kernel_launch: unexpected problem (n_in %d, out %d, ws %zu < %zu)\n", n_in, out_size, ws_size, (size_t)WS_END); grid = -1; return; }
        int dev = 0, cus = 0, per_cu = 0;
        if (hipGetDevice(&dev) != hipSuccess || hipDeviceGetAttribute(&cus, hipDeviceAttributeMultiprocessorCount, dev) != hipSuccess) { grid = -1; return; }
        if (hipFuncSetAttribute((const void*)mk_fwd, hipFuncAttributeMaxDynamicSharedMemorySize, LDS_BYTES) != hipSuccess) { fprintf(stderr, "kernel_launch: hipFuncSetAttribute failed\n"); grid = -1; return; }
        if (hipOccupancyMaxActiveBlocksPerMultiprocessor(&per_cu, (const void*)mk_fwd, NTHR, LDS_BYTES) != hipSuccess || per_cu < 1) fprintf(stderr, "kernel_launch: occupancy query reports %d\n", per_cu);
        (void)hipGetLastError();
        grid = cus > 1024 ? 1024 : cus;
    }
    if (grid < 0) return;
    (void)hipMemsetAsync((char*)d_ws + WS_CTL, 0, CTL_BYTES, stream);
    Args a{};
    for (int i = 0; i < 27; ++i) a.in[i] = (const float*)d_in[i];
    a.out = (float*)d_out; a.ws = (unsigned char*)d_ws;
#if MK_MULTI
#ifndef DBG_NRUN
#define DBG_NRUN NPHASE
#endif
    for (int p = 0; p < DBG_NRUN; ++p) { a.ph_lo = p; a.ph_hi = p + 1; hipLaunchKernelGGL(mk_fwd, dim3(grid), dim3(NTHR), LDS_BYTES, stream, a); }
#ifdef DBG_DUMP
    a.ph_lo = 100 + DBG_DUMP; a.ph_hi = 101 + DBG_DUMP; hipLaunchKernelGGL(mk_fwd, dim3(grid), dim3(NTHR), LDS_BYTES, stream, a);
#endif
#else
    a.ph_lo = 0; a.ph_hi = NPHASE;
    hipLaunchKernelGGL(mk_fwd, dim3(grid), dim3(NTHR), LDS_BYTES, stream, a);
#endif
}
```

```cpp
#include <hip/hip_runtime.h>
#include <cstdio>
#include <cstdint>
namespace pg8 {
#define PG8_LAS __attribute__((address_space(3)))
typedef unsigned short bf16_t;
typedef short bf16x8 __attribute__((ext_vector_type(8)));
typedef float f32x4 __attribute__((ext_vector_type(4)));
typedef unsigned u32x4 __attribute__((ext_vector_type(4)));
constexpr int BM = 256, BK = 64, HALF = 128, HTB = HALF * BK * 2  , STAGE_BYTES = 8 * HTB, NXCD = 8, WGM = 8;

__host__ __device__ __forceinline__ int lds_byte(int r, int c) { const int st = (r >> 4) * 2 + (c >> 5), rr = r & 15, cc = c & 31, ob = rr * 64 + cc * 2; return st * 1024 + (ob ^ (((ob >> 9) & 1) << 5)); }
__host__ __device__ __forceinline__ void stage_rc(int b, int& R, int& C) { const int st = b / 1024, sb = b % 1024, swz = sb ^ (((sb >> 9) & 1) << 5); R = (st >> 1) * 16 + swz / 64; C = (st & 1) * 32 + (swz % 64) / 2; }
__host__ __device__ __forceinline__ int perm32(int rho) { const int n = rho >> 4, i = rho & 15; return 8 * (i >> 2) + 4 * n + (i & 3); }

struct Unit { int pm, pn; int kb = 0, nk = 0; };
struct Gemm { const bf16_t* A; const bf16_t* Bt; int M, N, K, lda; const int* src; };

struct StaticOrder {
    int nM, nN, nwg, G, c;
    __host__ __device__ void init(int M, int N, int G_, int c_) { nM = M / BM; nN = N / BM; nwg = nM * nN; G = G_; c = c_; }
    __host__ __device__ bool next(int i, Unit& u) const {
        const long L = (long)i * G + c; if (L >= nwg) return false;
        int wgid = (int)L; { const int q = nwg / NXCD, r = nwg % NXCD, xcd = wgid % NXCD, off = wgid / NXCD; wgid = (xcd < r ? xcd * (q + 1) : r * (q + 1) + (xcd - r) * q) + off; }
        const int nig = WGM * nN, gid = wgid / nig, fm = gid * WGM, gsz = (nM - fm) < WGM ? (nM - fm) : WGM;
        u.pm = fm + ((wgid % nig) % gsz); u.pn = (wgid % nig) / gsz; return true;
    }
    __device__ __forceinline__ void a_ready(const Unit&) const {}
    __device__ __forceinline__ void done(const Unit&) const {}
};

__device__ __forceinline__ unsigned cvt_pk_bf16(float lo, float hi) { unsigned r; asm volatile("v_cvt_pk_bf16_f32 %0, %1, %2" : "=v"(r) : "v"(lo), "v"(hi)); return r; }
typedef float f32x2 __attribute__((ext_vector_type(2)));
__device__ __forceinline__ f32x2 gelu_pk(f32x2 v) {
    const f32x2 av = __builtin_elementwise_abs(v), d = av * 0.2316418882f + 1.0f;
    f32x2 t; t.x = __builtin_amdgcn_rcpf(d.x); t.y = __builtin_amdgcn_rcpf(d.y);
    f32x2 q = t * 0.5307027145f + (-0.7265760135f); q = q * t + 0.7107068705f; q = q * t + (-0.142248368f); q = q * t + 0.127414796f; q = q * t;
    const f32x2 s = (v * v) * (-0.72134752044f);
    f32x2 e; e.x = __builtin_amdgcn_exp2f(s.x); e.y = __builtin_amdgcn_exp2f(s.y);
    const f32x2 m = v * (q * e), r = v - m;
    f32x2 o; o.x = v.x < 0.f ? m.x : r.x; o.y = v.y < 0.f ? m.y : r.y; return o;
}

template <int ACT  > struct EpiBf16 {
    static constexpr bool PERM = true, AFTER_DRAIN = false; static_assert(ACT == 0 || ACT == 1, "EpiBf16: ACT is 0 (none) or 1 (gelu_pk)");
    bf16_t* O; int ldc; const float* bias; int split_cols; size_t split_stride; float scale0;
    __device__ __forceinline__ void operator()(const f32x4 (&acc)[2][2][4][2], const Unit& u, int wr, int wc, int fr, int fq) const {
        const int row0 = u.pm * BM + wr * 64 + fr; int colt = u.pn * BM; bf16_t* base = O;
        float sc = 1.f; if (split_cols) { const int t = colt / split_cols; base += (size_t)t * split_stride; colt -= t * split_cols; if (t == 0) sc = scale0; }
        const int col0 = colt + wc * 32 + 8 * fq, bcol0 = u.pn * BM + wc * 32 + 8 * fq;
        f32x4 bv[2][2];
#pragma unroll
        for (int bj = 0; bj < 2; ++bj)
#pragma unroll
            for (int n = 0; n < 2; ++n) bv[bj][n] = bias ? *(const f32x4*)(bias + bcol0 + bj * HALF + 4 * n) : (f32x4){0.f, 0.f, 0.f, 0.f};
#pragma unroll
        for (int ai = 0; ai < 2; ++ai)
#pragma unroll
            for (int m = 0; m < 4; ++m) { bf16_t* rowp = base + (size_t)(row0 + ai * HALF + m * 16) * ldc + col0;
#pragma unroll
                for (int bj = 0; bj < 2; ++bj) { f32x4 v0 = acc[ai][bj][m][0] + bv[bj][0], v1 = acc[ai][bj][m][1] + bv[bj][1];
                    if (ACT == 1) { f32x2 a = gelu_pk((f32x2){v0[0], v0[1]}), b = gelu_pk((f32x2){v0[2], v0[3]}), c = gelu_pk((f32x2){v1[0], v1[1]}), d = gelu_pk((f32x2){v1[2], v1[3]});
                        v0 = (f32x4){a.x, a.y, b.x, b.y}; v1 = (f32x4){c.x, c.y, d.x, d.y}; }
                    v0 = v0 * sc; v1 = v1 * sc; u32x4 w; w.x = cvt_pk_bf16(v0[0], v0[1]); w.y = cvt_pk_bf16(v0[2], v0[3]); w.z = cvt_pk_bf16(v1[0], v1[1]); w.w = cvt_pk_bf16(v1[2], v1[3]);
                    *(u32x4*)(rowp + bj * HALF) = w; } }
    }
};
template <int ACT  > struct EpiBf16NT {
    static constexpr bool PERM = true, AFTER_DRAIN = false; static_assert(ACT == 0 || ACT == 1, "EpiBf16: ACT is 0 (none) or 1 (gelu_pk)");
    bf16_t* O; int ldc; const float* bias; int split_cols; size_t split_stride; float scale0;
    __device__ __forceinline__ void operator()(const f32x4 (&acc)[2][2][4][2], const Unit& u, int wr, int wc, int fr, int fq) const {
        const int row0 = u.pm * BM + wr * 64 + fr; int colt = u.pn * BM; bf16_t* base = O;
        float sc = 1.f; if (split_cols) { const int t = colt / split_cols; base += (size_t)t * split_stride; colt -= t * split_cols; if (t == 0) sc = scale0; }
        const int col0 = colt + wc * 32 + 8 * fq, bcol0 = u.pn * BM + wc * 32 + 8 * fq;
        f32x4 bv[2][2];
#pragma unroll
        for (int bj = 0; bj < 2; ++bj)
#pragma unroll
            for (int n = 0; n < 2; ++n) bv[bj][n] = bias ? *(const f32x4*)(bias + bcol0 + bj * HALF + 4 * n) : (f32x4){0.f, 0.f, 0.f, 0.f};
#pragma unroll
        for (int ai = 0; ai < 2; ++ai)
#pragma unroll
            for (int m = 0; m < 4; ++m) { bf16_t* rowp = base + (size_t)(row0 + ai * HALF + m * 16) * ldc + col0;
#pragma unroll
                for (int bj = 0; bj < 2; ++bj) { f32x4 v0 = acc[ai][bj][m][0] + bv[bj][0], v1 = acc[ai][bj][m][1] + bv[bj][1];
                    if (ACT == 1) { f32x2 a = gelu_pk((f32x2){v0[0], v0[1]}), b = gelu_pk((f32x2){v0[2], v0[3]}), c = gelu_pk((f32x2){v1[0], v1[1]}), d = gelu_pk((f32x2){v1[2], v1[3]});
                        v0 = (f32x4){a.x, a.y, b.x, b.y}; v1 = (f32x4){c.x, c.y, d.x, d.y}; }
                    v0 = v0 * sc; v1 = v1 * sc; u32x4 w; w.x = cvt_pk_bf16(v0[0], v0[1]); w.y = cvt_pk_bf16(v0[2], v0[3]); w.z = cvt_pk_bf16(v1[0], v1[1]); w.w = cvt_pk_bf16(v1[2], v1[3]);
                    __builtin_nontemporal_store(w, (u32x4*)(rowp + bj * HALF)); } }
    }
};
struct EpiF32 {
    static constexpr bool PERM = false, AFTER_DRAIN = false;
    float* C; int ldc; const float* bias;
    __device__ __forceinline__ void operator()(const f32x4 (&acc)[2][2][4][2], const Unit& u, int wr, int wc, int fr, int fq) const {
        const int row0 = u.pm * BM + wr * 64 + fr, col0 = u.pn * BM + wc * 32 + 4 * fq;
        f32x4 bv[2][2];
#pragma unroll
        for (int bj = 0; bj < 2; ++bj)
#pragma unroll
            for (int n = 0; n < 2; ++n) bv[bj][n] = bias ? *(const f32x4*)(bias + col0 + bj * HALF + n * 16) : (f32x4){0.f, 0.f, 0.f, 0.f};
#pragma unroll
        for (int ai = 0; ai < 2; ++ai)
#pragma unroll
            for (int m = 0; m < 4; ++m) { float* rowp = C + (size_t)(row0 + ai * HALF + m * 16) * ldc + col0;
#pragma unroll
                for (int bj = 0; bj < 2; ++bj)
#pragma unroll
                    for (int n = 0; n < 2; ++n) *(f32x4*)(rowp + bj * HALF + n * 16) = acc[ai][bj][m][n] + bv[bj][n]; }
    }
};
template <class Epi, class Sched, bool ALIGN_EPI = false, bool SP2 = false, bool GATHER = false>
__device__ __forceinline__ void gemm_phase(PG8_LAS unsigned char* lds, const Gemm g, const Sched& S, const Epi& E) {
    int tid = threadIdx.x; asm volatile("" : "+v"(tid)); const int wid = __builtin_amdgcn_readfirstlane(tid >> 6), lane = tid & 63, wr = wid >> 2, wc = wid & 3, fr = lane & 15, fq = lane >> 4;
    const int K = g.K, nt = K / BK;
    unsigned voffA[2], voffB[2]; int RA[2]; unsigned CA2[2];
#pragma unroll
    for (int i = 0; i < 2; ++i) { int R, C; stage_rc(tid * 16 + i * 8192, R, C); const int Rb = Epi::PERM ? ((R & ~31) + perm32(R & 31)) : R;
        voffA[i] = (unsigned)(R * g.lda + C) * 2u; voffB[i] = (unsigned)(Rb * K + C) * 2u; RA[i] = R; CA2[i] = (unsigned)C * 2u; }
    unsigned gcur[2][2] = {{0u, 0u}, {0u, 0u}}, gnxt[2][2] = {{0u, 0u}, {0u, 0u}};
#define PG8_GOFF(dst, u_) do { _Pragma("unroll") for (int h_ = 0; h_ < 2; ++h_) _Pragma("unroll") for (int i_ = 0; i_ < 2; ++i_) \
        dst[h_][i_] = (unsigned)g.src[(u_).pm * BM + h_ * HALF + RA[i_]] * (unsigned)(g.lda * 2) + CA2[i_]; } while (0)
#define PG8_STAGE_A(bufoff, gbase, h, nx) do { if constexpr (GATHER) { unsigned vs_[2] = {(nx) ? gnxt[h][0] : gcur[h][0], (nx) ? gnxt[h][1] : gcur[h][1]}; PG8_STAGE(bufoff, gbase, vs_); } \
        else { PG8_STAGE(bufoff, (gbase) + ((h) ? hstepA : 0), voffA); } } while (0)
    const size_t kstep = (size_t)(BK * 2);
    const size_t hstepA = (size_t)HALF * g.lda * 2, hstepB = (size_t)HALF * K * 2;
    const size_t tstepA = 2 * hstepA, tstepB = 2 * hstepB;
    const unsigned ldsw = (unsigned)wid * 1024u;
    const int aoff = lds_byte(wr * 64 + fr, fq * 8), boff = lds_byte(wc * 32 + fr, fq * 8);
#define PG8_SA(b, h) (((b) * 2 + (h)) * HTB)
#define PG8_SB(b, h) ((4 + (b) * 2 + (h)) * HTB)
#define PG8_STAGE(bufoff, gbase, voff) do { _Pragma("unroll") for (int _i = 0; _i < 2; ++_i) \
        __builtin_amdgcn_global_load_lds((const unsigned*)((const char*)(gbase) + (voff)[_i]), (PG8_LAS unsigned*)(lds + (bufoff) + ldsw + _i * 8192), 16, 0, 0); } while (0)
#define PG8_LDA(dst, b, h) do { _Pragma("unroll") for (int m = 0; m < 4; ++m) _Pragma("unroll") for (int k = 0; k < 2; ++k) dst[m][k] = *(const PG8_LAS bf16x8*)(lds + PG8_SA(b, h) + aoff + m * 2048 + k * 1024); } while (0)
#define PG8_LDB(dst, b, h) do { _Pragma("unroll") for (int n = 0; n < 2; ++n) _Pragma("unroll") for (int k = 0; k < 2; ++k) dst[n][k] = *(const PG8_LAS bf16x8*)(lds + PG8_SB(b, h) + boff + n * 2048 + k * 1024); } while (0)
#define PG8_MMA(ai, bj, At, Bt) do { __builtin_amdgcn_s_setprio(1); _Pragma("unroll") for (int m = 0; m < 4; ++m) _Pragma("unroll") for (int n = 0; n < 2; ++n) _Pragma("unroll") for (int k = 0; k < 2; ++k) \
        acc[ai][bj][m][n] = __builtin_amdgcn_mfma_f32_16x16x32_bf16(Bt[n][k], At[m][k], acc[ai][bj][m][n], 0, 0, 0); __builtin_amdgcn_s_setprio(0); } while (0)
#define PG8_WAIT_V(n) asm volatile("s_waitcnt vmcnt(" #n ")" ::: "memory")
#define PG8_WAIT_L(n) asm volatile("s_waitcnt lgkmcnt(" #n ")" ::: "memory")
#define PG8_BAR __builtin_amdgcn_s_barrier()
#define PG8_SCHED __builtin_amdgcn_sched_barrier(0)
    Unit cur, nxt; int ui = 0;
    if (!S.next(0, cur)) return;
    f32x4 acc[2][2][4][2];
#pragma unroll
    for (int a = 0; a < 2; ++a)
#pragma unroll
        for (int b = 0; b < 2; ++b)
#pragma unroll
            for (int m = 0; m < 4; ++m)
#pragma unroll
                for (int n = 0; n < 2; ++n) acc[a][b][m][n] = (f32x4){0.f, 0.f, 0.f, 0.f};
    bf16x8 At[4][2], B0[2][2], B1[2][2];
    const char* cA = (const char*)g.A + (GATHER ? (size_t)0 : (size_t)cur.pm * tstepA) + (size_t)cur.kb * kstep; const char* cB = (const char*)g.Bt + (size_t)cur.pn * tstepB + (size_t)cur.kb * kstep;
    int cnt = cur.nk ? cur.nk : nt;
    if constexpr (GATHER) PG8_GOFF(gcur, cur);
    S.a_ready(cur);
    if constexpr (SP2) {
        PG8_STAGE(PG8_SB(0, 0), cB, voffB); PG8_STAGE(PG8_SB(0, 1), cB + hstepB, voffB); PG8_STAGE_A(PG8_SA(0, 0), cA, 0, false); PG8_STAGE_A(PG8_SA(0, 1), cA, 1, false);
        if (wr == 1) PG8_BAR;
        PG8_WAIT_V(2); PG8_BAR;
        PG8_STAGE(PG8_SB(1, 0), cB + kstep, voffB); PG8_STAGE_A(PG8_SA(1, 0), cA + kstep, 0, false); PG8_STAGE(PG8_SB(1, 1), cB + hstepB + kstep, voffB);
        PG8_WAIT_V(6); PG8_BAR;
    } else {
        PG8_STAGE(PG8_SB(0, 0), cB, voffB); PG8_STAGE_A(PG8_SA(0, 0), cA, 0, false); PG8_STAGE(PG8_SB(0, 1), cB + hstepB, voffB); PG8_STAGE_A(PG8_SA(0, 1), cA, 1, false);
        if (wr == 1) PG8_BAR;
        PG8_WAIT_V(4); PG8_BAR;
        PG8_STAGE(PG8_SB(1, 0), cB + kstep, voffB); PG8_STAGE_A(PG8_SA(1, 0), cA + kstep, 0, false); PG8_STAGE(PG8_SB(1, 1), cB + hstepB + kstep, voffB);
        PG8_WAIT_V(6); PG8_BAR;
    }
    for (;;) {
        const bool has_next = S.next(ui + 1, nxt);
        const char* nA = (has_next && !GATHER) ? (const char*)g.A + (size_t)nxt.pm * tstepA + (size_t)nxt.kb * kstep : cA; const char* nB = has_next ? (const char*)g.Bt + (size_t)nxt.pn * tstepB + (size_t)nxt.kb * kstep : cB;
        if constexpr (GATHER) { if (has_next) PG8_GOFF(gnxt, nxt); else { _Pragma("unroll") for (int h_ = 0; h_ < 2; ++h_) { gnxt[h_][0] = gcur[h_][0]; gnxt[h_][1] = gcur[h_][1]; } } }
#pragma unroll 1
        for (int t = 0; t < cnt; t += 2) {
            const bool last = (t == cnt - 2);
            const char* a1 = cA + (size_t)(t + 1) * kstep;
            const char* a2 = last ? nA : cA + (size_t)(t + 2) * kstep; const char* b2 = last ? nB : cB + (size_t)(t + 2) * kstep;
            const char* a3 = a2 + kstep; const char* b3 = b2 + kstep;
            if (last && has_next) S.a_ready(nxt);
            if constexpr (SP2) {
            PG8_LDB(B0, 0, 0); PG8_LDB(B1, 0, 1); PG8_SCHED; PG8_LDA(At, 0, 0); PG8_STAGE_A(PG8_SA(1, 1), a1, 1, false);
            PG8_WAIT_V(8); PG8_WAIT_L(0); PG8_BAR; PG8_MMA(0, 0, At, B0); PG8_MMA(0, 1, At, B1); PG8_BAR; PG8_SCHED;
            PG8_LDA(At, 0, 1); PG8_STAGE(PG8_SB(0, 0), b2, voffB); PG8_STAGE(PG8_SB(0, 1), b2 + hstepB, voffB); PG8_STAGE_A(PG8_SA(0, 0), a2, 0, last);
            PG8_WAIT_V(8); PG8_WAIT_L(0); PG8_BAR; PG8_MMA(1, 0, At, B0); PG8_MMA(1, 1, At, B1); PG8_BAR; PG8_SCHED;
            PG8_LDB(B0, 1, 0); PG8_LDB(B1, 1, 1); PG8_SCHED; PG8_LDA(At, 1, 0); PG8_STAGE_A(PG8_SA(0, 1), a2, 1, last);
            PG8_WAIT_V(8); PG8_WAIT_L(0); PG8_BAR; PG8_MMA(0, 0, At, B0); PG8_MMA(0, 1, At, B1); PG8_BAR; PG8_SCHED;
            PG8_LDA(At, 1, 1); PG8_STAGE(PG8_SB(1, 0), b3, voffB); PG8_STAGE(PG8_SB(1, 1), b3 + hstepB, voffB); PG8_STAGE_A(PG8_SA(1, 0), a3, 0, last);
            PG8_WAIT_V(8); PG8_WAIT_L(0); PG8_BAR; PG8_MMA(1, 0, At, B0); PG8_MMA(1, 1, At, B1); PG8_BAR; PG8_SCHED;
            } else {
            PG8_LDB(B0, 0, 0); PG8_SCHED; PG8_LDA(At, 0, 0); PG8_STAGE_A(PG8_SA(1, 1), a1, 1, false);
            PG8_WAIT_L(8); PG8_BAR; PG8_WAIT_L(0); PG8_MMA(0, 0, At, B0); PG8_BAR; PG8_SCHED;
            PG8_LDB(B1, 0, 1); PG8_STAGE(PG8_SB(0, 0), b2, voffB);
            PG8_BAR; PG8_WAIT_L(0); PG8_MMA(0, 1, At, B1); PG8_BAR;
            PG8_LDA(At, 0, 1); PG8_STAGE_A(PG8_SA(0, 0), a2, 0, last);
            PG8_BAR; PG8_WAIT_L(0); PG8_MMA(1, 0, At, B0); PG8_BAR; PG8_SCHED;
            PG8_STAGE(PG8_SB(0, 1), b2 + hstepB, voffB);
            PG8_WAIT_V(6); PG8_BAR; PG8_MMA(1, 1, At, B1); PG8_BAR;
            PG8_LDB(B0, 1, 0); PG8_SCHED; PG8_LDA(At, 1, 0); PG8_STAGE_A(PG8_SA(0, 1), a2, 1, last);
            PG8_WAIT_L(8); PG8_BAR; PG8_WAIT_L(0); PG8_MMA(0, 0, At, B0); PG8_BAR; PG8_SCHED;
            PG8_LDB(B1, 1, 1); PG8_STAGE(PG8_SB(1, 0), b3, voffB);
            PG8_BAR; PG8_WAIT_L(0); PG8_MMA(0, 1, At, B1); PG8_BAR;
            PG8_LDA(At, 1, 1); PG8_STAGE_A(PG8_SA(1, 0), a3, 0, last);
            PG8_BAR; PG8_WAIT_L(0); PG8_MMA(1, 0, At, B0); PG8_BAR; PG8_SCHED;
            PG8_STAGE(PG8_SB(1, 1), b3 + hstepB, voffB);
            PG8_WAIT_V(6); PG8_BAR; PG8_MMA(1, 1, At, B1); PG8_BAR;
            }
        }
        if constexpr (ALIGN_EPI) { if (wr == 0) PG8_BAR; }
        if constexpr (!Epi::AFTER_DRAIN) { E(acc, cur, wr, wc, fr, fq); S.done(cur); }
        if (!has_next) break;
#pragma unroll
        for (int a = 0; a < 2; ++a)
#pragma unroll
            for (int b = 0; b < 2; ++b)
#pragma unroll
                for (int m = 0; m < 4; ++m)
#pragma unroll
                    for (int n = 0; n < 2; ++n) acc[a][b][m][n] = (f32x4){0.f, 0.f, 0.f, 0.f};
        cur = nxt; cA = nA; cB = nB; ++ui; cnt = cur.nk ? cur.nk : nt;
        if constexpr (GATHER) { _Pragma("unroll") for (int h_ = 0; h_ < 2; ++h_) { gcur[h_][0] = gnxt[h_][0]; gcur[h_][1] = gnxt[h_][1]; } }
        if constexpr (ALIGN_EPI) { if (wr == 1) PG8_BAR; }
    }
    PG8_WAIT_V(0);
    if constexpr (!ALIGN_EPI) { if (wr == 0) PG8_BAR; }
    PG8_BAR;
    if constexpr (Epi::AFTER_DRAIN) { E.fused(acc, cur, wr, wc, fr, fq, lds, wid, lane); S.done(cur); }
#undef PG8_SA
#undef PG8_GOFF
#undef PG8_STAGE_A
#undef PG8_SB
#undef PG8_STAGE
#undef PG8_LDA
#undef PG8_LDB
#undef PG8_MMA
#undef PG8_WAIT_V
#undef PG8_WAIT_L
#undef PG8_BAR
#undef PG8_SCHED
}
}

constexpr int NB = 16, SEQ = 4096, CTX = 256, TT = SEQ + CTX, M = NB * TT, D = 1024, NL = 4;
constexpr int NPJ = 2304, DPROJ = 2208;
constexpr int MS = 143360;
constexpr float EPS = 1e-6f, ALPHA = 1.6817928305074290f, LOG2E = 1.4426950408889634f;
constexpr int NWAVES = 8, NTHR = 512;
#ifndef MK_DEBUG
#define MK_DEBUG 0
#endif
#ifndef MK_TIME
#define MK_TIME 0
#endif
#ifndef MK_TMUL
#define MK_TMUL 1
#endif
#ifndef MK_VM
#define MK_VM 0
#endif
#ifndef MK_DUP
#define MK_DUP 0
#endif
#ifndef MK_MULTI
#define MK_MULTI 0
#endif
constexpr int NPHASE = 2 + 10 * NL;

constexpr size_t WS_CTL = 0, CTL_BYTES = 65536;
constexpr size_t WS_MODS = WS_CTL + CTL_BYTES;
constexpr size_t WS_T64 = WS_MODS + (size_t)NL * 17 * 6144 * 4;
constexpr size_t WS_T32 = WS_T64 + 8192;
constexpr size_t WS_RS = WS_T32 + 4096;
constexpr size_t WS_RT = WS_RS + (size_t)M * 8;
constexpr size_t WS_HIST = WS_RT + (size_t)M * 32;
constexpr size_t WS_XS = WS_HIST + 65536;
constexpr size_t WS_WIN = WS_XS + (size_t)M * D * 2;
constexpr size_t WS_WD = WS_WIN + (size_t)NPJ * D * 2;
constexpr size_t WS_WOUT = WS_WD + (size_t)1024 * 384 * 2;
constexpr size_t WS_WGU = WS_WOUT + (size_t)D * D * 2;
constexpr size_t WS_WDN = WS_WGU + (size_t)16 * 1024 * 1024 * 2;
constexpr size_t WS_HA = WS_WDN + (size_t)16 * 1024 * 512 * 2;
constexpr size_t WS_PB = WS_HA + (size_t)M * D * 2;
constexpr size_t WS_QD = WS_PB + (size_t)M * NPJ * 2;
constexpr size_t WS_KD = WS_QD + (size_t)M * 384 * 2;
constexpr size_t WS_VD = WS_KD + (size_t)M * 384 * 2;
constexpr size_t WS_ACT = WS_VD + (size_t)M * 256 * 2;
constexpr size_t WS_END = WS_ACT + (size_t)MS * 512 * 2;
static_assert(WS_END <= (size_t)1073741824, "d_ws map must fit 1 GiB");
static_assert((size_t)M * NPJ * 2 >= (size_t)MS * D * 2 && (size_t)M * NPJ * 2 >= (size_t)M * D * 4, "region PB overlays");
constexpr int CW_BAR = 0;
constexpr int CW_QUEUE = 4096;

constexpr int RING_BYTES = 131072, MISC_OFF = RING_BYTES, LDS_BYTES = 147456;
constexpr int MI_BAR = 0, MI_Q = 4, MI_TOT = 16, MI_BASE = 32, MI_PST = 48, MI_LH = 80;

#define GAS __attribute__((address_space(1)))
#define LAS __attribute__((address_space(3)))
typedef unsigned short bf16;
typedef unsigned v4u __attribute__((ext_vector_type(4)));
typedef unsigned v2u __attribute__((ext_vector_type(2)));
typedef float f32x4 __attribute__((ext_vector_type(4)));
typedef float f32x2 __attribute__((ext_vector_type(2)));
typedef short bf16x8 __attribute__((ext_vector_type(8)));
typedef float f32x16 __attribute__((ext_vector_type(16)));
typedef short v4i16 __attribute__((ext_vector_type(4)));

__device__ __forceinline__ unsigned f2bf(float f) { unsigned u = __builtin_bit_cast(unsigned, f); return (u + 0x7fffu + ((u >> 16) & 1u)) >> 16; }
typedef __bf16 bf16x2_hw __attribute__((ext_vector_type(2)));
__device__ __forceinline__ unsigned pk2(float lo, float hi) { f32x2 v = {lo, hi}; const bf16x2_hw b = __builtin_convertvector(v, bf16x2_hw); return __builtin_bit_cast(unsigned, b); }
__device__ __forceinline__ float bflo(unsigned w) { return __builtin_bit_cast(float, w << 16); }
__device__ __forceinline__ float bfhi(unsigned w) { return __builtin_bit_cast(float, w & 0xffff0000u); }
__device__ __forceinline__ void unpack8(v4u w, float (&f)[8]) { f[0] = bflo(w.x); f[1] = bfhi(w.x); f[2] = bflo(w.y); f[3] = bfhi(w.y); f[4] = bflo(w.z); f[5] = bfhi(w.z); f[6] = bflo(w.w); f[7] = bfhi(w.w); }
__device__ __forceinline__ v4u pack8(const float (&f)[8]) { v4u w; w.x = pk2(f[0], f[1]); w.y = pk2(f[2], f[3]); w.z = pk2(f[4], f[5]); w.w = pk2(f[6], f[7]); return w; }
__device__ __forceinline__ float wave_sum(float v) {
    int x = __builtin_bit_cast(int, v);
#define WS_DPP(ctrl, rmask) v += __builtin_bit_cast(float, __builtin_amdgcn_update_dpp(0, x, ctrl, rmask, 0xf, true)); x = __builtin_bit_cast(int, v)
    WS_DPP(0xB1, 0xf);
    WS_DPP(0x4E, 0xf);
    WS_DPP(0x141, 0xf);
    WS_DPP(0x140, 0xf);
    WS_DPP(0x142, 0xa);
    WS_DPP(0x143, 0xc);
#undef WS_DPP
    return __builtin_bit_cast(float, __builtin_amdgcn_readlane(__builtin_bit_cast(int, v), 63));
}

#define XB_TMO      128
#define XB_XCNT(j)  (256  + 64 * (j))
#define XB_XSUB(j)  (1280 + 64 * (j))
#define XB_XGEN(j)  (2304 + 64 * (j))
#define XB_TOP      3328
#define XB_TOPGEN   3392
#define XCD_BAR_WORDS 3456
#define XB_SPIN_CAP (1u << 22)
__device__ __forceinline__ unsigned xb_ld(unsigned* p)              { return __hip_atomic_load(p, __ATOMIC_RELAXED, __HIP_MEMORY_SCOPE_AGENT); }
__device__ __forceinline__ unsigned xb_add(unsigned* p, unsigned v) { return __hip_atomic_fetch_add(p, v, __ATOMIC_RELAXED, __HIP_MEMORY_SCOPE_AGENT); }
__device__ __forceinline__ unsigned xb_xcc_id() { return (unsigned)__builtin_amdgcn_s_getreg((3 << 11) | 20) & 0xFu; }
#define XB_SPIN(cond, bar) do { unsigned _sp = 0; while (cond) { __builtin_amdgcn_s_sleep(1); \
    if ((++_sp & 255u) == 0u) { if (xb_ld(&(bar)[XB_TMO])) break; if (_sp > XB_SPIN_CAP) { atomicAdd(&(bar)[XB_TMO], 1u); break; } } } } while (0)
struct XcdBarrier { unsigned* bar; unsigned x; volatile LAS unsigned* st; };
__device__ __forceinline__ XcdBarrier xcd_barrier_post(unsigned* bar, volatile LAS unsigned* st) {
    XcdBarrier b; b.bar = bar; b.x = xb_xcc_id(); b.st = st;
    if (threadIdx.x == 0) (void)xb_add(&bar[XB_XCNT(b.x)], 1u);
    return b;
}
__device__ __forceinline__ void xcd_barrier_complete(unsigned* bar, unsigned x, unsigned& nloc, unsigned& nx) {
    const unsigned G = gridDim.x * gridDim.y * gridDim.z;
    unsigned sum, cnt, mine, sp = 0u;
    for (;;) {
        sum = 0u; cnt = 0u; mine = 0u;
#pragma unroll
        for (unsigned j = 0; j < 16; ++j) { const unsigned c = xb_ld(&bar[XB_XCNT(j)]); sum += c; cnt += (c > 0u) ? 1u : 0u; mine = (j == x) ? c : mine; }
        if (sum == G) break;
        __builtin_amdgcn_s_sleep(1);
        if ((++sp & 255u) == 0u) { if (xb_ld(&bar[XB_TMO])) break; if (sp > XB_SPIN_CAP) { atomicAdd(&bar[XB_TMO], 1u); break; } }
    }
    nloc = mine > 0u ? mine : 1u; nx = cnt > 0u ? cnt : 1u;
}
__device__ __forceinline__ void xcd_barrier(const XcdBarrier& b) {
    asm volatile("s_waitcnt vmcnt(0)" ::: "memory");
    __syncthreads();
    if (threadIdx.x == 0) {
        unsigned* bar = b.bar;
        __builtin_amdgcn_s_waitcnt(0);
        unsigned nloc = b.st[0], nx = b.st[1];
        if (nloc == 0u) { xcd_barrier_complete(bar, b.x, nloc, nx); b.st[0] = nloc; b.st[1] = nx; }
        const unsigned old = xb_add(&bar[XB_XSUB(b.x)], 1u);
        const unsigned gen = old / nloc;
        if (old + 1u == (gen + 1u) * nloc) {
            __builtin_amdgcn_fence(__ATOMIC_RELEASE, "agent");
            asm volatile("s_waitcnt vmcnt(0)" ::: "memory");
            const unsigned og = xb_add(&bar[XB_TOP], 1u);
            const unsigned tg = og / nx;
            if (og + 1u == (tg + 1u) * nx) xb_add(&bar[XB_TOPGEN], 1u);
            else XB_SPIN(xb_ld(&bar[XB_TOPGEN]) == tg, bar);
            __builtin_amdgcn_fence(__ATOMIC_ACQUIRE, "agent");
            xb_add(&bar[XB_XGEN(b.x)], 1u);
            asm volatile("s_waitcnt vmcnt(0)" ::: "memory");
        } else {
            XB_SPIN(xb_ld(&bar[XB_XGEN(b.x)]) == gen, bar);
            __builtin_amdgcn_fence(__ATOMIC_ACQUIRE, "agent");
            asm volatile("s_waitcnt vmcnt(0)" ::: "memory");
        }
    }
    __syncthreads();
}

struct Args { const float* in[27]; float* out; unsigned char* ws; int ph_lo, ph_hi; };
enum { I_X = 0, I_C, I_CTX, I_CCTX, I_WADA, I_BADA, I_WIN, I_NABIAS, I_GQG, I_GKG, I_SINK, I_MQG, I_WQB, I_MKVG, I_WKVB, I_WOUT, I_LN1G, I_LN1B, I_RGW, I_RGB, I_REW, I_REB, I_WG, I_WU, I_WDN, I_LN2G, I_LN2B };

struct Frame {
    LAS unsigned char* lds; volatile LAS unsigned* MISC;
    int tid, lane, wave, G, gw, ngw, bid;
    GAS unsigned char* ws;
};
__device__ __forceinline__ int opaque_tid() { int t = threadIdx.x; asm volatile("" : "+v"(t)); return t; }
__device__ __forceinline__ int opaque_s(int x) { asm volatile("" : "+s"(x)); return x; }
constexpr int PTAB_OFF = MISC_OFF + 2048, I_OUT = 27;
__device__ __forceinline__ GAS unsigned char* ptab_get(const Frame& F, int i) {
    const LAS unsigned* t = (const LAS unsigned*)(F.lds + PTAB_OFF) + 2 * i;
    const unsigned lo = __builtin_amdgcn_readfirstlane(t[0]), hi = __builtin_amdgcn_readfirstlane(t[1]);
    return (GAS unsigned char*)(((unsigned long long)hi << 32) | lo);
}
#define INP(i) ((const float*)ptab_get(F, (i)))
__device__ __forceinline__ Frame make_frame(GAS unsigned char* ws) {
    extern __shared__ __attribute__((aligned(16))) unsigned char lds_raw[];
    Frame F;
    F.lds = (LAS unsigned char*)lds_raw; F.MISC = (volatile LAS unsigned*)(F.lds + MISC_OFF);
    F.tid = opaque_tid(); F.lane = F.tid & 63; F.wave = __builtin_amdgcn_readfirstlane(F.tid >> 6);
    F.G = opaque_s((int)gridDim.x); F.bid = opaque_s((int)blockIdx.x); F.gw = F.bid * NWAVES + F.wave; F.ngw = F.G * NWAVES;
    { unsigned long long w = (unsigned long long)ws; asm volatile("" : "+s"(w)); F.ws = (GAS unsigned char*)w; }
    return F;
}
typedef _Float16 f16x4 __attribute__((ext_vector_type(4)));
struct RowPtrs { const float* x; const float* ctx; float* out; _Float16* xs; };
__device__ __forceinline__ RowPtrs row_ptrs(const Frame& F) { RowPtrs p; p.x = INP(I_X); p.ctx = INP(I_CTX); p.out = (float*)ptab_get(F, I_OUT); p.xs = (_Float16*)(F.ws + WS_XS); return p; }
__device__ __forceinline__ const float* xin_row(const RowPtrs& P, int r) {
    const int b = r / TT, t = r - b * TT;
    return t < SEQ ? P.x + ((size_t)b * SEQ + t) * D : P.ctx + ((size_t)b * CTX + (t - SEQ)) * D;
}
__device__ __forceinline__ float* out_row(const RowPtrs& P, int r) { const int b = r / TT, t = r - b * TT; return P.out + ((size_t)b * SEQ + t) * D; }
__device__ __forceinline__ void ld16h(const _Float16* p, int lane, float (&v)[16]) {
    const f16x4* q = (const f16x4*)p + lane;
#pragma unroll
    for (int g = 0; g < 4; ++g) { const f32x4 f = __builtin_convertvector(__builtin_nontemporal_load(q + 64 * g), f32x4); v[4 * g] = f.x; v[4 * g + 1] = f.y; v[4 * g + 2] = f.z; v[4 * g + 3] = f.w; }
}
__device__ __forceinline__ void st16h(_Float16* p, int lane, const float (&v)[16]) {
    f16x4* q = (f16x4*)p + lane;
#pragma unroll
    for (int g = 0; g < 4; ++g) __builtin_nontemporal_store(__builtin_convertvector((f32x4){v[4 * g], v[4 * g + 1], v[4 * g + 2], v[4 * g + 3]}, f16x4), q + 64 * g);
}
__device__ __forceinline__ void ld16(const float* p, int lane, float (&v)[16]) {
    const f32x4* q = (const f32x4*)p + lane;
    const f32x4 a = q[0], b = q[64], c = q[128], d = q[192];
    v[0] = a.x; v[1] = a.y; v[2] = a.z; v[3] = a.w; v[4] = b.x; v[5] = b.y; v[6] = b.z; v[7] = b.w;
    v[8] = c.x; v[9] = c.y; v[10] = c.z; v[11] = c.w; v[12] = d.x; v[13] = d.y; v[14] = d.z; v[15] = d.w;
}
__device__ __forceinline__ void st16(float* p, int lane, const float (&v)[16]) {
    f32x4* q = (f32x4*)p + lane;
    q[0] = (f32x4){v[0], v[1], v[2], v[3]}; q[64] = (f32x4){v[4], v[5], v[6], v[7]};
    q[128] = (f32x4){v[8], v[9], v[10], v[11]}; q[192] = (f32x4){v[12], v[13], v[14], v[15]};
}
__device__ __forceinline__ void ld16nt(const float* p, int lane, float (&v)[16]) {
    const f32x4* q = (const f32x4*)p + lane;
    const f32x4 a = __builtin_nontemporal_load(q), b = __builtin_nontemporal_load(q + 64), c = __builtin_nontemporal_load(q + 128), d = __builtin_nontemporal_load(q + 192);
    v[0] = a.x; v[1] = a.y; v[2] = a.z; v[3] = a.w; v[4] = b.x; v[5] = b.y; v[6] = b.z; v[7] = b.w;
    v[8] = c.x; v[9] = c.y; v[10] = c.z; v[11] = c.w; v[12] = d.x; v[13] = d.y; v[14] = d.z; v[15] = d.w;
}
__device__ __forceinline__ void st16nt(float* p, int lane, const float (&v)[16]) {
    f32x4* q = (f32x4*)p + lane;
    __builtin_nontemporal_store((f32x4){v[0], v[1], v[2], v[3]}, q); __builtin_nontemporal_store((f32x4){v[4], v[5], v[6], v[7]}, q + 64);
    __builtin_nontemporal_store((f32x4){v[8], v[9], v[10], v[11]}, q + 128); __builtin_nontemporal_store((f32x4){v[12], v[13], v[14], v[15]}, q + 192);
}
__device__ __forceinline__ void unpack16(const v2u (&w)[4], float (&v)[16]) {
#pragma unroll
    for (int g = 0; g < 4; ++g) { v[4 * g] = bflo(w[g].x); v[4 * g + 1] = bfhi(w[g].x); v[4 * g + 2] = bflo(w[g].y); v[4 * g + 3] = bfhi(w[g].y); }
}
__device__ __forceinline__ void ld16bf_raw(const bf16* p, int lane, v2u (&w)[4]) {
    const v2u* q = (const v2u*)p + lane; w[0] = q[0]; w[1] = q[64]; w[2] = q[128]; w[3] = q[192];
}
__device__ __forceinline__ void ld16bf_raw_nt(const bf16* p, int lane, v2u (&w)[4]) {
    const v2u* q = (const v2u*)p + lane; w[0] = __builtin_nontemporal_load(q); w[1] = __builtin_nontemporal_load(q + 64); w[2] = __builtin_nontemporal_load(q + 128); w[3] = __builtin_nontemporal_load(q + 192);
}
__device__ __forceinline__ void ld16bf(const bf16* p, int lane, float (&v)[16]) { v2u w[4]; ld16bf_raw(p, lane, w); unpack16(w, v); }
__device__ __forceinline__ void ld16bf_nt(const bf16* p, int lane, float (&v)[16]) { v2u w[4]; ld16bf_raw_nt(p, lane, w); unpack16(w, v); }
__device__ __forceinline__ void st16bf(bf16* p, int lane, const float (&v)[16]) {
    v2u* q = (v2u*)p + lane;
#pragma unroll
    for (int g = 0; g < 4; ++g) { v2u w; w.x = pk2(v[4 * g], v[4 * g + 1]); w.y = pk2(v[4 * g + 2], v[4 * g + 3]); q[64 * g] = w; }
}
__device__ __forceinline__ void ln16(float (&v)[16]) {
    float s = 0.f;
#pragma unroll
    for (int i = 0; i < 16; ++i) s += v[i];
    const float mean = wave_sum(s) * (1.0f / D); float q = 0.f;
#pragma unroll
    for (int i = 0; i < 16; ++i) { v[i] -= mean; q += v[i] * v[i]; }
    const float rstd = __builtin_amdgcn_rsqf(wave_sum(q) * (1.0f / D) + EPS);
#pragma unroll
    for (int i = 0; i < 16; ++i) v[i] *= rstd;
}

__device__ __forceinline__ int rows_per_wave(int ngw) {
    int rpw = (M + ngw - 1) / ngw;
    if (!((SEQ % rpw) % 4 == 0 && (TT % rpw) == 0 && (rpw % 2) == 0)) rpw = (rpw + 3) & ~3;
    return rpw;
}
template <int TYPE>
__device__ __forceinline__ float conv_src(const float* p0, const float* p1, const float* g0, const float* g1, int l, int k, int n) {
    if (TYPE == 0) return n < DPROJ ? p0[((size_t)l * D + k) * DPROJ + n] : 0.f;
    if (TYPE == 1) { if (n < 384) return k < 256 ? g0[l * 256 + k] * p0[((size_t)l * 256 + k) * 384 + n] : 0.f;
                     if (n < 896) return k >= 256 ? g1[l * 128 + (k - 256)] * p1[((size_t)l * 128 + (k - 256)) * 512 + (n - 384)] : 0.f;
                     return 0.f; }
    if (TYPE == 2) return p0[((size_t)l * D + k) * D + n];
    if (TYPE == 3) { const int e = n >> 10, nn = n & 1023, q = nn >> 3, j = nn & 7;
                     return j < 4 ? p0[(((size_t)l * 16 + e) * D + k) * 512 + 4 * q + j] : p1[(((size_t)l * 16 + e) * D + k) * 512 + 4 * q + (j - 4)]; }
    { const int e = n >> 10, nn = n & 1023; return p0[(((size_t)l * 16 + e) * 512 + k) * D + nn]; }
}
template <int TYPE>
__device__ __forceinline__ f32x4 conv_src4(const float* p0, const float* p1, const float* g0, const float* g1, int l, int k, int n) {
    const f32x4 z = {0.f, 0.f, 0.f, 0.f};
    if (TYPE == 0) return n < DPROJ ? *(const f32x4*)(p0 + ((size_t)l * D + k) * DPROJ + n) : z;
    if (TYPE == 1) { if (n < 384) return k < 256 ? *(const f32x4*)(p0 + ((size_t)l * 256 + k) * 384 + n) * g0[l * 256 + k] : z;
                     if (n < 896) return k >= 256 ? *(const f32x4*)(p1 + ((size_t)l * 128 + (k - 256)) * 512 + (n - 384)) * g1[l * 128 + (k - 256)] : z;
                     return z; }
    if (TYPE == 2) return *(const f32x4*)(p0 + ((size_t)l * D + k) * D + n);
    if (TYPE == 3) { const int e = n >> 10, nn = n & 1023, q = nn >> 3, j = nn & 7;
                     return *(const f32x4*)((j < 4 ? p0 : p1) + (((size_t)l * 16 + e) * D + k) * 512 + 4 * q); }
    { const int e = n >> 10, nn = n & 1023; return *(const f32x4*)(p0 + (((size_t)l * 16 + e) * 512 + k) * D + nn); }
}
template <int TYPE>
__device__ __forceinline__ void conv_item(const Frame& F, int l, int item, LAS float* scr) {
    constexpr int Nd = TYPE == 0 ? NPJ : TYPE == 1 ? 1024 : TYPE == 2 ? 1024 : 16384, Kd = TYPE == 1 ? 384 : TYPE == 4 ? 512 : 1024;
    bf16* dst = (bf16*)(F.ws + (TYPE == 0 ? WS_WIN : TYPE == 1 ? WS_WD : TYPE == 2 ? WS_WOUT : TYPE == 3 ? WS_WGU : WS_WDN));
    const float* p0 = INP(TYPE == 0 ? I_WIN : TYPE == 1 ? I_WQB : TYPE == 2 ? I_WOUT : TYPE == 3 ? I_WG : I_WDN);
    const float* p1 = INP(TYPE == 1 ? I_WKVB : I_WU); const float* g0 = INP(I_MQG); const float* g1 = INP(I_MKVG);
    constexpr int nblk = Nd / 32; const int kb = item / nblk, nb = item - kb * nblk, k0 = 64 * kb, n0 = 32 * nb, lane = F.lane;
#pragma unroll
    for (int i = 0; i < 8; ++i) { const int kk = 8 * i + (lane >> 3), nq = 4 * (lane & 7);
        const f32x4 v = conv_src4<TYPE>(p0, p1, g0, g1, l, k0 + kk, n0 + nq);
        LAS float* d = scr + kk * 33 + nq; d[0] = v.x; d[1] = v.y; d[2] = v.z; d[3] = v.w; }
    asm volatile("s_waitcnt lgkmcnt(0)" ::: "memory");
    const int c = lane & 7;
#pragma unroll
    for (int j = 0; j < 4; ++j) { const int n = (lane >> 3) + 8 * j; const LAS float* s = scr + (8 * c) * 33 + n;
        v4u o; o.x = pk2(s[0 * 33], s[1 * 33]); o.y = pk2(s[2 * 33], s[3 * 33]); o.z = pk2(s[4 * 33], s[5 * 33]); o.w = pk2(s[6 * 33], s[7 * 33]);
        *(v4u*)(dst + (size_t)(n0 + n) * Kd + k0 + 8 * c) = o; }
    asm volatile("s_waitcnt lgkmcnt(0)" ::: "memory");
}
__device__ __forceinline__ void phase_prologue(const Frame& F) {
    {
        LAS float* sv = (LAS float*)F.lds;
        LAS float* red = (LAS float*)(F.lds + 17 * 1024 * 4);
        float* mods = (float*)(F.ws + WS_MODS);
        for (int u = F.bid; u < NL * 48; u += F.G) {
            const int l = u / 48, cc = u - l * 48;
            const float* pc = INP(I_C); const float* pcc = INP(I_CCTX);
            for (int i = F.tid; i < 17 * 1024; i += NTHR) { const int mr = i >> 10, k = i & 1023; const float c = mr < 16 ? pc[mr * 1024 + k] : pcc[k]; sv[i] = c / (1.0f + expf(-c)); }
            __syncthreads();
            const int col = F.tid & 127, kg = F.tid >> 7;
            float acc[17];
#pragma unroll
            for (int mr = 0; mr < 17; ++mr) acc[mr] = 0.f;
            const float* w = INP(I_WADA) + ((size_t)l * 1024 + kg * 256) * 6144 + cc * 128 + col;
            for (int k8 = 0; k8 < 256; k8 += 8) {
                float wv[8];
#pragma unroll
                for (int j = 0; j < 8; ++j) wv[j] = w[(size_t)(k8 + j) * 6144];
#pragma unroll
                for (int q = 0; q < 2; ++q)
#pragma unroll
                    for (int mr = 0; mr < 17; ++mr) { const f32x4 s = *(const LAS f32x4*)(sv + mr * 1024 + kg * 256 + k8 + 4 * q); acc[mr] += (s.x * wv[4 * q] + s.y * wv[4 * q + 1]) + (s.z * wv[4 * q + 2] + s.w * wv[4 * q + 3]); }
            }
#pragma unroll
            for (int mr = 0; mr < 17; ++mr) red[(kg * 17 + mr) * 128 + col] = acc[mr];
            __syncthreads();
            const float* bada = INP(I_BADA);
            for (int i = F.tid; i < 17 * 128; i += NTHR) { const int mr = i >> 7, c = i & 127;
                const float s = (red[(0 * 17 + mr) * 128 + c] + red[(1 * 17 + mr) * 128 + c]) + (red[(2 * 17 + mr) * 128 + c] + red[(3 * 17 + mr) * 128 + c]);
                mods[((size_t)l * 17 + mr) * 6144 + cc * 128 + c] = s + bada[l * 6144 + cc * 128 + c]; }
            __syncthreads();
        }
    }
    {
        float* t64 = (float*)(F.ws + WS_T64); float* t32 = (float*)(F.ws + WS_T32);
        for (int i = F.bid * NTHR + F.tid; i < 64 * 16 + 64 * 8; i += F.G * NTHR) {
            if (i < 1024) { const int p = i >> 4, k = i & 15; const float fr = powf(10000.0f, -(float)k / 16.0f), ang = (float)p * fr; t64[2 * i] = cosf(ang); t64[2 * i + 1] = sinf(ang); }
            else { const int j = i - 1024, p = j >> 3, k = j & 7; const float fr = powf(10000.0f, -(float)k / 8.0f), ang = (float)p * fr; t32[2 * j] = cosf(ang); t32[2 * j + 1] = sinf(ang); }
        }
    }
}
template <int TYPE>
__device__ __forceinline__ void conv_load(const Frame& F, int l, int item, f32x4 (&v)[8], bf16*& dstp, int& kd) {
    constexpr int Nd = TYPE == 0 ? NPJ : TYPE == 1 ? 1024 : TYPE == 2 ? 1024 : 16384, Kd = TYPE == 1 ? 384 : TYPE == 4 ? 512 : 1024;
    bf16* dst = (bf16*)(F.ws + (TYPE == 0 ? WS_WIN : TYPE == 1 ? WS_WD : TYPE == 2 ? WS_WOUT : TYPE == 3 ? WS_WGU : WS_WDN));
    const float* p0 = INP(TYPE == 0 ? I_WIN : TYPE == 1 ? I_WQB : TYPE == 2 ? I_WOUT : TYPE == 3 ? I_WG : I_WDN);
    const float* p1 = INP(TYPE == 1 ? I_WKVB : I_WU); const float* g0 = INP(I_MQG); const float* g1 = INP(I_MKVG);
    constexpr int nblk = Nd / 32; const int kb = item / nblk, nb = item - kb * nblk, k0 = 64 * kb, n0 = 32 * nb, lane = F.lane;
#pragma unroll
    for (int i = 0; i < 8; ++i) v[i] = conv_src4<TYPE>(p0, p1, g0, g1, l, k0 + 8 * i + (lane >> 3), n0 + 4 * (lane & 7));
    dstp = dst + (size_t)n0 * Kd + k0; kd = Kd;
}
__device__ __forceinline__ void conv_load_any(const Frame& F, int l, int r, f32x4 (&v)[8], bf16*& dstp, int& kd) {
    constexpr int I0 = 1152, I1 = 192, I2 = 512, I3 = 8192;
    if (r < I0) { conv_load<0>(F, l, r, v, dstp, kd); return; } r -= I0;
    if (r < I1) { conv_load<1>(F, l, r, v, dstp, kd); return; } r -= I1;
    if (r < I2) { conv_load<2>(F, l, r, v, dstp, kd); return; } r -= I2;
    if (r < I3) { conv_load<3>(F, l, r, v, dstp, kd); return; } r -= I3;
    conv_load<4>(F, l, r, v, dstp, kd);
}
__device__ __forceinline__ void conv_finish(const Frame& F, const f32x4 (&v)[8], bf16* dstp, int kd, LAS float* scr) {
    const int lane = F.lane;
#pragma unroll
    for (int i = 0; i < 8; ++i) { LAS float* d = scr + (8 * i + (lane >> 3)) * 33 + 4 * (lane & 7); d[0] = v[i].x; d[1] = v[i].y; d[2] = v[i].z; d[3] = v[i].w; }
    asm volatile("s_waitcnt lgkmcnt(0)" ::: "memory");
    const int c = lane & 7;
#pragma unroll
    for (int j = 0; j < 4; ++j) { const int n = (lane >> 3) + 8 * j; const LAS float* s = scr + (8 * c) * 33 + n;
        v4u o; o.x = pk2(s[0 * 33], s[1 * 33]); o.y = pk2(s[2 * 33], s[3 * 33]); o.z = pk2(s[4 * 33], s[5 * 33]); o.w = pk2(s[6 * 33], s[7 * 33]);
        *(v4u*)(dstp + (size_t)n * kd + 8 * c) = o; }
    asm volatile("s_waitcnt lgkmcnt(0)" ::: "memory");
}
__device__ __forceinline__ void convert_layer_weights(const Frame& F, int l) {
    LAS float* scr = (LAS float*)(F.lds + F.wave * 8448);
    constexpr int IL = 1152 + 192 + 512 + 8192 + 4096;
    f32x4 va[8], vb[8]; bf16* da = nullptr; bf16* db = nullptr; int ka = 0, kb = 0;
    int r = F.gw;
    if (r < IL) conv_load_any(F, l, r, va, da, ka);
    while (r < IL) {
        const int r1 = r + F.ngw;
        if (r1 < IL) conv_load_any(F, l, r1, vb, db, kb);
        conv_finish(F, va, da, ka, scr);
        if (r1 >= IL) break;
        const int r2 = r1 + F.ngw;
        if (r2 < IL) conv_load_any(F, l, r2, va, da, ka);
        conv_finish(F, vb, db, kb, scr);
        r = r2;
    }
}

__device__ __forceinline__ void phase_ln(const Frame& F, int l) {
    if (l < NL) convert_layer_weights(F, l);
    constexpr int NR = 4;
    const float* mods = (const float*)(F.ws + WS_MODS); bf16* HA = (bf16*)(F.ws + WS_HA);
    const bf16* Y = (const bf16*)(F.ws + WS_PB); const unsigned* RT = (const unsigned*)(F.ws + WS_RT);
    const int lane = F.lane; const RowPtrs RP = row_ptrs(F);
    LAS float* LN2T = (LAS float*)(F.lds + 69632);
    { const float* ln2g = INP(I_LN2G) + (l > 0 ? l - 1 : 0) * D; const float* ln2b = INP(I_LN2B) + (l > 0 ? l - 1 : 0) * D;
      for (int i = F.tid; i < 1024; i += NTHR) { LN2T[i] = ln2g[i]; LN2T[1024 + i] = ln2b[i]; } }
    __syncthreads();
    const LAS unsigned char* l2base = (const LAS unsigned char*)LN2T + F.lane * 16; asm volatile("" : "+v"(l2base));
    const int rpw = rows_per_wave(F.ngw), rbeg = F.gw * rpw, rend = min(M, rbeg + rpw);
    float g2[16]; int cur_mr = -1;
    float alpha_l = ALPHA; asm volatile("" : "+v"(alpha_l));
    for (int r0 = rbeg; r0 < rend; r0 += NR) {
        float v[NR][16]; v4u rt[NR]; v2u ya[NR][4], yb[NR][4]; bool act[NR];
        const int b0 = r0 / TT, t0 = r0 - b0 * TT; const bool lat = t0 < SEQ; const int mr = lat ? b0 : 16;
        if (l == NL && !lat) continue;
#pragma unroll
        for (int u = 0; u < NR; ++u) {
            const int r = r0 + u; act[u] = r < rend; const int rc = act[u] ? r : r0;
            if (l == 0) ld16nt(xin_row(RP, rc), lane, v[u]); else ld16h(RP.xs + (size_t)rc * D, lane, v[u]);
            rt[u] = *(const v4u*)(RT + (size_t)rc * 8 + 4);
        }
        if (mr != cur_mr) { if (l > 0) ld16(mods + ((size_t)(l - 1) * 17 + mr) * 6144 + 5120, lane, g2); cur_mr = mr; }
        if (l > 0) {
#pragma unroll
            for (int u = 0; u < NR; ++u) { ld16bf_raw_nt(Y + (size_t)rt[u].z * D, lane, ya[u]); ld16bf_raw_nt(Y + (size_t)rt[u].w * D, lane, yb[u]); }
#pragma unroll
            for (int u = 0; u < NR; ++u) {
                float f0[16], f1[16], gg[16], bb[16];
                const float w0 = __uint_as_float(rt[u].x), w1 = __uint_as_float(rt[u].y);
                unpack16(ya[u], f0); unpack16(yb[u], f1);
#pragma unroll
                for (int i = 0; i < 16; ++i) v[u][i] = alpha_l * v[u][i] + g2[i] * (w0 * f0[i] + w1 * f1[i]);
#pragma unroll
                for (int g = 0; g < 4; ++g) { const f32x4 a = *(const LAS f32x4*)(l2base + 1024 * g), c = *(const LAS f32x4*)(l2base + 4096 + 1024 * g);
                    gg[4 * g] = a.x; gg[4 * g + 1] = a.y; gg[4 * g + 2] = a.z; gg[4 * g + 3] = a.w; bb[4 * g] = c.x; bb[4 * g + 1] = c.y; bb[4 * g + 2] = c.z; bb[4 * g + 3] = c.w; }
                ln16(v[u]);
#pragma unroll
                for (int i = 0; i < 16; ++i) v[u][i] = v[u][i] * gg[i] + bb[i];
                if (act[u]) { if (l == NL) st16nt(out_row(RP, r0 + u), lane, v[u]); else st16h(RP.xs + (size_t)(r0 + u) * D, lane, v[u]); }
            }
        }
        if (l < NL) {
            float sh[16], sc[16]; ld16(mods + ((size_t)l * 17 + mr) * 6144, lane, sh); ld16(mods + ((size_t)l * 17 + mr) * 6144 + 1024, lane, sc);
#pragma unroll
            for (int u = 0; u < NR; ++u) {
                ln16(v[u]);
#pragma unroll
                for (int i = 0; i < 16; ++i) v[u][i] = v[u][i] * (1.0f + sc[i]) + sh[i];
                if (act[u]) st16bf(HA + (size_t)(r0 + u) * D, lane, v[u]);
            }
        }
    }
}

__device__ __forceinline__ void rope8(float (&f)[8], const float (&p)[8], const float* cs, bool first) {
    const f32x4* c4 = (const f32x4*)cs;
#pragma unroll
    for (int q = 0; q < 4; ++q) { const f32x4 t = c4[q];
        f[2 * q] = first ? f[2 * q] * t.x - p[2 * q] * t.y : p[2 * q] * t.y + f[2 * q] * t.x;
        f[2 * q + 1] = first ? f[2 * q + 1] * t.z - p[2 * q + 1] * t.w : p[2 * q + 1] * t.w + f[2 * q + 1] * t.z; }
}
__device__ __forceinline__ void rope8(float (&f)[8], const float (&p)[8], const LAS float* cs, bool first) {
    const LAS f32x4* c4 = (const LAS f32x4*)cs;
#pragma unroll
    for (int q = 0; q < 4; ++q) { const f32x4 t = c4[q];
        f[2 * q] = first ? f[2 * q] * t.x - p[2 * q] * t.y : p[2 * q] * t.y + f[2 * q] * t.x;
        f[2 * q + 1] = first ? f[2 * q + 1] * t.z - p[2 * q + 1] * t.w : p[2 * q + 1] * t.w + f[2 * q + 1] * t.z; }
}
#define DPPF(v, ctrl) __builtin_bit_cast(float, __builtin_amdgcn_update_dpp(0, __builtin_bit_cast(int, (v)), (ctrl), 0xf, 0xf, true))
__device__ __forceinline__ float dpp_xor1(float v) { return DPPF(v, 0xB1); }
__device__ __forceinline__ float dpp_xor2(float v) { return DPPF(v, 0x4E); }
__device__ __forceinline__ float dpp_hmir(float v) { return DPPF(v, 0x141); }
__device__ __forceinline__ float dpp_mir(float v) { return DPPF(v, 0x140); }
__device__ __forceinline__ void phase_post(const Frame& F, int l) {
    constexpr int NR = 4;
    bf16* P = (bf16*)(F.ws + WS_PB); bf16* KD = (bf16*)(F.ws + WS_KD);
    LAS float* t64 = (LAS float*)F.lds; LAS float* t32 = t64 + 2048;
    { const float* g64 = (const float*)(F.ws + WS_T64); const float* g32 = (const float*)(F.ws + WS_T32);
      for (int i = F.tid; i < 2048; i += NTHR) t64[i] = g64[i];
      for (int i = F.tid; i < 1024; i += NTHR) t32[i] = g32[i]; }
    __syncthreads();
    const int lane = F.lane; const float* gains = (lane < 32 ? INP(I_GQG) : INP(I_GKG)) + l * 64;
    const int j = lane & 7, jj = lane & 3;
    float gn[8];
#pragma unroll
    for (int i = 0; i < 8; ++i) gn[i] = gains[j * 8 + i];
    const int prpw = (M + F.ngw - 1) / F.ngw, pbeg = F.gw * prpw, pend = min(M, pbeg + prpw);
    for (int r0 = pbeg; r0 < pend; r0 += NR) {
        v4u w0[NR], w1[NR], w2[NR]; int rr[NR]; bool act[NR];
#pragma unroll
        for (int u = 0; u < NR; ++u) { const int r = r0 + u; act[u] = r < pend; rr[u] = act[u] ? r : r0; const bf16* prow = P + (size_t)rr[u] * NPJ;
            w0[u] = *((const v4u*)(prow + 768) + lane); w1[u] = *((const v4u*)(prow + 1280) + lane); w2[u] = *((const v4u*)(prow + 1792) + lane); }
#pragma unroll
        for (int u = 0; u < NR; ++u) {
            const int r = rr[u]; const int b = r / TT, t = r - b * TT; const bool lat = t < SEQ; const int gr = (t >> 6) & 63, gc = t & 63;
            bf16* prow = P + (size_t)r * NPJ;
            const LAS float* cs64 = t64 + ((j < 4 ? gr : gc) * 16 + (j & 1) * 8) * 2;
            {
                float f[8]; unpack8(w0[u], f);
                float ss = 0.f;
#pragma unroll
                for (int i = 0; i < 8; ++i) ss += f[i] * f[i];
                ss += dpp_xor1(ss); ss += dpp_xor2(ss); ss += dpp_hmir(ss);
                const float rs = __builtin_amdgcn_rsqf(ss * (1.0f / 64.0f) + EPS);
#pragma unroll
                for (int i = 0; i < 8; ++i) f[i] = f[i] * rs * gn[i];
                float p[8];
#pragma unroll
                for (int i = 0; i < 8; ++i) p[i] = dpp_xor2(f[i]);
                if (lat) rope8(f, p, cs64, (j & 2) == 0);
                if (lane < 48 && act[u]) *((v4u*)(prow + 768) + lane) = pack8(f);
            }
            {
                float f[8]; unpack8(w1[u], f);
                float p[8];
#pragma unroll
                for (int i = 0; i < 8; ++i) p[i] = dpp_xor2(f[i]);
                rope8(f, p, cs64, (j & 2) == 0);
                if (lat && lane < 48 && act[u]) *((v4u*)(prow + 1280) + lane) = pack8(f);
            }
            {
                float f[8]; unpack8(w2[u], f);
                float ss = 0.f;
#pragma unroll
                for (int i = 0; i < 8; ++i) ss += f[i] * f[i];
                ss += dpp_xor1(ss); ss += dpp_xor2(ss); ss += dpp_hmir(ss); ss += dpp_mir(ss);
                const float s32 = __builtin_bit_cast(float, __builtin_amdgcn_readlane(__builtin_bit_cast(int, ss), 0)) + __builtin_bit_cast(float, __builtin_amdgcn_readlane(__builtin_bit_cast(int, ss), 16));
                const float rn = __builtin_amdgcn_rsqf(lane < 32 ? s32 * (1.0f / 256.0f) + EPS : ss * (1.0f / 128.0f) + EPS);
                if (lane < 48 && act[u]) { float fn[8];
#pragma unroll
                    for (int i = 0; i < 8; ++i) fn[i] = f[i] * rn;
                    *((v4u*)(prow + 1792) + lane) = pack8(fn); }
                float p[8];
#pragma unroll
                for (int i = 0; i < 8; ++i) p[i] = dpp_xor1(f[i]);
                if (lat) rope8(f, p, t32 + ((jj < 2 ? gr : gc) * 8) * 2, (jj & 1) == 0);
                if (lane >= 48 && lane < 52 && act[u]) { const v4u o = pack8(f);
#pragma unroll
                    for (int h = 0; h < 4; ++h) *(v4u*)(KD + (size_t)r * 384 + h * 96 + 64 + 8 * jj) = o; }
            }
        }
    }
}

__device__ __forceinline__ float rt_dot(const float (&x)[16], f32x4 w0, f32x4 w1, f32x4 w2, f32x4 w3) {
    float a = x[0] * w0.x, b = x[8] * w2.x;
    a = __builtin_fmaf(x[1], w0.y, a); b = __builtin_fmaf(x[9], w2.y, b); a = __builtin_fmaf(x[2], w0.z, a); b = __builtin_fmaf(x[10], w2.z, b);
    a = __builtin_fmaf(x[3], w0.w, a); b = __builtin_fmaf(x[11], w2.w, b); a = __builtin_fmaf(x[4], w1.x, a); b = __builtin_fmaf(x[12], w3.x, b);
    a = __builtin_fmaf(x[5], w1.y, a); b = __builtin_fmaf(x[13], w3.y, b); a = __builtin_fmaf(x[6], w1.z, a); b = __builtin_fmaf(x[14], w3.z, b);
    a = __builtin_fmaf(x[7], w1.w, a); b = __builtin_fmaf(x[15], w3.w, b);
    return a + b;
}
__device__ __forceinline__ void reduce4(float& a, float& b, float& c, float& d) {
    auto r1 = __builtin_amdgcn_permlane32_swap(__builtin_bit_cast(unsigned, a), __builtin_bit_cast(unsigned, b), false, false); const unsigned x0 = r1[0], x1 = r1[1];
    auto r2 = __builtin_amdgcn_permlane32_swap(__builtin_bit_cast(unsigned, c), __builtin_bit_cast(unsigned, d), false, false); const unsigned y0 = r2[0], y1 = r2[1];
    const float X = __uint_as_float(x0) + __uint_as_float(x1), Y = __uint_as_float(y0) + __uint_as_float(y1);
    auto r3 = __builtin_amdgcn_permlane16_swap(__builtin_bit_cast(unsigned, X), __builtin_bit_cast(unsigned, Y), false, false); const unsigned z0 = r3[0], z1 = r3[1];
    float z = __uint_as_float(z0) + __uint_as_float(z1);
    z += dpp_xor1(z); z += dpp_xor2(z); z += dpp_hmir(z); z += dpp_mir(z);
    const int zi = __builtin_bit_cast(int, z);
    a = __builtin_bit_cast(float, __builtin_amdgcn_readlane(zi, 0)); c = __builtin_bit_cast(float, __builtin_amdgcn_readlane(zi, 16));
    b = __builtin_bit_cast(float, __builtin_amdgcn_readlane(zi, 32)); d = __builtin_bit_cast(float, __builtin_amdgcn_readlane(zi, 48));
}
__device__ __forceinline__ void ln16_pair(float (&v0)[16], float (&v1)[16]) {
    float s0 = 0.f, q0 = 0.f, s1 = 0.f, q1 = 0.f;
#pragma unroll
    for (int i = 0; i < 16; ++i) { s0 += v0[i]; q0 = __builtin_fmaf(v0[i], v0[i], q0); s1 += v1[i]; q1 = __builtin_fmaf(v1[i], v1[i], q1); }
    reduce4(s0, q0, s1, q1);
    const float m0 = s0 * (1.0f / D), m1 = s1 * (1.0f / D);
    const float r0 = __builtin_amdgcn_rsqf(fmaxf(q0 * (1.0f / D) - m0 * m0, 0.f) + EPS), r1 = __builtin_amdgcn_rsqf(fmaxf(q1 * (1.0f / D) - m1 * m1, 0.f) + EPS);
    const float c0 = -m0 * r0, c1 = -m1 * r1;
#pragma unroll
    for (int i = 0; i < 16; ++i) { v0[i] = __builtin_fmaf(v0[i], r0, c0); v1[i] = __builtin_fmaf(v1[i], r1, c1); }
}
__device__ __forceinline__ void phase_route(const Frame& F, int l) {
    const float* mods = (const float*)(F.ws + WS_MODS); bf16* HA = (bf16*)(F.ws + WS_HA);
    const bf16* MIX = (const bf16*)(F.ws + WS_PB); unsigned* RT = (unsigned*)(F.ws + WS_RT); int* HIST = (int*)(F.ws + WS_HIST);
    LAS float* WR = (LAS float*)F.lds;
    { const float* rgw = INP(I_RGW); const float* rew = INP(I_REW);
      for (int k = F.tid; k < 1024; k += NTHR) {
        const f32x4 g = *(const f32x4*)(rgw + ((size_t)l * D + k) * 4);
        WR[0 * 1024 + k] = g.x; WR[1 * 1024 + k] = g.y; WR[2 * 1024 + k] = g.z; WR[3 * 1024 + k] = g.w;
#pragma unroll
        for (int q = 0; q < 4; ++q) { const f32x4 e = *(const f32x4*)(rew + ((size_t)l * D + k) * 16 + 4 * q);
            WR[(4 + 4 * q) * 1024 + k] = e.x; WR[(5 + 4 * q) * 1024 + k] = e.y; WR[(6 + 4 * q) * 1024 + k] = e.z; WR[(7 + 4 * q) * 1024 + k] = e.w; } } }
    if (F.tid < 16) F.MISC[MI_LH + F.tid] = 0u;
    __syncthreads();
    LAS float* bias = (LAS float*)(F.lds + 20 * 1024 * 4);
    if (F.tid < 20) bias[F.tid] = F.tid < 4 ? INP(I_RGB)[l * 4 + F.tid] : INP(I_REB)[l * 16 + (F.tid - 4)];
    __syncthreads();
    const RowPtrs RP = row_ptrs(F);
    LAS float* LNG = (LAS float*)(F.lds + 20 * 1024 * 4 + 128);
    { const float* ln1g = INP(I_LN1G) + l * D; const float* ln1b = INP(I_LN1B) + l * D;
      for (int i = F.tid; i < 1024; i += NTHR) { LNG[i] = ln1g[i]; LNG[1024 + i] = ln1b[i]; } }
    __syncthreads();
    constexpr int NR = 2;
    const LAS unsigned char* wbase = (const LAS unsigned char*)WR + F.lane * 16; asm volatile("" : "+v"(wbase));
    const LAS unsigned char* lbase = (const LAS unsigned char*)LNG + F.lane * 16; asm volatile("" : "+v"(lbase));
#define RT_W4(base_, off_) (*(const LAS f32x4*)((base_) + (off_)))
    const int rpw = rows_per_wave(F.ngw), rbeg = F.gw * rpw, rend = min(M, rbeg + rpw);
    float g1[16], sh[16], sc[16]; int cur_mr = -1;
    float alpha_l = ALPHA; asm volatile("" : "+v"(alpha_l));
    v4u rx[NR][4]; v2u rm[NR][4];
#define RT_ISSUE(r0_) do { _Pragma("unroll") for (int u = 0; u < NR; ++u) { const int r_ = (r0_) + u, rc_ = r_ < rend ? r_ : (r0_); \
        if (l == 0) { const v4u* q_ = (const v4u*)xin_row(RP, rc_) + F.lane; _Pragma("unroll") for (int g = 0; g < 4; ++g) rx[u][g] = __builtin_nontemporal_load(q_ + 64 * g); } \
        else { const v2u* q_ = (const v2u*)(RP.xs + (size_t)rc_ * D) + F.lane; _Pragma("unroll") for (int g = 0; g < 4; ++g) { const v2u t_ = __builtin_nontemporal_load(q_ + 64 * g); rx[u][g].x = t_.x; rx[u][g].y = t_.y; } } \
        ld16bf_raw_nt(MIX + (size_t)rc_ * D, F.lane, rm[u]); } } while (0)
    if (rbeg < rend) RT_ISSUE(rbeg);
    for (int r0 = rbeg; r0 < rend; r0 += NR) {
        float v[NR][16]; int rr[NR]; bool act[NR];
        { const int b = r0 / TT, t = r0 - b * TT, mr = t < SEQ ? b : 16;
          if (mr != cur_mr) { const float* md = mods + ((size_t)l * 17 + mr) * 6144; ld16(md + 2048, F.lane, g1); ld16(md + 3072, F.lane, sh); ld16(md + 4096, F.lane, sc); cur_mr = mr; } }
#pragma unroll
        for (int u = 0; u < NR; ++u) { const int r = r0 + u; act[u] = r < rend; rr[u] = act[u] ? r : r0;
            float mx[16]; unpack16(rm[u], mx);
            if (l == 0) {
#pragma unroll
                for (int g = 0; g < 4; ++g) { v[u][4 * g] = __uint_as_float(rx[u][g].x); v[u][4 * g + 1] = __uint_as_float(rx[u][g].y); v[u][4 * g + 2] = __uint_as_float(rx[u][g].z); v[u][4 * g + 3] = __uint_as_float(rx[u][g].w); }
            } else {
#pragma unroll
                for (int g = 0; g < 4; ++g) { const v2u t = {rx[u][g].x, rx[u][g].y}; const f32x4 f = __builtin_convertvector(__builtin_bit_cast(f16x4, t), f32x4);
                    v[u][4 * g] = f.x; v[u][4 * g + 1] = f.y; v[u][4 * g + 2] = f.z; v[u][4 * g + 3] = f.w; }
            }
#pragma unroll
            for (int i = 0; i < 16; ++i) v[u][i] = alpha_l * v[u][i] + g1[i] * mx[i]; }
        if (r0 + NR < rend) RT_ISSUE(r0 + NR);
        if (l == NL - 1 && (r0 % TT) >= SEQ) continue;
        ln16_pair(v[0], v[1]);
        { float gg[16], bb[16];
#pragma unroll
          for (int g = 0; g < 4; ++g) { const f32x4 a = RT_W4(lbase, 1024 * g), c = RT_W4(lbase, 4096 + 1024 * g);
              gg[4 * g] = a.x; gg[4 * g + 1] = a.y; gg[4 * g + 2] = a.z; gg[4 * g + 3] = a.w; bb[4 * g] = c.x; bb[4 * g + 1] = c.y; bb[4 * g + 2] = c.z; bb[4 * g + 3] = c.w; }
#pragma unroll
          for (int u = 0; u < NR; ++u) {
#pragma unroll
            for (int i = 0; i < 16; ++i) v[u][i] = v[u][i] * gg[i] + bb[i];
            if (act[u]) st16h(RP.xs + (size_t)rr[u] * D, F.lane, v[u]); } }
        ln16_pair(v[0], v[1]);
#pragma unroll
        for (int u = 0; u < NR; ++u) {
#pragma unroll
            for (int i = 0; i < 16; ++i) v[u][i] = v[u][i] * (1.0f + sc[i]) + sh[i];
            if (act[u]) st16bf(HA + (size_t)rr[u] * D, F.lane, v[u]); }
#define RT_DOT(u_, w0, w1, w2, w3) rt_dot(v[u_], w0, w1, w2, w3)
        float gl[NR][4];
#pragma unroll
        for (int jx = 0; jx < 4; ++jx) {
            const f32x4 w0 = RT_W4(wbase, 4096 * jx), w1 = RT_W4(wbase, 4096 * jx + 1024), w2 = RT_W4(wbase, 4096 * jx + 2048), w3 = RT_W4(wbase, 4096 * jx + 3072);
#pragma unroll
            for (int u = 0; u < NR; ++u) gl[u][jx] = RT_DOT(u, w0, w1, w2, w3);
        }
#pragma unroll
        for (int u = 0; u < NR; ++u) { reduce4(gl[u][0], gl[u][1], gl[u][2], gl[u][3]);
#pragma unroll
            for (int jx = 0; jx < 4; ++jx) gl[u][jx] += bias[jx]; }
        int grpv[NR]; float pgv[NR];
#pragma unroll
        for (int u = 0; u < NR; ++u) {
            int grp = 0; float mg = gl[u][0];
#pragma unroll
            for (int g = 1; g < 4; ++g) if (gl[u][g] > mg) { mg = gl[u][g]; grp = g; }
            float sg = 0.f;
#pragma unroll
            for (int g = 0; g < 4; ++g) sg += __builtin_amdgcn_exp2f((gl[u][g] - mg) * LOG2E);
            grpv[u] = grp; pgv[u] = __builtin_amdgcn_rcpf(sg);
        }
        float selv[NR][4];
#pragma unroll
        for (int u = 0; u < NR; ++u) {
            const LAS unsigned char* eb = wbase + (4 + 4 * grpv[u]) * 4096;
#pragma unroll
            for (int i = 0; i < 4; ++i) {
                const f32x4 w0 = RT_W4(eb, 4096 * i), w1 = RT_W4(eb, 4096 * i + 1024), w2 = RT_W4(eb, 4096 * i + 2048), w3 = RT_W4(eb, 4096 * i + 3072);
                selv[u][i] = RT_DOT(u, w0, w1, w2, w3);
            }
        }
#pragma unroll
        for (int u = 0; u < NR; ++u) { reduce4(selv[u][0], selv[u][1], selv[u][2], selv[u][3]);
#pragma unroll
            for (int i = 0; i < 4; ++i) selv[u][i] += bias[4 + 4 * grpv[u] + i]; }
#undef RT_DOT
#pragma unroll
        for (int u = 0; u < NR; ++u) {
            const int grp = grpv[u]; const float pg = pgv[u];
            float sel[4];
#pragma unroll
            for (int i = 0; i < 4; ++i) sel[i] = selv[u][i];
            int i1 = 0; float v1 = sel[0];
#pragma unroll
            for (int i = 1; i < 4; ++i) if (sel[i] > v1) { v1 = sel[i]; i1 = i; }
            int i2 = -1; float v2 = -3.0e38f;
#pragma unroll
            for (int i = 0; i < 4; ++i) if (i != i1 && (i2 < 0 || sel[i] > v2)) { v2 = sel[i]; i2 = i; }
            const float ee = __builtin_amdgcn_exp2f((v2 - v1) * LOG2E), rq = __builtin_amdgcn_rcpf(1.0f + ee), w1 = pg * rq, w2 = pg * ee * rq;
            const int e1 = grp * 4 + i1, e2 = grp * 4 + i2;
            if (F.lane == 0 && act[u]) {
                const unsigned k1 = __hip_atomic_fetch_add((LAS unsigned*)&F.MISC[MI_LH + e1], 1u, __ATOMIC_RELAXED, __HIP_MEMORY_SCOPE_WORKGROUP);
                const unsigned k2 = __hip_atomic_fetch_add((LAS unsigned*)&F.MISC[MI_LH + e2], 1u, __ATOMIC_RELAXED, __HIP_MEMORY_SCOPE_WORKGROUP);
                v4u ra; ra.x = (unsigned)e1; ra.y = (unsigned)e2; ra.z = k1; ra.w = k2;
                v4u rb; rb.x = __builtin_bit_cast(unsigned, w1); rb.y = __builtin_bit_cast(unsigned, w2); rb.z = 0u; rb.w = 0u;
                *(v4u*)(RT + (size_t)rr[u] * 8) = ra; *(v4u*)(RT + (size_t)rr[u] * 8 + 4) = rb;
            }
        }
    }
#undef RT_ISSUE
#undef RT_W4
    __syncthreads();
    if (F.tid < 16) HIST[F.bid * 16 + F.tid] = (int)F.MISC[MI_LH + F.tid];
}
__device__ __forceinline__ void moe_tables(const Frame& F) {
    const int* HIST = (const int*)(F.ws + WS_HIST); LAS int* hl = (LAS int*)F.lds;
    __syncthreads();
    for (int i = F.tid; i < F.G * 16; i += NTHR) hl[i] = HIST[i];
    __syncthreads();
    {
        LAS int* part = hl + F.G * 16;
        const int e = F.tid & 15, sl = F.tid >> 4, per = (F.G + 31) >> 5, g0 = sl * per, g1 = min(F.G, g0 + per);
        int tot = 0, mine = 0;
        for (int g = g0; g < g1; ++g) { const int c = hl[g * 16 + e]; tot += c; mine += (g < F.bid) ? c : 0; }
        part[sl * 16 + e] = tot; part[512 + sl * 16 + e] = mine;
        __syncthreads();
        if (F.tid < 16) { int t2 = 0, m2 = 0;
#pragma unroll
            for (int k = 0; k < 32; ++k) { t2 += part[k * 16 + F.tid]; m2 += part[512 + k * 16 + F.tid]; }
            F.MISC[MI_TOT + F.tid] = (unsigned)t2; F.MISC[MI_BASE + F.tid] = (unsigned)m2; } }
    __syncthreads();
    if (F.tid == 0) { unsigned p = 0; for (int e = 0; e < 16; ++e) { F.MISC[MI_PST + e] = p; F.MISC[MI_BASE + e] += p * 256u; p += (F.MISC[MI_TOT + e] + 255u) >> 8; } F.MISC[MI_PST + 16] = p; }
    __syncthreads();
}
__device__ __forceinline__ void phase_permute(const Frame& F, int l) {
    unsigned* RT = (unsigned*)(F.ws + WS_RT); int* SRC = (int*)(F.ws + WS_QD);
    moe_tables(F);
    const int rpw = rows_per_wave(F.ngw), rbeg = F.gw * rpw, rend = min(M, rbeg + rpw);
    for (int r = rbeg + F.lane; r < rend; r += 64) {
        if (l == NL - 1 && (r % TT) >= SEQ) continue;
        const v4u ra = *(const v4u*)(RT + (size_t)r * 8);
        const unsigned p0 = F.MISC[MI_BASE + (ra.x & 15u)] + ra.z, p1 = F.MISC[MI_BASE + (ra.y & 15u)] + ra.w;
        RT[(size_t)r * 8 + 6] = p0; RT[(size_t)r * 8 + 7] = p1; SRC[p0] = r; SRC[p1] = r;
    }
    if (F.bid == 0) {
        for (int e = 0; e < 16; ++e) { const int beg = (int)F.MISC[MI_PST + e] * 256 + (int)F.MISC[MI_TOT + e], end = (int)F.MISC[MI_PST + e + 1] * 256;
            for (int p = beg + F.tid; p < end; p += NTHR) SRC[p] = 0; }
    }
}

struct EpiMla {
    static constexpr bool PERM = true, AFTER_DRAIN = false;
    bf16* QD; bf16* KD; bf16* VD;
    __device__ __forceinline__ void operator()(const pg8::f32x4 (&acc)[2][2][4][2], const pg8::Unit& u, int wr, int wc, int fr, int fq) const {
#pragma unroll
        for (int bj = 0; bj < 2; ++bj) {
            const int g0 = u.pn * 256 + bj * 128 + wc * 32, col0 = g0 + 8 * fq;
            if (g0 >= 896) continue;
            const int c = col0 - 384, hd = c >> 7, jx = c & 127;
            bf16* dst = g0 < 384 ? QD + col0 : jx < 64 ? KD + hd * 96 + jx : VD + hd * 64 + (jx - 64);
            const int stride = (g0 < 384 || jx < 64) ? 384 : 256;
            dst += (size_t)(u.pm * 256 + wr * 64 + fr) * stride;
#pragma unroll
            for (int ai = 0; ai < 2; ++ai)
#pragma unroll
                for (int m = 0; m < 4; ++m) {
                    v4u o; o.x = pk2(acc[ai][bj][m][0][0], acc[ai][bj][m][0][1]); o.y = pk2(acc[ai][bj][m][0][2], acc[ai][bj][m][0][3]);
                    o.z = pk2(acc[ai][bj][m][1][0], acc[ai][bj][m][1][1]); o.w = pk2(acc[ai][bj][m][1][2], acc[ai][bj][m][1][3]);
                    *(v4u*)(dst + (size_t)(ai * 128 + m * 16) * stride) = o;
                }
        }
    }
};
struct EpiGU {
    static constexpr bool PERM = true, AFTER_DRAIN = false;
    bf16* ACT;
    __device__ __forceinline__ void operator()(const pg8::f32x4 (&acc)[2][2][4][2], const pg8::Unit& u, int wr, int wc, int fr, int fq) const {
#pragma unroll
        for (int ai = 0; ai < 2; ++ai)
#pragma unroll
            for (int mp = 0; mp < 4; mp += 2) {
                const int row = u.pm * 256 + ai * 128 + wr * 64 + (mp + (fq & 1)) * 16 + fr;
#pragma unroll
                for (int bj = 0; bj < 2; ++bj) {
                    const int c = (u.pn & 3) * 256 + bj * 128 + wc * 32 + 8 * (fq & ~1);
                    unsigned px[2], py[2];
#pragma unroll
                    for (int k = 0; k < 2; ++k) { float o[4];
#pragma unroll
                        for (int i = 0; i < 4; ++i) { const float g = acc[ai][bj][mp + k][0][i], up = acc[ai][bj][mp + k][1][i]; o[i] = g * __builtin_amdgcn_rcpf(1.0f + __expf(-g)) * up; }
                        px[k] = pk2(o[0], o[1]); py[k] = pk2(o[2], o[3]); }
                    auto rx = __builtin_amdgcn_permlane16_swap(px[0], px[1], false, false); const unsigned ax = rx[0], bx = rx[1];
                    auto ry = __builtin_amdgcn_permlane16_swap(py[0], py[1], false, false); const unsigned ay = ry[0], by = ry[1];
                    v4u w; w.x = ax; w.y = ay; w.z = bx; w.w = by;
                    *(v4u*)(ACT + (size_t)row * 512 + (c >> 1)) = w;
                }
            }
    }
};
struct MoeOrder {
    volatile LAS unsigned* pst; int G, c;
    __device__ __forceinline__ bool next(int i, pg8::Unit& u) const {
        const int np = (int)pst[16]; int panel, pn;
        if ((G & 7) == 0) { const int x = c & 7, uu = i * (G >> 3) + (c >> 3); panel = (uu >> 2) * 8 + x; pn = uu & 3; }
        else { const int L = i * G + c; panel = L >> 2; pn = L & 3; }
        if (panel >= np) return false;
        int e = 0;
#pragma unroll
        for (int k = 1; k < 16; ++k) e += (panel >= (int)pst[k]) ? 1 : 0;
        u.pm = __builtin_amdgcn_readfirstlane(panel); u.pn = __builtin_amdgcn_readfirstlane(e * 4 + pn); return true;
    }
    __device__ __forceinline__ void a_ready(const pg8::Unit&) const {}
    __device__ __forceinline__ void done(const pg8::Unit&) const {}
};

struct MlaOrder {
    pg8::StaticOrder S;
    __device__ __forceinline__ bool next(int i, pg8::Unit& u) const { pg8::StaticOrder T = S; if ((S.G & 31) == 0) T.c = (S.c + (S.G >> 2) * i) % S.G; if (!T.next(i, u)) return false;
        if (u.pn == 0) { u.kb = 0; u.nk = 4; } else if (u.pn == 1) { u.kb = 0; u.nk = 6; } else { u.kb = 4; u.nk = 2; } return true; }
    __device__ __forceinline__ void a_ready(const pg8::Unit&) const {}
    __device__ __forceinline__ void done(const pg8::Unit&) const {}
};
struct LatOrder {
    int G, c;
    __device__ __forceinline__ bool next(int i, pg8::Unit& u) const {
        int pl, pn;
        if ((G & 7) == 0) { const int x = c & 7, uu = i * (G >> 3) + (c >> 3); pl = (uu >> 2) * 8 + x; pn = uu & 3; } else { const int L = i * G + c; pl = L >> 2; pn = L & 3; }
        if (pl >= NB * 16) return false;
        u.pm = pl + (pl >> 4); u.pn = pn; return true;
    }
    __device__ __forceinline__ void a_ready(const pg8::Unit&) const {}
    __device__ __forceinline__ void done(const pg8::Unit&) const {}
};

#ifndef DBG_VAR
#define DBG_VAR 1
#endif
namespace att {
constexpr int VRS = 192, KBUF = 64 * 208, VBUF = 64 * VRS, BUF = KBUF + VBUF, BIAS_OFF = 4 * BUF;
constexpr float NEG = -30000.0f;
__device__ __forceinline__ int crow(int r, int hi) { return (r & 3) + 8 * (r >> 2) + 4 * hi; }
__device__ __forceinline__ float xhalf_max(float v) { const unsigned a = __builtin_bit_cast(unsigned, v);
    auto rr = __builtin_amdgcn_permlane32_swap(a, a, false, false); const unsigned r0 = rr[0], r1 = rr[1]; return fmaxf(__uint_as_float(r0), __uint_as_float(r1)); }
__device__ __forceinline__ float xhalf_sum(float v) { const unsigned a = __builtin_bit_cast(unsigned, v);
    auto rr = __builtin_amdgcn_permlane32_swap(a, a, false, false); const unsigned r0 = rr[0], r1 = rr[1]; return __uint_as_float(r0) + __uint_as_float(r1); }
__device__ __forceinline__ float max3f(float a, float b, float c) { float r; asm("v_max3_f32 %0, %1, %2, %3" : "=v"(r) : "v"(a), "v"(b), "v"(c)); return r; }
typedef __bf16 bf16x2_t __attribute__((ext_vector_type(2)));
__device__ __forceinline__ unsigned cvtpk(float lo, float hi) { f32x2 v = {lo, hi}; bf16x2_t b = __builtin_convertvector(v, bf16x2_t); return __builtin_bit_cast(unsigned, b); }

template <int DK, int VM = 0>
__device__ __forceinline__ void unit(LAS unsigned char* lds, const bf16* Qp, int qpitch, const bf16* Kp, int kpitch, const bf16* Vp, int vpitch, bf16* Op,
                                     int var, int qt, int lo, int n1, int nt, float qscale, float sinkl2, bool has_sink, const LAS float* bias, const float* t32, unsigned* dbg) {
    constexpr int KRS = DK * 2 + 16, NS = DK / 16, CPK = DK / 8;
    int tid = threadIdx.x; asm volatile("" : "+v"(tid)); const int lane = tid & 63, r32 = lane & 31, hi = lane >> 5, wid = __builtin_amdgcn_readfirstlane(tid >> 6);
    const int qrow = 256 * qt + 32 * wid + r32;
    bf16x8 qr[NS];
#pragma unroll
    for (int s = 0; s < NS; ++s) { const v4u raw = *(const v4u*)(Qp + (size_t)qrow * qpitch + 16 * s + 8 * hi); float f[8]; unpack8(raw, f);
#pragma unroll
        for (int i = 0; i < 8; ++i) f[i] *= qscale;
        if (DK == 96 && s >= 4) {
            float p[8];
#pragma unroll
            for (int i = 0; i < 8; ++i) p[i] = __shfl_xor(f[i], 32);
            if (qt < 16) rope8(f, p, t32 + ((size_t)((s == 4 ? (qrow >> 6) : (qrow & 63)) * 8)) * 2, hi == 0);
        }
        qr[s] = __builtin_bit_cast(bf16x8, pack8(f)); }
    const int kkey0 = tid / CPK, kch0 = tid - kkey0 * CPK, kkey1 = (tid + 512) / CPK, kch1 = (tid + 512) - kkey1 * CPK;
    const int vkey = tid >> 3, vch = tid & 7;
    v4u kreg0, kreg1 = {0u, 0u, 0u, 0u}, vreg;
#define ATT_TROW(j) ((((j) < n1) ? (lo + (j)) : (64 + (j) - n1)) * 64)
#define ATT_LOAD(j) do { const int tr_ = ATT_TROW(j); kreg0 = *(const v4u*)(Kp + (size_t)(tr_ + kkey0) * kpitch + kch0 * 8); \
        if (DK == 96 && tid < 256) kreg1 = *(const v4u*)(Kp + (size_t)(tr_ + kkey1) * kpitch + kch1 * 8); \
        vreg = *(const v4u*)(Vp + (size_t)(tr_ + vkey) * vpitch + vch * 8); } while (0)
#define ATT_STORE(bf) do { LAS unsigned char* b_ = lds + (bf) * BUF; *(LAS v4u*)(b_ + kkey0 * KRS + kch0 * 16) = kreg0; \
        if (DK == 96 && tid < 256) *(LAS v4u*)(b_ + kkey1 * KRS + kch1 * 16) = kreg1; \
        *(LAS v4u*)(b_ + KBUF + vkey * VRS + vch * 16) = vreg; } while (0)
    constexpr float THR = 6.0f;
    float m = 0.f; f32x2 lacc = {0.f, 0.f}; f32x16 o0 = {}, o1 = {}; f32x16 negm = {}; bool first = true;
    const int grw = 4 * qt + (wid >> 1), r0w = min(max(grw - 4, 0), 56), gc = (wid & 1) * 32 + r32, c0 = min(max(gc - 8, 0), 48), i0w = 256 * qt + 32 * wid;
    ATT_LOAD(0); ATT_STORE(0);
    __syncthreads();
    for (int j = 0; j < nt; ++j) {
        if (!(VM & 8) && j + 1 < nt) ATT_LOAD(j + 1);
        const int kt = ATT_TROW(j) >> 6;
        bool actv = true;
        if (kt < 64) { if (var == 0) actv = (kt >= r0w) && (kt <= r0w + 7); else if (var == 2) actv = !((64 * kt - (i0w + 31) > 128) || (i0w - (64 * kt + 63) > 128)); }
        if (actv) {
            const LAS unsigned char* Kb = lds + (j & 1) * BUF; const LAS unsigned char* Vb = Kb + KBUF;
            f32x16 s0 = negm, s1 = negm;
            bf16x8 ka[NS], kb[NS];
#pragma unroll
            for (int s = 0; s < NS; ++s) { ka[s] = *(const LAS bf16x8*)(Kb + r32 * KRS + (16 * s + 8 * hi) * 2); kb[s] = *(const LAS bf16x8*)(Kb + (32 + r32) * KRS + (16 * s + 8 * hi) * 2); }
            __builtin_amdgcn_sched_barrier(0);
            if (VM & 2) {
#pragma unroll
                for (int s = 0; s < NS; ++s) asm volatile("" :: "v"(ka[s]), "v"(kb[s]), "v"(qr[s]));
            } else {
#pragma unroll
            for (int s = 0; s < NS; ++s) { s0 = __builtin_amdgcn_mfma_f32_32x32x16_bf16(ka[s], qr[s], s0, 0, 0, 0); s1 = __builtin_amdgcn_mfma_f32_32x32x16_bf16(kb[s], qr[s], s1, 0, 0, 0); }
            }
            asm volatile("s_nop 15\n\ts_nop 7" : "+v"(s0), "+v"(s1));
            if (kt < 64 && var == 0) {
                const int rowoff = (kt - grw + 7) * 31 - gc + 15;
#pragma unroll
                for (int r = 0; r < 16; ++r) { const int j0 = crow(r, hi), j1 = j0 + 32;
                    const bool v0 = (unsigned)(j0 - c0) < 16u, v1 = (unsigned)(j1 - c0) < 16u;
                    const float b0 = bias[v0 ? rowoff + j0 : 0], b1 = bias[v1 ? rowoff + j1 : 0];
                    s0[r] = v0 ? s0[r] + b0 : NEG; s1[r] = v1 ? s1[r] + b1 : NEG; }
            } else if (kt < 64 && var == 2) {
                const int dbase = 64 * kt - qrow + 128;
#pragma unroll
                for (int r = 0; r < 16; ++r) { const int j0 = crow(r, hi);
                    s0[r] = (unsigned)(dbase + j0) <= 256u ? s0[r] : NEG; s1[r] = (unsigned)(dbase + j0 + 32) <= 256u ? s1[r] : NEG; }
            }
            if (!(VM & 4)) {
            float mxa = max3f(s0[0], s0[1], s1[0]), mxb = max3f(s0[2], s0[3], s1[1]); mxa = max3f(mxa, s1[2], s1[3]);
#pragma unroll
            for (int r = 4; r < 16; r += 4) { mxa = max3f(mxa, s0[r], s0[r + 1]); mxb = max3f(mxb, s0[r + 2], s0[r + 3]); mxa = max3f(mxa, s1[r], s1[r + 1]); mxb = max3f(mxb, s1[r + 2], s1[r + 3]); }
            const float mx = xhalf_max(fmaxf(mxa, mxb));
            if (first || __any(mx > THR)) {
                const float d = first ? fmaxf(mx, -64.0f) : fmaxf(mx, 0.f), alpha = __builtin_amdgcn_exp2f(-d);
                m += d; first = false;
#pragma unroll
                for (int r = 0; r < 16; ++r) { s0[r] -= d; s1[r] -= d; o0[r] *= alpha; o1[r] *= alpha; negm[r] = -m; }
                lacc *= alpha;
            }
#pragma unroll
            for (int r = 0; r < 16; ++r) { s0[r] = __builtin_amdgcn_exp2f(s0[r]); s1[r] = __builtin_amdgcn_exp2f(s1[r]); lacc += (f32x2){s0[r], s1[r]}; }
            }
            bf16x8 pb[4];
#pragma unroll
            for (int s = 0; s < 2; ++s) {
                v4u w; w.x = cvtpk(s0[8 * s], s0[8 * s + 1]); w.y = cvtpk(s0[8 * s + 2], s0[8 * s + 3]); w.z = cvtpk(s0[8 * s + 4], s0[8 * s + 5]); w.w = cvtpk(s0[8 * s + 6], s0[8 * s + 7]);
                pb[s] = __builtin_bit_cast(bf16x8, w);
                v4u x; x.x = cvtpk(s1[8 * s], s1[8 * s + 1]); x.y = cvtpk(s1[8 * s + 2], s1[8 * s + 3]); x.z = cvtpk(s1[8 * s + 4], s1[8 * s + 5]); x.w = cvtpk(s1[8 * s + 6], s1[8 * s + 7]);
                pb[2 + s] = __builtin_bit_cast(bf16x8, x);
            }
            if (VM & 1) { asm volatile("" :: "v"(pb[0]), "v"(pb[1]), "v"(pb[2]), "v"(pb[3])); } else {
            const LAS unsigned char* vbase = Vb + (4 * hi + ((lane & 15) >> 2)) * VRS + ((lane >> 4) & 1) * 32 + (lane & 3) * 8;
#pragma unroll
            for (int s = 0; s < 4; ++s) {
                const v4i16 a0 = __builtin_amdgcn_ds_read_tr16_b64_v4i16((LAS v4i16*)(vbase + (16 * s) * VRS));
                const v4i16 a1 = __builtin_amdgcn_ds_read_tr16_b64_v4i16((LAS v4i16*)(vbase + (16 * s + 8) * VRS));
                const v4i16 c0_ = __builtin_amdgcn_ds_read_tr16_b64_v4i16((LAS v4i16*)(vbase + (16 * s) * VRS + 64));
                const v4i16 c1_ = __builtin_amdgcn_ds_read_tr16_b64_v4i16((LAS v4i16*)(vbase + (16 * s + 8) * VRS + 64));
                const bf16x8 va = {a0[0], a0[1], a0[2], a0[3], a1[0], a1[1], a1[2], a1[3]};
                const bf16x8 vc = {c0_[0], c0_[1], c0_[2], c0_[3], c1_[0], c1_[1], c1_[2], c1_[3]};
                o0 = __builtin_amdgcn_mfma_f32_32x32x16_bf16(va, pb[s], o0, 0, 0, 0);
                o1 = __builtin_amdgcn_mfma_f32_32x32x16_bf16(vc, pb[s], o1, 0, 0, 0);
            }
            }
        }
        if (!(VM & 8) && j + 1 < nt) ATT_STORE((j + 1) & 1);
        if (!(VM & 16)) __syncthreads();
    }
    float l = xhalf_sum(lacc.x + lacc.y);
    const float sterm = has_sink ? __builtin_amdgcn_exp2f(sinkl2 - m) : 0.f;
#if MK_DEBUG
    if (dbg && hi == 0) { dbg[(size_t)qrow * 2] = __builtin_bit_cast(unsigned, m); dbg[(size_t)qrow * 2 + 1] = __builtin_bit_cast(unsigned, l); }
#endif
    if (has_sink) l += sterm;
    const float inv = 1.0f / l;
    bf16* orow = Op + (size_t)qrow * D;
#pragma unroll
    for (int g = 0; g < 4; ++g) {
        v2u w0; w0.x = pk2(o0[4 * g] * inv, o0[4 * g + 1] * inv); w0.y = pk2(o0[4 * g + 2] * inv, o0[4 * g + 3] * inv);
        v2u w1; w1.x = pk2(o1[4 * g] * inv, o1[4 * g + 1] * inv); w1.y = pk2(o1[4 * g + 2] * inv, o1[4 * g + 3] * inv);
        *(v2u*)(orow + 8 * g + 4 * hi) = w0; *(v2u*)(orow + 32 + 8 * g + 4 * hi) = w1;
    }
#undef ATT_TROW
#undef ATT_LOAD
#undef ATT_STORE
}

template <int DK, int MODE, int VM = 0, bool NOREF = false>
__device__ __forceinline__ void unit2(LAS unsigned char* lds, const bf16* Qp, int qpitch, const bf16* Kp, int kpitch, const bf16* Vp, int vpitch, bf16* Op,
                                      int var, int qt, int lo, int n1, int nt, float qscale, float sink0, float sink1, bool has_sink, const LAS float* bias, const float* t32) {
    constexpr int KRS = DK * 2 + 16, NS = DK / 16, CPK = DK / 8;
    int tid = threadIdx.x; asm volatile("" : "+v"(tid)); const int lane = tid & 63, r32 = lane & 31, hi = lane >> 5, wid = __builtin_amdgcn_readfirstlane(tid >> 6);
    const int rowbase = MODE == 0 ? 512 * qt + 64 * wid : 256 * qt + 32 * wid;
    bf16x8 qr[2][NS];
#pragma unroll
    for (int u = 0; u < 2; ++u) {
        const int qrow = rowbase + (MODE == 0 ? 32 * u : 0) + r32;
        const bf16* qp = Qp + (MODE == 1 ? 64 * u : 0) + (size_t)qrow * qpitch;
#pragma unroll
        for (int s = 0; s < NS; ++s) { const v4u raw = *(const v4u*)(qp + 16 * s + 8 * hi); float f[8]; unpack8(raw, f);
#pragma unroll
            for (int i = 0; i < 8; ++i) f[i] *= qscale;
            if (DK == 96 && s >= 4) { float p[8];
#pragma unroll
                for (int i = 0; i < 8; ++i) p[i] = __shfl_xor(f[i], 32);
                rope8(f, p, t32 + ((size_t)((s == 4 ? (qrow >> 6) : (qrow & 63)) * 8)) * 2, hi == 0); }
            qr[u][s] = __builtin_bit_cast(bf16x8, pack8(f)); }
    }
    const int kkey0 = tid / CPK, kch0 = tid - kkey0 * CPK, kkey1 = (tid + 512) / CPK, kch1 = (tid + 512) - kkey1 * CPK;
    const int vkey = tid >> 3, vch = tid & 7;
    v4u kreg0, kreg1 = {0u, 0u, 0u, 0u}, vreg;
#define ATT_TROW(j) ((((j) < n1) ? (lo + (j)) : (64 + (j) - n1)) * 64)
#define ATT_LOAD(j) do { const int tr_ = ATT_TROW(j); kreg0 = *(const v4u*)(Kp + (size_t)(tr_ + kkey0) * kpitch + kch0 * 8); \
        if (DK == 96 && tid < 256) kreg1 = *(const v4u*)(Kp + (size_t)(tr_ + kkey1) * kpitch + kch1 * 8); \
        vreg = *(const v4u*)(Vp + (size_t)(tr_ + vkey) * vpitch + vch * 8); } while (0)
#define ATT_STORE(bf) do { LAS unsigned char* b_ = lds + (bf) * BUF; *(LAS v4u*)(b_ + kkey0 * KRS + kch0 * 16) = kreg0; \
        if (DK == 96 && tid < 256) *(LAS v4u*)(b_ + kkey1 * KRS + kch1 * 16) = kreg1; \
        *(LAS v4u*)(b_ + KBUF + vkey * VRS + vch * 16) = vreg; } while (0)
    constexpr float THR = 6.0f;
    float m = 0.f; f32x2 lacc[2] = {{0.f, 0.f}, {0.f, 0.f}}; f32x16 o0[2] = {{}, {}}, o1[2] = {{}, {}}; bool first = true;
    const int grw = 8 * qt + wid, r0w = min(max(grw - 4, 0), 56), i0w = rowbase;
    ATT_LOAD(0); ATT_STORE(0);
    __syncthreads();
    for (int j = 0; j < nt; ++j) {
        if (!(VM & 8) && j + 1 < nt) ATT_LOAD(j + 1);
        const int kt = ATT_TROW(j) >> 6;
        bool actv = true;
        if (kt < 64) { if (var == 0) actv = (kt >= r0w) && (kt <= r0w + 7); else if (var == 2) actv = !((64 * kt - (i0w + 31) > 128) || (i0w - (64 * kt + 63) > 128)); }
        if (actv) {
            const LAS unsigned char* Kb = lds + (j & 1) * BUF; const LAS unsigned char* Vb = Kb + KBUF;
            f32x16 s0[2] = {{}, {}}, s1[2] = {{}, {}};
#pragma unroll
            for (int s = 0; s < NS; ++s) {
                const bf16x8 ka = *(const LAS bf16x8*)(Kb + r32 * KRS + (16 * s + 8 * hi) * 2);
                const bf16x8 kb = *(const LAS bf16x8*)(Kb + (32 + r32) * KRS + (16 * s + 8 * hi) * 2);
                if (VM & 2) { asm volatile("" :: "v"(ka), "v"(kb), "v"(qr[0][s]), "v"(qr[1][s])); } else {
#pragma unroll
                for (int u = 0; u < 2; ++u) { s0[u] = __builtin_amdgcn_mfma_f32_32x32x16_bf16(ka, qr[u][s], s0[u], 0, 0, 0); s1[u] = __builtin_amdgcn_mfma_f32_32x32x16_bf16(kb, qr[u][s], s1[u], 0, 0, 0); }
                }
            }
            asm volatile("s_nop 15\n\ts_nop 7" : "+v"(s0[0]), "+v"(s1[0]), "+v"(s0[1]), "+v"(s1[1]));
            if (kt < 64 && var == 0) {
#pragma unroll
                for (int u = 0; u < 2; ++u) { const int gc = 32 * u + r32, c0 = min(max(gc - 8, 0), 48), rowoff = (kt - grw + 7) * 31 - gc + 15;
#pragma unroll
                    for (int r = 0; r < 16; ++r) { const int j0 = crow(r, hi), j1 = j0 + 32;
                        const bool v0 = (unsigned)(j0 - c0) < 16u, v1 = (unsigned)(j1 - c0) < 16u;
                        const float b0 = bias[v0 ? rowoff + j0 : 0], b1 = bias[v1 ? rowoff + j1 : 0];
                        s0[u][r] = v0 ? s0[u][r] + b0 : NEG; s1[u][r] = v1 ? s1[u][r] + b1 : NEG; } }
            } else if (kt < 64 && var == 2) {
                const int dbase = 64 * kt - (rowbase + r32) + 128;
#pragma unroll
                for (int r = 0; r < 16; ++r) { const int j0 = crow(r, hi); const bool v0 = (unsigned)(dbase + j0) <= 256u, v1 = (unsigned)(dbase + j0 + 32) <= 256u;
                    s0[0][r] = v0 ? s0[0][r] : NEG; s1[0][r] = v1 ? s1[0][r] : NEG; s0[1][r] = v0 ? s0[1][r] : NEG; s1[1][r] = v1 ? s1[1][r] : NEG; }
            }
            if (!(VM & 4)) {
            if (!NOREF) {
            float mxa = max3f(s0[0][0], s0[0][1], s1[0][0]), mxb = max3f(s0[1][0], s0[1][1], s1[1][0]);
#pragma unroll
            for (int r = 0; r < 16; r += 2) { if (r) { mxa = max3f(mxa, s0[0][r], s0[0][r + 1]); mxb = max3f(mxb, s0[1][r], s0[1][r + 1]); }
                if (r) { mxa = max3f(mxa, s1[0][r], s1[0][r + 1]); mxb = max3f(mxb, s1[1][r], s1[1][r + 1]); } else { mxa = fmaxf(mxa, s1[0][1]); mxb = fmaxf(mxb, s1[1][1]); } }
            const float mx = xhalf_max(fmaxf(mxa, mxb)) - m;
            if (first || __any(mx > THR)) {
                const float d = first ? fmaxf(mx, -64.0f) : fmaxf(mx, 0.f), alpha = __builtin_amdgcn_exp2f(-d);
                m += d; first = false;
#pragma unroll
                for (int u = 0; u < 2; ++u) {
#pragma unroll
                    for (int r = 0; r < 16; ++r) { o0[u][r] *= alpha; o1[u][r] *= alpha; }
                    lacc[u] *= alpha; }
            }
            }
            }
            bf16x8 pb[2][4];
#pragma unroll
            for (int u = 0; u < 2; ++u) {
                if (!(VM & 4))
#pragma unroll
                for (int r = 0; r < 16; ++r) { s0[u][r] = __builtin_amdgcn_exp2f(NOREF ? s0[u][r] : s0[u][r] - m); s1[u][r] = __builtin_amdgcn_exp2f(NOREF ? s1[u][r] : s1[u][r] - m); lacc[u] += (f32x2){s0[u][r], s1[u][r]}; }
#pragma unroll
                for (int s = 0; s < 2; ++s) {
                    v4u w; w.x = cvtpk(s0[u][8 * s], s0[u][8 * s + 1]); w.y = cvtpk(s0[u][8 * s + 2], s0[u][8 * s + 3]); w.z = cvtpk(s0[u][8 * s + 4], s0[u][8 * s + 5]); w.w = cvtpk(s0[u][8 * s + 6], s0[u][8 * s + 7]);
                    pb[u][s] = __builtin_bit_cast(bf16x8, w);
                    v4u x; x.x = cvtpk(s1[u][8 * s], s1[u][8 * s + 1]); x.y = cvtpk(s1[u][8 * s + 2], s1[u][8 * s + 3]); x.z = cvtpk(s1[u][8 * s + 4], s1[u][8 * s + 5]); x.w = cvtpk(s1[u][8 * s + 6], s1[u][8 * s + 7]);
                    pb[u][2 + s] = __builtin_bit_cast(bf16x8, x);
                }
            }
            if (VM & 1) { asm volatile("" :: "v"(pb[0][0]), "v"(pb[0][1]), "v"(pb[0][2]), "v"(pb[0][3]), "v"(pb[1][0]), "v"(pb[1][1]), "v"(pb[1][2]), "v"(pb[1][3])); } else {
            const LAS unsigned char* vbase = Vb + (4 * hi + ((lane & 15) >> 2)) * VRS + ((lane >> 4) & 1) * 32 + (lane & 3) * 8;
#pragma unroll
            for (int s = 0; s < 4; ++s) {
                const v4i16 a0 = __builtin_amdgcn_ds_read_tr16_b64_v4i16((LAS v4i16*)(vbase + (16 * s) * VRS));
                const v4i16 a1 = __builtin_amdgcn_ds_read_tr16_b64_v4i16((LAS v4i16*)(vbase + (16 * s + 8) * VRS));
                const v4i16 c0_ = __builtin_amdgcn_ds_read_tr16_b64_v4i16((LAS v4i16*)(vbase + (16 * s) * VRS + 64));
                const v4i16 c1_ = __builtin_amdgcn_ds_read_tr16_b64_v4i16((LAS v4i16*)(vbase + (16 * s + 8) * VRS + 64));
                const bf16x8 va = {a0[0], a0[1], a0[2], a0[3], a1[0], a1[1], a1[2], a1[3]};
                const bf16x8 vc = {c0_[0], c0_[1], c0_[2], c0_[3], c1_[0], c1_[1], c1_[2], c1_[3]};
#pragma unroll
                for (int u = 0; u < 2; ++u) { o0[u] = __builtin_amdgcn_mfma_f32_32x32x16_bf16(va, pb[u][s], o0[u], 0, 0, 0); o1[u] = __builtin_amdgcn_mfma_f32_32x32x16_bf16(vc, pb[u][s], o1[u], 0, 0, 0); }
            }
            }
        }
        if (!(VM & 8) && j + 1 < nt) ATT_STORE((j + 1) & 1);
        if (!(VM & 16)) __syncthreads();
    }
#pragma unroll
    for (int u = 0; u < 2; ++u) {
        float l = xhalf_sum(lacc[u].x + lacc[u].y);
        if (has_sink) l += __builtin_amdgcn_exp2f((u == 0 ? sink0 : sink1) - m);
        const float inv = 1.0f / l;
        const int qrow = rowbase + (MODE == 0 ? 32 * u : 0) + r32;
        bf16* orow = Op + (MODE == 1 ? 64 * u : 0) + (size_t)qrow * D;
#pragma unroll
        for (int g = 0; g < 4; ++g) {
            v2u w0; w0.x = pk2(o0[u][4 * g] * inv, o0[u][4 * g + 1] * inv); w0.y = pk2(o0[u][4 * g + 2] * inv, o0[u][4 * g + 3] * inv);
            v2u w1; w1.x = pk2(o1[u][4 * g] * inv, o1[u][4 * g + 1] * inv); w1.y = pk2(o1[u][4 * g + 2] * inv, o1[u][4 * g + 3] * inv);
            *(v2u*)(orow + 8 * g + 4 * hi) = w0; *(v2u*)(orow + 32 + 8 * g + 4 * hi) = w1;
        }
    }
#undef ATT_TROW
#undef ATT_LOAD
#undef ATT_STORE
}

#define ATT_BAR() do { asm volatile("s_waitcnt lgkmcnt(0)" ::: "memory"); __builtin_amdgcn_s_barrier(); asm volatile("" ::: "memory"); } while (0)
template <int N> struct IC { static constexpr int v = N; };
template <int DK, int MODE, int VM = 0>
__device__ __forceinline__ bool unit_h(LAS unsigned char* lds, const bf16* Qp, int qpitch, const bf16* Kp, int kpitch, const bf16* Vp, int vpitch, bf16* Op,
                                       int var, int qt, int lo, int n1, int nt, float qscale, float sink0, float sink1, bool has_sink, const LAS float* bias, const float* t32, volatile LAS unsigned* flag) {
    constexpr int KRS = DK * 2 + 16, NS = DK / 16, CPK = DK / 8;
    int tid = threadIdx.x; asm volatile("" : "+v"(tid)); const int lane = tid & 63, r32 = lane & 31, hi = lane >> 5, wid = __builtin_amdgcn_readfirstlane(tid >> 6);
    const int rowbase = MODE == 0 ? 512 * qt + 64 * wid : 256 * qt + 32 * wid;
    const int kkey0 = tid / CPK, kch0 = tid - kkey0 * CPK, kkey1 = (tid + 512) / CPK, kch1 = (tid + 512) - kkey1 * CPK;
    const int vkey = tid >> 3, vch = tid & 7;
    constexpr int PD = DK == 96 ? 1 : 2;
    v4u kreg0[2], kreg1[2] = {{0u, 0u, 0u, 0u}, {0u, 0u, 0u, 0u}}, vreg[2];
#define ATT_TROW(j) ((((j) < n1) ? (lo + (j)) : (64 + (j) - n1)) * 64)
#define ATT_LOAD(j, S) do { const int tr_ = ATT_TROW(j); kreg0[S] = *(const v4u*)(Kp + (size_t)(tr_ + kkey0) * kpitch + kch0 * 8); \
        if (DK == 96 && tid < 256) kreg1[S] = *(const v4u*)(Kp + (size_t)(tr_ + kkey1) * kpitch + kch1 * 8); \
        vreg[S] = *(const v4u*)(Vp + (size_t)(tr_ + vkey) * vpitch + vch * 8); } while (0)
#define ATT_STORE(bf, S) do { LAS unsigned char* b_ = lds + (bf) * BUF; *(LAS v4u*)(b_ + kkey0 * KRS + kch0 * 16) = kreg0[S]; \
        if (DK == 96 && tid < 256) *(LAS v4u*)(b_ + kkey1 * KRS + kch1 * 16) = kreg1[S]; \
        *(LAS v4u*)(b_ + KBUF + vkey * VRS + vch * 16) = vreg[S]; } while (0)
    ATT_LOAD(0, PD - 1);
    bf16x8 qr[2][NS];
#pragma unroll
    for (int u = 0; u < 2; ++u) {
        const int qrow = rowbase + (MODE == 0 ? 32 * u : 0) + r32;
        const bf16* qp = Qp + (MODE == 1 ? 64 * u : 0) + (size_t)qrow * qpitch;
#pragma unroll
        for (int s = 0; s < NS; ++s) { const v4u raw = *(const v4u*)(qp + 16 * s + 8 * hi); float f[8]; unpack8(raw, f);
#pragma unroll
            for (int i = 0; i < 8; ++i) f[i] *= qscale;
            if (DK == 96 && s >= 4) { float p[8];
#pragma unroll
                for (int i = 0; i < 8; ++i) p[i] = __shfl_xor(f[i], 32);
                rope8(f, p, t32 + ((size_t)((s == 4 ? (qrow >> 6) : (qrow & 63)) * 8)) * 2, hi == 0); }
            qr[u][s] = __builtin_bit_cast(bf16x8, pack8(f)); }
    }
    f32x2 lacc[2] = {{0.f, 0.f}, {0.f, 0.f}}; f32x16 o0[2] = {{}, {}}, o1[2] = {{}, {}};
    const int grw = 8 * qt + wid, r0w = min(max(grw - 4, 0), 56), i0w = rowbase;
    ATT_STORE(0, PD - 1);
    if (PD == 2 && nt > 1) ATT_LOAD(1, 1);
    if (tid == 0) *flag = 0u;
    ATT_BAR();
    auto tile = [&](const int j, auto LS) __attribute__((always_inline)) {
        constexpr int SL = decltype(LS)::v, SS = PD == 1 ? SL : (SL ^ 1);
        if (j + PD < nt) ATT_LOAD(j + PD, SL);
        const int kt = ATT_TROW(j) >> 6;
        bool actv = true;
        if (kt < 64) { if (var == 0) actv = (kt >= r0w) && (kt <= r0w + 7); else if (var == 2) actv = !((64 * kt - (i0w + 31) > 128) || (i0w - (64 * kt + 63) > 128)); }
        if (actv) {
        const LAS unsigned char* Kb = lds + (j & 1) * BUF; const LAS unsigned char* Vb = Kb + KBUF;
        const LAS unsigned char* vbase = Vb + (4 * hi + ((lane & 15) >> 2)) * VRS + ((lane >> 4) & 1) * 32 + (lane & 3) * 8;
#pragma unroll
        for (int hf = 0; hf < 2; ++hf) {
            f32x16 sc[2] = {{}, {}};
#pragma unroll
            for (int s = 0; s < NS; ++s) {
                const bf16x8 kf = *(const LAS bf16x8*)(Kb + (32 * hf + r32) * KRS + (16 * s + 8 * hi) * 2);
#pragma unroll
                for (int u = 0; u < 2; ++u) sc[u] = __builtin_amdgcn_mfma_f32_32x32x16_bf16(kf, qr[u][s], sc[u], 0, 0, 0);
            }
            if (kt < 64 && var == 0) {
#pragma unroll
                for (int u = 0; u < 2; ++u) { const int gc = 32 * u + r32, c0 = min(max(gc - 8, 0), 48), rowoff = (kt - grw + 7) * 31 - gc + 15;
                    const LAS unsigned char* bb = (const LAS unsigned char*)(bias + rowoff + 4 * hi); asm volatile("" : "+v"(bb));
                    float bv[16];
#pragma unroll
                    for (int r = 0; r < 16; ++r) bv[r] = *(const LAS float*)(bb + 4 * (32 * hf + (r & 3) + 8 * (r >> 2)));
                    asm volatile("" : "+v"(bv[0]), "+v"(bv[1]), "+v"(bv[2]), "+v"(bv[3]), "+v"(bv[4]), "+v"(bv[5]), "+v"(bv[6]), "+v"(bv[7]),
                                      "+v"(bv[8]), "+v"(bv[9]), "+v"(bv[10]), "+v"(bv[11]), "+v"(bv[12]), "+v"(bv[13]), "+v"(bv[14]), "+v"(bv[15]));
#pragma unroll
                    for (int r = 0; r < 16; ++r) { const int jj = 32 * hf + crow(r, hi); const bool v = (unsigned)(jj - c0) < 16u; sc[u][r] = v ? sc[u][r] + bv[r] : NEG; } }
            } else if (kt < 64 && var == 2) {
                const int dbase = 64 * kt - (rowbase + r32) + 128;
#pragma unroll
                for (int r = 0; r < 16; ++r) { const bool v = (unsigned)(dbase + 32 * hf + crow(r, hi)) <= 256u; sc[0][r] = v ? sc[0][r] : NEG; sc[1][r] = v ? sc[1][r] : NEG; }
            }
            bf16x8 pb[2][2];
#pragma unroll
            for (int u = 0; u < 2; ++u) {
#pragma unroll
                for (int r = 0; r < 16; r += 2) { sc[u][r] = __builtin_amdgcn_exp2f(sc[u][r]); sc[u][r + 1] = __builtin_amdgcn_exp2f(sc[u][r + 1]); lacc[u] += (f32x2){sc[u][r], sc[u][r + 1]}; }
#pragma unroll
                for (int s = 0; s < 2; ++s) {
                    v4u w; w.x = cvtpk(sc[u][8 * s], sc[u][8 * s + 1]); w.y = cvtpk(sc[u][8 * s + 2], sc[u][8 * s + 3]); w.z = cvtpk(sc[u][8 * s + 4], sc[u][8 * s + 5]); w.w = cvtpk(sc[u][8 * s + 6], sc[u][8 * s + 7]);
                    pb[u][s] = __builtin_bit_cast(bf16x8, w);
                }
            }
#pragma unroll
            for (int s2 = 0; s2 < 2; ++s2) { const int s = 2 * hf + s2;
                const v4i16 a0 = __builtin_amdgcn_ds_read_tr16_b64_v4i16((LAS v4i16*)(vbase + (16 * s) * VRS));
                const v4i16 a1 = __builtin_amdgcn_ds_read_tr16_b64_v4i16((LAS v4i16*)(vbase + (16 * s + 8) * VRS));
                const v4i16 c0_ = __builtin_amdgcn_ds_read_tr16_b64_v4i16((LAS v4i16*)(vbase + (16 * s) * VRS + 64));
                const v4i16 c1_ = __builtin_amdgcn_ds_read_tr16_b64_v4i16((LAS v4i16*)(vbase + (16 * s + 8) * VRS + 64));
                const bf16x8 va = {a0[0], a0[1], a0[2], a0[3], a1[0], a1[1], a1[2], a1[3]};
                const bf16x8 vc = {c0_[0], c0_[1], c0_[2], c0_[3], c1_[0], c1_[1], c1_[2], c1_[3]};
#pragma unroll
                for (int u = 0; u < 2; ++u) { o0[u] = __builtin_amdgcn_mfma_f32_32x32x16_bf16(va, pb[u][s2], o0[u], 0, 0, 0); o1[u] = __builtin_amdgcn_mfma_f32_32x32x16_bf16(vc, pb[u][s2], o1[u], 0, 0, 0); }
            }
            __builtin_amdgcn_sched_barrier(0);
        }
        }
        if (j + 1 < nt) ATT_STORE((j + 1) & 1, SS);
        ATT_BAR();
    };
    if (PD == 1) { for (int j = 0; j < nt; ++j) tile(j, IC<0>{}); }
    else { for (int j = 0; j < nt; j += 2) { tile(j, IC<0>{}); if (j + 1 < nt) tile(j + 1, IC<1>{}); } }
    float lsum[2]; bool bad = false;
#pragma unroll
    for (int u = 0; u < 2; ++u) { lsum[u] = xhalf_sum(lacc[u].x + lacc[u].y); bad = bad || !(lsum[u] > 8.6736174e-19f && lsum[u] < 1.1529215e18f);
        if (has_sink) { lsum[u] += __builtin_amdgcn_exp2f(u == 0 ? sink0 : sink1); bad = bad || !(lsum[u] < 1.1529215e18f); } }
    if (__any(bad)) { if (lane == 0) *flag = 1u; }
#pragma unroll
    for (int u = 0; u < 2; ++u) {
        const float inv = __builtin_amdgcn_rcpf(lsum[u]);
        bf16* orow = Op + (MODE == 1 ? 64 * u : 0) + (size_t)(rowbase + (MODE == 0 ? 32 * u : 0) + r32) * D;
#pragma unroll
        for (int g = 0; g < 4; g += 2) {
#pragma unroll
            for (int half = 0; half < 2; ++half) {
                const f32x16& oo = half == 0 ? o0[u] : o1[u];
                unsigned ax = pk2(oo[4 * g] * inv, oo[4 * g + 1] * inv), ay = pk2(oo[4 * g + 2] * inv, oo[4 * g + 3] * inv);
                unsigned bx = pk2(oo[4 * g + 4] * inv, oo[4 * g + 5] * inv), by = pk2(oo[4 * g + 6] * inv, oo[4 * g + 7] * inv);
                { auto r = __builtin_amdgcn_permlane32_swap(ax, bx, false, false); const unsigned r0 = r[0], r1 = r[1]; ax = r0; bx = r1; }
                { auto r = __builtin_amdgcn_permlane32_swap(ay, by, false, false); const unsigned r0 = r[0], r1 = r[1]; ay = r0; by = r1; }
                v4u w; w.x = ax; w.y = ay; w.z = bx; w.w = by;
                *(v4u*)(orow + 32 * half + 8 * g + 8 * hi) = w;
            }
        }
    }
    ATT_BAR();
    return *flag == 0u;
#undef ATT_TROW
#undef ATT_LOAD
#undef ATT_STORE
}
}

template <int VM = 0>
__device__ __forceinline__ void phase_attn(const Frame& F, int lq) {
    const int l = lq & 3;
    const bf16* P = (const bf16*)(F.ws + WS_PB); const bf16* QD = (const bf16*)(F.ws + WS_QD); const bf16* KD = (const bf16*)(F.ws + WS_KD);
    const bf16* VD = (const bf16*)(F.ws + WS_VD); bf16* O = (bf16*)(F.ws + (lq >= 4 ? WS_ACT : WS_HA));
    unsigned* ctr = (unsigned*)(F.ws + WS_CTL) + CW_QUEUE + 64 * 8 * lq;
    LAS float* bias = (LAS float*)(F.lds + att::BIAS_OFF);
    { const float* nab = INP(I_NABIAS) + l * 4 * 465; for (int i = F.tid; i < 4 * 465; i += NTHR) bias[i] = nab[i] * LOG2E; }
    const float* sinks = INP(I_SINK) + l * 4;
    __syncthreads();
    const float* t32 = (const float*)(F.ws + WS_T32);
    volatile LAS unsigned* flag = F.MISC + MI_Q + 1;
    const int nloc = 256 + (l < NL - 1 ? 24 : 0);
    const int q0 = (int)xb_xcc_id();
    for (int qq = 0; qq < 8; ++qq) {
      const int q = (q0 + qq) & 7;
      unsigned* qctr = ctr + 64 * q;
      unsigned nxt = 0xffffffffu;
      for (;;) {
        if (F.tid == 0) { if (nxt == 0xffffffffu) nxt = __hip_atomic_fetch_add(qctr, 1u, __ATOMIC_RELAXED, __HIP_MEMORY_SCOPE_AGENT); F.MISC[MI_Q] = nxt; nxt = 0xffffffffu; }
        ATT_BAR();
        const int li = (int)F.MISC[MI_Q];
        ATT_BAR();
        if (li >= nloc) break;
        if (F.tid == 0 && li < 240) nxt = __hip_atomic_fetch_add(qctr, 1u, __ATOMIC_RELAXED, __HIP_MEMORY_SCOPE_AGENT);
        int idx;
        if (li < 64) idx = (q + 8 * (li >> 3)) * 8 + (li & 7);
        else if (li < 128) { const int jx = li - 64; idx = 1024 + (q + 8 * (jx >> 4)) * 16 + (jx & 15); }
        else if (li < 192) { const int jx = li - 128; idx = 1536 + (q + 8 * (jx >> 3)) * 8 + (jx & 7); }
        else if (li < 256) { const int jx = li - 192; idx = 2048 + (q + 8 * (jx >> 4)) * 16 + (jx & 15); }
        else if (li < 264) idx = 2560 + q + 8 * (li - 256);
        else idx = 2624 + q + 8 * (li - 264);
        if (idx < 512) {
            const int b = idx >> 5, h = (idx >> 3) & 3, qt = idx & 7; const size_t rb = (size_t)b * TT;
            if (!att::unit_h<96, 0, VM>(F.lds, QD + rb * 384 + h * 96, 384, KD + rb * 384 + h * 96, 384, VD + rb * 256 + h * 64, 256, O + rb * D + 768 + h * 64, 3, qt, 0, 64, 68, 0.10206207261596575f * LOG2E, 0.f, 0.f, false, bias, t32, flag)) {
                __syncthreads();
#pragma unroll 1
                for (int k2 = 0; k2 < 2; ++k2)
                    att::unit<96, VM>(F.lds, QD + rb * 384 + h * 96, 384, KD + rb * 384 + h * 96, 384, VD + rb * 256 + h * 64, 256, O + rb * D + 768 + h * 64, 3, 2 * qt + k2, 0, 64, 68, 0.10206207261596575f * LOG2E, 0.f, false, bias, t32, nullptr);
            }
        } else if (idx < 1024) {
        } else if (idx < 2560) {
            idx -= 1024;
            const int grp = idx >> 9, rem = idx & 511, b = rem >> 5; const size_t rb = (size_t)b * TT;
            if (grp == 1) {
                const int h = (rem >> 3) & 3, qt = rem & 7; const int lo = min(max(8 * qt - 4, 0), 56), n1 = min(max(8 * qt + 3, 0), 56) + 7 - lo + 1;
                if (!att::unit_h<64, 0, VM>(F.lds, P + rb * NPJ + h * 64, NPJ, P + rb * NPJ + 256 + h * 64, NPJ, P + rb * NPJ + 512 + h * 64, NPJ, O + rb * D + h * 64, 0, qt, lo, n1, n1 + 4, 0.125f * LOG2E, 0.f, 0.f, false, bias + h * 465, t32, flag)) { __syncthreads();
                att::unit2<64, 0, VM>(F.lds, P + rb * NPJ + h * 64, NPJ, P + rb * NPJ + 256 + h * 64, NPJ, P + rb * NPJ + 512 + h * 64, NPJ, O + rb * D + h * 64, 0, qt, lo, n1, n1 + 4,
                                  0.125f * LOG2E, 0.f, 0.f, false, bias + h * 465, t32); }
            } else {
                const int g = (rem >> 4) & 1, qt = rem & 15; const bool isc = grp == 2;
                const int lo = isc ? max(4 * qt - 2, 0) : 0, n1 = isc ? min(4 * qt + 5, 63) - lo + 1 : 64;
                const int qc = (isc ? 1280 : 768) + g * 128, kc = (isc ? 1536 : 1024) + g * 64, vc = (isc ? 1664 : 1152) + g * 64;
                const float sk0 = isc ? sinks[2 * g] * LOG2E : 0.f, sk1 = isc ? sinks[2 * g + 1] * LOG2E : 0.f;
                if (!att::unit_h<64, 1, VM>(F.lds, P + rb * NPJ + qc, NPJ, P + rb * NPJ + kc, NPJ, P + rb * NPJ + vc, NPJ, O + rb * D + (isc ? 512 : 256) + g * 128, isc ? 2 : 1, qt, lo, n1, n1 + 4, 0.125f * LOG2E, sk0, sk1, isc, bias, t32, flag)) { __syncthreads();
                att::unit2<64, 1, VM>(F.lds, P + rb * NPJ + qc, NPJ, P + rb * NPJ + kc, NPJ, P + rb * NPJ + vc, NPJ, O + rb * D + (isc ? 512 : 256) + g * 128, isc ? 2 : 1, qt, lo, n1, n1 + 4,
                                  0.125f * LOG2E, isc ? sinks[2 * g] * LOG2E : 0.f, isc ? sinks[2 * g + 1] * LOG2E : 0.f, isc, bias, t32); }
            }
        } else if (idx < 2624) {
            const int rem = idx - 2560, b = rem >> 2, isc = (rem >> 1) & 1, g = rem & 1; const size_t rb = (size_t)b * TT;
            const int qc = (isc ? 1280 : 768) + g * 128, kc = (isc ? 1536 : 1024) + g * 64, vc = (isc ? 1664 : 1152) + g * 64;
            att::unit2<64, 1, VM>(F.lds, P + rb * NPJ + qc, NPJ, P + rb * NPJ + kc, NPJ, P + rb * NPJ + vc, NPJ, O + rb * D + (isc ? 512 : 256) + g * 128, isc ? 2 : 1, 16, 0, 0, 4,
                              0.125f * LOG2E, isc ? sinks[2 * g] * LOG2E : 0.f, isc ? sinks[2 * g + 1] * LOG2E : 0.f, isc != 0, bias, t32);
        } else {
            const int rem = idx - 2624, b = rem >> 3, isd = (rem >> 2) & 1, h = rem & 3; const size_t rb = (size_t)b * TT;
            if (isd) att::unit<96, VM>(F.lds, QD + rb * 384 + h * 96, 384, KD + rb * 384 + h * 96, 384, VD + rb * 256 + h * 64, 256, O + rb * D + 768 + h * 64, 3, 16, 0, 0, 4, 0.10206207261596575f * LOG2E, 0.f, false, bias, t32, nullptr);
            else att::unit<64, VM>(F.lds, P + rb * NPJ + h * 64, NPJ, P + rb * NPJ + 256 + h * 64, NPJ, P + rb * NPJ + 512 + h * 64, NPJ, O + rb * D + h * 64, 0, 16, 0, 0, 4, 0.125f * LOG2E, 0.f, false, bias + h * 465, nullptr, nullptr);
        }
    }
    }
}


#define PHASE_FN static __device__ __forceinline__ void
PHASE_FN ph_prologue(GAS unsigned char* ws) { const Frame F = make_frame(ws); phase_prologue(F); }
PHASE_FN ph_ln(GAS unsigned char* ws, int l) { const Frame F = make_frame(ws); phase_ln(F, l); }
PHASE_FN ph_gemm_in(GAS unsigned char* ws, int l) {
    const Frame F = make_frame(ws);
    pg8::Gemm g{(const bf16*)(F.ws + WS_HA), (const bf16*)(F.ws + WS_WIN), M, NPJ, D, D, nullptr}; pg8::StaticOrder S; S.init(M, NPJ, F.G, F.bid);
    pg8::EpiBf16NT<0> E{(bf16*)(F.ws + WS_PB), NPJ, nullptr, 0, 0, 1.f};
    pg8::gemm_phase<pg8::EpiBf16NT<0>, pg8::StaticOrder, true, true>(F.lds, g, S, E);
}
PHASE_FN ph_post(GAS unsigned char* ws, int l) { const Frame F = make_frame(ws); phase_post(F, l); }
PHASE_FN ph_gemm_mla(GAS unsigned char* ws, int l) {
    const Frame F = make_frame(ws);
    pg8::Gemm g{(const bf16*)(F.ws + WS_PB) + 1792, (const bf16*)(F.ws + WS_WD), M, 1024, 384, NPJ, nullptr}; MlaOrder S; S.S.init(M, 1024, F.G, F.bid);
    EpiMla E{(bf16*)(F.ws + WS_QD), (bf16*)(F.ws + WS_KD), (bf16*)(F.ws + WS_VD)};
    pg8::gemm_phase<EpiMla, MlaOrder, true, true>(F.lds, g, S, E);
}
template <int VM>
PHASE_FN ph_attn(GAS unsigned char* ws, int l) { const Frame F = make_frame(ws); phase_attn<VM>(F, l); }
PHASE_FN ph_gemm_out(GAS unsigned char* ws, int l) {
    const Frame F = make_frame(ws);
    pg8::Gemm g{(const bf16*)(F.ws + WS_HA), (const bf16*)(F.ws + WS_WOUT), M, D, D, D, nullptr};
    pg8::EpiBf16NT<0> E{(bf16*)(F.ws + WS_PB), D, nullptr, 0, 0, 1.f};
    if (l == NL - 1) { LatOrder S{F.G, F.bid}; pg8::gemm_phase<pg8::EpiBf16NT<0>, LatOrder, true, true>(F.lds, g, S, E); }
    else { pg8::StaticOrder S; S.init(M, D, F.G, F.bid); pg8::gemm_phase<pg8::EpiBf16NT<0>, pg8::StaticOrder, true, true>(F.lds, g, S, E); }
}
PHASE_FN ph_route(GAS unsigned char* ws, int l) { const Frame F = make_frame(ws); phase_route(F, l); }
PHASE_FN ph_permute(GAS unsigned char* ws, int l) { const Frame F = make_frame(ws); phase_permute(F, l); }
PHASE_FN ph_gemm_gu(GAS unsigned char* ws, int l) {
    const Frame F = make_frame(ws);
    pg8::Gemm g{(const bf16*)(F.ws + WS_HA), (const bf16*)(F.ws + WS_WGU), MS, 16384, D, D, (const int*)(F.ws + WS_QD)}; MoeOrder S{F.MISC + MI_PST, F.G, F.bid};
    EpiGU E{(bf16*)(F.ws + WS_ACT)};
    pg8::gemm_phase<EpiGU, MoeOrder, true, true, true>(F.lds, g, S, E);
}
PHASE_FN ph_gemm_dn(GAS unsigned char* ws, int l) {
    const Frame F = make_frame(ws);
    pg8::Gemm g{(const bf16*)(F.ws + WS_ACT), (const bf16*)(F.ws + WS_WDN), MS, 16384, 512, 512, nullptr}; MoeOrder S{F.MISC + MI_PST, F.G, F.bid};
    pg8::EpiBf16NT<0> E{(bf16*)(F.ws + WS_PB), D, nullptr, 1024, 0, 1.f};
    pg8::gemm_phase<pg8::EpiBf16NT<0>, MoeOrder, true, true>(F.lds, g, S, E);
}


#if MK_DEBUG
#ifndef DBG_MODE
#define DBG_MODE 0
#endif
__device__ __forceinline__ float oracle_attn(const Frame& F, int l, int r, int var, int h, int mode = 0) {
    const bf16* P = (const bf16*)(F.ws + WS_PB); const bf16* QD = (const bf16*)(F.ws + WS_QD); const bf16* KD = (const bf16*)(F.ws + WS_KD); const bf16* VD = (const bf16*)(F.ws + WS_VD);
    const bf16* O = (const bf16*)(F.ws + WS_HA); const float* t32 = (const float*)(F.ws + WS_T32);
    const int b = r / TT, t = r - b * TT; const bool lat = t < SEQ; const size_t rb = (size_t)b * TT;
    const int dk = var == 3 ? 96 : 64;
    const bf16* qp; const bf16* kp; const bf16* vp; int kpitch, vpitch;
    if (var == 3) { qp = QD + (size_t)r * 384 + h * 96; kp = KD + rb * 384 + h * 96; kpitch = 384; vp = VD + rb * 256 + h * 64; vpitch = 256; }
    else { const int qc = var == 0 ? h * 64 : var == 1 ? 768 + h * 64 : 1280 + h * 64, kc = var == 0 ? 256 + h * 64 : var == 1 ? 1024 + (h >> 1) * 64 : 1536 + (h >> 1) * 64,
           vc = var == 0 ? 512 + h * 64 : var == 1 ? 1152 + (h >> 1) * 64 : 1664 + (h >> 1) * 64;
           qp = P + (size_t)r * NPJ + qc; kp = P + rb * NPJ + kc; kpitch = NPJ; vp = P + rb * NPJ + vc; vpitch = NPJ; }
    LAS float* qs = (LAS float*)(F.lds + 65536) + F.wave * 128;
    for (int d = F.lane; d < dk; d += 64) qs[d] = __builtin_bit_cast(float, (unsigned)qp[d] << 16);
    asm volatile("s_waitcnt lgkmcnt(0)" ::: "memory");
    if (var == 3 && lat && F.lane < 32) {
        const int c = F.lane >> 3, e = F.lane & 7, gr = t >> 6, gc = t & 63; const float own = qs[64 + F.lane], par = qs[64 + (F.lane ^ 8)];
        const float cs = t32[((c < 2 ? gr : gc) * 8 + e) * 2], sn = t32[((c < 2 ? gr : gc) * 8 + e) * 2 + 1];
        const float nv = (c & 1) == 0 ? own * cs - par * sn : par * sn + own * cs;
        asm volatile("s_waitcnt lgkmcnt(0)" ::: "memory"); qs[64 + F.lane] = nv; }
    asm volatile("s_waitcnt lgkmcnt(0)" ::: "memory");
    const float scale = var == 3 ? 0.10206207261596575f : 0.125f;
    const int gr = t >> 6, gc = t & 63, r0 = min(max(gr - 4, 0), 56), c0 = min(max(gc - 8, 0), 48);
    float m = -3.0e38f, lsum = 0.f, acc[64];
#pragma unroll
    for (int d = 0; d < 64; ++d) acc[d] = 0.f;
    for (int j = F.lane; j < TT; j += 64) {
        bool ok = true; float bias = 0.f;
        if (!lat) ok = j >= SEQ;
        else if (j < SEQ) {
            if (var == 0) { const int kr = j >> 6, kc2 = j & 63; ok = kr >= r0 && kr <= r0 + 7 && kc2 >= c0 && kc2 <= c0 + 15;
                if (ok) bias = INP(I_NABIAS)[((l * 4 + h) * 15 + (kr - gr + 7)) * 31 + (kc2 - gc + 15)]; }
            else if (var == 2) ok = (j - t <= 128) && (t - j <= 128);
        }
        if (!ok) continue;
        float sc = 0.f; const bf16* kr_ = kp + (size_t)j * kpitch;
        for (int d = 0; d < dk; ++d) sc += qs[d] * __builtin_bit_cast(float, (unsigned)kr_[d] << 16);
        sc = sc * scale + bias;
        const float mn = fmaxf(m, sc), a = expf(m - mn), p = expf(sc - mn); m = mn; lsum = lsum * a + p;
        const bf16* vr = vp + (size_t)j * vpitch;
#pragma unroll
        for (int d = 0; d < 64; ++d) acc[d] = acc[d] * a + p * __builtin_bit_cast(float, (unsigned)vr[d] << 16);
    }
    float mg = m;
#pragma unroll
    for (int o = 1; o < 64; o <<= 1) mg = fmaxf(mg, __shfl_xor(mg, o));
    if (mode >= 1) {
        const unsigned* rec = (const unsigned*)(F.ws + WS_RS) + (size_t)r * 2; const float mk = __builtin_bit_cast(float, rec[0]), lk = __builtin_bit_cast(float, rec[1]);
        const float lref = wave_sum(lsum * expf(m - mg));
        const float lker = lk * exp2f(mk - mg * LOG2E);
        if (mode == 2) return fabsf(mk / LOG2E - mg);
        return fabsf(lker / lref - 1.0f);
    }
    const float f = expf(m - mg); lsum *= f; lsum = wave_sum(lsum);
    if (var == 2) lsum += expf(INP(I_SINK)[l * 4 + h] - mg);
    float err = 0.f, mag = 1.0e-6f;
    const bf16* orow = O + (size_t)r * D + var * 256 + h * 64;
#pragma unroll
    for (int d = 0; d < 64; ++d) { const float ref = wave_sum(acc[d] * f) / lsum; const float got = __builtin_bit_cast(float, (unsigned)orow[d] << 16);
        const float df = fabsf(got - ref); err = (df == df) ? fmaxf(err, df) : 1.0e30f; mag = fmaxf(mag, fabsf(ref)); }
    return err / mag;
}
__device__ __forceinline__ void phase_dump(const Frame& F, int code) {
    float* out = (float*)ptab_get(F, I_OUT);
    for (int r = F.gw; r < M; r += F.ngw) {
        const int b = r / TT, t = r - b * TT; if (t >= SEQ) continue;
        float v[16];
        if (code == 1) ld16bf((const bf16*)(F.ws + WS_HA) + (size_t)r * D, F.lane, v);
        else if (code == 2) ld16bf((const bf16*)(F.ws + WS_PB) + (size_t)r * NPJ, F.lane, v);
        else if (code == 3) ld16bf((const bf16*)(F.ws + WS_PB) + (size_t)r * NPJ + 1024, F.lane, v);
        else if (code == 4) ld16bf((const bf16*)(F.ws + WS_PB) + (size_t)r * NPJ + 1280, F.lane, v);
        else if (code == 5) ld16((const float*)(F.ws + WS_PB) + (size_t)r * D, F.lane, v);
        else if (code == 8) {
            const v4u w0 = *((const v4u*)((const bf16*)(F.ws + WS_HA) + (size_t)r * D) + F.lane), w1 = *((const v4u*)((const bf16*)(F.ws + WS_HA) + (size_t)r * D) + 64 + F.lane);
            float f[8]; int bad0 = 0, bad1 = 0; unpack8(w0, f);
#pragma unroll
            for (int i = 0; i < 8; ++i) { const unsigned u = __builtin_bit_cast(unsigned, f[i]); bad0 |= ((u & 0x7f800000u) == 0x7f800000u) ? 1 : 0; }
            unpack8(w1, f);
#pragma unroll
            for (int i = 0; i < 8; ++i) { const unsigned u = __builtin_bit_cast(unsigned, f[i]); bad1 |= ((u & 0x7f800000u) == 0x7f800000u) ? 1 : 0; }
            const unsigned long long m0 = __ballot(bad0), m1 = __ballot(bad1);
            const bool vA = (m0 & 0xffffffffull) != 0, vB = (m0 >> 32) != 0, vC = (m1 & 0xffffffffull) != 0, vD = (m1 >> 32) != 0;
            const float val = (float)(t + 1) * ((vA ? 1.0f : 0.f) + (vB ? 1.0e2f : 0.f) + (vC ? 1.0e4f : 0.f) + (vD ? 1.0e6f : 0.f));
#pragma unroll
            for (int i = 0; i < 16; ++i) v[i] = val;
        }
        else if (code == 9) { const unsigned cd = ((const unsigned*)(F.ws + WS_RS))[(size_t)r * 2]; float val = 0.f; if (cd) { val = 1.f; for (unsigned k = 0; k < cd; ++k) val *= 10.f; }
#pragma unroll
            for (int i = 0; i < 16; ++i) v[i] = val; }
        else if (code == 10) {
            const v4u w1 = *((const v4u*)((const bf16*)(F.ws + WS_HA) + (size_t)r * D) + 64 + F.lane);
            float f[8]; int bad1 = 0; unpack8(w1, f);
#pragma unroll
            for (int i = 0; i < 8; ++i) { const unsigned u = __builtin_bit_cast(unsigned, f[i]); bad1 |= ((u & 0x7f800000u) == 0x7f800000u) ? 1 : 0; }
            const bool vC = (__ballot(bad1) & 0xffffffffull) != 0;
            const bf16* pc = (const bf16*)(F.ws + WS_PB) + ((size_t)b * TT + SEQ + (t & 255)) * NPJ; int badp = 0;
            for (int c = F.lane; c < 288; c += 64) { const v4u w = *((const v4u*)pc + c); unpack8(w, f);
#pragma unroll
                for (int i = 0; i < 8; ++i) { const unsigned u = __builtin_bit_cast(unsigned, f[i]); badp |= ((u & 0x7f800000u) == 0x7f800000u) ? 1 : 0; } }
            float val = 0.f; if (vC) { val = 1.f; for (int k = 0; k <= (t & 15); ++k) val *= 10.f; }
            if (__any(badp)) val = 1.0e30f;
#pragma unroll
            for (int i = 0; i < 16; ++i) v[i] = val;
        }
        else if (code == 11) {
            const bf16* pr = (const bf16*)(F.ws + WS_PB) + (size_t)r * NPJ; int grp = -1;
            for (int c = F.lane; c < 288; c += 64) { const v4u w = *((const v4u*)pr + c); float f[8]; unpack8(w, f);
#pragma unroll
                for (int i = 0; i < 8; ++i) if (!(fabsf(f[i]) < 1.0e4f)) grp = (c * 8) >> 8; }
#pragma unroll
            for (int o = 1; o < 64; o <<= 1) { const int g2 = __shfl_xor(grp, o); grp = g2 > grp ? g2 : grp; }
            float val = 0.f; if (grp >= 0) { val = 100.f; for (int k = 0; k < grp; ++k) val *= 10.f; }
#pragma unroll
            for (int i = 0; i < 16; ++i) v[i] = val;
        }
        else if (code >= 20 && code < 24) {
            float val = 0.f;
            if ((t & 15) == 5) { for (int h = 0; h < 4; ++h) { const float e = oracle_attn(F, 0, r, code - 20, h); const float cls = e > 1.0e20f ? 3.f : e > 0.5f ? 2.f : e > 0.03f ? 1.f : 0.f; if (cls > 0.f) { float w = cls; for (int k = 0; k <= h; ++k) w *= 10.f; val = fmaxf(val, w); } } }
#pragma unroll
            for (int i = 0; i < 16; ++i) v[i] = val;
        }
        else if (code >= 30 && code < 46) {
            float val = 0.f;
            if ((t & 15) == 5) { const float e = oracle_attn(F, 0, r, (code - 30) >> 2, (code - 30) & 3, DBG_MODE); val = e > 10.f ? 1.0e4f : 1000.f * e; }
#pragma unroll
            for (int i = 0; i < 16; ++i) v[i] = val;
        }
        else if (code == 7) {
            auto bad16 = [&](const bf16* p, int nchunks) { int bad = 0; for (int c = F.lane; c < nchunks; c += 64) { const v4u w = *((const v4u*)p + c); float f[8]; unpack8(w, f);
#pragma unroll
                for (int i = 0; i < 8; ++i) { const unsigned u = __builtin_bit_cast(unsigned, f[i]); bad |= ((u & 0x7f800000u) == 0x7f800000u) ? 1 : 0; } } return __any(bad); };
            const int bP = bad16((const bf16*)(F.ws + WS_PB) + (size_t)r * NPJ, 288), bQ = bad16((const bf16*)(F.ws + WS_QD) + (size_t)r * 384, 48),
                      bK = bad16((const bf16*)(F.ws + WS_KD) + (size_t)r * 384, 48), bV = bad16((const bf16*)(F.ws + WS_VD) + (size_t)r * 256, 32), bO = bad16((const bf16*)(F.ws + WS_HA) + (size_t)r * D, 128);
            const float val = bP ? 1.0e6f : bQ ? 1.0e5f : bK ? 1.0e4f : bV ? 1.0e3f : bO ? 1.0e2f : 0.f;
#pragma unroll
            for (int i = 0; i < 16; ++i) v[i] = val;
        }
#pragma unroll
        for (int i = 0; i < 16; ++i) { const unsigned u = __builtin_bit_cast(unsigned, v[i]); if ((u & 0x7f800000u) == 0x7f800000u) v[i] = 777.0f; }
        st16(out + ((size_t)b * SEQ + t) * D, F.lane, v);
    }
}
static __device__ __forceinline__ void ph_dump(GAS unsigned char* ws, int code) { const Frame F = make_frame(ws); phase_dump(F, code); }
#endif
__global__ void __launch_bounds__(NTHR, 2) mk_fwd(Args args) {
    extern __shared__ __attribute__((aligned(16))) unsigned char lds_raw[];
    LAS unsigned char* lds = (LAS unsigned char*)lds_raw; volatile LAS unsigned* MISC = (volatile LAS unsigned*)(lds + MISC_OFF);
    const int tid = threadIdx.x;
    GAS unsigned char* ws = (GAS unsigned char*)args.ws;
    for (int u = tid; u < (LDS_BYTES - MISC_OFF) / 4; u += NTHR) MISC[u] = 0u;
    __syncthreads();
    if (tid < 28) { const unsigned long long p = tid < 27 ? (unsigned long long)args.in[tid] : (unsigned long long)args.out;
        LAS unsigned* t = (LAS unsigned*)(lds + PTAB_OFF) + 2 * tid; t[0] = (unsigned)p; t[1] = (unsigned)(p >> 32); }
    __syncthreads();
#if MK_MULTI
#define GRID_BAR() do { } while (0)
#else
    XcdBarrier bar = xcd_barrier_post((unsigned*)(ws + WS_CTL) + CW_BAR, MISC + MI_BAR);
#define GRID_BAR() xcd_barrier(bar)
#endif
    const int lo = args.ph_lo, hi = args.ph_hi;
#define IN(k) (lo <= (k) && (k) < hi)
#if MK_TIME
    unsigned long long tcat = 0ull, tb0 = 0ull;
#define TBEG() do { tb0 = __builtin_amdgcn_s_memrealtime(); } while (0)
#define TEND(c) do { if ((c) == MK_TIME - 1) tcat += __builtin_amdgcn_s_memrealtime() - tb0; } while (0)
#define SEAM(k) do { if (IN(k) && IN((k) + 1)) { TBEG(); GRID_BAR(); TEND(1); } } while (0)
#else
#define TBEG() do { } while (0)
#define TEND(c) do { } while (0)
#define SEAM(k) do { if (IN(k) && IN((k) + 1)) GRID_BAR(); } while (0)
#endif

#if MK_DEBUG
    if (lo >= 100) { ph_dump(ws, lo - 100); return; }
#endif
    if (IN(0)) { TBEG(); ph_prologue(ws); TEND(2); } SEAM(0);
    for (int l = 0; l < NL; ++l) {
        const int pb = 1 + 10 * l;
        if (IN(pb + 0)) { TBEG(); ph_ln(ws, l); TEND(0); } SEAM(pb + 0);
        if (IN(pb + 1)) { TBEG(); ph_gemm_in(ws, l); if (MK_DUP & 2) { GRID_BAR(); ph_gemm_in(ws, l); } TEND(3); } SEAM(pb + 1);
        if (IN(pb + 2)) { TBEG(); ph_post(ws, l); TEND(0); } SEAM(pb + 2);
        if (IN(pb + 3)) { TBEG(); ph_gemm_mla(ws, l); if (MK_DUP & 8) { GRID_BAR(); ph_gemm_mla(ws, l); } TEND(3); } SEAM(pb + 3);
        if (IN(pb + 4)) { TBEG(); ph_attn<0>(ws, l); if (MK_DUP & 16) { GRID_BAR(); ph_attn<MK_VM>(ws, l + 4); } TEND(4); } SEAM(pb + 4);
        if (IN(pb + 5)) { TBEG(); ph_gemm_out(ws, l); if (MK_DUP & 32) { GRID_BAR(); ph_gemm_out(ws, l); } TEND(3); } SEAM(pb + 5);
        if (IN(pb + 6)) { TBEG(); ph_route(ws, l); TEND(0); } SEAM(pb + 6);
        if (IN(pb + 7)) { TBEG(); ph_permute(ws, l); if (MK_DUP & 128) { GRID_BAR(); ph_permute(ws, l); } TEND(0); } SEAM(pb + 7);
        if (IN(pb + 8)) { TBEG(); ph_gemm_gu(ws, l); if (MK_DUP & 256) { GRID_BAR(); ph_gemm_gu(ws, l); } TEND(3); } SEAM(pb + 8);
        if (IN(pb + 9)) { TBEG(); ph_gemm_dn(ws, l); if (MK_DUP & 512) { GRID_BAR(); ph_gemm_dn(ws, l); } TEND(3); } SEAM(pb + 9);
    }
    if (IN(NPHASE - 1)) { TBEG(); ph_ln(ws, NL); TEND(0); }
#if MK_TIME
    if (blockIdx.x == 0) { const unsigned long long tw = __builtin_amdgcn_s_memrealtime(); const unsigned long long dl = tcat * (unsigned long long)MK_TMUL; while (__builtin_amdgcn_s_memrealtime() - tw < dl) __builtin_amdgcn_s_sleep(8); }
#endif
#undef IN
#undef SEAM
#undef GRID_BAR
}

extern "C" void kernel_launch(void* const* d_in, const int* in_sizes, int n_in, void* d_out, int out_size, void* d_ws, size_t ws_size, hipStream_t stream) {
    static int grid = 0;
    if (grid == 0) {
        if (n_in != 27 || out_size != NB * SEQ * D || ws_size < WS_END) { fprintf(stderr, "kernel_launch: unexpected problem (n_in %d, out %d, ws %zu < %zu)\n", n_in, out_size, ws_size, (size_t)WS_END); grid = -1; return; }
        int dev = 0, cus = 0, per_cu = 0;
        if (hipGetDevice(&dev) != hipSuccess || hipDeviceGetAttribute(&cus, hipDeviceAttributeMultiprocessorCount, dev) != hipSuccess) { grid = -1; return; }
        if (hipFuncSetAttribute((const void*)mk_fwd, hipFuncAttributeMaxDynamicSharedMemorySize, LDS_BYTES) != hipSuccess) { fprintf(stderr, "kernel_launch: hipFuncSetAttribute failed\n"); grid = -1; return; }
        if (hipOccupancyMaxActiveBlocksPerMultiprocessor(&per_cu, (const void*)mk_fwd, NTHR, LDS_BYTES) != hipSuccess || per_cu < 1) fprintf(stderr, "kernel_launch: occupancy query reports %d\n", per_cu);
        (void)hipGetLastError();
        grid = cus > 1024 ? 1024 : cus;
    }
    if (grid < 0) return;
    (void)hipMemsetAsync((char*)d_ws + WS_CTL, 0, CTL_BYTES, stream);
    Args a{};
    for (int i = 0; i < 27; ++i) a.in[i] = (const float*)d_in[i];
    a.out = (float*)d_out; a.ws = (unsigned char*)d_ws;
#if MK_MULTI
#ifndef DBG_NRUN
#define DBG_NRUN NPHASE
#endif
    for (int p = 0; p < DBG_NRUN; ++p) { a.ph_lo = p; a.ph_hi = p + 1; hipLaunchKernelGGL(mk_fwd, dim3(grid), dim3(NTHR), LDS_BYTES, stream, a); }
#ifdef DBG_DUMP
    a.ph_lo = 100 + DBG_DUMP; a.ph_hi = 101 + DBG_DUMP; hipLaunchKernelGGL(mk_fwd, dim3(grid), dim3(NTHR), LDS_BYTES, stream, a);
#endif
#else
    a.ph_lo = 0; a.ph_hi = NPHASE;
    hipLaunchKernelGGL(mk_fwd, dim3(grid), dim3(NTHR), LDS_BYTES, stream, a);
#endif
}
```
